# Optimizing an MI355X kernel written in HIP

```python
import math
import jax, jax.numpy as jnp
from jax import lax
import numpy as np

D_MODEL = 1024
BATCH = 16
SEQ = 4096
DEPTH = 2
DEC_BATCH = 16
DEC_SEQ = 16
PAST_LEN = 4096

CHUNK = 64
SSD_D_INNER = 2 * D_MODEL
SSD_HEAD_DIM = 64
SSD_N_HEADS = SSD_D_INNER // SSD_HEAD_DIM
SSD_N_GROUPS = 8
SSD_D_STATE = 128
SSD_CONV = 4
SSD_CONV_DIM = SSD_D_INNER + 2 * SSD_N_GROUPS * SSD_D_STATE
ATT_HEAD_DIM = 64
ATT_HEADS = D_MODEL // ATT_HEAD_DIM
ATT_KV_HEADS = ATT_HEADS // 4
ATT_GROUP = ATT_HEADS // ATT_KV_HEADS
WINDOW = 128
N_BUCKETS = 32
MAX_DISTANCE = 128
SC_DIM = D_MODEL
SC_WIDTH = 3
N_EXPERTS = 32
TOP_K = 4
D_FF = D_MODEL
SWIGLU_LIMIT = 7.0
SWIGLU_ALPHA = 1.702
MOE_BLOCK = 128
LN_EPS = 1e-5
ALPHA = (2.0 * DEPTH) ** 0.25
BETA = (8.0 * DEPTH) ** -0.25
IN_SIZES = (SSD_D_INNER, SSD_CONV_DIM, SSD_N_HEADS,
            ATT_HEADS * ATT_HEAD_DIM, ATT_KV_HEADS * ATT_HEAD_DIM, ATT_KV_HEADS * ATT_HEAD_DIM,
            SC_DIM, SC_DIM, SC_DIM,
            D_MODEL, D_MODEL, D_MODEL)
D_IN = sum(IN_SIZES)

kernel_name = 'hybrid_ssd_swa_shortconv_moe_stream_step'


def _split_points():
    return [int(v) for v in np.cumsum(IN_SIZES)[:-1]]


def layer_norm(x, g, b):
    xf = x.astype(jnp.float32)
    mu = jnp.mean(xf, -1, keepdims=True)
    var = jnp.mean(jnp.square(xf - mu), -1, keepdims=True)
    return ((xf - mu) * lax.rsqrt(var + LN_EPS) * g.astype(jnp.float32) + b.astype(jnp.float32)).astype(x.dtype)


def group_rmsnorm(y, w):
    b, s, d = y.shape
    yf = y.astype(jnp.float32).reshape(b, s, SSD_N_GROUPS, d // SSD_N_GROUPS)
    yf = yf * lax.rsqrt(jnp.mean(yf * yf, -1, keepdims=True) + LN_EPS)
    return (yf.reshape(b, s, d) * w.astype(jnp.float32)).astype(y.dtype)


def causal_conv(u, hist, w):
    width = w.shape[0]
    s = u.shape[1]
    up = jnp.concatenate([hist, u], axis=1)
    y = up[:, 0:s] * w[0]
    for j in range(1, width):
        y = y + up[:, j:j + s] * w[j]
    return y, up[:, s:]


def ssd_scan(xdt, adt, bm, cm, init, chunk):
    b, s, h, p = xdt.shape
    g, n = SSD_N_GROUPS, SSD_D_STATE
    r = h // g
    nc = s // chunk
    f32 = jnp.float32
    x = xdt.astype(f32).reshape(b, nc, chunk, g, r, p)
    a = adt.astype(f32).reshape(b, nc, chunk, g, r)
    bc = bm.astype(f32).reshape(b, nc, chunk, g, n)
    cc = cm.astype(f32).reshape(b, nc, chunk, g, n)
    a_cs = jnp.cumsum(a, axis=2)
    seg = a_cs[:, :, :, None] - a_cs[:, :, None, :]
    causal = jnp.tril(jnp.ones((chunk, chunk), dtype=bool))[:, :, None, None]
    decay = jnp.exp(jnp.where(causal, seg, -jnp.inf))
    cb = jnp.einsum('bclgn,bcsgn->bclsg', cc, bc)
    y_diag = jnp.einsum('bclsg,bclsgr,bcsgrp->bclgrp', cb, decay, x)
    decay_to_end = jnp.exp(a_cs[:, :, -1:] - a_cs)
    chunk_states = jnp.einsum('bclgn,bclgr,bclgrp->bcgrpn', bc, decay_to_end, x)
    chunk_decay = jnp.exp(a_cs[:, :, -1])

    def step(carry, inp):
        st, dec = inp
        return carry * dec[..., None, None] + st, carry

    init_f = init.astype(f32).reshape(b, g, r, p, n)
    final, prev = lax.scan(step, init_f, (jnp.moveaxis(chunk_states, 1, 0), jnp.moveaxis(chunk_decay, 1, 0)))
    prev = jnp.moveaxis(prev, 0, 1)
    y_off = jnp.einsum('bclgn,bcgrpn,bclgr->bclgrp', cc, prev, jnp.exp(a_cs))
    y = (y_diag + y_off).reshape(b, s, h, p)
    return y, final.reshape(b, h, p, n)


def ssd_branch(z, xbc, dt_raw, hist, init_state, conv_w, conv_b, dt_bias, a_log, d_skip, norm_w, w_out, chunk):
    b, s, _ = z.shape
    xbc_c, new_hist = causal_conv(xbc, hist, conv_w)
    xbc_c = jax.nn.silu(xbc_c + conv_b)
    gn = SSD_N_GROUPS * SSD_D_STATE
    xs = xbc_c[..., :SSD_D_INNER].reshape(b, s, SSD_N_HEADS, SSD_HEAD_DIM)
    bm = xbc_c[..., SSD_D_INNER:SSD_D_INNER + gn].reshape(b, s, SSD_N_GROUPS, SSD_D_STATE)
    cm = xbc_c[..., SSD_D_INNER + gn:].reshape(b, s, SSD_N_GROUPS, SSD_D_STATE)
    dt = jax.nn.softplus(dt_raw.astype(jnp.float32) + dt_bias.astype(jnp.float32))
    a = -jnp.exp(a_log.astype(jnp.float32))
    y, final = ssd_scan(xs.astype(jnp.float32) * dt[..., None], dt * a, bm, cm, init_state, chunk)
    y = y + d_skip.astype(jnp.float32)[:, None] * xs.astype(jnp.float32)
    y = y.astype(z.dtype).reshape(b, s, SSD_D_INNER) * jax.nn.silu(z)
    y = group_rmsnorm(y, norm_w)
    return y @ w_out, new_hist, final.astype(z.dtype)


def t5_bucket(rel):
    half = N_BUCKETS // 2
    max_exact = half // 2
    ret = jnp.where(rel > 0, half, 0)
    n = jnp.abs(rel)
    nf = jnp.maximum(n, 1).astype(jnp.float32)
    large = max_exact + (jnp.log(nf / max_exact) / math.log(MAX_DISTANCE / max_exact) * (half - max_exact)).astype(jnp.int32)
    large = jnp.minimum(large, half - 1)
    return ret + jnp.where(n < max_exact, n, large)


def rel_bias_heads(rel, table):
    bias = table[t5_bucket(rel)].astype(jnp.float32)
    q, k = rel.shape
    return jnp.transpose(bias, (2, 0, 1)).reshape(ATT_KV_HEADS, ATT_GROUP, q, k)


def sink_softmax(scores, sink):
    sink = sink.astype(jnp.float32)
    m = jnp.maximum(jnp.max(scores, -1, keepdims=True), sink)
    e = jnp.exp(scores - m)
    return e / (jnp.sum(e, -1, keepdims=True) + jnp.exp(sink - m))


def swa_prompt(q, k, v, sinks, table):
    b, s = q.shape[:2]
    nc = s // CHUNK
    nprev = WINDOW // CHUNK
    kw = WINDOW + CHUNK
    qb = q.reshape(b, nc, CHUNK, ATT_KV_HEADS, ATT_GROUP, ATT_HEAD_DIM)
    pad = jnp.zeros((b, WINDOW, ATT_KV_HEADS, ATT_HEAD_DIM), k.dtype)
    kp = jnp.concatenate([pad, k], 1).reshape(b, nc + nprev, CHUNK, ATT_KV_HEADS, ATT_HEAD_DIM)
    vp = jnp.concatenate([pad, v], 1).reshape(b, nc + nprev, CHUNK, ATT_KV_HEADS, ATT_HEAD_DIM)
    kb = jnp.concatenate([kp[:, j:j + nc] for j in range(nprev + 1)], axis=2)
    vb = jnp.concatenate([vp[:, j:j + nc] for j in range(nprev + 1)], axis=2)
    qoff = jnp.arange(CHUNK)
    koff = jnp.arange(kw) - WINDOW
    bias = rel_bias_heads(koff[None, :] - qoff[:, None], table)
    valid = (jnp.arange(nc)[:, None] * CHUNK + koff[None, :]) >= 0
    scores = jnp.einsum('bcqhgd,bckhd->bchgqk', qb, kb).astype(jnp.float32) * (ATT_HEAD_DIM ** -0.5) + bias
    scores = jnp.where(valid[None, :, None, None, None, :], scores, -1e30)
    probs = sink_softmax(scores, sinks.reshape(ATT_KV_HEADS, ATT_GROUP, 1, 1))
    out = jnp.einsum('bchgqk,bckhd->bcqhgd', probs.astype(v.dtype), vb)
    return out.reshape(b, s, ATT_HEADS * ATT_HEAD_DIM)


def swa_sample(q, k_new, v_new, cache_k, cache_v, sinks, table):
    b, sd = q.shape[:2]
    kall = jnp.concatenate([cache_k, k_new], 1)
    vall = jnp.concatenate([cache_v, v_new], 1)
    qoff = jnp.arange(sd)
    koff = jnp.concatenate([jnp.arange(WINDOW) - WINDOW, jnp.arange(sd)])
    bias = rel_bias_heads(koff[None, :] - qoff[:, None], table)
    qg = q.reshape(b, sd, ATT_KV_HEADS, ATT_GROUP, ATT_HEAD_DIM)
    scores = jnp.einsum('bqhgd,bkhd->bhgqk', qg, kall).astype(jnp.float32) * (ATT_HEAD_DIM ** -0.5) + bias
    probs = sink_softmax(scores, sinks.reshape(ATT_KV_HEADS, ATT_GROUP, 1, 1))
    out = jnp.einsum('bhgqk,bkhd->bqhgd', probs.astype(vall.dtype), vall)
    return out.reshape(b, sd, ATT_HEADS * ATT_HEAD_DIM)


def clamped_swiglu(h):
    gate = jnp.minimum(h[..., :D_FF], SWIGLU_LIMIT)
    up = jnp.clip(h[..., D_FF:], -SWIGLU_LIMIT, SWIGLU_LIMIT)
    return (up + 1.0) * gate * jax.nn.sigmoid(SWIGLU_ALPHA * gate)


def moe(x, router_w, router_b, w_up, b_up, w_down, b_down):
    b, s, d = x.shape
    t = b * s
    xt = x.reshape(t, d)
    logits = (xt @ router_w).astype(jnp.float32) + router_b.astype(jnp.float32)
    top_v, top_i = lax.top_k(logits, TOP_K)
    gates = jax.nn.softmax(top_v, axis=-1).astype(x.dtype)
    n_assign = t * TOP_K
    flat_e = top_i.reshape(-1)
    order = jnp.argsort(flat_e)
    sorted_e = flat_e[order]
    sorted_tok = (order // TOP_K).astype(jnp.int32)
    sorted_gate = gates.reshape(-1)[order]
    counts = jnp.bincount(flat_e, length=N_EXPERTS)
    padded = (counts + MOE_BLOCK - 1) // MOE_BLOCK * MOE_BLOCK
    start = jnp.cumsum(counts) - counts
    pend = jnp.cumsum(padded)
    pstart = pend - padded
    dest = pstart[sorted_e] + jnp.arange(n_assign) - start[sorted_e]
    n_blocks = (n_assign + N_EXPERTS * (MOE_BLOCK - 1) + MOE_BLOCK - 1) // MOE_BLOCK
    rows = n_blocks * MOE_BLOCK
    row_tok = jnp.full((rows,), t, jnp.int32).at[dest].set(sorted_tok)
    row_gate = jnp.zeros((rows,), x.dtype).at[dest].set(sorted_gate)
    block_e = jnp.minimum(jnp.searchsorted(pend, jnp.arange(n_blocks) * MOE_BLOCK, side='right'), N_EXPERTS - 1)
    xpad = jnp.concatenate([xt, jnp.zeros((1, d), xt.dtype)], 0)

    def body(y, blk):
        tok, g, e = blk
        h = xpad[tok] @ w_up[e] + b_up[e]
        out = clamped_swiglu(h) @ w_down[e] + b_down[e]
        return y.at[tok].add(out * g[:, None]), None

    y0 = jnp.zeros((t + 1, d), x.dtype)
    y, _ = lax.scan(body, y0, (row_tok.reshape(n_blocks, MOE_BLOCK), row_gate.reshape(n_blocks, MOE_BLOCK), block_e))
    return y[:t].reshape(b, s, d)


def trunk_layer(x, ssd_hist, ssd_state, sc_hist, kv_cache, rel_bias,
                w_in, ssd_conv_w, ssd_conv_b, dt_bias, a_log, d_skip, ssd_norm_w, w_ssd_out,
                sinks, w_att_out, sc_w, w_sc_out, w_o, ln1_g, ln1_b,
                router_w, router_b, w_up, b_up, w_down, b_down, ln2_g, ln2_b):
    b, s, _ = x.shape
    h = x @ w_in
    (z, xbc, dt_raw, q, k, v, sc_b, sc_c, sc_h, g_ssd, g_att, g_sc) = jnp.split(h, _split_points(), axis=-1)
    k = k.reshape(b, s, ATT_KV_HEADS, ATT_HEAD_DIM)
    v = v.reshape(b, s, ATT_KV_HEADS, ATT_HEAD_DIM)
    if kv_cache is None:
        att = swa_prompt(q, k, v, sinks, rel_bias)
        new_k, new_v = k[:, -WINDOW:], v[:, -WINDOW:]
        chunk = CHUNK
    else:
        att = swa_sample(q, k, v, kv_cache[0], kv_cache[1], sinks, rel_bias)
        new_k, new_v = k, v
        chunk = s
    y_ssd, new_ssd_hist, new_ssd_state = ssd_branch(z, xbc, dt_raw, ssd_hist, ssd_state, ssd_conv_w, ssd_conv_b,
                                                    dt_bias, a_log, d_skip, ssd_norm_w, w_ssd_out, chunk)
    sc_conv, new_sc_hist = causal_conv(sc_c * sc_h, sc_hist, sc_w)
    y_sc = (sc_b * sc_conv) @ w_sc_out
    y_att = att @ w_att_out
    merged = jax.nn.sigmoid(g_ssd) * y_ssd + jax.nn.sigmoid(g_att) * y_att + jax.nn.sigmoid(g_sc) * y_sc
    x = layer_norm(ALPHA * x + merged @ w_o, ln1_g, ln1_b)
    x = layer_norm(ALPHA * x + moe(x, router_w, router_b, w_up, b_up, w_down, b_down), ln2_g, ln2_b)
    return x, new_k, new_v, new_ssd_state, new_ssd_hist, new_sc_hist


def setup_inputs(seed: int = 0) -> dict:
    key = jax.random.key(seed)
    ks = iter(jax.random.split(key, 40))
    f32 = jnp.float32

    def nrm(shape, scale):
        return jax.random.normal(next(ks), shape, f32) * scale

    v_start = SSD_D_INNER + SSD_CONV_DIM + SSD_N_HEADS + ATT_HEADS * ATT_HEAD_DIM + ATT_KV_HEADS * ATT_HEAD_DIM
    v_size = ATT_KV_HEADS * ATT_HEAD_DIM
    col_scale = jnp.concatenate([jnp.ones((v_start,), f32), jnp.full((v_size,), BETA, f32),
                                 jnp.ones((D_IN - v_start - v_size,), f32)])
    dt0 = jnp.exp(jax.random.uniform(next(ks), (DEPTH, SSD_N_HEADS), f32) * (math.log(0.1) - math.log(0.001)) + math.log(0.001))
    return {
        'x_prompt': nrm((BATCH, SEQ, D_MODEL), 1.0),
        'x_sample': nrm((DEC_BATCH, DEC_SEQ, D_MODEL), 1.0),
        'cache_attn_k': nrm((DEPTH, DEC_BATCH, WINDOW, ATT_KV_HEADS, ATT_HEAD_DIM), 1.0),
        'cache_attn_v': nrm((DEPTH, DEC_BATCH, WINDOW, ATT_KV_HEADS, ATT_HEAD_DIM), BETA),
        'state_ssd': nrm((DEPTH, DEC_BATCH, SSD_N_HEADS, SSD_HEAD_DIM, SSD_D_STATE), 0.1),
        'state_ssd_conv': nrm((DEPTH, DEC_BATCH, SSD_CONV - 1, SSD_CONV_DIM), 1.0),
        'state_short_conv': nrm((DEPTH, DEC_BATCH, SC_WIDTH - 1, SC_DIM), 1.0),
        'w_in': nrm((DEPTH, D_MODEL, D_IN), D_MODEL ** -0.5) * col_scale,
        'ssd_conv_w': nrm((DEPTH, SSD_CONV, SSD_CONV_DIM), SSD_CONV ** -0.5),
        'ssd_conv_b': nrm((DEPTH, SSD_CONV_DIM), 0.02),
        'ssd_dt_bias': dt0 + jnp.log(-jnp.expm1(-dt0)),
        'ssd_a_log': jnp.log(jax.random.uniform(next(ks), (DEPTH, SSD_N_HEADS), f32, 1.0, 16.0)),
        'ssd_d': 1.0 + nrm((DEPTH, SSD_N_HEADS), 0.1),
        'ssd_norm_w': 1.0 + nrm((DEPTH, SSD_D_INNER), 0.02),
        'w_ssd_out': nrm((DEPTH, SSD_D_INNER, D_MODEL), BETA * SSD_D_INNER ** -0.5),
        'attn_sinks': nrm((DEPTH, ATT_HEADS), 0.5),
        'w_attn_out': nrm((DEPTH, ATT_HEADS * ATT_HEAD_DIM, D_MODEL), BETA * (ATT_HEADS * ATT_HEAD_DIM) ** -0.5),
        'rel_bias': nrm((N_BUCKETS, ATT_HEADS), 0.5),
        'sc_conv_w': nrm((DEPTH, SC_WIDTH, SC_DIM), SC_WIDTH ** -0.5),
        'w_sc_out': nrm((DEPTH, SC_DIM, D_MODEL), BETA * SC_DIM ** -0.5),
        'w_o': nrm((DEPTH, D_MODEL, D_MODEL), BETA * D_MODEL ** -0.5),
        'ln1_g': 1.0 + nrm((DEPTH, D_MODEL), 0.02),
        'ln1_b': nrm((DEPTH, D_MODEL), 0.02),
        'router_w': nrm((DEPTH, D_MODEL, N_EXPERTS), D_MODEL ** -0.5),
        'router_b': nrm((DEPTH, N_EXPERTS), 0.01),
        'w_up': nrm((DEPTH, N_EXPERTS, D_MODEL, 2 * D_FF), BETA * D_MODEL ** -0.5),
        'b_up': nrm((DEPTH, N_EXPERTS, 2 * D_FF), 0.02),
        'w_down': nrm((DEPTH, N_EXPERTS, D_FF, D_MODEL), BETA * D_FF ** -0.5),
        'b_down': nrm((DEPTH, N_EXPERTS, D_MODEL), 0.02),
        'ln2_g': 1.0 + nrm((DEPTH, D_MODEL), 0.02),
        'ln2_b': nrm((DEPTH, D_MODEL), 0.02),
    }


def reference(x_prompt, x_sample, cache_attn_k, cache_attn_v, state_ssd, state_ssd_conv, state_short_conv,
              w_in, ssd_conv_w, ssd_conv_b, ssd_dt_bias, ssd_a_log, ssd_d, ssd_norm_w, w_ssd_out,
              attn_sinks, w_attn_out, rel_bias, sc_conv_w, w_sc_out, w_o, ln1_g, ln1_b,
              router_w, router_b, w_up, b_up, w_down, b_down, ln2_g, ln2_b):
    bp = x_prompt.shape[0]
    dt = x_prompt.dtype
    yp, ys = x_prompt, x_sample
    kp, vp, sp, cp, scp = [], [], [], [], []
    kd, vd, sd, cd, scd = [], [], [], [], []
    for l in range(DEPTH):
        lp = (w_in[l], ssd_conv_w[l], ssd_conv_b[l], ssd_dt_bias[l], ssd_a_log[l], ssd_d[l], ssd_norm_w[l],
              w_ssd_out[l], attn_sinks[l], w_attn_out[l], sc_conv_w[l], w_sc_out[l], w_o[l], ln1_g[l], ln1_b[l],
              router_w[l], router_b[l], w_up[l], b_up[l], w_down[l], b_down[l], ln2_g[l], ln2_b[l])
        yp, k_, v_, s_, c_, sc_ = trunk_layer(
            yp, jnp.zeros((bp, SSD_CONV - 1, SSD_CONV_DIM), dt),
            jnp.zeros((bp, SSD_N_HEADS, SSD_HEAD_DIM, SSD_D_STATE), dt),
            jnp.zeros((bp, SC_WIDTH - 1, SC_DIM), dt), None, rel_bias, *lp)
        kp.append(k_); vp.append(v_); sp.append(s_); cp.append(c_); scp.append(sc_)
        ys, k_, v_, s_, c_, sc_ = trunk_layer(
            ys, state_ssd_conv[l], state_ssd[l], state_short_conv[l],
            (cache_attn_k[l], cache_attn_v[l]), rel_bias, *lp)
        kd.append(k_); vd.append(v_); sd.append(s_); cd.append(c_); scd.append(sc_)
    return (yp, ys,
            jnp.stack(kp), jnp.stack(vp), jnp.stack(sp), jnp.stack(cp), jnp.stack(scp),
            jnp.stack(kd), jnp.stack(vd), jnp.stack(sd), jnp.stack(cd), jnp.stack(scd))
```

```cpp
#ifdef EMU
#include "emu.h"
#else
#include <hip/hip_runtime.h>
#endif
#include <cstdio>
#include <cstdint>
#include <cstring>
#include <cstddef>
#include <cmath>

#ifndef CFG_BATCH
#define CFG_BATCH 16
#endif
#ifndef CFG_SEQ
#define CFG_SEQ 4096
#endif
#ifndef CFG_NSEQ_MB
#define CFG_NSEQ_MB 8
#endif
#ifndef CFG_NEXP
#define CFG_NEXP 32
#endif
#ifndef CFG_ONE_LAUNCH
#define CFG_ONE_LAUNCH 0
#endif

constexpr int BATCH = CFG_BATCH, SEQ = CFG_SEQ, NSEQ_MB = CFG_NSEQ_MB, NEXP = CFG_NEXP, NMB = BATCH / NSEQ_MB;
constexpr int D = 1024, DEPTH = 2, DECB = 16, DECS = 16, NS = DECB * DECS;
constexpr int DINNER = 2048, CONVDIM = 4096;
constexpr int NKV = 4, WINDOW = 128, CHUNK = 64;
constexpr int DIN = 13856, DINP = 14080;
constexpr int NP = NSEQ_MB * SEQ, R = NP + NS;
constexpr int RP = ((4 * R + NEXP * 255) + 255) / 256 * 256;
constexpr int NCHUNK = SEQ / CHUNK;
constexpr int C_Z = 0, C_X = 2048, C_B = 4096, C_C = 5120, C_Q = 6144, C_K = 7168, C_V = 7424, C_SCB = 7680, C_SCC = 8704, C_SCH = 9728, C_GSSD = 10752, C_GATT = 11776, C_GSC = 12800, C_DT = 13824;
constexpr float LN_EPS = 1e-5f, ALPHA = 1.41421356237309515f  , SW_LIMIT = 7.0f, SW_ALPHA = 1.702f;
static_assert(BATCH % NSEQ_MB == 0 && SEQ % 256 == 0 && (NEXP & (NEXP - 1)) == 0 && NEXP <= 32 && NEXP >= 4, "config");

constexpr size_t O_YP = 0, O_YS = O_YP + (size_t)BATCH * SEQ * D, O_KP = O_YS + (size_t)NS * D, O_VP = O_KP + (size_t)DEPTH * BATCH * WINDOW * 256,
    O_SSP = O_VP + (size_t)DEPTH * BATCH * WINDOW * 256, O_CVP = O_SSP + (size_t)DEPTH * BATCH * 32 * 64 * 128, O_SCP = O_CVP + (size_t)DEPTH * BATCH * 3 * CONVDIM,
    O_KS = O_SCP + (size_t)DEPTH * BATCH * 2 * D, O_VS = O_KS + (size_t)DEPTH * DECB * DECS * 256, O_SSS = O_VS + (size_t)DEPTH * DECB * DECS * 256,
    O_CVS = O_SSS + (size_t)DEPTH * DECB * 32 * 64 * 128, O_SCS = O_CVS + (size_t)DEPTH * DECB * 3 * CONVDIM, O_END = O_SCS + (size_t)DEPTH * DECB * 2 * D;

constexpr size_t al256(size_t x) { return (x + 255) / 256 * 256; }
constexpr size_t WS_CTL = 0, CTL_BYTES = 1u << 20;
constexpr size_t WS_SSQ = CTL_BYTES, WS_TOPI = WS_SSQ + al256((size_t)R * 32 * 4), WS_GATE = WS_TOPI + al256((size_t)R * 16), WS_POS = WS_GATE + al256((size_t)R * 16),
    WS_GSORT = WS_POS + al256((size_t)R * 16), WS_W = WS_GSORT + al256((size_t)RP * 4);
constexpr size_t WL_IN = 0, WL_SSD = WL_IN + (size_t)DINP * D * 2, WL_ATT = WL_SSD + (size_t)D * DINNER * 2, WL_SC = WL_ATT + (size_t)D * D * 2, WL_O = WL_SC + (size_t)D * D * 2,
    WL_UP = WL_O + (size_t)D * D * 2, WL_DN = WL_UP + (size_t)NEXP * 2048 * D * 2, WL_BYTES = WL_DN + (size_t)NEXP * D * D * 2;
constexpr size_t WS_XB = WS_W + DEPTH * WL_BYTES, WS_H = WS_XB + (size_t)R * D * 2;
constexpr size_t H_BYTES = (size_t)R * DINP * 2, MOE_BYTES = (size_t)3 * RP * D * 2, U_BYTES = H_BYTES > MOE_BYTES ? H_BYTES : MOE_BYTES;
constexpr size_t WS_END = WS_H + U_BYTES;
static_assert(WS_END <= ((size_t)2 << 30), "workspace map exceeds 2 GiB");
constexpr int CW_BAR = 4096, CW_CNT = 16384;

constexpr int RING_BYTES = 131072, MISC_OFF = RING_BYTES + 320, LDS_BYTES = 147456;
constexpr int NWAVES = 8, NTHREADS = 512;

#ifdef EMU
#define LAS
#define WAVE_SYNC() emu_wave_barrier()
#else
#define LAS __attribute__((address_space(3)))
#define WAVE_SYNC() asm volatile("s_waitcnt lgkmcnt(0)" ::: "memory")
#endif
typedef unsigned short bf16_t;
typedef short bf16x8 __attribute__((ext_vector_type(8)));
typedef float f32x4 __attribute__((ext_vector_type(4)));
typedef float f32x16 __attribute__((ext_vector_type(16)));
typedef unsigned u32x4 __attribute__((ext_vector_type(4)));
typedef unsigned u32x2 __attribute__((ext_vector_type(2)));

__device__ __forceinline__ unsigned f2bf(float f) { unsigned u = __builtin_bit_cast(unsigned, f); return (u + 0x7fffu + ((u >> 16) & 1u)) >> 16; }
__device__ __forceinline__ float bf2f(unsigned h) { return __builtin_bit_cast(float, (h & 0xffffu) << 16); }
#ifdef EMU
__device__ __forceinline__ unsigned pk2(float lo, float hi) { return f2bf(lo) | (f2bf(hi) << 16); }
#else
typedef float f32x2_t __attribute__((ext_vector_type(2))); typedef __bf16 bf16x2_t __attribute__((ext_vector_type(2)));
__device__ __forceinline__ unsigned pk2(float lo, float hi) { f32x2_t v = {lo, hi}; bf16x2_t b = __builtin_convertvector(v, bf16x2_t); return __builtin_bit_cast(unsigned, b); }
#endif
__device__ __forceinline__ float blo(unsigned w) { return __builtin_bit_cast(float, w << 16); }
__device__ __forceinline__ float bhi(unsigned w) { return __builtin_bit_cast(float, w & 0xffff0000u); }
__device__ __forceinline__ void unpack8(const u32x4 w, float* f) { f[0] = blo(w.x); f[1] = bhi(w.x); f[2] = blo(w.y); f[3] = bhi(w.y); f[4] = blo(w.z); f[5] = bhi(w.z); f[6] = blo(w.w); f[7] = bhi(w.w); }
__device__ __forceinline__ u32x4 pack8(const float* f) { u32x4 w; w.x = pk2(f[0], f[1]); w.y = pk2(f[2], f[3]); w.z = pk2(f[4], f[5]); w.w = pk2(f[6], f[7]); return w; }
__device__ __forceinline__ float fexp(float x) { return __builtin_amdgcn_exp2f(x * 1.4426950408889634f); }
__device__ __forceinline__ float fsigmoid(float x) { return __builtin_amdgcn_rcpf(1.0f + __builtin_amdgcn_exp2f(-1.4426950408889634f * x)); }
__device__ __forceinline__ float fsilu(float x) { return x * fsigmoid(x); }
#ifdef EMU
__device__ __forceinline__ int opq(int x) { return x; }
#else
__device__ __forceinline__ int opq(int x) { asm volatile("" : "+v"(x)); return x; }
#endif
__device__ __forceinline__ float wave_sum(float v) {
#pragma unroll
    for (int o = 1; o < 64; o <<= 1) v += __shfl_xor(v, o);
    return v;
}

namespace pg8 {
constexpr int BM = 256, BK = 64, HALF = 128, HTB = HALF * BK * 2, NXCD = 8, WGM = 8;
struct Unit { int pm, pn, bt, e; };
struct Gemm { const bf16_t* A; const bf16_t* Bt; int M, N, K, lda; };
struct StaticOrder {
    int nM, nN, nwg, G, c;
    __host__ __device__ void init(int M, int N, int G_, int c_) { nM = M / BM; nN = N / BM; nwg = nM * nN; G = G_; c = c_; }
    __host__ __device__ bool next(int i, Unit& u) const {
        const long L = (long)i * G + c; if (L >= nwg) return false;
        int wgid = (int)L; { const int q = nwg / NXCD, r = nwg % NXCD, xcd = wgid % NXCD, off = wgid / NXCD; wgid = (xcd < r ? xcd * (q + 1) : r * (q + 1) + (xcd - r) * q) + off; }
        const int nig = WGM * nN, gid = wgid / nig, fm = gid * WGM, gsz = (nM - fm) < WGM ? (nM - fm) : WGM;
        u.pm = fm + ((wgid % nig) % gsz); u.pn = (wgid % nig) / gsz; u.bt = u.pn; u.e = 0; return true;
    }
    __device__ __forceinline__ void a_ready(const Unit&) const {}
    __device__ __forceinline__ void done(const Unit&) const {}
};
struct MoeOrder {
    const LAS int* tend; int npn, ntot, G, c;
    __device__ __forceinline__ bool next(int i, Unit& u) const {
        const long L = (long)i * G + c; if (L >= ntot) return false;
        const int rt = (int)L / npn, pn = (int)L % npn; int e = 0;
#pragma unroll
        for (int j = 0; j < NEXP; ++j) e += (tend[j] <= rt) ? 1 : 0;
        u.pm = rt; u.pn = pn; u.e = e; u.bt = e * npn + pn; return true;
    }
    __device__ __forceinline__ void a_ready(const Unit&) const {}
    __device__ __forceinline__ void done(const Unit&) const {}
};
#ifdef EMU
template <class Epi, class Sched>
__device__ void gemm_phase(LAS unsigned char* lds, const Gemm g, const Sched& S, const Epi& E) {
    const int tid = threadIdx.x, wid = tid >> 6, lane = tid & 63, wr = wid >> 2, wc = wid & 3, fr = lane & 15, fq = lane >> 4;
    Unit u;
    for (int i = 0; S.next(i, u); ++i) {
        f32x4 acc[2][2][4][2];
        for (int ai = 0; ai < 2; ++ai) for (int bj = 0; bj < 2; ++bj) for (int m = 0; m < 4; ++m) for (int n = 0; n < 2; ++n) for (int q = 0; q < 4; ++q) {
            const int row = u.pm * 256 + ai * 128 + wr * 64 + m * 16 + fr, col = u.bt * 256 + bj * 128 + wc * 32 + 8 * fq + 4 * n + q;
            const bf16_t* a = g.A + (size_t)row * g.lda; const bf16_t* b = g.Bt + (size_t)col * g.K; float s = 0.f;
            for (int k = 0; k < g.K; ++k) s += bf2f(a[k]) * bf2f(b[k]);
            acc[ai][bj][m][n][q] = s; }
        E(acc, u, wr, wc, fr, fq);
    }
    __syncthreads();
}
#else
#define PG8_LAS __attribute__((address_space(3)))
__host__ __device__ __forceinline__ int lds_byte(int r, int c) { const int st = (r >> 4) * 2 + (c >> 5), rr = r & 15, cc = c & 31, ob = rr * 64 + cc * 2; return st * 1024 + (ob ^ (((ob >> 9) & 1) << 5)); }
__host__ __device__ __forceinline__ void stage_rc(int b, int& R_, int& C_) { const int st = b / 1024, sb = b % 1024, swz = sb ^ (((sb >> 9) & 1) << 5); R_ = (st >> 1) * 16 + swz / 64; C_ = (st & 1) * 32 + (swz % 64) / 2; }
__host__ __device__ __forceinline__ int perm32(int rho) { const int n = rho >> 4, i = rho & 15; return 8 * (i >> 2) + 4 * n + (i & 3); }
template <class Epi, class Sched>
__device__ __forceinline__ void gemm_phase(PG8_LAS unsigned char* lds, const Gemm g, const Sched& S, const Epi& E) {
    const int tid = opq((int)threadIdx.x), wid = __builtin_amdgcn_readfirstlane(tid >> 6), lane = tid & 63, wr = wid >> 2, wc = wid & 3, fr = lane & 15, fq = lane >> 4;
    const int K = g.K, nt = K / BK, lda = g.lda;
    unsigned voffA[2], voffB[2];
#pragma unroll
    for (int i = 0; i < 2; ++i) { int R_, C_; stage_rc(tid * 16 + i * 8192, R_, C_); const int Rb = (R_ & ~31) + perm32(R_ & 31);
        voffA[i] = (unsigned)(R_ * lda + C_) * 2u; voffB[i] = (unsigned)(Rb * K + C_) * 2u; }
    const size_t kstep = (size_t)(BK * 2);
    const size_t hstepA = (size_t)HALF * lda * 2, tstepA = 2 * hstepA;
    const size_t hstepB = (size_t)HALF * K * 2, tstepB = 2 * hstepB;
    const unsigned ldsw = (unsigned)wid * 1024u;
    const int aoff = lds_byte(wr * 64 + fr, fq * 8), boff = lds_byte(wc * 32 + fr, fq * 8);
#define PG8_SA(b, h) (((b) * 2 + (h)) * HTB)
#define PG8_SB(b, h) ((4 + (b) * 2 + (h)) * HTB)
#define PG8_STAGE(bufoff, gbase, voff) do { _Pragma("unroll") for (int _i = 0; _i < 2; ++_i) \
        __builtin_amdgcn_global_load_lds((const unsigned*)((const char*)(gbase) + (voff)[_i]), (PG8_LAS unsigned*)(lds + (bufoff) + ldsw + _i * 8192), 16, 0, 0); } while (0)
#define PG8_LDA(dst, b, h) do { _Pragma("unroll") for (int m = 0; m < 4; ++m) _Pragma("unroll") for (int k = 0; k < 2; ++k) dst[m][k] = *(const PG8_LAS bf16x8*)(lds + PG8_SA(b, h) + aoff + m * 2048 + k * 1024); } while (0)
#define PG8_LDB(dst, b, h) do { _Pragma("unroll") for (int n = 0; n < 2; ++n) _Pragma("unroll") for (int k = 0; k < 2; ++k) dst[n][k] = *(const PG8_LAS bf16x8*)(lds + PG8_SB(b, h) + boff + n * 2048 + k * 1024); } while (0)
#define PG8_MMA(ai, bj, At, Bt) do { __builtin_amdgcn_s_setprio(1); _Pragma("unroll") for (int m = 0; m < 4; ++m) _Pragma("unroll") for (int n = 0; n < 2; ++n) _Pragma("unroll") for (int k = 0; k < 2; ++k) \
        acc[ai][bj][m][n] = __builtin_amdgcn_mfma_f32_16x16x32_bf16(Bt[n][k], At[m][k], acc[ai][bj][m][n], 0, 0, 0); __builtin_amdgcn_s_setprio(0); } while (0)
#define PG8_WAIT_V(n) asm volatile("s_waitcnt vmcnt(" #n ")" ::: "memory")
#define PG8_WAIT_L(n) asm volatile("s_waitcnt lgkmcnt(" #n ")" ::: "memory")
#define PG8_BAR __builtin_amdgcn_s_barrier()
#define PG8_SCHED __builtin_amdgcn_sched_barrier(0)
    Unit cur, nxt; int ui = 0;
    if (!S.next(0, cur)) return;
    f32x4 acc[2][2][4][2];
#pragma unroll
    for (int a = 0; a < 2; ++a)
#pragma unroll
        for (int b = 0; b < 2; ++b)
#pragma unroll
            for (int m = 0; m < 4; ++m)
#pragma unroll
                for (int n = 0; n < 2; ++n) acc[a][b][m][n] = (f32x4){0.f, 0.f, 0.f, 0.f};
    bf16x8 At[4][2], B0[2][2], B1[2][2];
    const char* cA = (const char*)g.A + (size_t)cur.pm * tstepA; const char* cB = (const char*)g.Bt + (size_t)cur.bt * tstepB;
    S.a_ready(cur);
    PG8_STAGE(PG8_SB(0, 0), cB, voffB); PG8_STAGE(PG8_SB(0, 1), cB + hstepB, voffB); PG8_STAGE(PG8_SA(0, 0), cA, voffA); PG8_STAGE(PG8_SA(0, 1), cA + hstepA, voffA);
    if (wr == 1) PG8_BAR;
    PG8_WAIT_V(2); PG8_BAR;
    PG8_STAGE(PG8_SB(1, 0), cB + kstep, voffB); PG8_STAGE(PG8_SA(1, 0), cA + kstep, voffA); PG8_STAGE(PG8_SB(1, 1), cB + hstepB + kstep, voffB);
    PG8_WAIT_V(6); PG8_BAR;
    for (;;) {
        const bool has_next = S.next(ui + 1, nxt);
        const char* nA = has_next ? (const char*)g.A + (size_t)nxt.pm * tstepA : cA; const char* nB = has_next ? (const char*)g.Bt + (size_t)nxt.bt * tstepB : cB;
        for (int t = 0; t < nt; t += 2) {
            const bool last = (t == nt - 2);
            const char* a1 = cA + (size_t)(t + 1) * kstep;
            const char* a2 = last ? nA : cA + (size_t)(t + 2) * kstep; const char* b2 = last ? nB : cB + (size_t)(t + 2) * kstep;
            const char* a3 = a2 + kstep; const char* b3 = b2 + kstep;
            if (last && has_next) S.a_ready(nxt);
            PG8_LDB(B0, 0, 0); PG8_LDB(B1, 0, 1); PG8_SCHED; PG8_LDA(At, 0, 0); PG8_STAGE(PG8_SA(1, 1), a1 + hstepA, voffA);
            PG8_WAIT_V(8); PG8_WAIT_L(0); PG8_BAR; PG8_MMA(0, 0, At, B0); PG8_MMA(0, 1, At, B1); PG8_BAR; PG8_SCHED;
            PG8_LDA(At, 0, 1); PG8_STAGE(PG8_SB(0, 0), b2, voffB); PG8_STAGE(PG8_SB(0, 1), b2 + hstepB, voffB); PG8_STAGE(PG8_SA(0, 0), a2, voffA);
            PG8_WAIT_V(8); PG8_WAIT_L(0); PG8_BAR; PG8_MMA(1, 0, At, B0); PG8_MMA(1, 1, At, B1); PG8_BAR; PG8_SCHED;
            PG8_LDB(B0, 1, 0); PG8_LDB(B1, 1, 1); PG8_SCHED; PG8_LDA(At, 1, 0); PG8_STAGE(PG8_SA(0, 1), a2 + hstepA, voffA);
            PG8_WAIT_V(8); PG8_WAIT_L(0); PG8_BAR; PG8_MMA(0, 0, At, B0); PG8_MMA(0, 1, At, B1); PG8_BAR; PG8_SCHED;
            PG8_LDA(At, 1, 1); PG8_STAGE(PG8_SB(1, 0), b3, voffB); PG8_STAGE(PG8_SB(1, 1), b3 + hstepB, voffB); PG8_STAGE(PG8_SA(1, 0), a3, voffA);
            PG8_WAIT_V(8); PG8_WAIT_L(0); PG8_BAR; PG8_MMA(1, 0, At, B0); PG8_MMA(1, 1, At, B1); PG8_BAR; PG8_SCHED;
        }
        if (wr == 0) PG8_BAR;
        E(acc, cur, wr, wc, fr, fq); S.done(cur);
        if (!has_next) break;
#pragma unroll
        for (int a = 0; a < 2; ++a)
#pragma unroll
            for (int b = 0; b < 2; ++b)
#pragma unroll
                for (int m = 0; m < 4; ++m)
#pragma unroll
                    for (int n = 0; n < 2; ++n) acc[a][b][m][n] = (f32x4){0.f, 0.f, 0.f, 0.f};
        cur = nxt; cA = nA; cB = nB; ++ui;
        if (wr == 1) PG8_BAR;
    }
    PG8_WAIT_V(0);
    PG8_BAR;
#undef PG8_SA
#undef PG8_SB
#undef PG8_STAGE
#undef PG8_LDA
#undef PG8_LDB
#undef PG8_MMA
#undef PG8_WAIT_V
#undef PG8_WAIT_L
#undef PG8_BAR
#undef PG8_SCHED
}
#endif

#define EPI_LOOP_BEGIN const int row0_ = u.pm * 256 + wr * 64 + fr, col0_ = u.pn * 256 + wc * 32 + 8 * fq; \
    _Pragma("unroll") for (int ai = 0; ai < 2; ++ai) _Pragma("unroll") for (int m = 0; m < 4; ++m) { const int row = row0_ + ai * 128 + m * 16; \
    _Pragma("unroll") for (int bj = 0; bj < 2; ++bj) { const int col = col0_ + bj * 128; const f32x4 v0 = acc[ai][bj][m][0], v1 = acc[ai][bj][m][1]; (void)row; (void)col;
#define EPI_LOOP_END asm volatile("" ::: "memory"); } }
struct EpiStoreBf16 {
    bf16_t* O; int ldc;
    __device__ __forceinline__ void operator()(const f32x4 (&acc)[2][2][4][2], const Unit& u, int wr, int wc, int fr, int fq) const {
        EPI_LOOP_BEGIN
            u32x4 w; w.x = pk2(v0[0], v0[1]); w.y = pk2(v0[2], v0[3]); w.z = pk2(v1[0], v1[1]); w.w = pk2(v1[2], v1[3]);
            *(u32x4*)(O + (size_t)row * ldc + col) = w;
        EPI_LOOP_END
    }
};
template <int MODE> struct EpiGate {
    const bf16_t* Hg; bf16_t* MGb;
    __device__ __forceinline__ void operator()(const f32x4 (&acc)[2][2][4][2], const Unit& u, int wr, int wc, int fr, int fq) const {
        EPI_LOOP_BEGIN
            const u32x4 gw = *(const u32x4*)(Hg + (size_t)row * DINP + col); float g[8]; unpack8(gw, g);
            float v[8] = {v0[0], v0[1], v0[2], v0[3], v1[0], v1[1], v1[2], v1[3]};
            bf16_t* mp = MGb + (size_t)row * D + col;
            if (MODE != 0) { float p[8]; unpack8(*(const u32x4*)mp, p);
#pragma unroll
                for (int i = 0; i < 8; ++i) v[i] = p[i] + v[i] * fsigmoid(g[i]); }
            else {
#pragma unroll
                for (int i = 0; i < 8; ++i) v[i] = v[i] * fsigmoid(g[i]); }
            *(u32x4*)mp = pack8(v);
        EPI_LOOP_END
    }
};
struct EpiResid {
    const float* xp; const float* xs; float* op; float* os;
    __device__ __forceinline__ void operator()(const f32x4 (&acc)[2][2][4][2], const Unit& u, int wr, int wc, int fr, int fq) const {
        EPI_LOOP_BEGIN
            const float* xi = row < NP ? xp + (size_t)row * D + col : xs + (size_t)(row - NP) * D + col;
            float* xo = row < NP ? op + (size_t)row * D + col : os + (size_t)(row - NP) * D + col;
            const f32x4 a0 = *(const f32x4*)xi, a1 = *(const f32x4*)(xi + 4);
            *(f32x4*)xo = a0 * ALPHA + v0; *(f32x4*)(xo + 4) = a1 * ALPHA + v1;
        EPI_LOOP_END
    }
};
struct EpiSwiglu {
    bf16_t* ACT; const float* bup;
    __device__ __forceinline__ void operator()(const f32x4 (&acc)[2][2][4][2], const Unit& u, int wr, int wc, int fr, int fq) const {
        const int row0_ = u.pm * 256 + wr * 64 + fr, j0 = u.pn * 128 + wc * 32 + 8 * fq;
        const float* bg = bup + (size_t)u.e * 2048 + j0; const f32x4 bg0 = *(const f32x4*)bg, bg1 = *(const f32x4*)(bg + 4), bu0 = *(const f32x4*)(bg + 1024), bu1 = *(const f32x4*)(bg + 1028);
#pragma unroll
        for (int ai = 0; ai < 2; ++ai)
#pragma unroll
            for (int m = 0; m < 4; ++m) { const int row = row0_ + ai * 128 + m * 16;
                const f32x4 g0 = acc[ai][0][m][0] + bg0, g1 = acc[ai][0][m][1] + bg1, u0 = acc[ai][1][m][0] + bu0, u1 = acc[ai][1][m][1] + bu1; float o[8];
#pragma unroll
                for (int i = 0; i < 4; ++i) { const float ga = fminf(g0[i], SW_LIMIT), ua = fminf(fmaxf(u0[i], -SW_LIMIT), SW_LIMIT); o[i] = (ua + 1.0f) * ga * fsigmoid(SW_ALPHA * ga);
                    const float gb = fminf(g1[i], SW_LIMIT), ub = fminf(fmaxf(u1[i], -SW_LIMIT), SW_LIMIT); o[4 + i] = (ub + 1.0f) * gb * fsigmoid(SW_ALPHA * gb); }
                *(u32x4*)(ACT + (size_t)row * D + j0) = pack8(o); }
    }
};
struct EpiDown {
    bf16_t* O; const float* bdn; const float* gs;
    __device__ __forceinline__ void operator()(const f32x4 (&acc)[2][2][4][2], const Unit& u, int wr, int wc, int fr, int fq) const {
        EPI_LOOP_BEGIN
            const float* bp = bdn + (size_t)u.e * D + col; const f32x4 b0 = *(const f32x4*)bp, b1 = *(const f32x4*)(bp + 4); const float gt = gs[row];
            const f32x4 a0 = (v0 + b0) * gt, a1 = (v1 + b1) * gt;
            u32x4 w; w.x = pk2(a0[0], a0[1]); w.y = pk2(a0[2], a0[3]); w.z = pk2(a1[0], a1[1]); w.w = pk2(a1[2], a1[3]);
            *(u32x4*)(O + (size_t)row * D + col) = w;
        EPI_LOOP_END
    }
};
}

#ifndef EMU
#define XB_TMO      128
#define XB_XCNT(j)  (256  + 64 * (j))
#define XB_XSUB(j)  (1280 + 64 * (j))
#define XB_XGEN(j)  (2304 + 64 * (j))
#define XB_TOP      3328
#define XB_TOPGEN   3392
#define XCD_BAR_WORDS 3456
#define XB_SPIN_CAP (1u << 27)
__device__ __forceinline__ unsigned xb_ld(unsigned* p)              { return __hip_atomic_load(p, __ATOMIC_RELAXED, __HIP_MEMORY_SCOPE_AGENT); }
__device__ __forceinline__ unsigned xb_add(unsigned* p, unsigned v) { return __hip_atomic_fetch_add(p, v, __ATOMIC_RELAXED, __HIP_MEMORY_SCOPE_AGENT); }
__device__ __forceinline__ unsigned xb_xcc_id() { return (unsigned)__builtin_amdgcn_s_getreg((3 << 11) | 20) & 0xFu; }
#define XB_SPIN(cond, bar) do { unsigned _sp = 0; while (cond) { __builtin_amdgcn_s_sleep(1); \
    if ((++_sp & 255u) == 0u) { if (xb_ld(&(bar)[XB_TMO])) break; if (_sp > XB_SPIN_CAP) { atomicAdd(&(bar)[XB_TMO], 1u); break; } } } } while (0)
struct XcdBarrier { unsigned* bar; unsigned x; volatile LAS unsigned* st; };
__device__ __forceinline__ XcdBarrier xcd_barrier_post(unsigned* bar, volatile LAS unsigned* st) {
    XcdBarrier b; b.bar = bar; b.x = xb_xcc_id(); b.st = st;
    if (threadIdx.x == 0) (void)xb_add(&bar[XB_XCNT(b.x)], 1u);
    return b;
}
__device__ __forceinline__ void xcd_barrier_complete(unsigned* bar, unsigned x, unsigned& nloc, unsigned& nx) {
    const unsigned G = gridDim.x * gridDim.y * gridDim.z;
    unsigned sum, cnt, mine, sp = 0u;
    for (;;) {
        sum = 0u; cnt = 0u; mine = 0u;
#pragma unroll
        for (unsigned j = 0; j < 16; ++j) { const unsigned c = xb_ld(&bar[XB_XCNT(j)]); sum += c; cnt += (c > 0u) ? 1u : 0u; mine = (j == x) ? c : mine; }
        if (sum == G) break;
        __builtin_amdgcn_s_sleep(1);
        if ((++sp & 255u) == 0u) { if (xb_ld(&bar[XB_TMO])) break; if (sp > XB_SPIN_CAP) { atomicAdd(&bar[XB_TMO], 1u); break; } }
    }
    nloc = mine > 0u ? mine : 1u; nx = cnt > 0u ? cnt : 1u;
}
__device__ __forceinline__ void xcd_barrier(const XcdBarrier& b) {
    asm volatile("s_waitcnt vmcnt(0)" ::: "memory");
    __syncthreads();
    if (threadIdx.x == 0) {
        unsigned* bar = b.bar;
        __builtin_amdgcn_s_waitcnt(0);
        unsigned nloc = b.st[0], nx = b.st[1];
        if (nloc == 0u) { xcd_barrier_complete(bar, b.x, nloc, nx); b.st[0] = nloc; b.st[1] = nx; }
        const unsigned old = xb_add(&bar[XB_XSUB(b.x)], 1u);
        const unsigned gen = old / nloc;
        if (old + 1u == (gen + 1u) * nloc) {
            __builtin_amdgcn_fence(__ATOMIC_RELEASE, "agent");
            asm volatile("s_waitcnt vmcnt(0)" ::: "memory");
            const unsigned og = xb_add(&bar[XB_TOP], 1u);
            const unsigned tg = og / nx;
            if (og + 1u == (tg + 1u) * nx) xb_add(&bar[XB_TOPGEN], 1u);
            else XB_SPIN(xb_ld(&bar[XB_TOPGEN]) == tg, bar);
            __builtin_amdgcn_fence(__ATOMIC_ACQUIRE, "agent");
            xb_add(&bar[XB_XGEN(b.x)], 1u);
            asm volatile("s_waitcnt vmcnt(0)" ::: "memory");
        } else {
            XB_SPIN(xb_ld(&bar[XB_XGEN(b.x)]) == gen, bar);
            __builtin_amdgcn_fence(__ATOMIC_ACQUIRE, "agent");
            asm volatile("s_waitcnt vmcnt(0)" ::: "memory");
        }
    }
    __syncthreads();
}
#endif

struct Args { const float* in[31]; float* out; unsigned char* ws; int lo, hi; };
typedef const float* FPtr;
#ifdef EMU
typedef const FPtr* ArgTab;
#else
typedef const __attribute__((address_space(4))) FPtr* ArgTab;
#endif
struct Frame {
    LAS unsigned char* lds; int tid, lane, wave, G, bid;
    ArgTab in; float* out; unsigned char* ws; unsigned* ctl;
};
enum { I_XP = 0, I_XS, I_CK, I_CV, I_SST, I_SCV, I_SSC, I_WIN, I_CONVW, I_CONVB, I_DTB, I_ALOG, I_SD, I_NORMW, I_WSSD, I_SINK, I_WATT, I_RELB, I_SCW, I_WSC, I_WO, I_LN1G, I_LN1B,
       I_RW, I_RB, I_WUP, I_BUP, I_WDN, I_BDN, I_LN2G, I_LN2B };

__device__ __forceinline__ bf16_t* ws_bf(const Frame& F, size_t off) { return (bf16_t*)(F.ws + off); }
__device__ __forceinline__ float* ws_f(const Frame& F, size_t off) { return (float*)(F.ws + off); }
__device__ __forceinline__ bf16_t* wl_ptr(const Frame& F, int layer, size_t off) { return (bf16_t*)(F.ws + WS_W + (size_t)layer * WL_BYTES + off); }

__device__ __forceinline__ void wt_item(const float* W, int ldw, int K, int k0, int nsrc0, const float* kscale, bf16_t* WT, int ndst0, LAS float* scr, int lane) {
    if (nsrc0 < 0) {
#pragma unroll
        for (int j = 0; j < 4; ++j) { const int n = (lane >> 3) + 8 * j; *(u32x4*)(WT + (size_t)(ndst0 + n) * K + k0 + 8 * (lane & 7)) = (u32x4){0u, 0u, 0u, 0u}; }
        return;
    }
#pragma unroll 8
    for (int i = 0; i < 32; ++i) { const int kk = 2 * i + (lane >> 5); float v = W[(size_t)(k0 + kk) * ldw + nsrc0 + (lane & 31)]; if (kscale) v *= kscale[k0 + kk]; scr[kk * 33 + (lane & 31)] = v; }
    WAVE_SYNC();
    const int c = lane & 7;
#pragma unroll
    for (int j = 0; j < 4; ++j) { const int n = (lane >> 3) + 8 * j; const LAS float* s = scr + (8 * c) * 33 + n;
        u32x4 o; o.x = pk2(s[0 * 33], s[1 * 33]); o.y = pk2(s[2 * 33], s[3 * 33]); o.z = pk2(s[4 * 33], s[5 * 33]); o.w = pk2(s[6 * 33], s[7 * 33]);
        *(u32x4*)(WT + (size_t)(ndst0 + n) * K + k0 + 8 * c) = o; }
    WAVE_SYNC();
}
__device__ __forceinline__ void step_weights(const Frame& F) {
    LAS float* scr = (LAS float*)(F.lds + F.wave * 16384);
    const int gw = F.bid * NWAVES + F.wave, NGW = F.G * NWAVES;
    constexpr int I_IN = (DINP / 32) * (D / 64), I_SSD = (D / 32) * (DINNER / 64), I_SQ = (D / 32) * (D / 64), I_UP = NEXP * (2048 / 32) * (D / 64), I_DN = NEXP * (D / 32) * (D / 64);
    constexpr int PER_LAYER = I_IN + I_SSD + 3 * I_SQ + I_UP + I_DN;
    for (int it = gw; it < DEPTH * PER_LAYER; it += NGW) {
        const int layer = it / PER_LAYER; int r = it % PER_LAYER;
        if (r < I_IN) { const int nb = r / (D / 64), kb = r % (D / 64), n0 = nb * 32;
            const int ns = n0 < 6144 ? n0 : (n0 < 13824 ? n0 + 32 : (n0 < 13856 ? n0 - 13824 + 6144 : -1));
            wt_item(F.in[I_WIN] + (size_t)layer * D * DIN, DIN, D, kb * 64, ns, nullptr, wl_ptr(F, layer, WL_IN), n0, scr, F.lane); continue; }
        r -= I_IN;
        if (r < I_SSD) { const int nb = r / (DINNER / 64), kb = r % (DINNER / 64);
            wt_item(F.in[I_WSSD] + (size_t)layer * DINNER * D, D, DINNER, kb * 64, nb * 32, F.in[I_NORMW] + (size_t)layer * DINNER, wl_ptr(F, layer, WL_SSD), nb * 32, scr, F.lane); continue; }
        r -= I_SSD;
        if (r < I_SQ) { const int nb = r / (D / 64), kb = r % (D / 64); wt_item(F.in[I_WATT] + (size_t)layer * D * D, D, D, kb * 64, nb * 32, nullptr, wl_ptr(F, layer, WL_ATT), nb * 32, scr, F.lane); continue; }
        r -= I_SQ;
        if (r < I_SQ) { const int nb = r / (D / 64), kb = r % (D / 64); wt_item(F.in[I_WSC] + (size_t)layer * D * D, D, D, kb * 64, nb * 32, nullptr, wl_ptr(F, layer, WL_SC), nb * 32, scr, F.lane); continue; }
        r -= I_SQ;
        if (r < I_SQ) { const int nb = r / (D / 64), kb = r % (D / 64); wt_item(F.in[I_WO] + (size_t)layer * D * D, D, D, kb * 64, nb * 32, nullptr, wl_ptr(F, layer, WL_O), nb * 32, scr, F.lane); continue; }
        r -= I_SQ;
        if (r < I_UP) { const int e = r / ((2048 / 32) * (D / 64)), q = r % ((2048 / 32) * (D / 64)), nb = q / (D / 64), kb = q % (D / 64), n0 = nb * 32;
            const int pn = n0 >> 8, bj = (n0 >> 7) & 1, jj = n0 & 127, ns = bj * 1024 + pn * 128 + jj;
            wt_item(F.in[I_WUP] + ((size_t)layer * NEXP + e) * D * 2048, 2048, D, kb * 64, ns, nullptr, wl_ptr(F, layer, WL_UP) + (size_t)e * 2048 * D, n0, scr, F.lane); continue; }
        r -= I_UP;
        { const int e = r / ((D / 32) * (D / 64)), q = r % ((D / 32) * (D / 64)), nb = q / (D / 64), kb = q % (D / 64);
            wt_item(F.in[I_WDN] + ((size_t)layer * NEXP + e) * D * D, D, D, kb * 64, nb * 32, nullptr, wl_ptr(F, layer, WL_DN) + (size_t)e * D * D, nb * 32, scr, F.lane); }
    }
}

__device__ __forceinline__ const float* x_in_row(const Frame& F, int layer, int mb, int r) {
    if (layer == 0) return r < NP ? F.in[I_XP] + ((size_t)mb * NP + r) * D : F.in[I_XS] + (size_t)(r - NP) * D;
    return r < NP ? F.out + O_YP + ((size_t)mb * NP + r) * D : F.out + O_YS + (size_t)(r - NP) * D;
}
__device__ __forceinline__ float* x_out_row(const Frame& F, int mb, int r) { return r < NP ? F.out + O_YP + ((size_t)mb * NP + r) * D : F.out + O_YS + (size_t)(r - NP) * D; }
__device__ __forceinline__ int rows_of(int mb) { return mb == 0 ? R : NP; }

__device__ __forceinline__ void step_xb(const Frame& F, int mb) {
    const int gw = F.bid * NWAVES + F.wave, NGW = F.G * NWAVES, nr = rows_of(mb);
    bf16_t* XB = ws_bf(F, WS_XB);
    for (int r = gw; r < nr; r += NGW) {
        const f32x4* xr = (const f32x4*)x_in_row(F, 0, mb, r) + F.lane; u32x2* o = (u32x2*)(XB + (size_t)r * D) + F.lane;
#pragma unroll
        for (int j = 0; j < 4; ++j) { const f32x4 v = xr[64 * j]; u32x2 w; w.x = pk2(v[0], v[1]); w.y = pk2(v[2], v[3]); o[64 * j] = w; }
    }
}

__device__ __forceinline__ float softplus_f(float x) { return x > 20.f ? x : log1pf(expf(x)); }
constexpr int S128 = 136, S64 = 72;
constexpr int SL_CM = 0, SL_BM = SL_CM + 64 * S128 * 2, SL_BT = SL_BM + 64 * S128 * 2, SL_XT = SL_BT + 128 * S64 * 2, SL_XTW = SL_XT + 64 * S64 * 2, SL_XS = SL_XTW + 64 * S64 * 2,
    SL_MM = SL_XS + 64 * S64 * 2, SL_SB = SL_MM + 64 * S64 * 2, SL_SM = SL_SB + 64 * S128 * 2, SL_CW = SL_SM + 5 * 64 * 4, SL_END = SL_CW + 5 * 320 * 4;
constexpr int SL_Y = SL_CM, YP = 68;
static_assert(SL_END <= RING_BYTES && 64 * YP * 4 <= 64 * S128 * 2, "ssd LDS map");

#define SSD_ITEM_L(it) ((it) == 0 ? xl : ((tid + 512 * (((it) - 1) & 1)) >> 4))
#define SSD_ITEM_CG(it) ((it) == 0 ? xcg : ((tid + 512 * (((it) - 1) & 1)) & 15))
#define SSD_LOAD_RAW(ck_) do { _Pragma("unroll") for (int it = 0; it < 5; ++it) { const int l_ = SSD_ITEM_L(it), cg_ = SSD_ITEM_CG(it); \
        const int col_ = it == 0 ? C_X + hd * 64 + 8 * cg_ : (it < 3 ? C_B + g * 128 + 8 * cg_ : C_C + g * 128 + 8 * cg_); \
        _Pragma("unroll") for (int i = 0; i < 4; ++i) { const int t_ = (ck_) * 64 + l_ - 3 + i; \
            raw[it][i] = t_ >= 0 ? *(const u32x4*)(H + (size_t)t_ * DINP + col_) : (u32x4){0u, 0u, 0u, 0u}; } } } while (0)

__device__ __forceinline__ void ssd_prompt_unit(const Frame& F, int layer, int mb, int sl, int hd) {
    const int tid = F.tid, lane = F.lane, w = F.wave, fr = lane & 15, fq = lane >> 4;
    LAS unsigned char* L = F.lds;
    LAS bf16_t* Cm = (LAS bf16_t*)(L + SL_CM); LAS bf16_t* Bm = (LAS bf16_t*)(L + SL_BM); LAS bf16_t* BT = (LAS bf16_t*)(L + SL_BT); LAS bf16_t* XT = (LAS bf16_t*)(L + SL_XT);
    LAS bf16_t* XTW = (LAS bf16_t*)(L + SL_XTW); LAS bf16_t* Xs = (LAS bf16_t*)(L + SL_XS); LAS bf16_t* Mm = (LAS bf16_t*)(L + SL_MM); LAS bf16_t* Sb = (LAS bf16_t*)(L + SL_SB);
    LAS float* sm = (LAS float*)(L + SL_SM);
    LAS float* cw = (LAS float*)(L + SL_CW);
    LAS float* Y = (LAS float*)(L + SL_Y);
    const int g = hd >> 2;
    bf16_t* H = ws_bf(F, WS_H) + (size_t)sl * SEQ * DINP;
    const float* convw = F.in[I_CONVW] + (size_t)layer * 4 * CONVDIM; const float* convb = F.in[I_CONVB] + (size_t)layer * CONVDIM;
    __syncthreads();
    for (int i = tid; i < 5 * 320; i += NTHREADS) { const int tap = i / 320, c = i % 320; const int xc = c < 64 ? hd * 64 + c : (c < 192 ? 2048 + g * 128 + (c - 64) : 3072 + g * 128 + (c - 192));
        cw[i] = tap < 4 ? convw[tap * CONVDIM + xc] : convb[xc]; }
    const float dtb = F.in[I_DTB][layer * 32 + hd], Ah = -expf(F.in[I_ALOG][layer * 32 + hd]), Dh = F.in[I_SD][layer * 32 + hd];
    const int xl = tid >> 3, xcg = tid & 7;
    u32x4 raw[5][4];
    f32x4 S[4];
#pragma unroll
    for (int j = 0; j < 4; ++j) S[j] = (f32x4){0.f, 0.f, 0.f, 0.f};
    const int ti = w >> 1, tj0 = 2 * (w & 1);
    const int pi = w & 3, nb = w >> 2;
    for (int ck = 0; ck < NCHUNK; ++ck) {
        const size_t rowb = (size_t)ck * 64;
        SSD_LOAD_RAW(ck);
#pragma unroll
        for (int jj = 0; jj < 4; ++jj)
#pragma unroll
            for (int r = 0; r < 4; ++r) Sb[(16 * pi + 4 * fq + r) * S128 + 64 * nb + 16 * jj + fr] = (bf16_t)f2bf(S[jj][r]);
        if (w == 0) {
            const float dtr = bf2f(H[(rowb + lane) * DINP + C_DT + hd]); const float dt = softplus_f(dtr + dtb); const float a = Ah * dt;
            float cs = a;
#pragma unroll
            for (int o = 1; o < 64; o <<= 1) { const float t = __shfl(cs, lane - o < 0 ? 0 : lane - o); if (lane >= o) cs += t; }
            const float tot = __shfl(cs, 63);
            sm[lane] = dt; sm[64 + lane] = cs; sm[128 + lane] = fexp(tot - cs); sm[192 + lane] = fexp(cs); if (lane == 0) sm[256] = fexp(tot);
        }
        const u32x4 zraw = *(const u32x4*)(H + (rowb + xl) * DINP + C_Z + hd * 64 + 8 * xcg);
        __syncthreads();
#pragma unroll
        for (int it = 0; it < 5; ++it) {
            const int l = SSD_ITEM_L(it), cg = SSD_ITEM_CG(it);
            const int cb = it == 0 ? 8 * cg : (it < 3 ? 64 + 8 * cg : 192 + 8 * cg);
            float acc8[8];
            { const f32x4 b0 = *(const LAS f32x4*)(cw + 4 * 320 + cb), b1 = *(const LAS f32x4*)(cw + 4 * 320 + cb + 4);
#pragma unroll
              for (int i = 0; i < 4; ++i) { acc8[i] = b0[i]; acc8[4 + i] = b1[i]; } }
#pragma unroll
            for (int tp = 0; tp < 4; ++tp) { float f[8]; unpack8(raw[it][tp], f); const f32x4 w0 = *(const LAS f32x4*)(cw + tp * 320 + cb), w1 = *(const LAS f32x4*)(cw + tp * 320 + cb + 4);
#pragma unroll
                for (int i = 0; i < 4; ++i) { acc8[i] += f[i] * w0[i]; acc8[4 + i] += f[4 + i] * w1[i]; } }
#pragma unroll
            for (int i = 0; i < 8; ++i) acc8[i] = fsilu(acc8[i]);
            if (it == 0) { const float dt = sm[l], wd = sm[128 + l];
                *(LAS u32x4*)(Xs + l * S64 + 8 * cg) = pack8(acc8);
#pragma unroll
                for (int i = 0; i < 8; ++i) { const float xd = acc8[i] * dt; XT[(8 * cg + i) * S64 + l] = (bf16_t)f2bf(xd); XTW[(8 * cg + i) * S64 + l] = (bf16_t)f2bf(xd * wd); } }
            else if (it < 3) { *(LAS u32x4*)(Bm + l * S128 + 8 * cg) = pack8(acc8);
#pragma unroll
                for (int i = 0; i < 8; ++i) BT[(8 * cg + i) * S64 + l] = (bf16_t)f2bf(acc8[i]); }
            else *(LAS u32x4*)(Cm + l * S128 + 8 * cg) = pack8(acc8);
            asm volatile("" ::: "memory");
        }
        __syncthreads();
        f32x4 yo[2];
#pragma unroll
        for (int jj = 0; jj < 2; ++jj) { const int tj = tj0 + jj;
            f32x4 cb = (f32x4){0.f, 0.f, 0.f, 0.f}; yo[jj] = (f32x4){0.f, 0.f, 0.f, 0.f};
#pragma unroll
            for (int ks = 0; ks < 4; ++ks) { const bf16x8 a = *(const LAS bf16x8*)(Cm + (16 * ti + fr) * S128 + 32 * ks + 8 * fq);
                if (tj <= ti) { const bf16x8 b = *(const LAS bf16x8*)(Bm + (16 * tj + fr) * S128 + 32 * ks + 8 * fq); cb = __builtin_amdgcn_mfma_f32_16x16x32_bf16(a, b, cb, 0, 0, 0); }
                const bf16x8 sb = *(const LAS bf16x8*)(Sb + (16 * tj + fr) * S128 + 32 * ks + 8 * fq); yo[jj] = __builtin_amdgcn_mfma_f32_16x16x32_bf16(a, sb, yo[jj], 0, 0, 0); }
            const int s = 16 * tj + fr; const float as = sm[64 + s];
#pragma unroll
            for (int r = 0; r < 4; ++r) { const int l = 16 * ti + 4 * fq + r; const float al = sm[64 + l];
                const float mv = (tj <= ti && l >= s) ? cb[r] * fexp(fminf(al - as, 0.f)) : 0.f; Mm[l * S64 + s] = (bf16_t)f2bf(mv); }
            asm volatile("" ::: "memory");
        }
        { const float cd = sm[256];
#pragma unroll
          for (int jj = 0; jj < 4; ++jj) { S[jj] = S[jj] * cd;
#pragma unroll
            for (int ks = 0; ks < 2; ++ks) { const bf16x8 a = *(const LAS bf16x8*)(XTW + (16 * pi + fr) * S64 + 32 * ks + 8 * fq); const bf16x8 b = *(const LAS bf16x8*)(BT + (64 * nb + 16 * jj + fr) * S64 + 32 * ks + 8 * fq);
                S[jj] = __builtin_amdgcn_mfma_f32_16x16x32_bf16(a, b, S[jj], 0, 0, 0); }
            if (jj & 1) asm volatile("" ::: "memory"); } }
        __syncthreads();
#pragma unroll
        for (int jj = 0; jj < 2; ++jj) { const int tj = tj0 + jj; f32x4 yd = (f32x4){0.f, 0.f, 0.f, 0.f};
#pragma unroll
            for (int ks = 0; ks < 2; ++ks) { const bf16x8 a = *(const LAS bf16x8*)(Mm + (16 * ti + fr) * S64 + 32 * ks + 8 * fq); const bf16x8 b = *(const LAS bf16x8*)(XT + (16 * tj + fr) * S64 + 32 * ks + 8 * fq);
                yd = __builtin_amdgcn_mfma_f32_16x16x32_bf16(a, b, yd, 0, 0, 0); }
#pragma unroll
            for (int r = 0; r < 4; ++r) { const int l = 16 * ti + 4 * fq + r; Y[l * YP + 16 * tj + fr] = yd[r] + sm[192 + l] * yo[jj][r]; } }
        __syncthreads();
        { float y8[8], x8[8], z8[8]; const f32x4 ya = *(const LAS f32x4*)(Y + xl * YP + 8 * xcg), yb = *(const LAS f32x4*)(Y + xl * YP + 8 * xcg + 4);
#pragma unroll
          for (int i = 0; i < 4; ++i) { y8[i] = ya[i]; y8[4 + i] = yb[i]; }
          unpack8(*(const LAS u32x4*)(Xs + xl * S64 + 8 * xcg), x8); unpack8(zraw, z8); float ss = 0.f;
#pragma unroll
          for (int i = 0; i < 8; ++i) { const float v = (y8[i] + Dh * x8[i]) * fsilu(z8[i]); y8[i] = v; ss += v * v; }
          *(u32x4*)(H + (rowb + xl) * DINP + C_Z + hd * 64 + 8 * xcg) = pack8(y8);
          ss += __shfl_xor(ss, 1); ss += __shfl_xor(ss, 2); ss += __shfl_xor(ss, 4);
          if (xcg == 0) ws_f(F, WS_SSQ)[((size_t)sl * SEQ + rowb + xl) * 32 + hd] = ss; }
    }
    float* so = F.out + O_SSP + ((((size_t)layer * BATCH + mb * NSEQ_MB + sl) * 32 + hd) * 64) * 128;
#pragma unroll
    for (int jj = 0; jj < 4; ++jj)
#pragma unroll
        for (int r = 0; r < 4; ++r) so[(size_t)(16 * pi + 4 * fq + r) * 128 + 64 * nb + 16 * jj + fr] = S[jj][r];
}

__device__ __forceinline__ void ssd_sample_unit(const Frame& F, int layer, int sq, int hd) {
    const int tid = F.tid, lane = F.lane; LAS float* L = (LAS float*)F.lds;
    LAS float* xs = L; LAS float* Bs = L + 16 * 64; LAS float* Cs = Bs + 16 * 128; LAS float* dts = Cs + 16 * 128; LAS float* das = dts + 16; LAS float* Yl = das + 16;
    const int g = hd >> 2;
    bf16_t* H = ws_bf(F, WS_H) + (size_t)(NP + sq * 16) * DINP;
    const float* hist = F.in[I_SCV] + ((size_t)layer * DECB + sq) * 3 * CONVDIM;
    const float* convw = F.in[I_CONVW] + (size_t)layer * 4 * CONVDIM; const float* convb = F.in[I_CONVB] + (size_t)layer * CONVDIM;
    __syncthreads();
    for (int it = tid; it < 16 * 320; it += NTHREADS) { const int t = it / 320, c = it % 320; const int xc = c < 64 ? hd * 64 + c : (c < 192 ? 2048 + g * 128 + (c - 64) : 3072 + g * 128 + (c - 192));
        float a = convb[xc];
#pragma unroll
        for (int i = 0; i < 4; ++i) { const int tt = t - 3 + i; const float v = tt >= 0 ? bf2f(H[(size_t)tt * DINP + C_X + xc]) : hist[(tt + 3) * CONVDIM + xc]; a += v * convw[i * CONVDIM + xc]; }
        a = a / (1.0f + expf(-a));
        if (c < 64) xs[t * 64 + c] = a; else if (c < 192) Bs[t * 128 + c - 64] = a; else Cs[t * 128 + c - 192] = a; }
    if (tid < 16) { const float dt = softplus_f(bf2f(H[(size_t)tid * DINP + C_DT + hd]) + F.in[I_DTB][layer * 32 + hd]); dts[tid] = dt; das[tid] = expf(-expf(F.in[I_ALOG][layer * 32 + hd]) * dt); }
    __syncthreads();
    const int p = tid >> 3, n0 = (tid & 7) * 16;
    const size_t sbase = ((((size_t)layer * DECB + sq) * 32 + hd) * 64 + p) * 128 + n0;
    float S[16];
#pragma unroll
    for (int i = 0; i < 16; ++i) S[i] = F.in[I_SST][sbase + i];
    for (int t = 0; t < 16; ++t) { const float dec = das[t], xv = xs[t * 64 + p] * dts[t]; float part = 0.f;
#pragma unroll
        for (int i = 0; i < 16; ++i) { S[i] = S[i] * dec + xv * Bs[t * 128 + n0 + i]; part += Cs[t * 128 + n0 + i] * S[i]; }
        part += __shfl_xor(part, 1); part += __shfl_xor(part, 2); part += __shfl_xor(part, 4);
        if ((tid & 7) == 0) Yl[t * 64 + p] = part; }
#pragma unroll
    for (int i = 0; i < 16; ++i) F.out[O_SSS + sbase + i] = S[i];
    __syncthreads();
    const float Dh = F.in[I_SD][layer * 32 + hd];
#pragma unroll
    for (int j = 0; j < 2; ++j) { const int it = tid + 512 * j, t = it >> 6, pp = it & 63;
        const float z = bf2f(H[(size_t)t * DINP + C_Z + hd * 64 + pp]); const float v = (Yl[t * 64 + pp] + Dh * xs[t * 64 + pp]) * (z / (1.0f + expf(-z)));
        H[(size_t)t * DINP + C_Z + hd * 64 + pp] = (bf16_t)f2bf(v);
        const float ss = wave_sum(v * v);
        if (lane == 0) ws_f(F, WS_SSQ)[((size_t)NP + sq * 16 + t) * 32 + hd] = ss; }
}

__device__ __forceinline__ int t5_bucket(int rel) {
    const int n = rel < 0 ? -rel : rel; const int b = rel > 0 ? 16 : 0;
    if (n < 8) return b + n;
    int v = 8; v += n >= 12; v += n >= 16; v += n >= 23; v += n >= 32; v += n >= 46; v += n >= 64; v += n >= 91;
    return b + v;
}
constexpr int AK_P = 72, AV_P = 200;
constexpr int AL_K = 0, AL_VT = AL_K + 192 * AK_P * 2, AL_LUT = AL_VT + 64 * AV_P * 2, AL_END = AL_LUT + 4 * 256 * 4;
static_assert(AL_END <= RING_BYTES, "attention LDS map");
__device__ __forceinline__ void attn_prompt_unit(const Frame& F, int layer, int sl, int ck, int kh) {
    const int tid = F.tid, lane = F.lane, w = F.wave, q32 = lane & 31, hi = lane >> 5;
    LAS bf16_t* Kl = (LAS bf16_t*)(F.lds + AL_K); LAS bf16_t* VT = (LAS bf16_t*)(F.lds + AL_VT); LAS float* lut = (LAS float*)(F.lds + AL_LUT);
    bf16_t* H = ws_bf(F, WS_H) + (size_t)sl * SEQ * DINP;
    __syncthreads();
#pragma unroll
    for (int j = 0; j < 3; ++j) { const int id = tid + 512 * j, key = id >> 3, cg = id & 7; const int t = 64 * (ck - 2) + key;
        u32x4 kv = (u32x4){0u, 0u, 0u, 0u}, vv = kv;
        if (t >= 0) { kv = *(const u32x4*)(H + (size_t)t * DINP + C_K + kh * 64 + 8 * cg); vv = *(const u32x4*)(H + (size_t)t * DINP + C_V + kh * 64 + 8 * cg); }
        *(LAS u32x4*)(Kl + key * AK_P + 8 * cg) = kv;
        VT[(8 * cg + 0) * AV_P + key] = (bf16_t)(vv.x & 0xffffu); VT[(8 * cg + 1) * AV_P + key] = (bf16_t)(vv.x >> 16); VT[(8 * cg + 2) * AV_P + key] = (bf16_t)(vv.y & 0xffffu); VT[(8 * cg + 3) * AV_P + key] = (bf16_t)(vv.y >> 16);
        VT[(8 * cg + 4) * AV_P + key] = (bf16_t)(vv.z & 0xffffu); VT[(8 * cg + 5) * AV_P + key] = (bf16_t)(vv.z >> 16); VT[(8 * cg + 6) * AV_P + key] = (bf16_t)(vv.w & 0xffffu); VT[(8 * cg + 7) * AV_P + key] = (bf16_t)(vv.w >> 16); }
    for (int e = tid; e < 4 * 255; e += NTHREADS) { const int gg = e / 255, idx = e % 255; lut[gg * 256 + idx] = F.in[I_RELB][t5_bucket(idx - 191) * 16 + kh * 4 + gg]; }
    __syncthreads();
    const int gq = w >> 1, qh = w & 1, head = kh * 4 + gq;
    const size_t qrow = (size_t)ck * 64 + 32 * qh + q32;
    bf16x8 qf[4];
#pragma unroll
    for (int ds = 0; ds < 4; ++ds) qf[ds] = *(const bf16x8*)(H + qrow * DINP + C_Q + head * 64 + 16 * ds + 8 * hi);
    f32x16 sc[6];
#pragma unroll
    for (int kt = 0; kt < 6; ++kt) {
#pragma unroll
        for (int r = 0; r < 16; ++r) sc[kt][r] = 0.f;
#pragma unroll
        for (int ds = 0; ds < 4; ++ds) { const bf16x8 a = *(const LAS bf16x8*)(Kl + (32 * kt + q32) * AK_P + 16 * ds + 8 * hi); sc[kt] = __builtin_amdgcn_mfma_f32_32x32x16_bf16(a, qf[ds], sc[kt], 0, 0, 0); } }
    const int qidx = 32 * qh + q32; const float sink = F.in[I_SINK][layer * 16 + head];
    float mx = -3.0e38f;
#pragma unroll
    for (int kt = 0; kt < 6; ++kt)
#pragma unroll
        for (int r = 0; r < 16; ++r) { const int key = 32 * kt + (r & 3) + 8 * (r >> 2) + 4 * hi; const int rel = key - 128 - qidx;
            float s = sc[kt][r] * 0.125f + lut[gq * 256 + rel + 191]; if (64 * ck + key - 128 < 0) s = -1e30f; sc[kt][r] = s; mx = fmaxf(mx, s); }
    mx = fmaxf(mx, __shfl_xor(mx, 32)); mx = fmaxf(mx, sink);
    float sum = 0.f;
#pragma unroll
    for (int kt = 0; kt < 6; ++kt)
#pragma unroll
        for (int r = 0; r < 16; ++r) { const float e = fexp(sc[kt][r] - mx); sc[kt][r] = e; sum += e; }
    sum += __shfl_xor(sum, 32);
    const float inv = 1.0f / (sum + fexp(sink - mx));
    f32x16 o[2];
#pragma unroll
    for (int d2 = 0; d2 < 2; ++d2)
#pragma unroll
        for (int r = 0; r < 16; ++r) o[d2][r] = 0.f;
#pragma unroll
    for (int kt = 0; kt < 6; ++kt)
#pragma unroll
        for (int s = 0; s < 2; ++s) {
            u32x4 pw; pw.x = pk2(sc[kt][8 * s + 0], sc[kt][8 * s + 1]); pw.y = pk2(sc[kt][8 * s + 2], sc[kt][8 * s + 3]); pw.z = pk2(sc[kt][8 * s + 4], sc[kt][8 * s + 5]); pw.w = pk2(sc[kt][8 * s + 6], sc[kt][8 * s + 7]);
            const bf16x8 pa = __builtin_bit_cast(bf16x8, pw);
#pragma unroll
            for (int d2 = 0; d2 < 2; ++d2) { const LAS bf16_t* vp = VT + (32 * d2 + q32) * AV_P + 32 * kt + 16 * s + 4 * hi;
                const u32x2 lo = *(const LAS u32x2*)vp, hh = *(const LAS u32x2*)(vp + 8); u32x4 vw; vw.x = lo.x; vw.y = lo.y; vw.z = hh.x; vw.w = hh.y;
                o[d2] = __builtin_amdgcn_mfma_f32_32x32x16_bf16(pa, __builtin_bit_cast(bf16x8, vw), o[d2], 0, 0, 0); } }
#pragma unroll
    for (int r = 0; r < 16; ++r) { const int q = (r & 3) + 8 * (r >> 2) + 4 * hi; const float iv = __shfl(inv, q);
        bf16_t* op = H + ((size_t)ck * 64 + 32 * qh + q) * DINP + C_Q + head * 64 + q32;
        op[0] = (bf16_t)f2bf(o[0][r] * iv); op[32] = (bf16_t)f2bf(o[1][r] * iv); }
}
__device__ __forceinline__ void attn_sample_unit(const Frame& F, int layer, int sq, int kh) {
    const int tid = F.tid; LAS float* L = (LAS float*)F.lds;
    LAS float* Kf = L; LAS float* Vf = Kf + 144 * 65; LAS float* Qf = Vf + 144 * 64; LAS float* P = Qf + 64 * 65; LAS float* Pinv = P + 64 * 145;
    static_assert((144 * 65 + 144 * 64 + 64 * 65 + 64 * 145 + 64) * 4 <= RING_BYTES, "sample attention LDS map");
    bf16_t* H = ws_bf(F, WS_H) + (size_t)(NP + sq * 16) * DINP;
    const float* ck = F.in[I_CK] + ((size_t)layer * DECB + sq) * WINDOW * 256; const float* cv = F.in[I_CV] + ((size_t)layer * DECB + sq) * WINDOW * 256;
    __syncthreads();
    for (int i = tid; i < 144 * 64; i += NTHREADS) { const int key = i >> 6, d = i & 63;
        Kf[key * 65 + d] = key < 128 ? ck[(size_t)key * 256 + kh * 64 + d] : bf2f(H[(size_t)(key - 128) * DINP + C_K + kh * 64 + d]);
        Vf[key * 64 + d] = key < 128 ? cv[(size_t)key * 256 + kh * 64 + d] : bf2f(H[(size_t)(key - 128) * DINP + C_V + kh * 64 + d]); }
    for (int i = tid; i < 64 * 64; i += NTHREADS) { const int row = i >> 6, d = i & 63; Qf[row * 65 + d] = bf2f(H[(size_t)(row & 15) * DINP + C_Q + (kh * 4 + (row >> 4)) * 64 + d]); }
    __syncthreads();
    for (int i = tid; i < 64 * 144; i += NTHREADS) { const int row = i / 144, key = i % 144; float s = 0.f;
        for (int d = 0; d < 64; ++d) s += Qf[row * 65 + d] * Kf[key * 65 + d];
        P[row * 145 + key] = s * 0.125f + F.in[I_RELB][t5_bucket(key - 128 - (row & 15)) * 16 + kh * 4 + (row >> 4)]; }
    __syncthreads();
    { const int row = tid >> 3, sub = tid & 7; const float sink = F.in[I_SINK][layer * 16 + kh * 4 + (row >> 4)]; float mx = -3.0e38f;
      for (int k = sub; k < 144; k += 8) mx = fmaxf(mx, P[row * 145 + k]);
      mx = fmaxf(mx, __shfl_xor(mx, 1)); mx = fmaxf(mx, __shfl_xor(mx, 2)); mx = fmaxf(mx, __shfl_xor(mx, 4)); mx = fmaxf(mx, sink);
      float sum = 0.f;
      for (int k = sub; k < 144; k += 8) { const float e = expf(P[row * 145 + k] - mx); P[row * 145 + k] = e; sum += e; }
      sum += __shfl_xor(sum, 1); sum += __shfl_xor(sum, 2); sum += __shfl_xor(sum, 4);
      if (sub == 0) Pinv[row] = 1.0f / (sum + expf(sink - mx)); }
    __syncthreads();
    { const int row = tid >> 3, d0 = (tid & 7) * 8; float o[8] = {0.f, 0.f, 0.f, 0.f, 0.f, 0.f, 0.f, 0.f};
      for (int k = 0; k < 144; ++k) { const float pv = P[row * 145 + k];
#pragma unroll
          for (int i = 0; i < 8; ++i) o[i] += pv * Vf[k * 64 + d0 + i]; }
      const float iv = Pinv[row];
#pragma unroll
      for (int i = 0; i < 8; ++i) o[i] *= iv;
      *(u32x4*)(H + (size_t)(row & 15) * DINP + C_Q + (kh * 4 + (row >> 4)) * 64 + d0) = pack8(o); }
}
__device__ __forceinline__ void sc_unit(const Frame& F, int layer, int tile) {
    const int tid = F.tid, cg = tid & 127, rs = tid >> 7; bf16_t* H = ws_bf(F, WS_H);
    const float* wsc = F.in[I_SCW] + (size_t)layer * 3 * D + 8 * cg; float wt[3][8];
#pragma unroll
    for (int i = 0; i < 3; ++i)
#pragma unroll
        for (int c = 0; c < 8; ++c) wt[i][c] = wsc[i * D + c];
    for (int rr = rs; rr < 64; rr += 4) { const int row = tile * 64 + rr; const bool smp = row >= NP;
        const int tt = smp ? (row - NP) & 15 : row % SEQ; float a[8] = {0.f, 0.f, 0.f, 0.f, 0.f, 0.f, 0.f, 0.f};
#pragma unroll
        for (int i = 0; i < 3; ++i) { const int t2 = tt - 2 + i; float u[8];
            if (t2 >= 0) { float c8[8], h8[8]; unpack8(*(const u32x4*)(H + (size_t)(row - 2 + i) * DINP + C_SCC + 8 * cg), c8); unpack8(*(const u32x4*)(H + (size_t)(row - 2 + i) * DINP + C_SCH + 8 * cg), h8);
#pragma unroll
                for (int c = 0; c < 8; ++c) u[c] = c8[c] * h8[c]; }
            else if (smp) { const float* hp = F.in[I_SSC] + (((size_t)layer * DECB + ((row - NP) >> 4)) * 2 + (t2 + 2)) * D + 8 * cg;
#pragma unroll
                for (int c = 0; c < 8; ++c) u[c] = hp[c]; }
            else {
#pragma unroll
                for (int c = 0; c < 8; ++c) u[c] = 0.f; }
#pragma unroll
            for (int c = 0; c < 8; ++c) a[c] += u[c] * wt[i][c]; }
        float b8[8]; unpack8(*(const u32x4*)(H + (size_t)row * DINP + C_SCB + 8 * cg), b8);
#pragma unroll
        for (int c = 0; c < 8; ++c) a[c] *= b8[c];
        *(u32x4*)(H + (size_t)row * DINP + C_SCB + 8 * cg) = pack8(a); }
}
__device__ __forceinline__ void state_out_unit(const Frame& F, int layer, int mb, int sl, bool smp) {
    const int tid = F.tid; const bf16_t* H = ws_bf(F, WS_H);
    const int nkv = smp ? DECS : WINDOW, len = smp ? DECS : SEQ; const size_t row0 = smp ? (size_t)NP + sl * 16 : (size_t)sl * SEQ; const int sg = smp ? sl : mb * NSEQ_MB + sl;
    const size_t nb_ = smp ? DECB : BATCH;
    float* ko = F.out + (smp ? O_KS : O_KP) + ((size_t)layer * nb_ + sg) * nkv * 256; float* vo = F.out + (smp ? O_VS : O_VP) + ((size_t)layer * nb_ + sg) * nkv * 256;
    for (int i = tid; i < nkv * 32; i += NTHREADS) { const int j = i >> 5, c8 = (i & 31) * 8; const bf16_t* hp = H + (row0 + len - nkv + j) * DINP; float f[8];
        unpack8(*(const u32x4*)(hp + C_K + c8), f); *(f32x4*)(ko + (size_t)j * 256 + c8) = (f32x4){f[0], f[1], f[2], f[3]}; *(f32x4*)(ko + (size_t)j * 256 + c8 + 4) = (f32x4){f[4], f[5], f[6], f[7]};
        unpack8(*(const u32x4*)(hp + C_V + c8), f); *(f32x4*)(vo + (size_t)j * 256 + c8) = (f32x4){f[0], f[1], f[2], f[3]}; *(f32x4*)(vo + (size_t)j * 256 + c8 + 4) = (f32x4){f[4], f[5], f[6], f[7]}; }
    float* co = F.out + (smp ? O_CVS : O_CVP) + ((size_t)layer * nb_ + sg) * 3 * CONVDIM;
    for (int i = tid; i < 3 * 512; i += NTHREADS) { const int j = i / 512, c8 = (i % 512) * 8; float f[8]; unpack8(*(const u32x4*)(H + (row0 + len - 3 + j) * DINP + C_X + c8), f);
        *(f32x4*)(co + (size_t)j * CONVDIM + c8) = (f32x4){f[0], f[1], f[2], f[3]}; *(f32x4*)(co + (size_t)j * CONVDIM + c8 + 4) = (f32x4){f[4], f[5], f[6], f[7]}; }
    float* so = F.out + (smp ? O_SCS : O_SCP) + ((size_t)layer * nb_ + sg) * 2 * D;
    for (int i = tid; i < 2 * 128; i += NTHREADS) { const int j = i >> 7, c8 = (i & 127) * 8; float c[8], h[8]; const bf16_t* hp = H + (row0 + len - 2 + j) * DINP;
        unpack8(*(const u32x4*)(hp + C_SCC + c8), c); unpack8(*(const u32x4*)(hp + C_SCH + c8), h);
        *(f32x4*)(so + (size_t)j * D + c8) = (f32x4){c[0] * h[0], c[1] * h[1], c[2] * h[2], c[3] * h[3]}; *(f32x4*)(so + (size_t)j * D + c8 + 4) = (f32x4){c[4] * h[4], c[5] * h[5], c[6] * h[6], c[7] * h[7]}; }
}
#ifndef MIX_MASK
#define MIX_MASK 0xFF
#endif
#define MIXON(b) ((MIX_MASK >> (b)) & 1)
__device__ __forceinline__ void step_mixers(const Frame& F, int layer, int mb) {
    const int n_ssd = NSEQ_MB * 32, n_att = NSEQ_MB * NCHUNK * NKV, n_sc = rows_of(mb) / 64, n_so = NSEQ_MB + (mb == 0 ? DECB : 0);
    const int n_ss = mb == 0 ? DECB * 32 : 0, n_as = mb == 0 ? DECB * NKV : 0;
    const int total = n_ssd + n_att + n_sc + n_so + n_ss + n_as;
    for (int un = F.bid; un < total; un += F.G) { int r = un;
#define UF(Fu) Frame Fu = F; Fu.tid = opq(F.tid); Fu.lane = Fu.tid & 63; Fu.wave = __builtin_amdgcn_readfirstlane(Fu.tid >> 6)
        if (r < n_ssd) { if constexpr (MIXON(0)) { UF(Fu); ssd_prompt_unit(Fu, layer, mb, r >> 5, r & 31); } continue; } r -= n_ssd;
        if (r < n_att) { if constexpr (MIXON(1)) { UF(Fu); attn_prompt_unit(Fu, layer, r / (NCHUNK * NKV), (r / NKV) % NCHUNK, r % NKV); } continue; } r -= n_att;
        if (r < n_sc) { if constexpr (MIXON(2)) { UF(Fu); sc_unit(Fu, layer, r); } continue; } r -= n_sc;
        if (r < n_so) { if constexpr (MIXON(3)) { UF(Fu); state_out_unit(Fu, layer, mb, r < NSEQ_MB ? r : r - NSEQ_MB, r >= NSEQ_MB); } continue; } r -= n_so;
        if (r < n_ss) { if constexpr (MIXON(4)) { UF(Fu); ssd_sample_unit(Fu, layer, r >> 5, r & 31); } continue; } r -= n_ss;
        if constexpr (MIXON(5)) { UF(Fu); attn_sample_unit(Fu, layer, r >> 2, r & 3); }
    }
}
__device__ __forceinline__ void step_gnorm(const Frame& F, int mb) {
    const int gw = F.bid * NWAVES + F.wave, NGW = F.G * NWAVES, nr = rows_of(mb); bf16_t* H = ws_bf(F, WS_H); const float* ssq = ws_f(F, WS_SSQ);
    for (int r = gw; r < nr; r += NGW) { const int g = F.lane >> 3; const f32x4 q = *(const f32x4*)(ssq + (size_t)r * 32 + 4 * g);
        const float rstd = 1.0f / sqrtf(((q[0] + q[1]) + (q[2] + q[3])) * (1.0f / 256.0f) + LN_EPS);
        u32x4* p = (u32x4*)(H + (size_t)r * DINP + C_Z + 32 * F.lane);
#pragma unroll
        for (int j = 0; j < 4; ++j) { float f[8]; unpack8(p[j], f);
#pragma unroll
            for (int i = 0; i < 8; ++i) f[i] *= rstd;
            p[j] = pack8(f); } }
}
constexpr int LOG_NEXP = NEXP == 32 ? 5 : (NEXP == 16 ? 4 : (NEXP == 8 ? 3 : 2));
template <int N, int MASK> struct RedStep {
    static __device__ __forceinline__ void run(float* v, int lane) {
        constexpr int Hn = N / 2; const bool up = (lane & MASK) != 0;
#pragma unroll
        for (int i = 0; i < Hn; ++i) { const float keep = up ? v[i + Hn] : v[i], send = up ? v[i] : v[i + Hn]; v[i] = keep + __shfl_xor(send, MASK); }
        if constexpr (Hn > 1) RedStep<Hn, (MASK >> 1)>::run(v, lane);
    }
};
__device__ __forceinline__ void step_ln1_router(const Frame& F, int layer, int mb) {
    LAS float* wT = (LAS float*)F.lds;
    const float* rw = F.in[I_RW] + (size_t)layer * D * NEXP;
    __syncthreads();
    for (int i = F.tid; i < D * NEXP; i += NTHREADS) { const int k = i / NEXP, e = i % NEXP; wT[e * D + k] = rw[i]; }
    __syncthreads();
    const int gw = F.bid * NWAVES + F.wave, NGW = F.G * NWAVES, nr = rows_of(mb), lane = F.lane;
    const float* lg = F.in[I_LN1G] + (size_t)layer * D; const float* lb = F.in[I_LN1B] + (size_t)layer * D; const float* rb = F.in[I_RB] + (size_t)layer * NEXP;
    unsigned* cnt = F.ctl + CW_CNT + (mb * DEPTH + layer) * 64;
    bf16_t* XB = ws_bf(F, WS_XB); int* topi = (int*)(F.ws + WS_TOPI); float* gate = ws_f(F, WS_GATE); int* pos = (int*)(F.ws + WS_POS);
    for (int r = gw; r < nr; r += NGW) {
        float* xr = x_out_row(F, mb, r); f32x4 v[4]; float s = 0.f;
#pragma unroll
        for (int j = 0; j < 4; ++j) { v[j] = *((const f32x4*)xr + lane + 64 * j); s += (v[j][0] + v[j][1]) + (v[j][2] + v[j][3]); }
        const float mean = wave_sum(s) * (1.0f / D); float s2 = 0.f;
#pragma unroll
        for (int j = 0; j < 4; ++j) { v[j] = v[j] - mean; s2 += (v[j][0] * v[j][0] + v[j][1] * v[j][1]) + (v[j][2] * v[j][2] + v[j][3] * v[j][3]); }
        const float rstd = 1.0f / sqrtf(wave_sum(s2) * (1.0f / D) + LN_EPS);
#pragma unroll
        for (int j = 0; j < 4; ++j) { const f32x4 gg = *((const f32x4*)lg + lane + 64 * j), bb = *((const f32x4*)lb + lane + 64 * j); v[j] = v[j] * rstd * gg + bb;
            *((f32x4*)xr + lane + 64 * j) = v[j]; u32x2 w; w.x = pk2(v[j][0], v[j][1]); w.y = pk2(v[j][2], v[j][3]); *((u32x2*)(XB + (size_t)r * D) + lane + 64 * j) = w; }
        float lgt[NEXP];
#pragma unroll
        for (int e = 0; e < NEXP; ++e) { float a = 0.f;
#pragma unroll
            for (int j = 0; j < 4; ++j) { const f32x4 wv = *((const LAS f32x4*)(wT + e * D) + lane + 64 * j); a += (v[j][0] * wv[0] + v[j][1] * wv[1]) + (v[j][2] * wv[2] + v[j][3] * wv[3]); }
            lgt[e] = a; if ((e & 1) == 1) asm volatile("" ::: "memory"); }
        RedStep<NEXP, 32>::run(lgt, lane);
        float tot = lgt[0];
#pragma unroll
        for (int mk = (32 >> LOG_NEXP); mk >= 1; mk >>= 1) tot += __shfl_xor(tot, mk);
        const int myexp = lane >> (6 - LOG_NEXP);
        float val = tot + rb[myexp];
        float tv[4]; int te[4];
#pragma unroll
        for (int k = 0; k < 4; ++k) { float bv = val; int be = myexp;
#pragma unroll
            for (int o = 1; o < 64; o <<= 1) { const float ov = __shfl_xor(bv, o); const int oe = __shfl_xor(be, o); if (ov > bv || (ov == bv && oe < be)) { bv = ov; be = oe; } }
            tv[k] = bv; te[k] = be; if (myexp == be) val = -3.0e38f; }
        const float e1 = expf(tv[1] - tv[0]), e2 = expf(tv[2] - tv[0]), e3 = expf(tv[3] - tv[0]); const float inv = 1.0f / (1.0f + e1 + e2 + e3);
        if (lane < 4) { const int e = lane == 0 ? te[0] : (lane == 1 ? te[1] : (lane == 2 ? te[2] : te[3])); const float gv = (lane == 0 ? 1.0f : (lane == 1 ? e1 : (lane == 2 ? e2 : e3))) * inv;
            const unsigned rk = __hip_atomic_fetch_add(cnt + e, 1u, __ATOMIC_RELAXED, __HIP_MEMORY_SCOPE_AGENT);
            topi[(size_t)r * 4 + lane] = e; gate[(size_t)r * 4 + lane] = gv; pos[(size_t)r * 4 + lane] = (int)rk; }
    }
}
__device__ __forceinline__ int moe_table(const Frame& F, int layer, int mb) {
    LAS int* M = (LAS int*)(F.lds + MISC_OFF);
    __syncthreads();
    if (F.tid == 0) { unsigned* cnt = F.ctl + CW_CNT + (mb * DEPTH + layer) * 64; int acc = 0;
        for (int e = 0; e < NEXP; ++e) { const int c = (int)__hip_atomic_load(cnt + e, __ATOMIC_RELAXED, __HIP_MEMORY_SCOPE_AGENT); M[64 + e] = acc * 256; acc += (c + 255) / 256; M[16 + e] = acc; } }
    __syncthreads();
    return M[16 + NEXP - 1];
}
__device__ __forceinline__ void step_gather(const Frame& F, int layer, int mb) {
    (void)moe_table(F, layer, mb); const LAS int* M = (const LAS int*)(F.lds + MISC_OFF);
    const int gw = F.bid * NWAVES + F.wave, NGW = F.G * NWAVES, nr = rows_of(mb), lane = F.lane;
    const bf16_t* XB = ws_bf(F, WS_XB); bf16_t* XS = ws_bf(F, WS_H); const int* topi = (const int*)(F.ws + WS_TOPI); const float* gate = ws_f(F, WS_GATE); int* pos = (int*)(F.ws + WS_POS); float* gs = ws_f(F, WS_GSORT);
    for (int r = gw; r < nr; r += NGW) {
        const u32x4 a = *((const u32x4*)(XB + (size_t)r * D) + lane), b = *((const u32x4*)(XB + (size_t)r * D) + 64 + lane);
        int pk[4];
#pragma unroll
        for (int k = 0; k < 4; ++k) { const int e = topi[(size_t)r * 4 + k]; pk[k] = M[64 + e] + pos[(size_t)r * 4 + k]; }
        WAVE_SYNC();
#pragma unroll
        for (int k = 0; k < 4; ++k) { const int p = pk[k];
            *((u32x4*)(XS + (size_t)p * D) + lane) = a; *((u32x4*)(XS + (size_t)p * D) + 64 + lane) = b;
            if (lane == k) { pos[(size_t)r * 4 + k] = p; gs[p] = gate[(size_t)r * 4 + k]; } }
    }
}
__device__ __forceinline__ void step_ln2(const Frame& F, int layer, int mb) {
    const int gw = F.bid * NWAVES + F.wave, NGW = F.G * NWAVES, nr = rows_of(mb), lane = F.lane;
    const float* lg = F.in[I_LN2G] + (size_t)layer * D; const float* lb = F.in[I_LN2B] + (size_t)layer * D;
    const bf16_t* OUTS = ws_bf(F, WS_H) + (size_t)2 * RP * D; const int* pos = (const int*)(F.ws + WS_POS); bf16_t* XB = ws_bf(F, WS_XB);
    for (int r = gw; r < nr; r += NGW) {
        float* xr = x_out_row(F, mb, r); f32x4 v[4]; float s = 0.f; int p[4];
#pragma unroll
        for (int k = 0; k < 4; ++k) p[k] = pos[(size_t)r * 4 + k];
#pragma unroll
        for (int j = 0; j < 4; ++j) { v[j] = *((const f32x4*)xr + lane + 64 * j) * ALPHA;
#pragma unroll
            for (int k = 0; k < 4; ++k) { const u32x2 w = *((const u32x2*)(OUTS + (size_t)p[k] * D) + lane + 64 * j); v[j] = v[j] + (f32x4){blo(w.x), bhi(w.x), blo(w.y), bhi(w.y)}; }
            s += (v[j][0] + v[j][1]) + (v[j][2] + v[j][3]); }
        const float mean = wave_sum(s) * (1.0f / D); float s2 = 0.f;
#pragma unroll
        for (int j = 0; j < 4; ++j) { v[j] = v[j] - mean; s2 += (v[j][0] * v[j][0] + v[j][1] * v[j][1]) + (v[j][2] * v[j][2] + v[j][3] * v[j][3]); }
        const float rstd = 1.0f / sqrtf(wave_sum(s2) * (1.0f / D) + LN_EPS);
#pragma unroll
        for (int j = 0; j < 4; ++j) { const f32x4 gg = *((const f32x4*)lg + lane + 64 * j), bb = *((const f32x4*)lb + lane + 64 * j); v[j] = v[j] * rstd * gg + bb;
            *((f32x4*)xr + lane + 64 * j) = v[j]; u32x2 w; w.x = pk2(v[j][0], v[j][1]); w.y = pk2(v[j][2], v[j][3]); *((u32x2*)(XB + (size_t)r * D) + lane + 64 * j) = w; }
    }
}

constexpr int PH_PER = 11, NSTEPS = 1 + NMB * DEPTH * PH_PER;
__global__ void __launch_bounds__(NTHREADS, 2) fwd(Args args) {
#ifdef EMU
    unsigned char* lds = emu_wg->lds;
#else
    extern __shared__ __attribute__((aligned(16))) unsigned char lds[];
#endif
    Frame F0; F0.lds = (LAS unsigned char*)lds; F0.tid = threadIdx.x; F0.lane = F0.tid & 63; F0.wave = __builtin_amdgcn_readfirstlane(F0.tid >> 6); F0.G = gridDim.x; F0.bid = blockIdx.x;
#ifdef EMU
    F0.in = args.in;
#else
    F0.in = (ArgTab)__builtin_amdgcn_kernarg_segment_ptr();
    static_assert(offsetof(Args, out) == 248 && offsetof(Args, ws) == 256 && offsetof(Args, in) == 0, "PF() reads the argument struct by offset");
#endif
    F0.out = args.out; F0.ws = args.ws; F0.ctl = (unsigned*)(args.ws + WS_CTL);
    const Frame& F = F0;
    const int lo = args.lo, hi = args.hi;
#ifndef EMU
    for (int u = F.tid; u < (LDS_BYTES - RING_BYTES) / 4; u += NTHREADS) ((LAS unsigned*)(F.lds + RING_BYTES))[u] = 0u;
    __syncthreads();
    XcdBarrier bar; bar.bar = F.ctl + CW_BAR; bar.x = 0; bar.st = nullptr;
    if (hi - lo > 1) bar = xcd_barrier_post(F.ctl + CW_BAR, (volatile LAS unsigned*)(F.lds + MISC_OFF) + 8);
#define SEAM(s) do { if ((s) + 1 < hi) xcd_barrier(bar); } while (0)
#else
#define SEAM(s) do { } while (0)
#endif
#ifndef PH_MASK
#define PH_MASK 0xFFFFFFFF
#endif
#define IN(s) (lo <= (s) && (s) < hi)
#define PHON(b) ((PH_MASK >> (b)) & 1)
#ifdef EMU
#define PF(Fp) Frame Fp = F0
#else
#define PF(Fp) Frame Fp; { unsigned long long kp_ = (unsigned long long)__builtin_amdgcn_kernarg_segment_ptr(); asm volatile("" : "+s"(kp_)); \
    Fp.in = (ArgTab)kp_; Fp.out = *(float* const __attribute__((address_space(4)))*)(kp_ + 248); Fp.ws = *(unsigned char* const __attribute__((address_space(4)))*)(kp_ + 256); Fp.ctl = (unsigned*)Fp.ws; \
    Fp.lds = F0.lds; Fp.G = F0.G; Fp.bid = F0.bid; Fp.tid = opq(F0.tid); Fp.lane = Fp.tid & 63; Fp.wave = __builtin_amdgcn_readfirstlane(Fp.tid >> 6); }
#endif
    int step = 0;
    if (IN(step)) { if constexpr (PHON(0)) { PF(F); step_weights(F); } SEAM(step); }
    ++step;
    for (int mb = 0; mb < NMB; ++mb)
        for (int layer = 0; layer < DEPTH; ++layer) {
            const int nr = rows_of(mb);
            if (IN(step)) { if constexpr (PHON(1)) { PF(F); if (layer == 0) step_xb(F, mb); } SEAM(step); }
            ++step;
            if (IN(step)) { if constexpr (PHON(2)) { PF(F); pg8::Gemm g{ws_bf(F, WS_XB), wl_ptr(F, layer, WL_IN), nr, DINP, D, D}; pg8::StaticOrder S; S.init(nr, DINP, F.G, F.bid);
                pg8::EpiStoreBf16 E{ws_bf(F, WS_H), DINP}; pg8::gemm_phase(F.lds, g, S, E); } SEAM(step); }
            ++step;
            if (IN(step)) { if constexpr (PHON(3)) { PF(F); step_mixers(F, layer, mb); } SEAM(step); }
            ++step;
            if (IN(step)) { if constexpr (PHON(4)) { PF(F); step_gnorm(F, mb); } SEAM(step); }
            ++step;
            if (IN(step)) { if constexpr (PHON(5)) { PF(F); pg8::StaticOrder S; S.init(nr, D, F.G, F.bid); bf16_t* H = ws_bf(F, WS_H); bf16_t* MGb = ws_bf(F, WS_XB);
#ifndef MERGE_MASK
#define MERGE_MASK 7
#endif
                if constexpr (MERGE_MASK & 1) { pg8::Gemm g{H + C_Z, wl_ptr(F, layer, WL_SSD), nr, D, DINNER, DINP}; pg8::EpiGate<0> E{H + C_GSSD, MGb}; pg8::gemm_phase(F.lds, g, S, E); }
                if constexpr (MERGE_MASK & 2) { pg8::Gemm g{H + C_Q, wl_ptr(F, layer, WL_ATT), nr, D, D, DINP}; pg8::EpiGate<1> E{H + C_GATT, MGb}; pg8::gemm_phase(F.lds, g, S, E); }
                if constexpr (MERGE_MASK & 4) { pg8::Gemm g{H + C_SCB, wl_ptr(F, layer, WL_SC), nr, D, D, DINP}; pg8::EpiGate<1> E{H + C_GSC, MGb}; pg8::gemm_phase(F.lds, g, S, E); } }
                SEAM(step); }
            ++step;
            if (IN(step)) { if constexpr (PHON(6)) { PF(F); pg8::Gemm g{ws_bf(F, WS_XB), wl_ptr(F, layer, WL_O), nr, D, D, D}; pg8::StaticOrder S; S.init(nr, D, F.G, F.bid);
                pg8::EpiResid E{layer == 0 ? F.in[I_XP] + (size_t)mb * NP * D : F.out + O_YP + (size_t)mb * NP * D, layer == 0 ? F.in[I_XS] : F.out + O_YS, F.out + O_YP + (size_t)mb * NP * D, F.out + O_YS};
                pg8::gemm_phase(F.lds, g, S, E); } SEAM(step); }
            ++step;
            if (IN(step)) { if constexpr (PHON(7)) { PF(F); step_ln1_router(F, layer, mb); } SEAM(step); }
            ++step;
            if (IN(step)) { if constexpr (PHON(8)) { PF(F); step_gather(F, layer, mb); } SEAM(step); }
            ++step;
            if (IN(step)) { if constexpr (PHON(9)) { PF(F); const int nt = moe_table(F, layer, mb); pg8::MoeOrder S{(const LAS int*)(F.lds + MISC_OFF) + 16, 8, nt * 8, F.G, F.bid};
                pg8::Gemm g{ws_bf(F, WS_H), wl_ptr(F, layer, WL_UP), nt * 256, 2048, D, D}; pg8::EpiSwiglu E{ws_bf(F, WS_H) + (size_t)RP * D, F.in[I_BUP] + (size_t)layer * NEXP * 2048};
                pg8::gemm_phase(F.lds, g, S, E); } SEAM(step); }
            ++step;
            if (IN(step)) { if constexpr (PHON(10)) { PF(F); const int nt = moe_table(F, layer, mb); pg8::MoeOrder S{(const LAS int*)(F.lds + MISC_OFF) + 16, 4, nt * 4, F.G, F.bid};
                pg8::Gemm g{ws_bf(F, WS_H) + (size_t)RP * D, wl_ptr(F, layer, WL_DN), nt * 256, D, D, D}; pg8::EpiDown E{ws_bf(F, WS_H) + (size_t)2 * RP * D, F.in[I_BDN] + (size_t)layer * NEXP * D, ws_f(F, WS_GSORT)};
                pg8::gemm_phase(F.lds, g, S, E); } SEAM(step); }
            ++step;
            if (IN(step)) { if constexpr (PHON(11)) { PF(F); step_ln2(F, layer, mb); } SEAM(step); }
            ++step;
        }
}

#ifdef EMU
extern int emu_grid, emu_step_lo, emu_step_hi;
#endif
extern "C" void kernel_launch(void* const* d_in, const int* in_sizes, int n_in, void* d_out, int out_size, void* d_ws, size_t ws_size, hipStream_t stream) {
    (void)in_sizes; (void)out_size;
    if (n_in != 31 || ws_size < WS_END) { fprintf(stderr, "kernel_launch: expected 31 inputs and >= %zu bytes of workspace (got %d, %zu)\n", (size_t)WS_END, n_in, ws_size); return; }
    Args a; memset(&a, 0, sizeof(a));
    for (int i = 0; i < 31; ++i) a.in[i] = (const float*)d_in[i];
    a.out = (float*)d_out; a.ws = (unsigned char*)d_ws;
#ifdef EMU
    if (emu_step_lo == 0) memset((char*)d_ws + WS_CTL, 0, CTL_BYTES);
    for (int s = emu_step_lo; s < emu_step_hi && s < NSTEPS; ++s) { a.lo = s; a.hi = s + 1; emu_launch(fwd, emu_grid, NTHREADS, LDS_BYTES, a); fprintf(stderr, "step %d done\n", s); }
#else
    (void)hipMemsetAsync((char*)d_ws + WS_CTL, 0, CTL_BYTES, stream);
    static int grid = 0;
    if (grid == 0) {
        int dev = 0, cus = 0;
        if (hipGetDevice(&dev) != hipSuccess || hipDeviceGetAttribute(&cus, hipDeviceAttributeMultiprocessorCount, dev) != hipSuccess) { grid = -1; return; }
        if (hipFuncSetAttribute((const void*)fwd, hipFuncAttributeMaxDynamicSharedMemorySize, LDS_BYTES) != hipSuccess) { grid = -1; return; }
        int per_cu = 0; (void)hipOccupancyMaxActiveBlocksPerMultiprocessor(&per_cu, (const void*)fwd, NTHREADS, LDS_BYTES); (void)hipGetLastError();
        grid = cus;
    }
    if (grid < 0) return;
#if CFG_ONE_LAUNCH
    a.lo = 0; a.hi = NSTEPS; hipLaunchKernelGGL(fwd, dim3(grid), dim3(NTHREADS), LDS_BYTES, stream, a);
#else
    for (int s = 0; s < NSTEPS; ++s) { a.lo = s; a.hi = s + 1; hipLaunchKernelGGL(fwd, dim3(grid), dim3(NTHREADS), LDS_BYTES, stream, a); }
#endif
#endif
}
```

```cpp
#ifdef EMU
#include "emu.h"
#else
#include <hip/hip_runtime.h>
#endif
#include <cstdio>
#include <cstdint>
#include <cstring>
#include <cstddef>
#include <cmath>

#ifndef CFG_BATCH
#define CFG_BATCH 16
#endif
#ifndef CFG_SEQ
#define CFG_SEQ 4096
#endif
#ifndef CFG_NSEQ_MB
#define CFG_NSEQ_MB 8
#endif
#ifndef CFG_NEXP
#define CFG_NEXP 32
#endif
#ifndef CFG_ONE_LAUNCH
#define CFG_ONE_LAUNCH 1
#endif

constexpr int BATCH = CFG_BATCH, SEQ = CFG_SEQ, NSEQ_MB = CFG_NSEQ_MB, NEXP = CFG_NEXP, NMB = BATCH / NSEQ_MB;
constexpr int D = 1024, DEPTH = 2, DECB = 16, DECS = 16, NS = DECB * DECS;
constexpr int DINNER = 2048, CONVDIM = 4096;
constexpr int NKV = 4, WINDOW = 128, CHUNK = 64;
constexpr int DIN = 13856, DINP = 14080;
constexpr int NP = NSEQ_MB * SEQ, R = NP + NS;
constexpr int RP = ((4 * R + NEXP * 255) + 255) / 256 * 256;
constexpr int NCHUNK = SEQ / CHUNK;
constexpr int C_Z = 0, C_X = 2048, C_B = 4096, C_C = 5120, C_Q = 6144, C_K = 7168, C_V = 7424, C_SCB = 7680, C_SCC = 8704, C_SCH = 9728, C_GSSD = 10752, C_GATT = 11776, C_GSC = 12800, C_DT = 13824;
constexpr float LN_EPS = 1e-5f, ALPHA = 1.41421356237309515f  , SW_LIMIT = 7.0f, SW_ALPHA = 1.702f;
static_assert(BATCH % NSEQ_MB == 0 && SEQ % 256 == 0 && (NEXP & (NEXP - 1)) == 0 && NEXP <= 32 && NEXP >= 4, "config");

constexpr size_t O_YP = 0, O_YS = O_YP + (size_t)BATCH * SEQ * D, O_KP = O_YS + (size_t)NS * D, O_VP = O_KP + (size_t)DEPTH * BATCH * WINDOW * 256,
    O_SSP = O_VP + (size_t)DEPTH * BATCH * WINDOW * 256, O_CVP = O_SSP + (size_t)DEPTH * BATCH * 32 * 64 * 128, O_SCP = O_CVP + (size_t)DEPTH * BATCH * 3 * CONVDIM,
    O_KS = O_SCP + (size_t)DEPTH * BATCH * 2 * D, O_VS = O_KS + (size_t)DEPTH * DECB * DECS * 256, O_SSS = O_VS + (size_t)DEPTH * DECB * DECS * 256,
    O_CVS = O_SSS + (size_t)DEPTH * DECB * 32 * 64 * 128, O_SCS = O_CVS + (size_t)DEPTH * DECB * 3 * CONVDIM, O_END = O_SCS + (size_t)DEPTH * DECB * 2 * D;

constexpr size_t al256(size_t x) { return (x + 255) / 256 * 256; }
constexpr size_t WS_CTL = 0, CTL_BYTES = 1u << 20;
constexpr size_t WS_SSQ = CTL_BYTES, WS_TOPI = WS_SSQ + al256((size_t)R * 32 * 4), WS_GATE = WS_TOPI + al256((size_t)R * 16), WS_POS = WS_GATE + al256((size_t)R * 16),
    WS_GSORT = WS_POS + al256((size_t)R * 16), WS_W = WS_GSORT + al256((size_t)RP * 4);
constexpr size_t WL_IN = 0, WL_SSD = WL_IN + (size_t)DINP * D * 2, WL_ATT = WL_SSD + (size_t)D * DINNER * 2, WL_SC = WL_ATT + (size_t)D * D * 2, WL_O = WL_SC + (size_t)D * D * 2,
    WL_UP = WL_O + (size_t)D * D * 2, WL_DN = WL_UP + (size_t)NEXP * 2048 * D * 2, WL_BYTES = WL_DN + (size_t)NEXP * D * D * 2;
constexpr size_t WS_XB = WS_W + DEPTH * WL_BYTES, WS_H = WS_XB + (size_t)R * D * 2;
constexpr size_t H_BYTES = (size_t)R * DINP * 2, MOE_BYTES = (size_t)3 * RP * D * 2, U_BYTES = H_BYTES > MOE_BYTES ? H_BYTES : MOE_BYTES;
constexpr size_t WS_END = WS_H + U_BYTES;
static_assert(WS_END <= ((size_t)2 << 30), "workspace map exceeds 2 GiB");
constexpr int CW_BAR = 4096, CW_CNT = 16384;

constexpr int RING_BYTES = 131072, MISC_OFF = RING_BYTES + 320, LDS_BYTES = 147456;
constexpr int NWAVES = 8, NTHREADS = 512;

#ifdef EMU
#define LAS
#define WAVE_SYNC() emu_wave_barrier()
#else
#define LAS __attribute__((address_space(3)))
#define WAVE_SYNC() asm volatile("s_waitcnt lgkmcnt(0)" ::: "memory")
#endif
typedef unsigned short bf16_t;
typedef short bf16x8 __attribute__((ext_vector_type(8)));
typedef float f32x4 __attribute__((ext_vector_type(4)));
typedef float f32x16 __attribute__((ext_vector_type(16)));
typedef unsigned u32x4 __attribute__((ext_vector_type(4)));
typedef unsigned u32x2 __attribute__((ext_vector_type(2)));

__device__ __forceinline__ unsigned f2bf(float f) { unsigned u = __builtin_bit_cast(unsigned, f); return (u + 0x7fffu + ((u >> 16) & 1u)) >> 16; }
__device__ __forceinline__ float bf2f(unsigned h) { return __builtin_bit_cast(float, (h & 0xffffu) << 16); }
#ifdef EMU
__device__ __forceinline__ unsigned pk2(float lo, float hi) { return f2bf(lo) | (f2bf(hi) << 16); }
#else
typedef float f32x2_t __attribute__((ext_vector_type(2))); typedef __bf16 bf16x2_t __attribute__((ext_vector_type(2)));
__device__ __forceinline__ unsigned pk2(float lo, float hi) { f32x2_t v = {lo, hi}; bf16x2_t b = __builtin_convertvector(v, bf16x2_t); return __builtin_bit_cast(unsigned, b); }
#endif
__device__ __forceinline__ float blo(unsigned w) { return __builtin_bit_cast(float, w << 16); }
__device__ __forceinline__ float bhi(unsigned w) { return __builtin_bit_cast(float, w & 0xffff0000u); }
__device__ __forceinline__ void unpack8(const u32x4 w, float* f) { f[0] = blo(w.x); f[1] = bhi(w.x); f[2] = blo(w.y); f[3] = bhi(w.y); f[4] = blo(w.z); f[5] = bhi(w.z); f[6] = blo(w.w); f[7] = bhi(w.w); }
__device__ __forceinline__ u32x4 pack8(const float* f) { u32x4 w; w.x = pk2(f[0], f[1]); w.y = pk2(f[2], f[3]); w.z = pk2(f[4], f[5]); w.w = pk2(f[6], f[7]); return w; }
__device__ __forceinline__ float fexp(float x) { return __builtin_amdgcn_exp2f(x * 1.4426950408889634f); }
__device__ __forceinline__ float fsigmoid(float x) { return __builtin_amdgcn_rcpf(1.0f + __builtin_amdgcn_exp2f(-1.4426950408889634f * x)); }
__device__ __forceinline__ float fsilu(float x) { return x * fsigmoid(x); }
#ifdef EMU
__device__ __forceinline__ int opq(int x) { return x; }
#else
__device__ __forceinline__ int opq(int x) { asm volatile("" : "+v"(x)); return x; }
#endif
__device__ __forceinline__ float wave_sum(float v) {
#pragma unroll
    for (int o = 1; o < 64; o <<= 1) v += __shfl_xor(v, o);
    return v;
}

namespace pg8 {
constexpr int BM = 256, BK = 64, HALF = 128, HTB = HALF * BK * 2, NXCD = 8, WGM = 8;
struct Unit { int pm, pn, bt, e; };
struct Gemm { const bf16_t* A; const bf16_t* Bt; int M, N, K, lda; };
struct StaticOrder {
    int nM, nN, nwg, G, c;
    __host__ __device__ void init(int M, int N, int G_, int c_) { nM = M / BM; nN = N / BM; nwg = nM * nN; G = G_; c = c_; }
    __host__ __device__ bool next(int i, Unit& u) const {
        const long L = (long)i * G + c; if (L >= nwg) return false;
        int wgid = (int)L; { const int q = nwg / NXCD, r = nwg % NXCD, xcd = wgid % NXCD, off = wgid / NXCD; wgid = (xcd < r ? xcd * (q + 1) : r * (q + 1) + (xcd - r) * q) + off; }
        const int nig = WGM * nN, gid = wgid / nig, fm = gid * WGM, gsz = (nM - fm) < WGM ? (nM - fm) : WGM;
        u.pm = fm + ((wgid % nig) % gsz); u.pn = (wgid % nig) / gsz; u.bt = u.pn; u.e = 0; return true;
    }
    __device__ __forceinline__ void a_ready(const Unit&) const {}
    __device__ __forceinline__ void done(const Unit&) const {}
};
struct MoeOrder {
    const LAS int* tend; int npn, ntot, G, c;
    __device__ __forceinline__ bool next(int i, Unit& u) const {
        const long L = (long)i * G + c; if (L >= ntot) return false;
        const int rt = (int)L / npn, pn = (int)L % npn; int e = 0;
#pragma unroll
        for (int j = 0; j < NEXP; ++j) e += (tend[j] <= rt) ? 1 : 0;
        u.pm = rt; u.pn = pn; u.e = e; u.bt = e * npn + pn; return true;
    }
    __device__ __forceinline__ void a_ready(const Unit&) const {}
    __device__ __forceinline__ void done(const Unit&) const {}
};
#ifdef EMU
template <class Epi, class Sched>
__device__ void gemm_phase(LAS unsigned char* lds, const Gemm g, const Sched& S, const Epi& E) {
    const int tid = threadIdx.x, wid = tid >> 6, lane = tid & 63, wr = wid >> 2, wc = wid & 3, fr = lane & 15, fq = lane >> 4;
    Unit u;
    for (int i = 0; S.next(i, u); ++i) {
        f32x4 acc[2][2][4][2];
        for (int ai = 0; ai < 2; ++ai) for (int bj = 0; bj < 2; ++bj) for (int m = 0; m < 4; ++m) for (int n = 0; n < 2; ++n) for (int q = 0; q < 4; ++q) {
            const int row = u.pm * 256 + ai * 128 + wr * 64 + m * 16 + fr, col = u.bt * 256 + bj * 128 + wc * 32 + 8 * fq + 4 * n + q;
            const bf16_t* a = g.A + (size_t)row * g.lda; const bf16_t* b = g.Bt + (size_t)col * g.K; float s = 0.f;
            for (int k = 0; k < g.K; ++k) s += bf2f(a[k]) * bf2f(b[k]);
            acc[ai][bj][m][n][q] = s; }
        E(acc, u, wr, wc, fr, fq);
    }
    __syncthreads();
}
#else
#define PG8_LAS __attribute__((address_space(3)))
__host__ __device__ __forceinline__ int lds_byte(int r, int c) { const int st = (r >> 4) * 2 + (c >> 5), rr = r & 15, cc = c & 31, ob = rr * 64 + cc * 2; return st * 1024 + (ob ^ (((ob >> 9) & 1) << 5)); }
__host__ __device__ __forceinline__ void stage_rc(int b, int& R_, int& C_) { const int st = b / 1024, sb = b % 1024, swz = sb ^ (((sb >> 9) & 1) << 5); R_ = (st >> 1) * 16 + swz / 64; C_ = (st & 1) * 32 + (swz % 64) / 2; }
__host__ __device__ __forceinline__ int perm32(int rho) { const int n = rho >> 4, i = rho & 15; return 8 * (i >> 2) + 4 * n + (i & 3); }
template <class Epi, class Sched>
__device__ __forceinline__ void gemm_phase(PG8_LAS unsigned char* lds, const Gemm g, const Sched& S, const Epi& E) {
    const int tid = opq((int)threadIdx.x), wid = __builtin_amdgcn_readfirstlane(tid >> 6), lane = tid & 63, wr = wid >> 2, wc = wid & 3, fr = lane & 15, fq = lane >> 4;
    const int K = g.K, nt = K / BK, lda = g.lda;
    unsigned voffA[2], voffB[2];
#pragma unroll
    for (int i = 0; i < 2; ++i) { int R_, C_; stage_rc(tid * 16 + i * 8192, R_, C_); const int Rb = (R_ & ~31) + perm32(R_ & 31);
        voffA[i] = (unsigned)(R_ * lda + C_) * 2u; voffB[i] = (unsigned)(Rb * K + C_) * 2u; }
    const size_t kstep = (size_t)(BK * 2);
    const size_t hstepA = (size_t)HALF * lda * 2, tstepA = 2 * hstepA;
    const size_t hstepB = (size_t)HALF * K * 2, tstepB = 2 * hstepB;
    const unsigned ldsw = (unsigned)wid * 1024u;
    const int aoff = lds_byte(wr * 64 + fr, fq * 8), boff = lds_byte(wc * 32 + fr, fq * 8);
#define PG8_SA(b, h) (((b) * 2 + (h)) * HTB)
#define PG8_SB(b, h) ((4 + (b) * 2 + (h)) * HTB)
#define PG8_STAGE(bufoff, gbase, voff) do { _Pragma("unroll") for (int _i = 0; _i < 2; ++_i) \
        __builtin_amdgcn_global_load_lds((const unsigned*)((const char*)(gbase) + (voff)[_i]), (PG8_LAS unsigned*)(lds + (bufoff) + ldsw + _i * 8192), 16, 0, 0); } while (0)
#define PG8_LDA(dst, b, h) do { _Pragma("unroll") for (int m = 0; m < 4; ++m) _Pragma("unroll") for (int k = 0; k < 2; ++k) dst[m][k] = *(const PG8_LAS bf16x8*)(lds + PG8_SA(b, h) + aoff + m * 2048 + k * 1024); } while (0)
#define PG8_LDB(dst, b, h) do { _Pragma("unroll") for (int n = 0; n < 2; ++n) _Pragma("unroll") for (int k = 0; k < 2; ++k) dst[n][k] = *(const PG8_LAS bf16x8*)(lds + PG8_SB(b, h) + boff + n * 2048 + k * 1024); } while (0)
#define PG8_MMA(ai, bj, At, Bt) do { __builtin_amdgcn_s_setprio(1); _Pragma("unroll") for (int m = 0; m < 4; ++m) _Pragma("unroll") for (int n = 0; n < 2; ++n) _Pragma("unroll") for (int k = 0; k < 2; ++k) \
        acc[ai][bj][m][n] = __builtin_amdgcn_mfma_f32_16x16x32_bf16(Bt[n][k], At[m][k], acc[ai][bj][m][n], 0, 0, 0); __builtin_amdgcn_s_setprio(0); } while (0)
#define PG8_WAIT_V(n) asm volatile("s_waitcnt vmcnt(" #n ")" ::: "memory")
#define PG8_WAIT_L(n) asm volatile("s_waitcnt lgkmcnt(" #n ")" ::: "memory")
#define PG8_BAR __builtin_amdgcn_s_barrier()
#define PG8_SCHED __builtin_amdgcn_sched_barrier(0)
    Unit cur, nxt; int ui = 0;
    if (!S.next(0, cur)) return;
    f32x4 acc[2][2][4][2];
#pragma unroll
    for (int a = 0; a < 2; ++a)
#pragma unroll
        for (int b = 0; b < 2; ++b)
#pragma unroll
            for (int m = 0; m < 4; ++m)
#pragma unroll
                for (int n = 0; n < 2; ++n) acc[a][b][m][n] = (f32x4){0.f, 0.f, 0.f, 0.f};
    bf16x8 At[4][2], B0[2][2], B1[2][2];
    const char* cA = (const char*)g.A + (size_t)cur.pm * tstepA; const char* cB = (const char*)g.Bt + (size_t)cur.bt * tstepB;
    S.a_ready(cur);
    PG8_STAGE(PG8_SB(0, 0), cB, voffB); PG8_STAGE(PG8_SB(0, 1), cB + hstepB, voffB); PG8_STAGE(PG8_SA(0, 0), cA, voffA); PG8_STAGE(PG8_SA(0, 1), cA + hstepA, voffA);
    if (wr == 1) PG8_BAR;
    PG8_WAIT_V(2); PG8_BAR;
    PG8_STAGE(PG8_SB(1, 0), cB + kstep, voffB); PG8_STAGE(PG8_SA(1, 0), cA + kstep, voffA); PG8_STAGE(PG8_SB(1, 1), cB + hstepB + kstep, voffB);
    PG8_WAIT_V(6); PG8_BAR;
    for (;;) {
        const bool has_next = S.next(ui + 1, nxt);
        const char* nA = has_next ? (const char*)g.A + (size_t)nxt.pm * tstepA : cA; const char* nB = has_next ? (const char*)g.Bt + (size_t)nxt.bt * tstepB : cB;
        for (int t = 0; t < nt; t += 2) {
            const bool last = (t == nt - 2);
            const char* a1 = cA + (size_t)(t + 1) * kstep;
            const char* a2 = last ? nA : cA + (size_t)(t + 2) * kstep; const char* b2 = last ? nB : cB + (size_t)(t + 2) * kstep;
            const char* a3 = a2 + kstep; const char* b3 = b2 + kstep;
            if (last && has_next) S.a_ready(nxt);
            PG8_LDB(B0, 0, 0); PG8_LDB(B1, 0, 1); PG8_SCHED; PG8_LDA(At, 0, 0); PG8_STAGE(PG8_SA(1, 1), a1 + hstepA, voffA);
            PG8_WAIT_V(8); PG8_WAIT_L(0); PG8_BAR; PG8_MMA(0, 0, At, B0); PG8_MMA(0, 1, At, B1); PG8_BAR; PG8_SCHED;
            PG8_LDA(At, 0, 1); PG8_STAGE(PG8_SB(0, 0), b2, voffB); PG8_STAGE(PG8_SB(0, 1), b2 + hstepB, voffB); PG8_STAGE(PG8_SA(0, 0), a2, voffA);
            PG8_WAIT_V(8); PG8_WAIT_L(0); PG8_BAR; PG8_MMA(1, 0, At, B0); PG8_MMA(1, 1, At, B1); PG8_BAR; PG8_SCHED;
            PG8_LDB(B0, 1, 0); PG8_LDB(B1, 1, 1); PG8_SCHED; PG8_LDA(At, 1, 0); PG8_STAGE(PG8_SA(0, 1), a2 + hstepA, voffA);
            PG8_WAIT_V(8); PG8_WAIT_L(0); PG8_BAR; PG8_MMA(0, 0, At, B0); PG8_MMA(0, 1, At, B1); PG8_BAR; PG8_SCHED;
            PG8_LDA(At, 1, 1); PG8_STAGE(PG8_SB(1, 0), b3, voffB); PG8_STAGE(PG8_SB(1, 1), b3 + hstepB, voffB); PG8_STAGE(PG8_SA(1, 0), a3, voffA);
            PG8_WAIT_V(8); PG8_WAIT_L(0); PG8_BAR; PG8_MMA(1, 0, At, B0); PG8_MMA(1, 1, At, B1); PG8_BAR; PG8_SCHED;
        }
        if (wr == 0) PG8_BAR;
        E(acc, cur, wr, wc, fr, fq); S.done(cur);
        if (!has_next) break;
#pragma unroll
        for (int a = 0; a < 2; ++a)
#pragma unroll
            for (int b = 0; b < 2; ++b)
#pragma unroll
                for (int m = 0; m < 4; ++m)
#pragma unroll
                    for (int n = 0; n < 2; ++n) acc[a][b][m][n] = (f32x4){0.f, 0.f, 0.f, 0.f};
        cur = nxt; cA = nA; cB = nB; ++ui;
        if (wr == 1) PG8_BAR;
    }
    PG8_WAIT_V(0);
    PG8_BAR;
#undef PG8_SA
#undef PG8_SB
#undef PG8_STAGE
#undef PG8_LDA
#undef PG8_LDB
#undef PG8_MMA
#undef PG8_WAIT_V
#undef PG8_WAIT_L
#undef PG8_BAR
#undef PG8_SCHED
}
#endif

#define EPI_LOOP_BEGIN const int row0_ = u.pm * 256 + wr * 64 + fr, col0_ = u.pn * 256 + wc * 32 + 8 * fq; \
    _Pragma("unroll") for (int ai = 0; ai < 2; ++ai) _Pragma("unroll") for (int m = 0; m < 4; ++m) { const int row = row0_ + ai * 128 + m * 16; \
    _Pragma("unroll") for (int bj = 0; bj < 2; ++bj) { const int col = col0_ + bj * 128; const f32x4 v0 = acc[ai][bj][m][0], v1 = acc[ai][bj][m][1]; (void)row; (void)col;
#define EPI_LOOP_END asm volatile("" ::: "memory"); } }
struct EpiStoreBf16 {
    bf16_t* O; int ldc;
    __device__ __forceinline__ void operator()(const f32x4 (&acc)[2][2][4][2], const Unit& u, int wr, int wc, int fr, int fq) const {
        EPI_LOOP_BEGIN
            u32x4 w; w.x = pk2(v0[0], v0[1]); w.y = pk2(v0[2], v0[3]); w.z = pk2(v1[0], v1[1]); w.w = pk2(v1[2], v1[3]);
            *(u32x4*)(O + (size_t)row * ldc + col) = w;
        EPI_LOOP_END
    }
};
template <int MODE> struct EpiGate {
    const bf16_t* Hg; bf16_t* MGb;
    __device__ __forceinline__ void operator()(const f32x4 (&acc)[2][2][4][2], const Unit& u, int wr, int wc, int fr, int fq) const {
        EPI_LOOP_BEGIN
            const u32x4 gw = *(const u32x4*)(Hg + (size_t)row * DINP + col); float g[8]; unpack8(gw, g);
            float v[8] = {v0[0], v0[1], v0[2], v0[3], v1[0], v1[1], v1[2], v1[3]};
            bf16_t* mp = MGb + (size_t)row * D + col;
            if (MODE != 0) { float p[8]; unpack8(*(const u32x4*)mp, p);
#pragma unroll
                for (int i = 0; i < 8; ++i) v[i] = p[i] + v[i] * fsigmoid(g[i]); }
            else {
#pragma unroll
                for (int i = 0; i < 8; ++i) v[i] = v[i] * fsigmoid(g[i]); }
            *(u32x4*)mp = pack8(v);
        EPI_LOOP_END
    }
};
struct EpiResid {
    const float* xp; const float* xs; float* op; float* os;
    __device__ __forceinline__ void operator()(const f32x4 (&acc)[2][2][4][2], const Unit& u, int wr, int wc, int fr, int fq) const {
        EPI_LOOP_BEGIN
            const float* xi = row < NP ? xp + (size_t)row * D + col : xs + (size_t)(row - NP) * D + col;
            float* xo = row < NP ? op + (size_t)row * D + col : os + (size_t)(row - NP) * D + col;
            const f32x4 a0 = *(const f32x4*)xi, a1 = *(const f32x4*)(xi + 4);
            *(f32x4*)xo = a0 * ALPHA + v0; *(f32x4*)(xo + 4) = a1 * ALPHA + v1;
        EPI_LOOP_END
    }
};
struct EpiSwiglu {
    bf16_t* ACT; const float* bup;
    __device__ __forceinline__ void operator()(const f32x4 (&acc)[2][2][4][2], const Unit& u, int wr, int wc, int fr, int fq) const {
        const int row0_ = u.pm * 256 + wr * 64 + fr, j0 = u.pn * 128 + wc * 32 + 8 * fq;
        const float* bg = bup + (size_t)u.e * 2048 + j0; const f32x4 bg0 = *(const f32x4*)bg, bg1 = *(const f32x4*)(bg + 4), bu0 = *(const f32x4*)(bg + 1024), bu1 = *(const f32x4*)(bg + 1028);
#pragma unroll
        for (int ai = 0; ai < 2; ++ai)
#pragma unroll
            for (int m = 0; m < 4; ++m) { const int row = row0_ + ai * 128 + m * 16;
                const f32x4 g0 = acc[ai][0][m][0] + bg0, g1 = acc[ai][0][m][1] + bg1, u0 = acc[ai][1][m][0] + bu0, u1 = acc[ai][1][m][1] + bu1; float o[8];
#pragma unroll
                for (int i = 0; i < 4; ++i) { const float ga = fminf(g0[i], SW_LIMIT), ua = fminf(fmaxf(u0[i], -SW_LIMIT), SW_LIMIT); o[i] = (ua + 1.0f) * ga * fsigmoid(SW_ALPHA * ga);
                    const float gb = fminf(g1[i], SW_LIMIT), ub = fminf(fmaxf(u1[i], -SW_LIMIT), SW_LIMIT); o[4 + i] = (ub + 1.0f) * gb * fsigmoid(SW_ALPHA * gb); }
                *(u32x4*)(ACT + (size_t)row * D + j0) = pack8(o); }
    }
};
struct EpiDown {
    bf16_t* O; const float* bdn; const float* gs;
    __device__ __forceinline__ void operator()(const f32x4 (&acc)[2][2][4][2], const Unit& u, int wr, int wc, int fr, int fq) const {
        EPI_LOOP_BEGIN
            const float* bp = bdn + (size_t)u.e * D + col; const f32x4 b0 = *(const f32x4*)bp, b1 = *(const f32x4*)(bp + 4); const float gt = gs[row];
            const f32x4 a0 = (v0 + b0) * gt, a1 = (v1 + b1) * gt;
            u32x4 w; w.x = pk2(a0[0], a0[1]); w.y = pk2(a0[2], a0[3]); w.z = pk2(a1[0], a1[1]); w.w = pk2(a1[2], a1[3]);
            *(u32x4*)(O + (size_t)row * D + col) = w;
        EPI_LOOP_END
    }
};
}

#ifndef EMU
#define XB_TMO      128
#define XB_XCNT(j)  (256  + 64 * (j))
#define XB_XSUB(j)  (1280 + 64 * (j))
#define XB_XGEN(j)  (2304 + 64 * (j))
#define XB_TOP      3328
#define XB_TOPGEN   3392
#define XCD_BAR_WORDS 3456
#define XB_SPIN_CAP (1u << 27)
__device__ __forceinline__ unsigned xb_ld(unsigned* p)              { return __hip_atomic_load(p, __ATOMIC_RELAXED, __HIP_MEMORY_SCOPE_AGENT); }
__device__ __forceinline__ unsigned xb_add(unsigned* p, unsigned v) { return __hip_atomic_fetch_add(p, v, __ATOMIC_RELAXED, __HIP_MEMORY_SCOPE_AGENT); }
__device__ __forceinline__ unsigned xb_xcc_id() { return (unsigned)__builtin_amdgcn_s_getreg((3 << 11) | 20) & 0xFu; }
#define XB_SPIN(cond, bar) do { unsigned _sp = 0; while (cond) { __builtin_amdgcn_s_sleep(1); \
    if ((++_sp & 255u) == 0u) { if (xb_ld(&(bar)[XB_TMO])) break; if (_sp > XB_SPIN_CAP) { atomicAdd(&(bar)[XB_TMO], 1u); break; } } } } while (0)
struct XcdBarrier { unsigned* bar; unsigned x; volatile LAS unsigned* st; };
__device__ __forceinline__ XcdBarrier xcd_barrier_post(unsigned* bar, volatile LAS unsigned* st) {
    XcdBarrier b; b.bar = bar; b.x = xb_xcc_id(); b.st = st;
    if (threadIdx.x == 0) (void)xb_add(&bar[XB_XCNT(b.x)], 1u);
    return b;
}
__device__ __forceinline__ void xcd_barrier_complete(unsigned* bar, unsigned x, unsigned& nloc, unsigned& nx) {
    const unsigned G = gridDim.x * gridDim.y * gridDim.z;
    unsigned sum, cnt, mine, sp = 0u;
    for (;;) {
        sum = 0u; cnt = 0u; mine = 0u;
#pragma unroll
        for (unsigned j = 0; j < 16; ++j) { const unsigned c = xb_ld(&bar[XB_XCNT(j)]); sum += c; cnt += (c > 0u) ? 1u : 0u; mine = (j == x) ? c : mine; }
        if (sum == G) break;
        __builtin_amdgcn_s_sleep(1);
        if ((++sp & 255u) == 0u) { if (xb_ld(&bar[XB_TMO])) break; if (sp > XB_SPIN_CAP) { atomicAdd(&bar[XB_TMO], 1u); break; } }
    }
    nloc = mine > 0u ? mine : 1u; nx = cnt > 0u ? cnt : 1u;
}
__device__ __forceinline__ void xcd_barrier(const XcdBarrier& b) {
    asm volatile("s_waitcnt vmcnt(0)" ::: "memory");
    __syncthreads();
    if (threadIdx.x == 0) {
        unsigned* bar = b.bar;
        __builtin_amdgcn_s_waitcnt(0);
        unsigned nloc = b.st[0], nx = b.st[1];
        if (nloc == 0u) { xcd_barrier_complete(bar, b.x, nloc, nx); b.st[0] = nloc; b.st[1] = nx; }
        const unsigned old = xb_add(&bar[XB_XSUB(b.x)], 1u);
        const unsigned gen = old / nloc;
        if (old + 1u == (gen + 1u) * nloc) {
            __builtin_amdgcn_fence(__ATOMIC_RELEASE, "agent");
            asm volatile("s_waitcnt vmcnt(0)" ::: "memory");
            const unsigned og = xb_add(&bar[XB_TOP], 1u);
            const unsigned tg = og / nx;
            if (og + 1u == (tg + 1u) * nx) xb_add(&bar[XB_TOPGEN], 1u);
            else XB_SPIN(xb_ld(&bar[XB_TOPGEN]) == tg, bar);
            __builtin_amdgcn_fence(__ATOMIC_ACQUIRE, "agent");
            xb_add(&bar[XB_XGEN(b.x)], 1u);
            asm volatile("s_waitcnt vmcnt(0)" ::: "memory");
        } else {
            XB_SPIN(xb_ld(&bar[XB_XGEN(b.x)]) == gen, bar);
            __builtin_amdgcn_fence(__ATOMIC_ACQUIRE, "agent");
            asm volatile("s_waitcnt vmcnt(0)" ::: "memory");
        }
    }
    __syncthreads();
}
#endif

struct Args { const float* in[31]; float* out; unsigned char* ws; int lo, hi; };
typedef const float* FPtr;
#ifdef EMU
typedef const FPtr* ArgTab;
#else
typedef const __attribute__((address_space(4))) FPtr* ArgTab;
#endif
struct Frame {
    LAS unsigned char* lds; int tid, lane, wave, G, bid;
    ArgTab in; float* out; unsigned char* ws; unsigned* ctl;
};
enum { I_XP = 0, I_XS, I_CK, I_CV, I_SST, I_SCV, I_SSC, I_WIN, I_CONVW, I_CONVB, I_DTB, I_ALOG, I_SD, I_NORMW, I_WSSD, I_SINK, I_WATT, I_RELB, I_SCW, I_WSC, I_WO, I_LN1G, I_LN1B,
       I_RW, I_RB, I_WUP, I_BUP, I_WDN, I_BDN, I_LN2G, I_LN2B };

__device__ __forceinline__ bf16_t* ws_bf(const Frame& F, size_t off) { return (bf16_t*)(F.ws + off); }
__device__ __forceinline__ float* ws_f(const Frame& F, size_t off) { return (float*)(F.ws + off); }
__device__ __forceinline__ bf16_t* wl_ptr(const Frame& F, int layer, size_t off) { return (bf16_t*)(F.ws + WS_W + (size_t)layer * WL_BYTES + off); }

__device__ __forceinline__ void wt_item(const float* W, int ldw, int K, int k0, int nsrc0, const float* kscale, bf16_t* WT, int ndst0, LAS float* scr, int lane) {
    if (nsrc0 < 0) {
#pragma unroll
        for (int j = 0; j < 4; ++j) { const int n = (lane >> 3) + 8 * j; *(u32x4*)(WT + (size_t)(ndst0 + n) * K + k0 + 8 * (lane & 7)) = (u32x4){0u, 0u, 0u, 0u}; }
        return;
    }
#pragma unroll 8
    for (int i = 0; i < 32; ++i) { const int kk = 2 * i + (lane >> 5); float v = W[(size_t)(k0 + kk) * ldw + nsrc0 + (lane & 31)]; if (kscale) v *= kscale[k0 + kk]; scr[kk * 33 + (lane & 31)] = v; }
    WAVE_SYNC();
    const int c = lane & 7;
#pragma unroll
    for (int j = 0; j < 4; ++j) { const int n = (lane >> 3) + 8 * j; const LAS float* s = scr + (8 * c) * 33 + n;
        u32x4 o; o.x = pk2(s[0 * 33], s[1 * 33]); o.y = pk2(s[2 * 33], s[3 * 33]); o.z = pk2(s[4 * 33], s[5 * 33]); o.w = pk2(s[6 * 33], s[7 * 33]);
        *(u32x4*)(WT + (size_t)(ndst0 + n) * K + k0 + 8 * c) = o; }
    WAVE_SYNC();
}
__device__ __forceinline__ void step_weights(const Frame& F) {
    LAS float* scr = (LAS float*)(F.lds + F.wave * 16384);
    const int gw = F.bid * NWAVES + F.wave, NGW = F.G * NWAVES;
    constexpr int I_IN = (DINP / 32) * (D / 64), I_SSD = (D / 32) * (DINNER / 64), I_SQ = (D / 32) * (D / 64), I_UP = NEXP * (2048 / 32) * (D / 64), I_DN = NEXP * (D / 32) * (D / 64);
    constexpr int PER_LAYER = I_IN + I_SSD + 3 * I_SQ + I_UP + I_DN;
    for (int it = gw; it < DEPTH * PER_LAYER; it += NGW) {
        const int layer = it / PER_LAYER; int r = it % PER_LAYER;
        if (r < I_IN) { const int nb = r / (D / 64), kb = r % (D / 64), n0 = nb * 32;
            const int ns = n0 < 6144 ? n0 : (n0 < 13824 ? n0 + 32 : (n0 < 13856 ? n0 - 13824 + 6144 : -1));
            wt_item(F.in[I_WIN] + (size_t)layer * D * DIN, DIN, D, kb * 64, ns, nullptr, wl_ptr(F, layer, WL_IN), n0, scr, F.lane); continue; }
        r -= I_IN;
        if (r < I_SSD) { const int nb = r / (DINNER / 64), kb = r % (DINNER / 64);
            wt_item(F.in[I_WSSD] + (size_t)layer * DINNER * D, D, DINNER, kb * 64, nb * 32, F.in[I_NORMW] + (size_t)layer * DINNER, wl_ptr(F, layer, WL_SSD), nb * 32, scr, F.lane); continue; }
        r -= I_SSD;
        if (r < I_SQ) { const int nb = r / (D / 64), kb = r % (D / 64); wt_item(F.in[I_WATT] + (size_t)layer * D * D, D, D, kb * 64, nb * 32, nullptr, wl_ptr(F, layer, WL_ATT), nb * 32, scr, F.lane); continue; }
        r -= I_SQ;
        if (r < I_SQ) { const int nb = r / (D / 64), kb = r % (D / 64); wt_item(F.in[I_WSC] + (size_t)layer * D * D, D, D, kb * 64, nb * 32, nullptr, wl_ptr(F, layer, WL_SC), nb * 32, scr, F.lane); continue; }
        r -= I_SQ;
        if (r < I_SQ) { const int nb = r / (D / 64), kb = r % (D / 64); wt_item(F.in[I_WO] + (size_t)layer * D * D, D, D, kb * 64, nb * 32, nullptr, wl_ptr(F, layer, WL_O), nb * 32, scr, F.lane); continue; }
        r -= I_SQ;
        if (r < I_UP) { const int e = r / ((2048 / 32) * (D / 64)), q = r % ((2048 / 32) * (D / 64)), nb = q / (D / 64), kb = q % (D / 64), n0 = nb * 32;
            const int pn = n0 >> 8, bj = (n0 >> 7) & 1, jj = n0 & 127, ns = bj * 1024 + pn * 128 + jj;
            wt_item(F.in[I_WUP] + ((size_t)layer * NEXP + e) * D * 2048, 2048, D, kb * 64, ns, nullptr, wl_ptr(F, layer, WL_UP) + (size_t)e * 2048 * D, n0, scr, F.lane); continue; }
        r -= I_UP;
        { const int e = r / ((D / 32) * (D / 64)), q = r % ((D / 32) * (D / 64)), nb = q / (D / 64), kb = q % (D / 64);
            wt_item(F.in[I_WDN] + ((size_t)layer * NEXP + e) * D * D, D, D, kb * 64, nb * 32, nullptr, wl_ptr(F, layer, WL_DN) + (size_t)e * D * D, nb * 32, scr, F.lane); }
    }
}

__device__ __forceinline__ const float* x_in_row(const Frame& F, int layer, int mb, int r) {
    if (layer == 0) return r < NP ? F.in[I_XP] + ((size_t)mb * NP + r) * D : F.in[I_XS] + (size_t)(r - NP) * D;
    return r < NP ? F.out + O_YP + ((size_t)mb * NP + r) * D : F.out + O_YS + (size_t)(r - NP) * D;
}
__device__ __forceinline__ float* x_out_row(const Frame& F, int mb, int r) { return r < NP ? F.out + O_YP + ((size_t)mb * NP + r) * D : F.out + O_YS + (size_t)(r - NP) * D; }
__device__ __forceinline__ int rows_of(int mb) { return mb == 0 ? R : NP; }

__device__ __forceinline__ void step_xb(const Frame& F, int mb) {
    const int gw = F.bid * NWAVES + F.wave, NGW = F.G * NWAVES, nr = rows_of(mb);
    bf16_t* XB = ws_bf(F, WS_XB);
    for (int r = gw; r < nr; r += NGW) {
        const f32x4* xr = (const f32x4*)x_in_row(F, 0, mb, r) + F.lane; u32x2* o = (u32x2*)(XB + (size_t)r * D) + F.lane;
#pragma unroll
        for (int j = 0; j < 4; ++j) { const f32x4 v = xr[64 * j]; u32x2 w; w.x = pk2(v[0], v[1]); w.y = pk2(v[2], v[3]); o[64 * j] = w; }
    }
}

__device__ __forceinline__ float softplus_f(float x) { return x > 20.f ? x : log1pf(expf(x)); }
constexpr int S128 = 136, S64 = 72;
constexpr int SL_CM = 0, SL_BM = SL_CM + 64 * S128 * 2, SL_BT = SL_BM + 64 * S128 * 2, SL_XT = SL_BT + 128 * S64 * 2, SL_XTW = SL_XT + 64 * S64 * 2, SL_XS = SL_XTW + 64 * S64 * 2,
    SL_MM = SL_XS + 64 * S64 * 2, SL_SB = SL_MM + 64 * S64 * 2, SL_SM = SL_SB + 64 * S128 * 2, SL_CW = SL_SM + 5 * 64 * 4, SL_END = SL_CW + 5 * 320 * 4;
constexpr int SL_Y = SL_CM, YP = 68;
static_assert(SL_END <= RING_BYTES && 64 * YP * 4 <= 64 * S128 * 2, "ssd LDS map");

#define SSD_ITEM_L(it) ((it) == 0 ? xl : ((tid + 512 * (((it) - 1) & 1)) >> 4))
#define SSD_ITEM_CG(it) ((it) == 0 ? xcg : ((tid + 512 * (((it) - 1) & 1)) & 15))
#define SSD_LOAD_RAW(ck_) do { _Pragma("unroll") for (int it = 0; it < 5; ++it) { const int l_ = SSD_ITEM_L(it), cg_ = SSD_ITEM_CG(it); \
        const int col_ = it == 0 ? C_X + hd * 64 + 8 * cg_ : (it < 3 ? C_B + g * 128 + 8 * cg_ : C_C + g * 128 + 8 * cg_); \
        _Pragma("unroll") for (int i = 0; i < 4; ++i) { const int t_ = (ck_) * 64 + l_ - 3 + i; \
            raw[it][i] = t_ >= 0 ? *(const u32x4*)(H + (size_t)t_ * DINP + col_) : (u32x4){0u, 0u, 0u, 0u}; } } } while (0)

__device__ __forceinline__ void ssd_prompt_unit(const Frame& F, int layer, int mb, int sl, int hd) {
    const int tid = F.tid, lane = F.lane, w = F.wave, fr = lane & 15, fq = lane >> 4;
    LAS unsigned char* L = F.lds;
    LAS bf16_t* Cm = (LAS bf16_t*)(L + SL_CM); LAS bf16_t* Bm = (LAS bf16_t*)(L + SL_BM); LAS bf16_t* BT = (LAS bf16_t*)(L + SL_BT); LAS bf16_t* XT = (LAS bf16_t*)(L + SL_XT);
    LAS bf16_t* XTW = (LAS bf16_t*)(L + SL_XTW); LAS bf16_t* Xs = (LAS bf16_t*)(L + SL_XS); LAS bf16_t* Mm = (LAS bf16_t*)(L + SL_MM); LAS bf16_t* Sb = (LAS bf16_t*)(L + SL_SB);
    LAS float* sm = (LAS float*)(L + SL_SM);
    LAS float* cw = (LAS float*)(L + SL_CW);
    LAS float* Y = (LAS float*)(L + SL_Y);
    const int g = hd >> 2;
    bf16_t* H = ws_bf(F, WS_H) + (size_t)sl * SEQ * DINP;
    const float* convw = F.in[I_CONVW] + (size_t)layer * 4 * CONVDIM; const float* convb = F.in[I_CONVB] + (size_t)layer * CONVDIM;
    __syncthreads();
    for (int i = tid; i < 5 * 320; i += NTHREADS) { const int tap = i / 320, c = i % 320; const int xc = c < 64 ? hd * 64 + c : (c < 192 ? 2048 + g * 128 + (c - 64) : 3072 + g * 128 + (c - 192));
        cw[i] = tap < 4 ? convw[tap * CONVDIM + xc] : convb[xc]; }
    const float dtb = F.in[I_DTB][layer * 32 + hd], Ah = -expf(F.in[I_ALOG][layer * 32 + hd]), Dh = F.in[I_SD][layer * 32 + hd];
    const int xl = tid >> 3, xcg = tid & 7;
    u32x4 raw[5][4];
    f32x4 S[4];
#pragma unroll
    for (int j = 0; j < 4; ++j) S[j] = (f32x4){0.f, 0.f, 0.f, 0.f};
    const int ti = w >> 1, tj0 = 2 * (w & 1);
    const int pi = w & 3, nb = w >> 2;
    for (int ck = 0; ck < NCHUNK; ++ck) {
        const size_t rowb = (size_t)ck * 64;
        SSD_LOAD_RAW(ck);
#pragma unroll
        for (int jj = 0; jj < 4; ++jj)
#pragma unroll
            for (int r = 0; r < 4; ++r) Sb[(16 * pi + 4 * fq + r) * S128 + 64 * nb + 16 * jj + fr] = (bf16_t)f2bf(S[jj][r]);
        if (w == 0) {
            const float dtr = bf2f(H[(rowb + lane) * DINP + C_DT + hd]); const float dt = softplus_f(dtr + dtb); const float a = Ah * dt;
            float cs = a;
#pragma unroll
            for (int o = 1; o < 64; o <<= 1) { const float t = __shfl(cs, lane - o < 0 ? 0 : lane - o); if (lane >= o) cs += t; }
            const float tot = __shfl(cs, 63);
            sm[lane] = dt; sm[64 + lane] = cs; sm[128 + lane] = fexp(tot - cs); sm[192 + lane] = fexp(cs); if (lane == 0) sm[256] = fexp(tot);
        }
        const u32x4 zraw = *(const u32x4*)(H + (rowb + xl) * DINP + C_Z + hd * 64 + 8 * xcg);
        __syncthreads();
#pragma unroll
        for (int it = 0; it < 5; ++it) {
            const int l = SSD_ITEM_L(it), cg = SSD_ITEM_CG(it);
            const int cb = it == 0 ? 8 * cg : (it < 3 ? 64 + 8 * cg : 192 + 8 * cg);
            float acc8[8];
            { const f32x4 b0 = *(const LAS f32x4*)(cw + 4 * 320 + cb), b1 = *(const LAS f32x4*)(cw + 4 * 320 + cb + 4);
#pragma unroll
              for (int i = 0; i < 4; ++i) { acc8[i] = b0[i]; acc8[4 + i] = b1[i]; } }
#pragma unroll
            for (int tp = 0; tp < 4; ++tp) { float f[8]; unpack8(raw[it][tp], f); const f32x4 w0 = *(const LAS f32x4*)(cw + tp * 320 + cb), w1 = *(const LAS f32x4*)(cw + tp * 320 + cb + 4);
#pragma unroll
                for (int i = 0; i < 4; ++i) { acc8[i] += f[i] * w0[i]; acc8[4 + i] += f[4 + i] * w1[i]; } }
#pragma unroll
            for (int i = 0; i < 8; ++i) acc8[i] = fsilu(acc8[i]);
            if (it == 0) { const float dt = sm[l], wd = sm[128 + l];
                *(LAS u32x4*)(Xs + l * S64 + 8 * cg) = pack8(acc8);
#pragma unroll
                for (int i = 0; i < 8; ++i) { const float xd = acc8[i] * dt; XT[(8 * cg + i) * S64 + l] = (bf16_t)f2bf(xd); XTW[(8 * cg + i) * S64 + l] = (bf16_t)f2bf(xd * wd); } }
            else if (it < 3) { *(LAS u32x4*)(Bm + l * S128 + 8 * cg) = pack8(acc8);
#pragma unroll
                for (int i = 0; i < 8; ++i) BT[(8 * cg + i) * S64 + l] = (bf16_t)f2bf(acc8[i]); }
            else *(LAS u32x4*)(Cm + l * S128 + 8 * cg) = pack8(acc8);
            asm volatile("" ::: "memory");
        }
        __syncthreads();
        f32x4 yo[2];
#pragma unroll
        for (int jj = 0; jj < 2; ++jj) { const int tj = tj0 + jj;
            f32x4 cb = (f32x4){0.f, 0.f, 0.f, 0.f}; yo[jj] = (f32x4){0.f, 0.f, 0.f, 0.f};
#pragma unroll
            for (int ks = 0; ks < 4; ++ks) { const bf16x8 a = *(const LAS bf16x8*)(Cm + (16 * ti + fr) * S128 + 32 * ks + 8 * fq);
                if (tj <= ti) { const bf16x8 b = *(const LAS bf16x8*)(Bm + (16 * tj + fr) * S128 + 32 * ks + 8 * fq); cb = __builtin_amdgcn_mfma_f32_16x16x32_bf16(a, b, cb, 0, 0, 0); }
                const bf16x8 sb = *(const LAS bf16x8*)(Sb + (16 * tj + fr) * S128 + 32 * ks + 8 * fq); yo[jj] = __builtin_amdgcn_mfma_f32_16x16x32_bf16(a, sb, yo[jj], 0, 0, 0); }
            const int s = 16 * tj + fr; const float as = sm[64 + s];
#pragma unroll
            for (int r = 0; r < 4; ++r) { const int l = 16 * ti + 4 * fq + r; const float al = sm[64 + l];
                const float mv = (tj <= ti && l >= s) ? cb[r] * fexp(fminf(al - as, 0.f)) : 0.f; Mm[l * S64 + s] = (bf16_t)f2bf(mv); }
            asm volatile("" ::: "memory");
        }
        { const float cd = sm[256];
#pragma unroll
          for (int jj = 0; jj < 4; ++jj) { S[jj] = S[jj] * cd;
#pragma unroll
            for (int ks = 0; ks < 2; ++ks) { const bf16x8 a = *(const LAS bf16x8*)(XTW + (16 * pi + fr) * S64 + 32 * ks + 8 * fq); const bf16x8 b = *(const LAS bf16x8*)(BT + (64 * nb + 16 * jj + fr) * S64 + 32 * ks + 8 * fq);
                S[jj] = __builtin_amdgcn_mfma_f32_16x16x32_bf16(a, b, S[jj], 0, 0, 0); }
            if (jj & 1) asm volatile("" ::: "memory"); } }
        __syncthreads();
#pragma unroll
        for (int jj = 0; jj < 2; ++jj) { const int tj = tj0 + jj; f32x4 yd = (f32x4){0.f, 0.f, 0.f, 0.f};
#pragma unroll
            for (int ks = 0; ks < 2; ++ks) { const bf16x8 a = *(const LAS bf16x8*)(Mm + (16 * ti + fr) * S64 + 32 * ks + 8 * fq); const bf16x8 b = *(const LAS bf16x8*)(XT + (16 * tj + fr) * S64 + 32 * ks + 8 * fq);
                yd = __builtin_amdgcn_mfma_f32_16x16x32_bf16(a, b, yd, 0, 0, 0); }
#pragma unroll
            for (int r = 0; r < 4; ++r) { const int l = 16 * ti + 4 * fq + r; Y[l * YP + 16 * tj + fr] = yd[r] + sm[192 + l] * yo[jj][r]; } }
        __syncthreads();
        { float y8[8], x8[8], z8[8]; const f32x4 ya = *(const LAS f32x4*)(Y + xl * YP + 8 * xcg), yb = *(const LAS f32x4*)(Y + xl * YP + 8 * xcg + 4);
#pragma unroll
          for (int i = 0; i < 4; ++i) { y8[i] = ya[i]; y8[4 + i] = yb[i]; }
          unpack8(*(const LAS u32x4*)(Xs + xl * S64 + 8 * xcg), x8); unpack8(zraw, z8); float ss = 0.f;
#pragma unroll
          for (int i = 0; i < 8; ++i) { const float v = (y8[i] + Dh * x8[i]) * fsilu(z8[i]); y8[i] = v; ss += v * v; }
          *(u32x4*)(H + (rowb + xl) * DINP + C_Z + hd * 64 + 8 * xcg) = pack8(y8);
          ss += __shfl_xor(ss, 1); ss += __shfl_xor(ss, 2); ss += __shfl_xor(ss, 4);
          if (xcg == 0) ws_f(F, WS_SSQ)[((size_t)sl * SEQ + rowb + xl) * 32 + hd] = ss; }
    }
    float* so = F.out + O_SSP + ((((size_t)layer * BATCH + mb * NSEQ_MB + sl) * 32 + hd) * 64) * 128;
#pragma unroll
    for (int jj = 0; jj < 4; ++jj)
#pragma unroll
        for (int r = 0; r < 4; ++r) so[(size_t)(16 * pi + 4 * fq + r) * 128 + 64 * nb + 16 * jj + fr] = S[jj][r];
}

__device__ __forceinline__ void ssd_sample_unit(const Frame& F, int layer, int sq, int hd) {
    const int tid = F.tid, lane = F.lane; LAS float* L = (LAS float*)F.lds;
    LAS float* xs = L; LAS float* Bs = L + 16 * 64; LAS float* Cs = Bs + 16 * 128; LAS float* dts = Cs + 16 * 128; LAS float* das = dts + 16; LAS float* Yl = das + 16;
    const int g = hd >> 2;
    bf16_t* H = ws_bf(F, WS_H) + (size_t)(NP + sq * 16) * DINP;
    const float* hist = F.in[I_SCV] + ((size_t)layer * DECB + sq) * 3 * CONVDIM;
    const float* convw = F.in[I_CONVW] + (size_t)layer * 4 * CONVDIM; const float* convb = F.in[I_CONVB] + (size_t)layer * CONVDIM;
    __syncthreads();
    for (int it = tid; it < 16 * 320; it += NTHREADS) { const int t = it / 320, c = it % 320; const int xc = c < 64 ? hd * 64 + c : (c < 192 ? 2048 + g * 128 + (c - 64) : 3072 + g * 128 + (c - 192));
        float a = convb[xc];
#pragma unroll
        for (int i = 0; i < 4; ++i) { const int tt = t - 3 + i; const float v = tt >= 0 ? bf2f(H[(size_t)tt * DINP + C_X + xc]) : hist[(tt + 3) * CONVDIM + xc]; a += v * convw[i * CONVDIM + xc]; }
        a = a / (1.0f + expf(-a));
        if (c < 64) xs[t * 64 + c] = a; else if (c < 192) Bs[t * 128 + c - 64] = a; else Cs[t * 128 + c - 192] = a; }
    if (tid < 16) { const float dt = softplus_f(bf2f(H[(size_t)tid * DINP + C_DT + hd]) + F.in[I_DTB][layer * 32 + hd]); dts[tid] = dt; das[tid] = expf(-expf(F.in[I_ALOG][layer * 32 + hd]) * dt); }
    __syncthreads();
    const int p = tid >> 3, n0 = (tid & 7) * 16;
    const size_t sbase = ((((size_t)layer * DECB + sq) * 32 + hd) * 64 + p) * 128 + n0;
    float S[16];
#pragma unroll
    for (int i = 0; i < 16; ++i) S[i] = F.in[I_SST][sbase + i];
    for (int t = 0; t < 16; ++t) { const float dec = das[t], xv = xs[t * 64 + p] * dts[t]; float part = 0.f;
#pragma unroll
        for (int i = 0; i < 16; ++i) { S[i] = S[i] * dec + xv * Bs[t * 128 + n0 + i]; part += Cs[t * 128 + n0 + i] * S[i]; }
        part += __shfl_xor(part, 1); part += __shfl_xor(part, 2); part += __shfl_xor(part, 4);
        if ((tid & 7) == 0) Yl[t * 64 + p] = part; }
#pragma unroll
    for (int i = 0; i < 16; ++i) F.out[O_SSS + sbase + i] = S[i];
    __syncthreads();
    const float Dh = F.in[I_SD][layer * 32 + hd];
#pragma unroll
    for (int j = 0; j < 2; ++j) { const int it = tid + 512 * j, t = it >> 6, pp = it & 63;
        const float z = bf2f(H[(size_t)t * DINP + C_Z + hd * 64 + pp]); const float v = (Yl[t * 64 + pp] + Dh * xs[t * 64 + pp]) * (z / (1.0f + expf(-z)));
        H[(size_t)t * DINP + C_Z + hd * 64 + pp] = (bf16_t)f2bf(v);
        const float ss = wave_sum(v * v);
        if (lane == 0) ws_f(F, WS_SSQ)[((size_t)NP + sq * 16 + t) * 32 + hd] = ss; }
}

__device__ __forceinline__ int t5_bucket(int rel) {
    const int n = rel < 0 ? -rel : rel; const int b = rel > 0 ? 16 : 0;
    if (n < 8) return b + n;
    int v = 8; v += n >= 12; v += n >= 16; v += n >= 23; v += n >= 32; v += n >= 46; v += n >= 64; v += n >= 91;
    return b + v;
}
constexpr int AK_P = 72, AV_P = 200;
constexpr int AL_K = 0, AL_VT = AL_K + 192 * AK_P * 2, AL_LUT = AL_VT + 64 * AV_P * 2, AL_END = AL_LUT + 4 * 256 * 4;
static_assert(AL_END <= RING_BYTES, "attention LDS map");
__device__ __forceinline__ void attn_prompt_unit(const Frame& F, int layer, int sl, int ck, int kh) {
    const int tid = F.tid, lane = F.lane, w = F.wave, q32 = lane & 31, hi = lane >> 5;
    LAS bf16_t* Kl = (LAS bf16_t*)(F.lds + AL_K); LAS bf16_t* VT = (LAS bf16_t*)(F.lds + AL_VT); LAS float* lut = (LAS float*)(F.lds + AL_LUT);
    bf16_t* H = ws_bf(F, WS_H) + (size_t)sl * SEQ * DINP;
    __syncthreads();
#pragma unroll
    for (int j = 0; j < 3; ++j) { const int id = tid + 512 * j, key = id >> 3, cg = id & 7; const int t = 64 * (ck - 2) + key;
        u32x4 kv = (u32x4){0u, 0u, 0u, 0u}, vv = kv;
        if (t >= 0) { kv = *(const u32x4*)(H + (size_t)t * DINP + C_K + kh * 64 + 8 * cg); vv = *(const u32x4*)(H + (size_t)t * DINP + C_V + kh * 64 + 8 * cg); }
        *(LAS u32x4*)(Kl + key * AK_P + 8 * cg) = kv;
        VT[(8 * cg + 0) * AV_P + key] = (bf16_t)(vv.x & 0xffffu); VT[(8 * cg + 1) * AV_P + key] = (bf16_t)(vv.x >> 16); VT[(8 * cg + 2) * AV_P + key] = (bf16_t)(vv.y & 0xffffu); VT[(8 * cg + 3) * AV_P + key] = (bf16_t)(vv.y >> 16);
        VT[(8 * cg + 4) * AV_P + key] = (bf16_t)(vv.z & 0xffffu); VT[(8 * cg + 5) * AV_P + key] = (bf16_t)(vv.z >> 16); VT[(8 * cg + 6) * AV_P + key] = (bf16_t)(vv.w & 0xffffu); VT[(8 * cg + 7) * AV_P + key] = (bf16_t)(vv.w >> 16); }
    for (int e = tid; e < 4 * 255; e += NTHREADS) { const int gg = e / 255, idx = e % 255; lut[gg * 256 + idx] = F.in[I_RELB][t5_bucket(idx - 191) * 16 + kh * 4 + gg]; }
    __syncthreads();
    const int gq = w >> 1, qh = w & 1, head = kh * 4 + gq;
    const size_t qrow = (size_t)ck * 64 + 32 * qh + q32;
    bf16x8 qf[4];
#pragma unroll
    for (int ds = 0; ds < 4; ++ds) qf[ds] = *(const bf16x8*)(H + qrow * DINP + C_Q + head * 64 + 16 * ds + 8 * hi);
    f32x16 sc[6];
#pragma unroll
    for (int kt = 0; kt < 6; ++kt) {
#pragma unroll
        for (int r = 0; r < 16; ++r) sc[kt][r] = 0.f;
#pragma unroll
        for (int ds = 0; ds < 4; ++ds) { const bf16x8 a = *(const LAS bf16x8*)(Kl + (32 * kt + q32) * AK_P + 16 * ds + 8 * hi); sc[kt] = __builtin_amdgcn_mfma_f32_32x32x16_bf16(a, qf[ds], sc[kt], 0, 0, 0); } }
    const int qidx = 32 * qh + q32; const float sink = F.in[I_SINK][layer * 16 + head];
    float mx = -3.0e38f;
#pragma unroll
    for (int kt = 0; kt < 6; ++kt)
#pragma unroll
        for (int r = 0; r < 16; ++r) { const int key = 32 * kt + (r & 3) + 8 * (r >> 2) + 4 * hi; const int rel = key - 128 - qidx;
            float s = sc[kt][r] * 0.125f + lut[gq * 256 + rel + 191]; if (64 * ck + key - 128 < 0) s = -1e30f; sc[kt][r] = s; mx = fmaxf(mx, s); }
    mx = fmaxf(mx, __shfl_xor(mx, 32)); mx = fmaxf(mx, sink);
    float sum = 0.f;
#pragma unroll
    for (int kt = 0; kt < 6; ++kt)
#pragma unroll
        for (int r = 0; r < 16; ++r) { const float e = fexp(sc[kt][r] - mx); sc[kt][r] = e; sum += e; }
    sum += __shfl_xor(sum, 32);
    const float inv = 1.0f / (sum + fexp(sink - mx));
    f32x16 o[2];
#pragma unroll
    for (int d2 = 0; d2 < 2; ++d2)
#pragma unroll
        for (int r = 0; r < 16; ++r) o[d2][r] = 0.f;
#pragma unroll
    for (int kt = 0; kt < 6; ++kt)
#pragma unroll
        for (int s = 0; s < 2; ++s) {
            u32x4 pw; pw.x = pk2(sc[kt][8 * s + 0], sc[kt][8 * s + 1]); pw.y = pk2(sc[kt][8 * s + 2], sc[kt][8 * s + 3]); pw.z = pk2(sc[kt][8 * s + 4], sc[kt][8 * s + 5]); pw.w = pk2(sc[kt][8 * s + 6], sc[kt][8 * s + 7]);
            const bf16x8 pa = __builtin_bit_cast(bf16x8, pw);
#pragma unroll
            for (int d2 = 0; d2 < 2; ++d2) { const LAS bf16_t* vp = VT + (32 * d2 + q32) * AV_P + 32 * kt + 16 * s + 4 * hi;
                const u32x2 lo = *(const LAS u32x2*)vp, hh = *(const LAS u32x2*)(vp + 8); u32x4 vw; vw.x = lo.x; vw.y = lo.y; vw.z = hh.x; vw.w = hh.y;
                o[d2] = __builtin_amdgcn_mfma_f32_32x32x16_bf16(pa, __builtin_bit_cast(bf16x8, vw), o[d2], 0, 0, 0); } }
#pragma unroll
    for (int r = 0; r < 16; ++r) { const int q = (r & 3) + 8 * (r >> 2) + 4 * hi; const float iv = __shfl(inv, q);
        bf16_t* op = H + ((size_t)ck * 64 + 32 * qh + q) * DINP + C_Q + head * 64 + q32;
        op[0] = (bf16_t)f2bf(o[0][r] * iv); op[32] = (bf16_t)f2bf(o[1][r] * iv); }
}
__device__ __forceinline__ void attn_sample_unit(const Frame& F, int layer, int sq, int kh) {
    const int tid = F.tid; LAS float* L = (LAS float*)F.lds;
    LAS float* Kf = L; LAS float* Vf = Kf + 144 * 65; LAS float* Qf = Vf + 144 * 64; LAS float* P = Qf + 64 * 65; LAS float* Pinv = P + 64 * 145;
    static_assert((144 * 65 + 144 * 64 + 64 * 65 + 64 * 145 + 64) * 4 <= RING_BYTES, "sample attention LDS map");
    bf16_t* H = ws_bf(F, WS_H) + (size_t)(NP + sq * 16) * DINP;
    const float* ck = F.in[I_CK] + ((size_t)layer * DECB + sq) * WINDOW * 256; const float* cv = F.in[I_CV] + ((size_t)layer * DECB + sq) * WINDOW * 256;
    __syncthreads();
    for (int i = tid; i < 144 * 64; i += NTHREADS) { const int key = i >> 6, d = i & 63;
        Kf[key * 65 + d] = key < 128 ? ck[(size_t)key * 256 + kh * 64 + d] : bf2f(H[(size_t)(key - 128) * DINP + C_K + kh * 64 + d]);
        Vf[key * 64 + d] = key < 128 ? cv[(size_t)key * 256 + kh * 64 + d] : bf2f(H[(size_t)(key - 128) * DINP + C_V + kh * 64 + d]); }
    for (int i = tid; i < 64 * 64; i += NTHREADS) { const int row = i >> 6, d = i & 63; Qf[row * 65 + d] = bf2f(H[(size_t)(row & 15) * DINP + C_Q + (kh * 4 + (row >> 4)) * 64 + d]); }
    __syncthreads();
    for (int i = tid; i < 64 * 144; i += NTHREADS) { const int row = i / 144, key = i % 144; float s = 0.f;
        for (int d = 0; d < 64; ++d) s += Qf[row * 65 + d] * Kf[key * 65 + d];
        P[row * 145 + key] = s * 0.125f + F.in[I_RELB][t5_bucket(key - 128 - (row & 15)) * 16 + kh * 4 + (row >> 4)]; }
    __syncthreads();
    { const int row = tid >> 3, sub = tid & 7; const float sink = F.in[I_SINK][layer * 16 + kh * 4 + (row >> 4)]; float mx = -3.0e38f;
      for (int k = sub; k < 144; k += 8) mx = fmaxf(mx, P[row * 145 + k]);
      mx = fmaxf(mx, __shfl_xor(mx, 1)); mx = fmaxf(mx, __shfl_xor(mx, 2)); mx = fmaxf(mx, __shfl_xor(mx, 4)); mx = fmaxf(mx, sink);
      float sum = 0.f;
      for (int k = sub; k < 144; k += 8) { const float e = expf(P[row * 145 + k] - mx); P[row * 145 + k] = e; sum += e; }
      sum += __shfl_xor(sum, 1); sum += __shfl_xor(sum, 2); sum += __shfl_xor(sum, 4);
      if (sub == 0) Pinv[row] = 1.0f / (sum + expf(sink - mx)); }
    __syncthreads();
    { const int row = tid >> 3, d0 = (tid & 7) * 8; float o[8] = {0.f, 0.f, 0.f, 0.f, 0.f, 0.f, 0.f, 0.f};
      for (int k = 0; k < 144; ++k) { const float pv = P[row * 145 + k];
#pragma unroll
          for (int i = 0; i < 8; ++i) o[i] += pv * Vf[k * 64 + d0 + i]; }
      const float iv = Pinv[row];
#pragma unroll
      for (int i = 0; i < 8; ++i) o[i] *= iv;
      *(u32x4*)(H + (size_t)(row & 15) * DINP + C_Q + (kh * 4 + (row >> 4)) * 64 + d0) = pack8(o); }
}
__device__ __forceinline__ void sc_unit(const Frame& F, int layer, int tile) {
    const int tid = F.tid, cg = tid & 127, rs = tid >> 7; bf16_t* H = ws_bf(F, WS_H);
    const float* wsc = F.in[I_SCW] + (size_t)layer * 3 * D + 8 * cg; float wt[3][8];
#pragma unroll
    for (int i = 0; i < 3; ++i)
#pragma unroll
        for (int c = 0; c < 8; ++c) wt[i][c] = wsc[i * D + c];
    for (int rr = rs; rr < 64; rr += 4) { const int row = tile * 64 + rr; const bool smp = row >= NP;
        const int tt = smp ? (row - NP) & 15 : row % SEQ; float a[8] = {0.f, 0.f, 0.f, 0.f, 0.f, 0.f, 0.f, 0.f};
#pragma unroll
        for (int i = 0; i < 3; ++i) { const int t2 = tt - 2 + i; float u[8];
            if (t2 >= 0) { float c8[8], h8[8]; unpack8(*(const u32x4*)(H + (size_t)(row - 2 + i) * DINP + C_SCC + 8 * cg), c8); unpack8(*(const u32x4*)(H + (size_t)(row - 2 + i) * DINP + C_SCH + 8 * cg), h8);
#pragma unroll
                for (int c = 0; c < 8; ++c) u[c] = c8[c] * h8[c]; }
            else if (smp) { const float* hp = F.in[I_SSC] + (((size_t)layer * DECB + ((row - NP) >> 4)) * 2 + (t2 + 2)) * D + 8 * cg;
#pragma unroll
                for (int c = 0; c < 8; ++c) u[c] = hp[c]; }
            else {
#pragma unroll
                for (int c = 0; c < 8; ++c) u[c] = 0.f; }
#pragma unroll
            for (int c = 0; c < 8; ++c) a[c] += u[c] * wt[i][c]; }
        float b8[8]; unpack8(*(const u32x4*)(H + (size_t)row * DINP + C_SCB + 8 * cg), b8);
#pragma unroll
        for (int c = 0; c < 8; ++c) a[c] *= b8[c];
        *(u32x4*)(H + (size_t)row * DINP + C_SCB + 8 * cg) = pack8(a); }
}
__device__ __forceinline__ void state_out_unit(const Frame& F, int layer, int mb, int sl, bool smp) {
    const int tid = F.tid; const bf16_t* H = ws_bf(F, WS_H);
    const int nkv = smp ? DECS : WINDOW, len = smp ? DECS : SEQ; const size_t row0 = smp ? (size_t)NP + sl * 16 : (size_t)sl * SEQ; const int sg = smp ? sl : mb * NSEQ_MB + sl;
    const size_t nb_ = smp ? DECB : BATCH;
    float* ko = F.out + (smp ? O_KS : O_KP) + ((size_t)layer * nb_ + sg) * nkv * 256; float* vo = F.out + (smp ? O_VS : O_VP) + ((size_t)layer * nb_ + sg) * nkv * 256;
    for (int i = tid; i < nkv * 32; i += NTHREADS) { const int j = i >> 5, c8 = (i & 31) * 8; const bf16_t* hp = H + (row0 + len - nkv + j) * DINP; float f[8];
        unpack8(*(const u32x4*)(hp + C_K + c8), f); *(f32x4*)(ko + (size_t)j * 256 + c8) = (f32x4){f[0], f[1], f[2], f[3]}; *(f32x4*)(ko + (size_t)j * 256 + c8 + 4) = (f32x4){f[4], f[5], f[6], f[7]};
        unpack8(*(const u32x4*)(hp + C_V + c8), f); *(f32x4*)(vo + (size_t)j * 256 + c8) = (f32x4){f[0], f[1], f[2], f[3]}; *(f32x4*)(vo + (size_t)j * 256 + c8 + 4) = (f32x4){f[4], f[5], f[6], f[7]}; }
    float* co = F.out + (smp ? O_CVS : O_CVP) + ((size_t)layer * nb_ + sg) * 3 * CONVDIM;
    for (int i = tid; i < 3 * 512; i += NTHREADS) { const int j = i / 512, c8 = (i % 512) * 8; float f[8]; unpack8(*(const u32x4*)(H + (row0 + len - 3 + j) * DINP + C_X + c8), f);
        *(f32x4*)(co + (size_t)j * CONVDIM + c8) = (f32x4){f[0], f[1], f[2], f[3]}; *(f32x4*)(co + (size_t)j * CONVDIM + c8 + 4) = (f32x4){f[4], f[5], f[6], f[7]}; }
    float* so = F.out + (smp ? O_SCS : O_SCP) + ((size_t)layer * nb_ + sg) * 2 * D;
    for (int i = tid; i < 2 * 128; i += NTHREADS) { const int j = i >> 7, c8 = (i & 127) * 8; float c[8], h[8]; const bf16_t* hp = H + (row0 + len - 2 + j) * DINP;
        unpack8(*(const u32x4*)(hp + C_SCC + c8), c); unpack8(*(const u32x4*)(hp + C_SCH + c8), h);
        *(f32x4*)(so + (size_t)j * D + c8) = (f32x4){c[0] * h[0], c[1] * h[1], c[2] * h[2], c[3] * h[3]}; *(f32x4*)(so + (size_t)j * D + c8 + 4) = (f32x4){c[4] * h[4], c[5] * h[5], c[6] * h[6], c[7] * h[7]}; }
}
#ifndef MIX_MASK
#define MIX_MASK 0xFF
#endif
#define MIXON(b) ((MIX_MASK >> (b)) & 1)
__device__ __forceinline__ void step_mixers(const Frame& F, int layer, int mb) {
    const int n_ssd = NSEQ_MB * 32, n_att = NSEQ_MB * NCHUNK * NKV, n_sc = rows_of(mb) / 64, n_so = NSEQ_MB + (mb == 0 ? DECB : 0);
    const int n_ss = mb == 0 ? DECB * 32 : 0, n_as = mb == 0 ? DECB * NKV : 0;
    const int total = n_ssd + n_att + n_sc + n_so + n_ss + n_as;
    for (int un = F.bid; un < total; un += F.G) { int r = un;
#define UF(Fu) Frame Fu = F; Fu.tid = opq(F.tid); Fu.lane = Fu.tid & 63; Fu.wave = __builtin_amdgcn_readfirstlane(Fu.tid >> 6)
        if (r < n_ssd) { if constexpr (MIXON(0)) { UF(Fu); ssd_prompt_unit(Fu, layer, mb, r >> 5, r & 31); } continue; } r -= n_ssd;
        if (r < n_att) { if constexpr (MIXON(1)) { UF(Fu); attn_prompt_unit(Fu, layer, r / (NCHUNK * NKV), (r / NKV) % NCHUNK, r % NKV); } continue; } r -= n_att;
        if (r < n_sc) { if constexpr (MIXON(2)) { UF(Fu); sc_unit(Fu, layer, r); } continue; } r -= n_sc;
        if (r < n_so) { if constexpr (MIXON(3)) { UF(Fu); state_out_unit(Fu, layer, mb, r < NSEQ_MB ? r : r - NSEQ_MB, r >= NSEQ_MB); } continue; } r -= n_so;
        if (r < n_ss) { if constexpr (MIXON(4)) { UF(Fu); ssd_sample_unit(Fu, layer, r >> 5, r & 31); } continue; } r -= n_ss;
        if constexpr (MIXON(5)) { UF(Fu); attn_sample_unit(Fu, layer, r >> 2, r & 3); }
    }
}
__device__ __forceinline__ void step_gnorm(const Frame& F, int mb) {
    const int gw = F.bid * NWAVES + F.wave, NGW = F.G * NWAVES, nr = rows_of(mb); bf16_t* H = ws_bf(F, WS_H); const float* ssq = ws_f(F, WS_SSQ);
    for (int r = gw; r < nr; r += NGW) { const int g = F.lane >> 3; const f32x4 q = *(const f32x4*)(ssq + (size_t)r * 32 + 4 * g);
        const float rstd = 1.0f / sqrtf(((q[0] + q[1]) + (q[2] + q[3])) * (1.0f / 256.0f) + LN_EPS);
        u32x4* p = (u32x4*)(H + (size_t)r * DINP + C_Z + 32 * F.lane);
#pragma unroll
        for (int j = 0; j < 4; ++j) { float f[8]; unpack8(p[j], f);
#pragma unroll
            for (int i = 0; i < 8; ++i) f[i] *= rstd;
            p[j] = pack8(f); } }
}
constexpr int LOG_NEXP = NEXP == 32 ? 5 : (NEXP == 16 ? 4 : (NEXP == 8 ? 3 : 2));
template <int N, int MASK> struct RedStep {
    static __device__ __forceinline__ void run(float* v, int lane) {
        constexpr int Hn = N / 2; const bool up = (lane & MASK) != 0;
#pragma unroll
        for (int i = 0; i < Hn; ++i) { const float keep = up ? v[i + Hn] : v[i], send = up ? v[i] : v[i + Hn]; v[i] = keep + __shfl_xor(send, MASK); }
        if constexpr (Hn > 1) RedStep<Hn, (MASK >> 1)>::run(v, lane);
    }
};
__device__ __forceinline__ void step_ln1_router(const Frame& F, int layer, int mb) {
    LAS float* wT = (LAS float*)F.lds;
    const float* rw = F.in[I_RW] + (size_t)layer * D * NEXP;
    __syncthreads();
    for (int i = F.tid; i < D * NEXP; i += NTHREADS) { const int k = i / NEXP, e = i % NEXP; wT[e * D + k] = rw[i]; }
    __syncthreads();
    const int gw = F.bid * NWAVES + F.wave, NGW = F.G * NWAVES, nr = rows_of(mb), lane = F.lane;
    const float* lg = F.in[I_LN1G] + (size_t)layer * D; const float* lb = F.in[I_LN1B] + (size_t)layer * D; const float* rb = F.in[I_RB] + (size_t)layer * NEXP;
    unsigned* cnt = F.ctl + CW_CNT + (mb * DEPTH + layer) * 64;
    bf16_t* XB = ws_bf(F, WS_XB); int* topi = (int*)(F.ws + WS_TOPI); float* gate = ws_f(F, WS_GATE); int* pos = (int*)(F.ws + WS_POS);
    for (int r = gw; r < nr; r += NGW) {
        float* xr = x_out_row(F, mb, r); f32x4 v[4]; float s = 0.f;
#pragma unroll
        for (int j = 0; j < 4; ++j) { v[j] = *((const f32x4*)xr + lane + 64 * j); s += (v[j][0] + v[j][1]) + (v[j][2] + v[j][3]); }
        const float mean = wave_sum(s) * (1.0f / D); float s2 = 0.f;
#pragma unroll
        for (int j = 0; j < 4; ++j) { v[j] = v[j] - mean; s2 += (v[j][0] * v[j][0] + v[j][1] * v[j][1]) + (v[j][2] * v[j][2] + v[j][3] * v[j][3]); }
        const float rstd = 1.0f / sqrtf(wave_sum(s2) * (1.0f / D) + LN_EPS);
#pragma unroll
        for (int j = 0; j < 4; ++j) { const f32x4 gg = *((const f32x4*)lg + lane + 64 * j), bb = *((const f32x4*)lb + lane + 64 * j); v[j] = v[j] * rstd * gg + bb;
            *((f32x4*)xr + lane + 64 * j) = v[j]; u32x2 w; w.x = pk2(v[j][0], v[j][1]); w.y = pk2(v[j][2], v[j][3]); *((u32x2*)(XB + (size_t)r * D) + lane + 64 * j) = w; }
        float lgt[NEXP];
#pragma unroll
        for (int e = 0; e < NEXP; ++e) { float a = 0.f;
#pragma unroll
            for (int j = 0; j < 4; ++j) { const f32x4 wv = *((const LAS f32x4*)(wT + e * D) + lane + 64 * j); a += (v[j][0] * wv[0] + v[j][1] * wv[1]) + (v[j][2] * wv[2] + v[j][3] * wv[3]); }
            lgt[e] = a; if ((e & 1) == 1) asm volatile("" ::: "memory"); }
        RedStep<NEXP, 32>::run(lgt, lane);
        float tot = lgt[0];
#pragma unroll
        for (int mk = (32 >> LOG_NEXP); mk >= 1; mk >>= 1) tot += __shfl_xor(tot, mk);
        const int myexp = lane >> (6 - LOG_NEXP);
        float val = tot + rb[myexp];
        float tv[4]; int te[4];
#pragma unroll
        for (int k = 0; k < 4; ++k) { float bv = val; int be = myexp;
#pragma unroll
            for (int o = 1; o < 64; o <<= 1) { const float ov = __shfl_xor(bv, o); const int oe = __shfl_xor(be, o); if (ov > bv || (ov == bv && oe < be)) { bv = ov; be = oe; } }
            tv[k] = bv; te[k] = be; if (myexp == be) val = -3.0e38f; }
        const float e1 = expf(tv[1] - tv[0]), e2 = expf(tv[2] - tv[0]), e3 = expf(tv[3] - tv[0]); const float inv = 1.0f / (1.0f + e1 + e2 + e3);
        if (lane < 4) { const int e = lane == 0 ? te[0] : (lane == 1 ? te[1] : (lane == 2 ? te[2] : te[3])); const float gv = (lane == 0 ? 1.0f : (lane == 1 ? e1 : (lane == 2 ? e2 : e3))) * inv;
            const unsigned rk = __hip_atomic_fetch_add(cnt + e, 1u, __ATOMIC_RELAXED, __HIP_MEMORY_SCOPE_AGENT);
            topi[(size_t)r * 4 + lane] = e; gate[(size_t)r * 4 + lane] = gv; pos[(size_t)r * 4 + lane] = (int)rk; }
    }
}
__device__ __forceinline__ int moe_table(const Frame& F, int layer, int mb) {
    LAS int* M = (LAS int*)(F.lds + MISC_OFF);
    __syncthreads();
    if (F.tid == 0) { unsigned* cnt = F.ctl + CW_CNT + (mb * DEPTH + layer) * 64; int acc = 0;
        for (int e = 0; e < NEXP; ++e) { const int c = (int)__hip_atomic_load(cnt + e, __ATOMIC_RELAXED, __HIP_MEMORY_SCOPE_AGENT); M[64 + e] = acc * 256; acc += (c + 255) / 256; M[16 + e] = acc; } }
    __syncthreads();
    return M[16 + NEXP - 1];
}
__device__ __forceinline__ void step_gather(const Frame& F, int layer, int mb) {
    (void)moe_table(F, layer, mb); const LAS int* M = (const LAS int*)(F.lds + MISC_OFF);
    const int gw = F.bid * NWAVES + F.wave, NGW = F.G * NWAVES, nr = rows_of(mb), lane = F.lane;
    const bf16_t* XB = ws_bf(F, WS_XB); bf16_t* XS = ws_bf(F, WS_H); const int* topi = (const int*)(F.ws + WS_TOPI); const float* gate = ws_f(F, WS_GATE); int* pos = (int*)(F.ws + WS_POS); float* gs = ws_f(F, WS_GSORT);
    for (int r = gw; r < nr; r += NGW) {
        const u32x4 a = *((const u32x4*)(XB + (size_t)r * D) + lane), b = *((const u32x4*)(XB + (size_t)r * D) + 64 + lane);
        int pk[4];
#pragma unroll
        for (int k = 0; k < 4; ++k) { const int e = topi[(size_t)r * 4 + k]; pk[k] = M[64 + e] + pos[(size_t)r * 4 + k]; }
        WAVE_SYNC();
#pragma unroll
        for (int k = 0; k < 4; ++k) { const int p = pk[k];
            *((u32x4*)(XS + (size_t)p * D) + lane) = a; *((u32x4*)(XS + (size_t)p * D) + 64 + lane) = b;
            if (lane == k) { pos[(size_t)r * 4 + k] = p; gs[p] = gate[(size_t)r * 4 + k]; } }
    }
}
__device__ __forceinline__ void step_ln2(const Frame& F, int layer, int mb) {
    const int gw = F.bid * NWAVES + F.wave, NGW = F.G * NWAVES, nr = rows_of(mb), lane = F.lane;
    const float* lg = F.in[I_LN2G] + (size_t)layer * D; const float* lb = F.in[I_LN2B] + (size_t)layer * D;
    const bf16_t* OUTS = ws_bf(F, WS_H) + (size_t)2 * RP * D; const int* pos = (const int*)(F.ws + WS_POS); bf16_t* XB = ws_bf(F, WS_XB);
    for (int r = gw; r < nr; r += NGW) {
        float* xr = x_out_row(F, mb, r); f32x4 v[4]; float s = 0.f; int p[4];
#pragma unroll
        for (int k = 0; k < 4; ++k) p[k] = pos[(size_t)r * 4 + k];
#pragma unroll
        for (int j = 0; j < 4; ++j) { v[j] = *((const f32x4*)xr + lane + 64 * j) * ALPHA;
#pragma unroll
            for (int k = 0; k < 4; ++k) { const u32x2 w = *((const u32x2*)(OUTS + (size_t)p[k] * D) + lane + 64 * j); v[j] = v[j] + (f32x4){blo(w.x), bhi(w.x), blo(w.y), bhi(w.y)}; }
            s += (v[j][0] + v[j][1]) + (v[j][2] + v[j][3]); }
        const float mean = wave_sum(s) * (1.0f / D); float s2 = 0.f;
#pragma unroll
        for (int j = 0; j < 4; ++j) { v[j] = v[j] - mean; s2 += (v[j][0] * v[j][0] + v[j][1] * v[j][1]) + (v[j][2] * v[j][2] + v[j][3] * v[j][3]); }
        const float rstd = 1.0f / sqrtf(wave_sum(s2) * (1.0f / D) + LN_EPS);
#pragma unroll
        for (int j = 0; j < 4; ++j) { const f32x4 gg = *((const f32x4*)lg + lane + 64 * j), bb = *((const f32x4*)lb + lane + 64 * j); v[j] = v[j] * rstd * gg + bb;
            *((f32x4*)xr + lane + 64 * j) = v[j]; u32x2 w; w.x = pk2(v[j][0], v[j][1]); w.y = pk2(v[j][2], v[j][3]); *((u32x2*)(XB + (size_t)r * D) + lane + 64 * j) = w; }
    }
}

constexpr int PH_PER = 11, NSTEPS = 1 + NMB * DEPTH * PH_PER;
__global__ void __launch_bounds__(NTHREADS, 2) fwd(Args args) {
#ifdef EMU
    unsigned char* lds = emu_wg->lds;
#else
    extern __shared__ __attribute__((aligned(16))) unsigned char lds[];
#endif
    Frame F0; F0.lds = (LAS unsigned char*)lds; F0.tid = threadIdx.x; F0.lane = F0.tid & 63; F0.wave = __builtin_amdgcn_readfirstlane(F0.tid >> 6); F0.G = gridDim.x; F0.bid = blockIdx.x;
#ifdef EMU
    F0.in = args.in;
#else
    F0.in = (ArgTab)__builtin_amdgcn_kernarg_segment_ptr();
    static_assert(offsetof(Args, out) == 248 && offsetof(Args, ws) == 256 && offsetof(Args, in) == 0, "PF() reads the argument struct by offset");
#endif
    F0.out = args.out; F0.ws = args.ws; F0.ctl = (unsigned*)(args.ws + WS_CTL);
    const Frame& F = F0;
    const int lo = args.lo, hi = args.hi;
#ifndef EMU
    for (int u = F.tid; u < (LDS_BYTES - RING_BYTES) / 4; u += NTHREADS) ((LAS unsigned*)(F.lds + RING_BYTES))[u] = 0u;
    __syncthreads();
    XcdBarrier bar; bar.bar = F.ctl + CW_BAR; bar.x = 0; bar.st = nullptr;
    if (hi - lo > 1) bar = xcd_barrier_post(F.ctl + CW_BAR, (volatile LAS unsigned*)(F.lds + MISC_OFF) + 8);
#define SEAM(s) do { if ((s) + 1 < hi) xcd_barrier(bar); } while (0)
#else
#define SEAM(s) do { } while (0)
#endif
#ifndef PH_MASK
#define PH_MASK 0xFFFFFFFF
#endif
#define IN(s) (lo <= (s) && (s) < hi)
#define PHON(b) ((PH_MASK >> (b)) & 1)
#ifdef EMU
#define PF(Fp) Frame Fp = F0
#else
#define PF(Fp) Frame Fp; { unsigned long long kp_ = (unsigned long long)__builtin_amdgcn_kernarg_segment_ptr(); asm volatile("" : "+s"(kp_)); \
    Fp.in = (ArgTab)kp_; Fp.out = *(float* const __attribute__((address_space(4)))*)(kp_ + 248); Fp.ws = *(unsigned char* const __attribute__((address_space(4)))*)(kp_ + 256); Fp.ctl = (unsigned*)Fp.ws; \
    Fp.lds = F0.lds; Fp.G = F0.G; Fp.bid = F0.bid; Fp.tid = opq(F0.tid); Fp.lane = Fp.tid & 63; Fp.wave = __builtin_amdgcn_readfirstlane(Fp.tid >> 6); }
#endif
    int step = 0;
    if (IN(step)) { if constexpr (PHON(0)) { PF(F); step_weights(F); } SEAM(step); }
    ++step;
    for (int mb = 0; mb < NMB; ++mb)
        for (int layer = 0; layer < DEPTH; ++layer) {
            const int nr = rows_of(mb);
            if (IN(step)) { if constexpr (PHON(1)) { PF(F); if (layer == 0) step_xb(F, mb); } SEAM(step); }
            ++step;
            if (IN(step)) { if constexpr (PHON(2)) { PF(F); pg8::Gemm g{ws_bf(F, WS_XB), wl_ptr(F, layer, WL_IN), nr, DINP, D, D}; pg8::StaticOrder S; S.init(nr, DINP, F.G, F.bid);
                pg8::EpiStoreBf16 E{ws_bf(F, WS_H), DINP}; pg8::gemm_phase(F.lds, g, S, E); } SEAM(step); }
            ++step;
            if (IN(step)) { if constexpr (PHON(3)) { PF(F); step_mixers(F, layer, mb); } SEAM(step); }
            ++step;
            if (IN(step)) { if constexpr (PHON(4)) { PF(F); step_gnorm(F, mb); } SEAM(step); }
            ++step;
            if (IN(step)) { if constexpr (PHON(5)) { PF(F); pg8::StaticOrder S; S.init(nr, D, F.G, F.bid); bf16_t* H = ws_bf(F, WS_H); bf16_t* MGb = ws_bf(F, WS_XB);
#ifndef MERGE_MASK
#define MERGE_MASK 7
#endif
                if constexpr (MERGE_MASK & 1) { pg8::Gemm g{H + C_Z, wl_ptr(F, layer, WL_SSD), nr, D, DINNER, DINP}; pg8::EpiGate<0> E{H + C_GSSD, MGb}; pg8::gemm_phase(F.lds, g, S, E); }
                if constexpr (MERGE_MASK & 2) { pg8::Gemm g{H + C_Q, wl_ptr(F, layer, WL_ATT), nr, D, D, DINP}; pg8::EpiGate<1> E{H + C_GATT, MGb}; pg8::gemm_phase(F.lds, g, S, E); }
                if constexpr (MERGE_MASK & 4) { pg8::Gemm g{H + C_SCB, wl_ptr(F, layer, WL_SC), nr, D, D, DINP}; pg8::EpiGate<1> E{H + C_GSC, MGb}; pg8::gemm_phase(F.lds, g, S, E); } }
                SEAM(step); }
            ++step;
            if (IN(step)) { if constexpr (PHON(6)) { PF(F); pg8::Gemm g{ws_bf(F, WS_XB), wl_ptr(F, layer, WL_O), nr, D, D, D}; pg8::StaticOrder S; S.init(nr, D, F.G, F.bid);
                pg8::EpiResid E{layer == 0 ? F.in[I_XP] + (size_t)mb * NP * D : F.out + O_YP + (size_t)mb * NP * D, layer == 0 ? F.in[I_XS] : F.out + O_YS, F.out + O_YP + (size_t)mb * NP * D, F.out + O_YS};
                pg8::gemm_phase(F.lds, g, S, E); } SEAM(step); }
            ++step;
            if (IN(step)) { if constexpr (PHON(7)) { PF(F); step_ln1_router(F, layer, mb); } SEAM(step); }
            ++step;
            if (IN(step)) { if constexpr (PHON(8)) { PF(F); step_gather(F, layer, mb); } SEAM(step); }
            ++step;
            if (IN(step)) { if constexpr (PHON(9)) { PF(F); const int nt = moe_table(F, layer, mb); pg8::MoeOrder S{(const LAS int*)(F.lds + MISC_OFF) + 16, 8, nt * 8, F.G, F.bid};
                pg8::Gemm g{ws_bf(F, WS_H), wl_ptr(F, layer, WL_UP), nt * 256, 2048, D, D}; pg8::EpiSwiglu E{ws_bf(F, WS_H) + (size_t)RP * D, F.in[I_BUP] + (size_t)layer * NEXP * 2048};
                pg8::gemm_phase(F.lds, g, S, E); } SEAM(step); }
            ++step;
            if (IN(step)) { if constexpr (PHON(10)) { PF(F); const int nt = moe_table(F, layer, mb); pg8::MoeOrder S{(const LAS int*)(F.lds + MISC_OFF) + 16, 4, nt * 4, F.G, F.bid};
                pg8::Gemm g{ws_bf(F, WS_H) + (size_t)RP * D, wl_ptr(F, layer, WL_DN), nt * 256, D, D, D}; pg8::EpiDown E{ws_bf(F, WS_H) + (size_t)2 * RP * D, F.in[I_BDN] + (size_t)layer * NEXP * D, ws_f(F, WS_GSORT)};
                pg8::gemm_phase(F.lds, g, S, E); } SEAM(step); }
            ++step;
            if (IN(step)) { if constexpr (PHON(11)) { PF(F); step_ln2(F, layer, mb); } SEAM(step); }
            ++step;
        }
}

#ifdef EMU
extern int emu_grid, emu_step_lo, emu_step_hi;
#endif
extern "C" void kernel_launch(void* const* d_in, const int* in_sizes, int n_in, void* d_out, int out_size, void* d_ws, size_t ws_size, hipStream_t stream) {
    (void)in_sizes; (void)out_size;
    if (n_in != 31 || ws_size < WS_END) { fprintf(stderr, "kernel_launch: expected 31 inputs and >= %zu bytes of workspace (got %d, %zu)\n", (size_t)WS_END, n_in, ws_size); return; }
    Args a; memset(&a, 0, sizeof(a));
    for (int i = 0; i < 31; ++i) a.in[i] = (const float*)d_in[i];
    a.out = (float*)d_out; a.ws = (unsigned char*)d_ws;
#ifdef EMU
    if (emu_step_lo == 0) memset((char*)d_ws + WS_CTL, 0, CTL_BYTES);
    for (int s = emu_step_lo; s < emu_step_hi && s < NSTEPS; ++s) { a.lo = s; a.hi = s + 1; emu_launch(fwd, emu_grid, NTHREADS, LDS_BYTES, a); fprintf(stderr, "step %d done\n", s); }
#else
    (void)hipMemsetAsync((char*)d_ws + WS_CTL, 0, CTL_BYTES, stream);
    static int grid = 0;
    if (grid == 0) {
        int dev = 0, cus = 0;
        if (hipGetDevice(&dev) != hipSuccess || hipDeviceGetAttribute(&cus, hipDeviceAttributeMultiprocessorCount, dev) != hipSuccess) { grid = -1; return; }
        if (hipFuncSetAttribute((const void*)fwd, hipFuncAttributeMaxDynamicSharedMemorySize, LDS_BYTES) != hipSuccess) { grid = -1; return; }
        int per_cu = 0; (void)hipOccupancyMaxActiveBlocksPerMultiprocessor(&per_cu, (const void*)fwd, NTHREADS, LDS_BYTES); (void)hipGetLastError();
        grid = cus;
    }
    if (grid < 0) return;
#if CFG_ONE_LAUNCH
    a.lo = 0; a.hi = NSTEPS; hipLaunchKernelGGL(fwd, dim3(grid), dim3(NTHREADS), LDS_BYTES, stream, a);
#else
    for (int s = 0; s < NSTEPS; ++s) { a.lo = s; a.hi = s + 1; hipLaunchKernelGGL(fwd, dim3(grid), dim3(NTHREADS), LDS_BYTES, stream, a); }
#endif
#endif
}
```

```cpp
#ifdef EMU
#include "emu.h"
#else
#include <hip/hip_runtime.h>
#endif
#include <cstdio>
#include <cstdint>
#include <cstring>
#include <cstddef>
#include <cmath>

#ifndef CFG_BATCH
#define CFG_BATCH 16
#endif
#ifndef CFG_SEQ
#define CFG_SEQ 4096
#endif
#ifndef CFG_NSEQ_MB
#define CFG_NSEQ_MB 8
#endif
#ifndef CFG_NEXP
#define CFG_NEXP 32
#endif
#ifndef CFG_ONE_LAUNCH
#define CFG_ONE_LAUNCH 1
#endif

constexpr int BATCH = CFG_BATCH, SEQ = CFG_SEQ, NSEQ_MB = CFG_NSEQ_MB, NEXP = CFG_NEXP, NMB = BATCH / NSEQ_MB;
constexpr int D = 1024, DEPTH = 2, DECB = 16, DECS = 16, NS = DECB * DECS;
constexpr int DINNER = 2048, CONVDIM = 4096;
constexpr int NKV = 4, WINDOW = 128, CHUNK = 64;
constexpr int DIN = 13856, DINP = 14080;
constexpr int NP = NSEQ_MB * SEQ, R = NP + NS;
constexpr int RP = ((4 * R + NEXP * 255) + 255) / 256 * 256;
constexpr int NCHUNK = SEQ / CHUNK;
constexpr int C_Z = 0, C_X = 2048, C_B = 4096, C_C = 5120, C_Q = 6144, C_K = 7168, C_V = 7424, C_SCB = 7680, C_SCC = 8704, C_SCH = 9728, C_GSSD = 10752, C_GATT = 11776, C_GSC = 12800, C_DT = 13824;
constexpr float LN_EPS = 1e-5f, ALPHA = 1.41421356237309515f  , SW_LIMIT = 7.0f, SW_ALPHA = 1.702f;
static_assert(BATCH % NSEQ_MB == 0 && SEQ % 256 == 0 && (NEXP & (NEXP - 1)) == 0 && NEXP <= 32 && NEXP >= 4, "config");

constexpr size_t O_YP = 0, O_YS = O_YP + (size_t)BATCH * SEQ * D, O_KP = O_YS + (size_t)NS * D, O_VP = O_KP + (size_t)DEPTH * BATCH * WINDOW * 256,
    O_SSP = O_VP + (size_t)DEPTH * BATCH * WINDOW * 256, O_CVP = O_SSP + (size_t)DEPTH * BATCH * 32 * 64 * 128, O_SCP = O_CVP + (size_t)DEPTH * BATCH * 3 * CONVDIM,
    O_KS = O_SCP + (size_t)DEPTH * BATCH * 2 * D, O_VS = O_KS + (size_t)DEPTH * DECB * DECS * 256, O_SSS = O_VS + (size_t)DEPTH * DECB * DECS * 256,
    O_CVS = O_SSS + (size_t)DEPTH * DECB * 32 * 64 * 128, O_SCS = O_CVS + (size_t)DEPTH * DECB * 3 * CONVDIM, O_END = O_SCS + (size_t)DEPTH * DECB * 2 * D;

constexpr size_t al256(size_t x) { return (x + 255) / 256 * 256; }
constexpr size_t WS_CTL = 0, CTL_BYTES = 1u << 20;
constexpr size_t WS_SSQ = CTL_BYTES, WS_TOPI = WS_SSQ + al256((size_t)R * 32 * 4), WS_GATE = WS_TOPI + al256((size_t)R * 16), WS_POS = WS_GATE + al256((size_t)R * 16),
    WS_GSORT = WS_POS + al256((size_t)R * 16), WS_W = WS_GSORT + al256((size_t)RP * 4);
constexpr size_t WL_IN = 0, WL_SSD = WL_IN + (size_t)DINP * D * 2, WL_ATT = WL_SSD + (size_t)D * DINNER * 2, WL_SC = WL_ATT + (size_t)D * D * 2, WL_O = WL_SC + (size_t)D * D * 2,
    WL_UP = WL_O + (size_t)D * D * 2, WL_DN = WL_UP + (size_t)NEXP * 2048 * D * 2, WL_BYTES = WL_DN + (size_t)NEXP * D * D * 2;
constexpr size_t WS_XB = WS_W + DEPTH * WL_BYTES, WS_H = WS_XB + (size_t)R * D * 2;
constexpr size_t H_BYTES = (size_t)R * DINP * 2, MOE_BYTES = (size_t)3 * RP * D * 2, U_BYTES = H_BYTES > MOE_BYTES ? H_BYTES : MOE_BYTES;
constexpr size_t WS_END = WS_H + U_BYTES;
static_assert(WS_END <= ((size_t)2 << 30), "workspace map exceeds 2 GiB");
constexpr int CW_BAR = 4096, CW_CNT = 16384;

constexpr int RING_BYTES = 131072, MISC_OFF = RING_BYTES + 320, LDS_BYTES = 147456;
constexpr int NWAVES = 8, NTHREADS = 512;

#ifdef EMU
#define LAS
#define WAVE_SYNC() emu_wave_barrier()
#else
#define LAS __attribute__((address_space(3)))
#define WAVE_SYNC() asm volatile("s_waitcnt lgkmcnt(0)" ::: "memory")
#endif
typedef unsigned short bf16_t;
typedef short bf16x8 __attribute__((ext_vector_type(8)));
typedef float f32x4 __attribute__((ext_vector_type(4)));
typedef float f32x16 __attribute__((ext_vector_type(16)));
typedef unsigned u32x4 __attribute__((ext_vector_type(4)));
typedef unsigned u32x2 __attribute__((ext_vector_type(2)));

__device__ __forceinline__ unsigned f2bf(float f) { unsigned u = __builtin_bit_cast(unsigned, f); return (u + 0x7fffu + ((u >> 16) & 1u)) >> 16; }
__device__ __forceinline__ float bf2f(unsigned h) { return __builtin_bit_cast(float, (h & 0xffffu) << 16); }
#ifdef EMU
__device__ __forceinline__ unsigned pk2(float lo, float hi) { return f2bf(lo) | (f2bf(hi) << 16); }
#else
typedef float f32x2_t __attribute__((ext_vector_type(2))); typedef __bf16 bf16x2_t __attribute__((ext_vector_type(2)));
__device__ __forceinline__ unsigned pk2(float lo, float hi) { f32x2_t v = {lo, hi}; bf16x2_t b = __builtin_convertvector(v, bf16x2_t); return __builtin_bit_cast(unsigned, b); }
#endif
__device__ __forceinline__ float blo(unsigned w) { return __builtin_bit_cast(float, w << 16); }
__device__ __forceinline__ float bhi(unsigned w) { return __builtin_bit_cast(float, w & 0xffff0000u); }
__device__ __forceinline__ void unpack8(const u32x4 w, float* f) { f[0] = blo(w.x); f[1] = bhi(w.x); f[2] = blo(w.y); f[3] = bhi(w.y); f[4] = blo(w.z); f[5] = bhi(w.z); f[6] = blo(w.w); f[7] = bhi(w.w); }
__device__ __forceinline__ u32x4 pack8(const float* f) { u32x4 w; w.x = pk2(f[0], f[1]); w.y = pk2(f[2], f[3]); w.z = pk2(f[4], f[5]); w.w = pk2(f[6], f[7]); return w; }
__device__ __forceinline__ float fexp(float x) { return __builtin_amdgcn_exp2f(x * 1.4426950408889634f); }
__device__ __forceinline__ float fsigmoid(float x) { return __builtin_amdgcn_rcpf(1.0f + __builtin_amdgcn_exp2f(-1.4426950408889634f * x)); }
__device__ __forceinline__ float fsilu(float x) { return x * fsigmoid(x); }
#ifdef EMU
__device__ __forceinline__ int opq(int x) { return x; }
#else
__device__ __forceinline__ int opq(int x) { asm volatile("" : "+v"(x)); return x; }
#endif
__device__ __forceinline__ float wave_sum(float v) {
#pragma unroll
    for (int o = 1; o < 64; o <<= 1) v += __shfl_xor(v, o);
    return v;
}

#ifndef PROBE_MASK
#define PROBE_MASK 0
#endif
#if PROBE_MASK && !defined(EMU)
#define PROBE_T0(b) unsigned long long pt0_ = 0; if constexpr ((PROBE_MASK >> (b)) & 1) pt0_ = __builtin_amdgcn_s_memrealtime();
#define PROBE_T1(b) if constexpr ((PROBE_MASK >> (b)) & 1) { asm volatile("s_waitcnt vmcnt(0) lgkmcnt(0)" ::: "memory"); const unsigned long long pt1_ = __builtin_amdgcn_s_memrealtime(); \
    while (__builtin_amdgcn_s_memrealtime() < pt1_ + (pt1_ - pt0_)) __builtin_amdgcn_s_sleep(8); }
#else
#define PROBE_T0(b)
#define PROBE_T1(b)
#endif
namespace pg8 {
constexpr int BM = 256, BK = 64, HALF = 128, HTB = HALF * BK * 2, NXCD = 8, WGM = 8;
struct Unit { int pm, pn, bt, e; };
struct Gemm { const bf16_t* A; const bf16_t* Bt; int M, N, K, lda; };
struct StaticOrder {
    int nM, nN, nwg, G, c;
    __host__ __device__ void init(int M, int N, int G_, int c_) { nM = M / BM; nN = N / BM; nwg = nM * nN; G = G_; c = c_; }
    __host__ __device__ bool next(int i, Unit& u) const {
        const long L = (long)i * G + c; if (L >= nwg) return false;
        int wgid = (int)L; { const int q = nwg / NXCD, r = nwg % NXCD, xcd = wgid % NXCD, off = wgid / NXCD; wgid = (xcd < r ? xcd * (q + 1) : r * (q + 1) + (xcd - r) * q) + off; }
        const int nig = WGM * nN, gid = wgid / nig, fm = gid * WGM, gsz = (nM - fm) < WGM ? (nM - fm) : WGM;
        u.pm = fm + ((wgid % nig) % gsz); u.pn = (wgid % nig) / gsz; u.bt = u.pn; u.e = 0; return true;
    }
    __device__ __forceinline__ void a_ready(const Unit&) const {}
    __device__ __forceinline__ void done(const Unit&) const {}
};
struct MoeOrder {
    const LAS int* tend; int npn, ntot, G, c;
    __device__ __forceinline__ bool next(int i, Unit& u) const {
        const long L = (long)i * G + c; if (L >= ntot) return false;
        const int rt = (int)L / npn, pn = (int)L % npn; int e = 0;
#pragma unroll
        for (int j = 0; j < NEXP; ++j) e += (tend[j] <= rt) ? 1 : 0;
        u.pm = rt; u.pn = pn; u.e = e; u.bt = e * npn + pn; return true;
    }
    __device__ __forceinline__ void a_ready(const Unit&) const {}
    __device__ __forceinline__ void done(const Unit&) const {}
};
#ifdef EMU
template <class Epi, class Sched>
__device__ void gemm_phase(LAS unsigned char* lds, const Gemm g, const Sched& S, const Epi& E) {
    const int tid = threadIdx.x, wid = tid >> 6, lane = tid & 63, wr = wid >> 2, wc = wid & 3, fr = lane & 15, fq = lane >> 4;
    Unit u;
    for (int i = 0; S.next(i, u); ++i) {
        f32x4 acc[2][2][4][2];
        for (int ai = 0; ai < 2; ++ai) for (int bj = 0; bj < 2; ++bj) for (int m = 0; m < 4; ++m) for (int n = 0; n < 2; ++n) for (int q = 0; q < 4; ++q) {
            const int row = u.pm * 256 + ai * 128 + wr * 64 + m * 16 + fr, col = u.bt * 256 + bj * 128 + wc * 32 + 8 * fq + 4 * n + q;
            const bf16_t* a = g.A + (size_t)row * g.lda; const bf16_t* b = g.Bt + (size_t)col * g.K; float s = 0.f;
            for (int k = 0; k < g.K; ++k) s += bf2f(a[k]) * bf2f(b[k]);
            acc[ai][bj][m][n][q] = s; }
        E(acc, u, wr, wc, fr, fq);
    }
    __syncthreads();
}
#else
#define PG8_LAS __attribute__((address_space(3)))
__host__ __device__ __forceinline__ int lds_byte(int r, int c) { const int st = (r >> 4) * 2 + (c >> 5), rr = r & 15, cc = c & 31, ob = rr * 64 + cc * 2; return st * 1024 + (ob ^ (((ob >> 9) & 1) << 5)); }
__host__ __device__ __forceinline__ void stage_rc(int b, int& R_, int& C_) { const int st = b / 1024, sb = b % 1024, swz = sb ^ (((sb >> 9) & 1) << 5); R_ = (st >> 1) * 16 + swz / 64; C_ = (st & 1) * 32 + (swz % 64) / 2; }
__host__ __device__ __forceinline__ int perm32(int rho) { const int n = rho >> 4, i = rho & 15; return 8 * (i >> 2) + 4 * n + (i & 3); }
template <class Epi, class Sched>
__device__ __forceinline__ void gemm_phase(PG8_LAS unsigned char* lds, const Gemm g, const Sched& S, const Epi& E) {
    const int tid = opq((int)threadIdx.x), wid = __builtin_amdgcn_readfirstlane(tid >> 6), lane = tid & 63, wr = wid >> 2, wc = wid & 3, fr = lane & 15, fq = lane >> 4;
    const int K = g.K, nt = K / BK, lda = g.lda;
    unsigned voffA[2], voffB[2];
#pragma unroll
    for (int i = 0; i < 2; ++i) { int R_, C_; stage_rc(tid * 16 + i * 8192, R_, C_); const int Rb = (R_ & ~31) + perm32(R_ & 31);
        voffA[i] = (unsigned)(R_ * lda + C_) * 2u; voffB[i] = (unsigned)(Rb * K + C_) * 2u; }
    const size_t kstep = (size_t)(BK * 2);
    const size_t hstepA = (size_t)HALF * lda * 2, tstepA = 2 * hstepA;
    const size_t hstepB = (size_t)HALF * K * 2, tstepB = 2 * hstepB;
    const unsigned ldsw = (unsigned)wid * 1024u;
    const int aoff = lds_byte(wr * 64 + fr, fq * 8), boff = lds_byte(wc * 32 + fr, fq * 8);
#define PG8_SA(b, h) (((b) * 2 + (h)) * HTB)
#define PG8_SB(b, h) ((4 + (b) * 2 + (h)) * HTB)
#define PG8_STAGE(bufoff, gbase, voff) do { _Pragma("unroll") for (int _i = 0; _i < 2; ++_i) \
        __builtin_amdgcn_global_load_lds((const unsigned*)((const char*)(gbase) + (voff)[_i]), (PG8_LAS unsigned*)(lds + (bufoff) + ldsw + _i * 8192), 16, 0, 0); } while (0)
#define PG8_LDA(dst, b, h) do { _Pragma("unroll") for (int m = 0; m < 4; ++m) _Pragma("unroll") for (int k = 0; k < 2; ++k) dst[m][k] = *(const PG8_LAS bf16x8*)(lds + PG8_SA(b, h) + aoff + m * 2048 + k * 1024); } while (0)
#define PG8_LDB(dst, b, h) do { _Pragma("unroll") for (int n = 0; n < 2; ++n) _Pragma("unroll") for (int k = 0; k < 2; ++k) dst[n][k] = *(const PG8_LAS bf16x8*)(lds + PG8_SB(b, h) + boff + n * 2048 + k * 1024); } while (0)
#define PG8_MMA(ai, bj, At, Bt) do { __builtin_amdgcn_s_setprio(1); _Pragma("unroll") for (int m = 0; m < 4; ++m) _Pragma("unroll") for (int n = 0; n < 2; ++n) _Pragma("unroll") for (int k = 0; k < 2; ++k) \
        acc[ai][bj][m][n] = __builtin_amdgcn_mfma_f32_16x16x32_bf16(Bt[n][k], At[m][k], acc[ai][bj][m][n], 0, 0, 0); __builtin_amdgcn_s_setprio(0); } while (0)
#define PG8_WAIT_V(n) asm volatile("s_waitcnt vmcnt(" #n ")" ::: "memory")
#define PG8_WAIT_L(n) asm volatile("s_waitcnt lgkmcnt(" #n ")" ::: "memory")
#define PG8_BAR __builtin_amdgcn_s_barrier()
#define PG8_SCHED __builtin_amdgcn_sched_barrier(0)
    Unit cur, nxt; int ui = 0;
    if (!S.next(0, cur)) return;
    f32x4 acc[2][2][4][2];
#pragma unroll
    for (int a = 0; a < 2; ++a)
#pragma unroll
        for (int b = 0; b < 2; ++b)
#pragma unroll
            for (int m = 0; m < 4; ++m)
#pragma unroll
                for (int n = 0; n < 2; ++n) acc[a][b][m][n] = (f32x4){0.f, 0.f, 0.f, 0.f};
    bf16x8 At[4][2], B0[2][2], B1[2][2];
    const char* cA = (const char*)g.A + (size_t)cur.pm * tstepA; const char* cB = (const char*)g.Bt + (size_t)cur.bt * tstepB;
    S.a_ready(cur);
    PG8_STAGE(PG8_SB(0, 0), cB, voffB); PG8_STAGE(PG8_SB(0, 1), cB + hstepB, voffB); PG8_STAGE(PG8_SA(0, 0), cA, voffA); PG8_STAGE(PG8_SA(0, 1), cA + hstepA, voffA);
    if (wr == 1) PG8_BAR;
    PG8_WAIT_V(2); PG8_BAR;
    PG8_STAGE(PG8_SB(1, 0), cB + kstep, voffB); PG8_STAGE(PG8_SA(1, 0), cA + kstep, voffA); PG8_STAGE(PG8_SB(1, 1), cB + hstepB + kstep, voffB);
    PG8_WAIT_V(6); PG8_BAR;
    for (;;) {
        const bool has_next = S.next(ui + 1, nxt);
        const char* nA = has_next ? (const char*)g.A + (size_t)nxt.pm * tstepA : cA; const char* nB = has_next ? (const char*)g.Bt + (size_t)nxt.bt * tstepB : cB;
        for (int t = 0; t < nt; t += 2) {
            const bool last = (t == nt - 2);
            const char* a1 = cA + (size_t)(t + 1) * kstep;
            const char* a2 = last ? nA : cA + (size_t)(t + 2) * kstep; const char* b2 = last ? nB : cB + (size_t)(t + 2) * kstep;
            const char* a3 = a2 + kstep; const char* b3 = b2 + kstep;
            if (last && has_next) S.a_ready(nxt);
            PG8_LDB(B0, 0, 0); PG8_LDB(B1, 0, 1); PG8_SCHED; PG8_LDA(At, 0, 0); PG8_STAGE(PG8_SA(1, 1), a1 + hstepA, voffA);
            PG8_WAIT_V(8); PG8_WAIT_L(0); PG8_BAR; PG8_MMA(0, 0, At, B0); PG8_MMA(0, 1, At, B1); PG8_BAR; PG8_SCHED;
            PG8_LDA(At, 0, 1); PG8_STAGE(PG8_SB(0, 0), b2, voffB); PG8_STAGE(PG8_SB(0, 1), b2 + hstepB, voffB); PG8_STAGE(PG8_SA(0, 0), a2, voffA);
            PG8_WAIT_V(8); PG8_WAIT_L(0); PG8_BAR; PG8_MMA(1, 0, At, B0); PG8_MMA(1, 1, At, B1); PG8_BAR; PG8_SCHED;
            PG8_LDB(B0, 1, 0); PG8_LDB(B1, 1, 1); PG8_SCHED; PG8_LDA(At, 1, 0); PG8_STAGE(PG8_SA(0, 1), a2 + hstepA, voffA);
            PG8_WAIT_V(8); PG8_WAIT_L(0); PG8_BAR; PG8_MMA(0, 0, At, B0); PG8_MMA(0, 1, At, B1); PG8_BAR; PG8_SCHED;
            PG8_LDA(At, 1, 1); PG8_STAGE(PG8_SB(1, 0), b3, voffB); PG8_STAGE(PG8_SB(1, 1), b3 + hstepB, voffB); PG8_STAGE(PG8_SA(1, 0), a3, voffA);
            PG8_WAIT_V(8); PG8_WAIT_L(0); PG8_BAR; PG8_MMA(1, 0, At, B0); PG8_MMA(1, 1, At, B1); PG8_BAR; PG8_SCHED;
        }
        if (wr == 0) PG8_BAR;
        E(acc, cur, wr, wc, fr, fq); S.done(cur);
        if (!has_next) break;
#pragma unroll
        for (int a = 0; a < 2; ++a)
#pragma unroll
            for (int b = 0; b < 2; ++b)
#pragma unroll
                for (int m = 0; m < 4; ++m)
#pragma unroll
                    for (int n = 0; n < 2; ++n) acc[a][b][m][n] = (f32x4){0.f, 0.f, 0.f, 0.f};
        cur = nxt; cA = nA; cB = nB; ++ui;
        if (wr == 1) PG8_BAR;
    }
    PG8_WAIT_V(0);
    PG8_BAR;
#undef PG8_SA
#undef PG8_SB
#undef PG8_STAGE
#undef PG8_LDA
#undef PG8_LDB
#undef PG8_MMA
#undef PG8_WAIT_V
#undef PG8_WAIT_L
#undef PG8_BAR
#undef PG8_SCHED
}
#endif

#define EPI_LOOP_BEGIN const int row0_ = u.pm * 256 + wr * 64 + fr, col0_ = u.pn * 256 + wc * 32 + 8 * fq; \
    _Pragma("unroll") for (int ai = 0; ai < 2; ++ai) _Pragma("unroll") for (int m = 0; m < 4; ++m) { const int row = row0_ + ai * 128 + m * 16; \
    _Pragma("unroll") for (int bj = 0; bj < 2; ++bj) { const int col = col0_ + bj * 128; const f32x4 v0 = acc[ai][bj][m][0], v1 = acc[ai][bj][m][1]; (void)row; (void)col;
#define EPI_LOOP_END asm volatile("" ::: "memory"); } }
struct EpiStoreBf16 {
    bf16_t* O; int ldc;
    __device__ __forceinline__ void operator()(const f32x4 (&acc)[2][2][4][2], const Unit& u, int wr, int wc, int fr, int fq) const {
        EPI_LOOP_BEGIN
            u32x4 w; w.x = pk2(v0[0], v0[1]); w.y = pk2(v0[2], v0[3]); w.z = pk2(v1[0], v1[1]); w.w = pk2(v1[2], v1[3]);
            *(u32x4*)(O + (size_t)row * ldc + col) = w;
        EPI_LOOP_END
    }
};
template <int MODE> struct EpiGate {
    const bf16_t* Hg; bf16_t* MGb;
    __device__ __forceinline__ void operator()(const f32x4 (&acc)[2][2][4][2], const Unit& u, int wr, int wc, int fr, int fq) const {
        EPI_LOOP_BEGIN
            const u32x4 gw = *(const u32x4*)(Hg + (size_t)row * DINP + col); float g[8]; unpack8(gw, g);
            float v[8] = {v0[0], v0[1], v0[2], v0[3], v1[0], v1[1], v1[2], v1[3]};
            bf16_t* mp = MGb + (size_t)row * D + col;
            if (MODE != 0) { float p[8]; unpack8(*(const u32x4*)mp, p);
#pragma unroll
                for (int i = 0; i < 8; ++i) v[i] = p[i] + v[i] * fsigmoid(g[i]); }
            else {
#pragma unroll
                for (int i = 0; i < 8; ++i) v[i] = v[i] * fsigmoid(g[i]); }
            *(u32x4*)mp = pack8(v);
        EPI_LOOP_END
    }
};
struct EpiResid {
    const float* xp; const float* xs; float* op; float* os;
    __device__ __forceinline__ void operator()(const f32x4 (&acc)[2][2][4][2], const Unit& u, int wr, int wc, int fr, int fq) const {
        EPI_LOOP_BEGIN
            const float* xi = row < NP ? xp + (size_t)row * D + col : xs + (size_t)(row - NP) * D + col;
            float* xo = row < NP ? op + (size_t)row * D + col : os + (size_t)(row - NP) * D + col;
            const f32x4 a0 = *(const f32x4*)xi, a1 = *(const f32x4*)(xi + 4);
            *(f32x4*)xo = a0 * ALPHA + v0; *(f32x4*)(xo + 4) = a1 * ALPHA + v1;
        EPI_LOOP_END
    }
};
struct EpiSwiglu {
    bf16_t* ACT; const float* bup;
    __device__ __forceinline__ void operator()(const f32x4 (&acc)[2][2][4][2], const Unit& u, int wr, int wc, int fr, int fq) const {
        const int row0_ = u.pm * 256 + wr * 64 + fr, j0 = u.pn * 128 + wc * 32 + 8 * fq;
        const float* bg = bup + (size_t)u.e * 2048 + j0; const f32x4 bg0 = *(const f32x4*)bg, bg1 = *(const f32x4*)(bg + 4), bu0 = *(const f32x4*)(bg + 1024), bu1 = *(const f32x4*)(bg + 1028);
#pragma unroll
        for (int ai = 0; ai < 2; ++ai)
#pragma unroll
            for (int m = 0; m < 4; ++m) { const int row = row0_ + ai * 128 + m * 16;
                const f32x4 g0 = acc[ai][0][m][0] + bg0, g1 = acc[ai][0][m][1] + bg1, u0 = acc[ai][1][m][0] + bu0, u1 = acc[ai][1][m][1] + bu1; float o[8];
#pragma unroll
                for (int i = 0; i < 4; ++i) { const float ga = fminf(g0[i], SW_LIMIT), ua = fminf(fmaxf(u0[i], -SW_LIMIT), SW_LIMIT); o[i] = (ua + 1.0f) * ga * fsigmoid(SW_ALPHA * ga);
                    const float gb = fminf(g1[i], SW_LIMIT), ub = fminf(fmaxf(u1[i], -SW_LIMIT), SW_LIMIT); o[4 + i] = (ub + 1.0f) * gb * fsigmoid(SW_ALPHA * gb); }
                *(u32x4*)(ACT + (size_t)row * D + j0) = pack8(o); }
    }
};
struct EpiDown {
    bf16_t* O; const float* bdn; const float* gs;
    __device__ __forceinline__ void operator()(const f32x4 (&acc)[2][2][4][2], const Unit& u, int wr, int wc, int fr, int fq) const {
        EPI_LOOP_BEGIN
            const float* bp = bdn + (size_t)u.e * D + col; const f32x4 b0 = *(const f32x4*)bp, b1 = *(const f32x4*)(bp + 4); const float gt = gs[row];
            const f32x4 a0 = (v0 + b0) * gt, a1 = (v1 + b1) * gt;
            u32x4 w; w.x = pk2(a0[0], a0[1]); w.y = pk2(a0[2], a0[3]); w.z = pk2(a1[0], a1[1]); w.w = pk2(a1[2], a1[3]);
            *(u32x4*)(O + (size_t)row * D + col) = w;
        EPI_LOOP_END
    }
};
}

#ifndef EMU
#define XB_TMO      128
#define XB_XCNT(j)  (256  + 64 * (j))
#define XB_XSUB(j)  (1280 + 64 * (j))
#define XB_XGEN(j)  (2304 + 64 * (j))
#define XB_TOP      3328
#define XB_TOPGEN   3392
#define XCD_BAR_WORDS 3456
#define XB_SPIN_CAP (1u << 27)
__device__ __forceinline__ unsigned xb_ld(unsigned* p)              { return __hip_atomic_load(p, __ATOMIC_RELAXED, __HIP_MEMORY_SCOPE_AGENT); }
__device__ __forceinline__ unsigned xb_add(unsigned* p, unsigned v) { return __hip_atomic_fetch_add(p, v, __ATOMIC_RELAXED, __HIP_MEMORY_SCOPE_AGENT); }
__device__ __forceinline__ unsigned xb_xcc_id() { return (unsigned)__builtin_amdgcn_s_getreg((3 << 11) | 20) & 0xFu; }
#define XB_SPIN(cond, bar) do { unsigned _sp = 0; while (cond) { __builtin_amdgcn_s_sleep(1); \
    if ((++_sp & 255u) == 0u) { if (xb_ld(&(bar)[XB_TMO])) break; if (_sp > XB_SPIN_CAP) { atomicAdd(&(bar)[XB_TMO], 1u); break; } } } } while (0)
struct XcdBarrier { unsigned* bar; unsigned x; volatile LAS unsigned* st; };
__device__ __forceinline__ XcdBarrier xcd_barrier_post(unsigned* bar, volatile LAS unsigned* st) {
    XcdBarrier b; b.bar = bar; b.x = xb_xcc_id(); b.st = st;
    if (threadIdx.x == 0) (void)xb_add(&bar[XB_XCNT(b.x)], 1u);
    return b;
}
__device__ __forceinline__ void xcd_barrier_complete(unsigned* bar, unsigned x, unsigned& nloc, unsigned& nx) {
    const unsigned G = gridDim.x * gridDim.y * gridDim.z;
    unsigned sum, cnt, mine, sp = 0u;
    for (;;) {
        sum = 0u; cnt = 0u; mine = 0u;
#pragma unroll
        for (unsigned j = 0; j < 16; ++j) { const unsigned c = xb_ld(&bar[XB_XCNT(j)]); sum += c; cnt += (c > 0u) ? 1u : 0u; mine = (j == x) ? c : mine; }
        if (sum == G) break;
        __builtin_amdgcn_s_sleep(1);
        if ((++sp & 255u) == 0u) { if (xb_ld(&bar[XB_TMO])) break; if (sp > XB_SPIN_CAP) { atomicAdd(&bar[XB_TMO], 1u); break; } }
    }
    nloc = mine > 0u ? mine : 1u; nx = cnt > 0u ? cnt : 1u;
}
__device__ __forceinline__ void xcd_barrier(const XcdBarrier& b) {
    asm volatile("s_waitcnt vmcnt(0)" ::: "memory");
    __syncthreads();
    if (threadIdx.x == 0) {
        unsigned* bar = b.bar;
        __builtin_amdgcn_s_waitcnt(0);
        unsigned nloc = b.st[0], nx = b.st[1];
        if (nloc == 0u) { xcd_barrier_complete(bar, b.x, nloc, nx); b.st[0] = nloc; b.st[1] = nx; }
        const unsigned old = xb_add(&bar[XB_XSUB(b.x)], 1u);
        const unsigned gen = old / nloc;
        if (old + 1u == (gen + 1u) * nloc) {
            __builtin_amdgcn_fence(__ATOMIC_RELEASE, "agent");
            asm volatile("s_waitcnt vmcnt(0)" ::: "memory");
            const unsigned og = xb_add(&bar[XB_TOP], 1u);
            const unsigned tg = og / nx;
            if (og + 1u == (tg + 1u) * nx) xb_add(&bar[XB_TOPGEN], 1u);
            else XB_SPIN(xb_ld(&bar[XB_TOPGEN]) == tg, bar);
            __builtin_amdgcn_fence(__ATOMIC_ACQUIRE, "agent");
            xb_add(&bar[XB_XGEN(b.x)], 1u);
            asm volatile("s_waitcnt vmcnt(0)" ::: "memory");
        } else {
            XB_SPIN(xb_ld(&bar[XB_XGEN(b.x)]) == gen, bar);
            __builtin_amdgcn_fence(__ATOMIC_ACQUIRE, "agent");
            asm volatile("s_waitcnt vmcnt(0)" ::: "memory");
        }
    }
    __syncthreads();
}
#endif

struct Args { const float* in[31]; float* out; unsigned char* ws; int lo, hi; };
typedef const float* FPtr;
#ifdef EMU
typedef const FPtr* ArgTab;
#else
typedef const __attribute__((address_space(4))) FPtr* ArgTab;
#endif
struct Frame {
    LAS unsigned char* lds; int tid, lane, wave, G, bid;
    ArgTab in; float* out; unsigned char* ws; unsigned* ctl;
};
enum { I_XP = 0, I_XS, I_CK, I_CV, I_SST, I_SCV, I_SSC, I_WIN, I_CONVW, I_CONVB, I_DTB, I_ALOG, I_SD, I_NORMW, I_WSSD, I_SINK, I_WATT, I_RELB, I_SCW, I_WSC, I_WO, I_LN1G, I_LN1B,
       I_RW, I_RB, I_WUP, I_BUP, I_WDN, I_BDN, I_LN2G, I_LN2B };

__device__ __forceinline__ bf16_t* ws_bf(const Frame& F, size_t off) { return (bf16_t*)(F.ws + off); }
__device__ __forceinline__ float* ws_f(const Frame& F, size_t off) { return (float*)(F.ws + off); }
__device__ __forceinline__ bf16_t* wl_ptr(const Frame& F, int layer, size_t off) { return (bf16_t*)(F.ws + WS_W + (size_t)layer * WL_BYTES + off); }

__device__ __forceinline__ void wt_item(const float* W, int ldw, int K, int k0, int nsrc0, const float* kscale, bf16_t* WT, int ndst0, LAS float* scr, int lane) {
    if (nsrc0 < 0) {
#pragma unroll
        for (int j = 0; j < 4; ++j) { const int n = (lane >> 3) + 8 * j; *(u32x4*)(WT + (size_t)(ndst0 + n) * K + k0 + 8 * (lane & 7)) = (u32x4){0u, 0u, 0u, 0u}; }
        return;
    }
#pragma unroll 8
    for (int i = 0; i < 32; ++i) { const int kk = 2 * i + (lane >> 5); float v = W[(size_t)(k0 + kk) * ldw + nsrc0 + (lane & 31)]; if (kscale) v *= kscale[k0 + kk]; scr[kk * 33 + (lane & 31)] = v; }
    WAVE_SYNC();
    const int c = lane & 7;
#pragma unroll
    for (int j = 0; j < 4; ++j) { const int n = (lane >> 3) + 8 * j; const LAS float* s = scr + (8 * c) * 33 + n;
        u32x4 o; o.x = pk2(s[0 * 33], s[1 * 33]); o.y = pk2(s[2 * 33], s[3 * 33]); o.z = pk2(s[4 * 33], s[5 * 33]); o.w = pk2(s[6 * 33], s[7 * 33]);
        *(u32x4*)(WT + (size_t)(ndst0 + n) * K + k0 + 8 * c) = o; }
    WAVE_SYNC();
}
__device__ __forceinline__ void step_weights(const Frame& F) {
    LAS float* scr = (LAS float*)(F.lds + F.wave * 16384);
    const int gw = F.bid * NWAVES + F.wave, NGW = F.G * NWAVES;
    constexpr int I_IN = (DINP / 32) * (D / 64), I_SSD = (D / 32) * (DINNER / 64), I_SQ = (D / 32) * (D / 64), I_UP = NEXP * (2048 / 32) * (D / 64), I_DN = NEXP * (D / 32) * (D / 64);
    constexpr int PER_LAYER = I_IN + I_SSD + 3 * I_SQ + I_UP + I_DN;
    for (int it = gw; it < DEPTH * PER_LAYER; it += NGW) {
        const int layer = it / PER_LAYER; int r = it % PER_LAYER;
        if (r < I_IN) { const int nb = r / (D / 64), kb = r % (D / 64), n0 = nb * 32;
            const int ns = n0 < 6144 ? n0 : (n0 < 13824 ? n0 + 32 : (n0 < 13856 ? n0 - 13824 + 6144 : -1));
            wt_item(F.in[I_WIN] + (size_t)layer * D * DIN, DIN, D, kb * 64, ns, nullptr, wl_ptr(F, layer, WL_IN), n0, scr, F.lane); continue; }
        r -= I_IN;
        if (r < I_SSD) { const int nb = r / (DINNER / 64), kb = r % (DINNER / 64);
            wt_item(F.in[I_WSSD] + (size_t)layer * DINNER * D, D, DINNER, kb * 64, nb * 32, F.in[I_NORMW] + (size_t)layer * DINNER, wl_ptr(F, layer, WL_SSD), nb * 32, scr, F.lane); continue; }
        r -= I_SSD;
        if (r < I_SQ) { const int nb = r / (D / 64), kb = r % (D / 64); wt_item(F.in[I_WATT] + (size_t)layer * D * D, D, D, kb * 64, nb * 32, nullptr, wl_ptr(F, layer, WL_ATT), nb * 32, scr, F.lane); continue; }
        r -= I_SQ;
        if (r < I_SQ) { const int nb = r / (D / 64), kb = r % (D / 64); wt_item(F.in[I_WSC] + (size_t)layer * D * D, D, D, kb * 64, nb * 32, nullptr, wl_ptr(F, layer, WL_SC), nb * 32, scr, F.lane); continue; }
        r -= I_SQ;
        if (r < I_SQ) { const int nb = r / (D / 64), kb = r % (D / 64); wt_item(F.in[I_WO] + (size_t)layer * D * D, D, D, kb * 64, nb * 32, nullptr, wl_ptr(F, layer, WL_O), nb * 32, scr, F.lane); continue; }
        r -= I_SQ;
        if (r < I_UP) { const int e = r / ((2048 / 32) * (D / 64)), q = r % ((2048 / 32) * (D / 64)), nb = q / (D / 64), kb = q % (D / 64), n0 = nb * 32;
            const int pn = n0 >> 8, bj = (n0 >> 7) & 1, jj = n0 & 127, ns = bj * 1024 + pn * 128 + jj;
            wt_item(F.in[I_WUP] + ((size_t)layer * NEXP + e) * D * 2048, 2048, D, kb * 64, ns, nullptr, wl_ptr(F, layer, WL_UP) + (size_t)e * 2048 * D, n0, scr, F.lane); continue; }
        r -= I_UP;
        { const int e = r / ((D / 32) * (D / 64)), q = r % ((D / 32) * (D / 64)), nb = q / (D / 64), kb = q % (D / 64);
            wt_item(F.in[I_WDN] + ((size_t)layer * NEXP + e) * D * D, D, D, kb * 64, nb * 32, nullptr, wl_ptr(F, layer, WL_DN) + (size_t)e * D * D, nb * 32, scr, F.lane); }
    }
}

__device__ __forceinline__ const float* x_in_row(const Frame& F, int layer, int mb, int r) {
    if (layer == 0) return r < NP ? F.in[I_XP] + ((size_t)mb * NP + r) * D : F.in[I_XS] + (size_t)(r - NP) * D;
    return r < NP ? F.out + O_YP + ((size_t)mb * NP + r) * D : F.out + O_YS + (size_t)(r - NP) * D;
}
__device__ __forceinline__ float* x_out_row(const Frame& F, int mb, int r) { return r < NP ? F.out + O_YP + ((size_t)mb * NP + r) * D : F.out + O_YS + (size_t)(r - NP) * D; }
__device__ __forceinline__ int rows_of(int mb) { return mb == 0 ? R : NP; }

__device__ __forceinline__ void step_xb(const Frame& F, int mb) {
    const int gw = F.bid * NWAVES + F.wave, NGW = F.G * NWAVES, nr = rows_of(mb);
    bf16_t* XB = ws_bf(F, WS_XB);
    for (int r = gw; r < nr; r += NGW) {
        const f32x4* xr = (const f32x4*)x_in_row(F, 0, mb, r) + F.lane; u32x2* o = (u32x2*)(XB + (size_t)r * D) + F.lane;
#pragma unroll
        for (int j = 0; j < 4; ++j) { const f32x4 v = xr[64 * j]; u32x2 w; w.x = pk2(v[0], v[1]); w.y = pk2(v[2], v[3]); o[64 * j] = w; }
    }
}

__device__ __forceinline__ float softplus_f(float x) { return x > 20.f ? x : log1pf(expf(x)); }
constexpr int S128 = 136, S64 = 72;
constexpr int SL_CM = 0, SL_BM = SL_CM + 64 * S128 * 2, SL_BT = SL_BM + 64 * S128 * 2, SL_XT = SL_BT + 128 * S64 * 2, SL_XTW = SL_XT + 64 * S64 * 2, SL_XS = SL_XTW + 64 * S64 * 2,
    SL_MM = SL_XS + 64 * S64 * 2, SL_SB = SL_MM + 64 * S64 * 2, SL_SM = SL_SB + 64 * S128 * 2, SL_CW = SL_SM + 5 * 64 * 4, SL_END = SL_CW + 5 * 320 * 4;
constexpr int SL_Y = SL_CM, YP = 68;
static_assert(SL_END <= RING_BYTES && 64 * YP * 4 <= 64 * S128 * 2, "ssd LDS map");

#define SSD_ITEM_L(it) ((it) == 0 ? xl : ((tid + 512 * (((it) - 1) & 1)) >> 4))
#define SSD_ITEM_CG(it) ((it) == 0 ? xcg : ((tid + 512 * (((it) - 1) & 1)) & 15))
#define SSD_LOAD_RAW(ck_) do { _Pragma("unroll") for (int it = 0; it < 5; ++it) { const int l_ = SSD_ITEM_L(it), cg_ = SSD_ITEM_CG(it); \
        const int col_ = it == 0 ? C_X + hd * 64 + 8 * cg_ : (it < 3 ? C_B + g * 128 + 8 * cg_ : C_C + g * 128 + 8 * cg_); \
        _Pragma("unroll") for (int i = 0; i < 4; ++i) { const int t_ = (ck_) * 64 + l_ - 3 + i; \
            raw[it][i] = t_ >= 0 ? *(const u32x4*)(H + (size_t)t_ * DINP + col_) : (u32x4){0u, 0u, 0u, 0u}; } } } while (0)

__device__ __forceinline__ void ssd_prompt_unit(const Frame& F, int layer, int mb, int sl, int hd) {
    const int tid = F.tid, lane = F.lane, w = F.wave, fr = lane & 15, fq = lane >> 4;
    LAS unsigned char* L = F.lds;
    LAS bf16_t* Cm = (LAS bf16_t*)(L + SL_CM); LAS bf16_t* Bm = (LAS bf16_t*)(L + SL_BM); LAS bf16_t* BT = (LAS bf16_t*)(L + SL_BT); LAS bf16_t* XT = (LAS bf16_t*)(L + SL_XT);
    LAS bf16_t* XTW = (LAS bf16_t*)(L + SL_XTW); LAS bf16_t* Xs = (LAS bf16_t*)(L + SL_XS); LAS bf16_t* Mm = (LAS bf16_t*)(L + SL_MM); LAS bf16_t* Sb = (LAS bf16_t*)(L + SL_SB);
    LAS float* sm = (LAS float*)(L + SL_SM);
    LAS float* cw = (LAS float*)(L + SL_CW);
    LAS float* Y = (LAS float*)(L + SL_Y);
    const int g = hd >> 2;
    bf16_t* H = ws_bf(F, WS_H) + (size_t)sl * SEQ * DINP;
    const float* convw = F.in[I_CONVW] + (size_t)layer * 4 * CONVDIM; const float* convb = F.in[I_CONVB] + (size_t)layer * CONVDIM;
    __syncthreads();
    for (int i = tid; i < 5 * 320; i += NTHREADS) { const int tap = i / 320, c = i % 320; const int xc = c < 64 ? hd * 64 + c : (c < 192 ? 2048 + g * 128 + (c - 64) : 3072 + g * 128 + (c - 192));
        cw[i] = tap < 4 ? convw[tap * CONVDIM + xc] : convb[xc]; }
    const float dtb = F.in[I_DTB][layer * 32 + hd], Ah = -expf(F.in[I_ALOG][layer * 32 + hd]), Dh = F.in[I_SD][layer * 32 + hd];
    const int xl = tid >> 3, xcg = tid & 7;
    u32x4 raw[5][4];
    f32x4 S[4];
#pragma unroll
    for (int j = 0; j < 4; ++j) S[j] = (f32x4){0.f, 0.f, 0.f, 0.f};
    const int ti = w >> 1, tj0 = 2 * (w & 1);
    const int pi = w & 3, nb = w >> 2;
    for (int ck = 0; ck < NCHUNK; ++ck) {
        const size_t rowb = (size_t)ck * 64;
        SSD_LOAD_RAW(ck);
#pragma unroll
        for (int jj = 0; jj < 4; ++jj)
#pragma unroll
            for (int r = 0; r < 4; ++r) Sb[(16 * pi + 4 * fq + r) * S128 + 64 * nb + 16 * jj + fr] = (bf16_t)f2bf(S[jj][r]);
        if (w == 0) {
            const float dtr = bf2f(H[(rowb + lane) * DINP + C_DT + hd]); const float dt = softplus_f(dtr + dtb); const float a = Ah * dt;
            float cs = a;
#pragma unroll
            for (int o = 1; o < 64; o <<= 1) { const float t = __shfl(cs, lane - o < 0 ? 0 : lane - o); if (lane >= o) cs += t; }
            const float tot = __shfl(cs, 63);
            sm[lane] = dt; sm[64 + lane] = cs; sm[128 + lane] = fexp(tot - cs); sm[192 + lane] = fexp(cs); if (lane == 0) sm[256] = fexp(tot);
        }
        const u32x4 zraw = *(const u32x4*)(H + (rowb + xl) * DINP + C_Z + hd * 64 + 8 * xcg);
        __syncthreads();
#pragma unroll
        for (int it = 0; it < 5; ++it) {
            const int l = SSD_ITEM_L(it), cg = SSD_ITEM_CG(it);
            const int cb = it == 0 ? 8 * cg : (it < 3 ? 64 + 8 * cg : 192 + 8 * cg);
            float acc8[8];
            { const f32x4 b0 = *(const LAS f32x4*)(cw + 4 * 320 + cb), b1 = *(const LAS f32x4*)(cw + 4 * 320 + cb + 4);
#pragma unroll
              for (int i = 0; i < 4; ++i) { acc8[i] = b0[i]; acc8[4 + i] = b1[i]; } }
#pragma unroll
            for (int tp = 0; tp < 4; ++tp) { float f[8]; unpack8(raw[it][tp], f); const f32x4 w0 = *(const LAS f32x4*)(cw + tp * 320 + cb), w1 = *(const LAS f32x4*)(cw + tp * 320 + cb + 4);
#pragma unroll
                for (int i = 0; i < 4; ++i) { acc8[i] += f[i] * w0[i]; acc8[4 + i] += f[4 + i] * w1[i]; } }
#pragma unroll
            for (int i = 0; i < 8; ++i) acc8[i] = fsilu(acc8[i]);
            if (it == 0) { const float dt = sm[l], wd = sm[128 + l];
                *(LAS u32x4*)(Xs + l * S64 + 8 * cg) = pack8(acc8);
#pragma unroll
                for (int i = 0; i < 8; ++i) { const float xd = acc8[i] * dt; XT[(8 * cg + i) * S64 + l] = (bf16_t)f2bf(xd); XTW[(8 * cg + i) * S64 + l] = (bf16_t)f2bf(xd * wd); } }
            else if (it < 3) { *(LAS u32x4*)(Bm + l * S128 + 8 * cg) = pack8(acc8);
#pragma unroll
                for (int i = 0; i < 8; ++i) BT[(8 * cg + i) * S64 + l] = (bf16_t)f2bf(acc8[i]); }
            else *(LAS u32x4*)(Cm + l * S128 + 8 * cg) = pack8(acc8);
            asm volatile("" ::: "memory");
        }
        __syncthreads();
        f32x4 yo[2];
#pragma unroll
        for (int jj = 0; jj < 2; ++jj) { const int tj = tj0 + jj;
            f32x4 cb = (f32x4){0.f, 0.f, 0.f, 0.f}; yo[jj] = (f32x4){0.f, 0.f, 0.f, 0.f};
#pragma unroll
            for (int ks = 0; ks < 4; ++ks) { const bf16x8 a = *(const LAS bf16x8*)(Cm + (16 * ti + fr) * S128 + 32 * ks + 8 * fq);
                if (tj <= ti) { const bf16x8 b = *(const LAS bf16x8*)(Bm + (16 * tj + fr) * S128 + 32 * ks + 8 * fq); cb = __builtin_amdgcn_mfma_f32_16x16x32_bf16(a, b, cb, 0, 0, 0); }
                const bf16x8 sb = *(const LAS bf16x8*)(Sb + (16 * tj + fr) * S128 + 32 * ks + 8 * fq); yo[jj] = __builtin_amdgcn_mfma_f32_16x16x32_bf16(a, sb, yo[jj], 0, 0, 0); }
            const int s = 16 * tj + fr; const float as = sm[64 + s];
#pragma unroll
            for (int r = 0; r < 4; ++r) { const int l = 16 * ti + 4 * fq + r; const float al = sm[64 + l];
                const float mv = (tj <= ti && l >= s) ? cb[r] * fexp(fminf(al - as, 0.f)) : 0.f; Mm[l * S64 + s] = (bf16_t)f2bf(mv); }
            asm volatile("" ::: "memory");
        }
        { const float cd = sm[256];
#pragma unroll
          for (int jj = 0; jj < 4; ++jj) { S[jj] = S[jj] * cd;
#pragma unroll
            for (int ks = 0; ks < 2; ++ks) { const bf16x8 a = *(const LAS bf16x8*)(XTW + (16 * pi + fr) * S64 + 32 * ks + 8 * fq); const bf16x8 b = *(const LAS bf16x8*)(BT + (64 * nb + 16 * jj + fr) * S64 + 32 * ks + 8 * fq);
                S[jj] = __builtin_amdgcn_mfma_f32_16x16x32_bf16(a, b, S[jj], 0, 0, 0); }
            if (jj & 1) asm volatile("" ::: "memory"); } }
        __syncthreads();
#pragma unroll
        for (int jj = 0; jj < 2; ++jj) { const int tj = tj0 + jj; f32x4 yd = (f32x4){0.f, 0.f, 0.f, 0.f};
#pragma unroll
            for (int ks = 0; ks < 2; ++ks) { const bf16x8 a = *(const LAS bf16x8*)(Mm + (16 * ti + fr) * S64 + 32 * ks + 8 * fq); const bf16x8 b = *(const LAS bf16x8*)(XT + (16 * tj + fr) * S64 + 32 * ks + 8 * fq);
                yd = __builtin_amdgcn_mfma_f32_16x16x32_bf16(a, b, yd, 0, 0, 0); }
#pragma unroll
            for (int r = 0; r < 4; ++r) { const int l = 16 * ti + 4 * fq + r; Y[l * YP + 16 * tj + fr] = yd[r] + sm[192 + l] * yo[jj][r]; } }
        __syncthreads();
        { float y8[8], x8[8], z8[8]; const f32x4 ya = *(const LAS f32x4*)(Y + xl * YP + 8 * xcg), yb = *(const LAS f32x4*)(Y + xl * YP + 8 * xcg + 4);
#pragma unroll
          for (int i = 0; i < 4; ++i) { y8[i] = ya[i]; y8[4 + i] = yb[i]; }
          unpack8(*(const LAS u32x4*)(Xs + xl * S64 + 8 * xcg), x8); unpack8(zraw, z8); float ss = 0.f;
#pragma unroll
          for (int i = 0; i < 8; ++i) { const float v = (y8[i] + Dh * x8[i]) * fsilu(z8[i]); y8[i] = v; ss += v * v; }
          *(u32x4*)(H + (rowb + xl) * DINP + C_Z + hd * 64 + 8 * xcg) = pack8(y8);
          ss += __shfl_xor(ss, 1); ss += __shfl_xor(ss, 2); ss += __shfl_xor(ss, 4);
          if (xcg == 0) ws_f(F, WS_SSQ)[((size_t)sl * SEQ + rowb + xl) * 32 + hd] = ss; }
    }
    float* so = F.out + O_SSP + ((((size_t)layer * BATCH + mb * NSEQ_MB + sl) * 32 + hd) * 64) * 128;
#pragma unroll
    for (int jj = 0; jj < 4; ++jj)
#pragma unroll
        for (int r = 0; r < 4; ++r) so[(size_t)(16 * pi + 4 * fq + r) * 128 + 64 * nb + 16 * jj + fr] = S[jj][r];
}

__device__ __forceinline__ void ssd_sample_unit(const Frame& F, int layer, int sq, int hd) {
    const int tid = F.tid, lane = F.lane; LAS float* L = (LAS float*)F.lds;
    LAS float* xs = L; LAS float* Bs = L + 16 * 64; LAS float* Cs = Bs + 16 * 128; LAS float* dts = Cs + 16 * 128; LAS float* das = dts + 16; LAS float* Yl = das + 16;
    const int g = hd >> 2;
    bf16_t* H = ws_bf(F, WS_H) + (size_t)(NP + sq * 16) * DINP;
    const float* hist = F.in[I_SCV] + ((size_t)layer * DECB + sq) * 3 * CONVDIM;
    const float* convw = F.in[I_CONVW] + (size_t)layer * 4 * CONVDIM; const float* convb = F.in[I_CONVB] + (size_t)layer * CONVDIM;
    __syncthreads();
    for (int it = tid; it < 16 * 320; it += NTHREADS) { const int t = it / 320, c = it % 320; const int xc = c < 64 ? hd * 64 + c : (c < 192 ? 2048 + g * 128 + (c - 64) : 3072 + g * 128 + (c - 192));
        float a = convb[xc];
#pragma unroll
        for (int i = 0; i < 4; ++i) { const int tt = t - 3 + i; const float v = tt >= 0 ? bf2f(H[(size_t)tt * DINP + C_X + xc]) : hist[(tt + 3) * CONVDIM + xc]; a += v * convw[i * CONVDIM + xc]; }
        a = a / (1.0f + expf(-a));
        if (c < 64) xs[t * 64 + c] = a; else if (c < 192) Bs[t * 128 + c - 64] = a; else Cs[t * 128 + c - 192] = a; }
    if (tid < 16) { const float dt = softplus_f(bf2f(H[(size_t)tid * DINP + C_DT + hd]) + F.in[I_DTB][layer * 32 + hd]); dts[tid] = dt; das[tid] = expf(-expf(F.in[I_ALOG][layer * 32 + hd]) * dt); }
    __syncthreads();
    const int p = tid >> 3, n0 = (tid & 7) * 16;
    const size_t sbase = ((((size_t)layer * DECB + sq) * 32 + hd) * 64 + p) * 128 + n0;
    float S[16];
#pragma unroll
    for (int i = 0; i < 16; ++i) S[i] = F.in[I_SST][sbase + i];
    for (int t = 0; t < 16; ++t) { const float dec = das[t], xv = xs[t * 64 + p] * dts[t]; float part = 0.f;
#pragma unroll
        for (int i = 0; i < 16; ++i) { S[i] = S[i] * dec + xv * Bs[t * 128 + n0 + i]; part += Cs[t * 128 + n0 + i] * S[i]; }
        part += __shfl_xor(part, 1); part += __shfl_xor(part, 2); part += __shfl_xor(part, 4);
        if ((tid & 7) == 0) Yl[t * 64 + p] = part; }
#pragma unroll
    for (int i = 0; i < 16; ++i) F.out[O_SSS + sbase + i] = S[i];
    __syncthreads();
    const float Dh = F.in[I_SD][layer * 32 + hd];
#pragma unroll
    for (int j = 0; j < 2; ++j) { const int it = tid + 512 * j, t = it >> 6, pp = it & 63;
        const float z = bf2f(H[(size_t)t * DINP + C_Z + hd * 64 + pp]); const float v = (Yl[t * 64 + pp] + Dh * xs[t * 64 + pp]) * (z / (1.0f + expf(-z)));
        H[(size_t)t * DINP + C_Z + hd * 64 + pp] = (bf16_t)f2bf(v);
        const float ss = wave_sum(v * v);
        if (lane == 0) ws_f(F, WS_SSQ)[((size_t)NP + sq * 16 + t) * 32 + hd] = ss; }
}

__device__ __forceinline__ int t5_bucket(int rel) {
    const int n = rel < 0 ? -rel : rel; const int b = rel > 0 ? 16 : 0;
    if (n < 8) return b + n;
    int v = 8; v += n >= 12; v += n >= 16; v += n >= 23; v += n >= 32; v += n >= 46; v += n >= 64; v += n >= 91;
    return b + v;
}
constexpr int AK_P = 72, AV_P = 200;
constexpr int AL_K = 0, AL_VT = AL_K + 192 * AK_P * 2, AL_LUT = AL_VT + 64 * AV_P * 2, AL_END = AL_LUT + 4 * 256 * 4;
static_assert(AL_END <= RING_BYTES, "attention LDS map");
__device__ __forceinline__ void attn_prompt_unit(const Frame& F, int layer, int sl, int ck, int kh) {
    const int tid = F.tid, lane = F.lane, w = F.wave, q32 = lane & 31, hi = lane >> 5;
    LAS bf16_t* Kl = (LAS bf16_t*)(F.lds + AL_K); LAS bf16_t* VT = (LAS bf16_t*)(F.lds + AL_VT); LAS float* lut = (LAS float*)(F.lds + AL_LUT);
    bf16_t* H = ws_bf(F, WS_H) + (size_t)sl * SEQ * DINP;
    __syncthreads();
#pragma unroll
    for (int j = 0; j < 3; ++j) { const int id = tid + 512 * j, key = id >> 3, cg = id & 7; const int t = 64 * (ck - 2) + key;
        u32x4 kv = (u32x4){0u, 0u, 0u, 0u}, vv = kv;
        if (t >= 0) { kv = *(const u32x4*)(H + (size_t)t * DINP + C_K + kh * 64 + 8 * cg); vv = *(const u32x4*)(H + (size_t)t * DINP + C_V + kh * 64 + 8 * cg); }
        *(LAS u32x4*)(Kl + key * AK_P + 8 * cg) = kv;
        VT[(8 * cg + 0) * AV_P + key] = (bf16_t)(vv.x & 0xffffu); VT[(8 * cg + 1) * AV_P + key] = (bf16_t)(vv.x >> 16); VT[(8 * cg + 2) * AV_P + key] = (bf16_t)(vv.y & 0xffffu); VT[(8 * cg + 3) * AV_P + key] = (bf16_t)(vv.y >> 16);
        VT[(8 * cg + 4) * AV_P + key] = (bf16_t)(vv.z & 0xffffu); VT[(8 * cg + 5) * AV_P + key] = (bf16_t)(vv.z >> 16); VT[(8 * cg + 6) * AV_P + key] = (bf16_t)(vv.w & 0xffffu); VT[(8 * cg + 7) * AV_P + key] = (bf16_t)(vv.w >> 16); }
    for (int e = tid; e < 4 * 255; e += NTHREADS) { const int gg = e / 255, idx = e % 255; lut[gg * 256 + idx] = F.in[I_RELB][t5_bucket(idx - 191) * 16 + kh * 4 + gg]; }
    __syncthreads();
    const int gq = w >> 1, qh = w & 1, head = kh * 4 + gq;
    const size_t qrow = (size_t)ck * 64 + 32 * qh + q32;
    bf16x8 qf[4];
#pragma unroll
    for (int ds = 0; ds < 4; ++ds) qf[ds] = *(const bf16x8*)(H + qrow * DINP + C_Q + head * 64 + 16 * ds + 8 * hi);
    f32x16 sc[6];
#pragma unroll
    for (int kt = 0; kt < 6; ++kt) {
#pragma unroll
        for (int r = 0; r < 16; ++r) sc[kt][r] = 0.f;
#pragma unroll
        for (int ds = 0; ds < 4; ++ds) { const bf16x8 a = *(const LAS bf16x8*)(Kl + (32 * kt + q32) * AK_P + 16 * ds + 8 * hi); sc[kt] = __builtin_amdgcn_mfma_f32_32x32x16_bf16(a, qf[ds], sc[kt], 0, 0, 0); } }
    const int qidx = 32 * qh + q32; const float sink = F.in[I_SINK][layer * 16 + head];
    float mx = -3.0e38f;
#pragma unroll
    for (int kt = 0; kt < 6; ++kt)
#pragma unroll
        for (int r = 0; r < 16; ++r) { const int key = 32 * kt + (r & 3) + 8 * (r >> 2) + 4 * hi; const int rel = key - 128 - qidx;
            float s = sc[kt][r] * 0.125f + lut[gq * 256 + rel + 191]; if (64 * ck + key - 128 < 0) s = -1e30f; sc[kt][r] = s; mx = fmaxf(mx, s); }
    mx = fmaxf(mx, __shfl_xor(mx, 32)); mx = fmaxf(mx, sink);
    float sum = 0.f;
#pragma unroll
    for (int kt = 0; kt < 6; ++kt)
#pragma unroll
        for (int r = 0; r < 16; ++r) { const float e = fexp(sc[kt][r] - mx); sc[kt][r] = e; sum += e; }
    sum += __shfl_xor(sum, 32);
    const float inv = 1.0f / (sum + fexp(sink - mx));
    f32x16 o[2];
#pragma unroll
    for (int d2 = 0; d2 < 2; ++d2)
#pragma unroll
        for (int r = 0; r < 16; ++r) o[d2][r] = 0.f;
#pragma unroll
    for (int kt = 0; kt < 6; ++kt)
#pragma unroll
        for (int s = 0; s < 2; ++s) {
            u32x4 pw; pw.x = pk2(sc[kt][8 * s + 0], sc[kt][8 * s + 1]); pw.y = pk2(sc[kt][8 * s + 2], sc[kt][8 * s + 3]); pw.z = pk2(sc[kt][8 * s + 4], sc[kt][8 * s + 5]); pw.w = pk2(sc[kt][8 * s + 6], sc[kt][8 * s + 7]);
            const bf16x8 pa = __builtin_bit_cast(bf16x8, pw);
#pragma unroll
            for (int d2 = 0; d2 < 2; ++d2) { const LAS bf16_t* vp = VT + (32 * d2 + q32) * AV_P + 32 * kt + 16 * s + 4 * hi;
                const u32x2 lo = *(const LAS u32x2*)vp, hh = *(const LAS u32x2*)(vp + 8); u32x4 vw; vw.x = lo.x; vw.y = lo.y; vw.z = hh.x; vw.w = hh.y;
                o[d2] = __builtin_amdgcn_mfma_f32_32x32x16_bf16(pa, __builtin_bit_cast(bf16x8, vw), o[d2], 0, 0, 0); } }
#pragma unroll
    for (int r = 0; r < 16; ++r) { const int q = (r & 3) + 8 * (r >> 2) + 4 * hi; const float iv = __shfl(inv, q);
        bf16_t* op = H + ((size_t)ck * 64 + 32 * qh + q) * DINP + C_Q + head * 64 + q32;
        op[0] = (bf16_t)f2bf(o[0][r] * iv); op[32] = (bf16_t)f2bf(o[1][r] * iv); }
}
__device__ __forceinline__ void attn_sample_unit(const Frame& F, int layer, int sq, int kh) {
    const int tid = F.tid; LAS float* L = (LAS float*)F.lds;
    LAS float* Kf = L; LAS float* Vf = Kf + 144 * 65; LAS float* Qf = Vf + 144 * 64; LAS float* P = Qf + 64 * 65; LAS float* Pinv = P + 64 * 145;
    static_assert((144 * 65 + 144 * 64 + 64 * 65 + 64 * 145 + 64) * 4 <= RING_BYTES, "sample attention LDS map");
    bf16_t* H = ws_bf(F, WS_H) + (size_t)(NP + sq * 16) * DINP;
    const float* ck = F.in[I_CK] + ((size_t)layer * DECB + sq) * WINDOW * 256; const float* cv = F.in[I_CV] + ((size_t)layer * DECB + sq) * WINDOW * 256;
    __syncthreads();
    for (int i = tid; i < 144 * 64; i += NTHREADS) { const int key = i >> 6, d = i & 63;
        Kf[key * 65 + d] = key < 128 ? ck[(size_t)key * 256 + kh * 64 + d] : bf2f(H[(size_t)(key - 128) * DINP + C_K + kh * 64 + d]);
        Vf[key * 64 + d] = key < 128 ? cv[(size_t)key * 256 + kh * 64 + d] : bf2f(H[(size_t)(key - 128) * DINP + C_V + kh * 64 + d]); }
    for (int i = tid; i < 64 * 64; i += NTHREADS) { const int row = i >> 6, d = i & 63; Qf[row * 65 + d] = bf2f(H[(size_t)(row & 15) * DINP + C_Q + (kh * 4 + (row >> 4)) * 64 + d]); }
    __syncthreads();
    for (int i = tid; i < 64 * 144; i += NTHREADS) { const int row = i / 144, key = i % 144; float s = 0.f;
        for (int d = 0; d < 64; ++d) s += Qf[row * 65 + d] * Kf[key * 65 + d];
        P[row * 145 + key] = s * 0.125f + F.in[I_RELB][t5_bucket(key - 128 - (row & 15)) * 16 + kh * 4 + (row >> 4)]; }
    __syncthreads();
    { const int row = tid >> 3, sub = tid & 7; const float sink = F.in[I_SINK][layer * 16 + kh * 4 + (row >> 4)]; float mx = -3.0e38f;
      for (int k = sub; k < 144; k += 8) mx = fmaxf(mx, P[row * 145 + k]);
      mx = fmaxf(mx, __shfl_xor(mx, 1)); mx = fmaxf(mx, __shfl_xor(mx, 2)); mx = fmaxf(mx, __shfl_xor(mx, 4)); mx = fmaxf(mx, sink);
      float sum = 0.f;
      for (int k = sub; k < 144; k += 8) { const float e = expf(P[row * 145 + k] - mx); P[row * 145 + k] = e; sum += e; }
      sum += __shfl_xor(sum, 1); sum += __shfl_xor(sum, 2); sum += __shfl_xor(sum, 4);
      if (sub == 0) Pinv[row] = 1.0f / (sum + expf(sink - mx)); }
    __syncthreads();
    { const int row = tid >> 3, d0 = (tid & 7) * 8; float o[8] = {0.f, 0.f, 0.f, 0.f, 0.f, 0.f, 0.f, 0.f};
      for (int k = 0; k < 144; ++k) { const float pv = P[row * 145 + k];
#pragma unroll
          for (int i = 0; i < 8; ++i) o[i] += pv * Vf[k * 64 + d0 + i]; }
      const float iv = Pinv[row];
#pragma unroll
      for (int i = 0; i < 8; ++i) o[i] *= iv;
      *(u32x4*)(H + (size_t)(row & 15) * DINP + C_Q + (kh * 4 + (row >> 4)) * 64 + d0) = pack8(o); }
}
__device__ __forceinline__ void sc_unit(const Frame& F, int layer, int tile) {
    const int tid = F.tid, cg = tid & 127, rs = tid >> 7; bf16_t* H = ws_bf(F, WS_H);
    const float* wsc = F.in[I_SCW] + (size_t)layer * 3 * D + 8 * cg; float wt[3][8];
#pragma unroll
    for (int i = 0; i < 3; ++i)
#pragma unroll
        for (int c = 0; c < 8; ++c) wt[i][c] = wsc[i * D + c];
    for (int rr = rs; rr < 64; rr += 4) { const int row = tile * 64 + rr; const bool smp = row >= NP;
        const int tt = smp ? (row - NP) & 15 : row % SEQ; float a[8] = {0.f, 0.f, 0.f, 0.f, 0.f, 0.f, 0.f, 0.f};
#pragma unroll
        for (int i = 0; i < 3; ++i) { const int t2 = tt - 2 + i; float u[8];
            if (t2 >= 0) { float c8[8], h8[8]; unpack8(*(const u32x4*)(H + (size_t)(row - 2 + i) * DINP + C_SCC + 8 * cg), c8); unpack8(*(const u32x4*)(H + (size_t)(row - 2 + i) * DINP + C_SCH + 8 * cg), h8);
#pragma unroll
                for (int c = 0; c < 8; ++c) u[c] = c8[c] * h8[c]; }
            else if (smp) { const float* hp = F.in[I_SSC] + (((size_t)layer * DECB + ((row - NP) >> 4)) * 2 + (t2 + 2)) * D + 8 * cg;
#pragma unroll
                for (int c = 0; c < 8; ++c) u[c] = hp[c]; }
            else {
#pragma unroll
                for (int c = 0; c < 8; ++c) u[c] = 0.f; }
#pragma unroll
            for (int c = 0; c < 8; ++c) a[c] += u[c] * wt[i][c]; }
        float b8[8]; unpack8(*(const u32x4*)(H + (size_t)row * DINP + C_SCB + 8 * cg), b8);
#pragma unroll
        for (int c = 0; c < 8; ++c) a[c] *= b8[c];
        *(u32x4*)(H + (size_t)row * DINP + C_SCB + 8 * cg) = pack8(a); }
}
__device__ __forceinline__ void state_out_unit(const Frame& F, int layer, int mb, int sl, bool smp) {
    const int tid = F.tid; const bf16_t* H = ws_bf(F, WS_H);
    const int nkv = smp ? DECS : WINDOW, len = smp ? DECS : SEQ; const size_t row0 = smp ? (size_t)NP + sl * 16 : (size_t)sl * SEQ; const int sg = smp ? sl : mb * NSEQ_MB + sl;
    const size_t nb_ = smp ? DECB : BATCH;
    float* ko = F.out + (smp ? O_KS : O_KP) + ((size_t)layer * nb_ + sg) * nkv * 256; float* vo = F.out + (smp ? O_VS : O_VP) + ((size_t)layer * nb_ + sg) * nkv * 256;
    for (int i = tid; i < nkv * 32; i += NTHREADS) { const int j = i >> 5, c8 = (i & 31) * 8; const bf16_t* hp = H + (row0 + len - nkv + j) * DINP; float f[8];
        unpack8(*(const u32x4*)(hp + C_K + c8), f); *(f32x4*)(ko + (size_t)j * 256 + c8) = (f32x4){f[0], f[1], f[2], f[3]}; *(f32x4*)(ko + (size_t)j * 256 + c8 + 4) = (f32x4){f[4], f[5], f[6], f[7]};
        unpack8(*(const u32x4*)(hp + C_V + c8), f); *(f32x4*)(vo + (size_t)j * 256 + c8) = (f32x4){f[0], f[1], f[2], f[3]}; *(f32x4*)(vo + (size_t)j * 256 + c8 + 4) = (f32x4){f[4], f[5], f[6], f[7]}; }
    float* co = F.out + (smp ? O_CVS : O_CVP) + ((size_t)layer * nb_ + sg) * 3 * CONVDIM;
    for (int i = tid; i < 3 * 512; i += NTHREADS) { const int j = i / 512, c8 = (i % 512) * 8; float f[8]; unpack8(*(const u32x4*)(H + (row0 + len - 3 + j) * DINP + C_X + c8), f);
        *(f32x4*)(co + (size_t)j * CONVDIM + c8) = (f32x4){f[0], f[1], f[2], f[3]}; *(f32x4*)(co + (size_t)j * CONVDIM + c8 + 4) = (f32x4){f[4], f[5], f[6], f[7]}; }
    float* so = F.out + (smp ? O_SCS : O_SCP) + ((size_t)layer * nb_ + sg) * 2 * D;
    for (int i = tid; i < 2 * 128; i += NTHREADS) { const int j = i >> 7, c8 = (i & 127) * 8; float c[8], h[8]; const bf16_t* hp = H + (row0 + len - 2 + j) * DINP;
        unpack8(*(const u32x4*)(hp + C_SCC + c8), c); unpack8(*(const u32x4*)(hp + C_SCH + c8), h);
        *(f32x4*)(so + (size_t)j * D + c8) = (f32x4){c[0] * h[0], c[1] * h[1], c[2] * h[2], c[3] * h[3]}; *(f32x4*)(so + (size_t)j * D + c8 + 4) = (f32x4){c[4] * h[4], c[5] * h[5], c[6] * h[6], c[7] * h[7]}; }
}
#ifndef MIX_MASK
#define MIX_MASK 0xFF
#endif
#define MIXON(b) ((MIX_MASK >> (b)) & 1)
__device__ __forceinline__ void step_mixers(const Frame& F, int layer, int mb) {
    const int n_ssd = NSEQ_MB * 32, n_att = NSEQ_MB * NCHUNK * NKV, n_sc = rows_of(mb) / 64, n_so = NSEQ_MB + (mb == 0 ? DECB : 0);
    const int n_ss = mb == 0 ? DECB * 32 : 0, n_as = mb == 0 ? DECB * NKV : 0;
    const int total = n_ssd + n_att + n_sc + n_so + n_ss + n_as;
    for (int un = F.bid; un < total; un += F.G) { int r = un;
#define UF(Fu) Frame Fu = F; Fu.tid = opq(F.tid); Fu.lane = Fu.tid & 63; Fu.wave = __builtin_amdgcn_readfirstlane(Fu.tid >> 6)
        if (r < n_ssd) { PROBE_T0(12) if constexpr (MIXON(0)) { UF(Fu); ssd_prompt_unit(Fu, layer, mb, r >> 5, r & 31); } PROBE_T1(12) continue; } r -= n_ssd;
        if (r < n_att) { if constexpr (MIXON(1)) { UF(Fu); attn_prompt_unit(Fu, layer, r / (NCHUNK * NKV), (r / NKV) % NCHUNK, r % NKV); } continue; } r -= n_att;
        if (r < n_sc) { if constexpr (MIXON(2)) { UF(Fu); sc_unit(Fu, layer, r); } continue; } r -= n_sc;
        if (r < n_so) { if constexpr (MIXON(3)) { UF(Fu); state_out_unit(Fu, layer, mb, r < NSEQ_MB ? r : r - NSEQ_MB, r >= NSEQ_MB); } continue; } r -= n_so;
        if (r < n_ss) { if constexpr (MIXON(4)) { UF(Fu); ssd_sample_unit(Fu, layer, r >> 5, r & 31); } continue; } r -= n_ss;
        if constexpr (MIXON(5)) { UF(Fu); attn_sample_unit(Fu, layer, r >> 2, r & 3); }
    }
}
__device__ __forceinline__ void step_gnorm(const Frame& F, int mb) {
    const int gw = F.bid * NWAVES + F.wave, NGW = F.G * NWAVES, nr = rows_of(mb); bf16_t* H = ws_bf(F, WS_H); const float* ssq = ws_f(F, WS_SSQ);
    for (int r = gw; r < nr; r += NGW) { const int g = F.lane >> 3; const f32x4 q = *(const f32x4*)(ssq + (size_t)r * 32 + 4 * g);
        const float rstd = 1.0f / sqrtf(((q[0] + q[1]) + (q[2] + q[3])) * (1.0f / 256.0f) + LN_EPS);
        u32x4* p = (u32x4*)(H + (size_t)r * DINP + C_Z + 32 * F.lane);
#pragma unroll
        for (int j = 0; j < 4; ++j) { float f[8]; unpack8(p[j], f);
#pragma unroll
            for (int i = 0; i < 8; ++i) f[i] *= rstd;
            p[j] = pack8(f); } }
}
constexpr int LOG_NEXP = NEXP == 32 ? 5 : (NEXP == 16 ? 4 : (NEXP == 8 ? 3 : 2));
template <int N, int MASK> struct RedStep {
    static __device__ __forceinline__ void run(float* v, int lane) {
        constexpr int Hn = N / 2; const bool up = (lane & MASK) != 0;
#pragma unroll
        for (int i = 0; i < Hn; ++i) { const float keep = up ? v[i + Hn] : v[i], send = up ? v[i] : v[i + Hn]; v[i] = keep + __shfl_xor(send, MASK); }
        if constexpr (Hn > 1) RedStep<Hn, (MASK >> 1)>::run(v, lane);
    }
};
__device__ __forceinline__ void step_ln1_router(const Frame& F, int layer, int mb) {
    LAS float* wT = (LAS float*)F.lds;
    const float* rw = F.in[I_RW] + (size_t)layer * D * NEXP;
    __syncthreads();
    for (int i = F.tid; i < D * NEXP; i += NTHREADS) { const int k = i / NEXP, e = i % NEXP; wT[e * D + k] = rw[i]; }
    __syncthreads();
    const int gw = F.bid * NWAVES + F.wave, NGW = F.G * NWAVES, nr = rows_of(mb), lane = F.lane;
    const float* lg = F.in[I_LN1G] + (size_t)layer * D; const float* lb = F.in[I_LN1B] + (size_t)layer * D; const float* rb = F.in[I_RB] + (size_t)layer * NEXP;
    unsigned* cnt = F.ctl + CW_CNT + (mb * DEPTH + layer) * 64;
    LAS unsigned* lcnt = (LAS unsigned*)(F.lds + MISC_OFF) + 128;
    if (F.tid < 64) lcnt[F.tid] = 0u;
    __syncthreads();
    bf16_t* XB = ws_bf(F, WS_XB); int* topi = (int*)(F.ws + WS_TOPI); float* gate = ws_f(F, WS_GATE); int* pos = (int*)(F.ws + WS_POS);
    for (int r = gw; r < nr; r += NGW) {
        float* xr = x_out_row(F, mb, r); f32x4 v[4]; float s = 0.f;
#pragma unroll
        for (int j = 0; j < 4; ++j) { v[j] = *((const f32x4*)xr + lane + 64 * j); s += (v[j][0] + v[j][1]) + (v[j][2] + v[j][3]); }
        const float mean = wave_sum(s) * (1.0f / D); float s2 = 0.f;
#pragma unroll
        for (int j = 0; j < 4; ++j) { v[j] = v[j] - mean; s2 += (v[j][0] * v[j][0] + v[j][1] * v[j][1]) + (v[j][2] * v[j][2] + v[j][3] * v[j][3]); }
        const float rstd = 1.0f / sqrtf(wave_sum(s2) * (1.0f / D) + LN_EPS);
#pragma unroll
        for (int j = 0; j < 4; ++j) { const f32x4 gg = *((const f32x4*)lg + lane + 64 * j), bb = *((const f32x4*)lb + lane + 64 * j); v[j] = v[j] * rstd * gg + bb;
            *((f32x4*)xr + lane + 64 * j) = v[j]; u32x2 w; w.x = pk2(v[j][0], v[j][1]); w.y = pk2(v[j][2], v[j][3]); *((u32x2*)(XB + (size_t)r * D) + lane + 64 * j) = w; }
        float lgt[NEXP];
#pragma unroll
        for (int e = 0; e < NEXP; ++e) { float a = 0.f;
#pragma unroll
            for (int j = 0; j < 4; ++j) { const f32x4 wv = *((const LAS f32x4*)(wT + e * D) + lane + 64 * j); a += (v[j][0] * wv[0] + v[j][1] * wv[1]) + (v[j][2] * wv[2] + v[j][3] * wv[3]); }
            lgt[e] = a; if ((e & 1) == 1) asm volatile("" ::: "memory"); }
        RedStep<NEXP, 32>::run(lgt, lane);
        float tot = lgt[0];
#pragma unroll
        for (int mk = (32 >> LOG_NEXP); mk >= 1; mk >>= 1) tot += __shfl_xor(tot, mk);
        const int myexp = lane >> (6 - LOG_NEXP);
        float val = tot + rb[myexp];
        float tv[4]; int te[4];
#pragma unroll
        for (int k = 0; k < 4; ++k) { float bv = val; int be = myexp;
#pragma unroll
            for (int o = 1; o < 64; o <<= 1) { const float ov = __shfl_xor(bv, o); const int oe = __shfl_xor(be, o); if (ov > bv || (ov == bv && oe < be)) { bv = ov; be = oe; } }
            tv[k] = bv; te[k] = be; if (myexp == be) val = -3.0e38f; }
        const float e1 = expf(tv[1] - tv[0]), e2 = expf(tv[2] - tv[0]), e3 = expf(tv[3] - tv[0]); const float inv = 1.0f / (1.0f + e1 + e2 + e3);
        if (lane < 4) { const int e = lane == 0 ? te[0] : (lane == 1 ? te[1] : (lane == 2 ? te[2] : te[3])); const float gv = (lane == 0 ? 1.0f : (lane == 1 ? e1 : (lane == 2 ? e2 : e3))) * inv;
            const unsigned rk = __hip_atomic_fetch_add(lcnt + e, 1u, __ATOMIC_RELAXED, __HIP_MEMORY_SCOPE_WORKGROUP);
            topi[(size_t)r * 4 + lane] = e; gate[(size_t)r * 4 + lane] = gv; pos[(size_t)r * 4 + lane] = (int)rk; }
    }
    __syncthreads();
    if (F.tid < NEXP) lcnt[32 + F.tid] = __hip_atomic_fetch_add(cnt + F.tid, lcnt[F.tid], __ATOMIC_RELAXED, __HIP_MEMORY_SCOPE_AGENT);
    __syncthreads();
    for (int r = gw; r < nr; r += NGW) if (lane < 4) pos[(size_t)r * 4 + lane] += (int)lcnt[32 + topi[(size_t)r * 4 + lane]];
}
__device__ __forceinline__ int moe_table(const Frame& F, int layer, int mb) {
    LAS int* M = (LAS int*)(F.lds + MISC_OFF);
    __syncthreads();
    if (F.tid == 0) { unsigned* cnt = F.ctl + CW_CNT + (mb * DEPTH + layer) * 64; int acc = 0;
        for (int e = 0; e < NEXP; ++e) { const int c = (int)__hip_atomic_load(cnt + e, __ATOMIC_RELAXED, __HIP_MEMORY_SCOPE_AGENT); M[64 + e] = acc * 256; acc += (c + 255) / 256; M[16 + e] = acc; } }
    __syncthreads();
    return M[16 + NEXP - 1];
}
__device__ __forceinline__ void step_gather(const Frame& F, int layer, int mb) {
    (void)moe_table(F, layer, mb); const LAS int* M = (const LAS int*)(F.lds + MISC_OFF);
    const int gw = F.bid * NWAVES + F.wave, NGW = F.G * NWAVES, nr = rows_of(mb), lane = F.lane;
    const bf16_t* XB = ws_bf(F, WS_XB); bf16_t* XS = ws_bf(F, WS_H); const int* topi = (const int*)(F.ws + WS_TOPI); const float* gate = ws_f(F, WS_GATE); int* pos = (int*)(F.ws + WS_POS); float* gs = ws_f(F, WS_GSORT);
    for (int r = gw; r < nr; r += NGW) {
        const u32x4 a = *((const u32x4*)(XB + (size_t)r * D) + lane), b = *((const u32x4*)(XB + (size_t)r * D) + 64 + lane);
        int pk[4];
#pragma unroll
        for (int k = 0; k < 4; ++k) { const int e = topi[(size_t)r * 4 + k]; pk[k] = M[64 + e] + pos[(size_t)r * 4 + k]; }
        WAVE_SYNC();
#pragma unroll
        for (int k = 0; k < 4; ++k) { const int p = pk[k];
            *((u32x4*)(XS + (size_t)p * D) + lane) = a; *((u32x4*)(XS + (size_t)p * D) + 64 + lane) = b;
            if (lane == k) { pos[(size_t)r * 4 + k] = p; gs[p] = gate[(size_t)r * 4 + k]; } }
    }
}
__device__ __forceinline__ void step_ln2(const Frame& F, int layer, int mb) {
    const int gw = F.bid * NWAVES + F.wave, NGW = F.G * NWAVES, nr = rows_of(mb), lane = F.lane;
    const float* lg = F.in[I_LN2G] + (size_t)layer * D; const float* lb = F.in[I_LN2B] + (size_t)layer * D;
    const bf16_t* OUTS = ws_bf(F, WS_H) + (size_t)2 * RP * D; const int* pos = (const int*)(F.ws + WS_POS); bf16_t* XB = ws_bf(F, WS_XB);
    for (int r = gw; r < nr; r += NGW) {
        float* xr = x_out_row(F, mb, r); f32x4 v[4]; float s = 0.f; int p[4];
#pragma unroll
        for (int k = 0; k < 4; ++k) p[k] = pos[(size_t)r * 4 + k];
#pragma unroll
        for (int j = 0; j < 4; ++j) { v[j] = *((const f32x4*)xr + lane + 64 * j) * ALPHA;
#pragma unroll
            for (int k = 0; k < 4; ++k) { const u32x2 w = *((const u32x2*)(OUTS + (size_t)p[k] * D) + lane + 64 * j); v[j] = v[j] + (f32x4){blo(w.x), bhi(w.x), blo(w.y), bhi(w.y)}; }
            s += (v[j][0] + v[j][1]) + (v[j][2] + v[j][3]); }
        const float mean = wave_sum(s) * (1.0f / D); float s2 = 0.f;
#pragma unroll
        for (int j = 0; j < 4; ++j) { v[j] = v[j] - mean; s2 += (v[j][0] * v[j][0] + v[j][1] * v[j][1]) + (v[j][2] * v[j][2] + v[j][3] * v[j][3]); }
        const float rstd = 1.0f / sqrtf(wave_sum(s2) * (1.0f / D) + LN_EPS);
#pragma unroll
        for (int j = 0; j < 4; ++j) { const f32x4 gg = *((const f32x4*)lg + lane + 64 * j), bb = *((const f32x4*)lb + lane + 64 * j); v[j] = v[j] * rstd * gg + bb;
            *((f32x4*)xr + lane + 64 * j) = v[j]; u32x2 w; w.x = pk2(v[j][0], v[j][1]); w.y = pk2(v[j][2], v[j][3]); *((u32x2*)(XB + (size_t)r * D) + lane + 64 * j) = w; }
    }
}

constexpr int PH_PER = 11, NSTEPS = 1 + NMB * DEPTH * PH_PER;
__global__ void __launch_bounds__(NTHREADS, 2) fwd(Args args) {
#ifdef EMU
    unsigned char* lds = emu_wg->lds;
#else
    extern __shared__ __attribute__((aligned(16))) unsigned char lds[];
#endif
    Frame F0; F0.lds = (LAS unsigned char*)lds; F0.tid = threadIdx.x; F0.lane = F0.tid & 63; F0.wave = __builtin_amdgcn_readfirstlane(F0.tid >> 6); F0.G = gridDim.x; F0.bid = blockIdx.x;
#ifdef EMU
    F0.in = args.in;
#else
    F0.in = (ArgTab)__builtin_amdgcn_kernarg_segment_ptr();
    static_assert(offsetof(Args, out) == 248 && offsetof(Args, ws) == 256 && offsetof(Args, in) == 0, "PF() reads the argument struct by offset");
#endif
    F0.out = args.out; F0.ws = args.ws; F0.ctl = (unsigned*)(args.ws + WS_CTL);
    const Frame& F = F0;
    const int lo = args.lo, hi = args.hi;
#ifndef EMU
    for (int u = F.tid; u < (LDS_BYTES - RING_BYTES) / 4; u += NTHREADS) ((LAS unsigned*)(F.lds + RING_BYTES))[u] = 0u;
    __syncthreads();
    XcdBarrier bar; bar.bar = F.ctl + CW_BAR; bar.x = 0; bar.st = nullptr;
    if (hi - lo > 1) bar = xcd_barrier_post(F.ctl + CW_BAR, (volatile LAS unsigned*)(F.lds + MISC_OFF) + 8);
#define SEAM(s) do { if ((s) + 1 < hi) xcd_barrier(bar); } while (0)
#else
#define SEAM(s) do { } while (0)
#endif
#ifndef PH_MASK
#define PH_MASK 0xFFFFFFFF
#endif
#define IN(s) (lo <= (s) && (s) < hi)
#define PHON(b) ((PH_MASK >> (b)) & 1)
#ifdef EMU
#define PF(Fp) Frame Fp = F0
#else
#define PF(Fp) Frame Fp; { unsigned long long kp_ = (unsigned long long)__builtin_amdgcn_kernarg_segment_ptr(); asm volatile("" : "+s"(kp_)); \
    Fp.in = (ArgTab)kp_; Fp.out = *(float* const __attribute__((address_space(4)))*)(kp_ + 248); Fp.ws = *(unsigned char* const __attribute__((address_space(4)))*)(kp_ + 256); Fp.ctl = (unsigned*)Fp.ws; \
    Fp.lds = F0.lds; Fp.G = F0.G; Fp.bid = F0.bid; Fp.tid = opq(F0.tid); Fp.lane = Fp.tid & 63; Fp.wave = __builtin_amdgcn_readfirstlane(Fp.tid >> 6); }
#endif
    int step = 0;
    if (IN(step)) { PROBE_T0(0) if constexpr (PHON(0)) { PF(F); step_weights(F); } PROBE_T1(0) SEAM(step); }
    ++step;
    for (int mb = 0; mb < NMB; ++mb)
        for (int layer = 0; layer < DEPTH; ++layer) {
            const int nr = rows_of(mb);
            if (IN(step)) { PROBE_T0(1) if constexpr (PHON(1)) { PF(F); if (layer == 0) step_xb(F, mb); } PROBE_T1(1) SEAM(step); }
            ++step;
            if (IN(step)) { PROBE_T0(2) if constexpr (PHON(2)) { PF(F); pg8::Gemm g{ws_bf(F, WS_XB), wl_ptr(F, layer, WL_IN), nr, DINP, D, D}; pg8::StaticOrder S; S.init(nr, DINP, F.G, F.bid);
                pg8::EpiStoreBf16 E{ws_bf(F, WS_H), DINP}; pg8::gemm_phase(F.lds, g, S, E); } PROBE_T1(2) SEAM(step); }
            ++step;
            if (IN(step)) { PROBE_T0(3) if constexpr (PHON(3)) { PF(F); step_mixers(F, layer, mb); } PROBE_T1(3) SEAM(step); }
            ++step;
            if (IN(step)) { PROBE_T0(4) if constexpr (PHON(4)) { PF(F); step_gnorm(F, mb); } PROBE_T1(4) SEAM(step); }
            ++step;
            if (IN(step)) { PROBE_T0(5) if constexpr (PHON(5)) { PF(F); pg8::StaticOrder S; S.init(nr, D, F.G, F.bid); bf16_t* H = ws_bf(F, WS_H); bf16_t* MGb = ws_bf(F, WS_XB);
#ifndef MERGE_MASK
#define MERGE_MASK 7
#endif
                if constexpr (MERGE_MASK & 1) { pg8::Gemm g{H + C_Z, wl_ptr(F, layer, WL_SSD), nr, D, DINNER, DINP}; pg8::EpiGate<0> E{H + C_GSSD, MGb}; pg8::gemm_phase(F.lds, g, S, E); }
                if constexpr (MERGE_MASK & 2) { pg8::Gemm g{H + C_Q, wl_ptr(F, layer, WL_ATT), nr, D, D, DINP}; pg8::EpiGate<1> E{H + C_GATT, MGb}; pg8::gemm_phase(F.lds, g, S, E); }
                if constexpr (MERGE_MASK & 4) { pg8::Gemm g{H + C_SCB, wl_ptr(F, layer, WL_SC), nr, D, D, DINP}; pg8::EpiGate<1> E{H + C_GSC, MGb}; pg8::gemm_phase(F.lds, g, S, E); } }
                PROBE_T1(5) SEAM(step); }
            ++step;
            if (IN(step)) { PROBE_T0(6) if constexpr (PHON(6)) { PF(F); pg8::Gemm g{ws_bf(F, WS_XB), wl_ptr(F, layer, WL_O), nr, D, D, D}; pg8::StaticOrder S; S.init(nr, D, F.G, F.bid);
                pg8::EpiResid E{layer == 0 ? F.in[I_XP] + (size_t)mb * NP * D : F.out + O_YP + (size_t)mb * NP * D, layer == 0 ? F.in[I_XS] : F.out + O_YS, F.out + O_YP + (size_t)mb * NP * D, F.out + O_YS};
                pg8::gemm_phase(F.lds, g, S, E); } PROBE_T1(6) SEAM(step); }
            ++step;
            if (IN(step)) { PROBE_T0(7) if constexpr (PHON(7)) { PF(F); step_ln1_router(F, layer, mb); } PROBE_T1(7) SEAM(step); }
            ++step;
            if (IN(step)) { PROBE_T0(8) if constexpr (PHON(8)) { PF(F); step_gather(F, layer, mb); } PROBE_T1(8) SEAM(step); }
            ++step;
            if (IN(step)) { PROBE_T0(9) if constexpr (PHON(9)) { PF(F); const int nt = moe_table(F, layer, mb); pg8::MoeOrder S{(const LAS int*)(F.lds + MISC_OFF) + 16, 8, nt * 8, F.G, F.bid};
                pg8::Gemm g{ws_bf(F, WS_H), wl_ptr(F, layer, WL_UP), nt * 256, 2048, D, D}; pg8::EpiSwiglu E{ws_bf(F, WS_H) + (size_t)RP * D, F.in[I_BUP] + (size_t)layer * NEXP * 2048};
                pg8::gemm_phase(F.lds, g, S, E); } PROBE_T1(9) SEAM(step); }
            ++step;
            if (IN(step)) { PROBE_T0(10) if constexpr (PHON(10)) { PF(F); const int nt = moe_table(F, layer, mb); pg8::MoeOrder S{(const LAS int*)(F.lds + MISC_OFF) + 16, 4, nt * 4, F.G, F.bid};
                pg8::Gemm g{ws_bf(F, WS_H) + (size_t)RP * D, wl_ptr(F, layer, WL_DN), nt * 256, D, D, D}; pg8::EpiDown E{ws_bf(F, WS_H) + (size_t)2 * RP * D, F.in[I_BDN] + (size_t)layer * NEXP * D, ws_f(F, WS_GSORT)};
                pg8::gemm_phase(F.lds, g, S, E); } PROBE_T1(10) SEAM(step); }
            ++step;
            if (IN(step)) { PROBE_T0(11) if constexpr (PHON(11)) { PF(F); step_ln2(F, layer, mb); } PROBE_T1(11) SEAM(step); }
            ++step;
        }
}

#ifdef EMU
extern int emu_grid, emu_step_lo, emu_step_hi;
#endif
extern "C" void kernel_launch(void* const* d_in, const int* in_sizes, int n_in, void* d_out, int out_size, void* d_ws, size_t ws_size, hipStream_t stream) {
    (void)in_sizes; (void)out_size;
    if (n_in != 31 || ws_size < WS_END) { fprintf(stderr, "kernel_launch: expected 31 inputs and >= %zu bytes of workspace (got %d, %zu)\n", (size_t)WS_END, n_in, ws_size); return; }
    Args a; memset(&a, 0, sizeof(a));
    for (int i = 0; i < 31; ++i) a.in[i] = (const float*)d_in[i];
    a.out = (float*)d_out; a.ws = (unsigned char*)d_ws;
#ifdef EMU
    if (emu_step_lo == 0) memset((char*)d_ws + WS_CTL, 0, CTL_BYTES);
    for (int s = emu_step_lo; s < emu_step_hi && s < NSTEPS; ++s) { a.lo = s; a.hi = s + 1; emu_launch(fwd, emu_grid, NTHREADS, LDS_BYTES, a); fprintf(stderr, "step %d done\n", s); }
#else
    (void)hipMemsetAsync((char*)d_ws + WS_CTL, 0, CTL_BYTES, stream);
    static int grid = 0;
    if (grid == 0) {
        int dev = 0, cus = 0;
        if (hipGetDevice(&dev) != hipSuccess || hipDeviceGetAttribute(&cus, hipDeviceAttributeMultiprocessorCount, dev) != hipSuccess) { grid = -1; return; }
        if (hipFuncSetAttribute((const void*)fwd, hipFuncAttributeMaxDynamicSharedMemorySize, LDS_BYTES) != hipSuccess) { grid = -1; return; }
        int per_cu = 0; (void)hipOccupancyMaxActiveBlocksPerMultiprocessor(&per_cu, (const void*)fwd, NTHREADS, LDS_BYTES); (void)hipGetLastError();
        grid = cus;
    }
    if (grid < 0) return;
#if CFG_ONE_LAUNCH
    a.lo = 0; a.hi = NSTEPS; hipLaunchKernelGGL(fwd, dim3(grid), dim3(NTHREADS), LDS_BYTES, stream, a);
#else
    for (int s = 0; s < NSTEPS; ++s) { a.lo = s; a.hi = s + 1; hipLaunchKernelGGL(fwd, dim3(grid), dim3(NTHREADS), LDS_BYTES, stream, a); }
#endif
#endif
}
```

```cpp
#ifdef EMU
#include "emu.h"
#else
#include <hip/hip_runtime.h>
#endif
#include <cstdio>
#include <cstdint>
#include <cstring>
#include <cstddef>
#include <cmath>

#ifndef CFG_BATCH
#define CFG_BATCH 16
#endif
#ifndef CFG_SEQ
#define CFG_SEQ 4096
#endif
#ifndef CFG_NSEQ_MB
#define CFG_NSEQ_MB 8
#endif
#ifndef CFG_NEXP
#define CFG_NEXP 32
#endif
#ifndef CFG_ONE_LAUNCH
#define CFG_ONE_LAUNCH 1
#endif

constexpr int BATCH = CFG_BATCH, SEQ = CFG_SEQ, NSEQ_MB = CFG_NSEQ_MB, NEXP = CFG_NEXP, NMB = BATCH / NSEQ_MB;
constexpr int D = 1024, DEPTH = 2, DECB = 16, DECS = 16, NS = DECB * DECS;
constexpr int DINNER = 2048, CONVDIM = 4096;
constexpr int NKV = 4, WINDOW = 128, CHUNK = 64;
constexpr int DIN = 13856, DINP = 14080;
constexpr int NP = NSEQ_MB * SEQ, R = NP + NS;
constexpr int RP = ((4 * R + NEXP * 255) + 255) / 256 * 256;
constexpr int NCHUNK = SEQ / CHUNK;
constexpr int C_Z = 0, C_X = 2048, C_B = 4096, C_C = 5120, C_Q = 6144, C_K = 7168, C_V = 7424, C_SCB = 7680, C_SCC = 8704, C_SCH = 9728, C_GSSD = 10752, C_GATT = 11776, C_GSC = 12800, C_DT = 13824;
constexpr float LN_EPS = 1e-5f, ALPHA = 1.41421356237309515f  , SW_LIMIT = 7.0f, SW_ALPHA = 1.702f;
static_assert(BATCH % NSEQ_MB == 0 && SEQ % 256 == 0 && (NEXP & (NEXP - 1)) == 0 && NEXP <= 32 && NEXP >= 4, "config");

constexpr size_t O_YP = 0, O_YS = O_YP + (size_t)BATCH * SEQ * D, O_KP = O_YS + (size_t)NS * D, O_VP = O_KP + (size_t)DEPTH * BATCH * WINDOW * 256,
    O_SSP = O_VP + (size_t)DEPTH * BATCH * WINDOW * 256, O_CVP = O_SSP + (size_t)DEPTH * BATCH * 32 * 64 * 128, O_SCP = O_CVP + (size_t)DEPTH * BATCH * 3 * CONVDIM,
    O_KS = O_SCP + (size_t)DEPTH * BATCH * 2 * D, O_VS = O_KS + (size_t)DEPTH * DECB * DECS * 256, O_SSS = O_VS + (size_t)DEPTH * DECB * DECS * 256,
    O_CVS = O_SSS + (size_t)DEPTH * DECB * 32 * 64 * 128, O_SCS = O_CVS + (size_t)DEPTH * DECB * 3 * CONVDIM, O_END = O_SCS + (size_t)DEPTH * DECB * 2 * D;

constexpr size_t al256(size_t x) { return (x + 255) / 256 * 256; }
constexpr size_t WS_CTL = 0, CTL_BYTES = 1u << 20;
constexpr size_t WS_SSQ = CTL_BYTES, WS_TOPI = WS_SSQ + al256((size_t)R * 32 * 4), WS_GATE = WS_TOPI + al256((size_t)R * 16), WS_POS = WS_GATE + al256((size_t)R * 16),
    WS_GSORT = WS_POS + al256((size_t)R * 16), WS_W = WS_GSORT + al256((size_t)RP * 4);
constexpr size_t WL_IN = 0, WL_SSD = WL_IN + (size_t)DINP * D * 2, WL_ATT = WL_SSD + (size_t)D * DINNER * 2, WL_SC = WL_ATT + (size_t)D * D * 2, WL_O = WL_SC + (size_t)D * D * 2,
    WL_UP = WL_O + (size_t)D * D * 2, WL_DN = WL_UP + (size_t)NEXP * 2048 * D * 2, WL_BYTES = WL_DN + (size_t)NEXP * D * D * 2;
constexpr size_t WS_XB = WS_W + DEPTH * WL_BYTES, WS_H = WS_XB + (size_t)R * D * 2;
constexpr size_t H_BYTES = (size_t)R * DINP * 2, MOE_BYTES = (size_t)3 * RP * D * 2, U_BYTES = H_BYTES > MOE_BYTES ? H_BYTES : MOE_BYTES;
constexpr size_t WS_END = WS_H + U_BYTES;
static_assert(WS_END <= ((size_t)2 << 30), "workspace map exceeds 2 GiB");
constexpr int CW_BAR = 4096, CW_CNT = 16384;

constexpr int RING_BYTES = 131072, LDS_BYTES = 147456, MISC_OFF = LDS_BYTES - 1024, SCR_BYTES = MISC_OFF;
constexpr int NWAVES = 8, NTHREADS = 512;

#ifdef EMU
#define LAS
#define WAVE_SYNC() emu_wave_barrier()
#else
#define LAS __attribute__((address_space(3)))
#define WAVE_SYNC() asm volatile("s_waitcnt lgkmcnt(0)" ::: "memory")
#endif
#ifdef EMU
#define LBAR() emu_wg_barrier()
#define VM_WAIT(n) do { } while (0)
#else
#define LBAR() do { asm volatile("s_waitcnt lgkmcnt(0)" ::: "memory"); __builtin_amdgcn_s_barrier(); asm volatile("" ::: "memory"); } while (0)
#define VM_WAIT(n) asm volatile("s_waitcnt vmcnt(" #n ")" ::: "memory")
#endif
typedef unsigned short bf16_t;
typedef short bf16x8 __attribute__((ext_vector_type(8)));
typedef float f32x4 __attribute__((ext_vector_type(4)));
typedef float f32x16 __attribute__((ext_vector_type(16)));
typedef unsigned u32x4 __attribute__((ext_vector_type(4)));
typedef unsigned u32x2 __attribute__((ext_vector_type(2)));

__device__ __forceinline__ unsigned f2bf(float f) { unsigned u = __builtin_bit_cast(unsigned, f); return (u + 0x7fffu + ((u >> 16) & 1u)) >> 16; }
__device__ __forceinline__ float bf2f(unsigned h) { return __builtin_bit_cast(float, (h & 0xffffu) << 16); }
#ifdef EMU
__device__ __forceinline__ unsigned pk2(float lo, float hi) { return f2bf(lo) | (f2bf(hi) << 16); }
#else
typedef float f32x2_t __attribute__((ext_vector_type(2))); typedef __bf16 bf16x2_t __attribute__((ext_vector_type(2)));
__device__ __forceinline__ unsigned pk2(float lo, float hi) { f32x2_t v = {lo, hi}; bf16x2_t b = __builtin_convertvector(v, bf16x2_t); return __builtin_bit_cast(unsigned, b); }
#endif
__device__ __forceinline__ float blo(unsigned w) { return __builtin_bit_cast(float, w << 16); }
__device__ __forceinline__ float bhi(unsigned w) { return __builtin_bit_cast(float, w & 0xffff0000u); }
__device__ __forceinline__ void unpack8(const u32x4 w, float* f) { f[0] = blo(w.x); f[1] = bhi(w.x); f[2] = blo(w.y); f[3] = bhi(w.y); f[4] = blo(w.z); f[5] = bhi(w.z); f[6] = blo(w.w); f[7] = bhi(w.w); }
__device__ __forceinline__ u32x4 pack8(const float* f) { u32x4 w; w.x = pk2(f[0], f[1]); w.y = pk2(f[2], f[3]); w.z = pk2(f[4], f[5]); w.w = pk2(f[6], f[7]); return w; }
__device__ __forceinline__ float fexp(float x) { return __builtin_amdgcn_exp2f(x * 1.4426950408889634f); }
__device__ __forceinline__ float fsigmoid(float x) { return __builtin_amdgcn_rcpf(1.0f + __builtin_amdgcn_exp2f(-1.4426950408889634f * x)); }
__device__ __forceinline__ float fsilu(float x) { return x * fsigmoid(x); }
#ifdef EMU
__device__ __forceinline__ int opq(int x) { return x; }
#else
__device__ __forceinline__ int opq(int x) { asm volatile("" : "+v"(x)); return x; }
#endif
__device__ __forceinline__ float wave_sum(float v) {
#pragma unroll
    for (int o = 1; o < 64; o <<= 1) v += __shfl_xor(v, o);
    return v;
}

#ifndef PROBE_MASK
#define PROBE_MASK 0
#endif
#if PROBE_MASK && !defined(EMU)
#define PROBE_T0(b) unsigned long long pt0_ = 0; if constexpr ((PROBE_MASK >> (b)) & 1) pt0_ = __builtin_amdgcn_s_memrealtime();
#define PROBE_T1(b) if constexpr ((PROBE_MASK >> (b)) & 1) { asm volatile("s_waitcnt vmcnt(0) lgkmcnt(0)" ::: "memory"); const unsigned long long pt1_ = __builtin_amdgcn_s_memrealtime(); \
    while (__builtin_amdgcn_s_memrealtime() < pt1_ + (pt1_ - pt0_)) __builtin_amdgcn_s_sleep(8); }
#else
#define PROBE_T0(b)
#define PROBE_T1(b)
#endif
namespace pg8 {
constexpr int BM = 256, BK = 64, HALF = 128, HTB = HALF * BK * 2, NXCD = 8, WGM = 8;
struct Unit { int pm, pn, bt, e; };
struct Gemm { const bf16_t* A; const bf16_t* Bt; int M, N, K, lda; };
struct StaticOrder {
    int nM, nN, nwg, G, c;
    __host__ __device__ void init(int M, int N, int G_, int c_) { nM = M / BM; nN = N / BM; nwg = nM * nN; G = G_; c = c_; }
    __host__ __device__ bool next(int i, Unit& u) const {
        const long L = (long)i * G + c; if (L >= nwg) return false;
        int wgid = (int)L; { const int q = nwg / NXCD, r = nwg % NXCD, xcd = wgid % NXCD, off = wgid / NXCD; wgid = (xcd < r ? xcd * (q + 1) : r * (q + 1) + (xcd - r) * q) + off; }
        const int nig = WGM * nN, gid = wgid / nig, fm = gid * WGM, gsz = (nM - fm) < WGM ? (nM - fm) : WGM;
        u.pm = fm + ((wgid % nig) % gsz); u.pn = (wgid % nig) / gsz; u.bt = u.pn; u.e = 0; return true;
    }
    __device__ __forceinline__ void a_ready(const Unit&) const {}
    __device__ __forceinline__ void done(const Unit&) const {}
};
struct MoeOrder {
    const LAS int* tend; int npn, ntot, G, c;
    __device__ __forceinline__ bool next(int i, Unit& u) const {
        const long L = (long)i * G + c; if (L >= ntot) return false;
        const int rt = (int)L / npn, pn = (int)L % npn; int e = 0;
#pragma unroll
        for (int j = 0; j < NEXP; ++j) e += (tend[j] <= rt) ? 1 : 0;
        u.pm = rt; u.pn = pn; u.e = e; u.bt = e * npn + pn; return true;
    }
    __device__ __forceinline__ void a_ready(const Unit&) const {}
    __device__ __forceinline__ void done(const Unit&) const {}
};
#ifdef EMU
template <class Epi, class Sched>
__device__ void gemm_phase(LAS unsigned char* lds, const Gemm g, const Sched& S, const Epi& E) {
    const int tid = threadIdx.x, wid = tid >> 6, lane = tid & 63, wr = wid >> 2, wc = wid & 3, fr = lane & 15, fq = lane >> 4;
    Unit u;
    for (int i = 0; S.next(i, u); ++i) {
        f32x4 acc[2][2][4][2];
        for (int ai = 0; ai < 2; ++ai) for (int bj = 0; bj < 2; ++bj) for (int m = 0; m < 4; ++m) for (int n = 0; n < 2; ++n) for (int q = 0; q < 4; ++q) {
            const int row = u.pm * 256 + ai * 128 + wr * 64 + m * 16 + fr, col = u.bt * 256 + bj * 128 + wc * 32 + 8 * fq + 4 * n + q;
            const bf16_t* a = g.A + (size_t)row * g.lda; const bf16_t* b = g.Bt + (size_t)col * g.K; float s = 0.f;
            for (int k = 0; k < g.K; ++k) s += bf2f(a[k]) * bf2f(b[k]);
            acc[ai][bj][m][n][q] = s; }
        E(acc, u, wr, wc, fr, fq);
    }
    __syncthreads();
}
#else
#define PG8_LAS __attribute__((address_space(3)))
__host__ __device__ __forceinline__ int lds_byte(int r, int c) { const int st = (r >> 4) * 2 + (c >> 5), rr = r & 15, cc = c & 31, ob = rr * 64 + cc * 2; return st * 1024 + (ob ^ (((ob >> 9) & 1) << 5)); }
__host__ __device__ __forceinline__ void stage_rc(int b, int& R_, int& C_) { const int st = b / 1024, sb = b % 1024, swz = sb ^ (((sb >> 9) & 1) << 5); R_ = (st >> 1) * 16 + swz / 64; C_ = (st & 1) * 32 + (swz % 64) / 2; }
__host__ __device__ __forceinline__ int perm32(int rho) { const int n = rho >> 4, i = rho & 15; return 8 * (i >> 2) + 4 * n + (i & 3); }
template <class Epi, class Sched>
__device__ __forceinline__ void gemm_phase(PG8_LAS unsigned char* lds, const Gemm g, const Sched& S, const Epi& E) {
    const int tid = opq((int)threadIdx.x), wid = __builtin_amdgcn_readfirstlane(tid >> 6), lane = tid & 63, wr = wid >> 2, wc = wid & 3, fr = lane & 15, fq = lane >> 4;
    const int K = g.K, nt = K / BK, lda = g.lda;
    unsigned voffA[2], voffB[2];
#pragma unroll
    for (int i = 0; i < 2; ++i) { int R_, C_; stage_rc(tid * 16 + i * 8192, R_, C_); const int Rb = (R_ & ~31) + perm32(R_ & 31);
        voffA[i] = (unsigned)(R_ * lda + C_) * 2u; voffB[i] = (unsigned)(Rb * K + C_) * 2u; }
    const size_t kstep = (size_t)(BK * 2);
    const size_t hstepA = (size_t)HALF * lda * 2, tstepA = 2 * hstepA;
    const size_t hstepB = (size_t)HALF * K * 2, tstepB = 2 * hstepB;
    const unsigned ldsw = (unsigned)wid * 1024u;
    const int aoff = lds_byte(wr * 64 + fr, fq * 8), boff = lds_byte(wc * 32 + fr, fq * 8);
#define PG8_SA(b, h) (((b) * 2 + (h)) * HTB)
#define PG8_SB(b, h) ((4 + (b) * 2 + (h)) * HTB)
#define PG8_STAGE(bufoff, gbase, voff) do { _Pragma("unroll") for (int _i = 0; _i < 2; ++_i) \
        __builtin_amdgcn_global_load_lds((const unsigned*)((const char*)(gbase) + (voff)[_i]), (PG8_LAS unsigned*)(lds + (bufoff) + ldsw + _i * 8192), 16, 0, 0); } while (0)
#define PG8_LDA(dst, b, h) do { _Pragma("unroll") for (int m = 0; m < 4; ++m) _Pragma("unroll") for (int k = 0; k < 2; ++k) dst[m][k] = *(const PG8_LAS bf16x8*)(lds + PG8_SA(b, h) + aoff + m * 2048 + k * 1024); } while (0)
#define PG8_LDB(dst, b, h) do { _Pragma("unroll") for (int n = 0; n < 2; ++n) _Pragma("unroll") for (int k = 0; k < 2; ++k) dst[n][k] = *(const PG8_LAS bf16x8*)(lds + PG8_SB(b, h) + boff + n * 2048 + k * 1024); } while (0)
#define PG8_MMA(ai, bj, At, Bt) do { __builtin_amdgcn_s_setprio(1); _Pragma("unroll") for (int m = 0; m < 4; ++m) _Pragma("unroll") for (int n = 0; n < 2; ++n) _Pragma("unroll") for (int k = 0; k < 2; ++k) \
        acc[ai][bj][m][n] = __builtin_amdgcn_mfma_f32_16x16x32_bf16(Bt[n][k], At[m][k], acc[ai][bj][m][n], 0, 0, 0); __builtin_amdgcn_s_setprio(0); } while (0)
#define PG8_WAIT_V(n) asm volatile("s_waitcnt vmcnt(" #n ")" ::: "memory")
#define PG8_WAIT_L(n) asm volatile("s_waitcnt lgkmcnt(" #n ")" ::: "memory")
#define PG8_BAR __builtin_amdgcn_s_barrier()
#define PG8_SCHED __builtin_amdgcn_sched_barrier(0)
    Unit cur, nxt; int ui = 0;
    if (!S.next(0, cur)) return;
    f32x4 acc[2][2][4][2];
#pragma unroll
    for (int a = 0; a < 2; ++a)
#pragma unroll
        for (int b = 0; b < 2; ++b)
#pragma unroll
            for (int m = 0; m < 4; ++m)
#pragma unroll
                for (int n = 0; n < 2; ++n) acc[a][b][m][n] = (f32x4){0.f, 0.f, 0.f, 0.f};
    bf16x8 At[4][2], B0[2][2], B1[2][2];
    const char* cA = (const char*)g.A + (size_t)cur.pm * tstepA; const char* cB = (const char*)g.Bt + (size_t)cur.bt * tstepB;
    S.a_ready(cur);
    PG8_STAGE(PG8_SB(0, 0), cB, voffB); PG8_STAGE(PG8_SB(0, 1), cB + hstepB, voffB); PG8_STAGE(PG8_SA(0, 0), cA, voffA); PG8_STAGE(PG8_SA(0, 1), cA + hstepA, voffA);
    if (wr == 1) PG8_BAR;
    PG8_WAIT_V(2); PG8_BAR;
    PG8_STAGE(PG8_SB(1, 0), cB + kstep, voffB); PG8_STAGE(PG8_SA(1, 0), cA + kstep, voffA); PG8_STAGE(PG8_SB(1, 1), cB + hstepB + kstep, voffB);
    PG8_WAIT_V(6); PG8_BAR;
    for (;;) {
        const bool has_next = S.next(ui + 1, nxt);
        const char* nA = has_next ? (const char*)g.A + (size_t)nxt.pm * tstepA : cA; const char* nB = has_next ? (const char*)g.Bt + (size_t)nxt.bt * tstepB : cB;
        for (int t = 0; t < nt; t += 2) {
            const bool last = (t == nt - 2);
            const char* a1 = cA + (size_t)(t + 1) * kstep;
            const char* a2 = last ? nA : cA + (size_t)(t + 2) * kstep; const char* b2 = last ? nB : cB + (size_t)(t + 2) * kstep;
            const char* a3 = a2 + kstep; const char* b3 = b2 + kstep;
            if (last && has_next) S.a_ready(nxt);
            PG8_LDB(B0, 0, 0); PG8_LDB(B1, 0, 1); PG8_SCHED; PG8_LDA(At, 0, 0); PG8_STAGE(PG8_SA(1, 1), a1 + hstepA, voffA);
            PG8_WAIT_V(8); PG8_WAIT_L(0); PG8_BAR; PG8_MMA(0, 0, At, B0); PG8_MMA(0, 1, At, B1); PG8_BAR; PG8_SCHED;
            PG8_LDA(At, 0, 1); PG8_STAGE(PG8_SB(0, 0), b2, voffB); PG8_STAGE(PG8_SB(0, 1), b2 + hstepB, voffB); PG8_STAGE(PG8_SA(0, 0), a2, voffA);
            PG8_WAIT_V(8); PG8_WAIT_L(0); PG8_BAR; PG8_MMA(1, 0, At, B0); PG8_MMA(1, 1, At, B1); PG8_BAR; PG8_SCHED;
            PG8_LDB(B0, 1, 0); PG8_LDB(B1, 1, 1); PG8_SCHED; PG8_LDA(At, 1, 0); PG8_STAGE(PG8_SA(0, 1), a2 + hstepA, voffA);
            PG8_WAIT_V(8); PG8_WAIT_L(0); PG8_BAR; PG8_MMA(0, 0, At, B0); PG8_MMA(0, 1, At, B1); PG8_BAR; PG8_SCHED;
            PG8_LDA(At, 1, 1); PG8_STAGE(PG8_SB(1, 0), b3, voffB); PG8_STAGE(PG8_SB(1, 1), b3 + hstepB, voffB); PG8_STAGE(PG8_SA(1, 0), a3, voffA);
            PG8_WAIT_V(8); PG8_WAIT_L(0); PG8_BAR; PG8_MMA(1, 0, At, B0); PG8_MMA(1, 1, At, B1); PG8_BAR; PG8_SCHED;
        }
        if (wr == 0) PG8_BAR;
        E(acc, cur, wr, wc, fr, fq); S.done(cur);
        if (!has_next) break;
#pragma unroll
        for (int a = 0; a < 2; ++a)
#pragma unroll
            for (int b = 0; b < 2; ++b)
#pragma unroll
                for (int m = 0; m < 4; ++m)
#pragma unroll
                    for (int n = 0; n < 2; ++n) acc[a][b][m][n] = (f32x4){0.f, 0.f, 0.f, 0.f};
        cur = nxt; cA = nA; cB = nB; ++ui;
        if (wr == 1) PG8_BAR;
    }
    PG8_WAIT_V(0);
    PG8_BAR;
#undef PG8_SA
#undef PG8_SB
#undef PG8_STAGE
#undef PG8_LDA
#undef PG8_LDB
#undef PG8_MMA
#undef PG8_WAIT_V
#undef PG8_WAIT_L
#undef PG8_BAR
#undef PG8_SCHED
}
#endif

struct EpiStoreBf16 {
    bf16_t* O; int ldc;
    __device__ __forceinline__ void operator()(const f32x4 (&acc)[2][2][4][2], const Unit& u, int wr, int wc, int fr, int fq) const {
        const int row0 = u.pm * 256 + wr * 64 + fr, col0 = u.pn * 256 + wc * 32 + 8 * fq;
#pragma unroll
        for (int ai = 0; ai < 2; ++ai)
#pragma unroll
            for (int m = 0; m < 4; ++m)
#pragma unroll
                for (int bj = 0; bj < 2; ++bj) { const f32x4 v0 = acc[ai][bj][m][0], v1 = acc[ai][bj][m][1];
                    u32x4 w; w.x = pk2(v0[0], v0[1]); w.y = pk2(v0[2], v0[3]); w.z = pk2(v1[0], v1[1]); w.w = pk2(v1[2], v1[3]);
                    *(u32x4*)(O + (size_t)(row0 + ai * 128 + m * 16) * ldc + col0 + bj * 128) = w; }
    }
};
template <int MODE> struct EpiGate {
    const bf16_t* Hg; bf16_t* MGb;
    __device__ __forceinline__ void operator()(const f32x4 (&acc)[2][2][4][2], const Unit& u, int wr, int wc, int fr, int fq) const {
        const int row0 = u.pm * 256 + wr * 64 + fr, col0 = u.pn * 256 + wc * 32 + 8 * fq;
#pragma unroll
        for (int ai = 0; ai < 2; ++ai) {
            u32x4 gw[4][2], pw[4][2];
#pragma unroll
            for (int m = 0; m < 4; ++m)
#pragma unroll
                for (int bj = 0; bj < 2; ++bj) { const int row = row0 + ai * 128 + m * 16, col = col0 + bj * 128;
                    gw[m][bj] = *(const u32x4*)(Hg + (size_t)row * DINP + col); if (MODE != 0) pw[m][bj] = *(const u32x4*)(MGb + (size_t)row * D + col); }
            asm volatile("" ::: "memory");
#pragma unroll
            for (int m = 0; m < 4; ++m)
#pragma unroll
                for (int bj = 0; bj < 2; ++bj) { const int row = row0 + ai * 128 + m * 16, col = col0 + bj * 128; const f32x4 v0 = acc[ai][bj][m][0], v1 = acc[ai][bj][m][1];
                    float g[8], p[8], v[8] = {v0[0], v0[1], v0[2], v0[3], v1[0], v1[1], v1[2], v1[3]}; unpack8(gw[m][bj], g);
                    if (MODE != 0) { unpack8(pw[m][bj], p);
#pragma unroll
                        for (int i = 0; i < 8; ++i) v[i] = p[i] + v[i] * fsigmoid(g[i]); }
                    else {
#pragma unroll
                        for (int i = 0; i < 8; ++i) v[i] = v[i] * fsigmoid(g[i]); }
                    *(u32x4*)(MGb + (size_t)row * D + col) = pack8(v); }
            asm volatile("" ::: "memory");
        }
    }
};
struct EpiResid {
    const float* xp; const float* xs; float* op; float* os;
    __device__ __forceinline__ void operator()(const f32x4 (&acc)[2][2][4][2], const Unit& u, int wr, int wc, int fr, int fq) const {
        const int row0 = u.pm * 256 + wr * 64 + fr, col0 = u.pn * 256 + wc * 32 + 8 * fq;
        const bool smp = u.pm * 256 >= NP;
        const float* xb = smp ? xs - (size_t)NP * D : xp; float* ob = smp ? os - (size_t)NP * D : op;
#pragma unroll
        for (int ai = 0; ai < 2; ++ai) {
            f32x4 xa[4][2][2];
#pragma unroll
            for (int m = 0; m < 4; ++m)
#pragma unroll
                for (int bj = 0; bj < 2; ++bj) { const float* xi = xb + (size_t)(row0 + ai * 128 + m * 16) * D + col0 + bj * 128; xa[m][bj][0] = *(const f32x4*)xi; xa[m][bj][1] = *(const f32x4*)(xi + 4); }
            asm volatile("" ::: "memory");
#pragma unroll
            for (int m = 0; m < 4; ++m)
#pragma unroll
                for (int bj = 0; bj < 2; ++bj) { float* xo = ob + (size_t)(row0 + ai * 128 + m * 16) * D + col0 + bj * 128;
                    *(f32x4*)xo = xa[m][bj][0] * ALPHA + acc[ai][bj][m][0]; *(f32x4*)(xo + 4) = xa[m][bj][1] * ALPHA + acc[ai][bj][m][1]; }
            asm volatile("" ::: "memory");
        }
    }
};
struct EpiSwiglu {
    bf16_t* ACT; const float* bup;
    __device__ __forceinline__ void operator()(const f32x4 (&acc)[2][2][4][2], const Unit& u, int wr, int wc, int fr, int fq) const {
        const int row0_ = u.pm * 256 + wr * 64 + fr, j0 = u.pn * 128 + wc * 32 + 8 * fq;
        const float* bg = bup + (size_t)u.e * 2048 + j0; const f32x4 bg0 = *(const f32x4*)bg, bg1 = *(const f32x4*)(bg + 4), bu0 = *(const f32x4*)(bg + 1024), bu1 = *(const f32x4*)(bg + 1028);
#pragma unroll
        for (int ai = 0; ai < 2; ++ai)
#pragma unroll
            for (int m = 0; m < 4; ++m) { const int row = row0_ + ai * 128 + m * 16;
                const f32x4 g0 = acc[ai][0][m][0] + bg0, g1 = acc[ai][0][m][1] + bg1, u0 = acc[ai][1][m][0] + bu0, u1 = acc[ai][1][m][1] + bu1; float o[8];
#pragma unroll
                for (int i = 0; i < 4; ++i) { const float ga = fminf(g0[i], SW_LIMIT), ua = fminf(fmaxf(u0[i], -SW_LIMIT), SW_LIMIT); o[i] = (ua + 1.0f) * ga * fsigmoid(SW_ALPHA * ga);
                    const float gb = fminf(g1[i], SW_LIMIT), ub = fminf(fmaxf(u1[i], -SW_LIMIT), SW_LIMIT); o[4 + i] = (ub + 1.0f) * gb * fsigmoid(SW_ALPHA * gb); }
                *(u32x4*)(ACT + (size_t)row * D + j0) = pack8(o); }
    }
};
struct EpiDown {
    bf16_t* O; const float* bdn; const float* gs;
    __device__ __forceinline__ void operator()(const f32x4 (&acc)[2][2][4][2], const Unit& u, int wr, int wc, int fr, int fq) const {
        const int row0 = u.pm * 256 + wr * 64 + fr, col0 = u.pn * 256 + wc * 32 + 8 * fq;
#pragma unroll
        for (int ai = 0; ai < 2; ++ai) {
            float gt[4];
#pragma unroll
            for (int m = 0; m < 4; ++m) gt[m] = gs[row0 + ai * 128 + m * 16];
#pragma unroll
            for (int bj = 0; bj < 2; ++bj) { const float* bp = bdn + (size_t)u.e * D + col0 + bj * 128; const f32x4 b0 = *(const f32x4*)bp, b1 = *(const f32x4*)(bp + 4);
#pragma unroll
                for (int m = 0; m < 4; ++m) { const f32x4 a0 = (acc[ai][bj][m][0] + b0) * gt[m], a1 = (acc[ai][bj][m][1] + b1) * gt[m];
                    u32x4 w; w.x = pk2(a0[0], a0[1]); w.y = pk2(a0[2], a0[3]); w.z = pk2(a1[0], a1[1]); w.w = pk2(a1[2], a1[3]);
                    *(u32x4*)(O + (size_t)(row0 + ai * 128 + m * 16) * D + col0 + bj * 128) = w; } }
            asm volatile("" ::: "memory");
        }
    }
};
}

#ifndef EMU
#define XB_TMO      128
#define XB_XCNT(j)  (256  + 64 * (j))
#define XB_XSUB(j)  (1280 + 64 * (j))
#define XB_XGEN(j)  (2304 + 64 * (j))
#define XB_TOP      3328
#define XB_TOPGEN   3392
#define XCD_BAR_WORDS 3456
#define XB_SPIN_CAP (1u << 27)
__device__ __forceinline__ unsigned xb_ld(unsigned* p)              { return __hip_atomic_load(p, __ATOMIC_RELAXED, __HIP_MEMORY_SCOPE_AGENT); }
__device__ __forceinline__ unsigned xb_add(unsigned* p, unsigned v) { return __hip_atomic_fetch_add(p, v, __ATOMIC_RELAXED, __HIP_MEMORY_SCOPE_AGENT); }
__device__ __forceinline__ unsigned xb_xcc_id() { return (unsigned)__builtin_amdgcn_s_getreg((3 << 11) | 20) & 0xFu; }
#define XB_SPIN(cond, bar) do { unsigned _sp = 0; while (cond) { __builtin_amdgcn_s_sleep(1); \
    if ((++_sp & 255u) == 0u) { if (xb_ld(&(bar)[XB_TMO])) break; if (_sp > XB_SPIN_CAP) { atomicAdd(&(bar)[XB_TMO], 1u); break; } } } } while (0)
struct XcdBarrier { unsigned* bar; unsigned x; volatile LAS unsigned* st; };
__device__ __forceinline__ XcdBarrier xcd_barrier_post(unsigned* bar, volatile LAS unsigned* st) {
    XcdBarrier b; b.bar = bar; b.x = xb_xcc_id(); b.st = st;
    if (threadIdx.x == 0) (void)xb_add(&bar[XB_XCNT(b.x)], 1u);
    return b;
}
__device__ __forceinline__ void xcd_barrier_complete(unsigned* bar, unsigned x, unsigned& nloc, unsigned& nx) {
    const unsigned G = gridDim.x * gridDim.y * gridDim.z;
    unsigned sum, cnt, mine, sp = 0u;
    for (;;) {
        sum = 0u; cnt = 0u; mine = 0u;
#pragma unroll
        for (unsigned j = 0; j < 16; ++j) { const unsigned c = xb_ld(&bar[XB_XCNT(j)]); sum += c; cnt += (c > 0u) ? 1u : 0u; mine = (j == x) ? c : mine; }
        if (sum == G) break;
        __builtin_amdgcn_s_sleep(1);
        if ((++sp & 255u) == 0u) { if (xb_ld(&bar[XB_TMO])) break; if (sp > XB_SPIN_CAP) { atomicAdd(&bar[XB_TMO], 1u); break; } }
    }
    nloc = mine > 0u ? mine : 1u; nx = cnt > 0u ? cnt : 1u;
}
__device__ __forceinline__ void xcd_barrier(const XcdBarrier& b) {
    asm volatile("s_waitcnt vmcnt(0)" ::: "memory");
    __syncthreads();
    if (threadIdx.x == 0) {
        unsigned* bar = b.bar;
        __builtin_amdgcn_s_waitcnt(0);
        unsigned nloc = b.st[0], nx = b.st[1];
        if (nloc == 0u) { xcd_barrier_complete(bar, b.x, nloc, nx); b.st[0] = nloc; b.st[1] = nx; }
        const unsigned old = xb_add(&bar[XB_XSUB(b.x)], 1u);
        const unsigned gen = old / nloc;
        if (old + 1u == (gen + 1u) * nloc) {
            __builtin_amdgcn_fence(__ATOMIC_RELEASE, "agent");
            asm volatile("s_waitcnt vmcnt(0)" ::: "memory");
            const unsigned og = xb_add(&bar[XB_TOP], 1u);
            const unsigned tg = og / nx;
            if (og + 1u == (tg + 1u) * nx) xb_add(&bar[XB_TOPGEN], 1u);
            else XB_SPIN(xb_ld(&bar[XB_TOPGEN]) == tg, bar);
            __builtin_amdgcn_fence(__ATOMIC_ACQUIRE, "agent");
            xb_add(&bar[XB_XGEN(b.x)], 1u);
            asm volatile("s_waitcnt vmcnt(0)" ::: "memory");
        } else {
            XB_SPIN(xb_ld(&bar[XB_XGEN(b.x)]) == gen, bar);
            __builtin_amdgcn_fence(__ATOMIC_ACQUIRE, "agent");
            asm volatile("s_waitcnt vmcnt(0)" ::: "memory");
        }
    }
    __syncthreads();
}
#endif

struct Args { const float* in[31]; float* out; unsigned char* ws; int lo, hi; };
typedef const float* FPtr;
#ifdef EMU
typedef const FPtr* ArgTab;
#else
typedef const __attribute__((address_space(4))) FPtr* ArgTab;
#endif
struct Frame {
    LAS unsigned char* lds; int tid, lane, wave, G, bid;
    ArgTab in; float* out; unsigned char* ws; unsigned* ctl;
};
enum { I_XP = 0, I_XS, I_CK, I_CV, I_SST, I_SCV, I_SSC, I_WIN, I_CONVW, I_CONVB, I_DTB, I_ALOG, I_SD, I_NORMW, I_WSSD, I_SINK, I_WATT, I_RELB, I_SCW, I_WSC, I_WO, I_LN1G, I_LN1B,
       I_RW, I_RB, I_WUP, I_BUP, I_WDN, I_BDN, I_LN2G, I_LN2B };

__device__ __forceinline__ bf16_t* ws_bf(const Frame& F, size_t off) { return (bf16_t*)(F.ws + off); }
__device__ __forceinline__ float* ws_f(const Frame& F, size_t off) { return (float*)(F.ws + off); }
__device__ __forceinline__ bf16_t* wl_ptr(const Frame& F, int layer, size_t off) { return (bf16_t*)(F.ws + WS_W + (size_t)layer * WL_BYTES + off); }

__device__ __forceinline__ void wt_item(const float* W, int ldw, int K, int k0, int nsrc0, const float* kscale, bf16_t* WT, int ndst0, LAS float* scr, int lane) {
    if (nsrc0 < 0) {
#pragma unroll
        for (int j = 0; j < 4; ++j) { const int n = (lane >> 3) + 8 * j; *(u32x4*)(WT + (size_t)(ndst0 + n) * K + k0 + 8 * (lane & 7)) = (u32x4){0u, 0u, 0u, 0u}; }
        return;
    }
#pragma unroll 8
    for (int i = 0; i < 32; ++i) { const int kk = 2 * i + (lane >> 5); float v = W[(size_t)(k0 + kk) * ldw + nsrc0 + (lane & 31)]; if (kscale) v *= kscale[k0 + kk]; scr[kk * 33 + (lane & 31)] = v; }
    WAVE_SYNC();
    const int c = lane & 7;
#pragma unroll
    for (int j = 0; j < 4; ++j) { const int n = (lane >> 3) + 8 * j; const LAS float* s = scr + (8 * c) * 33 + n;
        u32x4 o; o.x = pk2(s[0 * 33], s[1 * 33]); o.y = pk2(s[2 * 33], s[3 * 33]); o.z = pk2(s[4 * 33], s[5 * 33]); o.w = pk2(s[6 * 33], s[7 * 33]);
        *(u32x4*)(WT + (size_t)(ndst0 + n) * K + k0 + 8 * c) = o; }
    WAVE_SYNC();
}
__device__ __forceinline__ void step_weights(const Frame& F) {
    LAS float* scr = (LAS float*)(F.lds + F.wave * 16384);
    const int gw = F.bid * NWAVES + F.wave, NGW = F.G * NWAVES;
    constexpr int I_IN = (DINP / 32) * (D / 64), I_SSD = (D / 32) * (DINNER / 64), I_SQ = (D / 32) * (D / 64), I_UP = NEXP * (2048 / 32) * (D / 64), I_DN = NEXP * (D / 32) * (D / 64);
    constexpr int PER_LAYER = I_IN + I_SSD + 3 * I_SQ + I_UP + I_DN;
    for (int it = gw; it < DEPTH * PER_LAYER; it += NGW) {
        const int layer = it / PER_LAYER; int r = it % PER_LAYER;
        if (r < I_IN) { const int nb = r / (D / 64), kb = r % (D / 64), n0 = nb * 32;
            const int ns = n0 < 6144 ? n0 : (n0 < 13824 ? n0 + 32 : (n0 < 13856 ? n0 - 13824 + 6144 : -1));
            wt_item(F.in[I_WIN] + (size_t)layer * D * DIN, DIN, D, kb * 64, ns, nullptr, wl_ptr(F, layer, WL_IN), n0, scr, F.lane); continue; }
        r -= I_IN;
        if (r < I_SSD) { const int nb = r / (DINNER / 64), kb = r % (DINNER / 64);
            wt_item(F.in[I_WSSD] + (size_t)layer * DINNER * D, D, DINNER, kb * 64, nb * 32, F.in[I_NORMW] + (size_t)layer * DINNER, wl_ptr(F, layer, WL_SSD), nb * 32, scr, F.lane); continue; }
        r -= I_SSD;
        if (r < I_SQ) { const int nb = r / (D / 64), kb = r % (D / 64); wt_item(F.in[I_WATT] + (size_t)layer * D * D, D, D, kb * 64, nb * 32, nullptr, wl_ptr(F, layer, WL_ATT), nb * 32, scr, F.lane); continue; }
        r -= I_SQ;
        if (r < I_SQ) { const int nb = r / (D / 64), kb = r % (D / 64); wt_item(F.in[I_WSC] + (size_t)layer * D * D, D, D, kb * 64, nb * 32, nullptr, wl_ptr(F, layer, WL_SC), nb * 32, scr, F.lane); continue; }
        r -= I_SQ;
        if (r < I_SQ) { const int nb = r / (D / 64), kb = r % (D / 64); wt_item(F.in[I_WO] + (size_t)layer * D * D, D, D, kb * 64, nb * 32, nullptr, wl_ptr(F, layer, WL_O), nb * 32, scr, F.lane); continue; }
        r -= I_SQ;
        if (r < I_UP) { const int e = r / ((2048 / 32) * (D / 64)), q = r % ((2048 / 32) * (D / 64)), nb = q / (D / 64), kb = q % (D / 64), n0 = nb * 32;
            const int pn = n0 >> 8, bj = (n0 >> 7) & 1, jj = n0 & 127, ns = bj * 1024 + pn * 128 + jj;
            wt_item(F.in[I_WUP] + ((size_t)layer * NEXP + e) * D * 2048, 2048, D, kb * 64, ns, nullptr, wl_ptr(F, layer, WL_UP) + (size_t)e * 2048 * D, n0, scr, F.lane); continue; }
        r -= I_UP;
        { const int e = r / ((D / 32) * (D / 64)), q = r % ((D / 32) * (D / 64)), nb = q / (D / 64), kb = q % (D / 64);
            wt_item(F.in[I_WDN] + ((size_t)layer * NEXP + e) * D * D, D, D, kb * 64, nb * 32, nullptr, wl_ptr(F, layer, WL_DN) + (size_t)e * D * D, nb * 32, scr, F.lane); }
    }
}

__device__ __forceinline__ const float* x_in_row(const Frame& F, int layer, int mb, int r) {
    if (layer == 0) return r < NP ? F.in[I_XP] + ((size_t)mb * NP + r) * D : F.in[I_XS] + (size_t)(r - NP) * D;
    return r < NP ? F.out + O_YP + ((size_t)mb * NP + r) * D : F.out + O_YS + (size_t)(r - NP) * D;
}
__device__ __forceinline__ float* x_out_row(const Frame& F, int mb, int r) { return r < NP ? F.out + O_YP + ((size_t)mb * NP + r) * D : F.out + O_YS + (size_t)(r - NP) * D; }
__device__ __forceinline__ int rows_of(int mb) { return mb == 0 ? R : NP; }

__device__ __forceinline__ void step_xb(const Frame& F, int mb) {
    const int gw = F.bid * NWAVES + F.wave, NGW = F.G * NWAVES, nr = rows_of(mb);
    bf16_t* XB = ws_bf(F, WS_XB);
    for (int r = gw; r < nr; r += NGW) {
        const f32x4* xr = (const f32x4*)x_in_row(F, 0, mb, r) + F.lane; u32x2* o = (u32x2*)(XB + (size_t)r * D) + F.lane;
#pragma unroll
        for (int j = 0; j < 4; ++j) { const f32x4 v = xr[64 * j]; u32x2 w; w.x = pk2(v[0], v[1]); w.y = pk2(v[2], v[3]); o[64 * j] = w; }
    }
}

__device__ __forceinline__ float softplus_f(float x) { const float e = fexp(x); return x > 20.f ? x : (e < 0.01f ? e * (1.0f - e * (0.5f - e * 0.33333333f)) : __builtin_amdgcn_logf(1.0f + e) * 0.69314718056f); }
constexpr int S128 = 136, S64 = 72, RAWP = 264;
constexpr int SL_CM = 0, SL_BM = SL_CM + 64 * S128 * 2, SL_BT = SL_BM + 64 * S128 * 2, SL_XT = SL_BT + 128 * S64 * 2, SL_XTW = SL_XT + 64 * S64 * 2,
    SL_MM = SL_XTW + 64 * S64 * 2, SL_SB = SL_MM + 64 * S64 * 2, SL_SM = SL_SB + 64 * S128 * 2, SL_CW = SL_SM + 2 * 320 * 4, SL_RAW = SL_CW + 5 * 320 * 4, SL_END = SL_RAW + 35 * 1024;
constexpr int SL_Y = SL_CM, YP = 68;
static_assert(SL_END <= SCR_BYTES && 64 * YP * 4 <= 64 * S128 * 2 && 67 * RAWP * 2 <= 35 * 1024, "ssd LDS map");

#ifdef EMU
#define SSD_DMA_ONE(gp_, dst_) memcpy((unsigned char*)(dst_) + lane * 16, (gp_), 16)
#else
#define SSD_DMA_ONE(gp_, dst_) __builtin_amdgcn_global_load_lds((const unsigned*)(gp_), (LAS unsigned*)(dst_), 16, 0, 0)
#endif
#define SSD_DMA(ck_) do { _Pragma("unroll") for (int j_ = 0; j_ < 5; ++j_) if (w * 5 + j_ < 35) { int q_ = (w * 5 + j_) * 64 + lane; q_ = q_ < 67 * 33 ? q_ : 67 * 33 - 1; const int row_ = q_ / 33; int cc_ = q_ % 33; cc_ = cc_ < 32 ? cc_ : 31; \
        const int t_ = (ck_) * 64 + row_ - 3; const bf16_t* gp_ = t_ >= 0 ? H + (size_t)t_ * DINP + (cc_ < 16 ? C_B + g * 128 + 8 * cc_ : C_C + g * 128 + 8 * (cc_ - 16)) : (const bf16_t*)(F.ws + 1024 + lane * 16); \
        SSD_DMA_ONE(gp_, L + SL_RAW + (w * 5 + j_) * 1024); } } while (0)
#define SSD_LOAD_X(ck_) do { _Pragma("unroll") for (int i = 0; i < 4; ++i) { const int t_ = (ck_) * 64 + xl - 3 + i; rawx[i] = t_ >= 0 ? *(const u32x4*)(H + (size_t)t_ * DINP + C_X + hd * 64 + 8 * xcg) : (u32x4){0u, 0u, 0u, 0u}; } } while (0)
#define SSD_TABLE(tb_, dtr_) do { const float x_ = bf2f(dtr_) + dtb; const float e_ = fexp(x_); const float dt_ = x_ > 20.f ? x_ : (e_ < 0.01f ? e_ * (1.0f - e_ * (0.5f - e_ * 0.33333333f)) : __builtin_amdgcn_logf(1.0f + e_) * 0.69314718056f); \
        float cs_ = Ah * dt_; _Pragma("unroll") for (int o = 1; o < 64; o <<= 1) { const float t2_ = __shfl(cs_, lane - o < 0 ? 0 : lane - o); if (lane >= o) cs_ += t2_; } \
        const float tot_ = __shfl(cs_, 63); (tb_)[lane] = dt_; (tb_)[64 + lane] = cs_; (tb_)[128 + lane] = fexp(tot_ - cs_); (tb_)[192 + lane] = fexp(cs_); if (lane == 0) (tb_)[256] = fexp(tot_); } while (0)

__device__ __forceinline__ void ssd_prompt_unit(const Frame& F, int layer, int mb, int sl, int hd) {
    const int tid = F.tid, lane = F.lane, w = F.wave, fr = lane & 15, fq = lane >> 4;
    LAS unsigned char* L = F.lds;
    LAS bf16_t* Cm = (LAS bf16_t*)(L + SL_CM); LAS bf16_t* Bm = (LAS bf16_t*)(L + SL_BM); LAS bf16_t* BT = (LAS bf16_t*)(L + SL_BT); LAS bf16_t* XT = (LAS bf16_t*)(L + SL_XT);
    LAS bf16_t* XTW = (LAS bf16_t*)(L + SL_XTW); LAS bf16_t* Mm = (LAS bf16_t*)(L + SL_MM); LAS bf16_t* Sb = (LAS bf16_t*)(L + SL_SB); LAS bf16_t* RAW = (LAS bf16_t*)(L + SL_RAW);
    LAS float* smb = (LAS float*)(L + SL_SM);
    LAS float* cw = (LAS float*)(L + SL_CW);
    LAS float* Y = (LAS float*)(L + SL_Y);
    const int g = hd >> 2;
    bf16_t* H = ws_bf(F, WS_H) + (size_t)sl * SEQ * DINP;
    const float* convw = F.in[I_CONVW] + (size_t)layer * 4 * CONVDIM; const float* convb = F.in[I_CONVB] + (size_t)layer * CONVDIM;
    __syncthreads();
    for (int i = tid; i < 5 * 320; i += NTHREADS) { const int tap = i / 320, c = i % 320; const int xc = c < 64 ? hd * 64 + c : (c < 192 ? 2048 + g * 128 + (c - 64) : 3072 + g * 128 + (c - 192));
        cw[i] = tap < 4 ? convw[tap * CONVDIM + xc] : convb[xc]; }
    const float dtb = F.in[I_DTB][layer * 32 + hd], Ah = -fexp(F.in[I_ALOG][layer * 32 + hd]), Dh = F.in[I_SD][layer * 32 + hd];
    const int xl = tid >> 3, xcg = tid & 7;
    f32x4 S[4];
#pragma unroll
    for (int j = 0; j < 4; ++j) S[j] = (f32x4){0.f, 0.f, 0.f, 0.f};
    const int ti = w >> 1, tj0 = 2 * (w & 1);
    const int pi = w & 3, nb = w >> 2;
    u32x4 rawx[4]; u32x4 zraw; unsigned dtr_next;
    SSD_DMA(0); SSD_LOAD_X(0);
    zraw = *(const u32x4*)(H + (size_t)xl * DINP + C_Z + hd * 64 + 8 * xcg);
    { const unsigned d0 = H[(size_t)lane * DINP + C_DT + hd]; dtr_next = H[(size_t)(64 + lane) * DINP + C_DT + hd]; if (w == 0) SSD_TABLE(smb, d0); }
    VM_WAIT(0);
    for (int ck = 0; ck < NCHUNK; ++ck) {
        const size_t rowb = (size_t)ck * 64;
        LAS float* sm = smb + (ck & 1) * 320; LAS float* smn = smb + ((ck + 1) & 1) * 320;
        if (ck > 0) VM_WAIT(2);
        LBAR();
        float xs8[8];
        { float acc8[8];
          { const f32x4 b0 = *(const LAS f32x4*)(cw + 4 * 320 + 8 * xcg), b1 = *(const LAS f32x4*)(cw + 4 * 320 + 8 * xcg + 4);
#pragma unroll
            for (int i = 0; i < 4; ++i) { acc8[i] = b0[i]; acc8[4 + i] = b1[i]; } }
#pragma unroll
          for (int tp = 0; tp < 4; ++tp) { float f[8]; unpack8(rawx[tp], f); const f32x4 w0 = *(const LAS f32x4*)(cw + tp * 320 + 8 * xcg), w1 = *(const LAS f32x4*)(cw + tp * 320 + 8 * xcg + 4);
#pragma unroll
            for (int i = 0; i < 4; ++i) { acc8[i] += f[i] * w0[i]; acc8[4 + i] += f[4 + i] * w1[i]; } }
          const float dt = sm[xl], wd = sm[128 + xl];
#pragma unroll
          for (int i = 0; i < 8; ++i) { const float v = fsilu(acc8[i]); xs8[i] = v; const float xd = v * dt; XT[(8 * xcg + i) * S64 + xl] = (bf16_t)f2bf(xd); XTW[(8 * xcg + i) * S64 + xl] = (bf16_t)f2bf(xd * wd); } }
        asm volatile("" ::: "memory");
#pragma unroll
        for (int it = 0; it < 4; ++it) {
            const int cg = w + 8 * (it & 1); const int cb = (it < 2 ? 64 : 192) + 8 * cg, rc = (it < 2 ? 0 : 128) + 8 * cg;
            float acc8[8];
            { const f32x4 b0 = *(const LAS f32x4*)(cw + 4 * 320 + cb), b1 = *(const LAS f32x4*)(cw + 4 * 320 + cb + 4);
#pragma unroll
              for (int i = 0; i < 4; ++i) { acc8[i] = b0[i]; acc8[4 + i] = b1[i]; } }
#pragma unroll
            for (int tp = 0; tp < 4; ++tp) { float f[8]; unpack8(*(const LAS u32x4*)(RAW + (lane + tp) * RAWP + rc), f); const f32x4 w0 = *(const LAS f32x4*)(cw + tp * 320 + cb), w1 = *(const LAS f32x4*)(cw + tp * 320 + cb + 4);
#pragma unroll
                for (int i = 0; i < 4; ++i) { acc8[i] += f[i] * w0[i]; acc8[4 + i] += f[4 + i] * w1[i]; } }
#pragma unroll
            for (int i = 0; i < 8; ++i) acc8[i] = fsilu(acc8[i]);
            if (it < 2) { *(LAS u32x4*)(Bm + lane * S128 + 8 * cg) = pack8(acc8);
#pragma unroll
                for (int i = 0; i < 8; ++i) BT[(8 * cg + i) * S64 + lane] = (bf16_t)f2bf(acc8[i]); }
            else *(LAS u32x4*)(Cm + lane * S128 + 8 * cg) = pack8(acc8);
            asm volatile("" ::: "memory");
        }
#pragma unroll
        for (int jj = 0; jj < 4; ++jj)
#pragma unroll
            for (int r = 0; r < 4; ++r) Sb[(16 * pi + 4 * fq + r) * S128 + 64 * nb + 16 * jj + fr] = (bf16_t)f2bf(S[jj][r]);
        LBAR();
        const u32x4 zcur = zraw; const unsigned dtr_cur = dtr_next;
        if (ck + 1 < NCHUNK) { SSD_DMA(ck + 1); SSD_LOAD_X(ck + 1); zraw = *(const u32x4*)(H + (rowb + 64 + xl) * DINP + C_Z + hd * 64 + 8 * xcg);
            dtr_next = H[(rowb + (ck + 2 < NCHUNK ? 128 : 64) + lane) * DINP + C_DT + hd]; }
        asm volatile("" ::: "memory");
        if (w == 0 && ck + 1 < NCHUNK) SSD_TABLE(smn, dtr_cur);
        f32x4 yo[2];
#pragma unroll
        for (int jj = 0; jj < 2; ++jj) { const int tj = tj0 + jj;
            f32x4 cb = (f32x4){0.f, 0.f, 0.f, 0.f}; yo[jj] = (f32x4){0.f, 0.f, 0.f, 0.f};
#pragma unroll
            for (int ks = 0; ks < 4; ++ks) { const bf16x8 a = *(const LAS bf16x8*)(Cm + (16 * ti + fr) * S128 + 32 * ks + 8 * fq);
                if (tj <= ti) { const bf16x8 b = *(const LAS bf16x8*)(Bm + (16 * tj + fr) * S128 + 32 * ks + 8 * fq); cb = __builtin_amdgcn_mfma_f32_16x16x32_bf16(a, b, cb, 0, 0, 0); }
                const bf16x8 sb = *(const LAS bf16x8*)(Sb + (16 * tj + fr) * S128 + 32 * ks + 8 * fq); yo[jj] = __builtin_amdgcn_mfma_f32_16x16x32_bf16(a, sb, yo[jj], 0, 0, 0); }
            const int s = 16 * tj + fr; const float as = sm[64 + s];
#pragma unroll
            for (int r = 0; r < 4; ++r) { const int l = 16 * ti + 4 * fq + r; const float al = sm[64 + l];
                const float mv = (tj <= ti && l >= s) ? cb[r] * fexp(fminf(al - as, 0.f)) : 0.f; Mm[l * S64 + s] = (bf16_t)f2bf(mv); }
            asm volatile("" ::: "memory");
        }
        { const float cd = sm[256];
#pragma unroll
          for (int jj = 0; jj < 4; ++jj) { S[jj] = S[jj] * cd;
#pragma unroll
            for (int ks = 0; ks < 2; ++ks) { const bf16x8 a = *(const LAS bf16x8*)(XTW + (16 * pi + fr) * S64 + 32 * ks + 8 * fq); const bf16x8 b = *(const LAS bf16x8*)(BT + (64 * nb + 16 * jj + fr) * S64 + 32 * ks + 8 * fq);
                S[jj] = __builtin_amdgcn_mfma_f32_16x16x32_bf16(a, b, S[jj], 0, 0, 0); }
            if (jj & 1) asm volatile("" ::: "memory"); } }
        LBAR();
#pragma unroll
        for (int jj = 0; jj < 2; ++jj) { const int tj = tj0 + jj; f32x4 yd = (f32x4){0.f, 0.f, 0.f, 0.f};
#pragma unroll
            for (int ks = 0; ks < 2; ++ks) { const bf16x8 a = *(const LAS bf16x8*)(Mm + (16 * ti + fr) * S64 + 32 * ks + 8 * fq); const bf16x8 b = *(const LAS bf16x8*)(XT + (16 * tj + fr) * S64 + 32 * ks + 8 * fq);
                yd = __builtin_amdgcn_mfma_f32_16x16x32_bf16(a, b, yd, 0, 0, 0); }
#pragma unroll
            for (int r = 0; r < 4; ++r) { const int l = 16 * ti + 4 * fq + r; Y[l * YP + 16 * tj + fr] = yd[r] + sm[192 + l] * yo[jj][r]; } }
        LBAR();
        { float y8[8], z8[8]; const f32x4 ya = *(const LAS f32x4*)(Y + xl * YP + 8 * xcg), yb = *(const LAS f32x4*)(Y + xl * YP + 8 * xcg + 4);
#pragma unroll
          for (int i = 0; i < 4; ++i) { y8[i] = ya[i]; y8[4 + i] = yb[i]; }
          unpack8(zcur, z8); float ss = 0.f;
#pragma unroll
          for (int i = 0; i < 8; ++i) { const float v = (y8[i] + Dh * xs8[i]) * fsilu(z8[i]); y8[i] = v; ss += v * v; }
          asm volatile("" ::: "memory");
          *(u32x4*)(H + (rowb + xl) * DINP + C_Z + hd * 64 + 8 * xcg) = pack8(y8);
          ss += __shfl_xor(ss, 1); ss += __shfl_xor(ss, 2); ss += __shfl_xor(ss, 4);
          if (xcg == 0) ws_f(F, WS_SSQ)[((size_t)sl * SEQ + rowb + xl) * 32 + hd] = ss; }
    }
    float* so = F.out + O_SSP + ((((size_t)layer * BATCH + mb * NSEQ_MB + sl) * 32 + hd) * 64) * 128;
#pragma unroll
    for (int jj = 0; jj < 4; ++jj)
#pragma unroll
        for (int r = 0; r < 4; ++r) so[(size_t)(16 * pi + 4 * fq + r) * 128 + 64 * nb + 16 * jj + fr] = S[jj][r];
    VM_WAIT(0); __syncthreads();
}

__device__ __forceinline__ void ssd_sample_unit(const Frame& F, int layer, int sq, int hd) {
    const int tid = F.tid, lane = F.lane; LAS float* L = (LAS float*)F.lds;
    LAS float* xs = L; LAS float* Bs = L + 16 * 64; LAS float* Cs = Bs + 16 * 128; LAS float* dts = Cs + 16 * 128; LAS float* das = dts + 16; LAS float* Yl = das + 16;
    const int g = hd >> 2;
    bf16_t* H = ws_bf(F, WS_H) + (size_t)(NP + sq * 16) * DINP;
    const float* hist = F.in[I_SCV] + ((size_t)layer * DECB + sq) * 3 * CONVDIM;
    const float* convw = F.in[I_CONVW] + (size_t)layer * 4 * CONVDIM; const float* convb = F.in[I_CONVB] + (size_t)layer * CONVDIM;
    __syncthreads();
    for (int it = tid; it < 16 * 320; it += NTHREADS) { const int t = it / 320, c = it % 320; const int xc = c < 64 ? hd * 64 + c : (c < 192 ? 2048 + g * 128 + (c - 64) : 3072 + g * 128 + (c - 192));
        float a = convb[xc];
#pragma unroll
        for (int i = 0; i < 4; ++i) { const int tt = t - 3 + i; const float v = tt >= 0 ? bf2f(H[(size_t)tt * DINP + C_X + xc]) : hist[(tt + 3) * CONVDIM + xc]; a += v * convw[i * CONVDIM + xc]; }
        a = fsilu(a);
        if (c < 64) xs[t * 64 + c] = a; else if (c < 192) Bs[t * 128 + c - 64] = a; else Cs[t * 128 + c - 192] = a; }
    if (tid < 16) { const float dt = softplus_f(bf2f(H[(size_t)tid * DINP + C_DT + hd]) + F.in[I_DTB][layer * 32 + hd]); dts[tid] = dt; das[tid] = fexp(-fexp(F.in[I_ALOG][layer * 32 + hd]) * dt); }
    __syncthreads();
    const int p = tid >> 3, n0 = (tid & 7) * 16;
    const size_t sbase = ((((size_t)layer * DECB + sq) * 32 + hd) * 64 + p) * 128 + n0;
    float S[16];
#pragma unroll
    for (int i = 0; i < 16; ++i) S[i] = F.in[I_SST][sbase + i];
    for (int t = 0; t < 16; ++t) { const float dec = das[t], xv = xs[t * 64 + p] * dts[t]; float part = 0.f;
#pragma unroll
        for (int i = 0; i < 16; ++i) { S[i] = S[i] * dec + xv * Bs[t * 128 + n0 + i]; part += Cs[t * 128 + n0 + i] * S[i]; }
        part += __shfl_xor(part, 1); part += __shfl_xor(part, 2); part += __shfl_xor(part, 4);
        if ((tid & 7) == 0) Yl[t * 64 + p] = part; }
#pragma unroll
    for (int i = 0; i < 16; ++i) F.out[O_SSS + sbase + i] = S[i];
    __syncthreads();
    const float Dh = F.in[I_SD][layer * 32 + hd];
#pragma unroll
    for (int j = 0; j < 2; ++j) { const int it = tid + 512 * j, t = it >> 6, pp = it & 63;
        const float z = bf2f(H[(size_t)t * DINP + C_Z + hd * 64 + pp]); const float v = (Yl[t * 64 + pp] + Dh * xs[t * 64 + pp]) * fsilu(z);
        H[(size_t)t * DINP + C_Z + hd * 64 + pp] = (bf16_t)f2bf(v);
        const float ss = wave_sum(v * v);
        if (lane == 0) ws_f(F, WS_SSQ)[((size_t)NP + sq * 16 + t) * 32 + hd] = ss; }
}

__device__ __forceinline__ int t5_bucket(int rel) {
    const int n = rel < 0 ? -rel : rel; const int b = rel > 0 ? 16 : 0;
    if (n < 8) return b + n;
    int v = 8; v += n >= 12; v += n >= 16; v += n >= 23; v += n >= 32; v += n >= 46; v += n >= 64; v += n >= 91;
    return b + v;
}
constexpr int AK_P = 72, AV_P = 200;
constexpr int AL_K = 0, AL_VT = AL_K + 192 * AK_P * 2, AL_LUT = AL_VT + 64 * AV_P * 2, AL_END = AL_LUT + 4 * 256 * 4;
static_assert(AL_END <= RING_BYTES, "attention LDS map");
__device__ __forceinline__ void attn_prompt_unit(const Frame& F, int layer, int sl, int ck, int kh) {
    const int tid = F.tid, lane = F.lane, w = F.wave, q32 = lane & 31, hi = lane >> 5;
    LAS bf16_t* Kl = (LAS bf16_t*)(F.lds + AL_K); LAS bf16_t* VT = (LAS bf16_t*)(F.lds + AL_VT); LAS float* lut = (LAS float*)(F.lds + AL_LUT);
    bf16_t* H = ws_bf(F, WS_H) + (size_t)sl * SEQ * DINP;
    __syncthreads();
#pragma unroll
    for (int j = 0; j < 3; ++j) { const int id = tid + 512 * j, key = id >> 3, cg = id & 7; const int t = 64 * (ck - 2) + key;
        u32x4 kv = (u32x4){0u, 0u, 0u, 0u}, vv = kv;
        if (t >= 0) { kv = *(const u32x4*)(H + (size_t)t * DINP + C_K + kh * 64 + 8 * cg); vv = *(const u32x4*)(H + (size_t)t * DINP + C_V + kh * 64 + 8 * cg); }
        *(LAS u32x4*)(Kl + key * AK_P + 8 * cg) = kv;
        VT[(8 * cg + 0) * AV_P + key] = (bf16_t)(vv.x & 0xffffu); VT[(8 * cg + 1) * AV_P + key] = (bf16_t)(vv.x >> 16); VT[(8 * cg + 2) * AV_P + key] = (bf16_t)(vv.y & 0xffffu); VT[(8 * cg + 3) * AV_P + key] = (bf16_t)(vv.y >> 16);
        VT[(8 * cg + 4) * AV_P + key] = (bf16_t)(vv.z & 0xffffu); VT[(8 * cg + 5) * AV_P + key] = (bf16_t)(vv.z >> 16); VT[(8 * cg + 6) * AV_P + key] = (bf16_t)(vv.w & 0xffffu); VT[(8 * cg + 7) * AV_P + key] = (bf16_t)(vv.w >> 16); }
    for (int e = tid; e < 4 * 255; e += NTHREADS) { const int gg = e / 255, idx = e % 255; lut[gg * 256 + idx] = F.in[I_RELB][t5_bucket(idx - 191) * 16 + kh * 4 + gg]; }
    __syncthreads();
    const int gq = w >> 1, qh = w & 1, head = kh * 4 + gq;
    const size_t qrow = (size_t)ck * 64 + 32 * qh + q32;
    bf16x8 qf[4];
#pragma unroll
    for (int ds = 0; ds < 4; ++ds) qf[ds] = *(const bf16x8*)(H + qrow * DINP + C_Q + head * 64 + 16 * ds + 8 * hi);
    f32x16 sc[6];
#pragma unroll
    for (int kt = 0; kt < 6; ++kt) {
#pragma unroll
        for (int r = 0; r < 16; ++r) sc[kt][r] = 0.f;
#pragma unroll
        for (int ds = 0; ds < 4; ++ds) { const bf16x8 a = *(const LAS bf16x8*)(Kl + (32 * kt + q32) * AK_P + 16 * ds + 8 * hi); sc[kt] = __builtin_amdgcn_mfma_f32_32x32x16_bf16(a, qf[ds], sc[kt], 0, 0, 0); } }
    const int qidx = 32 * qh + q32; const float sink = F.in[I_SINK][layer * 16 + head];
    float mx = -3.0e38f;
#pragma unroll
    for (int kt = 0; kt < 6; ++kt)
#pragma unroll
        for (int r = 0; r < 16; ++r) { const int key = 32 * kt + (r & 3) + 8 * (r >> 2) + 4 * hi; const int rel = key - 128 - qidx;
            float s = sc[kt][r] * 0.125f + lut[gq * 256 + rel + 191]; if (64 * ck + key - 128 < 0) s = -1e30f; sc[kt][r] = s; mx = fmaxf(mx, s); }
    mx = fmaxf(mx, __shfl_xor(mx, 32)); mx = fmaxf(mx, sink);
    float sum = 0.f;
#pragma unroll
    for (int kt = 0; kt < 6; ++kt)
#pragma unroll
        for (int r = 0; r < 16; ++r) { const float e = fexp(sc[kt][r] - mx); sc[kt][r] = e; sum += e; }
    sum += __shfl_xor(sum, 32);
    const float inv = 1.0f / (sum + fexp(sink - mx));
    f32x16 o[2];
#pragma unroll
    for (int d2 = 0; d2 < 2; ++d2)
#pragma unroll
        for (int r = 0; r < 16; ++r) o[d2][r] = 0.f;
#pragma unroll
    for (int kt = 0; kt < 6; ++kt)
#pragma unroll
        for (int s = 0; s < 2; ++s) {
            u32x4 pw; pw.x = pk2(sc[kt][8 * s + 0], sc[kt][8 * s + 1]); pw.y = pk2(sc[kt][8 * s + 2], sc[kt][8 * s + 3]); pw.z = pk2(sc[kt][8 * s + 4], sc[kt][8 * s + 5]); pw.w = pk2(sc[kt][8 * s + 6], sc[kt][8 * s + 7]);
            const bf16x8 pa = __builtin_bit_cast(bf16x8, pw);
#pragma unroll
            for (int d2 = 0; d2 < 2; ++d2) { const LAS bf16_t* vp = VT + (32 * d2 + q32) * AV_P + 32 * kt + 16 * s + 4 * hi;
                const u32x2 lo = *(const LAS u32x2*)vp, hh = *(const LAS u32x2*)(vp + 8); u32x4 vw; vw.x = lo.x; vw.y = lo.y; vw.z = hh.x; vw.w = hh.y;
                o[d2] = __builtin_amdgcn_mfma_f32_32x32x16_bf16(pa, __builtin_bit_cast(bf16x8, vw), o[d2], 0, 0, 0); } }
#pragma unroll
    for (int r = 0; r < 16; ++r) { const int q = (r & 3) + 8 * (r >> 2) + 4 * hi; const float iv = __shfl(inv, q);
        bf16_t* op = H + ((size_t)ck * 64 + 32 * qh + q) * DINP + C_Q + head * 64 + q32;
        op[0] = (bf16_t)f2bf(o[0][r] * iv); op[32] = (bf16_t)f2bf(o[1][r] * iv); }
}
__device__ __forceinline__ void attn_sample_unit(const Frame& F, int layer, int sq, int kh) {
    const int tid = F.tid; LAS float* L = (LAS float*)F.lds;
    LAS float* Kf = L; LAS float* Vf = Kf + 144 * 65; LAS float* Qf = Vf + 144 * 64; LAS float* P = Qf + 64 * 65; LAS float* Pinv = P + 64 * 145;
    static_assert((144 * 65 + 144 * 64 + 64 * 65 + 64 * 145 + 64) * 4 <= RING_BYTES, "sample attention LDS map");
    bf16_t* H = ws_bf(F, WS_H) + (size_t)(NP + sq * 16) * DINP;
    const float* ck = F.in[I_CK] + ((size_t)layer * DECB + sq) * WINDOW * 256; const float* cv = F.in[I_CV] + ((size_t)layer * DECB + sq) * WINDOW * 256;
    __syncthreads();
    for (int i = tid; i < 144 * 64; i += NTHREADS) { const int key = i >> 6, d = i & 63;
        Kf[key * 65 + d] = key < 128 ? ck[(size_t)key * 256 + kh * 64 + d] : bf2f(H[(size_t)(key - 128) * DINP + C_K + kh * 64 + d]);
        Vf[key * 64 + d] = key < 128 ? cv[(size_t)key * 256 + kh * 64 + d] : bf2f(H[(size_t)(key - 128) * DINP + C_V + kh * 64 + d]); }
    for (int i = tid; i < 64 * 64; i += NTHREADS) { const int row = i >> 6, d = i & 63; Qf[row * 65 + d] = bf2f(H[(size_t)(row & 15) * DINP + C_Q + (kh * 4 + (row >> 4)) * 64 + d]); }
    __syncthreads();
    for (int i = tid; i < 64 * 144; i += NTHREADS) { const int row = i / 144, key = i % 144; float s = 0.f;
        for (int d = 0; d < 64; ++d) s += Qf[row * 65 + d] * Kf[key * 65 + d];
        P[row * 145 + key] = s * 0.125f + F.in[I_RELB][t5_bucket(key - 128 - (row & 15)) * 16 + kh * 4 + (row >> 4)]; }
    __syncthreads();
    { const int row = tid >> 3, sub = tid & 7; const float sink = F.in[I_SINK][layer * 16 + kh * 4 + (row >> 4)]; float mx = -3.0e38f;
      for (int k = sub; k < 144; k += 8) mx = fmaxf(mx, P[row * 145 + k]);
      mx = fmaxf(mx, __shfl_xor(mx, 1)); mx = fmaxf(mx, __shfl_xor(mx, 2)); mx = fmaxf(mx, __shfl_xor(mx, 4)); mx = fmaxf(mx, sink);
      float sum = 0.f;
      for (int k = sub; k < 144; k += 8) { const float e = fexp(P[row * 145 + k] - mx); P[row * 145 + k] = e; sum += e; }
      sum += __shfl_xor(sum, 1); sum += __shfl_xor(sum, 2); sum += __shfl_xor(sum, 4);
      if (sub == 0) Pinv[row] = 1.0f / (sum + fexp(sink - mx)); }
    __syncthreads();
    { const int row = tid >> 3, d0 = (tid & 7) * 8; float o[8] = {0.f, 0.f, 0.f, 0.f, 0.f, 0.f, 0.f, 0.f};
      for (int k = 0; k < 144; ++k) { const float pv = P[row * 145 + k];
#pragma unroll
          for (int i = 0; i < 8; ++i) o[i] += pv * Vf[k * 64 + d0 + i]; }
      const float iv = Pinv[row];
#pragma unroll
      for (int i = 0; i < 8; ++i) o[i] *= iv;
      *(u32x4*)(H + (size_t)(row & 15) * DINP + C_Q + (kh * 4 + (row >> 4)) * 64 + d0) = pack8(o); }
}
__device__ __forceinline__ void sc_unit(const Frame& F, int layer, int tile) {
    const int tid = F.tid, cg = tid & 127, rs = tid >> 7; bf16_t* H = ws_bf(F, WS_H);
    const float* wsc = F.in[I_SCW] + (size_t)layer * 3 * D + 8 * cg; float wt[3][8];
#pragma unroll
    for (int i = 0; i < 3; ++i)
#pragma unroll
        for (int c = 0; c < 8; ++c) wt[i][c] = wsc[i * D + c];
    for (int rr = rs; rr < 64; rr += 4) { const int row = tile * 64 + rr; const bool smp = row >= NP;
        const int tt = smp ? (row - NP) & 15 : row % SEQ; float a[8] = {0.f, 0.f, 0.f, 0.f, 0.f, 0.f, 0.f, 0.f};
#pragma unroll
        for (int i = 0; i < 3; ++i) { const int t2 = tt - 2 + i; float u[8];
            if (t2 >= 0) { float c8[8], h8[8]; unpack8(*(const u32x4*)(H + (size_t)(row - 2 + i) * DINP + C_SCC + 8 * cg), c8); unpack8(*(const u32x4*)(H + (size_t)(row - 2 + i) * DINP + C_SCH + 8 * cg), h8);
#pragma unroll
                for (int c = 0; c < 8; ++c) u[c] = c8[c] * h8[c]; }
            else if (smp) { const float* hp = F.in[I_SSC] + (((size_t)layer * DECB + ((row - NP) >> 4)) * 2 + (t2 + 2)) * D + 8 * cg;
#pragma unroll
                for (int c = 0; c < 8; ++c) u[c] = hp[c]; }
            else {
#pragma unroll
                for (int c = 0; c < 8; ++c) u[c] = 0.f; }
#pragma unroll
            for (int c = 0; c < 8; ++c) a[c] += u[c] * wt[i][c]; }
        float b8[8]; unpack8(*(const u32x4*)(H + (size_t)row * DINP + C_SCB + 8 * cg), b8);
#pragma unroll
        for (int c = 0; c < 8; ++c) a[c] *= b8[c];
        *(u32x4*)(H + (size_t)row * DINP + C_SCB + 8 * cg) = pack8(a); }
}
__device__ __forceinline__ void state_out_unit(const Frame& F, int layer, int mb, int sl, bool smp) {
    const int tid = F.tid; const bf16_t* H = ws_bf(F, WS_H);
    const int nkv = smp ? DECS : WINDOW, len = smp ? DECS : SEQ; const size_t row0 = smp ? (size_t)NP + sl * 16 : (size_t)sl * SEQ; const int sg = smp ? sl : mb * NSEQ_MB + sl;
    const size_t nb_ = smp ? DECB : BATCH;
    float* ko = F.out + (smp ? O_KS : O_KP) + ((size_t)layer * nb_ + sg) * nkv * 256; float* vo = F.out + (smp ? O_VS : O_VP) + ((size_t)layer * nb_ + sg) * nkv * 256;
    for (int i = tid; i < nkv * 32; i += NTHREADS) { const int j = i >> 5, c8 = (i & 31) * 8; const bf16_t* hp = H + (row0 + len - nkv + j) * DINP; float f[8];
        unpack8(*(const u32x4*)(hp + C_K + c8), f); *(f32x4*)(ko + (size_t)j * 256 + c8) = (f32x4){f[0], f[1], f[2], f[3]}; *(f32x4*)(ko + (size_t)j * 256 + c8 + 4) = (f32x4){f[4], f[5], f[6], f[7]};
        unpack8(*(const u32x4*)(hp + C_V + c8), f); *(f32x4*)(vo + (size_t)j * 256 + c8) = (f32x4){f[0], f[1], f[2], f[3]}; *(f32x4*)(vo + (size_t)j * 256 + c8 + 4) = (f32x4){f[4], f[5], f[6], f[7]}; }
    float* co = F.out + (smp ? O_CVS : O_CVP) + ((size_t)layer * nb_ + sg) * 3 * CONVDIM;
    for (int i = tid; i < 3 * 512; i += NTHREADS) { const int j = i / 512, c8 = (i % 512) * 8; float f[8]; unpack8(*(const u32x4*)(H + (row0 + len - 3 + j) * DINP + C_X + c8), f);
        *(f32x4*)(co + (size_t)j * CONVDIM + c8) = (f32x4){f[0], f[1], f[2], f[3]}; *(f32x4*)(co + (size_t)j * CONVDIM + c8 + 4) = (f32x4){f[4], f[5], f[6], f[7]}; }
    float* so = F.out + (smp ? O_SCS : O_SCP) + ((size_t)layer * nb_ + sg) * 2 * D;
    for (int i = tid; i < 2 * 128; i += NTHREADS) { const int j = i >> 7, c8 = (i & 127) * 8; float c[8], h[8]; const bf16_t* hp = H + (row0 + len - 2 + j) * DINP;
        unpack8(*(const u32x4*)(hp + C_SCC + c8), c); unpack8(*(const u32x4*)(hp + C_SCH + c8), h);
        *(f32x4*)(so + (size_t)j * D + c8) = (f32x4){c[0] * h[0], c[1] * h[1], c[2] * h[2], c[3] * h[3]}; *(f32x4*)(so + (size_t)j * D + c8 + 4) = (f32x4){c[4] * h[4], c[5] * h[5], c[6] * h[6], c[7] * h[7]}; }
}
#ifndef MIX_MASK
#define MIX_MASK 0xFF
#endif
#define MIXON(b) ((MIX_MASK >> (b)) & 1)
__device__ __forceinline__ void step_mixers(const Frame& F, int layer, int mb) {
    const int n_ssd = NSEQ_MB * 32, n_att = NSEQ_MB * NCHUNK * NKV, n_sc = rows_of(mb) / 64, n_so = NSEQ_MB + (mb == 0 ? DECB : 0);
    const int n_ss = mb == 0 ? DECB * 32 : 0, n_as = mb == 0 ? DECB * NKV : 0;
    const int total = n_ssd + n_att + n_sc + n_so + n_ss + n_as;
    for (int un = F.bid; un < total; un += F.G) { int r = un;
#define UF(Fu) Frame Fu = F; Fu.tid = opq(F.tid); Fu.lane = Fu.tid & 63; Fu.wave = __builtin_amdgcn_readfirstlane(Fu.tid >> 6)
        if (r < n_ssd) { PROBE_T0(12) if constexpr (MIXON(0)) { UF(Fu); ssd_prompt_unit(Fu, layer, mb, r >> 5, r & 31); } PROBE_T1(12) continue; } r -= n_ssd;
        if (r < n_att) { if constexpr (MIXON(1)) { UF(Fu); attn_prompt_unit(Fu, layer, r / (NCHUNK * NKV), (r / NKV) % NCHUNK, r % NKV); } continue; } r -= n_att;
        if (r < n_sc) { if constexpr (MIXON(2)) { UF(Fu); sc_unit(Fu, layer, r); } continue; } r -= n_sc;
        if (r < n_so) { if constexpr (MIXON(3)) { UF(Fu); state_out_unit(Fu, layer, mb, r < NSEQ_MB ? r : r - NSEQ_MB, r >= NSEQ_MB); } continue; } r -= n_so;
        if (r < n_ss) { if constexpr (MIXON(4)) { UF(Fu); ssd_sample_unit(Fu, layer, r >> 5, r & 31); } continue; } r -= n_ss;
        if constexpr (MIXON(5)) { UF(Fu); attn_sample_unit(Fu, layer, r >> 2, r & 3); }
    }
}
__device__ __forceinline__ void step_gnorm(const Frame& F, int mb) {
    const int gw = F.bid * NWAVES + F.wave, NGW = F.G * NWAVES, nr = rows_of(mb); bf16_t* H = ws_bf(F, WS_H); const float* ssq = ws_f(F, WS_SSQ);
    constexpr int RB = 4; const int g = F.lane >> 3;
    for (int r0 = gw; r0 < nr; r0 += RB * NGW) {
        u32x4 d[RB][4]; f32x4 q[RB];
#pragma unroll
        for (int i = 0; i < RB; ++i) { const int r = r0 + i * NGW < nr ? r0 + i * NGW : r0; q[i] = *(const f32x4*)(ssq + (size_t)r * 32 + 4 * g); const u32x4* p = (const u32x4*)(H + (size_t)r * DINP + C_Z + 32 * F.lane);
#pragma unroll
            for (int j = 0; j < 4; ++j) d[i][j] = p[j]; }
        asm volatile("" ::: "memory");
#pragma unroll
        for (int i = 0; i < RB; ++i) { const int r = r0 + i * NGW; if (r >= nr) continue;
            const float rstd = 1.0f / sqrtf(((q[i][0] + q[i][1]) + (q[i][2] + q[i][3])) * (1.0f / 256.0f) + LN_EPS); u32x4* p = (u32x4*)(H + (size_t)r * DINP + C_Z + 32 * F.lane);
#pragma unroll
            for (int j = 0; j < 4; ++j) { float f[8]; unpack8(d[i][j], f);
#pragma unroll
                for (int k = 0; k < 8; ++k) f[k] *= rstd;
                p[j] = pack8(f); } }
    }
}
constexpr int LOG_NEXP = NEXP == 32 ? 5 : (NEXP == 16 ? 4 : (NEXP == 8 ? 3 : 2));
template <int N, int MASK> struct RedStep {
    static __device__ __forceinline__ void run(float* v, int lane) {
        constexpr int Hn = N / 2; const bool up = (lane & MASK) != 0;
#pragma unroll
        for (int i = 0; i < Hn; ++i) { const float keep = up ? v[i + Hn] : v[i], send = up ? v[i] : v[i + Hn]; v[i] = keep + __shfl_xor(send, MASK); }
        if constexpr (Hn > 1) RedStep<Hn, (MASK >> 1)>::run(v, lane);
    }
};
__device__ __forceinline__ void step_ln1_router(const Frame& F, int layer, int mb) {
    LAS float* wT = (LAS float*)F.lds;
    const float* rw = F.in[I_RW] + (size_t)layer * D * NEXP;
    __syncthreads();
    for (int i = F.tid; i < D * NEXP; i += NTHREADS) { const int e = i / D, k = i % D; wT[i] = rw[(size_t)k * NEXP + e]; }
    unsigned* cnt = F.ctl + CW_CNT + (mb * DEPTH + layer) * 64;
    LAS unsigned* lcnt = (LAS unsigned*)(F.lds + MISC_OFF) + 128;
    if (F.tid < 64) lcnt[F.tid] = 0u;
    __syncthreads();
    const int gw = F.bid * NWAVES + F.wave, NGW = F.G * NWAVES, nr = rows_of(mb), lane = F.lane;
    const float* lg = F.in[I_LN1G] + (size_t)layer * D; const float* lb = F.in[I_LN1B] + (size_t)layer * D; const float* rb = F.in[I_RB] + (size_t)layer * NEXP;
    bf16_t* XB = ws_bf(F, WS_XB); int* topi = (int*)(F.ws + WS_TOPI); float* gate = ws_f(F, WS_GATE); int* pos = (int*)(F.ws + WS_POS);
    constexpr int RB = 4, NH = NEXP / 2, LOGH = LOG_NEXP - 1;
    const int myexp = ((lane & 1) * NH) | ((lane >> (6 - LOGH)) & (NH - 1));
    const float myb = rb[myexp];
    for (int r0 = gw; r0 < nr; r0 += RB * NGW) {
        f32x4 v[RB][4]; int rr[RB]; bool ok[RB];
#pragma unroll
        for (int i = 0; i < RB; ++i) { const int r = r0 + i * NGW; ok[i] = r < nr; rr[i] = ok[i] ? r : r0; const float* xr = x_out_row(F, mb, rr[i]);
#pragma unroll
            for (int j = 0; j < 4; ++j) v[i][j] = *((const f32x4*)xr + lane + 64 * j); }
        asm volatile("" ::: "memory");
#pragma unroll
        for (int i = 0; i < RB; ++i) {
            float* xr = x_out_row(F, mb, rr[i]); float s = 0.f;
#pragma unroll
            for (int j = 0; j < 4; ++j) s += (v[i][j][0] + v[i][j][1]) + (v[i][j][2] + v[i][j][3]);
            const float mean = wave_sum(s) * (1.0f / D); float s2 = 0.f;
#pragma unroll
            for (int j = 0; j < 4; ++j) { v[i][j] = v[i][j] - mean; s2 += (v[i][j][0] * v[i][j][0] + v[i][j][1] * v[i][j][1]) + (v[i][j][2] * v[i][j][2] + v[i][j][3] * v[i][j][3]); }
            const float rstd = 1.0f / sqrtf(wave_sum(s2) * (1.0f / D) + LN_EPS);
#pragma unroll
            for (int j = 0; j < 4; ++j) { const f32x4 gg = *((const f32x4*)lg + lane + 64 * j), bb = *((const f32x4*)lb + lane + 64 * j); v[i][j] = v[i][j] * rstd * gg + bb;
                if (ok[i]) { *((f32x4*)xr + lane + 64 * j) = v[i][j]; u32x2 w; w.x = pk2(v[i][j][0], v[i][j][1]); w.y = pk2(v[i][j][2], v[i][j][3]); *((u32x2*)(XB + (size_t)rr[i] * D) + lane + 64 * j) = w; } }
        }
        float val[RB];
#pragma unroll
        for (int hf = 0; hf < 2; ++hf) {
            float lgt[RB][NH];
#pragma unroll
            for (int e = 0; e < NH; ++e) { float a[RB];
#pragma unroll
                for (int i = 0; i < RB; ++i) a[i] = 0.f;
#pragma unroll
                for (int j = 0; j < 4; ++j) { const f32x4 wv = *((const LAS f32x4*)(wT + (hf * NH + e) * D) + lane + 64 * j);
#pragma unroll
                    for (int i = 0; i < RB; ++i) a[i] += (v[i][j][0] * wv[0] + v[i][j][1] * wv[1]) + (v[i][j][2] * wv[2] + v[i][j][3] * wv[3]); }
#pragma unroll
                for (int i = 0; i < RB; ++i) lgt[i][e] = a[i];
                if ((e & 1) == 1) asm volatile("" ::: "memory"); }
#pragma unroll
            for (int i = 0; i < RB; ++i) { RedStep<NH, 32>::run(lgt[i], lane); float tot = lgt[i][0];
#pragma unroll
                for (int mk = (32 >> LOGH); mk >= 1; mk >>= 1) tot += __shfl_xor(tot, mk);
                if ((lane & 1) == hf) val[i] = tot + myb; }
        }
#pragma unroll
        for (int i = 0; i < RB; ++i) {
            float tv[4]; int te[4]; float vv = val[i];
#pragma unroll
            for (int k = 0; k < 4; ++k) { float bv = vv; int be = myexp;
#pragma unroll
                for (int o = 1; o < 64; o <<= 1) { const float ov = __shfl_xor(bv, o); const int oe = __shfl_xor(be, o); if (ov > bv || (ov == bv && oe < be)) { bv = ov; be = oe; } }
                tv[k] = bv; te[k] = be; if (myexp == be) vv = -3.0e38f; }
            const float e1 = fexp(tv[1] - tv[0]), e2 = fexp(tv[2] - tv[0]), e3 = fexp(tv[3] - tv[0]); const float inv = 1.0f / (1.0f + e1 + e2 + e3);
            if (lane < 4 && ok[i]) { const int e = lane == 0 ? te[0] : (lane == 1 ? te[1] : (lane == 2 ? te[2] : te[3])); const float gv = (lane == 0 ? 1.0f : (lane == 1 ? e1 : (lane == 2 ? e2 : e3))) * inv;
                const unsigned rk = __hip_atomic_fetch_add(lcnt + e, 1u, __ATOMIC_RELAXED, __HIP_MEMORY_SCOPE_WORKGROUP);
                topi[(size_t)rr[i] * 4 + lane] = e; gate[(size_t)rr[i] * 4 + lane] = gv; pos[(size_t)rr[i] * 4 + lane] = (int)rk; }
        }
    }
    __syncthreads();
    if (F.tid < NEXP) lcnt[32 + F.tid] = __hip_atomic_fetch_add(cnt + F.tid, lcnt[F.tid], __ATOMIC_RELAXED, __HIP_MEMORY_SCOPE_AGENT);
    __syncthreads();
    for (int r = gw; r < nr; r += NGW) if (lane < 4) pos[(size_t)r * 4 + lane] += (int)lcnt[32 + topi[(size_t)r * 4 + lane]];
}
__device__ __forceinline__ int moe_table(const Frame& F, int layer, int mb) {
    LAS int* M = (LAS int*)(F.lds + MISC_OFF);
    __syncthreads();
    if (F.tid == 0) { unsigned* cnt = F.ctl + CW_CNT + (mb * DEPTH + layer) * 64; int acc = 0;
        for (int e = 0; e < NEXP; ++e) { const int c = (int)__hip_atomic_load(cnt + e, __ATOMIC_RELAXED, __HIP_MEMORY_SCOPE_AGENT); M[64 + e] = acc * 256; acc += (c + 255) / 256; M[16 + e] = acc; } }
    __syncthreads();
    return M[16 + NEXP - 1];
}
__device__ __forceinline__ void step_gather(const Frame& F, int layer, int mb) {
    (void)moe_table(F, layer, mb); const LAS int* M = (const LAS int*)(F.lds + MISC_OFF);
    const int gw = F.bid * NWAVES + F.wave, NGW = F.G * NWAVES, nr = rows_of(mb), lane = F.lane;
    const bf16_t* XB = ws_bf(F, WS_XB); bf16_t* XS = ws_bf(F, WS_H); const int* topi = (const int*)(F.ws + WS_TOPI); const float* gate = ws_f(F, WS_GATE); int* pos = (int*)(F.ws + WS_POS); float* gs = ws_f(F, WS_GSORT);
    constexpr int RB = 4;
    for (int r0 = gw; r0 < nr; r0 += RB * NGW) {
        u32x4 a[RB], b[RB]; int pk[RB][4]; float gk[RB];
#pragma unroll
        for (int i = 0; i < RB; ++i) { const int r = r0 + i * NGW < nr ? r0 + i * NGW : r0;
            a[i] = *((const u32x4*)(XB + (size_t)r * D) + lane); b[i] = *((const u32x4*)(XB + (size_t)r * D) + 64 + lane); gk[i] = gate[(size_t)r * 4 + (lane & 3)];
#pragma unroll
            for (int k = 0; k < 4; ++k) { const int e = topi[(size_t)r * 4 + k]; pk[i][k] = M[64 + e] + pos[(size_t)r * 4 + k]; } }
        WAVE_SYNC();
        asm volatile("" ::: "memory");
#pragma unroll
        for (int i = 0; i < RB; ++i) { const int r = r0 + i * NGW; if (r >= nr) continue;
#pragma unroll
            for (int k = 0; k < 4; ++k) { const int p = pk[i][k];
                *((u32x4*)(XS + (size_t)p * D) + lane) = a[i]; *((u32x4*)(XS + (size_t)p * D) + 64 + lane) = b[i];
                if (lane == k) { pos[(size_t)r * 4 + k] = p; gs[p] = gk[i]; } } }
    }
}
__device__ __forceinline__ void step_ln2(const Frame& F, int layer, int mb) {
    const int gw = F.bid * NWAVES + F.wave, NGW = F.G * NWAVES, nr = rows_of(mb), lane = F.lane;
    const float* lg = F.in[I_LN2G] + (size_t)layer * D; const float* lb = F.in[I_LN2B] + (size_t)layer * D;
    const bf16_t* OUTS = ws_bf(F, WS_H) + (size_t)2 * RP * D; const int* pos = (const int*)(F.ws + WS_POS); bf16_t* XB = ws_bf(F, WS_XB);
    constexpr int RB = 2;
    for (int r0 = gw; r0 < nr; r0 += RB * NGW) {
        f32x4 v[RB][4]; u32x2 ow[RB][4][4]; int rr[RB];
#pragma unroll
        for (int i = 0; i < RB; ++i) { rr[i] = r0 + i * NGW < nr ? r0 + i * NGW : r0; const float* xr = x_out_row(F, mb, rr[i]); int p[4];
#pragma unroll
            for (int k = 0; k < 4; ++k) p[k] = pos[(size_t)rr[i] * 4 + k];
#pragma unroll
            for (int j = 0; j < 4; ++j) { v[i][j] = *((const f32x4*)xr + lane + 64 * j);
#pragma unroll
                for (int k = 0; k < 4; ++k) ow[i][k][j] = *((const u32x2*)(OUTS + (size_t)p[k] * D) + lane + 64 * j); } }
        asm volatile("" ::: "memory");
#pragma unroll
        for (int i = 0; i < RB; ++i) { if (r0 + i * NGW >= nr) continue;
            float* xr = x_out_row(F, mb, rr[i]); float s = 0.f;
#pragma unroll
            for (int j = 0; j < 4; ++j) { v[i][j] = v[i][j] * ALPHA;
#pragma unroll
                for (int k = 0; k < 4; ++k) { const u32x2 w = ow[i][k][j]; v[i][j] = v[i][j] + (f32x4){blo(w.x), bhi(w.x), blo(w.y), bhi(w.y)}; }
                s += (v[i][j][0] + v[i][j][1]) + (v[i][j][2] + v[i][j][3]); }
            const float mean = wave_sum(s) * (1.0f / D); float s2 = 0.f;
#pragma unroll
            for (int j = 0; j < 4; ++j) { v[i][j] = v[i][j] - mean; s2 += (v[i][j][0] * v[i][j][0] + v[i][j][1] * v[i][j][1]) + (v[i][j][2] * v[i][j][2] + v[i][j][3] * v[i][j][3]); }
            const float rstd = 1.0f / sqrtf(wave_sum(s2) * (1.0f / D) + LN_EPS);
#pragma unroll
            for (int j = 0; j < 4; ++j) { const f32x4 gg = *((const f32x4*)lg + lane + 64 * j), bb = *((const f32x4*)lb + lane + 64 * j); v[i][j] = v[i][j] * rstd * gg + bb;
                *((f32x4*)xr + lane + 64 * j) = v[i][j]; u32x2 w; w.x = pk2(v[i][j][0], v[i][j][1]); w.y = pk2(v[i][j][2], v[i][j][3]); *((u32x2*)(XB + (size_t)rr[i] * D) + lane + 64 * j) = w; } }
    }
}

constexpr int PH_PER = 11, NSTEPS = 1 + NMB * DEPTH * PH_PER;
__global__ void __launch_bounds__(NTHREADS, 2) fwd(Args args) {
#ifdef EMU
    unsigned char* lds = emu_wg->lds;
#else
    extern __shared__ __attribute__((aligned(16))) unsigned char lds[];
#endif
    Frame F0; F0.lds = (LAS unsigned char*)lds; F0.tid = threadIdx.x; F0.lane = F0.tid & 63; F0.wave = __builtin_amdgcn_readfirstlane(F0.tid >> 6); F0.G = gridDim.x; F0.bid = blockIdx.x;
#ifdef EMU
    F0.in = args.in;
#else
    F0.in = (ArgTab)__builtin_amdgcn_kernarg_segment_ptr();
    static_assert(offsetof(Args, out) == 248 && offsetof(Args, ws) == 256 && offsetof(Args, in) == 0, "PF() reads the argument struct by offset");
#endif
    F0.out = args.out; F0.ws = args.ws; F0.ctl = (unsigned*)(args.ws + WS_CTL);
    const Frame& F = F0;
    const int lo = args.lo, hi = args.hi;
#ifndef EMU
    for (int u = F.tid; u < (LDS_BYTES - MISC_OFF) / 4; u += NTHREADS) ((LAS unsigned*)(F.lds + MISC_OFF))[u] = 0u;
    __syncthreads();
    XcdBarrier bar; bar.bar = F.ctl + CW_BAR; bar.x = 0; bar.st = nullptr;
    if (hi - lo > 1) bar = xcd_barrier_post(F.ctl + CW_BAR, (volatile LAS unsigned*)(F.lds + MISC_OFF) + 8);
#define SEAM(s) do { if ((s) + 1 < hi) { XcdBarrier b2_ = bar; unsigned long long bp_ = (unsigned long long)b2_.bar; asm volatile("" : "+s"(bp_)); b2_.bar = (unsigned*)bp_; xcd_barrier(b2_); } } while (0)
#else
#define SEAM(s) do { } while (0)
#endif
#ifndef PH_MASK
#define PH_MASK 0xFFFFFFFF
#endif
#define IN(s) (lo <= (s) && (s) < hi)
#define PHON(b) ((PH_MASK >> (b)) & 1)
#ifdef EMU
#define PF(Fp) Frame Fp = F0
#else
#define PF(Fp) Frame Fp; { unsigned long long kp_ = (unsigned long long)__builtin_amdgcn_kernarg_segment_ptr(); asm volatile("" : "+s"(kp_)); \
    Fp.in = (ArgTab)kp_; Fp.out = *(float* const __attribute__((address_space(4)))*)(kp_ + 248); Fp.ws = *(unsigned char* const __attribute__((address_space(4)))*)(kp_ + 256); Fp.ctl = (unsigned*)Fp.ws; \
    Fp.lds = F0.lds; Fp.G = F0.G; Fp.bid = F0.bid; Fp.tid = opq(F0.tid); Fp.lane = Fp.tid & 63; Fp.wave = __builtin_amdgcn_readfirstlane(Fp.tid >> 6); }
#endif
    int step = 0;
    if (IN(step)) { PROBE_T0(0) if constexpr (PHON(0)) { PF(F); step_weights(F); } PROBE_T1(0) SEAM(step); }
    ++step;
    for (int mb = 0; mb < NMB; ++mb)
        for (int layer = 0; layer < DEPTH; ++layer) {
            const int nr = rows_of(mb);
            if (IN(step)) { PROBE_T0(1) if constexpr (PHON(1)) { PF(F); if (layer == 0) step_xb(F, mb); } PROBE_T1(1) SEAM(step); }
            ++step;
            if (IN(step)) { PROBE_T0(2) if constexpr (PHON(2)) { PF(F); pg8::Gemm g{ws_bf(F, WS_XB), wl_ptr(F, layer, WL_IN), nr, DINP, D, D}; pg8::StaticOrder S; S.init(nr, DINP, F.G, F.bid);
                pg8::EpiStoreBf16 E{ws_bf(F, WS_H), DINP}; pg8::gemm_phase(F.lds, g, S, E); } PROBE_T1(2) SEAM(step); }
            ++step;
            if (IN(step)) { PROBE_T0(3) if constexpr (PHON(3)) { PF(F); step_mixers(F, layer, mb); } PROBE_T1(3) SEAM(step); }
            ++step;
            if (IN(step)) { PROBE_T0(4) if constexpr (PHON(4)) { PF(F); step_gnorm(F, mb); } PROBE_T1(4) SEAM(step); }
            ++step;
            if (IN(step)) { PROBE_T0(5) if constexpr (PHON(5)) { PF(F); pg8::StaticOrder S; S.init(nr, D, F.G, F.bid); bf16_t* H = ws_bf(F, WS_H); bf16_t* MGb = ws_bf(F, WS_XB);
#ifndef MERGE_MASK
#define MERGE_MASK 7
#endif
                if constexpr (MERGE_MASK & 1) { pg8::Gemm g{H + C_Z, wl_ptr(F, layer, WL_SSD), nr, D, DINNER, DINP}; pg8::EpiGate<0> E{H + C_GSSD, MGb}; pg8::gemm_phase(F.lds, g, S, E); }
                if constexpr (MERGE_MASK & 2) { pg8::Gemm g{H + C_Q, wl_ptr(F, layer, WL_ATT), nr, D, D, DINP}; pg8::EpiGate<1> E{H + C_GATT, MGb}; pg8::gemm_phase(F.lds, g, S, E); }
                if constexpr (MERGE_MASK & 4) { pg8::Gemm g{H + C_SCB, wl_ptr(F, layer, WL_SC), nr, D, D, DINP}; pg8::EpiGate<1> E{H + C_GSC, MGb}; pg8::gemm_phase(F.lds, g, S, E); } }
                PROBE_T1(5) SEAM(step); }
            ++step;
            if (IN(step)) { PROBE_T0(6) if constexpr (PHON(6)) { PF(F); pg8::Gemm g{ws_bf(F, WS_XB), wl_ptr(F, layer, WL_O), nr, D, D, D}; pg8::StaticOrder S; S.init(nr, D, F.G, F.bid);
                pg8::EpiResid E{layer == 0 ? F.in[I_XP] + (size_t)mb * NP * D : F.out + O_YP + (size_t)mb * NP * D, layer == 0 ? F.in[I_XS] : F.out + O_YS, F.out + O_YP + (size_t)mb * NP * D, F.out + O_YS};
                pg8::gemm_phase(F.lds, g, S, E); } PROBE_T1(6) SEAM(step); }
            ++step;
            if (IN(step)) { PROBE_T0(7) if constexpr (PHON(7)) { PF(F); step_ln1_router(F, layer, mb); } PROBE_T1(7) SEAM(step); }
            ++step;
            if (IN(step)) { PROBE_T0(8) if constexpr (PHON(8)) { PF(F); step_gather(F, layer, mb); } PROBE_T1(8) SEAM(step); }
            ++step;
            if (IN(step)) { PROBE_T0(9) if constexpr (PHON(9)) { PF(F); const int nt = moe_table(F, layer, mb); pg8::MoeOrder S{(const LAS int*)(F.lds + MISC_OFF) + 16, 8, nt * 8, F.G, F.bid};
                pg8::Gemm g{ws_bf(F, WS_H), wl_ptr(F, layer, WL_UP), nt * 256, 2048, D, D}; pg8::EpiSwiglu E{ws_bf(F, WS_H) + (size_t)RP * D, F.in[I_BUP] + (size_t)layer * NEXP * 2048};
                pg8::gemm_phase(F.lds, g, S, E); } PROBE_T1(9) SEAM(step); }
            ++step;
            if (IN(step)) { PROBE_T0(10) if constexpr (PHON(10)) { PF(F); const int nt = moe_table(F, layer, mb); pg8::MoeOrder S{(const LAS int*)(F.lds + MISC_OFF) + 16, 4, nt * 4, F.G, F.bid};
                pg8::Gemm g{ws_bf(F, WS_H) + (size_t)RP * D, wl_ptr(F, layer, WL_DN), nt * 256, D, D, D}; pg8::EpiDown E{ws_bf(F, WS_H) + (size_t)2 * RP * D, F.in[I_BDN] + (size_t)layer * NEXP * D, ws_f(F, WS_GSORT)};
                pg8::gemm_phase(F.lds, g, S, E); } PROBE_T1(10) SEAM(step); }
            ++step;
            if (IN(step)) { PROBE_T0(11) if constexpr (PHON(11)) { PF(F); step_ln2(F, layer, mb); } PROBE_T1(11) SEAM(step); }
            ++step;
        }
}

#ifdef EMU
extern int emu_grid, emu_step_lo, emu_step_hi;
#endif
extern "C" void kernel_launch(void* const* d_in, const int* in_sizes, int n_in, void* d_out, int out_size, void* d_ws, size_t ws_size, hipStream_t stream) {
    (void)in_sizes; (void)out_size;
    if (n_in != 31 || ws_size < WS_END) { fprintf(stderr, "kernel_launch: expected 31 inputs and >= %zu bytes of workspace (got %d, %zu)\n", (size_t)WS_END, n_in, ws_size); return; }
    Args a; memset(&a, 0, sizeof(a));
    for (int i = 0; i < 31; ++i) a.in[i] = (const float*)d_in[i];
    a.out = (float*)d_out; a.ws = (unsigned char*)d_ws;
#ifdef EMU
    if (emu_step_lo == 0) memset((char*)d_ws + WS_CTL, 0, CTL_BYTES);
    for (int s = emu_step_lo; s < emu_step_hi && s < NSTEPS; ++s) { a.lo = s; a.hi = s + 1; emu_launch(fwd, emu_grid, NTHREADS, LDS_BYTES, a); fprintf(stderr, "step %d done\n", s); }
#else
    (void)hipMemsetAsync((char*)d_ws + WS_CTL, 0, CTL_BYTES, stream);
    static int grid = 0;
    if (grid == 0) {
        int dev = 0, cus = 0;
        if (hipGetDevice(&dev) != hipSuccess || hipDeviceGetAttribute(&cus, hipDeviceAttributeMultiprocessorCount, dev) != hipSuccess) { grid = -1; return; }
        if (hipFuncSetAttribute((const void*)fwd, hipFuncAttributeMaxDynamicSharedMemorySize, LDS_BYTES) != hipSuccess) { grid = -1; return; }
        int per_cu = 0; (void)hipOccupancyMaxActiveBlocksPerMultiprocessor(&per_cu, (const void*)fwd, NTHREADS, LDS_BYTES); (void)hipGetLastError();
        grid = cus;
    }
    if (grid < 0) return;
#if CFG_ONE_LAUNCH
    a.lo = 0; a.hi = NSTEPS; hipLaunchKernelGGL(fwd, dim3(grid), dim3(NTHREADS), LDS_BYTES, stream, a);
#else
    for (int s = 0; s < NSTEPS; ++s) { a.lo = s; a.hi = s + 1; hipLaunchKernelGGL(fwd, dim3(grid), dim3(NTHREADS), LDS_BYTES, stream, a); }
#endif
#endif
}
```

```cpp
#ifdef EMU
#include "emu.h"
#else
#include <hip/hip_runtime.h>
#endif
#include <cstdio>
#include <cstdint>
#include <cstring>
#include <cstddef>
#include <cmath>

#ifndef CFG_BATCH
#define CFG_BATCH 16
#endif
#ifndef CFG_SEQ
#define CFG_SEQ 4096
#endif
#ifndef CFG_NSEQ_MB
#define CFG_NSEQ_MB 8
#endif
#ifndef CFG_NEXP
#define CFG_NEXP 32
#endif
#ifndef CFG_ONE_LAUNCH
#define CFG_ONE_LAUNCH 1
#endif

constexpr int BATCH = CFG_BATCH, SEQ = CFG_SEQ, NSEQ_MB = CFG_NSEQ_MB, NEXP = CFG_NEXP, NMB = BATCH / NSEQ_MB;
constexpr int D = 1024, DEPTH = 2, DECB = 16, DECS = 16, NS = DECB * DECS;
constexpr int DINNER = 2048, CONVDIM = 4096;
constexpr int NKV = 4, WINDOW = 128, CHUNK = 64;
constexpr int DIN = 13856, DINP = 14080;
constexpr int NP = NSEQ_MB * SEQ, R = NP + NS;
constexpr int RP = ((4 * R + NEXP * 255) + 255) / 256 * 256;
constexpr int NCHUNK = SEQ / CHUNK;
constexpr int C_Z = 0, C_X = 2048, C_B = 4096, C_C = 5120, C_Q = 6144, C_K = 7168, C_V = 7424, C_SCB = 7680, C_SCC = 8704, C_SCH = 9728, C_GSSD = 10752, C_GATT = 11776, C_GSC = 12800, C_DT = 13824;
constexpr float LN_EPS = 1e-5f, ALPHA = 1.41421356237309515f  , SW_LIMIT = 7.0f, SW_ALPHA = 1.702f;
static_assert(BATCH % NSEQ_MB == 0 && SEQ % 256 == 0 && (NEXP & (NEXP - 1)) == 0 && NEXP <= 32 && NEXP >= 4, "config");

constexpr size_t O_YP = 0, O_YS = O_YP + (size_t)BATCH * SEQ * D, O_KP = O_YS + (size_t)NS * D, O_VP = O_KP + (size_t)DEPTH * BATCH * WINDOW * 256,
    O_SSP = O_VP + (size_t)DEPTH * BATCH * WINDOW * 256, O_CVP = O_SSP + (size_t)DEPTH * BATCH * 32 * 64 * 128, O_SCP = O_CVP + (size_t)DEPTH * BATCH * 3 * CONVDIM,
    O_KS = O_SCP + (size_t)DEPTH * BATCH * 2 * D, O_VS = O_KS + (size_t)DEPTH * DECB * DECS * 256, O_SSS = O_VS + (size_t)DEPTH * DECB * DECS * 256,
    O_CVS = O_SSS + (size_t)DEPTH * DECB * 32 * 64 * 128, O_SCS = O_CVS + (size_t)DEPTH * DECB * 3 * CONVDIM, O_END = O_SCS + (size_t)DEPTH * DECB * 2 * D;

constexpr size_t al256(size_t x) { return (x + 255) / 256 * 256; }
constexpr size_t WS_CTL = 0, CTL_BYTES = 1u << 20;
constexpr size_t WS_SSQ = CTL_BYTES, WS_TOPI = WS_SSQ + al256((size_t)R * 32 * 4), WS_GATE = WS_TOPI + al256((size_t)R * 16), WS_POS = WS_GATE + al256((size_t)R * 16),
    WS_GSORT = WS_POS + al256((size_t)R * 16), WS_W = WS_GSORT + al256((size_t)RP * 4);
constexpr size_t WL_IN = 0, WL_SSD = WL_IN + (size_t)DINP * D * 2, WL_ATT = WL_SSD + (size_t)D * DINNER * 2, WL_SC = WL_ATT + (size_t)D * D * 2, WL_O = WL_SC + (size_t)D * D * 2,
    WL_UP = WL_O + (size_t)D * D * 2, WL_DN = WL_UP + (size_t)NEXP * 2048 * D * 2, WL_BYTES = WL_DN + (size_t)NEXP * D * D * 2;
constexpr size_t WS_XB = WS_W + DEPTH * WL_BYTES, WS_H = WS_XB + (size_t)R * D * 2;
constexpr size_t H_BYTES = (size_t)R * DINP * 2, MOE_BYTES = (size_t)3 * RP * D * 2, U_BYTES = H_BYTES > MOE_BYTES ? H_BYTES : MOE_BYTES;
constexpr size_t WS_END = WS_H + U_BYTES;
static_assert(WS_END <= ((size_t)2 << 30), "workspace map exceeds 2 GiB");
constexpr int CW_BAR = 4096, CW_CNT = 16384;

constexpr int RING_BYTES = 131072, LDS_BYTES = 147456, MISC_OFF = LDS_BYTES - 1024, SCR_BYTES = MISC_OFF;
constexpr int NWAVES = 8, NTHREADS = 512;

#ifdef EMU
#define LAS
#define WAVE_SYNC() emu_wave_barrier()
#else
#define LAS __attribute__((address_space(3)))
#define WAVE_SYNC() asm volatile("s_waitcnt lgkmcnt(0)" ::: "memory")
#endif
#ifdef EMU
#define LBAR() emu_wg_barrier()
#define VM_WAIT(n) do { } while (0)
#else
#define LBAR() do { asm volatile("s_waitcnt lgkmcnt(0)" ::: "memory"); __builtin_amdgcn_s_barrier(); asm volatile("" ::: "memory"); } while (0)
#define VM_WAIT(n) asm volatile("s_waitcnt vmcnt(" #n ")" ::: "memory")
#endif
typedef unsigned short bf16_t;
typedef short bf16x8 __attribute__((ext_vector_type(8)));
typedef float f32x4 __attribute__((ext_vector_type(4)));
typedef float f32x16 __attribute__((ext_vector_type(16)));
typedef unsigned u32x4 __attribute__((ext_vector_type(4)));
typedef unsigned u32x2 __attribute__((ext_vector_type(2)));

__device__ __forceinline__ unsigned f2bf(float f) { unsigned u = __builtin_bit_cast(unsigned, f); return (u + 0x7fffu + ((u >> 16) & 1u)) >> 16; }
__device__ __forceinline__ float bf2f(unsigned h) { return __builtin_bit_cast(float, (h & 0xffffu) << 16); }
#ifdef EMU
__device__ __forceinline__ unsigned pk2(float lo, float hi) { return f2bf(lo) | (f2bf(hi) << 16); }
#else
typedef float f32x2_t __attribute__((ext_vector_type(2))); typedef __bf16 bf16x2_t __attribute__((ext_vector_type(2)));
__device__ __forceinline__ unsigned pk2(float lo, float hi) { f32x2_t v = {lo, hi}; bf16x2_t b = __builtin_convertvector(v, bf16x2_t); return __builtin_bit_cast(unsigned, b); }
#endif
#ifdef EMU
__device__ __forceinline__ unsigned short bf1(float f) { return (unsigned short)f2bf(f); }
#else
__device__ __forceinline__ unsigned short bf1(float f) { return (unsigned short)pk2(f, f); }
#endif
__device__ __forceinline__ float blo(unsigned w) { return __builtin_bit_cast(float, w << 16); }
__device__ __forceinline__ float bhi(unsigned w) { return __builtin_bit_cast(float, w & 0xffff0000u); }
__device__ __forceinline__ void unpack8(const u32x4 w, float* f) { f[0] = blo(w.x); f[1] = bhi(w.x); f[2] = blo(w.y); f[3] = bhi(w.y); f[4] = blo(w.z); f[5] = bhi(w.z); f[6] = blo(w.w); f[7] = bhi(w.w); }
__device__ __forceinline__ u32x4 pack8(const float* f) { u32x4 w; w.x = pk2(f[0], f[1]); w.y = pk2(f[2], f[3]); w.z = pk2(f[4], f[5]); w.w = pk2(f[6], f[7]); return w; }
__device__ __forceinline__ float fexp(float x) { return __builtin_amdgcn_exp2f(x * 1.4426950408889634f); }
__device__ __forceinline__ float fsigmoid(float x) { return __builtin_amdgcn_rcpf(1.0f + __builtin_amdgcn_exp2f(-1.4426950408889634f * x)); }
__device__ __forceinline__ float fsilu(float x) { return x * fsigmoid(x); }
#ifdef EMU
__device__ __forceinline__ int opq(int x) { return x; }
#else
__device__ __forceinline__ int opq(int x) { asm volatile("" : "+v"(x)); return x; }
#endif
__device__ __forceinline__ float wave_sum(float v) {
#pragma unroll
    for (int o = 1; o < 64; o <<= 1) v += __shfl_xor(v, o);
    return v;
}

#ifndef PROBE_MASK
#define PROBE_MASK 0
#endif
#if PROBE_MASK && !defined(EMU)
#define PROBE_T0(b) unsigned long long pt0_ = 0; if constexpr ((PROBE_MASK >> (b)) & 1) pt0_ = __builtin_amdgcn_s_memrealtime();
#define PROBE_T1(b) if constexpr ((PROBE_MASK >> (b)) & 1) { asm volatile("s_waitcnt vmcnt(0) lgkmcnt(0)" ::: "memory"); const unsigned long long pt1_ = __builtin_amdgcn_s_memrealtime(); \
    while (__builtin_amdgcn_s_memrealtime() < pt1_ + (pt1_ - pt0_)) __builtin_amdgcn_s_sleep(8); }
#else
#define PROBE_T0(b)
#define PROBE_T1(b)
#endif
namespace pg8 {
constexpr int BM = 256, BK = 64, HALF = 128, HTB = HALF * BK * 2, NXCD = 8, WGM = 8;
struct Unit { int pm, pn, bt, e; };
struct Gemm { const bf16_t* A; const bf16_t* Bt; int M, N, K, lda; };
struct StaticOrder {
    int nM, nN, nwg, G, c;
    __host__ __device__ void init(int M, int N, int G_, int c_) { nM = M / BM; nN = N / BM; nwg = nM * nN; G = G_; c = c_; }
    __host__ __device__ bool next(int i, Unit& u) const {
        const long L = (long)i * G + c; if (L >= nwg) return false;
        int wgid = (int)L; { const int q = nwg / NXCD, r = nwg % NXCD, xcd = wgid % NXCD, off = wgid / NXCD; wgid = (xcd < r ? xcd * (q + 1) : r * (q + 1) + (xcd - r) * q) + off; }
        const int nig = WGM * nN, gid = wgid / nig, fm = gid * WGM, gsz = (nM - fm) < WGM ? (nM - fm) : WGM;
        u.pm = fm + ((wgid % nig) % gsz); u.pn = (wgid % nig) / gsz; u.bt = u.pn; u.e = 0; return true;
    }
    __device__ __forceinline__ void a_ready(const Unit&) const {}
    __device__ __forceinline__ void done(const Unit&) const {}
};
struct MoeOrder {
    const LAS int* tend; int npn, ntot, G, c;
    __device__ __forceinline__ bool next(int i, Unit& u) const {
        const long L = (long)i * G + c; if (L >= ntot) return false;
        const int rt = (int)L / npn, pn = (int)L % npn; int e = 0;
#pragma unroll
        for (int j = 0; j < NEXP; ++j) e += (tend[j] <= rt) ? 1 : 0;
        u.pm = rt; u.pn = pn; u.e = e; u.bt = e * npn + pn; return true;
    }
    __device__ __forceinline__ void a_ready(const Unit&) const {}
    __device__ __forceinline__ void done(const Unit&) const {}
};
#ifdef EMU
template <class Epi, class Sched>
__device__ void gemm_phase(LAS unsigned char* lds, const Gemm g, const Sched& S, const Epi& E) {
    const int tid = threadIdx.x, wid = tid >> 6, lane = tid & 63, wr = wid >> 2, wc = wid & 3, fr = lane & 15, fq = lane >> 4;
    Unit u;
    for (int i = 0; S.next(i, u); ++i) {
        f32x4 acc[2][2][4][2];
        for (int ai = 0; ai < 2; ++ai) for (int bj = 0; bj < 2; ++bj) for (int m = 0; m < 4; ++m) for (int n = 0; n < 2; ++n) for (int q = 0; q < 4; ++q) {
            const int row = u.pm * 256 + ai * 128 + wr * 64 + m * 16 + fr, col = u.bt * 256 + bj * 128 + wc * 32 + 8 * fq + 4 * n + q;
            const bf16_t* a = g.A + (size_t)row * g.lda; const bf16_t* b = g.Bt + (size_t)col * g.K; float s = 0.f;
            for (int k = 0; k < g.K; ++k) s += bf2f(a[k]) * bf2f(b[k]);
            acc[ai][bj][m][n][q] = s; }
        E(acc, u, wr, wc, fr, fq);
    }
    __syncthreads();
}
#else
#define PG8_LAS __attribute__((address_space(3)))
__host__ __device__ __forceinline__ int lds_byte(int r, int c) { const int st = (r >> 4) * 2 + (c >> 5), rr = r & 15, cc = c & 31, ob = rr * 64 + cc * 2; return st * 1024 + (ob ^ (((ob >> 9) & 1) << 5)); }
__host__ __device__ __forceinline__ void stage_rc(int b, int& R_, int& C_) { const int st = b / 1024, sb = b % 1024, swz = sb ^ (((sb >> 9) & 1) << 5); R_ = (st >> 1) * 16 + swz / 64; C_ = (st & 1) * 32 + (swz % 64) / 2; }
__host__ __device__ __forceinline__ int perm32(int rho) { const int n = rho >> 4, i = rho & 15; return 8 * (i >> 2) + 4 * n + (i & 3); }
template <class Epi, class Sched>
__device__ __forceinline__ void gemm_phase(PG8_LAS unsigned char* lds, const Gemm g, const Sched& S, const Epi& E) {
    const int tid = opq((int)threadIdx.x), wid = __builtin_amdgcn_readfirstlane(tid >> 6), lane = tid & 63, wr = wid >> 2, wc = wid & 3, fr = lane & 15, fq = lane >> 4;
    const int K = g.K, nt = K / BK, lda = g.lda;
    unsigned voffA[2], voffB[2];
#pragma unroll
    for (int i = 0; i < 2; ++i) { int R_, C_; stage_rc(tid * 16 + i * 8192, R_, C_); const int Rb = (R_ & ~31) + perm32(R_ & 31);
        voffA[i] = (unsigned)(R_ * lda + C_) * 2u; voffB[i] = (unsigned)(Rb * K + C_) * 2u; }
    const size_t kstep = (size_t)(BK * 2);
    const size_t hstepA = (size_t)HALF * lda * 2, tstepA = 2 * hstepA;
    const size_t hstepB = (size_t)HALF * K * 2, tstepB = 2 * hstepB;
    const unsigned ldsw = (unsigned)wid * 1024u;
    const int aoff = lds_byte(wr * 64 + fr, fq * 8), boff = lds_byte(wc * 32 + fr, fq * 8);
#define PG8_SA(b, h) (((b) * 2 + (h)) * HTB)
#define PG8_SB(b, h) ((4 + (b) * 2 + (h)) * HTB)
#define PG8_STAGE(bufoff, gbase, voff) do { _Pragma("unroll") for (int _i = 0; _i < 2; ++_i) \
        __builtin_amdgcn_global_load_lds((const unsigned*)((const char*)(gbase) + (voff)[_i]), (PG8_LAS unsigned*)(lds + (bufoff) + ldsw + _i * 8192), 16, 0, 0); } while (0)
#define PG8_LDA(dst, b, h) do { _Pragma("unroll") for (int m = 0; m < 4; ++m) _Pragma("unroll") for (int k = 0; k < 2; ++k) dst[m][k] = *(const PG8_LAS bf16x8*)(lds + PG8_SA(b, h) + aoff + m * 2048 + k * 1024); } while (0)
#define PG8_LDB(dst, b, h) do { _Pragma("unroll") for (int n = 0; n < 2; ++n) _Pragma("unroll") for (int k = 0; k < 2; ++k) dst[n][k] = *(const PG8_LAS bf16x8*)(lds + PG8_SB(b, h) + boff + n * 2048 + k * 1024); } while (0)
#define PG8_MMA(ai, bj, At, Bt) do { __builtin_amdgcn_s_setprio(1); _Pragma("unroll") for (int m = 0; m < 4; ++m) _Pragma("unroll") for (int n = 0; n < 2; ++n) _Pragma("unroll") for (int k = 0; k < 2; ++k) \
        acc[ai][bj][m][n] = __builtin_amdgcn_mfma_f32_16x16x32_bf16(Bt[n][k], At[m][k], acc[ai][bj][m][n], 0, 0, 0); __builtin_amdgcn_s_setprio(0); } while (0)
#define PG8_WAIT_V(n) asm volatile("s_waitcnt vmcnt(" #n ")" ::: "memory")
#define PG8_WAIT_L(n) asm volatile("s_waitcnt lgkmcnt(" #n ")" ::: "memory")
#define PG8_BAR __builtin_amdgcn_s_barrier()
#define PG8_SCHED __builtin_amdgcn_sched_barrier(0)
    Unit cur, nxt; int ui = 0;
    if (!S.next(0, cur)) return;
    f32x4 acc[2][2][4][2];
#pragma unroll
    for (int a = 0; a < 2; ++a)
#pragma unroll
        for (int b = 0; b < 2; ++b)
#pragma unroll
            for (int m = 0; m < 4; ++m)
#pragma unroll
                for (int n = 0; n < 2; ++n) acc[a][b][m][n] = (f32x4){0.f, 0.f, 0.f, 0.f};
    bf16x8 At[4][2], B0[2][2], B1[2][2];
    const char* cA = (const char*)g.A + (size_t)cur.pm * tstepA; const char* cB = (const char*)g.Bt + (size_t)cur.bt * tstepB;
    S.a_ready(cur);
    PG8_STAGE(PG8_SB(0, 0), cB, voffB); PG8_STAGE(PG8_SB(0, 1), cB + hstepB, voffB); PG8_STAGE(PG8_SA(0, 0), cA, voffA); PG8_STAGE(PG8_SA(0, 1), cA + hstepA, voffA);
    if (wr == 1) PG8_BAR;
    PG8_WAIT_V(2); PG8_BAR;
    PG8_STAGE(PG8_SB(1, 0), cB + kstep, voffB); PG8_STAGE(PG8_SA(1, 0), cA + kstep, voffA); PG8_STAGE(PG8_SB(1, 1), cB + hstepB + kstep, voffB);
    PG8_WAIT_V(6); PG8_BAR;
    for (;;) {
        const bool has_next = S.next(ui + 1, nxt);
        const char* nA = has_next ? (const char*)g.A + (size_t)nxt.pm * tstepA : cA; const char* nB = has_next ? (const char*)g.Bt + (size_t)nxt.bt * tstepB : cB;
        for (int t = 0; t < nt; t += 2) {
            const bool last = (t == nt - 2);
            const char* a1 = cA + (size_t)(t + 1) * kstep;
            const char* a2 = last ? nA : cA + (size_t)(t + 2) * kstep; const char* b2 = last ? nB : cB + (size_t)(t + 2) * kstep;
            const char* a3 = a2 + kstep; const char* b3 = b2 + kstep;
            if (last && has_next) S.a_ready(nxt);
            PG8_LDB(B0, 0, 0); PG8_LDB(B1, 0, 1); PG8_SCHED; PG8_LDA(At, 0, 0); PG8_STAGE(PG8_SA(1, 1), a1 + hstepA, voffA);
            PG8_WAIT_V(8); PG8_WAIT_L(0); PG8_BAR; PG8_MMA(0, 0, At, B0); PG8_MMA(0, 1, At, B1); PG8_BAR; PG8_SCHED;
            PG8_LDA(At, 0, 1); PG8_STAGE(PG8_SB(0, 0), b2, voffB); PG8_STAGE(PG8_SB(0, 1), b2 + hstepB, voffB); PG8_STAGE(PG8_SA(0, 0), a2, voffA);
            PG8_WAIT_V(8); PG8_WAIT_L(0); PG8_BAR; PG8_MMA(1, 0, At, B0); PG8_MMA(1, 1, At, B1); PG8_BAR; PG8_SCHED;
            PG8_LDB(B0, 1, 0); PG8_LDB(B1, 1, 1); PG8_SCHED; PG8_LDA(At, 1, 0); PG8_STAGE(PG8_SA(0, 1), a2 + hstepA, voffA);
            PG8_WAIT_V(8); PG8_WAIT_L(0); PG8_BAR; PG8_MMA(0, 0, At, B0); PG8_MMA(0, 1, At, B1); PG8_BAR; PG8_SCHED;
            PG8_LDA(At, 1, 1); PG8_STAGE(PG8_SB(1, 0), b3, voffB); PG8_STAGE(PG8_SB(1, 1), b3 + hstepB, voffB); PG8_STAGE(PG8_SA(1, 0), a3, voffA);
            PG8_WAIT_V(8); PG8_WAIT_L(0); PG8_BAR; PG8_MMA(1, 0, At, B0); PG8_MMA(1, 1, At, B1); PG8_BAR; PG8_SCHED;
        }
        if (wr == 0) PG8_BAR;
        E(acc, cur, wr, wc, fr, fq); S.done(cur);
        if (!has_next) break;
#pragma unroll
        for (int a = 0; a < 2; ++a)
#pragma unroll
            for (int b = 0; b < 2; ++b)
#pragma unroll
                for (int m = 0; m < 4; ++m)
#pragma unroll
                    for (int n = 0; n < 2; ++n) acc[a][b][m][n] = (f32x4){0.f, 0.f, 0.f, 0.f};
        cur = nxt; cA = nA; cB = nB; ++ui;
        if (wr == 1) PG8_BAR;
    }
    PG8_WAIT_V(0);
    PG8_BAR;
#undef PG8_SA
#undef PG8_SB
#undef PG8_STAGE
#undef PG8_LDA
#undef PG8_LDB
#undef PG8_MMA
#undef PG8_WAIT_V
#undef PG8_WAIT_L
#undef PG8_BAR
#undef PG8_SCHED
}
#endif

struct EpiStoreBf16 {
    bf16_t* O; int ldc;
    __device__ __forceinline__ void operator()(const f32x4 (&acc)[2][2][4][2], const Unit& u, int wr, int wc, int fr, int fq) const {
        const int row0 = u.pm * 256 + wr * 64 + fr, col0 = u.pn * 256 + wc * 32 + 8 * fq;
#pragma unroll
        for (int ai = 0; ai < 2; ++ai)
#pragma unroll
            for (int m = 0; m < 4; ++m)
#pragma unroll
                for (int bj = 0; bj < 2; ++bj) { const f32x4 v0 = acc[ai][bj][m][0], v1 = acc[ai][bj][m][1];
                    u32x4 w; w.x = pk2(v0[0], v0[1]); w.y = pk2(v0[2], v0[3]); w.z = pk2(v1[0], v1[1]); w.w = pk2(v1[2], v1[3]);
                    *(u32x4*)(O + (size_t)(row0 + ai * 128 + m * 16) * ldc + col0 + bj * 128) = w; }
    }
};
template <int MODE> struct EpiGate {
    const bf16_t* Hg; bf16_t* MGb;
    __device__ __forceinline__ void operator()(const f32x4 (&acc)[2][2][4][2], const Unit& u, int wr, int wc, int fr, int fq) const {
        const int row0 = u.pm * 256 + wr * 64 + fr, col0 = u.pn * 256 + wc * 32 + 8 * fq;
#pragma unroll
        for (int ai = 0; ai < 2; ++ai) {
            u32x4 gw[4][2], pw[4][2];
#pragma unroll
            for (int m = 0; m < 4; ++m)
#pragma unroll
                for (int bj = 0; bj < 2; ++bj) { const int row = row0 + ai * 128 + m * 16, col = col0 + bj * 128;
                    gw[m][bj] = *(const u32x4*)(Hg + (size_t)row * DINP + col); if (MODE != 0) pw[m][bj] = *(const u32x4*)(MGb + (size_t)row * D + col); }
            asm volatile("" ::: "memory");
#pragma unroll
            for (int m = 0; m < 4; ++m)
#pragma unroll
                for (int bj = 0; bj < 2; ++bj) { const int row = row0 + ai * 128 + m * 16, col = col0 + bj * 128; const f32x4 v0 = acc[ai][bj][m][0], v1 = acc[ai][bj][m][1];
                    float g[8], p[8], v[8] = {v0[0], v0[1], v0[2], v0[3], v1[0], v1[1], v1[2], v1[3]}; unpack8(gw[m][bj], g);
                    if (MODE != 0) { unpack8(pw[m][bj], p);
#pragma unroll
                        for (int i = 0; i < 8; ++i) v[i] = p[i] + v[i] * fsigmoid(g[i]); }
                    else {
#pragma unroll
                        for (int i = 0; i < 8; ++i) v[i] = v[i] * fsigmoid(g[i]); }
                    *(u32x4*)(MGb + (size_t)row * D + col) = pack8(v); }
            asm volatile("" ::: "memory");
        }
    }
};
struct EpiResid {
    const float* xp; const float* xs; float* op; float* os;
    __device__ __forceinline__ void operator()(const f32x4 (&acc)[2][2][4][2], const Unit& u, int wr, int wc, int fr, int fq) const {
        const int row0 = u.pm * 256 + wr * 64 + fr, col0 = u.pn * 256 + wc * 32 + 8 * fq;
        const bool smp = u.pm * 256 >= NP;
        const float* xb = smp ? xs - (size_t)NP * D : xp; float* ob = smp ? os - (size_t)NP * D : op;
#pragma unroll
        for (int ai = 0; ai < 2; ++ai) {
            f32x4 xa[4][2][2];
#pragma unroll
            for (int m = 0; m < 4; ++m)
#pragma unroll
                for (int bj = 0; bj < 2; ++bj) { const float* xi = xb + (size_t)(row0 + ai * 128 + m * 16) * D + col0 + bj * 128; xa[m][bj][0] = *(const f32x4*)xi; xa[m][bj][1] = *(const f32x4*)(xi + 4); }
            asm volatile("" ::: "memory");
#pragma unroll
            for (int m = 0; m < 4; ++m)
#pragma unroll
                for (int bj = 0; bj < 2; ++bj) { float* xo = ob + (size_t)(row0 + ai * 128 + m * 16) * D + col0 + bj * 128;
                    *(f32x4*)xo = xa[m][bj][0] * ALPHA + acc[ai][bj][m][0]; *(f32x4*)(xo + 4) = xa[m][bj][1] * ALPHA + acc[ai][bj][m][1]; }
            asm volatile("" ::: "memory");
        }
    }
};
struct EpiSwiglu {
    bf16_t* ACT; const float* bup;
    __device__ __forceinline__ void operator()(const f32x4 (&acc)[2][2][4][2], const Unit& u, int wr, int wc, int fr, int fq) const {
        const int row0_ = u.pm * 256 + wr * 64 + fr, j0 = u.pn * 128 + wc * 32 + 8 * fq;
        const float* bg = bup + (size_t)u.e * 2048 + j0; const f32x4 bg0 = *(const f32x4*)bg, bg1 = *(const f32x4*)(bg + 4), bu0 = *(const f32x4*)(bg + 1024), bu1 = *(const f32x4*)(bg + 1028);
#pragma unroll
        for (int ai = 0; ai < 2; ++ai)
#pragma unroll
            for (int m = 0; m < 4; ++m) { const int row = row0_ + ai * 128 + m * 16;
                const f32x4 g0 = acc[ai][0][m][0] + bg0, g1 = acc[ai][0][m][1] + bg1, u0 = acc[ai][1][m][0] + bu0, u1 = acc[ai][1][m][1] + bu1; float o[8];
#pragma unroll
                for (int i = 0; i < 4; ++i) { const float ga = fminf(g0[i], SW_LIMIT), ua = fminf(fmaxf(u0[i], -SW_LIMIT), SW_LIMIT); o[i] = (ua + 1.0f) * ga * fsigmoid(SW_ALPHA * ga);
                    const float gb = fminf(g1[i], SW_LIMIT), ub = fminf(fmaxf(u1[i], -SW_LIMIT), SW_LIMIT); o[4 + i] = (ub + 1.0f) * gb * fsigmoid(SW_ALPHA * gb); }
                *(u32x4*)(ACT + (size_t)row * D + j0) = pack8(o); }
    }
};
struct EpiDown {
    bf16_t* O; const float* bdn; const float* gs;
    __device__ __forceinline__ void operator()(const f32x4 (&acc)[2][2][4][2], const Unit& u, int wr, int wc, int fr, int fq) const {
        const int row0 = u.pm * 256 + wr * 64 + fr, col0 = u.pn * 256 + wc * 32 + 8 * fq;
#pragma unroll
        for (int ai = 0; ai < 2; ++ai) {
            float gt[4];
#pragma unroll
            for (int m = 0; m < 4; ++m) gt[m] = gs[row0 + ai * 128 + m * 16];
#pragma unroll
            for (int bj = 0; bj < 2; ++bj) { const float* bp = bdn + (size_t)u.e * D + col0 + bj * 128; const f32x4 b0 = *(const f32x4*)bp, b1 = *(const f32x4*)(bp + 4);
#pragma unroll
                for (int m = 0; m < 4; ++m) { const f32x4 a0 = (acc[ai][bj][m][0] + b0) * gt[m], a1 = (acc[ai][bj][m][1] + b1) * gt[m];
                    u32x4 w; w.x = pk2(a0[0], a0[1]); w.y = pk2(a0[2], a0[3]); w.z = pk2(a1[0], a1[1]); w.w = pk2(a1[2], a1[3]);
                    *(u32x4*)(O + (size_t)(row0 + ai * 128 + m * 16) * D + col0 + bj * 128) = w; } }
            asm volatile("" ::: "memory");
        }
    }
};
}

#ifndef EMU
#define XB_TMO      128
#define XB_XCNT(j)  (256  + 64 * (j))
#define XB_XSUB(j)  (1280 + 64 * (j))
#define XB_XGEN(j)  (2304 + 64 * (j))
#define XB_TOP      3328
#define XB_TOPGEN   3392
#define XCD_BAR_WORDS 3456
#define XB_SPIN_CAP (1u << 27)
__device__ __forceinline__ unsigned xb_ld(unsigned* p)              { return __hip_atomic_load(p, __ATOMIC_RELAXED, __HIP_MEMORY_SCOPE_AGENT); }
__device__ __forceinline__ unsigned xb_add(unsigned* p, unsigned v) { return __hip_atomic_fetch_add(p, v, __ATOMIC_RELAXED, __HIP_MEMORY_SCOPE_AGENT); }
__device__ __forceinline__ unsigned xb_xcc_id() { return (unsigned)__builtin_amdgcn_s_getreg((3 << 11) | 20) & 0xFu; }
#define XB_SPIN(cond, bar) do { unsigned _sp = 0; while (cond) { __builtin_amdgcn_s_sleep(1); \
    if ((++_sp & 255u) == 0u) { if (xb_ld(&(bar)[XB_TMO])) break; if (_sp > XB_SPIN_CAP) { atomicAdd(&(bar)[XB_TMO], 1u); break; } } } } while (0)
struct XcdBarrier { unsigned* bar; unsigned x; volatile LAS unsigned* st; };
__device__ __forceinline__ XcdBarrier xcd_barrier_post(unsigned* bar, volatile LAS unsigned* st) {
    XcdBarrier b; b.bar = bar; b.x = xb_xcc_id(); b.st = st;
    if (threadIdx.x == 0) (void)xb_add(&bar[XB_XCNT(b.x)], 1u);
    return b;
}
__device__ __forceinline__ void xcd_barrier_complete(unsigned* bar, unsigned x, unsigned& nloc, unsigned& nx) {
    const unsigned G = gridDim.x * gridDim.y * gridDim.z;
    unsigned sum, cnt, mine, sp = 0u;
    for (;;) {
        sum = 0u; cnt = 0u; mine = 0u;
#pragma unroll
        for (unsigned j = 0; j < 16; ++j) { const unsigned c = xb_ld(&bar[XB_XCNT(j)]); sum += c; cnt += (c > 0u) ? 1u : 0u; mine = (j == x) ? c : mine; }
        if (sum == G) break;
        __builtin_amdgcn_s_sleep(1);
        if ((++sp & 255u) == 0u) { if (xb_ld(&bar[XB_TMO])) break; if (sp > XB_SPIN_CAP) { atomicAdd(&bar[XB_TMO], 1u); break; } }
    }
    nloc = mine > 0u ? mine : 1u; nx = cnt > 0u ? cnt : 1u;
}
__device__ __forceinline__ void xcd_barrier(const XcdBarrier& b) {
    asm volatile("s_waitcnt vmcnt(0)" ::: "memory");
    __syncthreads();
    if (threadIdx.x == 0) {
        unsigned* bar = b.bar;
        __builtin_amdgcn_s_waitcnt(0);
        unsigned nloc = b.st[0], nx = b.st[1];
        if (nloc == 0u) { xcd_barrier_complete(bar, b.x, nloc, nx); b.st[0] = nloc; b.st[1] = nx; }
        const unsigned old = xb_add(&bar[XB_XSUB(b.x)], 1u);
        const unsigned gen = old / nloc;
        if (old + 1u == (gen + 1u) * nloc) {
            __builtin_amdgcn_fence(__ATOMIC_RELEASE, "agent");
            asm volatile("s_waitcnt vmcnt(0)" ::: "memory");
            const unsigned og = xb_add(&bar[XB_TOP], 1u);
            const unsigned tg = og / nx;
            if (og + 1u == (tg + 1u) * nx) xb_add(&bar[XB_TOPGEN], 1u);
            else XB_SPIN(xb_ld(&bar[XB_TOPGEN]) == tg, bar);
            __builtin_amdgcn_fence(__ATOMIC_ACQUIRE, "agent");
            xb_add(&bar[XB_XGEN(b.x)], 1u);
            asm volatile("s_waitcnt vmcnt(0)" ::: "memory");
        } else {
            XB_SPIN(xb_ld(&bar[XB_XGEN(b.x)]) == gen, bar);
            __builtin_amdgcn_fence(__ATOMIC_ACQUIRE, "agent");
            asm volatile("s_waitcnt vmcnt(0)" ::: "memory");
        }
    }
    __syncthreads();
}
#endif

struct Args { const float* in[31]; float* out; unsigned char* ws; int lo, hi; };
typedef const float* FPtr;
#ifdef EMU
typedef const FPtr* ArgTab;
#else
typedef const __attribute__((address_space(4))) FPtr* ArgTab;
#endif
struct Frame {
    LAS unsigned char* lds; int tid, lane, wave, G, bid;
    ArgTab in; float* out; unsigned char* ws; unsigned* ctl;
};
enum { I_XP = 0, I_XS, I_CK, I_CV, I_SST, I_SCV, I_SSC, I_WIN, I_CONVW, I_CONVB, I_DTB, I_ALOG, I_SD, I_NORMW, I_WSSD, I_SINK, I_WATT, I_RELB, I_SCW, I_WSC, I_WO, I_LN1G, I_LN1B,
       I_RW, I_RB, I_WUP, I_BUP, I_WDN, I_BDN, I_LN2G, I_LN2B };

__device__ __forceinline__ bf16_t* ws_bf(const Frame& F, size_t off) { return (bf16_t*)(F.ws + off); }
__device__ __forceinline__ float* ws_f(const Frame& F, size_t off) { return (float*)(F.ws + off); }
__device__ __forceinline__ bf16_t* wl_ptr(const Frame& F, int layer, size_t off) { return (bf16_t*)(F.ws + WS_W + (size_t)layer * WL_BYTES + off); }

__device__ __forceinline__ void wt_item(const float* W, int ldw, int K, int k0, int nsrc0, const float* kscale, bf16_t* WT, int ndst0, LAS float* scr, int lane) {
    if (nsrc0 < 0) {
#pragma unroll
        for (int j = 0; j < 4; ++j) { const int n = (lane >> 3) + 8 * j; *(u32x4*)(WT + (size_t)(ndst0 + n) * K + k0 + 8 * (lane & 7)) = (u32x4){0u, 0u, 0u, 0u}; }
        return;
    }
#pragma unroll 8
    for (int i = 0; i < 32; ++i) { const int kk = 2 * i + (lane >> 5); float v = W[(size_t)(k0 + kk) * ldw + nsrc0 + (lane & 31)]; if (kscale) v *= kscale[k0 + kk]; scr[kk * 33 + (lane & 31)] = v; }
    WAVE_SYNC();
    const int c = lane & 7;
#pragma unroll
    for (int j = 0; j < 4; ++j) { const int n = (lane >> 3) + 8 * j; const LAS float* s = scr + (8 * c) * 33 + n;
        u32x4 o; o.x = pk2(s[0 * 33], s[1 * 33]); o.y = pk2(s[2 * 33], s[3 * 33]); o.z = pk2(s[4 * 33], s[5 * 33]); o.w = pk2(s[6 * 33], s[7 * 33]);
        *(u32x4*)(WT + (size_t)(ndst0 + n) * K + k0 + 8 * c) = o; }
    WAVE_SYNC();
}
__device__ __forceinline__ void step_weights(const Frame& F) {
    LAS float* scr = (LAS float*)(F.lds + F.wave * 16384);
    const int gw = F.bid * NWAVES + F.wave, NGW = F.G * NWAVES;
    constexpr int I_IN = (DINP / 32) * (D / 64), I_SSD = (D / 32) * (DINNER / 64), I_SQ = (D / 32) * (D / 64), I_UP = NEXP * (2048 / 32) * (D / 64), I_DN = NEXP * (D / 32) * (D / 64);
    constexpr int PER_LAYER = I_IN + I_SSD + 3 * I_SQ + I_UP + I_DN;
    for (int it = gw; it < DEPTH * PER_LAYER; it += NGW) {
        const int layer = it / PER_LAYER; int r = it % PER_LAYER;
        if (r < I_IN) { const int nb = r / (D / 64), kb = r % (D / 64), n0 = nb * 32;
            const int ns = n0 < 6144 ? n0 : (n0 < 13824 ? n0 + 32 : (n0 < 13856 ? n0 - 13824 + 6144 : -1));
            wt_item(F.in[I_WIN] + (size_t)layer * D * DIN, DIN, D, kb * 64, ns, nullptr, wl_ptr(F, layer, WL_IN), n0, scr, F.lane); continue; }
        r -= I_IN;
        if (r < I_SSD) { const int nb = r / (DINNER / 64), kb = r % (DINNER / 64);
            wt_item(F.in[I_WSSD] + (size_t)layer * DINNER * D, D, DINNER, kb * 64, nb * 32, F.in[I_NORMW] + (size_t)layer * DINNER, wl_ptr(F, layer, WL_SSD), nb * 32, scr, F.lane); continue; }
        r -= I_SSD;
        if (r < I_SQ) { const int nb = r / (D / 64), kb = r % (D / 64); wt_item(F.in[I_WATT] + (size_t)layer * D * D, D, D, kb * 64, nb * 32, nullptr, wl_ptr(F, layer, WL_ATT), nb * 32, scr, F.lane); continue; }
        r -= I_SQ;
        if (r < I_SQ) { const int nb = r / (D / 64), kb = r % (D / 64); wt_item(F.in[I_WSC] + (size_t)layer * D * D, D, D, kb * 64, nb * 32, nullptr, wl_ptr(F, layer, WL_SC), nb * 32, scr, F.lane); continue; }
        r -= I_SQ;
        if (r < I_SQ) { const int nb = r / (D / 64), kb = r % (D / 64); wt_item(F.in[I_WO] + (size_t)layer * D * D, D, D, kb * 64, nb * 32, nullptr, wl_ptr(F, layer, WL_O), nb * 32, scr, F.lane); continue; }
        r -= I_SQ;
        if (r < I_UP) { const int e = r / ((2048 / 32) * (D / 64)), q = r % ((2048 / 32) * (D / 64)), nb = q / (D / 64), kb = q % (D / 64), n0 = nb * 32;
            const int pn = n0 >> 8, bj = (n0 >> 7) & 1, jj = n0 & 127, ns = bj * 1024 + pn * 128 + jj;
            wt_item(F.in[I_WUP] + ((size_t)layer * NEXP + e) * D * 2048, 2048, D, kb * 64, ns, nullptr, wl_ptr(F, layer, WL_UP) + (size_t)e * 2048 * D, n0, scr, F.lane); continue; }
        r -= I_UP;
        { const int e = r / ((D / 32) * (D / 64)), q = r % ((D / 32) * (D / 64)), nb = q / (D / 64), kb = q % (D / 64);
            wt_item(F.in[I_WDN] + ((size_t)layer * NEXP + e) * D * D, D, D, kb * 64, nb * 32, nullptr, wl_ptr(F, layer, WL_DN) + (size_t)e * D * D, nb * 32, scr, F.lane); }
    }
}

__device__ __forceinline__ const float* x_in_row(const Frame& F, int layer, int mb, int r) {
    if (layer == 0) return r < NP ? F.in[I_XP] + ((size_t)mb * NP + r) * D : F.in[I_XS] + (size_t)(r - NP) * D;
    return r < NP ? F.out + O_YP + ((size_t)mb * NP + r) * D : F.out + O_YS + (size_t)(r - NP) * D;
}
__device__ __forceinline__ float* x_out_row(const Frame& F, int mb, int r) { return r < NP ? F.out + O_YP + ((size_t)mb * NP + r) * D : F.out + O_YS + (size_t)(r - NP) * D; }
__device__ __forceinline__ int rows_of(int mb) { return mb == 0 ? R : NP; }

__device__ __forceinline__ void step_xb(const Frame& F, int mb) {
    const int gw = F.bid * NWAVES + F.wave, NGW = F.G * NWAVES, nr = rows_of(mb);
    bf16_t* XB = ws_bf(F, WS_XB);
    for (int r = gw; r < nr; r += NGW) {
        const f32x4* xr = (const f32x4*)x_in_row(F, 0, mb, r) + F.lane; u32x2* o = (u32x2*)(XB + (size_t)r * D) + F.lane;
#pragma unroll
        for (int j = 0; j < 4; ++j) { const f32x4 v = xr[64 * j]; u32x2 w; w.x = pk2(v[0], v[1]); w.y = pk2(v[2], v[3]); o[64 * j] = w; }
    }
}

__device__ __forceinline__ float softplus_f(float x) { const float e = fexp(x); return x > 20.f ? x : (e < 0.01f ? e * (1.0f - e * (0.5f - e * 0.33333333f)) : __builtin_amdgcn_logf(1.0f + e) * 0.69314718056f); }
constexpr int S128 = 136, S64 = 72, RAWP = 264;
constexpr int SL_CM = 0, SL_BM = SL_CM + 64 * S128 * 2, SL_BT = SL_BM + 64 * S128 * 2, SL_XT = SL_BT + 128 * S64 * 2, SL_XTW = SL_XT + 64 * S64 * 2,
    SL_MM = SL_XTW + 64 * S64 * 2, SL_SB = SL_MM + 64 * S64 * 2, SL_SM = SL_SB + 64 * S128 * 2, SL_CW = SL_SM + 2 * 320 * 4, SL_RAW = SL_CW + 5 * 320 * 4, SL_END = SL_RAW + 35 * 1024;
constexpr int SL_Y = SL_CM, YP = 68;
static_assert(SL_END <= SCR_BYTES && 64 * YP * 4 <= 64 * S128 * 2 && 67 * RAWP * 2 <= 35 * 1024, "ssd LDS map");

#ifdef EMU
#define SSD_DMA_ONE(gp_, dst_) memcpy((unsigned char*)(dst_) + lane * 16, (gp_), 16)
#else
#define SSD_DMA_ONE(gp_, dst_) __builtin_amdgcn_global_load_lds((const unsigned*)(gp_), (LAS unsigned*)(dst_), 16, 0, 0)
#endif
#define SSD_DMA(ck_) do { _Pragma("unroll") for (int j_ = 0; j_ < 5; ++j_) if (w * 5 + j_ < 35) { int q_ = (w * 5 + j_) * 64 + lane; q_ = q_ < 67 * 33 ? q_ : 67 * 33 - 1; const int row_ = q_ / 33; int cc_ = q_ % 33; cc_ = cc_ < 32 ? cc_ : 31; \
        const int t_ = (ck_) * 64 + row_ - 3; const bf16_t* gp_ = t_ >= 0 ? H + (size_t)t_ * DINP + (cc_ < 16 ? C_B + g * 128 + 8 * cc_ : C_C + g * 128 + 8 * (cc_ - 16)) : (const bf16_t*)(F.ws + 1024 + lane * 16); \
        SSD_DMA_ONE(gp_, L + SL_RAW + (w * 5 + j_) * 1024); } } while (0)
#define SSD_LOAD_X(ck_) do { _Pragma("unroll") for (int i = 0; i < 4; ++i) { const int t_ = (ck_) * 64 + xl - 3 + i; rawx[i] = t_ >= 0 ? *(const u32x4*)(H + (size_t)t_ * DINP + C_X + hd * 64 + 8 * xcg) : (u32x4){0u, 0u, 0u, 0u}; } } while (0)
#define SSD_TABLE(tb_, dtr_) do { const float x_ = bf2f(dtr_) + dtb; const float e_ = fexp(x_); const float dt_ = x_ > 20.f ? x_ : (e_ < 0.01f ? e_ * (1.0f - e_ * (0.5f - e_ * 0.33333333f)) : __builtin_amdgcn_logf(1.0f + e_) * 0.69314718056f); \
        float cs_ = Ah * dt_; _Pragma("unroll") for (int o = 1; o < 64; o <<= 1) { const float t2_ = __shfl(cs_, lane - o < 0 ? 0 : lane - o); if (lane >= o) cs_ += t2_; } \
        const float tot_ = __shfl(cs_, 63); (tb_)[lane] = dt_; (tb_)[64 + lane] = cs_; (tb_)[128 + lane] = fexp(tot_ - cs_); (tb_)[192 + lane] = fexp(cs_); if (lane == 0) (tb_)[256] = fexp(tot_); } while (0)

__device__ __forceinline__ void ssd_prompt_unit(const Frame& F, int layer, int mb, int sl, int hd) {
    const int tid = F.tid, lane = F.lane, w = F.wave, fr = lane & 15, fq = lane >> 4;
    LAS unsigned char* L = F.lds;
    LAS bf16_t* Cm = (LAS bf16_t*)(L + SL_CM); LAS bf16_t* Bm = (LAS bf16_t*)(L + SL_BM); LAS bf16_t* BT = (LAS bf16_t*)(L + SL_BT); LAS bf16_t* XT = (LAS bf16_t*)(L + SL_XT);
    LAS bf16_t* XTW = (LAS bf16_t*)(L + SL_XTW); LAS bf16_t* Mm = (LAS bf16_t*)(L + SL_MM); LAS bf16_t* Sb = (LAS bf16_t*)(L + SL_SB); LAS bf16_t* RAW = (LAS bf16_t*)(L + SL_RAW);
    LAS float* smb = (LAS float*)(L + SL_SM);
    LAS float* cw = (LAS float*)(L + SL_CW);
    LAS float* Y = (LAS float*)(L + SL_Y);
    const int g = hd >> 2;
    bf16_t* H = ws_bf(F, WS_H) + (size_t)sl * SEQ * DINP;
    const float* convw = F.in[I_CONVW] + (size_t)layer * 4 * CONVDIM; const float* convb = F.in[I_CONVB] + (size_t)layer * CONVDIM;
    __syncthreads();
    for (int i = tid; i < 5 * 320; i += NTHREADS) { const int tap = i / 320, c = i % 320; const int xc = c < 64 ? hd * 64 + c : (c < 192 ? 2048 + g * 128 + (c - 64) : 3072 + g * 128 + (c - 192));
        cw[i] = tap < 4 ? convw[tap * CONVDIM + xc] : convb[xc]; }
    const float dtb = F.in[I_DTB][layer * 32 + hd], Ah = -fexp(F.in[I_ALOG][layer * 32 + hd]), Dh = F.in[I_SD][layer * 32 + hd];
    const int xl = tid >> 3, xcg = tid & 7;
    f32x4 S[4];
#pragma unroll
    for (int j = 0; j < 4; ++j) S[j] = (f32x4){0.f, 0.f, 0.f, 0.f};
    const int ti = w >> 1, tj0 = 2 * (w & 1);
    const int pi = w & 3, nb = w >> 2;
    u32x4 rawx[4]; u32x4 zraw; unsigned dtr_next;
    SSD_DMA(0); SSD_LOAD_X(0);
    zraw = *(const u32x4*)(H + (size_t)xl * DINP + C_Z + hd * 64 + 8 * xcg);
    { const unsigned d0 = H[(size_t)lane * DINP + C_DT + hd]; dtr_next = H[(size_t)(64 + lane) * DINP + C_DT + hd]; if (w == 0) SSD_TABLE(smb, d0); }
    VM_WAIT(0);
    for (int ck = 0; ck < NCHUNK; ++ck) {
        const size_t rowb = (size_t)ck * 64;
        LAS float* sm = smb + (ck & 1) * 320; LAS float* smn = smb + ((ck + 1) & 1) * 320;
        if (ck > 0) VM_WAIT(2);
        LBAR();
        float xs8[8];
        { float acc8[8];
          { const f32x4 b0 = *(const LAS f32x4*)(cw + 4 * 320 + 8 * xcg), b1 = *(const LAS f32x4*)(cw + 4 * 320 + 8 * xcg + 4);
#pragma unroll
            for (int i = 0; i < 4; ++i) { acc8[i] = b0[i]; acc8[4 + i] = b1[i]; } }
#pragma unroll
          for (int tp = 0; tp < 4; ++tp) { float f[8]; unpack8(rawx[tp], f); const f32x4 w0 = *(const LAS f32x4*)(cw + tp * 320 + 8 * xcg), w1 = *(const LAS f32x4*)(cw + tp * 320 + 8 * xcg + 4);
#pragma unroll
            for (int i = 0; i < 4; ++i) { acc8[i] += f[i] * w0[i]; acc8[4 + i] += f[4 + i] * w1[i]; } }
          const float dt = sm[xl], wd = sm[128 + xl];
#pragma unroll
          for (int i = 0; i < 8; ++i) { const float v = fsilu(acc8[i]); xs8[i] = v; const float xd = v * dt; XT[(8 * xcg + i) * S64 + xl] = bf1(xd); XTW[(8 * xcg + i) * S64 + xl] = bf1(xd * wd); } }
        asm volatile("" ::: "memory");
#pragma unroll
        for (int it = 0; it < 4; ++it) {
            const int cg = w + 8 * (it & 1); const int cb = (it < 2 ? 64 : 192) + 8 * cg, rc = (it < 2 ? 0 : 128) + 8 * cg;
            float acc8[8];
            { const f32x4 b0 = *(const LAS f32x4*)(cw + 4 * 320 + cb), b1 = *(const LAS f32x4*)(cw + 4 * 320 + cb + 4);
#pragma unroll
              for (int i = 0; i < 4; ++i) { acc8[i] = b0[i]; acc8[4 + i] = b1[i]; } }
#pragma unroll
            for (int tp = 0; tp < 4; ++tp) { float f[8]; unpack8(*(const LAS u32x4*)(RAW + (lane + tp) * RAWP + rc), f); const f32x4 w0 = *(const LAS f32x4*)(cw + tp * 320 + cb), w1 = *(const LAS f32x4*)(cw + tp * 320 + cb + 4);
#pragma unroll
                for (int i = 0; i < 4; ++i) { acc8[i] += f[i] * w0[i]; acc8[4 + i] += f[4 + i] * w1[i]; } }
#pragma unroll
            for (int i = 0; i < 8; ++i) acc8[i] = fsilu(acc8[i]);
            if (it < 2) { *(LAS u32x4*)(Bm + lane * S128 + 8 * cg) = pack8(acc8);
#pragma unroll
                for (int i = 0; i < 8; ++i) BT[(8 * cg + i) * S64 + lane] = bf1(acc8[i]); }
            else *(LAS u32x4*)(Cm + lane * S128 + 8 * cg) = pack8(acc8);
            asm volatile("" ::: "memory");
        }
#pragma unroll
        for (int jj = 0; jj < 4; ++jj)
#pragma unroll
            for (int r = 0; r < 4; ++r) Sb[(16 * pi + 4 * fq + r) * S128 + 64 * nb + 16 * jj + fr] = bf1(S[jj][r]);
        LBAR();
        const u32x4 zcur = zraw; const unsigned dtr_cur = dtr_next;
        if (ck + 1 < NCHUNK) { SSD_DMA(ck + 1); SSD_LOAD_X(ck + 1); zraw = *(const u32x4*)(H + (rowb + 64 + xl) * DINP + C_Z + hd * 64 + 8 * xcg);
            dtr_next = H[(rowb + (ck + 2 < NCHUNK ? 128 : 64) + lane) * DINP + C_DT + hd]; }
        asm volatile("" ::: "memory");
        if (w == 0 && ck + 1 < NCHUNK) SSD_TABLE(smn, dtr_cur);
        f32x4 yo[2];
#pragma unroll
        for (int jj = 0; jj < 2; ++jj) { const int tj = tj0 + jj;
            f32x4 cb = (f32x4){0.f, 0.f, 0.f, 0.f}; yo[jj] = (f32x4){0.f, 0.f, 0.f, 0.f};
#pragma unroll
            for (int ks = 0; ks < 4; ++ks) { const bf16x8 a = *(const LAS bf16x8*)(Cm + (16 * ti + fr) * S128 + 32 * ks + 8 * fq);
                if (tj <= ti) { const bf16x8 b = *(const LAS bf16x8*)(Bm + (16 * tj + fr) * S128 + 32 * ks + 8 * fq); cb = __builtin_amdgcn_mfma_f32_16x16x32_bf16(a, b, cb, 0, 0, 0); }
                const bf16x8 sb = *(const LAS bf16x8*)(Sb + (16 * tj + fr) * S128 + 32 * ks + 8 * fq); yo[jj] = __builtin_amdgcn_mfma_f32_16x16x32_bf16(a, sb, yo[jj], 0, 0, 0); }
            const int s = 16 * tj + fr; const float as = sm[64 + s];
#pragma unroll
            for (int r = 0; r < 4; ++r) { const int l = 16 * ti + 4 * fq + r; const float al = sm[64 + l];
                const float mv = (tj <= ti && l >= s) ? cb[r] * fexp(fminf(al - as, 0.f)) : 0.f; Mm[l * S64 + s] = bf1(mv); }
            asm volatile("" ::: "memory");
        }
        { const float cd = sm[256];
#pragma unroll
          for (int jj = 0; jj < 4; ++jj) { S[jj] = S[jj] * cd;
#pragma unroll
            for (int ks = 0; ks < 2; ++ks) { const bf16x8 a = *(const LAS bf16x8*)(XTW + (16 * pi + fr) * S64 + 32 * ks + 8 * fq); const bf16x8 b = *(const LAS bf16x8*)(BT + (64 * nb + 16 * jj + fr) * S64 + 32 * ks + 8 * fq);
                S[jj] = __builtin_amdgcn_mfma_f32_16x16x32_bf16(a, b, S[jj], 0, 0, 0); }
            if (jj & 1) asm volatile("" ::: "memory"); } }
        LBAR();
#pragma unroll
        for (int jj = 0; jj < 2; ++jj) { const int tj = tj0 + jj; f32x4 yd = (f32x4){0.f, 0.f, 0.f, 0.f};
#pragma unroll
            for (int ks = 0; ks < 2; ++ks) { const bf16x8 a = *(const LAS bf16x8*)(Mm + (16 * ti + fr) * S64 + 32 * ks + 8 * fq); const bf16x8 b = *(const LAS bf16x8*)(XT + (16 * tj + fr) * S64 + 32 * ks + 8 * fq);
                yd = __builtin_amdgcn_mfma_f32_16x16x32_bf16(a, b, yd, 0, 0, 0); }
#pragma unroll
            for (int r = 0; r < 4; ++r) { const int l = 16 * ti + 4 * fq + r; Y[l * YP + 16 * tj + fr] = yd[r] + sm[192 + l] * yo[jj][r]; } }
        LBAR();
        { float y8[8], z8[8]; const f32x4 ya = *(const LAS f32x4*)(Y + xl * YP + 8 * xcg), yb = *(const LAS f32x4*)(Y + xl * YP + 8 * xcg + 4);
#pragma unroll
          for (int i = 0; i < 4; ++i) { y8[i] = ya[i]; y8[4 + i] = yb[i]; }
          unpack8(zcur, z8); float ss = 0.f;
#pragma unroll
          for (int i = 0; i < 8; ++i) { const float v = (y8[i] + Dh * xs8[i]) * fsilu(z8[i]); y8[i] = v; ss += v * v; }
          asm volatile("" ::: "memory");
          *(u32x4*)(H + (rowb + xl) * DINP + C_Z + hd * 64 + 8 * xcg) = pack8(y8);
          ss += __shfl_xor(ss, 1); ss += __shfl_xor(ss, 2); ss += __shfl_xor(ss, 4);
          if (xcg == 0) ws_f(F, WS_SSQ)[((size_t)sl * SEQ + rowb + xl) * 32 + hd] = ss; }
    }
    float* so = F.out + O_SSP + ((((size_t)layer * BATCH + mb * NSEQ_MB + sl) * 32 + hd) * 64) * 128;
#pragma unroll
    for (int jj = 0; jj < 4; ++jj)
#pragma unroll
        for (int r = 0; r < 4; ++r) so[(size_t)(16 * pi + 4 * fq + r) * 128 + 64 * nb + 16 * jj + fr] = S[jj][r];
    VM_WAIT(0); __syncthreads();
}

__device__ __forceinline__ void ssd_sample_unit(const Frame& F, int layer, int sq, int hd) {
    const int tid = F.tid, lane = F.lane; LAS float* L = (LAS float*)F.lds;
    LAS float* xs = L; LAS float* Bs = L + 16 * 64; LAS float* Cs = Bs + 16 * 128; LAS float* dts = Cs + 16 * 128; LAS float* das = dts + 16; LAS float* Yl = das + 16;
    const int g = hd >> 2;
    bf16_t* H = ws_bf(F, WS_H) + (size_t)(NP + sq * 16) * DINP;
    const float* hist = F.in[I_SCV] + ((size_t)layer * DECB + sq) * 3 * CONVDIM;
    const float* convw = F.in[I_CONVW] + (size_t)layer * 4 * CONVDIM; const float* convb = F.in[I_CONVB] + (size_t)layer * CONVDIM;
    __syncthreads();
    if (tid < 320) { const int c = tid; const int xc = c < 64 ? hd * 64 + c : (c < 192 ? 2048 + g * 128 + (c - 64) : 3072 + g * 128 + (c - 192));
        float win[19];
#pragma unroll
        for (int i = 0; i < 3; ++i) win[i] = hist[i * CONVDIM + xc];
#pragma unroll
        for (int t = 0; t < 16; ++t) win[3 + t] = bf2f(H[(size_t)t * DINP + C_X + xc]);
        const float w0 = convw[xc], w1 = convw[CONVDIM + xc], w2 = convw[2 * CONVDIM + xc], w3 = convw[3 * CONVDIM + xc], bb = convb[xc];
#pragma unroll
        for (int t = 0; t < 16; ++t) { const float a = fsilu(bb + win[t] * w0 + win[t + 1] * w1 + win[t + 2] * w2 + win[t + 3] * w3);
            if (c < 64) xs[t * 64 + c] = a; else if (c < 192) Bs[t * 128 + c - 64] = a; else Cs[t * 128 + c - 192] = a; } }
    if (tid < 16) { const float dt = softplus_f(bf2f(H[(size_t)tid * DINP + C_DT + hd]) + F.in[I_DTB][layer * 32 + hd]); dts[tid] = dt; das[tid] = fexp(-fexp(F.in[I_ALOG][layer * 32 + hd]) * dt); }
    __syncthreads();
    const int p = tid >> 3, n0 = (tid & 7) * 16;
    const size_t sbase = ((((size_t)layer * DECB + sq) * 32 + hd) * 64 + p) * 128 + n0;
    float S[16];
#pragma unroll
    for (int i = 0; i < 16; ++i) S[i] = F.in[I_SST][sbase + i];
    for (int t = 0; t < 16; ++t) { const float dec = das[t], xv = xs[t * 64 + p] * dts[t]; float part = 0.f;
#pragma unroll
        for (int i = 0; i < 16; ++i) { S[i] = S[i] * dec + xv * Bs[t * 128 + n0 + i]; part += Cs[t * 128 + n0 + i] * S[i]; }
        part += __shfl_xor(part, 1); part += __shfl_xor(part, 2); part += __shfl_xor(part, 4);
        if ((tid & 7) == 0) Yl[t * 64 + p] = part; }
#pragma unroll
    for (int i = 0; i < 16; ++i) F.out[O_SSS + sbase + i] = S[i];
    __syncthreads();
    const float Dh = F.in[I_SD][layer * 32 + hd];
#pragma unroll
    for (int j = 0; j < 2; ++j) { const int it = tid + 512 * j, t = it >> 6, pp = it & 63;
        const float z = bf2f(H[(size_t)t * DINP + C_Z + hd * 64 + pp]); const float v = (Yl[t * 64 + pp] + Dh * xs[t * 64 + pp]) * fsilu(z);
        H[(size_t)t * DINP + C_Z + hd * 64 + pp] = bf1(v);
        const float ss = wave_sum(v * v);
        if (lane == 0) ws_f(F, WS_SSQ)[((size_t)NP + sq * 16 + t) * 32 + hd] = ss; }
}

__device__ __forceinline__ int t5_bucket(int rel) {
    const int n = rel < 0 ? -rel : rel; const int b = rel > 0 ? 16 : 0;
    if (n < 8) return b + n;
    int v = 8; v += n >= 12; v += n >= 16; v += n >= 23; v += n >= 32; v += n >= 46; v += n >= 64; v += n >= 91;
    return b + v;
}
constexpr int AK_P = 72, AV_P = 200;
constexpr int AL_K = 0, AL_VT = AL_K + 192 * AK_P * 2, AL_LUT = AL_VT + 64 * AV_P * 2, AL_END = AL_LUT + 4 * 256 * 4;
static_assert(AL_END <= RING_BYTES, "attention LDS map");
__device__ __forceinline__ void attn_prompt_unit(const Frame& F, int layer, int sl, int ck, int kh) {
    const int tid = F.tid, lane = F.lane, w = F.wave, q32 = lane & 31, hi = lane >> 5;
    LAS bf16_t* Kl = (LAS bf16_t*)(F.lds + AL_K); LAS bf16_t* VT = (LAS bf16_t*)(F.lds + AL_VT); LAS float* lut = (LAS float*)(F.lds + AL_LUT);
    bf16_t* H = ws_bf(F, WS_H) + (size_t)sl * SEQ * DINP;
    __syncthreads();
#pragma unroll
    for (int j = 0; j < 3; ++j) { const int id = tid + 512 * j, key = id >> 3, cg = id & 7; const int t = 64 * (ck - 2) + key;
        u32x4 kv = (u32x4){0u, 0u, 0u, 0u}, vv = kv;
        if (t >= 0) { kv = *(const u32x4*)(H + (size_t)t * DINP + C_K + kh * 64 + 8 * cg); vv = *(const u32x4*)(H + (size_t)t * DINP + C_V + kh * 64 + 8 * cg); }
        *(LAS u32x4*)(Kl + key * AK_P + 8 * cg) = kv;
        VT[(8 * cg + 0) * AV_P + key] = (bf16_t)(vv.x & 0xffffu); VT[(8 * cg + 1) * AV_P + key] = (bf16_t)(vv.x >> 16); VT[(8 * cg + 2) * AV_P + key] = (bf16_t)(vv.y & 0xffffu); VT[(8 * cg + 3) * AV_P + key] = (bf16_t)(vv.y >> 16);
        VT[(8 * cg + 4) * AV_P + key] = (bf16_t)(vv.z & 0xffffu); VT[(8 * cg + 5) * AV_P + key] = (bf16_t)(vv.z >> 16); VT[(8 * cg + 6) * AV_P + key] = (bf16_t)(vv.w & 0xffffu); VT[(8 * cg + 7) * AV_P + key] = (bf16_t)(vv.w >> 16); }
    for (int e = tid; e < 4 * 255; e += NTHREADS) { const int gg = e / 255, idx = e % 255; lut[gg * 256 + idx] = F.in[I_RELB][t5_bucket(idx - 191) * 16 + kh * 4 + gg]; }
    __syncthreads();
    const int gq = w >> 1, qh = w & 1, head = kh * 4 + gq;
    const size_t qrow = (size_t)ck * 64 + 32 * qh + q32;
    bf16x8 qf[4];
#pragma unroll
    for (int ds = 0; ds < 4; ++ds) qf[ds] = *(const bf16x8*)(H + qrow * DINP + C_Q + head * 64 + 16 * ds + 8 * hi);
    f32x16 sc[6];
#pragma unroll
    for (int kt = 0; kt < 6; ++kt) {
#pragma unroll
        for (int r = 0; r < 16; ++r) sc[kt][r] = 0.f;
#pragma unroll
        for (int ds = 0; ds < 4; ++ds) { const bf16x8 a = *(const LAS bf16x8*)(Kl + (32 * kt + q32) * AK_P + 16 * ds + 8 * hi); sc[kt] = __builtin_amdgcn_mfma_f32_32x32x16_bf16(a, qf[ds], sc[kt], 0, 0, 0); } }
    const int qidx = 32 * qh + q32; const float sink = F.in[I_SINK][layer * 16 + head];
    float mx = -3.0e38f;
#pragma unroll
    for (int kt = 0; kt < 6; ++kt)
#pragma unroll
        for (int r = 0; r < 16; ++r) { const int key = 32 * kt + (r & 3) + 8 * (r >> 2) + 4 * hi; const int rel = key - 128 - qidx;
            float s = sc[kt][r] * 0.125f + lut[gq * 256 + rel + 191]; if (ck < 2 && 64 * ck + key - 128 < 0) s = -1e30f; sc[kt][r] = s; mx = fmaxf(mx, s); }
    mx = fmaxf(mx, __shfl_xor(mx, 32)); mx = fmaxf(mx, sink);
    float sum = 0.f;
#pragma unroll
    for (int kt = 0; kt < 6; ++kt)
#pragma unroll
        for (int r = 0; r < 16; ++r) { const float e = fexp(sc[kt][r] - mx); sc[kt][r] = e; sum += e; }
    sum += __shfl_xor(sum, 32);
    const float inv = 1.0f / (sum + fexp(sink - mx));
    f32x16 o[2];
#pragma unroll
    for (int d2 = 0; d2 < 2; ++d2)
#pragma unroll
        for (int r = 0; r < 16; ++r) o[d2][r] = 0.f;
#pragma unroll
    for (int kt = 0; kt < 6; ++kt)
#pragma unroll
        for (int s = 0; s < 2; ++s) {
            u32x4 pw; pw.x = pk2(sc[kt][8 * s + 0], sc[kt][8 * s + 1]); pw.y = pk2(sc[kt][8 * s + 2], sc[kt][8 * s + 3]); pw.z = pk2(sc[kt][8 * s + 4], sc[kt][8 * s + 5]); pw.w = pk2(sc[kt][8 * s + 6], sc[kt][8 * s + 7]);
            const bf16x8 pa = __builtin_bit_cast(bf16x8, pw);
#pragma unroll
            for (int d2 = 0; d2 < 2; ++d2) { const LAS bf16_t* vp = VT + (32 * d2 + q32) * AV_P + 32 * kt + 16 * s + 4 * hi;
                const u32x2 lo = *(const LAS u32x2*)vp, hh = *(const LAS u32x2*)(vp + 8); u32x4 vw; vw.x = lo.x; vw.y = lo.y; vw.z = hh.x; vw.w = hh.y;
                o[d2] = __builtin_amdgcn_mfma_f32_32x32x16_bf16(pa, __builtin_bit_cast(bf16x8, vw), o[d2], 0, 0, 0); } }
#pragma unroll
    for (int r = 0; r < 16; ++r) { const int q = (r & 3) + 8 * (r >> 2) + 4 * hi; const float iv = __shfl(inv, q);
        bf16_t* op = H + ((size_t)ck * 64 + 32 * qh + q) * DINP + C_Q + head * 64 + q32;
        op[0] = bf1(o[0][r] * iv); op[32] = bf1(o[1][r] * iv); }
}
__device__ __forceinline__ void attn_sample_unit(const Frame& F, int layer, int sq, int kh) {
    const int tid = F.tid; LAS float* L = (LAS float*)F.lds;
    LAS float* Kf = L; LAS float* Vf = Kf + 144 * 65; LAS float* Qf = Vf + 144 * 64; LAS float* P = Qf + 64 * 65; LAS float* Pinv = P + 64 * 145;
    static_assert((144 * 65 + 144 * 64 + 64 * 65 + 64 * 145 + 64) * 4 <= RING_BYTES, "sample attention LDS map");
    bf16_t* H = ws_bf(F, WS_H) + (size_t)(NP + sq * 16) * DINP;
    const float* ck = F.in[I_CK] + ((size_t)layer * DECB + sq) * WINDOW * 256; const float* cv = F.in[I_CV] + ((size_t)layer * DECB + sq) * WINDOW * 256;
    __syncthreads();
    for (int i = tid; i < 144 * 64; i += NTHREADS) { const int key = i >> 6, d = i & 63;
        Kf[key * 65 + d] = key < 128 ? ck[(size_t)key * 256 + kh * 64 + d] : bf2f(H[(size_t)(key - 128) * DINP + C_K + kh * 64 + d]);
        Vf[key * 64 + d] = key < 128 ? cv[(size_t)key * 256 + kh * 64 + d] : bf2f(H[(size_t)(key - 128) * DINP + C_V + kh * 64 + d]); }
    for (int i = tid; i < 64 * 64; i += NTHREADS) { const int row = i >> 6, d = i & 63; Qf[row * 65 + d] = bf2f(H[(size_t)(row & 15) * DINP + C_Q + (kh * 4 + (row >> 4)) * 64 + d]); }
    __syncthreads();
    for (int i = tid; i < 64 * 144; i += NTHREADS) { const int row = i / 144, key = i % 144; float s = 0.f;
        for (int d = 0; d < 64; ++d) s += Qf[row * 65 + d] * Kf[key * 65 + d];
        P[row * 145 + key] = s * 0.125f + F.in[I_RELB][t5_bucket(key - 128 - (row & 15)) * 16 + kh * 4 + (row >> 4)]; }
    __syncthreads();
    { const int row = tid >> 3, sub = tid & 7; const float sink = F.in[I_SINK][layer * 16 + kh * 4 + (row >> 4)]; float mx = -3.0e38f;
      for (int k = sub; k < 144; k += 8) mx = fmaxf(mx, P[row * 145 + k]);
      mx = fmaxf(mx, __shfl_xor(mx, 1)); mx = fmaxf(mx, __shfl_xor(mx, 2)); mx = fmaxf(mx, __shfl_xor(mx, 4)); mx = fmaxf(mx, sink);
      float sum = 0.f;
      for (int k = sub; k < 144; k += 8) { const float e = fexp(P[row * 145 + k] - mx); P[row * 145 + k] = e; sum += e; }
      sum += __shfl_xor(sum, 1); sum += __shfl_xor(sum, 2); sum += __shfl_xor(sum, 4);
      if (sub == 0) Pinv[row] = 1.0f / (sum + fexp(sink - mx)); }
    __syncthreads();
    { const int row = tid >> 3, d0 = (tid & 7) * 8; float o[8] = {0.f, 0.f, 0.f, 0.f, 0.f, 0.f, 0.f, 0.f};
      for (int k = 0; k < 144; ++k) { const float pv = P[row * 145 + k];
#pragma unroll
          for (int i = 0; i < 8; ++i) o[i] += pv * Vf[k * 64 + d0 + i]; }
      const float iv = Pinv[row];
#pragma unroll
      for (int i = 0; i < 8; ++i) o[i] *= iv;
      *(u32x4*)(H + (size_t)(row & 15) * DINP + C_Q + (kh * 4 + (row >> 4)) * 64 + d0) = pack8(o); }
}
__device__ __forceinline__ void sc_unit(const Frame& F, int layer, int tile) {
    const int tid = F.tid, cg = tid & 127, rs = tid >> 7; bf16_t* H = ws_bf(F, WS_H);
    const float* wsc = F.in[I_SCW] + (size_t)layer * 3 * D + 8 * cg; float wt[3][8];
#pragma unroll
    for (int i = 0; i < 3; ++i)
#pragma unroll
        for (int c = 0; c < 8; ++c) wt[i][c] = wsc[i * D + c];
    const int row0 = tile * 64 + 16 * rs; const bool smp = row0 >= NP; const int tt0 = smp ? 0 : row0 % SEQ;
    float u1[8], u2[8];
    if (tt0 >= 2) { float c8[8], h8[8];
        unpack8(*(const u32x4*)(H + (size_t)(row0 - 2) * DINP + C_SCC + 8 * cg), c8); unpack8(*(const u32x4*)(H + (size_t)(row0 - 2) * DINP + C_SCH + 8 * cg), h8);
#pragma unroll
        for (int c = 0; c < 8; ++c) u2[c] = c8[c] * h8[c];
        unpack8(*(const u32x4*)(H + (size_t)(row0 - 1) * DINP + C_SCC + 8 * cg), c8); unpack8(*(const u32x4*)(H + (size_t)(row0 - 1) * DINP + C_SCH + 8 * cg), h8);
#pragma unroll
        for (int c = 0; c < 8; ++c) u1[c] = c8[c] * h8[c]; }
    else if (smp) { const float* hp = F.in[I_SSC] + (((size_t)layer * DECB + ((row0 - NP) >> 4)) * 2) * D + 8 * cg;
#pragma unroll
        for (int c = 0; c < 8; ++c) { u2[c] = hp[c]; u1[c] = hp[D + c]; } }
    else {
#pragma unroll
        for (int c = 0; c < 8; ++c) { u2[c] = 0.f; u1[c] = 0.f; } }
#pragma unroll 1
    for (int q = 0; q < 4; ++q) {
        u32x4 cw_[4], hw_[4], bw_[4];
#pragma unroll
        for (int i = 0; i < 4; ++i) { const bf16_t* hp = H + (size_t)(row0 + 4 * q + i) * DINP + 8 * cg; cw_[i] = *(const u32x4*)(hp + C_SCC); hw_[i] = *(const u32x4*)(hp + C_SCH); bw_[i] = *(const u32x4*)(hp + C_SCB); }
        asm volatile("" ::: "memory");
#pragma unroll
        for (int i = 0; i < 4; ++i) { float c8[8], h8[8], b8[8], a[8]; unpack8(cw_[i], c8); unpack8(hw_[i], h8); unpack8(bw_[i], b8);
#pragma unroll
            for (int c = 0; c < 8; ++c) { const float u0 = c8[c] * h8[c]; a[c] = (u2[c] * wt[0][c] + u1[c] * wt[1][c] + u0 * wt[2][c]) * b8[c]; u2[c] = u1[c]; u1[c] = u0; }
            *(u32x4*)(H + (size_t)(row0 + 4 * q + i) * DINP + C_SCB + 8 * cg) = pack8(a); }
    }
}
__device__ __forceinline__ void state_out_unit(const Frame& F, int layer, int mb, int sl, bool smp) {
    const int tid = F.tid; const bf16_t* H = ws_bf(F, WS_H);
    const int nkv = smp ? DECS : WINDOW, len = smp ? DECS : SEQ; const size_t row0 = smp ? (size_t)NP + sl * 16 : (size_t)sl * SEQ; const int sg = smp ? sl : mb * NSEQ_MB + sl;
    const size_t nb_ = smp ? DECB : BATCH;
    float* ko = F.out + (smp ? O_KS : O_KP) + ((size_t)layer * nb_ + sg) * nkv * 256; float* vo = F.out + (smp ? O_VS : O_VP) + ((size_t)layer * nb_ + sg) * nkv * 256;
    for (int i = tid; i < nkv * 32; i += NTHREADS) { const int j = i >> 5, c8 = (i & 31) * 8; const bf16_t* hp = H + (row0 + len - nkv + j) * DINP; float f[8];
        unpack8(*(const u32x4*)(hp + C_K + c8), f); *(f32x4*)(ko + (size_t)j * 256 + c8) = (f32x4){f[0], f[1], f[2], f[3]}; *(f32x4*)(ko + (size_t)j * 256 + c8 + 4) = (f32x4){f[4], f[5], f[6], f[7]};
        unpack8(*(const u32x4*)(hp + C_V + c8), f); *(f32x4*)(vo + (size_t)j * 256 + c8) = (f32x4){f[0], f[1], f[2], f[3]}; *(f32x4*)(vo + (size_t)j * 256 + c8 + 4) = (f32x4){f[4], f[5], f[6], f[7]}; }
    float* co = F.out + (smp ? O_CVS : O_CVP) + ((size_t)layer * nb_ + sg) * 3 * CONVDIM;
    for (int i = tid; i < 3 * 512; i += NTHREADS) { const int j = i / 512, c8 = (i % 512) * 8; float f[8]; unpack8(*(const u32x4*)(H + (row0 + len - 3 + j) * DINP + C_X + c8), f);
        *(f32x4*)(co + (size_t)j * CONVDIM + c8) = (f32x4){f[0], f[1], f[2], f[3]}; *(f32x4*)(co + (size_t)j * CONVDIM + c8 + 4) = (f32x4){f[4], f[5], f[6], f[7]}; }
    float* so = F.out + (smp ? O_SCS : O_SCP) + ((size_t)layer * nb_ + sg) * 2 * D;
    for (int i = tid; i < 2 * 128; i += NTHREADS) { const int j = i >> 7, c8 = (i & 127) * 8; float c[8], h[8]; const bf16_t* hp = H + (row0 + len - 2 + j) * DINP;
        unpack8(*(const u32x4*)(hp + C_SCC + c8), c); unpack8(*(const u32x4*)(hp + C_SCH + c8), h);
        *(f32x4*)(so + (size_t)j * D + c8) = (f32x4){c[0] * h[0], c[1] * h[1], c[2] * h[2], c[3] * h[3]}; *(f32x4*)(so + (size_t)j * D + c8 + 4) = (f32x4){c[4] * h[4], c[5] * h[5], c[6] * h[6], c[7] * h[7]}; }
}
#ifndef MIX_MASK
#define MIX_MASK 0xFF
#endif
#define MIXON(b) ((MIX_MASK >> (b)) & 1)
__device__ __forceinline__ void step_mixers(const Frame& F, int layer, int mb) {
    const int n_ssd = NSEQ_MB * 32, n_att = NSEQ_MB * NCHUNK * NKV, n_sc = rows_of(mb) / 64, n_so = NSEQ_MB + (mb == 0 ? DECB : 0);
    const int n_ss = mb == 0 ? DECB * 32 : 0, n_as = mb == 0 ? DECB * NKV : 0;
    const int total = n_ssd + n_att + n_sc + n_so + n_ss + n_as;
    for (int un = F.bid; un < total; un += F.G) { int r = un;
#define UF(Fu) Frame Fu = F; Fu.tid = opq(F.tid); Fu.lane = Fu.tid & 63; Fu.wave = __builtin_amdgcn_readfirstlane(Fu.tid >> 6)
        if (r < n_ssd) { PROBE_T0(12) if constexpr (MIXON(0)) { UF(Fu); ssd_prompt_unit(Fu, layer, mb, r >> 5, r & 31); } PROBE_T1(12) continue; } r -= n_ssd;
        if (r < n_att) { if constexpr (MIXON(1)) { UF(Fu); attn_prompt_unit(Fu, layer, r / (NCHUNK * NKV), (r / NKV) % NCHUNK, r % NKV); } continue; } r -= n_att;
        if (r < n_sc) { if constexpr (MIXON(2)) { UF(Fu); sc_unit(Fu, layer, r); } continue; } r -= n_sc;
        if (r < n_so) { if constexpr (MIXON(3)) { UF(Fu); state_out_unit(Fu, layer, mb, r < NSEQ_MB ? r : r - NSEQ_MB, r >= NSEQ_MB); } continue; } r -= n_so;
        if (r < n_ss) { if constexpr (MIXON(4)) { UF(Fu); ssd_sample_unit(Fu, layer, r >> 5, r & 31); } continue; } r -= n_ss;
        if constexpr (MIXON(5)) { UF(Fu); attn_sample_unit(Fu, layer, r >> 2, r & 3); }
    }
}
__device__ __forceinline__ void step_gnorm(const Frame& F, int mb) {
    const int gw = F.bid * NWAVES + F.wave, NGW = F.G * NWAVES, nr = rows_of(mb); bf16_t* H = ws_bf(F, WS_H); const float* ssq = ws_f(F, WS_SSQ);
    constexpr int RB = 4; const int g = F.lane >> 3;
    for (int r0 = gw; r0 < nr; r0 += RB * NGW) {
        u32x4 d[RB][4]; f32x4 q[RB];
#pragma unroll
        for (int i = 0; i < RB; ++i) { const int r = r0 + i * NGW < nr ? r0 + i * NGW : r0; q[i] = *(const f32x4*)(ssq + (size_t)r * 32 + 4 * g); const u32x4* p = (const u32x4*)(H + (size_t)r * DINP + C_Z + 32 * F.lane);
#pragma unroll
            for (int j = 0; j < 4; ++j) d[i][j] = p[j]; }
        asm volatile("" ::: "memory");
#pragma unroll
        for (int i = 0; i < RB; ++i) { const int r = r0 + i * NGW; if (r >= nr) continue;
            const float rstd = 1.0f / sqrtf(((q[i][0] + q[i][1]) + (q[i][2] + q[i][3])) * (1.0f / 256.0f) + LN_EPS); u32x4* p = (u32x4*)(H + (size_t)r * DINP + C_Z + 32 * F.lane);
#pragma unroll
            for (int j = 0; j < 4; ++j) { float f[8]; unpack8(d[i][j], f);
#pragma unroll
                for (int k = 0; k < 8; ++k) f[k] *= rstd;
                p[j] = pack8(f); } }
    }
}
constexpr int LOG_NEXP = NEXP == 32 ? 5 : (NEXP == 16 ? 4 : (NEXP == 8 ? 3 : 2));
template <int N, int MASK> struct RedStep {
    static __device__ __forceinline__ void run(float* v, int lane) {
        constexpr int Hn = N / 2; const bool up = (lane & MASK) != 0;
#pragma unroll
        for (int i = 0; i < Hn; ++i) { const float keep = up ? v[i + Hn] : v[i], send = up ? v[i] : v[i + Hn]; v[i] = keep + __shfl_xor(send, MASK); }
        if constexpr (Hn > 1) RedStep<Hn, (MASK >> 1)>::run(v, lane);
    }
};
__device__ __forceinline__ void step_ln1_router(const Frame& F, int layer, int mb) {
    LAS float* wT = (LAS float*)F.lds;
    const float* rw = F.in[I_RW] + (size_t)layer * D * NEXP;
    __syncthreads();
    for (int i = F.tid; i < D * NEXP; i += NTHREADS) { const int e = i / D, k = i % D; wT[i] = rw[(size_t)k * NEXP + e]; }
    unsigned* cnt = F.ctl + CW_CNT + (mb * DEPTH + layer) * 64;
    LAS unsigned* lcnt = (LAS unsigned*)(F.lds + MISC_OFF) + 128;
    if (F.tid < 64) lcnt[F.tid] = 0u;
    __syncthreads();
    const int gw = F.bid * NWAVES + F.wave, NGW = F.G * NWAVES, nr = rows_of(mb), lane = F.lane;
    const float* lg = F.in[I_LN1G] + (size_t)layer * D; const float* lb = F.in[I_LN1B] + (size_t)layer * D; const float* rb = F.in[I_RB] + (size_t)layer * NEXP;
    bf16_t* XB = ws_bf(F, WS_XB); int* topi = (int*)(F.ws + WS_TOPI); float* gate = ws_f(F, WS_GATE); int* pos = (int*)(F.ws + WS_POS);
    constexpr int RB = 4, NH = NEXP / 2, LOGH = LOG_NEXP - 1;
    const int myexp = ((lane & 1) * NH) | ((lane >> (6 - LOGH)) & (NH - 1));
    const float myb = rb[myexp];
    for (int r0 = gw; r0 < nr; r0 += RB * NGW) {
        f32x4 v[RB][4]; int rr[RB]; bool ok[RB];
#pragma unroll
        for (int i = 0; i < RB; ++i) { const int r = r0 + i * NGW; ok[i] = r < nr; rr[i] = ok[i] ? r : r0; const float* xr = x_out_row(F, mb, rr[i]);
#pragma unroll
            for (int j = 0; j < 4; ++j) v[i][j] = *((const f32x4*)xr + lane + 64 * j); }
        asm volatile("" ::: "memory");
#pragma unroll
        for (int i = 0; i < RB; ++i) {
            float* xr = x_out_row(F, mb, rr[i]); float s = 0.f;
#pragma unroll
            for (int j = 0; j < 4; ++j) s += (v[i][j][0] + v[i][j][1]) + (v[i][j][2] + v[i][j][3]);
            const float mean = wave_sum(s) * (1.0f / D); float s2 = 0.f;
#pragma unroll
            for (int j = 0; j < 4; ++j) { v[i][j] = v[i][j] - mean; s2 += (v[i][j][0] * v[i][j][0] + v[i][j][1] * v[i][j][1]) + (v[i][j][2] * v[i][j][2] + v[i][j][3] * v[i][j][3]); }
            const float rstd = 1.0f / sqrtf(wave_sum(s2) * (1.0f / D) + LN_EPS);
#pragma unroll
            for (int j = 0; j < 4; ++j) { const f32x4 gg = *((const f32x4*)lg + lane + 64 * j), bb = *((const f32x4*)lb + lane + 64 * j); v[i][j] = v[i][j] * rstd * gg + bb;
                if (ok[i]) { *((f32x4*)xr + lane + 64 * j) = v[i][j]; u32x2 w; w.x = pk2(v[i][j][0], v[i][j][1]); w.y = pk2(v[i][j][2], v[i][j][3]); *((u32x2*)(XB + (size_t)rr[i] * D) + lane + 64 * j) = w; } }
        }
        float val[RB];
#pragma unroll
        for (int hf = 0; hf < 2; ++hf) {
            float lgt[RB][NH];
#pragma unroll
            for (int e = 0; e < NH; ++e) { float a[RB];
#pragma unroll
                for (int i = 0; i < RB; ++i) a[i] = 0.f;
#pragma unroll
                for (int j = 0; j < 4; ++j) { const f32x4 wv = *((const LAS f32x4*)(wT + (hf * NH + e) * D) + lane + 64 * j);
#pragma unroll
                    for (int i = 0; i < RB; ++i) a[i] += (v[i][j][0] * wv[0] + v[i][j][1] * wv[1]) + (v[i][j][2] * wv[2] + v[i][j][3] * wv[3]); }
#pragma unroll
                for (int i = 0; i < RB; ++i) lgt[i][e] = a[i];
                if ((e & 1) == 1) asm volatile("" ::: "memory"); }
#pragma unroll
            for (int i = 0; i < RB; ++i) { RedStep<NH, 32>::run(lgt[i], lane); float tot = lgt[i][0];
#pragma unroll
                for (int mk = (32 >> LOGH); mk >= 1; mk >>= 1) tot += __shfl_xor(tot, mk);
                if ((lane & 1) == hf) val[i] = tot + myb; }
        }
#pragma unroll
        for (int i = 0; i < RB; ++i) {
            float tv[4]; int te[4]; float vv = val[i];
#pragma unroll
            for (int k = 0; k < 4; ++k) { float bv = vv; int be = myexp;
#pragma unroll
                for (int o = 1; o < 64; o <<= 1) { const float ov = __shfl_xor(bv, o); const int oe = __shfl_xor(be, o); if (ov > bv || (ov == bv && oe < be)) { bv = ov; be = oe; } }
                tv[k] = bv; te[k] = be; if (myexp == be) vv = -3.0e38f; }
            const float e1 = fexp(tv[1] - tv[0]), e2 = fexp(tv[2] - tv[0]), e3 = fexp(tv[3] - tv[0]); const float inv = 1.0f / (1.0f + e1 + e2 + e3);
            if (lane < 4 && ok[i]) { const int e = lane == 0 ? te[0] : (lane == 1 ? te[1] : (lane == 2 ? te[2] : te[3])); const float gv = (lane == 0 ? 1.0f : (lane == 1 ? e1 : (lane == 2 ? e2 : e3))) * inv;
                const unsigned rk = __hip_atomic_fetch_add(lcnt + e, 1u, __ATOMIC_RELAXED, __HIP_MEMORY_SCOPE_WORKGROUP);
                topi[(size_t)rr[i] * 4 + lane] = e; gate[(size_t)rr[i] * 4 + lane] = gv; pos[(size_t)rr[i] * 4 + lane] = (int)rk; }
        }
    }
    __syncthreads();
    if (F.tid < NEXP) lcnt[32 + F.tid] = __hip_atomic_fetch_add(cnt + F.tid, lcnt[F.tid], __ATOMIC_RELAXED, __HIP_MEMORY_SCOPE_AGENT);
    __syncthreads();
    for (int r = gw; r < nr; r += NGW) if (lane < 4) pos[(size_t)r * 4 + lane] += (int)lcnt[32 + topi[(size_t)r * 4 + lane]];
}
__device__ __forceinline__ int moe_table(const Frame& F, int layer, int mb) {
    LAS int* M = (LAS int*)(F.lds + MISC_OFF);
    __syncthreads();
    if (F.tid == 0) { unsigned* cnt = F.ctl + CW_CNT + (mb * DEPTH + layer) * 64; int acc = 0;
        for (int e = 0; e < NEXP; ++e) { const int c = (int)__hip_atomic_load(cnt + e, __ATOMIC_RELAXED, __HIP_MEMORY_SCOPE_AGENT); M[64 + e] = acc * 256; acc += (c + 255) / 256; M[16 + e] = acc; } }
    __syncthreads();
    return M[16 + NEXP - 1];
}
__device__ __forceinline__ void step_gather(const Frame& F, int layer, int mb) {
    (void)moe_table(F, layer, mb); const LAS int* M = (const LAS int*)(F.lds + MISC_OFF);
    const int gw = F.bid * NWAVES + F.wave, NGW = F.G * NWAVES, nr = rows_of(mb), lane = F.lane;
    const bf16_t* XB = ws_bf(F, WS_XB); bf16_t* XS = ws_bf(F, WS_H); const int* topi = (const int*)(F.ws + WS_TOPI); const float* gate = ws_f(F, WS_GATE); int* pos = (int*)(F.ws + WS_POS); float* gs = ws_f(F, WS_GSORT);
    constexpr int RB = 4;
    for (int r0 = gw; r0 < nr; r0 += RB * NGW) {
        u32x4 a[RB], b[RB]; int pk[RB][4]; float gk[RB];
#pragma unroll
        for (int i = 0; i < RB; ++i) { const int r = r0 + i * NGW < nr ? r0 + i * NGW : r0;
            a[i] = *((const u32x4*)(XB + (size_t)r * D) + lane); b[i] = *((const u32x4*)(XB + (size_t)r * D) + 64 + lane); gk[i] = gate[(size_t)r * 4 + (lane & 3)];
#pragma unroll
            for (int k = 0; k < 4; ++k) { const int e = topi[(size_t)r * 4 + k]; pk[i][k] = M[64 + e] + pos[(size_t)r * 4 + k]; } }
        WAVE_SYNC();
        asm volatile("" ::: "memory");
#pragma unroll
        for (int i = 0; i < RB; ++i) { const int r = r0 + i * NGW; if (r >= nr) continue;
#pragma unroll
            for (int k = 0; k < 4; ++k) { const int p = pk[i][k];
                *((u32x4*)(XS + (size_t)p * D) + lane) = a[i]; *((u32x4*)(XS + (size_t)p * D) + 64 + lane) = b[i];
                if (lane == k) { pos[(size_t)r * 4 + k] = p; gs[p] = gk[i]; } } }
    }
}
__device__ __forceinline__ void step_ln2(const Frame& F, int layer, int mb) {
    const int gw = F.bid * NWAVES + F.wave, NGW = F.G * NWAVES, nr = rows_of(mb), lane = F.lane;
    const float* lg = F.in[I_LN2G] + (size_t)layer * D; const float* lb = F.in[I_LN2B] + (size_t)layer * D;
    const bf16_t* OUTS = ws_bf(F, WS_H) + (size_t)2 * RP * D; const int* pos = (const int*)(F.ws + WS_POS); bf16_t* XB = ws_bf(F, WS_XB);
    constexpr int RB = 2;
    for (int r0 = gw; r0 < nr; r0 += RB * NGW) {
        f32x4 v[RB][4]; u32x2 ow[RB][4][4]; int rr[RB];
#pragma unroll
        for (int i = 0; i < RB; ++i) { rr[i] = r0 + i * NGW < nr ? r0 + i * NGW : r0; const float* xr = x_out_row(F, mb, rr[i]); int p[4];
#pragma unroll
            for (int k = 0; k < 4; ++k) p[k] = pos[(size_t)rr[i] * 4 + k];
#pragma unroll
            for (int j = 0; j < 4; ++j) { v[i][j] = *((const f32x4*)xr + lane + 64 * j);
#pragma unroll
                for (int k = 0; k < 4; ++k) ow[i][k][j] = *((const u32x2*)(OUTS + (size_t)p[k] * D) + lane + 64 * j); } }
        asm volatile("" ::: "memory");
#pragma unroll
        for (int i = 0; i < RB; ++i) { if (r0 + i * NGW >= nr) continue;
            float* xr = x_out_row(F, mb, rr[i]); float s = 0.f;
#pragma unroll
            for (int j = 0; j < 4; ++j) { v[i][j] = v[i][j] * ALPHA;
#pragma unroll
                for (int k = 0; k < 4; ++k) { const u32x2 w = ow[i][k][j]; v[i][j] = v[i][j] + (f32x4){blo(w.x), bhi(w.x), blo(w.y), bhi(w.y)}; }
                s += (v[i][j][0] + v[i][j][1]) + (v[i][j][2] + v[i][j][3]); }
            const float mean = wave_sum(s) * (1.0f / D); float s2 = 0.f;
#pragma unroll
            for (int j = 0; j < 4; ++j) { v[i][j] = v[i][j] - mean; s2 += (v[i][j][0] * v[i][j][0] + v[i][j][1] * v[i][j][1]) + (v[i][j][2] * v[i][j][2] + v[i][j][3] * v[i][j][3]); }
            const float rstd = 1.0f / sqrtf(wave_sum(s2) * (1.0f / D) + LN_EPS);
#pragma unroll
            for (int j = 0; j < 4; ++j) { const f32x4 gg = *((const f32x4*)lg + lane + 64 * j), bb = *((const f32x4*)lb + lane + 64 * j); v[i][j] = v[i][j] * rstd * gg + bb;
                *((f32x4*)xr + lane + 64 * j) = v[i][j]; u32x2 w; w.x = pk2(v[i][j][0], v[i][j][1]); w.y = pk2(v[i][j][2], v[i][j][3]); *((u32x2*)(XB + (size_t)rr[i] * D) + lane + 64 * j) = w; } }
    }
}

constexpr int PH_PER = 11, NSTEPS = 1 + NMB * (DEPTH * (PH_PER - 1) + 1);
__global__ void __launch_bounds__(NTHREADS, 2) fwd(Args args) {
#ifdef EMU
    unsigned char* lds = emu_wg->lds;
#else
    extern __shared__ __attribute__((aligned(16))) unsigned char lds[];
#endif
    Frame F0; F0.lds = (LAS unsigned char*)lds; F0.tid = threadIdx.x; F0.lane = F0.tid & 63; F0.wave = __builtin_amdgcn_readfirstlane(F0.tid >> 6); F0.G = gridDim.x; F0.bid = blockIdx.x;
#ifdef EMU
    F0.in = args.in;
#else
    F0.in = (ArgTab)__builtin_amdgcn_kernarg_segment_ptr();
    static_assert(offsetof(Args, out) == 248 && offsetof(Args, ws) == 256 && offsetof(Args, in) == 0, "PF() reads the argument struct by offset");
#endif
    F0.out = args.out; F0.ws = args.ws; F0.ctl = (unsigned*)(args.ws + WS_CTL);
    const Frame& F = F0;
    const int lo = args.lo, hi = args.hi;
#ifndef EMU
    for (int u = F.tid; u < (LDS_BYTES - MISC_OFF) / 4; u += NTHREADS) ((LAS unsigned*)(F.lds + MISC_OFF))[u] = 0u;
    __syncthreads();
    XcdBarrier bar; bar.bar = F.ctl + CW_BAR; bar.x = 0; bar.st = nullptr;
    if (hi - lo > 1) bar = xcd_barrier_post(F.ctl + CW_BAR, (volatile LAS unsigned*)(F.lds + MISC_OFF) + 8);
#define SEAM(s) do { if ((s) + 1 < hi) { XcdBarrier b2_ = bar; unsigned long long bp_ = (unsigned long long)b2_.bar; asm volatile("" : "+s"(bp_)); b2_.bar = (unsigned*)bp_; xcd_barrier(b2_); } } while (0)
#else
#define SEAM(s) do { } while (0)
#endif
#ifndef PH_MASK
#define PH_MASK 0xFFFFFFFF
#endif
#define IN(s) (lo <= (s) && (s) < hi)
#define PHON(b) ((PH_MASK >> (b)) & 1)
#ifdef EMU
#define PF(Fp) Frame Fp = F0
#else
#define PF(Fp) Frame Fp; { unsigned long long kp_ = (unsigned long long)__builtin_amdgcn_kernarg_segment_ptr(); asm volatile("" : "+s"(kp_)); \
    Fp.in = (ArgTab)kp_; Fp.out = *(float* const __attribute__((address_space(4)))*)(kp_ + 248); Fp.ws = *(unsigned char* const __attribute__((address_space(4)))*)(kp_ + 256); Fp.ctl = (unsigned*)Fp.ws; \
    Fp.lds = F0.lds; Fp.G = F0.G; Fp.bid = F0.bid; Fp.tid = opq(F0.tid); Fp.lane = Fp.tid & 63; Fp.wave = __builtin_amdgcn_readfirstlane(Fp.tid >> 6); }
#endif
    int step = 0;
    if (IN(step)) { PROBE_T0(0) if constexpr (PHON(0)) { PF(F); step_weights(F); } PROBE_T1(0) SEAM(step); }
    ++step;
    for (int mb = 0; mb < NMB; ++mb)
        for (int layer = 0; layer < DEPTH; ++layer) {
            const int nr = rows_of(mb);
            if (layer == 0) { if (IN(step)) { PROBE_T0(1) if constexpr (PHON(1)) { PF(F); step_xb(F, mb); } PROBE_T1(1) SEAM(step); }
                ++step; }
            if (IN(step)) { PROBE_T0(2) if constexpr (PHON(2)) { PF(F); pg8::Gemm g{ws_bf(F, WS_XB), wl_ptr(F, layer, WL_IN), nr, DINP, D, D}; pg8::StaticOrder S; S.init(nr, DINP, F.G, F.bid);
                pg8::EpiStoreBf16 E{ws_bf(F, WS_H), DINP}; pg8::gemm_phase(F.lds, g, S, E); } PROBE_T1(2) SEAM(step); }
            ++step;
            if (IN(step)) { PROBE_T0(3) if constexpr (PHON(3)) { PF(F); step_mixers(F, layer, mb); } PROBE_T1(3) SEAM(step); }
            ++step;
            if (IN(step)) { PROBE_T0(4) if constexpr (PHON(4)) { PF(F); step_gnorm(F, mb); } PROBE_T1(4) SEAM(step); }
            ++step;
            if (IN(step)) { PROBE_T0(5) if constexpr (PHON(5)) { PF(F); pg8::StaticOrder S; S.init(nr, D, F.G, F.bid); bf16_t* H = ws_bf(F, WS_H); bf16_t* MGb = ws_bf(F, WS_XB);
#ifndef MERGE_MASK
#define MERGE_MASK 7
#endif
                if constexpr (MERGE_MASK & 1) { pg8::Gemm g{H + C_Z, wl_ptr(F, layer, WL_SSD), nr, D, DINNER, DINP}; pg8::EpiGate<0> E{H + C_GSSD, MGb}; pg8::gemm_phase(F.lds, g, S, E); }
                if constexpr (MERGE_MASK & 2) { pg8::Gemm g{H + C_Q, wl_ptr(F, layer, WL_ATT), nr, D, D, DINP}; pg8::EpiGate<1> E{H + C_GATT, MGb}; pg8::gemm_phase(F.lds, g, S, E); }
                if constexpr (MERGE_MASK & 4) { pg8::Gemm g{H + C_SCB, wl_ptr(F, layer, WL_SC), nr, D, D, DINP}; pg8::EpiGate<1> E{H + C_GSC, MGb}; pg8::gemm_phase(F.lds, g, S, E); } }
                PROBE_T1(5) SEAM(step); }
            ++step;
            if (IN(step)) { PROBE_T0(6) if constexpr (PHON(6)) { PF(F); pg8::Gemm g{ws_bf(F, WS_XB), wl_ptr(F, layer, WL_O), nr, D, D, D}; pg8::StaticOrder S; S.init(nr, D, F.G, F.bid);
                pg8::EpiResid E{layer == 0 ? F.in[I_XP] + (size_t)mb * NP * D : F.out + O_YP + (size_t)mb * NP * D, layer == 0 ? F.in[I_XS] : F.out + O_YS, F.out + O_YP + (size_t)mb * NP * D, F.out + O_YS};
                pg8::gemm_phase(F.lds, g, S, E); } PROBE_T1(6) SEAM(step); }
            ++step;
            if (IN(step)) { PROBE_T0(7) if constexpr (PHON(7)) { PF(F); step_ln1_router(F, layer, mb); } PROBE_T1(7) SEAM(step); }
            ++step;
            if (IN(step)) { PROBE_T0(8) if constexpr (PHON(8)) { PF(F); step_gather(F, layer, mb); } PROBE_T1(8) SEAM(step); }
            ++step;
            if (IN(step)) { PROBE_T0(9) if constexpr (PHON(9)) { PF(F); const int nt = moe_table(F, layer, mb); pg8::MoeOrder S{(const LAS int*)(F.lds + MISC_OFF) + 16, 8, nt * 8, F.G, F.bid};
                pg8::Gemm g{ws_bf(F, WS_H), wl_ptr(F, layer, WL_UP), nt * 256, 2048, D, D}; pg8::EpiSwiglu E{ws_bf(F, WS_H) + (size_t)RP * D, F.in[I_BUP] + (size_t)layer * NEXP * 2048};
                pg8::gemm_phase(F.lds, g, S, E); } PROBE_T1(9) SEAM(step); }
            ++step;
            if (IN(step)) { PROBE_T0(10) if constexpr (PHON(10)) { PF(F); const int nt = moe_table(F, layer, mb); pg8::MoeOrder S{(const LAS int*)(F.lds + MISC_OFF) + 16, 4, nt * 4, F.G, F.bid};
                pg8::Gemm g{ws_bf(F, WS_H) + (size_t)RP * D, wl_ptr(F, layer, WL_DN), nt * 256, D, D, D}; pg8::EpiDown E{ws_bf(F, WS_H) + (size_t)2 * RP * D, F.in[I_BDN] + (size_t)layer * NEXP * D, ws_f(F, WS_GSORT)};
                pg8::gemm_phase(F.lds, g, S, E); } PROBE_T1(10) SEAM(step); }
            ++step;
            if (IN(step)) { PROBE_T0(11) if constexpr (PHON(11)) { PF(F); step_ln2(F, layer, mb); } PROBE_T1(11) SEAM(step); }
            ++step;
        }
}

#ifdef EMU
extern int emu_grid, emu_step_lo, emu_step_hi;
#endif
extern "C" void kernel_launch(void* const* d_in, const int* in_sizes, int n_in, void* d_out, int out_size, void* d_ws, size_t ws_size, hipStream_t stream) {
    (void)in_sizes; (void)out_size;
    if (n_in != 31 || ws_size < WS_END) { fprintf(stderr, "kernel_launch: expected 31 inputs and >= %zu bytes of workspace (got %d, %zu)\n", (size_t)WS_END, n_in, ws_size); return; }
    Args a; memset(&a, 0, sizeof(a));
    for (int i = 0; i < 31; ++i) a.in[i] = (const float*)d_in[i];
    a.out = (float*)d_out; a.ws = (unsigned char*)d_ws;
#ifdef EMU
    if (emu_step_lo == 0) memset((char*)d_ws + WS_CTL, 0, CTL_BYTES);
    for (int s = emu_step_lo; s < emu_step_hi && s < NSTEPS; ++s) { a.lo = s; a.hi = s + 1; emu_launch(fwd, emu_grid, NTHREADS, LDS_BYTES, a); fprintf(stderr, "step %d done\n", s); }
#else
    (void)hipMemsetAsync((char*)d_ws + WS_CTL, 0, CTL_BYTES, stream);
    static int grid = 0;
    if (grid == 0) {
        int dev = 0, cus = 0;
        if (hipGetDevice(&dev) != hipSuccess || hipDeviceGetAttribute(&cus, hipDeviceAttributeMultiprocessorCount, dev) != hipSuccess) { grid = -1; return; }
        if (hipFuncSetAttribute((const void*)fwd, hipFuncAttributeMaxDynamicSharedMemorySize, LDS_BYTES) != hipSuccess) { grid = -1; return; }
        int per_cu = 0; (void)hipOccupancyMaxActiveBlocksPerMultiprocessor(&per_cu, (const void*)fwd, NTHREADS, LDS_BYTES); (void)hipGetLastError();
        grid = cus;
    }
    if (grid < 0) return;
#if CFG_ONE_LAUNCH
    a.lo = 0; a.hi = NSTEPS; hipLaunchKernelGGL(fwd, dim3(grid), dim3(NTHREADS), LDS_BYTES, stream, a);
#else
    for (int s = 0; s < NSTEPS; ++s) { a.lo = s; a.hi = s + 1; hipLaunchKernelGGL(fwd, dim3(grid), dim3(NTHREADS), LDS_BYTES, stream, a); }
#endif
#endif
}
```

```cpp
#ifdef EMU
#include "emu.h"
#else
#include <hip/hip_runtime.h>
#endif
#include <cstdio>
#include <cstdint>
#include <cstring>
#include <cstddef>
#include <cmath>

#ifndef CFG_BATCH
#define CFG_BATCH 16
#endif
#ifndef CFG_SEQ
#define CFG_SEQ 4096
#endif
#ifndef CFG_NSEQ_MB
#define CFG_NSEQ_MB 8
#endif
#ifndef CFG_NEXP
#define CFG_NEXP 32
#endif
#ifndef CFG_ONE_LAUNCH
#define CFG_ONE_LAUNCH 1
#endif

constexpr int BATCH = CFG_BATCH, SEQ = CFG_SEQ, NSEQ_MB = CFG_NSEQ_MB, NEXP = CFG_NEXP, NMB = BATCH / NSEQ_MB;
constexpr int D = 1024, DEPTH = 2, DECB = 16, DECS = 16, NS = DECB * DECS;
constexpr int DINNER = 2048, CONVDIM = 4096;
constexpr int NKV = 4, WINDOW = 128, CHUNK = 64;
constexpr int DIN = 13856, DINP = 14080;
constexpr int NP = NSEQ_MB * SEQ, R = NP + NS;
constexpr int RP = ((4 * R + NEXP * 255) + 255) / 256 * 256;
constexpr int NCHUNK = SEQ / CHUNK;
constexpr int C_Z = 0, C_X = 2048, C_B = 4096, C_C = 5120, C_Q = 6144, C_K = 7168, C_V = 7424, C_SCB = 7680, C_SCC = 8704, C_SCH = 9728, C_GSSD = 10752, C_GATT = 11776, C_GSC = 12800, C_DT = 13824;
constexpr float LN_EPS = 1e-5f, ALPHA = 1.41421356237309515f  , SW_LIMIT = 7.0f, SW_ALPHA = 1.702f;
static_assert(BATCH % NSEQ_MB == 0 && SEQ % 256 == 0 && (NEXP & (NEXP - 1)) == 0 && NEXP <= 32 && NEXP >= 4, "config");

constexpr size_t O_YP = 0, O_YS = O_YP + (size_t)BATCH * SEQ * D, O_KP = O_YS + (size_t)NS * D, O_VP = O_KP + (size_t)DEPTH * BATCH * WINDOW * 256,
    O_SSP = O_VP + (size_t)DEPTH * BATCH * WINDOW * 256, O_CVP = O_SSP + (size_t)DEPTH * BATCH * 32 * 64 * 128, O_SCP = O_CVP + (size_t)DEPTH * BATCH * 3 * CONVDIM,
    O_KS = O_SCP + (size_t)DEPTH * BATCH * 2 * D, O_VS = O_KS + (size_t)DEPTH * DECB * DECS * 256, O_SSS = O_VS + (size_t)DEPTH * DECB * DECS * 256,
    O_CVS = O_SSS + (size_t)DEPTH * DECB * 32 * 64 * 128, O_SCS = O_CVS + (size_t)DEPTH * DECB * 3 * CONVDIM, O_END = O_SCS + (size_t)DEPTH * DECB * 2 * D;

constexpr size_t al256(size_t x) { return (x + 255) / 256 * 256; }
constexpr size_t WS_CTL = 0, CTL_BYTES = 1u << 20;
constexpr size_t WS_SSQ = CTL_BYTES, WS_TOPI = WS_SSQ + al256((size_t)R * 32 * 4), WS_GATE = WS_TOPI + al256((size_t)R * 16), WS_POS = WS_GATE + al256((size_t)R * 16),
    WS_GSORT = WS_POS + al256((size_t)R * 16), WS_RTOK = WS_GSORT + al256((size_t)RP * 4), WS_W = WS_RTOK + al256((size_t)RP * 4);
constexpr size_t WL_IN = 0, WL_SSD = WL_IN + (size_t)DINP * D * 2, WL_ATT = WL_SSD + (size_t)D * DINNER * 2, WL_SC = WL_ATT + (size_t)D * D * 2, WL_O = WL_SC + (size_t)D * D * 2,
    WL_UP = WL_O + (size_t)D * D * 2, WL_DN = WL_UP + (size_t)NEXP * 2048 * D * 2, WL_BYTES = WL_DN + (size_t)NEXP * D * D * 2;
constexpr size_t WS_XB = WS_W + DEPTH * WL_BYTES, WS_H = WS_XB + (size_t)R * D * 2;
constexpr size_t H_BYTES = (size_t)R * DINP * 2, MOE_BYTES = (size_t)3 * RP * D * 2, U_BYTES = H_BYTES > MOE_BYTES ? H_BYTES : MOE_BYTES;
constexpr size_t WS_END = WS_H + U_BYTES;
static_assert(WS_END <= ((size_t)2 << 30), "workspace map exceeds 2 GiB");
constexpr int CW_BAR = 4096, CW_CNT = 16384;

constexpr int RING_BYTES = 131072, LDS_BYTES = 147456, MISC_OFF = LDS_BYTES - 1024, SCR_BYTES = MISC_OFF;
constexpr int NWAVES = 8, NTHREADS = 512;

#ifdef EMU
#define LAS
#define WAVE_SYNC() emu_wave_barrier()
#else
#define LAS __attribute__((address_space(3)))
#define WAVE_SYNC() asm volatile("s_waitcnt lgkmcnt(0)" ::: "memory")
#endif
#ifdef EMU
#define LBAR() emu_wg_barrier()
#define VM_WAIT(n) do { } while (0)
#else
#define LBAR() do { asm volatile("s_waitcnt lgkmcnt(0)" ::: "memory"); __builtin_amdgcn_s_barrier(); asm volatile("" ::: "memory"); } while (0)
#define VM_WAIT(n) asm volatile("s_waitcnt vmcnt(" #n ")" ::: "memory")
#endif
typedef unsigned short bf16_t;
typedef short bf16x8 __attribute__((ext_vector_type(8)));
typedef float f32x4 __attribute__((ext_vector_type(4)));
typedef float f32x16 __attribute__((ext_vector_type(16)));
typedef unsigned u32x4 __attribute__((ext_vector_type(4)));
typedef unsigned u32x2 __attribute__((ext_vector_type(2)));

__device__ __forceinline__ unsigned f2bf(float f) { unsigned u = __builtin_bit_cast(unsigned, f); return (u + 0x7fffu + ((u >> 16) & 1u)) >> 16; }
__device__ __forceinline__ float bf2f(unsigned h) { return __builtin_bit_cast(float, (h & 0xffffu) << 16); }
#ifdef EMU
__device__ __forceinline__ unsigned pk2(float lo, float hi) { return f2bf(lo) | (f2bf(hi) << 16); }
#else
typedef float f32x2_t __attribute__((ext_vector_type(2))); typedef __bf16 bf16x2_t __attribute__((ext_vector_type(2)));
__device__ __forceinline__ unsigned pk2(float lo, float hi) { f32x2_t v = {lo, hi}; bf16x2_t b = __builtin_convertvector(v, bf16x2_t); return __builtin_bit_cast(unsigned, b); }
#endif
#ifdef EMU
__device__ __forceinline__ unsigned short bf1(float f) { return (unsigned short)f2bf(f); }
#else
__device__ __forceinline__ unsigned short bf1(float f) { return (unsigned short)pk2(f, f); }
#endif
__device__ __forceinline__ float blo(unsigned w) { return __builtin_bit_cast(float, w << 16); }
__device__ __forceinline__ float bhi(unsigned w) { return __builtin_bit_cast(float, w & 0xffff0000u); }
__device__ __forceinline__ void unpack8(const u32x4 w, float* f) { f[0] = blo(w.x); f[1] = bhi(w.x); f[2] = blo(w.y); f[3] = bhi(w.y); f[4] = blo(w.z); f[5] = bhi(w.z); f[6] = blo(w.w); f[7] = bhi(w.w); }
__device__ __forceinline__ u32x4 pack8(const float* f) { u32x4 w; w.x = pk2(f[0], f[1]); w.y = pk2(f[2], f[3]); w.z = pk2(f[4], f[5]); w.w = pk2(f[6], f[7]); return w; }
__device__ __forceinline__ float fexp(float x) { return __builtin_amdgcn_exp2f(x * 1.4426950408889634f); }
__device__ __forceinline__ float fsigmoid(float x) { return __builtin_amdgcn_rcpf(1.0f + __builtin_amdgcn_exp2f(-1.4426950408889634f * x)); }
__device__ __forceinline__ float fsilu(float x) { return x * fsigmoid(x); }
#ifdef EMU
__device__ __forceinline__ int opq(int x) { return x; }
#else
__device__ __forceinline__ int opq(int x) { asm volatile("" : "+v"(x)); return x; }
#endif
#ifdef EMU
__device__ __forceinline__ int opqs(int x) { return x; }
#else
__device__ __forceinline__ int opqs(int x) { asm volatile("" : "+s"(x)); return x; }
#endif
#ifdef EMU
__device__ __forceinline__ int lane_id() { return (int)(threadIdx.x & 63); }
#else
__device__ __forceinline__ int lane_id() { return (int)__builtin_amdgcn_mbcnt_hi(~0u, __builtin_amdgcn_mbcnt_lo(~0u, 0u)); }
#endif
__device__ __forceinline__ float wave_sum(float v) {
#pragma unroll
    for (int o = 1; o < 64; o <<= 1) v += __shfl_xor(v, o);
    return v;
}

#ifndef PROBE_MASK
#define PROBE_MASK 0
#endif
#if PROBE_MASK && !defined(EMU)
#define PROBE_T0(b) unsigned long long pt0_ = 0; if constexpr ((PROBE_MASK >> (b)) & 1) pt0_ = __builtin_amdgcn_s_memrealtime();
#define PROBE_T1(b) if constexpr ((PROBE_MASK >> (b)) & 1) { asm volatile("s_waitcnt vmcnt(0) lgkmcnt(0)" ::: "memory"); const unsigned long long pt1_ = __builtin_amdgcn_s_memrealtime(); \
    while (__builtin_amdgcn_s_memrealtime() < pt1_ + (pt1_ - pt0_)) __builtin_amdgcn_s_sleep(8); }
#else
#define PROBE_T0(b)
#define PROBE_T1(b)
#endif
namespace pg8 {
constexpr int BM = 256, BK = 64, HALF = 128, HTB = HALF * BK * 2, NXCD = 8, WGM = 8;
struct Unit { int pm, pn, bt, e; };
struct Gemm { const bf16_t* A; const bf16_t* Bt; int M, N, K, lda; const int* tok; };
struct StaticOrder {
    int nM, nN, nwg, G, c;
    __host__ __device__ void init(int M, int N, int G_, int c_) { nM = M / BM; nN = N / BM; nwg = nM * nN; G = G_; c = c_; }
    __host__ __device__ bool next(int i, Unit& u) const {
        const long L = (long)i * G + c; if (L >= nwg) return false;
        int wgid = (int)L; { const int q = nwg / NXCD, r = nwg % NXCD, xcd = wgid % NXCD, off = wgid / NXCD; wgid = (xcd < r ? xcd * (q + 1) : r * (q + 1) + (xcd - r) * q) + off; }
        const int nig = WGM * nN, gid = wgid / nig, fm = gid * WGM, gsz = (nM - fm) < WGM ? (nM - fm) : WGM;
        u.pm = fm + ((wgid % nig) % gsz); u.pn = (wgid % nig) / gsz; u.bt = u.pn; u.e = 0; return true;
    }
    __device__ __forceinline__ void a_ready(const Unit&) const {}
    __device__ __forceinline__ void done(const Unit&) const {}
};
struct MoeOrder {
    const LAS int* tend; int npn, ntot, G, c;
    __device__ __forceinline__ bool next(int i, Unit& u) const {
        const long L = (long)i * G + c; if (L >= ntot) return false;
        const int rt = (int)L / npn, pn = (int)L % npn; int e = 0;
#pragma unroll
        for (int j = 0; j < NEXP; ++j) e += (tend[j] <= rt) ? 1 : 0;
        u.pm = rt; u.pn = pn; u.e = e; u.bt = e * npn + pn; return true;
    }
    __device__ __forceinline__ void a_ready(const Unit&) const {}
    __device__ __forceinline__ void done(const Unit&) const {}
};
#ifdef EMU
template <class Epi, class Sched, bool GATHER = false>
__device__ void gemm_phase(LAS unsigned char* lds, const Gemm g, const Sched& S, const Epi& E) {
    const int tid = threadIdx.x, wid = tid >> 6, lane = tid & 63, wr = wid >> 2, wc = wid & 3, fr = lane & 15, fq = lane >> 4;
    Unit u;
    for (int i = 0; S.next(i, u); ++i) {
        f32x4 acc[2][2][4][2];
        for (int ai = 0; ai < 2; ++ai) for (int bj = 0; bj < 2; ++bj) for (int m = 0; m < 4; ++m) for (int n = 0; n < 2; ++n) for (int q = 0; q < 4; ++q) {
            const int row = u.pm * 256 + ai * 128 + wr * 64 + m * 16 + fr, col = u.bt * 256 + bj * 128 + wc * 32 + 8 * fq + 4 * n + q;
            const bf16_t* a = g.A + (size_t)(GATHER ? g.tok[row] : row) * g.lda; const bf16_t* b = g.Bt + (size_t)col * g.K; float s = 0.f;
            for (int k = 0; k < g.K; ++k) s += bf2f(a[k]) * bf2f(b[k]);
            acc[ai][bj][m][n][q] = s; }
        E(acc, u, wr, wc, fr, fq);
    }
    __syncthreads();
}
#else
#define PG8_LAS __attribute__((address_space(3)))
__host__ __device__ __forceinline__ int lds_byte(int r, int c) { const int st = (r >> 4) * 2 + (c >> 5), rr = r & 15, cc = c & 31, ob = rr * 64 + cc * 2; return st * 1024 + (ob ^ (((ob >> 9) & 1) << 5)); }
__host__ __device__ __forceinline__ void stage_rc(int b, int& R_, int& C_) { const int st = b / 1024, sb = b % 1024, swz = sb ^ (((sb >> 9) & 1) << 5); R_ = (st >> 1) * 16 + swz / 64; C_ = (st & 1) * 32 + (swz % 64) / 2; }
__host__ __device__ __forceinline__ int perm32(int rho) { const int n = rho >> 4, i = rho & 15; return 8 * (i >> 2) + 4 * n + (i & 3); }
template <class Epi, class Sched, bool GATHER = false>
__device__ __forceinline__ void gemm_phase(PG8_LAS unsigned char* lds, const Gemm g, const Sched& S, const Epi& E) {
    const int lane = opq(lane_id()), wid = __builtin_amdgcn_readfirstlane((int)threadIdx.x >> 6), tid = wid * 64 + lane, wr = wid >> 2, wc = wid & 3, fr = lane & 15, fq = lane >> 4;
    const int K = g.K, nt = K / BK, lda = g.lda;
    unsigned voffA[2], voffB[2];
#pragma unroll
    for (int i = 0; i < 2; ++i) { int R_, C_; stage_rc(tid * 16 + i * 8192, R_, C_); const int Rb = (R_ & ~31) + perm32(R_ & 31);
        voffA[i] = (unsigned)(R_ * lda + C_) * 2u; voffB[i] = (unsigned)(Rb * K + C_) * 2u; }
    unsigned vG[2][2], vN[2][2];
#define PG8_TOK(dst, pm_) do { _Pragma("unroll") for (int i_ = 0; i_ < 2; ++i_) { int R_, C_; stage_rc(opq(tid) * 16 + i_ * 8192, R_, C_); _Pragma("unroll") for (int h_ = 0; h_ < 2; ++h_) \
        dst[h_][i_] = (unsigned)g.tok[(pm_) * 256 + h_ * 128 + R_] * (unsigned)(lda * 2) + (unsigned)(C_ * 2); } } while (0)
#define PG8_STAGE_A(bufoff, base_, h_, nx_) do { if constexpr (GATHER) { unsigned vs_[2] = {(nx_) ? vN[h_][0] : vG[h_][0], (nx_) ? vN[h_][1] : vG[h_][1]}; PG8_STAGE(bufoff, base_, vs_); } \
        else { PG8_STAGE(bufoff, (base_) + ((h_) ? hstepA : 0), voffA); } } while (0)
    const size_t kstep = (size_t)(BK * 2);
    const size_t hstepA = (size_t)HALF * lda * 2, tstepA = 2 * hstepA;
    const size_t hstepB = (size_t)HALF * K * 2, tstepB = 2 * hstepB;
    const unsigned ldsw = (unsigned)wid * 1024u;
    const int aoff = lds_byte(wr * 64 + fr, fq * 8), boff = lds_byte(wc * 32 + fr, fq * 8);
#define PG8_SA(b, h) (((b) * 2 + (h)) * HTB)
#define PG8_SB(b, h) ((4 + (b) * 2 + (h)) * HTB)
#define PG8_STAGE(bufoff, gbase, voff) do { _Pragma("unroll") for (int _i = 0; _i < 2; ++_i) \
        __builtin_amdgcn_global_load_lds((const unsigned*)((const char*)(gbase) + (voff)[_i]), (PG8_LAS unsigned*)(lds + (bufoff) + ldsw + _i * 8192), 16, 0, 0); } while (0)
#define PG8_LDA(dst, b, h) do { _Pragma("unroll") for (int m = 0; m < 4; ++m) _Pragma("unroll") for (int k = 0; k < 2; ++k) dst[m][k] = *(const PG8_LAS bf16x8*)(lds + PG8_SA(b, h) + aoff + m * 2048 + k * 1024); } while (0)
#define PG8_LDB(dst, b, h) do { _Pragma("unroll") for (int n = 0; n < 2; ++n) _Pragma("unroll") for (int k = 0; k < 2; ++k) dst[n][k] = *(const PG8_LAS bf16x8*)(lds + PG8_SB(b, h) + boff + n * 2048 + k * 1024); } while (0)
#define PG8_MMA(ai, bj, At, Bt) do { __builtin_amdgcn_s_setprio(1); _Pragma("unroll") for (int m = 0; m < 4; ++m) _Pragma("unroll") for (int n = 0; n < 2; ++n) _Pragma("unroll") for (int k = 0; k < 2; ++k) \
        acc[ai][bj][m][n] = __builtin_amdgcn_mfma_f32_16x16x32_bf16(Bt[n][k], At[m][k], acc[ai][bj][m][n], 0, 0, 0); __builtin_amdgcn_s_setprio(0); } while (0)
#define PG8_WAIT_V(n) asm volatile("s_waitcnt vmcnt(" #n ")" ::: "memory")
#define PG8_WAIT_L(n) asm volatile("s_waitcnt lgkmcnt(" #n ")" ::: "memory")
#define PG8_BAR __builtin_amdgcn_s_barrier()
#define PG8_SCHED __builtin_amdgcn_sched_barrier(0)
    Unit cur, nxt; int ui = 0;
    if (!S.next(0, cur)) return;
    f32x4 acc[2][2][4][2];
#pragma unroll
    for (int a = 0; a < 2; ++a)
#pragma unroll
        for (int b = 0; b < 2; ++b)
#pragma unroll
            for (int m = 0; m < 4; ++m)
#pragma unroll
                for (int n = 0; n < 2; ++n) acc[a][b][m][n] = (f32x4){0.f, 0.f, 0.f, 0.f};
    bf16x8 At[4][2], B0[2][2], B1[2][2];
    const char* cA = (const char*)g.A + (GATHER ? (size_t)0 : (size_t)cur.pm * tstepA); const char* cB = (const char*)g.Bt + (size_t)cur.bt * tstepB;
    if constexpr (GATHER) { PG8_TOK(vG, cur.pm); }
    S.a_ready(cur);
    PG8_STAGE(PG8_SB(0, 0), cB, voffB); PG8_STAGE(PG8_SB(0, 1), cB + hstepB, voffB); PG8_STAGE_A(PG8_SA(0, 0), cA, 0, false); PG8_STAGE_A(PG8_SA(0, 1), cA, 1, false);
    if (wr == 1) PG8_BAR;
    PG8_WAIT_V(2); PG8_BAR;
    PG8_STAGE(PG8_SB(1, 0), cB + kstep, voffB); PG8_STAGE_A(PG8_SA(1, 0), cA + kstep, 0, false); PG8_STAGE(PG8_SB(1, 1), cB + hstepB + kstep, voffB);
    PG8_WAIT_V(6); PG8_BAR;
    for (;;) {
        const bool has_next = S.next(ui + 1, nxt);
        const char* nA = has_next ? (const char*)g.A + (GATHER ? (size_t)0 : (size_t)nxt.pm * tstepA) : cA; const char* nB = has_next ? (const char*)g.Bt + (size_t)nxt.bt * tstepB : cB;
        if constexpr (GATHER) {
#pragma unroll
            for (int h_ = 0; h_ < 2; ++h_) { vN[h_][0] = vG[h_][0]; vN[h_][1] = vG[h_][1]; }
            if (has_next) {
#pragma unroll
                for (int i_ = 0; i_ < 2; ++i_) { int R_, C_; stage_rc(opq(tid) * 16 + i_ * 8192, R_, C_);
#pragma unroll
                    for (int h_ = 0; h_ < 2; ++h_) { const int* tp_ = g.tok + nxt.pm * 256 + h_ * 128 + R_;
                        asm volatile("global_load_dword %0, %1, off" : "=v"(vN[h_][i_]) : "v"(tp_) : "memory"); } } } }
        for (int t = 0; t < nt; t += 2) {
            const bool last = (t == nt - 2);
            const char* a1 = cA + (size_t)(t + 1) * kstep;
            const char* a2 = last ? nA : cA + (size_t)(t + 2) * kstep; const char* b2 = last ? nB : cB + (size_t)(t + 2) * kstep;
            const char* a3 = a2 + kstep; const char* b3 = b2 + kstep;
            if (last && has_next) S.a_ready(nxt);
            if constexpr (GATHER) { if (last && has_next) {
#pragma unroll
                for (int i_ = 0; i_ < 2; ++i_) { int R_, C_; stage_rc(opq(tid) * 16 + i_ * 8192, R_, C_);
#pragma unroll
                    for (int h_ = 0; h_ < 2; ++h_) { unsigned tk_ = vN[h_][i_]; asm volatile("" : "+v"(tk_)); vN[h_][i_] = tk_ * (unsigned)(lda * 2) + (unsigned)(C_ * 2); } } } }
            PG8_LDB(B0, 0, 0); PG8_LDB(B1, 0, 1); PG8_SCHED; PG8_LDA(At, 0, 0); PG8_STAGE_A(PG8_SA(1, 1), a1, 1, false);
            PG8_WAIT_V(8); PG8_WAIT_L(0); PG8_BAR; PG8_MMA(0, 0, At, B0); PG8_MMA(0, 1, At, B1); PG8_BAR; PG8_SCHED;
            PG8_LDA(At, 0, 1); PG8_STAGE(PG8_SB(0, 0), b2, voffB); PG8_STAGE(PG8_SB(0, 1), b2 + hstepB, voffB); PG8_STAGE_A(PG8_SA(0, 0), a2, 0, last);
            PG8_WAIT_V(8); PG8_WAIT_L(0); PG8_BAR; PG8_MMA(1, 0, At, B0); PG8_MMA(1, 1, At, B1); PG8_BAR; PG8_SCHED;
            PG8_LDB(B0, 1, 0); PG8_LDB(B1, 1, 1); PG8_SCHED; PG8_LDA(At, 1, 0); PG8_STAGE_A(PG8_SA(0, 1), a2, 1, last);
            PG8_WAIT_V(8); PG8_WAIT_L(0); PG8_BAR; PG8_MMA(0, 0, At, B0); PG8_MMA(0, 1, At, B1); PG8_BAR; PG8_SCHED;
            PG8_LDA(At, 1, 1); PG8_STAGE(PG8_SB(1, 0), b3, voffB); PG8_STAGE(PG8_SB(1, 1), b3 + hstepB, voffB); PG8_STAGE_A(PG8_SA(1, 0), a3, 0, last);
            PG8_WAIT_V(8); PG8_WAIT_L(0); PG8_BAR; PG8_MMA(1, 0, At, B0); PG8_MMA(1, 1, At, B1); PG8_BAR; PG8_SCHED;
        }
        if (wr == 0) PG8_BAR;
        E(acc, cur, wr, wc, fr, fq); S.done(cur);
        if (!has_next) break;
#pragma unroll
        for (int a = 0; a < 2; ++a)
#pragma unroll
            for (int b = 0; b < 2; ++b)
#pragma unroll
                for (int m = 0; m < 4; ++m)
#pragma unroll
                    for (int n = 0; n < 2; ++n) acc[a][b][m][n] = (f32x4){0.f, 0.f, 0.f, 0.f};
        cur = nxt; cA = nA; cB = nB; ++ui;
        if constexpr (GATHER) {
#pragma unroll
            for (int h_ = 0; h_ < 2; ++h_) { vG[h_][0] = vN[h_][0]; vG[h_][1] = vN[h_][1]; } }
        if (wr == 1) PG8_BAR;
    }
    PG8_WAIT_V(0);
    PG8_BAR;
#undef PG8_SA
#undef PG8_SB
#undef PG8_STAGE
#undef PG8_STAGE_A
#undef PG8_TOK
#undef PG8_LDA
#undef PG8_LDB
#undef PG8_MMA
#undef PG8_WAIT_V
#undef PG8_WAIT_L
#undef PG8_BAR
#undef PG8_SCHED
}
#endif

struct EpiStoreBf16 {
    bf16_t* O; int ldc;
    __device__ __forceinline__ void operator()(const f32x4 (&acc)[2][2][4][2], const Unit& u, int wr, int wc, int fr, int fq) const {
        const int row0 = u.pm * 256 + wr * 64 + fr, col0 = u.pn * 256 + wc * 32 + 8 * fq;
#pragma unroll
        for (int ai = 0; ai < 2; ++ai)
#pragma unroll
            for (int m = 0; m < 4; ++m)
#pragma unroll
                for (int bj = 0; bj < 2; ++bj) { const f32x4 v0 = acc[ai][bj][m][0], v1 = acc[ai][bj][m][1];
                    u32x4 w; w.x = pk2(v0[0], v0[1]); w.y = pk2(v0[2], v0[3]); w.z = pk2(v1[0], v1[1]); w.w = pk2(v1[2], v1[3]);
                    *(u32x4*)(O + (size_t)(row0 + ai * 128 + m * 16) * ldc + col0 + bj * 128) = w; }
    }
};
template <int MODE> struct EpiGate {
    const bf16_t* Hg; bf16_t* MGb;
    __device__ __forceinline__ void operator()(const f32x4 (&acc)[2][2][4][2], const Unit& u, int wr, int wc, int fr, int fq) const {
        const int row0 = u.pm * 256 + wr * 64 + fr, col0 = u.pn * 256 + wc * 32 + 8 * fq;
#pragma unroll
        for (int ai = 0; ai < 2; ++ai) {
            u32x4 gw[4][2], pw[4][2];
#pragma unroll
            for (int m = 0; m < 4; ++m)
#pragma unroll
                for (int bj = 0; bj < 2; ++bj) { const int row = row0 + ai * 128 + m * 16, col = col0 + bj * 128;
                    gw[m][bj] = *(const u32x4*)(Hg + (size_t)row * DINP + col); if (MODE != 0) pw[m][bj] = *(const u32x4*)(MGb + (size_t)row * D + col); }
            asm volatile("" ::: "memory");
#pragma unroll
            for (int m = 0; m < 4; ++m)
#pragma unroll
                for (int bj = 0; bj < 2; ++bj) { const int row = row0 + ai * 128 + m * 16, col = col0 + bj * 128; const f32x4 v0 = acc[ai][bj][m][0], v1 = acc[ai][bj][m][1];
                    float g[8], p[8], v[8] = {v0[0], v0[1], v0[2], v0[3], v1[0], v1[1], v1[2], v1[3]}; unpack8(gw[m][bj], g);
                    if (MODE != 0) { unpack8(pw[m][bj], p);
#pragma unroll
                        for (int i = 0; i < 8; ++i) v[i] = p[i] + v[i] * fsigmoid(g[i]); }
                    else {
#pragma unroll
                        for (int i = 0; i < 8; ++i) v[i] = v[i] * fsigmoid(g[i]); }
                    *(u32x4*)(MGb + (size_t)row * D + col) = pack8(v); }
            asm volatile("" ::: "memory");
        }
    }
};
struct EpiResid {
    const float* xp; const float* xs; float* op; float* os;
    __device__ __forceinline__ void operator()(const f32x4 (&acc)[2][2][4][2], const Unit& u, int wr, int wc, int fr, int fq) const {
        const int row0 = u.pm * 256 + wr * 64 + fr, col0 = u.pn * 256 + wc * 32 + 8 * fq;
        const bool smp = u.pm * 256 >= NP;
        const float* xb = smp ? xs - (size_t)NP * D : xp; float* ob = smp ? os - (size_t)NP * D : op;
#pragma unroll
        for (int ai = 0; ai < 2; ++ai) {
            f32x4 xa[4][2][2];
#pragma unroll
            for (int m = 0; m < 4; ++m)
#pragma unroll
                for (int bj = 0; bj < 2; ++bj) { const float* xi = xb + (size_t)(row0 + ai * 128 + m * 16) * D + col0 + bj * 128; xa[m][bj][0] = *(const f32x4*)xi; xa[m][bj][1] = *(const f32x4*)(xi + 4); }
            asm volatile("" ::: "memory");
#pragma unroll
            for (int m = 0; m < 4; ++m)
#pragma unroll
                for (int bj = 0; bj < 2; ++bj) { float* xo = ob + (size_t)(row0 + ai * 128 + m * 16) * D + col0 + bj * 128;
                    *(f32x4*)xo = xa[m][bj][0] * ALPHA + acc[ai][bj][m][0]; *(f32x4*)(xo + 4) = xa[m][bj][1] * ALPHA + acc[ai][bj][m][1]; }
            asm volatile("" ::: "memory");
        }
    }
};
struct EpiSwiglu {
    bf16_t* ACT; const float* bup;
    __device__ __forceinline__ void operator()(const f32x4 (&acc)[2][2][4][2], const Unit& u, int wr, int wc, int fr, int fq) const {
        const int row0_ = u.pm * 256 + wr * 64 + fr, j0 = u.pn * 128 + wc * 32 + 8 * fq;
        const float* bg = bup + (size_t)u.e * 2048 + j0; const f32x4 bg0 = *(const f32x4*)bg, bg1 = *(const f32x4*)(bg + 4), bu0 = *(const f32x4*)(bg + 1024), bu1 = *(const f32x4*)(bg + 1028);
#pragma unroll
        for (int ai = 0; ai < 2; ++ai)
#pragma unroll
            for (int m = 0; m < 4; ++m) { const int row = row0_ + ai * 128 + m * 16;
                const f32x4 g0 = acc[ai][0][m][0] + bg0, g1 = acc[ai][0][m][1] + bg1, u0 = acc[ai][1][m][0] + bu0, u1 = acc[ai][1][m][1] + bu1; float o[8];
#pragma unroll
                for (int i = 0; i < 4; ++i) { const float ga = fminf(g0[i], SW_LIMIT), ua = fminf(fmaxf(u0[i], -SW_LIMIT), SW_LIMIT); o[i] = (ua + 1.0f) * ga * fsigmoid(SW_ALPHA * ga);
                    const float gb = fminf(g1[i], SW_LIMIT), ub = fminf(fmaxf(u1[i], -SW_LIMIT), SW_LIMIT); o[4 + i] = (ub + 1.0f) * gb * fsigmoid(SW_ALPHA * gb); }
                *(u32x4*)(ACT + (size_t)row * D + j0) = pack8(o); }
    }
};
struct EpiDown {
    bf16_t* O; const float* bdn; const float* gs;
    __device__ __forceinline__ void operator()(const f32x4 (&acc)[2][2][4][2], const Unit& u, int wr, int wc, int fr, int fq) const {
        const int row0 = u.pm * 256 + wr * 64 + fr, col0 = u.pn * 256 + wc * 32 + 8 * fq;
#pragma unroll
        for (int ai = 0; ai < 2; ++ai) {
            float gt[4];
#pragma unroll
            for (int m = 0; m < 4; ++m) gt[m] = gs[row0 + ai * 128 + m * 16];
#pragma unroll
            for (int bj = 0; bj < 2; ++bj) { const float* bp = bdn + (size_t)u.e * D + col0 + bj * 128; const f32x4 b0 = *(const f32x4*)bp, b1 = *(const f32x4*)(bp + 4);
#pragma unroll
                for (int m = 0; m < 4; ++m) { const f32x4 a0 = (acc[ai][bj][m][0] + b0) * gt[m], a1 = (acc[ai][bj][m][1] + b1) * gt[m];
                    u32x4 w; w.x = pk2(a0[0], a0[1]); w.y = pk2(a0[2], a0[3]); w.z = pk2(a1[0], a1[1]); w.w = pk2(a1[2], a1[3]);
                    *(u32x4*)(O + (size_t)(row0 + ai * 128 + m * 16) * D + col0 + bj * 128) = w; } }
            asm volatile("" ::: "memory");
        }
    }
};
}

#ifndef EMU
#define XB_TMO      128
#define XB_XCNT(j)  (256  + 64 * (j))
#define XB_XSUB(j)  (1280 + 64 * (j))
#define XB_XGEN(j)  (2304 + 64 * (j))
#define XB_TOP      3328
#define XB_TOPGEN   3392
#define XCD_BAR_WORDS 3456
#define XB_SPIN_CAP (1u << 27)
__device__ __forceinline__ unsigned xb_ld(unsigned* p)              { return __hip_atomic_load(p, __ATOMIC_RELAXED, __HIP_MEMORY_SCOPE_AGENT); }
__device__ __forceinline__ unsigned xb_add(unsigned* p, unsigned v) { return __hip_atomic_fetch_add(p, v, __ATOMIC_RELAXED, __HIP_MEMORY_SCOPE_AGENT); }
__device__ __forceinline__ unsigned xb_xcc_id() { return (unsigned)__builtin_amdgcn_s_getreg((3 << 11) | 20) & 0xFu; }
#define XB_SPIN(cond, bar) do { unsigned _sp = 0; while (cond) { __builtin_amdgcn_s_sleep(1); \
    if ((++_sp & 255u) == 0u) { if (xb_ld(&(bar)[XB_TMO])) break; if (_sp > XB_SPIN_CAP) { atomicAdd(&(bar)[XB_TMO], 1u); break; } } } } while (0)
struct XcdBarrier { unsigned* bar; unsigned x; volatile LAS unsigned* st; };
__device__ __forceinline__ XcdBarrier xcd_barrier_post(unsigned* bar, volatile LAS unsigned* st) {
    XcdBarrier b; b.bar = bar; b.x = xb_xcc_id(); b.st = st;
    if (threadIdx.x == 0) (void)xb_add(&bar[XB_XCNT(b.x)], 1u);
    return b;
}
__device__ __forceinline__ void xcd_barrier_complete(unsigned* bar, unsigned x, unsigned& nloc, unsigned& nx) {
    const unsigned G = gridDim.x * gridDim.y * gridDim.z;
    unsigned sum, cnt, mine, sp = 0u;
    for (;;) {
        sum = 0u; cnt = 0u; mine = 0u;
#pragma unroll
        for (unsigned j = 0; j < 16; ++j) { const unsigned c = xb_ld(&bar[XB_XCNT(j)]); sum += c; cnt += (c > 0u) ? 1u : 0u; mine = (j == x) ? c : mine; }
        if (sum == G) break;
        __builtin_amdgcn_s_sleep(1);
        if ((++sp & 255u) == 0u) { if (xb_ld(&bar[XB_TMO])) break; if (sp > XB_SPIN_CAP) { atomicAdd(&bar[XB_TMO], 1u); break; } }
    }
    nloc = mine > 0u ? mine : 1u; nx = cnt > 0u ? cnt : 1u;
}
__device__ __forceinline__ void xcd_barrier(const XcdBarrier& b) {
    asm volatile("s_waitcnt vmcnt(0)" ::: "memory");
    __syncthreads();
    if (threadIdx.x == 0) {
        unsigned* bar = b.bar;
        __builtin_amdgcn_s_waitcnt(0);
        unsigned nloc = b.st[0], nx = b.st[1];
        if (nloc == 0u) { xcd_barrier_complete(bar, b.x, nloc, nx); b.st[0] = nloc; b.st[1] = nx; }
        const unsigned old = xb_add(&bar[XB_XSUB(b.x)], 1u);
        const unsigned gen = old / nloc;
        if (old + 1u == (gen + 1u) * nloc) {
            __builtin_amdgcn_fence(__ATOMIC_RELEASE, "agent");
            asm volatile("s_waitcnt vmcnt(0)" ::: "memory");
            const unsigned og = xb_add(&bar[XB_TOP], 1u);
            const unsigned tg = og / nx;
            if (og + 1u == (tg + 1u) * nx) xb_add(&bar[XB_TOPGEN], 1u);
            else XB_SPIN(xb_ld(&bar[XB_TOPGEN]) == tg, bar);
            __builtin_amdgcn_fence(__ATOMIC_ACQUIRE, "agent");
            xb_add(&bar[XB_XGEN(b.x)], 1u);
            asm volatile("s_waitcnt vmcnt(0)" ::: "memory");
        } else {
            XB_SPIN(xb_ld(&bar[XB_XGEN(b.x)]) == gen, bar);
            __builtin_amdgcn_fence(__ATOMIC_ACQUIRE, "agent");
            asm volatile("s_waitcnt vmcnt(0)" ::: "memory");
        }
    }
    __syncthreads();
}
#endif

struct Args { const float* in[31]; float* out; unsigned char* ws; int lo, hi; };
typedef const float* FPtr;
#ifdef EMU
typedef const FPtr* ArgTab;
#else
typedef const __attribute__((address_space(4))) FPtr* ArgTab;
#endif
struct Frame {
    LAS unsigned char* lds; int tid, lane, wave, G, bid;
    ArgTab in; float* out; unsigned char* ws; unsigned* ctl;
};
enum { I_XP = 0, I_XS, I_CK, I_CV, I_SST, I_SCV, I_SSC, I_WIN, I_CONVW, I_CONVB, I_DTB, I_ALOG, I_SD, I_NORMW, I_WSSD, I_SINK, I_WATT, I_RELB, I_SCW, I_WSC, I_WO, I_LN1G, I_LN1B,
       I_RW, I_RB, I_WUP, I_BUP, I_WDN, I_BDN, I_LN2G, I_LN2B };

__device__ __forceinline__ bf16_t* ws_bf(const Frame& F, size_t off) { return (bf16_t*)(F.ws + off); }
__device__ __forceinline__ float* ws_f(const Frame& F, size_t off) { return (float*)(F.ws + off); }
__device__ __forceinline__ bf16_t* wl_ptr(const Frame& F, int layer, size_t off) { return (bf16_t*)(F.ws + WS_W + (size_t)layer * WL_BYTES + off); }

__device__ __forceinline__ void wt_item(const float* W, int ldw, int K, int k0, int nsrc0, const float* kscale, bf16_t* WT, int ndst0, LAS float* scr, int lane) {
    if (nsrc0 < 0) {
#pragma unroll
        for (int j = 0; j < 4; ++j) { const int n = (lane >> 3) + 8 * j; *(u32x4*)(WT + (size_t)(ndst0 + n) * K + k0 + 8 * (lane & 7)) = (u32x4){0u, 0u, 0u, 0u}; }
        return;
    }
#pragma unroll 8
    for (int i = 0; i < 32; ++i) { const int kk = 2 * i + (lane >> 5); float v = W[(size_t)(k0 + kk) * ldw + nsrc0 + (lane & 31)]; if (kscale) v *= kscale[k0 + kk]; scr[kk * 33 + (lane & 31)] = v; }
    WAVE_SYNC();
    const int c = lane & 7;
#pragma unroll
    for (int j = 0; j < 4; ++j) { const int n = (lane >> 3) + 8 * j; const LAS float* s = scr + (8 * c) * 33 + n;
        u32x4 o; o.x = pk2(s[0 * 33], s[1 * 33]); o.y = pk2(s[2 * 33], s[3 * 33]); o.z = pk2(s[4 * 33], s[5 * 33]); o.w = pk2(s[6 * 33], s[7 * 33]);
        *(u32x4*)(WT + (size_t)(ndst0 + n) * K + k0 + 8 * c) = o; }
    WAVE_SYNC();
}
__device__ __forceinline__ void step_weights(const Frame& F) {
    LAS float* scr = (LAS float*)(F.lds + F.wave * 16384);
    const int gw = F.bid * NWAVES + F.wave, NGW = F.G * NWAVES;
    constexpr int I_IN = (DINP / 32) * (D / 64), I_SSD = (D / 32) * (DINNER / 64), I_SQ = (D / 32) * (D / 64), I_UP = NEXP * (2048 / 32) * (D / 64), I_DN = NEXP * (D / 32) * (D / 64);
    constexpr int PER_LAYER = I_IN + I_SSD + 3 * I_SQ + I_UP + I_DN;
    for (int it = gw; it < DEPTH * PER_LAYER; it += NGW) {
        const int layer = it / PER_LAYER; int r = it % PER_LAYER;
        if (r < I_IN) { const int nb = r / (D / 64), kb = r % (D / 64), n0 = nb * 32;
            const int ns = n0 < 6144 ? n0 : (n0 < 13824 ? n0 + 32 : (n0 < 13856 ? n0 - 13824 + 6144 : -1));
            wt_item(F.in[I_WIN] + (size_t)layer * D * DIN, DIN, D, kb * 64, ns, nullptr, wl_ptr(F, layer, WL_IN), n0, scr, F.lane); continue; }
        r -= I_IN;
        if (r < I_SSD) { const int nb = r / (DINNER / 64), kb = r % (DINNER / 64);
            wt_item(F.in[I_WSSD] + (size_t)layer * DINNER * D, D, DINNER, kb * 64, nb * 32, F.in[I_NORMW] + (size_t)layer * DINNER, wl_ptr(F, layer, WL_SSD), nb * 32, scr, F.lane); continue; }
        r -= I_SSD;
        if (r < I_SQ) { const int nb = r / (D / 64), kb = r % (D / 64); wt_item(F.in[I_WATT] + (size_t)layer * D * D, D, D, kb * 64, nb * 32, nullptr, wl_ptr(F, layer, WL_ATT), nb * 32, scr, F.lane); continue; }
        r -= I_SQ;
        if (r < I_SQ) { const int nb = r / (D / 64), kb = r % (D / 64); wt_item(F.in[I_WSC] + (size_t)layer * D * D, D, D, kb * 64, nb * 32, nullptr, wl_ptr(F, layer, WL_SC), nb * 32, scr, F.lane); continue; }
        r -= I_SQ;
        if (r < I_SQ) { const int nb = r / (D / 64), kb = r % (D / 64); wt_item(F.in[I_WO] + (size_t)layer * D * D, D, D, kb * 64, nb * 32, nullptr, wl_ptr(F, layer, WL_O), nb * 32, scr, F.lane); continue; }
        r -= I_SQ;
        if (r < I_UP) { const int e = r / ((2048 / 32) * (D / 64)), q = r % ((2048 / 32) * (D / 64)), nb = q / (D / 64), kb = q % (D / 64), n0 = nb * 32;
            const int pn = n0 >> 8, bj = (n0 >> 7) & 1, jj = n0 & 127, ns = bj * 1024 + pn * 128 + jj;
            wt_item(F.in[I_WUP] + ((size_t)layer * NEXP + e) * D * 2048, 2048, D, kb * 64, ns, nullptr, wl_ptr(F, layer, WL_UP) + (size_t)e * 2048 * D, n0, scr, F.lane); continue; }
        r -= I_UP;
        { const int e = r / ((D / 32) * (D / 64)), q = r % ((D / 32) * (D / 64)), nb = q / (D / 64), kb = q % (D / 64);
            wt_item(F.in[I_WDN] + ((size_t)layer * NEXP + e) * D * D, D, D, kb * 64, nb * 32, nullptr, wl_ptr(F, layer, WL_DN) + (size_t)e * D * D, nb * 32, scr, F.lane); }
    }
}

__device__ __forceinline__ const float* x_in_row(const Frame& F, int layer, int mb, int r) {
    if (layer == 0) return r < NP ? F.in[I_XP] + ((size_t)mb * NP + r) * D : F.in[I_XS] + (size_t)(r - NP) * D;
    return r < NP ? F.out + O_YP + ((size_t)mb * NP + r) * D : F.out + O_YS + (size_t)(r - NP) * D;
}
__device__ __forceinline__ float* x_out_row(const Frame& F, int mb, int r) { return r < NP ? F.out + O_YP + ((size_t)mb * NP + r) * D : F.out + O_YS + (size_t)(r - NP) * D; }
__device__ __forceinline__ int rows_of(int mb) { return mb == 0 ? R : NP; }

__device__ __forceinline__ void step_xb(const Frame& F, int mb) {
    const int gw = F.bid * NWAVES + F.wave, NGW = F.G * NWAVES, nr = rows_of(mb);
    bf16_t* XB = ws_bf(F, WS_XB);
    for (int r = gw; r < nr; r += NGW) {
        const f32x4* xr = (const f32x4*)x_in_row(F, 0, mb, r) + F.lane; u32x2* o = (u32x2*)(XB + (size_t)r * D) + F.lane;
#pragma unroll
        for (int j = 0; j < 4; ++j) { const f32x4 v = xr[64 * j]; u32x2 w; w.x = pk2(v[0], v[1]); w.y = pk2(v[2], v[3]); o[64 * j] = w; }
    }
}

__device__ __forceinline__ float softplus_f(float x) { const float e = fexp(x); return x > 20.f ? x : (e < 0.01f ? e * (1.0f - e * (0.5f - e * 0.33333333f)) : __builtin_amdgcn_logf(1.0f + e) * 0.69314718056f); }
constexpr int S128 = 136, S64 = 72, RAWP = 264;
constexpr int SL_CM = 0, SL_BM = SL_CM + 64 * S128 * 2, SL_BT = SL_BM + 64 * S128 * 2, SL_XT = SL_BT + 128 * S64 * 2, SL_XTW = SL_XT + 64 * S64 * 2,
    SL_MM = SL_XTW + 64 * S64 * 2, SL_SB = SL_MM + 64 * S64 * 2, SL_SM = SL_SB + 64 * S128 * 2, SL_CW = SL_SM + 2 * 320 * 4, SL_RAW = SL_CW + 5 * 320 * 4, SL_END = SL_RAW + 35 * 1024;
constexpr int SL_Y = SL_CM, YP = 68;
static_assert(SL_END <= SCR_BYTES && 64 * YP * 4 <= 64 * S128 * 2 && 67 * RAWP * 2 <= 35 * 1024, "ssd LDS map");

#ifdef EMU
#define SSD_DMA_ONE(gp_, dst_) memcpy((unsigned char*)(dst_) + lane * 16, (gp_), 16)
#else
#define SSD_DMA_ONE(gp_, dst_) __builtin_amdgcn_global_load_lds((const unsigned*)(gp_), (LAS unsigned*)(dst_), 16, 0, 0)
#endif
#define SSD_DMA(ck_) do { _Pragma("unroll") for (int j_ = 0; j_ < 5; ++j_) if (w * 5 + j_ < 35) { int q_ = (w * 5 + j_) * 64 + lane; q_ = q_ < 67 * 33 ? q_ : 67 * 33 - 1; const int row_ = q_ / 33; int cc_ = q_ % 33; cc_ = cc_ < 32 ? cc_ : 31; \
        const int t_ = (ck_) * 64 + row_ - 3; const bf16_t* gp_ = t_ >= 0 ? H + (size_t)t_ * DINP + (cc_ < 16 ? C_B + g * 128 + 8 * cc_ : C_C + g * 128 + 8 * (cc_ - 16)) : (const bf16_t*)(F.ws + 1024 + lane * 16); \
        SSD_DMA_ONE(gp_, L + SL_RAW + (w * 5 + j_) * 1024); } } while (0)
#define SSD_LOAD_X(ck_) do { _Pragma("unroll") for (int i = 0; i < 4; ++i) { const int t_ = (ck_) * 64 + xl - 3 + i; rawx[i] = t_ >= 0 ? *(const u32x4*)(H + (size_t)t_ * DINP + C_X + hd * 64 + 8 * xcg) : (u32x4){0u, 0u, 0u, 0u}; } } while (0)
#define SSD_TABLE(tb_, dtr_) do { const float x_ = bf2f(dtr_) + dtb; const float e_ = fexp(x_); const float dt_ = x_ > 20.f ? x_ : (e_ < 0.01f ? e_ * (1.0f - e_ * (0.5f - e_ * 0.33333333f)) : __builtin_amdgcn_logf(1.0f + e_) * 0.69314718056f); \
        float cs_ = Ah * dt_; _Pragma("unroll") for (int o = 1; o < 64; o <<= 1) { const float t2_ = __shfl(cs_, lane - o < 0 ? 0 : lane - o); if (lane >= o) cs_ += t2_; } \
        const float tot_ = __shfl(cs_, 63); (tb_)[lane] = dt_; (tb_)[64 + lane] = cs_; (tb_)[128 + lane] = fexp(tot_ - cs_); (tb_)[192 + lane] = fexp(cs_); if (lane == 0) (tb_)[256] = fexp(tot_); } while (0)

__device__ __forceinline__ void ssd_prompt_unit(const Frame& F, int layer, int mb, int sl, int hd) {
    const int tid = F.tid, lane = F.lane, w = F.wave, fr = lane & 15, fq = lane >> 4;
    LAS unsigned char* L = F.lds;
    LAS bf16_t* Cm = (LAS bf16_t*)(L + SL_CM); LAS bf16_t* Bm = (LAS bf16_t*)(L + SL_BM); LAS bf16_t* BT = (LAS bf16_t*)(L + SL_BT); LAS bf16_t* XT = (LAS bf16_t*)(L + SL_XT);
    LAS bf16_t* XTW = (LAS bf16_t*)(L + SL_XTW); LAS bf16_t* Mm = (LAS bf16_t*)(L + SL_MM); LAS bf16_t* Sb = (LAS bf16_t*)(L + SL_SB); LAS bf16_t* RAW = (LAS bf16_t*)(L + SL_RAW);
    LAS float* smb = (LAS float*)(L + SL_SM);
    LAS float* cw = (LAS float*)(L + SL_CW);
    LAS float* Y = (LAS float*)(L + SL_Y);
    const int g = hd >> 2;
    bf16_t* H = ws_bf(F, WS_H) + (size_t)sl * SEQ * DINP;
    const float* convw = F.in[I_CONVW] + (size_t)layer * 4 * CONVDIM; const float* convb = F.in[I_CONVB] + (size_t)layer * CONVDIM;
    __syncthreads();
    for (int i = tid; i < 5 * 320; i += NTHREADS) { const int tap = i / 320, c = i % 320; const int xc = c < 64 ? hd * 64 + c : (c < 192 ? 2048 + g * 128 + (c - 64) : 3072 + g * 128 + (c - 192));
        cw[i] = tap < 4 ? convw[tap * CONVDIM + xc] : convb[xc]; }
    const float dtb = F.in[I_DTB][layer * 32 + hd], Ah = -fexp(F.in[I_ALOG][layer * 32 + hd]), Dh = F.in[I_SD][layer * 32 + hd];
    const int xl = tid >> 3, xcg = tid & 7;
    f32x4 S[4];
#pragma unroll
    for (int j = 0; j < 4; ++j) S[j] = (f32x4){0.f, 0.f, 0.f, 0.f};
    const int ti = w >> 1, tj0 = 2 * (w & 1);
    const int pi = w & 3, nb = w >> 2;
    u32x4 rawx[4]; u32x4 zraw; unsigned dtr_next;
    SSD_DMA(0); SSD_LOAD_X(0);
    zraw = *(const u32x4*)(H + (size_t)xl * DINP + C_Z + hd * 64 + 8 * xcg);
    { const unsigned d0 = H[(size_t)lane * DINP + C_DT + hd]; dtr_next = H[(size_t)(64 + lane) * DINP + C_DT + hd]; if (w == 7) SSD_TABLE(smb, d0); }
    VM_WAIT(0);
    for (int ck = 0; ck < NCHUNK; ++ck) {
        const size_t rowb = (size_t)ck * 64;
        LAS float* sm = smb + (ck & 1) * 320; LAS float* smn = smb + ((ck + 1) & 1) * 320;
        if (ck > 0) VM_WAIT(2);
        LBAR();
        float xs8[8];
        { float acc8[8];
          { const f32x4 b0 = *(const LAS f32x4*)(cw + 4 * 320 + 8 * xcg), b1 = *(const LAS f32x4*)(cw + 4 * 320 + 8 * xcg + 4);
#pragma unroll
            for (int i = 0; i < 4; ++i) { acc8[i] = b0[i]; acc8[4 + i] = b1[i]; } }
#pragma unroll
          for (int tp = 0; tp < 4; ++tp) { float f[8]; unpack8(rawx[tp], f); const f32x4 w0 = *(const LAS f32x4*)(cw + tp * 320 + 8 * xcg), w1 = *(const LAS f32x4*)(cw + tp * 320 + 8 * xcg + 4);
#pragma unroll
            for (int i = 0; i < 4; ++i) { acc8[i] += f[i] * w0[i]; acc8[4 + i] += f[4 + i] * w1[i]; } }
          const float dt = sm[xl], wd = sm[128 + xl];
#pragma unroll
          for (int i = 0; i < 8; ++i) { const float v = fsilu(acc8[i]); xs8[i] = v; const float xd = v * dt; XT[(8 * xcg + i) * S64 + xl] = bf1(xd); XTW[(8 * xcg + i) * S64 + xl] = bf1(xd * wd); } }
        asm volatile("" ::: "memory");
#pragma unroll
        for (int it = 0; it < 4; ++it) {
            const int cg = w + 8 * (it & 1); const int cb = (it < 2 ? 64 : 192) + 8 * cg, rc = (it < 2 ? 0 : 128) + 8 * cg;
            float acc8[8];
            { const f32x4 b0 = *(const LAS f32x4*)(cw + 4 * 320 + cb), b1 = *(const LAS f32x4*)(cw + 4 * 320 + cb + 4);
#pragma unroll
              for (int i = 0; i < 4; ++i) { acc8[i] = b0[i]; acc8[4 + i] = b1[i]; } }
#pragma unroll
            for (int tp = 0; tp < 4; ++tp) { float f[8]; unpack8(*(const LAS u32x4*)(RAW + (lane + tp) * RAWP + rc), f); const f32x4 w0 = *(const LAS f32x4*)(cw + tp * 320 + cb), w1 = *(const LAS f32x4*)(cw + tp * 320 + cb + 4);
#pragma unroll
                for (int i = 0; i < 4; ++i) { acc8[i] += f[i] * w0[i]; acc8[4 + i] += f[4 + i] * w1[i]; } }
#pragma unroll
            for (int i = 0; i < 8; ++i) acc8[i] = fsilu(acc8[i]);
            if (it < 2) { *(LAS u32x4*)(Bm + lane * S128 + 8 * cg) = pack8(acc8);
#pragma unroll
                for (int i = 0; i < 8; ++i) BT[(8 * cg + i) * S64 + lane] = bf1(acc8[i]); }
            else *(LAS u32x4*)(Cm + lane * S128 + 8 * cg) = pack8(acc8);
            asm volatile("" ::: "memory");
        }
#pragma unroll
        for (int jj = 0; jj < 4; ++jj)
#pragma unroll
            for (int r = 0; r < 4; ++r) Sb[(16 * pi + 4 * fq + r) * S128 + 64 * nb + 16 * jj + fr] = bf1(S[jj][r]);
        LBAR();
        const u32x4 zcur = zraw; const unsigned dtr_cur = dtr_next;
        if (ck + 1 < NCHUNK) { SSD_DMA(ck + 1); SSD_LOAD_X(ck + 1); zraw = *(const u32x4*)(H + (rowb + 64 + xl) * DINP + C_Z + hd * 64 + 8 * xcg);
            dtr_next = H[(rowb + (ck + 2 < NCHUNK ? 128 : 64) + lane) * DINP + C_DT + hd]; }
        asm volatile("" ::: "memory");
        if (w == 7 && ck + 1 < NCHUNK) SSD_TABLE(smn, dtr_cur);
        f32x4 yo[2];
#pragma unroll
        for (int jj = 0; jj < 2; ++jj) { const int tj = tj0 + jj;
            f32x4 cb = (f32x4){0.f, 0.f, 0.f, 0.f}; yo[jj] = (f32x4){0.f, 0.f, 0.f, 0.f};
#pragma unroll
            for (int ks = 0; ks < 4; ++ks) { const bf16x8 a = *(const LAS bf16x8*)(Cm + (16 * ti + fr) * S128 + 32 * ks + 8 * fq);
                if (tj <= ti) { const bf16x8 b = *(const LAS bf16x8*)(Bm + (16 * tj + fr) * S128 + 32 * ks + 8 * fq); cb = __builtin_amdgcn_mfma_f32_16x16x32_bf16(a, b, cb, 0, 0, 0); }
                const bf16x8 sb = *(const LAS bf16x8*)(Sb + (16 * tj + fr) * S128 + 32 * ks + 8 * fq); yo[jj] = __builtin_amdgcn_mfma_f32_16x16x32_bf16(a, sb, yo[jj], 0, 0, 0); }
            const int s = 16 * tj + fr; const float as = sm[64 + s];
#pragma unroll
            for (int r = 0; r < 4; ++r) { const int l = 16 * ti + 4 * fq + r; const float al = sm[64 + l];
                const float mv = (tj <= ti && l >= s) ? cb[r] * fexp(fminf(al - as, 0.f)) : 0.f; Mm[l * S64 + s] = bf1(mv); }
            asm volatile("" ::: "memory");
        }
        { const float cd = sm[256];
#pragma unroll
          for (int jj = 0; jj < 4; ++jj) { S[jj] = S[jj] * cd;
#pragma unroll
            for (int ks = 0; ks < 2; ++ks) { const bf16x8 a = *(const LAS bf16x8*)(XTW + (16 * pi + fr) * S64 + 32 * ks + 8 * fq); const bf16x8 b = *(const LAS bf16x8*)(BT + (64 * nb + 16 * jj + fr) * S64 + 32 * ks + 8 * fq);
                S[jj] = __builtin_amdgcn_mfma_f32_16x16x32_bf16(a, b, S[jj], 0, 0, 0); }
            if (jj & 1) asm volatile("" ::: "memory"); } }
        LBAR();
#pragma unroll
        for (int jj = 0; jj < 2; ++jj) { const int tj = tj0 + jj; f32x4 yd = (f32x4){0.f, 0.f, 0.f, 0.f};
#pragma unroll
            for (int ks = 0; ks < 2; ++ks) { const bf16x8 a = *(const LAS bf16x8*)(Mm + (16 * ti + fr) * S64 + 32 * ks + 8 * fq); const bf16x8 b = *(const LAS bf16x8*)(XT + (16 * tj + fr) * S64 + 32 * ks + 8 * fq);
                yd = __builtin_amdgcn_mfma_f32_16x16x32_bf16(a, b, yd, 0, 0, 0); }
#pragma unroll
            for (int r = 0; r < 4; ++r) { const int l = 16 * ti + 4 * fq + r; Y[l * YP + 16 * tj + fr] = yd[r] + sm[192 + l] * yo[jj][r]; } }
        LBAR();
        { float y8[8], z8[8]; const f32x4 ya = *(const LAS f32x4*)(Y + xl * YP + 8 * xcg), yb = *(const LAS f32x4*)(Y + xl * YP + 8 * xcg + 4);
#pragma unroll
          for (int i = 0; i < 4; ++i) { y8[i] = ya[i]; y8[4 + i] = yb[i]; }
          unpack8(zcur, z8); float ss = 0.f;
#pragma unroll
          for (int i = 0; i < 8; ++i) { const float v = (y8[i] + Dh * xs8[i]) * fsilu(z8[i]); y8[i] = v; ss += v * v; }
          asm volatile("" ::: "memory");
          *(u32x4*)(H + (rowb + xl) * DINP + C_Z + hd * 64 + 8 * xcg) = pack8(y8);
          ss += __shfl_xor(ss, 1); ss += __shfl_xor(ss, 2); ss += __shfl_xor(ss, 4);
          if (xcg == 0) ws_f(F, WS_SSQ)[((size_t)sl * SEQ + rowb + xl) * 32 + hd] = ss; }
    }
    float* so = F.out + O_SSP + ((((size_t)layer * BATCH + mb * NSEQ_MB + sl) * 32 + hd) * 64) * 128;
#pragma unroll
    for (int jj = 0; jj < 4; ++jj)
#pragma unroll
        for (int r = 0; r < 4; ++r) so[(size_t)(16 * pi + 4 * fq + r) * 128 + 64 * nb + 16 * jj + fr] = S[jj][r];
    VM_WAIT(0); __syncthreads();
}

__device__ __forceinline__ void ssd_sample_unit(const Frame& F, int layer, int sq, int hd) {
    const int tid = F.tid, lane = F.lane; LAS float* L = (LAS float*)F.lds;
    LAS float* xs = L; LAS float* Bs = L + 16 * 64; LAS float* Cs = Bs + 16 * 128; LAS float* dts = Cs + 16 * 128; LAS float* das = dts + 16; LAS float* Yl = das + 16;
    const int g = hd >> 2;
    bf16_t* H = ws_bf(F, WS_H) + (size_t)(NP + sq * 16) * DINP;
    const float* hist = F.in[I_SCV] + ((size_t)layer * DECB + sq) * 3 * CONVDIM;
    const float* convw = F.in[I_CONVW] + (size_t)layer * 4 * CONVDIM; const float* convb = F.in[I_CONVB] + (size_t)layer * CONVDIM;
    __syncthreads();
    if (tid < 320) { const int c = tid; const int xc = c < 64 ? hd * 64 + c : (c < 192 ? 2048 + g * 128 + (c - 64) : 3072 + g * 128 + (c - 192));
        float win[19];
#pragma unroll
        for (int i = 0; i < 3; ++i) win[i] = hist[i * CONVDIM + xc];
#pragma unroll
        for (int t = 0; t < 16; ++t) win[3 + t] = bf2f(H[(size_t)t * DINP + C_X + xc]);
        const float w0 = convw[xc], w1 = convw[CONVDIM + xc], w2 = convw[2 * CONVDIM + xc], w3 = convw[3 * CONVDIM + xc], bb = convb[xc];
#pragma unroll
        for (int t = 0; t < 16; ++t) { const float a = fsilu(bb + win[t] * w0 + win[t + 1] * w1 + win[t + 2] * w2 + win[t + 3] * w3);
            if (c < 64) xs[t * 64 + c] = a; else if (c < 192) Bs[t * 128 + c - 64] = a; else Cs[t * 128 + c - 192] = a; } }
    if (tid < 16) { const float dt = softplus_f(bf2f(H[(size_t)tid * DINP + C_DT + hd]) + F.in[I_DTB][layer * 32 + hd]); dts[tid] = dt; das[tid] = fexp(-fexp(F.in[I_ALOG][layer * 32 + hd]) * dt); }
    __syncthreads();
    const int p = tid >> 3, n0 = (tid & 7) * 16;
    const size_t sbase = ((((size_t)layer * DECB + sq) * 32 + hd) * 64 + p) * 128 + n0;
    float S[16];
#pragma unroll
    for (int i = 0; i < 16; ++i) S[i] = F.in[I_SST][sbase + i];
    for (int t = 0; t < 16; ++t) { const float dec = das[t], xv = xs[t * 64 + p] * dts[t]; float part = 0.f;
#pragma unroll
        for (int i = 0; i < 16; ++i) { S[i] = S[i] * dec + xv * Bs[t * 128 + n0 + i]; part += Cs[t * 128 + n0 + i] * S[i]; }
        part += __shfl_xor(part, 1); part += __shfl_xor(part, 2); part += __shfl_xor(part, 4);
        if ((tid & 7) == 0) Yl[t * 64 + p] = part; }
#pragma unroll
    for (int i = 0; i < 16; ++i) F.out[O_SSS + sbase + i] = S[i];
    __syncthreads();
    const float Dh = F.in[I_SD][layer * 32 + hd];
#pragma unroll
    for (int j = 0; j < 2; ++j) { const int it = tid + 512 * j, t = it >> 6, pp = it & 63;
        const float z = bf2f(H[(size_t)t * DINP + C_Z + hd * 64 + pp]); const float v = (Yl[t * 64 + pp] + Dh * xs[t * 64 + pp]) * fsilu(z);
        H[(size_t)t * DINP + C_Z + hd * 64 + pp] = bf1(v);
        const float ss = wave_sum(v * v);
        if (lane == 0) ws_f(F, WS_SSQ)[((size_t)NP + sq * 16 + t) * 32 + hd] = ss; }
}

__device__ __forceinline__ int t5_bucket(int rel) {
    const int n = rel < 0 ? -rel : rel; const int b = rel > 0 ? 16 : 0;
    if (n < 8) return b + n;
    int v = 8; v += n >= 12; v += n >= 16; v += n >= 23; v += n >= 32; v += n >= 46; v += n >= 64; v += n >= 91;
    return b + v;
}
constexpr int AK_P = 72, AV_P = 200;
constexpr int AL_K = 0, AL_VT = AL_K + 192 * AK_P * 2, AL_LUT = AL_VT + 64 * AV_P * 2, AL_END = AL_LUT + 4 * 256 * 4;
static_assert(AL_END <= RING_BYTES, "attention LDS map");
__device__ __forceinline__ void attn_prompt_unit(const Frame& F, int layer, int sl, int ck, int kh) {
    const int tid = F.tid, lane = F.lane, w = F.wave, q32 = lane & 31, hi = lane >> 5;
    LAS bf16_t* Kl = (LAS bf16_t*)(F.lds + AL_K); LAS bf16_t* VT = (LAS bf16_t*)(F.lds + AL_VT); LAS float* lut = (LAS float*)(F.lds + AL_LUT);
    bf16_t* H = ws_bf(F, WS_H) + (size_t)sl * SEQ * DINP;
    __syncthreads();
#pragma unroll
    for (int j = 0; j < 3; ++j) { const int id = tid + 512 * j, key = id >> 3, cg = id & 7; const int t = 64 * (ck - 2) + key;
        u32x4 kv = (u32x4){0u, 0u, 0u, 0u}, vv = kv;
        if (t >= 0) { kv = *(const u32x4*)(H + (size_t)t * DINP + C_K + kh * 64 + 8 * cg); vv = *(const u32x4*)(H + (size_t)t * DINP + C_V + kh * 64 + 8 * cg); }
        *(LAS u32x4*)(Kl + key * AK_P + 8 * cg) = kv;
        VT[(8 * cg + 0) * AV_P + key] = (bf16_t)(vv.x & 0xffffu); VT[(8 * cg + 1) * AV_P + key] = (bf16_t)(vv.x >> 16); VT[(8 * cg + 2) * AV_P + key] = (bf16_t)(vv.y & 0xffffu); VT[(8 * cg + 3) * AV_P + key] = (bf16_t)(vv.y >> 16);
        VT[(8 * cg + 4) * AV_P + key] = (bf16_t)(vv.z & 0xffffu); VT[(8 * cg + 5) * AV_P + key] = (bf16_t)(vv.z >> 16); VT[(8 * cg + 6) * AV_P + key] = (bf16_t)(vv.w & 0xffffu); VT[(8 * cg + 7) * AV_P + key] = (bf16_t)(vv.w >> 16); }
    for (int e = tid; e < 4 * 255; e += NTHREADS) { const int gg = e / 255, idx = e % 255; lut[gg * 256 + idx] = F.in[I_RELB][t5_bucket(idx - 191) * 16 + kh * 4 + gg]; }
    __syncthreads();
    const int gq = w >> 1, qh = w & 1, head = kh * 4 + gq;
    const size_t qrow = (size_t)ck * 64 + 32 * qh + q32;
    bf16x8 qf[4];
#pragma unroll
    for (int ds = 0; ds < 4; ++ds) qf[ds] = *(const bf16x8*)(H + qrow * DINP + C_Q + head * 64 + 16 * ds + 8 * hi);
    f32x16 sc[6];
#pragma unroll
    for (int kt = 0; kt < 6; ++kt) {
#pragma unroll
        for (int r = 0; r < 16; ++r) sc[kt][r] = 0.f;
#pragma unroll
        for (int ds = 0; ds < 4; ++ds) { const bf16x8 a = *(const LAS bf16x8*)(Kl + (32 * kt + q32) * AK_P + 16 * ds + 8 * hi); sc[kt] = __builtin_amdgcn_mfma_f32_32x32x16_bf16(a, qf[ds], sc[kt], 0, 0, 0); } }
    const int qidx = 32 * qh + q32; const float sink = F.in[I_SINK][layer * 16 + head];
    float mx = -3.0e38f;
#pragma unroll
    for (int kt = 0; kt < 6; ++kt)
#pragma unroll
        for (int r = 0; r < 16; ++r) { const int key = 32 * kt + (r & 3) + 8 * (r >> 2) + 4 * hi; const int rel = key - 128 - qidx;
            float s = sc[kt][r] * 0.125f + lut[gq * 256 + rel + 191]; if (ck < 2 && 64 * ck + key - 128 < 0) s = -1e30f; sc[kt][r] = s; mx = fmaxf(mx, s); }
    mx = fmaxf(mx, __shfl_xor(mx, 32)); mx = fmaxf(mx, sink);
    float sum = 0.f;
#pragma unroll
    for (int kt = 0; kt < 6; ++kt)
#pragma unroll
        for (int r = 0; r < 16; ++r) { const float e = fexp(sc[kt][r] - mx); sc[kt][r] = e; sum += e; }
    sum += __shfl_xor(sum, 32);
    const float inv = 1.0f / (sum + fexp(sink - mx));
    f32x16 o[2];
#pragma unroll
    for (int d2 = 0; d2 < 2; ++d2)
#pragma unroll
        for (int r = 0; r < 16; ++r) o[d2][r] = 0.f;
#pragma unroll
    for (int kt = 0; kt < 6; ++kt)
#pragma unroll
        for (int s = 0; s < 2; ++s) {
            u32x4 pw; pw.x = pk2(sc[kt][8 * s + 0], sc[kt][8 * s + 1]); pw.y = pk2(sc[kt][8 * s + 2], sc[kt][8 * s + 3]); pw.z = pk2(sc[kt][8 * s + 4], sc[kt][8 * s + 5]); pw.w = pk2(sc[kt][8 * s + 6], sc[kt][8 * s + 7]);
            const bf16x8 pa = __builtin_bit_cast(bf16x8, pw);
#pragma unroll
            for (int d2 = 0; d2 < 2; ++d2) { const LAS bf16_t* vp = VT + (32 * d2 + q32) * AV_P + 32 * kt + 16 * s + 4 * hi;
                const u32x2 lo = *(const LAS u32x2*)vp, hh = *(const LAS u32x2*)(vp + 8); u32x4 vw; vw.x = lo.x; vw.y = lo.y; vw.z = hh.x; vw.w = hh.y;
                o[d2] = __builtin_amdgcn_mfma_f32_32x32x16_bf16(pa, __builtin_bit_cast(bf16x8, vw), o[d2], 0, 0, 0); } }
#pragma unroll
    for (int r = 0; r < 16; ++r) { const int q = (r & 3) + 8 * (r >> 2) + 4 * hi; const float iv = __shfl(inv, q);
        bf16_t* op = H + ((size_t)ck * 64 + 32 * qh + q) * DINP + C_Q + head * 64 + q32;
        op[0] = bf1(o[0][r] * iv); op[32] = bf1(o[1][r] * iv); }
}
__device__ __forceinline__ void attn_sample_unit(const Frame& F, int layer, int sq, int kh) {
    const int tid = F.tid; LAS float* L = (LAS float*)F.lds;
    LAS float* Kf = L; LAS float* Vf = Kf + 144 * 65; LAS float* Qf = Vf + 144 * 64; LAS float* P = Qf + 64 * 65; LAS float* Pinv = P + 64 * 145;
    static_assert((144 * 65 + 144 * 64 + 64 * 65 + 64 * 145 + 64) * 4 <= RING_BYTES, "sample attention LDS map");
    bf16_t* H = ws_bf(F, WS_H) + (size_t)(NP + sq * 16) * DINP;
    const float* ck = F.in[I_CK] + ((size_t)layer * DECB + sq) * WINDOW * 256; const float* cv = F.in[I_CV] + ((size_t)layer * DECB + sq) * WINDOW * 256;
    __syncthreads();
    for (int i = tid; i < 144 * 64; i += NTHREADS) { const int key = i >> 6, d = i & 63;
        Kf[key * 65 + d] = key < 128 ? ck[(size_t)key * 256 + kh * 64 + d] : bf2f(H[(size_t)(key - 128) * DINP + C_K + kh * 64 + d]);
        Vf[key * 64 + d] = key < 128 ? cv[(size_t)key * 256 + kh * 64 + d] : bf2f(H[(size_t)(key - 128) * DINP + C_V + kh * 64 + d]); }
    for (int i = tid; i < 64 * 64; i += NTHREADS) { const int row = i >> 6, d = i & 63; Qf[row * 65 + d] = bf2f(H[(size_t)(row & 15) * DINP + C_Q + (kh * 4 + (row >> 4)) * 64 + d]); }
    __syncthreads();
    for (int i = tid; i < 64 * 144; i += NTHREADS) { const int row = i / 144, key = i % 144; float s = 0.f;
        for (int d = 0; d < 64; ++d) s += Qf[row * 65 + d] * Kf[key * 65 + d];
        P[row * 145 + key] = s * 0.125f + F.in[I_RELB][t5_bucket(key - 128 - (row & 15)) * 16 + kh * 4 + (row >> 4)]; }
    __syncthreads();
    { const int row = tid >> 3, sub = tid & 7; const float sink = F.in[I_SINK][layer * 16 + kh * 4 + (row >> 4)]; float mx = -3.0e38f;
      for (int k = sub; k < 144; k += 8) mx = fmaxf(mx, P[row * 145 + k]);
      mx = fmaxf(mx, __shfl_xor(mx, 1)); mx = fmaxf(mx, __shfl_xor(mx, 2)); mx = fmaxf(mx, __shfl_xor(mx, 4)); mx = fmaxf(mx, sink);
      float sum = 0.f;
      for (int k = sub; k < 144; k += 8) { const float e = fexp(P[row * 145 + k] - mx); P[row * 145 + k] = e; sum += e; }
      sum += __shfl_xor(sum, 1); sum += __shfl_xor(sum, 2); sum += __shfl_xor(sum, 4);
      if (sub == 0) Pinv[row] = 1.0f / (sum + fexp(sink - mx)); }
    __syncthreads();
    { const int row = tid >> 3, d0 = (tid & 7) * 8; float o[8] = {0.f, 0.f, 0.f, 0.f, 0.f, 0.f, 0.f, 0.f};
      for (int k = 0; k < 144; ++k) { const float pv = P[row * 145 + k];
#pragma unroll
          for (int i = 0; i < 8; ++i) o[i] += pv * Vf[k * 64 + d0 + i]; }
      const float iv = Pinv[row];
#pragma unroll
      for (int i = 0; i < 8; ++i) o[i] *= iv;
      *(u32x4*)(H + (size_t)(row & 15) * DINP + C_Q + (kh * 4 + (row >> 4)) * 64 + d0) = pack8(o); }
}
__device__ __forceinline__ void sc_unit(const Frame& F, int layer, int tile) {
    const int tid = F.tid, cg = tid & 127, rs = tid >> 7; bf16_t* H = ws_bf(F, WS_H);
    const float* wsc = F.in[I_SCW] + (size_t)layer * 3 * D + 8 * cg; float wt[3][8];
#pragma unroll
    for (int i = 0; i < 3; ++i)
#pragma unroll
        for (int c = 0; c < 8; ++c) wt[i][c] = wsc[i * D + c];
    const int row0 = tile * 64 + 16 * rs; const bool smp = row0 >= NP; const int tt0 = smp ? 0 : row0 % SEQ;
    float u1[8], u2[8];
    if (tt0 >= 2) { float c8[8], h8[8];
        unpack8(*(const u32x4*)(H + (size_t)(row0 - 2) * DINP + C_SCC + 8 * cg), c8); unpack8(*(const u32x4*)(H + (size_t)(row0 - 2) * DINP + C_SCH + 8 * cg), h8);
#pragma unroll
        for (int c = 0; c < 8; ++c) u2[c] = c8[c] * h8[c];
        unpack8(*(const u32x4*)(H + (size_t)(row0 - 1) * DINP + C_SCC + 8 * cg), c8); unpack8(*(const u32x4*)(H + (size_t)(row0 - 1) * DINP + C_SCH + 8 * cg), h8);
#pragma unroll
        for (int c = 0; c < 8; ++c) u1[c] = c8[c] * h8[c]; }
    else if (smp) { const float* hp = F.in[I_SSC] + (((size_t)layer * DECB + ((row0 - NP) >> 4)) * 2) * D + 8 * cg;
#pragma unroll
        for (int c = 0; c < 8; ++c) { u2[c] = hp[c]; u1[c] = hp[D + c]; } }
    else {
#pragma unroll
        for (int c = 0; c < 8; ++c) { u2[c] = 0.f; u1[c] = 0.f; } }
#pragma unroll 1
    for (int q = 0; q < 4; ++q) {
        u32x4 cw_[4], hw_[4], bw_[4];
#pragma unroll
        for (int i = 0; i < 4; ++i) { const bf16_t* hp = H + (size_t)(row0 + 4 * q + i) * DINP + 8 * cg; cw_[i] = *(const u32x4*)(hp + C_SCC); hw_[i] = *(const u32x4*)(hp + C_SCH); bw_[i] = *(const u32x4*)(hp + C_SCB); }
        asm volatile("" ::: "memory");
#pragma unroll
        for (int i = 0; i < 4; ++i) { float c8[8], h8[8], b8[8], a[8]; unpack8(cw_[i], c8); unpack8(hw_[i], h8); unpack8(bw_[i], b8);
#pragma unroll
            for (int c = 0; c < 8; ++c) { const float u0 = c8[c] * h8[c]; a[c] = (u2[c] * wt[0][c] + u1[c] * wt[1][c] + u0 * wt[2][c]) * b8[c]; u2[c] = u1[c]; u1[c] = u0; }
            *(u32x4*)(H + (size_t)(row0 + 4 * q + i) * DINP + C_SCB + 8 * cg) = pack8(a); }
    }
}
__device__ __forceinline__ void state_out_unit(const Frame& F, int layer, int mb, int sl, bool smp) {
    const int tid = F.tid; const bf16_t* H = ws_bf(F, WS_H);
    const int nkv = smp ? DECS : WINDOW, len = smp ? DECS : SEQ; const size_t row0 = smp ? (size_t)NP + sl * 16 : (size_t)sl * SEQ; const int sg = smp ? sl : mb * NSEQ_MB + sl;
    const size_t nb_ = smp ? DECB : BATCH;
    float* ko = F.out + (smp ? O_KS : O_KP) + ((size_t)layer * nb_ + sg) * nkv * 256; float* vo = F.out + (smp ? O_VS : O_VP) + ((size_t)layer * nb_ + sg) * nkv * 256;
    for (int i = tid; i < nkv * 32; i += NTHREADS) { const int j = i >> 5, c8 = (i & 31) * 8; const bf16_t* hp = H + (row0 + len - nkv + j) * DINP; float f[8];
        unpack8(*(const u32x4*)(hp + C_K + c8), f); *(f32x4*)(ko + (size_t)j * 256 + c8) = (f32x4){f[0], f[1], f[2], f[3]}; *(f32x4*)(ko + (size_t)j * 256 + c8 + 4) = (f32x4){f[4], f[5], f[6], f[7]};
        unpack8(*(const u32x4*)(hp + C_V + c8), f); *(f32x4*)(vo + (size_t)j * 256 + c8) = (f32x4){f[0], f[1], f[2], f[3]}; *(f32x4*)(vo + (size_t)j * 256 + c8 + 4) = (f32x4){f[4], f[5], f[6], f[7]}; }
    float* co = F.out + (smp ? O_CVS : O_CVP) + ((size_t)layer * nb_ + sg) * 3 * CONVDIM;
    for (int i = tid; i < 3 * 512; i += NTHREADS) { const int j = i / 512, c8 = (i % 512) * 8; float f[8]; unpack8(*(const u32x4*)(H + (row0 + len - 3 + j) * DINP + C_X + c8), f);
        *(f32x4*)(co + (size_t)j * CONVDIM + c8) = (f32x4){f[0], f[1], f[2], f[3]}; *(f32x4*)(co + (size_t)j * CONVDIM + c8 + 4) = (f32x4){f[4], f[5], f[6], f[7]}; }
    float* so = F.out + (smp ? O_SCS : O_SCP) + ((size_t)layer * nb_ + sg) * 2 * D;
    for (int i = tid; i < 2 * 128; i += NTHREADS) { const int j = i >> 7, c8 = (i & 127) * 8; float c[8], h[8]; const bf16_t* hp = H + (row0 + len - 2 + j) * DINP;
        unpack8(*(const u32x4*)(hp + C_SCC + c8), c); unpack8(*(const u32x4*)(hp + C_SCH + c8), h);
        *(f32x4*)(so + (size_t)j * D + c8) = (f32x4){c[0] * h[0], c[1] * h[1], c[2] * h[2], c[3] * h[3]}; *(f32x4*)(so + (size_t)j * D + c8 + 4) = (f32x4){c[4] * h[4], c[5] * h[5], c[6] * h[6], c[7] * h[7]}; }
}
#ifndef MIX_MASK
#define MIX_MASK 0xFF
#endif
#define MIXON(b) ((MIX_MASK >> (b)) & 1)
__device__ __forceinline__ void step_mixers(const Frame& F, int layer, int mb) {
    const int n_ssd = NSEQ_MB * 32, n_att = NSEQ_MB * NCHUNK * NKV, n_sc = rows_of(mb) / 64, n_so = NSEQ_MB + (mb == 0 ? DECB : 0);
    const int n_ss = mb == 0 ? DECB * 32 : 0, n_as = mb == 0 ? DECB * NKV : 0;
    const int total = n_ssd + n_att + n_sc + n_so + n_ss + n_as;
    for (int un = F.bid; un < total; un += F.G) { int r = un;
#define UF(Fu) Frame Fu = F; Fu.lane = opq(lane_id()); Fu.tid = Fu.wave * 64 + Fu.lane
        if (r < n_ssd) { PROBE_T0(12) if constexpr (MIXON(0)) { UF(Fu); ssd_prompt_unit(Fu, layer, mb, r >> 5, r & 31); } PROBE_T1(12) continue; } r -= n_ssd;
        if (r < n_att) { if constexpr (MIXON(1)) { UF(Fu); attn_prompt_unit(Fu, layer, r / (NCHUNK * NKV), (r / NKV) % NCHUNK, r % NKV); } continue; } r -= n_att;
        if (r < n_sc) { if constexpr (MIXON(2)) { UF(Fu); sc_unit(Fu, layer, r); } continue; } r -= n_sc;
        if (r < n_so) { if constexpr (MIXON(3)) { UF(Fu); state_out_unit(Fu, layer, mb, r < NSEQ_MB ? r : r - NSEQ_MB, r >= NSEQ_MB); } continue; } r -= n_so;
        if (r < n_ss) { if constexpr (MIXON(4)) { UF(Fu); ssd_sample_unit(Fu, layer, r >> 5, r & 31); } continue; } r -= n_ss;
        if constexpr (MIXON(5)) { UF(Fu); attn_sample_unit(Fu, layer, r >> 2, r & 3); }
    }
}
__device__ __forceinline__ void step_gnorm(const Frame& F, int mb) {
    const int gw = F.bid * NWAVES + F.wave, NGW = F.G * NWAVES, nr = rows_of(mb); bf16_t* H = ws_bf(F, WS_H); const float* ssq = ws_f(F, WS_SSQ);
    constexpr int RB = 4; const int g = F.lane >> 3;
    for (int r0 = gw; r0 < nr; r0 += RB * NGW) {
        u32x4 d[RB][4]; f32x4 q[RB];
#pragma unroll
        for (int i = 0; i < RB; ++i) { const int r = r0 + i * NGW < nr ? r0 + i * NGW : r0; q[i] = *(const f32x4*)(ssq + (size_t)r * 32 + 4 * g); const u32x4* p = (const u32x4*)(H + (size_t)r * DINP + C_Z + 32 * F.lane);
#pragma unroll
            for (int j = 0; j < 4; ++j) d[i][j] = p[j]; }
        asm volatile("" ::: "memory");
#pragma unroll
        for (int i = 0; i < RB; ++i) { const int r = r0 + i * NGW; if (r >= nr) continue;
            const float rstd = 1.0f / sqrtf(((q[i][0] + q[i][1]) + (q[i][2] + q[i][3])) * (1.0f / 256.0f) + LN_EPS); u32x4* p = (u32x4*)(H + (size_t)r * DINP + C_Z + 32 * F.lane);
#pragma unroll
            for (int j = 0; j < 4; ++j) { float f[8]; unpack8(d[i][j], f);
#pragma unroll
                for (int k = 0; k < 8; ++k) f[k] *= rstd;
                p[j] = pack8(f); } }
    }
}
constexpr int LOG_NEXP = NEXP == 32 ? 5 : (NEXP == 16 ? 4 : (NEXP == 8 ? 3 : 2));
template <int N, int MASK> struct RedStep {
    static __device__ __forceinline__ void run(float* v, int lane) {
        constexpr int Hn = N / 2; const bool up = (lane & MASK) != 0;
#pragma unroll
        for (int i = 0; i < Hn; ++i) { const float keep = up ? v[i + Hn] : v[i], send = up ? v[i] : v[i + Hn]; v[i] = keep + __shfl_xor(send, MASK); }
        if constexpr (Hn > 1) RedStep<Hn, (MASK >> 1)>::run(v, lane);
    }
};
__device__ __forceinline__ void step_ln1_router(const Frame& F, int layer, int mb) {
    LAS float* wT = (LAS float*)F.lds;
    const float* rw = F.in[I_RW] + (size_t)layer * D * NEXP;
    __syncthreads();
    for (int i = F.tid; i < D * NEXP; i += NTHREADS) { const int e = i / D, k = i % D; wT[i] = rw[(size_t)k * NEXP + e]; }
    { int* rtok = (int*)(F.ws + WS_RTOK); for (int i = F.bid * NTHREADS + F.tid; i < RP; i += F.G * NTHREADS) rtok[i] = 0; }
    unsigned* cnt = F.ctl + CW_CNT + (mb * DEPTH + layer) * 64;
    LAS unsigned* lcnt = (LAS unsigned*)(F.lds + MISC_OFF) + 128;
    if (F.tid < 64) lcnt[F.tid] = 0u;
    __syncthreads();
    const int gw = F.bid * NWAVES + F.wave, NGW = F.G * NWAVES, nr = rows_of(mb), lane = F.lane;
    const float* lg = F.in[I_LN1G] + (size_t)layer * D; const float* lb = F.in[I_LN1B] + (size_t)layer * D; const float* rb = F.in[I_RB] + (size_t)layer * NEXP;
    bf16_t* XB = ws_bf(F, WS_XB); int* topi = (int*)(F.ws + WS_TOPI); float* gate = ws_f(F, WS_GATE); int* pos = (int*)(F.ws + WS_POS);
    constexpr int RB = 4, NH = NEXP / 2, LOGH = LOG_NEXP - 1;
    const int myexp = ((lane & 1) * NH) | ((lane >> (6 - LOGH)) & (NH - 1));
    const float myb = rb[myexp];
    for (int r0 = gw; r0 < nr; r0 += RB * NGW) {
        f32x4 v[RB][4]; int rr[RB]; bool ok[RB];
#pragma unroll
        for (int i = 0; i < RB; ++i) { const int r = r0 + i * NGW; ok[i] = r < nr; rr[i] = ok[i] ? r : r0; const float* xr = x_out_row(F, mb, rr[i]);
#pragma unroll
            for (int j = 0; j < 4; ++j) v[i][j] = *((const f32x4*)xr + lane + 64 * j); }
        asm volatile("" ::: "memory");
#pragma unroll
        for (int i = 0; i < RB; ++i) {
            float* xr = x_out_row(F, mb, rr[i]); float s = 0.f;
#pragma unroll
            for (int j = 0; j < 4; ++j) s += (v[i][j][0] + v[i][j][1]) + (v[i][j][2] + v[i][j][3]);
            const float mean = wave_sum(s) * (1.0f / D); float s2 = 0.f;
#pragma unroll
            for (int j = 0; j < 4; ++j) { v[i][j] = v[i][j] - mean; s2 += (v[i][j][0] * v[i][j][0] + v[i][j][1] * v[i][j][1]) + (v[i][j][2] * v[i][j][2] + v[i][j][3] * v[i][j][3]); }
            const float rstd = 1.0f / sqrtf(wave_sum(s2) * (1.0f / D) + LN_EPS);
#pragma unroll
            for (int j = 0; j < 4; ++j) { const f32x4 gg = *((const f32x4*)lg + lane + 64 * j), bb = *((const f32x4*)lb + lane + 64 * j); v[i][j] = v[i][j] * rstd * gg + bb;
                if (ok[i]) { *((f32x4*)xr + lane + 64 * j) = v[i][j]; u32x2 w; w.x = pk2(v[i][j][0], v[i][j][1]); w.y = pk2(v[i][j][2], v[i][j][3]); *((u32x2*)(XB + (size_t)rr[i] * D) + lane + 64 * j) = w; } }
        }
        float val[RB];
#pragma unroll
        for (int hf = 0; hf < 2; ++hf) {
            float lgt[RB][NH];
#pragma unroll
            for (int e = 0; e < NH; ++e) { float a[RB];
#pragma unroll
                for (int i = 0; i < RB; ++i) a[i] = 0.f;
#pragma unroll
                for (int j = 0; j < 4; ++j) { const f32x4 wv = *((const LAS f32x4*)(wT + (hf * NH + e) * D) + lane + 64 * j);
#pragma unroll
                    for (int i = 0; i < RB; ++i) a[i] += (v[i][j][0] * wv[0] + v[i][j][1] * wv[1]) + (v[i][j][2] * wv[2] + v[i][j][3] * wv[3]); }
#pragma unroll
                for (int i = 0; i < RB; ++i) lgt[i][e] = a[i];
                if ((e & 1) == 1) asm volatile("" ::: "memory"); }
#pragma unroll
            for (int i = 0; i < RB; ++i) { RedStep<NH, 32>::run(lgt[i], lane); float tot = lgt[i][0];
#pragma unroll
                for (int mk = (32 >> LOGH); mk >= 1; mk >>= 1) tot += __shfl_xor(tot, mk);
                if ((lane & 1) == hf) val[i] = tot + myb; }
        }
#pragma unroll
        for (int i = 0; i < RB; ++i) {
            float tv[4]; int te[4]; float vv = val[i];
#pragma unroll
            for (int k = 0; k < 4; ++k) { float bv = vv; int be = myexp;
#pragma unroll
                for (int o = 1; o < 64; o <<= 1) { const float ov = __shfl_xor(bv, o); const int oe = __shfl_xor(be, o); if (ov > bv || (ov == bv && oe < be)) { bv = ov; be = oe; } }
                tv[k] = bv; te[k] = be; if (myexp == be) vv = -3.0e38f; }
            const float e1 = fexp(tv[1] - tv[0]), e2 = fexp(tv[2] - tv[0]), e3 = fexp(tv[3] - tv[0]); const float inv = 1.0f / (1.0f + e1 + e2 + e3);
            if (lane < 4 && ok[i]) { const int e = lane == 0 ? te[0] : (lane == 1 ? te[1] : (lane == 2 ? te[2] : te[3])); const float gv = (lane == 0 ? 1.0f : (lane == 1 ? e1 : (lane == 2 ? e2 : e3))) * inv;
                const unsigned rk = __hip_atomic_fetch_add(lcnt + e, 1u, __ATOMIC_RELAXED, __HIP_MEMORY_SCOPE_WORKGROUP);
                topi[(size_t)rr[i] * 4 + lane] = e; gate[(size_t)rr[i] * 4 + lane] = gv; pos[(size_t)rr[i] * 4 + lane] = (int)rk; }
        }
    }
    __syncthreads();
    if (F.tid < NEXP) lcnt[32 + F.tid] = __hip_atomic_fetch_add(cnt + F.tid, lcnt[F.tid], __ATOMIC_RELAXED, __HIP_MEMORY_SCOPE_AGENT);
    __syncthreads();
    for (int r = gw; r < nr; r += NGW) if (lane < 4) pos[(size_t)r * 4 + lane] += (int)lcnt[32 + topi[(size_t)r * 4 + lane]];
}
__device__ __forceinline__ int moe_table(const Frame& F, int layer, int mb) {
    LAS int* M = (LAS int*)(F.lds + MISC_OFF);
    __syncthreads();
    if (F.tid == 0) { unsigned* cnt = F.ctl + CW_CNT + (mb * DEPTH + layer) * 64; int acc = 0;
        for (int e = 0; e < NEXP; ++e) { const int c = (int)__hip_atomic_load(cnt + e, __ATOMIC_RELAXED, __HIP_MEMORY_SCOPE_AGENT); M[64 + e] = acc * 256; acc += (c + 255) / 256; M[16 + e] = acc; } }
    __syncthreads();
    return M[16 + NEXP - 1];
}
__device__ __forceinline__ void step_gather(const Frame& F, int layer, int mb) {
    (void)moe_table(F, layer, mb); const LAS int* M = (const LAS int*)(F.lds + MISC_OFF);
    const int nr = rows_of(mb);
    const int* topi = (const int*)(F.ws + WS_TOPI); const float* gate = ws_f(F, WS_GATE); int* pos = (int*)(F.ws + WS_POS); float* gs = ws_f(F, WS_GSORT); int* rtok = (int*)(F.ws + WS_RTOK);
    for (int i = F.bid * NTHREADS + F.tid; i < nr * 4; i += F.G * NTHREADS) { const int p = M[64 + topi[i]] + pos[i]; pos[i] = p; rtok[p] = i >> 2; gs[p] = gate[i]; }
}
__device__ __forceinline__ void step_ln2(const Frame& F, int layer, int mb) {
    const int gw = F.bid * NWAVES + F.wave, NGW = F.G * NWAVES, nr = rows_of(mb), lane = F.lane;
    const float* lg = F.in[I_LN2G] + (size_t)layer * D; const float* lb = F.in[I_LN2B] + (size_t)layer * D;
    const bf16_t* OUTS = ws_bf(F, WS_H) + (size_t)2 * RP * D; const int* pos = (const int*)(F.ws + WS_POS); bf16_t* XB = ws_bf(F, WS_XB);
    constexpr int RB = 2;
    for (int r0 = gw; r0 < nr; r0 += RB * NGW) {
        f32x4 v[RB][4]; u32x2 ow[RB][4][4]; int rr[RB];
#pragma unroll
        for (int i = 0; i < RB; ++i) { rr[i] = r0 + i * NGW < nr ? r0 + i * NGW : r0; const float* xr = x_out_row(F, mb, rr[i]); int p[4];
#pragma unroll
            for (int k = 0; k < 4; ++k) p[k] = pos[(size_t)rr[i] * 4 + k];
#pragma unroll
            for (int j = 0; j < 4; ++j) { v[i][j] = *((const f32x4*)xr + lane + 64 * j);
#pragma unroll
                for (int k = 0; k < 4; ++k) ow[i][k][j] = *((const u32x2*)(OUTS + (size_t)p[k] * D) + lane + 64 * j); } }
        asm volatile("" ::: "memory");
#pragma unroll
        for (int i = 0; i < RB; ++i) { if (r0 + i * NGW >= nr) continue;
            float* xr = x_out_row(F, mb, rr[i]); float s = 0.f;
#pragma unroll
            for (int j = 0; j < 4; ++j) { v[i][j] = v[i][j] * ALPHA;
#pragma unroll
                for (int k = 0; k < 4; ++k) { const u32x2 w = ow[i][k][j]; v[i][j] = v[i][j] + (f32x4){blo(w.x), bhi(w.x), blo(w.y), bhi(w.y)}; }
                s += (v[i][j][0] + v[i][j][1]) + (v[i][j][2] + v[i][j][3]); }
            const float mean = wave_sum(s) * (1.0f / D); float s2 = 0.f;
#pragma unroll
            for (int j = 0; j < 4; ++j) { v[i][j] = v[i][j] - mean; s2 += (v[i][j][0] * v[i][j][0] + v[i][j][1] * v[i][j][1]) + (v[i][j][2] * v[i][j][2] + v[i][j][3] * v[i][j][3]); }
            const float rstd = 1.0f / sqrtf(wave_sum(s2) * (1.0f / D) + LN_EPS);
#pragma unroll
            for (int j = 0; j < 4; ++j) { const f32x4 gg = *((const f32x4*)lg + lane + 64 * j), bb = *((const f32x4*)lb + lane + 64 * j); v[i][j] = v[i][j] * rstd * gg + bb;
                *((f32x4*)xr + lane + 64 * j) = v[i][j]; u32x2 w; w.x = pk2(v[i][j][0], v[i][j][1]); w.y = pk2(v[i][j][2], v[i][j][3]); *((u32x2*)(XB + (size_t)rr[i] * D) + lane + 64 * j) = w; } }
    }
}

constexpr int PH_PER = 11, NSTEPS = 1 + NMB * (DEPTH * (PH_PER - 1) + 1);
__global__ void __launch_bounds__(NTHREADS, 2) fwd(Args args) {
#ifdef EMU
    unsigned char* lds = emu_wg->lds;
#else
    extern __shared__ __attribute__((aligned(16))) unsigned char lds[];
#endif
    Frame F0; F0.lds = (LAS unsigned char*)lds; F0.tid = threadIdx.x; F0.lane = F0.tid & 63; F0.wave = __builtin_amdgcn_readfirstlane(F0.tid >> 6); F0.G = gridDim.x; F0.bid = blockIdx.x;
#ifdef EMU
    F0.in = args.in;
#else
    F0.in = (ArgTab)__builtin_amdgcn_kernarg_segment_ptr();
    static_assert(offsetof(Args, out) == 248 && offsetof(Args, ws) == 256 && offsetof(Args, in) == 0, "PF() reads the argument struct by offset");
#endif
    F0.out = args.out; F0.ws = args.ws; F0.ctl = (unsigned*)(args.ws + WS_CTL);
    const Frame& F = F0;
    const int lo = args.lo, hi = args.hi;
#ifndef EMU
    for (int u = F.tid; u < (LDS_BYTES - MISC_OFF) / 4; u += NTHREADS) ((LAS unsigned*)(F.lds + MISC_OFF))[u] = 0u;
    __syncthreads();
    XcdBarrier bar; bar.bar = F.ctl + CW_BAR; bar.x = 0; bar.st = nullptr;
    if (hi - lo > 1) bar = xcd_barrier_post(F.ctl + CW_BAR, (volatile LAS unsigned*)(F.lds + MISC_OFF) + 8);
#define SEAM(s) do { if ((s) + 1 < hi) { XcdBarrier b2_ = bar; unsigned long long bp_ = (unsigned long long)b2_.bar; asm volatile("" : "+s"(bp_)); b2_.bar = (unsigned*)bp_; xcd_barrier(b2_); } } while (0)
#else
#define SEAM(s) do { } while (0)
#endif
#ifndef PH_MASK
#define PH_MASK 0xFFFFFFFF
#endif
#define IN(s) (lo <= (s) && (s) < hi)
#define PHON(b) ((PH_MASK >> (b)) & 1)
#ifdef EMU
#define PF(Fp) Frame Fp = F0
#else
#define PF(Fp) Frame Fp; { unsigned long long kp_ = (unsigned long long)__builtin_amdgcn_kernarg_segment_ptr(); asm volatile("" : "+s"(kp_)); \
    Fp.in = (ArgTab)kp_; Fp.out = *(float* const __attribute__((address_space(4)))*)(kp_ + 248); Fp.ws = *(unsigned char* const __attribute__((address_space(4)))*)(kp_ + 256); Fp.ctl = (unsigned*)Fp.ws; \
    Fp.lds = F0.lds; Fp.G = F0.G; Fp.bid = F0.bid; Fp.wave = F0.wave; Fp.lane = opq(lane_id()); Fp.tid = Fp.wave * 64 + Fp.lane; }
#endif
    int step = 0;
    if (IN(step)) { PROBE_T0(0) if constexpr (PHON(0)) { PF(F); step_weights(F); } PROBE_T1(0) SEAM(step); }
    ++step;
#define PHV const int mb = opqs(mb0), layer = opqs(layer0), nr = rows_of(mb); (void)nr; (void)layer
    for (int mb0 = 0; mb0 < NMB; ++mb0)
        for (int layer0 = 0; layer0 < DEPTH; ++layer0) {
            if (layer0 == 0) { if (IN(step)) { PROBE_T0(1) if constexpr (PHON(1)) { PF(F); PHV; step_xb(F, mb); } PROBE_T1(1) SEAM(step); }
                ++step; }
            if (IN(step)) { PROBE_T0(2) if constexpr (PHON(2)) { PF(F); PHV; pg8::Gemm g{ws_bf(F, WS_XB), wl_ptr(F, layer, WL_IN), nr, DINP, D, D, nullptr}; pg8::StaticOrder S; S.init(nr, DINP, F.G, F.bid);
                pg8::EpiStoreBf16 E{ws_bf(F, WS_H), DINP}; pg8::gemm_phase(F.lds, g, S, E); } PROBE_T1(2) SEAM(step); }
            ++step;
            if (IN(step)) { PROBE_T0(3) if constexpr (PHON(3)) { PF(F); PHV; step_mixers(F, layer, mb); } PROBE_T1(3) SEAM(step); }
            ++step;
            if (IN(step)) { PROBE_T0(4) if constexpr (PHON(4)) { PF(F); PHV; step_gnorm(F, mb); } PROBE_T1(4) SEAM(step); }
            ++step;
            if (IN(step)) { PROBE_T0(5) if constexpr (PHON(5)) { PF(F); PHV; pg8::StaticOrder S; S.init(nr, D, F.G, F.bid); bf16_t* H = ws_bf(F, WS_H); bf16_t* MGb = ws_bf(F, WS_XB);
#ifndef MERGE_MASK
#define MERGE_MASK 7
#endif
                if constexpr (MERGE_MASK & 1) { pg8::Gemm g{H + C_Z, wl_ptr(F, layer, WL_SSD), nr, D, DINNER, DINP, nullptr}; pg8::EpiGate<0> E{H + C_GSSD, MGb}; pg8::gemm_phase(F.lds, g, S, E); }
                if constexpr (MERGE_MASK & 2) { pg8::Gemm g{H + C_Q, wl_ptr(F, layer, WL_ATT), nr, D, D, DINP, nullptr}; pg8::EpiGate<1> E{H + C_GATT, MGb}; pg8::gemm_phase(F.lds, g, S, E); }
                if constexpr (MERGE_MASK & 4) { pg8::Gemm g{H + C_SCB, wl_ptr(F, layer, WL_SC), nr, D, D, DINP, nullptr}; pg8::EpiGate<1> E{H + C_GSC, MGb}; pg8::gemm_phase(F.lds, g, S, E); } }
                PROBE_T1(5) SEAM(step); }
            ++step;
            if (IN(step)) { PROBE_T0(6) if constexpr (PHON(6)) { PF(F); PHV; pg8::Gemm g{ws_bf(F, WS_XB), wl_ptr(F, layer, WL_O), nr, D, D, D, nullptr}; pg8::StaticOrder S; S.init(nr, D, F.G, F.bid);
                pg8::EpiResid E{layer == 0 ? F.in[I_XP] + (size_t)mb * NP * D : F.out + O_YP + (size_t)mb * NP * D, layer == 0 ? F.in[I_XS] : F.out + O_YS, F.out + O_YP + (size_t)mb * NP * D, F.out + O_YS};
                pg8::gemm_phase(F.lds, g, S, E); } PROBE_T1(6) SEAM(step); }
            ++step;
            if (IN(step)) { PROBE_T0(7) if constexpr (PHON(7)) { PF(F); PHV; step_ln1_router(F, layer, mb); } PROBE_T1(7) SEAM(step); }
            ++step;
            if (IN(step)) { PROBE_T0(8) if constexpr (PHON(8)) { PF(F); PHV; step_gather(F, layer, mb); } PROBE_T1(8) SEAM(step); }
            ++step;
            if (IN(step)) { PROBE_T0(9) if constexpr (PHON(9)) { PF(F); PHV; const int nt = moe_table(F, layer, mb); pg8::MoeOrder S{(const LAS int*)(F.lds + MISC_OFF) + 16, 8, nt * 8, F.G, F.bid};
                pg8::Gemm g{ws_bf(F, WS_XB), wl_ptr(F, layer, WL_UP), nt * 256, 2048, D, D, (const int*)(F.ws + WS_RTOK)}; pg8::EpiSwiglu E{ws_bf(F, WS_H) + (size_t)RP * D, F.in[I_BUP] + (size_t)layer * NEXP * 2048};
                pg8::gemm_phase<pg8::EpiSwiglu, pg8::MoeOrder, true>(F.lds, g, S, E); } PROBE_T1(9) SEAM(step); }
            ++step;
            if (IN(step)) { PROBE_T0(10) if constexpr (PHON(10)) { PF(F); PHV; const int nt = moe_table(F, layer, mb); pg8::MoeOrder S{(const LAS int*)(F.lds + MISC_OFF) + 16, 4, nt * 4, F.G, F.bid};
                pg8::Gemm g{ws_bf(F, WS_H) + (size_t)RP * D, wl_ptr(F, layer, WL_DN), nt * 256, D, D, D, nullptr}; pg8::EpiDown E{ws_bf(F, WS_H) + (size_t)2 * RP * D, F.in[I_BDN] + (size_t)layer * NEXP * D, ws_f(F, WS_GSORT)};
                pg8::gemm_phase(F.lds, g, S, E); } PROBE_T1(10) SEAM(step); }
            ++step;
            if (IN(step)) { PROBE_T0(11) if constexpr (PHON(11)) { PF(F); PHV; step_ln2(F, layer, mb); } PROBE_T1(11) SEAM(step); }
            ++step;
        }
}

#ifdef EMU
extern int emu_grid, emu_step_lo, emu_step_hi;
#endif
extern "C" void kernel_launch(void* const* d_in, const int* in_sizes, int n_in, void* d_out, int out_size, void* d_ws, size_t ws_size, hipStream_t stream) {
    (void)in_sizes; (void)out_size;
    if (n_in != 31 || ws_size < WS_END) { fprintf(stderr, "kernel_launch: expected 31 inputs and >= %zu bytes of workspace (got %d, %zu)\n", (size_t)WS_END, n_in, ws_size); return; }
    Args a; memset(&a, 0, sizeof(a));
    for (int i = 0; i < 31; ++i) a.in[i] = (const float*)d_in[i];
    a.out = (float*)d_out; a.ws = (unsigned char*)d_ws;
#ifdef EMU
    if (emu_step_lo == 0) memset((char*)d_ws + WS_CTL, 0, CTL_BYTES);
    for (int s = emu_step_lo; s < emu_step_hi && s < NSTEPS; ++s) { a.lo = s; a.hi = s + 1; emu_launch(fwd, emu_grid, NTHREADS, LDS_BYTES, a); fprintf(stderr, "step %d done\n", s); }
#else
    (void)hipMemsetAsync((char*)d_ws + WS_CTL, 0, CTL_BYTES, stream);
    static int grid = 0;
    if (grid == 0) {
        int dev = 0, cus = 0;
        if (hipGetDevice(&dev) != hipSuccess || hipDeviceGetAttribute(&cus, hipDeviceAttributeMultiprocessorCount, dev) != hipSuccess) { grid = -1; return; }
        if (hipFuncSetAttribute((const void*)fwd, hipFuncAttributeMaxDynamicSharedMemorySize, LDS_BYTES) != hipSuccess) { grid = -1; return; }
        int per_cu = 0; (void)hipOccupancyMaxActiveBlocksPerMultiprocessor(&per_cu, (const void*)fwd, NTHREADS, LDS_BYTES); (void)hipGetLastError();
        grid = cus;
    }
    if (grid < 0) return;
#if CFG_ONE_LAUNCH
    a.lo = 0; a.hi = NSTEPS; hipLaunchKernelGGL(fwd, dim3(grid), dim3(NTHREADS), LDS_BYTES, stream, a);
#else
    for (int s = 0; s < NSTEPS; ++s) { a.lo = s; a.hi = s + 1; hipLaunchKernelGGL(fwd, dim3(grid), dim3(NTHREADS), LDS_BYTES, stream, a); }
#endif
#endif
}
```

```cpp
#ifdef EMU
#include "emu.h"
#else
#include <hip/hip_runtime.h>
#endif
#include <cstdio>
#include <cstdint>
#include <cstring>
#include <cstddef>
#include <cmath>

#ifndef CFG_BATCH
#define CFG_BATCH 16
#endif
#ifndef CFG_SEQ
#define CFG_SEQ 4096
#endif
#ifndef CFG_NSEQ_MB
#define CFG_NSEQ_MB 8
#endif
#ifndef CFG_NEXP
#define CFG_NEXP 32
#endif
#ifndef CFG_ONE_LAUNCH
#define CFG_ONE_LAUNCH 1
#endif

constexpr int BATCH = CFG_BATCH, SEQ = CFG_SEQ, NSEQ_MB = CFG_NSEQ_MB, NEXP = CFG_NEXP, NMB = BATCH / NSEQ_MB;
constexpr int D = 1024, DEPTH = 2, DECB = 16, DECS = 16, NS = DECB * DECS;
constexpr int DINNER = 2048, CONVDIM = 4096;
constexpr int NKV = 4, WINDOW = 128, CHUNK = 64;
constexpr int DIN = 13856, DINP = 14080;
constexpr int NP = NSEQ_MB * SEQ, R = NP + NS;
constexpr int RP = ((4 * R + NEXP * 255) + 255) / 256 * 256;
constexpr int NCHUNK = SEQ / CHUNK;
constexpr int C_Z = 0, C_X = 2048, C_B = 4096, C_C = 5120, C_Q = 6144, C_K = 7168, C_V = 7424, C_SCB = 7680, C_SCC = 8704, C_SCH = 9728, C_GSSD = 10752, C_GATT = 11776, C_GSC = 12800, C_DT = 13824;
constexpr float LN_EPS = 1e-5f, ALPHA = 1.41421356237309515f  , SW_LIMIT = 7.0f, SW_ALPHA = 1.702f;
static_assert(BATCH % NSEQ_MB == 0 && SEQ % 256 == 0 && (NEXP & (NEXP - 1)) == 0 && NEXP <= 32 && NEXP >= 4, "config");

constexpr size_t O_YP = 0, O_YS = O_YP + (size_t)BATCH * SEQ * D, O_KP = O_YS + (size_t)NS * D, O_VP = O_KP + (size_t)DEPTH * BATCH * WINDOW * 256,
    O_SSP = O_VP + (size_t)DEPTH * BATCH * WINDOW * 256, O_CVP = O_SSP + (size_t)DEPTH * BATCH * 32 * 64 * 128, O_SCP = O_CVP + (size_t)DEPTH * BATCH * 3 * CONVDIM,
    O_KS = O_SCP + (size_t)DEPTH * BATCH * 2 * D, O_VS = O_KS + (size_t)DEPTH * DECB * DECS * 256, O_SSS = O_VS + (size_t)DEPTH * DECB * DECS * 256,
    O_CVS = O_SSS + (size_t)DEPTH * DECB * 32 * 64 * 128, O_SCS = O_CVS + (size_t)DEPTH * DECB * 3 * CONVDIM, O_END = O_SCS + (size_t)DEPTH * DECB * 2 * D;

constexpr size_t al256(size_t x) { return (x + 255) / 256 * 256; }
constexpr size_t WS_CTL = 0, CTL_BYTES = 1u << 20;
constexpr size_t WS_SSQ = CTL_BYTES, WS_TOPI = WS_SSQ + al256((size_t)R * 64 * 4), WS_GATE = WS_TOPI + al256((size_t)R * 16), WS_POS = WS_GATE + al256((size_t)R * 16),
    WS_GSORT = WS_POS + al256((size_t)R * 16), WS_RTOK = WS_GSORT + al256((size_t)RP * 4), WS_W = WS_RTOK + al256((size_t)RP * 4);
constexpr size_t WL_IN = 0, WL_SSD = WL_IN + (size_t)DINP * D * 2, WL_ATT = WL_SSD + (size_t)D * DINNER * 2, WL_SC = WL_ATT + (size_t)D * D * 2, WL_O = WL_SC + (size_t)D * D * 2,
    WL_UP = WL_O + (size_t)D * D * 2, WL_DN = WL_UP + (size_t)NEXP * 2048 * D * 2, WL_BYTES = WL_DN + (size_t)NEXP * D * D * 2;
constexpr size_t WS_XB = WS_W + DEPTH * WL_BYTES, WS_XB0 = WS_XB + (size_t)R * D * 2  , WS_H = WS_XB0 + (size_t)NMB * R * D * 2;
constexpr size_t H_BYTES = (size_t)R * DINP * 2, MOE_BYTES = (size_t)3 * RP * D * 2, U_BYTES = H_BYTES > MOE_BYTES ? H_BYTES : MOE_BYTES;
constexpr size_t WS_CMC = WS_H + U_BYTES, WS_BTG = WS_CMC + (size_t)NP * 1024 * 2, WS_CBG = WS_BTG + (size_t)NSEQ_MB * NCHUNK * 8 * 8192 * 2, WS_END = WS_CBG + (size_t)NSEQ_MB * NCHUNK * 8 * 4096 * 2;
static_assert(WS_END <= ((size_t)2 << 30), "workspace map exceeds 2 GiB");
constexpr int CW_BAR = 4096, CW_CNT = 16384;

constexpr int RING_BYTES = 131072, LDS_BYTES = 163840  , MISC_OFF = LDS_BYTES - 1024, SCR_BYTES = MISC_OFF;
constexpr int NWAVES = 8, NTHREADS = 512;

#ifdef EMU
#define LAS
#define WAVE_SYNC() emu_wave_barrier()
#else
#define LAS __attribute__((address_space(3)))
#define WAVE_SYNC() asm volatile("s_waitcnt lgkmcnt(0)" ::: "memory")
#endif
#ifdef EMU
#define LBAR() emu_wg_barrier()
#define VM_WAIT(n) do { } while (0)
#else
#define LBAR() do { asm volatile("s_waitcnt lgkmcnt(0)" ::: "memory"); __builtin_amdgcn_s_barrier(); asm volatile("" ::: "memory"); } while (0)
#define VM_WAIT(n) asm volatile("s_waitcnt vmcnt(" #n ")" ::: "memory")
#endif
typedef unsigned short bf16_t;
typedef short bf16x8 __attribute__((ext_vector_type(8)));
typedef float f32x4 __attribute__((ext_vector_type(4)));
typedef float f32x16 __attribute__((ext_vector_type(16)));
typedef unsigned u32x4 __attribute__((ext_vector_type(4)));
typedef unsigned u32x2 __attribute__((ext_vector_type(2)));

__device__ __forceinline__ unsigned f2bf(float f) { unsigned u = __builtin_bit_cast(unsigned, f); return (u + 0x7fffu + ((u >> 16) & 1u)) >> 16; }
__device__ __forceinline__ float bf2f(unsigned h) { return __builtin_bit_cast(float, (h & 0xffffu) << 16); }
#ifdef EMU
__device__ __forceinline__ unsigned pk2(float lo, float hi) { return f2bf(lo) | (f2bf(hi) << 16); }
#else
typedef float f32x2_t __attribute__((ext_vector_type(2))); typedef __bf16 bf16x2_t __attribute__((ext_vector_type(2)));
__device__ __forceinline__ unsigned pk2(float lo, float hi) { f32x2_t v = {lo, hi}; bf16x2_t b = __builtin_convertvector(v, bf16x2_t); return __builtin_bit_cast(unsigned, b); }
#endif
#ifdef EMU
__device__ __forceinline__ unsigned short bf1(float f) { return (unsigned short)f2bf(f); }
#else
__device__ __forceinline__ unsigned short bf1(float f) { return (unsigned short)pk2(f, f); }
#endif
__device__ __forceinline__ float blo(unsigned w) { return __builtin_bit_cast(float, w << 16); }
__device__ __forceinline__ float bhi(unsigned w) { return __builtin_bit_cast(float, w & 0xffff0000u); }
__device__ __forceinline__ void unpack8(const u32x4 w, float* f) { f[0] = blo(w.x); f[1] = bhi(w.x); f[2] = blo(w.y); f[3] = bhi(w.y); f[4] = blo(w.z); f[5] = bhi(w.z); f[6] = blo(w.w); f[7] = bhi(w.w); }
__device__ __forceinline__ u32x4 pack8(const float* f) { u32x4 w; w.x = pk2(f[0], f[1]); w.y = pk2(f[2], f[3]); w.z = pk2(f[4], f[5]); w.w = pk2(f[6], f[7]); return w; }
__device__ __forceinline__ float fexp(float x) { return __builtin_amdgcn_exp2f(x * 1.4426950408889634f); }
__device__ __forceinline__ float fsigmoid(float x) { return __builtin_amdgcn_rcpf(1.0f + __builtin_amdgcn_exp2f(-1.4426950408889634f * x)); }
__device__ __forceinline__ float fsilu(float x) { return x * fsigmoid(x); }
#ifdef EMU
__device__ __forceinline__ int opq(int x) { return x; }
#else
__device__ __forceinline__ int opq(int x) { asm volatile("" : "+v"(x)); return x; }
#endif
#ifdef EMU
__device__ __forceinline__ int opqs(int x) { return x; }
#else
__device__ __forceinline__ int opqs(int x) { asm volatile("" : "+s"(x)); return x; }
#endif
#ifdef EMU
__device__ __forceinline__ int lane_id() { return (int)(threadIdx.x & 63); }
#else
__device__ __forceinline__ int lane_id() { return (int)__builtin_amdgcn_mbcnt_hi(~0u, __builtin_amdgcn_mbcnt_lo(~0u, 0u)); }
#endif
#ifdef EMU
template <int MASK> __device__ __forceinline__ unsigned xshfl_u(unsigned x) { return __shfl_xor(x, MASK); }
#else
template <int MASK> __device__ __forceinline__ unsigned xshfl_u(unsigned x) {
    if constexpr (MASK == 1) return (unsigned)__builtin_amdgcn_update_dpp((int)x, (int)x, 0xB1, 0xF, 0xF, false);
    else if constexpr (MASK == 2) return (unsigned)__builtin_amdgcn_update_dpp((int)x, (int)x, 0x4E, 0xF, 0xF, false);
    else if constexpr (MASK == 4) { const int t = __builtin_amdgcn_update_dpp((int)x, (int)x, 0x114, 0xF, 0xA, false);
        return (unsigned)__builtin_amdgcn_update_dpp(t, (int)x, 0x104, 0xF, 0x5, false); }
    else if constexpr (MASK == 8) return (unsigned)__builtin_amdgcn_update_dpp((int)x, (int)x, 0x128, 0xF, 0xF, false);
    else if constexpr (MASK == 16) { const auto rr = __builtin_amdgcn_permlane16_swap(x, x, false, false); return (lane_id() & 16) ? rr[0] : rr[1]; }
    else { const auto rr = __builtin_amdgcn_permlane32_swap(x, x, false, false); return (lane_id() & 32) ? rr[0] : rr[1]; }
}
#endif
template <int MASK> __device__ __forceinline__ float xshfl(float x) { return __builtin_bit_cast(float, xshfl_u<MASK>(__builtin_bit_cast(unsigned, x))); }
template <int MASK> __device__ __forceinline__ int xshfl(int x) { return (int)xshfl_u<MASK>((unsigned)x); }
__device__ __forceinline__ float wave_sum(float v) { v += xshfl<1>(v); v += xshfl<2>(v); v += xshfl<4>(v); v += xshfl<8>(v); v += xshfl<16>(v); v += xshfl<32>(v); return v; }

#ifndef PROBE_MASK
#define PROBE_MASK 0
#endif
#if PROBE_MASK && !defined(EMU)
#define PROBE_T0(b) unsigned long long pt0_ = 0; if constexpr ((PROBE_MASK >> (b)) & 1) pt0_ = __builtin_amdgcn_s_memrealtime();
#define PROBE_T1(b) if constexpr ((PROBE_MASK >> (b)) & 1) { asm volatile("s_waitcnt vmcnt(0) lgkmcnt(0)" ::: "memory"); const unsigned long long pt1_ = __builtin_amdgcn_s_memrealtime(); \
    while (__builtin_amdgcn_s_memrealtime() < pt1_ + (pt1_ - pt0_)) __builtin_amdgcn_s_sleep(8); }
#else
#define PROBE_T0(b)
#define PROBE_T1(b)
#endif
namespace pg8 {
constexpr int BM = 256, BK = 64, HALF = 128, HTB = HALF * BK * 2, NXCD = 8, WGM = 8;
struct Unit { int pm, pn, bt, e; };
struct Gemm { const bf16_t* A; const bf16_t* Bt; int M, N, K, lda; const int* tok; };
struct StaticOrder {
    int nM, nN, nwg, G, c;
    __host__ __device__ void init(int M, int N, int G_, int c_) { nM = M / BM; nN = N / BM; nwg = nM * nN; G = G_; c = c_; }
    __host__ __device__ bool next(int i, Unit& u) const {
        const long L = (long)i * G + c; if (L >= nwg) return false;
        int wgid = (int)L; { const int q = nwg / NXCD, r = nwg % NXCD, xcd = wgid % NXCD, off = wgid / NXCD; wgid = (xcd < r ? xcd * (q + 1) : r * (q + 1) + (xcd - r) * q) + off; }
        const int nig = WGM * nN, gid = wgid / nig, fm = gid * WGM, gsz = (nM - fm) < WGM ? (nM - fm) : WGM;
        u.pm = fm + ((wgid % nig) % gsz); u.pn = (wgid % nig) / gsz; u.bt = u.pn; u.e = 0; return true;
    }
    __device__ __forceinline__ void a_ready(const Unit&) const {}
    __device__ __forceinline__ void done(const Unit&) const {}
};
struct MoeOrder {
    const LAS int* tend; int npn, ntot, G, c;
    __device__ __forceinline__ bool next(int i, Unit& u) const {
        const long L = (long)i * G + c; if (L >= ntot) return false;
        const int rt = (int)L / npn, pn = (int)L % npn; int e = 0;
#pragma unroll
        for (int j = 0; j < NEXP; ++j) e += (tend[j] <= rt) ? 1 : 0;
        u.pm = rt; u.pn = pn; u.e = e; u.bt = e * npn + pn; return true;
    }
    __device__ __forceinline__ void a_ready(const Unit&) const {}
    __device__ __forceinline__ void done(const Unit&) const {}
};
#ifdef EMU
template <class Epi, class Sched, bool GATHER = false>
__device__ void gemm_phase(LAS unsigned char* lds, const Gemm g, const Sched& S, const Epi& E, int  ) {
    const int tid = threadIdx.x, wid = tid >> 6, lane = tid & 63, wr = wid >> 2, wc = wid & 3, fr = lane & 15, fq = lane >> 4;
    Unit u;
    for (int i = 0; S.next(i, u); ++i) {
        f32x4 acc[2][2][4][2];
        for (int ai = 0; ai < 2; ++ai) for (int bj = 0; bj < 2; ++bj) for (int m = 0; m < 4; ++m) for (int n = 0; n < 2; ++n) for (int q = 0; q < 4; ++q) {
            const int row = u.pm * 256 + ai * 128 + wr * 64 + m * 16 + fr, col = u.bt * 256 + bj * 128 + wc * 32 + 8 * fq + 4 * n + q;
            const bf16_t* a = g.A + (size_t)(GATHER ? ((unsigned)g.tok[row] < (unsigned)g.M ? g.tok[row] : 0) : row) * g.lda; const bf16_t* b = g.Bt + (size_t)col * g.K; float s = 0.f;
            for (int k = 0; k < g.K; ++k) s += bf2f(a[k]) * bf2f(b[k]);
            acc[ai][bj][m][n][q] = s; }
        E(acc, u, wr, wc, fr, fq);
    }
    __syncthreads();
}
#else
#define PG8_LAS __attribute__((address_space(3)))
__host__ __device__ __forceinline__ int lds_byte(int r, int c) { const int st = (r >> 4) * 2 + (c >> 5), rr = r & 15, cc = c & 31, ob = rr * 64 + cc * 2; return st * 1024 + (ob ^ (((ob >> 9) & 1) << 5)); }
__host__ __device__ __forceinline__ void stage_rc(int b, int& R_, int& C_) { const int st = b / 1024, sb = b % 1024, swz = sb ^ (((sb >> 9) & 1) << 5); R_ = (st >> 1) * 16 + swz / 64; C_ = (st & 1) * 32 + (swz % 64) / 2; }
__host__ __device__ __forceinline__ int perm32(int rho) { const int n = rho >> 4, i = rho & 15; return 8 * (i >> 2) + 4 * n + (i & 3); }
template <class Epi, class Sched, bool GATHER = false>
__device__ __forceinline__ void gemm_phase(PG8_LAS unsigned char* lds, const Gemm g, const Sched& S, const Epi& E, int wave_id) {
    const int lane = opq(lane_id()), wid = __builtin_amdgcn_readfirstlane(wave_id), tid = wid * 64 + lane, wr = wid >> 2, wc = wid & 3, fr = lane & 15, fq = lane >> 4;
    const int K = g.K, nt = K / BK, lda = g.lda;
    unsigned voffA[2], voffB[2];
#pragma unroll
    for (int i = 0; i < 2; ++i) { int R_, C_; stage_rc(tid * 16 + i * 8192, R_, C_); const int Rb = (R_ & ~31) + perm32(R_ & 31);
        voffA[i] = (unsigned)(R_ * lda + C_) * 2u; voffB[i] = (unsigned)(Rb * K + C_) * 2u; }
    unsigned vG[2][2], vN[2][2];
#define PG8_TOK(dst, pm_) do { _Pragma("unroll") for (int i_ = 0; i_ < 2; ++i_) { int R_, C_; stage_rc(opq(tid) * 16 + i_ * 8192, R_, C_); _Pragma("unroll") for (int h_ = 0; h_ < 2; ++h_) \
        { unsigned tk_ = (unsigned)g.tok[(pm_) * 256 + h_ * 128 + R_]; tk_ = tk_ < (unsigned)g.M ? tk_ : 0u; dst[h_][i_] = tk_ * (unsigned)(lda * 2) + (unsigned)(C_ * 2); } } } while (0)
#define PG8_STAGE_A(bufoff, base_, h_, nx_) do { if constexpr (GATHER) { unsigned vs_[2] = {(nx_) ? vN[h_][0] : vG[h_][0], (nx_) ? vN[h_][1] : vG[h_][1]}; PG8_STAGE(bufoff, base_, vs_); } \
        else { PG8_STAGE(bufoff, (base_) + ((h_) ? hstepA : 0), voffA); } } while (0)
    const size_t kstep = (size_t)(BK * 2);
    const size_t hstepA = (size_t)HALF * lda * 2, tstepA = 2 * hstepA;
    const size_t hstepB = (size_t)HALF * K * 2, tstepB = 2 * hstepB;
    const unsigned ldsw = (unsigned)wid * 1024u;
    const int aoff = lds_byte(wr * 64 + fr, fq * 8), boff = lds_byte(wc * 32 + fr, fq * 8);
#define PG8_SA(b, h) (((b) * 2 + (h)) * HTB)
#define PG8_SB(b, h) ((4 + (b) * 2 + (h)) * HTB)
#define PG8_STAGE(bufoff, gbase, voff) do { _Pragma("unroll") for (int _i = 0; _i < 2; ++_i) \
        __builtin_amdgcn_global_load_lds((const unsigned*)((const char*)(gbase) + (voff)[_i]), (PG8_LAS unsigned*)(lds + (bufoff) + ldsw + _i * 8192), 16, 0, 0); } while (0)
#define PG8_LDA(dst, b, h) do { _Pragma("unroll") for (int m = 0; m < 4; ++m) _Pragma("unroll") for (int k = 0; k < 2; ++k) dst[m][k] = *(const PG8_LAS bf16x8*)(lds + PG8_SA(b, h) + aoff + m * 2048 + k * 1024); } while (0)
#define PG8_LDB(dst, b, h) do { _Pragma("unroll") for (int n = 0; n < 2; ++n) _Pragma("unroll") for (int k = 0; k < 2; ++k) dst[n][k] = *(const PG8_LAS bf16x8*)(lds + PG8_SB(b, h) + boff + n * 2048 + k * 1024); } while (0)
#define PG8_MMA(ai, bj, At, Bt) do { __builtin_amdgcn_s_setprio(1); _Pragma("unroll") for (int m = 0; m < 4; ++m) _Pragma("unroll") for (int n = 0; n < 2; ++n) _Pragma("unroll") for (int k = 0; k < 2; ++k) \
        acc[ai][bj][m][n] = __builtin_amdgcn_mfma_f32_16x16x32_bf16(Bt[n][k], At[m][k], acc[ai][bj][m][n], 0, 0, 0); __builtin_amdgcn_s_setprio(0); } while (0)
#define PG8_WAIT_V(n) asm volatile("s_waitcnt vmcnt(" #n ")" ::: "memory")
#define PG8_WAIT_L(n) asm volatile("s_waitcnt lgkmcnt(" #n ")" ::: "memory")
#define PG8_BAR __builtin_amdgcn_s_barrier()
#define PG8_SCHED __builtin_amdgcn_sched_barrier(0)
    Unit cur, nxt; int ui = 0;
    if (!S.next(0, cur)) return;
    f32x4 acc[2][2][4][2];
#pragma unroll
    for (int a = 0; a < 2; ++a)
#pragma unroll
        for (int b = 0; b < 2; ++b)
#pragma unroll
            for (int m = 0; m < 4; ++m)
#pragma unroll
                for (int n = 0; n < 2; ++n) acc[a][b][m][n] = (f32x4){0.f, 0.f, 0.f, 0.f};
    bf16x8 At[4][2], B0[2][2], B1[2][2];
    const char* cA = (const char*)g.A + (GATHER ? (size_t)0 : (size_t)cur.pm * tstepA); const char* cB = (const char*)g.Bt + (size_t)cur.bt * tstepB;
    if constexpr (GATHER) { PG8_TOK(vG, cur.pm); }
    S.a_ready(cur);
    PG8_STAGE(PG8_SB(0, 0), cB, voffB); PG8_STAGE(PG8_SB(0, 1), cB + hstepB, voffB); PG8_STAGE_A(PG8_SA(0, 0), cA, 0, false); PG8_STAGE_A(PG8_SA(0, 1), cA, 1, false);
    if (wr == 1) PG8_BAR;
    PG8_WAIT_V(2); PG8_BAR;
    PG8_STAGE(PG8_SB(1, 0), cB + kstep, voffB); PG8_STAGE_A(PG8_SA(1, 0), cA + kstep, 0, false); PG8_STAGE(PG8_SB(1, 1), cB + hstepB + kstep, voffB);
    PG8_WAIT_V(6); PG8_BAR;
    for (;;) {
        const bool has_next = S.next(ui + 1, nxt);
        const char* nA = has_next ? (const char*)g.A + (GATHER ? (size_t)0 : (size_t)nxt.pm * tstepA) : cA; const char* nB = has_next ? (const char*)g.Bt + (size_t)nxt.bt * tstepB : cB;
        if constexpr (GATHER) {
#pragma unroll
            for (int h_ = 0; h_ < 2; ++h_) { vN[h_][0] = vG[h_][0]; vN[h_][1] = vG[h_][1]; }
            if (has_next) {
#pragma unroll
                for (int i_ = 0; i_ < 2; ++i_) { int R_, C_; stage_rc(opq(tid) * 16 + i_ * 8192, R_, C_);
#pragma unroll
                    for (int h_ = 0; h_ < 2; ++h_) { const int* tp_ = g.tok + nxt.pm * 256 + h_ * 128 + R_;
                        asm volatile("global_load_dword %0, %1, off" : "=v"(vN[h_][i_]) : "v"(tp_) : "memory"); } } } }
        for (int t = 0; t < nt; t += 2) {
            const bool last = (t == nt - 2);
            const char* a1 = cA + (size_t)(t + 1) * kstep;
            const char* a2 = last ? nA : cA + (size_t)(t + 2) * kstep; const char* b2 = last ? nB : cB + (size_t)(t + 2) * kstep;
            const char* a3 = a2 + kstep; const char* b3 = b2 + kstep;
            if (last && has_next) S.a_ready(nxt);
            if constexpr (GATHER) { if (last && has_next) {
#pragma unroll
                for (int i_ = 0; i_ < 2; ++i_) { int R_, C_; stage_rc(opq(tid) * 16 + i_ * 8192, R_, C_);
#pragma unroll
                    for (int h_ = 0; h_ < 2; ++h_) { unsigned tk_ = vN[h_][i_]; asm volatile("" : "+v"(tk_)); tk_ = tk_ < (unsigned)g.M ? tk_ : 0u; vN[h_][i_] = tk_ * (unsigned)(lda * 2) + (unsigned)(C_ * 2); } } } }
            PG8_LDB(B0, 0, 0); PG8_LDB(B1, 0, 1); PG8_SCHED; PG8_LDA(At, 0, 0); PG8_STAGE_A(PG8_SA(1, 1), a1, 1, false);
            PG8_WAIT_V(8); PG8_WAIT_L(0); PG8_BAR; PG8_MMA(0, 0, At, B0); PG8_MMA(0, 1, At, B1); PG8_BAR; PG8_SCHED;
            PG8_LDA(At, 0, 1); PG8_STAGE(PG8_SB(0, 0), b2, voffB); PG8_STAGE(PG8_SB(0, 1), b2 + hstepB, voffB); PG8_STAGE_A(PG8_SA(0, 0), a2, 0, last);
            PG8_WAIT_V(8); PG8_WAIT_L(0); PG8_BAR; PG8_MMA(1, 0, At, B0); PG8_MMA(1, 1, At, B1); PG8_BAR; PG8_SCHED;
            PG8_LDB(B0, 1, 0); PG8_LDB(B1, 1, 1); PG8_SCHED; PG8_LDA(At, 1, 0); PG8_STAGE_A(PG8_SA(0, 1), a2, 1, last);
            PG8_WAIT_V(8); PG8_WAIT_L(0); PG8_BAR; PG8_MMA(0, 0, At, B0); PG8_MMA(0, 1, At, B1); PG8_BAR; PG8_SCHED;
            PG8_LDA(At, 1, 1); PG8_STAGE(PG8_SB(1, 0), b3, voffB); PG8_STAGE(PG8_SB(1, 1), b3 + hstepB, voffB); PG8_STAGE_A(PG8_SA(1, 0), a3, 0, last);
            PG8_WAIT_V(8); PG8_WAIT_L(0); PG8_BAR; PG8_MMA(1, 0, At, B0); PG8_MMA(1, 1, At, B1); PG8_BAR; PG8_SCHED;
        }
        if (wr == 0) PG8_BAR;
        E(acc, cur, wr, wc, fr, fq); S.done(cur);
        if (!has_next) break;
#pragma unroll
        for (int a = 0; a < 2; ++a)
#pragma unroll
            for (int b = 0; b < 2; ++b)
#pragma unroll
                for (int m = 0; m < 4; ++m)
#pragma unroll
                    for (int n = 0; n < 2; ++n) acc[a][b][m][n] = (f32x4){0.f, 0.f, 0.f, 0.f};
        cur = nxt; cA = nA; cB = nB; ++ui;
        if constexpr (GATHER) {
#pragma unroll
            for (int h_ = 0; h_ < 2; ++h_) { vG[h_][0] = vN[h_][0]; vG[h_][1] = vN[h_][1]; } }
        if (wr == 1) PG8_BAR;
    }
    PG8_WAIT_V(0);
    PG8_BAR;
#undef PG8_SA
#undef PG8_SB
#undef PG8_STAGE
#undef PG8_STAGE_A
#undef PG8_TOK
#undef PG8_LDA
#undef PG8_LDB
#undef PG8_MMA
#undef PG8_WAIT_V
#undef PG8_WAIT_L
#undef PG8_BAR
#undef PG8_SCHED
}
#endif

struct EpiStoreBf16 {
    bf16_t* O; int ldc;
    __device__ __forceinline__ void operator()(const f32x4 (&acc)[2][2][4][2], const Unit& u, int wr, int wc, int fr, int fq) const {
        const int row0 = u.pm * 256 + wr * 64 + fr, col0 = u.pn * 256 + wc * 32 + 8 * fq;
#pragma unroll
        for (int ai = 0; ai < 2; ++ai)
#pragma unroll
            for (int m = 0; m < 4; ++m)
#pragma unroll
                for (int bj = 0; bj < 2; ++bj) { const f32x4 v0 = acc[ai][bj][m][0], v1 = acc[ai][bj][m][1];
                    u32x4 w; w.x = pk2(v0[0], v0[1]); w.y = pk2(v0[2], v0[3]); w.z = pk2(v1[0], v1[1]); w.w = pk2(v1[2], v1[3]);
                    *(u32x4*)(O + (size_t)(row0 + ai * 128 + m * 16) * ldc + col0 + bj * 128) = w; }
    }
};
template <int MODE> struct EpiGate {
    const bf16_t* Hg; bf16_t* MGb;
    __device__ __forceinline__ void operator()(const f32x4 (&acc)[2][2][4][2], const Unit& u, int wr, int wc, int fr, int fq) const {
        const int row0 = u.pm * 256 + wr * 64 + fr, col0 = u.pn * 256 + wc * 32 + 8 * fq;
#pragma unroll
        for (int ai = 0; ai < 2; ++ai) {
            u32x4 gw[4][2], pw[4][2];
#pragma unroll
            for (int m = 0; m < 4; ++m)
#pragma unroll
                for (int bj = 0; bj < 2; ++bj) { const int row = row0 + ai * 128 + m * 16, col = col0 + bj * 128;
                    gw[m][bj] = *(const u32x4*)(Hg + (size_t)row * DINP + col); if (MODE != 0) pw[m][bj] = *(const u32x4*)(MGb + (size_t)row * D + col); }
            asm volatile("" ::: "memory");
#pragma unroll
            for (int m = 0; m < 4; ++m)
#pragma unroll
                for (int bj = 0; bj < 2; ++bj) { const int row = row0 + ai * 128 + m * 16, col = col0 + bj * 128; const f32x4 v0 = acc[ai][bj][m][0], v1 = acc[ai][bj][m][1];
                    float g[8], p[8], v[8] = {v0[0], v0[1], v0[2], v0[3], v1[0], v1[1], v1[2], v1[3]}; unpack8(gw[m][bj], g);
                    if (MODE != 0) { unpack8(pw[m][bj], p);
#pragma unroll
                        for (int i = 0; i < 8; ++i) v[i] = p[i] + v[i] * fsigmoid(g[i]); }
                    else {
#pragma unroll
                        for (int i = 0; i < 8; ++i) v[i] = v[i] * fsigmoid(g[i]); }
                    *(u32x4*)(MGb + (size_t)row * D + col) = pack8(v); }
            asm volatile("" ::: "memory");
        }
    }
};
struct EpiResid {
    const float* xp; const float* xs; float* op; float* os;
    __device__ __forceinline__ void operator()(const f32x4 (&acc)[2][2][4][2], const Unit& u, int wr, int wc, int fr, int fq) const {
        const int row0 = u.pm * 256 + wr * 64 + fr, col0 = u.pn * 256 + wc * 32 + 8 * fq;
        const bool smp = u.pm * 256 >= NP;
        const float* xb = smp ? xs - (size_t)NP * D : xp; float* ob = smp ? os - (size_t)NP * D : op;
#pragma unroll
        for (int ai = 0; ai < 2; ++ai) {
            f32x4 xa[4][2][2];
#pragma unroll
            for (int m = 0; m < 4; ++m)
#pragma unroll
                for (int bj = 0; bj < 2; ++bj) { const float* xi = xb + (size_t)(row0 + ai * 128 + m * 16) * D + col0 + bj * 128; xa[m][bj][0] = *(const f32x4*)xi; xa[m][bj][1] = *(const f32x4*)(xi + 4); }
            asm volatile("" ::: "memory");
#pragma unroll
            for (int m = 0; m < 4; ++m)
#pragma unroll
                for (int bj = 0; bj < 2; ++bj) { float* xo = ob + (size_t)(row0 + ai * 128 + m * 16) * D + col0 + bj * 128;
                    *(f32x4*)xo = xa[m][bj][0] * ALPHA + acc[ai][bj][m][0]; *(f32x4*)(xo + 4) = xa[m][bj][1] * ALPHA + acc[ai][bj][m][1]; }
            asm volatile("" ::: "memory");
        }
    }
};
struct EpiSwiglu {
    bf16_t* ACT; const float* bup;
    __device__ __forceinline__ void operator()(const f32x4 (&acc)[2][2][4][2], const Unit& u, int wr, int wc, int fr, int fq) const {
        const int row0_ = u.pm * 256 + wr * 64 + fr, j0 = u.pn * 128 + wc * 32 + 8 * fq;
        const float* bg = bup + (size_t)u.e * 2048 + j0; const f32x4 bg0 = *(const f32x4*)bg, bg1 = *(const f32x4*)(bg + 4), bu0 = *(const f32x4*)(bg + 1024), bu1 = *(const f32x4*)(bg + 1028);
#pragma unroll
        for (int ai = 0; ai < 2; ++ai)
#pragma unroll
            for (int m = 0; m < 4; ++m) { const int row = row0_ + ai * 128 + m * 16;
                const f32x4 g0 = acc[ai][0][m][0] + bg0, g1 = acc[ai][0][m][1] + bg1, u0 = acc[ai][1][m][0] + bu0, u1 = acc[ai][1][m][1] + bu1; float o[8];
#pragma unroll
                for (int i = 0; i < 4; ++i) { const float ga = fminf(g0[i], SW_LIMIT), ua = fminf(fmaxf(u0[i], -SW_LIMIT), SW_LIMIT); o[i] = (ua + 1.0f) * ga * fsigmoid(SW_ALPHA * ga);
                    const float gb = fminf(g1[i], SW_LIMIT), ub = fminf(fmaxf(u1[i], -SW_LIMIT), SW_LIMIT); o[4 + i] = (ub + 1.0f) * gb * fsigmoid(SW_ALPHA * gb); }
                *(u32x4*)(ACT + (size_t)row * D + j0) = pack8(o); }
    }
};
struct EpiDown {
    bf16_t* O; const float* bdn; const float* gs;
    __device__ __forceinline__ void operator()(const f32x4 (&acc)[2][2][4][2], const Unit& u, int wr, int wc, int fr, int fq) const {
        const int row0 = u.pm * 256 + wr * 64 + fr, col0 = u.pn * 256 + wc * 32 + 8 * fq;
#pragma unroll
        for (int ai = 0; ai < 2; ++ai) {
            float gt[4];
#pragma unroll
            for (int m = 0; m < 4; ++m) gt[m] = gs[row0 + ai * 128 + m * 16];
#pragma unroll
            for (int bj = 0; bj < 2; ++bj) { const float* bp = bdn + (size_t)u.e * D + col0 + bj * 128; const f32x4 b0 = *(const f32x4*)bp, b1 = *(const f32x4*)(bp + 4);
#pragma unroll
                for (int m = 0; m < 4; ++m) { const f32x4 a0 = (acc[ai][bj][m][0] + b0) * gt[m], a1 = (acc[ai][bj][m][1] + b1) * gt[m];
                    u32x4 w; w.x = pk2(a0[0], a0[1]); w.y = pk2(a0[2], a0[3]); w.z = pk2(a1[0], a1[1]); w.w = pk2(a1[2], a1[3]);
                    *(u32x4*)(O + (size_t)(row0 + ai * 128 + m * 16) * D + col0 + bj * 128) = w; } }
            asm volatile("" ::: "memory");
        }
    }
};
}

#ifndef EMU
#define XB_TMO      128
#define XB_XCNT(j)  (256  + 64 * (j))
#define XB_XSUB(j)  (1280 + 64 * (j))
#define XB_XGEN(j)  (2304 + 64 * (j))
#define XB_TOP      3328
#define XB_TOPGEN   3392
#define XCD_BAR_WORDS 3456
#define XB_SPIN_CAP (1u << 27)
__device__ __forceinline__ unsigned xb_ld(unsigned* p)              { return __hip_atomic_load(p, __ATOMIC_RELAXED, __HIP_MEMORY_SCOPE_AGENT); }
__device__ __forceinline__ unsigned xb_add(unsigned* p, unsigned v) { return __hip_atomic_fetch_add(p, v, __ATOMIC_RELAXED, __HIP_MEMORY_SCOPE_AGENT); }
__device__ __forceinline__ unsigned xb_xcc_id() { return (unsigned)__builtin_amdgcn_s_getreg((3 << 11) | 20) & 0xFu; }
#define XB_SPIN(cond, bar) do { unsigned _sp = 0; while (cond) { __builtin_amdgcn_s_sleep(1); \
    if ((++_sp & 255u) == 0u) { if (xb_ld(&(bar)[XB_TMO])) break; if (_sp > XB_SPIN_CAP) { atomicAdd(&(bar)[XB_TMO], 1u); break; } } } } while (0)
struct XcdBarrier { unsigned* bar; unsigned x; volatile LAS unsigned* st; };
__device__ __forceinline__ XcdBarrier xcd_barrier_post(unsigned* bar, volatile LAS unsigned* st) {
    XcdBarrier b; b.bar = bar; b.x = xb_xcc_id(); b.st = st;
    if (threadIdx.x == 0) (void)xb_add(&bar[XB_XCNT(b.x)], 1u);
    return b;
}
__device__ __forceinline__ void xcd_barrier_complete(unsigned* bar, unsigned x, unsigned& nloc, unsigned& nx) {
    const unsigned G = gridDim.x * gridDim.y * gridDim.z;
    unsigned sum, cnt, mine, sp = 0u;
    for (;;) {
        sum = 0u; cnt = 0u; mine = 0u;
#pragma unroll
        for (unsigned j = 0; j < 16; ++j) { const unsigned c = xb_ld(&bar[XB_XCNT(j)]); sum += c; cnt += (c > 0u) ? 1u : 0u; mine = (j == x) ? c : mine; }
        if (sum == G) break;
        __builtin_amdgcn_s_sleep(1);
        if ((++sp & 255u) == 0u) { if (xb_ld(&bar[XB_TMO])) break; if (sp > XB_SPIN_CAP) { atomicAdd(&bar[XB_TMO], 1u); break; } }
    }
    nloc = mine > 0u ? mine : 1u; nx = cnt > 0u ? cnt : 1u;
}
__device__ __forceinline__ void xcd_barrier(const XcdBarrier& b) {
    asm volatile("s_waitcnt vmcnt(0)" ::: "memory");
    __syncthreads();
    if (threadIdx.x == 0) {
        unsigned* bar = b.bar;
        __builtin_amdgcn_s_waitcnt(0);
        unsigned nloc = b.st[0], nx = b.st[1];
        if (nloc == 0u) { xcd_barrier_complete(bar, b.x, nloc, nx); b.st[0] = nloc; b.st[1] = nx; }
        const unsigned old = xb_add(&bar[XB_XSUB(b.x)], 1u);
        const unsigned gen = old / nloc;
        if (old + 1u == (gen + 1u) * nloc) {
            __builtin_amdgcn_fence(__ATOMIC_RELEASE, "agent");
            asm volatile("s_waitcnt vmcnt(0)" ::: "memory");
            const unsigned og = xb_add(&bar[XB_TOP], 1u);
            const unsigned tg = og / nx;
            if (og + 1u == (tg + 1u) * nx) xb_add(&bar[XB_TOPGEN], 1u);
            else XB_SPIN(xb_ld(&bar[XB_TOPGEN]) == tg, bar);
            __builtin_amdgcn_fence(__ATOMIC_ACQUIRE, "agent");
            xb_add(&bar[XB_XGEN(b.x)], 1u);
            asm volatile("s_waitcnt vmcnt(0)" ::: "memory");
        } else {
            XB_SPIN(xb_ld(&bar[XB_XGEN(b.x)]) == gen, bar);
            __builtin_amdgcn_fence(__ATOMIC_ACQUIRE, "agent");
            asm volatile("s_waitcnt vmcnt(0)" ::: "memory");
        }
    }
    __syncthreads();
}
#endif

struct Args { const float* in[31]; float* out; unsigned char* ws; int lo, hi; };
typedef const float* FPtr;
#ifdef EMU
typedef const FPtr* ArgTab;
#else
typedef const __attribute__((address_space(4))) FPtr* ArgTab;
#endif
struct Frame {
    LAS unsigned char* lds; int tid, lane, wave, G, bid;
    ArgTab in; float* out; unsigned char* ws; unsigned* ctl;
};
enum { I_XP = 0, I_XS, I_CK, I_CV, I_SST, I_SCV, I_SSC, I_WIN, I_CONVW, I_CONVB, I_DTB, I_ALOG, I_SD, I_NORMW, I_WSSD, I_SINK, I_WATT, I_RELB, I_SCW, I_WSC, I_WO, I_LN1G, I_LN1B,
       I_RW, I_RB, I_WUP, I_BUP, I_WDN, I_BDN, I_LN2G, I_LN2B };

__device__ __forceinline__ bf16_t* ws_bf(const Frame& F, size_t off) { return (bf16_t*)(F.ws + off); }
__device__ __forceinline__ float* ws_f(const Frame& F, size_t off) { return (float*)(F.ws + off); }
__device__ __forceinline__ bf16_t* wl_ptr(const Frame& F, int layer, size_t off) { return (bf16_t*)(F.ws + WS_W + (size_t)layer * WL_BYTES + off); }

__device__ __forceinline__ void wt_item(const float* W, int ldw, int K, int k0, int nsrc0, const float* kscale, bf16_t* WT, int ndst0, LAS float* scr, int lane) {
    if (nsrc0 < 0) {
#pragma unroll
        for (int j = 0; j < 4; ++j) { const int n = (lane >> 3) + 8 * j; *(u32x4*)(WT + (size_t)(ndst0 + n) * K + k0 + 8 * (lane & 7)) = (u32x4){0u, 0u, 0u, 0u}; }
        return;
    }
#pragma unroll 8
    for (int i = 0; i < 32; ++i) { const int kk = 2 * i + (lane >> 5); float v = W[(size_t)(k0 + kk) * ldw + nsrc0 + (lane & 31)]; if (kscale) v *= kscale[k0 + kk]; scr[kk * 33 + (lane & 31)] = v; }
    WAVE_SYNC();
    const int c = lane & 7;
#pragma unroll
    for (int j = 0; j < 4; ++j) { const int n = (lane >> 3) + 8 * j; const LAS float* s = scr + (8 * c) * 33 + n;
        u32x4 o; o.x = pk2(s[0 * 33], s[1 * 33]); o.y = pk2(s[2 * 33], s[3 * 33]); o.z = pk2(s[4 * 33], s[5 * 33]); o.w = pk2(s[6 * 33], s[7 * 33]);
        *(u32x4*)(WT + (size_t)(ndst0 + n) * K + k0 + 8 * c) = o; }
    WAVE_SYNC();
}
__device__ __forceinline__ void step_weights(const Frame& F) {
    LAS float* scr = (LAS float*)(F.lds + F.wave * 16384);
    const int gw = F.bid * NWAVES + F.wave, NGW = F.G * NWAVES;
    constexpr int I_IN = (DINP / 32) * (D / 64), I_SSD = (D / 32) * (DINNER / 64), I_SQ = (D / 32) * (D / 64), I_UP = NEXP * (2048 / 32) * (D / 64), I_DN = NEXP * (D / 32) * (D / 64);
    constexpr int PER_LAYER = I_IN + I_SSD + 3 * I_SQ + I_UP + I_DN;
    for (int it = gw; it < DEPTH * PER_LAYER; it += NGW) {
        const int layer = it / PER_LAYER; int r = it % PER_LAYER;
        if (r < I_IN) { const int nb = r / (D / 64), kb = r % (D / 64), n0 = nb * 32;
            const int ns = n0 < 6144 ? n0 : (n0 < 13824 ? n0 + 32 : (n0 < 13856 ? n0 - 13824 + 6144 : -1));
            wt_item(F.in[I_WIN] + (size_t)layer * D * DIN, DIN, D, kb * 64, ns, nullptr, wl_ptr(F, layer, WL_IN), n0, scr, F.lane); continue; }
        r -= I_IN;
        if (r < I_SSD) { const int nb = r / (DINNER / 64), kb = r % (DINNER / 64);
            wt_item(F.in[I_WSSD] + (size_t)layer * DINNER * D, D, DINNER, kb * 64, nb * 32, F.in[I_NORMW] + (size_t)layer * DINNER, wl_ptr(F, layer, WL_SSD), nb * 32, scr, F.lane); continue; }
        r -= I_SSD;
        if (r < I_SQ) { const int nb = r / (D / 64), kb = r % (D / 64); wt_item(F.in[I_WATT] + (size_t)layer * D * D, D, D, kb * 64, nb * 32, nullptr, wl_ptr(F, layer, WL_ATT), nb * 32, scr, F.lane); continue; }
        r -= I_SQ;
        if (r < I_SQ) { const int nb = r / (D / 64), kb = r % (D / 64); wt_item(F.in[I_WSC] + (size_t)layer * D * D, D, D, kb * 64, nb * 32, nullptr, wl_ptr(F, layer, WL_SC), nb * 32, scr, F.lane); continue; }
        r -= I_SQ;
        if (r < I_SQ) { const int nb = r / (D / 64), kb = r % (D / 64); wt_item(F.in[I_WO] + (size_t)layer * D * D, D, D, kb * 64, nb * 32, nullptr, wl_ptr(F, layer, WL_O), nb * 32, scr, F.lane); continue; }
        r -= I_SQ;
        if (r < I_UP) { const int e = r / ((2048 / 32) * (D / 64)), q = r % ((2048 / 32) * (D / 64)), nb = q / (D / 64), kb = q % (D / 64), n0 = nb * 32;
            const int pn = n0 >> 8, bj = (n0 >> 7) & 1, jj = n0 & 127, ns = bj * 1024 + pn * 128 + jj;
            wt_item(F.in[I_WUP] + ((size_t)layer * NEXP + e) * D * 2048, 2048, D, kb * 64, ns, nullptr, wl_ptr(F, layer, WL_UP) + (size_t)e * 2048 * D, n0, scr, F.lane); continue; }
        r -= I_UP;
        { const int e = r / ((D / 32) * (D / 64)), q = r % ((D / 32) * (D / 64)), nb = q / (D / 64), kb = q % (D / 64);
            wt_item(F.in[I_WDN] + ((size_t)layer * NEXP + e) * D * D, D, D, kb * 64, nb * 32, nullptr, wl_ptr(F, layer, WL_DN) + (size_t)e * D * D, nb * 32, scr, F.lane); }
    }
}

__device__ __forceinline__ const float* x_in_row(const Frame& F, int layer, int mb, int r) {
    if (layer == 0) return r < NP ? F.in[I_XP] + ((size_t)mb * NP + r) * D : F.in[I_XS] + (size_t)(r - NP) * D;
    return r < NP ? F.out + O_YP + ((size_t)mb * NP + r) * D : F.out + O_YS + (size_t)(r - NP) * D;
}
__device__ __forceinline__ float* x_out_row(const Frame& F, int mb, int r) { return r < NP ? F.out + O_YP + ((size_t)mb * NP + r) * D : F.out + O_YS + (size_t)(r - NP) * D; }
__device__ __forceinline__ int rows_of(int mb) { return mb == 0 ? R : NP; }

__device__ __forceinline__ void step_xb(const Frame& F, int mb) {
    const int gw = F.bid * NWAVES + F.wave, NGW = F.G * NWAVES, nr = rows_of(mb);
    bf16_t* XB = ws_bf(F, WS_XB0) + (size_t)mb * R * D;
    for (int r = gw; r < nr; r += NGW) {
        const f32x4* xr = (const f32x4*)x_in_row(F, 0, mb, r) + F.lane; u32x2* o = (u32x2*)(XB + (size_t)r * D) + F.lane;
#pragma unroll
        for (int j = 0; j < 4; ++j) { const f32x4 v = xr[64 * j]; u32x2 w; w.x = pk2(v[0], v[1]); w.y = pk2(v[2], v[3]); o[64 * j] = w; }
    }
}

__device__ __forceinline__ float softplus_f(float x) { const float e = fexp(x); return x > 20.f ? x : (e < 0.01f ? e * (1.0f - e * (0.5f - e * 0.33333333f)) : __builtin_amdgcn_logf(1.0f + e) * 0.69314718056f); }
constexpr int S128 = 136, S64 = 72;
constexpr int BL_BM = 0, BL_CM = BL_BM + 64 * S128 * 2, BL_CB = BL_CM + 64 * S128 * 2, BL_END = BL_CB + 64 * S64 * 2;
struct BcRegs { u32x4 raw[7]; f32x4 wq[4][2], bq[2]; };
__device__ __forceinline__ void ssd_bc_load(const Frame& F, int layer, int u, BcRegs& R_) {
    const int sl = (u / NCHUNK) % NSEQ_MB, ck = u % NCHUNK, g = u / (NCHUNK * NSEQ_MB); const int tid = F.tid;
    const bf16_t* H = ws_bf(F, WS_H) + (size_t)sl * SEQ * DINP; const int cgi = tid & 31, rb = tid >> 5; const int xc = (cgi < 16 ? 2048 : 3072) + g * 128 + 8 * (cgi & 15);
#pragma unroll
    for (int i = 0; i < 7; ++i) { const int t = ck * 64 + 4 * rb - 3 + i; R_.raw[i] = t >= 0 ? *(const u32x4*)(H + (size_t)t * DINP + C_X + xc) : (u32x4){0u, 0u, 0u, 0u}; }
    const float* convw = F.in[I_CONVW] + (size_t)layer * 4 * CONVDIM + xc; const float* convb = F.in[I_CONVB] + (size_t)layer * CONVDIM + xc;
#pragma unroll
    for (int tp = 0; tp < 4; ++tp) { R_.wq[tp][0] = *(const f32x4*)(convw + tp * CONVDIM); R_.wq[tp][1] = *(const f32x4*)(convw + tp * CONVDIM + 4); }
    R_.bq[0] = *(const f32x4*)convb; R_.bq[1] = *(const f32x4*)(convb + 4);
}
__device__ __forceinline__ void ssd_bc_unit(const Frame& F, int u, const BcRegs& R_) {
    const int sl = (u / NCHUNK) % NSEQ_MB, ck = u % NCHUNK, g = u / (NCHUNK * NSEQ_MB);
    const int tid = F.tid, lane = F.lane, w = F.wave, fr = lane & 15, fq = lane >> 4;
    LAS bf16_t* Bm = (LAS bf16_t*)(F.lds + BL_BM); LAS bf16_t* Cm = (LAS bf16_t*)(F.lds + BL_CM); LAS bf16_t* CBs = (LAS bf16_t*)(F.lds + BL_CB);
    const size_t rowg = (size_t)sl * SEQ + (size_t)ck * 64; const size_t tix = ((size_t)sl * NCHUNK + ck) * 8 + g;
    const int cgi = tid & 31, rb = tid >> 5; const bool isB = cgi < 16; const int n0 = 8 * (cgi & 15);
    const u32x4 (&raw)[7] = R_.raw; const f32x4 (&wq)[4][2] = R_.wq; const f32x4 (&bq)[2] = R_.bq;
    __syncthreads();
    { float val[4][8];
#pragma unroll
      for (int r = 0; r < 4; ++r) { float a[8] = {bq[0][0], bq[0][1], bq[0][2], bq[0][3], bq[1][0], bq[1][1], bq[1][2], bq[1][3]};
#pragma unroll
          for (int tp = 0; tp < 4; ++tp) { float f[8]; unpack8(raw[r + tp], f);
#pragma unroll
              for (int i = 0; i < 4; ++i) { a[i] += f[i] * wq[tp][0][i]; a[4 + i] += f[4 + i] * wq[tp][1][i]; } }
#pragma unroll
          for (int i = 0; i < 8; ++i) val[r][i] = fsilu(a[i]); }
      if (isB) { bf16_t* bt = ws_bf(F, WS_BTG) + tix * 8192 + (size_t)n0 * 64 + 4 * rb;
#pragma unroll
          for (int r = 0; r < 4; ++r) *(LAS u32x4*)(Bm + (4 * rb + r) * S128 + n0) = pack8(val[r]);
#pragma unroll
          for (int i = 0; i < 8; ++i) { u32x2 wv; wv.x = pk2(val[0][i], val[1][i]); wv.y = pk2(val[2][i], val[3][i]); *(u32x2*)(bt + (size_t)i * 64) = wv; } }
      else { bf16_t* cmc = ws_bf(F, WS_CMC) + (rowg + 4 * rb) * 1024 + g * 128 + n0;
#pragma unroll
          for (int r = 0; r < 4; ++r) { const u32x4 pk = pack8(val[r]); *(LAS u32x4*)(Cm + (4 * rb + r) * S128 + n0) = pk; *(u32x4*)(cmc + (size_t)r * 1024) = pk; } } }
    __syncthreads();
    { const int ti = w >> 1;
#pragma unroll
      for (int jj = 0; jj < 2; ++jj) { const int tj = 2 * (w & 1) + jj; f32x4 cb = (f32x4){0.f, 0.f, 0.f, 0.f};
          if (tj <= ti) {
#pragma unroll
              for (int ks = 0; ks < 4; ++ks) { const bf16x8 a = *(const LAS bf16x8*)(Cm + (16 * ti + fr) * S128 + 32 * ks + 8 * fq); const bf16x8 b = *(const LAS bf16x8*)(Bm + (16 * tj + fr) * S128 + 32 * ks + 8 * fq);
                  cb = __builtin_amdgcn_mfma_f32_16x16x32_bf16(a, b, cb, 0, 0, 0); } }
#pragma unroll
          for (int r = 0; r < 4; ++r) CBs[(16 * ti + 4 * fq + r) * S64 + 16 * tj + fr] = bf1(cb[r]); } }
    __syncthreads();
    { const int row = tid >> 3, cc = tid & 7; *(u32x4*)(ws_bf(F, WS_CBG) + tix * 4096 + row * 64 + 8 * cc) = *(const LAS u32x4*)(CBs + row * S64 + 8 * cc); }
}

constexpr int SL_CM = 0, SL_BT = SL_CM + 64 * S128 * 2, SL_CB = SL_BT + 128 * S64 * 2, SL_DMA_SZ = SL_CB + 64 * S64 * 2, SL_DMA_END = 2 * SL_DMA_SZ;
constexpr int SL_XT = SL_DMA_END  , SL_XTW = SL_XT + 2 * 64 * S64 * 2, SL_MM = SL_XTW + 64 * S64 * 2, SL_SB = SL_MM + 64 * S64 * 2,
    SL_SM = SL_SB + 64 * S128 * 2, SL_END = SL_SM + 2 * 384 * 4;
static_assert(SL_END <= SCR_BYTES && SL_DMA_SZ == 2816 * 16, "ssd LDS map");
#ifdef EMU
#define SSD_DMA_ONE(gp_, dst_) memcpy((unsigned char*)(dst_) + lane * 16, (gp_), 16)
#else
#define SSD_DMA_ONE(gp_, dst_) __builtin_amdgcn_global_load_lds((const unsigned*)(gp_), (LAS unsigned*)(dst_), 16, 0, 0)
#endif
#define SSD_DMA_SETUP() do { _Pragma("unroll") for (int j_ = 0; j_ < 6; ++j_) { const int pc_ = w * 6 + j_; const int q_ = pc_ * 64 + lane; const size_t tx0_ = ((size_t)sl * NCHUNK) * 8 + g; \
        if (pc_ < 17) { const int r_ = q_ / 17; int c_ = q_ % 17; c_ = c_ < 16 ? c_ : 15; dsrc[j_] = cmc + (size_t)r_ * 1024 + 8 * c_; } \
        else if (pc_ < 35) { const int q2_ = q_ - 1088, r_ = q2_ / 9; int c_ = q2_ % 9; c_ = c_ < 8 ? c_ : 7; dsrc[j_] = btg + tx0_ * 8192 + r_ * 64 + 8 * c_; } \
        else { const int q3_ = q_ - 2240, r_ = q3_ / 9; int c_ = q3_ % 9; c_ = c_ < 8 ? c_ : 7; dsrc[j_] = cbg + tx0_ * 4096 + r_ * 64 + 8 * c_; } } } while (0)
#define SSD_DMA(ck_) do { _Pragma("unroll") for (int j_ = 0; j_ < 6; ++j_) { const int pc_ = w * 6 + j_; if (pc_ < 44) { \
        SSD_DMA_ONE(dsrc[j_], L + ((ck_) & 1) * SL_DMA_SZ + SL_CM + pc_ * 1024); dsrc[j_] += pc_ < 17 ? (size_t)64 * 1024 : (pc_ < 35 ? (size_t)8 * 8192 : (size_t)8 * 4096); } } } while (0)
#define SSD_LOAD_X(ck_) do { _Pragma("unroll") for (int i = 0; i < 11; ++i) { const int t_ = (ck_) * 64 + 8 * w - 3 + i; rawx[i] = t_ >= 0 ? (unsigned)H[(size_t)t_ * DINP + C_X + hd * 64 + lane] : 0u; } } while (0)
#define SSD_LOAD_XN(ck_) do { const bf16_t* px_ = H + ((size_t)(ck_) * 64 + 8 * w - 3) * DINP + C_X + hd * 64 + lane; _Pragma("unroll") for (int i = 0; i < 11; ++i) rawx[i] = (unsigned)px_[(size_t)i * DINP]; } while (0)
#define SSD_TABLE(tb_, dtr_) do { const float dt_ = softplus_f(bf2f(dtr_) + dtb); \
        float cs_ = Ah * dt_; _Pragma("unroll") for (int o = 1; o < 64; o <<= 1) { const float t2_ = __shfl(cs_, lane - o < 0 ? 0 : lane - o); if (lane >= o) cs_ += t2_; } \
        const float tot_ = __shfl(cs_, 63); (tb_)[lane] = dt_; (tb_)[64 + lane] = cs_; (tb_)[128 + lane] = fexp(tot_ - cs_); (tb_)[192 + lane] = fexp(cs_); if (lane == 0) (tb_)[256] = fexp(tot_); } while (0)

__device__ __forceinline__ void ssd_prompt_unit(const Frame& F, int layer, int mb, int sl, int hd) {
    const int tid = F.tid, lane = F.lane, w = F.wave, fr = lane & 15, fq = lane >> 4;
    LAS unsigned char* L = F.lds;
    LAS bf16_t* XT0 = (LAS bf16_t*)(L + SL_XT);
    LAS bf16_t* XTW = (LAS bf16_t*)(L + SL_XTW); LAS bf16_t* Mm = (LAS bf16_t*)(L + SL_MM); LAS bf16_t* Sb = (LAS bf16_t*)(L + SL_SB);
    LAS float* smb = (LAS float*)(L + SL_SM);
    const int g = hd >> 2;
    bf16_t* H = ws_bf(F, WS_H) + (size_t)sl * SEQ * DINP;
    const bf16_t* cmc = ws_bf(F, WS_CMC) + (size_t)sl * SEQ * 1024 + g * 128; const bf16_t* btg = ws_bf(F, WS_BTG); const bf16_t* cbg = ws_bf(F, WS_CBG);
    const float* convw = F.in[I_CONVW] + (size_t)layer * 4 * CONVDIM + hd * 64; const float* convb = F.in[I_CONVB] + (size_t)layer * CONVDIM + hd * 64;
    const float cw0 = convw[lane], cw1 = convw[CONVDIM + lane], cw2 = convw[2 * CONVDIM + lane], cw3 = convw[3 * CONVDIM + lane], cwb = convb[lane];
    __syncthreads();
    const float dtb = F.in[I_DTB][layer * 32 + hd], Ah = -fexp(F.in[I_ALOG][layer * 32 + hd]), Dh = F.in[I_SD][layer * 32 + hd];
    const int xl = tid >> 3, xcg = tid & 7;
    f32x4 S[4];
#pragma unroll
    for (int j = 0; j < 4; ++j) S[j] = (f32x4){0.f, 0.f, 0.f, 0.f};
    const int ti = w >> 1, tj0 = 2 * (w & 1);
    const int pi = w & 3, nb = w >> 2;
    bf16_t* pz = H + (size_t)(16 * ti + fr) * DINP + C_Z + hd * 64 + 16 * tj0 + 4 * fq; float* pss = ws_f(F, WS_SSQ) + ((size_t)sl * SEQ + 16 * ti + fr) * 64 + hd * 2 + (w & 1);
    unsigned rawx[11]; u32x2 zraw[2]; unsigned dtr_next;
    const bf16_t* dsrc[6]; SSD_DMA_SETUP();
    SSD_DMA(0); SSD_LOAD_X(0);
    zraw[0] = *(const u32x2*)pz; zraw[1] = *(const u32x2*)(pz + 16);
    { const unsigned d0 = H[(size_t)lane * DINP + C_DT + hd]; dtr_next = H[(size_t)(64 + lane) * DINP + C_DT + hd]; if (w == 7) { SSD_TABLE(smb, d0); smb[320 + lane] = Dh * __builtin_amdgcn_rcpf(smb[lane]); } }
    VM_WAIT(0);
    __syncthreads();
    for (int ck = 0; ck < NCHUNK; ++ck) {
        LAS float* sm = smb + (ck & 1) * 384; LAS float* smn = smb + ((ck + 1) & 1) * 384; LAS bf16_t* XT = XT0 + (ck & 1) * 64 * S64;
        LAS unsigned char* Ld = L + (ck & 1) * SL_DMA_SZ; LAS bf16_t* Cm = (LAS bf16_t*)(Ld + SL_CM); LAS bf16_t* BT = (LAS bf16_t*)(Ld + SL_BT); LAS bf16_t* CBl = (LAS bf16_t*)(Ld + SL_CB);
        { const f32x4 d0 = *(const LAS f32x4*)(sm + 8 * w), d1 = *(const LAS f32x4*)(sm + 8 * w + 4), e0 = *(const LAS f32x4*)(sm + 128 + 8 * w), e1 = *(const LAS f32x4*)(sm + 128 + 8 * w + 4);
          const float dtv[8] = {d0[0], d0[1], d0[2], d0[3], d1[0], d1[1], d1[2], d1[3]}, wdv[8] = {e0[0], e0[1], e0[2], e0[3], e1[0], e1[1], e1[2], e1[3]}; float xr[11], xa[8], xb[8];
#pragma unroll
          for (int i = 0; i < 11; ++i) xr[i] = blo(rawx[i]);
#pragma unroll
          for (int r = 0; r < 8; ++r) { const float xd = fsilu(cwb + xr[r] * cw0 + xr[r + 1] * cw1 + xr[r + 2] * cw2 + xr[r + 3] * cw3) * dtv[r]; xa[r] = xd; xb[r] = xd * wdv[r]; }
          *(LAS u32x4*)(XT + lane * S64 + 8 * w) = pack8(xa); *(LAS u32x4*)(XTW + lane * S64 + 8 * w) = pack8(xb); }
#pragma unroll
        for (int jj = 0; jj < 4; ++jj) { u32x2 wv; wv.x = pk2(S[jj][0], S[jj][1]); wv.y = pk2(S[jj][2], S[jj][3]); *(LAS u32x2*)(Sb + (16 * pi + fr) * S128 + 64 * nb + 16 * jj + 4 * fq) = wv; }
        if (ck > 0) VM_WAIT(2);
        LBAR();
        const u32x2 z0 = zraw[0], z1 = zraw[1]; const unsigned dtr_cur = dtr_next;
        if (ck + 1 < NCHUNK) SSD_DMA(ck + 1);
        if (ck + 1 < NCHUNK) { SSD_LOAD_XN(ck + 1); zraw[0] = *(const u32x2*)(pz + (size_t)64 * DINP); zraw[1] = *(const u32x2*)(pz + (size_t)64 * DINP + 16);
            dtr_next = H[((size_t)ck * 64 + (ck + 2 < NCHUNK ? 128 : 64) + lane) * DINP + C_DT + hd]; }
        asm volatile("" ::: "memory");
        if (w == 7 && ck + 1 < NCHUNK) { SSD_TABLE(smn, dtr_cur); smn[320 + lane] = Dh * __builtin_amdgcn_rcpf(smn[lane]); }
        { const int s0 = 8 * xcg; float mv[8];
          if (s0 <= xl) { float cbv[8]; unpack8(*(const LAS u32x4*)(CBl + xl * S64 + s0), cbv); const float al = sm[64 + xl]; const f32x4 a0 = *(const LAS f32x4*)(sm + 64 + s0), a1 = *(const LAS f32x4*)(sm + 64 + s0 + 4);
#pragma unroll
              for (int i = 0; i < 4; ++i) { mv[i] = (xl >= s0 + i) ? cbv[i] * fexp(fminf(al - a0[i], 0.f)) : 0.f; mv[4 + i] = (xl >= s0 + 4 + i) ? cbv[4 + i] * fexp(fminf(al - a1[i], 0.f)) : 0.f; }
              if ((xl >> 3) == xcg) { const float dd = sm[320 + xl];
#pragma unroll
                  for (int i = 0; i < 8; ++i) if (i == (xl & 7)) mv[i] += dd; } }
          else {
#pragma unroll
              for (int i = 0; i < 8; ++i) mv[i] = 0.f; }
          *(LAS u32x4*)(Mm + xl * S64 + s0) = pack8(mv); }
        f32x4 yo[2];
#pragma unroll
        for (int jj = 0; jj < 2; ++jj) { const int tj = tj0 + jj; yo[jj] = (f32x4){0.f, 0.f, 0.f, 0.f};
#pragma unroll
            for (int ks = 0; ks < 4; ++ks) { const bf16x8 sb = *(const LAS bf16x8*)(Sb + (16 * tj + fr) * S128 + 32 * ks + 8 * fq); const bf16x8 c = *(const LAS bf16x8*)(Cm + (16 * ti + fr) * S128 + 32 * ks + 8 * fq);
                yo[jj] = __builtin_amdgcn_mfma_f32_16x16x32_bf16(sb, c, yo[jj], 0, 0, 0); } }
        { const float cd = sm[256];
#pragma unroll
          for (int jj = 0; jj < 4; ++jj) { S[jj] = S[jj] * cd;
#pragma unroll
            for (int ks = 0; ks < 2; ++ks) { const bf16x8 a = *(const LAS bf16x8*)(BT + (64 * nb + 16 * jj + fr) * S64 + 32 * ks + 8 * fq); const bf16x8 b = *(const LAS bf16x8*)(XTW + (16 * pi + fr) * S64 + 32 * ks + 8 * fq);
                S[jj] = __builtin_amdgcn_mfma_f32_16x16x32_bf16(a, b, S[jj], 0, 0, 0); }
            if (jj & 1) asm volatile("" ::: "memory"); } }
        const float ec = sm[192 + 16 * ti + fr];
        LBAR();
        { float ss = 0.f; const u32x2 zz[2] = {z0, z1};
#pragma unroll
          for (int jj = 0; jj < 2; ++jj) { const int tj = tj0 + jj; f32x4 yd = (f32x4){0.f, 0.f, 0.f, 0.f};
#pragma unroll
              for (int ks = 0; ks < 2; ++ks) { const bf16x8 a = *(const LAS bf16x8*)(XT + (16 * tj + fr) * S64 + 32 * ks + 8 * fq); const bf16x8 b = *(const LAS bf16x8*)(Mm + (16 * ti + fr) * S64 + 32 * ks + 8 * fq);
                  yd = __builtin_amdgcn_mfma_f32_16x16x32_bf16(a, b, yd, 0, 0, 0); }
              const float z[4] = {blo(zz[jj].x), bhi(zz[jj].x), blo(zz[jj].y), bhi(zz[jj].y)}; float v[4];
#pragma unroll
              for (int r = 0; r < 4; ++r) { v[r] = (yd[r] + ec * yo[jj][r]) * fsilu(z[r]); ss += v[r] * v[r]; }
              u32x2 ov; ov.x = pk2(v[0], v[1]); ov.y = pk2(v[2], v[3]); *(u32x2*)(pz + 16 * jj) = ov; }
          ss += __shfl_xor(ss, 16); ss += __shfl_xor(ss, 32);
          if (fq == 0) *pss = ss;
          pz += (size_t)64 * DINP; pss += 64 * 64; }
    }
    float* so = F.out + O_SSP + ((((size_t)layer * BATCH + mb * NSEQ_MB + sl) * 32 + hd) * 64) * 128;
#pragma unroll
    for (int jj = 0; jj < 4; ++jj) *(f32x4*)(so + (size_t)(16 * pi + fr) * 128 + 64 * nb + 16 * jj + 4 * fq) = S[jj];
    VM_WAIT(0); __syncthreads();
}

__device__ __forceinline__ void ssd_sample_unit(const Frame& F, int layer, int sq, int hd) {
    const int tid = F.tid, lane = F.lane; LAS float* L = (LAS float*)F.lds;
    LAS float* xs = L; LAS float* Bs = L + 16 * 64; LAS float* Cs = Bs + 16 * 128; LAS float* dts = Cs + 16 * 128; LAS float* das = dts + 16; LAS float* Yl = das + 16;
    const int g = hd >> 2;
    bf16_t* H = ws_bf(F, WS_H) + (size_t)(NP + sq * 16) * DINP;
    const float* hist = F.in[I_SCV] + ((size_t)layer * DECB + sq) * 3 * CONVDIM;
    const float* convw = F.in[I_CONVW] + (size_t)layer * 4 * CONVDIM; const float* convb = F.in[I_CONVB] + (size_t)layer * CONVDIM;
    __syncthreads();
    if (tid < 320) { const int c = tid; const int xc = c < 64 ? hd * 64 + c : (c < 192 ? 2048 + g * 128 + (c - 64) : 3072 + g * 128 + (c - 192));
        float win[19];
#pragma unroll
        for (int i = 0; i < 3; ++i) win[i] = hist[i * CONVDIM + xc];
#pragma unroll
        for (int t = 0; t < 16; ++t) win[3 + t] = bf2f(H[(size_t)t * DINP + C_X + xc]);
        const float w0 = convw[xc], w1 = convw[CONVDIM + xc], w2 = convw[2 * CONVDIM + xc], w3 = convw[3 * CONVDIM + xc], bb = convb[xc];
#pragma unroll
        for (int t = 0; t < 16; ++t) { const float a = fsilu(bb + win[t] * w0 + win[t + 1] * w1 + win[t + 2] * w2 + win[t + 3] * w3);
            if (c < 64) xs[t * 64 + c] = a; else if (c < 192) Bs[t * 128 + c - 64] = a; else Cs[t * 128 + c - 192] = a; } }
    if (tid < 16) { const float dt = softplus_f(bf2f(H[(size_t)tid * DINP + C_DT + hd]) + F.in[I_DTB][layer * 32 + hd]); dts[tid] = dt; das[tid] = fexp(-fexp(F.in[I_ALOG][layer * 32 + hd]) * dt); }
    __syncthreads();
    const int p = tid >> 3, n0 = (tid & 7) * 16;
    const size_t sbase = ((((size_t)layer * DECB + sq) * 32 + hd) * 64 + p) * 128 + n0;
    float S[16];
#pragma unroll
    for (int i = 0; i < 16; ++i) S[i] = F.in[I_SST][sbase + i];
    for (int t = 0; t < 16; ++t) { const float dec = das[t], xv = xs[t * 64 + p] * dts[t]; float part = 0.f;
#pragma unroll
        for (int i = 0; i < 16; ++i) { S[i] = S[i] * dec + xv * Bs[t * 128 + n0 + i]; part += Cs[t * 128 + n0 + i] * S[i]; }
        part += __shfl_xor(part, 1); part += __shfl_xor(part, 2); part += __shfl_xor(part, 4);
        if ((tid & 7) == 0) Yl[t * 64 + p] = part; }
#pragma unroll
    for (int i = 0; i < 16; ++i) F.out[O_SSS + sbase + i] = S[i];
    __syncthreads();
    const float Dh = F.in[I_SD][layer * 32 + hd];
#pragma unroll
    for (int j = 0; j < 2; ++j) { const int it = tid + 512 * j, t = it >> 6, pp = it & 63;
        const float z = bf2f(H[(size_t)t * DINP + C_Z + hd * 64 + pp]); const float v = (Yl[t * 64 + pp] + Dh * xs[t * 64 + pp]) * fsilu(z);
        H[(size_t)t * DINP + C_Z + hd * 64 + pp] = bf1(v);
        const float ss = wave_sum(v * v);
        if (lane < 2) ws_f(F, WS_SSQ)[((size_t)NP + sq * 16 + t) * 64 + hd * 2 + lane] = lane == 0 ? ss : 0.f; }
}

__device__ __forceinline__ int t5_bucket(int rel) {
    const int n = rel < 0 ? -rel : rel; const int b = rel > 0 ? 16 : 0;
    if (n < 8) return b + n;
    int v = 8; v += n >= 12; v += n >= 16; v += n >= 23; v += n >= 32; v += n >= 46; v += n >= 64; v += n >= 91;
    return b + v;
}
constexpr int AK_P = 72, AV_P = 200;
constexpr int AL_K = 0, AL_VT = AL_K + 192 * AK_P * 2, AL_LUT = AL_VT + 64 * AV_P * 2, AL_END = AL_LUT + 4 * 256 * 4;
static_assert(AL_END <= RING_BYTES, "attention LDS map");
__device__ __forceinline__ void attn_prompt_unit(const Frame& F, int layer, int sl, int ck, int kh) {
    const int tid = F.tid, lane = F.lane, w = F.wave, q32 = lane & 31, hi = lane >> 5;
    LAS bf16_t* Kl = (LAS bf16_t*)(F.lds + AL_K); LAS bf16_t* VT = (LAS bf16_t*)(F.lds + AL_VT); LAS float* lut = (LAS float*)(F.lds + AL_LUT);
    bf16_t* H = ws_bf(F, WS_H) + (size_t)sl * SEQ * DINP;
    const int gq = w >> 1, qh = w & 1, head = kh * 4 + gq;
    const size_t qrow = (size_t)ck * 64 + 32 * qh + q32;
    bf16x8 qf[4];
#pragma unroll
    for (int ds = 0; ds < 4; ++ds) qf[ds] = *(const bf16x8*)(H + qrow * DINP + C_Q + head * 64 + 16 * ds + 8 * hi);
    __syncthreads();
#pragma unroll
    for (int j = 0; j < 3; ++j) { const int id = tid + 512 * j, key = id >> 3, cg = id & 7; const int t = 64 * (ck - 2) + key;
        u32x4 kv = (u32x4){0u, 0u, 0u, 0u}, vv = kv;
        if (t >= 0) { kv = *(const u32x4*)(H + (size_t)t * DINP + C_K + kh * 64 + 8 * cg); vv = *(const u32x4*)(H + (size_t)t * DINP + C_V + kh * 64 + 8 * cg); }
        *(LAS u32x4*)(Kl + key * AK_P + 8 * cg) = kv;
        VT[(8 * cg + 0) * AV_P + key] = (bf16_t)(vv.x & 0xffffu); VT[(8 * cg + 1) * AV_P + key] = (bf16_t)(vv.x >> 16); VT[(8 * cg + 2) * AV_P + key] = (bf16_t)(vv.y & 0xffffu); VT[(8 * cg + 3) * AV_P + key] = (bf16_t)(vv.y >> 16);
        VT[(8 * cg + 4) * AV_P + key] = (bf16_t)(vv.z & 0xffffu); VT[(8 * cg + 5) * AV_P + key] = (bf16_t)(vv.z >> 16); VT[(8 * cg + 6) * AV_P + key] = (bf16_t)(vv.w & 0xffffu); VT[(8 * cg + 7) * AV_P + key] = (bf16_t)(vv.w >> 16); }
    for (int e = tid; e < 4 * 255; e += NTHREADS) { const int gg = e / 255, idx = e % 255; lut[gg * 256 + idx] = F.in[I_RELB][t5_bucket(idx - 191) * 16 + kh * 4 + gg]; }
    __syncthreads();
    f32x16 sc[6];
#pragma unroll
    for (int kt = 0; kt < 6; ++kt) {
#pragma unroll
        for (int r = 0; r < 16; ++r) sc[kt][r] = 0.f;
#pragma unroll
        for (int ds = 0; ds < 4; ++ds) { const bf16x8 a = *(const LAS bf16x8*)(Kl + (32 * kt + q32) * AK_P + 16 * ds + 8 * hi); sc[kt] = __builtin_amdgcn_mfma_f32_32x32x16_bf16(a, qf[ds], sc[kt], 0, 0, 0); } }
    const int qidx = 32 * qh + q32; const float sink = F.in[I_SINK][layer * 16 + head];
    float mx = -3.0e38f;
#pragma unroll
    for (int kt = 0; kt < 6; ++kt)
#pragma unroll
        for (int r = 0; r < 16; ++r) { const int key = 32 * kt + (r & 3) + 8 * (r >> 2) + 4 * hi; const int rel = key - 128 - qidx;
            float s = sc[kt][r] * 0.125f + lut[gq * 256 + rel + 191]; if (ck < 2 && 64 * ck + key - 128 < 0) s = -1e30f; sc[kt][r] = s; mx = fmaxf(mx, s); }
    mx = fmaxf(mx, __shfl_xor(mx, 32)); mx = fmaxf(mx, sink);
    float sum = 0.f;
#pragma unroll
    for (int kt = 0; kt < 6; ++kt)
#pragma unroll
        for (int r = 0; r < 16; ++r) { const float e = fexp(sc[kt][r] - mx); sc[kt][r] = e; sum += e; }
    sum += __shfl_xor(sum, 32);
    const float inv = 1.0f / (sum + fexp(sink - mx));
    f32x16 o[2];
#pragma unroll
    for (int d2 = 0; d2 < 2; ++d2)
#pragma unroll
        for (int r = 0; r < 16; ++r) o[d2][r] = 0.f;
#pragma unroll
    for (int kt = 0; kt < 6; ++kt)
#pragma unroll
        for (int s = 0; s < 2; ++s) {
            u32x4 pw; pw.x = pk2(sc[kt][8 * s + 0], sc[kt][8 * s + 1]); pw.y = pk2(sc[kt][8 * s + 2], sc[kt][8 * s + 3]); pw.z = pk2(sc[kt][8 * s + 4], sc[kt][8 * s + 5]); pw.w = pk2(sc[kt][8 * s + 6], sc[kt][8 * s + 7]);
            const bf16x8 pa = __builtin_bit_cast(bf16x8, pw);
#pragma unroll
            for (int d2 = 0; d2 < 2; ++d2) { const LAS bf16_t* vp = VT + (32 * d2 + q32) * AV_P + 32 * kt + 16 * s + 4 * hi;
                const u32x2 lo = *(const LAS u32x2*)vp, hh = *(const LAS u32x2*)(vp + 8); u32x4 vw; vw.x = lo.x; vw.y = lo.y; vw.z = hh.x; vw.w = hh.y;
                o[d2] = __builtin_amdgcn_mfma_f32_32x32x16_bf16(pa, __builtin_bit_cast(bf16x8, vw), o[d2], 0, 0, 0); } }
#pragma unroll
    for (int r = 0; r < 16; ++r) { const int q = (r & 3) + 8 * (r >> 2) + 4 * hi; const float iv = __shfl(inv, q);
        bf16_t* op = H + ((size_t)ck * 64 + 32 * qh + q) * DINP + C_Q + head * 64 + q32;
        op[0] = bf1(o[0][r] * iv); op[32] = bf1(o[1][r] * iv); }
}
__device__ __forceinline__ void attn_sample_unit(const Frame& F, int layer, int sq, int kh) {
    const int tid = F.tid; LAS float* L = (LAS float*)F.lds;
    LAS float* Kf = L; LAS float* Vf = Kf + 144 * 65; LAS float* Qf = Vf + 144 * 64; LAS float* P = Qf + 64 * 65; LAS float* Pinv = P + 64 * 145;
    static_assert((144 * 65 + 144 * 64 + 64 * 65 + 64 * 145 + 64) * 4 <= RING_BYTES, "sample attention LDS map");
    bf16_t* H = ws_bf(F, WS_H) + (size_t)(NP + sq * 16) * DINP;
    const float* ck = F.in[I_CK] + ((size_t)layer * DECB + sq) * WINDOW * 256; const float* cv = F.in[I_CV] + ((size_t)layer * DECB + sq) * WINDOW * 256;
    __syncthreads();
    for (int i = tid; i < 144 * 64; i += NTHREADS) { const int key = i >> 6, d = i & 63;
        Kf[key * 65 + d] = key < 128 ? ck[(size_t)key * 256 + kh * 64 + d] : bf2f(H[(size_t)(key - 128) * DINP + C_K + kh * 64 + d]);
        Vf[key * 64 + d] = key < 128 ? cv[(size_t)key * 256 + kh * 64 + d] : bf2f(H[(size_t)(key - 128) * DINP + C_V + kh * 64 + d]); }
    for (int i = tid; i < 64 * 64; i += NTHREADS) { const int row = i >> 6, d = i & 63; Qf[row * 65 + d] = bf2f(H[(size_t)(row & 15) * DINP + C_Q + (kh * 4 + (row >> 4)) * 64 + d]); }
    __syncthreads();
    for (int i = tid; i < 64 * 144; i += NTHREADS) { const int row = i / 144, key = i % 144; float s = 0.f;
        for (int d = 0; d < 64; ++d) s += Qf[row * 65 + d] * Kf[key * 65 + d];
        P[row * 145 + key] = s * 0.125f + F.in[I_RELB][t5_bucket(key - 128 - (row & 15)) * 16 + kh * 4 + (row >> 4)]; }
    __syncthreads();
    { const int row = tid >> 3, sub = tid & 7; const float sink = F.in[I_SINK][layer * 16 + kh * 4 + (row >> 4)]; float mx = -3.0e38f;
      for (int k = sub; k < 144; k += 8) mx = fmaxf(mx, P[row * 145 + k]);
      mx = fmaxf(mx, __shfl_xor(mx, 1)); mx = fmaxf(mx, __shfl_xor(mx, 2)); mx = fmaxf(mx, __shfl_xor(mx, 4)); mx = fmaxf(mx, sink);
      float sum = 0.f;
      for (int k = sub; k < 144; k += 8) { const float e = fexp(P[row * 145 + k] - mx); P[row * 145 + k] = e; sum += e; }
      sum += __shfl_xor(sum, 1); sum += __shfl_xor(sum, 2); sum += __shfl_xor(sum, 4);
      if (sub == 0) Pinv[row] = 1.0f / (sum + fexp(sink - mx)); }
    __syncthreads();
    { const int row = tid >> 3, d0 = (tid & 7) * 8; float o[8] = {0.f, 0.f, 0.f, 0.f, 0.f, 0.f, 0.f, 0.f};
      for (int k = 0; k < 144; ++k) { const float pv = P[row * 145 + k];
#pragma unroll
          for (int i = 0; i < 8; ++i) o[i] += pv * Vf[k * 64 + d0 + i]; }
      const float iv = Pinv[row];
#pragma unroll
      for (int i = 0; i < 8; ++i) o[i] *= iv;
      *(u32x4*)(H + (size_t)(row & 15) * DINP + C_Q + (kh * 4 + (row >> 4)) * 64 + d0) = pack8(o); }
}
__device__ __forceinline__ void sc_unit(const Frame& F, int layer, int tile) {
    const int tid = F.tid, cg = tid & 127, rs = tid >> 7; bf16_t* H = ws_bf(F, WS_H);
    const float* wsc = F.in[I_SCW] + (size_t)layer * 3 * D + 8 * cg; float wt[3][8];
#pragma unroll
    for (int i = 0; i < 3; ++i)
#pragma unroll
        for (int c = 0; c < 8; ++c) wt[i][c] = wsc[i * D + c];
    const int row0 = tile * 64 + 16 * rs; const bool smp = row0 >= NP; const int tt0 = smp ? 0 : row0 % SEQ;
    float u1[8], u2[8];
    if (tt0 >= 2) { float c8[8], h8[8];
        unpack8(*(const u32x4*)(H + (size_t)(row0 - 2) * DINP + C_SCC + 8 * cg), c8); unpack8(*(const u32x4*)(H + (size_t)(row0 - 2) * DINP + C_SCH + 8 * cg), h8);
#pragma unroll
        for (int c = 0; c < 8; ++c) u2[c] = c8[c] * h8[c];
        unpack8(*(const u32x4*)(H + (size_t)(row0 - 1) * DINP + C_SCC + 8 * cg), c8); unpack8(*(const u32x4*)(H + (size_t)(row0 - 1) * DINP + C_SCH + 8 * cg), h8);
#pragma unroll
        for (int c = 0; c < 8; ++c) u1[c] = c8[c] * h8[c]; }
    else if (smp) { const float* hp = F.in[I_SSC] + (((size_t)layer * DECB + ((row0 - NP) >> 4)) * 2) * D + 8 * cg;
#pragma unroll
        for (int c = 0; c < 8; ++c) { u2[c] = hp[c]; u1[c] = hp[D + c]; } }
    else {
#pragma unroll
        for (int c = 0; c < 8; ++c) { u2[c] = 0.f; u1[c] = 0.f; } }
#pragma unroll 1
    for (int q = 0; q < 4; ++q) {
        u32x4 cw_[4], hw_[4], bw_[4];
#pragma unroll
        for (int i = 0; i < 4; ++i) { const bf16_t* hp = H + (size_t)(row0 + 4 * q + i) * DINP + 8 * cg; cw_[i] = *(const u32x4*)(hp + C_SCC); hw_[i] = *(const u32x4*)(hp + C_SCH); bw_[i] = *(const u32x4*)(hp + C_SCB); }
        asm volatile("" ::: "memory");
#pragma unroll
        for (int i = 0; i < 4; ++i) { float c8[8], h8[8], b8[8], a[8]; unpack8(cw_[i], c8); unpack8(hw_[i], h8); unpack8(bw_[i], b8);
#pragma unroll
            for (int c = 0; c < 8; ++c) { const float u0 = c8[c] * h8[c]; a[c] = (u2[c] * wt[0][c] + u1[c] * wt[1][c] + u0 * wt[2][c]) * b8[c]; u2[c] = u1[c]; u1[c] = u0; }
            *(u32x4*)(H + (size_t)(row0 + 4 * q + i) * DINP + C_SCB + 8 * cg) = pack8(a); }
    }
}
__device__ __forceinline__ void state_out_unit(const Frame& F, int layer, int mb, int sl, bool smp) {
    const int tid = F.tid; const bf16_t* H = ws_bf(F, WS_H);
    const int nkv = smp ? DECS : WINDOW, len = smp ? DECS : SEQ; const size_t row0 = smp ? (size_t)NP + sl * 16 : (size_t)sl * SEQ; const int sg = smp ? sl : mb * NSEQ_MB + sl;
    const size_t nb_ = smp ? DECB : BATCH;
    float* ko = F.out + (smp ? O_KS : O_KP) + ((size_t)layer * nb_ + sg) * nkv * 256; float* vo = F.out + (smp ? O_VS : O_VP) + ((size_t)layer * nb_ + sg) * nkv * 256;
    for (int i = tid; i < nkv * 32; i += NTHREADS) { const int j = i >> 5, c8 = (i & 31) * 8; const bf16_t* hp = H + (row0 + len - nkv + j) * DINP; float f[8];
        unpack8(*(const u32x4*)(hp + C_K + c8), f); *(f32x4*)(ko + (size_t)j * 256 + c8) = (f32x4){f[0], f[1], f[2], f[3]}; *(f32x4*)(ko + (size_t)j * 256 + c8 + 4) = (f32x4){f[4], f[5], f[6], f[7]};
        unpack8(*(const u32x4*)(hp + C_V + c8), f); *(f32x4*)(vo + (size_t)j * 256 + c8) = (f32x4){f[0], f[1], f[2], f[3]}; *(f32x4*)(vo + (size_t)j * 256 + c8 + 4) = (f32x4){f[4], f[5], f[6], f[7]}; }
    float* co = F.out + (smp ? O_CVS : O_CVP) + ((size_t)layer * nb_ + sg) * 3 * CONVDIM;
    for (int i = tid; i < 3 * 512; i += NTHREADS) { const int j = i / 512, c8 = (i % 512) * 8; float f[8]; unpack8(*(const u32x4*)(H + (row0 + len - 3 + j) * DINP + C_X + c8), f);
        *(f32x4*)(co + (size_t)j * CONVDIM + c8) = (f32x4){f[0], f[1], f[2], f[3]}; *(f32x4*)(co + (size_t)j * CONVDIM + c8 + 4) = (f32x4){f[4], f[5], f[6], f[7]}; }
    float* so = F.out + (smp ? O_SCS : O_SCP) + ((size_t)layer * nb_ + sg) * 2 * D;
    for (int i = tid; i < 2 * 128; i += NTHREADS) { const int j = i >> 7, c8 = (i & 127) * 8; float c[8], h[8]; const bf16_t* hp = H + (row0 + len - 2 + j) * DINP;
        unpack8(*(const u32x4*)(hp + C_SCC + c8), c); unpack8(*(const u32x4*)(hp + C_SCH + c8), h);
        *(f32x4*)(so + (size_t)j * D + c8) = (f32x4){c[0] * h[0], c[1] * h[1], c[2] * h[2], c[3] * h[3]}; *(f32x4*)(so + (size_t)j * D + c8 + 4) = (f32x4){c[4] * h[4], c[5] * h[5], c[6] * h[6], c[7] * h[7]}; }
}
#ifndef MIX_MASK
#define MIX_MASK 0xFF
#endif
#define MIXON(b) ((MIX_MASK >> (b)) & 1)
__device__ __forceinline__ void step_premix(const Frame& F, int layer, int mb) {
    const int n_bc = NSEQ_MB * NCHUNK * 8, n_att = NSEQ_MB * NCHUNK * NKV, n_sc = rows_of(mb) / 64, n_so = NSEQ_MB + (mb == 0 ? DECB : 0);
    const int n_ss = mb == 0 ? DECB * 32 : 0, n_as = mb == 0 ? DECB * NKV : 0;
    const int total = n_bc + n_att + n_sc + n_so + n_ss + n_as;
#define UF(Fu) Frame Fu = F; Fu.lane = opq(lane_id()); Fu.tid = Fu.wave * 64 + Fu.lane
    PROBE_T0(14) if constexpr (MIXON(0)) { UF(Fu); BcRegs ra, rn_;
        if (F.bid < n_bc) ssd_bc_load(Fu, layer, F.bid, ra);
        for (int u = F.bid; u < n_bc; u += F.G) { const bool more = u + F.G < n_bc; if (more) ssd_bc_load(Fu, layer, u + F.G, rn_);
            ssd_bc_unit(Fu, u, ra);
            if (more) ra = rn_; } }
    PROBE_T1(14)
    for (int un = F.bid; un < total; un += F.G) { int r = un;
        if (r < n_bc) continue;
        r -= n_bc;
        if (r < n_att) { PROBE_T0(15) if constexpr (MIXON(1)) { UF(Fu); attn_prompt_unit(Fu, layer, r / (NCHUNK * NKV), (r / NKV) % NCHUNK, r % NKV); } PROBE_T1(15) continue; } r -= n_att;
        if (r < n_sc) { PROBE_T0(16) if constexpr (MIXON(2)) { UF(Fu); sc_unit(Fu, layer, r); } PROBE_T1(16) continue; } r -= n_sc;
        if (r < n_so) { PROBE_T0(17) if constexpr (MIXON(3)) { UF(Fu); state_out_unit(Fu, layer, mb, r < NSEQ_MB ? r : r - NSEQ_MB, r >= NSEQ_MB); } PROBE_T1(17) continue; } r -= n_so;
        if (r < n_ss) { PROBE_T0(18) if constexpr (MIXON(4)) { UF(Fu); ssd_sample_unit(Fu, layer, r >> 5, r & 31); } PROBE_T1(18) continue; } r -= n_ss;
        { PROBE_T0(19) if constexpr (MIXON(5)) { UF(Fu); attn_sample_unit(Fu, layer, r >> 2, r & 3); } PROBE_T1(19) }
    }
}
__device__ __forceinline__ void step_mixers(const Frame& F, int layer, int mb) {
    for (int v = F.bid; v < NSEQ_MB * 32; v += F.G) { const int un = (NSEQ_MB == 8 && F.G == 256) ? (v & 7) * 32 + (v >> 3) : v; UF(Fu); ssd_prompt_unit(Fu, layer, mb, un >> 5, un & 31); }
}
__device__ __forceinline__ void step_gnorm(const Frame& F, int mb) {
    const int gw = F.bid * NWAVES + F.wave, NGW = F.G * NWAVES, nr = rows_of(mb); bf16_t* H = ws_bf(F, WS_H); const float* ssq = ws_f(F, WS_SSQ);
    constexpr int RB = 4; const int g = F.lane >> 3;
    for (int r0 = gw; r0 < nr; r0 += RB * NGW) {
        u32x4 d[RB][4]; f32x4 q[RB];
#pragma unroll
        for (int i = 0; i < RB; ++i) { const int r = r0 + i * NGW < nr ? r0 + i * NGW : r0; { const f32x4 qa = *(const f32x4*)(ssq + (size_t)r * 64 + 8 * g), qb = *(const f32x4*)(ssq + (size_t)r * 64 + 8 * g + 4); q[i] = qa + qb; } const u32x4* p = (const u32x4*)(H + (size_t)r * DINP + C_Z + 32 * F.lane);
#pragma unroll
            for (int j = 0; j < 4; ++j) d[i][j] = p[j]; }
        asm volatile("" ::: "memory");
#pragma unroll
        for (int i = 0; i < RB; ++i) { const int r = r0 + i * NGW; if (r >= nr) continue;
            const float rstd = 1.0f / sqrtf(((q[i][0] + q[i][1]) + (q[i][2] + q[i][3])) * (1.0f / 256.0f) + LN_EPS); u32x4* p = (u32x4*)(H + (size_t)r * DINP + C_Z + 32 * F.lane);
#pragma unroll
            for (int j = 0; j < 4; ++j) { float f[8]; unpack8(d[i][j], f);
#pragma unroll
                for (int k = 0; k < 8; ++k) f[k] *= rstd;
                p[j] = pack8(f); } }
    }
}
constexpr int LOG_NEXP = NEXP == 32 ? 5 : (NEXP == 16 ? 4 : (NEXP == 8 ? 3 : 2));
template <int N, int MASK> struct RedStep {
    static __device__ __forceinline__ void run(float* v, int lane) {
        constexpr int Hn = N / 2; const bool up = (lane & MASK) != 0;
#pragma unroll
        for (int i = 0; i < Hn; ++i) { const float keep = up ? v[i + Hn] : v[i], send = up ? v[i] : v[i + Hn]; v[i] = keep + xshfl<MASK>(send); }
        if constexpr (Hn > 1) RedStep<Hn, (MASK >> 1)>::run(v, lane);
    }
};
__device__ __forceinline__ void step_ln1_router(const Frame& F, int layer, int mb) {
    LAS float* wT = (LAS float*)F.lds;
    const float* rw = F.in[I_RW] + (size_t)layer * D * NEXP;
    __syncthreads();
    for (int i = F.tid; i < D * NEXP; i += NTHREADS) { const int e = i / D, k = i % D; wT[i] = rw[(size_t)k * NEXP + e]; }
    unsigned* cnt = F.ctl + CW_CNT + (mb * DEPTH + layer) * 64;
    LAS unsigned* lcnt = (LAS unsigned*)(F.lds + MISC_OFF) + 128;
    if (F.tid < 64) lcnt[F.tid] = 0u;
    __syncthreads();
    const int gw = F.bid * NWAVES + F.wave, NGW = F.G * NWAVES, nr = rows_of(mb), lane = F.lane;
    const float* lg = F.in[I_LN1G] + (size_t)layer * D; const float* lb = F.in[I_LN1B] + (size_t)layer * D; const float* rb = F.in[I_RB] + (size_t)layer * NEXP;
    bf16_t* XB = ws_bf(F, WS_XB); int* topi = (int*)(F.ws + WS_TOPI); float* gate = ws_f(F, WS_GATE); int* pos = (int*)(F.ws + WS_POS);
    constexpr int RB = 4, NH = NEXP / 2, LOGH = LOG_NEXP - 1;
    const int myexp = ((lane & 1) * NH) | ((lane >> (6 - LOGH)) & (NH - 1));
    const float myb = rb[myexp];
    for (int r0 = gw; r0 < nr; r0 += RB * NGW) {
        f32x4 v[RB][4]; int rr[RB]; bool ok[RB];
#pragma unroll
        for (int i = 0; i < RB; ++i) { const int r = r0 + i * NGW; ok[i] = r < nr; rr[i] = ok[i] ? r : r0; const float* xr = x_out_row(F, mb, rr[i]);
#pragma unroll
            for (int j = 0; j < 4; ++j) v[i][j] = *((const f32x4*)xr + lane + 64 * j); }
        asm volatile("" ::: "memory");
#pragma unroll
        for (int i = 0; i < RB; ++i) {
            float* xr = x_out_row(F, mb, rr[i]); float s = 0.f;
#pragma unroll
            for (int j = 0; j < 4; ++j) s += (v[i][j][0] + v[i][j][1]) + (v[i][j][2] + v[i][j][3]);
            const float mean = wave_sum(s) * (1.0f / D); float s2 = 0.f;
#pragma unroll
            for (int j = 0; j < 4; ++j) { v[i][j] = v[i][j] - mean; s2 += (v[i][j][0] * v[i][j][0] + v[i][j][1] * v[i][j][1]) + (v[i][j][2] * v[i][j][2] + v[i][j][3] * v[i][j][3]); }
            const float rstd = 1.0f / sqrtf(wave_sum(s2) * (1.0f / D) + LN_EPS);
#pragma unroll
            for (int j = 0; j < 4; ++j) { const f32x4 gg = *((const f32x4*)lg + lane + 64 * j), bb = *((const f32x4*)lb + lane + 64 * j); v[i][j] = v[i][j] * rstd * gg + bb;
                if (ok[i]) { *((f32x4*)xr + lane + 64 * j) = v[i][j]; u32x2 w; w.x = pk2(v[i][j][0], v[i][j][1]); w.y = pk2(v[i][j][2], v[i][j][3]); *((u32x2*)(XB + (size_t)rr[i] * D) + lane + 64 * j) = w; } }
        }
        typedef float f32x2v __attribute__((ext_vector_type(2)));
        float val[RB];
#pragma unroll
        for (int hf = 0; hf < 2; ++hf) {
            float lgt[RB][NH];
#pragma unroll
            for (int e = 0; e < NH; ++e) { f32x2v a2[RB / 2];
#pragma unroll
                for (int i = 0; i < RB / 2; ++i) a2[i] = (f32x2v){0.f, 0.f};
#pragma unroll
                for (int j = 0; j < 4; ++j) { const f32x4 wv = *((const LAS f32x4*)(wT + (hf * NH + e) * D) + lane + 64 * j);
#pragma unroll
                    for (int c = 0; c < 4; ++c) { const f32x2v w2 = (f32x2v){wv[c], wv[c]};
#pragma unroll
                        for (int i = 0; i < RB / 2; ++i) a2[i] = __builtin_elementwise_fma((f32x2v){v[2 * i][j][c], v[2 * i + 1][j][c]}, w2, a2[i]); } }
#pragma unroll
                for (int i = 0; i < RB / 2; ++i) { lgt[2 * i][e] = a2[i].x; lgt[2 * i + 1][e] = a2[i].y; }
                if ((e & 1) == 1) asm volatile("" ::: "memory"); }
#pragma unroll
            for (int i = 0; i < RB; ++i) { RedStep<NH, 32>::run(lgt[i], lane); float tot = lgt[i][0];
                if constexpr ((32 >> LOGH) >= 8) tot += xshfl<8>(tot);
                if constexpr ((32 >> LOGH) >= 4) tot += xshfl<4>(tot);
                if constexpr ((32 >> LOGH) >= 2) tot += xshfl<2>(tot);
                tot += xshfl<1>(tot);
                if ((lane & 1) == hf) val[i] = tot + myb; }
        }
#pragma unroll
        for (int i = 0; i < RB; ++i) {
            float tv[4]; int te[4]; float vv = val[i];
#pragma unroll
            for (int k = 0; k < 4; ++k) { float m = vv; m = fmaxf(m, xshfl<1>(m)); m = fmaxf(m, xshfl<2>(m)); m = fmaxf(m, xshfl<4>(m)); m = fmaxf(m, xshfl<8>(m)); m = fmaxf(m, xshfl<16>(m)); m = fmaxf(m, xshfl<32>(m));
                const unsigned long long bal = __ballot(vv == m); const int wl = __builtin_ctzll(bal);
                const int be = ((wl & 1) * NH) | ((wl >> (6 - LOGH)) & (NH - 1));
                tv[k] = m; te[k] = be; if (myexp == be) vv = -3.0e38f; }
            const float e1 = fexp(tv[1] - tv[0]), e2 = fexp(tv[2] - tv[0]), e3 = fexp(tv[3] - tv[0]); const float inv = 1.0f / (1.0f + e1 + e2 + e3);
            if (lane < 4 && ok[i]) { const int e = lane == 0 ? te[0] : (lane == 1 ? te[1] : (lane == 2 ? te[2] : te[3])); const float gv = (lane == 0 ? 1.0f : (lane == 1 ? e1 : (lane == 2 ? e2 : e3))) * inv;
                const unsigned rk = __hip_atomic_fetch_add(lcnt + e, 1u, __ATOMIC_RELAXED, __HIP_MEMORY_SCOPE_WORKGROUP);
                topi[(size_t)rr[i] * 4 + lane] = e; gate[(size_t)rr[i] * 4 + lane] = gv; pos[(size_t)rr[i] * 4 + lane] = (int)rk; }
        }
    }
    __syncthreads();
    if (F.tid < NEXP) lcnt[32 + F.tid] = __hip_atomic_fetch_add(cnt + F.tid, lcnt[F.tid], __ATOMIC_RELAXED, __HIP_MEMORY_SCOPE_AGENT);
    __syncthreads();
    for (int r = gw; r < nr; r += NGW) if (lane < 4) pos[(size_t)r * 4 + lane] += (int)lcnt[32 + topi[(size_t)r * 4 + lane]];
}
__device__ __forceinline__ int moe_table(const Frame& F, int layer, int mb) {
    LAS int* M = (LAS int*)(F.lds + MISC_OFF);
    __syncthreads();
    if (F.tid == 0) { unsigned* cnt = F.ctl + CW_CNT + (mb * DEPTH + layer) * 64; int acc = 0;
        for (int e = 0; e < NEXP; ++e) { const int c = (int)__hip_atomic_load(cnt + e, __ATOMIC_RELAXED, __HIP_MEMORY_SCOPE_AGENT); M[64 + e] = acc * 256; acc += (c + 255) / 256; M[16 + e] = acc; } }
    __syncthreads();
    return M[16 + NEXP - 1];
}
__device__ __forceinline__ void step_gather(const Frame& F, int layer, int mb) {
    (void)moe_table(F, layer, mb); const LAS int* M = (const LAS int*)(F.lds + MISC_OFF);
    const int nr = rows_of(mb);
    const int* topi = (const int*)(F.ws + WS_TOPI); const float* gate = ws_f(F, WS_GATE); int* pos = (int*)(F.ws + WS_POS); float* gs = ws_f(F, WS_GSORT); int* rtok = (int*)(F.ws + WS_RTOK);
#pragma nounroll
    for (int i = F.bid * NTHREADS + F.tid; i < nr * 4; i += F.G * NTHREADS) { const int p = M[64 + topi[i]] + pos[i]; pos[i] = p; rtok[p] = i >> 2; gs[p] = gate[i]; }
}
__device__ __forceinline__ void step_ln2(const Frame& F, int layer, int mb) {
    const int gw = F.bid * NWAVES + F.wave, NGW = F.G * NWAVES, nr = rows_of(mb), lane = F.lane;
    const float* lg = F.in[I_LN2G] + (size_t)layer * D; const float* lb = F.in[I_LN2B] + (size_t)layer * D;
    const bf16_t* OUTS = ws_bf(F, WS_H) + (size_t)2 * RP * D; const int* pos = (const int*)(F.ws + WS_POS); bf16_t* XB = ws_bf(F, WS_XB);
    constexpr int RB = 2;
    for (int r0 = gw; r0 < nr; r0 += RB * NGW) {
        f32x4 v[RB][4]; u32x2 ow[RB][4][4]; int rr[RB];
#pragma unroll
        for (int i = 0; i < RB; ++i) { rr[i] = r0 + i * NGW < nr ? r0 + i * NGW : r0; const float* xr = x_out_row(F, mb, rr[i]); int p[4];
#pragma unroll
            for (int k = 0; k < 4; ++k) p[k] = pos[(size_t)rr[i] * 4 + k];
#pragma unroll
            for (int j = 0; j < 4; ++j) { v[i][j] = *((const f32x4*)xr + lane + 64 * j);
#pragma unroll
                for (int k = 0; k < 4; ++k) ow[i][k][j] = *((const u32x2*)(OUTS + (size_t)p[k] * D) + lane + 64 * j); } }
        asm volatile("" ::: "memory");
#pragma unroll
        for (int i = 0; i < RB; ++i) { if (r0 + i * NGW >= nr) continue;
            float* xr = x_out_row(F, mb, rr[i]); float s = 0.f;
#pragma unroll
            for (int j = 0; j < 4; ++j) { v[i][j] = v[i][j] * ALPHA;
#pragma unroll
                for (int k = 0; k < 4; ++k) { const u32x2 w = ow[i][k][j]; v[i][j] = v[i][j] + (f32x4){blo(w.x), bhi(w.x), blo(w.y), bhi(w.y)}; }
                s += (v[i][j][0] + v[i][j][1]) + (v[i][j][2] + v[i][j][3]); }
            const float mean = wave_sum(s) * (1.0f / D); float s2 = 0.f;
#pragma unroll
            for (int j = 0; j < 4; ++j) { v[i][j] = v[i][j] - mean; s2 += (v[i][j][0] * v[i][j][0] + v[i][j][1] * v[i][j][1]) + (v[i][j][2] * v[i][j][2] + v[i][j][3] * v[i][j][3]); }
            const float rstd = 1.0f / sqrtf(wave_sum(s2) * (1.0f / D) + LN_EPS);
#pragma unroll
            for (int j = 0; j < 4; ++j) { const f32x4 gg = *((const f32x4*)lg + lane + 64 * j), bb = *((const f32x4*)lb + lane + 64 * j); v[i][j] = v[i][j] * rstd * gg + bb;
                *((f32x4*)xr + lane + 64 * j) = v[i][j]; u32x2 w; w.x = pk2(v[i][j][0], v[i][j][1]); w.y = pk2(v[i][j][2], v[i][j][3]); *((u32x2*)(XB + (size_t)rr[i] * D) + lane + 64 * j) = w; } }
    }
}

constexpr int PH_PER = 11, NSTEPS = 1 + NMB * DEPTH * PH_PER;
__global__ void __launch_bounds__(NTHREADS, 2) fwd(Args args) {
#ifdef EMU
    unsigned char* lds = emu_wg->lds;
#else
    extern __shared__ __attribute__((aligned(16))) unsigned char lds[];
#endif
    Frame F0; F0.lds = (LAS unsigned char*)lds; F0.tid = threadIdx.x; F0.lane = F0.tid & 63; F0.wave = __builtin_amdgcn_readfirstlane(F0.tid >> 6); F0.G = gridDim.x; F0.bid = blockIdx.x;
#ifdef EMU
    F0.in = args.in;
#else
    F0.in = (ArgTab)__builtin_amdgcn_kernarg_segment_ptr();
    static_assert(offsetof(Args, out) == 248 && offsetof(Args, ws) == 256 && offsetof(Args, in) == 0, "PF() reads the argument struct by offset");
#endif
    F0.out = args.out; F0.ws = args.ws; F0.ctl = (unsigned*)(args.ws + WS_CTL);
    const Frame& F = F0;
    const int lo = args.lo, hi = args.hi;
#ifndef EMU
    for (int u = F.tid; u < (LDS_BYTES - MISC_OFF) / 4; u += NTHREADS) ((LAS unsigned*)(F.lds + MISC_OFF))[u] = 0u;
    __syncthreads();
    XcdBarrier bar; bar.bar = F.ctl + CW_BAR; bar.x = 0; bar.st = nullptr;
    if (hi - lo > 1) bar = xcd_barrier_post(F.ctl + CW_BAR, (volatile LAS unsigned*)(F.lds + MISC_OFF) + 8);
#define SEAM(s) do { if ((s) + 1 < hi) { XcdBarrier b2_ = bar; unsigned long long bp_ = (unsigned long long)b2_.bar; asm volatile("" : "+s"(bp_)); b2_.bar = (unsigned*)bp_; xcd_barrier(b2_); } } while (0)
#else
#define SEAM(s) do { } while (0)
#endif
#ifndef PH_MASK
#define PH_MASK 0xFFFFFFFF
#endif
#define IN(s) (lo <= (s) && (s) < hi)
#define PHON(b) ((PH_MASK >> (b)) & 1)
#ifdef EMU
#define PF(Fp) Frame Fp = F0
#else
#define PF(Fp) Frame Fp; { unsigned long long kp_ = (unsigned long long)__builtin_amdgcn_kernarg_segment_ptr(); asm volatile("" : "+s"(kp_)); \
    Fp.in = (ArgTab)kp_; Fp.out = *(float* const __attribute__((address_space(4)))*)(kp_ + 248); Fp.ws = *(unsigned char* const __attribute__((address_space(4)))*)(kp_ + 256); Fp.ctl = (unsigned*)Fp.ws; \
    Fp.lds = F0.lds; Fp.G = F0.G; Fp.bid = F0.bid; Fp.wave = F0.wave; Fp.lane = opq(lane_id()); Fp.tid = Fp.wave * 64 + Fp.lane; }
#endif
    int step = 0;
    if (IN(step)) { PROBE_T0(0) if constexpr (PHON(0)) { PF(F); step_weights(F); for (int m = 0; m < NMB; ++m) step_xb(F, m); } PROBE_T1(0) SEAM(step); }
    ++step;
#define PHV const int mb = opqs(mb0), layer = opqs(layer0), nr = rows_of(mb); (void)nr; (void)layer
    for (int mb0 = 0; mb0 < NMB; ++mb0)
        for (int layer0 = 0; layer0 < DEPTH; ++layer0) {
            if (IN(step)) { PROBE_T0(2) if constexpr (PHON(2)) { PF(F); PHV; pg8::Gemm g{layer == 0 ? ws_bf(F, WS_XB0) + (size_t)mb * R * D : ws_bf(F, WS_XB), wl_ptr(F, layer, WL_IN), nr, DINP, D, D, nullptr}; pg8::StaticOrder S; S.init(nr, DINP, F.G, F.bid);
                pg8::EpiStoreBf16 E{ws_bf(F, WS_H), DINP}; pg8::gemm_phase(F.lds, g, S, E, F.wave); } PROBE_T1(2) SEAM(step); }
            ++step;
            if (IN(step)) { PROBE_T0(13) if constexpr (PHON(13)) { PF(F); PHV; step_premix(F, layer, mb); } PROBE_T1(13) SEAM(step); }
            ++step;
            if (IN(step)) { PROBE_T0(3) if constexpr (PHON(3)) { PF(F); PHV; step_mixers(F, layer, mb); } PROBE_T1(3) SEAM(step); }
            ++step;
            if (IN(step)) { PROBE_T0(4) if constexpr (PHON(4)) { PF(F); PHV; step_gnorm(F, mb); } PROBE_T1(4) SEAM(step); }
            ++step;
            if (IN(step)) { PROBE_T0(5) if constexpr (PHON(5)) { PF(F); PHV; pg8::StaticOrder S; S.init(nr, D, F.G, F.bid); bf16_t* H = ws_bf(F, WS_H); bf16_t* MGb = ws_bf(F, WS_XB);
#ifndef MERGE_MASK
#define MERGE_MASK 7
#endif
                if constexpr (MERGE_MASK & 1) { pg8::Gemm g{H + C_Z, wl_ptr(F, layer, WL_SSD), nr, D, DINNER, DINP, nullptr}; pg8::EpiGate<0> E{H + C_GSSD, MGb}; pg8::gemm_phase(F.lds, g, S, E, F.wave); }
                if constexpr (MERGE_MASK & 2) { pg8::Gemm g{H + C_Q, wl_ptr(F, layer, WL_ATT), nr, D, D, DINP, nullptr}; pg8::EpiGate<1> E{H + C_GATT, MGb}; pg8::gemm_phase(F.lds, g, S, E, F.wave); }
                if constexpr (MERGE_MASK & 4) { pg8::Gemm g{H + C_SCB, wl_ptr(F, layer, WL_SC), nr, D, D, DINP, nullptr}; pg8::EpiGate<1> E{H + C_GSC, MGb}; pg8::gemm_phase(F.lds, g, S, E, F.wave); } }
                PROBE_T1(5) SEAM(step); }
            ++step;
            if (IN(step)) { PROBE_T0(6) if constexpr (PHON(6)) { PF(F); PHV; pg8::Gemm g{ws_bf(F, WS_XB), wl_ptr(F, layer, WL_O), nr, D, D, D, nullptr}; pg8::StaticOrder S; S.init(nr, D, F.G, F.bid);
                pg8::EpiResid E{layer == 0 ? F.in[I_XP] + (size_t)mb * NP * D : F.out + O_YP + (size_t)mb * NP * D, layer == 0 ? F.in[I_XS] : F.out + O_YS, F.out + O_YP + (size_t)mb * NP * D, F.out + O_YS};
                pg8::gemm_phase(F.lds, g, S, E, F.wave); } PROBE_T1(6) SEAM(step); }
            ++step;
            if (IN(step)) { PROBE_T0(7) if constexpr (PHON(7)) { PF(F); PHV; step_ln1_router(F, layer, mb); } PROBE_T1(7) SEAM(step); }
            ++step;
            if (IN(step)) { PROBE_T0(8) if constexpr (PHON(8)) { PF(F); PHV; step_gather(F, layer, mb); } PROBE_T1(8) SEAM(step); }
            ++step;
            if (IN(step)) { PROBE_T0(9) if constexpr (PHON(9)) { PF(F); PHV; const int nt = moe_table(F, layer, mb); pg8::MoeOrder S{(const LAS int*)(F.lds + MISC_OFF) + 16, 8, nt * 8, F.G, F.bid};
                pg8::Gemm g{ws_bf(F, WS_XB), wl_ptr(F, layer, WL_UP), nr  , 2048, D, D, (const int*)(F.ws + WS_RTOK)}; pg8::EpiSwiglu E{ws_bf(F, WS_H) + (size_t)RP * D, F.in[I_BUP] + (size_t)layer * NEXP * 2048};
                pg8::gemm_phase<pg8::EpiSwiglu, pg8::MoeOrder, true>(F.lds, g, S, E, F.wave); } PROBE_T1(9) SEAM(step); }
            ++step;
            if (IN(step)) { PROBE_T0(10) if constexpr (PHON(10)) { PF(F); PHV; const int nt = moe_table(F, layer, mb); pg8::MoeOrder S{(const LAS int*)(F.lds + MISC_OFF) + 16, 4, nt * 4, F.G, F.bid};
                pg8::Gemm g{ws_bf(F, WS_H) + (size_t)RP * D, wl_ptr(F, layer, WL_DN), nt * 256, D, D, D, nullptr}; pg8::EpiDown E{ws_bf(F, WS_H) + (size_t)2 * RP * D, F.in[I_BDN] + (size_t)layer * NEXP * D, ws_f(F, WS_GSORT)};
                pg8::gemm_phase(F.lds, g, S, E, F.wave); } PROBE_T1(10) SEAM(step); }
            ++step;
            if (IN(step)) { PROBE_T0(11) if constexpr (PHON(11)) { PF(F); PHV; step_ln2(F, layer, mb); } PROBE_T1(11) SEAM(step); }
            ++step;
        }
}

#ifdef EMU
extern int emu_grid, emu_step_lo, emu_step_hi;
#endif
extern "C" void kernel_launch(void* const* d_in, const int* in_sizes, int n_in, void* d_out, int out_size, void* d_ws, size_t ws_size, hipStream_t stream) {
    (void)in_sizes; (void)out_size;
    if (n_in != 31 || ws_size < WS_END) { fprintf(stderr, "kernel_launch: expected 31 inputs and >= %zu bytes of workspace (got %d, %zu)\n", (size_t)WS_END, n_in, ws_size); return; }
    Args a; memset(&a, 0, sizeof(a));
    for (int i = 0; i < 31; ++i) a.in[i] = (const float*)d_in[i];
    a.out = (float*)d_out; a.ws = (unsigned char*)d_ws;
#ifdef EMU
    if (emu_step_lo == 0) memset((char*)d_ws + WS_CTL, 0, CTL_BYTES);
    for (int s = emu_step_lo; s < emu_step_hi && s < NSTEPS; ++s) { a.lo = s; a.hi = s + 1; emu_launch(fwd, emu_grid, NTHREADS, LDS_BYTES, a); fprintf(stderr, "step %d done\n", s); }
#else
    (void)hipMemsetAsync((char*)d_ws + WS_CTL, 0, CTL_BYTES, stream);
    static int grid = 0;
    if (grid == 0) {
        int dev = 0, cus = 0;
        if (hipGetDevice(&dev) != hipSuccess || hipDeviceGetAttribute(&cus, hipDeviceAttributeMultiprocessorCount, dev) != hipSuccess) { grid = -1; return; }
        if (hipFuncSetAttribute((const void*)fwd, hipFuncAttributeMaxDynamicSharedMemorySize, LDS_BYTES) != hipSuccess) { grid = -1; return; }
        int per_cu = 0; (void)hipOccupancyMaxActiveBlocksPerMultiprocessor(&per_cu, (const void*)fwd, NTHREADS, LDS_BYTES); (void)hipGetLastError();
        grid = cus;
    }
    if (grid < 0) return;
#if CFG_ONE_LAUNCH
    a.lo = 0; a.hi = NSTEPS; hipLaunchKernelGGL(fwd, dim3(grid), dim3(NTHREADS), LDS_BYTES, stream, a);
#else
    for (int s = 0; s < NSTEPS; ++s) { a.lo = s; a.hi = s + 1; hipLaunchKernelGGL(fwd, dim3(grid), dim3(NTHREADS), LDS_BYTES, stream, a); }
#endif
#endif
}
```

```cpp
#ifdef EMU
#include "emu.h"
#else
#include <hip/hip_runtime.h>
#endif
#include <cstdio>
#include <cstdint>
#include <cstring>
#include <cstddef>
#include <cmath>

#ifndef CFG_BATCH
#define CFG_BATCH 16
#endif
#ifndef CFG_SEQ
#define CFG_SEQ 4096
#endif
#ifndef CFG_NSEQ_MB
#define CFG_NSEQ_MB 8
#endif
#ifndef CFG_NEXP
#define CFG_NEXP 32
#endif
#ifndef CFG_ONE_LAUNCH
#define CFG_ONE_LAUNCH 1
#endif

constexpr int BATCH = CFG_BATCH, SEQ = CFG_SEQ, NSEQ_MB = CFG_NSEQ_MB, NEXP = CFG_NEXP, NMB = BATCH / NSEQ_MB;
constexpr int D = 1024, DEPTH = 2, DECB = 16, DECS = 16, NS = DECB * DECS;
constexpr int DINNER = 2048, CONVDIM = 4096;
constexpr int NKV = 4, WINDOW = 128, CHUNK = 64;
constexpr int DIN = 13856, DINP = 14080;
constexpr int NP = NSEQ_MB * SEQ, R = NP + NS;
constexpr int RP = ((4 * R + NEXP * 255) + 255) / 256 * 256;
constexpr int NCHUNK = SEQ / CHUNK;
constexpr int C_Z = 0, C_X = 2048, C_B = 4096, C_C = 5120, C_Q = 6144, C_K = 7168, C_V = 7424, C_SCB = 7680, C_SCC = 8704, C_SCH = 9728, C_GSSD = 10752, C_GATT = 11776, C_GSC = 12800, C_DT = 13824;
constexpr float LN_EPS = 1e-5f, ALPHA = 1.41421356237309515f  , SW_LIMIT = 7.0f, SW_ALPHA = 1.702f;
static_assert(BATCH % NSEQ_MB == 0 && SEQ % 256 == 0 && (NEXP & (NEXP - 1)) == 0 && NEXP <= 32 && NEXP >= 4, "config");

constexpr size_t O_YP = 0, O_YS = O_YP + (size_t)BATCH * SEQ * D, O_KP = O_YS + (size_t)NS * D, O_VP = O_KP + (size_t)DEPTH * BATCH * WINDOW * 256,
    O_SSP = O_VP + (size_t)DEPTH * BATCH * WINDOW * 256, O_CVP = O_SSP + (size_t)DEPTH * BATCH * 32 * 64 * 128, O_SCP = O_CVP + (size_t)DEPTH * BATCH * 3 * CONVDIM,
    O_KS = O_SCP + (size_t)DEPTH * BATCH * 2 * D, O_VS = O_KS + (size_t)DEPTH * DECB * DECS * 256, O_SSS = O_VS + (size_t)DEPTH * DECB * DECS * 256,
    O_CVS = O_SSS + (size_t)DEPTH * DECB * 32 * 64 * 128, O_SCS = O_CVS + (size_t)DEPTH * DECB * 3 * CONVDIM, O_END = O_SCS + (size_t)DEPTH * DECB * 2 * D;

constexpr size_t al256(size_t x) { return (x + 255) / 256 * 256; }
constexpr size_t WS_CTL = 0, CTL_BYTES = 1u << 20;
constexpr size_t WS_SSQ = CTL_BYTES, WS_TOPI = WS_SSQ + al256((size_t)R * 64 * 4), WS_GATE = WS_TOPI + al256((size_t)R * 16), WS_POS = WS_GATE + al256((size_t)R * 16),
    WS_GSORT = WS_POS + al256((size_t)R * 16), WS_RTOK = WS_GSORT + al256((size_t)RP * 4), WS_W = WS_RTOK + al256((size_t)RP * 4);
constexpr size_t WL_IN = 0, WL_SSD = WL_IN + (size_t)DINP * D * 2, WL_ATT = WL_SSD + (size_t)D * DINNER * 2, WL_SC = WL_ATT + (size_t)D * D * 2, WL_O = WL_SC + (size_t)D * D * 2,
    WL_UP = WL_O + (size_t)D * D * 2, WL_DN = WL_UP + (size_t)NEXP * 2048 * D * 2, WL_BYTES = WL_DN + (size_t)NEXP * D * D * 2;
constexpr size_t WS_XB = WS_W + DEPTH * WL_BYTES, WS_XB0 = WS_XB + (size_t)R * D * 2  , WS_PRE = WS_XB0 + (size_t)NMB * R * D * 2  , WS_H = WS_PRE + (size_t)R * D * 2;
constexpr size_t H_BYTES = (size_t)R * DINP * 2, MOE_BYTES = (size_t)3 * RP * D * 2, U_BYTES = H_BYTES > MOE_BYTES ? H_BYTES : MOE_BYTES;
constexpr size_t WS_CMC = WS_H + U_BYTES, WS_BTG = WS_CMC + (size_t)NP * 1024 * 2, WS_CBG = WS_BTG + (size_t)NSEQ_MB * NCHUNK * 8 * 8192 * 2, WS_END = WS_CBG + (size_t)NSEQ_MB * NCHUNK * 8 * 4096 * 2;
static_assert(WS_END <= ((size_t)2 << 30), "workspace map exceeds 2 GiB");
constexpr int CW_BAR = 4096, CW_CNT = 16384;

constexpr int RING_BYTES = 131072, LDS_BYTES = 163840  , MISC_OFF = LDS_BYTES - 1024, SCR_BYTES = MISC_OFF;
constexpr int NWAVES = 8, NTHREADS = 512;

#ifdef EMU
#define LAS
#define WAVE_SYNC() emu_wave_barrier()
#else
#define LAS __attribute__((address_space(3)))
#define WAVE_SYNC() asm volatile("s_waitcnt lgkmcnt(0)" ::: "memory")
#endif
#ifdef EMU
#define LBAR() emu_wg_barrier()
#define VM_WAIT(n) do { } while (0)
#else
#define LBAR() do { asm volatile("s_waitcnt lgkmcnt(0)" ::: "memory"); __builtin_amdgcn_s_barrier(); asm volatile("" ::: "memory"); } while (0)
#define VM_WAIT(n) asm volatile("s_waitcnt vmcnt(" #n ")" ::: "memory")
#endif
typedef unsigned short bf16_t;
typedef short bf16x8 __attribute__((ext_vector_type(8)));
typedef float f32x4 __attribute__((ext_vector_type(4)));
typedef float f32x16 __attribute__((ext_vector_type(16)));
typedef unsigned u32x4 __attribute__((ext_vector_type(4)));
typedef unsigned u32x2 __attribute__((ext_vector_type(2)));

__device__ __forceinline__ unsigned f2bf(float f) { unsigned u = __builtin_bit_cast(unsigned, f); return (u + 0x7fffu + ((u >> 16) & 1u)) >> 16; }
__device__ __forceinline__ float bf2f(unsigned h) { return __builtin_bit_cast(float, (h & 0xffffu) << 16); }
#ifdef EMU
__device__ __forceinline__ unsigned pk2(float lo, float hi) { return f2bf(lo) | (f2bf(hi) << 16); }
#else
typedef float f32x2_t __attribute__((ext_vector_type(2))); typedef __bf16 bf16x2_t __attribute__((ext_vector_type(2)));
__device__ __forceinline__ unsigned pk2(float lo, float hi) { f32x2_t v = {lo, hi}; bf16x2_t b = __builtin_convertvector(v, bf16x2_t); return __builtin_bit_cast(unsigned, b); }
#endif
#ifdef EMU
__device__ __forceinline__ unsigned short bf1(float f) { return (unsigned short)f2bf(f); }
#else
__device__ __forceinline__ unsigned short bf1(float f) { return (unsigned short)pk2(f, f); }
#endif
__device__ __forceinline__ float blo(unsigned w) { return __builtin_bit_cast(float, w << 16); }
__device__ __forceinline__ float bhi(unsigned w) { return __builtin_bit_cast(float, w & 0xffff0000u); }
__device__ __forceinline__ void unpack8(const u32x4 w, float* f) { f[0] = blo(w.x); f[1] = bhi(w.x); f[2] = blo(w.y); f[3] = bhi(w.y); f[4] = blo(w.z); f[5] = bhi(w.z); f[6] = blo(w.w); f[7] = bhi(w.w); }
__device__ __forceinline__ u32x4 pack8(const float* f) { u32x4 w; w.x = pk2(f[0], f[1]); w.y = pk2(f[2], f[3]); w.z = pk2(f[4], f[5]); w.w = pk2(f[6], f[7]); return w; }
__device__ __forceinline__ float fexp(float x) { return __builtin_amdgcn_exp2f(x * 1.4426950408889634f); }
__device__ __forceinline__ float fsigmoid(float x) { return __builtin_amdgcn_rcpf(1.0f + __builtin_amdgcn_exp2f(-1.4426950408889634f * x)); }
__device__ __forceinline__ float fsilu(float x) { return x * fsigmoid(x); }
#ifdef EMU
__device__ __forceinline__ int opq(int x) { return x; }
#else
__device__ __forceinline__ int opq(int x) { asm volatile("" : "+v"(x)); return x; }
#endif
#ifdef EMU
__device__ __forceinline__ int opqs(int x) { return x; }
#else
__device__ __forceinline__ int opqs(int x) { asm volatile("" : "+s"(x)); return x; }
#endif
#ifdef EMU
__device__ __forceinline__ int lane_id() { return (int)(threadIdx.x & 63); }
#else
__device__ __forceinline__ int lane_id() { return (int)__builtin_amdgcn_mbcnt_hi(~0u, __builtin_amdgcn_mbcnt_lo(~0u, 0u)); }
#endif
#ifdef EMU
template <int MASK> __device__ __forceinline__ unsigned xshfl_u(unsigned x) { return __shfl_xor(x, MASK); }
#else
template <int MASK> __device__ __forceinline__ unsigned xshfl_u(unsigned x) {
    if constexpr (MASK == 1) return (unsigned)__builtin_amdgcn_update_dpp((int)x, (int)x, 0xB1, 0xF, 0xF, false);
    else if constexpr (MASK == 2) return (unsigned)__builtin_amdgcn_update_dpp((int)x, (int)x, 0x4E, 0xF, 0xF, false);
    else if constexpr (MASK == 4) { const int t = __builtin_amdgcn_update_dpp((int)x, (int)x, 0x114, 0xF, 0xA, false);
        return (unsigned)__builtin_amdgcn_update_dpp(t, (int)x, 0x104, 0xF, 0x5, false); }
    else if constexpr (MASK == 8) return (unsigned)__builtin_amdgcn_update_dpp((int)x, (int)x, 0x128, 0xF, 0xF, false);
    else if constexpr (MASK == 16) { const auto rr = __builtin_amdgcn_permlane16_swap(x, x, false, false); return (lane_id() & 16) ? rr[0] : rr[1]; }
    else { const auto rr = __builtin_amdgcn_permlane32_swap(x, x, false, false); return (lane_id() & 32) ? rr[0] : rr[1]; }
}
#endif
template <int MASK> __device__ __forceinline__ float xshfl(float x) { return __builtin_bit_cast(float, xshfl_u<MASK>(__builtin_bit_cast(unsigned, x))); }
template <int MASK> __device__ __forceinline__ int xshfl(int x) { return (int)xshfl_u<MASK>((unsigned)x); }
__device__ __forceinline__ float wave_sum(float v) { v += xshfl<1>(v); v += xshfl<2>(v); v += xshfl<4>(v); v += xshfl<8>(v); v += xshfl<16>(v); v += xshfl<32>(v); return v; }

#ifndef PROBE_MASK
#define PROBE_MASK 0
#endif
#if PROBE_MASK && !defined(EMU)
#define PROBE_T0(b) unsigned long long pt0_ = 0; if constexpr ((PROBE_MASK >> (b)) & 1) pt0_ = __builtin_amdgcn_s_memrealtime();
#define PROBE_T1(b) if constexpr ((PROBE_MASK >> (b)) & 1) { asm volatile("s_waitcnt vmcnt(0) lgkmcnt(0)" ::: "memory"); const unsigned long long pt1_ = __builtin_amdgcn_s_memrealtime(); \
    while (__builtin_amdgcn_s_memrealtime() < pt1_ + (pt1_ - pt0_)) __builtin_amdgcn_s_sleep(8); }
#else
#define PROBE_T0(b)
#define PROBE_T1(b)
#endif
namespace pg8 {
constexpr int BM = 256, BK = 64, HALF = 128, HTB = HALF * BK * 2, NXCD = 8, WGM = 8;
struct Unit { int pm, pn, bt, e; };
struct Gemm { const bf16_t* A; const bf16_t* Bt; int M, N, K, lda; const int* tok; };
struct StaticOrder {
    int nM, nN, nwg, G, c;
    __host__ __device__ void init(int M, int N, int G_, int c_) { nM = M / BM; nN = N / BM; nwg = nM * nN; G = G_; c = c_; }
    __host__ __device__ bool next(int i, Unit& u) const {
        const long L = (long)i * G + c; if (L >= nwg) return false;
        int wgid = (int)L; { const int q = nwg / NXCD, r = nwg % NXCD, xcd = wgid % NXCD, off = wgid / NXCD; wgid = (xcd < r ? xcd * (q + 1) : r * (q + 1) + (xcd - r) * q) + off; }
        const int nig = WGM * nN, gid = wgid / nig, fm = gid * WGM, gsz = (nM - fm) < WGM ? (nM - fm) : WGM;
        u.pm = fm + ((wgid % nig) % gsz); u.pn = (wgid % nig) / gsz; u.bt = u.pn; u.e = 0; return true;
    }
    __device__ __forceinline__ void a_ready(const Unit&) const {}
    __device__ __forceinline__ void done(const Unit&) const {}
};
struct MoeOrder {
    const LAS int* tend; int npn, ntot, G, c;
    __device__ __forceinline__ bool next(int i, Unit& u) const {
        int rt, pn;
        {
            const int xcd = c & 7, j = c >> 3, rpx = (G >> 3) / npn; rt = (i * 8 + xcd) * rpx + j / npn; pn = j % npn; if (rt >= ntot / npn) return false; }
        int e = 0;
#pragma unroll
        for (int j = 0; j < NEXP; ++j) e += (tend[j] <= rt) ? 1 : 0;
        u.pm = rt; u.pn = pn; u.e = e; u.bt = e * npn + pn; return true;
    }
    __device__ __forceinline__ void a_ready(const Unit&) const {}
    __device__ __forceinline__ void done(const Unit&) const {}
};
#ifdef EMU
template <class Epi, class Sched, bool GATHER = false>
__device__ void gemm_phase(LAS unsigned char* lds, const Gemm g, const Sched& S, const Epi& E, int  ) {
    const int tid = threadIdx.x, wid = tid >> 6, lane = tid & 63, wr = wid >> 2, wc = wid & 3, fr = lane & 15, fq = lane >> 4;
    Unit u;
    for (int i = 0; S.next(i, u); ++i) {
        f32x4 acc[2][2][4][2];
        for (int ai = 0; ai < 2; ++ai) for (int bj = 0; bj < 2; ++bj) for (int m = 0; m < 4; ++m) for (int n = 0; n < 2; ++n) for (int q = 0; q < 4; ++q) {
            const int row = u.pm * 256 + ai * 128 + wr * 64 + m * 16 + fr, col = u.bt * 256 + bj * 128 + wc * 32 + 8 * fq + 4 * n + q;
            const bf16_t* a = g.A + (size_t)(GATHER ? ((unsigned)g.tok[row] < (unsigned)g.M ? g.tok[row] : 0) : row) * g.lda; const bf16_t* b = g.Bt + (size_t)col * g.K; float s = 0.f;
            for (int k = 0; k < g.K; ++k) s += bf2f(a[k]) * bf2f(b[k]);
            acc[ai][bj][m][n][q] = s; }
        E(acc, u, wr, wc, fr, fq);
    }
    __syncthreads();
}
#else
#define PG8_LAS __attribute__((address_space(3)))
__host__ __device__ __forceinline__ int lds_byte(int r, int c) { const int st = (r >> 4) * 2 + (c >> 5), rr = r & 15, cc = c & 31, ob = rr * 64 + cc * 2; return st * 1024 + (ob ^ (((ob >> 9) & 1) << 5)); }
__host__ __device__ __forceinline__ void stage_rc(int b, int& R_, int& C_) { const int st = b / 1024, sb = b % 1024, swz = sb ^ (((sb >> 9) & 1) << 5); R_ = (st >> 1) * 16 + swz / 64; C_ = (st & 1) * 32 + (swz % 64) / 2; }
__host__ __device__ __forceinline__ int perm32(int rho) { const int n = rho >> 4, i = rho & 15; return 8 * (i >> 2) + 4 * n + (i & 3); }
template <class Epi, class Sched, bool GATHER = false>
__device__ __forceinline__ void gemm_phase(PG8_LAS unsigned char* lds, const Gemm g, const Sched& S, const Epi& E, int wave_id) {
    const int lane = opq(lane_id()), wid = __builtin_amdgcn_readfirstlane(wave_id), tid = wid * 64 + lane, wr = wid >> 2, wc = wid & 3, fr = lane & 15, fq = lane >> 4;
    const int K = g.K, nt = K / BK, lda = g.lda;
    unsigned voffA[2], voffB[2];
#pragma unroll
    for (int i = 0; i < 2; ++i) { int R_, C_; stage_rc(tid * 16 + i * 8192, R_, C_); const int Rb = (R_ & ~31) + perm32(R_ & 31);
        voffA[i] = (unsigned)(R_ * lda + C_) * 2u; voffB[i] = (unsigned)(Rb * K + C_) * 2u; }
    unsigned vG[2][2], vN[2][2];
#define PG8_TOK(dst, pm_) do { _Pragma("unroll") for (int i_ = 0; i_ < 2; ++i_) { int R_, C_; stage_rc(opq(tid) * 16 + i_ * 8192, R_, C_); _Pragma("unroll") for (int h_ = 0; h_ < 2; ++h_) \
        { unsigned tk_ = (unsigned)g.tok[(pm_) * 256 + h_ * 128 + R_]; tk_ = tk_ < (unsigned)g.M ? tk_ : 0u; dst[h_][i_] = tk_ * (unsigned)(lda * 2) + (unsigned)(C_ * 2); } } } while (0)
#define PG8_STAGE_A(bufoff, base_, h_, nx_) do { if constexpr (GATHER) { unsigned vs_[2] = {(nx_) ? vN[h_][0] : vG[h_][0], (nx_) ? vN[h_][1] : vG[h_][1]}; PG8_STAGE(bufoff, base_, vs_); } \
        else { PG8_STAGE(bufoff, (base_) + ((h_) ? hstepA : 0), voffA); } } while (0)
    const size_t kstep = (size_t)(BK * 2);
    const size_t hstepA = (size_t)HALF * lda * 2, tstepA = 2 * hstepA;
    const size_t hstepB = (size_t)HALF * K * 2, tstepB = 2 * hstepB;
    const unsigned ldsw = (unsigned)wid * 1024u;
    const int aoff = lds_byte(wr * 64 + fr, fq * 8), boff = lds_byte(wc * 32 + fr, fq * 8);
#define PG8_SA(b, h) (((b) * 2 + (h)) * HTB)
#define PG8_SB(b, h) ((4 + (b) * 2 + (h)) * HTB)
#define PG8_STAGE(bufoff, gbase, voff) do { _Pragma("unroll") for (int _i = 0; _i < 2; ++_i) \
        __builtin_amdgcn_global_load_lds((const unsigned*)((const char*)(gbase) + (voff)[_i]), (PG8_LAS unsigned*)(lds + (bufoff) + ldsw + _i * 8192), 16, 0, 0); } while (0)
#define PG8_LDA(dst, b, h) do { _Pragma("unroll") for (int m = 0; m < 4; ++m) _Pragma("unroll") for (int k = 0; k < 2; ++k) dst[m][k] = *(const PG8_LAS bf16x8*)(lds + PG8_SA(b, h) + aoff + m * 2048 + k * 1024); } while (0)
#define PG8_LDB(dst, b, h) do { _Pragma("unroll") for (int n = 0; n < 2; ++n) _Pragma("unroll") for (int k = 0; k < 2; ++k) dst[n][k] = *(const PG8_LAS bf16x8*)(lds + PG8_SB(b, h) + boff + n * 2048 + k * 1024); } while (0)
#define PG8_MMA(ai, bj, At, Bt) do { __builtin_amdgcn_s_setprio(1); _Pragma("unroll") for (int m = 0; m < 4; ++m) _Pragma("unroll") for (int n = 0; n < 2; ++n) _Pragma("unroll") for (int k = 0; k < 2; ++k) \
        acc[ai][bj][m][n] = __builtin_amdgcn_mfma_f32_16x16x32_bf16(Bt[n][k], At[m][k], acc[ai][bj][m][n], 0, 0, 0); __builtin_amdgcn_s_setprio(0); } while (0)
#define PG8_WAIT_V(n) asm volatile("s_waitcnt vmcnt(" #n ")" ::: "memory")
#define PG8_WAIT_L(n) asm volatile("s_waitcnt lgkmcnt(" #n ")" ::: "memory")
#define PG8_BAR __builtin_amdgcn_s_barrier()
#define PG8_SCHED __builtin_amdgcn_sched_barrier(0)
    Unit cur, nxt; int ui = 0;
    if (!S.next(0, cur)) return;
    f32x4 acc[2][2][4][2];
#pragma unroll
    for (int a = 0; a < 2; ++a)
#pragma unroll
        for (int b = 0; b < 2; ++b)
#pragma unroll
            for (int m = 0; m < 4; ++m)
#pragma unroll
                for (int n = 0; n < 2; ++n) acc[a][b][m][n] = (f32x4){0.f, 0.f, 0.f, 0.f};
    bf16x8 At[4][2], B0[2][2], B1[2][2];
    const char* cA = (const char*)g.A + (GATHER ? (size_t)0 : (size_t)cur.pm * tstepA); const char* cB = (const char*)g.Bt + (size_t)cur.bt * tstepB;
    if constexpr (GATHER) { PG8_TOK(vG, cur.pm); }
    S.a_ready(cur);
    PG8_STAGE(PG8_SB(0, 0), cB, voffB); PG8_STAGE(PG8_SB(0, 1), cB + hstepB, voffB); PG8_STAGE_A(PG8_SA(0, 0), cA, 0, false); PG8_STAGE_A(PG8_SA(0, 1), cA, 1, false);
    if (wr == 1) PG8_BAR;
    PG8_WAIT_V(2); PG8_BAR;
    PG8_STAGE(PG8_SB(1, 0), cB + kstep, voffB); PG8_STAGE_A(PG8_SA(1, 0), cA + kstep, 0, false); PG8_STAGE(PG8_SB(1, 1), cB + hstepB + kstep, voffB);
    PG8_WAIT_V(6); PG8_BAR;
    for (;;) {
        const bool has_next = S.next(ui + 1, nxt);
        const char* nA = has_next ? (const char*)g.A + (GATHER ? (size_t)0 : (size_t)nxt.pm * tstepA) : cA; const char* nB = has_next ? (const char*)g.Bt + (size_t)nxt.bt * tstepB : cB;
        if constexpr (GATHER) {
#pragma unroll
            for (int h_ = 0; h_ < 2; ++h_) { vN[h_][0] = vG[h_][0]; vN[h_][1] = vG[h_][1]; }
            if (has_next) {
#pragma unroll
                for (int i_ = 0; i_ < 2; ++i_) { int R_, C_; stage_rc(opq(tid) * 16 + i_ * 8192, R_, C_);
#pragma unroll
                    for (int h_ = 0; h_ < 2; ++h_) { const int* tp_ = g.tok + nxt.pm * 256 + h_ * 128 + R_;
                        asm volatile("global_load_dword %0, %1, off" : "=v"(vN[h_][i_]) : "v"(tp_) : "memory"); } } } }
        for (int t = 0; t < nt; t += 2) {
            const bool last = (t == nt - 2);
            const char* a1 = cA + (size_t)(t + 1) * kstep;
            const char* a2 = last ? nA : cA + (size_t)(t + 2) * kstep; const char* b2 = last ? nB : cB + (size_t)(t + 2) * kstep;
            const char* a3 = a2 + kstep; const char* b3 = b2 + kstep;
            if (last && has_next) S.a_ready(nxt);
            if constexpr (GATHER) { if (last && has_next) {
#pragma unroll
                for (int i_ = 0; i_ < 2; ++i_) { int R_, C_; stage_rc(opq(tid) * 16 + i_ * 8192, R_, C_);
#pragma unroll
                    for (int h_ = 0; h_ < 2; ++h_) { unsigned tk_ = vN[h_][i_]; asm volatile("" : "+v"(tk_)); tk_ = tk_ < (unsigned)g.M ? tk_ : 0u; vN[h_][i_] = tk_ * (unsigned)(lda * 2) + (unsigned)(C_ * 2); } } } }
            PG8_LDB(B0, 0, 0); PG8_LDB(B1, 0, 1); PG8_SCHED; PG8_LDA(At, 0, 0); PG8_STAGE_A(PG8_SA(1, 1), a1, 1, false);
            PG8_WAIT_V(8); PG8_WAIT_L(0); PG8_BAR; PG8_MMA(0, 0, At, B0); PG8_MMA(0, 1, At, B1); PG8_BAR; PG8_SCHED;
            PG8_LDA(At, 0, 1); PG8_STAGE(PG8_SB(0, 0), b2, voffB); PG8_STAGE(PG8_SB(0, 1), b2 + hstepB, voffB); PG8_STAGE_A(PG8_SA(0, 0), a2, 0, last);
            PG8_WAIT_V(8); PG8_WAIT_L(0); PG8_BAR; PG8_MMA(1, 0, At, B0); PG8_MMA(1, 1, At, B1); PG8_BAR; PG8_SCHED;
            PG8_LDB(B0, 1, 0); PG8_LDB(B1, 1, 1); PG8_SCHED; PG8_LDA(At, 1, 0); PG8_STAGE_A(PG8_SA(0, 1), a2, 1, last);
            PG8_WAIT_V(8); PG8_WAIT_L(0); PG8_BAR; PG8_MMA(0, 0, At, B0); PG8_MMA(0, 1, At, B1); PG8_BAR; PG8_SCHED;
            PG8_LDA(At, 1, 1); PG8_STAGE(PG8_SB(1, 0), b3, voffB); PG8_STAGE(PG8_SB(1, 1), b3 + hstepB, voffB); PG8_STAGE_A(PG8_SA(1, 0), a3, 0, last);
            PG8_WAIT_V(8); PG8_WAIT_L(0); PG8_BAR; PG8_MMA(1, 0, At, B0); PG8_MMA(1, 1, At, B1); PG8_BAR; PG8_SCHED;
        }
        if (wr == 0) PG8_BAR;
        E(acc, cur, wr, wc, fr, fq); S.done(cur);
        if (!has_next) break;
#pragma unroll
        for (int a = 0; a < 2; ++a)
#pragma unroll
            for (int b = 0; b < 2; ++b)
#pragma unroll
                for (int m = 0; m < 4; ++m)
#pragma unroll
                    for (int n = 0; n < 2; ++n) acc[a][b][m][n] = (f32x4){0.f, 0.f, 0.f, 0.f};
        cur = nxt; cA = nA; cB = nB; ++ui;
        if constexpr (GATHER) {
#pragma unroll
            for (int h_ = 0; h_ < 2; ++h_) { vG[h_][0] = vN[h_][0]; vG[h_][1] = vN[h_][1]; } }
        if (wr == 1) PG8_BAR;
    }
    PG8_WAIT_V(0);
    PG8_BAR;
#undef PG8_SA
#undef PG8_SB
#undef PG8_STAGE
#undef PG8_STAGE_A
#undef PG8_TOK
#undef PG8_LDA
#undef PG8_LDB
#undef PG8_MMA
#undef PG8_WAIT_V
#undef PG8_WAIT_L
#undef PG8_BAR
#undef PG8_SCHED
}
#endif

struct EpiStoreBf16 {
    bf16_t* O; int ldc;
    __device__ __forceinline__ void operator()(const f32x4 (&acc)[2][2][4][2], const Unit& u, int wr, int wc, int fr, int fq) const {
        const int row0 = u.pm * 256 + wr * 64 + fr, col0 = u.pn * 256 + wc * 32 + 8 * fq;
#pragma unroll
        for (int ai = 0; ai < 2; ++ai)
#pragma unroll
            for (int m = 0; m < 4; ++m)
#pragma unroll
                for (int bj = 0; bj < 2; ++bj) { const f32x4 v0 = acc[ai][bj][m][0], v1 = acc[ai][bj][m][1];
                    u32x4 w; w.x = pk2(v0[0], v0[1]); w.y = pk2(v0[2], v0[3]); w.z = pk2(v1[0], v1[1]); w.w = pk2(v1[2], v1[3]);
                    *(u32x4*)(O + (size_t)(row0 + ai * 128 + m * 16) * ldc + col0 + bj * 128) = w; }
    }
};
template <int MODE> struct EpiGate {
    const bf16_t* Hg; bf16_t* MGb;
    __device__ __forceinline__ void operator()(const f32x4 (&acc)[2][2][4][2], const Unit& u, int wr, int wc, int fr, int fq) const {
        const int row0 = u.pm * 256 + wr * 64 + fr, col0 = u.pn * 256 + wc * 32 + 8 * fq;
#pragma unroll
        for (int ai = 0; ai < 2; ++ai) {
            u32x4 gw[4][2], pw[4][2];
#pragma unroll
            for (int m = 0; m < 4; ++m)
#pragma unroll
                for (int bj = 0; bj < 2; ++bj) { const int row = row0 + ai * 128 + m * 16, col = col0 + bj * 128;
                    gw[m][bj] = *(const u32x4*)(Hg + (size_t)row * DINP + col); if (MODE != 0) pw[m][bj] = *(const u32x4*)(MGb + (size_t)row * D + col); }
            asm volatile("" ::: "memory");
#pragma unroll
            for (int m = 0; m < 4; ++m)
#pragma unroll
                for (int bj = 0; bj < 2; ++bj) { const int row = row0 + ai * 128 + m * 16, col = col0 + bj * 128; const f32x4 v0 = acc[ai][bj][m][0], v1 = acc[ai][bj][m][1];
                    float g[8], p[8], v[8] = {v0[0], v0[1], v0[2], v0[3], v1[0], v1[1], v1[2], v1[3]}; unpack8(gw[m][bj], g);
                    if (MODE != 0) { unpack8(pw[m][bj], p);
#pragma unroll
                        for (int i = 0; i < 8; ++i) v[i] = p[i] + v[i] * fsigmoid(g[i]); }
                    else {
#pragma unroll
                        for (int i = 0; i < 8; ++i) v[i] = v[i] * fsigmoid(g[i]); }
                    *(u32x4*)(MGb + (size_t)row * D + col) = pack8(v); }
            asm volatile("" ::: "memory");
        }
    }
};
struct EpiResid {
    const float* xp; const float* xs; float* op; float* os;
    __device__ __forceinline__ void operator()(const f32x4 (&acc)[2][2][4][2], const Unit& u, int wr, int wc, int fr, int fq) const {
        const int row0 = u.pm * 256 + wr * 64 + fr, col0 = u.pn * 256 + wc * 32 + 8 * fq;
        const bool smp = u.pm * 256 >= NP;
        const float* xb = smp ? xs - (size_t)NP * D : xp; float* ob = smp ? os - (size_t)NP * D : op;
#pragma unroll
        for (int ai = 0; ai < 2; ++ai) {
            f32x4 xa[4][2][2];
#pragma unroll
            for (int m = 0; m < 4; ++m)
#pragma unroll
                for (int bj = 0; bj < 2; ++bj) { const float* xi = xb + (size_t)(row0 + ai * 128 + m * 16) * D + col0 + bj * 128; xa[m][bj][0] = *(const f32x4*)xi; xa[m][bj][1] = *(const f32x4*)(xi + 4); }
            asm volatile("" ::: "memory");
#pragma unroll
            for (int m = 0; m < 4; ++m)
#pragma unroll
                for (int bj = 0; bj < 2; ++bj) { float* xo = ob + (size_t)(row0 + ai * 128 + m * 16) * D + col0 + bj * 128;
                    *(f32x4*)xo = xa[m][bj][0] * ALPHA + acc[ai][bj][m][0]; *(f32x4*)(xo + 4) = xa[m][bj][1] * ALPHA + acc[ai][bj][m][1]; }
            asm volatile("" ::: "memory");
        }
    }
};
struct EpiSwiglu {
    bf16_t* ACT; const float* bup;
    __device__ __forceinline__ void operator()(const f32x4 (&acc)[2][2][4][2], const Unit& u, int wr, int wc, int fr, int fq) const {
        const int row0_ = u.pm * 256 + wr * 64 + fr, j0 = u.pn * 128 + wc * 32 + 8 * fq;
        const float* bg = bup + (size_t)u.e * 2048 + j0; const f32x4 bg0 = *(const f32x4*)bg, bg1 = *(const f32x4*)(bg + 4), bu0 = *(const f32x4*)(bg + 1024), bu1 = *(const f32x4*)(bg + 1028);
#pragma unroll
        for (int ai = 0; ai < 2; ++ai)
#pragma unroll
            for (int m = 0; m < 4; ++m) { const int row = row0_ + ai * 128 + m * 16;
                const f32x4 g0 = acc[ai][0][m][0] + bg0, g1 = acc[ai][0][m][1] + bg1, u0 = acc[ai][1][m][0] + bu0, u1 = acc[ai][1][m][1] + bu1; float o[8];
#pragma unroll
                for (int i = 0; i < 4; ++i) { const float ga = fminf(g0[i], SW_LIMIT), ua = fminf(fmaxf(u0[i], -SW_LIMIT), SW_LIMIT); o[i] = (ua + 1.0f) * ga * fsigmoid(SW_ALPHA * ga);
                    const float gb = fminf(g1[i], SW_LIMIT), ub = fminf(fmaxf(u1[i], -SW_LIMIT), SW_LIMIT); o[4 + i] = (ub + 1.0f) * gb * fsigmoid(SW_ALPHA * gb); }
                *(u32x4*)(ACT + (size_t)row * D + j0) = pack8(o); }
    }
};
struct EpiDown {
    bf16_t* O; const float* bdn; const float* gs;
    __device__ __forceinline__ void operator()(const f32x4 (&acc)[2][2][4][2], const Unit& u, int wr, int wc, int fr, int fq) const {
        const int row0 = u.pm * 256 + wr * 64 + fr, col0 = u.pn * 256 + wc * 32 + 8 * fq;
#pragma unroll
        for (int ai = 0; ai < 2; ++ai) {
            float gt[4];
#pragma unroll
            for (int m = 0; m < 4; ++m) gt[m] = gs[row0 + ai * 128 + m * 16];
#pragma unroll
            for (int bj = 0; bj < 2; ++bj) { const float* bp = bdn + (size_t)u.e * D + col0 + bj * 128; const f32x4 b0 = *(const f32x4*)bp, b1 = *(const f32x4*)(bp + 4);
#pragma unroll
                for (int m = 0; m < 4; ++m) { const f32x4 a0 = (acc[ai][bj][m][0] + b0) * gt[m], a1 = (acc[ai][bj][m][1] + b1) * gt[m];
                    u32x4 w; w.x = pk2(a0[0], a0[1]); w.y = pk2(a0[2], a0[3]); w.z = pk2(a1[0], a1[1]); w.w = pk2(a1[2], a1[3]);
                    *(u32x4*)(O + (size_t)(row0 + ai * 128 + m * 16) * D + col0 + bj * 128) = w; } }
            asm volatile("" ::: "memory");
        }
    }
};
}

#ifndef EMU
#define XB_TMO      128
#define XB_XCNT(j)  (256  + 64 * (j))
#define XB_XSUB(j)  (1280 + 64 * (j))
#define XB_XGEN(j)  (2304 + 64 * (j))
#define XB_TOP      3328
#define XB_TOPGEN   3392
#define XCD_BAR_WORDS 3456
#define XB_SPIN_CAP (1u << 27)
__device__ __forceinline__ unsigned xb_ld(unsigned* p)              { return __hip_atomic_load(p, __ATOMIC_RELAXED, __HIP_MEMORY_SCOPE_AGENT); }
__device__ __forceinline__ unsigned xb_add(unsigned* p, unsigned v) { return __hip_atomic_fetch_add(p, v, __ATOMIC_RELAXED, __HIP_MEMORY_SCOPE_AGENT); }
__device__ __forceinline__ unsigned xb_xcc_id() { return (unsigned)__builtin_amdgcn_s_getreg((3 << 11) | 20) & 0xFu; }
#define XB_SPIN(cond, bar) do { unsigned _sp = 0; while (cond) { __builtin_amdgcn_s_sleep(1); \
    if ((++_sp & 255u) == 0u) { if (xb_ld(&(bar)[XB_TMO])) break; if (_sp > XB_SPIN_CAP) { atomicAdd(&(bar)[XB_TMO], 1u); break; } } } } while (0)
struct XcdBarrier { unsigned* bar; unsigned x; volatile LAS unsigned* st; };
__device__ __forceinline__ XcdBarrier xcd_barrier_post(unsigned* bar, volatile LAS unsigned* st) {
    XcdBarrier b; b.bar = bar; b.x = xb_xcc_id(); b.st = st;
    if (threadIdx.x == 0) (void)xb_add(&bar[XB_XCNT(b.x)], 1u);
    return b;
}
__device__ __forceinline__ void xcd_barrier_complete(unsigned* bar, unsigned x, unsigned& nloc, unsigned& nx) {
    const unsigned G = gridDim.x * gridDim.y * gridDim.z;
    unsigned sum, cnt, mine, sp = 0u;
    for (;;) {
        sum = 0u; cnt = 0u; mine = 0u;
#pragma unroll
        for (unsigned j = 0; j < 16; ++j) { const unsigned c = xb_ld(&bar[XB_XCNT(j)]); sum += c; cnt += (c > 0u) ? 1u : 0u; mine = (j == x) ? c : mine; }
        if (sum == G) break;
        __builtin_amdgcn_s_sleep(1);
        if ((++sp & 255u) == 0u) { if (xb_ld(&bar[XB_TMO])) break; if (sp > XB_SPIN_CAP) { atomicAdd(&bar[XB_TMO], 1u); break; } }
    }
    nloc = mine > 0u ? mine : 1u; nx = cnt > 0u ? cnt : 1u;
}
__device__ __forceinline__ void xcd_barrier(const XcdBarrier& b) {
    asm volatile("s_waitcnt vmcnt(0)" ::: "memory");
    __syncthreads();
    if (threadIdx.x == 0) {
        unsigned* bar = b.bar;
        __builtin_amdgcn_s_waitcnt(0);
        unsigned nloc = b.st[0], nx = b.st[1];
        if (nloc == 0u) { xcd_barrier_complete(bar, b.x, nloc, nx); b.st[0] = nloc; b.st[1] = nx; }
        const unsigned old = xb_add(&bar[XB_XSUB(b.x)], 1u);
        const unsigned gen = old / nloc;
        if (old + 1u == (gen + 1u) * nloc) {
            __builtin_amdgcn_fence(__ATOMIC_RELEASE, "agent");
            asm volatile("s_waitcnt vmcnt(0)" ::: "memory");
            const unsigned og = xb_add(&bar[XB_TOP], 1u);
            const unsigned tg = og / nx;
            if (og + 1u == (tg + 1u) * nx) xb_add(&bar[XB_TOPGEN], 1u);
            else XB_SPIN(xb_ld(&bar[XB_TOPGEN]) == tg, bar);
            __builtin_amdgcn_fence(__ATOMIC_ACQUIRE, "agent");
            xb_add(&bar[XB_XGEN(b.x)], 1u);
            asm volatile("s_waitcnt vmcnt(0)" ::: "memory");
        } else {
            XB_SPIN(xb_ld(&bar[XB_XGEN(b.x)]) == gen, bar);
            __builtin_amdgcn_fence(__ATOMIC_ACQUIRE, "agent");
            asm volatile("s_waitcnt vmcnt(0)" ::: "memory");
        }
    }
    __syncthreads();
}
#endif

struct Args { const float* in[31]; float* out; unsigned char* ws; int lo, hi; };
typedef const float* FPtr;
#ifdef EMU
typedef const FPtr* ArgTab;
#else
typedef const __attribute__((address_space(4))) FPtr* ArgTab;
#endif
struct Frame {
    LAS unsigned char* lds; int tid, lane, wave, G, bid;
    ArgTab in; float* out; unsigned char* ws; unsigned* ctl;
};
enum { I_XP = 0, I_XS, I_CK, I_CV, I_SST, I_SCV, I_SSC, I_WIN, I_CONVW, I_CONVB, I_DTB, I_ALOG, I_SD, I_NORMW, I_WSSD, I_SINK, I_WATT, I_RELB, I_SCW, I_WSC, I_WO, I_LN1G, I_LN1B,
       I_RW, I_RB, I_WUP, I_BUP, I_WDN, I_BDN, I_LN2G, I_LN2B };

__device__ __forceinline__ bf16_t* ws_bf(const Frame& F, size_t off) { return (bf16_t*)(F.ws + off); }
__device__ __forceinline__ float* ws_f(const Frame& F, size_t off) { return (float*)(F.ws + off); }
__device__ __forceinline__ bf16_t* wl_ptr(const Frame& F, int layer, size_t off) { return (bf16_t*)(F.ws + WS_W + (size_t)layer * WL_BYTES + off); }

__device__ __forceinline__ void wt_item(const float* W, int ldw, int K, int k0, int nsrc0, const float* kscale, bf16_t* WT, int ndst0, LAS float* scr, int lane) {
    if (nsrc0 < 0) {
#pragma unroll
        for (int j = 0; j < 4; ++j) { const int n = (lane >> 3) + 8 * j; *(u32x4*)(WT + (size_t)(ndst0 + n) * K + k0 + 8 * (lane & 7)) = (u32x4){0u, 0u, 0u, 0u}; }
        return;
    }
#pragma unroll 8
    for (int i = 0; i < 32; ++i) { const int kk = 2 * i + (lane >> 5); float v = W[(size_t)(k0 + kk) * ldw + nsrc0 + (lane & 31)]; if (kscale) v *= kscale[k0 + kk]; scr[kk * 33 + (lane & 31)] = v; }
    WAVE_SYNC();
    const int c = lane & 7;
#pragma unroll
    for (int j = 0; j < 4; ++j) { const int n = (lane >> 3) + 8 * j; const LAS float* s = scr + (8 * c) * 33 + n;
        u32x4 o; o.x = pk2(s[0 * 33], s[1 * 33]); o.y = pk2(s[2 * 33], s[3 * 33]); o.z = pk2(s[4 * 33], s[5 * 33]); o.w = pk2(s[6 * 33], s[7 * 33]);
        *(u32x4*)(WT + (size_t)(ndst0 + n) * K + k0 + 8 * c) = o; }
    WAVE_SYNC();
}
__device__ __forceinline__ void step_weights(const Frame& F) {
    LAS float* scr = (LAS float*)(F.lds + F.wave * 16384);
    const int gw = F.bid * NWAVES + F.wave, NGW = F.G * NWAVES;
    constexpr int I_IN = (DINP / 32) * (D / 64), I_SSD = (D / 32) * (DINNER / 64), I_SQ = (D / 32) * (D / 64), I_UP = NEXP * (2048 / 32) * (D / 64), I_DN = NEXP * (D / 32) * (D / 64);
    constexpr int PER_LAYER = I_IN + I_SSD + 3 * I_SQ + I_UP + I_DN;
    for (int it = gw; it < DEPTH * PER_LAYER; it += NGW) {
        const int layer = it / PER_LAYER; int r = it % PER_LAYER;
        if (r < I_IN) { const int nb = r / (D / 64), kb = r % (D / 64), n0 = nb * 32;
            const int ns = n0 < 6144 ? n0 : (n0 < 13824 ? n0 + 32 : (n0 < 13856 ? n0 - 13824 + 6144 : -1));
            wt_item(F.in[I_WIN] + (size_t)layer * D * DIN, DIN, D, kb * 64, ns, nullptr, wl_ptr(F, layer, WL_IN), n0, scr, F.lane); continue; }
        r -= I_IN;
        if (r < I_SSD) { const int nb = r / (DINNER / 64), kb = r % (DINNER / 64);
            wt_item(F.in[I_WSSD] + (size_t)layer * DINNER * D, D, DINNER, kb * 64, nb * 32, F.in[I_NORMW] + (size_t)layer * DINNER, wl_ptr(F, layer, WL_SSD), nb * 32, scr, F.lane); continue; }
        r -= I_SSD;
        if (r < I_SQ) { const int nb = r / (D / 64), kb = r % (D / 64); wt_item(F.in[I_WATT] + (size_t)layer * D * D, D, D, kb * 64, nb * 32, nullptr, wl_ptr(F, layer, WL_ATT), nb * 32, scr, F.lane); continue; }
        r -= I_SQ;
        if (r < I_SQ) { const int nb = r / (D / 64), kb = r % (D / 64); wt_item(F.in[I_WSC] + (size_t)layer * D * D, D, D, kb * 64, nb * 32, nullptr, wl_ptr(F, layer, WL_SC), nb * 32, scr, F.lane); continue; }
        r -= I_SQ;
        if (r < I_SQ) { const int nb = r / (D / 64), kb = r % (D / 64); wt_item(F.in[I_WO] + (size_t)layer * D * D, D, D, kb * 64, nb * 32, nullptr, wl_ptr(F, layer, WL_O), nb * 32, scr, F.lane); continue; }
        r -= I_SQ;
        if (r < I_UP) { const int e = r / ((2048 / 32) * (D / 64)), q = r % ((2048 / 32) * (D / 64)), nb = q / (D / 64), kb = q % (D / 64), n0 = nb * 32;
            const int pn = n0 >> 8, bj = (n0 >> 7) & 1, jj = n0 & 127, ns = bj * 1024 + pn * 128 + jj;
            wt_item(F.in[I_WUP] + ((size_t)layer * NEXP + e) * D * 2048, 2048, D, kb * 64, ns, nullptr, wl_ptr(F, layer, WL_UP) + (size_t)e * 2048 * D, n0, scr, F.lane); continue; }
        r -= I_UP;
        { const int e = r / ((D / 32) * (D / 64)), q = r % ((D / 32) * (D / 64)), nb = q / (D / 64), kb = q % (D / 64);
            wt_item(F.in[I_WDN] + ((size_t)layer * NEXP + e) * D * D, D, D, kb * 64, nb * 32, nullptr, wl_ptr(F, layer, WL_DN) + (size_t)e * D * D, nb * 32, scr, F.lane); }
    }
}

__device__ __forceinline__ const float* x_in_row(const Frame& F, int layer, int mb, int r) {
    if (layer == 0) return r < NP ? F.in[I_XP] + ((size_t)mb * NP + r) * D : F.in[I_XS] + (size_t)(r - NP) * D;
    return r < NP ? F.out + O_YP + ((size_t)mb * NP + r) * D : F.out + O_YS + (size_t)(r - NP) * D;
}
__device__ __forceinline__ float* x_out_row(const Frame& F, int mb, int r) { return r < NP ? F.out + O_YP + ((size_t)mb * NP + r) * D : F.out + O_YS + (size_t)(r - NP) * D; }
__device__ __forceinline__ int rows_of(int mb) { return mb == 0 ? R : NP; }

__device__ __forceinline__ void step_xb(const Frame& F, int mb) {
    const int gw = F.bid * NWAVES + F.wave, NGW = F.G * NWAVES, nr = rows_of(mb);
    bf16_t* XB = ws_bf(F, WS_XB0) + (size_t)mb * R * D;
    for (int r = gw; r < nr; r += NGW) {
        const f32x4* xr = (const f32x4*)x_in_row(F, 0, mb, r) + F.lane; u32x2* o = (u32x2*)(XB + (size_t)r * D) + F.lane;
#pragma unroll
        for (int j = 0; j < 4; ++j) { const f32x4 v = xr[64 * j]; u32x2 w; w.x = pk2(v[0], v[1]); w.y = pk2(v[2], v[3]); o[64 * j] = w; }
    }
}

__device__ __forceinline__ float softplus_f(float x) { const float e = fexp(x); return x > 20.f ? x : (e < 0.01f ? e * (1.0f - e * (0.5f - e * 0.33333333f)) : __builtin_amdgcn_logf(1.0f + e) * 0.69314718056f); }
constexpr int S128 = 136, S64 = 72;
constexpr int BL_BM = 0, BL_CM = BL_BM + 64 * S128 * 2, BL_CB = BL_CM + 64 * S128 * 2, BL_END = BL_CB + 64 * S64 * 2;
struct BcRegs { u32x4 raw[7]; f32x4 wq[4][2], bq[2]; };
__device__ __forceinline__ void ssd_bc_load(const Frame& F, int layer, int u, BcRegs& R_) {
    const int sl = (u / NCHUNK) % NSEQ_MB, ck = u % NCHUNK, g = u / (NCHUNK * NSEQ_MB); const int tid = F.tid;
    const bf16_t* H = ws_bf(F, WS_H) + (size_t)sl * SEQ * DINP; const int cgi = tid & 31, rb = tid >> 5; const int xc = (cgi < 16 ? 2048 : 3072) + g * 128 + 8 * (cgi & 15);
#pragma unroll
    for (int i = 0; i < 7; ++i) { const int t = ck * 64 + 4 * rb - 3 + i; R_.raw[i] = t >= 0 ? *(const u32x4*)(H + (size_t)t * DINP + C_X + xc) : (u32x4){0u, 0u, 0u, 0u}; }
    const float* convw = F.in[I_CONVW] + (size_t)layer * 4 * CONVDIM + xc; const float* convb = F.in[I_CONVB] + (size_t)layer * CONVDIM + xc;
#pragma unroll
    for (int tp = 0; tp < 4; ++tp) { R_.wq[tp][0] = *(const f32x4*)(convw + tp * CONVDIM); R_.wq[tp][1] = *(const f32x4*)(convw + tp * CONVDIM + 4); }
    R_.bq[0] = *(const f32x4*)convb; R_.bq[1] = *(const f32x4*)(convb + 4);
}
__device__ __forceinline__ void ssd_bc_unit(const Frame& F, int u, const BcRegs& R_) {
    const int sl = (u / NCHUNK) % NSEQ_MB, ck = u % NCHUNK, g = u / (NCHUNK * NSEQ_MB);
    const int tid = F.tid, lane = F.lane, w = F.wave, fr = lane & 15, fq = lane >> 4;
    LAS bf16_t* Bm = (LAS bf16_t*)(F.lds + BL_BM); LAS bf16_t* Cm = (LAS bf16_t*)(F.lds + BL_CM); LAS bf16_t* CBs = (LAS bf16_t*)(F.lds + BL_CB);
    const size_t rowg = (size_t)sl * SEQ + (size_t)ck * 64; const size_t tix = ((size_t)sl * NCHUNK + ck) * 8 + g;
    const int cgi = tid & 31, rb = tid >> 5; const bool isB = cgi < 16; const int n0 = 8 * (cgi & 15);
    const u32x4 (&raw)[7] = R_.raw; const f32x4 (&wq)[4][2] = R_.wq; const f32x4 (&bq)[2] = R_.bq;
    __syncthreads();
    { float val[4][8];
#pragma unroll
      for (int r = 0; r < 4; ++r) { float a[8] = {bq[0][0], bq[0][1], bq[0][2], bq[0][3], bq[1][0], bq[1][1], bq[1][2], bq[1][3]};
#pragma unroll
          for (int tp = 0; tp < 4; ++tp) { float f[8]; unpack8(raw[r + tp], f);
#pragma unroll
              for (int i = 0; i < 4; ++i) { a[i] += f[i] * wq[tp][0][i]; a[4 + i] += f[4 + i] * wq[tp][1][i]; } }
#pragma unroll
          for (int i = 0; i < 8; ++i) val[r][i] = fsilu(a[i]); }
      if (isB) { bf16_t* bt = ws_bf(F, WS_BTG) + tix * 8192 + (size_t)n0 * 64 + 4 * rb;
#pragma unroll
          for (int r = 0; r < 4; ++r) *(LAS u32x4*)(Bm + (4 * rb + r) * S128 + n0) = pack8(val[r]);
#pragma unroll
          for (int i = 0; i < 8; ++i) { u32x2 wv; wv.x = pk2(val[0][i], val[1][i]); wv.y = pk2(val[2][i], val[3][i]); *(u32x2*)(bt + (size_t)i * 64) = wv; } }
      else { bf16_t* cmc = ws_bf(F, WS_CMC) + (rowg + 4 * rb) * 1024 + g * 128 + n0;
#pragma unroll
          for (int r = 0; r < 4; ++r) { const u32x4 pk = pack8(val[r]); *(LAS u32x4*)(Cm + (4 * rb + r) * S128 + n0) = pk; *(u32x4*)(cmc + (size_t)r * 1024) = pk; } } }
    __syncthreads();
    { const int ti = w >> 1;
#pragma unroll
      for (int jj = 0; jj < 2; ++jj) { const int tj = 2 * (w & 1) + jj; f32x4 cb = (f32x4){0.f, 0.f, 0.f, 0.f};
          if (tj <= ti) {
#pragma unroll
              for (int ks = 0; ks < 4; ++ks) { const bf16x8 a = *(const LAS bf16x8*)(Cm + (16 * ti + fr) * S128 + 32 * ks + 8 * fq); const bf16x8 b = *(const LAS bf16x8*)(Bm + (16 * tj + fr) * S128 + 32 * ks + 8 * fq);
                  cb = __builtin_amdgcn_mfma_f32_16x16x32_bf16(a, b, cb, 0, 0, 0); } }
#pragma unroll
          for (int r = 0; r < 4; ++r) CBs[(16 * ti + 4 * fq + r) * S64 + 16 * tj + fr] = bf1(cb[r]); } }
    __syncthreads();
    { const int row = tid >> 3, cc = tid & 7; *(u32x4*)(ws_bf(F, WS_CBG) + tix * 4096 + row * 64 + 8 * cc) = *(const LAS u32x4*)(CBs + row * S64 + 8 * cc); }
}

constexpr int SL_CM = 0, SL_BT = SL_CM + 64 * S128 * 2, SL_CB = SL_BT + 128 * S64 * 2, SL_DMA_SZ = SL_CB + 64 * S64 * 2, SL_DMA_END = 2 * SL_DMA_SZ;
constexpr int SL_XT = SL_DMA_END  , SL_XTW = SL_XT + 2 * 64 * S64 * 2, SL_MM = SL_XTW + 64 * S64 * 2, SL_SB = SL_MM + 64 * S64 * 2,
    SL_SM = SL_SB + 64 * S128 * 2, SL_END = SL_SM + 2 * 384 * 4;
static_assert(SL_END <= SCR_BYTES && SL_DMA_SZ == 2816 * 16, "ssd LDS map");
#ifdef EMU
#define SSD_DMA_ONE(gp_, dst_) memcpy((unsigned char*)(dst_) + lane * 16, (gp_), 16)
#else
#define SSD_DMA_ONE(gp_, dst_) __builtin_amdgcn_global_load_lds((const unsigned*)(gp_), (LAS unsigned*)(dst_), 16, 0, 0)
#endif
#define SSD_DMA_SETUP() do { _Pragma("unroll") for (int j_ = 0; j_ < 6; ++j_) { const int pc_ = w * 6 + j_; const int q_ = pc_ * 64 + lane; const size_t tx0_ = ((size_t)sl * NCHUNK) * 8 + g; \
        if (pc_ < 17) { const int r_ = q_ / 17; int c_ = q_ % 17; c_ = c_ < 16 ? c_ : 15; dsrc[j_] = cmc + (size_t)r_ * 1024 + 8 * c_; } \
        else if (pc_ < 35) { const int q2_ = q_ - 1088, r_ = q2_ / 9; int c_ = q2_ % 9; c_ = c_ < 8 ? c_ : 7; dsrc[j_] = btg + tx0_ * 8192 + r_ * 64 + 8 * c_; } \
        else { const int q3_ = q_ - 2240, r_ = q3_ / 9; int c_ = q3_ % 9; c_ = c_ < 8 ? c_ : 7; dsrc[j_] = cbg + tx0_ * 4096 + r_ * 64 + 8 * c_; } } } while (0)
#define SSD_DMA(ck_) do { _Pragma("unroll") for (int j_ = 0; j_ < 6; ++j_) { const int pc_ = w * 6 + j_; if (pc_ < 44) { \
        SSD_DMA_ONE(dsrc[j_], L + ((ck_) & 1) * SL_DMA_SZ + SL_CM + pc_ * 1024); dsrc[j_] += pc_ < 17 ? (size_t)64 * 1024 : (pc_ < 35 ? (size_t)8 * 8192 : (size_t)8 * 4096); } } } while (0)
#define SSD_LOAD_X(ck_) do { _Pragma("unroll") for (int i = 0; i < 11; ++i) { const int t_ = (ck_) * 64 + 8 * w - 3 + i; rawx[i] = t_ >= 0 ? (unsigned)H[(size_t)t_ * DINP + C_X + hd * 64 + lane] : 0u; } } while (0)
#define SSD_LOAD_XN(ck_) do { const bf16_t* px_ = H + ((size_t)(ck_) * 64 + 8 * w - 3) * DINP + C_X + hd * 64 + lane; _Pragma("unroll") for (int i = 0; i < 11; ++i) rawx[i] = (unsigned)px_[(size_t)i * DINP]; } while (0)
#define SSD_TABLE(tb_, dtr_) do { const float dt_ = softplus_f(bf2f(dtr_) + dtb); \
        float cs_ = Ah * dt_; _Pragma("unroll") for (int o = 1; o < 64; o <<= 1) { const float t2_ = __shfl(cs_, lane - o < 0 ? 0 : lane - o); if (lane >= o) cs_ += t2_; } \
        const float tot_ = __shfl(cs_, 63); (tb_)[lane] = dt_; (tb_)[64 + lane] = cs_; (tb_)[128 + lane] = fexp(tot_ - cs_); (tb_)[192 + lane] = fexp(cs_); if (lane == 0) (tb_)[256] = fexp(tot_); } while (0)

__device__ __forceinline__ void ssd_prompt_unit(const Frame& F, int layer, int mb, int sl, int hd) {
    const int tid = F.tid, lane = F.lane, w = F.wave, fr = lane & 15, fq = lane >> 4;
    LAS unsigned char* L = F.lds;
    LAS bf16_t* XT0 = (LAS bf16_t*)(L + SL_XT);
    LAS bf16_t* XTW = (LAS bf16_t*)(L + SL_XTW); LAS bf16_t* Mm = (LAS bf16_t*)(L + SL_MM); LAS bf16_t* Sb = (LAS bf16_t*)(L + SL_SB);
    LAS float* smb = (LAS float*)(L + SL_SM);
    const int g = hd >> 2;
    bf16_t* H = ws_bf(F, WS_H) + (size_t)sl * SEQ * DINP;
    const bf16_t* cmc = ws_bf(F, WS_CMC) + (size_t)sl * SEQ * 1024 + g * 128; const bf16_t* btg = ws_bf(F, WS_BTG); const bf16_t* cbg = ws_bf(F, WS_CBG);
    const float* convw = F.in[I_CONVW] + (size_t)layer * 4 * CONVDIM + hd * 64; const float* convb = F.in[I_CONVB] + (size_t)layer * CONVDIM + hd * 64;
    const float cw0 = convw[lane], cw1 = convw[CONVDIM + lane], cw2 = convw[2 * CONVDIM + lane], cw3 = convw[3 * CONVDIM + lane], cwb = convb[lane];
    __syncthreads();
    const float dtb = F.in[I_DTB][layer * 32 + hd], Ah = -fexp(F.in[I_ALOG][layer * 32 + hd]), Dh = F.in[I_SD][layer * 32 + hd];
    const int xl = tid >> 3, xcg = tid & 7;
    f32x4 S[4];
#pragma unroll
    for (int j = 0; j < 4; ++j) S[j] = (f32x4){0.f, 0.f, 0.f, 0.f};
    const int ti = w >> 1, tj0 = 2 * (w & 1);
    const int pi = w & 3, nb = w >> 2;
    bf16_t* pz = H + (size_t)(16 * ti + fr) * DINP + C_Z + hd * 64 + 16 * tj0 + 4 * fq; float* pss = ws_f(F, WS_SSQ) + ((size_t)sl * SEQ + 16 * ti + fr) * 64 + hd * 2 + (w & 1);
    unsigned rawx[11]; u32x2 zraw[2]; unsigned dtr_next;
    const bf16_t* dsrc[6]; SSD_DMA_SETUP();
    SSD_DMA(0); SSD_LOAD_X(0);
    zraw[0] = *(const u32x2*)pz; zraw[1] = *(const u32x2*)(pz + 16);
    { const unsigned d0 = H[(size_t)lane * DINP + C_DT + hd]; dtr_next = H[(size_t)(64 + lane) * DINP + C_DT + hd]; if (w == 7) { SSD_TABLE(smb, d0); smb[320 + lane] = Dh * __builtin_amdgcn_rcpf(smb[lane]); } }
    VM_WAIT(0);
    __syncthreads();
    for (int ck = 0; ck < NCHUNK; ++ck) {
        LAS float* sm = smb + (ck & 1) * 384; LAS float* smn = smb + ((ck + 1) & 1) * 384; LAS bf16_t* XT = XT0 + (ck & 1) * 64 * S64;
        LAS unsigned char* Ld = L + (ck & 1) * SL_DMA_SZ; LAS bf16_t* Cm = (LAS bf16_t*)(Ld + SL_CM); LAS bf16_t* BT = (LAS bf16_t*)(Ld + SL_BT); LAS bf16_t* CBl = (LAS bf16_t*)(Ld + SL_CB);
        { const f32x4 d0 = *(const LAS f32x4*)(sm + 8 * w), d1 = *(const LAS f32x4*)(sm + 8 * w + 4), e0 = *(const LAS f32x4*)(sm + 128 + 8 * w), e1 = *(const LAS f32x4*)(sm + 128 + 8 * w + 4);
          const float dtv[8] = {d0[0], d0[1], d0[2], d0[3], d1[0], d1[1], d1[2], d1[3]}, wdv[8] = {e0[0], e0[1], e0[2], e0[3], e1[0], e1[1], e1[2], e1[3]}; float xr[11], xa[8], xb[8];
#pragma unroll
          for (int i = 0; i < 11; ++i) xr[i] = blo(rawx[i]);
#pragma unroll
          for (int r = 0; r < 8; ++r) { const float xd = fsilu(cwb + xr[r] * cw0 + xr[r + 1] * cw1 + xr[r + 2] * cw2 + xr[r + 3] * cw3) * dtv[r]; xa[r] = xd; xb[r] = xd * wdv[r]; }
          *(LAS u32x4*)(XT + lane * S64 + 8 * w) = pack8(xa); *(LAS u32x4*)(XTW + lane * S64 + 8 * w) = pack8(xb); }
#pragma unroll
        for (int jj = 0; jj < 4; ++jj) { u32x2 wv; wv.x = pk2(S[jj][0], S[jj][1]); wv.y = pk2(S[jj][2], S[jj][3]); *(LAS u32x2*)(Sb + (16 * pi + fr) * S128 + 64 * nb + 16 * jj + 4 * fq) = wv; }
        if (ck > 0) VM_WAIT(2);
        LBAR();
        const u32x2 z0 = zraw[0], z1 = zraw[1]; const unsigned dtr_cur = dtr_next;
        if (ck + 1 < NCHUNK) SSD_DMA(ck + 1);
        if (ck + 1 < NCHUNK) { SSD_LOAD_XN(ck + 1); zraw[0] = *(const u32x2*)(pz + (size_t)64 * DINP); zraw[1] = *(const u32x2*)(pz + (size_t)64 * DINP + 16);
            dtr_next = H[((size_t)ck * 64 + (ck + 2 < NCHUNK ? 128 : 64) + lane) * DINP + C_DT + hd]; }
        asm volatile("" ::: "memory");
        if (w == 7 && ck + 1 < NCHUNK) { SSD_TABLE(smn, dtr_cur); smn[320 + lane] = Dh * __builtin_amdgcn_rcpf(smn[lane]); }
        { const int s0 = 8 * xcg; float mv[8];
          if (s0 <= xl) { float cbv[8]; unpack8(*(const LAS u32x4*)(CBl + xl * S64 + s0), cbv); const float al = sm[64 + xl]; const f32x4 a0 = *(const LAS f32x4*)(sm + 64 + s0), a1 = *(const LAS f32x4*)(sm + 64 + s0 + 4);
#pragma unroll
              for (int i = 0; i < 4; ++i) { mv[i] = (xl >= s0 + i) ? cbv[i] * fexp(fminf(al - a0[i], 0.f)) : 0.f; mv[4 + i] = (xl >= s0 + 4 + i) ? cbv[4 + i] * fexp(fminf(al - a1[i], 0.f)) : 0.f; }
              if ((xl >> 3) == xcg) { const float dd = sm[320 + xl];
#pragma unroll
                  for (int i = 0; i < 8; ++i) if (i == (xl & 7)) mv[i] += dd; } }
          else {
#pragma unroll
              for (int i = 0; i < 8; ++i) mv[i] = 0.f; }
          *(LAS u32x4*)(Mm + xl * S64 + s0) = pack8(mv); }
        f32x4 yo[2];
#pragma unroll
        for (int jj = 0; jj < 2; ++jj) { const int tj = tj0 + jj; yo[jj] = (f32x4){0.f, 0.f, 0.f, 0.f};
#pragma unroll
            for (int ks = 0; ks < 4; ++ks) { const bf16x8 sb = *(const LAS bf16x8*)(Sb + (16 * tj + fr) * S128 + 32 * ks + 8 * fq); const bf16x8 c = *(const LAS bf16x8*)(Cm + (16 * ti + fr) * S128 + 32 * ks + 8 * fq);
                yo[jj] = __builtin_amdgcn_mfma_f32_16x16x32_bf16(sb, c, yo[jj], 0, 0, 0); } }
        { const float cd = sm[256];
#pragma unroll
          for (int jj = 0; jj < 4; ++jj) { S[jj] = S[jj] * cd;
#pragma unroll
            for (int ks = 0; ks < 2; ++ks) { const bf16x8 a = *(const LAS bf16x8*)(BT + (64 * nb + 16 * jj + fr) * S64 + 32 * ks + 8 * fq); const bf16x8 b = *(const LAS bf16x8*)(XTW + (16 * pi + fr) * S64 + 32 * ks + 8 * fq);
                S[jj] = __builtin_amdgcn_mfma_f32_16x16x32_bf16(a, b, S[jj], 0, 0, 0); }
            if (jj & 1) asm volatile("" ::: "memory"); } }
        const float ec = sm[192 + 16 * ti + fr];
        LBAR();
        { float ss = 0.f; const u32x2 zz[2] = {z0, z1};
#pragma unroll
          for (int jj = 0; jj < 2; ++jj) { const int tj = tj0 + jj; f32x4 yd = (f32x4){0.f, 0.f, 0.f, 0.f};
#pragma unroll
              for (int ks = 0; ks < 2; ++ks) { const bf16x8 a = *(const LAS bf16x8*)(XT + (16 * tj + fr) * S64 + 32 * ks + 8 * fq); const bf16x8 b = *(const LAS bf16x8*)(Mm + (16 * ti + fr) * S64 + 32 * ks + 8 * fq);
                  yd = __builtin_amdgcn_mfma_f32_16x16x32_bf16(a, b, yd, 0, 0, 0); }
              const float z[4] = {blo(zz[jj].x), bhi(zz[jj].x), blo(zz[jj].y), bhi(zz[jj].y)}; float v[4];
#pragma unroll
              for (int r = 0; r < 4; ++r) { v[r] = (yd[r] + ec * yo[jj][r]) * fsilu(z[r]); ss += v[r] * v[r]; }
              u32x2 ov; ov.x = pk2(v[0], v[1]); ov.y = pk2(v[2], v[3]); *(u32x2*)(pz + 16 * jj) = ov; }
          ss += __shfl_xor(ss, 16); ss += __shfl_xor(ss, 32);
          if (fq == 0) *pss = ss;
          pz += (size_t)64 * DINP; pss += 64 * 64; }
    }
    float* so = F.out + O_SSP + ((((size_t)layer * BATCH + mb * NSEQ_MB + sl) * 32 + hd) * 64) * 128;
#pragma unroll
    for (int jj = 0; jj < 4; ++jj) *(f32x4*)(so + (size_t)(16 * pi + fr) * 128 + 64 * nb + 16 * jj + 4 * fq) = S[jj];
    VM_WAIT(0); __syncthreads();
}

__device__ __forceinline__ void ssd_sample_unit(const Frame& F, int layer, int sq, int hd) {
    const int tid = F.tid, lane = F.lane; LAS float* L = (LAS float*)F.lds;
    LAS float* xs = L; LAS float* Bs = L + 16 * 64; LAS float* Cs = Bs + 16 * 128; LAS float* dts = Cs + 16 * 128; LAS float* das = dts + 16; LAS float* Yl = das + 16;
    const int g = hd >> 2;
    bf16_t* H = ws_bf(F, WS_H) + (size_t)(NP + sq * 16) * DINP;
    const float* hist = F.in[I_SCV] + ((size_t)layer * DECB + sq) * 3 * CONVDIM;
    const float* convw = F.in[I_CONVW] + (size_t)layer * 4 * CONVDIM; const float* convb = F.in[I_CONVB] + (size_t)layer * CONVDIM;
    __syncthreads();
    if (tid < 320) { const int c = tid; const int xc = c < 64 ? hd * 64 + c : (c < 192 ? 2048 + g * 128 + (c - 64) : 3072 + g * 128 + (c - 192));
        float win[19];
#pragma unroll
        for (int i = 0; i < 3; ++i) win[i] = hist[i * CONVDIM + xc];
#pragma unroll
        for (int t = 0; t < 16; ++t) win[3 + t] = bf2f(H[(size_t)t * DINP + C_X + xc]);
        const float w0 = convw[xc], w1 = convw[CONVDIM + xc], w2 = convw[2 * CONVDIM + xc], w3 = convw[3 * CONVDIM + xc], bb = convb[xc];
#pragma unroll
        for (int t = 0; t < 16; ++t) { const float a = fsilu(bb + win[t] * w0 + win[t + 1] * w1 + win[t + 2] * w2 + win[t + 3] * w3);
            if (c < 64) xs[t * 64 + c] = a; else if (c < 192) Bs[t * 128 + c - 64] = a; else Cs[t * 128 + c - 192] = a; } }
    if (tid < 16) { const float dt = softplus_f(bf2f(H[(size_t)tid * DINP + C_DT + hd]) + F.in[I_DTB][layer * 32 + hd]); dts[tid] = dt; das[tid] = fexp(-fexp(F.in[I_ALOG][layer * 32 + hd]) * dt); }
    __syncthreads();
    const int p = tid >> 3, n0 = (tid & 7) * 16;
    const size_t sbase = ((((size_t)layer * DECB + sq) * 32 + hd) * 64 + p) * 128 + n0;
    float S[16];
#pragma unroll
    for (int i = 0; i < 16; ++i) S[i] = F.in[I_SST][sbase + i];
    for (int t = 0; t < 16; ++t) { const float dec = das[t], xv = xs[t * 64 + p] * dts[t]; float part = 0.f;
#pragma unroll
        for (int i = 0; i < 16; ++i) { S[i] = S[i] * dec + xv * Bs[t * 128 + n0 + i]; part += Cs[t * 128 + n0 + i] * S[i]; }
        part += __shfl_xor(part, 1); part += __shfl_xor(part, 2); part += __shfl_xor(part, 4);
        if ((tid & 7) == 0) Yl[t * 64 + p] = part; }
#pragma unroll
    for (int i = 0; i < 16; ++i) F.out[O_SSS + sbase + i] = S[i];
    __syncthreads();
    const float Dh = F.in[I_SD][layer * 32 + hd];
#pragma unroll
    for (int j = 0; j < 2; ++j) { const int it = tid + 512 * j, t = it >> 6, pp = it & 63;
        const float z = bf2f(H[(size_t)t * DINP + C_Z + hd * 64 + pp]); const float v = (Yl[t * 64 + pp] + Dh * xs[t * 64 + pp]) * fsilu(z);
        H[(size_t)t * DINP + C_Z + hd * 64 + pp] = bf1(v);
        const float ss = wave_sum(v * v);
        if (lane < 2) ws_f(F, WS_SSQ)[((size_t)NP + sq * 16 + t) * 64 + hd * 2 + lane] = lane == 0 ? ss : 0.f; }
}

__device__ __forceinline__ int t5_bucket(int rel) {
    const int n = rel < 0 ? -rel : rel; const int b = rel > 0 ? 16 : 0;
    if (n < 8) return b + n;
    int v = 8; v += n >= 12; v += n >= 16; v += n >= 23; v += n >= 32; v += n >= 46; v += n >= 64; v += n >= 91;
    return b + v;
}
constexpr int AK_P = 72, AV_P = 200;
constexpr int AL_K = 0, AL_VT = AL_K + 192 * AK_P * 2, AL_LUT = AL_VT + 64 * AV_P * 2, AL_END = AL_LUT + 4 * 256 * 4;
static_assert(AL_END <= RING_BYTES, "attention LDS map");
__device__ __forceinline__ void attn_prompt_unit(const Frame& F, int layer, int sl, int ck, int kh) {
    const int tid = F.tid, lane = F.lane, w = F.wave, q32 = lane & 31, hi = lane >> 5;
    LAS bf16_t* Kl = (LAS bf16_t*)(F.lds + AL_K); LAS bf16_t* VT = (LAS bf16_t*)(F.lds + AL_VT); LAS float* lut = (LAS float*)(F.lds + AL_LUT);
    bf16_t* H = ws_bf(F, WS_H) + (size_t)sl * SEQ * DINP;
    const int gq = w >> 1, qh = w & 1, head = kh * 4 + gq;
    const size_t qrow = (size_t)ck * 64 + 32 * qh + q32;
    bf16x8 qf[4];
#pragma unroll
    for (int ds = 0; ds < 4; ++ds) qf[ds] = *(const bf16x8*)(H + qrow * DINP + C_Q + head * 64 + 16 * ds + 8 * hi);
    __syncthreads();
#pragma unroll
    for (int j = 0; j < 3; ++j) { const int id = tid + 512 * j, key = id >> 3, cg = id & 7; const int t = 64 * (ck - 2) + key;
        u32x4 kv = (u32x4){0u, 0u, 0u, 0u}, vv = kv;
        if (t >= 0) { kv = *(const u32x4*)(H + (size_t)t * DINP + C_K + kh * 64 + 8 * cg); vv = *(const u32x4*)(H + (size_t)t * DINP + C_V + kh * 64 + 8 * cg); }
        *(LAS u32x4*)(Kl + key * AK_P + 8 * cg) = kv;
        VT[(8 * cg + 0) * AV_P + key] = (bf16_t)(vv.x & 0xffffu); VT[(8 * cg + 1) * AV_P + key] = (bf16_t)(vv.x >> 16); VT[(8 * cg + 2) * AV_P + key] = (bf16_t)(vv.y & 0xffffu); VT[(8 * cg + 3) * AV_P + key] = (bf16_t)(vv.y >> 16);
        VT[(8 * cg + 4) * AV_P + key] = (bf16_t)(vv.z & 0xffffu); VT[(8 * cg + 5) * AV_P + key] = (bf16_t)(vv.z >> 16); VT[(8 * cg + 6) * AV_P + key] = (bf16_t)(vv.w & 0xffffu); VT[(8 * cg + 7) * AV_P + key] = (bf16_t)(vv.w >> 16); }
    for (int e = tid; e < 4 * 255; e += NTHREADS) { const int gg = e / 255, idx = e % 255; lut[gg * 256 + idx] = F.in[I_RELB][t5_bucket(idx - 191) * 16 + kh * 4 + gg]; }
    __syncthreads();
    f32x16 sc[6];
#pragma unroll
    for (int kt = 0; kt < 6; ++kt) {
#pragma unroll
        for (int r = 0; r < 16; ++r) sc[kt][r] = 0.f;
#pragma unroll
        for (int ds = 0; ds < 4; ++ds) { const bf16x8 a = *(const LAS bf16x8*)(Kl + (32 * kt + q32) * AK_P + 16 * ds + 8 * hi); sc[kt] = __builtin_amdgcn_mfma_f32_32x32x16_bf16(a, qf[ds], sc[kt], 0, 0, 0); } }
    const int qidx = 32 * qh + q32; const float sink = F.in[I_SINK][layer * 16 + head];
    float mx = -3.0e38f;
#pragma unroll
    for (int kt = 0; kt < 6; ++kt)
#pragma unroll
        for (int r = 0; r < 16; ++r) { const int key = 32 * kt + (r & 3) + 8 * (r >> 2) + 4 * hi; const int rel = key - 128 - qidx;
            float s = sc[kt][r] * 0.125f + lut[gq * 256 + rel + 191]; if (ck < 2 && 64 * ck + key - 128 < 0) s = -1e30f; sc[kt][r] = s; mx = fmaxf(mx, s); }
    mx = fmaxf(mx, __shfl_xor(mx, 32)); mx = fmaxf(mx, sink);
    float sum = 0.f;
#pragma unroll
    for (int kt = 0; kt < 6; ++kt)
#pragma unroll
        for (int r = 0; r < 16; ++r) { const float e = fexp(sc[kt][r] - mx); sc[kt][r] = e; sum += e; }
    sum += __shfl_xor(sum, 32);
    const float inv = 1.0f / (sum + fexp(sink - mx));
    f32x16 o[2];
#pragma unroll
    for (int d2 = 0; d2 < 2; ++d2)
#pragma unroll
        for (int r = 0; r < 16; ++r) o[d2][r] = 0.f;
#pragma unroll
    for (int kt = 0; kt < 6; ++kt)
#pragma unroll
        for (int s = 0; s < 2; ++s) {
            u32x4 pw; pw.x = pk2(sc[kt][8 * s + 0], sc[kt][8 * s + 1]); pw.y = pk2(sc[kt][8 * s + 2], sc[kt][8 * s + 3]); pw.z = pk2(sc[kt][8 * s + 4], sc[kt][8 * s + 5]); pw.w = pk2(sc[kt][8 * s + 6], sc[kt][8 * s + 7]);
            const bf16x8 pa = __builtin_bit_cast(bf16x8, pw);
#pragma unroll
            for (int d2 = 0; d2 < 2; ++d2) { const LAS bf16_t* vp = VT + (32 * d2 + q32) * AV_P + 32 * kt + 16 * s + 4 * hi;
                const u32x2 lo = *(const LAS u32x2*)vp, hh = *(const LAS u32x2*)(vp + 8); u32x4 vw; vw.x = lo.x; vw.y = lo.y; vw.z = hh.x; vw.w = hh.y;
                o[d2] = __builtin_amdgcn_mfma_f32_32x32x16_bf16(pa, __builtin_bit_cast(bf16x8, vw), o[d2], 0, 0, 0); } }
#pragma unroll
    for (int r = 0; r < 16; ++r) { const int q = (r & 3) + 8 * (r >> 2) + 4 * hi; const float iv = __shfl(inv, q);
        bf16_t* op = H + ((size_t)ck * 64 + 32 * qh + q) * DINP + C_Q + head * 64 + q32;
        op[0] = bf1(o[0][r] * iv); op[32] = bf1(o[1][r] * iv); }
}
__device__ __forceinline__ void attn_sample_unit(const Frame& F, int layer, int sq, int kh) {
    const int tid = F.tid; LAS float* L = (LAS float*)F.lds;
    LAS float* Kf = L; LAS float* Vf = Kf + 144 * 65; LAS float* Qf = Vf + 144 * 64; LAS float* P = Qf + 64 * 65; LAS float* Pinv = P + 64 * 145;
    static_assert((144 * 65 + 144 * 64 + 64 * 65 + 64 * 145 + 64) * 4 <= RING_BYTES, "sample attention LDS map");
    bf16_t* H = ws_bf(F, WS_H) + (size_t)(NP + sq * 16) * DINP;
    const float* ck = F.in[I_CK] + ((size_t)layer * DECB + sq) * WINDOW * 256; const float* cv = F.in[I_CV] + ((size_t)layer * DECB + sq) * WINDOW * 256;
    __syncthreads();
    for (int i = tid; i < 144 * 64; i += NTHREADS) { const int key = i >> 6, d = i & 63;
        Kf[key * 65 + d] = key < 128 ? ck[(size_t)key * 256 + kh * 64 + d] : bf2f(H[(size_t)(key - 128) * DINP + C_K + kh * 64 + d]);
        Vf[key * 64 + d] = key < 128 ? cv[(size_t)key * 256 + kh * 64 + d] : bf2f(H[(size_t)(key - 128) * DINP + C_V + kh * 64 + d]); }
    for (int i = tid; i < 64 * 64; i += NTHREADS) { const int row = i >> 6, d = i & 63; Qf[row * 65 + d] = bf2f(H[(size_t)(row & 15) * DINP + C_Q + (kh * 4 + (row >> 4)) * 64 + d]); }
    __syncthreads();
    for (int i = tid; i < 64 * 144; i += NTHREADS) { const int row = i / 144, key = i % 144; float s = 0.f;
        for (int d = 0; d < 64; ++d) s += Qf[row * 65 + d] * Kf[key * 65 + d];
        P[row * 145 + key] = s * 0.125f + F.in[I_RELB][t5_bucket(key - 128 - (row & 15)) * 16 + kh * 4 + (row >> 4)]; }
    __syncthreads();
    { const int row = tid >> 3, sub = tid & 7; const float sink = F.in[I_SINK][layer * 16 + kh * 4 + (row >> 4)]; float mx = -3.0e38f;
      for (int k = sub; k < 144; k += 8) mx = fmaxf(mx, P[row * 145 + k]);
      mx = fmaxf(mx, __shfl_xor(mx, 1)); mx = fmaxf(mx, __shfl_xor(mx, 2)); mx = fmaxf(mx, __shfl_xor(mx, 4)); mx = fmaxf(mx, sink);
      float sum = 0.f;
      for (int k = sub; k < 144; k += 8) { const float e = fexp(P[row * 145 + k] - mx); P[row * 145 + k] = e; sum += e; }
      sum += __shfl_xor(sum, 1); sum += __shfl_xor(sum, 2); sum += __shfl_xor(sum, 4);
      if (sub == 0) Pinv[row] = 1.0f / (sum + fexp(sink - mx)); }
    __syncthreads();
    { const int row = tid >> 3, d0 = (tid & 7) * 8; float o[8] = {0.f, 0.f, 0.f, 0.f, 0.f, 0.f, 0.f, 0.f};
      for (int k = 0; k < 144; ++k) { const float pv = P[row * 145 + k];
#pragma unroll
          for (int i = 0; i < 8; ++i) o[i] += pv * Vf[k * 64 + d0 + i]; }
      const float iv = Pinv[row];
#pragma unroll
      for (int i = 0; i < 8; ++i) o[i] *= iv;
      *(u32x4*)(H + (size_t)(row & 15) * DINP + C_Q + (kh * 4 + (row >> 4)) * 64 + d0) = pack8(o); }
}
__device__ __forceinline__ void sc_unit(const Frame& F, int layer, int tile) {
    const int tid = F.tid, cg = tid & 127, rs = tid >> 7; bf16_t* H = ws_bf(F, WS_H);
    const float* wsc = F.in[I_SCW] + (size_t)layer * 3 * D + 8 * cg; float wt[3][8];
#pragma unroll
    for (int i = 0; i < 3; ++i)
#pragma unroll
        for (int c = 0; c < 8; ++c) wt[i][c] = wsc[i * D + c];
    const int row0 = tile * 64 + 16 * rs; const bool smp = row0 >= NP; const int tt0 = smp ? 0 : row0 % SEQ;
    float u1[8], u2[8];
    if (tt0 >= 2) { float c8[8], h8[8];
        unpack8(*(const u32x4*)(H + (size_t)(row0 - 2) * DINP + C_SCC + 8 * cg), c8); unpack8(*(const u32x4*)(H + (size_t)(row0 - 2) * DINP + C_SCH + 8 * cg), h8);
#pragma unroll
        for (int c = 0; c < 8; ++c) u2[c] = c8[c] * h8[c];
        unpack8(*(const u32x4*)(H + (size_t)(row0 - 1) * DINP + C_SCC + 8 * cg), c8); unpack8(*(const u32x4*)(H + (size_t)(row0 - 1) * DINP + C_SCH + 8 * cg), h8);
#pragma unroll
        for (int c = 0; c < 8; ++c) u1[c] = c8[c] * h8[c]; }
    else if (smp) { const float* hp = F.in[I_SSC] + (((size_t)layer * DECB + ((row0 - NP) >> 4)) * 2) * D + 8 * cg;
#pragma unroll
        for (int c = 0; c < 8; ++c) { u2[c] = hp[c]; u1[c] = hp[D + c]; } }
    else {
#pragma unroll
        for (int c = 0; c < 8; ++c) { u2[c] = 0.f; u1[c] = 0.f; } }
#pragma unroll 1
    for (int q = 0; q < 4; ++q) {
        u32x4 cw_[4], hw_[4], bw_[4];
#pragma unroll
        for (int i = 0; i < 4; ++i) { const bf16_t* hp = H + (size_t)(row0 + 4 * q + i) * DINP + 8 * cg; cw_[i] = *(const u32x4*)(hp + C_SCC); hw_[i] = *(const u32x4*)(hp + C_SCH); bw_[i] = *(const u32x4*)(hp + C_SCB); }
        asm volatile("" ::: "memory");
#pragma unroll
        for (int i = 0; i < 4; ++i) { float c8[8], h8[8], b8[8], a[8]; unpack8(cw_[i], c8); unpack8(hw_[i], h8); unpack8(bw_[i], b8);
#pragma unroll
            for (int c = 0; c < 8; ++c) { const float u0 = c8[c] * h8[c]; a[c] = (u2[c] * wt[0][c] + u1[c] * wt[1][c] + u0 * wt[2][c]) * b8[c]; u2[c] = u1[c]; u1[c] = u0; }
            *(u32x4*)(H + (size_t)(row0 + 4 * q + i) * DINP + C_SCB + 8 * cg) = pack8(a); }
    }
}
__device__ __forceinline__ void state_out_unit(const Frame& F, int layer, int mb, int sl, bool smp) {
    const int tid = F.tid; const bf16_t* H = ws_bf(F, WS_H);
    const int nkv = smp ? DECS : WINDOW, len = smp ? DECS : SEQ; const size_t row0 = smp ? (size_t)NP + sl * 16 : (size_t)sl * SEQ; const int sg = smp ? sl : mb * NSEQ_MB + sl;
    const size_t nb_ = smp ? DECB : BATCH;
    float* ko = F.out + (smp ? O_KS : O_KP) + ((size_t)layer * nb_ + sg) * nkv * 256; float* vo = F.out + (smp ? O_VS : O_VP) + ((size_t)layer * nb_ + sg) * nkv * 256;
    for (int i = tid; i < nkv * 32; i += NTHREADS) { const int j = i >> 5, c8 = (i & 31) * 8; const bf16_t* hp = H + (row0 + len - nkv + j) * DINP; float f[8];
        unpack8(*(const u32x4*)(hp + C_K + c8), f); *(f32x4*)(ko + (size_t)j * 256 + c8) = (f32x4){f[0], f[1], f[2], f[3]}; *(f32x4*)(ko + (size_t)j * 256 + c8 + 4) = (f32x4){f[4], f[5], f[6], f[7]};
        unpack8(*(const u32x4*)(hp + C_V + c8), f); *(f32x4*)(vo + (size_t)j * 256 + c8) = (f32x4){f[0], f[1], f[2], f[3]}; *(f32x4*)(vo + (size_t)j * 256 + c8 + 4) = (f32x4){f[4], f[5], f[6], f[7]}; }
    float* co = F.out + (smp ? O_CVS : O_CVP) + ((size_t)layer * nb_ + sg) * 3 * CONVDIM;
    for (int i = tid; i < 3 * 512; i += NTHREADS) { const int j = i / 512, c8 = (i % 512) * 8; float f[8]; unpack8(*(const u32x4*)(H + (row0 + len - 3 + j) * DINP + C_X + c8), f);
        *(f32x4*)(co + (size_t)j * CONVDIM + c8) = (f32x4){f[0], f[1], f[2], f[3]}; *(f32x4*)(co + (size_t)j * CONVDIM + c8 + 4) = (f32x4){f[4], f[5], f[6], f[7]}; }
    float* so = F.out + (smp ? O_SCS : O_SCP) + ((size_t)layer * nb_ + sg) * 2 * D;
    for (int i = tid; i < 2 * 128; i += NTHREADS) { const int j = i >> 7, c8 = (i & 127) * 8; float c[8], h[8]; const bf16_t* hp = H + (row0 + len - 2 + j) * DINP;
        unpack8(*(const u32x4*)(hp + C_SCC + c8), c); unpack8(*(const u32x4*)(hp + C_SCH + c8), h);
        *(f32x4*)(so + (size_t)j * D + c8) = (f32x4){c[0] * h[0], c[1] * h[1], c[2] * h[2], c[3] * h[3]}; *(f32x4*)(so + (size_t)j * D + c8 + 4) = (f32x4){c[4] * h[4], c[5] * h[5], c[6] * h[6], c[7] * h[7]}; }
}
#ifndef MIX_MASK
#define MIX_MASK 0xFF
#endif
#define MIXON(b) ((MIX_MASK >> (b)) & 1)
__device__ __forceinline__ void step_premix(const Frame& F, int layer, int mb) {
    const int n_bc = NSEQ_MB * NCHUNK * 8, n_att = NSEQ_MB * NCHUNK * NKV, n_sc = rows_of(mb) / 64, n_so = NSEQ_MB + (mb == 0 ? DECB : 0);
    const int n_ss = mb == 0 ? DECB * 32 : 0, n_as = mb == 0 ? DECB * NKV : 0;
    const int total = n_bc + n_att + n_sc + n_so + n_ss + n_as;
#define UF(Fu) Frame Fu = F; Fu.lane = opq(lane_id()); Fu.tid = Fu.wave * 64 + Fu.lane
    PROBE_T0(14) if constexpr (MIXON(0)) { UF(Fu); BcRegs ra, rn_;
        if (F.bid < n_bc) ssd_bc_load(Fu, layer, F.bid, ra);
        for (int u = F.bid; u < n_bc; u += F.G) { const bool more = u + F.G < n_bc; if (more) ssd_bc_load(Fu, layer, u + F.G, rn_);
            ssd_bc_unit(Fu, u, ra);
            if (more) ra = rn_; } }
    PROBE_T1(14)
    for (int un = F.bid; un < total; un += F.G) { int r = un;
        if (r < n_bc) continue;
        r -= n_bc;
        if (r < n_att) { PROBE_T0(15) if constexpr (MIXON(1)) { UF(Fu); attn_prompt_unit(Fu, layer, r / (NCHUNK * NKV), (r / NKV) % NCHUNK, r % NKV); } PROBE_T1(15) continue; } r -= n_att;
        if (r < n_sc) { PROBE_T0(16) if constexpr (MIXON(2)) { UF(Fu); sc_unit(Fu, layer, r); } PROBE_T1(16) continue; } r -= n_sc;
        if (r < n_so) { PROBE_T0(17) if constexpr (MIXON(3)) { UF(Fu); state_out_unit(Fu, layer, mb, r < NSEQ_MB ? r : r - NSEQ_MB, r >= NSEQ_MB); } PROBE_T1(17) continue; } r -= n_so;
        if (r < n_ss) { PROBE_T0(18) if constexpr (MIXON(4)) { UF(Fu); ssd_sample_unit(Fu, layer, r >> 5, r & 31); } PROBE_T1(18) continue; } r -= n_ss;
        { PROBE_T0(19) if constexpr (MIXON(5)) { UF(Fu); attn_sample_unit(Fu, layer, r >> 2, r & 3); } PROBE_T1(19) }
    }
}
__device__ __forceinline__ void step_mixers(const Frame& F, int layer, int mb) {
    for (int v = F.bid; v < NSEQ_MB * 32; v += F.G) { const int un = (NSEQ_MB == 8 && F.G == 256) ? (v & 7) * 32 + (v >> 3) : v; UF(Fu); ssd_prompt_unit(Fu, layer, mb, un >> 5, un & 31); }
}
__device__ __forceinline__ void step_gnorm(const Frame& F, int mb) {
    const int gw = F.bid * NWAVES + F.wave, NGW = F.G * NWAVES, nr = rows_of(mb); bf16_t* H = ws_bf(F, WS_H); const float* ssq = ws_f(F, WS_SSQ);
    constexpr int RB = 4; const int g = F.lane >> 3;
    for (int r0 = gw; r0 < nr; r0 += RB * NGW) {
        u32x4 d[RB][4]; f32x4 q[RB];
#pragma unroll
        for (int i = 0; i < RB; ++i) { const int r = r0 + i * NGW < nr ? r0 + i * NGW : r0; { const f32x4 qa = *(const f32x4*)(ssq + (size_t)r * 64 + 8 * g), qb = *(const f32x4*)(ssq + (size_t)r * 64 + 8 * g + 4); q[i] = qa + qb; } const u32x4* p = (const u32x4*)(H + (size_t)r * DINP + C_Z + 32 * F.lane);
#pragma unroll
            for (int j = 0; j < 4; ++j) d[i][j] = p[j]; }
        asm volatile("" ::: "memory");
#pragma unroll
        for (int i = 0; i < RB; ++i) { const int r = r0 + i * NGW; if (r >= nr) continue;
            const float rstd = 1.0f / sqrtf(((q[i][0] + q[i][1]) + (q[i][2] + q[i][3])) * (1.0f / 256.0f) + LN_EPS); u32x4* p = (u32x4*)(H + (size_t)r * DINP + C_Z + 32 * F.lane);
#pragma unroll
            for (int j = 0; j < 4; ++j) { float f[8]; unpack8(d[i][j], f);
#pragma unroll
                for (int k = 0; k < 8; ++k) f[k] *= rstd;
                p[j] = pack8(f); } }
    }
}
constexpr int LOG_NEXP = NEXP == 32 ? 5 : (NEXP == 16 ? 4 : (NEXP == 8 ? 3 : 2));
template <int N, int MASK> struct RedStep {
    static __device__ __forceinline__ void run(float* v, int lane) {
        constexpr int Hn = N / 2; const bool up = (lane & MASK) != 0;
#pragma unroll
        for (int i = 0; i < Hn; ++i) { const float keep = up ? v[i + Hn] : v[i], send = up ? v[i] : v[i + Hn]; v[i] = keep + xshfl<MASK>(send); }
        if constexpr (Hn > 1) RedStep<Hn, (MASK >> 1)>::run(v, lane);
    }
};
__device__ __forceinline__ void step_ln1_router(const Frame& F, int layer, int mb) {
    LAS float* wT = (LAS float*)F.lds;
    const float* rw = F.in[I_RW] + (size_t)layer * D * NEXP;
    __syncthreads();
    for (int i = F.tid; i < D * NEXP; i += NTHREADS) { const int e = i / D, k = i % D; wT[i] = rw[(size_t)k * NEXP + e]; }
    unsigned* cnt = F.ctl + CW_CNT + (mb * DEPTH + layer) * 64;
    LAS unsigned* lcnt = (LAS unsigned*)(F.lds + MISC_OFF) + 128;
    if (F.tid < 64) lcnt[F.tid] = 0u;
    __syncthreads();
    const int gw = F.bid * NWAVES + F.wave, NGW = F.G * NWAVES, nr = rows_of(mb), lane = F.lane;
    const float* lg = F.in[I_LN1G] + (size_t)layer * D; const float* lb = F.in[I_LN1B] + (size_t)layer * D; const float* rb = F.in[I_RB] + (size_t)layer * NEXP;
    bf16_t* XB = ws_bf(F, WS_XB); int* topi = (int*)(F.ws + WS_TOPI); float* gate = ws_f(F, WS_GATE); int* pos = (int*)(F.ws + WS_POS);
    constexpr int RB = 4, NH = NEXP / 2, LOGH = LOG_NEXP - 1;
    const int myexp = ((lane & 1) * NH) | ((lane >> (6 - LOGH)) & (NH - 1));
    const float myb = rb[myexp];
    for (int r0 = gw; r0 < nr; r0 += RB * NGW) {
        f32x4 v[RB][4]; int rr[RB]; bool ok[RB];
#pragma unroll
        for (int i = 0; i < RB; ++i) { const int r = r0 + i * NGW; ok[i] = r < nr; rr[i] = ok[i] ? r : r0; const float* xr = x_out_row(F, mb, rr[i]);
#pragma unroll
            for (int j = 0; j < 4; ++j) v[i][j] = *((const f32x4*)xr + lane + 64 * j); }
        asm volatile("" ::: "memory");
#pragma unroll
        for (int i = 0; i < RB; ++i) {
            float s = 0.f;
#pragma unroll
            for (int j = 0; j < 4; ++j) s += (v[i][j][0] + v[i][j][1]) + (v[i][j][2] + v[i][j][3]);
            const float mean = wave_sum(s) * (1.0f / D); float s2 = 0.f;
#pragma unroll
            for (int j = 0; j < 4; ++j) { v[i][j] = v[i][j] - mean; s2 += (v[i][j][0] * v[i][j][0] + v[i][j][1] * v[i][j][1]) + (v[i][j][2] * v[i][j][2] + v[i][j][3] * v[i][j][3]); }
            const float rstd = 1.0f / sqrtf(wave_sum(s2) * (1.0f / D) + LN_EPS);
#pragma unroll
            for (int j = 0; j < 4; ++j) { const f32x4 gg = *((const f32x4*)lg + lane + 64 * j), bb = *((const f32x4*)lb + lane + 64 * j); v[i][j] = v[i][j] * rstd * gg + bb;
                if (ok[i]) { u32x2 w; w.x = pk2(v[i][j][0], v[i][j][1]); w.y = pk2(v[i][j][2], v[i][j][3]); *((u32x2*)(XB + (size_t)rr[i] * D) + lane + 64 * j) = w; } }
        }
        typedef float f32x2v __attribute__((ext_vector_type(2)));
        float val[RB];
#pragma unroll
        for (int hf = 0; hf < 2; ++hf) {
            float lgt[RB][NH];
#pragma unroll
            for (int e = 0; e < NH; ++e) { f32x2v a2[RB / 2];
#pragma unroll
                for (int i = 0; i < RB / 2; ++i) a2[i] = (f32x2v){0.f, 0.f};
#pragma unroll
                for (int j = 0; j < 4; ++j) { const f32x4 wv = *((const LAS f32x4*)(wT + (hf * NH + e) * D) + lane + 64 * j);
#pragma unroll
                    for (int c = 0; c < 4; ++c) { const f32x2v w2 = (f32x2v){wv[c], wv[c]};
#pragma unroll
                        for (int i = 0; i < RB / 2; ++i) a2[i] = __builtin_elementwise_fma((f32x2v){v[2 * i][j][c], v[2 * i + 1][j][c]}, w2, a2[i]); } }
#pragma unroll
                for (int i = 0; i < RB / 2; ++i) { lgt[2 * i][e] = a2[i].x; lgt[2 * i + 1][e] = a2[i].y; }
                if ((e & 1) == 1) asm volatile("" ::: "memory"); }
#pragma unroll
            for (int i = 0; i < RB; ++i) { RedStep<NH, 32>::run(lgt[i], lane); float tot = lgt[i][0];
                if constexpr ((32 >> LOGH) >= 8) tot += xshfl<8>(tot);
                if constexpr ((32 >> LOGH) >= 4) tot += xshfl<4>(tot);
                if constexpr ((32 >> LOGH) >= 2) tot += xshfl<2>(tot);
                tot += xshfl<1>(tot);
                if ((lane & 1) == hf) val[i] = tot + myb; }
        }
#pragma unroll
        for (int i = 0; i < RB; ++i) {
            float tv[4]; int te[4]; float vv = val[i];
#pragma unroll
            for (int k = 0; k < 4; ++k) { float m = vv; m = fmaxf(m, xshfl<1>(m)); m = fmaxf(m, xshfl<2>(m)); m = fmaxf(m, xshfl<4>(m)); m = fmaxf(m, xshfl<8>(m)); m = fmaxf(m, xshfl<16>(m)); m = fmaxf(m, xshfl<32>(m));
                const unsigned long long bal = __ballot(vv == m); const int wl = __builtin_ctzll(bal);
                const int be = ((wl & 1) * NH) | ((wl >> (6 - LOGH)) & (NH - 1));
                tv[k] = m; te[k] = be; if (myexp == be) vv = -3.0e38f; }
            const float e1 = fexp(tv[1] - tv[0]), e2 = fexp(tv[2] - tv[0]), e3 = fexp(tv[3] - tv[0]); const float inv = 1.0f / (1.0f + e1 + e2 + e3);
            if (lane < 4 && ok[i]) { const int e = lane == 0 ? te[0] : (lane == 1 ? te[1] : (lane == 2 ? te[2] : te[3])); const float gv = (lane == 0 ? 1.0f : (lane == 1 ? e1 : (lane == 2 ? e2 : e3))) * inv;
                const unsigned rk = __hip_atomic_fetch_add(lcnt + e, 1u, __ATOMIC_RELAXED, __HIP_MEMORY_SCOPE_WORKGROUP);
                topi[(size_t)rr[i] * 4 + lane] = e; gate[(size_t)rr[i] * 4 + lane] = gv; pos[(size_t)rr[i] * 4 + lane] = (int)rk; }
        }
    }
    __syncthreads();
    if (F.tid < NEXP) lcnt[32 + F.tid] = __hip_atomic_fetch_add(cnt + F.tid, lcnt[F.tid], __ATOMIC_RELAXED, __HIP_MEMORY_SCOPE_AGENT);
    __syncthreads();
    for (int r = gw; r < nr; r += NGW) if (lane < 4) pos[(size_t)r * 4 + lane] += (int)lcnt[32 + topi[(size_t)r * 4 + lane]];
}
__device__ __forceinline__ int moe_table(const Frame& F, int layer, int mb) {
    LAS int* M = (LAS int*)(F.lds + MISC_OFF);
    __syncthreads();
    if (F.tid == 0) { unsigned* cnt = F.ctl + CW_CNT + (mb * DEPTH + layer) * 64; int acc = 0;
        for (int e = 0; e < NEXP; ++e) { const int c = (int)__hip_atomic_load(cnt + e, __ATOMIC_RELAXED, __HIP_MEMORY_SCOPE_AGENT); M[64 + e] = acc * 256; acc += (c + 255) / 256; M[16 + e] = acc; } }
    __syncthreads();
    return M[16 + NEXP - 1];
}
__device__ __forceinline__ void step_gather(const Frame& F, int layer, int mb) {
    (void)moe_table(F, layer, mb); const LAS int* M = (const LAS int*)(F.lds + MISC_OFF);
    const int nr = rows_of(mb);
    const int* topi = (const int*)(F.ws + WS_TOPI); const float* gate = ws_f(F, WS_GATE); int* pos = (int*)(F.ws + WS_POS); float* gs = ws_f(F, WS_GSORT); int* rtok = (int*)(F.ws + WS_RTOK);
#pragma nounroll
    for (int i = F.bid * NTHREADS + F.tid; i < nr * 4; i += F.G * NTHREADS) { const int p = M[64 + topi[i]] + pos[i]; pos[i] = p; rtok[p] = i >> 2; gs[p] = gate[i]; }
}
__device__ __forceinline__ void step_ln2(const Frame& F, int layer, int mb) {
    const int gw = F.bid * NWAVES + F.wave, NGW = F.G * NWAVES, nr = rows_of(mb), lane = F.lane;
    const float* lg = F.in[I_LN2G] + (size_t)layer * D; const float* lb = F.in[I_LN2B] + (size_t)layer * D;
    const bf16_t* OUTS = ws_bf(F, WS_H) + (size_t)2 * RP * D; const int* pos = (const int*)(F.ws + WS_POS); bf16_t* XB = ws_bf(F, WS_XB);
    constexpr int RB = 2;
    for (int r0 = gw; r0 < nr; r0 += RB * NGW) {
        f32x4 v[RB][4]; u32x2 ow[RB][4][4]; int rr[RB];
#pragma unroll
        for (int i = 0; i < RB; ++i) { rr[i] = r0 + i * NGW < nr ? r0 + i * NGW : r0; const u32x2* xr = (const u32x2*)(XB + (size_t)rr[i] * D); int p[4];
#pragma unroll
            for (int k = 0; k < 4; ++k) p[k] = pos[(size_t)rr[i] * 4 + k];
#pragma unroll
            for (int j = 0; j < 4; ++j) { { const u32x2 w = xr[lane + 64 * j]; v[i][j] = (f32x4){blo(w.x), bhi(w.x), blo(w.y), bhi(w.y)}; }
#pragma unroll
                for (int k = 0; k < 4; ++k) ow[i][k][j] = *((const u32x2*)(OUTS + (size_t)p[k] * D) + lane + 64 * j); } }
        asm volatile("" ::: "memory");
#pragma unroll
        for (int i = 0; i < RB; ++i) { if (r0 + i * NGW >= nr) continue;
            float* xr = x_out_row(F, mb, rr[i]); float s = 0.f;
#pragma unroll
            for (int j = 0; j < 4; ++j) { v[i][j] = v[i][j] * ALPHA;
#pragma unroll
                for (int k = 0; k < 4; ++k) { const u32x2 w = ow[i][k][j]; v[i][j] = v[i][j] + (f32x4){blo(w.x), bhi(w.x), blo(w.y), bhi(w.y)}; }
                s += (v[i][j][0] + v[i][j][1]) + (v[i][j][2] + v[i][j][3]); }
            const float mean = wave_sum(s) * (1.0f / D); float s2 = 0.f;
#pragma unroll
            for (int j = 0; j < 4; ++j) { v[i][j] = v[i][j] - mean; s2 += (v[i][j][0] * v[i][j][0] + v[i][j][1] * v[i][j][1]) + (v[i][j][2] * v[i][j][2] + v[i][j][3] * v[i][j][3]); }
            const float rstd = 1.0f / sqrtf(wave_sum(s2) * (1.0f / D) + LN_EPS);
#pragma unroll
            for (int j = 0; j < 4; ++j) { const f32x4 gg = *((const f32x4*)lg + lane + 64 * j), bb = *((const f32x4*)lb + lane + 64 * j); v[i][j] = v[i][j] * rstd * gg + bb;
                *((f32x4*)xr + lane + 64 * j) = v[i][j]; u32x2 w; w.x = pk2(v[i][j][0], v[i][j][1]); w.y = pk2(v[i][j][2], v[i][j][3]); *((u32x2*)(XB + (size_t)rr[i] * D) + lane + 64 * j) = w; } }
    }
}

constexpr int PH_PER = 11, NSTEPS = 1 + NMB * DEPTH * PH_PER;
__global__ void __launch_bounds__(NTHREADS, 2) fwd(Args args) {
#ifdef EMU
    unsigned char* lds = emu_wg->lds;
#else
    extern __shared__ __attribute__((aligned(16))) unsigned char lds[];
#endif
    Frame F0; F0.lds = (LAS unsigned char*)lds; F0.tid = threadIdx.x; F0.lane = F0.tid & 63; F0.wave = __builtin_amdgcn_readfirstlane(F0.tid >> 6); F0.G = gridDim.x; F0.bid = blockIdx.x;
#ifdef EMU
    F0.in = args.in;
#else
    F0.in = (ArgTab)__builtin_amdgcn_kernarg_segment_ptr();
    static_assert(offsetof(Args, out) == 248 && offsetof(Args, ws) == 256 && offsetof(Args, in) == 0, "PF() reads the argument struct by offset");
#endif
    F0.out = args.out; F0.ws = args.ws; F0.ctl = (unsigned*)(args.ws + WS_CTL);
    const Frame& F = F0;
    const int lo = args.lo, hi = args.hi;
#ifndef EMU
    for (int u = F.tid; u < (LDS_BYTES - MISC_OFF) / 4; u += NTHREADS) ((LAS unsigned*)(F.lds + MISC_OFF))[u] = 0u;
    __syncthreads();
    XcdBarrier bar; bar.bar = F.ctl + CW_BAR; bar.x = 0; bar.st = nullptr;
    if (hi - lo > 1) bar = xcd_barrier_post(F.ctl + CW_BAR, (volatile LAS unsigned*)(F.lds + MISC_OFF) + 8);
#define SEAM(s) do { if ((s) + 1 < hi) { XcdBarrier b2_ = bar; unsigned long long bp_ = (unsigned long long)b2_.bar; asm volatile("" : "+s"(bp_)); b2_.bar = (unsigned*)bp_; xcd_barrier(b2_); } } while (0)
#else
#define SEAM(s) do { } while (0)
#endif
#ifndef PH_MASK
#define PH_MASK 0xFFFFFFFF
#endif
#define IN(s) (lo <= (s) && (s) < hi)
#define PHON(b) ((PH_MASK >> (b)) & 1)
#ifdef EMU
#define PF(Fp) Frame Fp = F0
#else
#define PF(Fp) Frame Fp; { unsigned long long kp_ = (unsigned long long)__builtin_amdgcn_kernarg_segment_ptr(); asm volatile("" : "+s"(kp_)); \
    Fp.in = (ArgTab)kp_; Fp.out = *(float* const __attribute__((address_space(4)))*)(kp_ + 248); Fp.ws = *(unsigned char* const __attribute__((address_space(4)))*)(kp_ + 256); Fp.ctl = (unsigned*)Fp.ws; \
    Fp.lds = F0.lds; Fp.G = F0.G; Fp.bid = F0.bid; Fp.wave = F0.wave; Fp.lane = opq(lane_id()); Fp.tid = Fp.wave * 64 + Fp.lane; }
#endif
    int step = 0;
    if (IN(step)) { PROBE_T0(0) if constexpr (PHON(0)) { PF(F); step_weights(F); for (int m = 0; m < NMB; ++m) step_xb(F, m); } PROBE_T1(0) SEAM(step); }
    ++step;
#define PHV const int mb = opqs(mb0), layer = opqs(layer0), nr = rows_of(mb); (void)nr; (void)layer
    for (int mb0 = 0; mb0 < NMB; ++mb0)
        for (int layer0 = 0; layer0 < DEPTH; ++layer0) {
            if (IN(step)) { PROBE_T0(2) if constexpr (PHON(2)) { PF(F); PHV; pg8::Gemm g{layer == 0 ? ws_bf(F, WS_XB0) + (size_t)mb * R * D : ws_bf(F, WS_XB), wl_ptr(F, layer, WL_IN), nr, DINP, D, D, nullptr}; pg8::StaticOrder S; S.init(nr, DINP, F.G, F.bid);
                pg8::EpiStoreBf16 E{ws_bf(F, WS_H), DINP}; pg8::gemm_phase(F.lds, g, S, E, F.wave); } PROBE_T1(2) SEAM(step); }
            ++step;
            if (IN(step)) { PROBE_T0(13) if constexpr (PHON(13)) { PF(F); PHV; step_premix(F, layer, mb); } PROBE_T1(13) SEAM(step); }
            ++step;
            if (IN(step)) { PROBE_T0(3) if constexpr (PHON(3)) { PF(F); PHV; step_mixers(F, layer, mb); } PROBE_T1(3) SEAM(step); }
            ++step;
            if (IN(step)) { PROBE_T0(4) if constexpr (PHON(4)) { PF(F); PHV; step_gnorm(F, mb); } PROBE_T1(4) SEAM(step); }
            ++step;
            if (IN(step)) { PROBE_T0(5) if constexpr (PHON(5)) { PF(F); PHV; pg8::StaticOrder S; S.init(nr, D, F.G, F.bid); bf16_t* H = ws_bf(F, WS_H); bf16_t* MGb = ws_bf(F, WS_XB);
#ifndef MERGE_MASK
#define MERGE_MASK 7
#endif
                if constexpr (MERGE_MASK & 1) { pg8::Gemm g{H + C_Z, wl_ptr(F, layer, WL_SSD), nr, D, DINNER, DINP, nullptr}; pg8::EpiGate<0> E{H + C_GSSD, MGb}; pg8::gemm_phase(F.lds, g, S, E, F.wave); }
                if constexpr (MERGE_MASK & 2) { pg8::Gemm g{H + C_Q, wl_ptr(F, layer, WL_ATT), nr, D, D, DINP, nullptr}; pg8::EpiGate<1> E{H + C_GATT, MGb}; pg8::gemm_phase(F.lds, g, S, E, F.wave); }
                if constexpr (MERGE_MASK & 4) { pg8::Gemm g{H + C_SCB, wl_ptr(F, layer, WL_SC), nr, D, D, DINP, nullptr}; pg8::EpiGate<1> E{H + C_GSC, MGb}; pg8::gemm_phase(F.lds, g, S, E, F.wave); } }
                PROBE_T1(5) SEAM(step); }
            ++step;
            if (IN(step)) { PROBE_T0(6) if constexpr (PHON(6)) { PF(F); PHV; pg8::Gemm g{ws_bf(F, WS_XB), wl_ptr(F, layer, WL_O), nr, D, D, D, nullptr}; pg8::StaticOrder S; S.init(nr, D, F.G, F.bid);
                pg8::EpiResid E{layer == 0 ? F.in[I_XP] + (size_t)mb * NP * D : F.out + O_YP + (size_t)mb * NP * D, layer == 0 ? F.in[I_XS] : F.out + O_YS, F.out + O_YP + (size_t)mb * NP * D, F.out + O_YS};
                pg8::gemm_phase(F.lds, g, S, E, F.wave); } PROBE_T1(6) SEAM(step); }
            ++step;
            if (IN(step)) { PROBE_T0(7) if constexpr (PHON(7)) { PF(F); PHV; step_ln1_router(F, layer, mb); } PROBE_T1(7) SEAM(step); }
            ++step;
            if (IN(step)) { PROBE_T0(8) if constexpr (PHON(8)) { PF(F); PHV; step_gather(F, layer, mb); } PROBE_T1(8) SEAM(step); }
            ++step;
            if (IN(step)) { PROBE_T0(9) if constexpr (PHON(9)) { PF(F); PHV; const int nt = moe_table(F, layer, mb); pg8::MoeOrder S{(const LAS int*)(F.lds + MISC_OFF) + 16, 8, nt * 8, F.G, F.bid};
                pg8::Gemm g{ws_bf(F, WS_XB), wl_ptr(F, layer, WL_UP), nr  , 2048, D, D, (const int*)(F.ws + WS_RTOK)}; pg8::EpiSwiglu E{ws_bf(F, WS_H) + (size_t)RP * D, F.in[I_BUP] + (size_t)layer * NEXP * 2048};
                pg8::gemm_phase<pg8::EpiSwiglu, pg8::MoeOrder, true>(F.lds, g, S, E, F.wave); } PROBE_T1(9) SEAM(step); }
            ++step;
            if (IN(step)) { PROBE_T0(10) if constexpr (PHON(10)) { PF(F); PHV; const int nt = moe_table(F, layer, mb); pg8::MoeOrder S{(const LAS int*)(F.lds + MISC_OFF) + 16, 4, nt * 4, F.G, F.bid};
                pg8::Gemm g{ws_bf(F, WS_H) + (size_t)RP * D, wl_ptr(F, layer, WL_DN), nt * 256, D, D, D, nullptr}; pg8::EpiDown E{ws_bf(F, WS_H) + (size_t)2 * RP * D, F.in[I_BDN] + (size_t)layer * NEXP * D, ws_f(F, WS_GSORT)};
                pg8::gemm_phase(F.lds, g, S, E, F.wave); } PROBE_T1(10) SEAM(step); }
            ++step;
            if (IN(step)) { PROBE_T0(11) if constexpr (PHON(11)) { PF(F); PHV; step_ln2(F, layer, mb); } PROBE_T1(11) SEAM(step); }
            ++step;
        }
}

#ifdef EMU
extern int emu_grid, emu_step_lo, emu_step_hi;
#endif
extern "C" void kernel_launch(void* const* d_in, const int* in_sizes, int n_in, void* d_out, int out_size, void* d_ws, size_t ws_size, hipStream_t stream) {
    (void)in_sizes; (void)out_size;
    if (n_in != 31 || ws_size < WS_END) { fprintf(stderr, "kernel_launch: expected 31 inputs and >= %zu bytes of workspace (got %d, %zu)\n", (size_t)WS_END, n_in, ws_size); return; }
    Args a; memset(&a, 0, sizeof(a));
    for (int i = 0; i < 31; ++i) a.in[i] = (const float*)d_in[i];
    a.out = (float*)d_out; a.ws = (unsigned char*)d_ws;
#ifdef EMU
    if (emu_step_lo == 0) memset((char*)d_ws + WS_CTL, 0, CTL_BYTES);
    for (int s = emu_step_lo; s < emu_step_hi && s < NSTEPS; ++s) { a.lo = s; a.hi = s + 1; emu_launch(fwd, emu_grid, NTHREADS, LDS_BYTES, a); fprintf(stderr, "step %d done\n", s); }
#else
    (void)hipMemsetAsync((char*)d_ws + WS_CTL, 0, CTL_BYTES, stream);
    static int grid = 0;
    if (grid == 0) {
        int dev = 0, cus = 0;
        if (hipGetDevice(&dev) != hipSuccess || hipDeviceGetAttribute(&cus, hipDeviceAttributeMultiprocessorCount, dev) != hipSuccess) { grid = -1; return; }
        if (hipFuncSetAttribute((const void*)fwd, hipFuncAttributeMaxDynamicSharedMemorySize, LDS_BYTES) != hipSuccess) { grid = -1; return; }
        int per_cu = 0; (void)hipOccupancyMaxActiveBlocksPerMultiprocessor(&per_cu, (const void*)fwd, NTHREADS, LDS_BYTES); (void)hipGetLastError();
        grid = cus / 64 * 64;
        if (grid < 64) { grid = -1; return; }
    }
    if (grid < 0) return;
#if CFG_ONE_LAUNCH
    a.lo = 0; a.hi = NSTEPS; hipLaunchKernelGGL(fwd, dim3(grid), dim3(NTHREADS), LDS_BYTES, stream, a);
#else
    for (int s = 0; s < NSTEPS; ++s) { a.lo = s; a.hi = s + 1; hipLaunchKernelGGL(fwd, dim3(grid), dim3(NTHREADS), LDS_BYTES, stream, a); }
#endif
#endif
}
```

```cpp
#ifdef EMU
#include "emu.h"
#else
#include <hip/hip_runtime.h>
#endif
#include <cstdio>
#include <cstdint>
#include <cstring>
#include <cstddef>
#include <cmath>

#ifndef CFG_BATCH
#define CFG_BATCH 16
#endif
#ifndef CFG_SEQ
#define CFG_SEQ 4096
#endif
#ifndef CFG_NSEQ_MB
#define CFG_NSEQ_MB 8
#endif
#ifndef CFG_NEXP
#define CFG_NEXP 32
#endif
#ifndef CFG_ONE_LAUNCH
#define CFG_ONE_LAUNCH 1
#endif

constexpr int BATCH = CFG_BATCH, SEQ = CFG_SEQ, NSEQ_MB = CFG_NSEQ_MB, NEXP = CFG_NEXP, NMB = BATCH / NSEQ_MB;
constexpr int D = 1024, DEPTH = 2, DECB = 16, DECS = 16, NS = DECB * DECS;
constexpr int DINNER = 2048, CONVDIM = 4096;
constexpr int NKV = 4, WINDOW = 128, CHUNK = 64;
constexpr int DIN = 13856, DINP = 14080;
constexpr int NP = NSEQ_MB * SEQ, R = NP + NS;
constexpr int RP = ((4 * R + NEXP * 255) + 255) / 256 * 256;
constexpr int NCHUNK = SEQ / CHUNK;
constexpr int C_Z = 0, C_X = 2048, C_B = 4096, C_C = 5120, C_Q = 6144, C_K = 7168, C_V = 7424, C_SCB = 7680, C_SCC = 8704, C_SCH = 9728, C_GSSD = 10752, C_GATT = 11776, C_GSC = 12800, C_DT = 13824;
constexpr float LN_EPS = 1e-5f, ALPHA = 1.41421356237309515f  , SW_LIMIT = 7.0f, SW_ALPHA = 1.702f;
static_assert(BATCH % NSEQ_MB == 0 && SEQ % 256 == 0 && (NEXP & (NEXP - 1)) == 0 && NEXP <= 32 && NEXP >= 4, "config");

constexpr size_t O_YP = 0, O_YS = O_YP + (size_t)BATCH * SEQ * D, O_KP = O_YS + (size_t)NS * D, O_VP = O_KP + (size_t)DEPTH * BATCH * WINDOW * 256,
    O_SSP = O_VP + (size_t)DEPTH * BATCH * WINDOW * 256, O_CVP = O_SSP + (size_t)DEPTH * BATCH * 32 * 64 * 128, O_SCP = O_CVP + (size_t)DEPTH * BATCH * 3 * CONVDIM,
    O_KS = O_SCP + (size_t)DEPTH * BATCH * 2 * D, O_VS = O_KS + (size_t)DEPTH * DECB * DECS * 256, O_SSS = O_VS + (size_t)DEPTH * DECB * DECS * 256,
    O_CVS = O_SSS + (size_t)DEPTH * DECB * 32 * 64 * 128, O_SCS = O_CVS + (size_t)DEPTH * DECB * 3 * CONVDIM, O_END = O_SCS + (size_t)DEPTH * DECB * 2 * D;

constexpr size_t al256(size_t x) { return (x + 255) / 256 * 256; }
constexpr size_t WS_CTL = 0, CTL_BYTES = 1u << 20;
constexpr size_t WS_SSQ = CTL_BYTES, WS_TOPI = WS_SSQ + al256((size_t)R * 64 * 4), WS_GATE = WS_TOPI + al256((size_t)R * 16), WS_POS = WS_GATE + al256((size_t)R * 16),
    WS_GSORT = WS_POS + al256((size_t)R * 16), WS_RTOK = WS_GSORT + al256((size_t)RP * 4), WS_W = WS_RTOK + al256((size_t)RP * 4);
constexpr size_t WL_IN = 0, WL_SSD = WL_IN + (size_t)DINP * D * 2, WL_ATT = WL_SSD + (size_t)D * DINNER * 2, WL_SC = WL_ATT + (size_t)D * D * 2, WL_O = WL_SC + (size_t)D * D * 2,
    WL_UP = WL_O + (size_t)D * D * 2, WL_DN = WL_UP + (size_t)NEXP * 2048 * D * 2, WL_BYTES = WL_DN + (size_t)NEXP * D * D * 2;
constexpr size_t WS_XB = WS_W + DEPTH * WL_BYTES, WS_XB0 = WS_XB + (size_t)R * D * 2  , WS_PRE = WS_XB0 + (size_t)NMB * R * D * 2  , WS_H = WS_PRE + (size_t)R * D * 2;
constexpr size_t H_BYTES = (size_t)R * DINP * 2, MOE_BYTES = (size_t)3 * RP * D * 2, U_BYTES = H_BYTES > MOE_BYTES ? H_BYTES : MOE_BYTES;
constexpr size_t WS_CMC = WS_H + U_BYTES, WS_BTG = WS_CMC + (size_t)NP * 1024 * 2, WS_CBG = WS_BTG + (size_t)NSEQ_MB * NCHUNK * 8 * 8192 * 2, WS_END = WS_CBG + (size_t)NSEQ_MB * NCHUNK * 8 * 4096 * 2;
static_assert(WS_END <= ((size_t)2 << 30), "workspace map exceeds 2 GiB");
constexpr int CW_BAR = 4096, CW_CNT = 16384;

constexpr int RING_BYTES = 131072, LDS_BYTES = 163840  , MISC_OFF = LDS_BYTES - 1024, SCR_BYTES = MISC_OFF;
constexpr int NWAVES = 8, NTHREADS = 512;

#ifdef EMU
#define LAS
#define WAVE_SYNC() emu_wave_barrier()
#else
#define LAS __attribute__((address_space(3)))
#define WAVE_SYNC() asm volatile("s_waitcnt lgkmcnt(0)" ::: "memory")
#endif
#ifdef EMU
#define LBAR() emu_wg_barrier()
#define VM_WAIT(n) do { } while (0)
#else
#define LBAR() do { asm volatile("s_waitcnt lgkmcnt(0)" ::: "memory"); __builtin_amdgcn_s_barrier(); asm volatile("" ::: "memory"); } while (0)
#define VM_WAIT(n) asm volatile("s_waitcnt vmcnt(" #n ")" ::: "memory")
#endif
typedef unsigned short bf16_t;
typedef short bf16x8 __attribute__((ext_vector_type(8)));
typedef float f32x4 __attribute__((ext_vector_type(4)));
typedef float f32x16 __attribute__((ext_vector_type(16)));
typedef unsigned u32x4 __attribute__((ext_vector_type(4)));
typedef unsigned u32x2 __attribute__((ext_vector_type(2)));

__device__ __forceinline__ unsigned f2bf(float f) { unsigned u = __builtin_bit_cast(unsigned, f); return (u + 0x7fffu + ((u >> 16) & 1u)) >> 16; }
__device__ __forceinline__ float bf2f(unsigned h) { return __builtin_bit_cast(float, (h & 0xffffu) << 16); }
#ifdef EMU
__device__ __forceinline__ unsigned pk2(float lo, float hi) { return f2bf(lo) | (f2bf(hi) << 16); }
#else
typedef float f32x2_t __attribute__((ext_vector_type(2))); typedef __bf16 bf16x2_t __attribute__((ext_vector_type(2)));
__device__ __forceinline__ unsigned pk2(float lo, float hi) { f32x2_t v = {lo, hi}; bf16x2_t b = __builtin_convertvector(v, bf16x2_t); return __builtin_bit_cast(unsigned, b); }
#endif
#ifdef EMU
__device__ __forceinline__ unsigned short bf1(float f) { return (unsigned short)f2bf(f); }
#else
__device__ __forceinline__ unsigned short bf1(float f) { return (unsigned short)pk2(f, f); }
#endif
__device__ __forceinline__ float blo(unsigned w) { return __builtin_bit_cast(float, w << 16); }
__device__ __forceinline__ float bhi(unsigned w) { return __builtin_bit_cast(float, w & 0xffff0000u); }
__device__ __forceinline__ void unpack8(const u32x4 w, float* f) { f[0] = blo(w.x); f[1] = bhi(w.x); f[2] = blo(w.y); f[3] = bhi(w.y); f[4] = blo(w.z); f[5] = bhi(w.z); f[6] = blo(w.w); f[7] = bhi(w.w); }
__device__ __forceinline__ u32x4 pack8(const float* f) { u32x4 w; w.x = pk2(f[0], f[1]); w.y = pk2(f[2], f[3]); w.z = pk2(f[4], f[5]); w.w = pk2(f[6], f[7]); return w; }
__device__ __forceinline__ float fexp(float x) { return __builtin_amdgcn_exp2f(x * 1.4426950408889634f); }
__device__ __forceinline__ float fsigmoid(float x) { return __builtin_amdgcn_rcpf(1.0f + __builtin_amdgcn_exp2f(-1.4426950408889634f * x)); }
__device__ __forceinline__ float fsilu(float x) { return x * fsigmoid(x); }
#ifdef EMU
__device__ __forceinline__ int opq(int x) { return x; }
#else
__device__ __forceinline__ int opq(int x) { asm volatile("" : "+v"(x)); return x; }
#endif
#ifdef EMU
__device__ __forceinline__ int opqs(int x) { return x; }
#else
__device__ __forceinline__ int opqs(int x) { asm volatile("" : "+s"(x)); return x; }
#endif
#ifdef EMU
__device__ __forceinline__ int lane_id() { return (int)(threadIdx.x & 63); }
#else
__device__ __forceinline__ int lane_id() { return (int)__builtin_amdgcn_mbcnt_hi(~0u, __builtin_amdgcn_mbcnt_lo(~0u, 0u)); }
#endif
#ifdef EMU
template <int MASK> __device__ __forceinline__ unsigned xshfl_u(unsigned x) { return __shfl_xor(x, MASK); }
#else
template <int MASK> __device__ __forceinline__ unsigned xshfl_u(unsigned x) {
    if constexpr (MASK == 1) return (unsigned)__builtin_amdgcn_update_dpp((int)x, (int)x, 0xB1, 0xF, 0xF, false);
    else if constexpr (MASK == 2) return (unsigned)__builtin_amdgcn_update_dpp((int)x, (int)x, 0x4E, 0xF, 0xF, false);
    else if constexpr (MASK == 4) { const int t = __builtin_amdgcn_update_dpp((int)x, (int)x, 0x114, 0xF, 0xA, false);
        return (unsigned)__builtin_amdgcn_update_dpp(t, (int)x, 0x104, 0xF, 0x5, false); }
    else if constexpr (MASK == 8) return (unsigned)__builtin_amdgcn_update_dpp((int)x, (int)x, 0x128, 0xF, 0xF, false);
    else if constexpr (MASK == 16) { const auto rr = __builtin_amdgcn_permlane16_swap(x, x, false, false); return (lane_id() & 16) ? rr[0] : rr[1]; }
    else { const auto rr = __builtin_amdgcn_permlane32_swap(x, x, false, false); return (lane_id() & 32) ? rr[0] : rr[1]; }
}
#endif
template <int MASK> __device__ __forceinline__ float xshfl(float x) { return __builtin_bit_cast(float, xshfl_u<MASK>(__builtin_bit_cast(unsigned, x))); }
template <int MASK> __device__ __forceinline__ int xshfl(int x) { return (int)xshfl_u<MASK>((unsigned)x); }
__device__ __forceinline__ float wave_sum(float v) { v += xshfl<1>(v); v += xshfl<2>(v); v += xshfl<4>(v); v += xshfl<8>(v); v += xshfl<16>(v); v += xshfl<32>(v); return v; }

#ifndef PROBE_MASK
#define PROBE_MASK 0
#endif
#if PROBE_MASK && !defined(EMU)
#define PROBE_T0(b) unsigned long long pt0_ = 0; if constexpr ((PROBE_MASK >> (b)) & 1) pt0_ = __builtin_amdgcn_s_memrealtime();
#define PROBE_T1(b) if constexpr ((PROBE_MASK >> (b)) & 1) { asm volatile("s_waitcnt vmcnt(0) lgkmcnt(0)" ::: "memory"); const unsigned long long pt1_ = __builtin_amdgcn_s_memrealtime(); \
    while (__builtin_amdgcn_s_memrealtime() < pt1_ + (pt1_ - pt0_)) __builtin_amdgcn_s_sleep(8); }
#else
#define PROBE_T0(b)
#define PROBE_T1(b)
#endif
namespace pg8 {
constexpr int BM = 256, BK = 64, HALF = 128, HTB = HALF * BK * 2, NXCD = 8, WGM = 8;
struct Unit { int pm, pn, bt, e; };
struct Gemm { const bf16_t* A; const bf16_t* Bt; int M, N, K, lda; const int* tok; };
struct StaticOrder {
    int nM, nN, nwg, G, c, wgm;
    __host__ __device__ void init(int M, int N, int G_, int c_, int wgm_ = WGM) { nM = M / BM; nN = N / BM; nwg = nM * nN; G = G_; c = c_; wgm = wgm_; }
    __host__ __device__ bool next(int i, Unit& u) const {
        const long L = (long)i * G + c; if (L >= nwg) return false;
        int wgid = (int)L; { const int q = nwg / NXCD, r = nwg % NXCD, xcd = wgid % NXCD, off = wgid / NXCD; wgid = (xcd < r ? xcd * (q + 1) : r * (q + 1) + (xcd - r) * q) + off; }
        const int nig = wgm * nN, gid = wgid / nig, fm = gid * wgm, gsz = (nM - fm) < wgm ? (nM - fm) : wgm;
        u.pm = fm + ((wgid % nig) % gsz); u.pn = (wgid % nig) / gsz; u.bt = u.pn; u.e = 0; return true;
    }
    __device__ __forceinline__ void a_ready(const Unit&) const {}
    __device__ __forceinline__ void done(const Unit&) const {}
};
struct MoeOrder {
    const LAS int* tend; int npn, ntot, G, c;
    __device__ __forceinline__ bool next(int i, Unit& u) const {
        int rt, pn;
        {
            const int xcd = c & 7, j = c >> 3, rpx = (G >> 3) / npn; rt = (i * 8 + xcd) * rpx + j / npn; pn = j % npn; if (rt >= ntot / npn) return false; }
        int e = 0;
#pragma unroll
        for (int j = 0; j < NEXP; ++j) e += (tend[j] <= rt) ? 1 : 0;
        u.pm = rt; u.pn = pn; u.e = e; u.bt = e * npn + pn; return true;
    }
    __device__ __forceinline__ void a_ready(const Unit&) const {}
    __device__ __forceinline__ void done(const Unit&) const {}
};
#ifdef EMU
template <class Epi, class Sched, bool GATHER = false>
__device__ void gemm_phase(LAS unsigned char* lds, const Gemm g, const Sched& S, const Epi& E, int  ) {
    const int tid = threadIdx.x, wid = tid >> 6, lane = tid & 63, wr = wid >> 2, wc = wid & 3, fr = lane & 15, fq = lane >> 4;
    Unit u;
    for (int i = 0; S.next(i, u); ++i) {
        f32x4 acc[2][2][4][2];
        for (int ai = 0; ai < 2; ++ai) for (int bj = 0; bj < 2; ++bj) for (int m = 0; m < 4; ++m) for (int n = 0; n < 2; ++n) for (int q = 0; q < 4; ++q) {
            const int row = u.pm * 256 + ai * 128 + wr * 64 + m * 16 + fr, col = u.bt * 256 + bj * 128 + wc * 32 + 8 * fq + 4 * n + q;
            const bf16_t* a = g.A + (size_t)(GATHER ? ((unsigned)g.tok[row] < (unsigned)g.M ? g.tok[row] : 0) : row) * g.lda; const bf16_t* b = g.Bt + (size_t)col * g.K; float s = 0.f;
            for (int k = 0; k < g.K; ++k) s += bf2f(a[k]) * bf2f(b[k]);
            acc[ai][bj][m][n][q] = s; }
        E(acc, u, wr, wc, fr, fq);
    }
    __syncthreads();
}
#else
#define PG8_LAS __attribute__((address_space(3)))
__host__ __device__ __forceinline__ int lds_byte(int r, int c) { const int st = (r >> 4) * 2 + (c >> 5), rr = r & 15, cc = c & 31, ob = rr * 64 + cc * 2; return st * 1024 + (ob ^ (((ob >> 9) & 1) << 5)); }
__host__ __device__ __forceinline__ void stage_rc(int b, int& R_, int& C_) { const int st = b / 1024, sb = b % 1024, swz = sb ^ (((sb >> 9) & 1) << 5); R_ = (st >> 1) * 16 + swz / 64; C_ = (st & 1) * 32 + (swz % 64) / 2; }
__host__ __device__ __forceinline__ int perm32(int rho) { const int n = rho >> 4, i = rho & 15; return 8 * (i >> 2) + 4 * n + (i & 3); }
template <class Epi, class Sched, bool GATHER = false>
__device__ __forceinline__ void gemm_phase(PG8_LAS unsigned char* lds, const Gemm g, const Sched& S, const Epi& E, int wave_id) {
    const int lane = opq(lane_id()), wid = __builtin_amdgcn_readfirstlane(wave_id), tid = wid * 64 + lane, wr = wid >> 2, wc = wid & 3, fr = lane & 15, fq = lane >> 4;
    const int K = g.K, nt = K / BK, lda = g.lda;
    unsigned voffA[2], voffB[2];
#pragma unroll
    for (int i = 0; i < 2; ++i) { int R_, C_; stage_rc(tid * 16 + i * 8192, R_, C_); const int Rb = (R_ & ~31) + perm32(R_ & 31);
        voffA[i] = (unsigned)(R_ * lda + C_) * 2u; voffB[i] = (unsigned)(Rb * K + C_) * 2u; }
    unsigned vG[2][2], vN[2][2];
#define PG8_TOK(dst, pm_) do { _Pragma("unroll") for (int i_ = 0; i_ < 2; ++i_) { int R_, C_; stage_rc(opq(tid) * 16 + i_ * 8192, R_, C_); _Pragma("unroll") for (int h_ = 0; h_ < 2; ++h_) \
        { unsigned tk_ = (unsigned)g.tok[(pm_) * 256 + h_ * 128 + R_]; tk_ = tk_ < (unsigned)g.M ? tk_ : 0u; dst[h_][i_] = tk_ * (unsigned)(lda * 2) + (unsigned)(C_ * 2); } } } while (0)
#define PG8_STAGE_A(bufoff, base_, h_, nx_) do { if constexpr (GATHER) { unsigned vs_[2] = {(nx_) ? vN[h_][0] : vG[h_][0], (nx_) ? vN[h_][1] : vG[h_][1]}; PG8_STAGE(bufoff, base_, vs_); } \
        else { PG8_STAGE(bufoff, (base_) + ((h_) ? hstepA : 0), voffA); } } while (0)
    const size_t kstep = (size_t)(BK * 2);
    const size_t hstepA = (size_t)HALF * lda * 2, tstepA = 2 * hstepA;
    const size_t hstepB = (size_t)HALF * K * 2, tstepB = 2 * hstepB;
    const unsigned ldsw = (unsigned)wid * 1024u;
    const int aoff = lds_byte(wr * 64 + fr, fq * 8), boff = lds_byte(wc * 32 + fr, fq * 8);
#define PG8_SA(b, h) (((b) * 2 + (h)) * HTB)
#define PG8_SB(b, h) ((4 + (b) * 2 + (h)) * HTB)
#define PG8_STAGE(bufoff, gbase, voff) do { _Pragma("unroll") for (int _i = 0; _i < 2; ++_i) \
        __builtin_amdgcn_global_load_lds((const unsigned*)((const char*)(gbase) + (voff)[_i]), (PG8_LAS unsigned*)(lds + (bufoff) + ldsw + _i * 8192), 16, 0, 0); } while (0)
#define PG8_LDA(dst, b, h) do { _Pragma("unroll") for (int m = 0; m < 4; ++m) _Pragma("unroll") for (int k = 0; k < 2; ++k) dst[m][k] = *(const PG8_LAS bf16x8*)(lds + PG8_SA(b, h) + aoff + m * 2048 + k * 1024); } while (0)
#define PG8_LDB(dst, b, h) do { _Pragma("unroll") for (int n = 0; n < 2; ++n) _Pragma("unroll") for (int k = 0; k < 2; ++k) dst[n][k] = *(const PG8_LAS bf16x8*)(lds + PG8_SB(b, h) + boff + n * 2048 + k * 1024); } while (0)
#define PG8_MMA(ai, bj, At, Bt) do { __builtin_amdgcn_s_setprio(1); _Pragma("unroll") for (int m = 0; m < 4; ++m) _Pragma("unroll") for (int n = 0; n < 2; ++n) _Pragma("unroll") for (int k = 0; k < 2; ++k) \
        acc[ai][bj][m][n] = __builtin_amdgcn_mfma_f32_16x16x32_bf16(Bt[n][k], At[m][k], acc[ai][bj][m][n], 0, 0, 0); __builtin_amdgcn_s_setprio(0); } while (0)
#define PG8_WAIT_V(n) asm volatile("s_waitcnt vmcnt(" #n ")" ::: "memory")
#define PG8_WAIT_L(n) asm volatile("s_waitcnt lgkmcnt(" #n ")" ::: "memory")
#define PG8_BAR __builtin_amdgcn_s_barrier()
#define PG8_SCHED __builtin_amdgcn_sched_barrier(0)
    Unit cur, nxt; int ui = 0;
    if (!S.next(0, cur)) return;
    f32x4 acc[2][2][4][2];
#pragma unroll
    for (int a = 0; a < 2; ++a)
#pragma unroll
        for (int b = 0; b < 2; ++b)
#pragma unroll
            for (int m = 0; m < 4; ++m)
#pragma unroll
                for (int n = 0; n < 2; ++n) acc[a][b][m][n] = (f32x4){0.f, 0.f, 0.f, 0.f};
    bf16x8 At[4][2], B0[2][2], B1[2][2];
    const char* cA = (const char*)g.A + (GATHER ? (size_t)0 : (size_t)cur.pm * tstepA); const char* cB = (const char*)g.Bt + (size_t)cur.bt * tstepB;
    if constexpr (GATHER) { PG8_TOK(vG, cur.pm); }
    S.a_ready(cur);
    PG8_STAGE(PG8_SB(0, 0), cB, voffB); PG8_STAGE(PG8_SB(0, 1), cB + hstepB, voffB); PG8_STAGE_A(PG8_SA(0, 0), cA, 0, false); PG8_STAGE_A(PG8_SA(0, 1), cA, 1, false);
    if (wr == 1) PG8_BAR;
    PG8_WAIT_V(2); PG8_BAR;
    PG8_STAGE(PG8_SB(1, 0), cB + kstep, voffB); PG8_STAGE_A(PG8_SA(1, 0), cA + kstep, 0, false); PG8_STAGE(PG8_SB(1, 1), cB + hstepB + kstep, voffB);
    PG8_WAIT_V(6); PG8_BAR;
    for (;;) {
        const bool has_next = S.next(ui + 1, nxt);
        const char* nA = has_next ? (const char*)g.A + (GATHER ? (size_t)0 : (size_t)nxt.pm * tstepA) : cA; const char* nB = has_next ? (const char*)g.Bt + (size_t)nxt.bt * tstepB : cB;
        if constexpr (GATHER) {
#pragma unroll
            for (int h_ = 0; h_ < 2; ++h_) { vN[h_][0] = vG[h_][0]; vN[h_][1] = vG[h_][1]; }
            if (has_next) {
#pragma unroll
                for (int i_ = 0; i_ < 2; ++i_) { int R_, C_; stage_rc(opq(tid) * 16 + i_ * 8192, R_, C_);
#pragma unroll
                    for (int h_ = 0; h_ < 2; ++h_) { const int* tp_ = g.tok + nxt.pm * 256 + h_ * 128 + R_;
                        asm volatile("global_load_dword %0, %1, off" : "=v"(vN[h_][i_]) : "v"(tp_) : "memory"); } } } }
        for (int t = 0; t < nt; t += 2) {
            const bool last = (t == nt - 2);
            const char* a1 = cA + (size_t)(t + 1) * kstep;
            const char* a2 = last ? nA : cA + (size_t)(t + 2) * kstep; const char* b2 = last ? nB : cB + (size_t)(t + 2) * kstep;
            const char* a3 = a2 + kstep; const char* b3 = b2 + kstep;
            if (last && has_next) S.a_ready(nxt);
            if constexpr (GATHER) { if (last && has_next) {
#pragma unroll
                for (int i_ = 0; i_ < 2; ++i_) { int R_, C_; stage_rc(opq(tid) * 16 + i_ * 8192, R_, C_);
#pragma unroll
                    for (int h_ = 0; h_ < 2; ++h_) { unsigned tk_ = vN[h_][i_]; asm volatile("" : "+v"(tk_)); tk_ = tk_ < (unsigned)g.M ? tk_ : 0u; vN[h_][i_] = tk_ * (unsigned)(lda * 2) + (unsigned)(C_ * 2); } } } }
            PG8_LDB(B0, 0, 0); PG8_LDB(B1, 0, 1); PG8_SCHED; PG8_LDA(At, 0, 0); PG8_STAGE_A(PG8_SA(1, 1), a1, 1, false);
            PG8_WAIT_V(8); PG8_WAIT_L(0); PG8_BAR; PG8_MMA(0, 0, At, B0); PG8_MMA(0, 1, At, B1); PG8_BAR; PG8_SCHED;
            PG8_LDA(At, 0, 1); PG8_STAGE(PG8_SB(0, 0), b2, voffB); PG8_STAGE(PG8_SB(0, 1), b2 + hstepB, voffB); PG8_STAGE_A(PG8_SA(0, 0), a2, 0, last);
            PG8_WAIT_V(8); PG8_WAIT_L(0); PG8_BAR; PG8_MMA(1, 0, At, B0); PG8_MMA(1, 1, At, B1); PG8_BAR; PG8_SCHED;
            PG8_LDB(B0, 1, 0); PG8_LDB(B1, 1, 1); PG8_SCHED; PG8_LDA(At, 1, 0); PG8_STAGE_A(PG8_SA(0, 1), a2, 1, last);
            PG8_WAIT_V(8); PG8_WAIT_L(0); PG8_BAR; PG8_MMA(0, 0, At, B0); PG8_MMA(0, 1, At, B1); PG8_BAR; PG8_SCHED;
            PG8_LDA(At, 1, 1); PG8_STAGE(PG8_SB(1, 0), b3, voffB); PG8_STAGE(PG8_SB(1, 1), b3 + hstepB, voffB); PG8_STAGE_A(PG8_SA(1, 0), a3, 0, last);
            PG8_WAIT_V(8); PG8_WAIT_L(0); PG8_BAR; PG8_MMA(1, 0, At, B0); PG8_MMA(1, 1, At, B1); PG8_BAR; PG8_SCHED;
        }
        if (wr == 0) PG8_BAR;
        E(acc, cur, wr, wc, fr, fq); S.done(cur);
        if (!has_next) break;
#pragma unroll
        for (int a = 0; a < 2; ++a)
#pragma unroll
            for (int b = 0; b < 2; ++b)
#pragma unroll
                for (int m = 0; m < 4; ++m)
#pragma unroll
                    for (int n = 0; n < 2; ++n) acc[a][b][m][n] = (f32x4){0.f, 0.f, 0.f, 0.f};
        cur = nxt; cA = nA; cB = nB; ++ui;
        if constexpr (GATHER) {
#pragma unroll
            for (int h_ = 0; h_ < 2; ++h_) { vG[h_][0] = vN[h_][0]; vG[h_][1] = vN[h_][1]; } }
        if (wr == 1) PG8_BAR;
    }
    PG8_WAIT_V(0);
    PG8_BAR;
#undef PG8_SA
#undef PG8_SB
#undef PG8_STAGE
#undef PG8_STAGE_A
#undef PG8_TOK
#undef PG8_LDA
#undef PG8_LDB
#undef PG8_MMA
#undef PG8_WAIT_V
#undef PG8_WAIT_L
#undef PG8_BAR
#undef PG8_SCHED
}
#endif

struct EpiStoreBf16 {
    bf16_t* O; int ldc;
    __device__ __forceinline__ void operator()(const f32x4 (&acc)[2][2][4][2], const Unit& u, int wr, int wc, int fr, int fq) const {
        const int row0 = u.pm * 256 + wr * 64 + fr, col0 = u.pn * 256 + wc * 32 + 8 * fq;
#pragma unroll
        for (int ai = 0; ai < 2; ++ai)
#pragma unroll
            for (int m = 0; m < 4; ++m)
#pragma unroll
                for (int bj = 0; bj < 2; ++bj) { const f32x4 v0 = acc[ai][bj][m][0], v1 = acc[ai][bj][m][1];
                    u32x4 w; w.x = pk2(v0[0], v0[1]); w.y = pk2(v0[2], v0[3]); w.z = pk2(v1[0], v1[1]); w.w = pk2(v1[2], v1[3]);
                    *(u32x4*)(O + (size_t)(row0 + ai * 128 + m * 16) * ldc + col0 + bj * 128) = w; }
    }
};
template <int MODE> struct EpiGate {
    const bf16_t* Hg; bf16_t* MGb;
    __device__ __forceinline__ void operator()(const f32x4 (&acc)[2][2][4][2], const Unit& u, int wr, int wc, int fr, int fq) const {
        const int row0 = u.pm * 256 + wr * 64 + fr, col0 = u.pn * 256 + wc * 32 + 8 * fq;
#pragma unroll
        for (int ai = 0; ai < 2; ++ai) {
            u32x4 gw[4][2], pw[4][2];
#pragma unroll
            for (int m = 0; m < 4; ++m)
#pragma unroll
                for (int bj = 0; bj < 2; ++bj) { const int row = row0 + ai * 128 + m * 16, col = col0 + bj * 128;
                    gw[m][bj] = *(const u32x4*)(Hg + (size_t)row * DINP + col); if (MODE != 0) pw[m][bj] = *(const u32x4*)(MGb + (size_t)row * D + col); }
            asm volatile("" ::: "memory");
#pragma unroll
            for (int m = 0; m < 4; ++m)
#pragma unroll
                for (int bj = 0; bj < 2; ++bj) { const int row = row0 + ai * 128 + m * 16, col = col0 + bj * 128; const f32x4 v0 = acc[ai][bj][m][0], v1 = acc[ai][bj][m][1];
                    float g[8], p[8], v[8] = {v0[0], v0[1], v0[2], v0[3], v1[0], v1[1], v1[2], v1[3]}; unpack8(gw[m][bj], g);
                    if (MODE != 0) { unpack8(pw[m][bj], p);
#pragma unroll
                        for (int i = 0; i < 8; ++i) v[i] = p[i] + v[i] * fsigmoid(g[i]); }
                    else {
#pragma unroll
                        for (int i = 0; i < 8; ++i) v[i] = v[i] * fsigmoid(g[i]); }
                    *(u32x4*)(MGb + (size_t)row * D + col) = pack8(v); }
            asm volatile("" ::: "memory");
        }
    }
};
struct EpiResid {
    const float* xp; const float* xs; float* op; float* os;
    __device__ __forceinline__ void operator()(const f32x4 (&acc)[2][2][4][2], const Unit& u, int wr, int wc, int fr, int fq) const {
        const int row0 = u.pm * 256 + wr * 64 + fr, col0 = u.pn * 256 + wc * 32 + 8 * fq;
        const bool smp = u.pm * 256 >= NP;
        const float* xb = smp ? xs - (size_t)NP * D : xp; float* ob = smp ? os - (size_t)NP * D : op;
#pragma unroll
        for (int ai = 0; ai < 2; ++ai) {
            f32x4 xa[4][2][2];
#pragma unroll
            for (int m = 0; m < 4; ++m)
#pragma unroll
                for (int bj = 0; bj < 2; ++bj) { const float* xi = xb + (size_t)(row0 + ai * 128 + m * 16) * D + col0 + bj * 128; xa[m][bj][0] = *(const f32x4*)xi; xa[m][bj][1] = *(const f32x4*)(xi + 4); }
            asm volatile("" ::: "memory");
#pragma unroll
            for (int m = 0; m < 4; ++m)
#pragma unroll
                for (int bj = 0; bj < 2; ++bj) { float* xo = ob + (size_t)(row0 + ai * 128 + m * 16) * D + col0 + bj * 128;
                    *(f32x4*)xo = xa[m][bj][0] * ALPHA + acc[ai][bj][m][0]; *(f32x4*)(xo + 4) = xa[m][bj][1] * ALPHA + acc[ai][bj][m][1]; }
            asm volatile("" ::: "memory");
        }
    }
};
struct EpiSwiglu {
    bf16_t* ACT; const float* bup;
    __device__ __forceinline__ void operator()(const f32x4 (&acc)[2][2][4][2], const Unit& u, int wr, int wc, int fr, int fq) const {
        const int row0_ = u.pm * 256 + wr * 64 + fr, j0 = u.pn * 128 + wc * 32 + 8 * fq;
        const float* bg = bup + (size_t)u.e * 2048 + j0; const f32x4 bg0 = *(const f32x4*)bg, bg1 = *(const f32x4*)(bg + 4), bu0 = *(const f32x4*)(bg + 1024), bu1 = *(const f32x4*)(bg + 1028);
#pragma unroll
        for (int ai = 0; ai < 2; ++ai)
#pragma unroll
            for (int m = 0; m < 4; ++m) { const int row = row0_ + ai * 128 + m * 16;
                const f32x4 g0 = acc[ai][0][m][0] + bg0, g1 = acc[ai][0][m][1] + bg1, u0 = acc[ai][1][m][0] + bu0, u1 = acc[ai][1][m][1] + bu1; float o[8];
#pragma unroll
                for (int i = 0; i < 4; ++i) { const float ga = fminf(g0[i], SW_LIMIT), ua = fminf(fmaxf(u0[i], -SW_LIMIT), SW_LIMIT); o[i] = (ua + 1.0f) * ga * fsigmoid(SW_ALPHA * ga);
                    const float gb = fminf(g1[i], SW_LIMIT), ub = fminf(fmaxf(u1[i], -SW_LIMIT), SW_LIMIT); o[4 + i] = (ub + 1.0f) * gb * fsigmoid(SW_ALPHA * gb); }
                *(u32x4*)(ACT + (size_t)row * D + j0) = pack8(o); }
    }
};
struct EpiDown {
    bf16_t* O; const float* bdn; const float* gs;
    __device__ __forceinline__ void operator()(const f32x4 (&acc)[2][2][4][2], const Unit& u, int wr, int wc, int fr, int fq) const {
        const int row0 = u.pm * 256 + wr * 64 + fr, col0 = u.pn * 256 + wc * 32 + 8 * fq;
#pragma unroll
        for (int ai = 0; ai < 2; ++ai) {
            float gt[4];
#pragma unroll
            for (int m = 0; m < 4; ++m) gt[m] = gs[row0 + ai * 128 + m * 16];
#pragma unroll
            for (int bj = 0; bj < 2; ++bj) { const float* bp = bdn + (size_t)u.e * D + col0 + bj * 128; const f32x4 b0 = *(const f32x4*)bp, b1 = *(const f32x4*)(bp + 4);
#pragma unroll
                for (int m = 0; m < 4; ++m) { const f32x4 a0 = (acc[ai][bj][m][0] + b0) * gt[m], a1 = (acc[ai][bj][m][1] + b1) * gt[m];
                    u32x4 w; w.x = pk2(a0[0], a0[1]); w.y = pk2(a0[2], a0[3]); w.z = pk2(a1[0], a1[1]); w.w = pk2(a1[2], a1[3]);
                    *(u32x4*)(O + (size_t)(row0 + ai * 128 + m * 16) * D + col0 + bj * 128) = w; } }
            asm volatile("" ::: "memory");
        }
    }
};
}

#ifndef EMU
#define XB_TMO      128
#define XB_XCNT(j)  (256  + 64 * (j))
#define XB_XSUB(j)  (1280 + 64 * (j))
#define XB_XGEN(j)  (2304 + 64 * (j))
#define XB_TOP      3328
#define XB_TOPGEN   3392
#define XCD_BAR_WORDS 3456
#define XB_SPIN_CAP (1u << 27)
__device__ __forceinline__ unsigned xb_ld(unsigned* p)              { return __hip_atomic_load(p, __ATOMIC_RELAXED, __HIP_MEMORY_SCOPE_AGENT); }
__device__ __forceinline__ unsigned xb_add(unsigned* p, unsigned v) { return __hip_atomic_fetch_add(p, v, __ATOMIC_RELAXED, __HIP_MEMORY_SCOPE_AGENT); }
__device__ __forceinline__ unsigned xb_xcc_id() { return (unsigned)__builtin_amdgcn_s_getreg((3 << 11) | 20) & 0xFu; }
#define XB_SPIN(cond, bar) do { unsigned _sp = 0; while (cond) { __builtin_amdgcn_s_sleep(1); \
    if ((++_sp & 255u) == 0u) { if (xb_ld(&(bar)[XB_TMO])) break; if (_sp > XB_SPIN_CAP) { atomicAdd(&(bar)[XB_TMO], 1u); break; } } } } while (0)
struct XcdBarrier { unsigned* bar; unsigned x; volatile LAS unsigned* st; };
__device__ __forceinline__ XcdBarrier xcd_barrier_post(unsigned* bar, volatile LAS unsigned* st) {
    XcdBarrier b; b.bar = bar; b.x = xb_xcc_id(); b.st = st;
    if (threadIdx.x == 0) (void)xb_add(&bar[XB_XCNT(b.x)], 1u);
    return b;
}
__device__ __forceinline__ void xcd_barrier_complete(unsigned* bar, unsigned x, unsigned& nloc, unsigned& nx) {
    const unsigned G = gridDim.x * gridDim.y * gridDim.z;
    unsigned sum, cnt, mine, sp = 0u;
    for (;;) {
        sum = 0u; cnt = 0u; mine = 0u;
#pragma unroll
        for (unsigned j = 0; j < 16; ++j) { const unsigned c = xb_ld(&bar[XB_XCNT(j)]); sum += c; cnt += (c > 0u) ? 1u : 0u; mine = (j == x) ? c : mine; }
        if (sum == G) break;
        __builtin_amdgcn_s_sleep(1);
        if ((++sp & 255u) == 0u) { if (xb_ld(&bar[XB_TMO])) break; if (sp > XB_SPIN_CAP) { atomicAdd(&bar[XB_TMO], 1u); break; } }
    }
    nloc = mine > 0u ? mine : 1u; nx = cnt > 0u ? cnt : 1u;
}
__device__ __forceinline__ void xcd_barrier(const XcdBarrier& b) {
    asm volatile("s_waitcnt vmcnt(0)" ::: "memory");
    __syncthreads();
    if (threadIdx.x == 0) {
        unsigned* bar = b.bar;
        __builtin_amdgcn_s_waitcnt(0);
        unsigned nloc = b.st[0], nx = b.st[1];
        if (nloc == 0u) { xcd_barrier_complete(bar, b.x, nloc, nx); b.st[0] = nloc; b.st[1] = nx; }
        const unsigned old = xb_add(&bar[XB_XSUB(b.x)], 1u);
        const unsigned gen = old / nloc;
        if (old + 1u == (gen + 1u) * nloc) {
            __builtin_amdgcn_fence(__ATOMIC_RELEASE, "agent");
            asm volatile("s_waitcnt vmcnt(0)" ::: "memory");
            const unsigned og = xb_add(&bar[XB_TOP], 1u);
            const unsigned tg = og / nx;
            if (og + 1u == (tg + 1u) * nx) xb_add(&bar[XB_TOPGEN], 1u);
            else XB_SPIN(xb_ld(&bar[XB_TOPGEN]) == tg, bar);
            __builtin_amdgcn_fence(__ATOMIC_ACQUIRE, "agent");
            xb_add(&bar[XB_XGEN(b.x)], 1u);
            asm volatile("s_waitcnt vmcnt(0)" ::: "memory");
        } else {
            XB_SPIN(xb_ld(&bar[XB_XGEN(b.x)]) == gen, bar);
            __builtin_amdgcn_fence(__ATOMIC_ACQUIRE, "agent");
            asm volatile("s_waitcnt vmcnt(0)" ::: "memory");
        }
    }
    __syncthreads();
}
#endif

struct Args { const float* in[31]; float* out; unsigned char* ws; int lo, hi; };
typedef const float* FPtr;
#ifdef EMU
typedef const FPtr* ArgTab;
#else
typedef const __attribute__((address_space(4))) FPtr* ArgTab;
#endif
struct Frame {
    LAS unsigned char* lds; int tid, lane, wave, G, bid;
    ArgTab in; float* out; unsigned char* ws; unsigned* ctl;
};
enum { I_XP = 0, I_XS, I_CK, I_CV, I_SST, I_SCV, I_SSC, I_WIN, I_CONVW, I_CONVB, I_DTB, I_ALOG, I_SD, I_NORMW, I_WSSD, I_SINK, I_WATT, I_RELB, I_SCW, I_WSC, I_WO, I_LN1G, I_LN1B,
       I_RW, I_RB, I_WUP, I_BUP, I_WDN, I_BDN, I_LN2G, I_LN2B };

__device__ __forceinline__ bf16_t* ws_bf(const Frame& F, size_t off) { return (bf16_t*)(F.ws + off); }
__device__ __forceinline__ float* ws_f(const Frame& F, size_t off) { return (float*)(F.ws + off); }
__device__ __forceinline__ bf16_t* wl_ptr(const Frame& F, int layer, size_t off) { return (bf16_t*)(F.ws + WS_W + (size_t)layer * WL_BYTES + off); }

__device__ __forceinline__ void wt_item(const float* W, int ldw, int K, int k0, int nsrc0, const float* kscale, bf16_t* WT, int ndst0, LAS float* scr, int lane) {
    if (nsrc0 < 0) {
#pragma unroll
        for (int j = 0; j < 4; ++j) { const int n = (lane >> 3) + 8 * j; *(u32x4*)(WT + (size_t)(ndst0 + n) * K + k0 + 8 * (lane & 7)) = (u32x4){0u, 0u, 0u, 0u}; }
        return;
    }
#pragma unroll 8
    for (int i = 0; i < 32; ++i) { const int kk = 2 * i + (lane >> 5); float v = W[(size_t)(k0 + kk) * ldw + nsrc0 + (lane & 31)]; if (kscale) v *= kscale[k0 + kk]; scr[kk * 33 + (lane & 31)] = v; }
    WAVE_SYNC();
    const int c = lane & 7;
#pragma unroll
    for (int j = 0; j < 4; ++j) { const int n = (lane >> 3) + 8 * j; const LAS float* s = scr + (8 * c) * 33 + n;
        u32x4 o; o.x = pk2(s[0 * 33], s[1 * 33]); o.y = pk2(s[2 * 33], s[3 * 33]); o.z = pk2(s[4 * 33], s[5 * 33]); o.w = pk2(s[6 * 33], s[7 * 33]);
        *(u32x4*)(WT + (size_t)(ndst0 + n) * K + k0 + 8 * c) = o; }
    WAVE_SYNC();
}
__device__ __forceinline__ void step_weights(const Frame& F) {
    LAS float* scr = (LAS float*)(F.lds + F.wave * 16384);
    const int gw = F.bid * NWAVES + F.wave, NGW = F.G * NWAVES;
    constexpr int I_IN = (DINP / 32) * (D / 64), I_SSD = (D / 32) * (DINNER / 64), I_SQ = (D / 32) * (D / 64), I_UP = NEXP * (2048 / 32) * (D / 64), I_DN = NEXP * (D / 32) * (D / 64);
    constexpr int PER_LAYER = I_IN + I_SSD + 3 * I_SQ + I_UP + I_DN;
    for (int it = gw; it < DEPTH * PER_LAYER; it += NGW) {
        const int layer = it / PER_LAYER; int r = it % PER_LAYER;
        if (r < I_IN) { const int nb = r / (D / 64), kb = r % (D / 64), n0 = nb * 32;
            const int ns = n0 < 6144 ? n0 : (n0 < 13824 ? n0 + 32 : (n0 < 13856 ? n0 - 13824 + 6144 : -1));
            wt_item(F.in[I_WIN] + (size_t)layer * D * DIN, DIN, D, kb * 64, ns, nullptr, wl_ptr(F, layer, WL_IN), n0, scr, F.lane); continue; }
        r -= I_IN;
        if (r < I_SSD) { const int nb = r / (DINNER / 64), kb = r % (DINNER / 64);
            wt_item(F.in[I_WSSD] + (size_t)layer * DINNER * D, D, DINNER, kb * 64, nb * 32, F.in[I_NORMW] + (size_t)layer * DINNER, wl_ptr(F, layer, WL_SSD), nb * 32, scr, F.lane); continue; }
        r -= I_SSD;
        if (r < I_SQ) { const int nb = r / (D / 64), kb = r % (D / 64); wt_item(F.in[I_WATT] + (size_t)layer * D * D, D, D, kb * 64, nb * 32, nullptr, wl_ptr(F, layer, WL_ATT), nb * 32, scr, F.lane); continue; }
        r -= I_SQ;
        if (r < I_SQ) { const int nb = r / (D / 64), kb = r % (D / 64); wt_item(F.in[I_WSC] + (size_t)layer * D * D, D, D, kb * 64, nb * 32, nullptr, wl_ptr(F, layer, WL_SC), nb * 32, scr, F.lane); continue; }
        r -= I_SQ;
        if (r < I_SQ) { const int nb = r / (D / 64), kb = r % (D / 64); wt_item(F.in[I_WO] + (size_t)layer * D * D, D, D, kb * 64, nb * 32, nullptr, wl_ptr(F, layer, WL_O), nb * 32, scr, F.lane); continue; }
        r -= I_SQ;
        if (r < I_UP) { const int e = r / ((2048 / 32) * (D / 64)), q = r % ((2048 / 32) * (D / 64)), nb = q / (D / 64), kb = q % (D / 64), n0 = nb * 32;
            const int pn = n0 >> 8, bj = (n0 >> 7) & 1, jj = n0 & 127, ns = bj * 1024 + pn * 128 + jj;
            wt_item(F.in[I_WUP] + ((size_t)layer * NEXP + e) * D * 2048, 2048, D, kb * 64, ns, nullptr, wl_ptr(F, layer, WL_UP) + (size_t)e * 2048 * D, n0, scr, F.lane); continue; }
        r -= I_UP;
        { const int e = r / ((D / 32) * (D / 64)), q = r % ((D / 32) * (D / 64)), nb = q / (D / 64), kb = q % (D / 64);
            wt_item(F.in[I_WDN] + ((size_t)layer * NEXP + e) * D * D, D, D, kb * 64, nb * 32, nullptr, wl_ptr(F, layer, WL_DN) + (size_t)e * D * D, nb * 32, scr, F.lane); }
    }
}

__device__ __forceinline__ const float* x_in_row(const Frame& F, int layer, int mb, int r) {
    if (layer == 0) return r < NP ? F.in[I_XP] + ((size_t)mb * NP + r) * D : F.in[I_XS] + (size_t)(r - NP) * D;
    return r < NP ? F.out + O_YP + ((size_t)mb * NP + r) * D : F.out + O_YS + (size_t)(r - NP) * D;
}
__device__ __forceinline__ float* x_out_row(const Frame& F, int mb, int r) { return r < NP ? F.out + O_YP + ((size_t)mb * NP + r) * D : F.out + O_YS + (size_t)(r - NP) * D; }
__device__ __forceinline__ int rows_of(int mb) { return mb == 0 ? R : NP; }

__device__ __forceinline__ void step_xb(const Frame& F, int mb) {
    const int gw = F.bid * NWAVES + F.wave, NGW = F.G * NWAVES, nr = rows_of(mb);
    bf16_t* XB = ws_bf(F, WS_XB0) + (size_t)mb * R * D;
    for (int r = gw; r < nr; r += NGW) {
        const f32x4* xr = (const f32x4*)x_in_row(F, 0, mb, r) + F.lane; u32x2* o = (u32x2*)(XB + (size_t)r * D) + F.lane;
#pragma unroll
        for (int j = 0; j < 4; ++j) { const f32x4 v = xr[64 * j]; u32x2 w; w.x = pk2(v[0], v[1]); w.y = pk2(v[2], v[3]); o[64 * j] = w; }
    }
}

__device__ __forceinline__ float softplus_f(float x) { const float e = fexp(x); return x > 20.f ? x : (e < 0.01f ? e * (1.0f - e * (0.5f - e * 0.33333333f)) : __builtin_amdgcn_logf(1.0f + e) * 0.69314718056f); }
constexpr int S128 = 136, S64 = 72;
constexpr int BL_BM = 0, BL_CM = BL_BM + 64 * S128 * 2, BL_CB = BL_CM + 64 * S128 * 2, BL_END = BL_CB + 64 * S64 * 2;
struct BcRegs { u32x4 raw[7]; f32x4 wq[4][2], bq[2]; };
__device__ __forceinline__ void ssd_bc_load(const Frame& F, int layer, int u, BcRegs& R_) {
    const int sl = (u / NCHUNK) % NSEQ_MB, ck = u % NCHUNK, g = u / (NCHUNK * NSEQ_MB); const int tid = F.tid;
    const bf16_t* H = ws_bf(F, WS_H) + (size_t)sl * SEQ * DINP; const int cgi = tid & 31, rb = tid >> 5; const int xc = (cgi < 16 ? 2048 : 3072) + g * 128 + 8 * (cgi & 15);
#pragma unroll
    for (int i = 0; i < 7; ++i) { const int t = ck * 64 + 4 * rb - 3 + i; R_.raw[i] = t >= 0 ? *(const u32x4*)(H + (size_t)t * DINP + C_X + xc) : (u32x4){0u, 0u, 0u, 0u}; }
    const float* convw = F.in[I_CONVW] + (size_t)layer * 4 * CONVDIM + xc; const float* convb = F.in[I_CONVB] + (size_t)layer * CONVDIM + xc;
#pragma unroll
    for (int tp = 0; tp < 4; ++tp) { R_.wq[tp][0] = *(const f32x4*)(convw + tp * CONVDIM); R_.wq[tp][1] = *(const f32x4*)(convw + tp * CONVDIM + 4); }
    R_.bq[0] = *(const f32x4*)convb; R_.bq[1] = *(const f32x4*)(convb + 4);
}
__device__ __forceinline__ void ssd_bc_unit(const Frame& F, int u, const BcRegs& R_) {
    const int sl = (u / NCHUNK) % NSEQ_MB, ck = u % NCHUNK, g = u / (NCHUNK * NSEQ_MB);
    const int tid = F.tid, lane = F.lane, w = F.wave, fr = lane & 15, fq = lane >> 4;
    LAS bf16_t* Bm = (LAS bf16_t*)(F.lds + BL_BM); LAS bf16_t* Cm = (LAS bf16_t*)(F.lds + BL_CM); LAS bf16_t* CBs = (LAS bf16_t*)(F.lds + BL_CB);
    const size_t rowg = (size_t)sl * SEQ + (size_t)ck * 64; const size_t tix = ((size_t)sl * NCHUNK + ck) * 8 + g;
    const int cgi = tid & 31, rb = tid >> 5; const bool isB = cgi < 16; const int n0 = 8 * (cgi & 15);
    const u32x4 (&raw)[7] = R_.raw; const f32x4 (&wq)[4][2] = R_.wq; const f32x4 (&bq)[2] = R_.bq;
    __syncthreads();
    { float val[4][8];
#pragma unroll
      for (int r = 0; r < 4; ++r) { float a[8] = {bq[0][0], bq[0][1], bq[0][2], bq[0][3], bq[1][0], bq[1][1], bq[1][2], bq[1][3]};
#pragma unroll
          for (int tp = 0; tp < 4; ++tp) { float f[8]; unpack8(raw[r + tp], f);
#pragma unroll
              for (int i = 0; i < 4; ++i) { a[i] += f[i] * wq[tp][0][i]; a[4 + i] += f[4 + i] * wq[tp][1][i]; } }
#pragma unroll
          for (int i = 0; i < 8; ++i) val[r][i] = fsilu(a[i]); }
      if (isB) { bf16_t* bt = ws_bf(F, WS_BTG) + tix * 8192 + (size_t)n0 * 64 + 4 * rb;
#pragma unroll
          for (int r = 0; r < 4; ++r) *(LAS u32x4*)(Bm + (4 * rb + r) * S128 + n0) = pack8(val[r]);
#pragma unroll
          for (int i = 0; i < 8; ++i) { u32x2 wv; wv.x = pk2(val[0][i], val[1][i]); wv.y = pk2(val[2][i], val[3][i]); *(u32x2*)(bt + (size_t)i * 64) = wv; } }
      else { bf16_t* cmc = ws_bf(F, WS_CMC) + (rowg + 4 * rb) * 1024 + g * 128 + n0;
#pragma unroll
          for (int r = 0; r < 4; ++r) { const u32x4 pk = pack8(val[r]); *(LAS u32x4*)(Cm + (4 * rb + r) * S128 + n0) = pk; *(u32x4*)(cmc + (size_t)r * 1024) = pk; } } }
    __syncthreads();
    { const int ti = w >> 1;
#pragma unroll
      for (int jj = 0; jj < 2; ++jj) { const int tj = 2 * (w & 1) + jj; f32x4 cb = (f32x4){0.f, 0.f, 0.f, 0.f};
          if (tj <= ti) {
#pragma unroll
              for (int ks = 0; ks < 4; ++ks) { const bf16x8 a = *(const LAS bf16x8*)(Cm + (16 * ti + fr) * S128 + 32 * ks + 8 * fq); const bf16x8 b = *(const LAS bf16x8*)(Bm + (16 * tj + fr) * S128 + 32 * ks + 8 * fq);
                  cb = __builtin_amdgcn_mfma_f32_16x16x32_bf16(a, b, cb, 0, 0, 0); } }
#pragma unroll
          for (int r = 0; r < 4; ++r) CBs[(16 * ti + 4 * fq + r) * S64 + 16 * tj + fr] = bf1(cb[r]); } }
    __syncthreads();
    { const int row = tid >> 3, cc = tid & 7; *(u32x4*)(ws_bf(F, WS_CBG) + tix * 4096 + row * 64 + 8 * cc) = *(const LAS u32x4*)(CBs + row * S64 + 8 * cc); }
}

constexpr int SL_CM = 0, SL_BT = SL_CM + 64 * S128 * 2, SL_CB = SL_BT + 128 * S64 * 2, SL_DMA_SZ = SL_CB + 64 * S64 * 2, SL_DMA_END = 2 * SL_DMA_SZ;
constexpr int SL_XT = SL_DMA_END  , SL_XTW = SL_XT + 2 * 64 * S64 * 2, SL_MM = SL_XTW + 64 * S64 * 2, SL_SB = SL_MM + 64 * S64 * 2,
    SL_SM = SL_SB + 64 * S128 * 2, SL_END = SL_SM + 2 * 384 * 4;
static_assert(SL_END <= SCR_BYTES && SL_DMA_SZ == 2816 * 16, "ssd LDS map");
#ifdef EMU
#define SSD_DMA_ONE(gp_, dst_) memcpy((unsigned char*)(dst_) + lane * 16, (gp_), 16)
#else
#define SSD_DMA_ONE(gp_, dst_) __builtin_amdgcn_global_load_lds((const unsigned*)(gp_), (LAS unsigned*)(dst_), 16, 0, 0)
#endif
#define SSD_DMA_SETUP() do { _Pragma("unroll") for (int j_ = 0; j_ < 6; ++j_) { const int pc_ = w * 6 + j_; const int q_ = pc_ * 64 + lane; const size_t tx0_ = ((size_t)sl * NCHUNK) * 8 + g; \
        if (pc_ < 17) { const int r_ = q_ / 17; int c_ = q_ % 17; c_ = c_ < 16 ? c_ : 15; dsrc[j_] = cmc + (size_t)r_ * 1024 + 8 * c_; } \
        else if (pc_ < 35) { const int q2_ = q_ - 1088, r_ = q2_ / 9; int c_ = q2_ % 9; c_ = c_ < 8 ? c_ : 7; dsrc[j_] = btg + tx0_ * 8192 + r_ * 64 + 8 * c_; } \
        else { const int q3_ = q_ - 2240, r_ = q3_ / 9; int c_ = q3_ % 9; c_ = c_ < 8 ? c_ : 7; dsrc[j_] = cbg + tx0_ * 4096 + r_ * 64 + 8 * c_; } } } while (0)
#define SSD_DMA(ck_) do { _Pragma("unroll") for (int j_ = 0; j_ < 6; ++j_) { const int pc_ = w * 6 + j_; if (pc_ < 44) { \
        SSD_DMA_ONE(dsrc[j_], L + ((ck_) & 1) * SL_DMA_SZ + SL_CM + pc_ * 1024); dsrc[j_] += pc_ < 17 ? (size_t)64 * 1024 : (pc_ < 35 ? (size_t)8 * 8192 : (size_t)8 * 4096); } } } while (0)
#define SSD_LOAD_X(ck_) do { _Pragma("unroll") for (int i = 0; i < 11; ++i) { const int t_ = (ck_) * 64 + 8 * w - 3 + i; rawx[i] = t_ >= 0 ? (unsigned)H[(size_t)t_ * DINP + C_X + hd * 64 + lane] : 0u; } } while (0)
#define SSD_LOAD_XN(ck_) do { const bf16_t* px_ = H + ((size_t)(ck_) * 64 + 8 * w - 3) * DINP + C_X + hd * 64 + lane; _Pragma("unroll") for (int i = 0; i < 11; ++i) rawx[i] = (unsigned)px_[(size_t)i * DINP]; } while (0)
#define SSD_TABLE(tb_, dtr_) do { const float dt_ = softplus_f(bf2f(dtr_) + dtb); \
        float cs_ = Ah * dt_; _Pragma("unroll") for (int o = 1; o < 64; o <<= 1) { const float t2_ = __shfl(cs_, lane - o < 0 ? 0 : lane - o); if (lane >= o) cs_ += t2_; } \
        const float tot_ = __shfl(cs_, 63); (tb_)[lane] = dt_; (tb_)[64 + lane] = cs_; (tb_)[128 + lane] = fexp(tot_ - cs_); (tb_)[192 + lane] = fexp(cs_); if (lane == 0) (tb_)[256] = fexp(tot_); } while (0)

__device__ __forceinline__ void ssd_prompt_unit(const Frame& F, int layer, int mb, int sl, int hd) {
    const int tid = F.tid, lane = F.lane, w = F.wave, fr = lane & 15, fq = lane >> 4;
    LAS unsigned char* L = F.lds;
    LAS bf16_t* XT0 = (LAS bf16_t*)(L + SL_XT);
    LAS bf16_t* XTW = (LAS bf16_t*)(L + SL_XTW); LAS bf16_t* Mm = (LAS bf16_t*)(L + SL_MM); LAS bf16_t* Sb = (LAS bf16_t*)(L + SL_SB);
    LAS float* smb = (LAS float*)(L + SL_SM);
    const int g = hd >> 2;
    bf16_t* H = ws_bf(F, WS_H) + (size_t)sl * SEQ * DINP;
    const bf16_t* cmc = ws_bf(F, WS_CMC) + (size_t)sl * SEQ * 1024 + g * 128; const bf16_t* btg = ws_bf(F, WS_BTG); const bf16_t* cbg = ws_bf(F, WS_CBG);
    const float* convw = F.in[I_CONVW] + (size_t)layer * 4 * CONVDIM + hd * 64; const float* convb = F.in[I_CONVB] + (size_t)layer * CONVDIM + hd * 64;
    const float cw0 = convw[lane], cw1 = convw[CONVDIM + lane], cw2 = convw[2 * CONVDIM + lane], cw3 = convw[3 * CONVDIM + lane], cwb = convb[lane];
    __syncthreads();
    const float dtb = F.in[I_DTB][layer * 32 + hd], Ah = -fexp(F.in[I_ALOG][layer * 32 + hd]), Dh = F.in[I_SD][layer * 32 + hd];
    const int xl = tid >> 3, xcg = tid & 7;
    f32x4 S[4];
#pragma unroll
    for (int j = 0; j < 4; ++j) S[j] = (f32x4){0.f, 0.f, 0.f, 0.f};
    const int ti = w >> 1, tj0 = 2 * (w & 1);
    const int pi = w & 3, nb = w >> 2;
    bf16_t* pz = H + (size_t)(16 * ti + fr) * DINP + C_Z + hd * 64 + 16 * tj0 + 4 * fq; float* pss = ws_f(F, WS_SSQ) + ((size_t)sl * SEQ + 16 * ti + fr) * 64 + hd * 2 + (w & 1);
    unsigned rawx[11]; u32x2 zraw[2]; unsigned dtr_next;
    const bf16_t* dsrc[6]; SSD_DMA_SETUP();
    SSD_DMA(0); SSD_LOAD_X(0);
    zraw[0] = *(const u32x2*)pz; zraw[1] = *(const u32x2*)(pz + 16);
    { const unsigned d0 = H[(size_t)lane * DINP + C_DT + hd]; dtr_next = H[(size_t)(64 + lane) * DINP + C_DT + hd]; if (w == 7) { SSD_TABLE(smb, d0); smb[320 + lane] = Dh * __builtin_amdgcn_rcpf(smb[lane]); } }
    VM_WAIT(0);
    __syncthreads();
    for (int ck = 0; ck < NCHUNK; ++ck) {
        LAS float* sm = smb + (ck & 1) * 384; LAS float* smn = smb + ((ck + 1) & 1) * 384; LAS bf16_t* XT = XT0 + (ck & 1) * 64 * S64;
        LAS unsigned char* Ld = L + (ck & 1) * SL_DMA_SZ; LAS bf16_t* Cm = (LAS bf16_t*)(Ld + SL_CM); LAS bf16_t* BT = (LAS bf16_t*)(Ld + SL_BT); LAS bf16_t* CBl = (LAS bf16_t*)(Ld + SL_CB);
        { const f32x4 d0 = *(const LAS f32x4*)(sm + 8 * w), d1 = *(const LAS f32x4*)(sm + 8 * w + 4), e0 = *(const LAS f32x4*)(sm + 128 + 8 * w), e1 = *(const LAS f32x4*)(sm + 128 + 8 * w + 4);
          const float dtv[8] = {d0[0], d0[1], d0[2], d0[3], d1[0], d1[1], d1[2], d1[3]}, wdv[8] = {e0[0], e0[1], e0[2], e0[3], e1[0], e1[1], e1[2], e1[3]}; float xr[11], xa[8], xb[8];
#pragma unroll
          for (int i = 0; i < 11; ++i) xr[i] = blo(rawx[i]);
#pragma unroll
          for (int r = 0; r < 8; ++r) { const float xd = fsilu(cwb + xr[r] * cw0 + xr[r + 1] * cw1 + xr[r + 2] * cw2 + xr[r + 3] * cw3) * dtv[r]; xa[r] = xd; xb[r] = xd * wdv[r]; }
          *(LAS u32x4*)(XT + lane * S64 + 8 * w) = pack8(xa); *(LAS u32x4*)(XTW + lane * S64 + 8 * w) = pack8(xb); }
#pragma unroll
        for (int jj = 0; jj < 4; ++jj) { u32x2 wv; wv.x = pk2(S[jj][0], S[jj][1]); wv.y = pk2(S[jj][2], S[jj][3]); *(LAS u32x2*)(Sb + (16 * pi + fr) * S128 + 64 * nb + 16 * jj + 4 * fq) = wv; }
        if (ck > 0) VM_WAIT(2);
        LBAR();
        const u32x2 z0 = zraw[0], z1 = zraw[1]; const unsigned dtr_cur = dtr_next;
        if (ck + 1 < NCHUNK) SSD_DMA(ck + 1);
        if (ck + 1 < NCHUNK) { SSD_LOAD_XN(ck + 1); zraw[0] = *(const u32x2*)(pz + (size_t)64 * DINP); zraw[1] = *(const u32x2*)(pz + (size_t)64 * DINP + 16);
            dtr_next = H[((size_t)ck * 64 + (ck + 2 < NCHUNK ? 128 : 64) + lane) * DINP + C_DT + hd]; }
        asm volatile("" ::: "memory");
        if (w == 7 && ck + 1 < NCHUNK) { SSD_TABLE(smn, dtr_cur); smn[320 + lane] = Dh * __builtin_amdgcn_rcpf(smn[lane]); }
        { const int s0 = 8 * xcg; float mv[8];
          if (s0 <= xl) { float cbv[8]; unpack8(*(const LAS u32x4*)(CBl + xl * S64 + s0), cbv); const float al = sm[64 + xl]; const f32x4 a0 = *(const LAS f32x4*)(sm + 64 + s0), a1 = *(const LAS f32x4*)(sm + 64 + s0 + 4);
#pragma unroll
              for (int i = 0; i < 4; ++i) { mv[i] = (xl >= s0 + i) ? cbv[i] * fexp(fminf(al - a0[i], 0.f)) : 0.f; mv[4 + i] = (xl >= s0 + 4 + i) ? cbv[4 + i] * fexp(fminf(al - a1[i], 0.f)) : 0.f; }
              if ((xl >> 3) == xcg) { const float dd = sm[320 + xl];
#pragma unroll
                  for (int i = 0; i < 8; ++i) if (i == (xl & 7)) mv[i] += dd; } }
          else {
#pragma unroll
              for (int i = 0; i < 8; ++i) mv[i] = 0.f; }
          *(LAS u32x4*)(Mm + xl * S64 + s0) = pack8(mv); }
        f32x4 yo[2];
#pragma unroll
        for (int jj = 0; jj < 2; ++jj) { const int tj = tj0 + jj; yo[jj] = (f32x4){0.f, 0.f, 0.f, 0.f};
#pragma unroll
            for (int ks = 0; ks < 4; ++ks) { const bf16x8 sb = *(const LAS bf16x8*)(Sb + (16 * tj + fr) * S128 + 32 * ks + 8 * fq); const bf16x8 c = *(const LAS bf16x8*)(Cm + (16 * ti + fr) * S128 + 32 * ks + 8 * fq);
                yo[jj] = __builtin_amdgcn_mfma_f32_16x16x32_bf16(sb, c, yo[jj], 0, 0, 0); } }
        { const float cd = sm[256];
#pragma unroll
          for (int jj = 0; jj < 4; ++jj) { S[jj] = S[jj] * cd;
#pragma unroll
            for (int ks = 0; ks < 2; ++ks) { const bf16x8 a = *(const LAS bf16x8*)(BT + (64 * nb + 16 * jj + fr) * S64 + 32 * ks + 8 * fq); const bf16x8 b = *(const LAS bf16x8*)(XTW + (16 * pi + fr) * S64 + 32 * ks + 8 * fq);
                S[jj] = __builtin_amdgcn_mfma_f32_16x16x32_bf16(a, b, S[jj], 0, 0, 0); }
            if (jj & 1) asm volatile("" ::: "memory"); } }
        const float ec = sm[192 + 16 * ti + fr];
        LBAR();
        { float ss = 0.f; const u32x2 zz[2] = {z0, z1};
#pragma unroll
          for (int jj = 0; jj < 2; ++jj) { const int tj = tj0 + jj; f32x4 yd = (f32x4){0.f, 0.f, 0.f, 0.f};
#pragma unroll
              for (int ks = 0; ks < 2; ++ks) { const bf16x8 a = *(const LAS bf16x8*)(XT + (16 * tj + fr) * S64 + 32 * ks + 8 * fq); const bf16x8 b = *(const LAS bf16x8*)(Mm + (16 * ti + fr) * S64 + 32 * ks + 8 * fq);
                  yd = __builtin_amdgcn_mfma_f32_16x16x32_bf16(a, b, yd, 0, 0, 0); }
              const float z[4] = {blo(zz[jj].x), bhi(zz[jj].x), blo(zz[jj].y), bhi(zz[jj].y)}; float v[4];
#pragma unroll
              for (int r = 0; r < 4; ++r) { v[r] = (yd[r] + ec * yo[jj][r]) * fsilu(z[r]); ss += v[r] * v[r]; }
              u32x2 ov; ov.x = pk2(v[0], v[1]); ov.y = pk2(v[2], v[3]); *(u32x2*)(pz + 16 * jj) = ov; }
          ss += __shfl_xor(ss, 16); ss += __shfl_xor(ss, 32);
          if (fq == 0) *pss = ss;
          pz += (size_t)64 * DINP; pss += 64 * 64; }
    }
    float* so = F.out + O_SSP + ((((size_t)layer * BATCH + mb * NSEQ_MB + sl) * 32 + hd) * 64) * 128;
#pragma unroll
    for (int jj = 0; jj < 4; ++jj) *(f32x4*)(so + (size_t)(16 * pi + fr) * 128 + 64 * nb + 16 * jj + 4 * fq) = S[jj];
    VM_WAIT(0); __syncthreads();
}

__device__ __forceinline__ void ssd_sample_unit(const Frame& F, int layer, int sq, int hd) {
    const int tid = F.tid, lane = F.lane; LAS float* L = (LAS float*)F.lds;
    LAS float* xs = L; LAS float* Bs = L + 16 * 64; LAS float* Cs = Bs + 16 * 128; LAS float* dts = Cs + 16 * 128; LAS float* das = dts + 16; LAS float* Yl = das + 16;
    const int g = hd >> 2;
    bf16_t* H = ws_bf(F, WS_H) + (size_t)(NP + sq * 16) * DINP;
    const float* hist = F.in[I_SCV] + ((size_t)layer * DECB + sq) * 3 * CONVDIM;
    const float* convw = F.in[I_CONVW] + (size_t)layer * 4 * CONVDIM; const float* convb = F.in[I_CONVB] + (size_t)layer * CONVDIM;
    __syncthreads();
    if (tid < 320) { const int c = tid; const int xc = c < 64 ? hd * 64 + c : (c < 192 ? 2048 + g * 128 + (c - 64) : 3072 + g * 128 + (c - 192));
        float win[19];
#pragma unroll
        for (int i = 0; i < 3; ++i) win[i] = hist[i * CONVDIM + xc];
#pragma unroll
        for (int t = 0; t < 16; ++t) win[3 + t] = bf2f(H[(size_t)t * DINP + C_X + xc]);
        const float w0 = convw[xc], w1 = convw[CONVDIM + xc], w2 = convw[2 * CONVDIM + xc], w3 = convw[3 * CONVDIM + xc], bb = convb[xc];
#pragma unroll
        for (int t = 0; t < 16; ++t) { const float a = fsilu(bb + win[t] * w0 + win[t + 1] * w1 + win[t + 2] * w2 + win[t + 3] * w3);
            if (c < 64) xs[t * 64 + c] = a; else if (c < 192) Bs[t * 128 + c - 64] = a; else Cs[t * 128 + c - 192] = a; } }
    if (tid < 16) { const float dt = softplus_f(bf2f(H[(size_t)tid * DINP + C_DT + hd]) + F.in[I_DTB][layer * 32 + hd]); dts[tid] = dt; das[tid] = fexp(-fexp(F.in[I_ALOG][layer * 32 + hd]) * dt); }
    __syncthreads();
    const int p = tid >> 3, n0 = (tid & 7) * 16;
    const size_t sbase = ((((size_t)layer * DECB + sq) * 32 + hd) * 64 + p) * 128 + n0;
    float S[16];
#pragma unroll
    for (int i = 0; i < 16; ++i) S[i] = F.in[I_SST][sbase + i];
    for (int t = 0; t < 16; ++t) { const float dec = das[t], xv = xs[t * 64 + p] * dts[t]; float part = 0.f;
#pragma unroll
        for (int i = 0; i < 16; ++i) { S[i] = S[i] * dec + xv * Bs[t * 128 + n0 + i]; part += Cs[t * 128 + n0 + i] * S[i]; }
        part += __shfl_xor(part, 1); part += __shfl_xor(part, 2); part += __shfl_xor(part, 4);
        if ((tid & 7) == 0) Yl[t * 64 + p] = part; }
#pragma unroll
    for (int i = 0; i < 16; ++i) F.out[O_SSS + sbase + i] = S[i];
    __syncthreads();
    const float Dh = F.in[I_SD][layer * 32 + hd];
#pragma unroll
    for (int j = 0; j < 2; ++j) { const int it = tid + 512 * j, t = it >> 6, pp = it & 63;
        const float z = bf2f(H[(size_t)t * DINP + C_Z + hd * 64 + pp]); const float v = (Yl[t * 64 + pp] + Dh * xs[t * 64 + pp]) * fsilu(z);
        H[(size_t)t * DINP + C_Z + hd * 64 + pp] = bf1(v);
        const float ss = wave_sum(v * v);
        if (lane < 2) ws_f(F, WS_SSQ)[((size_t)NP + sq * 16 + t) * 64 + hd * 2 + lane] = lane == 0 ? ss : 0.f; }
}

__device__ __forceinline__ int t5_bucket(int rel) {
    const int n = rel < 0 ? -rel : rel; const int b = rel > 0 ? 16 : 0;
    if (n < 8) return b + n;
    int v = 8; v += n >= 12; v += n >= 16; v += n >= 23; v += n >= 32; v += n >= 46; v += n >= 64; v += n >= 91;
    return b + v;
}
constexpr int AK_P = 72, AV_P = 200;
constexpr int AL_K = 0, AL_VT = AL_K + 192 * AK_P * 2, AL_LUT = AL_VT + 64 * AV_P * 2, AL_END = AL_LUT + 4 * 256 * 4;
static_assert(AL_END <= RING_BYTES, "attention LDS map");
__device__ __forceinline__ void attn_prompt_unit(const Frame& F, int layer, int sl, int ck, int kh) {
    const int tid = F.tid, lane = F.lane, w = F.wave, q32 = lane & 31, hi = lane >> 5;
    LAS bf16_t* Kl = (LAS bf16_t*)(F.lds + AL_K); LAS bf16_t* VT = (LAS bf16_t*)(F.lds + AL_VT); LAS float* lut = (LAS float*)(F.lds + AL_LUT);
    bf16_t* H = ws_bf(F, WS_H) + (size_t)sl * SEQ * DINP;
    const int gq = w >> 1, qh = w & 1, head = kh * 4 + gq;
    const size_t qrow = (size_t)ck * 64 + 32 * qh + q32;
    bf16x8 qf[4];
#pragma unroll
    for (int ds = 0; ds < 4; ++ds) qf[ds] = *(const bf16x8*)(H + qrow * DINP + C_Q + head * 64 + 16 * ds + 8 * hi);
    __syncthreads();
#pragma unroll
    for (int j = 0; j < 3; ++j) { const int id = tid + 512 * j, key = id >> 3, cg = id & 7; const int t = 64 * (ck - 2) + key;
        u32x4 kv = (u32x4){0u, 0u, 0u, 0u}, vv = kv;
        if (t >= 0) { kv = *(const u32x4*)(H + (size_t)t * DINP + C_K + kh * 64 + 8 * cg); vv = *(const u32x4*)(H + (size_t)t * DINP + C_V + kh * 64 + 8 * cg); }
        *(LAS u32x4*)(Kl + key * AK_P + 8 * cg) = kv;
        VT[(8 * cg + 0) * AV_P + key] = (bf16_t)(vv.x & 0xffffu); VT[(8 * cg + 1) * AV_P + key] = (bf16_t)(vv.x >> 16); VT[(8 * cg + 2) * AV_P + key] = (bf16_t)(vv.y & 0xffffu); VT[(8 * cg + 3) * AV_P + key] = (bf16_t)(vv.y >> 16);
        VT[(8 * cg + 4) * AV_P + key] = (bf16_t)(vv.z & 0xffffu); VT[(8 * cg + 5) * AV_P + key] = (bf16_t)(vv.z >> 16); VT[(8 * cg + 6) * AV_P + key] = (bf16_t)(vv.w & 0xffffu); VT[(8 * cg + 7) * AV_P + key] = (bf16_t)(vv.w >> 16); }
    for (int e = tid; e < 4 * 255; e += NTHREADS) { const int gg = e / 255, idx = e % 255; lut[gg * 256 + idx] = F.in[I_RELB][t5_bucket(idx - 191) * 16 + kh * 4 + gg]; }
    __syncthreads();
    f32x16 sc[6];
#pragma unroll
    for (int kt = 0; kt < 6; ++kt) {
#pragma unroll
        for (int r = 0; r < 16; ++r) sc[kt][r] = 0.f;
#pragma unroll
        for (int ds = 0; ds < 4; ++ds) { const bf16x8 a = *(const LAS bf16x8*)(Kl + (32 * kt + q32) * AK_P + 16 * ds + 8 * hi); sc[kt] = __builtin_amdgcn_mfma_f32_32x32x16_bf16(a, qf[ds], sc[kt], 0, 0, 0); } }
    const int qidx = 32 * qh + q32; const float sink = F.in[I_SINK][layer * 16 + head];
    float mx = -3.0e38f;
#pragma unroll
    for (int kt = 0; kt < 6; ++kt)
#pragma unroll
        for (int r = 0; r < 16; ++r) { const int key = 32 * kt + (r & 3) + 8 * (r >> 2) + 4 * hi; const int rel = key - 128 - qidx;
            float s = sc[kt][r] * 0.125f + lut[gq * 256 + rel + 191]; if (ck < 2 && 64 * ck + key - 128 < 0) s = -1e30f; sc[kt][r] = s; mx = fmaxf(mx, s); }
    mx = fmaxf(mx, __shfl_xor(mx, 32)); mx = fmaxf(mx, sink);
    float sum = 0.f;
#pragma unroll
    for (int kt = 0; kt < 6; ++kt)
#pragma unroll
        for (int r = 0; r < 16; ++r) { const float e = fexp(sc[kt][r] - mx); sc[kt][r] = e; sum += e; }
    sum += __shfl_xor(sum, 32);
    const float inv = 1.0f / (sum + fexp(sink - mx));
    f32x16 o[2];
#pragma unroll
    for (int d2 = 0; d2 < 2; ++d2)
#pragma unroll
        for (int r = 0; r < 16; ++r) o[d2][r] = 0.f;
#pragma unroll
    for (int kt = 0; kt < 6; ++kt)
#pragma unroll
        for (int s = 0; s < 2; ++s) {
            u32x4 pw; pw.x = pk2(sc[kt][8 * s + 0], sc[kt][8 * s + 1]); pw.y = pk2(sc[kt][8 * s + 2], sc[kt][8 * s + 3]); pw.z = pk2(sc[kt][8 * s + 4], sc[kt][8 * s + 5]); pw.w = pk2(sc[kt][8 * s + 6], sc[kt][8 * s + 7]);
            const bf16x8 pa = __builtin_bit_cast(bf16x8, pw);
#pragma unroll
            for (int d2 = 0; d2 < 2; ++d2) { const LAS bf16_t* vp = VT + (32 * d2 + q32) * AV_P + 32 * kt + 16 * s + 4 * hi;
                const u32x2 lo = *(const LAS u32x2*)vp, hh = *(const LAS u32x2*)(vp + 8); u32x4 vw; vw.x = lo.x; vw.y = lo.y; vw.z = hh.x; vw.w = hh.y;
                o[d2] = __builtin_amdgcn_mfma_f32_32x32x16_bf16(pa, __builtin_bit_cast(bf16x8, vw), o[d2], 0, 0, 0); } }
#pragma unroll
    for (int r = 0; r < 16; ++r) { const int q = (r & 3) + 8 * (r >> 2) + 4 * hi; const float iv = __shfl(inv, q);
        bf16_t* op = H + ((size_t)ck * 64 + 32 * qh + q) * DINP + C_Q + head * 64 + q32;
        op[0] = bf1(o[0][r] * iv); op[32] = bf1(o[1][r] * iv); }
}
__device__ __forceinline__ void attn_sample_unit(const Frame& F, int layer, int sq, int kh) {
    const int tid = F.tid; LAS float* L = (LAS float*)F.lds;
    LAS float* Kf = L; LAS float* Vf = Kf + 144 * 65; LAS float* Qf = Vf + 144 * 64; LAS float* P = Qf + 64 * 65; LAS float* Pinv = P + 64 * 145;
    static_assert((144 * 65 + 144 * 64 + 64 * 65 + 64 * 145 + 64) * 4 <= RING_BYTES, "sample attention LDS map");
    bf16_t* H = ws_bf(F, WS_H) + (size_t)(NP + sq * 16) * DINP;
    const float* ck = F.in[I_CK] + ((size_t)layer * DECB + sq) * WINDOW * 256; const float* cv = F.in[I_CV] + ((size_t)layer * DECB + sq) * WINDOW * 256;
    __syncthreads();
    for (int i = tid; i < 144 * 64; i += NTHREADS) { const int key = i >> 6, d = i & 63;
        Kf[key * 65 + d] = key < 128 ? ck[(size_t)key * 256 + kh * 64 + d] : bf2f(H[(size_t)(key - 128) * DINP + C_K + kh * 64 + d]);
        Vf[key * 64 + d] = key < 128 ? cv[(size_t)key * 256 + kh * 64 + d] : bf2f(H[(size_t)(key - 128) * DINP + C_V + kh * 64 + d]); }
    for (int i = tid; i < 64 * 64; i += NTHREADS) { const int row = i >> 6, d = i & 63; Qf[row * 65 + d] = bf2f(H[(size_t)(row & 15) * DINP + C_Q + (kh * 4 + (row >> 4)) * 64 + d]); }
    __syncthreads();
    for (int i = tid; i < 64 * 144; i += NTHREADS) { const int row = i / 144, key = i % 144; float s = 0.f;
        for (int d = 0; d < 64; ++d) s += Qf[row * 65 + d] * Kf[key * 65 + d];
        P[row * 145 + key] = s * 0.125f + F.in[I_RELB][t5_bucket(key - 128 - (row & 15)) * 16 + kh * 4 + (row >> 4)]; }
    __syncthreads();
    { const int row = tid >> 3, sub = tid & 7; const float sink = F.in[I_SINK][layer * 16 + kh * 4 + (row >> 4)]; float mx = -3.0e38f;
      for (int k = sub; k < 144; k += 8) mx = fmaxf(mx, P[row * 145 + k]);
      mx = fmaxf(mx, __shfl_xor(mx, 1)); mx = fmaxf(mx, __shfl_xor(mx, 2)); mx = fmaxf(mx, __shfl_xor(mx, 4)); mx = fmaxf(mx, sink);
      float sum = 0.f;
      for (int k = sub; k < 144; k += 8) { const float e = fexp(P[row * 145 + k] - mx); P[row * 145 + k] = e; sum += e; }
      sum += __shfl_xor(sum, 1); sum += __shfl_xor(sum, 2); sum += __shfl_xor(sum, 4);
      if (sub == 0) Pinv[row] = 1.0f / (sum + fexp(sink - mx)); }
    __syncthreads();
    { const int row = tid >> 3, d0 = (tid & 7) * 8; float o[8] = {0.f, 0.f, 0.f, 0.f, 0.f, 0.f, 0.f, 0.f};
      for (int k = 0; k < 144; ++k) { const float pv = P[row * 145 + k];
#pragma unroll
          for (int i = 0; i < 8; ++i) o[i] += pv * Vf[k * 64 + d0 + i]; }
      const float iv = Pinv[row];
#pragma unroll
      for (int i = 0; i < 8; ++i) o[i] *= iv;
      *(u32x4*)(H + (size_t)(row & 15) * DINP + C_Q + (kh * 4 + (row >> 4)) * 64 + d0) = pack8(o); }
}
__device__ __forceinline__ void sc_unit(const Frame& F, int layer, int tile) {
    const int tid = F.tid, cg = tid & 127, rs = tid >> 7; bf16_t* H = ws_bf(F, WS_H);
    const float* wsc = F.in[I_SCW] + (size_t)layer * 3 * D + 8 * cg; float wt[3][8];
#pragma unroll
    for (int i = 0; i < 3; ++i)
#pragma unroll
        for (int c = 0; c < 8; ++c) wt[i][c] = wsc[i * D + c];
    const int row0 = tile * 64 + 16 * rs; const bool smp = row0 >= NP; const int tt0 = smp ? 0 : row0 % SEQ;
    float u1[8], u2[8];
    if (tt0 >= 2) { float c8[8], h8[8];
        unpack8(*(const u32x4*)(H + (size_t)(row0 - 2) * DINP + C_SCC + 8 * cg), c8); unpack8(*(const u32x4*)(H + (size_t)(row0 - 2) * DINP + C_SCH + 8 * cg), h8);
#pragma unroll
        for (int c = 0; c < 8; ++c) u2[c] = c8[c] * h8[c];
        unpack8(*(const u32x4*)(H + (size_t)(row0 - 1) * DINP + C_SCC + 8 * cg), c8); unpack8(*(const u32x4*)(H + (size_t)(row0 - 1) * DINP + C_SCH + 8 * cg), h8);
#pragma unroll
        for (int c = 0; c < 8; ++c) u1[c] = c8[c] * h8[c]; }
    else if (smp) { const float* hp = F.in[I_SSC] + (((size_t)layer * DECB + ((row0 - NP) >> 4)) * 2) * D + 8 * cg;
#pragma unroll
        for (int c = 0; c < 8; ++c) { u2[c] = hp[c]; u1[c] = hp[D + c]; } }
    else {
#pragma unroll
        for (int c = 0; c < 8; ++c) { u2[c] = 0.f; u1[c] = 0.f; } }
#pragma unroll 1
    for (int q = 0; q < 4; ++q) {
        u32x4 cw_[4], hw_[4], bw_[4];
#pragma unroll
        for (int i = 0; i < 4; ++i) { const bf16_t* hp = H + (size_t)(row0 + 4 * q + i) * DINP + 8 * cg; cw_[i] = *(const u32x4*)(hp + C_SCC); hw_[i] = *(const u32x4*)(hp + C_SCH); bw_[i] = *(const u32x4*)(hp + C_SCB); }
        asm volatile("" ::: "memory");
#pragma unroll
        for (int i = 0; i < 4; ++i) { float c8[8], h8[8], b8[8], a[8]; unpack8(cw_[i], c8); unpack8(hw_[i], h8); unpack8(bw_[i], b8);
#pragma unroll
            for (int c = 0; c < 8; ++c) { const float u0 = c8[c] * h8[c]; a[c] = (u2[c] * wt[0][c] + u1[c] * wt[1][c] + u0 * wt[2][c]) * b8[c]; u2[c] = u1[c]; u1[c] = u0; }
            *(u32x4*)(H + (size_t)(row0 + 4 * q + i) * DINP + C_SCB + 8 * cg) = pack8(a); }
    }
}
__device__ __forceinline__ void state_out_unit(const Frame& F, int layer, int mb, int sl, bool smp) {
    const int tid = F.tid; const bf16_t* H = ws_bf(F, WS_H);
    const int nkv = smp ? DECS : WINDOW, len = smp ? DECS : SEQ; const size_t row0 = smp ? (size_t)NP + sl * 16 : (size_t)sl * SEQ; const int sg = smp ? sl : mb * NSEQ_MB + sl;
    const size_t nb_ = smp ? DECB : BATCH;
    float* ko = F.out + (smp ? O_KS : O_KP) + ((size_t)layer * nb_ + sg) * nkv * 256; float* vo = F.out + (smp ? O_VS : O_VP) + ((size_t)layer * nb_ + sg) * nkv * 256;
    for (int i = tid; i < nkv * 32; i += NTHREADS) { const int j = i >> 5, c8 = (i & 31) * 8; const bf16_t* hp = H + (row0 + len - nkv + j) * DINP; float f[8];
        unpack8(*(const u32x4*)(hp + C_K + c8), f); *(f32x4*)(ko + (size_t)j * 256 + c8) = (f32x4){f[0], f[1], f[2], f[3]}; *(f32x4*)(ko + (size_t)j * 256 + c8 + 4) = (f32x4){f[4], f[5], f[6], f[7]};
        unpack8(*(const u32x4*)(hp + C_V + c8), f); *(f32x4*)(vo + (size_t)j * 256 + c8) = (f32x4){f[0], f[1], f[2], f[3]}; *(f32x4*)(vo + (size_t)j * 256 + c8 + 4) = (f32x4){f[4], f[5], f[6], f[7]}; }
    float* co = F.out + (smp ? O_CVS : O_CVP) + ((size_t)layer * nb_ + sg) * 3 * CONVDIM;
    for (int i = tid; i < 3 * 512; i += NTHREADS) { const int j = i / 512, c8 = (i % 512) * 8; float f[8]; unpack8(*(const u32x4*)(H + (row0 + len - 3 + j) * DINP + C_X + c8), f);
        *(f32x4*)(co + (size_t)j * CONVDIM + c8) = (f32x4){f[0], f[1], f[2], f[3]}; *(f32x4*)(co + (size_t)j * CONVDIM + c8 + 4) = (f32x4){f[4], f[5], f[6], f[7]}; }
    float* so = F.out + (smp ? O_SCS : O_SCP) + ((size_t)layer * nb_ + sg) * 2 * D;
    for (int i = tid; i < 2 * 128; i += NTHREADS) { const int j = i >> 7, c8 = (i & 127) * 8; float c[8], h[8]; const bf16_t* hp = H + (row0 + len - 2 + j) * DINP;
        unpack8(*(const u32x4*)(hp + C_SCC + c8), c); unpack8(*(const u32x4*)(hp + C_SCH + c8), h);
        *(f32x4*)(so + (size_t)j * D + c8) = (f32x4){c[0] * h[0], c[1] * h[1], c[2] * h[2], c[3] * h[3]}; *(f32x4*)(so + (size_t)j * D + c8 + 4) = (f32x4){c[4] * h[4], c[5] * h[5], c[6] * h[6], c[7] * h[7]}; }
}
#ifndef MIX_MASK
#define MIX_MASK 0xFF
#endif
#define MIXON(b) ((MIX_MASK >> (b)) & 1)
__device__ __forceinline__ void step_premix(const Frame& F, int layer, int mb) {
    const int n_bc = NSEQ_MB * NCHUNK * 8, n_att = NSEQ_MB * NCHUNK * NKV, n_sc = rows_of(mb) / 64, n_so = NSEQ_MB + (mb == 0 ? DECB : 0);
    const int n_ss = mb == 0 ? DECB * 32 : 0, n_as = mb == 0 ? DECB * NKV : 0;
    const int total = n_bc + n_att + n_sc + n_so + n_ss + n_as;
#define UF(Fu) Frame Fu = F; Fu.lane = opq(lane_id()); Fu.tid = Fu.wave * 64 + Fu.lane
    PROBE_T0(14) if constexpr (MIXON(0)) { UF(Fu); BcRegs ra, rn_;
        if (F.bid < n_bc) ssd_bc_load(Fu, layer, F.bid, ra);
        for (int u = F.bid; u < n_bc; u += F.G) { const bool more = u + F.G < n_bc; if (more) ssd_bc_load(Fu, layer, u + F.G, rn_);
            ssd_bc_unit(Fu, u, ra);
            if (more) ra = rn_; } }
    PROBE_T1(14)
    for (int un = F.bid; un < total; un += F.G) { int r = un;
        if (r < n_bc) continue;
        r -= n_bc;
        if (r < n_att) { PROBE_T0(15) if constexpr (MIXON(1)) { UF(Fu);
                const int ra = (n_att % 8 == 0 && F.G % 8 == 0 && n_bc % F.G == 0) ? (r & 7) * (n_att >> 3) + (r >> 3) : r;
                attn_prompt_unit(Fu, layer, ra / (NCHUNK * NKV), (ra / NKV) % NCHUNK, ra % NKV); } PROBE_T1(15) continue; } r -= n_att;
        if (r < n_sc) { PROBE_T0(16) if constexpr (MIXON(2)) { UF(Fu); sc_unit(Fu, layer, r); } PROBE_T1(16) continue; } r -= n_sc;
        if (r < n_so) { PROBE_T0(17) if constexpr (MIXON(3)) { UF(Fu); state_out_unit(Fu, layer, mb, r < NSEQ_MB ? r : r - NSEQ_MB, r >= NSEQ_MB); } PROBE_T1(17) continue; } r -= n_so;
        if (r < n_ss) { PROBE_T0(18) if constexpr (MIXON(4)) { UF(Fu); ssd_sample_unit(Fu, layer, r >> 5, r & 31); } PROBE_T1(18) continue; } r -= n_ss;
        { PROBE_T0(19) if constexpr (MIXON(5)) { UF(Fu); attn_sample_unit(Fu, layer, r >> 2, r & 3); } PROBE_T1(19) }
    }
}
__device__ __forceinline__ void step_mixers(const Frame& F, int layer, int mb) {
    for (int v = F.bid; v < NSEQ_MB * 32; v += F.G) { const int un = (NSEQ_MB == 8 && F.G == 256) ? (v & 7) * 32 + (v >> 3) : v; UF(Fu); ssd_prompt_unit(Fu, layer, mb, un >> 5, un & 31); }
}
__device__ __forceinline__ void step_gnorm(const Frame& F, int mb) {
    const int gw = F.bid * NWAVES + F.wave, NGW = F.G * NWAVES, nr = rows_of(mb); bf16_t* H = ws_bf(F, WS_H); const float* ssq = ws_f(F, WS_SSQ);
    constexpr int RB = 4; const int g = F.lane >> 3;
    for (int r0 = gw; r0 < nr; r0 += RB * NGW) {
        u32x4 d[RB][4]; f32x4 q[RB];
#pragma unroll
        for (int i = 0; i < RB; ++i) { const int r = r0 + i * NGW < nr ? r0 + i * NGW : r0; { const f32x4 qa = *(const f32x4*)(ssq + (size_t)r * 64 + 8 * g), qb = *(const f32x4*)(ssq + (size_t)r * 64 + 8 * g + 4); q[i] = qa + qb; } const u32x4* p = (const u32x4*)(H + (size_t)r * DINP + C_Z + 32 * F.lane);
#pragma unroll
            for (int j = 0; j < 4; ++j) d[i][j] = p[j]; }
        asm volatile("" ::: "memory");
#pragma unroll
        for (int i = 0; i < RB; ++i) { const int r = r0 + i * NGW; if (r >= nr) continue;
            const float rstd = 1.0f / sqrtf(((q[i][0] + q[i][1]) + (q[i][2] + q[i][3])) * (1.0f / 256.0f) + LN_EPS); u32x4* p = (u32x4*)(H + (size_t)r * DINP + C_Z + 32 * F.lane);
#pragma unroll
            for (int j = 0; j < 4; ++j) { float f[8]; unpack8(d[i][j], f);
#pragma unroll
                for (int k = 0; k < 8; ++k) f[k] *= rstd;
                p[j] = pack8(f); } }
    }
}
constexpr int LOG_NEXP = NEXP == 32 ? 5 : (NEXP == 16 ? 4 : (NEXP == 8 ? 3 : 2));
template <int N, int MASK> struct RedStep {
    static __device__ __forceinline__ void run(float* v, int lane) {
        constexpr int Hn = N / 2; const bool up = (lane & MASK) != 0;
#pragma unroll
        for (int i = 0; i < Hn; ++i) { const float keep = up ? v[i + Hn] : v[i], send = up ? v[i] : v[i + Hn]; v[i] = keep + xshfl<MASK>(send); }
        if constexpr (Hn > 1) RedStep<Hn, (MASK >> 1)>::run(v, lane);
    }
};
__device__ __forceinline__ void step_ln1_router(const Frame& F, int layer, int mb) {
    LAS float* wT = (LAS float*)F.lds;
    const float* rw = F.in[I_RW] + (size_t)layer * D * NEXP;
    __syncthreads();
    for (int i = F.tid; i < D * NEXP; i += NTHREADS) { const int e = i / D, k = i % D; wT[i] = rw[(size_t)k * NEXP + e]; }
    unsigned* cnt = F.ctl + CW_CNT + (mb * DEPTH + layer) * 64;
    LAS unsigned* lcnt = (LAS unsigned*)(F.lds + MISC_OFF) + 128;
    if (F.tid < 64) lcnt[F.tid] = 0u;
    __syncthreads();
    const int gw = F.bid * NWAVES + F.wave, NGW = F.G * NWAVES, nr = rows_of(mb), lane = F.lane;
    const float* lg = F.in[I_LN1G] + (size_t)layer * D; const float* lb = F.in[I_LN1B] + (size_t)layer * D; const float* rb = F.in[I_RB] + (size_t)layer * NEXP;
    bf16_t* XB = ws_bf(F, WS_XB); int* topi = (int*)(F.ws + WS_TOPI); float* gate = ws_f(F, WS_GATE); int* pos = (int*)(F.ws + WS_POS);
    constexpr int RB = 4, NH = NEXP / 2, LOGH = LOG_NEXP - 1;
    const int myexp = ((lane & 1) * NH) | ((lane >> (6 - LOGH)) & (NH - 1));
    const float myb = rb[myexp];
    for (int r0 = gw; r0 < nr; r0 += RB * NGW) {
        f32x4 v[RB][4]; int rr[RB]; bool ok[RB];
#pragma unroll
        for (int i = 0; i < RB; ++i) { const int r = r0 + i * NGW; ok[i] = r < nr; rr[i] = ok[i] ? r : r0; const float* xr = x_out_row(F, mb, rr[i]);
#pragma unroll
            for (int j = 0; j < 4; ++j) v[i][j] = *((const f32x4*)xr + lane + 64 * j); }
        asm volatile("" ::: "memory");
#pragma unroll
        for (int i = 0; i < RB; ++i) {
            float s = 0.f;
#pragma unroll
            for (int j = 0; j < 4; ++j) s += (v[i][j][0] + v[i][j][1]) + (v[i][j][2] + v[i][j][3]);
            const float mean = wave_sum(s) * (1.0f / D); float s2 = 0.f;
#pragma unroll
            for (int j = 0; j < 4; ++j) { v[i][j] = v[i][j] - mean; s2 += (v[i][j][0] * v[i][j][0] + v[i][j][1] * v[i][j][1]) + (v[i][j][2] * v[i][j][2] + v[i][j][3] * v[i][j][3]); }
            const float rstd = 1.0f / sqrtf(wave_sum(s2) * (1.0f / D) + LN_EPS);
#pragma unroll
            for (int j = 0; j < 4; ++j) { const f32x4 gg = *((const f32x4*)lg + lane + 64 * j), bb = *((const f32x4*)lb + lane + 64 * j); v[i][j] = v[i][j] * rstd * gg + bb;
                if (ok[i]) { u32x2 w; w.x = pk2(v[i][j][0], v[i][j][1]); w.y = pk2(v[i][j][2], v[i][j][3]); *((u32x2*)(XB + (size_t)rr[i] * D) + lane + 64 * j) = w; } }
        }
        typedef float f32x2v __attribute__((ext_vector_type(2)));
        float val[RB];
#pragma unroll
        for (int hf = 0; hf < 2; ++hf) {
            float lgt[RB][NH];
#pragma unroll
            for (int e = 0; e < NH; ++e) { f32x2v a2[RB / 2];
#pragma unroll
                for (int i = 0; i < RB / 2; ++i) a2[i] = (f32x2v){0.f, 0.f};
#pragma unroll
                for (int j = 0; j < 4; ++j) { const f32x4 wv = *((const LAS f32x4*)(wT + (hf * NH + e) * D) + lane + 64 * j);
#pragma unroll
                    for (int c = 0; c < 4; ++c) { const f32x2v w2 = (f32x2v){wv[c], wv[c]};
#pragma unroll
                        for (int i = 0; i < RB / 2; ++i) a2[i] = __builtin_elementwise_fma((f32x2v){v[2 * i][j][c], v[2 * i + 1][j][c]}, w2, a2[i]); } }
#pragma unroll
                for (int i = 0; i < RB / 2; ++i) { lgt[2 * i][e] = a2[i].x; lgt[2 * i + 1][e] = a2[i].y; }
                if ((e & 1) == 1) asm volatile("" ::: "memory"); }
#pragma unroll
            for (int i = 0; i < RB; ++i) { RedStep<NH, 32>::run(lgt[i], lane); float tot = lgt[i][0];
                if constexpr ((32 >> LOGH) >= 8) tot += xshfl<8>(tot);
                if constexpr ((32 >> LOGH) >= 4) tot += xshfl<4>(tot);
                if constexpr ((32 >> LOGH) >= 2) tot += xshfl<2>(tot);
                tot += xshfl<1>(tot);
                if ((lane & 1) == hf) val[i] = tot + myb; }
        }
#pragma unroll
        for (int i = 0; i < RB; ++i) {
            float tv[4]; int te[4]; float vv = val[i];
#pragma unroll
            for (int k = 0; k < 4; ++k) { float m = vv; m = fmaxf(m, xshfl<1>(m)); m = fmaxf(m, xshfl<2>(m)); m = fmaxf(m, xshfl<4>(m)); m = fmaxf(m, xshfl<8>(m)); m = fmaxf(m, xshfl<16>(m)); m = fmaxf(m, xshfl<32>(m));
                const unsigned long long bal = __ballot(vv == m); const int wl = __builtin_ctzll(bal);
                const int be = ((wl & 1) * NH) | ((wl >> (6 - LOGH)) & (NH - 1));
                tv[k] = m; te[k] = be; if (myexp == be) vv = -3.0e38f; }
            const float e1 = fexp(tv[1] - tv[0]), e2 = fexp(tv[2] - tv[0]), e3 = fexp(tv[3] - tv[0]); const float inv = 1.0f / (1.0f + e1 + e2 + e3);
            if (lane < 4 && ok[i]) { const int e = lane == 0 ? te[0] : (lane == 1 ? te[1] : (lane == 2 ? te[2] : te[3])); const float gv = (lane == 0 ? 1.0f : (lane == 1 ? e1 : (lane == 2 ? e2 : e3))) * inv;
                const unsigned rk = __hip_atomic_fetch_add(lcnt + e, 1u, __ATOMIC_RELAXED, __HIP_MEMORY_SCOPE_WORKGROUP);
                topi[(size_t)rr[i] * 4 + lane] = e; gate[(size_t)rr[i] * 4 + lane] = gv; pos[(size_t)rr[i] * 4 + lane] = (int)rk; }
        }
    }
    __syncthreads();
    if (F.tid < NEXP) lcnt[32 + F.tid] = __hip_atomic_fetch_add(cnt + F.tid, lcnt[F.tid], __ATOMIC_RELAXED, __HIP_MEMORY_SCOPE_AGENT);
    __syncthreads();
    for (int r = gw; r < nr; r += NGW) if (lane < 4) pos[(size_t)r * 4 + lane] += (int)lcnt[32 + topi[(size_t)r * 4 + lane]];
}
__device__ __forceinline__ int moe_table(const Frame& F, int layer, int mb) {
    LAS int* M = (LAS int*)(F.lds + MISC_OFF);
    __syncthreads();
    if (F.tid == 0) { unsigned* cnt = F.ctl + CW_CNT + (mb * DEPTH + layer) * 64; int acc = 0;
        for (int e = 0; e < NEXP; ++e) { const int c = (int)__hip_atomic_load(cnt + e, __ATOMIC_RELAXED, __HIP_MEMORY_SCOPE_AGENT); M[64 + e] = acc * 256; acc += (c + 255) / 256; M[16 + e] = acc; } }
    __syncthreads();
    return M[16 + NEXP - 1];
}
__device__ __forceinline__ void step_gather(const Frame& F, int layer, int mb) {
    (void)moe_table(F, layer, mb); const LAS int* M = (const LAS int*)(F.lds + MISC_OFF);
    const int nr = rows_of(mb);
    const int* topi = (const int*)(F.ws + WS_TOPI); const float* gate = ws_f(F, WS_GATE); int* pos = (int*)(F.ws + WS_POS); float* gs = ws_f(F, WS_GSORT); int* rtok = (int*)(F.ws + WS_RTOK);
#pragma nounroll
    for (int i = F.bid * NTHREADS + F.tid; i < nr * 4; i += F.G * NTHREADS) { const int p = M[64 + topi[i]] + pos[i]; pos[i] = p; rtok[p] = i >> 2; gs[p] = gate[i]; }
}
__device__ __forceinline__ void step_ln2(const Frame& F, int layer, int mb) {
    const int gw = F.bid * NWAVES + F.wave, NGW = F.G * NWAVES, nr = rows_of(mb), lane = F.lane;
    const float* lg = F.in[I_LN2G] + (size_t)layer * D; const float* lb = F.in[I_LN2B] + (size_t)layer * D;
    const bf16_t* OUTS = ws_bf(F, WS_H) + (size_t)2 * RP * D; const int* pos = (const int*)(F.ws + WS_POS); bf16_t* XB = ws_bf(F, WS_XB);
    constexpr int RB = 2;
    for (int r0 = gw; r0 < nr; r0 += RB * NGW) {
        f32x4 v[RB][4]; u32x2 ow[RB][4][4]; int rr[RB];
#pragma unroll
        for (int i = 0; i < RB; ++i) { rr[i] = r0 + i * NGW < nr ? r0 + i * NGW : r0; const u32x2* xr = (const u32x2*)(XB + (size_t)rr[i] * D); int p[4];
#pragma unroll
            for (int k = 0; k < 4; ++k) p[k] = pos[(size_t)rr[i] * 4 + k];
#pragma unroll
            for (int j = 0; j < 4; ++j) { { const u32x2 w = xr[lane + 64 * j]; v[i][j] = (f32x4){blo(w.x), bhi(w.x), blo(w.y), bhi(w.y)}; }
#pragma unroll
                for (int k = 0; k < 4; ++k) ow[i][k][j] = *((const u32x2*)(OUTS + (size_t)p[k] * D) + lane + 64 * j); } }
        asm volatile("" ::: "memory");
#pragma unroll
        for (int i = 0; i < RB; ++i) { if (r0 + i * NGW >= nr) continue;
            float* xr = x_out_row(F, mb, rr[i]); float s = 0.f;
#pragma unroll
            for (int j = 0; j < 4; ++j) { v[i][j] = v[i][j] * ALPHA;
#pragma unroll
                for (int k = 0; k < 4; ++k) { const u32x2 w = ow[i][k][j]; v[i][j] = v[i][j] + (f32x4){blo(w.x), bhi(w.x), blo(w.y), bhi(w.y)}; }
                s += (v[i][j][0] + v[i][j][1]) + (v[i][j][2] + v[i][j][3]); }
            const float mean = wave_sum(s) * (1.0f / D); float s2 = 0.f;
#pragma unroll
            for (int j = 0; j < 4; ++j) { v[i][j] = v[i][j] - mean; s2 += (v[i][j][0] * v[i][j][0] + v[i][j][1] * v[i][j][1]) + (v[i][j][2] * v[i][j][2] + v[i][j][3] * v[i][j][3]); }
            const float rstd = 1.0f / sqrtf(wave_sum(s2) * (1.0f / D) + LN_EPS);
#pragma unroll
            for (int j = 0; j < 4; ++j) { const f32x4 gg = *((const f32x4*)lg + lane + 64 * j), bb = *((const f32x4*)lb + lane + 64 * j); v[i][j] = v[i][j] * rstd * gg + bb;
                *((f32x4*)xr + lane + 64 * j) = v[i][j]; u32x2 w; w.x = pk2(v[i][j][0], v[i][j][1]); w.y = pk2(v[i][j][2], v[i][j][3]); *((u32x2*)(XB + (size_t)rr[i] * D) + lane + 64 * j) = w; } }
    }
}

constexpr int PH_PER = 11, NSTEPS = 1 + NMB * DEPTH * PH_PER;
__global__ void __launch_bounds__(NTHREADS, 2) fwd(Args args) {
#ifdef EMU
    unsigned char* lds = emu_wg->lds;
#else
    extern __shared__ __attribute__((aligned(16))) unsigned char lds[];
#endif
    Frame F0; F0.lds = (LAS unsigned char*)lds; F0.tid = threadIdx.x; F0.lane = F0.tid & 63; F0.wave = __builtin_amdgcn_readfirstlane(F0.tid >> 6); F0.G = gridDim.x; F0.bid = blockIdx.x;
#ifdef EMU
    F0.in = args.in;
#else
    F0.in = (ArgTab)__builtin_amdgcn_kernarg_segment_ptr();
    static_assert(offsetof(Args, out) == 248 && offsetof(Args, ws) == 256 && offsetof(Args, in) == 0, "PF() reads the argument struct by offset");
#endif
    F0.out = args.out; F0.ws = args.ws; F0.ctl = (unsigned*)(args.ws + WS_CTL);
    const Frame& F = F0;
    const int lo = args.lo, hi = args.hi;
#ifndef EMU
    for (int u = F.tid; u < (LDS_BYTES - MISC_OFF) / 4; u += NTHREADS) ((LAS unsigned*)(F.lds + MISC_OFF))[u] = 0u;
    __syncthreads();
    XcdBarrier bar; bar.bar = F.ctl + CW_BAR; bar.x = 0; bar.st = nullptr;
    if (hi - lo > 1) bar = xcd_barrier_post(F.ctl + CW_BAR, (volatile LAS unsigned*)(F.lds + MISC_OFF) + 8);
#define SEAM(s) do { if ((s) + 1 < hi) { XcdBarrier b2_ = bar; unsigned long long bp_ = (unsigned long long)b2_.bar; asm volatile("" : "+s"(bp_)); b2_.bar = (unsigned*)bp_; xcd_barrier(b2_); } } while (0)
#else
#define SEAM(s) do { } while (0)
#endif
#ifndef PH_MASK
#define PH_MASK 0xFFFFFFFF
#endif
#define IN(s) (lo <= (s) && (s) < hi)
#define PHON(b) ((PH_MASK >> (b)) & 1)
#ifdef EMU
#define PF(Fp) Frame Fp = F0
#else
#define PF(Fp) Frame Fp; { unsigned long long kp_ = (unsigned long long)__builtin_amdgcn_kernarg_segment_ptr(); asm volatile("" : "+s"(kp_)); \
    Fp.in = (ArgTab)kp_; Fp.out = *(float* const __attribute__((address_space(4)))*)(kp_ + 248); Fp.ws = *(unsigned char* const __attribute__((address_space(4)))*)(kp_ + 256); Fp.ctl = (unsigned*)Fp.ws; \
    Fp.lds = F0.lds; Fp.G = F0.G; Fp.bid = F0.bid; Fp.wave = F0.wave; Fp.lane = opq(lane_id()); Fp.tid = Fp.wave * 64 + Fp.lane; }
#endif
    int step = 0;
    if (IN(step)) { PROBE_T0(0) if constexpr (PHON(0)) { PF(F); step_weights(F); for (int m = 0; m < NMB; ++m) step_xb(F, m); } PROBE_T1(0) SEAM(step); }
    ++step;
#define PHV const int mb = opqs(mb0), layer = opqs(layer0), nr = rows_of(mb); (void)nr; (void)layer
    for (int mb0 = 0; mb0 < NMB; ++mb0)
        for (int layer0 = 0; layer0 < DEPTH; ++layer0) {
            if (IN(step)) { PROBE_T0(2) if constexpr (PHON(2)) { PF(F); PHV; pg8::Gemm g{layer == 0 ? ws_bf(F, WS_XB0) + (size_t)mb * R * D : ws_bf(F, WS_XB), wl_ptr(F, layer, WL_IN), nr, DINP, D, D, nullptr}; pg8::StaticOrder S; S.init(nr, DINP, F.G, F.bid, 2);
                pg8::EpiStoreBf16 E{ws_bf(F, WS_H), DINP}; pg8::gemm_phase(F.lds, g, S, E, F.wave); } PROBE_T1(2) SEAM(step); }
            ++step;
            if (IN(step)) { PROBE_T0(13) if constexpr (PHON(13)) { PF(F); PHV; step_premix(F, layer, mb); } PROBE_T1(13) SEAM(step); }
            ++step;
            if (IN(step)) { PROBE_T0(3) if constexpr (PHON(3)) { PF(F); PHV; step_mixers(F, layer, mb); } PROBE_T1(3) SEAM(step); }
            ++step;
            if (IN(step)) { PROBE_T0(4) if constexpr (PHON(4)) { PF(F); PHV; step_gnorm(F, mb); } PROBE_T1(4) SEAM(step); }
            ++step;
            if (IN(step)) { PROBE_T0(5) if constexpr (PHON(5)) { PF(F); PHV; pg8::StaticOrder S; S.init(nr, D, F.G, F.bid); bf16_t* H = ws_bf(F, WS_H); bf16_t* MGb = ws_bf(F, WS_XB);
#ifndef MERGE_MASK
#define MERGE_MASK 7
#endif
                if constexpr (MERGE_MASK & 1) { pg8::Gemm g{H + C_Z, wl_ptr(F, layer, WL_SSD), nr, D, DINNER, DINP, nullptr}; pg8::EpiGate<0> E{H + C_GSSD, MGb}; pg8::gemm_phase(F.lds, g, S, E, F.wave); }
                if constexpr (MERGE_MASK & 2) { pg8::Gemm g{H + C_Q, wl_ptr(F, layer, WL_ATT), nr, D, D, DINP, nullptr}; pg8::EpiGate<1> E{H + C_GATT, MGb}; pg8::gemm_phase(F.lds, g, S, E, F.wave); }
                if constexpr (MERGE_MASK & 4) { pg8::Gemm g{H + C_SCB, wl_ptr(F, layer, WL_SC), nr, D, D, DINP, nullptr}; pg8::EpiGate<1> E{H + C_GSC, MGb}; pg8::gemm_phase(F.lds, g, S, E, F.wave); } }
                PROBE_T1(5) SEAM(step); }
            ++step;
            if (IN(step)) { PROBE_T0(6) if constexpr (PHON(6)) { PF(F); PHV; pg8::Gemm g{ws_bf(F, WS_XB), wl_ptr(F, layer, WL_O), nr, D, D, D, nullptr}; pg8::StaticOrder S; S.init(nr, D, F.G, F.bid);
                pg8::EpiResid E{layer == 0 ? F.in[I_XP] + (size_t)mb * NP * D : F.out + O_YP + (size_t)mb * NP * D, layer == 0 ? F.in[I_XS] : F.out + O_YS, F.out + O_YP + (size_t)mb * NP * D, F.out + O_YS};
                pg8::gemm_phase(F.lds, g, S, E, F.wave); } PROBE_T1(6) SEAM(step); }
            ++step;
            if (IN(step)) { PROBE_T0(7) if constexpr (PHON(7)) { PF(F); PHV; step_ln1_router(F, layer, mb); } PROBE_T1(7) SEAM(step); }
            ++step;
            if (IN(step)) { PROBE_T0(8) if constexpr (PHON(8)) { PF(F); PHV; step_gather(F, layer, mb); } PROBE_T1(8) SEAM(step); }
            ++step;
            if (IN(step)) { PROBE_T0(9) if constexpr (PHON(9)) { PF(F); PHV; const int nt = moe_table(F, layer, mb); pg8::MoeOrder S{(const LAS int*)(F.lds + MISC_OFF) + 16, 8, nt * 8, F.G, F.bid};
                pg8::Gemm g{ws_bf(F, WS_XB), wl_ptr(F, layer, WL_UP), nr  , 2048, D, D, (const int*)(F.ws + WS_RTOK)}; pg8::EpiSwiglu E{ws_bf(F, WS_H) + (size_t)RP * D, F.in[I_BUP] + (size_t)layer * NEXP * 2048};
                pg8::gemm_phase<pg8::EpiSwiglu, pg8::MoeOrder, true>(F.lds, g, S, E, F.wave); } PROBE_T1(9) SEAM(step); }
            ++step;
            if (IN(step)) { PROBE_T0(10) if constexpr (PHON(10)) { PF(F); PHV; const int nt = moe_table(F, layer, mb); pg8::MoeOrder S{(const LAS int*)(F.lds + MISC_OFF) + 16, 4, nt * 4, F.G, F.bid};
                pg8::Gemm g{ws_bf(F, WS_H) + (size_t)RP * D, wl_ptr(F, layer, WL_DN), nt * 256, D, D, D, nullptr}; pg8::EpiDown E{ws_bf(F, WS_H) + (size_t)2 * RP * D, F.in[I_BDN] + (size_t)layer * NEXP * D, ws_f(F, WS_GSORT)};
                pg8::gemm_phase(F.lds, g, S, E, F.wave); } PROBE_T1(10) SEAM(step); }
            ++step;
            if (IN(step)) { PROBE_T0(11) if constexpr (PHON(11)) { PF(F); PHV; step_ln2(F, layer, mb); } PROBE_T1(11) SEAM(step); }
            ++step;
        }
}

#ifdef EMU
extern int emu_grid, emu_step_lo, emu_step_hi;
#endif
extern "C" void kernel_launch(void* const* d_in, const int* in_sizes, int n_in, void* d_out, int out_size, void* d_ws, size_t ws_size, hipStream_t stream) {
    (void)in_sizes; (void)out_size;
    if (n_in != 31 || ws_size < WS_END) { fprintf(stderr, "kernel_launch: expected 31 inputs and >= %zu bytes of workspace (got %d, %zu)\n", (size_t)WS_END, n_in, ws_size); return; }
    Args a; memset(&a, 0, sizeof(a));
    for (int i = 0; i < 31; ++i) a.in[i] = (const float*)d_in[i];
    a.out = (float*)d_out; a.ws = (unsigned char*)d_ws;
#ifdef EMU
    if (emu_step_lo == 0) memset((char*)d_ws + WS_CTL, 0, CTL_BYTES);
    for (int s = emu_step_lo; s < emu_step_hi && s < NSTEPS; ++s) { a.lo = s; a.hi = s + 1; emu_launch(fwd, emu_grid, NTHREADS, LDS_BYTES, a); fprintf(stderr, "step %d done\n", s); }
#else
    (void)hipMemsetAsync((char*)d_ws + WS_CTL, 0, CTL_BYTES, stream);
    static int grid = 0;
    if (grid == 0) {
        int dev = 0, cus = 0;
        if (hipGetDevice(&dev) != hipSuccess || hipDeviceGetAttribute(&cus, hipDeviceAttributeMultiprocessorCount, dev) != hipSuccess) { grid = -1; return; }
        if (hipFuncSetAttribute((const void*)fwd, hipFuncAttributeMaxDynamicSharedMemorySize, LDS_BYTES) != hipSuccess) { grid = -1; return; }
        int per_cu = 0; (void)hipOccupancyMaxActiveBlocksPerMultiprocessor(&per_cu, (const void*)fwd, NTHREADS, LDS_BYTES); (void)hipGetLastError();
        grid = cus / 64 * 64;
        if (grid < 64) { grid = -1; return; }
    }
    if (grid < 0) return;
#if CFG_ONE_LAUNCH
    a.lo = 0; a.hi = NSTEPS; hipLaunchKernelGGL(fwd, dim3(grid), dim3(NTHREADS), LDS_BYTES, stream, a);
#else
    for (int s = 0; s < NSTEPS; ++s) { a.lo = s; a.hi = s + 1; hipLaunchKernelGGL(fwd, dim3(grid), dim3(NTHREADS), LDS_BYTES, stream, a); }
#endif
#endif
}
```

```cpp
#ifdef EMU
#include "emu.h"
#else
#include <hip/hip_runtime.h>
#endif
#include <cstdio>
#include <cstdint>
#include <cstring>
#include <cstddef>
#include <cmath>

#ifndef CFG_BATCH
#define CFG_BATCH 16
#endif
#ifndef CFG_SEQ
#define CFG_SEQ 4096
#endif
#ifndef CFG_NSEQ_MB
#define CFG_NSEQ_MB 8
#endif
#ifndef CFG_NEXP
#define CFG_NEXP 32
#endif
#ifndef CFG_ONE_LAUNCH
#define CFG_ONE_LAUNCH 1
#endif

constexpr int BATCH = CFG_BATCH, SEQ = CFG_SEQ, NSEQ_MB = CFG_NSEQ_MB, NEXP = CFG_NEXP, NMB = BATCH / NSEQ_MB;
constexpr int D = 1024, DEPTH = 2, DECB = 16, DECS = 16, NS = DECB * DECS;
constexpr int DINNER = 2048, CONVDIM = 4096;
constexpr int NKV = 4, WINDOW = 128, CHUNK = 64;
constexpr int DIN = 13856, DINP = 14080;
constexpr int NP = NSEQ_MB * SEQ, R = NP + NS;
constexpr int RP = ((4 * R + NEXP * 255) + 255) / 256 * 256;
constexpr int NCHUNK = SEQ / CHUNK;
constexpr int C_Z = 0, C_X = 2048, C_B = 4096, C_C = 5120, C_Q = 6144, C_K = 7168, C_V = 7424, C_SCB = 7680, C_SCC = 8704, C_SCH = 9728, C_GSSD = 10752, C_GATT = 11776, C_GSC = 12800, C_DT = 13824;
constexpr float LN_EPS = 1e-5f, ALPHA = 1.41421356237309515f  , SW_LIMIT = 7.0f, SW_ALPHA = 1.702f;
static_assert(BATCH % NSEQ_MB == 0 && SEQ % 256 == 0 && (NEXP & (NEXP - 1)) == 0 && NEXP <= 32 && NEXP >= 4, "config");

constexpr size_t O_YP = 0, O_YS = O_YP + (size_t)BATCH * SEQ * D, O_KP = O_YS + (size_t)NS * D, O_VP = O_KP + (size_t)DEPTH * BATCH * WINDOW * 256,
    O_SSP = O_VP + (size_t)DEPTH * BATCH * WINDOW * 256, O_CVP = O_SSP + (size_t)DEPTH * BATCH * 32 * 64 * 128, O_SCP = O_CVP + (size_t)DEPTH * BATCH * 3 * CONVDIM,
    O_KS = O_SCP + (size_t)DEPTH * BATCH * 2 * D, O_VS = O_KS + (size_t)DEPTH * DECB * DECS * 256, O_SSS = O_VS + (size_t)DEPTH * DECB * DECS * 256,
    O_CVS = O_SSS + (size_t)DEPTH * DECB * 32 * 64 * 128, O_SCS = O_CVS + (size_t)DEPTH * DECB * 3 * CONVDIM, O_END = O_SCS + (size_t)DEPTH * DECB * 2 * D;

constexpr size_t al256(size_t x) { return (x + 255) / 256 * 256; }
constexpr size_t WS_CTL = 0, CTL_BYTES = 1u << 20;
constexpr size_t WS_SSQ = CTL_BYTES, WS_TOPI = WS_SSQ + al256((size_t)R * 64 * 4), WS_GATE = WS_TOPI + al256((size_t)R * 16), WS_POS = WS_GATE + al256((size_t)R * 16),
    WS_GSORT = WS_POS + al256((size_t)R * 16), WS_RTOK = WS_GSORT + al256((size_t)RP * 4), WS_W = WS_RTOK + al256((size_t)RP * 4);
constexpr size_t WL_IN = 0, WL_SSD = WL_IN + (size_t)DINP * D * 2, WL_ATT = WL_SSD + (size_t)D * DINNER * 2, WL_SC = WL_ATT + (size_t)D * D * 2, WL_O = WL_SC + (size_t)D * D * 2,
    WL_UP = WL_O + (size_t)D * D * 2, WL_DN = WL_UP + (size_t)NEXP * 2048 * D * 2, WL_BYTES = WL_DN + (size_t)NEXP * D * D * 2;
constexpr size_t WS_XB = WS_W + DEPTH * WL_BYTES, WS_XB0 = WS_XB + (size_t)R * D * 2  , WS_PRE = WS_XB0 + (size_t)NMB * R * D * 2  , WS_H = WS_PRE + (size_t)R * D * 2;
constexpr size_t H_BYTES = (size_t)R * DINP * 2, MOE_BYTES = (size_t)3 * RP * D * 2, U_BYTES = H_BYTES > MOE_BYTES ? H_BYTES : MOE_BYTES;
constexpr size_t WS_CMC = WS_H + U_BYTES, WS_BTG = WS_CMC + (size_t)NP * 1024 * 2, WS_CBG = WS_BTG + (size_t)NSEQ_MB * NCHUNK * 8 * 8192 * 2, WS_END = WS_CBG + (size_t)NSEQ_MB * NCHUNK * 8 * 4096 * 2;
static_assert(WS_END <= ((size_t)2 << 30), "workspace map exceeds 2 GiB");
constexpr int CW_BAR = 4096, CW_CNT = 16384;

constexpr int RING_BYTES = 131072, LDS_BYTES = 163840  , MISC_OFF = LDS_BYTES - 1024, SCR_BYTES = MISC_OFF;
constexpr int NWAVES = 8, NTHREADS = 512;

#ifdef EMU
#define LAS
#define WAVE_SYNC() emu_wave_barrier()
#else
#define LAS __attribute__((address_space(3)))
#define WAVE_SYNC() asm volatile("s_waitcnt lgkmcnt(0)" ::: "memory")
#endif
#ifdef EMU
#define LBAR() emu_wg_barrier()
#define VM_WAIT(n) do { } while (0)
#else
#define LBAR() do { asm volatile("s_waitcnt lgkmcnt(0)" ::: "memory"); __builtin_amdgcn_s_barrier(); asm volatile("" ::: "memory"); } while (0)
#define VM_WAIT(n) asm volatile("s_waitcnt vmcnt(" #n ")" ::: "memory")
#endif
typedef unsigned short bf16_t;
typedef short bf16x8 __attribute__((ext_vector_type(8)));
typedef float f32x4 __attribute__((ext_vector_type(4)));
typedef float f32x16 __attribute__((ext_vector_type(16)));
typedef unsigned u32x4 __attribute__((ext_vector_type(4)));
typedef unsigned u32x2 __attribute__((ext_vector_type(2)));

__device__ __forceinline__ unsigned f2bf(float f) { unsigned u = __builtin_bit_cast(unsigned, f); return (u + 0x7fffu + ((u >> 16) & 1u)) >> 16; }
__device__ __forceinline__ float bf2f(unsigned h) { return __builtin_bit_cast(float, (h & 0xffffu) << 16); }
#ifdef EMU
__device__ __forceinline__ unsigned pk2(float lo, float hi) { return f2bf(lo) | (f2bf(hi) << 16); }
#else
typedef float f32x2_t __attribute__((ext_vector_type(2))); typedef __bf16 bf16x2_t __attribute__((ext_vector_type(2)));
__device__ __forceinline__ unsigned pk2(float lo, float hi) { f32x2_t v = {lo, hi}; bf16x2_t b = __builtin_convertvector(v, bf16x2_t); return __builtin_bit_cast(unsigned, b); }
#endif
#ifdef EMU
__device__ __forceinline__ unsigned short bf1(float f) { return (unsigned short)f2bf(f); }
#else
__device__ __forceinline__ unsigned short bf1(float f) { return (unsigned short)pk2(f, f); }
#endif
__device__ __forceinline__ float blo(unsigned w) { return __builtin_bit_cast(float, w << 16); }
__device__ __forceinline__ float bhi(unsigned w) { return __builtin_bit_cast(float, w & 0xffff0000u); }
__device__ __forceinline__ void unpack8(const u32x4 w, float* f) { f[0] = blo(w.x); f[1] = bhi(w.x); f[2] = blo(w.y); f[3] = bhi(w.y); f[4] = blo(w.z); f[5] = bhi(w.z); f[6] = blo(w.w); f[7] = bhi(w.w); }
__device__ __forceinline__ u32x4 pack8(const float* f) { u32x4 w; w.x = pk2(f[0], f[1]); w.y = pk2(f[2], f[3]); w.z = pk2(f[4], f[5]); w.w = pk2(f[6], f[7]); return w; }
__device__ __forceinline__ float fexp(float x) { return __builtin_amdgcn_exp2f(x * 1.4426950408889634f); }
__device__ __forceinline__ float fsigmoid(float x) { return __builtin_amdgcn_rcpf(1.0f + __builtin_amdgcn_exp2f(-1.4426950408889634f * x)); }
__device__ __forceinline__ float fsilu(float x) { return x * fsigmoid(x); }
#ifdef EMU
__device__ __forceinline__ int opq(int x) { return x; }
#else
__device__ __forceinline__ int opq(int x) { asm volatile("" : "+v"(x)); return x; }
#endif
#ifdef EMU
__device__ __forceinline__ int opqs(int x) { return x; }
#else
__device__ __forceinline__ int opqs(int x) { asm volatile("" : "+s"(x)); return x; }
#endif
#ifdef EMU
__device__ __forceinline__ int lane_id() { return (int)(threadIdx.x & 63); }
#else
__device__ __forceinline__ int lane_id() { return (int)__builtin_amdgcn_mbcnt_hi(~0u, __builtin_amdgcn_mbcnt_lo(~0u, 0u)); }
#endif
#ifdef EMU
template <int MASK> __device__ __forceinline__ unsigned xshfl_u(unsigned x) { return __shfl_xor(x, MASK); }
#else
template <int MASK> __device__ __forceinline__ unsigned xshfl_u(unsigned x) {
    if constexpr (MASK == 1) return (unsigned)__builtin_amdgcn_update_dpp((int)x, (int)x, 0xB1, 0xF, 0xF, false);
    else if constexpr (MASK == 2) return (unsigned)__builtin_amdgcn_update_dpp((int)x, (int)x, 0x4E, 0xF, 0xF, false);
    else if constexpr (MASK == 4) { const int t = __builtin_amdgcn_update_dpp((int)x, (int)x, 0x114, 0xF, 0xA, false);
        return (unsigned)__builtin_amdgcn_update_dpp(t, (int)x, 0x104, 0xF, 0x5, false); }
    else if constexpr (MASK == 8) return (unsigned)__builtin_amdgcn_update_dpp((int)x, (int)x, 0x128, 0xF, 0xF, false);
    else if constexpr (MASK == 16) { const auto rr = __builtin_amdgcn_permlane16_swap(x, x, false, false); return (lane_id() & 16) ? rr[0] : rr[1]; }
    else { const auto rr = __builtin_amdgcn_permlane32_swap(x, x, false, false); return (lane_id() & 32) ? rr[0] : rr[1]; }
}
#endif
template <int MASK> __device__ __forceinline__ float xshfl(float x) { return __builtin_bit_cast(float, xshfl_u<MASK>(__builtin_bit_cast(unsigned, x))); }
template <int MASK> __device__ __forceinline__ int xshfl(int x) { return (int)xshfl_u<MASK>((unsigned)x); }
__device__ __forceinline__ float wave_sum(float v) { v += xshfl<1>(v); v += xshfl<2>(v); v += xshfl<4>(v); v += xshfl<8>(v); v += xshfl<16>(v); v += xshfl<32>(v); return v; }

#ifndef PROBE_MASK
#define PROBE_MASK 0
#endif
#if PROBE_MASK && !defined(EMU)
#define PROBE_T0(b) unsigned long long pt0_ = 0; if constexpr ((PROBE_MASK >> (b)) & 1) pt0_ = __builtin_amdgcn_s_memrealtime();
#define PROBE_T1(b) if constexpr ((PROBE_MASK >> (b)) & 1) { asm volatile("s_waitcnt vmcnt(0) lgkmcnt(0)" ::: "memory"); const unsigned long long pt1_ = __builtin_amdgcn_s_memrealtime(); \
    while (__builtin_amdgcn_s_memrealtime() < pt1_ + (pt1_ - pt0_)) __builtin_amdgcn_s_sleep(8); }
#else
#define PROBE_T0(b)
#define PROBE_T1(b)
#endif
namespace pg8 {
constexpr int BM = 256, BK = 64, HALF = 128, HTB = HALF * BK * 2, NXCD = 8, WGM = 8;
struct Unit { int pm, pn, bt, e; };
struct Gemm { const bf16_t* A; const bf16_t* Bt; int M, N, K, lda; const int* tok; };
struct StaticOrder {
    int nM, nN, nwg, G, c, wgm;
    __host__ __device__ void init(int M, int N, int G_, int c_, int wgm_ = WGM) { nM = M / BM; nN = N / BM; nwg = nM * nN; G = G_; c = c_; wgm = wgm_; }
    __host__ __device__ bool next(int i, Unit& u) const {
        const long L = (long)i * G + c; if (L >= nwg) return false;
        int wgid = (int)L; { const int q = nwg / NXCD, r = nwg % NXCD, xcd = wgid % NXCD, off = wgid / NXCD; wgid = (xcd < r ? xcd * (q + 1) : r * (q + 1) + (xcd - r) * q) + off; }
        const int nig = wgm * nN, gid = wgid / nig, fm = gid * wgm, gsz = (nM - fm) < wgm ? (nM - fm) : wgm;
        u.pm = fm + ((wgid % nig) % gsz); u.pn = (wgid % nig) / gsz; u.bt = u.pn; u.e = 0; return true;
    }
    __device__ __forceinline__ void a_ready(const Unit&) const {}
    __device__ __forceinline__ void done(const Unit&) const {}
};
struct MoeOrder {
    const LAS int* tend; int npn, ntot, G, c;
    __device__ __forceinline__ bool next(int i, Unit& u) const {
        int rt, pn;
        {
            const int xcd = c & 7, j = c >> 3, rpx = (G >> 3) / npn; rt = (i * 8 + xcd) * rpx + j / npn; pn = j % npn; if (rt >= ntot / npn) return false; }
        int e = 0;
#pragma unroll
        for (int j = 0; j < NEXP; ++j) e += (tend[j] <= rt) ? 1 : 0;
        u.pm = rt; u.pn = pn; u.e = e; u.bt = e * npn + pn; return true;
    }
    __device__ __forceinline__ void a_ready(const Unit&) const {}
    __device__ __forceinline__ void done(const Unit&) const {}
};
#ifdef EMU
template <class Epi, class Sched, bool GATHER = false>
__device__ void gemm_phase(LAS unsigned char* lds, const Gemm g, const Sched& S, const Epi& E, int  ) {
    const int tid = threadIdx.x, wid = tid >> 6, lane = tid & 63, wr = wid >> 2, wc = wid & 3, fr = lane & 15, fq = lane >> 4;
    Unit u;
    for (int i = 0; S.next(i, u); ++i) {
        f32x4 acc[2][2][4][2];
        for (int ai = 0; ai < 2; ++ai) for (int bj = 0; bj < 2; ++bj) for (int m = 0; m < 4; ++m) for (int n = 0; n < 2; ++n) for (int q = 0; q < 4; ++q) {
            const int row = u.pm * 256 + ai * 128 + wr * 64 + m * 16 + fr, col = u.bt * 256 + bj * 128 + wc * 32 + 8 * fq + 4 * n + q;
            const bf16_t* a = g.A + (size_t)(GATHER ? ((unsigned)g.tok[row] < (unsigned)g.M ? g.tok[row] : 0) : row) * g.lda; const bf16_t* b = g.Bt + (size_t)col * g.K; float s = 0.f;
            for (int k = 0; k < g.K; ++k) s += bf2f(a[k]) * bf2f(b[k]);
            acc[ai][bj][m][n][q] = s; }
        E(acc, u, wr, wc, fr, fq);
    }
    __syncthreads();
}
#else
#define PG8_LAS __attribute__((address_space(3)))
__host__ __device__ __forceinline__ int lds_byte(int r, int c) { const int st = (r >> 4) * 2 + (c >> 5), rr = r & 15, cc = c & 31, ob = rr * 64 + cc * 2; return st * 1024 + (ob ^ (((ob >> 9) & 1) << 5)); }
__host__ __device__ __forceinline__ void stage_rc(int b, int& R_, int& C_) { const int st = b / 1024, sb = b % 1024, swz = sb ^ (((sb >> 9) & 1) << 5); R_ = (st >> 1) * 16 + swz / 64; C_ = (st & 1) * 32 + (swz % 64) / 2; }
__host__ __device__ __forceinline__ int perm32(int rho) { const int n = rho >> 4, i = rho & 15; return 8 * (i >> 2) + 4 * n + (i & 3); }
template <class Epi, class Sched, bool GATHER = false>
__device__ __forceinline__ void gemm_phase(PG8_LAS unsigned char* lds, const Gemm g, const Sched& S, const Epi& E, int wave_id) {
    const int lane = opq(lane_id()), wid = __builtin_amdgcn_readfirstlane(wave_id), tid = wid * 64 + lane, wr = wid >> 2, wc = wid & 3, fr = lane & 15, fq = lane >> 4;
    const int K = g.K, nt = K / BK, lda = g.lda;
    unsigned voffA[2], voffB[2];
#pragma unroll
    for (int i = 0; i < 2; ++i) { int R_, C_; stage_rc(tid * 16 + i * 8192, R_, C_); const int Rb = (R_ & ~31) + perm32(R_ & 31);
        voffA[i] = (unsigned)(R_ * lda + C_) * 2u; voffB[i] = (unsigned)(Rb * K + C_) * 2u; }
    unsigned vG[2][2], vN[2][2];
#define PG8_TOK(dst, pm_) do { _Pragma("unroll") for (int i_ = 0; i_ < 2; ++i_) { int R_, C_; stage_rc(opq(tid) * 16 + i_ * 8192, R_, C_); _Pragma("unroll") for (int h_ = 0; h_ < 2; ++h_) \
        { unsigned tk_ = (unsigned)g.tok[(pm_) * 256 + h_ * 128 + R_]; tk_ = tk_ < (unsigned)g.M ? tk_ : 0u; dst[h_][i_] = tk_ * (unsigned)(lda * 2) + (unsigned)(C_ * 2); } } } while (0)
#define PG8_STAGE_A(bufoff, base_, h_, nx_) do { if constexpr (GATHER) { unsigned vs_[2] = {(nx_) ? vN[h_][0] : vG[h_][0], (nx_) ? vN[h_][1] : vG[h_][1]}; PG8_STAGE(bufoff, base_, vs_); } \
        else { PG8_STAGE(bufoff, (base_) + ((h_) ? hstepA : 0), voffA); } } while (0)
    const size_t kstep = (size_t)(BK * 2);
    const size_t hstepA = (size_t)HALF * lda * 2, tstepA = 2 * hstepA;
    const size_t hstepB = (size_t)HALF * K * 2, tstepB = 2 * hstepB;
    const unsigned ldsw = (unsigned)wid * 1024u;
    const int aoff = lds_byte(wr * 64 + fr, fq * 8), boff = lds_byte(wc * 32 + fr, fq * 8);
#define PG8_SA(b, h) (((b) * 2 + (h)) * HTB)
#define PG8_SB(b, h) ((4 + (b) * 2 + (h)) * HTB)
#define PG8_STAGE(bufoff, gbase, voff) do { _Pragma("unroll") for (int _i = 0; _i < 2; ++_i) \
        __builtin_amdgcn_global_load_lds((const unsigned*)((const char*)(gbase) + (voff)[_i]), (PG8_LAS unsigned*)(lds + (bufoff) + ldsw + _i * 8192), 16, 0, 0); } while (0)
#define PG8_LDA(dst, b, h) do { _Pragma("unroll") for (int m = 0; m < 4; ++m) _Pragma("unroll") for (int k = 0; k < 2; ++k) dst[m][k] = *(const PG8_LAS bf16x8*)(lds + PG8_SA(b, h) + aoff + m * 2048 + k * 1024); } while (0)
#define PG8_LDB(dst, b, h) do { _Pragma("unroll") for (int n = 0; n < 2; ++n) _Pragma("unroll") for (int k = 0; k < 2; ++k) dst[n][k] = *(const PG8_LAS bf16x8*)(lds + PG8_SB(b, h) + boff + n * 2048 + k * 1024); } while (0)
#define PG8_MMA(ai, bj, At, Bt) do { __builtin_amdgcn_s_setprio(1); _Pragma("unroll") for (int m = 0; m < 4; ++m) _Pragma("unroll") for (int n = 0; n < 2; ++n) _Pragma("unroll") for (int k = 0; k < 2; ++k) \
        acc[ai][bj][m][n] = __builtin_amdgcn_mfma_f32_16x16x32_bf16(Bt[n][k], At[m][k], acc[ai][bj][m][n], 0, 0, 0); __builtin_amdgcn_s_setprio(0); } while (0)
#define PG8_WAIT_V(n) asm volatile("s_waitcnt vmcnt(" #n ")" ::: "memory")
#define PG8_WAIT_L(n) asm volatile("s_waitcnt lgkmcnt(" #n ")" ::: "memory")
#define PG8_BAR __builtin_amdgcn_s_barrier()
#define PG8_SCHED __builtin_amdgcn_sched_barrier(0)
    Unit cur, nxt; int ui = 0;
    if (!S.next(0, cur)) return;
    f32x4 acc[2][2][4][2];
#pragma unroll
    for (int a = 0; a < 2; ++a)
#pragma unroll
        for (int b = 0; b < 2; ++b)
#pragma unroll
            for (int m = 0; m < 4; ++m)
#pragma unroll
                for (int n = 0; n < 2; ++n) acc[a][b][m][n] = (f32x4){0.f, 0.f, 0.f, 0.f};
    bf16x8 At[4][2], B0[2][2], B1[2][2];
    const char* cA = (const char*)g.A + (GATHER ? (size_t)0 : (size_t)cur.pm * tstepA); const char* cB = (const char*)g.Bt + (size_t)cur.bt * tstepB;
    if constexpr (GATHER) { PG8_TOK(vG, cur.pm); }
    S.a_ready(cur);
    PG8_STAGE(PG8_SB(0, 0), cB, voffB); PG8_STAGE(PG8_SB(0, 1), cB + hstepB, voffB); PG8_STAGE_A(PG8_SA(0, 0), cA, 0, false); PG8_STAGE_A(PG8_SA(0, 1), cA, 1, false);
    if (wr == 1) PG8_BAR;
    PG8_WAIT_V(2); PG8_BAR;
    PG8_STAGE(PG8_SB(1, 0), cB + kstep, voffB); PG8_STAGE_A(PG8_SA(1, 0), cA + kstep, 0, false); PG8_STAGE(PG8_SB(1, 1), cB + hstepB + kstep, voffB);
    PG8_WAIT_V(6); PG8_BAR;
    for (;;) {
        const bool has_next = S.next(ui + 1, nxt);
        const char* nA = has_next ? (const char*)g.A + (GATHER ? (size_t)0 : (size_t)nxt.pm * tstepA) : cA; const char* nB = has_next ? (const char*)g.Bt + (size_t)nxt.bt * tstepB : cB;
        if constexpr (GATHER) {
#pragma unroll
            for (int h_ = 0; h_ < 2; ++h_) { vN[h_][0] = vG[h_][0]; vN[h_][1] = vG[h_][1]; }
            if (has_next) {
#pragma unroll
                for (int i_ = 0; i_ < 2; ++i_) { int R_, C_; stage_rc(opq(tid) * 16 + i_ * 8192, R_, C_);
#pragma unroll
                    for (int h_ = 0; h_ < 2; ++h_) { const int* tp_ = g.tok + nxt.pm * 256 + h_ * 128 + R_;
                        asm volatile("global_load_dword %0, %1, off" : "=v"(vN[h_][i_]) : "v"(tp_) : "memory"); } } } }
        for (int t = 0; t < nt; t += 2) {
            const bool last = (t == nt - 2);
            const char* a1 = cA + (size_t)(t + 1) * kstep;
            const char* a2 = last ? nA : cA + (size_t)(t + 2) * kstep; const char* b2 = last ? nB : cB + (size_t)(t + 2) * kstep;
            const char* a3 = a2 + kstep; const char* b3 = b2 + kstep;
            if (last && has_next) S.a_ready(nxt);
            if constexpr (GATHER) { if (last && has_next) {
#pragma unroll
                for (int i_ = 0; i_ < 2; ++i_) { int R_, C_; stage_rc(opq(tid) * 16 + i_ * 8192, R_, C_);
#pragma unroll
                    for (int h_ = 0; h_ < 2; ++h_) { unsigned tk_ = vN[h_][i_]; asm volatile("" : "+v"(tk_)); tk_ = tk_ < (unsigned)g.M ? tk_ : 0u; vN[h_][i_] = tk_ * (unsigned)(lda * 2) + (unsigned)(C_ * 2); } } } }
            PG8_LDB(B0, 0, 0); PG8_LDB(B1, 0, 1); PG8_SCHED; PG8_LDA(At, 0, 0); PG8_STAGE_A(PG8_SA(1, 1), a1, 1, false);
            PG8_WAIT_V(8); PG8_WAIT_L(0); PG8_BAR; PG8_MMA(0, 0, At, B0); PG8_MMA(0, 1, At, B1); PG8_BAR; PG8_SCHED;
            PG8_LDA(At, 0, 1); PG8_STAGE(PG8_SB(0, 0), b2, voffB); PG8_STAGE(PG8_SB(0, 1), b2 + hstepB, voffB); PG8_STAGE_A(PG8_SA(0, 0), a2, 0, last);
            PG8_WAIT_V(8); PG8_WAIT_L(0); PG8_BAR; PG8_MMA(1, 0, At, B0); PG8_MMA(1, 1, At, B1); PG8_BAR; PG8_SCHED;
            PG8_LDB(B0, 1, 0); PG8_LDB(B1, 1, 1); PG8_SCHED; PG8_LDA(At, 1, 0); PG8_STAGE_A(PG8_SA(0, 1), a2, 1, last);
            PG8_WAIT_V(8); PG8_WAIT_L(0); PG8_BAR; PG8_MMA(0, 0, At, B0); PG8_MMA(0, 1, At, B1); PG8_BAR; PG8_SCHED;
            PG8_LDA(At, 1, 1); PG8_STAGE(PG8_SB(1, 0), b3, voffB); PG8_STAGE(PG8_SB(1, 1), b3 + hstepB, voffB); PG8_STAGE_A(PG8_SA(1, 0), a3, 0, last);
            PG8_WAIT_V(8); PG8_WAIT_L(0); PG8_BAR; PG8_MMA(1, 0, At, B0); PG8_MMA(1, 1, At, B1); PG8_BAR; PG8_SCHED;
        }
        if (wr == 0) PG8_BAR;
        E(acc, cur, wr, wc, fr, fq); S.done(cur);
        if (!has_next) break;
#pragma unroll
        for (int a = 0; a < 2; ++a)
#pragma unroll
            for (int b = 0; b < 2; ++b)
#pragma unroll
                for (int m = 0; m < 4; ++m)
#pragma unroll
                    for (int n = 0; n < 2; ++n) acc[a][b][m][n] = (f32x4){0.f, 0.f, 0.f, 0.f};
        cur = nxt; cA = nA; cB = nB; ++ui;
        if constexpr (GATHER) {
#pragma unroll
            for (int h_ = 0; h_ < 2; ++h_) { vG[h_][0] = vN[h_][0]; vG[h_][1] = vN[h_][1]; } }
        if (wr == 1) PG8_BAR;
    }
    PG8_WAIT_V(0);
    PG8_BAR;
#undef PG8_SA
#undef PG8_SB
#undef PG8_STAGE
#undef PG8_STAGE_A
#undef PG8_TOK
#undef PG8_LDA
#undef PG8_LDB
#undef PG8_MMA
#undef PG8_WAIT_V
#undef PG8_WAIT_L
#undef PG8_BAR
#undef PG8_SCHED
}
#endif

struct EpiStoreBf16 {
    bf16_t* O; int ldc;
    __device__ __forceinline__ void operator()(const f32x4 (&acc)[2][2][4][2], const Unit& u, int wr, int wc, int fr, int fq) const {
        const int row0 = u.pm * 256 + wr * 64 + fr, col0 = u.pn * 256 + wc * 32 + 8 * fq;
#pragma unroll
        for (int ai = 0; ai < 2; ++ai)
#pragma unroll
            for (int m = 0; m < 4; ++m)
#pragma unroll
                for (int bj = 0; bj < 2; ++bj) { const f32x4 v0 = acc[ai][bj][m][0], v1 = acc[ai][bj][m][1];
                    u32x4 w; w.x = pk2(v0[0], v0[1]); w.y = pk2(v0[2], v0[3]); w.z = pk2(v1[0], v1[1]); w.w = pk2(v1[2], v1[3]);
                    *(u32x4*)(O + (size_t)(row0 + ai * 128 + m * 16) * ldc + col0 + bj * 128) = w; }
    }
};
template <int MODE> struct EpiGate {
    const bf16_t* Hg; bf16_t* MGb;
    __device__ __forceinline__ void operator()(const f32x4 (&acc)[2][2][4][2], const Unit& u, int wr, int wc, int fr, int fq) const {
        const int row0 = u.pm * 256 + wr * 64 + fr, col0 = u.pn * 256 + wc * 32 + 8 * fq;
#pragma unroll
        for (int ai = 0; ai < 2; ++ai) {
            u32x4 gw[4][2], pw[4][2];
#pragma unroll
            for (int m = 0; m < 4; ++m)
#pragma unroll
                for (int bj = 0; bj < 2; ++bj) { const int row = row0 + ai * 128 + m * 16, col = col0 + bj * 128;
                    gw[m][bj] = *(const u32x4*)(Hg + (size_t)row * DINP + col); if (MODE != 0) pw[m][bj] = *(const u32x4*)(MGb + (size_t)row * D + col); }
            asm volatile("" ::: "memory");
#pragma unroll
            for (int m = 0; m < 4; ++m)
#pragma unroll
                for (int bj = 0; bj < 2; ++bj) { const int row = row0 + ai * 128 + m * 16, col = col0 + bj * 128; const f32x4 v0 = acc[ai][bj][m][0], v1 = acc[ai][bj][m][1];
                    float g[8], p[8], v[8] = {v0[0], v0[1], v0[2], v0[3], v1[0], v1[1], v1[2], v1[3]}; unpack8(gw[m][bj], g);
                    if (MODE != 0) { unpack8(pw[m][bj], p);
#pragma unroll
                        for (int i = 0; i < 8; ++i) v[i] = p[i] + v[i] * fsigmoid(g[i]); }
                    else {
#pragma unroll
                        for (int i = 0; i < 8; ++i) v[i] = v[i] * fsigmoid(g[i]); }
                    *(u32x4*)(MGb + (size_t)row * D + col) = pack8(v); }
            asm volatile("" ::: "memory");
        }
    }
};
struct EpiResid {
    const float* xp; const float* xs; float* op; float* os;
    __device__ __forceinline__ void operator()(const f32x4 (&acc)[2][2][4][2], const Unit& u, int wr, int wc, int fr, int fq) const {
        const int row0 = u.pm * 256 + wr * 64 + fr, col0 = u.pn * 256 + wc * 32 + 8 * fq;
        const bool smp = u.pm * 256 >= NP;
        const float* xb = smp ? xs - (size_t)NP * D : xp; float* ob = smp ? os - (size_t)NP * D : op;
#pragma unroll
        for (int ai = 0; ai < 2; ++ai) {
            f32x4 xa[4][2][2];
#pragma unroll
            for (int m = 0; m < 4; ++m)
#pragma unroll
                for (int bj = 0; bj < 2; ++bj) { const float* xi = xb + (size_t)(row0 + ai * 128 + m * 16) * D + col0 + bj * 128; xa[m][bj][0] = *(const f32x4*)xi; xa[m][bj][1] = *(const f32x4*)(xi + 4); }
            asm volatile("" ::: "memory");
#pragma unroll
            for (int m = 0; m < 4; ++m)
#pragma unroll
                for (int bj = 0; bj < 2; ++bj) { float* xo = ob + (size_t)(row0 + ai * 128 + m * 16) * D + col0 + bj * 128;
                    *(f32x4*)xo = xa[m][bj][0] * ALPHA + acc[ai][bj][m][0]; *(f32x4*)(xo + 4) = xa[m][bj][1] * ALPHA + acc[ai][bj][m][1]; }
            asm volatile("" ::: "memory");
        }
    }
};
struct EpiSwiglu {
    bf16_t* ACT; const float* bup;
    __device__ __forceinline__ void operator()(const f32x4 (&acc)[2][2][4][2], const Unit& u, int wr, int wc, int fr, int fq) const {
        const int row0_ = u.pm * 256 + wr * 64 + fr, j0 = u.pn * 128 + wc * 32 + 8 * fq;
        const float* bg = bup + (size_t)u.e * 2048 + j0; const f32x4 bg0 = *(const f32x4*)bg, bg1 = *(const f32x4*)(bg + 4), bu0 = *(const f32x4*)(bg + 1024), bu1 = *(const f32x4*)(bg + 1028);
#pragma unroll
        for (int ai = 0; ai < 2; ++ai)
#pragma unroll
            for (int m = 0; m < 4; ++m) { const int row = row0_ + ai * 128 + m * 16;
                const f32x4 g0 = acc[ai][0][m][0] + bg0, g1 = acc[ai][0][m][1] + bg1, u0 = acc[ai][1][m][0] + bu0, u1 = acc[ai][1][m][1] + bu1; float o[8];
#pragma unroll
                for (int i = 0; i < 4; ++i) { const float ga = fminf(g0[i], SW_LIMIT), ua = fminf(fmaxf(u0[i], -SW_LIMIT), SW_LIMIT); o[i] = (ua + 1.0f) * ga * fsigmoid(SW_ALPHA * ga);
                    const float gb = fminf(g1[i], SW_LIMIT), ub = fminf(fmaxf(u1[i], -SW_LIMIT), SW_LIMIT); o[4 + i] = (ub + 1.0f) * gb * fsigmoid(SW_ALPHA * gb); }
                *(u32x4*)(ACT + (size_t)row * D + j0) = pack8(o); }
    }
};
struct EpiDown {
    bf16_t* O; const float* bdn; const float* gs;
    __device__ __forceinline__ void operator()(const f32x4 (&acc)[2][2][4][2], const Unit& u, int wr, int wc, int fr, int fq) const {
        const int row0 = u.pm * 256 + wr * 64 + fr, col0 = u.pn * 256 + wc * 32 + 8 * fq;
#pragma unroll
        for (int ai = 0; ai < 2; ++ai) {
            float gt[4];
#pragma unroll
            for (int m = 0; m < 4; ++m) gt[m] = gs[row0 + ai * 128 + m * 16];
#pragma unroll
            for (int bj = 0; bj < 2; ++bj) { const float* bp = bdn + (size_t)u.e * D + col0 + bj * 128; const f32x4 b0 = *(const f32x4*)bp, b1 = *(const f32x4*)(bp + 4);
#pragma unroll
                for (int m = 0; m < 4; ++m) { const f32x4 a0 = (acc[ai][bj][m][0] + b0) * gt[m], a1 = (acc[ai][bj][m][1] + b1) * gt[m];
                    u32x4 w; w.x = pk2(a0[0], a0[1]); w.y = pk2(a0[2], a0[3]); w.z = pk2(a1[0], a1[1]); w.w = pk2(a1[2], a1[3]);
                    *(u32x4*)(O + (size_t)(row0 + ai * 128 + m * 16) * D + col0 + bj * 128) = w; } }
            asm volatile("" ::: "memory");
        }
    }
};
}

#ifndef EMU
#define XB_TMO      128
#define XB_XCNT(j)  (256  + 64 * (j))
#define XB_XSUB(j)  (1280 + 64 * (j))
#define XB_XGEN(j)  (2304 + 64 * (j))
#define XB_TOP      3328
#define XB_TOPGEN   3392
#define XCD_BAR_WORDS 3456
#define XB_SPIN_CAP (1u << 27)
__device__ __forceinline__ unsigned xb_ld(unsigned* p)              { return __hip_atomic_load(p, __ATOMIC_RELAXED, __HIP_MEMORY_SCOPE_AGENT); }
__device__ __forceinline__ unsigned xb_add(unsigned* p, unsigned v) { return __hip_atomic_fetch_add(p, v, __ATOMIC_RELAXED, __HIP_MEMORY_SCOPE_AGENT); }
__device__ __forceinline__ unsigned xb_xcc_id() { return (unsigned)__builtin_amdgcn_s_getreg((3 << 11) | 20) & 0xFu; }
#define XB_SPIN(cond, bar) do { unsigned _sp = 0; while (cond) { __builtin_amdgcn_s_sleep(1); \
    if ((++_sp & 255u) == 0u) { if (xb_ld(&(bar)[XB_TMO])) break; if (_sp > XB_SPIN_CAP) { atomicAdd(&(bar)[XB_TMO], 1u); break; } } } } while (0)
struct XcdBarrier { unsigned* bar; unsigned x; volatile LAS unsigned* st; };
__device__ __forceinline__ XcdBarrier xcd_barrier_post(unsigned* bar, volatile LAS unsigned* st) {
    XcdBarrier b; b.bar = bar; b.x = xb_xcc_id(); b.st = st;
    if (threadIdx.x == 0) (void)xb_add(&bar[XB_XCNT(b.x)], 1u);
    return b;
}
__device__ __forceinline__ void xcd_barrier_complete(unsigned* bar, unsigned x, unsigned& nloc, unsigned& nx) {
    const unsigned G = gridDim.x * gridDim.y * gridDim.z;
    unsigned sum, cnt, mine, sp = 0u;
    for (;;) {
        sum = 0u; cnt = 0u; mine = 0u;
#pragma unroll
        for (unsigned j = 0; j < 16; ++j) { const unsigned c = xb_ld(&bar[XB_XCNT(j)]); sum += c; cnt += (c > 0u) ? 1u : 0u; mine = (j == x) ? c : mine; }
        if (sum == G) break;
        __builtin_amdgcn_s_sleep(1);
        if ((++sp & 255u) == 0u) { if (xb_ld(&bar[XB_TMO])) break; if (sp > XB_SPIN_CAP) { atomicAdd(&bar[XB_TMO], 1u); break; } }
    }
    nloc = mine > 0u ? mine : 1u; nx = cnt > 0u ? cnt : 1u;
}
__device__ __forceinline__ void xcd_barrier(const XcdBarrier& b) {
    asm volatile("s_waitcnt vmcnt(0)" ::: "memory");
    __syncthreads();
    if (threadIdx.x == 0) {
        unsigned* bar = b.bar;
        __builtin_amdgcn_s_waitcnt(0);
        unsigned nloc = b.st[0], nx = b.st[1];
        if (nloc == 0u) { xcd_barrier_complete(bar, b.x, nloc, nx); b.st[0] = nloc; b.st[1] = nx; }
        const unsigned old = xb_add(&bar[XB_XSUB(b.x)], 1u);
        const unsigned gen = old / nloc;
        if (old + 1u == (gen + 1u) * nloc) {
            __builtin_amdgcn_fence(__ATOMIC_RELEASE, "agent");
            asm volatile("s_waitcnt vmcnt(0)" ::: "memory");
            const unsigned og = xb_add(&bar[XB_TOP], 1u);
            const unsigned tg = og / nx;
            if (og + 1u == (tg + 1u) * nx) xb_add(&bar[XB_TOPGEN], 1u);
            else XB_SPIN(xb_ld(&bar[XB_TOPGEN]) == tg, bar);
            __builtin_amdgcn_fence(__ATOMIC_ACQUIRE, "agent");
            xb_add(&bar[XB_XGEN(b.x)], 1u);
            asm volatile("s_waitcnt vmcnt(0)" ::: "memory");
        } else {
            XB_SPIN(xb_ld(&bar[XB_XGEN(b.x)]) == gen, bar);
            __builtin_amdgcn_fence(__ATOMIC_ACQUIRE, "agent");
            asm volatile("s_waitcnt vmcnt(0)" ::: "memory");
        }
    }
    __syncthreads();
}
#endif

struct Args { const float* in[31]; float* out; unsigned char* ws; int lo, hi; };
typedef const float* FPtr;
#ifdef EMU
typedef const FPtr* ArgTab;
#else
typedef const __attribute__((address_space(4))) FPtr* ArgTab;
#endif
struct Frame {
    LAS unsigned char* lds; int tid, lane, wave, G, bid;
    ArgTab in; float* out; unsigned char* ws; unsigned* ctl;
};
enum { I_XP = 0, I_XS, I_CK, I_CV, I_SST, I_SCV, I_SSC, I_WIN, I_CONVW, I_CONVB, I_DTB, I_ALOG, I_SD, I_NORMW, I_WSSD, I_SINK, I_WATT, I_RELB, I_SCW, I_WSC, I_WO, I_LN1G, I_LN1B,
       I_RW, I_RB, I_WUP, I_BUP, I_WDN, I_BDN, I_LN2G, I_LN2B };

__device__ __forceinline__ bf16_t* ws_bf(const Frame& F, size_t off) { return (bf16_t*)(F.ws + off); }
__device__ __forceinline__ float* ws_f(const Frame& F, size_t off) { return (float*)(F.ws + off); }
__device__ __forceinline__ bf16_t* wl_ptr(const Frame& F, int layer, size_t off) { return (bf16_t*)(F.ws + WS_W + (size_t)layer * WL_BYTES + off); }

__device__ __forceinline__ void wt_item(const float* W, int ldw, int K, int k0, int nsrc0, const float* kscale, bf16_t* WT, int ndst0, LAS float* scr, int lane) {
    if (nsrc0 < 0) {
#pragma unroll
        for (int j = 0; j < 4; ++j) { const int n = (lane >> 3) + 8 * j; *(u32x4*)(WT + (size_t)(ndst0 + n) * K + k0 + 8 * (lane & 7)) = (u32x4){0u, 0u, 0u, 0u}; }
        return;
    }
#pragma unroll 8
    for (int i = 0; i < 32; ++i) { const int kk = 2 * i + (lane >> 5); float v = W[(size_t)(k0 + kk) * ldw + nsrc0 + (lane & 31)]; if (kscale) v *= kscale[k0 + kk]; scr[kk * 33 + (lane & 31)] = v; }
    WAVE_SYNC();
    const int c = lane & 7;
#pragma unroll
    for (int j = 0; j < 4; ++j) { const int n = (lane >> 3) + 8 * j; const LAS float* s = scr + (8 * c) * 33 + n;
        u32x4 o; o.x = pk2(s[0 * 33], s[1 * 33]); o.y = pk2(s[2 * 33], s[3 * 33]); o.z = pk2(s[4 * 33], s[5 * 33]); o.w = pk2(s[6 * 33], s[7 * 33]);
        *(u32x4*)(WT + (size_t)(ndst0 + n) * K + k0 + 8 * c) = o; }
    WAVE_SYNC();
}
__device__ __forceinline__ void step_weights(const Frame& F) {
    LAS float* scr = (LAS float*)(F.lds + F.wave * 16384);
    const int gw = F.bid * NWAVES + F.wave, NGW = F.G * NWAVES;
    constexpr int I_IN = (DINP / 32) * (D / 64), I_SSD = (D / 32) * (DINNER / 64), I_SQ = (D / 32) * (D / 64), I_UP = NEXP * (2048 / 32) * (D / 64), I_DN = NEXP * (D / 32) * (D / 64);
    constexpr int PER_LAYER = I_IN + I_SSD + 3 * I_SQ + I_UP + I_DN;
    for (int it = gw; it < DEPTH * PER_LAYER; it += NGW) {
        const int layer = it / PER_LAYER; int r = it % PER_LAYER;
        if (r < I_IN) { const int nb = r / (D / 64), kb = r % (D / 64), n0 = nb * 32;
            const int ns = n0 < 6144 ? n0 : (n0 < 13824 ? n0 + 32 : (n0 < 13856 ? n0 - 13824 + 6144 : -1));
            wt_item(F.in[I_WIN] + (size_t)layer * D * DIN, DIN, D, kb * 64, ns, nullptr, wl_ptr(F, layer, WL_IN), n0, scr, F.lane); continue; }
        r -= I_IN;
        if (r < I_SSD) { const int nb = r / (DINNER / 64), kb = r % (DINNER / 64);
            wt_item(F.in[I_WSSD] + (size_t)layer * DINNER * D, D, DINNER, kb * 64, nb * 32, F.in[I_NORMW] + (size_t)layer * DINNER, wl_ptr(F, layer, WL_SSD), nb * 32, scr, F.lane); continue; }
        r -= I_SSD;
        if (r < I_SQ) { const int nb = r / (D / 64), kb = r % (D / 64); wt_item(F.in[I_WATT] + (size_t)layer * D * D, D, D, kb * 64, nb * 32, nullptr, wl_ptr(F, layer, WL_ATT), nb * 32, scr, F.lane); continue; }
        r -= I_SQ;
        if (r < I_SQ) { const int nb = r / (D / 64), kb = r % (D / 64); wt_item(F.in[I_WSC] + (size_t)layer * D * D, D, D, kb * 64, nb * 32, nullptr, wl_ptr(F, layer, WL_SC), nb * 32, scr, F.lane); continue; }
        r -= I_SQ;
        if (r < I_SQ) { const int nb = r / (D / 64), kb = r % (D / 64); wt_item(F.in[I_WO] + (size_t)layer * D * D, D, D, kb * 64, nb * 32, nullptr, wl_ptr(F, layer, WL_O), nb * 32, scr, F.lane); continue; }
        r -= I_SQ;
        if (r < I_UP) { const int e = r / ((2048 / 32) * (D / 64)), q = r % ((2048 / 32) * (D / 64)), nb = q / (D / 64), kb = q % (D / 64), n0 = nb * 32;
            const int pn = n0 >> 8, bj = (n0 >> 7) & 1, jj = n0 & 127, ns = bj * 1024 + pn * 128 + jj;
            wt_item(F.in[I_WUP] + ((size_t)layer * NEXP + e) * D * 2048, 2048, D, kb * 64, ns, nullptr, wl_ptr(F, layer, WL_UP) + (size_t)e * 2048 * D, n0, scr, F.lane); continue; }
        r -= I_UP;
        { const int e = r / ((D / 32) * (D / 64)), q = r % ((D / 32) * (D / 64)), nb = q / (D / 64), kb = q % (D / 64);
            wt_item(F.in[I_WDN] + ((size_t)layer * NEXP + e) * D * D, D, D, kb * 64, nb * 32, nullptr, wl_ptr(F, layer, WL_DN) + (size_t)e * D * D, nb * 32, scr, F.lane); }
    }
}

__device__ __forceinline__ const float* x_in_row(const Frame& F, int layer, int mb, int r) {
    if (layer == 0) return r < NP ? F.in[I_XP] + ((size_t)mb * NP + r) * D : F.in[I_XS] + (size_t)(r - NP) * D;
    return r < NP ? F.out + O_YP + ((size_t)mb * NP + r) * D : F.out + O_YS + (size_t)(r - NP) * D;
}
__device__ __forceinline__ float* x_out_row(const Frame& F, int mb, int r) { return r < NP ? F.out + O_YP + ((size_t)mb * NP + r) * D : F.out + O_YS + (size_t)(r - NP) * D; }
__device__ __forceinline__ int rows_of(int mb) { return mb == 0 ? R : NP; }

__device__ __forceinline__ void step_xb(const Frame& F, int mb) {
    const int gw = F.bid * NWAVES + F.wave, NGW = F.G * NWAVES, nr = rows_of(mb);
    bf16_t* XB = ws_bf(F, WS_XB0) + (size_t)mb * R * D;
    for (int r = gw; r < nr; r += NGW) {
        const f32x4* xr = (const f32x4*)x_in_row(F, 0, mb, r) + F.lane; u32x2* o = (u32x2*)(XB + (size_t)r * D) + F.lane;
#pragma unroll
        for (int j = 0; j < 4; ++j) { const f32x4 v = xr[64 * j]; u32x2 w; w.x = pk2(v[0], v[1]); w.y = pk2(v[2], v[3]); o[64 * j] = w; }
    }
}

__device__ __forceinline__ float softplus_f(float x) { const float e = fexp(x); return x > 20.f ? x : (e < 0.01f ? e * (1.0f - e * (0.5f - e * 0.33333333f)) : __builtin_amdgcn_logf(1.0f + e) * 0.69314718056f); }
constexpr int S128 = 136, S64 = 72;
constexpr int BL_BM = 0, BL_CM = BL_BM + 64 * S128 * 2, BL_CB = BL_CM + 64 * S128 * 2, BL_END = BL_CB + 64 * S64 * 2;
struct BcRegs { u32x4 raw[7]; f32x4 wq[4][2], bq[2]; };
__device__ __forceinline__ void ssd_bc_load(const Frame& F, int layer, int u, BcRegs& R_) {
    const int sl = (u / NCHUNK) % NSEQ_MB, ck = u % NCHUNK, g = u / (NCHUNK * NSEQ_MB); const int tid = F.tid;
    const bf16_t* H = ws_bf(F, WS_H) + (size_t)sl * SEQ * DINP; const int cgi = tid & 31, rb = tid >> 5; const int xc = (cgi < 16 ? 2048 : 3072) + g * 128 + 8 * (cgi & 15);
#pragma unroll
    for (int i = 0; i < 7; ++i) { const int t = ck * 64 + 4 * rb - 3 + i; R_.raw[i] = t >= 0 ? *(const u32x4*)(H + (size_t)t * DINP + C_X + xc) : (u32x4){0u, 0u, 0u, 0u}; }
    const float* convw = F.in[I_CONVW] + (size_t)layer * 4 * CONVDIM + xc; const float* convb = F.in[I_CONVB] + (size_t)layer * CONVDIM + xc;
#pragma unroll
    for (int tp = 0; tp < 4; ++tp) { R_.wq[tp][0] = *(const f32x4*)(convw + tp * CONVDIM); R_.wq[tp][1] = *(const f32x4*)(convw + tp * CONVDIM + 4); }
    R_.bq[0] = *(const f32x4*)convb; R_.bq[1] = *(const f32x4*)(convb + 4);
}
__device__ __forceinline__ void ssd_bc_unit(const Frame& F, int u, const BcRegs& R_) {
    const int sl = (u / NCHUNK) % NSEQ_MB, ck = u % NCHUNK, g = u / (NCHUNK * NSEQ_MB);
    const int tid = F.tid, lane = F.lane, w = F.wave, fr = lane & 15, fq = lane >> 4;
    LAS bf16_t* Bm = (LAS bf16_t*)(F.lds + BL_BM); LAS bf16_t* Cm = (LAS bf16_t*)(F.lds + BL_CM); LAS bf16_t* CBs = (LAS bf16_t*)(F.lds + BL_CB);
    const size_t rowg = (size_t)sl * SEQ + (size_t)ck * 64; const size_t tix = ((size_t)sl * NCHUNK + ck) * 8 + g;
    const int cgi = tid & 31, rb = tid >> 5; const bool isB = cgi < 16; const int n0 = 8 * (cgi & 15);
    const u32x4 (&raw)[7] = R_.raw; const f32x4 (&wq)[4][2] = R_.wq; const f32x4 (&bq)[2] = R_.bq;
    __syncthreads();
    { float val[4][8];
#pragma unroll
      for (int r = 0; r < 4; ++r) { float a[8] = {bq[0][0], bq[0][1], bq[0][2], bq[0][3], bq[1][0], bq[1][1], bq[1][2], bq[1][3]};
#pragma unroll
          for (int tp = 0; tp < 4; ++tp) { float f[8]; unpack8(raw[r + tp], f);
#pragma unroll
              for (int i = 0; i < 4; ++i) { a[i] += f[i] * wq[tp][0][i]; a[4 + i] += f[4 + i] * wq[tp][1][i]; } }
#pragma unroll
          for (int i = 0; i < 8; ++i) val[r][i] = fsilu(a[i]); }
      if (isB) { bf16_t* bt = ws_bf(F, WS_BTG) + tix * 8192 + (size_t)n0 * 64 + 4 * rb;
#pragma unroll
          for (int r = 0; r < 4; ++r) *(LAS u32x4*)(Bm + (4 * rb + r) * S128 + n0) = pack8(val[r]);
#pragma unroll
          for (int i = 0; i < 8; ++i) { u32x2 wv; wv.x = pk2(val[0][i], val[1][i]); wv.y = pk2(val[2][i], val[3][i]); *(u32x2*)(bt + (size_t)i * 64) = wv; } }
      else { bf16_t* cmc = ws_bf(F, WS_CMC) + (rowg + 4 * rb) * 1024 + g * 128 + n0;
#pragma unroll
          for (int r = 0; r < 4; ++r) { const u32x4 pk = pack8(val[r]); *(LAS u32x4*)(Cm + (4 * rb + r) * S128 + n0) = pk; *(u32x4*)(cmc + (size_t)r * 1024) = pk; } } }
    __syncthreads();
    { const int ti = w >> 1;
#pragma unroll
      for (int jj = 0; jj < 2; ++jj) { const int tj = 2 * (w & 1) + jj; f32x4 cb = (f32x4){0.f, 0.f, 0.f, 0.f};
          if (tj <= ti) {
#pragma unroll
              for (int ks = 0; ks < 4; ++ks) { const bf16x8 a = *(const LAS bf16x8*)(Cm + (16 * ti + fr) * S128 + 32 * ks + 8 * fq); const bf16x8 b = *(const LAS bf16x8*)(Bm + (16 * tj + fr) * S128 + 32 * ks + 8 * fq);
                  cb = __builtin_amdgcn_mfma_f32_16x16x32_bf16(a, b, cb, 0, 0, 0); } }
#pragma unroll
          for (int r = 0; r < 4; ++r) CBs[(16 * ti + 4 * fq + r) * S64 + 16 * tj + fr] = bf1(cb[r]); } }
    __syncthreads();
    { const int row = tid >> 3, cc = tid & 7; *(u32x4*)(ws_bf(F, WS_CBG) + tix * 4096 + row * 64 + 8 * cc) = *(const LAS u32x4*)(CBs + row * S64 + 8 * cc); }
}

constexpr int SL_CM = 0, SL_BT = SL_CM + 64 * S128 * 2, SL_CB = SL_BT + 128 * S64 * 2, SL_DMA_SZ = SL_CB + 64 * S64 * 2, SL_DMA_END = 2 * SL_DMA_SZ;
constexpr int SL_XT = SL_DMA_END  , SL_XTW = SL_XT + 2 * 64 * S64 * 2, SL_MM = SL_XTW + 64 * S64 * 2, SL_SB = SL_MM + 64 * S64 * 2,
    SL_SM = SL_SB + 64 * S128 * 2, SL_END = SL_SM + 2 * 384 * 4;
static_assert(SL_END <= SCR_BYTES && SL_DMA_SZ == 2816 * 16, "ssd LDS map");
#ifdef EMU
#define SSD_DMA_ONE(gp_, dst_) memcpy((unsigned char*)(dst_) + lane * 16, (gp_), 16)
#else
#define SSD_DMA_ONE(gp_, dst_) __builtin_amdgcn_global_load_lds((const unsigned*)(gp_), (LAS unsigned*)(dst_), 16, 0, 0)
#endif
#define SSD_DMA_SETUP() do { _Pragma("unroll") for (int j_ = 0; j_ < 6; ++j_) { const int pc_ = w * 6 + j_; const int q_ = pc_ * 64 + lane; const size_t tx0_ = ((size_t)sl * NCHUNK) * 8 + g; \
        if (pc_ < 17) { const int r_ = q_ / 17; int c_ = q_ % 17; c_ = c_ < 16 ? c_ : 15; dsrc[j_] = cmc + (size_t)r_ * 1024 + 8 * c_; } \
        else if (pc_ < 35) { const int q2_ = q_ - 1088, r_ = q2_ / 9; int c_ = q2_ % 9; c_ = c_ < 8 ? c_ : 7; dsrc[j_] = btg + tx0_ * 8192 + r_ * 64 + 8 * c_; } \
        else { const int q3_ = q_ - 2240, r_ = q3_ / 9; int c_ = q3_ % 9; c_ = c_ < 8 ? c_ : 7; dsrc[j_] = cbg + tx0_ * 4096 + r_ * 64 + 8 * c_; } } } while (0)
#define SSD_DMA(ck_) do { _Pragma("unroll") for (int j_ = 0; j_ < 6; ++j_) { const int pc_ = w * 6 + j_; if (pc_ < 44) { \
        SSD_DMA_ONE(dsrc[j_], L + ((ck_) & 1) * SL_DMA_SZ + SL_CM + pc_ * 1024); dsrc[j_] += pc_ < 17 ? (size_t)64 * 1024 : (pc_ < 35 ? (size_t)8 * 8192 : (size_t)8 * 4096); } } } while (0)
#define SSD_LOAD_X(ck_) do { _Pragma("unroll") for (int i = 0; i < 11; ++i) { const int t_ = (ck_) * 64 + 8 * w - 3 + i; rawx[i] = t_ >= 0 ? (unsigned)H[(size_t)t_ * DINP + C_X + hd * 64 + lane] : 0u; } } while (0)
#define SSD_LOAD_XN(ck_) do { const bf16_t* px_ = H + ((size_t)(ck_) * 64 + 8 * w - 3) * DINP + C_X + hd * 64 + lane; _Pragma("unroll") for (int i = 0; i < 11; ++i) rawx[i] = (unsigned)px_[(size_t)i * DINP]; } while (0)
#define SSD_TABLE(tb_, dtr_) do { const float dt_ = softplus_f(bf2f(dtr_) + dtb); \
        float cs_ = Ah * dt_; _Pragma("unroll") for (int o = 1; o < 64; o <<= 1) { const float t2_ = __shfl(cs_, lane - o < 0 ? 0 : lane - o); if (lane >= o) cs_ += t2_; } \
        const float tot_ = __shfl(cs_, 63); (tb_)[lane] = dt_; (tb_)[64 + lane] = cs_; (tb_)[128 + lane] = fexp(tot_ - cs_); (tb_)[192 + lane] = fexp(cs_); if (lane == 0) (tb_)[256] = fexp(tot_); } while (0)

__device__ __forceinline__ void ssd_prompt_unit(const Frame& F, int layer, int mb, int sl, int hd) {
    const int tid = F.tid, lane = F.lane, w = F.wave, fr = lane & 15, fq = lane >> 4;
    LAS unsigned char* L = F.lds;
    LAS bf16_t* XT0 = (LAS bf16_t*)(L + SL_XT);
    LAS bf16_t* XTW = (LAS bf16_t*)(L + SL_XTW); LAS bf16_t* Mm = (LAS bf16_t*)(L + SL_MM); LAS bf16_t* Sb = (LAS bf16_t*)(L + SL_SB);
    LAS float* smb = (LAS float*)(L + SL_SM);
    const int g = hd >> 2;
    bf16_t* H = ws_bf(F, WS_H) + (size_t)sl * SEQ * DINP;
    const bf16_t* cmc = ws_bf(F, WS_CMC) + (size_t)sl * SEQ * 1024 + g * 128; const bf16_t* btg = ws_bf(F, WS_BTG); const bf16_t* cbg = ws_bf(F, WS_CBG);
    const float* convw = F.in[I_CONVW] + (size_t)layer * 4 * CONVDIM + hd * 64; const float* convb = F.in[I_CONVB] + (size_t)layer * CONVDIM + hd * 64;
    const float cw0 = convw[lane], cw1 = convw[CONVDIM + lane], cw2 = convw[2 * CONVDIM + lane], cw3 = convw[3 * CONVDIM + lane], cwb = convb[lane];
    __syncthreads();
    const float dtb = F.in[I_DTB][layer * 32 + hd], Ah = -fexp(F.in[I_ALOG][layer * 32 + hd]), Dh = F.in[I_SD][layer * 32 + hd];
    const int xl = tid >> 3, xcg = tid & 7;
    f32x4 S[4];
#pragma unroll
    for (int j = 0; j < 4; ++j) S[j] = (f32x4){0.f, 0.f, 0.f, 0.f};
    const int ti = w >> 1, tj0 = 2 * (w & 1);
    const int pi = w & 3, nb = w >> 2;
    bf16_t* pz = H + (size_t)(16 * ti + fr) * DINP + C_Z + hd * 64 + 16 * tj0 + 4 * fq; float* pss = ws_f(F, WS_SSQ) + ((size_t)sl * SEQ + 16 * ti + fr) * 64 + hd * 2 + (w & 1);
    unsigned rawx[11]; u32x2 zraw[2]; unsigned dtr_next;
    const bf16_t* dsrc[6]; SSD_DMA_SETUP();
    SSD_DMA(0); SSD_LOAD_X(0);
    zraw[0] = *(const u32x2*)pz; zraw[1] = *(const u32x2*)(pz + 16);
    { const unsigned d0 = H[(size_t)lane * DINP + C_DT + hd]; dtr_next = H[(size_t)(64 + lane) * DINP + C_DT + hd]; if (w == 7) { SSD_TABLE(smb, d0); smb[320 + lane] = Dh * __builtin_amdgcn_rcpf(smb[lane]); } }
    VM_WAIT(0);
    __syncthreads();
    for (int ck = 0; ck < NCHUNK; ++ck) {
        LAS float* sm = smb + (ck & 1) * 384; LAS float* smn = smb + ((ck + 1) & 1) * 384; LAS bf16_t* XT = XT0 + (ck & 1) * 64 * S64;
        LAS unsigned char* Ld = L + (ck & 1) * SL_DMA_SZ; LAS bf16_t* Cm = (LAS bf16_t*)(Ld + SL_CM); LAS bf16_t* BT = (LAS bf16_t*)(Ld + SL_BT); LAS bf16_t* CBl = (LAS bf16_t*)(Ld + SL_CB);
        { const f32x4 d0 = *(const LAS f32x4*)(sm + 8 * w), d1 = *(const LAS f32x4*)(sm + 8 * w + 4), e0 = *(const LAS f32x4*)(sm + 128 + 8 * w), e1 = *(const LAS f32x4*)(sm + 128 + 8 * w + 4);
          const float dtv[8] = {d0[0], d0[1], d0[2], d0[3], d1[0], d1[1], d1[2], d1[3]}, wdv[8] = {e0[0], e0[1], e0[2], e0[3], e1[0], e1[1], e1[2], e1[3]}; float xr[11], xa[8], xb[8];
#pragma unroll
          for (int i = 0; i < 11; ++i) xr[i] = blo(rawx[i]);
#pragma unroll
          for (int r = 0; r < 8; ++r) { const float xd = fsilu(cwb + xr[r] * cw0 + xr[r + 1] * cw1 + xr[r + 2] * cw2 + xr[r + 3] * cw3) * dtv[r]; xa[r] = xd; xb[r] = xd * wdv[r]; }
          *(LAS u32x4*)(XT + lane * S64 + 8 * w) = pack8(xa); *(LAS u32x4*)(XTW + lane * S64 + 8 * w) = pack8(xb); }
#pragma unroll
        for (int jj = 0; jj < 4; ++jj) { u32x2 wv; wv.x = pk2(S[jj][0], S[jj][1]); wv.y = pk2(S[jj][2], S[jj][3]); *(LAS u32x2*)(Sb + (16 * pi + fr) * S128 + 64 * nb + 16 * jj + 4 * fq) = wv; }
        if (ck > 0) VM_WAIT(2);
        LBAR();
        const u32x2 z0 = zraw[0], z1 = zraw[1]; const unsigned dtr_cur = dtr_next;
        if (ck + 1 < NCHUNK) SSD_DMA(ck + 1);
        if (ck + 1 < NCHUNK) { SSD_LOAD_XN(ck + 1); zraw[0] = *(const u32x2*)(pz + (size_t)64 * DINP); zraw[1] = *(const u32x2*)(pz + (size_t)64 * DINP + 16);
            dtr_next = H[((size_t)ck * 64 + (ck + 2 < NCHUNK ? 128 : 64) + lane) * DINP + C_DT + hd]; }
        asm volatile("" ::: "memory");
        if (w == 7 && ck + 1 < NCHUNK) { SSD_TABLE(smn, dtr_cur); smn[320 + lane] = Dh * __builtin_amdgcn_rcpf(smn[lane]); }
        { const int s0 = 8 * xcg; float mv[8];
          if (s0 <= xl) { float cbv[8]; unpack8(*(const LAS u32x4*)(CBl + xl * S64 + s0), cbv); const float al = sm[64 + xl]; const f32x4 a0 = *(const LAS f32x4*)(sm + 64 + s0), a1 = *(const LAS f32x4*)(sm + 64 + s0 + 4);
#pragma unroll
              for (int i = 0; i < 4; ++i) { mv[i] = (xl >= s0 + i) ? cbv[i] * fexp(fminf(al - a0[i], 0.f)) : 0.f; mv[4 + i] = (xl >= s0 + 4 + i) ? cbv[4 + i] * fexp(fminf(al - a1[i], 0.f)) : 0.f; }
              if ((xl >> 3) == xcg) { const float dd = sm[320 + xl];
#pragma unroll
                  for (int i = 0; i < 8; ++i) if (i == (xl & 7)) mv[i] += dd; } }
          else {
#pragma unroll
              for (int i = 0; i < 8; ++i) mv[i] = 0.f; }
          *(LAS u32x4*)(Mm + xl * S64 + s0) = pack8(mv); }
        f32x4 yo[2];
#pragma unroll
        for (int jj = 0; jj < 2; ++jj) { const int tj = tj0 + jj; yo[jj] = (f32x4){0.f, 0.f, 0.f, 0.f};
#pragma unroll
            for (int ks = 0; ks < 4; ++ks) { const bf16x8 sb = *(const LAS bf16x8*)(Sb + (16 * tj + fr) * S128 + 32 * ks + 8 * fq); const bf16x8 c = *(const LAS bf16x8*)(Cm + (16 * ti + fr) * S128 + 32 * ks + 8 * fq);
                yo[jj] = __builtin_amdgcn_mfma_f32_16x16x32_bf16(sb, c, yo[jj], 0, 0, 0); } }
        { const float cd = sm[256];
#pragma unroll
          for (int jj = 0; jj < 4; ++jj) { S[jj] = S[jj] * cd;
#pragma unroll
            for (int ks = 0; ks < 2; ++ks) { const bf16x8 a = *(const LAS bf16x8*)(BT + (64 * nb + 16 * jj + fr) * S64 + 32 * ks + 8 * fq); const bf16x8 b = *(const LAS bf16x8*)(XTW + (16 * pi + fr) * S64 + 32 * ks + 8 * fq);
                S[jj] = __builtin_amdgcn_mfma_f32_16x16x32_bf16(a, b, S[jj], 0, 0, 0); }
            if (jj & 1) asm volatile("" ::: "memory"); } }
        const float ec = sm[192 + 16 * ti + fr];
        LBAR();
        { float ss = 0.f; const u32x2 zz[2] = {z0, z1};
#pragma unroll
          for (int jj = 0; jj < 2; ++jj) { const int tj = tj0 + jj; f32x4 yd = (f32x4){0.f, 0.f, 0.f, 0.f};
#pragma unroll
              for (int ks = 0; ks < 2; ++ks) { const bf16x8 a = *(const LAS bf16x8*)(XT + (16 * tj + fr) * S64 + 32 * ks + 8 * fq); const bf16x8 b = *(const LAS bf16x8*)(Mm + (16 * ti + fr) * S64 + 32 * ks + 8 * fq);
                  yd = __builtin_amdgcn_mfma_f32_16x16x32_bf16(a, b, yd, 0, 0, 0); }
              const float z[4] = {blo(zz[jj].x), bhi(zz[jj].x), blo(zz[jj].y), bhi(zz[jj].y)}; float v[4];
#pragma unroll
              for (int r = 0; r < 4; ++r) { v[r] = (yd[r] + ec * yo[jj][r]) * fsilu(z[r]); ss += v[r] * v[r]; }
              u32x2 ov; ov.x = pk2(v[0], v[1]); ov.y = pk2(v[2], v[3]); *(u32x2*)(pz + 16 * jj) = ov; }
          ss += __shfl_xor(ss, 16); ss += __shfl_xor(ss, 32);
          if (fq == 0) *pss = ss;
          pz += (size_t)64 * DINP; pss += 64 * 64; }
    }
    float* so = F.out + O_SSP + ((((size_t)layer * BATCH + mb * NSEQ_MB + sl) * 32 + hd) * 64) * 128;
#pragma unroll
    for (int jj = 0; jj < 4; ++jj) *(f32x4*)(so + (size_t)(16 * pi + fr) * 128 + 64 * nb + 16 * jj + 4 * fq) = S[jj];
    VM_WAIT(0); __syncthreads();
}

__device__ __forceinline__ void ssd_sample_unit(const Frame& F, int layer, int sq, int hd) {
    const int tid = F.tid, lane = F.lane; LAS float* L = (LAS float*)F.lds;
    LAS float* xs = L; LAS float* Bs = L + 16 * 64; LAS float* Cs = Bs + 16 * 128; LAS float* dts = Cs + 16 * 128; LAS float* das = dts + 16; LAS float* Yl = das + 16;
    const int g = hd >> 2;
    bf16_t* H = ws_bf(F, WS_H) + (size_t)(NP + sq * 16) * DINP;
    const float* hist = F.in[I_SCV] + ((size_t)layer * DECB + sq) * 3 * CONVDIM;
    const float* convw = F.in[I_CONVW] + (size_t)layer * 4 * CONVDIM; const float* convb = F.in[I_CONVB] + (size_t)layer * CONVDIM;
    __syncthreads();
    if (tid < 320) { const int c = tid; const int xc = c < 64 ? hd * 64 + c : (c < 192 ? 2048 + g * 128 + (c - 64) : 3072 + g * 128 + (c - 192));
        float win[19];
#pragma unroll
        for (int i = 0; i < 3; ++i) win[i] = hist[i * CONVDIM + xc];
#pragma unroll
        for (int t = 0; t < 16; ++t) win[3 + t] = bf2f(H[(size_t)t * DINP + C_X + xc]);
        const float w0 = convw[xc], w1 = convw[CONVDIM + xc], w2 = convw[2 * CONVDIM + xc], w3 = convw[3 * CONVDIM + xc], bb = convb[xc];
#pragma unroll
        for (int t = 0; t < 16; ++t) { const float a = fsilu(bb + win[t] * w0 + win[t + 1] * w1 + win[t + 2] * w2 + win[t + 3] * w3);
            if (c < 64) xs[t * 64 + c] = a; else if (c < 192) Bs[t * 128 + c - 64] = a; else Cs[t * 128 + c - 192] = a; } }
    if (tid < 16) { const float dt = softplus_f(bf2f(H[(size_t)tid * DINP + C_DT + hd]) + F.in[I_DTB][layer * 32 + hd]); dts[tid] = dt; das[tid] = fexp(-fexp(F.in[I_ALOG][layer * 32 + hd]) * dt); }
    __syncthreads();
    const int p = tid >> 3, n0 = (tid & 7) * 16;
    const size_t sbase = ((((size_t)layer * DECB + sq) * 32 + hd) * 64 + p) * 128 + n0;
    float S[16];
#pragma unroll
    for (int i = 0; i < 16; ++i) S[i] = F.in[I_SST][sbase + i];
    for (int t = 0; t < 16; ++t) { const float dec = das[t], xv = xs[t * 64 + p] * dts[t]; float part = 0.f;
#pragma unroll
        for (int i = 0; i < 16; ++i) { S[i] = S[i] * dec + xv * Bs[t * 128 + n0 + i]; part += Cs[t * 128 + n0 + i] * S[i]; }
        part += __shfl_xor(part, 1); part += __shfl_xor(part, 2); part += __shfl_xor(part, 4);
        if ((tid & 7) == 0) Yl[t * 64 + p] = part; }
#pragma unroll
    for (int i = 0; i < 16; ++i) F.out[O_SSS + sbase + i] = S[i];
    __syncthreads();
    const float Dh = F.in[I_SD][layer * 32 + hd];
#pragma unroll
    for (int j = 0; j < 2; ++j) { const int it = tid + 512 * j, t = it >> 6, pp = it & 63;
        const float z = bf2f(H[(size_t)t * DINP + C_Z + hd * 64 + pp]); const float v = (Yl[t * 64 + pp] + Dh * xs[t * 64 + pp]) * fsilu(z);
        H[(size_t)t * DINP + C_Z + hd * 64 + pp] = bf1(v);
        const float ss = wave_sum(v * v);
        if (lane < 2) ws_f(F, WS_SSQ)[((size_t)NP + sq * 16 + t) * 64 + hd * 2 + lane] = lane == 0 ? ss : 0.f; }
}

__device__ __forceinline__ int t5_bucket(int rel) {
    const int n = rel < 0 ? -rel : rel; const int b = rel > 0 ? 16 : 0;
    if (n < 8) return b + n;
    int v = 8; v += n >= 12; v += n >= 16; v += n >= 23; v += n >= 32; v += n >= 46; v += n >= 64; v += n >= 91;
    return b + v;
}
constexpr int AK_P = 72, AV_P = 200;
constexpr int AL_K = 0, AL_VT = AL_K + 192 * AK_P * 2, AL_LUT = AL_VT + 64 * AV_P * 2, AL_END = AL_LUT + 4 * 256 * 4;
static_assert(AL_END <= RING_BYTES, "attention LDS map");
__device__ __forceinline__ void attn_prompt_unit(const Frame& F, int layer, int sl, int ck, int kh) {
    const int tid = F.tid, lane = F.lane, w = F.wave, q32 = lane & 31, hi = lane >> 5;
    LAS bf16_t* Kl = (LAS bf16_t*)(F.lds + AL_K); LAS bf16_t* VT = (LAS bf16_t*)(F.lds + AL_VT); LAS float* lut = (LAS float*)(F.lds + AL_LUT);
    bf16_t* H = ws_bf(F, WS_H) + (size_t)sl * SEQ * DINP;
    const int gq = w >> 1, qh = w & 1, head = kh * 4 + gq;
    const size_t qrow = (size_t)ck * 64 + 32 * qh + q32;
    bf16x8 qf[4];
#pragma unroll
    for (int ds = 0; ds < 4; ++ds) qf[ds] = *(const bf16x8*)(H + qrow * DINP + C_Q + head * 64 + 16 * ds + 8 * hi);
    __syncthreads();
#pragma unroll
    for (int j = 0; j < 3; ++j) { const int id = tid + 512 * j, key = id >> 3, cg = id & 7; const int t = 64 * (ck - 2) + key;
        u32x4 kv = (u32x4){0u, 0u, 0u, 0u}, vv = kv;
        if (t >= 0) { kv = *(const u32x4*)(H + (size_t)t * DINP + C_K + kh * 64 + 8 * cg); vv = *(const u32x4*)(H + (size_t)t * DINP + C_V + kh * 64 + 8 * cg); }
        *(LAS u32x4*)(Kl + key * AK_P + 8 * cg) = kv;
        VT[(8 * cg + 0) * AV_P + key] = (bf16_t)(vv.x & 0xffffu); VT[(8 * cg + 1) * AV_P + key] = (bf16_t)(vv.x >> 16); VT[(8 * cg + 2) * AV_P + key] = (bf16_t)(vv.y & 0xffffu); VT[(8 * cg + 3) * AV_P + key] = (bf16_t)(vv.y >> 16);
        VT[(8 * cg + 4) * AV_P + key] = (bf16_t)(vv.z & 0xffffu); VT[(8 * cg + 5) * AV_P + key] = (bf16_t)(vv.z >> 16); VT[(8 * cg + 6) * AV_P + key] = (bf16_t)(vv.w & 0xffffu); VT[(8 * cg + 7) * AV_P + key] = (bf16_t)(vv.w >> 16); }
    for (int e = tid; e < 4 * 255; e += NTHREADS) { const int gg = e / 255, idx = e % 255; lut[gg * 256 + idx] = F.in[I_RELB][t5_bucket(idx - 191) * 16 + kh * 4 + gg]; }
    __syncthreads();
    f32x16 sc[6];
#pragma unroll
    for (int kt = 0; kt < 6; ++kt) {
#pragma unroll
        for (int r = 0; r < 16; ++r) sc[kt][r] = 0.f;
#pragma unroll
        for (int ds = 0; ds < 4; ++ds) { const bf16x8 a = *(const LAS bf16x8*)(Kl + (32 * kt + q32) * AK_P + 16 * ds + 8 * hi); sc[kt] = __builtin_amdgcn_mfma_f32_32x32x16_bf16(a, qf[ds], sc[kt], 0, 0, 0); } }
    const int qidx = 32 * qh + q32; const float sink = F.in[I_SINK][layer * 16 + head];
    float mx = -3.0e38f;
#pragma unroll
    for (int kt = 0; kt < 6; ++kt)
#pragma unroll
        for (int r = 0; r < 16; ++r) { const int key = 32 * kt + (r & 3) + 8 * (r >> 2) + 4 * hi; const int rel = key - 128 - qidx;
            float s = sc[kt][r] * 0.125f + lut[gq * 256 + rel + 191]; if (ck < 2 && 64 * ck + key - 128 < 0) s = -1e30f; sc[kt][r] = s; mx = fmaxf(mx, s); }
    mx = fmaxf(mx, __shfl_xor(mx, 32)); mx = fmaxf(mx, sink);
    float sum = 0.f;
#pragma unroll
    for (int kt = 0; kt < 6; ++kt)
#pragma unroll
        for (int r = 0; r < 16; ++r) { const float e = fexp(sc[kt][r] - mx); sc[kt][r] = e; sum += e; }
    sum += __shfl_xor(sum, 32);
    const float inv = 1.0f / (sum + fexp(sink - mx));
    f32x16 o[2];
#pragma unroll
    for (int d2 = 0; d2 < 2; ++d2)
#pragma unroll
        for (int r = 0; r < 16; ++r) o[d2][r] = 0.f;
#pragma unroll
    for (int kt = 0; kt < 6; ++kt)
#pragma unroll
        for (int s = 0; s < 2; ++s) {
            u32x4 pw; pw.x = pk2(sc[kt][8 * s + 0], sc[kt][8 * s + 1]); pw.y = pk2(sc[kt][8 * s + 2], sc[kt][8 * s + 3]); pw.z = pk2(sc[kt][8 * s + 4], sc[kt][8 * s + 5]); pw.w = pk2(sc[kt][8 * s + 6], sc[kt][8 * s + 7]);
            const bf16x8 pa = __builtin_bit_cast(bf16x8, pw);
#pragma unroll
            for (int d2 = 0; d2 < 2; ++d2) { const LAS bf16_t* vp = VT + (32 * d2 + q32) * AV_P + 32 * kt + 16 * s + 4 * hi;
                const u32x2 lo = *(const LAS u32x2*)vp, hh = *(const LAS u32x2*)(vp + 8); u32x4 vw; vw.x = lo.x; vw.y = lo.y; vw.z = hh.x; vw.w = hh.y;
                o[d2] = __builtin_amdgcn_mfma_f32_32x32x16_bf16(pa, __builtin_bit_cast(bf16x8, vw), o[d2], 0, 0, 0); } }
#pragma unroll
    for (int r = 0; r < 16; ++r) { const int q = (r & 3) + 8 * (r >> 2) + 4 * hi; const float iv = __shfl(inv, q);
        bf16_t* op = H + ((size_t)ck * 64 + 32 * qh + q) * DINP + C_Q + head * 64 + q32;
        op[0] = bf1(o[0][r] * iv); op[32] = bf1(o[1][r] * iv); }
}
__device__ __forceinline__ void attn_sample_unit(const Frame& F, int layer, int sq, int kh) {
    const int tid = F.tid; LAS float* L = (LAS float*)F.lds;
    LAS float* Kf = L; LAS float* Vf = Kf + 144 * 65; LAS float* Qf = Vf + 144 * 64; LAS float* P = Qf + 64 * 65; LAS float* Pinv = P + 64 * 145;
    static_assert((144 * 65 + 144 * 64 + 64 * 65 + 64 * 145 + 64) * 4 <= RING_BYTES, "sample attention LDS map");
    bf16_t* H = ws_bf(F, WS_H) + (size_t)(NP + sq * 16) * DINP;
    const float* ck = F.in[I_CK] + ((size_t)layer * DECB + sq) * WINDOW * 256; const float* cv = F.in[I_CV] + ((size_t)layer * DECB + sq) * WINDOW * 256;
    __syncthreads();
    for (int i = tid; i < 144 * 64; i += NTHREADS) { const int key = i >> 6, d = i & 63;
        Kf[key * 65 + d] = key < 128 ? ck[(size_t)key * 256 + kh * 64 + d] : bf2f(H[(size_t)(key - 128) * DINP + C_K + kh * 64 + d]);
        Vf[key * 64 + d] = key < 128 ? cv[(size_t)key * 256 + kh * 64 + d] : bf2f(H[(size_t)(key - 128) * DINP + C_V + kh * 64 + d]); }
    for (int i = tid; i < 64 * 64; i += NTHREADS) { const int row = i >> 6, d = i & 63; Qf[row * 65 + d] = bf2f(H[(size_t)(row & 15) * DINP + C_Q + (kh * 4 + (row >> 4)) * 64 + d]); }
    __syncthreads();
    for (int i = tid; i < 64 * 144; i += NTHREADS) { const int row = i / 144, key = i % 144; float s = 0.f;
        for (int d = 0; d < 64; ++d) s += Qf[row * 65 + d] * Kf[key * 65 + d];
        P[row * 145 + key] = s * 0.125f + F.in[I_RELB][t5_bucket(key - 128 - (row & 15)) * 16 + kh * 4 + (row >> 4)]; }
    __syncthreads();
    { const int row = tid >> 3, sub = tid & 7; const float sink = F.in[I_SINK][layer * 16 + kh * 4 + (row >> 4)]; float mx = -3.0e38f;
      for (int k = sub; k < 144; k += 8) mx = fmaxf(mx, P[row * 145 + k]);
      mx = fmaxf(mx, __shfl_xor(mx, 1)); mx = fmaxf(mx, __shfl_xor(mx, 2)); mx = fmaxf(mx, __shfl_xor(mx, 4)); mx = fmaxf(mx, sink);
      float sum = 0.f;
      for (int k = sub; k < 144; k += 8) { const float e = fexp(P[row * 145 + k] - mx); P[row * 145 + k] = e; sum += e; }
      sum += __shfl_xor(sum, 1); sum += __shfl_xor(sum, 2); sum += __shfl_xor(sum, 4);
      if (sub == 0) Pinv[row] = 1.0f / (sum + fexp(sink - mx)); }
    __syncthreads();
    { const int row = tid >> 3, d0 = (tid & 7) * 8; float o[8] = {0.f, 0.f, 0.f, 0.f, 0.f, 0.f, 0.f, 0.f};
      for (int k = 0; k < 144; ++k) { const float pv = P[row * 145 + k];
#pragma unroll
          for (int i = 0; i < 8; ++i) o[i] += pv * Vf[k * 64 + d0 + i]; }
      const float iv = Pinv[row];
#pragma unroll
      for (int i = 0; i < 8; ++i) o[i] *= iv;
      *(u32x4*)(H + (size_t)(row & 15) * DINP + C_Q + (kh * 4 + (row >> 4)) * 64 + d0) = pack8(o); }
}
__device__ __forceinline__ void sc_unit(const Frame& F, int layer, int tile) {
    const int tid = F.tid, cg = tid & 127, rs = tid >> 7; bf16_t* H = ws_bf(F, WS_H);
    const float* wsc = F.in[I_SCW] + (size_t)layer * 3 * D + 8 * cg; float wt[3][8];
#pragma unroll
    for (int i = 0; i < 3; ++i)
#pragma unroll
        for (int c = 0; c < 8; ++c) wt[i][c] = wsc[i * D + c];
    const int row0 = tile * 64 + 16 * rs; const bool smp = row0 >= NP; const int tt0 = smp ? 0 : row0 % SEQ;
    float u1[8], u2[8];
    if (tt0 >= 2) { float c8[8], h8[8];
        unpack8(*(const u32x4*)(H + (size_t)(row0 - 2) * DINP + C_SCC + 8 * cg), c8); unpack8(*(const u32x4*)(H + (size_t)(row0 - 2) * DINP + C_SCH + 8 * cg), h8);
#pragma unroll
        for (int c = 0; c < 8; ++c) u2[c] = c8[c] * h8[c];
        unpack8(*(const u32x4*)(H + (size_t)(row0 - 1) * DINP + C_SCC + 8 * cg), c8); unpack8(*(const u32x4*)(H + (size_t)(row0 - 1) * DINP + C_SCH + 8 * cg), h8);
#pragma unroll
        for (int c = 0; c < 8; ++c) u1[c] = c8[c] * h8[c]; }
    else if (smp) { const float* hp = F.in[I_SSC] + (((size_t)layer * DECB + ((row0 - NP) >> 4)) * 2) * D + 8 * cg;
#pragma unroll
        for (int c = 0; c < 8; ++c) { u2[c] = hp[c]; u1[c] = hp[D + c]; } }
    else {
#pragma unroll
        for (int c = 0; c < 8; ++c) { u2[c] = 0.f; u1[c] = 0.f; } }
#pragma unroll 1
    for (int q = 0; q < 4; ++q) {
        u32x4 cw_[4], hw_[4], bw_[4];
#pragma unroll
        for (int i = 0; i < 4; ++i) { const bf16_t* hp = H + (size_t)(row0 + 4 * q + i) * DINP + 8 * cg; cw_[i] = *(const u32x4*)(hp + C_SCC); hw_[i] = *(const u32x4*)(hp + C_SCH); bw_[i] = *(const u32x4*)(hp + C_SCB); }
        asm volatile("" ::: "memory");
#pragma unroll
        for (int i = 0; i < 4; ++i) { float c8[8], h8[8], b8[8], a[8]; unpack8(cw_[i], c8); unpack8(hw_[i], h8); unpack8(bw_[i], b8);
#pragma unroll
            for (int c = 0; c < 8; ++c) { const float u0 = c8[c] * h8[c]; a[c] = (u2[c] * wt[0][c] + u1[c] * wt[1][c] + u0 * wt[2][c]) * b8[c]; u2[c] = u1[c]; u1[c] = u0; }
            *(u32x4*)(H + (size_t)(row0 + 4 * q + i) * DINP + C_SCB + 8 * cg) = pack8(a); }
    }
}
__device__ __forceinline__ void state_out_unit(const Frame& F, int layer, int mb, int sl, bool smp) {
    const int tid = F.tid; const bf16_t* H = ws_bf(F, WS_H);
    const int nkv = smp ? DECS : WINDOW, len = smp ? DECS : SEQ; const size_t row0 = smp ? (size_t)NP + sl * 16 : (size_t)sl * SEQ; const int sg = smp ? sl : mb * NSEQ_MB + sl;
    const size_t nb_ = smp ? DECB : BATCH;
    float* ko = F.out + (smp ? O_KS : O_KP) + ((size_t)layer * nb_ + sg) * nkv * 256; float* vo = F.out + (smp ? O_VS : O_VP) + ((size_t)layer * nb_ + sg) * nkv * 256;
    for (int i = tid; i < nkv * 32; i += NTHREADS) { const int j = i >> 5, c8 = (i & 31) * 8; const bf16_t* hp = H + (row0 + len - nkv + j) * DINP; float f[8];
        unpack8(*(const u32x4*)(hp + C_K + c8), f); *(f32x4*)(ko + (size_t)j * 256 + c8) = (f32x4){f[0], f[1], f[2], f[3]}; *(f32x4*)(ko + (size_t)j * 256 + c8 + 4) = (f32x4){f[4], f[5], f[6], f[7]};
        unpack8(*(const u32x4*)(hp + C_V + c8), f); *(f32x4*)(vo + (size_t)j * 256 + c8) = (f32x4){f[0], f[1], f[2], f[3]}; *(f32x4*)(vo + (size_t)j * 256 + c8 + 4) = (f32x4){f[4], f[5], f[6], f[7]}; }
    float* co = F.out + (smp ? O_CVS : O_CVP) + ((size_t)layer * nb_ + sg) * 3 * CONVDIM;
    for (int i = tid; i < 3 * 512; i += NTHREADS) { const int j = i / 512, c8 = (i % 512) * 8; float f[8]; unpack8(*(const u32x4*)(H + (row0 + len - 3 + j) * DINP + C_X + c8), f);
        *(f32x4*)(co + (size_t)j * CONVDIM + c8) = (f32x4){f[0], f[1], f[2], f[3]}; *(f32x4*)(co + (size_t)j * CONVDIM + c8 + 4) = (f32x4){f[4], f[5], f[6], f[7]}; }
    float* so = F.out + (smp ? O_SCS : O_SCP) + ((size_t)layer * nb_ + sg) * 2 * D;
    for (int i = tid; i < 2 * 128; i += NTHREADS) { const int j = i >> 7, c8 = (i & 127) * 8; float c[8], h[8]; const bf16_t* hp = H + (row0 + len - 2 + j) * DINP;
        unpack8(*(const u32x4*)(hp + C_SCC + c8), c); unpack8(*(const u32x4*)(hp + C_SCH + c8), h);
        *(f32x4*)(so + (size_t)j * D + c8) = (f32x4){c[0] * h[0], c[1] * h[1], c[2] * h[2], c[3] * h[3]}; *(f32x4*)(so + (size_t)j * D + c8 + 4) = (f32x4){c[4] * h[4], c[5] * h[5], c[6] * h[6], c[7] * h[7]}; }
}
#ifndef MIX_MASK
#define MIX_MASK 0xFF
#endif
#define MIXON(b) ((MIX_MASK >> (b)) & 1)
__device__ __forceinline__ void step_premix(const Frame& F, int layer, int mb) {
    const int n_bc = NSEQ_MB * NCHUNK * 8, n_att = NSEQ_MB * NCHUNK * NKV, n_sc = rows_of(mb) / 64, n_so = NSEQ_MB + (mb == 0 ? DECB : 0);
    const int n_ss = mb == 0 ? DECB * 32 : 0, n_as = mb == 0 ? DECB * NKV : 0;
    const int total = n_bc + n_att + n_sc + n_so + n_ss + n_as;
#define UF(Fu) Frame Fu = F; Fu.lane = opq(lane_id()); Fu.tid = Fu.wave * 64 + Fu.lane
    PROBE_T0(14) if constexpr (MIXON(0)) { UF(Fu); BcRegs ra, rn_;
        if (F.bid < n_bc) ssd_bc_load(Fu, layer, F.bid, ra);
        for (int u = F.bid; u < n_bc; u += F.G) { const bool more = u + F.G < n_bc; if (more) ssd_bc_load(Fu, layer, u + F.G, rn_);
            ssd_bc_unit(Fu, u, ra);
            if (more) ra = rn_; } }
    PROBE_T1(14)
    for (int un = F.bid; un < total; un += F.G) { int r = un;
        if (r < n_bc) continue;
        r -= n_bc;
        if (r < n_att) { PROBE_T0(15) if constexpr (MIXON(1)) { UF(Fu);
                const int ra = (n_att % 8 == 0 && F.G % 8 == 0 && n_bc % F.G == 0) ? (r & 7) * (n_att >> 3) + (r >> 3) : r;
                attn_prompt_unit(Fu, layer, ra / (NCHUNK * NKV), (ra / NKV) % NCHUNK, ra % NKV); } PROBE_T1(15) continue; } r -= n_att;
        if (r < n_sc) { PROBE_T0(16) if constexpr (MIXON(2)) { UF(Fu); sc_unit(Fu, layer, r); } PROBE_T1(16) continue; } r -= n_sc;
        if (r < n_so) { PROBE_T0(17) if constexpr (MIXON(3)) { UF(Fu); state_out_unit(Fu, layer, mb, r < NSEQ_MB ? r : r - NSEQ_MB, r >= NSEQ_MB); } PROBE_T1(17) continue; } r -= n_so;
        if (r < n_ss) { PROBE_T0(18) if constexpr (MIXON(4)) { UF(Fu); ssd_sample_unit(Fu, layer, r >> 5, r & 31); } PROBE_T1(18) continue; } r -= n_ss;
        { PROBE_T0(19) if constexpr (MIXON(5)) { UF(Fu); attn_sample_unit(Fu, layer, r >> 2, r & 3); } PROBE_T1(19) }
    }
}
__device__ __forceinline__ void step_mixers(const Frame& F, int layer, int mb) {
    for (int v = F.bid; v < NSEQ_MB * 32; v += F.G) { const int un = (NSEQ_MB == 8 && F.G == 256) ? (v & 7) * 32 + (v >> 3) : v; UF(Fu); ssd_prompt_unit(Fu, layer, mb, un >> 5, un & 31); }
}
__device__ __forceinline__ void step_gnorm(const Frame& F, int mb) {
    const int gw = F.bid * NWAVES + F.wave, NGW = F.G * NWAVES, nr = rows_of(mb); bf16_t* H = ws_bf(F, WS_H); const float* ssq = ws_f(F, WS_SSQ);
    constexpr int RB = 4; const int g = F.lane >> 3;
    for (int r0 = gw; r0 < nr; r0 += RB * NGW) {
        u32x4 d[RB][4]; f32x4 q[RB];
#pragma unroll
        for (int i = 0; i < RB; ++i) { const int r = r0 + i * NGW < nr ? r0 + i * NGW : r0; { const f32x4 qa = *(const f32x4*)(ssq + (size_t)r * 64 + 8 * g), qb = *(const f32x4*)(ssq + (size_t)r * 64 + 8 * g + 4); q[i] = qa + qb; } const u32x4* p = (const u32x4*)(H + (size_t)r * DINP + C_Z + 32 * F.lane);
#pragma unroll
            for (int j = 0; j < 4; ++j) d[i][j] = p[j]; }
        asm volatile("" ::: "memory");
#pragma unroll
        for (int i = 0; i < RB; ++i) { const int r = r0 + i * NGW; if (r >= nr) continue;
            const float rstd = 1.0f / sqrtf(((q[i][0] + q[i][1]) + (q[i][2] + q[i][3])) * (1.0f / 256.0f) + LN_EPS); u32x4* p = (u32x4*)(H + (size_t)r * DINP + C_Z + 32 * F.lane);
#pragma unroll
            for (int j = 0; j < 4; ++j) { float f[8]; unpack8(d[i][j], f);
#pragma unroll
                for (int k = 0; k < 8; ++k) f[k] *= rstd;
                p[j] = pack8(f); } }
    }
}
constexpr int LOG_NEXP = NEXP == 32 ? 5 : (NEXP == 16 ? 4 : (NEXP == 8 ? 3 : 2));
template <int N, int MASK> struct RedStep {
    static __device__ __forceinline__ void run(float* v, int lane) {
        constexpr int Hn = N / 2; const bool up = (lane & MASK) != 0;
#pragma unroll
        for (int i = 0; i < Hn; ++i) { const float keep = up ? v[i + Hn] : v[i], send = up ? v[i] : v[i + Hn]; v[i] = keep + xshfl<MASK>(send); }
        if constexpr (Hn > 1) RedStep<Hn, (MASK >> 1)>::run(v, lane);
    }
};
__device__ __forceinline__ void step_ln1_router(const Frame& F, int layer, int mb) {
    LAS float* wT = (LAS float*)F.lds;
    const float* rw = F.in[I_RW] + (size_t)layer * D * NEXP;
    __syncthreads();
    for (int i = F.tid; i < D * NEXP; i += NTHREADS) { const int e = i / D, k = i % D; wT[i] = rw[(size_t)k * NEXP + e]; }
    unsigned* cnt = F.ctl + CW_CNT + (mb * DEPTH + layer) * 64;
    LAS unsigned* lcnt = (LAS unsigned*)(F.lds + MISC_OFF) + 128;
    if (F.tid < 64) lcnt[F.tid] = 0u;
    __syncthreads();
    const int gw = F.bid * NWAVES + F.wave, NGW = F.G * NWAVES, nr = rows_of(mb), lane = F.lane;
    const float* lg = F.in[I_LN1G] + (size_t)layer * D; const float* lb = F.in[I_LN1B] + (size_t)layer * D; const float* rb = F.in[I_RB] + (size_t)layer * NEXP;
    bf16_t* XB = ws_bf(F, WS_XB); int* topi = (int*)(F.ws + WS_TOPI); float* gate = ws_f(F, WS_GATE); int* pos = (int*)(F.ws + WS_POS);
    constexpr int RB = 4, NH = NEXP / 2, LOGH = LOG_NEXP - 1;
    const int myexp = ((lane & 1) * NH) | ((lane >> (6 - LOGH)) & (NH - 1));
    const float myb = rb[myexp];
    for (int r0 = gw; r0 < nr; r0 += RB * NGW) {
        f32x4 v[RB][4]; int rr[RB]; bool ok[RB];
#pragma unroll
        for (int i = 0; i < RB; ++i) { const int r = r0 + i * NGW; ok[i] = r < nr; rr[i] = ok[i] ? r : r0; const float* xr = x_out_row(F, mb, rr[i]);
#pragma unroll
            for (int j = 0; j < 4; ++j) v[i][j] = *((const f32x4*)xr + lane + 64 * j); }
        asm volatile("" ::: "memory");
#pragma unroll
        for (int i = 0; i < RB; ++i) {
            float s = 0.f;
#pragma unroll
            for (int j = 0; j < 4; ++j) s += (v[i][j][0] + v[i][j][1]) + (v[i][j][2] + v[i][j][3]);
            const float mean = wave_sum(s) * (1.0f / D); float s2 = 0.f;
#pragma unroll
            for (int j = 0; j < 4; ++j) { v[i][j] = v[i][j] - mean; s2 += (v[i][j][0] * v[i][j][0] + v[i][j][1] * v[i][j][1]) + (v[i][j][2] * v[i][j][2] + v[i][j][3] * v[i][j][3]); }
            const float rstd = 1.0f / sqrtf(wave_sum(s2) * (1.0f / D) + LN_EPS);
#pragma unroll
            for (int j = 0; j < 4; ++j) { const f32x4 gg = *((const f32x4*)lg + lane + 64 * j), bb = *((const f32x4*)lb + lane + 64 * j); v[i][j] = v[i][j] * rstd * gg + bb;
                if (ok[i]) { u32x2 w; w.x = pk2(v[i][j][0], v[i][j][1]); w.y = pk2(v[i][j][2], v[i][j][3]); *((u32x2*)(XB + (size_t)rr[i] * D) + lane + 64 * j) = w; } }
        }
        typedef float f32x2v __attribute__((ext_vector_type(2)));
        float val[RB];
#pragma unroll
        for (int hf = 0; hf < 2; ++hf) {
            float lgt[RB][NH];
#pragma unroll
            for (int e = 0; e < NH; ++e) { f32x2v a2[RB / 2];
#pragma unroll
                for (int i = 0; i < RB / 2; ++i) a2[i] = (f32x2v){0.f, 0.f};
#pragma unroll
                for (int j = 0; j < 4; ++j) { const f32x4 wv = *((const LAS f32x4*)(wT + (hf * NH + e) * D) + lane + 64 * j);
#pragma unroll
                    for (int c = 0; c < 4; ++c) { const f32x2v w2 = (f32x2v){wv[c], wv[c]};
#pragma unroll
                        for (int i = 0; i < RB / 2; ++i) a2[i] = __builtin_elementwise_fma((f32x2v){v[2 * i][j][c], v[2 * i + 1][j][c]}, w2, a2[i]); } }
#pragma unroll
                for (int i = 0; i < RB / 2; ++i) { lgt[2 * i][e] = a2[i].x; lgt[2 * i + 1][e] = a2[i].y; }
                if ((e & 1) == 1) asm volatile("" ::: "memory"); }
#pragma unroll
            for (int i = 0; i < RB; ++i) { RedStep<NH, 32>::run(lgt[i], lane); float tot = lgt[i][0];
                if constexpr ((32 >> LOGH) >= 8) tot += xshfl<8>(tot);
                if constexpr ((32 >> LOGH) >= 4) tot += xshfl<4>(tot);
                if constexpr ((32 >> LOGH) >= 2) tot += xshfl<2>(tot);
                tot += xshfl<1>(tot);
                if ((lane & 1) == hf) val[i] = tot + myb; }
        }
#pragma unroll
        for (int i = 0; i < RB; ++i) {
            float tv[4]; int te[4]; float vv = val[i];
#pragma unroll
            for (int k = 0; k < 4; ++k) { float m = vv; m = fmaxf(m, xshfl<1>(m)); m = fmaxf(m, xshfl<2>(m)); m = fmaxf(m, xshfl<4>(m)); m = fmaxf(m, xshfl<8>(m)); m = fmaxf(m, xshfl<16>(m)); m = fmaxf(m, xshfl<32>(m));
                const unsigned long long bal = __ballot(vv == m); const int wl = __builtin_ctzll(bal);
                const int be = ((wl & 1) * NH) | ((wl >> (6 - LOGH)) & (NH - 1));
                tv[k] = m; te[k] = be; if (myexp == be) vv = -3.0e38f; }
            const float e1 = fexp(tv[1] - tv[0]), e2 = fexp(tv[2] - tv[0]), e3 = fexp(tv[3] - tv[0]); const float inv = 1.0f / (1.0f + e1 + e2 + e3);
            if (lane < 4 && ok[i]) { const int e = lane == 0 ? te[0] : (lane == 1 ? te[1] : (lane == 2 ? te[2] : te[3])); const float gv = (lane == 0 ? 1.0f : (lane == 1 ? e1 : (lane == 2 ? e2 : e3))) * inv;
                const unsigned rk = __hip_atomic_fetch_add(lcnt + e, 1u, __ATOMIC_RELAXED, __HIP_MEMORY_SCOPE_WORKGROUP);
                topi[(size_t)rr[i] * 4 + lane] = e; gate[(size_t)rr[i] * 4 + lane] = gv; pos[(size_t)rr[i] * 4 + lane] = (int)rk; }
        }
    }
    __syncthreads();
    if (F.tid < NEXP) lcnt[32 + F.tid] = __hip_atomic_fetch_add(cnt + F.tid, lcnt[F.tid], __ATOMIC_RELAXED, __HIP_MEMORY_SCOPE_AGENT);
    __syncthreads();
    for (int r = gw; r < nr; r += NGW) if (lane < 4) pos[(size_t)r * 4 + lane] += (int)lcnt[32 + topi[(size_t)r * 4 + lane]];
}
__device__ __forceinline__ int moe_table(const Frame& F, int layer, int mb) {
    LAS int* M = (LAS int*)(F.lds + MISC_OFF);
    __syncthreads();
    if (F.tid == 0) { unsigned* cnt = F.ctl + CW_CNT + (mb * DEPTH + layer) * 64; int acc = 0;
        for (int e = 0; e < NEXP; ++e) { const int c = (int)__hip_atomic_load(cnt + e, __ATOMIC_RELAXED, __HIP_MEMORY_SCOPE_AGENT); M[64 + e] = acc * 256; acc += (c + 255) / 256; M[16 + e] = acc; } }
    __syncthreads();
    return M[16 + NEXP - 1];
}
__device__ __forceinline__ void step_gather(const Frame& F, int layer, int mb) {
    (void)moe_table(F, layer, mb); const LAS int* M = (const LAS int*)(F.lds + MISC_OFF);
    const int nr = rows_of(mb);
    const int* topi = (const int*)(F.ws + WS_TOPI); const float* gate = ws_f(F, WS_GATE); int* pos = (int*)(F.ws + WS_POS); float* gs = ws_f(F, WS_GSORT); int* rtok = (int*)(F.ws + WS_RTOK);
#pragma nounroll
    for (int i = F.bid * NTHREADS + F.tid; i < nr * 4; i += F.G * NTHREADS) { const int p = M[64 + topi[i]] + pos[i]; pos[i] = p; rtok[p] = i >> 2; gs[p] = gate[i]; }
}
__device__ __forceinline__ void step_ln2(const Frame& F, int layer, int mb) {
    const int gw = F.bid * NWAVES + F.wave, NGW = F.G * NWAVES, nr = rows_of(mb), lane = F.lane;
    const float* lg = F.in[I_LN2G] + (size_t)layer * D; const float* lb = F.in[I_LN2B] + (size_t)layer * D;
    const bf16_t* OUTS = ws_bf(F, WS_H) + (size_t)2 * RP * D; const int* pos = (const int*)(F.ws + WS_POS); bf16_t* XB = ws_bf(F, WS_XB);
    constexpr int RB = 2;
    for (int r0 = gw; r0 < nr; r0 += RB * NGW) {
        f32x4 v[RB][4]; u32x2 ow[RB][4][4]; int rr[RB];
#pragma unroll
        for (int i = 0; i < RB; ++i) { rr[i] = r0 + i * NGW < nr ? r0 + i * NGW : r0; const u32x2* xr = (const u32x2*)(XB + (size_t)rr[i] * D); int p[4];
#pragma unroll
            for (int k = 0; k < 4; ++k) p[k] = pos[(size_t)rr[i] * 4 + k];
#pragma unroll
            for (int j = 0; j < 4; ++j) { { const u32x2 w = xr[lane + 64 * j]; v[i][j] = (f32x4){blo(w.x), bhi(w.x), blo(w.y), bhi(w.y)}; }
#pragma unroll
                for (int k = 0; k < 4; ++k) ow[i][k][j] = *((const u32x2*)(OUTS + (size_t)p[k] * D) + lane + 64 * j); } }
        asm volatile("" ::: "memory");
#pragma unroll
        for (int i = 0; i < RB; ++i) { if (r0 + i * NGW >= nr) continue;
            float* xr = x_out_row(F, mb, rr[i]); float s = 0.f;
#pragma unroll
            for (int j = 0; j < 4; ++j) { v[i][j] = v[i][j] * ALPHA;
#pragma unroll
                for (int k = 0; k < 4; ++k) { const u32x2 w = ow[i][k][j]; v[i][j] = v[i][j] + (f32x4){blo(w.x), bhi(w.x), blo(w.y), bhi(w.y)}; }
                s += (v[i][j][0] + v[i][j][1]) + (v[i][j][2] + v[i][j][3]); }
            const float mean = wave_sum(s) * (1.0f / D); float s2 = 0.f;
#pragma unroll
            for (int j = 0; j < 4; ++j) { v[i][j] = v[i][j] - mean; s2 += (v[i][j][0] * v[i][j][0] + v[i][j][1] * v[i][j][1]) + (v[i][j][2] * v[i][j][2] + v[i][j][3] * v[i][j][3]); }
            const float rstd = 1.0f / sqrtf(wave_sum(s2) * (1.0f / D) + LN_EPS);
#pragma unroll
            for (int j = 0; j < 4; ++j) { const f32x4 gg = *((const f32x4*)lg + lane + 64 * j), bb = *((const f32x4*)lb + lane + 64 * j); v[i][j] = v[i][j] * rstd * gg + bb;
                *((f32x4*)xr + lane + 64 * j) = v[i][j]; u32x2 w; w.x = pk2(v[i][j][0], v[i][j][1]); w.y = pk2(v[i][j][2], v[i][j][3]); *((u32x2*)(XB + (size_t)rr[i] * D) + lane + 64 * j) = w; } }
    }
}

constexpr int SP_P = 68;
template <int KS  > __device__ __forceinline__ void small_mma(const bf16_t* A, int lda, const bf16_t* Bt, int K, int tok0, int n0, int k0, int fr, int fq, f32x4 (&acc)[4]) {
    const bf16_t* ap = A + (size_t)(tok0 + fr) * lda + k0 + 8 * fq; const bf16_t* bp = Bt + (size_t)(n0 + fr) * K + k0 + 8 * fq;
#pragma unroll
    for (int k = 0; k < KS; k += 32) { const bf16x8 a = *(const bf16x8*)(ap + k);
#pragma unroll
        for (int jj = 0; jj < 4; ++jj) { const bf16x8 x = *(const bf16x8*)(bp + (size_t)16 * jj * K + k); acc[jj] = __builtin_amdgcn_mfma_f32_16x16x32_bf16(x, a, acc[jj], 0, 0, 0); } }
}
template <int MODE  >
__device__ __forceinline__ void sample_unit(const Frame& F, int layer, int u) {
    const int tid = F.tid, lane = F.lane, w = F.wave, fr = lane & 15, fq = lane >> 4; const int tok0 = NP + 16 * (u >> 4), n0 = 64 * (u & 15);
    LAS float* P = (LAS float*)F.lds;
    const bf16_t* H = ws_bf(F, WS_H); const size_t trow = (size_t)(tok0 + fr);
    f32x4 v[4];
#pragma unroll
    for (int jj = 0; jj < 4; ++jj) v[jj] = (f32x4){0.f, 0.f, 0.f, 0.f};
    if constexpr (MODE == 0) {
#pragma unroll
        for (int b = 0; b < 3; ++b) { f32x4 acc[4] = {(f32x4){0.f, 0.f, 0.f, 0.f}, (f32x4){0.f, 0.f, 0.f, 0.f}, (f32x4){0.f, 0.f, 0.f, 0.f}, (f32x4){0.f, 0.f, 0.f, 0.f}};
            if (b == 0) small_mma<DINNER / 8>(H + C_Z, DINP, wl_ptr(F, layer, WL_SSD), DINNER, tok0, n0, w * (DINNER / 8), fr, fq, acc);
            else small_mma<D / 8>(H + (b == 1 ? C_Q : C_SCB), DINP, wl_ptr(F, layer, b == 1 ? WL_ATT : WL_SC), D, tok0, n0, w * (D / 8), fr, fq, acc);
#pragma unroll
            for (int jj = 0; jj < 4; ++jj) { const u32x2 gw = *(const u32x2*)(H + trow * DINP + (b == 0 ? C_GSSD : (b == 1 ? C_GATT : C_GSC)) + n0 + 16 * jj + 4 * fq);
                v[jj] = v[jj] + acc[jj] * (f32x4){fsigmoid(blo(gw.x)), fsigmoid(bhi(gw.x)), fsigmoid(blo(gw.y)), fsigmoid(bhi(gw.y))}; } }
    } else small_mma<D / 8>(ws_bf(F, WS_XB), D, wl_ptr(F, layer, WL_O), D, tok0, n0, w * (D / 8), fr, fq, v);
    __syncthreads();
#pragma unroll
    for (int jj = 0; jj < 4; ++jj) *(LAS f32x4*)(P + (w * 16 + fr) * SP_P + 16 * jj + 4 * fq) = v[jj];
    __syncthreads();
    { const int tk = tid >> 5, c2 = 2 * (tid & 31); float s0 = 0.f, s1 = 0.f;
#pragma unroll
      for (int ww = 0; ww < 8; ++ww) { s0 += P[(ww * 16 + tk) * SP_P + c2]; s1 += P[(ww * 16 + tk) * SP_P + c2 + 1]; }
      const size_t orow = (size_t)(tok0 + tk);
      if constexpr (MODE == 0) *(unsigned*)(ws_bf(F, WS_XB) + orow * D + n0 + c2) = pk2(s0, s1);
      else { const float* xs = (layer == 0 ? F.in[I_XS] : F.out + O_YS) + (orow - NP) * D + n0 + c2; float* os = F.out + O_YS + (orow - NP) * D + n0 + c2; os[0] = xs[0] * ALPHA + s0; os[1] = xs[1] * ALPHA + s1; } }
}

constexpr int PH_PER = 11, NSTEPS = 1 + NMB * DEPTH * PH_PER;
__global__ void __launch_bounds__(NTHREADS, 2) fwd(Args args) {
#ifdef EMU
    unsigned char* lds = emu_wg->lds;
#else
    extern __shared__ __attribute__((aligned(16))) unsigned char lds[];
#endif
    Frame F0; F0.lds = (LAS unsigned char*)lds; F0.tid = threadIdx.x; F0.lane = F0.tid & 63; F0.wave = __builtin_amdgcn_readfirstlane(F0.tid >> 6); F0.G = gridDim.x; F0.bid = blockIdx.x;
#ifdef EMU
    F0.in = args.in;
#else
    F0.in = (ArgTab)__builtin_amdgcn_kernarg_segment_ptr();
    static_assert(offsetof(Args, out) == 248 && offsetof(Args, ws) == 256 && offsetof(Args, in) == 0, "PF() reads the argument struct by offset");
#endif
    F0.out = args.out; F0.ws = args.ws; F0.ctl = (unsigned*)(args.ws + WS_CTL);
    const Frame& F = F0;
    const int lo = args.lo, hi = args.hi;
#ifndef EMU
    for (int u = F.tid; u < (LDS_BYTES - MISC_OFF) / 4; u += NTHREADS) ((LAS unsigned*)(F.lds + MISC_OFF))[u] = 0u;
    __syncthreads();
    XcdBarrier bar; bar.bar = F.ctl + CW_BAR; bar.x = 0; bar.st = nullptr;
    if (hi - lo > 1) bar = xcd_barrier_post(F.ctl + CW_BAR, (volatile LAS unsigned*)(F.lds + MISC_OFF) + 8);
#define SEAM(s) do { if ((s) + 1 < hi) { XcdBarrier b2_ = bar; unsigned long long bp_ = (unsigned long long)b2_.bar; asm volatile("" : "+s"(bp_)); b2_.bar = (unsigned*)bp_; xcd_barrier(b2_); } } while (0)
#else
#define SEAM(s) do { } while (0)
#endif
#ifndef PH_MASK
#define PH_MASK 0xFFFFFFFF
#endif
#define IN(s) (lo <= (s) && (s) < hi)
#define PHON(b) ((PH_MASK >> (b)) & 1)
#ifdef EMU
#define PF(Fp) Frame Fp = F0
#else
#define PF(Fp) Frame Fp; { unsigned long long kp_ = (unsigned long long)__builtin_amdgcn_kernarg_segment_ptr(); asm volatile("" : "+s"(kp_)); \
    Fp.in = (ArgTab)kp_; Fp.out = *(float* const __attribute__((address_space(4)))*)(kp_ + 248); Fp.ws = *(unsigned char* const __attribute__((address_space(4)))*)(kp_ + 256); Fp.ctl = (unsigned*)Fp.ws; \
    Fp.lds = F0.lds; Fp.G = F0.G; Fp.bid = F0.bid; Fp.wave = F0.wave; Fp.lane = opq(lane_id()); Fp.tid = Fp.wave * 64 + Fp.lane; }
#endif
    int step = 0;
    if (IN(step)) { PROBE_T0(0) if constexpr (PHON(0)) { PF(F); step_weights(F); for (int m = 0; m < NMB; ++m) step_xb(F, m); } PROBE_T1(0) SEAM(step); }
    ++step;
#define PHV const int mb = opqs(mb0), layer = opqs(layer0), nr = rows_of(mb); (void)nr; (void)layer
    for (int mb0 = 0; mb0 < NMB; ++mb0)
        for (int layer0 = 0; layer0 < DEPTH; ++layer0) {
            if (IN(step)) { PROBE_T0(2) if constexpr (PHON(2)) { PF(F); PHV; pg8::Gemm g{layer == 0 ? ws_bf(F, WS_XB0) + (size_t)mb * R * D : ws_bf(F, WS_XB), wl_ptr(F, layer, WL_IN), nr, DINP, D, D, nullptr}; pg8::StaticOrder S; S.init(nr, DINP, F.G, F.bid, 2);
                pg8::EpiStoreBf16 E{ws_bf(F, WS_H), DINP}; pg8::gemm_phase(F.lds, g, S, E, F.wave); } PROBE_T1(2) SEAM(step); }
            ++step;
            if (IN(step)) { PROBE_T0(13) if constexpr (PHON(13)) { PF(F); PHV; step_premix(F, layer, mb); } PROBE_T1(13) SEAM(step); }
            ++step;
            if (IN(step)) { PROBE_T0(3) if constexpr (PHON(3)) { PF(F); PHV; step_mixers(F, layer, mb); } PROBE_T1(3) SEAM(step); }
            ++step;
            if (IN(step)) { PROBE_T0(4) if constexpr (PHON(4)) { PF(F); PHV; step_gnorm(F, mb); } PROBE_T1(4) SEAM(step); }
            ++step;
            if (IN(step)) { PROBE_T0(5) if constexpr (PHON(5)) { PF(F); PHV; pg8::StaticOrder S; S.init(NP, D, F.G, F.bid); bf16_t* H = ws_bf(F, WS_H); bf16_t* MGb = ws_bf(F, WS_XB);
#ifndef MERGE_MASK
#define MERGE_MASK 7
#endif
                if constexpr (MERGE_MASK & 1) { pg8::Gemm g{H + C_Z, wl_ptr(F, layer, WL_SSD), NP, D, DINNER, DINP, nullptr}; pg8::EpiGate<0> E{H + C_GSSD, MGb}; pg8::gemm_phase(F.lds, g, S, E, F.wave); }
                if constexpr (MERGE_MASK & 2) { pg8::Gemm g{H + C_Q, wl_ptr(F, layer, WL_ATT), NP, D, D, DINP, nullptr}; pg8::EpiGate<1> E{H + C_GATT, MGb}; pg8::gemm_phase(F.lds, g, S, E, F.wave); }
                if constexpr (MERGE_MASK & 4) { pg8::Gemm g{H + C_SCB, wl_ptr(F, layer, WL_SC), NP, D, D, DINP, nullptr}; pg8::EpiGate<1> E{H + C_GSC, MGb}; pg8::gemm_phase(F.lds, g, S, E, F.wave); }
                if (mb == 0) for (int u = F.bid; u < 256; u += F.G) sample_unit<0>(F, layer, u); }
                PROBE_T1(5) SEAM(step); }
            ++step;
            if (IN(step)) { PROBE_T0(6) if constexpr (PHON(6)) { PF(F); PHV; pg8::Gemm g{ws_bf(F, WS_XB), wl_ptr(F, layer, WL_O), NP, D, D, D, nullptr}; pg8::StaticOrder S; S.init(NP, D, F.G, F.bid);
                pg8::EpiResid E{layer == 0 ? F.in[I_XP] + (size_t)mb * NP * D : F.out + O_YP + (size_t)mb * NP * D, layer == 0 ? F.in[I_XS] : F.out + O_YS, F.out + O_YP + (size_t)mb * NP * D, F.out + O_YS};
                pg8::gemm_phase(F.lds, g, S, E, F.wave);
                if (mb == 0) for (int u = F.bid; u < 256; u += F.G) sample_unit<1>(F, layer, u); } PROBE_T1(6) SEAM(step); }
            ++step;
            if (IN(step)) { PROBE_T0(7) if constexpr (PHON(7)) { PF(F); PHV; step_ln1_router(F, layer, mb); } PROBE_T1(7) SEAM(step); }
            ++step;
            if (IN(step)) { PROBE_T0(8) if constexpr (PHON(8)) { PF(F); PHV; step_gather(F, layer, mb); } PROBE_T1(8) SEAM(step); }
            ++step;
            if (IN(step)) { PROBE_T0(9) if constexpr (PHON(9)) { PF(F); PHV; const int nt = moe_table(F, layer, mb); pg8::MoeOrder S{(const LAS int*)(F.lds + MISC_OFF) + 16, 8, nt * 8, F.G, F.bid};
                pg8::Gemm g{ws_bf(F, WS_XB), wl_ptr(F, layer, WL_UP), nr  , 2048, D, D, (const int*)(F.ws + WS_RTOK)}; pg8::EpiSwiglu E{ws_bf(F, WS_H) + (size_t)RP * D, F.in[I_BUP] + (size_t)layer * NEXP * 2048};
                pg8::gemm_phase<pg8::EpiSwiglu, pg8::MoeOrder, true>(F.lds, g, S, E, F.wave); } PROBE_T1(9) SEAM(step); }
            ++step;
            if (IN(step)) { PROBE_T0(10) if constexpr (PHON(10)) { PF(F); PHV; const int nt = moe_table(F, layer, mb); pg8::MoeOrder S{(const LAS int*)(F.lds + MISC_OFF) + 16, 4, nt * 4, F.G, F.bid};
                pg8::Gemm g{ws_bf(F, WS_H) + (size_t)RP * D, wl_ptr(F, layer, WL_DN), nt * 256, D, D, D, nullptr}; pg8::EpiDown E{ws_bf(F, WS_H) + (size_t)2 * RP * D, F.in[I_BDN] + (size_t)layer * NEXP * D, ws_f(F, WS_GSORT)};
                pg8::gemm_phase(F.lds, g, S, E, F.wave); } PROBE_T1(10) SEAM(step); }
            ++step;
            if (IN(step)) { PROBE_T0(11) if constexpr (PHON(11)) { PF(F); PHV; step_ln2(F, layer, mb); } PROBE_T1(11) SEAM(step); }
            ++step;
        }
}

#ifdef EMU
extern int emu_grid, emu_step_lo, emu_step_hi;
#endif
extern "C" void kernel_launch(void* const* d_in, const int* in_sizes, int n_in, void* d_out, int out_size, void* d_ws, size_t ws_size, hipStream_t stream) {
    (void)in_sizes; (void)out_size;
    if (n_in != 31 || ws_size < WS_END) { fprintf(stderr, "kernel_launch: expected 31 inputs and >= %zu bytes of workspace (got %d, %zu)\n", (size_t)WS_END, n_in, ws_size); return; }
    Args a; memset(&a, 0, sizeof(a));
    for (int i = 0; i < 31; ++i) a.in[i] = (const float*)d_in[i];
    a.out = (float*)d_out; a.ws = (unsigned char*)d_ws;
#ifdef EMU
    if (emu_step_lo == 0) memset((char*)d_ws + WS_CTL, 0, CTL_BYTES);
    for (int s = emu_step_lo; s < emu_step_hi && s < NSTEPS; ++s) { a.lo = s; a.hi = s + 1; emu_launch(fwd, emu_grid, NTHREADS, LDS_BYTES, a); fprintf(stderr, "step %d done\n", s); }
#else
    (void)hipMemsetAsync((char*)d_ws + WS_CTL, 0, CTL_BYTES, stream);
    static int grid = 0;
    if (grid == 0) {
        int dev = 0, cus = 0;
        if (hipGetDevice(&dev) != hipSuccess || hipDeviceGetAttribute(&cus, hipDeviceAttributeMultiprocessorCount, dev) != hipSuccess) { grid = -1; return; }
        if (hipFuncSetAttribute((const void*)fwd, hipFuncAttributeMaxDynamicSharedMemorySize, LDS_BYTES) != hipSuccess) { grid = -1; return; }
        int per_cu = 0; (void)hipOccupancyMaxActiveBlocksPerMultiprocessor(&per_cu, (const void*)fwd, NTHREADS, LDS_BYTES); (void)hipGetLastError();
        grid = cus / 64 * 64;
        if (grid < 64) { grid = -1; return; }
    }
    if (grid < 0) return;
#if CFG_ONE_LAUNCH
    a.lo = 0; a.hi = NSTEPS; hipLaunchKernelGGL(fwd, dim3(grid), dim3(NTHREADS), LDS_BYTES, stream, a);
#else
    for (int s = 0; s < NSTEPS; ++s) { a.lo = s; a.hi = s + 1; hipLaunchKernelGGL(fwd, dim3(grid), dim3(NTHREADS), LDS_BYTES, stream, a); }
#endif
#endif
}
```

```cpp
#ifdef EMU
#include "emu.h"
#else
#include <hip/hip_runtime.h>
#endif
#include <cstdio>
#include <cstdint>
#include <cstring>
#include <cstddef>
#include <cmath>

#ifndef CFG_BATCH
#define CFG_BATCH 16
#endif
#ifndef CFG_SEQ
#define CFG_SEQ 4096
#endif
#ifndef CFG_NSEQ_MB
#define CFG_NSEQ_MB 8
#endif
#ifndef CFG_NEXP
#define CFG_NEXP 32
#endif
#ifndef CFG_ONE_LAUNCH
#define CFG_ONE_LAUNCH 1
#endif

constexpr int BATCH = CFG_BATCH, SEQ = CFG_SEQ, NSEQ_MB = CFG_NSEQ_MB, NEXP = CFG_NEXP, NMB = BATCH / NSEQ_MB;
constexpr int D = 1024, DEPTH = 2, DECB = 16, DECS = 16, NS = DECB * DECS;
constexpr int DINNER = 2048, CONVDIM = 4096;
constexpr int NKV = 4, WINDOW = 128, CHUNK = 64;
constexpr int DIN = 13856, DINP = 14080;
constexpr int NP = NSEQ_MB * SEQ, R = NP + NS;
constexpr int NTE = (NEXP + 15) / 16;
constexpr int RP = ((4 * R + NEXP * 255) + 255) / 256 * 256;
constexpr int NCHUNK = SEQ / CHUNK;
constexpr int C_Z = 0, C_X = 2048, C_B = 4096, C_C = 5120, C_Q = 6144, C_K = 7168, C_V = 7424, C_SCB = 7680, C_SCC = 8704, C_SCH = 9728, C_GSSD = 10752, C_GATT = 11776, C_GSC = 12800, C_DT = 13824;
constexpr float LN_EPS = 1e-5f, ALPHA = 1.41421356237309515f  , SW_LIMIT = 7.0f, SW_ALPHA = 1.702f;
static_assert(BATCH % NSEQ_MB == 0 && SEQ % 256 == 0 && (NEXP & (NEXP - 1)) == 0 && NEXP <= 32 && NEXP >= 4, "config");

constexpr size_t O_YP = 0, O_YS = O_YP + (size_t)BATCH * SEQ * D, O_KP = O_YS + (size_t)NS * D, O_VP = O_KP + (size_t)DEPTH * BATCH * WINDOW * 256,
    O_SSP = O_VP + (size_t)DEPTH * BATCH * WINDOW * 256, O_CVP = O_SSP + (size_t)DEPTH * BATCH * 32 * 64 * 128, O_SCP = O_CVP + (size_t)DEPTH * BATCH * 3 * CONVDIM,
    O_KS = O_SCP + (size_t)DEPTH * BATCH * 2 * D, O_VS = O_KS + (size_t)DEPTH * DECB * DECS * 256, O_SSS = O_VS + (size_t)DEPTH * DECB * DECS * 256,
    O_CVS = O_SSS + (size_t)DEPTH * DECB * 32 * 64 * 128, O_SCS = O_CVS + (size_t)DEPTH * DECB * 3 * CONVDIM, O_END = O_SCS + (size_t)DEPTH * DECB * 2 * D;

constexpr size_t al256(size_t x) { return (x + 255) / 256 * 256; }
constexpr size_t WS_CTL = 0, CTL_BYTES = 1u << 20;
constexpr size_t WS_SSQ = CTL_BYTES, WS_TOPI = WS_SSQ + al256((size_t)R * 64 * 4), WS_GATE = WS_TOPI + al256((size_t)R * 16), WS_POS = WS_GATE + al256((size_t)R * 16),
    WS_GSORT = WS_POS + al256((size_t)R * 16), WS_RTOK = WS_GSORT + al256((size_t)RP * 4),
    WS_RWH = WS_RTOK + al256((size_t)RP * 4)  , WS_RWL = WS_RWH + (size_t)DEPTH * NTE * 16 * D * 2  , WS_W = WS_RWL + (size_t)DEPTH * NTE * 16 * D * 2;
constexpr size_t WL_IN = 0, WL_SSD = WL_IN + (size_t)DINP * D * 2, WL_ATT = WL_SSD + (size_t)D * DINNER * 2, WL_SC = WL_ATT + (size_t)D * D * 2, WL_O = WL_SC + (size_t)D * D * 2,
    WL_UP = WL_O + (size_t)D * D * 2, WL_DN = WL_UP + (size_t)NEXP * 2048 * D * 2, WL_BYTES = WL_DN + (size_t)NEXP * D * D * 2;
constexpr size_t WS_XB = WS_W + DEPTH * WL_BYTES, WS_XB0 = WS_XB + (size_t)R * D * 2  , WS_PRE = WS_XB0 + (size_t)NMB * R * D * 2  , WS_H = WS_PRE + (size_t)R * D * 2;
constexpr size_t H_BYTES = (size_t)R * DINP * 2, MOE_BYTES = (size_t)3 * RP * D * 2, U_BYTES = H_BYTES > MOE_BYTES ? H_BYTES : MOE_BYTES;
constexpr size_t WS_CMC = WS_H + U_BYTES, WS_BTG = WS_CMC + (size_t)NP * 1024 * 2, WS_CBG = WS_BTG + (size_t)NSEQ_MB * NCHUNK * 8 * 8192 * 2, WS_END = WS_CBG + (size_t)NSEQ_MB * NCHUNK * 8 * 4096 * 2;
static_assert(WS_END <= ((size_t)2 << 30), "workspace map exceeds 2 GiB");
constexpr int CW_BAR = 4096, CW_CNT = 16384;

constexpr int RING_BYTES = 131072, LDS_BYTES = 163840  , MISC_OFF = LDS_BYTES - 1024, SCR_BYTES = MISC_OFF;
constexpr int NWAVES = 8, NTHREADS = 512;

#ifdef EMU
#define LAS
#define WAVE_SYNC() emu_wave_barrier()
#else
#define LAS __attribute__((address_space(3)))
#define WAVE_SYNC() asm volatile("s_waitcnt lgkmcnt(0)" ::: "memory")
#endif
#ifdef EMU
#define LBAR() emu_wg_barrier()
#define VM_WAIT(n) do { } while (0)
#else
#define LBAR() do { asm volatile("s_waitcnt lgkmcnt(0)" ::: "memory"); __builtin_amdgcn_s_barrier(); asm volatile("" ::: "memory"); } while (0)
#define VM_WAIT(n) asm volatile("s_waitcnt vmcnt(" #n ")" ::: "memory")
#endif
typedef unsigned short bf16_t;
typedef short bf16x8 __attribute__((ext_vector_type(8)));
typedef float f32x4 __attribute__((ext_vector_type(4)));
typedef float f32x16 __attribute__((ext_vector_type(16)));
typedef unsigned u32x4 __attribute__((ext_vector_type(4)));
typedef unsigned u32x2 __attribute__((ext_vector_type(2)));

__device__ __forceinline__ unsigned f2bf(float f) { unsigned u = __builtin_bit_cast(unsigned, f); return (u + 0x7fffu + ((u >> 16) & 1u)) >> 16; }
__device__ __forceinline__ float bf2f(unsigned h) { return __builtin_bit_cast(float, (h & 0xffffu) << 16); }
#ifdef EMU
__device__ __forceinline__ unsigned pk2(float lo, float hi) { return f2bf(lo) | (f2bf(hi) << 16); }
#else
typedef float f32x2_t __attribute__((ext_vector_type(2))); typedef __bf16 bf16x2_t __attribute__((ext_vector_type(2)));
__device__ __forceinline__ unsigned pk2(float lo, float hi) { f32x2_t v = {lo, hi}; bf16x2_t b = __builtin_convertvector(v, bf16x2_t); return __builtin_bit_cast(unsigned, b); }
#endif
#ifdef EMU
__device__ __forceinline__ unsigned short bf1(float f) { return (unsigned short)f2bf(f); }
#else
__device__ __forceinline__ unsigned short bf1(float f) { return (unsigned short)pk2(f, f); }
#endif
__device__ __forceinline__ float blo(unsigned w) { return __builtin_bit_cast(float, w << 16); }
__device__ __forceinline__ float bhi(unsigned w) { return __builtin_bit_cast(float, w & 0xffff0000u); }
__device__ __forceinline__ void unpack8(const u32x4 w, float* f) { f[0] = blo(w.x); f[1] = bhi(w.x); f[2] = blo(w.y); f[3] = bhi(w.y); f[4] = blo(w.z); f[5] = bhi(w.z); f[6] = blo(w.w); f[7] = bhi(w.w); }
__device__ __forceinline__ u32x4 pack8(const float* f) { u32x4 w; w.x = pk2(f[0], f[1]); w.y = pk2(f[2], f[3]); w.z = pk2(f[4], f[5]); w.w = pk2(f[6], f[7]); return w; }
__device__ __forceinline__ float fexp(float x) { return __builtin_amdgcn_exp2f(x * 1.4426950408889634f); }
__device__ __forceinline__ float fsigmoid(float x) { return __builtin_amdgcn_rcpf(1.0f + __builtin_amdgcn_exp2f(-1.4426950408889634f * x)); }
__device__ __forceinline__ float fsilu(float x) { return x * fsigmoid(x); }
#ifdef EMU
__device__ __forceinline__ int opq(int x) { return x; }
#else
__device__ __forceinline__ int opq(int x) { asm volatile("" : "+v"(x)); return x; }
#endif
#ifdef EMU
__device__ __forceinline__ int opqs(int x) { return x; }
#else
__device__ __forceinline__ int opqs(int x) { asm volatile("" : "+s"(x)); return x; }
#endif
#ifdef EMU
__device__ __forceinline__ int lane_id() { return (int)(threadIdx.x & 63); }
#else
__device__ __forceinline__ int lane_id() { return (int)__builtin_amdgcn_mbcnt_hi(~0u, __builtin_amdgcn_mbcnt_lo(~0u, 0u)); }
#endif
#ifdef EMU
template <int MASK> __device__ __forceinline__ unsigned xshfl_u(unsigned x) { return __shfl_xor(x, MASK); }
#else
template <int MASK> __device__ __forceinline__ unsigned xshfl_u(unsigned x) {
    if constexpr (MASK == 1) return (unsigned)__builtin_amdgcn_update_dpp((int)x, (int)x, 0xB1, 0xF, 0xF, false);
    else if constexpr (MASK == 2) return (unsigned)__builtin_amdgcn_update_dpp((int)x, (int)x, 0x4E, 0xF, 0xF, false);
    else if constexpr (MASK == 4) { const int t = __builtin_amdgcn_update_dpp((int)x, (int)x, 0x114, 0xF, 0xA, false);
        return (unsigned)__builtin_amdgcn_update_dpp(t, (int)x, 0x104, 0xF, 0x5, false); }
    else if constexpr (MASK == 8) return (unsigned)__builtin_amdgcn_update_dpp((int)x, (int)x, 0x128, 0xF, 0xF, false);
    else if constexpr (MASK == 16) { const auto rr = __builtin_amdgcn_permlane16_swap(x, x, false, false); return (lane_id() & 16) ? rr[0] : rr[1]; }
    else { const auto rr = __builtin_amdgcn_permlane32_swap(x, x, false, false); return (lane_id() & 32) ? rr[0] : rr[1]; }
}
#endif
template <int MASK> __device__ __forceinline__ float xshfl(float x) { return __builtin_bit_cast(float, xshfl_u<MASK>(__builtin_bit_cast(unsigned, x))); }
template <int MASK> __device__ __forceinline__ int xshfl(int x) { return (int)xshfl_u<MASK>((unsigned)x); }
__device__ __forceinline__ float wave_sum(float v) { v += xshfl<1>(v); v += xshfl<2>(v); v += xshfl<4>(v); v += xshfl<8>(v); v += xshfl<16>(v); v += xshfl<32>(v); return v; }

#ifndef PROBE_MASK
#define PROBE_MASK 0
#endif
#if PROBE_MASK && !defined(EMU)
#define PROBE_T0(b) unsigned long long pt0_ = 0; if constexpr ((PROBE_MASK >> (b)) & 1) pt0_ = __builtin_amdgcn_s_memrealtime();
#define PROBE_T1(b) if constexpr ((PROBE_MASK >> (b)) & 1) { asm volatile("s_waitcnt vmcnt(0) lgkmcnt(0)" ::: "memory"); const unsigned long long pt1_ = __builtin_amdgcn_s_memrealtime(); \
    while (__builtin_amdgcn_s_memrealtime() < pt1_ + (pt1_ - pt0_)) __builtin_amdgcn_s_sleep(8); }
#else
#define PROBE_T0(b)
#define PROBE_T1(b)
#endif
namespace pg8 {
constexpr int BM = 256, BK = 64, HALF = 128, HTB = HALF * BK * 2, NXCD = 8, WGM = 8;
struct Unit { int pm, pn, bt, e; };
struct Gemm { const bf16_t* A; const bf16_t* Bt; int M, N, K, lda; const int* tok; };
struct StaticOrder {
    int nM, nN, nwg, G, c, wgm;
    __host__ __device__ void init(int M, int N, int G_, int c_, int wgm_ = WGM) { nM = M / BM; nN = N / BM; nwg = nM * nN; G = G_; c = c_; wgm = wgm_; }
    __host__ __device__ bool next(int i, Unit& u) const {
        const long L = (long)i * G + c; if (L >= nwg) return false;
        int wgid = (int)L; { const int q = nwg / NXCD, r = nwg % NXCD, xcd = wgid % NXCD, off = wgid / NXCD; wgid = (xcd < r ? xcd * (q + 1) : r * (q + 1) + (xcd - r) * q) + off; }
        const int nig = wgm * nN, gid = wgid / nig, fm = gid * wgm, gsz = (nM - fm) < wgm ? (nM - fm) : wgm;
        u.pm = fm + ((wgid % nig) % gsz); u.pn = (wgid % nig) / gsz; u.bt = u.pn; u.e = 0; return true;
    }
    __device__ __forceinline__ void a_ready(const Unit&) const {}
    __device__ __forceinline__ void done(const Unit&) const {}
};
struct MoeOrder {
    const LAS int* tend; int npn, ntot, G, c;
    __device__ __forceinline__ bool next(int i, Unit& u) const {
        int rt, pn;
        {
            const int xcd = c & 7, j = c >> 3, rpx = (G >> 3) / npn; rt = (i * 8 + xcd) * rpx + j / npn; pn = j % npn; if (rt >= ntot / npn) return false; }
        int e = 0;
#pragma unroll
        for (int j = 0; j < NEXP; ++j) e += (tend[j] <= rt) ? 1 : 0;
        u.pm = rt; u.pn = pn; u.e = e; u.bt = e * npn + pn; return true;
    }
    __device__ __forceinline__ void a_ready(const Unit&) const {}
    __device__ __forceinline__ void done(const Unit&) const {}
};
#ifdef EMU
template <class Epi, class Sched, bool GATHER = false>
__device__ void gemm_phase(LAS unsigned char* lds, const Gemm g, const Sched& S, const Epi& E, int  ) {
    const int tid = threadIdx.x, wid = tid >> 6, lane = tid & 63, wr = wid >> 2, wc = wid & 3, fr = lane & 15, fq = lane >> 4;
    Unit u;
    for (int i = 0; S.next(i, u); ++i) {
        f32x4 acc[2][2][4][2];
        for (int ai = 0; ai < 2; ++ai) for (int bj = 0; bj < 2; ++bj) for (int m = 0; m < 4; ++m) for (int n = 0; n < 2; ++n) for (int q = 0; q < 4; ++q) {
            const int row = u.pm * 256 + ai * 128 + wr * 64 + m * 16 + fr, col = u.bt * 256 + bj * 128 + wc * 32 + 8 * fq + 4 * n + q;
            const bf16_t* a = g.A + (size_t)(GATHER ? ((unsigned)g.tok[row] < (unsigned)g.M ? g.tok[row] : 0) : row) * g.lda; const bf16_t* b = g.Bt + (size_t)col * g.K; float s = 0.f;
            for (int k = 0; k < g.K; ++k) s += bf2f(a[k]) * bf2f(b[k]);
            acc[ai][bj][m][n][q] = s; }
        E(acc, u, wr, wc, fr, fq);
    }
    __syncthreads();
}
#else
#define PG8_LAS __attribute__((address_space(3)))
__host__ __device__ __forceinline__ int lds_byte(int r, int c) { const int st = (r >> 4) * 2 + (c >> 5), rr = r & 15, cc = c & 31, ob = rr * 64 + cc * 2; return st * 1024 + (ob ^ (((ob >> 9) & 1) << 5)); }
__host__ __device__ __forceinline__ void stage_rc(int b, int& R_, int& C_) { const int st = b / 1024, sb = b % 1024, swz = sb ^ (((sb >> 9) & 1) << 5); R_ = (st >> 1) * 16 + swz / 64; C_ = (st & 1) * 32 + (swz % 64) / 2; }
__host__ __device__ __forceinline__ int perm32(int rho) { const int n = rho >> 4, i = rho & 15; return 8 * (i >> 2) + 4 * n + (i & 3); }
template <class Epi, class Sched, bool GATHER = false>
__device__ __forceinline__ void gemm_phase(PG8_LAS unsigned char* lds, const Gemm g, const Sched& S, const Epi& E, int wave_id) {
    const int lane = opq(lane_id()), wid = opqs(wave_id), tid = wid * 64 + lane, wr = wid >> 2, wc = wid & 3, fr = lane & 15, fq = lane >> 4;
    const int K = g.K, nt = K / BK, lda = g.lda;
    unsigned voffA[2], voffB[2];
#pragma unroll
    for (int i = 0; i < 2; ++i) { int R_, C_; stage_rc(tid * 16 + i * 8192, R_, C_); const int Rb = (R_ & ~31) + perm32(R_ & 31);
        voffA[i] = (unsigned)(R_ * lda + C_) * 2u; voffB[i] = (unsigned)(Rb * K + C_) * 2u; }
    unsigned vG[2][2], vN[2][2];
#define PG8_TOK(dst, pm_) do { _Pragma("unroll") for (int i_ = 0; i_ < 2; ++i_) { int R_, C_; stage_rc(opq(tid) * 16 + i_ * 8192, R_, C_); _Pragma("unroll") for (int h_ = 0; h_ < 2; ++h_) \
        { unsigned tk_ = (unsigned)g.tok[(pm_) * 256 + h_ * 128 + R_]; tk_ = tk_ < (unsigned)g.M ? tk_ : 0u; dst[h_][i_] = tk_ * (unsigned)(lda * 2) + (unsigned)(C_ * 2); } } } while (0)
#define PG8_STAGE_A(bufoff, base_, h_, nx_) do { if constexpr (GATHER) { unsigned vs_[2] = {(nx_) ? vN[h_][0] : vG[h_][0], (nx_) ? vN[h_][1] : vG[h_][1]}; PG8_STAGE(bufoff, base_, vs_); } \
        else { PG8_STAGE(bufoff, (base_) + ((h_) ? hstepA : 0), voffA); } } while (0)
    const size_t kstep = (size_t)(BK * 2);
    const size_t hstepA = (size_t)HALF * lda * 2, tstepA = 2 * hstepA;
    const size_t hstepB = (size_t)HALF * K * 2, tstepB = 2 * hstepB;
    const unsigned ldsw = (unsigned)wid * 1024u;
    const int aoff = lds_byte(wr * 64 + fr, fq * 8), boff = lds_byte(wc * 32 + fr, fq * 8);
#define PG8_SA(b, h) (((b) * 2 + (h)) * HTB)
#define PG8_SB(b, h) ((4 + (b) * 2 + (h)) * HTB)
#define PG8_STAGE(bufoff, gbase, voff) do { _Pragma("unroll") for (int _i = 0; _i < 2; ++_i) \
        __builtin_amdgcn_global_load_lds((const unsigned*)((const char*)(gbase) + (voff)[_i]), (PG8_LAS unsigned*)(lds + (bufoff) + ldsw + _i * 8192), 16, 0, 0); } while (0)
#define PG8_LDA(dst, b, h) do { _Pragma("unroll") for (int m = 0; m < 4; ++m) _Pragma("unroll") for (int k = 0; k < 2; ++k) dst[m][k] = *(const PG8_LAS bf16x8*)(lds + PG8_SA(b, h) + aoff + m * 2048 + k * 1024); } while (0)
#define PG8_LDB(dst, b, h) do { _Pragma("unroll") for (int n = 0; n < 2; ++n) _Pragma("unroll") for (int k = 0; k < 2; ++k) dst[n][k] = *(const PG8_LAS bf16x8*)(lds + PG8_SB(b, h) + boff + n * 2048 + k * 1024); } while (0)
#define PG8_MMA(ai, bj, At, Bt) do { __builtin_amdgcn_s_setprio(1); _Pragma("unroll") for (int m = 0; m < 4; ++m) _Pragma("unroll") for (int n = 0; n < 2; ++n) _Pragma("unroll") for (int k = 0; k < 2; ++k) \
        acc[ai][bj][m][n] = __builtin_amdgcn_mfma_f32_16x16x32_bf16(Bt[n][k], At[m][k], acc[ai][bj][m][n], 0, 0, 0); __builtin_amdgcn_s_setprio(0); } while (0)
#define PG8_WAIT_V(n) asm volatile("s_waitcnt vmcnt(" #n ")" ::: "memory")
#define PG8_WAIT_L(n) asm volatile("s_waitcnt lgkmcnt(" #n ")" ::: "memory")
#define PG8_BAR __builtin_amdgcn_s_barrier()
#define PG8_SCHED __builtin_amdgcn_sched_barrier(0)
    Unit cur, nxt; int ui = 0;
    if (!S.next(0, cur)) return;
    f32x4 acc[2][2][4][2];
#pragma unroll
    for (int a = 0; a < 2; ++a)
#pragma unroll
        for (int b = 0; b < 2; ++b)
#pragma unroll
            for (int m = 0; m < 4; ++m)
#pragma unroll
                for (int n = 0; n < 2; ++n) acc[a][b][m][n] = (f32x4){0.f, 0.f, 0.f, 0.f};
    bf16x8 At[4][2], B0[2][2], B1[2][2];
    const char* cA = (const char*)g.A + (GATHER ? (size_t)0 : (size_t)cur.pm * tstepA); const char* cB = (const char*)g.Bt + (size_t)cur.bt * tstepB;
    if constexpr (GATHER) { PG8_TOK(vG, cur.pm); }
    S.a_ready(cur);
    PG8_STAGE(PG8_SB(0, 0), cB, voffB); PG8_STAGE(PG8_SB(0, 1), cB + hstepB, voffB); PG8_STAGE_A(PG8_SA(0, 0), cA, 0, false); PG8_STAGE_A(PG8_SA(0, 1), cA, 1, false);
    if (wr == 1) PG8_BAR;
    PG8_WAIT_V(2); PG8_BAR;
    PG8_STAGE(PG8_SB(1, 0), cB + kstep, voffB); PG8_STAGE_A(PG8_SA(1, 0), cA + kstep, 0, false); PG8_STAGE(PG8_SB(1, 1), cB + hstepB + kstep, voffB);
    PG8_WAIT_V(6); PG8_BAR;
    for (;;) {
        const bool has_next = S.next(ui + 1, nxt);
        const char* nA = has_next ? (const char*)g.A + (GATHER ? (size_t)0 : (size_t)nxt.pm * tstepA) : cA; const char* nB = has_next ? (const char*)g.Bt + (size_t)nxt.bt * tstepB : cB;
        if constexpr (GATHER) {
#pragma unroll
            for (int h_ = 0; h_ < 2; ++h_) { vN[h_][0] = vG[h_][0]; vN[h_][1] = vG[h_][1]; }
            if (has_next) {
#pragma unroll
                for (int i_ = 0; i_ < 2; ++i_) { int R_, C_; stage_rc(opq(tid) * 16 + i_ * 8192, R_, C_);
#pragma unroll
                    for (int h_ = 0; h_ < 2; ++h_) { const int* tp_ = g.tok + nxt.pm * 256 + h_ * 128 + R_;
                        asm volatile("global_load_dword %0, %1, off" : "=v"(vN[h_][i_]) : "v"(tp_) : "memory"); } } } }
        for (int t = 0; t < nt; t += 2) {
            const bool last = (t == nt - 2);
            const char* a1 = cA + (size_t)(t + 1) * kstep;
            const char* a2 = last ? nA : cA + (size_t)(t + 2) * kstep; const char* b2 = last ? nB : cB + (size_t)(t + 2) * kstep;
            const char* a3 = a2 + kstep; const char* b3 = b2 + kstep;
            if (last && has_next) S.a_ready(nxt);
            if constexpr (GATHER) { if (last && has_next) {
#pragma unroll
                for (int i_ = 0; i_ < 2; ++i_) { int R_, C_; stage_rc(opq(tid) * 16 + i_ * 8192, R_, C_);
#pragma unroll
                    for (int h_ = 0; h_ < 2; ++h_) { unsigned tk_ = vN[h_][i_]; asm volatile("" : "+v"(tk_)); tk_ = tk_ < (unsigned)g.M ? tk_ : 0u; vN[h_][i_] = tk_ * (unsigned)(lda * 2) + (unsigned)(C_ * 2); } } } }
            PG8_LDB(B0, 0, 0); PG8_LDB(B1, 0, 1); PG8_SCHED; PG8_LDA(At, 0, 0); PG8_STAGE_A(PG8_SA(1, 1), a1, 1, false);
            PG8_WAIT_V(8); PG8_WAIT_L(0); PG8_BAR; PG8_MMA(0, 0, At, B0); PG8_MMA(0, 1, At, B1); PG8_BAR; PG8_SCHED;
            PG8_LDA(At, 0, 1); PG8_STAGE(PG8_SB(0, 0), b2, voffB); PG8_STAGE(PG8_SB(0, 1), b2 + hstepB, voffB); PG8_STAGE_A(PG8_SA(0, 0), a2, 0, last);
            PG8_WAIT_V(8); PG8_WAIT_L(0); PG8_BAR; PG8_MMA(1, 0, At, B0); PG8_MMA(1, 1, At, B1); PG8_BAR; PG8_SCHED;
            PG8_LDB(B0, 1, 0); PG8_LDB(B1, 1, 1); PG8_SCHED; PG8_LDA(At, 1, 0); PG8_STAGE_A(PG8_SA(0, 1), a2, 1, last);
            PG8_WAIT_V(8); PG8_WAIT_L(0); PG8_BAR; PG8_MMA(0, 0, At, B0); PG8_MMA(0, 1, At, B1); PG8_BAR; PG8_SCHED;
            PG8_LDA(At, 1, 1); PG8_STAGE(PG8_SB(1, 0), b3, voffB); PG8_STAGE(PG8_SB(1, 1), b3 + hstepB, voffB); PG8_STAGE_A(PG8_SA(1, 0), a3, 0, last);
            PG8_WAIT_V(8); PG8_WAIT_L(0); PG8_BAR; PG8_MMA(1, 0, At, B0); PG8_MMA(1, 1, At, B1); PG8_BAR; PG8_SCHED;
        }
        if (wr == 0) PG8_BAR;
        E(acc, cur, wr, wc, fr, fq); S.done(cur);
        if (!has_next) break;
#pragma unroll
        for (int a = 0; a < 2; ++a)
#pragma unroll
            for (int b = 0; b < 2; ++b)
#pragma unroll
                for (int m = 0; m < 4; ++m)
#pragma unroll
                    for (int n = 0; n < 2; ++n) acc[a][b][m][n] = (f32x4){0.f, 0.f, 0.f, 0.f};
        cur = nxt; cA = nA; cB = nB; ++ui;
        if constexpr (GATHER) {
#pragma unroll
            for (int h_ = 0; h_ < 2; ++h_) { vG[h_][0] = vN[h_][0]; vG[h_][1] = vN[h_][1]; } }
        if (wr == 1) PG8_BAR;
    }
    PG8_WAIT_V(0);
    PG8_BAR;
#undef PG8_SA
#undef PG8_SB
#undef PG8_STAGE
#undef PG8_STAGE_A
#undef PG8_TOK
#undef PG8_LDA
#undef PG8_LDB
#undef PG8_MMA
#undef PG8_WAIT_V
#undef PG8_WAIT_L
#undef PG8_BAR
#undef PG8_SCHED
}
#endif

struct EpiStoreBf16 {
    bf16_t* O; int ldc;
    __device__ __forceinline__ void operator()(const f32x4 (&acc)[2][2][4][2], const Unit& u, int wr, int wc, int fr, int fq) const {
        const int row0 = u.pm * 256 + wr * 64 + fr, col0 = u.pn * 256 + wc * 32 + 8 * fq;
#pragma unroll
        for (int ai = 0; ai < 2; ++ai)
#pragma unroll
            for (int m = 0; m < 4; ++m)
#pragma unroll
                for (int bj = 0; bj < 2; ++bj) { const f32x4 v0 = acc[ai][bj][m][0], v1 = acc[ai][bj][m][1];
                    u32x4 w; w.x = pk2(v0[0], v0[1]); w.y = pk2(v0[2], v0[3]); w.z = pk2(v1[0], v1[1]); w.w = pk2(v1[2], v1[3]);
                    *(u32x4*)(O + (size_t)(row0 + ai * 128 + m * 16) * ldc + col0 + bj * 128) = w; }
    }
};
template <int MODE> struct EpiGate {
    const bf16_t* Hg; bf16_t* MGb;
    __device__ __forceinline__ void operator()(const f32x4 (&acc)[2][2][4][2], const Unit& u, int wr, int wc, int fr, int fq) const {
        const int row0 = u.pm * 256 + wr * 64 + fr, col0 = u.pn * 256 + wc * 32 + 8 * fq;
#pragma unroll
        for (int ai = 0; ai < 2; ++ai) {
            u32x4 gw[4][2], pw[4][2];
#pragma unroll
            for (int m = 0; m < 4; ++m)
#pragma unroll
                for (int bj = 0; bj < 2; ++bj) { const int row = row0 + ai * 128 + m * 16, col = col0 + bj * 128;
                    gw[m][bj] = *(const u32x4*)(Hg + (size_t)row * DINP + col); if (MODE != 0) pw[m][bj] = *(const u32x4*)(MGb + (size_t)row * D + col); }
            asm volatile("" ::: "memory");
#pragma unroll
            for (int m = 0; m < 4; ++m)
#pragma unroll
                for (int bj = 0; bj < 2; ++bj) { const int row = row0 + ai * 128 + m * 16, col = col0 + bj * 128; const f32x4 v0 = acc[ai][bj][m][0], v1 = acc[ai][bj][m][1];
                    float g[8], p[8], v[8] = {v0[0], v0[1], v0[2], v0[3], v1[0], v1[1], v1[2], v1[3]}; unpack8(gw[m][bj], g);
                    if (MODE != 0) { unpack8(pw[m][bj], p);
#pragma unroll
                        for (int i = 0; i < 8; ++i) v[i] = p[i] + v[i] * fsigmoid(g[i]); }
                    else {
#pragma unroll
                        for (int i = 0; i < 8; ++i) v[i] = v[i] * fsigmoid(g[i]); }
                    *(u32x4*)(MGb + (size_t)row * D + col) = pack8(v); }
            asm volatile("" ::: "memory");
        }
    }
};
struct EpiResid {
    const float* xp; const float* xs; float* op; float* os;
    __device__ __forceinline__ void operator()(const f32x4 (&acc)[2][2][4][2], const Unit& u, int wr, int wc, int fr, int fq) const {
        const int row0 = u.pm * 256 + wr * 64 + fr, col0 = u.pn * 256 + wc * 32 + 8 * fq;
        const bool smp = u.pm * 256 >= NP;
        const float* xb = smp ? xs - (size_t)NP * D : xp; float* ob = smp ? os - (size_t)NP * D : op;
#pragma unroll
        for (int ai = 0; ai < 2; ++ai) {
            f32x4 xa[4][2][2];
#pragma unroll
            for (int m = 0; m < 4; ++m)
#pragma unroll
                for (int bj = 0; bj < 2; ++bj) { const float* xi = xb + (size_t)(row0 + ai * 128 + m * 16) * D + col0 + bj * 128; xa[m][bj][0] = *(const f32x4*)xi; xa[m][bj][1] = *(const f32x4*)(xi + 4); }
            asm volatile("" ::: "memory");
#pragma unroll
            for (int m = 0; m < 4; ++m)
#pragma unroll
                for (int bj = 0; bj < 2; ++bj) { float* xo = ob + (size_t)(row0 + ai * 128 + m * 16) * D + col0 + bj * 128;
                    *(f32x4*)xo = xa[m][bj][0] * ALPHA + acc[ai][bj][m][0]; *(f32x4*)(xo + 4) = xa[m][bj][1] * ALPHA + acc[ai][bj][m][1]; }
            asm volatile("" ::: "memory");
        }
    }
};
struct EpiSwiglu {
    bf16_t* ACT; const float* bup;
    __device__ __forceinline__ void operator()(const f32x4 (&acc)[2][2][4][2], const Unit& u, int wr, int wc, int fr, int fq) const {
        const int row0_ = u.pm * 256 + wr * 64 + fr, j0 = u.pn * 128 + wc * 32 + 8 * fq;
        const float* bg = bup + (size_t)u.e * 2048 + j0; const f32x4 bg0 = *(const f32x4*)bg, bg1 = *(const f32x4*)(bg + 4), bu0 = *(const f32x4*)(bg + 1024), bu1 = *(const f32x4*)(bg + 1028);
#pragma unroll
        for (int ai = 0; ai < 2; ++ai)
#pragma unroll
            for (int m = 0; m < 4; ++m) { const int row = row0_ + ai * 128 + m * 16;
                const f32x4 g0 = acc[ai][0][m][0] + bg0, g1 = acc[ai][0][m][1] + bg1, u0 = acc[ai][1][m][0] + bu0, u1 = acc[ai][1][m][1] + bu1; float o[8];
#pragma unroll
                for (int i = 0; i < 4; ++i) { const float ga = fminf(g0[i], SW_LIMIT), ua = fminf(fmaxf(u0[i], -SW_LIMIT), SW_LIMIT); o[i] = (ua + 1.0f) * ga * fsigmoid(SW_ALPHA * ga);
                    const float gb = fminf(g1[i], SW_LIMIT), ub = fminf(fmaxf(u1[i], -SW_LIMIT), SW_LIMIT); o[4 + i] = (ub + 1.0f) * gb * fsigmoid(SW_ALPHA * gb); }
                *(u32x4*)(ACT + (size_t)row * D + j0) = pack8(o); }
    }
};
struct EpiDown {
    bf16_t* O; const float* bdn; const float* gs;
    __device__ __forceinline__ void operator()(const f32x4 (&acc)[2][2][4][2], const Unit& u, int wr, int wc, int fr, int fq) const {
        const int row0 = u.pm * 256 + wr * 64 + fr, col0 = u.pn * 256 + wc * 32 + 8 * fq;
#pragma unroll
        for (int ai = 0; ai < 2; ++ai) {
            float gt[4];
#pragma unroll
            for (int m = 0; m < 4; ++m) gt[m] = gs[row0 + ai * 128 + m * 16];
#pragma unroll
            for (int bj = 0; bj < 2; ++bj) { const float* bp = bdn + (size_t)u.e * D + col0 + bj * 128; const f32x4 b0 = *(const f32x4*)bp, b1 = *(const f32x4*)(bp + 4);
#pragma unroll
                for (int m = 0; m < 4; ++m) { const f32x4 a0 = (acc[ai][bj][m][0] + b0) * gt[m], a1 = (acc[ai][bj][m][1] + b1) * gt[m];
                    u32x4 w; w.x = pk2(a0[0], a0[1]); w.y = pk2(a0[2], a0[3]); w.z = pk2(a1[0], a1[1]); w.w = pk2(a1[2], a1[3]);
                    *(u32x4*)(O + (size_t)(row0 + ai * 128 + m * 16) * D + col0 + bj * 128) = w; } }
            asm volatile("" ::: "memory");
        }
    }
};
}

#ifndef EMU
#define XB_TMO      128
#define XB_XCNT(j)  (256  + 64 * (j))
#define XB_XSUB(j)  (1280 + 64 * (j))
#define XB_XGEN(j)  (2304 + 64 * (j))
#define XB_TOP      3328
#define XB_TOPGEN   3392
#define XCD_BAR_WORDS 3456
#define XB_SPIN_CAP (1u << 27)
__device__ __forceinline__ unsigned xb_ld(unsigned* p)              { return __hip_atomic_load(p, __ATOMIC_RELAXED, __HIP_MEMORY_SCOPE_AGENT); }
__device__ __forceinline__ unsigned xb_add(unsigned* p, unsigned v) { return __hip_atomic_fetch_add(p, v, __ATOMIC_RELAXED, __HIP_MEMORY_SCOPE_AGENT); }
__device__ __forceinline__ unsigned xb_xcc_id() { return (unsigned)__builtin_amdgcn_s_getreg((3 << 11) | 20) & 0xFu; }
#define XB_SPIN(cond, bar) do { unsigned _sp = 0; while (cond) { __builtin_amdgcn_s_sleep(1); \
    if ((++_sp & 255u) == 0u) { if (xb_ld(&(bar)[XB_TMO])) break; if (_sp > XB_SPIN_CAP) { atomicAdd(&(bar)[XB_TMO], 1u); break; } } } } while (0)
struct XcdBarrier { unsigned* bar; unsigned x; volatile LAS unsigned* st; };
__device__ __forceinline__ XcdBarrier xcd_barrier_post(unsigned* bar, volatile LAS unsigned* st) {
    XcdBarrier b; b.bar = bar; b.x = xb_xcc_id(); b.st = st;
    if (threadIdx.x == 0) (void)xb_add(&bar[XB_XCNT(b.x)], 1u);
    return b;
}
__device__ __forceinline__ void xcd_barrier_complete(unsigned* bar, unsigned x, unsigned& nloc, unsigned& nx) {
    const unsigned G = gridDim.x * gridDim.y * gridDim.z;
    unsigned sum, cnt, mine, sp = 0u;
    for (;;) {
        sum = 0u; cnt = 0u; mine = 0u;
#pragma unroll
        for (unsigned j = 0; j < 16; ++j) { const unsigned c = xb_ld(&bar[XB_XCNT(j)]); sum += c; cnt += (c > 0u) ? 1u : 0u; mine = (j == x) ? c : mine; }
        if (sum == G) break;
        __builtin_amdgcn_s_sleep(1);
        if ((++sp & 255u) == 0u) { if (xb_ld(&bar[XB_TMO])) break; if (sp > XB_SPIN_CAP) { atomicAdd(&bar[XB_TMO], 1u); break; } }
    }
    nloc = mine > 0u ? mine : 1u; nx = cnt > 0u ? cnt : 1u;
}
__device__ __forceinline__ void xcd_barrier(const XcdBarrier& b) {
    asm volatile("s_waitcnt vmcnt(0)" ::: "memory");
    __syncthreads();
    if (threadIdx.x == 0) {
        unsigned* bar = b.bar;
        __builtin_amdgcn_s_waitcnt(0);
        unsigned nloc = b.st[0], nx = b.st[1];
        if (nloc == 0u) { xcd_barrier_complete(bar, b.x, nloc, nx); b.st[0] = nloc; b.st[1] = nx; }
        const unsigned old = xb_add(&bar[XB_XSUB(b.x)], 1u);
        const unsigned gen = old / nloc;
        if (old + 1u == (gen + 1u) * nloc) {
            __builtin_amdgcn_fence(__ATOMIC_RELEASE, "agent");
            asm volatile("s_waitcnt vmcnt(0)" ::: "memory");
            const unsigned og = xb_add(&bar[XB_TOP], 1u);
            const unsigned tg = og / nx;
            if (og + 1u == (tg + 1u) * nx) xb_add(&bar[XB_TOPGEN], 1u);
            else XB_SPIN(xb_ld(&bar[XB_TOPGEN]) == tg, bar);
            __builtin_amdgcn_fence(__ATOMIC_ACQUIRE, "agent");
            xb_add(&bar[XB_XGEN(b.x)], 1u);
            asm volatile("s_waitcnt vmcnt(0)" ::: "memory");
        } else {
            XB_SPIN(xb_ld(&bar[XB_XGEN(b.x)]) == gen, bar);
            __builtin_amdgcn_fence(__ATOMIC_ACQUIRE, "agent");
            asm volatile("s_waitcnt vmcnt(0)" ::: "memory");
        }
    }
    __syncthreads();
}
#endif

struct Args { const float* in[31]; float* out; unsigned char* ws; int lo, hi; };
typedef const float* FPtr;
#ifdef EMU
typedef const FPtr* ArgTab;
#else
typedef const __attribute__((address_space(4))) FPtr* ArgTab;
#endif
struct Frame {
    LAS unsigned char* lds; int tid, lane, wave, G, bid;
    ArgTab in; float* out; unsigned char* ws; unsigned* ctl;
};
enum { I_XP = 0, I_XS, I_CK, I_CV, I_SST, I_SCV, I_SSC, I_WIN, I_CONVW, I_CONVB, I_DTB, I_ALOG, I_SD, I_NORMW, I_WSSD, I_SINK, I_WATT, I_RELB, I_SCW, I_WSC, I_WO, I_LN1G, I_LN1B,
       I_RW, I_RB, I_WUP, I_BUP, I_WDN, I_BDN, I_LN2G, I_LN2B };

__device__ __forceinline__ bf16_t* ws_bf(const Frame& F, size_t off) { return (bf16_t*)(F.ws + off); }
__device__ __forceinline__ float* ws_f(const Frame& F, size_t off) { return (float*)(F.ws + off); }
__device__ __forceinline__ bf16_t* wl_ptr(const Frame& F, int layer, size_t off) { return (bf16_t*)(F.ws + WS_W + (size_t)layer * WL_BYTES + off); }

__device__ __forceinline__ void wt_item(const float* W, int ldw, int K, int k0, int nsrc0, const float* kscale, bf16_t* WT, int ndst0, LAS float* scr, int lane) {
    if (nsrc0 < 0) {
#pragma unroll
        for (int j = 0; j < 4; ++j) { const int n = (lane >> 3) + 8 * j; *(u32x4*)(WT + (size_t)(ndst0 + n) * K + k0 + 8 * (lane & 7)) = (u32x4){0u, 0u, 0u, 0u}; }
        return;
    }
#pragma unroll 8
    for (int i = 0; i < 32; ++i) { const int kk = 2 * i + (lane >> 5); float v = W[(size_t)(k0 + kk) * ldw + nsrc0 + (lane & 31)]; if (kscale) v *= kscale[k0 + kk]; scr[kk * 33 + (lane & 31)] = v; }
    WAVE_SYNC();
    const int c = lane & 7;
#pragma unroll
    for (int j = 0; j < 4; ++j) { const int n = (lane >> 3) + 8 * j; const LAS float* s = scr + (8 * c) * 33 + n;
        u32x4 o; o.x = pk2(s[0 * 33], s[1 * 33]); o.y = pk2(s[2 * 33], s[3 * 33]); o.z = pk2(s[4 * 33], s[5 * 33]); o.w = pk2(s[6 * 33], s[7 * 33]);
        *(u32x4*)(WT + (size_t)(ndst0 + n) * K + k0 + 8 * c) = o; }
    WAVE_SYNC();
}
__device__ __forceinline__ void step_weights(const Frame& F) {
    LAS float* scr = (LAS float*)(F.lds + F.wave * 16384);
    const int gw = F.bid * NWAVES + F.wave, NGW = F.G * NWAVES;
    constexpr int I_IN = (DINP / 32) * (D / 64), I_SSD = (D / 32) * (DINNER / 64), I_SQ = (D / 32) * (D / 64), I_UP = NEXP * (2048 / 32) * (D / 64), I_DN = NEXP * (D / 32) * (D / 64);
    constexpr int PER_LAYER = I_IN + I_SSD + 3 * I_SQ + I_UP + I_DN;
    for (int it = gw; it < DEPTH * PER_LAYER; it += NGW) {
        const int layer = it / PER_LAYER; int r = it % PER_LAYER;
        if (r < I_IN) { const int nb = r / (D / 64), kb = r % (D / 64), n0 = nb * 32;
            const int ns = n0 < 6144 ? n0 : (n0 < 13824 ? n0 + 32 : (n0 < 13856 ? n0 - 13824 + 6144 : -1));
            wt_item(F.in[I_WIN] + (size_t)layer * D * DIN, DIN, D, kb * 64, ns, nullptr, wl_ptr(F, layer, WL_IN), n0, scr, F.lane); continue; }
        r -= I_IN;
        if (r < I_SSD) { const int nb = r / (DINNER / 64), kb = r % (DINNER / 64);
            wt_item(F.in[I_WSSD] + (size_t)layer * DINNER * D, D, DINNER, kb * 64, nb * 32, F.in[I_NORMW] + (size_t)layer * DINNER, wl_ptr(F, layer, WL_SSD), nb * 32, scr, F.lane); continue; }
        r -= I_SSD;
        if (r < I_SQ) { const int nb = r / (D / 64), kb = r % (D / 64); wt_item(F.in[I_WATT] + (size_t)layer * D * D, D, D, kb * 64, nb * 32, nullptr, wl_ptr(F, layer, WL_ATT), nb * 32, scr, F.lane); continue; }
        r -= I_SQ;
        if (r < I_SQ) { const int nb = r / (D / 64), kb = r % (D / 64); wt_item(F.in[I_WSC] + (size_t)layer * D * D, D, D, kb * 64, nb * 32, nullptr, wl_ptr(F, layer, WL_SC), nb * 32, scr, F.lane); continue; }
        r -= I_SQ;
        if (r < I_SQ) { const int nb = r / (D / 64), kb = r % (D / 64); wt_item(F.in[I_WO] + (size_t)layer * D * D, D, D, kb * 64, nb * 32, nullptr, wl_ptr(F, layer, WL_O), nb * 32, scr, F.lane); continue; }
        r -= I_SQ;
        if (r < I_UP) { const int e = r / ((2048 / 32) * (D / 64)), q = r % ((2048 / 32) * (D / 64)), nb = q / (D / 64), kb = q % (D / 64), n0 = nb * 32;
            const int pn = n0 >> 8, bj = (n0 >> 7) & 1, jj = n0 & 127, ns = bj * 1024 + pn * 128 + jj;
            wt_item(F.in[I_WUP] + ((size_t)layer * NEXP + e) * D * 2048, 2048, D, kb * 64, ns, nullptr, wl_ptr(F, layer, WL_UP) + (size_t)e * 2048 * D, n0, scr, F.lane); continue; }
        r -= I_UP;
        { const int e = r / ((D / 32) * (D / 64)), q = r % ((D / 32) * (D / 64)), nb = q / (D / 64), kb = q % (D / 64);
            wt_item(F.in[I_WDN] + ((size_t)layer * NEXP + e) * D * D, D, D, kb * 64, nb * 32, nullptr, wl_ptr(F, layer, WL_DN) + (size_t)e * D * D, nb * 32, scr, F.lane); }
    }
}

__device__ __forceinline__ const float* x_in_row(const Frame& F, int layer, int mb, int r) {
    if (layer == 0) return r < NP ? F.in[I_XP] + ((size_t)mb * NP + r) * D : F.in[I_XS] + (size_t)(r - NP) * D;
    return r < NP ? F.out + O_YP + ((size_t)mb * NP + r) * D : F.out + O_YS + (size_t)(r - NP) * D;
}
__device__ __forceinline__ float* x_out_row(const Frame& F, int mb, int r) { return r < NP ? F.out + O_YP + ((size_t)mb * NP + r) * D : F.out + O_YS + (size_t)(r - NP) * D; }
__device__ __forceinline__ int rows_of(int mb) { return mb == 0 ? R : NP; }

__device__ __forceinline__ void step_xb(const Frame& F, int mb) {
    const int gw = F.bid * NWAVES + F.wave, NGW = F.G * NWAVES, nr = rows_of(mb);
    bf16_t* XB = ws_bf(F, WS_XB0) + (size_t)mb * R * D;
    for (int r = gw; r < nr; r += NGW) {
        const f32x4* xr = (const f32x4*)x_in_row(F, 0, mb, r) + F.lane; u32x2* o = (u32x2*)(XB + (size_t)r * D) + F.lane;
#pragma unroll
        for (int j = 0; j < 4; ++j) { const f32x4 v = xr[64 * j]; u32x2 w; w.x = pk2(v[0], v[1]); w.y = pk2(v[2], v[3]); o[64 * j] = w; }
    }
}

__device__ __forceinline__ float softplus_f(float x) { const float e = fexp(x); return x > 20.f ? x : (e < 0.01f ? e * (1.0f - e * (0.5f - e * 0.33333333f)) : __builtin_amdgcn_logf(1.0f + e) * 0.69314718056f); }
constexpr int S128 = 136, S64 = 72;
constexpr int BL_BM = 0, BL_CM = BL_BM + 64 * S128 * 2, BL_CB = BL_CM + 64 * S128 * 2, BL_END = BL_CB + 64 * S64 * 2;
struct BcRegs { u32x4 raw[7]; f32x4 wq[4][2], bq[2]; };
__device__ __forceinline__ void ssd_bc_load(const Frame& F, int layer, int u, BcRegs& R_) {
    const int sl = (u / NCHUNK) % NSEQ_MB, ck = u % NCHUNK, g = u / (NCHUNK * NSEQ_MB); const int tid = F.tid;
    const bf16_t* H = ws_bf(F, WS_H) + (size_t)sl * SEQ * DINP; const int cgi = tid & 31, rb = tid >> 5; const int xc = (cgi < 16 ? 2048 : 3072) + g * 128 + 8 * (cgi & 15);
#pragma unroll
    for (int i = 0; i < 7; ++i) { const int t = ck * 64 + 4 * rb - 3 + i; R_.raw[i] = t >= 0 ? *(const u32x4*)(H + (size_t)t * DINP + C_X + xc) : (u32x4){0u, 0u, 0u, 0u}; }
    const float* convw = F.in[I_CONVW] + (size_t)layer * 4 * CONVDIM + xc; const float* convb = F.in[I_CONVB] + (size_t)layer * CONVDIM + xc;
#pragma unroll
    for (int tp = 0; tp < 4; ++tp) { R_.wq[tp][0] = *(const f32x4*)(convw + tp * CONVDIM); R_.wq[tp][1] = *(const f32x4*)(convw + tp * CONVDIM + 4); }
    R_.bq[0] = *(const f32x4*)convb; R_.bq[1] = *(const f32x4*)(convb + 4);
}
__device__ __forceinline__ void ssd_bc_unit(const Frame& F, int u, const BcRegs& R_) {
    const int sl = (u / NCHUNK) % NSEQ_MB, ck = u % NCHUNK, g = u / (NCHUNK * NSEQ_MB);
    const int tid = F.tid, lane = F.lane, w = F.wave, fr = lane & 15, fq = lane >> 4;
    LAS bf16_t* Bm = (LAS bf16_t*)(F.lds + BL_BM); LAS bf16_t* Cm = (LAS bf16_t*)(F.lds + BL_CM); LAS bf16_t* CBs = (LAS bf16_t*)(F.lds + BL_CB);
    const size_t rowg = (size_t)sl * SEQ + (size_t)ck * 64; const size_t tix = ((size_t)sl * NCHUNK + ck) * 8 + g;
    const int cgi = tid & 31, rb = tid >> 5; const bool isB = cgi < 16; const int n0 = 8 * (cgi & 15);
    const u32x4 (&raw)[7] = R_.raw; const f32x4 (&wq)[4][2] = R_.wq; const f32x4 (&bq)[2] = R_.bq;
    __syncthreads();
    { float val[4][8];
#pragma unroll
      for (int r = 0; r < 4; ++r) { float a[8] = {bq[0][0], bq[0][1], bq[0][2], bq[0][3], bq[1][0], bq[1][1], bq[1][2], bq[1][3]};
#pragma unroll
          for (int tp = 0; tp < 4; ++tp) { float f[8]; unpack8(raw[r + tp], f);
#pragma unroll
              for (int i = 0; i < 4; ++i) { a[i] += f[i] * wq[tp][0][i]; a[4 + i] += f[4 + i] * wq[tp][1][i]; } }
#pragma unroll
          for (int i = 0; i < 8; ++i) val[r][i] = fsilu(a[i]); }
      if (isB) { bf16_t* bt = ws_bf(F, WS_BTG) + tix * 8192 + (size_t)n0 * 64 + 4 * rb;
#pragma unroll
          for (int r = 0; r < 4; ++r) *(LAS u32x4*)(Bm + (4 * rb + r) * S128 + n0) = pack8(val[r]);
#pragma unroll
          for (int i = 0; i < 8; ++i) { u32x2 wv; wv.x = pk2(val[0][i], val[1][i]); wv.y = pk2(val[2][i], val[3][i]); *(u32x2*)(bt + (size_t)i * 64) = wv; } }
      else { bf16_t* cmc = ws_bf(F, WS_CMC) + (rowg + 4 * rb) * 1024 + g * 128 + n0;
#pragma unroll
          for (int r = 0; r < 4; ++r) { const u32x4 pk = pack8(val[r]); *(LAS u32x4*)(Cm + (4 * rb + r) * S128 + n0) = pk; *(u32x4*)(cmc + (size_t)r * 1024) = pk; } } }
    __syncthreads();
    { const int ti = w >> 1;
#pragma unroll
      for (int jj = 0; jj < 2; ++jj) { const int tj = 2 * (w & 1) + jj; f32x4 cb = (f32x4){0.f, 0.f, 0.f, 0.f};
          if (tj <= ti) {
#pragma unroll
              for (int ks = 0; ks < 4; ++ks) { const bf16x8 a = *(const LAS bf16x8*)(Cm + (16 * ti + fr) * S128 + 32 * ks + 8 * fq); const bf16x8 b = *(const LAS bf16x8*)(Bm + (16 * tj + fr) * S128 + 32 * ks + 8 * fq);
                  cb = __builtin_amdgcn_mfma_f32_16x16x32_bf16(a, b, cb, 0, 0, 0); } }
#pragma unroll
          for (int r = 0; r < 4; ++r) CBs[(16 * ti + 4 * fq + r) * S64 + 16 * tj + fr] = bf1(cb[r]); } }
    __syncthreads();
    { const int row = tid >> 3, cc = tid & 7; *(u32x4*)(ws_bf(F, WS_CBG) + tix * 4096 + row * 64 + 8 * cc) = *(const LAS u32x4*)(CBs + row * S64 + 8 * cc); }
}

constexpr int SL_CM = 0, SL_BT = SL_CM + 64 * S128 * 2, SL_CB = SL_BT + 128 * S64 * 2, SL_DMA_SZ = SL_CB + 64 * S64 * 2, SL_DMA_END = 2 * SL_DMA_SZ;
constexpr int SL_XT = SL_DMA_END  , SL_XTW = SL_XT + 2 * 64 * S64 * 2, SL_MM = SL_XTW + 64 * S64 * 2, SL_SB = SL_MM + 64 * S64 * 2,
    SL_SM = SL_SB + 64 * S128 * 2, SL_END = SL_SM + 2 * 384 * 4;
static_assert(SL_END <= SCR_BYTES && SL_DMA_SZ == 2816 * 16, "ssd LDS map");
#ifdef EMU
#define SSD_DMA_ONE(gp_, dst_) memcpy((unsigned char*)(dst_) + lane * 16, (gp_), 16)
#else
#define SSD_DMA_ONE(gp_, dst_) __builtin_amdgcn_global_load_lds((const unsigned*)(gp_), (LAS unsigned*)(dst_), 16, 0, 0)
#endif
#define SSD_DMA_SETUP() do { _Pragma("unroll") for (int j_ = 0; j_ < 6; ++j_) { const int pc_ = w * 6 + j_; const int q_ = pc_ * 64 + lane; const size_t tx0_ = ((size_t)sl * NCHUNK) * 8 + g; \
        if (pc_ < 17) { const int r_ = q_ / 17; int c_ = q_ % 17; c_ = c_ < 16 ? c_ : 15; dsrc[j_] = cmc + (size_t)r_ * 1024 + 8 * c_; } \
        else if (pc_ < 35) { const int q2_ = q_ - 1088, r_ = q2_ / 9; int c_ = q2_ % 9; c_ = c_ < 8 ? c_ : 7; dsrc[j_] = btg + tx0_ * 8192 + r_ * 64 + 8 * c_; } \
        else { const int q3_ = q_ - 2240, r_ = q3_ / 9; int c_ = q3_ % 9; c_ = c_ < 8 ? c_ : 7; dsrc[j_] = cbg + tx0_ * 4096 + r_ * 64 + 8 * c_; } } } while (0)
#define SSD_DMA(ck_) do { _Pragma("unroll") for (int j_ = 0; j_ < 6; ++j_) { const int pc_ = w * 6 + j_; if (pc_ < 44) { \
        SSD_DMA_ONE(dsrc[j_], L + ((ck_) & 1) * SL_DMA_SZ + SL_CM + pc_ * 1024); dsrc[j_] += pc_ < 17 ? (size_t)64 * 1024 : (pc_ < 35 ? (size_t)8 * 8192 : (size_t)8 * 4096); } } } while (0)
#define SSD_LOAD_X(ck_) do { _Pragma("unroll") for (int i = 0; i < 11; ++i) { const int t_ = (ck_) * 64 + 8 * w - 3 + i; rawx[i] = t_ >= 0 ? (unsigned)H[(size_t)t_ * DINP + C_X + hd * 64 + lane] : 0u; } } while (0)
#define SSD_LOAD_XN(ck_) do { const bf16_t* px_ = H + ((size_t)(ck_) * 64 + 8 * w - 3) * DINP + C_X + hd * 64 + lane; _Pragma("unroll") for (int i = 0; i < 11; ++i) rawx[i] = (unsigned)px_[(size_t)i * DINP]; } while (0)
#define SSD_TABLE(tb_, dtr_) do { const float dt_ = softplus_f(bf2f(dtr_) + dtb); \
        float cs_ = Ah * dt_; _Pragma("unroll") for (int o = 1; o < 64; o <<= 1) { const float t2_ = __shfl(cs_, lane - o < 0 ? 0 : lane - o); if (lane >= o) cs_ += t2_; } \
        const float tot_ = __shfl(cs_, 63); (tb_)[lane] = dt_; (tb_)[64 + lane] = cs_; (tb_)[128 + lane] = fexp(tot_ - cs_); (tb_)[192 + lane] = fexp(cs_); if (lane == 0) (tb_)[256] = fexp(tot_); } while (0)

__device__ __forceinline__ void ssd_prompt_unit(const Frame& F, int layer, int mb, int sl, int hd) {
    const int tid = F.tid, lane = F.lane, w = F.wave, fr = lane & 15, fq = lane >> 4;
    LAS unsigned char* L = F.lds;
    LAS bf16_t* XT0 = (LAS bf16_t*)(L + SL_XT);
    LAS bf16_t* XTW = (LAS bf16_t*)(L + SL_XTW); LAS bf16_t* Mm = (LAS bf16_t*)(L + SL_MM); LAS bf16_t* Sb = (LAS bf16_t*)(L + SL_SB);
    LAS float* smb = (LAS float*)(L + SL_SM);
    const int g = hd >> 2;
    bf16_t* H = ws_bf(F, WS_H) + (size_t)sl * SEQ * DINP;
    const bf16_t* cmc = ws_bf(F, WS_CMC) + (size_t)sl * SEQ * 1024 + g * 128; const bf16_t* btg = ws_bf(F, WS_BTG); const bf16_t* cbg = ws_bf(F, WS_CBG);
    const float* convw = F.in[I_CONVW] + (size_t)layer * 4 * CONVDIM + hd * 64; const float* convb = F.in[I_CONVB] + (size_t)layer * CONVDIM + hd * 64;
    const float cw0 = convw[lane], cw1 = convw[CONVDIM + lane], cw2 = convw[2 * CONVDIM + lane], cw3 = convw[3 * CONVDIM + lane], cwb = convb[lane];
    __syncthreads();
    const float dtb = F.in[I_DTB][layer * 32 + hd], Ah = -fexp(F.in[I_ALOG][layer * 32 + hd]), Dh = F.in[I_SD][layer * 32 + hd];
    const int xl = tid >> 3, xcg = tid & 7;
    f32x4 S[4];
#pragma unroll
    for (int j = 0; j < 4; ++j) S[j] = (f32x4){0.f, 0.f, 0.f, 0.f};
    const int ti = w >> 1, tj0 = 2 * (w & 1);
    const int pi = w & 3, nb = w >> 2;
    bf16_t* pz = H + (size_t)(16 * ti + fr) * DINP + C_Z + hd * 64 + 16 * tj0 + 4 * fq; float* pss = ws_f(F, WS_SSQ) + ((size_t)sl * SEQ + 16 * ti + fr) * 64 + hd * 2 + (w & 1);
    unsigned rawx[11]; u32x2 zraw[2]; unsigned dtr_next;
    const bf16_t* dsrc[6]; SSD_DMA_SETUP();
    SSD_DMA(0); SSD_LOAD_X(0);
    zraw[0] = *(const u32x2*)pz; zraw[1] = *(const u32x2*)(pz + 16);
    { const unsigned d0 = H[(size_t)lane * DINP + C_DT + hd]; dtr_next = H[(size_t)(64 + lane) * DINP + C_DT + hd]; if (w == 7) { SSD_TABLE(smb, d0); smb[320 + lane] = Dh * __builtin_amdgcn_rcpf(smb[lane]); } }
    VM_WAIT(0);
    __syncthreads();
    for (int ck = 0; ck < NCHUNK; ++ck) {
        LAS float* sm = smb + (ck & 1) * 384; LAS float* smn = smb + ((ck + 1) & 1) * 384; LAS bf16_t* XT = XT0 + (ck & 1) * 64 * S64;
        LAS unsigned char* Ld = L + (ck & 1) * SL_DMA_SZ; LAS bf16_t* Cm = (LAS bf16_t*)(Ld + SL_CM); LAS bf16_t* BT = (LAS bf16_t*)(Ld + SL_BT); LAS bf16_t* CBl = (LAS bf16_t*)(Ld + SL_CB);
        { const f32x4 d0 = *(const LAS f32x4*)(sm + 8 * w), d1 = *(const LAS f32x4*)(sm + 8 * w + 4), e0 = *(const LAS f32x4*)(sm + 128 + 8 * w), e1 = *(const LAS f32x4*)(sm + 128 + 8 * w + 4);
          const float dtv[8] = {d0[0], d0[1], d0[2], d0[3], d1[0], d1[1], d1[2], d1[3]}, wdv[8] = {e0[0], e0[1], e0[2], e0[3], e1[0], e1[1], e1[2], e1[3]}; float xr[11], xa[8], xb[8];
#pragma unroll
          for (int i = 0; i < 11; ++i) xr[i] = blo(rawx[i]);
#pragma unroll
          for (int r = 0; r < 8; ++r) { const float xd = fsilu(cwb + xr[r] * cw0 + xr[r + 1] * cw1 + xr[r + 2] * cw2 + xr[r + 3] * cw3) * dtv[r]; xa[r] = xd; xb[r] = xd * wdv[r]; }
          *(LAS u32x4*)(XT + lane * S64 + 8 * w) = pack8(xa); *(LAS u32x4*)(XTW + lane * S64 + 8 * w) = pack8(xb); }
#pragma unroll
        for (int jj = 0; jj < 4; ++jj) { u32x2 wv; wv.x = pk2(S[jj][0], S[jj][1]); wv.y = pk2(S[jj][2], S[jj][3]); *(LAS u32x2*)(Sb + (16 * pi + fr) * S128 + 64 * nb + 16 * jj + 4 * fq) = wv; }
        if (ck > 0) VM_WAIT(2);
        LBAR();
        const u32x2 z0 = zraw[0], z1 = zraw[1]; const unsigned dtr_cur = dtr_next;
        if (ck + 1 < NCHUNK) SSD_DMA(ck + 1);
        if (ck + 1 < NCHUNK) { SSD_LOAD_XN(ck + 1); zraw[0] = *(const u32x2*)(pz + (size_t)64 * DINP); zraw[1] = *(const u32x2*)(pz + (size_t)64 * DINP + 16);
            dtr_next = H[((size_t)ck * 64 + (ck + 2 < NCHUNK ? 128 : 64) + lane) * DINP + C_DT + hd]; }
        asm volatile("" ::: "memory");
        if (w == 7 && ck + 1 < NCHUNK) { SSD_TABLE(smn, dtr_cur); smn[320 + lane] = Dh * __builtin_amdgcn_rcpf(smn[lane]); }
        { const int s0 = 8 * xcg; float mv[8];
          if (s0 <= xl) { float cbv[8]; unpack8(*(const LAS u32x4*)(CBl + xl * S64 + s0), cbv); const float al = sm[64 + xl]; const f32x4 a0 = *(const LAS f32x4*)(sm + 64 + s0), a1 = *(const LAS f32x4*)(sm + 64 + s0 + 4);
#pragma unroll
              for (int i = 0; i < 4; ++i) { mv[i] = (xl >= s0 + i) ? cbv[i] * fexp(fminf(al - a0[i], 0.f)) : 0.f; mv[4 + i] = (xl >= s0 + 4 + i) ? cbv[4 + i] * fexp(fminf(al - a1[i], 0.f)) : 0.f; }
              if ((xl >> 3) == xcg) { const float dd = sm[320 + xl];
#pragma unroll
                  for (int i = 0; i < 8; ++i) if (i == (xl & 7)) mv[i] += dd; } }
          else {
#pragma unroll
              for (int i = 0; i < 8; ++i) mv[i] = 0.f; }
          *(LAS u32x4*)(Mm + xl * S64 + s0) = pack8(mv); }
        f32x4 yo[2];
#pragma unroll
        for (int jj = 0; jj < 2; ++jj) { const int tj = tj0 + jj; yo[jj] = (f32x4){0.f, 0.f, 0.f, 0.f};
#pragma unroll
            for (int ks = 0; ks < 4; ++ks) { const bf16x8 sb = *(const LAS bf16x8*)(Sb + (16 * tj + fr) * S128 + 32 * ks + 8 * fq); const bf16x8 c = *(const LAS bf16x8*)(Cm + (16 * ti + fr) * S128 + 32 * ks + 8 * fq);
                yo[jj] = __builtin_amdgcn_mfma_f32_16x16x32_bf16(sb, c, yo[jj], 0, 0, 0); } }
        { const float cd = sm[256];
#pragma unroll
          for (int jj = 0; jj < 4; ++jj) { S[jj] = S[jj] * cd;
#pragma unroll
            for (int ks = 0; ks < 2; ++ks) { const bf16x8 a = *(const LAS bf16x8*)(BT + (64 * nb + 16 * jj + fr) * S64 + 32 * ks + 8 * fq); const bf16x8 b = *(const LAS bf16x8*)(XTW + (16 * pi + fr) * S64 + 32 * ks + 8 * fq);
                S[jj] = __builtin_amdgcn_mfma_f32_16x16x32_bf16(a, b, S[jj], 0, 0, 0); }
            if (jj & 1) asm volatile("" ::: "memory"); } }
        const float ec = sm[192 + 16 * ti + fr];
        LBAR();
        { float ss = 0.f; const u32x2 zz[2] = {z0, z1};
#pragma unroll
          for (int jj = 0; jj < 2; ++jj) { const int tj = tj0 + jj; f32x4 yd = (f32x4){0.f, 0.f, 0.f, 0.f};
#pragma unroll
              for (int ks = 0; ks < 2; ++ks) { const bf16x8 a = *(const LAS bf16x8*)(XT + (16 * tj + fr) * S64 + 32 * ks + 8 * fq); const bf16x8 b = *(const LAS bf16x8*)(Mm + (16 * ti + fr) * S64 + 32 * ks + 8 * fq);
                  yd = __builtin_amdgcn_mfma_f32_16x16x32_bf16(a, b, yd, 0, 0, 0); }
              const float z[4] = {blo(zz[jj].x), bhi(zz[jj].x), blo(zz[jj].y), bhi(zz[jj].y)}; float v[4];
#pragma unroll
              for (int r = 0; r < 4; ++r) { v[r] = (yd[r] + ec * yo[jj][r]) * fsilu(z[r]); ss += v[r] * v[r]; }
              u32x2 ov; ov.x = pk2(v[0], v[1]); ov.y = pk2(v[2], v[3]); *(u32x2*)(pz + 16 * jj) = ov; }
          ss += __shfl_xor(ss, 16); ss += __shfl_xor(ss, 32);
          if (fq == 0) *pss = ss;
          pz += (size_t)64 * DINP; pss += 64 * 64; }
    }
    float* so = F.out + O_SSP + ((((size_t)layer * BATCH + mb * NSEQ_MB + sl) * 32 + hd) * 64) * 128;
#pragma unroll
    for (int jj = 0; jj < 4; ++jj) *(f32x4*)(so + (size_t)(16 * pi + fr) * 128 + 64 * nb + 16 * jj + 4 * fq) = S[jj];
    VM_WAIT(0); __syncthreads();
}

__device__ __forceinline__ void ssd_sample_unit(const Frame& F, int layer, int sq, int hd) {
    const int tid = F.tid, lane = F.lane; LAS float* L = (LAS float*)F.lds;
    LAS float* xs = L; LAS float* Bs = L + 16 * 64; LAS float* Cs = Bs + 16 * 128; LAS float* dts = Cs + 16 * 128; LAS float* das = dts + 16; LAS float* Yl = das + 16;
    const int g = hd >> 2;
    bf16_t* H = ws_bf(F, WS_H) + (size_t)(NP + sq * 16) * DINP;
    const float* hist = F.in[I_SCV] + ((size_t)layer * DECB + sq) * 3 * CONVDIM;
    const float* convw = F.in[I_CONVW] + (size_t)layer * 4 * CONVDIM; const float* convb = F.in[I_CONVB] + (size_t)layer * CONVDIM;
    __syncthreads();
    if (tid < 320) { const int c = tid; const int xc = c < 64 ? hd * 64 + c : (c < 192 ? 2048 + g * 128 + (c - 64) : 3072 + g * 128 + (c - 192));
        float win[19];
#pragma unroll
        for (int i = 0; i < 3; ++i) win[i] = hist[i * CONVDIM + xc];
#pragma unroll
        for (int t = 0; t < 16; ++t) win[3 + t] = bf2f(H[(size_t)t * DINP + C_X + xc]);
        const float w0 = convw[xc], w1 = convw[CONVDIM + xc], w2 = convw[2 * CONVDIM + xc], w3 = convw[3 * CONVDIM + xc], bb = convb[xc];
#pragma unroll
        for (int t = 0; t < 16; ++t) { const float a = fsilu(bb + win[t] * w0 + win[t + 1] * w1 + win[t + 2] * w2 + win[t + 3] * w3);
            if (c < 64) xs[t * 64 + c] = a; else if (c < 192) Bs[t * 128 + c - 64] = a; else Cs[t * 128 + c - 192] = a; } }
    if (tid < 16) { const float dt = softplus_f(bf2f(H[(size_t)tid * DINP + C_DT + hd]) + F.in[I_DTB][layer * 32 + hd]); dts[tid] = dt; das[tid] = fexp(-fexp(F.in[I_ALOG][layer * 32 + hd]) * dt); }
    __syncthreads();
    const int p = tid >> 3, n0 = (tid & 7) * 16;
    const size_t sbase = ((((size_t)layer * DECB + sq) * 32 + hd) * 64 + p) * 128 + n0;
    float S[16];
#pragma unroll
    for (int i = 0; i < 16; ++i) S[i] = F.in[I_SST][sbase + i];
    for (int t = 0; t < 16; ++t) { const float dec = das[t], xv = xs[t * 64 + p] * dts[t]; float part = 0.f;
#pragma unroll
        for (int i = 0; i < 16; ++i) { S[i] = S[i] * dec + xv * Bs[t * 128 + n0 + i]; part += Cs[t * 128 + n0 + i] * S[i]; }
        part += __shfl_xor(part, 1); part += __shfl_xor(part, 2); part += __shfl_xor(part, 4);
        if ((tid & 7) == 0) Yl[t * 64 + p] = part; }
#pragma unroll
    for (int i = 0; i < 16; ++i) F.out[O_SSS + sbase + i] = S[i];
    __syncthreads();
    const float Dh = F.in[I_SD][layer * 32 + hd];
#pragma unroll
    for (int j = 0; j < 2; ++j) { const int it = tid + 512 * j, t = it >> 6, pp = it & 63;
        const float z = bf2f(H[(size_t)t * DINP + C_Z + hd * 64 + pp]); const float v = (Yl[t * 64 + pp] + Dh * xs[t * 64 + pp]) * fsilu(z);
        H[(size_t)t * DINP + C_Z + hd * 64 + pp] = bf1(v);
        const float ss = wave_sum(v * v);
        if (lane < 2) ws_f(F, WS_SSQ)[((size_t)NP + sq * 16 + t) * 64 + hd * 2 + lane] = lane == 0 ? ss : 0.f; }
}

__device__ __forceinline__ int t5_bucket(int rel) {
    const int n = rel < 0 ? -rel : rel; const int b = rel > 0 ? 16 : 0;
    if (n < 8) return b + n;
    int v = 8; v += n >= 12; v += n >= 16; v += n >= 23; v += n >= 32; v += n >= 46; v += n >= 64; v += n >= 91;
    return b + v;
}
constexpr int AK_P = 72, AV_P = 200;
constexpr int AL_K = 0, AL_VT = AL_K + 192 * AK_P * 2, AL_LUT = AL_VT + 64 * AV_P * 2, AL_END = AL_LUT + 4 * 256 * 4;
static_assert(AL_END <= RING_BYTES, "attention LDS map");
__device__ __forceinline__ void attn_prompt_unit(const Frame& F, int layer, int sl, int ck, int kh) {
    const int tid = F.tid, lane = F.lane, w = F.wave, q32 = lane & 31, hi = lane >> 5;
    LAS bf16_t* Kl = (LAS bf16_t*)(F.lds + AL_K); LAS bf16_t* VT = (LAS bf16_t*)(F.lds + AL_VT); LAS float* lut = (LAS float*)(F.lds + AL_LUT);
    bf16_t* H = ws_bf(F, WS_H) + (size_t)sl * SEQ * DINP;
    const int gq = w >> 1, qh = w & 1, head = kh * 4 + gq;
    const size_t qrow = (size_t)ck * 64 + 32 * qh + q32;
    bf16x8 qf[4];
#pragma unroll
    for (int ds = 0; ds < 4; ++ds) qf[ds] = *(const bf16x8*)(H + qrow * DINP + C_Q + head * 64 + 16 * ds + 8 * hi);
    __syncthreads();
#pragma unroll
    for (int j = 0; j < 3; ++j) { const int id = tid + 512 * j, key = id >> 3, cg = id & 7; const int t = 64 * (ck - 2) + key;
        u32x4 kv = (u32x4){0u, 0u, 0u, 0u}, vv = kv;
        if (t >= 0) { kv = *(const u32x4*)(H + (size_t)t * DINP + C_K + kh * 64 + 8 * cg); vv = *(const u32x4*)(H + (size_t)t * DINP + C_V + kh * 64 + 8 * cg); }
        *(LAS u32x4*)(Kl + key * AK_P + 8 * cg) = kv;
        VT[(8 * cg + 0) * AV_P + key] = (bf16_t)(vv.x & 0xffffu); VT[(8 * cg + 1) * AV_P + key] = (bf16_t)(vv.x >> 16); VT[(8 * cg + 2) * AV_P + key] = (bf16_t)(vv.y & 0xffffu); VT[(8 * cg + 3) * AV_P + key] = (bf16_t)(vv.y >> 16);
        VT[(8 * cg + 4) * AV_P + key] = (bf16_t)(vv.z & 0xffffu); VT[(8 * cg + 5) * AV_P + key] = (bf16_t)(vv.z >> 16); VT[(8 * cg + 6) * AV_P + key] = (bf16_t)(vv.w & 0xffffu); VT[(8 * cg + 7) * AV_P + key] = (bf16_t)(vv.w >> 16); }
    for (int e = tid; e < 4 * 255; e += NTHREADS) { const int gg = e / 255, idx = e % 255; lut[gg * 256 + idx] = F.in[I_RELB][t5_bucket(idx - 191) * 16 + kh * 4 + gg]; }
    __syncthreads();
    f32x16 sc[6];
#pragma unroll
    for (int kt = 0; kt < 6; ++kt) {
#pragma unroll
        for (int r = 0; r < 16; ++r) sc[kt][r] = 0.f;
#pragma unroll
        for (int ds = 0; ds < 4; ++ds) { const bf16x8 a = *(const LAS bf16x8*)(Kl + (32 * kt + q32) * AK_P + 16 * ds + 8 * hi); sc[kt] = __builtin_amdgcn_mfma_f32_32x32x16_bf16(a, qf[ds], sc[kt], 0, 0, 0); } }
    const int qidx = 32 * qh + q32; const float sink = F.in[I_SINK][layer * 16 + head];
    float mx = -3.0e38f;
#pragma unroll
    for (int kt = 0; kt < 6; ++kt)
#pragma unroll
        for (int r = 0; r < 16; ++r) { const int key = 32 * kt + (r & 3) + 8 * (r >> 2) + 4 * hi; const int rel = key - 128 - qidx;
            float s = sc[kt][r] * 0.125f + lut[gq * 256 + rel + 191]; if (ck < 2 && 64 * ck + key - 128 < 0) s = -1e30f; sc[kt][r] = s; mx = fmaxf(mx, s); }
    mx = fmaxf(mx, __shfl_xor(mx, 32)); mx = fmaxf(mx, sink);
    float sum = 0.f;
#pragma unroll
    for (int kt = 0; kt < 6; ++kt)
#pragma unroll
        for (int r = 0; r < 16; ++r) { const float e = fexp(sc[kt][r] - mx); sc[kt][r] = e; sum += e; }
    sum += __shfl_xor(sum, 32);
    const float inv = 1.0f / (sum + fexp(sink - mx));
    f32x16 o[2];
#pragma unroll
    for (int d2 = 0; d2 < 2; ++d2)
#pragma unroll
        for (int r = 0; r < 16; ++r) o[d2][r] = 0.f;
#pragma unroll
    for (int kt = 0; kt < 6; ++kt)
#pragma unroll
        for (int s = 0; s < 2; ++s) {
            u32x4 pw; pw.x = pk2(sc[kt][8 * s + 0], sc[kt][8 * s + 1]); pw.y = pk2(sc[kt][8 * s + 2], sc[kt][8 * s + 3]); pw.z = pk2(sc[kt][8 * s + 4], sc[kt][8 * s + 5]); pw.w = pk2(sc[kt][8 * s + 6], sc[kt][8 * s + 7]);
            const bf16x8 pa = __builtin_bit_cast(bf16x8, pw);
#pragma unroll
            for (int d2 = 0; d2 < 2; ++d2) { const LAS bf16_t* vp = VT + (32 * d2 + q32) * AV_P + 32 * kt + 16 * s + 4 * hi;
                const u32x2 lo = *(const LAS u32x2*)vp, hh = *(const LAS u32x2*)(vp + 8); u32x4 vw; vw.x = lo.x; vw.y = lo.y; vw.z = hh.x; vw.w = hh.y;
                o[d2] = __builtin_amdgcn_mfma_f32_32x32x16_bf16(pa, __builtin_bit_cast(bf16x8, vw), o[d2], 0, 0, 0); } }
#pragma unroll
    for (int r = 0; r < 16; ++r) { const int q = (r & 3) + 8 * (r >> 2) + 4 * hi; const float iv = __shfl(inv, q);
        bf16_t* op = H + ((size_t)ck * 64 + 32 * qh + q) * DINP + C_Q + head * 64 + q32;
        op[0] = bf1(o[0][r] * iv); op[32] = bf1(o[1][r] * iv); }
}
__device__ __forceinline__ void attn_sample_unit(const Frame& F, int layer, int sq, int kh) {
    const int tid = F.tid; LAS float* L = (LAS float*)F.lds;
    LAS float* Kf = L; LAS float* Vf = Kf + 144 * 65; LAS float* Qf = Vf + 144 * 64; LAS float* P = Qf + 64 * 65; LAS float* Pinv = P + 64 * 145;
    static_assert((144 * 65 + 144 * 64 + 64 * 65 + 64 * 145 + 64) * 4 <= RING_BYTES, "sample attention LDS map");
    bf16_t* H = ws_bf(F, WS_H) + (size_t)(NP + sq * 16) * DINP;
    const float* ck = F.in[I_CK] + ((size_t)layer * DECB + sq) * WINDOW * 256; const float* cv = F.in[I_CV] + ((size_t)layer * DECB + sq) * WINDOW * 256;
    __syncthreads();
    for (int i = tid; i < 144 * 64; i += NTHREADS) { const int key = i >> 6, d = i & 63;
        Kf[key * 65 + d] = key < 128 ? ck[(size_t)key * 256 + kh * 64 + d] : bf2f(H[(size_t)(key - 128) * DINP + C_K + kh * 64 + d]);
        Vf[key * 64 + d] = key < 128 ? cv[(size_t)key * 256 + kh * 64 + d] : bf2f(H[(size_t)(key - 128) * DINP + C_V + kh * 64 + d]); }
    for (int i = tid; i < 64 * 64; i += NTHREADS) { const int row = i >> 6, d = i & 63; Qf[row * 65 + d] = bf2f(H[(size_t)(row & 15) * DINP + C_Q + (kh * 4 + (row >> 4)) * 64 + d]); }
    __syncthreads();
    for (int i = tid; i < 64 * 144; i += NTHREADS) { const int row = i / 144, key = i % 144; float s = 0.f;
        for (int d = 0; d < 64; ++d) s += Qf[row * 65 + d] * Kf[key * 65 + d];
        P[row * 145 + key] = s * 0.125f + F.in[I_RELB][t5_bucket(key - 128 - (row & 15)) * 16 + kh * 4 + (row >> 4)]; }
    __syncthreads();
    { const int row = tid >> 3, sub = tid & 7; const float sink = F.in[I_SINK][layer * 16 + kh * 4 + (row >> 4)]; float mx = -3.0e38f;
      for (int k = sub; k < 144; k += 8) mx = fmaxf(mx, P[row * 145 + k]);
      mx = fmaxf(mx, __shfl_xor(mx, 1)); mx = fmaxf(mx, __shfl_xor(mx, 2)); mx = fmaxf(mx, __shfl_xor(mx, 4)); mx = fmaxf(mx, sink);
      float sum = 0.f;
      for (int k = sub; k < 144; k += 8) { const float e = fexp(P[row * 145 + k] - mx); P[row * 145 + k] = e; sum += e; }
      sum += __shfl_xor(sum, 1); sum += __shfl_xor(sum, 2); sum += __shfl_xor(sum, 4);
      if (sub == 0) Pinv[row] = 1.0f / (sum + fexp(sink - mx)); }
    __syncthreads();
    { const int row = tid >> 3, d0 = (tid & 7) * 8; float o[8] = {0.f, 0.f, 0.f, 0.f, 0.f, 0.f, 0.f, 0.f};
      for (int k = 0; k < 144; ++k) { const float pv = P[row * 145 + k];
#pragma unroll
          for (int i = 0; i < 8; ++i) o[i] += pv * Vf[k * 64 + d0 + i]; }
      const float iv = Pinv[row];
#pragma unroll
      for (int i = 0; i < 8; ++i) o[i] *= iv;
      *(u32x4*)(H + (size_t)(row & 15) * DINP + C_Q + (kh * 4 + (row >> 4)) * 64 + d0) = pack8(o); }
}
__device__ __forceinline__ void sc_unit(const Frame& F, int layer, int tile) {
    const int tid = F.tid, cg = tid & 127, rs = tid >> 7; bf16_t* H = ws_bf(F, WS_H);
    const float* wsc = F.in[I_SCW] + (size_t)layer * 3 * D + 8 * cg; float wt[3][8];
#pragma unroll
    for (int i = 0; i < 3; ++i)
#pragma unroll
        for (int c = 0; c < 8; ++c) wt[i][c] = wsc[i * D + c];
    const int row0 = tile * 64 + 16 * rs; const bool smp = row0 >= NP; const int tt0 = smp ? 0 : row0 % SEQ;
    float u1[8], u2[8];
    if (tt0 >= 2) { float c8[8], h8[8];
        unpack8(*(const u32x4*)(H + (size_t)(row0 - 2) * DINP + C_SCC + 8 * cg), c8); unpack8(*(const u32x4*)(H + (size_t)(row0 - 2) * DINP + C_SCH + 8 * cg), h8);
#pragma unroll
        for (int c = 0; c < 8; ++c) u2[c] = c8[c] * h8[c];
        unpack8(*(const u32x4*)(H + (size_t)(row0 - 1) * DINP + C_SCC + 8 * cg), c8); unpack8(*(const u32x4*)(H + (size_t)(row0 - 1) * DINP + C_SCH + 8 * cg), h8);
#pragma unroll
        for (int c = 0; c < 8; ++c) u1[c] = c8[c] * h8[c]; }
    else if (smp) { const float* hp = F.in[I_SSC] + (((size_t)layer * DECB + ((row0 - NP) >> 4)) * 2) * D + 8 * cg;
#pragma unroll
        for (int c = 0; c < 8; ++c) { u2[c] = hp[c]; u1[c] = hp[D + c]; } }
    else {
#pragma unroll
        for (int c = 0; c < 8; ++c) { u2[c] = 0.f; u1[c] = 0.f; } }
#pragma unroll 1
    for (int q = 0; q < 4; ++q) {
        u32x4 cw_[4], hw_[4], bw_[4];
#pragma unroll
        for (int i = 0; i < 4; ++i) { const bf16_t* hp = H + (size_t)(row0 + 4 * q + i) * DINP + 8 * cg; cw_[i] = *(const u32x4*)(hp + C_SCC); hw_[i] = *(const u32x4*)(hp + C_SCH); bw_[i] = *(const u32x4*)(hp + C_SCB); }
        asm volatile("" ::: "memory");
#pragma unroll
        for (int i = 0; i < 4; ++i) { float c8[8], h8[8], b8[8], a[8]; unpack8(cw_[i], c8); unpack8(hw_[i], h8); unpack8(bw_[i], b8);
#pragma unroll
            for (int c = 0; c < 8; ++c) { const float u0 = c8[c] * h8[c]; a[c] = (u2[c] * wt[0][c] + u1[c] * wt[1][c] + u0 * wt[2][c]) * b8[c]; u2[c] = u1[c]; u1[c] = u0; }
            *(u32x4*)(H + (size_t)(row0 + 4 * q + i) * DINP + C_SCB + 8 * cg) = pack8(a); }
    }
}
__device__ __forceinline__ void state_out_unit(const Frame& F, int layer, int mb, int sl, bool smp) {
    const int tid = F.tid; const bf16_t* H = ws_bf(F, WS_H);
    const int nkv = smp ? DECS : WINDOW, len = smp ? DECS : SEQ; const size_t row0 = smp ? (size_t)NP + sl * 16 : (size_t)sl * SEQ; const int sg = smp ? sl : mb * NSEQ_MB + sl;
    const size_t nb_ = smp ? DECB : BATCH;
    float* ko = F.out + (smp ? O_KS : O_KP) + ((size_t)layer * nb_ + sg) * nkv * 256; float* vo = F.out + (smp ? O_VS : O_VP) + ((size_t)layer * nb_ + sg) * nkv * 256;
    for (int i = tid; i < nkv * 32; i += NTHREADS) { const int j = i >> 5, c8 = (i & 31) * 8; const bf16_t* hp = H + (row0 + len - nkv + j) * DINP; float f[8];
        unpack8(*(const u32x4*)(hp + C_K + c8), f); *(f32x4*)(ko + (size_t)j * 256 + c8) = (f32x4){f[0], f[1], f[2], f[3]}; *(f32x4*)(ko + (size_t)j * 256 + c8 + 4) = (f32x4){f[4], f[5], f[6], f[7]};
        unpack8(*(const u32x4*)(hp + C_V + c8), f); *(f32x4*)(vo + (size_t)j * 256 + c8) = (f32x4){f[0], f[1], f[2], f[3]}; *(f32x4*)(vo + (size_t)j * 256 + c8 + 4) = (f32x4){f[4], f[5], f[6], f[7]}; }
    float* co = F.out + (smp ? O_CVS : O_CVP) + ((size_t)layer * nb_ + sg) * 3 * CONVDIM;
    for (int i = tid; i < 3 * 512; i += NTHREADS) { const int j = i / 512, c8 = (i % 512) * 8; float f[8]; unpack8(*(const u32x4*)(H + (row0 + len - 3 + j) * DINP + C_X + c8), f);
        *(f32x4*)(co + (size_t)j * CONVDIM + c8) = (f32x4){f[0], f[1], f[2], f[3]}; *(f32x4*)(co + (size_t)j * CONVDIM + c8 + 4) = (f32x4){f[4], f[5], f[6], f[7]}; }
    float* so = F.out + (smp ? O_SCS : O_SCP) + ((size_t)layer * nb_ + sg) * 2 * D;
    for (int i = tid; i < 2 * 128; i += NTHREADS) { const int j = i >> 7, c8 = (i & 127) * 8; float c[8], h[8]; const bf16_t* hp = H + (row0 + len - 2 + j) * DINP;
        unpack8(*(const u32x4*)(hp + C_SCC + c8), c); unpack8(*(const u32x4*)(hp + C_SCH + c8), h);
        *(f32x4*)(so + (size_t)j * D + c8) = (f32x4){c[0] * h[0], c[1] * h[1], c[2] * h[2], c[3] * h[3]}; *(f32x4*)(so + (size_t)j * D + c8 + 4) = (f32x4){c[4] * h[4], c[5] * h[5], c[6] * h[6], c[7] * h[7]}; }
}
#ifndef MIX_MASK
#define MIX_MASK 0xFF
#endif
#define MIXON(b) ((MIX_MASK >> (b)) & 1)
__device__ __forceinline__ void step_premix(const Frame& F, int layer, int mb) {
    const int n_bc = NSEQ_MB * NCHUNK * 8, n_att = NSEQ_MB * NCHUNK * NKV, n_sc = rows_of(mb) / 64, n_so = NSEQ_MB + (mb == 0 ? DECB : 0);
    const int n_ss = mb == 0 ? DECB * 32 : 0, n_as = mb == 0 ? DECB * NKV : 0;
    const int total = n_bc + n_att + n_sc + n_so + n_ss + n_as;
#define UF(Fu) Frame Fu = F; Fu.lane = opq(lane_id()); Fu.tid = Fu.wave * 64 + Fu.lane
    PROBE_T0(14) if constexpr (MIXON(0)) { UF(Fu); BcRegs ra, rn_;
        if (F.bid < n_bc) ssd_bc_load(Fu, layer, F.bid, ra);
        for (int u = F.bid; u < n_bc; u += F.G) { const bool more = u + F.G < n_bc; if (more) ssd_bc_load(Fu, layer, u + F.G, rn_);
            ssd_bc_unit(Fu, u, ra);
            if (more) ra = rn_; } }
    PROBE_T1(14)
    for (int un = F.bid; un < total; un += F.G) { int r = un;
        if (r < n_bc) continue;
        r -= n_bc;
        if (r < n_att) { PROBE_T0(15) if constexpr (MIXON(1)) { UF(Fu);
                const int ra = (n_att % 8 == 0 && F.G % 8 == 0 && n_bc % F.G == 0) ? (r & 7) * (n_att >> 3) + (r >> 3) : r;
                attn_prompt_unit(Fu, layer, ra / (NCHUNK * NKV), (ra / NKV) % NCHUNK, ra % NKV); } PROBE_T1(15) continue; } r -= n_att;
        if (r < n_sc) { PROBE_T0(16) if constexpr (MIXON(2)) { UF(Fu); sc_unit(Fu, layer, r); } PROBE_T1(16) continue; } r -= n_sc;
        if (r < n_so) { PROBE_T0(17) if constexpr (MIXON(3)) { UF(Fu); state_out_unit(Fu, layer, mb, r < NSEQ_MB ? r : r - NSEQ_MB, r >= NSEQ_MB); } PROBE_T1(17) continue; } r -= n_so;
        if (r < n_ss) { PROBE_T0(18) if constexpr (MIXON(4)) { UF(Fu); ssd_sample_unit(Fu, layer, r >> 5, r & 31); } PROBE_T1(18) continue; } r -= n_ss;
        { PROBE_T0(19) if constexpr (MIXON(5)) { UF(Fu); attn_sample_unit(Fu, layer, r >> 2, r & 3); } PROBE_T1(19) }
    }
}
__device__ __forceinline__ void step_mixers(const Frame& F, int layer, int mb) {
    for (int v = F.bid; v < NSEQ_MB * 32; v += F.G) { const int un = (NSEQ_MB == 8 && F.G == 256) ? (v & 7) * 32 + (v >> 3) : v; UF(Fu); ssd_prompt_unit(Fu, layer, mb, un >> 5, un & 31); }
}
__device__ __forceinline__ void step_gnorm(const Frame& F, int mb) {
    const int gw = F.bid * NWAVES + F.wave, NGW = F.G * NWAVES, nr = rows_of(mb); bf16_t* H = ws_bf(F, WS_H); const float* ssq = ws_f(F, WS_SSQ);
    constexpr int RB = 4; const int g = F.lane >> 3;
    for (int r0 = gw; r0 < nr; r0 += RB * NGW) {
        u32x4 d[RB][4]; f32x4 q[RB];
#pragma unroll
        for (int i = 0; i < RB; ++i) { const int r = r0 + i * NGW < nr ? r0 + i * NGW : r0; { const f32x4 qa = *(const f32x4*)(ssq + (size_t)r * 64 + 8 * g), qb = *(const f32x4*)(ssq + (size_t)r * 64 + 8 * g + 4); q[i] = qa + qb; } const u32x4* p = (const u32x4*)(H + (size_t)r * DINP + C_Z + 32 * F.lane);
#pragma unroll
            for (int j = 0; j < 4; ++j) d[i][j] = p[j]; }
        asm volatile("" ::: "memory");
#pragma unroll
        for (int i = 0; i < RB; ++i) { const int r = r0 + i * NGW; if (r >= nr) continue;
            const float rstd = 1.0f / sqrtf(((q[i][0] + q[i][1]) + (q[i][2] + q[i][3])) * (1.0f / 256.0f) + LN_EPS); u32x4* p = (u32x4*)(H + (size_t)r * DINP + C_Z + 32 * F.lane);
#pragma unroll
            for (int j = 0; j < 4; ++j) { float f[8]; unpack8(d[i][j], f);
#pragma unroll
                for (int k = 0; k < 8; ++k) f[k] *= rstd;
                p[j] = pack8(f); } }
    }
}
constexpr int LOG_NEXP = NEXP == 32 ? 5 : (NEXP == 16 ? 4 : (NEXP == 8 ? 3 : 2));
template <int N, int MASK> struct RedStep {
    static __device__ __forceinline__ void run(float* v, int lane) {
        constexpr int Hn = N / 2; const bool up = (lane & MASK) != 0;
#pragma unroll
        for (int i = 0; i < Hn; ++i) { const float keep = up ? v[i + Hn] : v[i], send = up ? v[i] : v[i + Hn]; v[i] = keep + xshfl<MASK>(send); }
        if constexpr (Hn > 1) RedStep<Hn, (MASK >> 1)>::run(v, lane);
    }
};
constexpr int RW_P = D + 8;
__device__ __forceinline__ void step_ln1_router_mfma(const Frame& F, int layer, int mb) {
    LAS bf16_t* WH = (LAS bf16_t*)F.lds; LAS bf16_t* WL = WH + NTE * 16 * RW_P; LAS float* GB = (LAS float*)(WL + NTE * 16 * RW_P);
    static_assert((size_t)2 * NTE * 16 * RW_P * 2 + 2 * D * 4 <= (size_t)SCR_BYTES, "router LDS map");
    const int lane = F.lane, fr = lane & 15, fq = lane >> 4;
    __syncthreads();
    { const bf16_t* rwh = ws_bf(F, WS_RWH) + (size_t)layer * NTE * 16 * D; const bf16_t* rwl = ws_bf(F, WS_RWL) + (size_t)layer * NTE * 16 * D;
      for (int i = F.tid; i < NTE * 16 * (D / 8); i += NTHREADS) { const int e = i / (D / 8), c = i % (D / 8); *(LAS u32x4*)(WH + e * RW_P + 8 * c) = *(const u32x4*)(rwh + (size_t)e * D + 8 * c); *(LAS u32x4*)(WL + e * RW_P + 8 * c) = *(const u32x4*)(rwl + (size_t)e * D + 8 * c); }
      for (int i = F.tid; i < D; i += NTHREADS) { GB[i] = F.in[I_LN1G][(size_t)layer * D + i]; GB[D + i] = F.in[I_LN1B][(size_t)layer * D + i]; } }
    unsigned* cnt = F.ctl + CW_CNT + (mb * DEPTH + layer) * 64;
    LAS unsigned* lcnt = (LAS unsigned*)(F.lds + MISC_OFF) + 128;
    if (F.tid < 64) lcnt[F.tid] = 0u;
    __syncthreads();
    const int gw = F.bid * NWAVES + F.wave, NGW = F.G * NWAVES, nr = rows_of(mb);
    const float* rb = F.in[I_RB] + (size_t)layer * NEXP;
    bf16_t* XB = ws_bf(F, WS_XB); int* topi = (int*)(F.ws + WS_TOPI); float* gate = ws_f(F, WS_GATE); int* pos = (int*)(F.ws + WS_POS);
    float rbv[NTE];
#pragma unroll
    for (int t = 0; t < NTE; ++t) rbv[t] = 16 * t + fr < NEXP ? rb[16 * t + fr] : 0.f;
    for (int blk = gw; blk < nr / 16; blk += NGW) {
        const int row = 16 * blk + fr; const float* xr = x_out_row(F, mb, row) + 8 * fq;
        float s1 = 0.f, s2 = 0.f;
#pragma unroll 8
        for (int sI = 0; sI < D / 32; ++sI) { const f32x4 a = *(const f32x4*)(xr + 32 * sI), b = *(const f32x4*)(xr + 32 * sI + 4);
            s1 += ((a[0] + a[1]) + (a[2] + a[3])) + ((b[0] + b[1]) + (b[2] + b[3])); s2 += ((a[0] * a[0] + a[1] * a[1]) + (a[2] * a[2] + a[3] * a[3])) + ((b[0] * b[0] + b[1] * b[1]) + (b[2] * b[2] + b[3] * b[3])); }
        s1 += xshfl<16>(s1); s1 += xshfl<32>(s1); s2 += xshfl<16>(s2); s2 += xshfl<32>(s2);
        const float mean = s1 * (1.0f / D); const float rstd = 1.0f / sqrtf(fmaxf(s2 * (1.0f / D) - mean * mean, 0.f) + LN_EPS);
        f32x4 acc[NTE];
#pragma unroll
        for (int t = 0; t < NTE; ++t) acc[t] = (f32x4){0.f, 0.f, 0.f, 0.f};
        bf16_t* xo = XB + (size_t)row * D + 8 * fq;
#pragma unroll 4
        for (int sI = 0; sI < D / 32; ++sI) { const f32x4 a = *(const f32x4*)(xr + 32 * sI), b = *(const f32x4*)(xr + 32 * sI + 4);
            const f32x4 g0 = *(const LAS f32x4*)(GB + 32 * sI + 8 * fq), g1 = *(const LAS f32x4*)(GB + 32 * sI + 8 * fq + 4), b0 = *(const LAS f32x4*)(GB + D + 32 * sI + 8 * fq), b1 = *(const LAS f32x4*)(GB + D + 32 * sI + 8 * fq + 4);
            const f32x4 n0 = (a - mean) * rstd * g0 + b0, n1 = (b - mean) * rstd * g1 + b1;
            u32x4 hw; hw.x = pk2(n0[0], n0[1]); hw.y = pk2(n0[2], n0[3]); hw.z = pk2(n1[0], n1[1]); hw.w = pk2(n1[2], n1[3]);
            *(u32x4*)(xo + 32 * sI) = hw;
            u32x4 lw; lw.x = pk2(n0[0] - blo(hw.x), n0[1] - bhi(hw.x)); lw.y = pk2(n0[2] - blo(hw.y), n0[3] - bhi(hw.y)); lw.z = pk2(n1[0] - blo(hw.z), n1[1] - bhi(hw.z)); lw.w = pk2(n1[2] - blo(hw.w), n1[3] - bhi(hw.w));
            const bf16x8 ah = __builtin_bit_cast(bf16x8, hw), al = __builtin_bit_cast(bf16x8, lw);
#pragma unroll
            for (int t = 0; t < NTE; ++t) { const bf16x8 wh = *(const LAS bf16x8*)(WH + (16 * t + fr) * RW_P + 32 * sI + 8 * fq), wl = *(const LAS bf16x8*)(WL + (16 * t + fr) * RW_P + 32 * sI + 8 * fq);
                acc[t] = __builtin_amdgcn_mfma_f32_16x16x32_bf16(ah, wh, acc[t], 0, 0, 0); acc[t] = __builtin_amdgcn_mfma_f32_16x16x32_bf16(al, wh, acc[t], 0, 0, 0); acc[t] = __builtin_amdgcn_mfma_f32_16x16x32_bf16(ah, wl, acc[t], 0, 0, 0); } }
#pragma unroll
        for (int r = 0; r < 4; ++r) { float val[NTE];
#pragma unroll
            for (int t = 0; t < NTE; ++t) val[t] = 16 * t + fr < NEXP ? acc[t][r] + rbv[t] : -3.0e38f;
            float tv[4]; int te[4];
#pragma unroll
            for (int k = 0; k < 4; ++k) { float m = val[0];
#pragma unroll
                for (int t = 1; t < NTE; ++t) m = fmaxf(m, val[t]);
                m = fmaxf(m, xshfl<1>(m)); m = fmaxf(m, xshfl<2>(m)); m = fmaxf(m, xshfl<4>(m)); m = fmaxf(m, xshfl<8>(m));
                int ce = 9999;
#pragma unroll
                for (int t = NTE - 1; t >= 0; --t) ce = val[t] == m ? 16 * t + fr : ce;
                { int o = xshfl<1>(ce); ce = o < ce ? o : ce; o = xshfl<2>(ce); ce = o < ce ? o : ce; o = xshfl<4>(ce); ce = o < ce ? o : ce; o = xshfl<8>(ce); ce = o < ce ? o : ce; }
                tv[k] = m; te[k] = ce;
#pragma unroll
                for (int t = 0; t < NTE; ++t) if (16 * t + fr == ce) val[t] = -3.0e38f; }
            const float e1 = fexp(tv[1] - tv[0]), e2 = fexp(tv[2] - tv[0]), e3 = fexp(tv[3] - tv[0]); const float inv = 1.0f / (1.0f + e1 + e2 + e3);
            if (fr < 4) { const int e = fr == 0 ? te[0] : (fr == 1 ? te[1] : (fr == 2 ? te[2] : te[3])); const float gv = (fr == 0 ? 1.0f : (fr == 1 ? e1 : (fr == 2 ? e2 : e3))) * inv;
                const size_t tok = (size_t)16 * blk + 4 * fq + r;
                const unsigned rk = __hip_atomic_fetch_add(lcnt + e, 1u, __ATOMIC_RELAXED, __HIP_MEMORY_SCOPE_WORKGROUP);
                topi[tok * 4 + fr] = e; gate[tok * 4 + fr] = gv; pos[tok * 4 + fr] = (int)rk; } }
    }
    __syncthreads();
    if (F.tid < NEXP) lcnt[32 + F.tid] = __hip_atomic_fetch_add(cnt + F.tid, lcnt[F.tid], __ATOMIC_RELAXED, __HIP_MEMORY_SCOPE_AGENT);
    __syncthreads();
    for (int blk = gw; blk < nr / 16; blk += NGW) pos[(size_t)16 * blk * 4 + lane] += (int)lcnt[32 + topi[(size_t)16 * blk * 4 + lane]];
}
__device__ __forceinline__ void step_ln1_router(const Frame& F, int layer, int mb) {
    LAS float* wT = (LAS float*)F.lds;
    const float* rw = F.in[I_RW] + (size_t)layer * D * NEXP;
    __syncthreads();
    for (int i = F.tid; i < D * NEXP; i += NTHREADS) { const int e = i / D, k = i % D; wT[i] = rw[(size_t)k * NEXP + e]; }
    unsigned* cnt = F.ctl + CW_CNT + (mb * DEPTH + layer) * 64;
    LAS unsigned* lcnt = (LAS unsigned*)(F.lds + MISC_OFF) + 128;
    if (F.tid < 64) lcnt[F.tid] = 0u;
    __syncthreads();
    const int gw = F.bid * NWAVES + F.wave, NGW = F.G * NWAVES, nr = rows_of(mb), lane = F.lane;
    const float* lg = F.in[I_LN1G] + (size_t)layer * D; const float* lb = F.in[I_LN1B] + (size_t)layer * D; const float* rb = F.in[I_RB] + (size_t)layer * NEXP;
    bf16_t* XB = ws_bf(F, WS_XB); int* topi = (int*)(F.ws + WS_TOPI); float* gate = ws_f(F, WS_GATE); int* pos = (int*)(F.ws + WS_POS);
    constexpr int RB = 4, NH = NEXP / 2, LOGH = LOG_NEXP - 1;
    const int myexp = ((lane & 1) * NH) | ((lane >> (6 - LOGH)) & (NH - 1));
    const float myb = rb[myexp];
    for (int r0 = gw; r0 < nr; r0 += RB * NGW) {
        f32x4 v[RB][4]; int rr[RB]; bool ok[RB];
#pragma unroll
        for (int i = 0; i < RB; ++i) { const int r = r0 + i * NGW; ok[i] = r < nr; rr[i] = ok[i] ? r : r0; const float* xr = x_out_row(F, mb, rr[i]);
#pragma unroll
            for (int j = 0; j < 4; ++j) v[i][j] = *((const f32x4*)xr + lane + 64 * j); }
        asm volatile("" ::: "memory");
#pragma unroll
        for (int i = 0; i < RB; ++i) {
            float s = 0.f;
#pragma unroll
            for (int j = 0; j < 4; ++j) s += (v[i][j][0] + v[i][j][1]) + (v[i][j][2] + v[i][j][3]);
            const float mean = wave_sum(s) * (1.0f / D); float s2 = 0.f;
#pragma unroll
            for (int j = 0; j < 4; ++j) { v[i][j] = v[i][j] - mean; s2 += (v[i][j][0] * v[i][j][0] + v[i][j][1] * v[i][j][1]) + (v[i][j][2] * v[i][j][2] + v[i][j][3] * v[i][j][3]); }
            const float rstd = 1.0f / sqrtf(wave_sum(s2) * (1.0f / D) + LN_EPS);
#pragma unroll
            for (int j = 0; j < 4; ++j) { const f32x4 gg = *((const f32x4*)lg + lane + 64 * j), bb = *((const f32x4*)lb + lane + 64 * j); v[i][j] = v[i][j] * rstd * gg + bb;
                if (ok[i]) { u32x2 w; w.x = pk2(v[i][j][0], v[i][j][1]); w.y = pk2(v[i][j][2], v[i][j][3]); *((u32x2*)(XB + (size_t)rr[i] * D) + lane + 64 * j) = w; } }
        }
        typedef float f32x2v __attribute__((ext_vector_type(2)));
        float val[RB];
#pragma unroll
        for (int hf = 0; hf < 2; ++hf) {
            float lgt[RB][NH];
#pragma unroll
            for (int e = 0; e < NH; ++e) { f32x2v a2[RB / 2];
#pragma unroll
                for (int i = 0; i < RB / 2; ++i) a2[i] = (f32x2v){0.f, 0.f};
#pragma unroll
                for (int j = 0; j < 4; ++j) { const f32x4 wv = *((const LAS f32x4*)(wT + (hf * NH + e) * D) + lane + 64 * j);
#pragma unroll
                    for (int c = 0; c < 4; ++c) { const f32x2v w2 = (f32x2v){wv[c], wv[c]};
#pragma unroll
                        for (int i = 0; i < RB / 2; ++i) a2[i] = __builtin_elementwise_fma((f32x2v){v[2 * i][j][c], v[2 * i + 1][j][c]}, w2, a2[i]); } }
#pragma unroll
                for (int i = 0; i < RB / 2; ++i) { lgt[2 * i][e] = a2[i].x; lgt[2 * i + 1][e] = a2[i].y; }
                if ((e & 1) == 1) asm volatile("" ::: "memory"); }
#pragma unroll
            for (int i = 0; i < RB; ++i) { RedStep<NH, 32>::run(lgt[i], lane); float tot = lgt[i][0];
                if constexpr ((32 >> LOGH) >= 8) tot += xshfl<8>(tot);
                if constexpr ((32 >> LOGH) >= 4) tot += xshfl<4>(tot);
                if constexpr ((32 >> LOGH) >= 2) tot += xshfl<2>(tot);
                tot += xshfl<1>(tot);
                if ((lane & 1) == hf) val[i] = tot + myb; }
        }
#pragma unroll
        for (int i = 0; i < RB; ++i) {
            float tv[4]; int te[4]; float vv = val[i];
#pragma unroll
            for (int k = 0; k < 4; ++k) { float m = vv; m = fmaxf(m, xshfl<1>(m)); m = fmaxf(m, xshfl<2>(m)); m = fmaxf(m, xshfl<4>(m)); m = fmaxf(m, xshfl<8>(m)); m = fmaxf(m, xshfl<16>(m)); m = fmaxf(m, xshfl<32>(m));
                const unsigned long long bal = __ballot(vv == m); const int wl = __builtin_ctzll(bal);
                const int be = ((wl & 1) * NH) | ((wl >> (6 - LOGH)) & (NH - 1));
                tv[k] = m; te[k] = be; if (myexp == be) vv = -3.0e38f; }
            const float e1 = fexp(tv[1] - tv[0]), e2 = fexp(tv[2] - tv[0]), e3 = fexp(tv[3] - tv[0]); const float inv = 1.0f / (1.0f + e1 + e2 + e3);
            if (lane < 4 && ok[i]) { const int e = lane == 0 ? te[0] : (lane == 1 ? te[1] : (lane == 2 ? te[2] : te[3])); const float gv = (lane == 0 ? 1.0f : (lane == 1 ? e1 : (lane == 2 ? e2 : e3))) * inv;
                const unsigned rk = __hip_atomic_fetch_add(lcnt + e, 1u, __ATOMIC_RELAXED, __HIP_MEMORY_SCOPE_WORKGROUP);
                topi[(size_t)rr[i] * 4 + lane] = e; gate[(size_t)rr[i] * 4 + lane] = gv; pos[(size_t)rr[i] * 4 + lane] = (int)rk; }
        }
    }
    __syncthreads();
    if (F.tid < NEXP) lcnt[32 + F.tid] = __hip_atomic_fetch_add(cnt + F.tid, lcnt[F.tid], __ATOMIC_RELAXED, __HIP_MEMORY_SCOPE_AGENT);
    __syncthreads();
    for (int r = gw; r < nr; r += NGW) if (lane < 4) pos[(size_t)r * 4 + lane] += (int)lcnt[32 + topi[(size_t)r * 4 + lane]];
}
__device__ __forceinline__ int moe_table(const Frame& F, int layer, int mb) {
    LAS int* M = (LAS int*)(F.lds + MISC_OFF);
    __syncthreads();
    if (F.tid == 0) { unsigned* cnt = F.ctl + CW_CNT + (mb * DEPTH + layer) * 64; int acc = 0;
        for (int e = 0; e < NEXP; ++e) { const int c = (int)__hip_atomic_load(cnt + e, __ATOMIC_RELAXED, __HIP_MEMORY_SCOPE_AGENT); M[64 + e] = acc * 256; acc += (c + 255) / 256; M[16 + e] = acc; } }
    __syncthreads();
    return M[16 + NEXP - 1];
}
__device__ __forceinline__ void step_gather(const Frame& F, int layer, int mb) {
    (void)moe_table(F, layer, mb); const LAS int* M = (const LAS int*)(F.lds + MISC_OFF);
    const int nr = rows_of(mb);
    const int* topi = (const int*)(F.ws + WS_TOPI); const float* gate = ws_f(F, WS_GATE); int* pos = (int*)(F.ws + WS_POS); float* gs = ws_f(F, WS_GSORT); int* rtok = (int*)(F.ws + WS_RTOK);
#pragma nounroll
    for (int i = F.bid * NTHREADS + F.tid; i < nr * 4; i += F.G * NTHREADS) { const int p = M[64 + topi[i]] + pos[i]; pos[i] = p; rtok[p] = i >> 2; gs[p] = gate[i]; }
}
__device__ __forceinline__ void step_ln2(const Frame& F, int layer, int mb) {
    const int gw = F.bid * NWAVES + F.wave, NGW = F.G * NWAVES, nr = rows_of(mb), lane = F.lane;
    const float* lg = F.in[I_LN2G] + (size_t)layer * D; const float* lb = F.in[I_LN2B] + (size_t)layer * D;
    const bf16_t* OUTS = ws_bf(F, WS_H) + (size_t)2 * RP * D; const int* pos = (const int*)(F.ws + WS_POS); bf16_t* XB = ws_bf(F, WS_XB);
    constexpr int RB = 2;
    for (int r0 = gw; r0 < nr; r0 += RB * NGW) {
        f32x4 v[RB][4]; u32x2 ow[RB][4][4]; int rr[RB];
#pragma unroll
        for (int i = 0; i < RB; ++i) { rr[i] = r0 + i * NGW < nr ? r0 + i * NGW : r0; const u32x2* xr = (const u32x2*)(XB + (size_t)rr[i] * D); int p[4];
#pragma unroll
            for (int k = 0; k < 4; ++k) p[k] = pos[(size_t)rr[i] * 4 + k];
#pragma unroll
            for (int j = 0; j < 4; ++j) { { const u32x2 w = xr[lane + 64 * j]; v[i][j] = (f32x4){blo(w.x), bhi(w.x), blo(w.y), bhi(w.y)}; }
#pragma unroll
                for (int k = 0; k < 4; ++k) ow[i][k][j] = *((const u32x2*)(OUTS + (size_t)p[k] * D) + lane + 64 * j); } }
        asm volatile("" ::: "memory");
#pragma unroll
        for (int i = 0; i < RB; ++i) { if (r0 + i * NGW >= nr) continue;
            float* xr = x_out_row(F, mb, rr[i]); float s = 0.f;
#pragma unroll
            for (int j = 0; j < 4; ++j) { v[i][j] = v[i][j] * ALPHA;
#pragma unroll
                for (int k = 0; k < 4; ++k) { const u32x2 w = ow[i][k][j]; v[i][j] = v[i][j] + (f32x4){blo(w.x), bhi(w.x), blo(w.y), bhi(w.y)}; }
                s += (v[i][j][0] + v[i][j][1]) + (v[i][j][2] + v[i][j][3]); }
            const float mean = wave_sum(s) * (1.0f / D); float s2 = 0.f;
#pragma unroll
            for (int j = 0; j < 4; ++j) { v[i][j] = v[i][j] - mean; s2 += (v[i][j][0] * v[i][j][0] + v[i][j][1] * v[i][j][1]) + (v[i][j][2] * v[i][j][2] + v[i][j][3] * v[i][j][3]); }
            const float rstd = 1.0f / sqrtf(wave_sum(s2) * (1.0f / D) + LN_EPS);
#pragma unroll
            for (int j = 0; j < 4; ++j) { const f32x4 gg = *((const f32x4*)lg + lane + 64 * j), bb = *((const f32x4*)lb + lane + 64 * j); v[i][j] = v[i][j] * rstd * gg + bb;
                *((f32x4*)xr + lane + 64 * j) = v[i][j]; u32x2 w; w.x = pk2(v[i][j][0], v[i][j][1]); w.y = pk2(v[i][j][2], v[i][j][3]); *((u32x2*)(XB + (size_t)rr[i] * D) + lane + 64 * j) = w; } }
    }
}

constexpr int SP_P = 68;
template <int KS  > __device__ __forceinline__ void small_mma(const bf16_t* A, int lda, const bf16_t* Bt, int K, int tok0, int n0, int k0, int fr, int fq, f32x4 (&acc)[4]) {
    const bf16_t* ap = A + (size_t)(tok0 + fr) * lda + k0 + 8 * fq; const bf16_t* bp = Bt + (size_t)(n0 + fr) * K + k0 + 8 * fq;
#pragma unroll
    for (int k = 0; k < KS; k += 32) { const bf16x8 a = *(const bf16x8*)(ap + k);
#pragma unroll
        for (int jj = 0; jj < 4; ++jj) { const bf16x8 x = *(const bf16x8*)(bp + (size_t)16 * jj * K + k); acc[jj] = __builtin_amdgcn_mfma_f32_16x16x32_bf16(x, a, acc[jj], 0, 0, 0); } }
}
template <int MODE  >
__device__ __forceinline__ void sample_unit(const Frame& F, int layer, int u) {
    const int tid = F.tid, lane = F.lane, w = F.wave, fr = lane & 15, fq = lane >> 4; const int tok0 = NP + 16 * (u >> 4), n0 = 64 * (u & 15);
    LAS float* P = (LAS float*)F.lds;
    const bf16_t* H = ws_bf(F, WS_H); const size_t trow = (size_t)(tok0 + fr);
    f32x4 v[4];
#pragma unroll
    for (int jj = 0; jj < 4; ++jj) v[jj] = (f32x4){0.f, 0.f, 0.f, 0.f};
    if constexpr (MODE == 0) {
#pragma unroll
        for (int b = 0; b < 3; ++b) { f32x4 acc[4] = {(f32x4){0.f, 0.f, 0.f, 0.f}, (f32x4){0.f, 0.f, 0.f, 0.f}, (f32x4){0.f, 0.f, 0.f, 0.f}, (f32x4){0.f, 0.f, 0.f, 0.f}};
            if (b == 0) small_mma<DINNER / 8>(H + C_Z, DINP, wl_ptr(F, layer, WL_SSD), DINNER, tok0, n0, w * (DINNER / 8), fr, fq, acc);
            else small_mma<D / 8>(H + (b == 1 ? C_Q : C_SCB), DINP, wl_ptr(F, layer, b == 1 ? WL_ATT : WL_SC), D, tok0, n0, w * (D / 8), fr, fq, acc);
#pragma unroll
            for (int jj = 0; jj < 4; ++jj) { const u32x2 gw = *(const u32x2*)(H + trow * DINP + (b == 0 ? C_GSSD : (b == 1 ? C_GATT : C_GSC)) + n0 + 16 * jj + 4 * fq);
                v[jj] = v[jj] + acc[jj] * (f32x4){fsigmoid(blo(gw.x)), fsigmoid(bhi(gw.x)), fsigmoid(blo(gw.y)), fsigmoid(bhi(gw.y))}; } }
    } else small_mma<D / 8>(ws_bf(F, WS_XB), D, wl_ptr(F, layer, WL_O), D, tok0, n0, w * (D / 8), fr, fq, v);
    __syncthreads();
#pragma unroll
    for (int jj = 0; jj < 4; ++jj) *(LAS f32x4*)(P + (w * 16 + fr) * SP_P + 16 * jj + 4 * fq) = v[jj];
    __syncthreads();
    { const int tk = tid >> 5, c2 = 2 * (tid & 31); float s0 = 0.f, s1 = 0.f;
#pragma unroll
      for (int ww = 0; ww < 8; ++ww) { s0 += P[(ww * 16 + tk) * SP_P + c2]; s1 += P[(ww * 16 + tk) * SP_P + c2 + 1]; }
      const size_t orow = (size_t)(tok0 + tk);
      if constexpr (MODE == 0) *(unsigned*)(ws_bf(F, WS_XB) + orow * D + n0 + c2) = pk2(s0, s1);
      else { const float* xs = (layer == 0 ? F.in[I_XS] : F.out + O_YS) + (orow - NP) * D + n0 + c2; float* os = F.out + O_YS + (orow - NP) * D + n0 + c2; os[0] = xs[0] * ALPHA + s0; os[1] = xs[1] * ALPHA + s1; } }
}

constexpr int PH_PER = 11, NSTEPS = 1 + NMB * DEPTH * PH_PER;
__global__ void __launch_bounds__(NTHREADS, 2) fwd(Args args) {
#ifdef EMU
    unsigned char* lds = emu_wg->lds;
#else
    extern __shared__ __attribute__((aligned(16))) unsigned char lds[];
#endif
    Frame F0; F0.lds = (LAS unsigned char*)lds; F0.tid = threadIdx.x; F0.lane = F0.tid & 63; F0.wave = __builtin_amdgcn_readfirstlane(F0.tid >> 6); F0.G = gridDim.x; F0.bid = blockIdx.x;
#ifdef EMU
    F0.in = args.in;
#else
    F0.in = (ArgTab)__builtin_amdgcn_kernarg_segment_ptr();
    static_assert(offsetof(Args, out) == 248 && offsetof(Args, ws) == 256 && offsetof(Args, in) == 0, "PF() reads the argument struct by offset");
#endif
    F0.out = args.out; F0.ws = args.ws; F0.ctl = (unsigned*)(args.ws + WS_CTL);
    const Frame& F = F0;
    const int lo = args.lo, hi = args.hi;
#ifndef EMU
    for (int u = F.tid; u < (LDS_BYTES - MISC_OFF) / 4; u += NTHREADS) ((LAS unsigned*)(F.lds + MISC_OFF))[u] = 0u;
    __syncthreads();
    XcdBarrier bar; bar.bar = F.ctl + CW_BAR; bar.x = 0; bar.st = nullptr;
    if (hi - lo > 1) bar = xcd_barrier_post(F.ctl + CW_BAR, (volatile LAS unsigned*)(F.lds + MISC_OFF) + 8);
#define SEAM(s) do { if ((s) + 1 < hi) { XcdBarrier b2_ = bar; unsigned long long bp_ = (unsigned long long)b2_.bar; asm volatile("" : "+s"(bp_)); b2_.bar = (unsigned*)bp_; xcd_barrier(b2_); } } while (0)
#else
#define SEAM(s) do { } while (0)
#endif
#ifndef PH_MASK
#define PH_MASK 0xFFFFFFFF
#endif
#define IN(s) (lo <= (s) && (s) < hi)
#define PHON(b) ((PH_MASK >> (b)) & 1)
#ifdef EMU
#define PF(Fp) Frame Fp = F0
#else
#define PF(Fp) Frame Fp; { unsigned long long kp_ = (unsigned long long)__builtin_amdgcn_kernarg_segment_ptr(); asm volatile("" : "+s"(kp_)); \
    Fp.in = (ArgTab)kp_; Fp.out = *(float* const __attribute__((address_space(4)))*)(kp_ + 248); Fp.ws = *(unsigned char* const __attribute__((address_space(4)))*)(kp_ + 256); Fp.ctl = (unsigned*)Fp.ws; \
    Fp.lds = F0.lds; Fp.G = F0.G; Fp.bid = F0.bid; Fp.wave = F0.wave; Fp.lane = opq(lane_id()); Fp.tid = Fp.wave * 64 + Fp.lane; }
#endif
    int step = 0;
    if (IN(step)) { PROBE_T0(0) if constexpr (PHON(0)) { PF(F); step_weights(F); for (int m = 0; m < NMB; ++m) step_xb(F, m);
        { bf16_t* rwh = ws_bf(F, WS_RWH); bf16_t* rwl = ws_bf(F, WS_RWL); const float* rw = F.in[I_RW];
#pragma nounroll
          for (int i = F.bid * NTHREADS + F.tid; i < DEPTH * NTE * 16 * D; i += F.G * NTHREADS) { const int l = i / (NTE * 16 * D), e = (i / D) % (NTE * 16), k = i % D;
              const float wv = e < NEXP ? rw[((size_t)l * D + k) * NEXP + e] : 0.f; const unsigned hi = f2bf(wv); rwh[i] = (bf16_t)hi; rwl[i] = (bf16_t)f2bf(wv - bf2f(hi)); } } } PROBE_T1(0) SEAM(step); }
    ++step;
#define PHV const int mb = opqs(mb0), layer = opqs(layer0), nr = rows_of(mb); (void)nr; (void)layer
    for (int mb0 = 0; mb0 < NMB; ++mb0)
        for (int layer0 = 0; layer0 < DEPTH; ++layer0) {
            if (IN(step)) { PROBE_T0(2) if constexpr (PHON(2)) { PF(F); PHV; pg8::Gemm g{layer == 0 ? ws_bf(F, WS_XB0) + (size_t)mb * R * D : ws_bf(F, WS_XB), wl_ptr(F, layer, WL_IN), nr, DINP, D, D, nullptr}; pg8::StaticOrder S; S.init(nr, DINP, F.G, F.bid, 2);
                pg8::EpiStoreBf16 E{ws_bf(F, WS_H), DINP}; pg8::gemm_phase(F.lds, g, S, E, F.wave); } PROBE_T1(2) SEAM(step); }
            ++step;
            if (IN(step)) { PROBE_T0(13) if constexpr (PHON(13)) { PF(F); PHV; step_premix(F, layer, mb); } PROBE_T1(13) SEAM(step); }
            ++step;
            if (IN(step)) { PROBE_T0(3) if constexpr (PHON(3)) { PF(F); PHV; step_mixers(F, layer, mb); } PROBE_T1(3) SEAM(step); }
            ++step;
            if (IN(step)) { PROBE_T0(4) if constexpr (PHON(4)) { PF(F); PHV; step_gnorm(F, mb); } PROBE_T1(4) SEAM(step); }
            ++step;
            if (IN(step)) { PROBE_T0(5) if constexpr (PHON(5)) { PF(F); PHV; pg8::StaticOrder S; S.init(NP, D, F.G, F.bid); bf16_t* H = ws_bf(F, WS_H); bf16_t* MGb = ws_bf(F, WS_XB);
#ifndef MERGE_MASK
#define MERGE_MASK 7
#endif
                if constexpr (MERGE_MASK & 1) { pg8::Gemm g{H + C_Z, wl_ptr(F, layer, WL_SSD), NP, D, DINNER, DINP, nullptr}; pg8::EpiGate<0> E{H + C_GSSD, MGb}; pg8::gemm_phase(F.lds, g, S, E, F.wave); }
                if constexpr (MERGE_MASK & 2) { pg8::Gemm g{H + C_Q, wl_ptr(F, layer, WL_ATT), NP, D, D, DINP, nullptr}; pg8::EpiGate<1> E{H + C_GATT, MGb}; pg8::gemm_phase(F.lds, g, S, E, F.wave); }
                if constexpr (MERGE_MASK & 4) { pg8::Gemm g{H + C_SCB, wl_ptr(F, layer, WL_SC), NP, D, D, DINP, nullptr}; pg8::EpiGate<1> E{H + C_GSC, MGb}; pg8::gemm_phase(F.lds, g, S, E, F.wave); }
                if (mb == 0) for (int u = F.bid; u < 256; u += F.G) sample_unit<0>(F, layer, u); }
                PROBE_T1(5) SEAM(step); }
            ++step;
            if (IN(step)) { PROBE_T0(6) if constexpr (PHON(6)) { PF(F); PHV; pg8::Gemm g{ws_bf(F, WS_XB), wl_ptr(F, layer, WL_O), NP, D, D, D, nullptr}; pg8::StaticOrder S; S.init(NP, D, F.G, F.bid);
                pg8::EpiResid E{layer == 0 ? F.in[I_XP] + (size_t)mb * NP * D : F.out + O_YP + (size_t)mb * NP * D, layer == 0 ? F.in[I_XS] : F.out + O_YS, F.out + O_YP + (size_t)mb * NP * D, F.out + O_YS};
                pg8::gemm_phase(F.lds, g, S, E, F.wave);
                if (mb == 0) for (int u = F.bid; u < 256; u += F.G) sample_unit<1>(F, layer, u); } PROBE_T1(6) SEAM(step); }
            ++step;
            if (IN(step)) { PROBE_T0(7) if constexpr (PHON(7)) { PF(F); PHV; step_ln1_router_mfma(F, layer, mb); } PROBE_T1(7) SEAM(step); }
            ++step;
            if (IN(step)) { PROBE_T0(8) if constexpr (PHON(8)) { PF(F); PHV; step_gather(F, layer, mb); } PROBE_T1(8) SEAM(step); }
            ++step;
            if (IN(step)) { PROBE_T0(9) if constexpr (PHON(9)) { PF(F); PHV; const int nt = moe_table(F, layer, mb); pg8::MoeOrder S{(const LAS int*)(F.lds + MISC_OFF) + 16, 8, nt * 8, F.G, F.bid};
                pg8::Gemm g{ws_bf(F, WS_XB), wl_ptr(F, layer, WL_UP), nr  , 2048, D, D, (const int*)(F.ws + WS_RTOK)}; pg8::EpiSwiglu E{ws_bf(F, WS_H) + (size_t)RP * D, F.in[I_BUP] + (size_t)layer * NEXP * 2048};
                pg8::gemm_phase<pg8::EpiSwiglu, pg8::MoeOrder, true>(F.lds, g, S, E, F.wave); } PROBE_T1(9) SEAM(step); }
            ++step;
            if (IN(step)) { PROBE_T0(10) if constexpr (PHON(10)) { PF(F); PHV; const int nt = moe_table(F, layer, mb); pg8::MoeOrder S{(const LAS int*)(F.lds + MISC_OFF) + 16, 4, nt * 4, F.G, F.bid};
                pg8::Gemm g{ws_bf(F, WS_H) + (size_t)RP * D, wl_ptr(F, layer, WL_DN), nt * 256, D, D, D, nullptr}; pg8::EpiDown E{ws_bf(F, WS_H) + (size_t)2 * RP * D, F.in[I_BDN] + (size_t)layer * NEXP * D, ws_f(F, WS_GSORT)};
                pg8::gemm_phase(F.lds, g, S, E, F.wave); } PROBE_T1(10) SEAM(step); }
            ++step;
            if (IN(step)) { PROBE_T0(11) if constexpr (PHON(11)) { PF(F); PHV; step_ln2(F, layer, mb); } PROBE_T1(11) SEAM(step); }
            ++step;
        }
}

#ifdef EMU
extern int emu_grid, emu_step_lo, emu_step_hi;
#endif
extern "C" void kernel_launch(void* const* d_in, const int* in_sizes, int n_in, void* d_out, int out_size, void* d_ws, size_t ws_size, hipStream_t stream) {
    (void)in_sizes; (void)out_size;
    if (n_in != 31 || ws_size < WS_END) { fprintf(stderr, "kernel_launch: expected 31 inputs and >= %zu bytes of workspace (got %d, %zu)\n", (size_t)WS_END, n_in, ws_size); return; }
    Args a; memset(&a, 0, sizeof(a));
    for (int i = 0; i < 31; ++i) a.in[i] = (const float*)d_in[i];
    a.out = (float*)d_out; a.ws = (unsigned char*)d_ws;
#ifdef EMU
    if (emu_step_lo == 0) memset((char*)d_ws + WS_CTL, 0, CTL_BYTES);
    for (int s = emu_step_lo; s < emu_step_hi && s < NSTEPS; ++s) { a.lo = s; a.hi = s + 1; emu_launch(fwd, emu_grid, NTHREADS, LDS_BYTES, a); fprintf(stderr, "step %d done\n", s); }
#else
    (void)hipMemsetAsync((char*)d_ws + WS_CTL, 0, CTL_BYTES, stream);
    static int grid = 0;
    if (grid == 0) {
        int dev = 0, cus = 0;
        if (hipGetDevice(&dev) != hipSuccess || hipDeviceGetAttribute(&cus, hipDeviceAttributeMultiprocessorCount, dev) != hipSuccess) { grid = -1; return; }
        if (hipFuncSetAttribute((const void*)fwd, hipFuncAttributeMaxDynamicSharedMemorySize, LDS_BYTES) != hipSuccess) { grid = -1; return; }
        int per_cu = 0; (void)hipOccupancyMaxActiveBlocksPerMultiprocessor(&per_cu, (const void*)fwd, NTHREADS, LDS_BYTES); (void)hipGetLastError();
        grid = cus / 64 * 64;
        if (grid < 64) { grid = -1; return; }
    }
    if (grid < 0) return;
#if CFG_ONE_LAUNCH
    a.lo = 0; a.hi = NSTEPS; hipLaunchKernelGGL(fwd, dim3(grid), dim3(NTHREADS), LDS_BYTES, stream, a);
#else
    for (int s = 0; s < NSTEPS; ++s) { a.lo = s; a.hi = s + 1; hipLaunchKernelGGL(fwd, dim3(grid), dim3(NTHREADS), LDS_BYTES, stream, a); }
#endif
#endif
}
```

```cpp
#ifdef EMU
#include "emu.h"
#else
#include <hip/hip_runtime.h>
#endif
#include <cstdio>
#include <cstdint>
#include <cstring>
#include <cstddef>
#include <cmath>

#ifndef CFG_BATCH
#define CFG_BATCH 16
#endif
#ifndef CFG_SEQ
#define CFG_SEQ 4096
#endif
#ifndef CFG_NSEQ_MB
#define CFG_NSEQ_MB 8
#endif
#ifndef CFG_NEXP
#define CFG_NEXP 32
#endif
#ifndef CFG_ONE_LAUNCH
#define CFG_ONE_LAUNCH 1
#endif

constexpr int BATCH = CFG_BATCH, SEQ = CFG_SEQ, NSEQ_MB = CFG_NSEQ_MB, NEXP = CFG_NEXP, NMB = BATCH / NSEQ_MB;
constexpr int D = 1024, DEPTH = 2, DECB = 16, DECS = 16, NS = DECB * DECS;
constexpr int DINNER = 2048, CONVDIM = 4096;
constexpr int NKV = 4, WINDOW = 128, CHUNK = 64;
constexpr int DIN = 13856, DINP = 14080;
constexpr int NP = NSEQ_MB * SEQ, R = NP + NS;
constexpr int NTE = (NEXP + 15) / 16;
constexpr int RP = ((4 * R + NEXP * 255) + 255) / 256 * 256;
constexpr int NCHUNK = SEQ / CHUNK;
constexpr int C_Z = 0, C_X = 2048, C_B = 4096, C_C = 5120, C_Q = 6144, C_K = 7168, C_V = 7424, C_SCB = 7680, C_SCC = 8704, C_SCH = 9728, C_GSSD = 10752, C_GATT = 11776, C_GSC = 12800, C_DT = 13824;
constexpr float LN_EPS = 1e-5f, ALPHA = 1.41421356237309515f  , SW_LIMIT = 7.0f, SW_ALPHA = 1.702f;
static_assert(BATCH % NSEQ_MB == 0 && SEQ % 256 == 0 && (NEXP & (NEXP - 1)) == 0 && NEXP <= 32 && NEXP >= 4, "config");

constexpr size_t O_YP = 0, O_YS = O_YP + (size_t)BATCH * SEQ * D, O_KP = O_YS + (size_t)NS * D, O_VP = O_KP + (size_t)DEPTH * BATCH * WINDOW * 256,
    O_SSP = O_VP + (size_t)DEPTH * BATCH * WINDOW * 256, O_CVP = O_SSP + (size_t)DEPTH * BATCH * 32 * 64 * 128, O_SCP = O_CVP + (size_t)DEPTH * BATCH * 3 * CONVDIM,
    O_KS = O_SCP + (size_t)DEPTH * BATCH * 2 * D, O_VS = O_KS + (size_t)DEPTH * DECB * DECS * 256, O_SSS = O_VS + (size_t)DEPTH * DECB * DECS * 256,
    O_CVS = O_SSS + (size_t)DEPTH * DECB * 32 * 64 * 128, O_SCS = O_CVS + (size_t)DEPTH * DECB * 3 * CONVDIM, O_END = O_SCS + (size_t)DEPTH * DECB * 2 * D;

constexpr size_t al256(size_t x) { return (x + 255) / 256 * 256; }
constexpr size_t WS_CTL = 0, CTL_BYTES = 1u << 20;
constexpr size_t WS_SSQ = CTL_BYTES, WS_TOPI = WS_SSQ + al256((size_t)R * 64 * 4), WS_GATE = WS_TOPI + al256((size_t)R * 16), WS_POS = WS_GATE + al256((size_t)R * 16),
    WS_GSORT = WS_POS + al256((size_t)R * 16), WS_RTOK = WS_GSORT + al256((size_t)RP * 4),
    WS_RWH = WS_RTOK + al256((size_t)RP * 4)  , WS_RWL = WS_RWH + (size_t)DEPTH * NTE * 16 * D * 2  , WS_W = WS_RWL + (size_t)DEPTH * NTE * 16 * D * 2;
constexpr size_t WL_IN = 0, WL_SSD = WL_IN + (size_t)DINP * D * 2, WL_ATT = WL_SSD + (size_t)D * DINNER * 2, WL_SC = WL_ATT + (size_t)D * D * 2, WL_O = WL_SC + (size_t)D * D * 2,
    WL_UP = WL_O + (size_t)D * D * 2, WL_DN = WL_UP + (size_t)NEXP * 2048 * D * 2, WL_BYTES = WL_DN + (size_t)NEXP * D * D * 2;
constexpr size_t WS_XB = WS_W + DEPTH * WL_BYTES, WS_XB0 = WS_XB + (size_t)R * D * 2  , WS_PRE = WS_XB0 + (size_t)NMB * R * D * 2  , WS_H = WS_PRE + (size_t)R * D * 2;
constexpr size_t H_BYTES = (size_t)R * DINP * 2, MOE_BYTES = (size_t)3 * RP * D * 2, U_BYTES = H_BYTES > MOE_BYTES ? H_BYTES : MOE_BYTES;
constexpr size_t WS_CMC = WS_H + U_BYTES, WS_BTG = WS_CMC + (size_t)NP * 1024 * 2, WS_CBG = WS_BTG + (size_t)NSEQ_MB * NCHUNK * 8 * 8192 * 2, WS_END = WS_CBG + (size_t)NSEQ_MB * NCHUNK * 8 * 4096 * 2;
static_assert(WS_END <= ((size_t)2 << 30), "workspace map exceeds 2 GiB");
constexpr int CW_BAR = 4096, CW_CNT = 16384;

constexpr int RING_BYTES = 131072, LDS_BYTES = 163840  , MISC_OFF = LDS_BYTES - 1024, SCR_BYTES = MISC_OFF;
constexpr int NWAVES = 8, NTHREADS = 512;

#ifdef EMU
#define LAS
#define WAVE_SYNC() emu_wave_barrier()
#else
#define LAS __attribute__((address_space(3)))
#define WAVE_SYNC() asm volatile("s_waitcnt lgkmcnt(0)" ::: "memory")
#endif
#ifdef EMU
#define LBAR() emu_wg_barrier()
#define VM_WAIT(n) do { } while (0)
#else
#define LBAR() do { asm volatile("s_waitcnt lgkmcnt(0)" ::: "memory"); __builtin_amdgcn_s_barrier(); asm volatile("" ::: "memory"); } while (0)
#define VM_WAIT(n) asm volatile("s_waitcnt vmcnt(" #n ")" ::: "memory")
#endif
typedef unsigned short bf16_t;
typedef short bf16x8 __attribute__((ext_vector_type(8)));
typedef float f32x4 __attribute__((ext_vector_type(4)));
typedef float f32x16 __attribute__((ext_vector_type(16)));
typedef unsigned u32x4 __attribute__((ext_vector_type(4)));
typedef unsigned u32x2 __attribute__((ext_vector_type(2)));

__device__ __forceinline__ unsigned f2bf(float f) { unsigned u = __builtin_bit_cast(unsigned, f); return (u + 0x7fffu + ((u >> 16) & 1u)) >> 16; }
__device__ __forceinline__ float bf2f(unsigned h) { return __builtin_bit_cast(float, (h & 0xffffu) << 16); }
#ifdef EMU
__device__ __forceinline__ unsigned pk2(float lo, float hi) { return f2bf(lo) | (f2bf(hi) << 16); }
#else
typedef float f32x2_t __attribute__((ext_vector_type(2))); typedef __bf16 bf16x2_t __attribute__((ext_vector_type(2)));
__device__ __forceinline__ unsigned pk2(float lo, float hi) { f32x2_t v = {lo, hi}; bf16x2_t b = __builtin_convertvector(v, bf16x2_t); return __builtin_bit_cast(unsigned, b); }
#endif
#ifdef EMU
__device__ __forceinline__ unsigned short bf1(float f) { return (unsigned short)f2bf(f); }
#else
__device__ __forceinline__ unsigned short bf1(float f) { return (unsigned short)pk2(f, f); }
#endif
__device__ __forceinline__ float blo(unsigned w) { return __builtin_bit_cast(float, w << 16); }
__device__ __forceinline__ float bhi(unsigned w) { return __builtin_bit_cast(float, w & 0xffff0000u); }
__device__ __forceinline__ void unpack8(const u32x4 w, float* f) { f[0] = blo(w.x); f[1] = bhi(w.x); f[2] = blo(w.y); f[3] = bhi(w.y); f[4] = blo(w.z); f[5] = bhi(w.z); f[6] = blo(w.w); f[7] = bhi(w.w); }
__device__ __forceinline__ u32x4 pack8(const float* f) { u32x4 w; w.x = pk2(f[0], f[1]); w.y = pk2(f[2], f[3]); w.z = pk2(f[4], f[5]); w.w = pk2(f[6], f[7]); return w; }
__device__ __forceinline__ float fexp(float x) { return __builtin_amdgcn_exp2f(x * 1.4426950408889634f); }
__device__ __forceinline__ float fsigmoid(float x) { return __builtin_amdgcn_rcpf(1.0f + __builtin_amdgcn_exp2f(-1.4426950408889634f * x)); }
__device__ __forceinline__ float fsilu(float x) { return x * fsigmoid(x); }
#ifdef EMU
__device__ __forceinline__ int opq(int x) { return x; }
#else
__device__ __forceinline__ int opq(int x) { asm volatile("" : "+v"(x)); return x; }
#endif
#ifdef EMU
__device__ __forceinline__ int opqs(int x) { return x; }
#else
__device__ __forceinline__ int opqs(int x) { asm volatile("" : "+s"(x)); return x; }
#endif
#ifdef EMU
__device__ __forceinline__ int lane_id() { return (int)(threadIdx.x & 63); }
#else
__device__ __forceinline__ int lane_id() { return (int)__builtin_amdgcn_mbcnt_hi(~0u, __builtin_amdgcn_mbcnt_lo(~0u, 0u)); }
#endif
#ifdef EMU
template <int MASK> __device__ __forceinline__ unsigned xshfl_u(unsigned x) { return __shfl_xor(x, MASK); }
#else
template <int MASK> __device__ __forceinline__ unsigned xshfl_u(unsigned x) {
    if constexpr (MASK == 1) return (unsigned)__builtin_amdgcn_update_dpp((int)x, (int)x, 0xB1, 0xF, 0xF, false);
    else if constexpr (MASK == 2) return (unsigned)__builtin_amdgcn_update_dpp((int)x, (int)x, 0x4E, 0xF, 0xF, false);
    else if constexpr (MASK == 4) { const int t = __builtin_amdgcn_update_dpp((int)x, (int)x, 0x114, 0xF, 0xA, false);
        return (unsigned)__builtin_amdgcn_update_dpp(t, (int)x, 0x104, 0xF, 0x5, false); }
    else if constexpr (MASK == 8) return (unsigned)__builtin_amdgcn_update_dpp((int)x, (int)x, 0x128, 0xF, 0xF, false);
    else if constexpr (MASK == 16) { const auto rr = __builtin_amdgcn_permlane16_swap(x, x, false, false); return (lane_id() & 16) ? rr[0] : rr[1]; }
    else { const auto rr = __builtin_amdgcn_permlane32_swap(x, x, false, false); return (lane_id() & 32) ? rr[0] : rr[1]; }
}
#endif
template <int MASK> __device__ __forceinline__ float xshfl(float x) { return __builtin_bit_cast(float, xshfl_u<MASK>(__builtin_bit_cast(unsigned, x))); }
template <int MASK> __device__ __forceinline__ int xshfl(int x) { return (int)xshfl_u<MASK>((unsigned)x); }
__device__ __forceinline__ float wave_sum(float v) { v += xshfl<1>(v); v += xshfl<2>(v); v += xshfl<4>(v); v += xshfl<8>(v); v += xshfl<16>(v); v += xshfl<32>(v); return v; }

#ifndef PROBE_MASK
#define PROBE_MASK 0
#endif
#if PROBE_MASK && !defined(EMU)
#define PROBE_T0(b) unsigned long long pt0_ = 0; if constexpr ((PROBE_MASK >> (b)) & 1) pt0_ = __builtin_amdgcn_s_memrealtime();
#define PROBE_T1(b) if constexpr ((PROBE_MASK >> (b)) & 1) { asm volatile("s_waitcnt vmcnt(0) lgkmcnt(0)" ::: "memory"); const unsigned long long pt1_ = __builtin_amdgcn_s_memrealtime(); \
    while (__builtin_amdgcn_s_memrealtime() < pt1_ + (pt1_ - pt0_)) __builtin_amdgcn_s_sleep(8); }
#else
#define PROBE_T0(b)
#define PROBE_T1(b)
#endif
namespace pg8 {
constexpr int BM = 256, BK = 64, HALF = 128, HTB = HALF * BK * 2, NXCD = 8, WGM = 8;
struct Unit { int pm, pn, bt, e; };
struct Gemm { const bf16_t* A; const bf16_t* Bt; int M, N, K, lda; const int* tok; const float* ssq = nullptr; };
struct StaticOrder {
    int nM, nN, nwg, G, c, wgm;
    __host__ __device__ void init(int M, int N, int G_, int c_, int wgm_ = WGM) { nM = M / BM; nN = N / BM; nwg = nM * nN; G = G_; c = c_; wgm = wgm_; }
    __host__ __device__ bool next(int i, Unit& u) const {
        const long L = (long)i * G + c; if (L >= nwg) return false;
        int wgid = (int)L; { const int q = nwg / NXCD, r = nwg % NXCD, xcd = wgid % NXCD, off = wgid / NXCD; wgid = (xcd < r ? xcd * (q + 1) : r * (q + 1) + (xcd - r) * q) + off; }
        const int nig = wgm * nN, gid = wgid / nig, fm = gid * wgm, gsz = (nM - fm) < wgm ? (nM - fm) : wgm;
        u.pm = fm + ((wgid % nig) % gsz); u.pn = (wgid % nig) / gsz; u.bt = u.pn; u.e = 0; return true;
    }
    __device__ __forceinline__ void a_ready(const Unit&) const {}
    __device__ __forceinline__ void done(const Unit&) const {}
};
struct MoeOrder {
    const LAS int* tend; int npn, ntot, G, c;
    __device__ __forceinline__ bool next(int i, Unit& u) const {
        int rt, pn;
        {
            const int xcd = c & 7, j = c >> 3, rpx = (G >> 3) / npn; rt = (i * 8 + xcd) * rpx + j / npn; pn = j % npn; if (rt >= ntot / npn) return false; }
        int e = 0;
#pragma unroll
        for (int j = 0; j < NEXP; ++j) e += (tend[j] <= rt) ? 1 : 0;
        u.pm = rt; u.pn = pn; u.e = e; u.bt = e * npn + pn; return true;
    }
    __device__ __forceinline__ void a_ready(const Unit&) const {}
    __device__ __forceinline__ void done(const Unit&) const {}
};
#ifdef EMU
template <class Epi, class Sched, bool GATHER = false, bool GSCALE = false>
__device__ void gemm_phase(LAS unsigned char* lds, const Gemm g, const Sched& S, const Epi& E, int  ) {
    const int tid = threadIdx.x, wid = tid >> 6, lane = tid & 63, wr = wid >> 2, wc = wid & 3, fr = lane & 15, fq = lane >> 4;
    Unit u;
    for (int i = 0; S.next(i, u); ++i) {
        f32x4 acc[2][2][4][2];
        for (int ai = 0; ai < 2; ++ai) for (int bj = 0; bj < 2; ++bj) for (int m = 0; m < 4; ++m) for (int n = 0; n < 2; ++n) for (int q = 0; q < 4; ++q) {
            const int row = u.pm * 256 + ai * 128 + wr * 64 + m * 16 + fr, col = u.bt * 256 + bj * 128 + wc * 32 + 8 * fq + 4 * n + q;
            const bf16_t* a = g.A + (size_t)(GATHER ? ((unsigned)g.tok[row] < (unsigned)g.M ? g.tok[row] : 0) : row) * g.lda; const bf16_t* b = g.Bt + (size_t)col * g.K; float s = 0.f;
            if constexpr (GSCALE) {
                float rs[9]; for (int j = 0; j < 8; ++j) { float q2 = 0.f; for (int i = 0; i < 8; ++i) q2 += g.ssq[(size_t)row * 64 + 8 * j + i]; rs[j] = 1.0f / sqrtf(q2 * (1.0f / 256.0f) + LN_EPS); } rs[8] = 1.f;
                for (int j = 0; j < 8; ++j) { for (int k = 256 * j; k < 256 * j + 256; ++k) s += bf2f(a[k]) * bf2f(b[k]); s *= rs[j] * (1.0f / rs[j + 1]); } }
            else for (int k = 0; k < g.K; ++k) s += bf2f(a[k]) * bf2f(b[k]);
            acc[ai][bj][m][n][q] = s; }
        E(acc, u, wr, wc, fr, fq);
    }
    __syncthreads();
}
#else
#define PG8_LAS __attribute__((address_space(3)))
__host__ __device__ __forceinline__ int lds_byte(int r, int c) { const int st = (r >> 4) * 2 + (c >> 5), rr = r & 15, cc = c & 31, ob = rr * 64 + cc * 2; return st * 1024 + (ob ^ (((ob >> 9) & 1) << 5)); }
__host__ __device__ __forceinline__ void stage_rc(int b, int& R_, int& C_) { const int st = b / 1024, sb = b % 1024, swz = sb ^ (((sb >> 9) & 1) << 5); R_ = (st >> 1) * 16 + swz / 64; C_ = (st & 1) * 32 + (swz % 64) / 2; }
__host__ __device__ __forceinline__ int perm32(int rho) { const int n = rho >> 4, i = rho & 15; return 8 * (i >> 2) + 4 * n + (i & 3); }
template <class Epi, class Sched, bool GATHER = false, bool GSCALE = false>
__device__ __forceinline__ void gemm_phase(PG8_LAS unsigned char* lds, const Gemm g, const Sched& S, const Epi& E, int wave_id) {
    const int lane = opq(lane_id()), wid = opqs(wave_id), tid = wid * 64 + lane, wr = wid >> 2, wc = wid & 3, fr = lane & 15, fq = lane >> 4;
    const int K = g.K, nt = K / BK, lda = g.lda;
    unsigned voffA[2], voffB[2];
#pragma unroll
    for (int i = 0; i < 2; ++i) { int R_, C_; stage_rc(tid * 16 + i * 8192, R_, C_); const int Rb = (R_ & ~31) + perm32(R_ & 31);
        voffA[i] = (unsigned)(R_ * lda + C_) * 2u; voffB[i] = (unsigned)(Rb * K + C_) * 2u; }
    unsigned vG[2][2], vN[2][2];
#define PG8_TOK(dst, pm_) do { _Pragma("unroll") for (int i_ = 0; i_ < 2; ++i_) { int R_, C_; stage_rc(opq(tid) * 16 + i_ * 8192, R_, C_); _Pragma("unroll") for (int h_ = 0; h_ < 2; ++h_) \
        { unsigned tk_ = (unsigned)g.tok[(pm_) * 256 + h_ * 128 + R_]; tk_ = tk_ < (unsigned)g.M ? tk_ : 0u; dst[h_][i_] = tk_ * (unsigned)(lda * 2) + (unsigned)(C_ * 2); } } } while (0)
#define PG8_STAGE_A(bufoff, base_, h_, nx_) do { if constexpr (GATHER) { unsigned vs_[2] = {(nx_) ? vN[h_][0] : vG[h_][0], (nx_) ? vN[h_][1] : vG[h_][1]}; PG8_STAGE(bufoff, base_, vs_); } \
        else { PG8_STAGE(bufoff, (base_) + ((h_) ? hstepA : 0), voffA); } } while (0)
    const size_t kstep = (size_t)(BK * 2);
    const size_t hstepA = (size_t)HALF * lda * 2, tstepA = 2 * hstepA;
    const size_t hstepB = (size_t)HALF * K * 2, tstepB = 2 * hstepB;
    const unsigned ldsw = (unsigned)wid * 1024u;
    const int aoff = lds_byte(wr * 64 + fr, fq * 8), boff = lds_byte(wc * 32 + fr, fq * 8);
#define PG8_SA(b, h) (((b) * 2 + (h)) * HTB)
#define PG8_SB(b, h) ((4 + (b) * 2 + (h)) * HTB)
#define PG8_STAGE(bufoff, gbase, voff) do { _Pragma("unroll") for (int _i = 0; _i < 2; ++_i) \
        __builtin_amdgcn_global_load_lds((const unsigned*)((const char*)(gbase) + (voff)[_i]), (PG8_LAS unsigned*)(lds + (bufoff) + ldsw + _i * 8192), 16, 0, 0); } while (0)
#define PG8_LDA(dst, b, h) do { _Pragma("unroll") for (int m = 0; m < 4; ++m) _Pragma("unroll") for (int k = 0; k < 2; ++k) dst[m][k] = *(const PG8_LAS bf16x8*)(lds + PG8_SA(b, h) + aoff + m * 2048 + k * 1024); } while (0)
#define PG8_LDB(dst, b, h) do { _Pragma("unroll") for (int n = 0; n < 2; ++n) _Pragma("unroll") for (int k = 0; k < 2; ++k) dst[n][k] = *(const PG8_LAS bf16x8*)(lds + PG8_SB(b, h) + boff + n * 2048 + k * 1024); } while (0)
#define PG8_MMA(ai, bj, At, Bt) do { __builtin_amdgcn_s_setprio(1); _Pragma("unroll") for (int m = 0; m < 4; ++m) _Pragma("unroll") for (int n = 0; n < 2; ++n) _Pragma("unroll") for (int k = 0; k < 2; ++k) \
        acc[ai][bj][m][n] = __builtin_amdgcn_mfma_f32_16x16x32_bf16(Bt[n][k], At[m][k], acc[ai][bj][m][n], 0, 0, 0); __builtin_amdgcn_s_setprio(0); } while (0)
#define PG8_WAIT_V(n) asm volatile("s_waitcnt vmcnt(" #n ")" ::: "memory")
#define PG8_WAIT_L(n) asm volatile("s_waitcnt lgkmcnt(" #n ")" ::: "memory")
#define PG8_BAR __builtin_amdgcn_s_barrier()
#define PG8_SCHED __builtin_amdgcn_sched_barrier(0)
    Unit cur, nxt; int ui = 0;
    if (!S.next(0, cur)) return;
    if constexpr (GSCALE) {
        static_assert(RING_BYTES + 3 * 8192 <= MISC_OFF, "group-norm factor tables");
        Unit tu;
        if (S.next(3, tu)) __builtin_trap();
#pragma unroll 1
        for (int q = 0; q < 3 && S.next(q, tu); ++q) { const int row = tid & 255, h = tid >> 8;
            const float* sp = g.ssq + (size_t)(tu.pm * 256 + row) * 64 + 32 * h; float qv[5];
#pragma unroll
            for (int gi = 0; gi < 5; ++gi) { f32x4 a_ = (f32x4){0.f, 0.f, 0.f, 0.f}, b_ = a_; if (gi < 4 || h == 0) { a_ = *(const f32x4*)(sp + 8 * gi); b_ = *(const f32x4*)(sp + 8 * gi + 4); }
                a_ = a_ + b_; qv[gi] = sqrtf(((a_[0] + a_[1]) + (a_[2] + a_[3])) * (1.0f / 256.0f) + LN_EPS); }
            PG8_LAS float* ct = (PG8_LAS float*)(lds + RING_BYTES) + q * 2048 + 4 * h * 256 + row;
#pragma unroll
            for (int j = 0; j < 4; ++j) ct[j * 256] = (h == 1 && j == 3) ? 1.0f / qv[3] : qv[j + 1] / qv[j]; }
        __syncthreads();
    }
    f32x4 acc[2][2][4][2];
#pragma unroll
    for (int a = 0; a < 2; ++a)
#pragma unroll
        for (int b = 0; b < 2; ++b)
#pragma unroll
            for (int m = 0; m < 4; ++m)
#pragma unroll
                for (int n = 0; n < 2; ++n) acc[a][b][m][n] = (f32x4){0.f, 0.f, 0.f, 0.f};
    bf16x8 At[4][2], B0[2][2], B1[2][2];
    const char* cA = (const char*)g.A + (GATHER ? (size_t)0 : (size_t)cur.pm * tstepA); const char* cB = (const char*)g.Bt + (size_t)cur.bt * tstepB;
    if constexpr (GATHER) { PG8_TOK(vG, cur.pm); }
    S.a_ready(cur);
    PG8_STAGE(PG8_SB(0, 0), cB, voffB); PG8_STAGE(PG8_SB(0, 1), cB + hstepB, voffB); PG8_STAGE_A(PG8_SA(0, 0), cA, 0, false); PG8_STAGE_A(PG8_SA(0, 1), cA, 1, false);
    if (wr == 1) PG8_BAR;
    PG8_WAIT_V(2); PG8_BAR;
    PG8_STAGE(PG8_SB(1, 0), cB + kstep, voffB); PG8_STAGE_A(PG8_SA(1, 0), cA + kstep, 0, false); PG8_STAGE(PG8_SB(1, 1), cB + hstepB + kstep, voffB);
    PG8_WAIT_V(6); PG8_BAR;
    for (;;) {
        const bool has_next = S.next(ui + 1, nxt);
        const char* nA = has_next ? (const char*)g.A + (GATHER ? (size_t)0 : (size_t)nxt.pm * tstepA) : cA; const char* nB = has_next ? (const char*)g.Bt + (size_t)nxt.bt * tstepB : cB;
        if constexpr (GATHER) {
#pragma unroll
            for (int h_ = 0; h_ < 2; ++h_) { vN[h_][0] = vG[h_][0]; vN[h_][1] = vG[h_][1]; }
            if (has_next) {
#pragma unroll
                for (int i_ = 0; i_ < 2; ++i_) { int R_, C_; stage_rc(opq(tid) * 16 + i_ * 8192, R_, C_);
#pragma unroll
                    for (int h_ = 0; h_ < 2; ++h_) { const int* tp_ = g.tok + nxt.pm * 256 + h_ * 128 + R_;
                        asm volatile("global_load_dword %0, %1, off" : "=v"(vN[h_][i_]) : "v"(tp_) : "memory"); } } } }
        for (int t = 0; t < nt; t += 2) {
            const bool last = (t == nt - 2);
            const char* a1 = cA + (size_t)(t + 1) * kstep;
            const char* a2 = last ? nA : cA + (size_t)(t + 2) * kstep; const char* b2 = last ? nB : cB + (size_t)(t + 2) * kstep;
            const char* a3 = a2 + kstep; const char* b3 = b2 + kstep;
            if (last && has_next) S.a_ready(nxt);
            if constexpr (GATHER) { if (last && has_next) {
#pragma unroll
                for (int i_ = 0; i_ < 2; ++i_) { int R_, C_; stage_rc(opq(tid) * 16 + i_ * 8192, R_, C_);
#pragma unroll
                    for (int h_ = 0; h_ < 2; ++h_) { unsigned tk_ = vN[h_][i_]; asm volatile("" : "+v"(tk_)); tk_ = tk_ < (unsigned)g.M ? tk_ : 0u; vN[h_][i_] = tk_ * (unsigned)(lda * 2) + (unsigned)(C_ * 2); } } } }
            PG8_LDB(B0, 0, 0); PG8_LDB(B1, 0, 1); PG8_SCHED; PG8_LDA(At, 0, 0); PG8_STAGE_A(PG8_SA(1, 1), a1, 1, false);
            PG8_WAIT_V(8); PG8_WAIT_L(0); PG8_BAR; PG8_MMA(0, 0, At, B0); PG8_MMA(0, 1, At, B1); PG8_BAR; PG8_SCHED;
            PG8_LDA(At, 0, 1); PG8_STAGE(PG8_SB(0, 0), b2, voffB); PG8_STAGE(PG8_SB(0, 1), b2 + hstepB, voffB); PG8_STAGE_A(PG8_SA(0, 0), a2, 0, last);
            PG8_WAIT_V(8); PG8_WAIT_L(0); PG8_BAR; PG8_MMA(1, 0, At, B0); PG8_MMA(1, 1, At, B1); PG8_BAR; PG8_SCHED;
            PG8_LDB(B0, 1, 0); PG8_LDB(B1, 1, 1); PG8_SCHED; PG8_LDA(At, 1, 0); PG8_STAGE_A(PG8_SA(0, 1), a2, 1, last);
            PG8_WAIT_V(8); PG8_WAIT_L(0); PG8_BAR; PG8_MMA(0, 0, At, B0); PG8_MMA(0, 1, At, B1); PG8_BAR; PG8_SCHED;
            PG8_LDA(At, 1, 1); PG8_STAGE(PG8_SB(1, 0), b3, voffB); PG8_STAGE(PG8_SB(1, 1), b3 + hstepB, voffB); PG8_STAGE_A(PG8_SA(1, 0), a3, 0, last);
            PG8_WAIT_V(8); PG8_WAIT_L(0); PG8_BAR; PG8_MMA(1, 0, At, B0); PG8_MMA(1, 1, At, B1); PG8_BAR; PG8_SCHED;
            if constexpr (GSCALE) { if (t & 2) {
                const PG8_LAS float* cp = (const PG8_LAS float*)(lds + RING_BYTES) + ui * 2048 + (t >> 2) * 256 + wr * 64 + fr; float cv[2][4];
#pragma unroll
                for (int a = 0; a < 2; ++a)
#pragma unroll
                    for (int m = 0; m < 4; ++m) cv[a][m] = cp[a * 128 + m * 16];
#pragma unroll
                for (int a = 0; a < 2; ++a)
#pragma unroll
                    for (int b = 0; b < 2; ++b)
#pragma unroll
                        for (int m = 0; m < 4; ++m)
#pragma unroll
                            for (int n = 0; n < 2; ++n) acc[a][b][m][n] = acc[a][b][m][n] * cv[a][m];
                PG8_SCHED; } }
        }
        if (wr == 0) PG8_BAR;
        E(acc, cur, wr, wc, fr, fq); S.done(cur);
        if (!has_next) break;
#pragma unroll
        for (int a = 0; a < 2; ++a)
#pragma unroll
            for (int b = 0; b < 2; ++b)
#pragma unroll
                for (int m = 0; m < 4; ++m)
#pragma unroll
                    for (int n = 0; n < 2; ++n) acc[a][b][m][n] = (f32x4){0.f, 0.f, 0.f, 0.f};
        cur = nxt; cA = nA; cB = nB; ++ui;
        if constexpr (GATHER) {
#pragma unroll
            for (int h_ = 0; h_ < 2; ++h_) { vG[h_][0] = vN[h_][0]; vG[h_][1] = vN[h_][1]; } }
        if (wr == 1) PG8_BAR;
    }
    PG8_WAIT_V(0);
    PG8_BAR;
#undef PG8_SA
#undef PG8_SB
#undef PG8_STAGE
#undef PG8_STAGE_A
#undef PG8_TOK
#undef PG8_LDA
#undef PG8_LDB
#undef PG8_MMA
#undef PG8_WAIT_V
#undef PG8_WAIT_L
#undef PG8_BAR
#undef PG8_SCHED
}
#endif

struct EpiStoreBf16 {
    bf16_t* O; int ldc;
    __device__ __forceinline__ void operator()(const f32x4 (&acc)[2][2][4][2], const Unit& u, int wr, int wc, int fr, int fq) const {
        const int row0 = u.pm * 256 + wr * 64 + fr, col0 = u.pn * 256 + wc * 32 + 8 * fq;
#pragma unroll
        for (int ai = 0; ai < 2; ++ai)
#pragma unroll
            for (int m = 0; m < 4; ++m)
#pragma unroll
                for (int bj = 0; bj < 2; ++bj) { const f32x4 v0 = acc[ai][bj][m][0], v1 = acc[ai][bj][m][1];
                    u32x4 w; w.x = pk2(v0[0], v0[1]); w.y = pk2(v0[2], v0[3]); w.z = pk2(v1[0], v1[1]); w.w = pk2(v1[2], v1[3]);
                    *(u32x4*)(O + (size_t)(row0 + ai * 128 + m * 16) * ldc + col0 + bj * 128) = w; }
    }
};
template <int MODE> struct EpiGate {
    const bf16_t* Hg; bf16_t* MGb;
    __device__ __forceinline__ void operator()(const f32x4 (&acc)[2][2][4][2], const Unit& u, int wr, int wc, int fr, int fq) const {
        const int row0 = u.pm * 256 + wr * 64 + fr, col0 = u.pn * 256 + wc * 32 + 8 * fq;
#pragma unroll
        for (int ai = 0; ai < 2; ++ai) {
            u32x4 gw[4][2], pw[4][2];
#pragma unroll
            for (int m = 0; m < 4; ++m)
#pragma unroll
                for (int bj = 0; bj < 2; ++bj) { const int row = row0 + ai * 128 + m * 16, col = col0 + bj * 128;
                    gw[m][bj] = *(const u32x4*)(Hg + (size_t)row * DINP + col); if (MODE != 0) pw[m][bj] = *(const u32x4*)(MGb + (size_t)row * D + col); }
            asm volatile("" ::: "memory");
#pragma unroll
            for (int m = 0; m < 4; ++m)
#pragma unroll
                for (int bj = 0; bj < 2; ++bj) { const int row = row0 + ai * 128 + m * 16, col = col0 + bj * 128; const f32x4 v0 = acc[ai][bj][m][0], v1 = acc[ai][bj][m][1];
                    float g[8], p[8], v[8] = {v0[0], v0[1], v0[2], v0[3], v1[0], v1[1], v1[2], v1[3]}; unpack8(gw[m][bj], g);
                    if (MODE != 0) { unpack8(pw[m][bj], p);
#pragma unroll
                        for (int i = 0; i < 8; ++i) v[i] = p[i] + v[i] * fsigmoid(g[i]); }
                    else {
#pragma unroll
                        for (int i = 0; i < 8; ++i) v[i] = v[i] * fsigmoid(g[i]); }
                    *(u32x4*)(MGb + (size_t)row * D + col) = pack8(v); }
            asm volatile("" ::: "memory");
        }
    }
};
struct EpiResid {
    const float* xp; const float* xs; float* op; float* os;
    __device__ __forceinline__ void operator()(const f32x4 (&acc)[2][2][4][2], const Unit& u, int wr, int wc, int fr, int fq) const {
        const int row0 = u.pm * 256 + wr * 64 + fr, col0 = u.pn * 256 + wc * 32 + 8 * fq;
        const bool smp = u.pm * 256 >= NP;
        const float* xb = smp ? xs - (size_t)NP * D : xp; float* ob = smp ? os - (size_t)NP * D : op;
#pragma unroll
        for (int ai = 0; ai < 2; ++ai) {
            f32x4 xa[4][2][2];
#pragma unroll
            for (int m = 0; m < 4; ++m)
#pragma unroll
                for (int bj = 0; bj < 2; ++bj) { const float* xi = xb + (size_t)(row0 + ai * 128 + m * 16) * D + col0 + bj * 128; xa[m][bj][0] = *(const f32x4*)xi; xa[m][bj][1] = *(const f32x4*)(xi + 4); }
            asm volatile("" ::: "memory");
#pragma unroll
            for (int m = 0; m < 4; ++m)
#pragma unroll
                for (int bj = 0; bj < 2; ++bj) { float* xo = ob + (size_t)(row0 + ai * 128 + m * 16) * D + col0 + bj * 128;
                    *(f32x4*)xo = xa[m][bj][0] * ALPHA + acc[ai][bj][m][0]; *(f32x4*)(xo + 4) = xa[m][bj][1] * ALPHA + acc[ai][bj][m][1]; }
            asm volatile("" ::: "memory");
        }
    }
};
struct EpiSwiglu {
    bf16_t* ACT; const float* bup;
    __device__ __forceinline__ void operator()(const f32x4 (&acc)[2][2][4][2], const Unit& u, int wr, int wc, int fr, int fq) const {
        const int row0_ = u.pm * 256 + wr * 64 + fr, j0 = u.pn * 128 + wc * 32 + 8 * fq;
        const float* bg = bup + (size_t)u.e * 2048 + j0; const f32x4 bg0 = *(const f32x4*)bg, bg1 = *(const f32x4*)(bg + 4), bu0 = *(const f32x4*)(bg + 1024), bu1 = *(const f32x4*)(bg + 1028);
#pragma unroll
        for (int ai = 0; ai < 2; ++ai)
#pragma unroll
            for (int m = 0; m < 4; ++m) { const int row = row0_ + ai * 128 + m * 16;
                const f32x4 g0 = acc[ai][0][m][0] + bg0, g1 = acc[ai][0][m][1] + bg1, u0 = acc[ai][1][m][0] + bu0, u1 = acc[ai][1][m][1] + bu1; float o[8];
#pragma unroll
                for (int i = 0; i < 4; ++i) { const float ga = fminf(g0[i], SW_LIMIT), ua = fminf(fmaxf(u0[i], -SW_LIMIT), SW_LIMIT); o[i] = (ua + 1.0f) * ga * fsigmoid(SW_ALPHA * ga);
                    const float gb = fminf(g1[i], SW_LIMIT), ub = fminf(fmaxf(u1[i], -SW_LIMIT), SW_LIMIT); o[4 + i] = (ub + 1.0f) * gb * fsigmoid(SW_ALPHA * gb); }
                *(u32x4*)(ACT + (size_t)row * D + j0) = pack8(o); }
    }
};
struct EpiDown {
    bf16_t* O; const float* bdn; const float* gs;
    __device__ __forceinline__ void operator()(const f32x4 (&acc)[2][2][4][2], const Unit& u, int wr, int wc, int fr, int fq) const {
        const int row0 = u.pm * 256 + wr * 64 + fr, col0 = u.pn * 256 + wc * 32 + 8 * fq;
#pragma unroll
        for (int ai = 0; ai < 2; ++ai) {
            float gt[4];
#pragma unroll
            for (int m = 0; m < 4; ++m) gt[m] = gs[row0 + ai * 128 + m * 16];
#pragma unroll
            for (int bj = 0; bj < 2; ++bj) { const float* bp = bdn + (size_t)u.e * D + col0 + bj * 128; const f32x4 b0 = *(const f32x4*)bp, b1 = *(const f32x4*)(bp + 4);
#pragma unroll
                for (int m = 0; m < 4; ++m) { const f32x4 a0 = (acc[ai][bj][m][0] + b0) * gt[m], a1 = (acc[ai][bj][m][1] + b1) * gt[m];
                    u32x4 w; w.x = pk2(a0[0], a0[1]); w.y = pk2(a0[2], a0[3]); w.z = pk2(a1[0], a1[1]); w.w = pk2(a1[2], a1[3]);
                    *(u32x4*)(O + (size_t)(row0 + ai * 128 + m * 16) * D + col0 + bj * 128) = w; } }
            asm volatile("" ::: "memory");
        }
    }
};
}

#ifndef EMU
#define XB_TMO      128
#define XB_XCNT(j)  (256  + 64 * (j))
#define XB_XSUB(j)  (1280 + 64 * (j))
#define XB_XGEN(j)  (2304 + 64 * (j))
#define XB_TOP      3328
#define XB_TOPGEN   3392
#define XCD_BAR_WORDS 3456
#define XB_SPIN_CAP (1u << 27)
__device__ __forceinline__ unsigned xb_ld(unsigned* p)              { return __hip_atomic_load(p, __ATOMIC_RELAXED, __HIP_MEMORY_SCOPE_AGENT); }
__device__ __forceinline__ unsigned xb_add(unsigned* p, unsigned v) { return __hip_atomic_fetch_add(p, v, __ATOMIC_RELAXED, __HIP_MEMORY_SCOPE_AGENT); }
__device__ __forceinline__ unsigned xb_xcc_id() { return (unsigned)__builtin_amdgcn_s_getreg((3 << 11) | 20) & 0xFu; }
#define XB_SPIN(cond, bar) do { unsigned _sp = 0; while (cond) { __builtin_amdgcn_s_sleep(1); \
    if ((++_sp & 255u) == 0u) { if (xb_ld(&(bar)[XB_TMO])) break; if (_sp > XB_SPIN_CAP) { atomicAdd(&(bar)[XB_TMO], 1u); break; } } } } while (0)
struct XcdBarrier { unsigned* bar; unsigned x; volatile LAS unsigned* st; };
__device__ __forceinline__ XcdBarrier xcd_barrier_post(unsigned* bar, volatile LAS unsigned* st) {
    XcdBarrier b; b.bar = bar; b.x = xb_xcc_id(); b.st = st;
    if (threadIdx.x == 0) (void)xb_add(&bar[XB_XCNT(b.x)], 1u);
    return b;
}
__device__ __forceinline__ void xcd_barrier_complete(unsigned* bar, unsigned x, unsigned& nloc, unsigned& nx) {
    const unsigned G = gridDim.x * gridDim.y * gridDim.z;
    unsigned sum, cnt, mine, sp = 0u;
    for (;;) {
        sum = 0u; cnt = 0u; mine = 0u;
#pragma unroll
        for (unsigned j = 0; j < 16; ++j) { const unsigned c = xb_ld(&bar[XB_XCNT(j)]); sum += c; cnt += (c > 0u) ? 1u : 0u; mine = (j == x) ? c : mine; }
        if (sum == G) break;
        __builtin_amdgcn_s_sleep(1);
        if ((++sp & 255u) == 0u) { if (xb_ld(&bar[XB_TMO])) break; if (sp > XB_SPIN_CAP) { atomicAdd(&bar[XB_TMO], 1u); break; } }
    }
    nloc = mine > 0u ? mine : 1u; nx = cnt > 0u ? cnt : 1u;
}
__device__ __forceinline__ void xcd_barrier(const XcdBarrier& b) {
    asm volatile("s_waitcnt vmcnt(0)" ::: "memory");
    __syncthreads();
    if (threadIdx.x == 0) {
        unsigned* bar = b.bar;
        __builtin_amdgcn_s_waitcnt(0);
        unsigned nloc = b.st[0], nx = b.st[1];
        if (nloc == 0u) { xcd_barrier_complete(bar, b.x, nloc, nx); b.st[0] = nloc; b.st[1] = nx; }
        const unsigned old = xb_add(&bar[XB_XSUB(b.x)], 1u);
        const unsigned gen = old / nloc;
        if (old + 1u == (gen + 1u) * nloc) {
            __builtin_amdgcn_fence(__ATOMIC_RELEASE, "agent");
            asm volatile("s_waitcnt vmcnt(0)" ::: "memory");
            const unsigned og = xb_add(&bar[XB_TOP], 1u);
            const unsigned tg = og / nx;
            if (og + 1u == (tg + 1u) * nx) xb_add(&bar[XB_TOPGEN], 1u);
            else XB_SPIN(xb_ld(&bar[XB_TOPGEN]) == tg, bar);
            __builtin_amdgcn_fence(__ATOMIC_ACQUIRE, "agent");
            xb_add(&bar[XB_XGEN(b.x)], 1u);
            asm volatile("s_waitcnt vmcnt(0)" ::: "memory");
        } else {
            XB_SPIN(xb_ld(&bar[XB_XGEN(b.x)]) == gen, bar);
            __builtin_amdgcn_fence(__ATOMIC_ACQUIRE, "agent");
            asm volatile("s_waitcnt vmcnt(0)" ::: "memory");
        }
    }
    __syncthreads();
}
#endif

struct Args { const float* in[31]; float* out; unsigned char* ws; int lo, hi; };
typedef const float* FPtr;
#ifdef EMU
typedef const FPtr* ArgTab;
#else
typedef const __attribute__((address_space(4))) FPtr* ArgTab;
#endif
struct Frame {
    LAS unsigned char* lds; int tid, lane, wave, G, bid;
    ArgTab in; float* out; unsigned char* ws; unsigned* ctl;
};
enum { I_XP = 0, I_XS, I_CK, I_CV, I_SST, I_SCV, I_SSC, I_WIN, I_CONVW, I_CONVB, I_DTB, I_ALOG, I_SD, I_NORMW, I_WSSD, I_SINK, I_WATT, I_RELB, I_SCW, I_WSC, I_WO, I_LN1G, I_LN1B,
       I_RW, I_RB, I_WUP, I_BUP, I_WDN, I_BDN, I_LN2G, I_LN2B };

__device__ __forceinline__ bf16_t* ws_bf(const Frame& F, size_t off) { return (bf16_t*)(F.ws + off); }
__device__ __forceinline__ float* ws_f(const Frame& F, size_t off) { return (float*)(F.ws + off); }
__device__ __forceinline__ bf16_t* wl_ptr(const Frame& F, int layer, size_t off) { return (bf16_t*)(F.ws + WS_W + (size_t)layer * WL_BYTES + off); }

__device__ __forceinline__ void wt_item(const float* W, int ldw, int K, int k0, int nsrc0, const float* kscale, bf16_t* WT, int ndst0, LAS float* scr, int lane) {
    if (nsrc0 < 0) {
#pragma unroll
        for (int j = 0; j < 4; ++j) { const int n = (lane >> 3) + 8 * j; *(u32x4*)(WT + (size_t)(ndst0 + n) * K + k0 + 8 * (lane & 7)) = (u32x4){0u, 0u, 0u, 0u}; }
        return;
    }
#pragma unroll 8
    for (int i = 0; i < 32; ++i) { const int kk = 2 * i + (lane >> 5); float v = W[(size_t)(k0 + kk) * ldw + nsrc0 + (lane & 31)]; if (kscale) v *= kscale[k0 + kk]; scr[kk * 33 + (lane & 31)] = v; }
    WAVE_SYNC();
    const int c = lane & 7;
#pragma unroll
    for (int j = 0; j < 4; ++j) { const int n = (lane >> 3) + 8 * j; const LAS float* s = scr + (8 * c) * 33 + n;
        u32x4 o; o.x = pk2(s[0 * 33], s[1 * 33]); o.y = pk2(s[2 * 33], s[3 * 33]); o.z = pk2(s[4 * 33], s[5 * 33]); o.w = pk2(s[6 * 33], s[7 * 33]);
        *(u32x4*)(WT + (size_t)(ndst0 + n) * K + k0 + 8 * c) = o; }
    WAVE_SYNC();
}
__device__ __forceinline__ void step_weights(const Frame& F) {
    LAS float* scr = (LAS float*)(F.lds + F.wave * 16384);
    const int gw = F.bid * NWAVES + F.wave, NGW = F.G * NWAVES;
    constexpr int I_IN = (DINP / 32) * (D / 64), I_SSD = (D / 32) * (DINNER / 64), I_SQ = (D / 32) * (D / 64), I_UP = NEXP * (2048 / 32) * (D / 64), I_DN = NEXP * (D / 32) * (D / 64);
    constexpr int PER_LAYER = I_IN + I_SSD + 3 * I_SQ + I_UP + I_DN;
    for (int it = gw; it < DEPTH * PER_LAYER; it += NGW) {
        const int layer = it / PER_LAYER; int r = it % PER_LAYER;
        if (r < I_IN) { const int nb = r / (D / 64), kb = r % (D / 64), n0 = nb * 32;
            const int ns = n0 < 6144 ? n0 : (n0 < 13824 ? n0 + 32 : (n0 < 13856 ? n0 - 13824 + 6144 : -1));
            wt_item(F.in[I_WIN] + (size_t)layer * D * DIN, DIN, D, kb * 64, ns, nullptr, wl_ptr(F, layer, WL_IN), n0, scr, F.lane); continue; }
        r -= I_IN;
        if (r < I_SSD) { const int nb = r / (DINNER / 64), kb = r % (DINNER / 64);
            wt_item(F.in[I_WSSD] + (size_t)layer * DINNER * D, D, DINNER, kb * 64, nb * 32, F.in[I_NORMW] + (size_t)layer * DINNER, wl_ptr(F, layer, WL_SSD), nb * 32, scr, F.lane); continue; }
        r -= I_SSD;
        if (r < I_SQ) { const int nb = r / (D / 64), kb = r % (D / 64); wt_item(F.in[I_WATT] + (size_t)layer * D * D, D, D, kb * 64, nb * 32, nullptr, wl_ptr(F, layer, WL_ATT), nb * 32, scr, F.lane); continue; }
        r -= I_SQ;
        if (r < I_SQ) { const int nb = r / (D / 64), kb = r % (D / 64); wt_item(F.in[I_WSC] + (size_t)layer * D * D, D, D, kb * 64, nb * 32, nullptr, wl_ptr(F, layer, WL_SC), nb * 32, scr, F.lane); continue; }
        r -= I_SQ;
        if (r < I_SQ) { const int nb = r / (D / 64), kb = r % (D / 64); wt_item(F.in[I_WO] + (size_t)layer * D * D, D, D, kb * 64, nb * 32, nullptr, wl_ptr(F, layer, WL_O), nb * 32, scr, F.lane); continue; }
        r -= I_SQ;
        if (r < I_UP) { const int e = r / ((2048 / 32) * (D / 64)), q = r % ((2048 / 32) * (D / 64)), nb = q / (D / 64), kb = q % (D / 64), n0 = nb * 32;
            const int pn = n0 >> 8, bj = (n0 >> 7) & 1, jj = n0 & 127, ns = bj * 1024 + pn * 128 + jj;
            wt_item(F.in[I_WUP] + ((size_t)layer * NEXP + e) * D * 2048, 2048, D, kb * 64, ns, nullptr, wl_ptr(F, layer, WL_UP) + (size_t)e * 2048 * D, n0, scr, F.lane); continue; }
        r -= I_UP;
        { const int e = r / ((D / 32) * (D / 64)), q = r % ((D / 32) * (D / 64)), nb = q / (D / 64), kb = q % (D / 64);
            wt_item(F.in[I_WDN] + ((size_t)layer * NEXP + e) * D * D, D, D, kb * 64, nb * 32, nullptr, wl_ptr(F, layer, WL_DN) + (size_t)e * D * D, nb * 32, scr, F.lane); }
    }
}

__device__ __forceinline__ const float* x_in_row(const Frame& F, int layer, int mb, int r) {
    if (layer == 0) return r < NP ? F.in[I_XP] + ((size_t)mb * NP + r) * D : F.in[I_XS] + (size_t)(r - NP) * D;
    return r < NP ? F.out + O_YP + ((size_t)mb * NP + r) * D : F.out + O_YS + (size_t)(r - NP) * D;
}
__device__ __forceinline__ float* x_out_row(const Frame& F, int mb, int r) { return r < NP ? F.out + O_YP + ((size_t)mb * NP + r) * D : F.out + O_YS + (size_t)(r - NP) * D; }
__device__ __forceinline__ int rows_of(int mb) { return mb == 0 ? R : NP; }

__device__ __forceinline__ void step_xb(const Frame& F, int mb) {
    const int gw = F.bid * NWAVES + F.wave, NGW = F.G * NWAVES, nr = rows_of(mb);
    bf16_t* XB = ws_bf(F, WS_XB0) + (size_t)mb * R * D;
    for (int r = gw; r < nr; r += NGW) {
        const f32x4* xr = (const f32x4*)x_in_row(F, 0, mb, r) + F.lane; u32x2* o = (u32x2*)(XB + (size_t)r * D) + F.lane;
#pragma unroll
        for (int j = 0; j < 4; ++j) { const f32x4 v = xr[64 * j]; u32x2 w; w.x = pk2(v[0], v[1]); w.y = pk2(v[2], v[3]); o[64 * j] = w; }
    }
}

__device__ __forceinline__ float softplus_f(float x) { const float e = fexp(x); return x > 20.f ? x : (e < 0.01f ? e * (1.0f - e * (0.5f - e * 0.33333333f)) : __builtin_amdgcn_logf(1.0f + e) * 0.69314718056f); }
constexpr int S128 = 136, S64 = 72;
constexpr int BL_BM = 0, BL_CM = BL_BM + 64 * S128 * 2, BL_CB = BL_CM + 64 * S128 * 2, BL_END = BL_CB + 64 * S64 * 2;
struct BcRegs { u32x4 raw[7]; f32x4 wq[4][2], bq[2]; };
__device__ __forceinline__ void ssd_bc_load(const Frame& F, int layer, int u, BcRegs& R_) {
    const int sl = (u / NCHUNK) % NSEQ_MB, ck = u % NCHUNK, g = u / (NCHUNK * NSEQ_MB); const int tid = F.tid;
    const bf16_t* H = ws_bf(F, WS_H) + (size_t)sl * SEQ * DINP; const int cgi = tid & 31, rb = tid >> 5; const int xc = (cgi < 16 ? 2048 : 3072) + g * 128 + 8 * (cgi & 15);
#pragma unroll
    for (int i = 0; i < 7; ++i) { const int t = ck * 64 + 4 * rb - 3 + i; R_.raw[i] = t >= 0 ? *(const u32x4*)(H + (size_t)t * DINP + C_X + xc) : (u32x4){0u, 0u, 0u, 0u}; }
    const float* convw = F.in[I_CONVW] + (size_t)layer * 4 * CONVDIM + xc; const float* convb = F.in[I_CONVB] + (size_t)layer * CONVDIM + xc;
#pragma unroll
    for (int tp = 0; tp < 4; ++tp) { R_.wq[tp][0] = *(const f32x4*)(convw + tp * CONVDIM); R_.wq[tp][1] = *(const f32x4*)(convw + tp * CONVDIM + 4); }
    R_.bq[0] = *(const f32x4*)convb; R_.bq[1] = *(const f32x4*)(convb + 4);
}
__device__ __forceinline__ void ssd_bc_unit(const Frame& F, int u, const BcRegs& R_) {
    const int sl = (u / NCHUNK) % NSEQ_MB, ck = u % NCHUNK, g = u / (NCHUNK * NSEQ_MB);
    const int tid = F.tid, lane = F.lane, w = F.wave, fr = lane & 15, fq = lane >> 4;
    LAS bf16_t* Bm = (LAS bf16_t*)(F.lds + BL_BM); LAS bf16_t* Cm = (LAS bf16_t*)(F.lds + BL_CM); LAS bf16_t* CBs = (LAS bf16_t*)(F.lds + BL_CB);
    const size_t rowg = (size_t)sl * SEQ + (size_t)ck * 64; const size_t tix = ((size_t)sl * NCHUNK + ck) * 8 + g;
    const int cgi = tid & 31, rb = tid >> 5; const bool isB = cgi < 16; const int n0 = 8 * (cgi & 15);
    const u32x4 (&raw)[7] = R_.raw; const f32x4 (&wq)[4][2] = R_.wq; const f32x4 (&bq)[2] = R_.bq;
    __syncthreads();
    { float val[4][8];
#pragma unroll
      for (int r = 0; r < 4; ++r) { float a[8] = {bq[0][0], bq[0][1], bq[0][2], bq[0][3], bq[1][0], bq[1][1], bq[1][2], bq[1][3]};
#pragma unroll
          for (int tp = 0; tp < 4; ++tp) { float f[8]; unpack8(raw[r + tp], f);
#pragma unroll
              for (int i = 0; i < 4; ++i) { a[i] += f[i] * wq[tp][0][i]; a[4 + i] += f[4 + i] * wq[tp][1][i]; } }
#pragma unroll
          for (int i = 0; i < 8; ++i) val[r][i] = fsilu(a[i]); }
      if (isB) { bf16_t* bt = ws_bf(F, WS_BTG) + tix * 8192 + (size_t)n0 * 64 + 4 * rb;
#pragma unroll
          for (int r = 0; r < 4; ++r) *(LAS u32x4*)(Bm + (4 * rb + r) * S128 + n0) = pack8(val[r]);
#pragma unroll
          for (int i = 0; i < 8; ++i) { u32x2 wv; wv.x = pk2(val[0][i], val[1][i]); wv.y = pk2(val[2][i], val[3][i]); *(u32x2*)(bt + (size_t)i * 64) = wv; } }
      else { bf16_t* cmc = ws_bf(F, WS_CMC) + (rowg + 4 * rb) * 1024 + g * 128 + n0;
#pragma unroll
          for (int r = 0; r < 4; ++r) { const u32x4 pk = pack8(val[r]); *(LAS u32x4*)(Cm + (4 * rb + r) * S128 + n0) = pk; *(u32x4*)(cmc + (size_t)r * 1024) = pk; } } }
    __syncthreads();
    { const int ti = w >> 1;
#pragma unroll
      for (int jj = 0; jj < 2; ++jj) { const int tj = 2 * (w & 1) + jj; f32x4 cb = (f32x4){0.f, 0.f, 0.f, 0.f};
          if (tj <= ti) {
#pragma unroll
              for (int ks = 0; ks < 4; ++ks) { const bf16x8 a = *(const LAS bf16x8*)(Cm + (16 * ti + fr) * S128 + 32 * ks + 8 * fq); const bf16x8 b = *(const LAS bf16x8*)(Bm + (16 * tj + fr) * S128 + 32 * ks + 8 * fq);
                  cb = __builtin_amdgcn_mfma_f32_16x16x32_bf16(a, b, cb, 0, 0, 0); } }
#pragma unroll
          for (int r = 0; r < 4; ++r) CBs[(16 * ti + 4 * fq + r) * S64 + 16 * tj + fr] = bf1(cb[r]); } }
    __syncthreads();
    { const int row = tid >> 3, cc = tid & 7; *(u32x4*)(ws_bf(F, WS_CBG) + tix * 4096 + row * 64 + 8 * cc) = *(const LAS u32x4*)(CBs + row * S64 + 8 * cc); }
}

constexpr int SL_CM = 0, SL_BT = SL_CM + 64 * S128 * 2, SL_CB = SL_BT + 128 * S64 * 2, SL_DMA_SZ = SL_CB + 64 * S64 * 2, SL_DMA_END = 2 * SL_DMA_SZ;
constexpr int SL_XT = SL_DMA_END  , SL_XTW = SL_XT + 2 * 64 * S64 * 2, SL_MM = SL_XTW + 64 * S64 * 2, SL_SB = SL_MM + 64 * S64 * 2,
    SL_SM = SL_SB + 64 * S128 * 2, SL_END = SL_SM + 2 * 384 * 4;
static_assert(SL_END <= SCR_BYTES && SL_DMA_SZ == 2816 * 16, "ssd LDS map");
#ifdef EMU
#define SSD_DMA_ONE(gp_, dst_) memcpy((unsigned char*)(dst_) + lane * 16, (gp_), 16)
#else
#define SSD_DMA_ONE(gp_, dst_) __builtin_amdgcn_global_load_lds((const unsigned*)(gp_), (LAS unsigned*)(dst_), 16, 0, 0)
#endif
#define SSD_DMA_SETUP() do { _Pragma("unroll") for (int j_ = 0; j_ < 6; ++j_) { const int pc_ = w * 6 + j_; const int q_ = pc_ * 64 + lane; const size_t tx0_ = ((size_t)sl * NCHUNK) * 8 + g; \
        if (pc_ < 17) { const int r_ = q_ / 17; int c_ = q_ % 17; c_ = c_ < 16 ? c_ : 15; dsrc[j_] = cmc + (size_t)r_ * 1024 + 8 * c_; } \
        else if (pc_ < 35) { const int q2_ = q_ - 1088, r_ = q2_ / 9; int c_ = q2_ % 9; c_ = c_ < 8 ? c_ : 7; dsrc[j_] = btg + tx0_ * 8192 + r_ * 64 + 8 * c_; } \
        else { const int q3_ = q_ - 2240, r_ = q3_ / 9; int c_ = q3_ % 9; c_ = c_ < 8 ? c_ : 7; dsrc[j_] = cbg + tx0_ * 4096 + r_ * 64 + 8 * c_; } } } while (0)
#define SSD_DMA(ck_) do { _Pragma("unroll") for (int j_ = 0; j_ < 6; ++j_) { const int pc_ = w * 6 + j_; if (pc_ < 44) { \
        SSD_DMA_ONE(dsrc[j_], L + ((ck_) & 1) * SL_DMA_SZ + SL_CM + pc_ * 1024); dsrc[j_] += pc_ < 17 ? (size_t)64 * 1024 : (pc_ < 35 ? (size_t)8 * 8192 : (size_t)8 * 4096); } } } while (0)
#define SSD_LOAD_X(ck_) do { _Pragma("unroll") for (int i = 0; i < 11; ++i) { const int t_ = (ck_) * 64 + 8 * w - 3 + i; rawx[i] = t_ >= 0 ? (unsigned)H[(size_t)t_ * DINP + C_X + hd * 64 + lane] : 0u; } } while (0)
#define SSD_LOAD_XN(ck_) do { const bf16_t* px_ = H + ((size_t)(ck_) * 64 + 8 * w - 3) * DINP + C_X + hd * 64 + lane; _Pragma("unroll") for (int i = 0; i < 11; ++i) rawx[i] = (unsigned)px_[(size_t)i * DINP]; } while (0)
#define SSD_TABLE(tb_, dtr_) do { const float dt_ = softplus_f(bf2f(dtr_) + dtb); \
        float cs_ = Ah * dt_; _Pragma("unroll") for (int o = 1; o < 64; o <<= 1) { const float t2_ = __shfl(cs_, lane - o < 0 ? 0 : lane - o); if (lane >= o) cs_ += t2_; } \
        const float tot_ = __shfl(cs_, 63); (tb_)[lane] = dt_; (tb_)[64 + lane] = cs_; (tb_)[128 + lane] = fexp(tot_ - cs_); (tb_)[192 + lane] = fexp(cs_); if (lane == 0) (tb_)[256] = fexp(tot_); } while (0)

__device__ __forceinline__ void ssd_prompt_unit(const Frame& F, int layer, int mb, int sl, int hd) {
    const int tid = F.tid, lane = F.lane, w = F.wave, fr = lane & 15, fq = lane >> 4;
    LAS unsigned char* L = F.lds;
    LAS bf16_t* XT0 = (LAS bf16_t*)(L + SL_XT);
    LAS bf16_t* XTW = (LAS bf16_t*)(L + SL_XTW); LAS bf16_t* Mm = (LAS bf16_t*)(L + SL_MM); LAS bf16_t* Sb = (LAS bf16_t*)(L + SL_SB);
    LAS float* smb = (LAS float*)(L + SL_SM);
    const int g = hd >> 2;
    bf16_t* H = ws_bf(F, WS_H) + (size_t)sl * SEQ * DINP;
    const bf16_t* cmc = ws_bf(F, WS_CMC) + (size_t)sl * SEQ * 1024 + g * 128; const bf16_t* btg = ws_bf(F, WS_BTG); const bf16_t* cbg = ws_bf(F, WS_CBG);
    const float* convw = F.in[I_CONVW] + (size_t)layer * 4 * CONVDIM + hd * 64; const float* convb = F.in[I_CONVB] + (size_t)layer * CONVDIM + hd * 64;
    const float cw0 = convw[lane], cw1 = convw[CONVDIM + lane], cw2 = convw[2 * CONVDIM + lane], cw3 = convw[3 * CONVDIM + lane], cwb = convb[lane];
    __syncthreads();
    const float dtb = F.in[I_DTB][layer * 32 + hd], Ah = -fexp(F.in[I_ALOG][layer * 32 + hd]), Dh = F.in[I_SD][layer * 32 + hd];
    const int xl = tid >> 3, xcg = tid & 7;
    f32x4 S[4];
#pragma unroll
    for (int j = 0; j < 4; ++j) S[j] = (f32x4){0.f, 0.f, 0.f, 0.f};
    const int ti = w >> 1, tj0 = 2 * (w & 1);
    const int pi = w & 3, nb = w >> 2;
    bf16_t* pz = H + (size_t)(16 * ti + fr) * DINP + C_Z + hd * 64 + 16 * tj0 + 4 * fq; float* pss = ws_f(F, WS_SSQ) + ((size_t)sl * SEQ + 16 * ti + fr) * 64 + hd * 2 + (w & 1);
    unsigned rawx[11]; u32x2 zraw[2]; unsigned dtr_next;
    const bf16_t* dsrc[6]; SSD_DMA_SETUP();
    SSD_DMA(0); SSD_LOAD_X(0);
    zraw[0] = *(const u32x2*)pz; zraw[1] = *(const u32x2*)(pz + 16);
    { const unsigned d0 = H[(size_t)lane * DINP + C_DT + hd]; dtr_next = H[(size_t)(64 + lane) * DINP + C_DT + hd]; if (w == 7) { SSD_TABLE(smb, d0); smb[320 + lane] = Dh * __builtin_amdgcn_rcpf(smb[lane]); } }
    VM_WAIT(0);
    __syncthreads();
    for (int ck = 0; ck < NCHUNK; ++ck) {
        LAS float* sm = smb + (ck & 1) * 384; LAS float* smn = smb + ((ck + 1) & 1) * 384; LAS bf16_t* XT = XT0 + (ck & 1) * 64 * S64;
        LAS unsigned char* Ld = L + (ck & 1) * SL_DMA_SZ; LAS bf16_t* Cm = (LAS bf16_t*)(Ld + SL_CM); LAS bf16_t* BT = (LAS bf16_t*)(Ld + SL_BT); LAS bf16_t* CBl = (LAS bf16_t*)(Ld + SL_CB);
        { const f32x4 d0 = *(const LAS f32x4*)(sm + 8 * w), d1 = *(const LAS f32x4*)(sm + 8 * w + 4), e0 = *(const LAS f32x4*)(sm + 128 + 8 * w), e1 = *(const LAS f32x4*)(sm + 128 + 8 * w + 4);
          const float dtv[8] = {d0[0], d0[1], d0[2], d0[3], d1[0], d1[1], d1[2], d1[3]}, wdv[8] = {e0[0], e0[1], e0[2], e0[3], e1[0], e1[1], e1[2], e1[3]}; float xr[11], xa[8], xb[8];
#pragma unroll
          for (int i = 0; i < 11; ++i) xr[i] = blo(rawx[i]);
#pragma unroll
          for (int r = 0; r < 8; ++r) { const float xd = fsilu(cwb + xr[r] * cw0 + xr[r + 1] * cw1 + xr[r + 2] * cw2 + xr[r + 3] * cw3) * dtv[r]; xa[r] = xd; xb[r] = xd * wdv[r]; }
          *(LAS u32x4*)(XT + lane * S64 + 8 * w) = pack8(xa); *(LAS u32x4*)(XTW + lane * S64 + 8 * w) = pack8(xb); }
#pragma unroll
        for (int jj = 0; jj < 4; ++jj) { u32x2 wv; wv.x = pk2(S[jj][0], S[jj][1]); wv.y = pk2(S[jj][2], S[jj][3]); *(LAS u32x2*)(Sb + (16 * pi + fr) * S128 + 64 * nb + 16 * jj + 4 * fq) = wv; }
        if (ck > 0) VM_WAIT(2);
        LBAR();
        const u32x2 z0 = zraw[0], z1 = zraw[1]; const unsigned dtr_cur = dtr_next;
        if (ck + 1 < NCHUNK) SSD_DMA(ck + 1);
        if (ck + 1 < NCHUNK) { SSD_LOAD_XN(ck + 1); zraw[0] = *(const u32x2*)(pz + (size_t)64 * DINP); zraw[1] = *(const u32x2*)(pz + (size_t)64 * DINP + 16);
            dtr_next = H[((size_t)ck * 64 + (ck + 2 < NCHUNK ? 128 : 64) + lane) * DINP + C_DT + hd]; }
        asm volatile("" ::: "memory");
        if (w == 7 && ck + 1 < NCHUNK) { SSD_TABLE(smn, dtr_cur); smn[320 + lane] = Dh * __builtin_amdgcn_rcpf(smn[lane]); }
        { const int s0 = 8 * xcg; float mv[8];
          if (s0 <= xl) { float cbv[8]; unpack8(*(const LAS u32x4*)(CBl + xl * S64 + s0), cbv); const float al = sm[64 + xl]; const f32x4 a0 = *(const LAS f32x4*)(sm + 64 + s0), a1 = *(const LAS f32x4*)(sm + 64 + s0 + 4);
#pragma unroll
              for (int i = 0; i < 4; ++i) { mv[i] = (xl >= s0 + i) ? cbv[i] * fexp(fminf(al - a0[i], 0.f)) : 0.f; mv[4 + i] = (xl >= s0 + 4 + i) ? cbv[4 + i] * fexp(fminf(al - a1[i], 0.f)) : 0.f; }
              if ((xl >> 3) == xcg) { const float dd = sm[320 + xl];
#pragma unroll
                  for (int i = 0; i < 8; ++i) if (i == (xl & 7)) mv[i] += dd; } }
          else {
#pragma unroll
              for (int i = 0; i < 8; ++i) mv[i] = 0.f; }
          *(LAS u32x4*)(Mm + xl * S64 + s0) = pack8(mv); }
        f32x4 yo[2];
#pragma unroll
        for (int jj = 0; jj < 2; ++jj) { const int tj = tj0 + jj; yo[jj] = (f32x4){0.f, 0.f, 0.f, 0.f};
#pragma unroll
            for (int ks = 0; ks < 4; ++ks) { const bf16x8 sb = *(const LAS bf16x8*)(Sb + (16 * tj + fr) * S128 + 32 * ks + 8 * fq); const bf16x8 c = *(const LAS bf16x8*)(Cm + (16 * ti + fr) * S128 + 32 * ks + 8 * fq);
                yo[jj] = __builtin_amdgcn_mfma_f32_16x16x32_bf16(sb, c, yo[jj], 0, 0, 0); } }
        { const float cd = sm[256];
#pragma unroll
          for (int jj = 0; jj < 4; ++jj) { S[jj] = S[jj] * cd;
#pragma unroll
            for (int ks = 0; ks < 2; ++ks) { const bf16x8 a = *(const LAS bf16x8*)(BT + (64 * nb + 16 * jj + fr) * S64 + 32 * ks + 8 * fq); const bf16x8 b = *(const LAS bf16x8*)(XTW + (16 * pi + fr) * S64 + 32 * ks + 8 * fq);
                S[jj] = __builtin_amdgcn_mfma_f32_16x16x32_bf16(a, b, S[jj], 0, 0, 0); }
            if (jj & 1) asm volatile("" ::: "memory"); } }
        const float ec = sm[192 + 16 * ti + fr];
        LBAR();
        { float ss = 0.f; const u32x2 zz[2] = {z0, z1};
#pragma unroll
          for (int jj = 0; jj < 2; ++jj) { const int tj = tj0 + jj; f32x4 yd = (f32x4){0.f, 0.f, 0.f, 0.f};
#pragma unroll
              for (int ks = 0; ks < 2; ++ks) { const bf16x8 a = *(const LAS bf16x8*)(XT + (16 * tj + fr) * S64 + 32 * ks + 8 * fq); const bf16x8 b = *(const LAS bf16x8*)(Mm + (16 * ti + fr) * S64 + 32 * ks + 8 * fq);
                  yd = __builtin_amdgcn_mfma_f32_16x16x32_bf16(a, b, yd, 0, 0, 0); }
              const float z[4] = {blo(zz[jj].x), bhi(zz[jj].x), blo(zz[jj].y), bhi(zz[jj].y)}; float v[4];
#pragma unroll
              for (int r = 0; r < 4; ++r) { v[r] = (yd[r] + ec * yo[jj][r]) * fsilu(z[r]); ss += v[r] * v[r]; }
              u32x2 ov; ov.x = pk2(v[0], v[1]); ov.y = pk2(v[2], v[3]); *(u32x2*)(pz + 16 * jj) = ov; }
          ss += __shfl_xor(ss, 16); ss += __shfl_xor(ss, 32);
          if (fq == 0) *pss = ss;
          pz += (size_t)64 * DINP; pss += 64 * 64; }
    }
    float* so = F.out + O_SSP + ((((size_t)layer * BATCH + mb * NSEQ_MB + sl) * 32 + hd) * 64) * 128;
#pragma unroll
    for (int jj = 0; jj < 4; ++jj) *(f32x4*)(so + (size_t)(16 * pi + fr) * 128 + 64 * nb + 16 * jj + 4 * fq) = S[jj];
    VM_WAIT(0); __syncthreads();
}

__device__ __forceinline__ void ssd_sample_unit(const Frame& F, int layer, int sq, int hd) {
    const int tid = F.tid, lane = F.lane; LAS float* L = (LAS float*)F.lds;
    LAS float* xs = L; LAS float* Bs = L + 16 * 64; LAS float* Cs = Bs + 16 * 128; LAS float* dts = Cs + 16 * 128; LAS float* das = dts + 16; LAS float* Yl = das + 16;
    const int g = hd >> 2;
    bf16_t* H = ws_bf(F, WS_H) + (size_t)(NP + sq * 16) * DINP;
    const float* hist = F.in[I_SCV] + ((size_t)layer * DECB + sq) * 3 * CONVDIM;
    const float* convw = F.in[I_CONVW] + (size_t)layer * 4 * CONVDIM; const float* convb = F.in[I_CONVB] + (size_t)layer * CONVDIM;
    __syncthreads();
    if (tid < 320) { const int c = tid; const int xc = c < 64 ? hd * 64 + c : (c < 192 ? 2048 + g * 128 + (c - 64) : 3072 + g * 128 + (c - 192));
        float win[19];
#pragma unroll
        for (int i = 0; i < 3; ++i) win[i] = hist[i * CONVDIM + xc];
#pragma unroll
        for (int t = 0; t < 16; ++t) win[3 + t] = bf2f(H[(size_t)t * DINP + C_X + xc]);
        const float w0 = convw[xc], w1 = convw[CONVDIM + xc], w2 = convw[2 * CONVDIM + xc], w3 = convw[3 * CONVDIM + xc], bb = convb[xc];
#pragma unroll
        for (int t = 0; t < 16; ++t) { const float a = fsilu(bb + win[t] * w0 + win[t + 1] * w1 + win[t + 2] * w2 + win[t + 3] * w3);
            if (c < 64) xs[t * 64 + c] = a; else if (c < 192) Bs[t * 128 + c - 64] = a; else Cs[t * 128 + c - 192] = a; } }
    if (tid < 16) { const float dt = softplus_f(bf2f(H[(size_t)tid * DINP + C_DT + hd]) + F.in[I_DTB][layer * 32 + hd]); dts[tid] = dt; das[tid] = fexp(-fexp(F.in[I_ALOG][layer * 32 + hd]) * dt); }
    __syncthreads();
    const int p = tid >> 3, n0 = (tid & 7) * 16;
    const size_t sbase = ((((size_t)layer * DECB + sq) * 32 + hd) * 64 + p) * 128 + n0;
    float S[16];
#pragma unroll
    for (int i = 0; i < 16; ++i) S[i] = F.in[I_SST][sbase + i];
    for (int t = 0; t < 16; ++t) { const float dec = das[t], xv = xs[t * 64 + p] * dts[t]; float part = 0.f;
#pragma unroll
        for (int i = 0; i < 16; ++i) { S[i] = S[i] * dec + xv * Bs[t * 128 + n0 + i]; part += Cs[t * 128 + n0 + i] * S[i]; }
        part += __shfl_xor(part, 1); part += __shfl_xor(part, 2); part += __shfl_xor(part, 4);
        if ((tid & 7) == 0) Yl[t * 64 + p] = part; }
#pragma unroll
    for (int i = 0; i < 16; ++i) F.out[O_SSS + sbase + i] = S[i];
    __syncthreads();
    const float Dh = F.in[I_SD][layer * 32 + hd];
#pragma unroll
    for (int j = 0; j < 2; ++j) { const int it = tid + 512 * j, t = it >> 6, pp = it & 63;
        const float z = bf2f(H[(size_t)t * DINP + C_Z + hd * 64 + pp]); const float v = (Yl[t * 64 + pp] + Dh * xs[t * 64 + pp]) * fsilu(z);
        H[(size_t)t * DINP + C_Z + hd * 64 + pp] = bf1(v);
        const float ss = wave_sum(v * v);
        if (lane < 2) ws_f(F, WS_SSQ)[((size_t)NP + sq * 16 + t) * 64 + hd * 2 + lane] = lane == 0 ? ss : 0.f; }
}

__device__ __forceinline__ int t5_bucket(int rel) {
    const int n = rel < 0 ? -rel : rel; const int b = rel > 0 ? 16 : 0;
    if (n < 8) return b + n;
    int v = 8; v += n >= 12; v += n >= 16; v += n >= 23; v += n >= 32; v += n >= 46; v += n >= 64; v += n >= 91;
    return b + v;
}
constexpr int AK_P = 72, AV_P = 200;
constexpr int AL_K = 0, AL_VT = AL_K + 192 * AK_P * 2, AL_LUT = AL_VT + 64 * AV_P * 2, AL_END = AL_LUT + 4 * 256 * 4;
static_assert(AL_END <= RING_BYTES, "attention LDS map");
__device__ __forceinline__ void attn_prompt_unit(const Frame& F, int layer, int sl, int ck, int kh) {
    const int tid = F.tid, lane = F.lane, w = F.wave, q32 = lane & 31, hi = lane >> 5;
    LAS bf16_t* Kl = (LAS bf16_t*)(F.lds + AL_K); LAS bf16_t* VT = (LAS bf16_t*)(F.lds + AL_VT); LAS float* lut = (LAS float*)(F.lds + AL_LUT);
    bf16_t* H = ws_bf(F, WS_H) + (size_t)sl * SEQ * DINP;
    const int gq = w >> 1, qh = w & 1, head = kh * 4 + gq;
    const size_t qrow = (size_t)ck * 64 + 32 * qh + q32;
    bf16x8 qf[4];
#pragma unroll
    for (int ds = 0; ds < 4; ++ds) qf[ds] = *(const bf16x8*)(H + qrow * DINP + C_Q + head * 64 + 16 * ds + 8 * hi);
    __syncthreads();
#pragma unroll
    for (int j = 0; j < 3; ++j) { const int id = tid + 512 * j, key = id >> 3, cg = id & 7; const int t = 64 * (ck - 2) + key;
        u32x4 kv = (u32x4){0u, 0u, 0u, 0u}, vv = kv;
        if (t >= 0) { kv = *(const u32x4*)(H + (size_t)t * DINP + C_K + kh * 64 + 8 * cg); vv = *(const u32x4*)(H + (size_t)t * DINP + C_V + kh * 64 + 8 * cg); }
        *(LAS u32x4*)(Kl + key * AK_P + 8 * cg) = kv;
        VT[(8 * cg + 0) * AV_P + key] = (bf16_t)(vv.x & 0xffffu); VT[(8 * cg + 1) * AV_P + key] = (bf16_t)(vv.x >> 16); VT[(8 * cg + 2) * AV_P + key] = (bf16_t)(vv.y & 0xffffu); VT[(8 * cg + 3) * AV_P + key] = (bf16_t)(vv.y >> 16);
        VT[(8 * cg + 4) * AV_P + key] = (bf16_t)(vv.z & 0xffffu); VT[(8 * cg + 5) * AV_P + key] = (bf16_t)(vv.z >> 16); VT[(8 * cg + 6) * AV_P + key] = (bf16_t)(vv.w & 0xffffu); VT[(8 * cg + 7) * AV_P + key] = (bf16_t)(vv.w >> 16); }
    for (int e = tid; e < 4 * 255; e += NTHREADS) { const int gg = e / 255, idx = e % 255; lut[gg * 256 + idx] = F.in[I_RELB][t5_bucket(idx - 191) * 16 + kh * 4 + gg]; }
    __syncthreads();
    f32x16 sc[6];
#pragma unroll
    for (int kt = 0; kt < 6; ++kt) {
#pragma unroll
        for (int r = 0; r < 16; ++r) sc[kt][r] = 0.f;
#pragma unroll
        for (int ds = 0; ds < 4; ++ds) { const bf16x8 a = *(const LAS bf16x8*)(Kl + (32 * kt + q32) * AK_P + 16 * ds + 8 * hi); sc[kt] = __builtin_amdgcn_mfma_f32_32x32x16_bf16(a, qf[ds], sc[kt], 0, 0, 0); } }
    const int qidx = 32 * qh + q32; const float sink = F.in[I_SINK][layer * 16 + head];
    float mx = -3.0e38f;
#pragma unroll
    for (int kt = 0; kt < 6; ++kt)
#pragma unroll
        for (int r = 0; r < 16; ++r) { const int key = 32 * kt + (r & 3) + 8 * (r >> 2) + 4 * hi; const int rel = key - 128 - qidx;
            float s = sc[kt][r] * 0.125f + lut[gq * 256 + rel + 191]; if (ck < 2 && 64 * ck + key - 128 < 0) s = -1e30f; sc[kt][r] = s; mx = fmaxf(mx, s); }
    mx = fmaxf(mx, __shfl_xor(mx, 32)); mx = fmaxf(mx, sink);
    float sum = 0.f;
#pragma unroll
    for (int kt = 0; kt < 6; ++kt)
#pragma unroll
        for (int r = 0; r < 16; ++r) { const float e = fexp(sc[kt][r] - mx); sc[kt][r] = e; sum += e; }
    sum += __shfl_xor(sum, 32);
    const float inv = 1.0f / (sum + fexp(sink - mx));
    f32x16 o[2];
#pragma unroll
    for (int d2 = 0; d2 < 2; ++d2)
#pragma unroll
        for (int r = 0; r < 16; ++r) o[d2][r] = 0.f;
#pragma unroll
    for (int kt = 0; kt < 6; ++kt)
#pragma unroll
        for (int s = 0; s < 2; ++s) {
            u32x4 pw; pw.x = pk2(sc[kt][8 * s + 0], sc[kt][8 * s + 1]); pw.y = pk2(sc[kt][8 * s + 2], sc[kt][8 * s + 3]); pw.z = pk2(sc[kt][8 * s + 4], sc[kt][8 * s + 5]); pw.w = pk2(sc[kt][8 * s + 6], sc[kt][8 * s + 7]);
            const bf16x8 pa = __builtin_bit_cast(bf16x8, pw);
#pragma unroll
            for (int d2 = 0; d2 < 2; ++d2) { const LAS bf16_t* vp = VT + (32 * d2 + q32) * AV_P + 32 * kt + 16 * s + 4 * hi;
                const u32x2 lo = *(const LAS u32x2*)vp, hh = *(const LAS u32x2*)(vp + 8); u32x4 vw; vw.x = lo.x; vw.y = lo.y; vw.z = hh.x; vw.w = hh.y;
                o[d2] = __builtin_amdgcn_mfma_f32_32x32x16_bf16(pa, __builtin_bit_cast(bf16x8, vw), o[d2], 0, 0, 0); } }
#pragma unroll
    for (int r = 0; r < 16; ++r) { const int q = (r & 3) + 8 * (r >> 2) + 4 * hi; const float iv = __shfl(inv, q);
        bf16_t* op = H + ((size_t)ck * 64 + 32 * qh + q) * DINP + C_Q + head * 64 + q32;
        op[0] = bf1(o[0][r] * iv); op[32] = bf1(o[1][r] * iv); }
}
__device__ __forceinline__ void attn_sample_unit(const Frame& F, int layer, int sq, int kh) {
    const int tid = F.tid; LAS float* L = (LAS float*)F.lds;
    LAS float* Kf = L; LAS float* Vf = Kf + 144 * 65; LAS float* Qf = Vf + 144 * 64; LAS float* P = Qf + 64 * 65; LAS float* Pinv = P + 64 * 145;
    static_assert((144 * 65 + 144 * 64 + 64 * 65 + 64 * 145 + 64) * 4 <= RING_BYTES, "sample attention LDS map");
    bf16_t* H = ws_bf(F, WS_H) + (size_t)(NP + sq * 16) * DINP;
    const float* ck = F.in[I_CK] + ((size_t)layer * DECB + sq) * WINDOW * 256; const float* cv = F.in[I_CV] + ((size_t)layer * DECB + sq) * WINDOW * 256;
    __syncthreads();
    for (int i = tid; i < 144 * 64; i += NTHREADS) { const int key = i >> 6, d = i & 63;
        Kf[key * 65 + d] = key < 128 ? ck[(size_t)key * 256 + kh * 64 + d] : bf2f(H[(size_t)(key - 128) * DINP + C_K + kh * 64 + d]);
        Vf[key * 64 + d] = key < 128 ? cv[(size_t)key * 256 + kh * 64 + d] : bf2f(H[(size_t)(key - 128) * DINP + C_V + kh * 64 + d]); }
    for (int i = tid; i < 64 * 64; i += NTHREADS) { const int row = i >> 6, d = i & 63; Qf[row * 65 + d] = bf2f(H[(size_t)(row & 15) * DINP + C_Q + (kh * 4 + (row >> 4)) * 64 + d]); }
    __syncthreads();
    for (int i = tid; i < 64 * 144; i += NTHREADS) { const int row = i / 144, key = i % 144; float s = 0.f;
        for (int d = 0; d < 64; ++d) s += Qf[row * 65 + d] * Kf[key * 65 + d];
        P[row * 145 + key] = s * 0.125f + F.in[I_RELB][t5_bucket(key - 128 - (row & 15)) * 16 + kh * 4 + (row >> 4)]; }
    __syncthreads();
    { const int row = tid >> 3, sub = tid & 7; const float sink = F.in[I_SINK][layer * 16 + kh * 4 + (row >> 4)]; float mx = -3.0e38f;
      for (int k = sub; k < 144; k += 8) mx = fmaxf(mx, P[row * 145 + k]);
      mx = fmaxf(mx, __shfl_xor(mx, 1)); mx = fmaxf(mx, __shfl_xor(mx, 2)); mx = fmaxf(mx, __shfl_xor(mx, 4)); mx = fmaxf(mx, sink);
      float sum = 0.f;
      for (int k = sub; k < 144; k += 8) { const float e = fexp(P[row * 145 + k] - mx); P[row * 145 + k] = e; sum += e; }
      sum += __shfl_xor(sum, 1); sum += __shfl_xor(sum, 2); sum += __shfl_xor(sum, 4);
      if (sub == 0) Pinv[row] = 1.0f / (sum + fexp(sink - mx)); }
    __syncthreads();
    { const int row = tid >> 3, d0 = (tid & 7) * 8; float o[8] = {0.f, 0.f, 0.f, 0.f, 0.f, 0.f, 0.f, 0.f};
      for (int k = 0; k < 144; ++k) { const float pv = P[row * 145 + k];
#pragma unroll
          for (int i = 0; i < 8; ++i) o[i] += pv * Vf[k * 64 + d0 + i]; }
      const float iv = Pinv[row];
#pragma unroll
      for (int i = 0; i < 8; ++i) o[i] *= iv;
      *(u32x4*)(H + (size_t)(row & 15) * DINP + C_Q + (kh * 4 + (row >> 4)) * 64 + d0) = pack8(o); }
}
__device__ __forceinline__ void sc_unit(const Frame& F, int layer, int tile) {
    const int tid = F.tid, cg = tid & 127, rs = tid >> 7; bf16_t* H = ws_bf(F, WS_H);
    const float* wsc = F.in[I_SCW] + (size_t)layer * 3 * D + 8 * cg; float wt[3][8];
#pragma unroll
    for (int i = 0; i < 3; ++i)
#pragma unroll
        for (int c = 0; c < 8; ++c) wt[i][c] = wsc[i * D + c];
    const int row0 = tile * 64 + 16 * rs; const bool smp = row0 >= NP; const int tt0 = smp ? 0 : row0 % SEQ;
    float u1[8], u2[8];
    if (tt0 >= 2) { float c8[8], h8[8];
        unpack8(*(const u32x4*)(H + (size_t)(row0 - 2) * DINP + C_SCC + 8 * cg), c8); unpack8(*(const u32x4*)(H + (size_t)(row0 - 2) * DINP + C_SCH + 8 * cg), h8);
#pragma unroll
        for (int c = 0; c < 8; ++c) u2[c] = c8[c] * h8[c];
        unpack8(*(const u32x4*)(H + (size_t)(row0 - 1) * DINP + C_SCC + 8 * cg), c8); unpack8(*(const u32x4*)(H + (size_t)(row0 - 1) * DINP + C_SCH + 8 * cg), h8);
#pragma unroll
        for (int c = 0; c < 8; ++c) u1[c] = c8[c] * h8[c]; }
    else if (smp) { const float* hp = F.in[I_SSC] + (((size_t)layer * DECB + ((row0 - NP) >> 4)) * 2) * D + 8 * cg;
#pragma unroll
        for (int c = 0; c < 8; ++c) { u2[c] = hp[c]; u1[c] = hp[D + c]; } }
    else {
#pragma unroll
        for (int c = 0; c < 8; ++c) { u2[c] = 0.f; u1[c] = 0.f; } }
#pragma unroll 1
    for (int q = 0; q < 4; ++q) {
        u32x4 cw_[4], hw_[4], bw_[4];
#pragma unroll
        for (int i = 0; i < 4; ++i) { const bf16_t* hp = H + (size_t)(row0 + 4 * q + i) * DINP + 8 * cg; cw_[i] = *(const u32x4*)(hp + C_SCC); hw_[i] = *(const u32x4*)(hp + C_SCH); bw_[i] = *(const u32x4*)(hp + C_SCB); }
        asm volatile("" ::: "memory");
#pragma unroll
        for (int i = 0; i < 4; ++i) { float c8[8], h8[8], b8[8], a[8]; unpack8(cw_[i], c8); unpack8(hw_[i], h8); unpack8(bw_[i], b8);
#pragma unroll
            for (int c = 0; c < 8; ++c) { const float u0 = c8[c] * h8[c]; a[c] = (u2[c] * wt[0][c] + u1[c] * wt[1][c] + u0 * wt[2][c]) * b8[c]; u2[c] = u1[c]; u1[c] = u0; }
            *(u32x4*)(H + (size_t)(row0 + 4 * q + i) * DINP + C_SCB + 8 * cg) = pack8(a); }
    }
}
__device__ __forceinline__ void state_out_unit(const Frame& F, int layer, int mb, int sl, bool smp) {
    const int tid = F.tid; const bf16_t* H = ws_bf(F, WS_H);
    const int nkv = smp ? DECS : WINDOW, len = smp ? DECS : SEQ; const size_t row0 = smp ? (size_t)NP + sl * 16 : (size_t)sl * SEQ; const int sg = smp ? sl : mb * NSEQ_MB + sl;
    const size_t nb_ = smp ? DECB : BATCH;
    float* ko = F.out + (smp ? O_KS : O_KP) + ((size_t)layer * nb_ + sg) * nkv * 256; float* vo = F.out + (smp ? O_VS : O_VP) + ((size_t)layer * nb_ + sg) * nkv * 256;
    for (int i = tid; i < nkv * 32; i += NTHREADS) { const int j = i >> 5, c8 = (i & 31) * 8; const bf16_t* hp = H + (row0 + len - nkv + j) * DINP; float f[8];
        unpack8(*(const u32x4*)(hp + C_K + c8), f); *(f32x4*)(ko + (size_t)j * 256 + c8) = (f32x4){f[0], f[1], f[2], f[3]}; *(f32x4*)(ko + (size_t)j * 256 + c8 + 4) = (f32x4){f[4], f[5], f[6], f[7]};
        unpack8(*(const u32x4*)(hp + C_V + c8), f); *(f32x4*)(vo + (size_t)j * 256 + c8) = (f32x4){f[0], f[1], f[2], f[3]}; *(f32x4*)(vo + (size_t)j * 256 + c8 + 4) = (f32x4){f[4], f[5], f[6], f[7]}; }
    float* co = F.out + (smp ? O_CVS : O_CVP) + ((size_t)layer * nb_ + sg) * 3 * CONVDIM;
    for (int i = tid; i < 3 * 512; i += NTHREADS) { const int j = i / 512, c8 = (i % 512) * 8; float f[8]; unpack8(*(const u32x4*)(H + (row0 + len - 3 + j) * DINP + C_X + c8), f);
        *(f32x4*)(co + (size_t)j * CONVDIM + c8) = (f32x4){f[0], f[1], f[2], f[3]}; *(f32x4*)(co + (size_t)j * CONVDIM + c8 + 4) = (f32x4){f[4], f[5], f[6], f[7]}; }
    float* so = F.out + (smp ? O_SCS : O_SCP) + ((size_t)layer * nb_ + sg) * 2 * D;
    for (int i = tid; i < 2 * 128; i += NTHREADS) { const int j = i >> 7, c8 = (i & 127) * 8; float c[8], h[8]; const bf16_t* hp = H + (row0 + len - 2 + j) * DINP;
        unpack8(*(const u32x4*)(hp + C_SCC + c8), c); unpack8(*(const u32x4*)(hp + C_SCH + c8), h);
        *(f32x4*)(so + (size_t)j * D + c8) = (f32x4){c[0] * h[0], c[1] * h[1], c[2] * h[2], c[3] * h[3]}; *(f32x4*)(so + (size_t)j * D + c8 + 4) = (f32x4){c[4] * h[4], c[5] * h[5], c[6] * h[6], c[7] * h[7]}; }
}
#ifndef MIX_MASK
#define MIX_MASK 0xFF
#endif
#define MIXON(b) ((MIX_MASK >> (b)) & 1)
__device__ __forceinline__ void step_premix(const Frame& F, int layer, int mb) {
    const int n_bc = NSEQ_MB * NCHUNK * 8, n_att = NSEQ_MB * NCHUNK * NKV, n_sc = rows_of(mb) / 64, n_so = NSEQ_MB + (mb == 0 ? DECB : 0);
    const int n_ss = mb == 0 ? DECB * 32 : 0, n_as = mb == 0 ? DECB * NKV : 0;
    const int total = n_bc + n_att + n_sc + n_so + n_ss + n_as;
#define UF(Fu) Frame Fu = F; Fu.lane = opq(lane_id()); Fu.tid = Fu.wave * 64 + Fu.lane
    PROBE_T0(14) if constexpr (MIXON(0)) { UF(Fu); BcRegs ra, rn_;
        if (F.bid < n_bc) ssd_bc_load(Fu, layer, F.bid, ra);
        for (int u = F.bid; u < n_bc; u += F.G) { const bool more = u + F.G < n_bc; if (more) ssd_bc_load(Fu, layer, u + F.G, rn_);
            ssd_bc_unit(Fu, u, ra);
            if (more) ra = rn_; } }
    PROBE_T1(14)
    for (int un = F.bid; un < total; un += F.G) { int r = un;
        if (r < n_bc) continue;
        r -= n_bc;
        if (r < n_att) { PROBE_T0(15) if constexpr (MIXON(1)) { UF(Fu);
                const int ra = (n_att % 8 == 0 && F.G % 8 == 0 && n_bc % F.G == 0) ? (r & 7) * (n_att >> 3) + (r >> 3) : r;
                attn_prompt_unit(Fu, layer, ra / (NCHUNK * NKV), (ra / NKV) % NCHUNK, ra % NKV); } PROBE_T1(15) continue; } r -= n_att;
        if (r < n_sc) { PROBE_T0(16) if constexpr (MIXON(2)) { UF(Fu); sc_unit(Fu, layer, r); } PROBE_T1(16) continue; } r -= n_sc;
        if (r < n_so) { PROBE_T0(17) if constexpr (MIXON(3)) { UF(Fu); state_out_unit(Fu, layer, mb, r < NSEQ_MB ? r : r - NSEQ_MB, r >= NSEQ_MB); } PROBE_T1(17) continue; } r -= n_so;
        if (r < n_ss) { PROBE_T0(18) if constexpr (MIXON(4)) { UF(Fu); ssd_sample_unit(Fu, layer, r >> 5, r & 31); } PROBE_T1(18) continue; } r -= n_ss;
        { PROBE_T0(19) if constexpr (MIXON(5)) { UF(Fu); attn_sample_unit(Fu, layer, r >> 2, r & 3); } PROBE_T1(19) }
    }
}
__device__ __forceinline__ void step_mixers(const Frame& F, int layer, int mb) {
    for (int v = F.bid; v < NSEQ_MB * 32; v += F.G) { const int un = (NSEQ_MB == 8 && F.G == 256) ? (v & 7) * 32 + (v >> 3) : v; UF(Fu); ssd_prompt_unit(Fu, layer, mb, un >> 5, un & 31); }
}
__device__ __forceinline__ void step_gnorm(const Frame& F, int mb) {
    const int gw = F.bid * NWAVES + F.wave, NGW = F.G * NWAVES, nr = rows_of(mb); bf16_t* H = ws_bf(F, WS_H); const float* ssq = ws_f(F, WS_SSQ);
    constexpr int RB = 4; const int g = F.lane >> 3;
    for (int r0 = gw; r0 < nr; r0 += RB * NGW) {
        u32x4 d[RB][4]; f32x4 q[RB];
#pragma unroll
        for (int i = 0; i < RB; ++i) { const int r = r0 + i * NGW < nr ? r0 + i * NGW : r0; { const f32x4 qa = *(const f32x4*)(ssq + (size_t)r * 64 + 8 * g), qb = *(const f32x4*)(ssq + (size_t)r * 64 + 8 * g + 4); q[i] = qa + qb; } const u32x4* p = (const u32x4*)(H + (size_t)r * DINP + C_Z + 32 * F.lane);
#pragma unroll
            for (int j = 0; j < 4; ++j) d[i][j] = p[j]; }
        asm volatile("" ::: "memory");
#pragma unroll
        for (int i = 0; i < RB; ++i) { const int r = r0 + i * NGW; if (r >= nr) continue;
            const float rstd = 1.0f / sqrtf(((q[i][0] + q[i][1]) + (q[i][2] + q[i][3])) * (1.0f / 256.0f) + LN_EPS); u32x4* p = (u32x4*)(H + (size_t)r * DINP + C_Z + 32 * F.lane);
#pragma unroll
            for (int j = 0; j < 4; ++j) { float f[8]; unpack8(d[i][j], f);
#pragma unroll
                for (int k = 0; k < 8; ++k) f[k] *= rstd;
                p[j] = pack8(f); } }
    }
}
constexpr int LOG_NEXP = NEXP == 32 ? 5 : (NEXP == 16 ? 4 : (NEXP == 8 ? 3 : 2));
template <int N, int MASK> struct RedStep {
    static __device__ __forceinline__ void run(float* v, int lane) {
        constexpr int Hn = N / 2; const bool up = (lane & MASK) != 0;
#pragma unroll
        for (int i = 0; i < Hn; ++i) { const float keep = up ? v[i + Hn] : v[i], send = up ? v[i] : v[i + Hn]; v[i] = keep + xshfl<MASK>(send); }
        if constexpr (Hn > 1) RedStep<Hn, (MASK >> 1)>::run(v, lane);
    }
};
constexpr int RW_P = D + 8;
__device__ __forceinline__ void step_ln1_router_mfma(const Frame& F, int layer, int mb) {
    LAS bf16_t* WH = (LAS bf16_t*)F.lds; LAS bf16_t* WL = WH + NTE * 16 * RW_P; LAS float* GB = (LAS float*)(WL + NTE * 16 * RW_P);
    static_assert((size_t)2 * NTE * 16 * RW_P * 2 + 2 * D * 4 <= (size_t)SCR_BYTES, "router LDS map");
    const int lane = F.lane, fr = lane & 15, fq = lane >> 4;
    __syncthreads();
    { const bf16_t* rwh = ws_bf(F, WS_RWH) + (size_t)layer * NTE * 16 * D; const bf16_t* rwl = ws_bf(F, WS_RWL) + (size_t)layer * NTE * 16 * D;
      for (int i = F.tid; i < NTE * 16 * (D / 8); i += NTHREADS) { const int e = i / (D / 8), c = i % (D / 8); *(LAS u32x4*)(WH + e * RW_P + 8 * c) = *(const u32x4*)(rwh + (size_t)e * D + 8 * c); *(LAS u32x4*)(WL + e * RW_P + 8 * c) = *(const u32x4*)(rwl + (size_t)e * D + 8 * c); }
      for (int i = F.tid; i < D; i += NTHREADS) { GB[i] = F.in[I_LN1G][(size_t)layer * D + i]; GB[D + i] = F.in[I_LN1B][(size_t)layer * D + i]; } }
    unsigned* cnt = F.ctl + CW_CNT + (mb * DEPTH + layer) * 64;
    LAS unsigned* lcnt = (LAS unsigned*)(F.lds + MISC_OFF) + 128;
    if (F.tid < 64) lcnt[F.tid] = 0u;
    __syncthreads();
    const int gw = F.bid * NWAVES + F.wave, NGW = F.G * NWAVES, nr = rows_of(mb);
    const float* rb = F.in[I_RB] + (size_t)layer * NEXP;
    bf16_t* XB = ws_bf(F, WS_XB); int* topi = (int*)(F.ws + WS_TOPI); float* gate = ws_f(F, WS_GATE); int* pos = (int*)(F.ws + WS_POS);
    float rbv[NTE];
#pragma unroll
    for (int t = 0; t < NTE; ++t) rbv[t] = 16 * t + fr < NEXP ? rb[16 * t + fr] : 0.f;
    for (int blk = gw; blk < nr / 16; blk += NGW) {
        const int row = 16 * blk + fr; const float* xr = x_out_row(F, mb, row) + 8 * fq;
        float s1 = 0.f, s2 = 0.f;
#pragma unroll 8
        for (int sI = 0; sI < D / 32; ++sI) { const f32x4 a = *(const f32x4*)(xr + 32 * sI), b = *(const f32x4*)(xr + 32 * sI + 4);
            s1 += ((a[0] + a[1]) + (a[2] + a[3])) + ((b[0] + b[1]) + (b[2] + b[3])); s2 += ((a[0] * a[0] + a[1] * a[1]) + (a[2] * a[2] + a[3] * a[3])) + ((b[0] * b[0] + b[1] * b[1]) + (b[2] * b[2] + b[3] * b[3])); }
        s1 += xshfl<16>(s1); s1 += xshfl<32>(s1); s2 += xshfl<16>(s2); s2 += xshfl<32>(s2);
        const float mean = s1 * (1.0f / D); const float rstd = 1.0f / sqrtf(fmaxf(s2 * (1.0f / D) - mean * mean, 0.f) + LN_EPS);
        f32x4 acc[NTE];
#pragma unroll
        for (int t = 0; t < NTE; ++t) acc[t] = (f32x4){0.f, 0.f, 0.f, 0.f};
        bf16_t* xo = XB + (size_t)row * D + 8 * fq;
#pragma unroll 4
        for (int sI = 0; sI < D / 32; ++sI) { const f32x4 a = *(const f32x4*)(xr + 32 * sI), b = *(const f32x4*)(xr + 32 * sI + 4);
            const f32x4 g0 = *(const LAS f32x4*)(GB + 32 * sI + 8 * fq), g1 = *(const LAS f32x4*)(GB + 32 * sI + 8 * fq + 4), b0 = *(const LAS f32x4*)(GB + D + 32 * sI + 8 * fq), b1 = *(const LAS f32x4*)(GB + D + 32 * sI + 8 * fq + 4);
            const f32x4 n0 = (a - mean) * rstd * g0 + b0, n1 = (b - mean) * rstd * g1 + b1;
            u32x4 hw; hw.x = pk2(n0[0], n0[1]); hw.y = pk2(n0[2], n0[3]); hw.z = pk2(n1[0], n1[1]); hw.w = pk2(n1[2], n1[3]);
            *(u32x4*)(xo + 32 * sI) = hw;
            u32x4 lw; lw.x = pk2(n0[0] - blo(hw.x), n0[1] - bhi(hw.x)); lw.y = pk2(n0[2] - blo(hw.y), n0[3] - bhi(hw.y)); lw.z = pk2(n1[0] - blo(hw.z), n1[1] - bhi(hw.z)); lw.w = pk2(n1[2] - blo(hw.w), n1[3] - bhi(hw.w));
            const bf16x8 ah = __builtin_bit_cast(bf16x8, hw), al = __builtin_bit_cast(bf16x8, lw);
#pragma unroll
            for (int t = 0; t < NTE; ++t) { const bf16x8 wh = *(const LAS bf16x8*)(WH + (16 * t + fr) * RW_P + 32 * sI + 8 * fq), wl = *(const LAS bf16x8*)(WL + (16 * t + fr) * RW_P + 32 * sI + 8 * fq);
                acc[t] = __builtin_amdgcn_mfma_f32_16x16x32_bf16(ah, wh, acc[t], 0, 0, 0); acc[t] = __builtin_amdgcn_mfma_f32_16x16x32_bf16(al, wh, acc[t], 0, 0, 0); acc[t] = __builtin_amdgcn_mfma_f32_16x16x32_bf16(ah, wl, acc[t], 0, 0, 0); } }
#pragma unroll
        for (int r = 0; r < 4; ++r) { float val[NTE];
#pragma unroll
            for (int t = 0; t < NTE; ++t) val[t] = 16 * t + fr < NEXP ? acc[t][r] + rbv[t] : -3.0e38f;
            float tv[4]; int te[4];
#pragma unroll
            for (int k = 0; k < 4; ++k) { float m = val[0];
#pragma unroll
                for (int t = 1; t < NTE; ++t) m = fmaxf(m, val[t]);
                m = fmaxf(m, xshfl<1>(m)); m = fmaxf(m, xshfl<2>(m)); m = fmaxf(m, xshfl<4>(m)); m = fmaxf(m, xshfl<8>(m));
                int ce = 9999;
#pragma unroll
                for (int t = NTE - 1; t >= 0; --t) ce = val[t] == m ? 16 * t + fr : ce;
                { int o = xshfl<1>(ce); ce = o < ce ? o : ce; o = xshfl<2>(ce); ce = o < ce ? o : ce; o = xshfl<4>(ce); ce = o < ce ? o : ce; o = xshfl<8>(ce); ce = o < ce ? o : ce; }
                tv[k] = m; te[k] = ce;
#pragma unroll
                for (int t = 0; t < NTE; ++t) if (16 * t + fr == ce) val[t] = -3.0e38f; }
            const float e1 = fexp(tv[1] - tv[0]), e2 = fexp(tv[2] - tv[0]), e3 = fexp(tv[3] - tv[0]); const float inv = 1.0f / (1.0f + e1 + e2 + e3);
            if (fr < 4) { const int e = fr == 0 ? te[0] : (fr == 1 ? te[1] : (fr == 2 ? te[2] : te[3])); const float gv = (fr == 0 ? 1.0f : (fr == 1 ? e1 : (fr == 2 ? e2 : e3))) * inv;
                const size_t tok = (size_t)16 * blk + 4 * fq + r;
                const unsigned rk = __hip_atomic_fetch_add(lcnt + e, 1u, __ATOMIC_RELAXED, __HIP_MEMORY_SCOPE_WORKGROUP);
                topi[tok * 4 + fr] = e; gate[tok * 4 + fr] = gv; pos[tok * 4 + fr] = (int)rk; } }
    }
    __syncthreads();
    if (F.tid < NEXP) lcnt[32 + F.tid] = __hip_atomic_fetch_add(cnt + F.tid, lcnt[F.tid], __ATOMIC_RELAXED, __HIP_MEMORY_SCOPE_AGENT);
    __syncthreads();
    for (int blk = gw; blk < nr / 16; blk += NGW) pos[(size_t)16 * blk * 4 + lane] += (int)lcnt[32 + topi[(size_t)16 * blk * 4 + lane]];
}
__device__ __forceinline__ void step_ln1_router(const Frame& F, int layer, int mb) {
    LAS float* wT = (LAS float*)F.lds;
    const float* rw = F.in[I_RW] + (size_t)layer * D * NEXP;
    __syncthreads();
    for (int i = F.tid; i < D * NEXP; i += NTHREADS) { const int e = i / D, k = i % D; wT[i] = rw[(size_t)k * NEXP + e]; }
    unsigned* cnt = F.ctl + CW_CNT + (mb * DEPTH + layer) * 64;
    LAS unsigned* lcnt = (LAS unsigned*)(F.lds + MISC_OFF) + 128;
    if (F.tid < 64) lcnt[F.tid] = 0u;
    __syncthreads();
    const int gw = F.bid * NWAVES + F.wave, NGW = F.G * NWAVES, nr = rows_of(mb), lane = F.lane;
    const float* lg = F.in[I_LN1G] + (size_t)layer * D; const float* lb = F.in[I_LN1B] + (size_t)layer * D; const float* rb = F.in[I_RB] + (size_t)layer * NEXP;
    bf16_t* XB = ws_bf(F, WS_XB); int* topi = (int*)(F.ws + WS_TOPI); float* gate = ws_f(F, WS_GATE); int* pos = (int*)(F.ws + WS_POS);
    constexpr int RB = 4, NH = NEXP / 2, LOGH = LOG_NEXP - 1;
    const int myexp = ((lane & 1) * NH) | ((lane >> (6 - LOGH)) & (NH - 1));
    const float myb = rb[myexp];
    for (int r0 = gw; r0 < nr; r0 += RB * NGW) {
        f32x4 v[RB][4]; int rr[RB]; bool ok[RB];
#pragma unroll
        for (int i = 0; i < RB; ++i) { const int r = r0 + i * NGW; ok[i] = r < nr; rr[i] = ok[i] ? r : r0; const float* xr = x_out_row(F, mb, rr[i]);
#pragma unroll
            for (int j = 0; j < 4; ++j) v[i][j] = *((const f32x4*)xr + lane + 64 * j); }
        asm volatile("" ::: "memory");
#pragma unroll
        for (int i = 0; i < RB; ++i) {
            float s = 0.f;
#pragma unroll
            for (int j = 0; j < 4; ++j) s += (v[i][j][0] + v[i][j][1]) + (v[i][j][2] + v[i][j][3]);
            const float mean = wave_sum(s) * (1.0f / D); float s2 = 0.f;
#pragma unroll
            for (int j = 0; j < 4; ++j) { v[i][j] = v[i][j] - mean; s2 += (v[i][j][0] * v[i][j][0] + v[i][j][1] * v[i][j][1]) + (v[i][j][2] * v[i][j][2] + v[i][j][3] * v[i][j][3]); }
            const float rstd = 1.0f / sqrtf(wave_sum(s2) * (1.0f / D) + LN_EPS);
#pragma unroll
            for (int j = 0; j < 4; ++j) { const f32x4 gg = *((const f32x4*)lg + lane + 64 * j), bb = *((const f32x4*)lb + lane + 64 * j); v[i][j] = v[i][j] * rstd * gg + bb;
                if (ok[i]) { u32x2 w; w.x = pk2(v[i][j][0], v[i][j][1]); w.y = pk2(v[i][j][2], v[i][j][3]); *((u32x2*)(XB + (size_t)rr[i] * D) + lane + 64 * j) = w; } }
        }
        typedef float f32x2v __attribute__((ext_vector_type(2)));
        float val[RB];
#pragma unroll
        for (int hf = 0; hf < 2; ++hf) {
            float lgt[RB][NH];
#pragma unroll
            for (int e = 0; e < NH; ++e) { f32x2v a2[RB / 2];
#pragma unroll
                for (int i = 0; i < RB / 2; ++i) a2[i] = (f32x2v){0.f, 0.f};
#pragma unroll
                for (int j = 0; j < 4; ++j) { const f32x4 wv = *((const LAS f32x4*)(wT + (hf * NH + e) * D) + lane + 64 * j);
#pragma unroll
                    for (int c = 0; c < 4; ++c) { const f32x2v w2 = (f32x2v){wv[c], wv[c]};
#pragma unroll
                        for (int i = 0; i < RB / 2; ++i) a2[i] = __builtin_elementwise_fma((f32x2v){v[2 * i][j][c], v[2 * i + 1][j][c]}, w2, a2[i]); } }
#pragma unroll
                for (int i = 0; i < RB / 2; ++i) { lgt[2 * i][e] = a2[i].x; lgt[2 * i + 1][e] = a2[i].y; }
                if ((e & 1) == 1) asm volatile("" ::: "memory"); }
#pragma unroll
            for (int i = 0; i < RB; ++i) { RedStep<NH, 32>::run(lgt[i], lane); float tot = lgt[i][0];
                if constexpr ((32 >> LOGH) >= 8) tot += xshfl<8>(tot);
                if constexpr ((32 >> LOGH) >= 4) tot += xshfl<4>(tot);
                if constexpr ((32 >> LOGH) >= 2) tot += xshfl<2>(tot);
                tot += xshfl<1>(tot);
                if ((lane & 1) == hf) val[i] = tot + myb; }
        }
#pragma unroll
        for (int i = 0; i < RB; ++i) {
            float tv[4]; int te[4]; float vv = val[i];
#pragma unroll
            for (int k = 0; k < 4; ++k) { float m = vv; m = fmaxf(m, xshfl<1>(m)); m = fmaxf(m, xshfl<2>(m)); m = fmaxf(m, xshfl<4>(m)); m = fmaxf(m, xshfl<8>(m)); m = fmaxf(m, xshfl<16>(m)); m = fmaxf(m, xshfl<32>(m));
                const unsigned long long bal = __ballot(vv == m); const int wl = __builtin_ctzll(bal);
                const int be = ((wl & 1) * NH) | ((wl >> (6 - LOGH)) & (NH - 1));
                tv[k] = m; te[k] = be; if (myexp == be) vv = -3.0e38f; }
            const float e1 = fexp(tv[1] - tv[0]), e2 = fexp(tv[2] - tv[0]), e3 = fexp(tv[3] - tv[0]); const float inv = 1.0f / (1.0f + e1 + e2 + e3);
            if (lane < 4 && ok[i]) { const int e = lane == 0 ? te[0] : (lane == 1 ? te[1] : (lane == 2 ? te[2] : te[3])); const float gv = (lane == 0 ? 1.0f : (lane == 1 ? e1 : (lane == 2 ? e2 : e3))) * inv;
                const unsigned rk = __hip_atomic_fetch_add(lcnt + e, 1u, __ATOMIC_RELAXED, __HIP_MEMORY_SCOPE_WORKGROUP);
                topi[(size_t)rr[i] * 4 + lane] = e; gate[(size_t)rr[i] * 4 + lane] = gv; pos[(size_t)rr[i] * 4 + lane] = (int)rk; }
        }
    }
    __syncthreads();
    if (F.tid < NEXP) lcnt[32 + F.tid] = __hip_atomic_fetch_add(cnt + F.tid, lcnt[F.tid], __ATOMIC_RELAXED, __HIP_MEMORY_SCOPE_AGENT);
    __syncthreads();
    for (int r = gw; r < nr; r += NGW) if (lane < 4) pos[(size_t)r * 4 + lane] += (int)lcnt[32 + topi[(size_t)r * 4 + lane]];
}
__device__ __forceinline__ int moe_table(const Frame& F, int layer, int mb) {
    LAS int* M = (LAS int*)(F.lds + MISC_OFF);
    __syncthreads();
    if (F.tid == 0) { unsigned* cnt = F.ctl + CW_CNT + (mb * DEPTH + layer) * 64; int acc = 0;
        for (int e = 0; e < NEXP; ++e) { const int c = (int)__hip_atomic_load(cnt + e, __ATOMIC_RELAXED, __HIP_MEMORY_SCOPE_AGENT); M[64 + e] = acc * 256; acc += (c + 255) / 256; M[16 + e] = acc; } }
    __syncthreads();
    return M[16 + NEXP - 1];
}
__device__ __forceinline__ void step_gather(const Frame& F, int layer, int mb) {
    (void)moe_table(F, layer, mb); const LAS int* M = (const LAS int*)(F.lds + MISC_OFF);
    const int nr = rows_of(mb);
    const int* topi = (const int*)(F.ws + WS_TOPI); const float* gate = ws_f(F, WS_GATE); int* pos = (int*)(F.ws + WS_POS); float* gs = ws_f(F, WS_GSORT); int* rtok = (int*)(F.ws + WS_RTOK);
#pragma nounroll
    for (int i = F.bid * NTHREADS + F.tid; i < nr * 4; i += F.G * NTHREADS) { const int p = M[64 + topi[i]] + pos[i]; pos[i] = p; rtok[p] = i >> 2; gs[p] = gate[i]; }
}
__device__ __forceinline__ void step_ln2(const Frame& F, int layer, int mb) {
    const int gw = F.bid * NWAVES + F.wave, NGW = F.G * NWAVES, nr = rows_of(mb), lane = F.lane;
    const float* lg = F.in[I_LN2G] + (size_t)layer * D; const float* lb = F.in[I_LN2B] + (size_t)layer * D;
    const bf16_t* OUTS = ws_bf(F, WS_H) + (size_t)2 * RP * D; const int* pos = (const int*)(F.ws + WS_POS); bf16_t* XB = ws_bf(F, WS_XB);
    constexpr int RB = 2;
    for (int r0 = gw; r0 < nr; r0 += RB * NGW) {
        f32x4 v[RB][4]; u32x2 ow[RB][4][4]; int rr[RB];
#pragma unroll
        for (int i = 0; i < RB; ++i) { rr[i] = r0 + i * NGW < nr ? r0 + i * NGW : r0; const u32x2* xr = (const u32x2*)(XB + (size_t)rr[i] * D); int p[4];
#pragma unroll
            for (int k = 0; k < 4; ++k) p[k] = pos[(size_t)rr[i] * 4 + k];
#pragma unroll
            for (int j = 0; j < 4; ++j) { { const u32x2 w = xr[lane + 64 * j]; v[i][j] = (f32x4){blo(w.x), bhi(w.x), blo(w.y), bhi(w.y)}; }
#pragma unroll
                for (int k = 0; k < 4; ++k) ow[i][k][j] = *((const u32x2*)(OUTS + (size_t)p[k] * D) + lane + 64 * j); } }
        asm volatile("" ::: "memory");
#pragma unroll
        for (int i = 0; i < RB; ++i) { if (r0 + i * NGW >= nr) continue;
            float* xr = x_out_row(F, mb, rr[i]); float s = 0.f;
#pragma unroll
            for (int j = 0; j < 4; ++j) { v[i][j] = v[i][j] * ALPHA;
#pragma unroll
                for (int k = 0; k < 4; ++k) { const u32x2 w = ow[i][k][j]; v[i][j] = v[i][j] + (f32x4){blo(w.x), bhi(w.x), blo(w.y), bhi(w.y)}; }
                s += (v[i][j][0] + v[i][j][1]) + (v[i][j][2] + v[i][j][3]); }
            const float mean = wave_sum(s) * (1.0f / D); float s2 = 0.f;
#pragma unroll
            for (int j = 0; j < 4; ++j) { v[i][j] = v[i][j] - mean; s2 += (v[i][j][0] * v[i][j][0] + v[i][j][1] * v[i][j][1]) + (v[i][j][2] * v[i][j][2] + v[i][j][3] * v[i][j][3]); }
            const float rstd = 1.0f / sqrtf(wave_sum(s2) * (1.0f / D) + LN_EPS);
#pragma unroll
            for (int j = 0; j < 4; ++j) { const f32x4 gg = *((const f32x4*)lg + lane + 64 * j), bb = *((const f32x4*)lb + lane + 64 * j); v[i][j] = v[i][j] * rstd * gg + bb;
                *((f32x4*)xr + lane + 64 * j) = v[i][j]; u32x2 w; w.x = pk2(v[i][j][0], v[i][j][1]); w.y = pk2(v[i][j][2], v[i][j][3]); *((u32x2*)(XB + (size_t)rr[i] * D) + lane + 64 * j) = w; } }
    }
}

constexpr int SP_P = 68;
template <int KS  > __device__ __forceinline__ void small_mma(const bf16_t* A, int lda, const bf16_t* Bt, int K, int tok0, int n0, int k0, int fr, int fq, f32x4 (&acc)[4]) {
    const bf16_t* ap = A + (size_t)(tok0 + fr) * lda + k0 + 8 * fq; const bf16_t* bp = Bt + (size_t)(n0 + fr) * K + k0 + 8 * fq;
#pragma unroll
    for (int k = 0; k < KS; k += 32) { const bf16x8 a = *(const bf16x8*)(ap + k);
#pragma unroll
        for (int jj = 0; jj < 4; ++jj) { const bf16x8 x = *(const bf16x8*)(bp + (size_t)16 * jj * K + k); acc[jj] = __builtin_amdgcn_mfma_f32_16x16x32_bf16(x, a, acc[jj], 0, 0, 0); } }
}
template <int MODE  >
__device__ __forceinline__ void sample_unit(const Frame& F, int layer, int u) {
    const int tid = F.tid, lane = F.lane, w = F.wave, fr = lane & 15, fq = lane >> 4; const int tok0 = NP + 16 * (u >> 4), n0 = 64 * (u & 15);
    LAS float* P = (LAS float*)F.lds;
    const bf16_t* H = ws_bf(F, WS_H); const size_t trow = (size_t)(tok0 + fr);
    f32x4 v[4];
#pragma unroll
    for (int jj = 0; jj < 4; ++jj) v[jj] = (f32x4){0.f, 0.f, 0.f, 0.f};
    if constexpr (MODE == 0) {
#pragma unroll
        for (int b = 0; b < 3; ++b) { f32x4 acc[4] = {(f32x4){0.f, 0.f, 0.f, 0.f}, (f32x4){0.f, 0.f, 0.f, 0.f}, (f32x4){0.f, 0.f, 0.f, 0.f}, (f32x4){0.f, 0.f, 0.f, 0.f}};
            if (b == 0) { small_mma<DINNER / 8>(H + C_Z, DINP, wl_ptr(F, layer, WL_SSD), DINNER, tok0, n0, w * (DINNER / 8), fr, fq, acc);
                const float* sq = ws_f(F, WS_SSQ) + trow * 64 + 8 * w; const f32x4 qa = *(const f32x4*)sq + *(const f32x4*)(sq + 4); const float rs = 1.0f / sqrtf(((qa[0] + qa[1]) + (qa[2] + qa[3])) * (1.0f / 256.0f) + LN_EPS);
#pragma unroll
                for (int jj = 0; jj < 4; ++jj) acc[jj] = acc[jj] * rs; }
            else small_mma<D / 8>(H + (b == 1 ? C_Q : C_SCB), DINP, wl_ptr(F, layer, b == 1 ? WL_ATT : WL_SC), D, tok0, n0, w * (D / 8), fr, fq, acc);
#pragma unroll
            for (int jj = 0; jj < 4; ++jj) { const u32x2 gw = *(const u32x2*)(H + trow * DINP + (b == 0 ? C_GSSD : (b == 1 ? C_GATT : C_GSC)) + n0 + 16 * jj + 4 * fq);
                v[jj] = v[jj] + acc[jj] * (f32x4){fsigmoid(blo(gw.x)), fsigmoid(bhi(gw.x)), fsigmoid(blo(gw.y)), fsigmoid(bhi(gw.y))}; } }
    } else small_mma<D / 8>(ws_bf(F, WS_XB), D, wl_ptr(F, layer, WL_O), D, tok0, n0, w * (D / 8), fr, fq, v);
    __syncthreads();
#pragma unroll
    for (int jj = 0; jj < 4; ++jj) *(LAS f32x4*)(P + (w * 16 + fr) * SP_P + 16 * jj + 4 * fq) = v[jj];
    __syncthreads();
    { const int tk = tid >> 5, c2 = 2 * (tid & 31); float s0 = 0.f, s1 = 0.f;
#pragma unroll
      for (int ww = 0; ww < 8; ++ww) { s0 += P[(ww * 16 + tk) * SP_P + c2]; s1 += P[(ww * 16 + tk) * SP_P + c2 + 1]; }
      const size_t orow = (size_t)(tok0 + tk);
      if constexpr (MODE == 0) *(unsigned*)(ws_bf(F, WS_XB) + orow * D + n0 + c2) = pk2(s0, s1);
      else { const float* xs = (layer == 0 ? F.in[I_XS] : F.out + O_YS) + (orow - NP) * D + n0 + c2; float* os = F.out + O_YS + (orow - NP) * D + n0 + c2; os[0] = xs[0] * ALPHA + s0; os[1] = xs[1] * ALPHA + s1; } }
}

constexpr int PH_PER = 10, NSTEPS = 1 + NMB * DEPTH * PH_PER;
__global__ void __launch_bounds__(NTHREADS, 2) fwd(Args args) {
#ifdef EMU
    unsigned char* lds = emu_wg->lds;
#else
    extern __shared__ __attribute__((aligned(16))) unsigned char lds[];
#endif
    Frame F0; F0.lds = (LAS unsigned char*)lds; F0.tid = threadIdx.x; F0.lane = F0.tid & 63; F0.wave = __builtin_amdgcn_readfirstlane(F0.tid >> 6); F0.G = gridDim.x; F0.bid = blockIdx.x;
#ifdef EMU
    F0.in = args.in;
#else
    F0.in = (ArgTab)__builtin_amdgcn_kernarg_segment_ptr();
    static_assert(offsetof(Args, out) == 248 && offsetof(Args, ws) == 256 && offsetof(Args, in) == 0, "PF() reads the argument struct by offset");
#endif
    F0.out = args.out; F0.ws = args.ws; F0.ctl = (unsigned*)(args.ws + WS_CTL);
    const Frame& F = F0;
    const int lo = args.lo, hi = args.hi;
#ifndef EMU
    for (int u = F.tid; u < (LDS_BYTES - MISC_OFF) / 4; u += NTHREADS) ((LAS unsigned*)(F.lds + MISC_OFF))[u] = 0u;
    __syncthreads();
    XcdBarrier bar; bar.bar = F.ctl + CW_BAR; bar.x = 0; bar.st = nullptr;
    if (hi - lo > 1) bar = xcd_barrier_post(F.ctl + CW_BAR, (volatile LAS unsigned*)(F.lds + MISC_OFF) + 8);
#define SEAM(s) do { if ((s) + 1 < hi) { XcdBarrier b2_ = bar; unsigned long long bp_ = (unsigned long long)b2_.bar; asm volatile("" : "+s"(bp_)); b2_.bar = (unsigned*)bp_; xcd_barrier(b2_); } } while (0)
#else
#define SEAM(s) do { } while (0)
#endif
#ifndef PH_MASK
#define PH_MASK 0xFFFFFFFF
#endif
#define IN(s) (lo <= (s) && (s) < hi)
#define PHON(b) ((PH_MASK >> (b)) & 1)
#ifdef EMU
#define PF(Fp) Frame Fp = F0
#else
#define PF(Fp) Frame Fp; { unsigned long long kp_ = (unsigned long long)__builtin_amdgcn_kernarg_segment_ptr(); asm volatile("" : "+s"(kp_)); \
    Fp.in = (ArgTab)kp_; Fp.out = *(float* const __attribute__((address_space(4)))*)(kp_ + 248); Fp.ws = *(unsigned char* const __attribute__((address_space(4)))*)(kp_ + 256); Fp.ctl = (unsigned*)Fp.ws; \
    Fp.lds = F0.lds; Fp.G = F0.G; Fp.bid = F0.bid; Fp.wave = F0.wave; Fp.lane = opq(lane_id()); Fp.tid = Fp.wave * 64 + Fp.lane; }
#endif
    int step = 0;
    if (IN(step)) { PROBE_T0(0) if constexpr (PHON(0)) { PF(F); step_weights(F); for (int m = 0; m < NMB; ++m) step_xb(F, m);
        { bf16_t* rwh = ws_bf(F, WS_RWH); bf16_t* rwl = ws_bf(F, WS_RWL); const float* rw = F.in[I_RW];
#pragma nounroll
          for (int i = F.bid * NTHREADS + F.tid; i < DEPTH * NTE * 16 * D; i += F.G * NTHREADS) { const int l = i / (NTE * 16 * D), e = (i / D) % (NTE * 16), k = i % D;
              const float wv = e < NEXP ? rw[((size_t)l * D + k) * NEXP + e] : 0.f; const unsigned hi = f2bf(wv); rwh[i] = (bf16_t)hi; rwl[i] = (bf16_t)f2bf(wv - bf2f(hi)); } } } PROBE_T1(0) SEAM(step); }
    ++step;
#define PHV const int mb = opqs(mb0), layer = opqs(layer0), nr = rows_of(mb); (void)nr; (void)layer
    for (int mb0 = 0; mb0 < NMB; ++mb0)
        for (int layer0 = 0; layer0 < DEPTH; ++layer0) {
            if (IN(step)) { PROBE_T0(2) if constexpr (PHON(2)) { PF(F); PHV; pg8::Gemm g{layer == 0 ? ws_bf(F, WS_XB0) + (size_t)mb * R * D : ws_bf(F, WS_XB), wl_ptr(F, layer, WL_IN), nr, DINP, D, D, nullptr}; pg8::StaticOrder S; S.init(nr, DINP, F.G, F.bid, 2);
                pg8::EpiStoreBf16 E{ws_bf(F, WS_H), DINP}; pg8::gemm_phase(F.lds, g, S, E, F.wave); } PROBE_T1(2) SEAM(step); }
            ++step;
            if (IN(step)) { PROBE_T0(13) if constexpr (PHON(13)) { PF(F); PHV; step_premix(F, layer, mb); } PROBE_T1(13) SEAM(step); }
            ++step;
            if (IN(step)) { PROBE_T0(3) if constexpr (PHON(3)) { PF(F); PHV; step_mixers(F, layer, mb); } PROBE_T1(3) SEAM(step); }
            ++step;
            if (IN(step)) { PROBE_T0(5) if constexpr (PHON(5)) { PF(F); PHV; pg8::StaticOrder S; S.init(NP, D, F.G, F.bid); bf16_t* H = ws_bf(F, WS_H); bf16_t* MGb = ws_bf(F, WS_XB);
#ifndef MERGE_MASK
#define MERGE_MASK 7
#endif
                if constexpr (MERGE_MASK & 1) { pg8::Gemm g{H + C_Z, wl_ptr(F, layer, WL_SSD), NP, D, DINNER, DINP, nullptr, ws_f(F, WS_SSQ)}; pg8::EpiGate<0> E{H + C_GSSD, MGb}; pg8::gemm_phase<pg8::EpiGate<0>, pg8::StaticOrder, false, true>(F.lds, g, S, E, F.wave); }
                if constexpr (MERGE_MASK & 2) { pg8::Gemm g{H + C_Q, wl_ptr(F, layer, WL_ATT), NP, D, D, DINP, nullptr}; pg8::EpiGate<1> E{H + C_GATT, MGb}; pg8::gemm_phase(F.lds, g, S, E, F.wave); }
                if constexpr (MERGE_MASK & 4) { pg8::Gemm g{H + C_SCB, wl_ptr(F, layer, WL_SC), NP, D, D, DINP, nullptr}; pg8::EpiGate<1> E{H + C_GSC, MGb}; pg8::gemm_phase(F.lds, g, S, E, F.wave); }
                if (mb == 0) for (int u = F.bid; u < 256; u += F.G) sample_unit<0>(F, layer, u); }
                PROBE_T1(5) SEAM(step); }
            ++step;
            if (IN(step)) { PROBE_T0(6) if constexpr (PHON(6)) { PF(F); PHV; pg8::Gemm g{ws_bf(F, WS_XB), wl_ptr(F, layer, WL_O), NP, D, D, D, nullptr}; pg8::StaticOrder S; S.init(NP, D, F.G, F.bid);
                pg8::EpiResid E{layer == 0 ? F.in[I_XP] + (size_t)mb * NP * D : F.out + O_YP + (size_t)mb * NP * D, layer == 0 ? F.in[I_XS] : F.out + O_YS, F.out + O_YP + (size_t)mb * NP * D, F.out + O_YS};
                pg8::gemm_phase(F.lds, g, S, E, F.wave);
                if (mb == 0) for (int u = F.bid; u < 256; u += F.G) sample_unit<1>(F, layer, u); } PROBE_T1(6) SEAM(step); }
            ++step;
            if (IN(step)) { PROBE_T0(7) if constexpr (PHON(7)) { PF(F); PHV; step_ln1_router_mfma(F, layer, mb); } PROBE_T1(7) SEAM(step); }
            ++step;
            if (IN(step)) { PROBE_T0(8) if constexpr (PHON(8)) { PF(F); PHV; step_gather(F, layer, mb); } PROBE_T1(8) SEAM(step); }
            ++step;
            if (IN(step)) { PROBE_T0(9) if constexpr (PHON(9)) { PF(F); PHV; const int nt = moe_table(F, layer, mb); pg8::MoeOrder S{(const LAS int*)(F.lds + MISC_OFF) + 16, 8, nt * 8, F.G, F.bid};
                pg8::Gemm g{ws_bf(F, WS_XB), wl_ptr(F, layer, WL_UP), nr  , 2048, D, D, (const int*)(F.ws + WS_RTOK)}; pg8::EpiSwiglu E{ws_bf(F, WS_H) + (size_t)RP * D, F.in[I_BUP] + (size_t)layer * NEXP * 2048};
                pg8::gemm_phase<pg8::EpiSwiglu, pg8::MoeOrder, true>(F.lds, g, S, E, F.wave); } PROBE_T1(9) SEAM(step); }
            ++step;
            if (IN(step)) { PROBE_T0(10) if constexpr (PHON(10)) { PF(F); PHV; const int nt = moe_table(F, layer, mb); pg8::MoeOrder S{(const LAS int*)(F.lds + MISC_OFF) + 16, 4, nt * 4, F.G, F.bid};
                pg8::Gemm g{ws_bf(F, WS_H) + (size_t)RP * D, wl_ptr(F, layer, WL_DN), nt * 256, D, D, D, nullptr}; pg8::EpiDown E{ws_bf(F, WS_H) + (size_t)2 * RP * D, F.in[I_BDN] + (size_t)layer * NEXP * D, ws_f(F, WS_GSORT)};
                pg8::gemm_phase(F.lds, g, S, E, F.wave); } PROBE_T1(10) SEAM(step); }
            ++step;
            if (IN(step)) { PROBE_T0(11) if constexpr (PHON(11)) { PF(F); PHV; step_ln2(F, layer, mb); } PROBE_T1(11) SEAM(step); }
            ++step;
        }
}

#ifdef EMU
extern int emu_grid, emu_step_lo, emu_step_hi;
#endif
extern "C" void kernel_launch(void* const* d_in, const int* in_sizes, int n_in, void* d_out, int out_size, void* d_ws, size_t ws_size, hipStream_t stream) {
    (void)in_sizes; (void)out_size;
    if (n_in != 31 || ws_size < WS_END) { fprintf(stderr, "kernel_launch: expected 31 inputs and >= %zu bytes of workspace (got %d, %zu)\n", (size_t)WS_END, n_in, ws_size); return; }
    Args a; memset(&a, 0, sizeof(a));
    for (int i = 0; i < 31; ++i) a.in[i] = (const float*)d_in[i];
    a.out = (float*)d_out; a.ws = (unsigned char*)d_ws;
#ifdef EMU
    if (emu_step_lo == 0) memset((char*)d_ws + WS_CTL, 0, CTL_BYTES);
    for (int s = emu_step_lo; s < emu_step_hi && s < NSTEPS; ++s) { a.lo = s; a.hi = s + 1; emu_launch(fwd, emu_grid, NTHREADS, LDS_BYTES, a); fprintf(stderr, "step %d done\n", s); }
#else
    (void)hipMemsetAsync((char*)d_ws + WS_CTL, 0, CTL_BYTES, stream);
    static int grid = 0;
    if (grid == 0) {
        int dev = 0, cus = 0;
        if (hipGetDevice(&dev) != hipSuccess || hipDeviceGetAttribute(&cus, hipDeviceAttributeMultiprocessorCount, dev) != hipSuccess) { grid = -1; return; }
        if (hipFuncSetAttribute((const void*)fwd, hipFuncAttributeMaxDynamicSharedMemorySize, LDS_BYTES) != hipSuccess) { grid = -1; return; }
        int per_cu = 0; (void)hipOccupancyMaxActiveBlocksPerMultiprocessor(&per_cu, (const void*)fwd, NTHREADS, LDS_BYTES); (void)hipGetLastError();
        grid = cus / 64 * 64;
        if (grid < 64) { grid = -1; return; }
    }
    if (grid < 0) return;
#if CFG_ONE_LAUNCH
    a.lo = 0; a.hi = NSTEPS; hipLaunchKernelGGL(fwd, dim3(grid), dim3(NTHREADS), LDS_BYTES, stream, a);
#else
    for (int s = 0; s < NSTEPS; ++s) { a.lo = s; a.hi = s + 1; hipLaunchKernelGGL(fwd, dim3(grid), dim3(NTHREADS), LDS_BYTES, stream, a); }
#endif
#endif
}
```

```cpp
#ifdef EMU
#include "emu.h"
#else
#include <hip/hip_runtime.h>
#endif
#include <cstdio>
#include <cstdint>
#include <cstring>
#include <cstddef>
#include <cmath>

#ifndef CFG_BATCH
#define CFG_BATCH 16
#endif
#ifndef CFG_SEQ
#define CFG_SEQ 4096
#endif
#ifndef CFG_NSEQ_MB
#define CFG_NSEQ_MB 8
#endif
#ifndef CFG_NEXP
#define CFG_NEXP 32
#endif
#ifndef CFG_ONE_LAUNCH
#define CFG_ONE_LAUNCH 1
#endif

constexpr int BATCH = CFG_BATCH, SEQ = CFG_SEQ, NSEQ_MB = CFG_NSEQ_MB, NEXP = CFG_NEXP, NMB = BATCH / NSEQ_MB;
constexpr int D = 1024, DEPTH = 2, DECB = 16, DECS = 16, NS = DECB * DECS;
constexpr int DINNER = 2048, CONVDIM = 4096;
constexpr int NKV = 4, WINDOW = 128, CHUNK = 64;
constexpr int DIN = 13856, DINP = 14080;
constexpr int NP = NSEQ_MB * SEQ, R = NP + NS;
constexpr int NTE = (NEXP + 15) / 16;
constexpr int RP = ((4 * R + NEXP * 255) + 255) / 256 * 256;
constexpr int NCHUNK = SEQ / CHUNK;
constexpr int C_Z = 0, C_X = 2048, C_B = 4096, C_C = 5120, C_Q = 6144, C_K = 7168, C_V = 7424, C_SCB = 7680, C_SCC = 8704, C_SCH = 9728, C_GSSD = 10752, C_GATT = 11776, C_GSC = 12800, C_DT = 13824;
constexpr float LN_EPS = 1e-5f, ALPHA = 1.41421356237309515f  , SW_LIMIT = 7.0f, SW_ALPHA = 1.702f;
static_assert(BATCH % NSEQ_MB == 0 && SEQ % 256 == 0 && (NEXP & (NEXP - 1)) == 0 && NEXP <= 32 && NEXP >= 4, "config");

constexpr size_t O_YP = 0, O_YS = O_YP + (size_t)BATCH * SEQ * D, O_KP = O_YS + (size_t)NS * D, O_VP = O_KP + (size_t)DEPTH * BATCH * WINDOW * 256,
    O_SSP = O_VP + (size_t)DEPTH * BATCH * WINDOW * 256, O_CVP = O_SSP + (size_t)DEPTH * BATCH * 32 * 64 * 128, O_SCP = O_CVP + (size_t)DEPTH * BATCH * 3 * CONVDIM,
    O_KS = O_SCP + (size_t)DEPTH * BATCH * 2 * D, O_VS = O_KS + (size_t)DEPTH * DECB * DECS * 256, O_SSS = O_VS + (size_t)DEPTH * DECB * DECS * 256,
    O_CVS = O_SSS + (size_t)DEPTH * DECB * 32 * 64 * 128, O_SCS = O_CVS + (size_t)DEPTH * DECB * 3 * CONVDIM, O_END = O_SCS + (size_t)DEPTH * DECB * 2 * D;

constexpr size_t al256(size_t x) { return (x + 255) / 256 * 256; }
constexpr size_t WS_CTL = 0, CTL_BYTES = 1u << 20;
constexpr size_t WS_SSQ = CTL_BYTES, WS_TOPI = WS_SSQ + al256((size_t)R * 64 * 4), WS_GATE = WS_TOPI + al256((size_t)R * 16), WS_POS = WS_GATE + al256((size_t)R * 16),
    WS_GSORT = WS_POS + al256((size_t)R * 16), WS_RTOK = WS_GSORT + al256((size_t)RP * 4),
    WS_RWH = WS_RTOK + al256((size_t)RP * 4)  , WS_RWL = WS_RWH + (size_t)DEPTH * NTE * 16 * D * 2  , WS_W = WS_RWL + (size_t)DEPTH * NTE * 16 * D * 2;
constexpr size_t WL_IN = 0, WL_SSD = WL_IN + (size_t)DINP * D * 2, WL_ATT = WL_SSD + (size_t)D * DINNER * 2, WL_SC = WL_ATT + (size_t)D * D * 2, WL_O = WL_SC + (size_t)D * D * 2,
    WL_UP = WL_O + (size_t)D * D * 2, WL_DN = WL_UP + (size_t)NEXP * 2048 * D * 2, WL_BYTES = WL_DN + (size_t)NEXP * D * D * 2;
constexpr size_t WS_XB = WS_W + DEPTH * WL_BYTES, WS_XB0 = WS_XB + (size_t)R * D * 2  , WS_PRE = WS_XB0 + (size_t)NMB * R * D * 2  , WS_H = WS_PRE + (size_t)R * D * 2;
constexpr size_t WS_STAT = WS_PRE;
constexpr size_t H_BYTES = (size_t)R * DINP * 2, MOE_BYTES = (size_t)3 * RP * D * 2, U_BYTES = H_BYTES > MOE_BYTES ? H_BYTES : MOE_BYTES;
constexpr size_t WS_CMC = WS_H + U_BYTES, WS_BTG = WS_CMC + (size_t)NP * 1024 * 2, WS_CBG = WS_BTG + (size_t)NSEQ_MB * NCHUNK * 8 * 8192 * 2, WS_END = WS_CBG + (size_t)NSEQ_MB * NCHUNK * 8 * 4096 * 2;
static_assert(WS_END <= ((size_t)2 << 30), "workspace map exceeds 2 GiB");
constexpr int CW_BAR = 4096, CW_CNT = 16384;

constexpr int RING_BYTES = 131072, LDS_BYTES = 163840  , MISC_OFF = LDS_BYTES - 1024, SCR_BYTES = MISC_OFF;
constexpr int NWAVES = 8, NTHREADS = 512;

#ifdef EMU
#define LAS
#define WAVE_SYNC() emu_wave_barrier()
#else
#define LAS __attribute__((address_space(3)))
#define WAVE_SYNC() asm volatile("s_waitcnt lgkmcnt(0)" ::: "memory")
#endif
#ifdef EMU
#define LBAR() emu_wg_barrier()
#define VM_WAIT(n) do { } while (0)
#else
#define LBAR() do { asm volatile("s_waitcnt lgkmcnt(0)" ::: "memory"); __builtin_amdgcn_s_barrier(); asm volatile("" ::: "memory"); } while (0)
#define VM_WAIT(n) asm volatile("s_waitcnt vmcnt(" #n ")" ::: "memory")
#endif
typedef unsigned short bf16_t;
typedef short bf16x8 __attribute__((ext_vector_type(8)));
typedef float f32x4 __attribute__((ext_vector_type(4)));
typedef float f32x16 __attribute__((ext_vector_type(16)));
typedef unsigned u32x4 __attribute__((ext_vector_type(4)));
typedef unsigned u32x2 __attribute__((ext_vector_type(2)));

__device__ __forceinline__ unsigned f2bf(float f) { unsigned u = __builtin_bit_cast(unsigned, f); return (u + 0x7fffu + ((u >> 16) & 1u)) >> 16; }
__device__ __forceinline__ float bf2f(unsigned h) { return __builtin_bit_cast(float, (h & 0xffffu) << 16); }
#ifdef EMU
__device__ __forceinline__ unsigned pk2(float lo, float hi) { return f2bf(lo) | (f2bf(hi) << 16); }
#else
typedef float f32x2_t __attribute__((ext_vector_type(2))); typedef __bf16 bf16x2_t __attribute__((ext_vector_type(2)));
__device__ __forceinline__ unsigned pk2(float lo, float hi) { f32x2_t v = {lo, hi}; bf16x2_t b = __builtin_convertvector(v, bf16x2_t); return __builtin_bit_cast(unsigned, b); }
#endif
#ifdef EMU
__device__ __forceinline__ unsigned short bf1(float f) { return (unsigned short)f2bf(f); }
#else
__device__ __forceinline__ unsigned short bf1(float f) { return (unsigned short)pk2(f, f); }
#endif
__device__ __forceinline__ float blo(unsigned w) { return __builtin_bit_cast(float, w << 16); }
__device__ __forceinline__ float bhi(unsigned w) { return __builtin_bit_cast(float, w & 0xffff0000u); }
__device__ __forceinline__ void unpack8(const u32x4 w, float* f) { f[0] = blo(w.x); f[1] = bhi(w.x); f[2] = blo(w.y); f[3] = bhi(w.y); f[4] = blo(w.z); f[5] = bhi(w.z); f[6] = blo(w.w); f[7] = bhi(w.w); }
__device__ __forceinline__ u32x4 pack8(const float* f) { u32x4 w; w.x = pk2(f[0], f[1]); w.y = pk2(f[2], f[3]); w.z = pk2(f[4], f[5]); w.w = pk2(f[6], f[7]); return w; }
__device__ __forceinline__ float fexp(float x) { return __builtin_amdgcn_exp2f(x * 1.4426950408889634f); }
__device__ __forceinline__ float fsigmoid(float x) { return __builtin_amdgcn_rcpf(1.0f + __builtin_amdgcn_exp2f(-1.4426950408889634f * x)); }
__device__ __forceinline__ float fsilu(float x) { return x * fsigmoid(x); }
#ifdef EMU
__device__ __forceinline__ int opq(int x) { return x; }
#else
__device__ __forceinline__ int opq(int x) { asm volatile("" : "+v"(x)); return x; }
#endif
#ifdef EMU
__device__ __forceinline__ int opqs(int x) { return x; }
#else
__device__ __forceinline__ int opqs(int x) { asm volatile("" : "+s"(x)); return x; }
#endif
#ifdef EMU
__device__ __forceinline__ int lane_id() { return (int)(threadIdx.x & 63); }
#else
__device__ __forceinline__ int lane_id() { return (int)__builtin_amdgcn_mbcnt_hi(~0u, __builtin_amdgcn_mbcnt_lo(~0u, 0u)); }
#endif
#ifdef EMU
template <int MASK> __device__ __forceinline__ unsigned xshfl_u(unsigned x) { return __shfl_xor(x, MASK); }
#else
template <int MASK> __device__ __forceinline__ unsigned xshfl_u(unsigned x) {
    if constexpr (MASK == 1) return (unsigned)__builtin_amdgcn_update_dpp((int)x, (int)x, 0xB1, 0xF, 0xF, false);
    else if constexpr (MASK == 2) return (unsigned)__builtin_amdgcn_update_dpp((int)x, (int)x, 0x4E, 0xF, 0xF, false);
    else if constexpr (MASK == 4) { const int t = __builtin_amdgcn_update_dpp((int)x, (int)x, 0x114, 0xF, 0xA, false);
        return (unsigned)__builtin_amdgcn_update_dpp(t, (int)x, 0x104, 0xF, 0x5, false); }
    else if constexpr (MASK == 8) return (unsigned)__builtin_amdgcn_update_dpp((int)x, (int)x, 0x128, 0xF, 0xF, false);
    else if constexpr (MASK == 16) { const auto rr = __builtin_amdgcn_permlane16_swap(x, x, false, false); return (lane_id() & 16) ? rr[0] : rr[1]; }
    else { const auto rr = __builtin_amdgcn_permlane32_swap(x, x, false, false); return (lane_id() & 32) ? rr[0] : rr[1]; }
}
#endif
template <int MASK> __device__ __forceinline__ float xshfl(float x) { return __builtin_bit_cast(float, xshfl_u<MASK>(__builtin_bit_cast(unsigned, x))); }
template <int MASK> __device__ __forceinline__ int xshfl(int x) { return (int)xshfl_u<MASK>((unsigned)x); }
__device__ __forceinline__ float wave_sum(float v) { v += xshfl<1>(v); v += xshfl<2>(v); v += xshfl<4>(v); v += xshfl<8>(v); v += xshfl<16>(v); v += xshfl<32>(v); return v; }

#ifndef PROBE_MASK
#define PROBE_MASK 0
#endif
#if PROBE_MASK && !defined(EMU)
#define PROBE_T0(b) unsigned long long pt0_ = 0; if constexpr ((PROBE_MASK >> (b)) & 1) pt0_ = __builtin_amdgcn_s_memrealtime();
#define PROBE_T1(b) if constexpr ((PROBE_MASK >> (b)) & 1) { asm volatile("s_waitcnt vmcnt(0) lgkmcnt(0)" ::: "memory"); const unsigned long long pt1_ = __builtin_amdgcn_s_memrealtime(); \
    while (__builtin_amdgcn_s_memrealtime() < pt1_ + (pt1_ - pt0_)) __builtin_amdgcn_s_sleep(8); }
#else
#define PROBE_T0(b)
#define PROBE_T1(b)
#endif
namespace pg8 {
constexpr int BM = 256, BK = 64, HALF = 128, HTB = HALF * BK * 2, NXCD = 8, WGM = 8;
struct Unit { int pm, pn, bt, e; };
struct Gemm { const bf16_t* A; const bf16_t* Bt; int M, N, K, lda; const int* tok; const float* ssq = nullptr; };
struct StaticOrder {
    int nM, nN, nwg, G, c, wgm;
    __host__ __device__ void init(int M, int N, int G_, int c_, int wgm_ = WGM) { nM = M / BM; nN = N / BM; nwg = nM * nN; G = G_; c = c_; wgm = wgm_; }
    __host__ __device__ bool next(int i, Unit& u) const {
        const long L = (long)i * G + c; if (L >= nwg) return false;
        int wgid = (int)L; { const int q = nwg / NXCD, r = nwg % NXCD, xcd = wgid % NXCD, off = wgid / NXCD; wgid = (xcd < r ? xcd * (q + 1) : r * (q + 1) + (xcd - r) * q) + off; }
        const int nig = wgm * nN, gid = wgid / nig, fm = gid * wgm, gsz = (nM - fm) < wgm ? (nM - fm) : wgm;
        u.pm = fm + ((wgid % nig) % gsz); u.pn = (wgid % nig) / gsz; u.bt = u.pn; u.e = 0; return true;
    }
    __device__ __forceinline__ void a_ready(const Unit&) const {}
    __device__ __forceinline__ void done(const Unit&) const {}
};
struct MoeOrder {
    const LAS int* tend; int npn, ntot, G, c;
    __device__ __forceinline__ bool next(int i, Unit& u) const {
        int rt, pn;
        {
            const int xcd = c & 7, j = c >> 3, rpx = (G >> 3) / npn; rt = (i * 8 + xcd) * rpx + j / npn; pn = j % npn; if (rt >= ntot / npn) return false; }
        int e = 0;
#pragma unroll
        for (int j = 0; j < NEXP; ++j) e += (tend[j] <= rt) ? 1 : 0;
        u.pm = rt; u.pn = pn; u.e = e; u.bt = e * npn + pn; return true;
    }
    __device__ __forceinline__ void a_ready(const Unit&) const {}
    __device__ __forceinline__ void done(const Unit&) const {}
};
#ifdef EMU
template <class Epi, class Sched, bool GATHER = false, bool GSCALE = false>
__device__ void gemm_phase(LAS unsigned char* lds, const Gemm g, const Sched& S, const Epi& E, int  ) {
    const int tid = threadIdx.x, wid = tid >> 6, lane = tid & 63, wr = wid >> 2, wc = wid & 3, fr = lane & 15, fq = lane >> 4;
    Unit u;
    for (int i = 0; S.next(i, u); ++i) {
        f32x4 acc[2][2][4][2];
        for (int ai = 0; ai < 2; ++ai) for (int bj = 0; bj < 2; ++bj) for (int m = 0; m < 4; ++m) for (int n = 0; n < 2; ++n) for (int q = 0; q < 4; ++q) {
            const int row = u.pm * 256 + ai * 128 + wr * 64 + m * 16 + fr, col = u.bt * 256 + bj * 128 + wc * 32 + 8 * fq + 4 * n + q;
            const bf16_t* a = g.A + (size_t)(GATHER ? ((unsigned)g.tok[row] < (unsigned)g.M ? g.tok[row] : 0) : row) * g.lda; const bf16_t* b = g.Bt + (size_t)col * g.K; float s = 0.f;
            if constexpr (GSCALE) {
                float rs[9]; for (int j = 0; j < 8; ++j) { float q2 = 0.f; for (int i = 0; i < 8; ++i) q2 += g.ssq[(size_t)row * 64 + 8 * j + i]; rs[j] = 1.0f / sqrtf(q2 * (1.0f / 256.0f) + LN_EPS); } rs[8] = 1.f;
                for (int j = 0; j < 8; ++j) { for (int k = 256 * j; k < 256 * j + 256; ++k) s += bf2f(a[k]) * bf2f(b[k]); s *= rs[j] * (1.0f / rs[j + 1]); } }
            else for (int k = 0; k < g.K; ++k) s += bf2f(a[k]) * bf2f(b[k]);
            acc[ai][bj][m][n][q] = s; }
        E(acc, u, wr, wc, fr, fq);
    }
    __syncthreads();
}
#else
#define PG8_LAS __attribute__((address_space(3)))
__host__ __device__ __forceinline__ int lds_byte(int r, int c) { const int st = (r >> 4) * 2 + (c >> 5), rr = r & 15, cc = c & 31, ob = rr * 64 + cc * 2; return st * 1024 + (ob ^ (((ob >> 9) & 1) << 5)); }
__host__ __device__ __forceinline__ void stage_rc(int b, int& R_, int& C_) { const int st = b / 1024, sb = b % 1024, swz = sb ^ (((sb >> 9) & 1) << 5); R_ = (st >> 1) * 16 + swz / 64; C_ = (st & 1) * 32 + (swz % 64) / 2; }
__host__ __device__ __forceinline__ int perm32(int rho) { const int n = rho >> 4, i = rho & 15; return 8 * (i >> 2) + 4 * n + (i & 3); }
template <class Epi, class Sched, bool GATHER = false, bool GSCALE = false>
__device__ __forceinline__ void gemm_phase(PG8_LAS unsigned char* lds, const Gemm g, const Sched& S, const Epi& E, int wave_id) {
    const int lane = opq(lane_id()), wid = opqs(wave_id), tid = wid * 64 + lane, wr = wid >> 2, wc = wid & 3, fr = lane & 15, fq = lane >> 4;
    const int K = g.K, nt = K / BK, lda = g.lda;
    unsigned voffA[2], voffB[2];
#pragma unroll
    for (int i = 0; i < 2; ++i) { int R_, C_; stage_rc(tid * 16 + i * 8192, R_, C_); const int Rb = (R_ & ~31) + perm32(R_ & 31);
        voffA[i] = (unsigned)(R_ * lda + C_) * 2u; voffB[i] = (unsigned)(Rb * K + C_) * 2u; }
    unsigned vG[2][2], vN[2][2];
#define PG8_TOK(dst, pm_) do { _Pragma("unroll") for (int i_ = 0; i_ < 2; ++i_) { int R_, C_; stage_rc(opq(tid) * 16 + i_ * 8192, R_, C_); _Pragma("unroll") for (int h_ = 0; h_ < 2; ++h_) \
        { unsigned tk_ = (unsigned)g.tok[(pm_) * 256 + h_ * 128 + R_]; tk_ = tk_ < (unsigned)g.M ? tk_ : 0u; dst[h_][i_] = tk_ * (unsigned)(lda * 2) + (unsigned)(C_ * 2); } } } while (0)
#define PG8_STAGE_A(bufoff, base_, h_, nx_) do { if constexpr (GATHER) { unsigned vs_[2] = {(nx_) ? vN[h_][0] : vG[h_][0], (nx_) ? vN[h_][1] : vG[h_][1]}; PG8_STAGE(bufoff, base_, vs_); } \
        else { PG8_STAGE(bufoff, (base_) + ((h_) ? hstepA : 0), voffA); } } while (0)
    const size_t kstep = (size_t)(BK * 2);
    const size_t hstepA = (size_t)HALF * lda * 2, tstepA = 2 * hstepA;
    const size_t hstepB = (size_t)HALF * K * 2, tstepB = 2 * hstepB;
    const unsigned ldsw = (unsigned)wid * 1024u;
    const int aoff = lds_byte(wr * 64 + fr, fq * 8), boff = lds_byte(wc * 32 + fr, fq * 8);
#define PG8_SA(b, h) (((b) * 2 + (h)) * HTB)
#define PG8_SB(b, h) ((4 + (b) * 2 + (h)) * HTB)
#define PG8_STAGE(bufoff, gbase, voff) do { _Pragma("unroll") for (int _i = 0; _i < 2; ++_i) \
        __builtin_amdgcn_global_load_lds((const unsigned*)((const char*)(gbase) + (voff)[_i]), (PG8_LAS unsigned*)(lds + (bufoff) + ldsw + _i * 8192), 16, 0, 0); } while (0)
#define PG8_LDA(dst, b, h) do { _Pragma("unroll") for (int m = 0; m < 4; ++m) _Pragma("unroll") for (int k = 0; k < 2; ++k) dst[m][k] = *(const PG8_LAS bf16x8*)(lds + PG8_SA(b, h) + aoff + m * 2048 + k * 1024); } while (0)
#define PG8_LDB(dst, b, h) do { _Pragma("unroll") for (int n = 0; n < 2; ++n) _Pragma("unroll") for (int k = 0; k < 2; ++k) dst[n][k] = *(const PG8_LAS bf16x8*)(lds + PG8_SB(b, h) + boff + n * 2048 + k * 1024); } while (0)
#define PG8_MMA(ai, bj, At, Bt) do { __builtin_amdgcn_s_setprio(1); _Pragma("unroll") for (int m = 0; m < 4; ++m) _Pragma("unroll") for (int n = 0; n < 2; ++n) _Pragma("unroll") for (int k = 0; k < 2; ++k) \
        acc[ai][bj][m][n] = __builtin_amdgcn_mfma_f32_16x16x32_bf16(Bt[n][k], At[m][k], acc[ai][bj][m][n], 0, 0, 0); __builtin_amdgcn_s_setprio(0); } while (0)
#define PG8_WAIT_V(n) asm volatile("s_waitcnt vmcnt(" #n ")" ::: "memory")
#define PG8_WAIT_L(n) asm volatile("s_waitcnt lgkmcnt(" #n ")" ::: "memory")
#define PG8_BAR __builtin_amdgcn_s_barrier()
#define PG8_SCHED __builtin_amdgcn_sched_barrier(0)
    Unit cur, nxt; int ui = 0;
    if (!S.next(0, cur)) return;
    if constexpr (GSCALE) {
        static_assert(RING_BYTES + 3 * 8192 <= MISC_OFF, "group-norm factor tables");
        Unit tu;
        if (S.next(3, tu)) __builtin_trap();
#pragma unroll 1
        for (int q = 0; q < 3 && S.next(q, tu); ++q) { const int row = tid & 255, h = tid >> 8;
            const float* sp = g.ssq + (size_t)(tu.pm * 256 + row) * 64 + 32 * h; float qv[5];
#pragma unroll
            for (int gi = 0; gi < 5; ++gi) { f32x4 a_ = (f32x4){0.f, 0.f, 0.f, 0.f}, b_ = a_; if (gi < 4 || h == 0) { a_ = *(const f32x4*)(sp + 8 * gi); b_ = *(const f32x4*)(sp + 8 * gi + 4); }
                a_ = a_ + b_; qv[gi] = sqrtf(((a_[0] + a_[1]) + (a_[2] + a_[3])) * (1.0f / 256.0f) + LN_EPS); }
            PG8_LAS float* ct = (PG8_LAS float*)(lds + RING_BYTES) + q * 2048 + 4 * h * 256 + row;
#pragma unroll
            for (int j = 0; j < 4; ++j) ct[j * 256] = (h == 1 && j == 3) ? 1.0f / qv[3] : qv[j + 1] / qv[j]; }
        __syncthreads();
    }
    f32x4 acc[2][2][4][2];
#pragma unroll
    for (int a = 0; a < 2; ++a)
#pragma unroll
        for (int b = 0; b < 2; ++b)
#pragma unroll
            for (int m = 0; m < 4; ++m)
#pragma unroll
                for (int n = 0; n < 2; ++n) acc[a][b][m][n] = (f32x4){0.f, 0.f, 0.f, 0.f};
    bf16x8 At[4][2], B0[2][2], B1[2][2];
    const char* cA = (const char*)g.A + (GATHER ? (size_t)0 : (size_t)cur.pm * tstepA); const char* cB = (const char*)g.Bt + (size_t)cur.bt * tstepB;
    if constexpr (GATHER) { PG8_TOK(vG, cur.pm); }
    S.a_ready(cur);
    PG8_STAGE(PG8_SB(0, 0), cB, voffB); PG8_STAGE(PG8_SB(0, 1), cB + hstepB, voffB); PG8_STAGE_A(PG8_SA(0, 0), cA, 0, false); PG8_STAGE_A(PG8_SA(0, 1), cA, 1, false);
    if (wr == 1) PG8_BAR;
    PG8_WAIT_V(2); PG8_BAR;
    PG8_STAGE(PG8_SB(1, 0), cB + kstep, voffB); PG8_STAGE_A(PG8_SA(1, 0), cA + kstep, 0, false); PG8_STAGE(PG8_SB(1, 1), cB + hstepB + kstep, voffB);
    PG8_WAIT_V(6); PG8_BAR;
    for (;;) {
        const bool has_next = S.next(ui + 1, nxt);
        const char* nA = has_next ? (const char*)g.A + (GATHER ? (size_t)0 : (size_t)nxt.pm * tstepA) : cA; const char* nB = has_next ? (const char*)g.Bt + (size_t)nxt.bt * tstepB : cB;
        if constexpr (GATHER) {
#pragma unroll
            for (int h_ = 0; h_ < 2; ++h_) { vN[h_][0] = vG[h_][0]; vN[h_][1] = vG[h_][1]; }
            if (has_next) {
#pragma unroll
                for (int i_ = 0; i_ < 2; ++i_) { int R_, C_; stage_rc(opq(tid) * 16 + i_ * 8192, R_, C_);
#pragma unroll
                    for (int h_ = 0; h_ < 2; ++h_) { const int* tp_ = g.tok + nxt.pm * 256 + h_ * 128 + R_;
                        asm volatile("global_load_dword %0, %1, off" : "=v"(vN[h_][i_]) : "v"(tp_) : "memory"); } } } }
        for (int t = 0; t < nt; t += 2) {
            const bool last = (t == nt - 2);
            const char* a1 = cA + (size_t)(t + 1) * kstep;
            const char* a2 = last ? nA : cA + (size_t)(t + 2) * kstep; const char* b2 = last ? nB : cB + (size_t)(t + 2) * kstep;
            const char* a3 = a2 + kstep; const char* b3 = b2 + kstep;
            if (last && has_next) S.a_ready(nxt);
            if constexpr (GATHER) { if (last && has_next) {
#pragma unroll
                for (int i_ = 0; i_ < 2; ++i_) { int R_, C_; stage_rc(opq(tid) * 16 + i_ * 8192, R_, C_);
#pragma unroll
                    for (int h_ = 0; h_ < 2; ++h_) { unsigned tk_ = vN[h_][i_]; asm volatile("" : "+v"(tk_)); tk_ = tk_ < (unsigned)g.M ? tk_ : 0u; vN[h_][i_] = tk_ * (unsigned)(lda * 2) + (unsigned)(C_ * 2); } } } }
            PG8_LDB(B0, 0, 0); PG8_LDB(B1, 0, 1); PG8_SCHED; PG8_LDA(At, 0, 0); PG8_STAGE_A(PG8_SA(1, 1), a1, 1, false);
            PG8_WAIT_V(8); PG8_WAIT_L(0); PG8_BAR; PG8_MMA(0, 0, At, B0); PG8_MMA(0, 1, At, B1); PG8_BAR; PG8_SCHED;
            PG8_LDA(At, 0, 1); PG8_STAGE(PG8_SB(0, 0), b2, voffB); PG8_STAGE(PG8_SB(0, 1), b2 + hstepB, voffB); PG8_STAGE_A(PG8_SA(0, 0), a2, 0, last);
            PG8_WAIT_V(8); PG8_WAIT_L(0); PG8_BAR; PG8_MMA(1, 0, At, B0); PG8_MMA(1, 1, At, B1); PG8_BAR; PG8_SCHED;
            PG8_LDB(B0, 1, 0); PG8_LDB(B1, 1, 1); PG8_SCHED; PG8_LDA(At, 1, 0); PG8_STAGE_A(PG8_SA(0, 1), a2, 1, last);
            PG8_WAIT_V(8); PG8_WAIT_L(0); PG8_BAR; PG8_MMA(0, 0, At, B0); PG8_MMA(0, 1, At, B1); PG8_BAR; PG8_SCHED;
            PG8_LDA(At, 1, 1); PG8_STAGE(PG8_SB(1, 0), b3, voffB); PG8_STAGE(PG8_SB(1, 1), b3 + hstepB, voffB); PG8_STAGE_A(PG8_SA(1, 0), a3, 0, last);
            PG8_WAIT_V(8); PG8_WAIT_L(0); PG8_BAR; PG8_MMA(1, 0, At, B0); PG8_MMA(1, 1, At, B1); PG8_BAR; PG8_SCHED;
            if constexpr (GSCALE) { if (t & 2) {
                const PG8_LAS float* cp = (const PG8_LAS float*)(lds + RING_BYTES) + ui * 2048 + (t >> 2) * 256 + wr * 64 + fr; float cv[2][4];
#pragma unroll
                for (int a = 0; a < 2; ++a)
#pragma unroll
                    for (int m = 0; m < 4; ++m) cv[a][m] = cp[a * 128 + m * 16];
#pragma unroll
                for (int a = 0; a < 2; ++a)
#pragma unroll
                    for (int b = 0; b < 2; ++b)
#pragma unroll
                        for (int m = 0; m < 4; ++m)
#pragma unroll
                            for (int n = 0; n < 2; ++n) acc[a][b][m][n] = acc[a][b][m][n] * cv[a][m];
                PG8_SCHED; } }
        }
        if (wr == 0) PG8_BAR;
        E(acc, cur, wr, wc, fr, fq); S.done(cur);
        if (!has_next) break;
#pragma unroll
        for (int a = 0; a < 2; ++a)
#pragma unroll
            for (int b = 0; b < 2; ++b)
#pragma unroll
                for (int m = 0; m < 4; ++m)
#pragma unroll
                    for (int n = 0; n < 2; ++n) acc[a][b][m][n] = (f32x4){0.f, 0.f, 0.f, 0.f};
        cur = nxt; cA = nA; cB = nB; ++ui;
        if constexpr (GATHER) {
#pragma unroll
            for (int h_ = 0; h_ < 2; ++h_) { vG[h_][0] = vN[h_][0]; vG[h_][1] = vN[h_][1]; } }
        if (wr == 1) PG8_BAR;
    }
    PG8_WAIT_V(0);
    PG8_BAR;
#undef PG8_SA
#undef PG8_SB
#undef PG8_STAGE
#undef PG8_STAGE_A
#undef PG8_TOK
#undef PG8_LDA
#undef PG8_LDB
#undef PG8_MMA
#undef PG8_WAIT_V
#undef PG8_WAIT_L
#undef PG8_BAR
#undef PG8_SCHED
}
#endif

struct EpiStoreBf16 {
    bf16_t* O; int ldc;
    __device__ __forceinline__ void operator()(const f32x4 (&acc)[2][2][4][2], const Unit& u, int wr, int wc, int fr, int fq) const {
        const int row0 = u.pm * 256 + wr * 64 + fr, col0 = u.pn * 256 + wc * 32 + 8 * fq;
#pragma unroll
        for (int ai = 0; ai < 2; ++ai)
#pragma unroll
            for (int m = 0; m < 4; ++m)
#pragma unroll
                for (int bj = 0; bj < 2; ++bj) { const f32x4 v0 = acc[ai][bj][m][0], v1 = acc[ai][bj][m][1];
                    u32x4 w; w.x = pk2(v0[0], v0[1]); w.y = pk2(v0[2], v0[3]); w.z = pk2(v1[0], v1[1]); w.w = pk2(v1[2], v1[3]);
                    *(u32x4*)(O + (size_t)(row0 + ai * 128 + m * 16) * ldc + col0 + bj * 128) = w; }
    }
};
template <int MODE> struct EpiGate {
    const bf16_t* Hg; bf16_t* MGb;
    __device__ __forceinline__ void operator()(const f32x4 (&acc)[2][2][4][2], const Unit& u, int wr, int wc, int fr, int fq) const {
        const int row0 = u.pm * 256 + wr * 64 + fr, col0 = u.pn * 256 + wc * 32 + 8 * fq;
#pragma unroll
        for (int ai = 0; ai < 2; ++ai) {
            u32x4 gw[4][2], pw[4][2];
#pragma unroll
            for (int m = 0; m < 4; ++m)
#pragma unroll
                for (int bj = 0; bj < 2; ++bj) { const int row = row0 + ai * 128 + m * 16, col = col0 + bj * 128;
                    gw[m][bj] = *(const u32x4*)(Hg + (size_t)row * DINP + col); if (MODE != 0) pw[m][bj] = *(const u32x4*)(MGb + (size_t)row * D + col); }
            asm volatile("" ::: "memory");
#pragma unroll
            for (int m = 0; m < 4; ++m)
#pragma unroll
                for (int bj = 0; bj < 2; ++bj) { const int row = row0 + ai * 128 + m * 16, col = col0 + bj * 128; const f32x4 v0 = acc[ai][bj][m][0], v1 = acc[ai][bj][m][1];
                    float g[8], p[8], v[8] = {v0[0], v0[1], v0[2], v0[3], v1[0], v1[1], v1[2], v1[3]}; unpack8(gw[m][bj], g);
                    if (MODE != 0) { unpack8(pw[m][bj], p);
#pragma unroll
                        for (int i = 0; i < 8; ++i) v[i] = p[i] + v[i] * fsigmoid(g[i]); }
                    else {
#pragma unroll
                        for (int i = 0; i < 8; ++i) v[i] = v[i] * fsigmoid(g[i]); }
                    *(u32x4*)(MGb + (size_t)row * D + col) = pack8(v); }
            asm volatile("" ::: "memory");
        }
    }
};
struct EpiResid {
    const float* xp; const float* xs; float* op; float* os;
    float* st;
    __device__ __forceinline__ void operator()(const f32x4 (&acc)[2][2][4][2], const Unit& u, int wr, int wc, int fr, int fq) const {
        const int row0 = u.pm * 256 + wr * 64 + fr, col0 = u.pn * 256 + wc * 32 + 8 * fq;
        const bool smp = u.pm * 256 >= NP;
        const float* xb = smp ? xs - (size_t)NP * D : xp; float* ob = smp ? os - (size_t)NP * D : op;
#pragma unroll
        for (int ai = 0; ai < 2; ++ai) {
            f32x4 xa[4][2][2];
#pragma unroll
            for (int m = 0; m < 4; ++m)
#pragma unroll
                for (int bj = 0; bj < 2; ++bj) { const float* xi = xb + (size_t)(row0 + ai * 128 + m * 16) * D + col0 + bj * 128; xa[m][bj][0] = *(const f32x4*)xi; xa[m][bj][1] = *(const f32x4*)(xi + 4); }
            asm volatile("" ::: "memory");
#pragma unroll
            for (int m = 0; m < 4; ++m) { float s1 = 0.f, s2 = 0.f;
#pragma unroll
                for (int bj = 0; bj < 2; ++bj) { float* xo = ob + (size_t)(row0 + ai * 128 + m * 16) * D + col0 + bj * 128;
                    const f32x4 o0 = xa[m][bj][0] * ALPHA + acc[ai][bj][m][0], o1 = xa[m][bj][1] * ALPHA + acc[ai][bj][m][1]; *(f32x4*)xo = o0; *(f32x4*)(xo + 4) = o1;
                    s1 += ((o0[0] + o0[1]) + (o0[2] + o0[3])) + ((o1[0] + o1[1]) + (o1[2] + o1[3])); s2 += ((o0[0] * o0[0] + o0[1] * o0[1]) + (o0[2] * o0[2] + o0[3] * o0[3])) + ((o1[0] * o1[0] + o1[1] * o1[1]) + (o1[2] * o1[2] + o1[3] * o1[3])); }
                s1 += xshfl<16>(s1); s1 += xshfl<32>(s1); s2 += xshfl<16>(s2); s2 += xshfl<32>(s2);
                if (fq == 0) { float* sp = st + (size_t)(row0 + ai * 128 + m * 16) * 32 + 2 * (u.pn * 4 + wc); sp[0] = s1; sp[1] = s2; } }
            asm volatile("" ::: "memory");
        }
    }
};
struct EpiSwiglu {
    bf16_t* ACT; const float* bup;
    __device__ __forceinline__ void operator()(const f32x4 (&acc)[2][2][4][2], const Unit& u, int wr, int wc, int fr, int fq) const {
        const int row0_ = u.pm * 256 + wr * 64 + fr, j0 = u.pn * 128 + wc * 32 + 8 * fq;
        const float* bg = bup + (size_t)u.e * 2048 + j0; const f32x4 bg0 = *(const f32x4*)bg, bg1 = *(const f32x4*)(bg + 4), bu0 = *(const f32x4*)(bg + 1024), bu1 = *(const f32x4*)(bg + 1028);
#pragma unroll
        for (int ai = 0; ai < 2; ++ai)
#pragma unroll
            for (int m = 0; m < 4; ++m) { const int row = row0_ + ai * 128 + m * 16;
                const f32x4 g0 = acc[ai][0][m][0] + bg0, g1 = acc[ai][0][m][1] + bg1, u0 = acc[ai][1][m][0] + bu0, u1 = acc[ai][1][m][1] + bu1; float o[8];
#pragma unroll
                for (int i = 0; i < 4; ++i) { const float ga = fminf(g0[i], SW_LIMIT), ua = fminf(fmaxf(u0[i], -SW_LIMIT), SW_LIMIT); o[i] = (ua + 1.0f) * ga * fsigmoid(SW_ALPHA * ga);
                    const float gb = fminf(g1[i], SW_LIMIT), ub = fminf(fmaxf(u1[i], -SW_LIMIT), SW_LIMIT); o[4 + i] = (ub + 1.0f) * gb * fsigmoid(SW_ALPHA * gb); }
                *(u32x4*)(ACT + (size_t)row * D + j0) = pack8(o); }
    }
};
struct EpiDown {
    bf16_t* O; const float* bdn; const float* gs;
    __device__ __forceinline__ void operator()(const f32x4 (&acc)[2][2][4][2], const Unit& u, int wr, int wc, int fr, int fq) const {
        const int row0 = u.pm * 256 + wr * 64 + fr, col0 = u.pn * 256 + wc * 32 + 8 * fq;
#pragma unroll
        for (int ai = 0; ai < 2; ++ai) {
            float gt[4];
#pragma unroll
            for (int m = 0; m < 4; ++m) gt[m] = gs[row0 + ai * 128 + m * 16];
#pragma unroll
            for (int bj = 0; bj < 2; ++bj) { const float* bp = bdn + (size_t)u.e * D + col0 + bj * 128; const f32x4 b0 = *(const f32x4*)bp, b1 = *(const f32x4*)(bp + 4);
#pragma unroll
                for (int m = 0; m < 4; ++m) { const f32x4 a0 = (acc[ai][bj][m][0] + b0) * gt[m], a1 = (acc[ai][bj][m][1] + b1) * gt[m];
                    u32x4 w; w.x = pk2(a0[0], a0[1]); w.y = pk2(a0[2], a0[3]); w.z = pk2(a1[0], a1[1]); w.w = pk2(a1[2], a1[3]);
                    *(u32x4*)(O + (size_t)(row0 + ai * 128 + m * 16) * D + col0 + bj * 128) = w; } }
            asm volatile("" ::: "memory");
        }
    }
};
}

#ifndef EMU
#define XB_TMO      128
#define XB_XCNT(j)  (256  + 64 * (j))
#define XB_XSUB(j)  (1280 + 64 * (j))
#define XB_XGEN(j)  (2304 + 64 * (j))
#define XB_TOP      3328
#define XB_TOPGEN   3392
#define XCD_BAR_WORDS 3456
#define XB_SPIN_CAP (1u << 27)
__device__ __forceinline__ unsigned xb_ld(unsigned* p)              { return __hip_atomic_load(p, __ATOMIC_RELAXED, __HIP_MEMORY_SCOPE_AGENT); }
__device__ __forceinline__ unsigned xb_add(unsigned* p, unsigned v) { return __hip_atomic_fetch_add(p, v, __ATOMIC_RELAXED, __HIP_MEMORY_SCOPE_AGENT); }
__device__ __forceinline__ unsigned xb_xcc_id() { return (unsigned)__builtin_amdgcn_s_getreg((3 << 11) | 20) & 0xFu; }
#define XB_SPIN(cond, bar) do { unsigned _sp = 0; while (cond) { __builtin_amdgcn_s_sleep(1); \
    if ((++_sp & 255u) == 0u) { if (xb_ld(&(bar)[XB_TMO])) break; if (_sp > XB_SPIN_CAP) { atomicAdd(&(bar)[XB_TMO], 1u); break; } } } } while (0)
struct XcdBarrier { unsigned* bar; unsigned x; volatile LAS unsigned* st; };
__device__ __forceinline__ XcdBarrier xcd_barrier_post(unsigned* bar, volatile LAS unsigned* st) {
    XcdBarrier b; b.bar = bar; b.x = xb_xcc_id(); b.st = st;
    if (threadIdx.x == 0) (void)xb_add(&bar[XB_XCNT(b.x)], 1u);
    return b;
}
__device__ __forceinline__ void xcd_barrier_complete(unsigned* bar, unsigned x, unsigned& nloc, unsigned& nx) {
    const unsigned G = gridDim.x * gridDim.y * gridDim.z;
    unsigned sum, cnt, mine, sp = 0u;
    for (;;) {
        sum = 0u; cnt = 0u; mine = 0u;
#pragma unroll
        for (unsigned j = 0; j < 16; ++j) { const unsigned c = xb_ld(&bar[XB_XCNT(j)]); sum += c; cnt += (c > 0u) ? 1u : 0u; mine = (j == x) ? c : mine; }
        if (sum == G) break;
        __builtin_amdgcn_s_sleep(1);
        if ((++sp & 255u) == 0u) { if (xb_ld(&bar[XB_TMO])) break; if (sp > XB_SPIN_CAP) { atomicAdd(&bar[XB_TMO], 1u); break; } }
    }
    nloc = mine > 0u ? mine : 1u; nx = cnt > 0u ? cnt : 1u;
}
__device__ __forceinline__ void xcd_barrier(const XcdBarrier& b) {
    asm volatile("s_waitcnt vmcnt(0)" ::: "memory");
    __syncthreads();
    if (threadIdx.x == 0) {
        unsigned* bar = b.bar;
        __builtin_amdgcn_s_waitcnt(0);
        unsigned nloc = b.st[0], nx = b.st[1];
        if (nloc == 0u) { xcd_barrier_complete(bar, b.x, nloc, nx); b.st[0] = nloc; b.st[1] = nx; }
        const unsigned old = xb_add(&bar[XB_XSUB(b.x)], 1u);
        const unsigned gen = old / nloc;
        if (old + 1u == (gen + 1u) * nloc) {
            __builtin_amdgcn_fence(__ATOMIC_RELEASE, "agent");
            asm volatile("s_waitcnt vmcnt(0)" ::: "memory");
            const unsigned og = xb_add(&bar[XB_TOP], 1u);
            const unsigned tg = og / nx;
            if (og + 1u == (tg + 1u) * nx) xb_add(&bar[XB_TOPGEN], 1u);
            else XB_SPIN(xb_ld(&bar[XB_TOPGEN]) == tg, bar);
            __builtin_amdgcn_fence(__ATOMIC_ACQUIRE, "agent");
            xb_add(&bar[XB_XGEN(b.x)], 1u);
            asm volatile("s_waitcnt vmcnt(0)" ::: "memory");
        } else {
            XB_SPIN(xb_ld(&bar[XB_XGEN(b.x)]) == gen, bar);
            __builtin_amdgcn_fence(__ATOMIC_ACQUIRE, "agent");
            asm volatile("s_waitcnt vmcnt(0)" ::: "memory");
        }
    }
    __syncthreads();
}
#endif

struct Args { const float* in[31]; float* out; unsigned char* ws; int lo, hi; };
typedef const float* FPtr;
#ifdef EMU
typedef const FPtr* ArgTab;
#else
typedef const __attribute__((address_space(4))) FPtr* ArgTab;
#endif
struct Frame {
    LAS unsigned char* lds; int tid, lane, wave, G, bid;
    ArgTab in; float* out; unsigned char* ws; unsigned* ctl;
};
enum { I_XP = 0, I_XS, I_CK, I_CV, I_SST, I_SCV, I_SSC, I_WIN, I_CONVW, I_CONVB, I_DTB, I_ALOG, I_SD, I_NORMW, I_WSSD, I_SINK, I_WATT, I_RELB, I_SCW, I_WSC, I_WO, I_LN1G, I_LN1B,
       I_RW, I_RB, I_WUP, I_BUP, I_WDN, I_BDN, I_LN2G, I_LN2B };

__device__ __forceinline__ bf16_t* ws_bf(const Frame& F, size_t off) { return (bf16_t*)(F.ws + off); }
__device__ __forceinline__ float* ws_f(const Frame& F, size_t off) { return (float*)(F.ws + off); }
__device__ __forceinline__ bf16_t* wl_ptr(const Frame& F, int layer, size_t off) { return (bf16_t*)(F.ws + WS_W + (size_t)layer * WL_BYTES + off); }

__device__ __forceinline__ void wt_item(const float* W, int ldw, int K, int k0, int nsrc0, const float* kscale, bf16_t* WT, int ndst0, LAS float* scr, int lane) {
    if (nsrc0 < 0) {
#pragma unroll
        for (int j = 0; j < 4; ++j) { const int n = (lane >> 3) + 8 * j; *(u32x4*)(WT + (size_t)(ndst0 + n) * K + k0 + 8 * (lane & 7)) = (u32x4){0u, 0u, 0u, 0u}; }
        return;
    }
#pragma unroll 8
    for (int i = 0; i < 32; ++i) { const int kk = 2 * i + (lane >> 5); float v = W[(size_t)(k0 + kk) * ldw + nsrc0 + (lane & 31)]; if (kscale) v *= kscale[k0 + kk]; scr[kk * 33 + (lane & 31)] = v; }
    WAVE_SYNC();
    const int c = lane & 7;
#pragma unroll
    for (int j = 0; j < 4; ++j) { const int n = (lane >> 3) + 8 * j; const LAS float* s = scr + (8 * c) * 33 + n;
        u32x4 o; o.x = pk2(s[0 * 33], s[1 * 33]); o.y = pk2(s[2 * 33], s[3 * 33]); o.z = pk2(s[4 * 33], s[5 * 33]); o.w = pk2(s[6 * 33], s[7 * 33]);
        *(u32x4*)(WT + (size_t)(ndst0 + n) * K + k0 + 8 * c) = o; }
    WAVE_SYNC();
}
__device__ __forceinline__ void step_weights(const Frame& F) {
    LAS float* scr = (LAS float*)(F.lds + F.wave * 16384);
    const int gw = F.bid * NWAVES + F.wave, NGW = F.G * NWAVES;
    constexpr int I_IN = (DINP / 32) * (D / 64), I_SSD = (D / 32) * (DINNER / 64), I_SQ = (D / 32) * (D / 64), I_UP = NEXP * (2048 / 32) * (D / 64), I_DN = NEXP * (D / 32) * (D / 64);
    constexpr int PER_LAYER = I_IN + I_SSD + 3 * I_SQ + I_UP + I_DN;
    for (int it = gw; it < DEPTH * PER_LAYER; it += NGW) {
        const int layer = it / PER_LAYER; int r = it % PER_LAYER;
        if (r < I_IN) { const int nb = r / (D / 64), kb = r % (D / 64), n0 = nb * 32;
            const int ns = n0 < 6144 ? n0 : (n0 < 13824 ? n0 + 32 : (n0 < 13856 ? n0 - 13824 + 6144 : -1));
            wt_item(F.in[I_WIN] + (size_t)layer * D * DIN, DIN, D, kb * 64, ns, nullptr, wl_ptr(F, layer, WL_IN), n0, scr, F.lane); continue; }
        r -= I_IN;
        if (r < I_SSD) { const int nb = r / (DINNER / 64), kb = r % (DINNER / 64);
            wt_item(F.in[I_WSSD] + (size_t)layer * DINNER * D, D, DINNER, kb * 64, nb * 32, F.in[I_NORMW] + (size_t)layer * DINNER, wl_ptr(F, layer, WL_SSD), nb * 32, scr, F.lane); continue; }
        r -= I_SSD;
        if (r < I_SQ) { const int nb = r / (D / 64), kb = r % (D / 64); wt_item(F.in[I_WATT] + (size_t)layer * D * D, D, D, kb * 64, nb * 32, nullptr, wl_ptr(F, layer, WL_ATT), nb * 32, scr, F.lane); continue; }
        r -= I_SQ;
        if (r < I_SQ) { const int nb = r / (D / 64), kb = r % (D / 64); wt_item(F.in[I_WSC] + (size_t)layer * D * D, D, D, kb * 64, nb * 32, nullptr, wl_ptr(F, layer, WL_SC), nb * 32, scr, F.lane); continue; }
        r -= I_SQ;
        if (r < I_SQ) { const int nb = r / (D / 64), kb = r % (D / 64); wt_item(F.in[I_WO] + (size_t)layer * D * D, D, D, kb * 64, nb * 32, nullptr, wl_ptr(F, layer, WL_O), nb * 32, scr, F.lane); continue; }
        r -= I_SQ;
        if (r < I_UP) { const int e = r / ((2048 / 32) * (D / 64)), q = r % ((2048 / 32) * (D / 64)), nb = q / (D / 64), kb = q % (D / 64), n0 = nb * 32;
            const int pn = n0 >> 8, bj = (n0 >> 7) & 1, jj = n0 & 127, ns = bj * 1024 + pn * 128 + jj;
            wt_item(F.in[I_WUP] + ((size_t)layer * NEXP + e) * D * 2048, 2048, D, kb * 64, ns, nullptr, wl_ptr(F, layer, WL_UP) + (size_t)e * 2048 * D, n0, scr, F.lane); continue; }
        r -= I_UP;
        { const int e = r / ((D / 32) * (D / 64)), q = r % ((D / 32) * (D / 64)), nb = q / (D / 64), kb = q % (D / 64);
            wt_item(F.in[I_WDN] + ((size_t)layer * NEXP + e) * D * D, D, D, kb * 64, nb * 32, nullptr, wl_ptr(F, layer, WL_DN) + (size_t)e * D * D, nb * 32, scr, F.lane); }
    }
}

__device__ __forceinline__ const float* x_in_row(const Frame& F, int layer, int mb, int r) {
    if (layer == 0) return r < NP ? F.in[I_XP] + ((size_t)mb * NP + r) * D : F.in[I_XS] + (size_t)(r - NP) * D;
    return r < NP ? F.out + O_YP + ((size_t)mb * NP + r) * D : F.out + O_YS + (size_t)(r - NP) * D;
}
__device__ __forceinline__ float* x_out_row(const Frame& F, int mb, int r) { return r < NP ? F.out + O_YP + ((size_t)mb * NP + r) * D : F.out + O_YS + (size_t)(r - NP) * D; }
__device__ __forceinline__ int rows_of(int mb) { return mb == 0 ? R : NP; }

__device__ __forceinline__ void step_xb(const Frame& F, int mb) {
    const int gw = F.bid * NWAVES + F.wave, NGW = F.G * NWAVES, nr = rows_of(mb);
    bf16_t* XB = ws_bf(F, WS_XB0) + (size_t)mb * R * D;
    for (int r = gw; r < nr; r += NGW) {
        const f32x4* xr = (const f32x4*)x_in_row(F, 0, mb, r) + F.lane; u32x2* o = (u32x2*)(XB + (size_t)r * D) + F.lane;
#pragma unroll
        for (int j = 0; j < 4; ++j) { const f32x4 v = xr[64 * j]; u32x2 w; w.x = pk2(v[0], v[1]); w.y = pk2(v[2], v[3]); o[64 * j] = w; }
    }
}

__device__ __forceinline__ float softplus_f(float x) { const float e = fexp(x); return x > 20.f ? x : (e < 0.01f ? e * (1.0f - e * (0.5f - e * 0.33333333f)) : __builtin_amdgcn_logf(1.0f + e) * 0.69314718056f); }
constexpr int S128 = 136, S64 = 72;
constexpr int BL_BM = 0, BL_CM = BL_BM + 64 * S128 * 2, BL_CB = BL_CM + 64 * S128 * 2, BL_END = BL_CB + 64 * S64 * 2;
struct BcRegs { u32x4 raw[7]; f32x4 wq[4][2], bq[2]; };
__device__ __forceinline__ void ssd_bc_load(const Frame& F, int layer, int u, BcRegs& R_) {
    const int sl = (u / NCHUNK) % NSEQ_MB, ck = u % NCHUNK, g = u / (NCHUNK * NSEQ_MB); const int tid = F.tid;
    const bf16_t* H = ws_bf(F, WS_H) + (size_t)sl * SEQ * DINP; const int cgi = tid & 31, rb = tid >> 5; const int xc = (cgi < 16 ? 2048 : 3072) + g * 128 + 8 * (cgi & 15);
#pragma unroll
    for (int i = 0; i < 7; ++i) { const int t = ck * 64 + 4 * rb - 3 + i; R_.raw[i] = t >= 0 ? *(const u32x4*)(H + (size_t)t * DINP + C_X + xc) : (u32x4){0u, 0u, 0u, 0u}; }
    const float* convw = F.in[I_CONVW] + (size_t)layer * 4 * CONVDIM + xc; const float* convb = F.in[I_CONVB] + (size_t)layer * CONVDIM + xc;
#pragma unroll
    for (int tp = 0; tp < 4; ++tp) { R_.wq[tp][0] = *(const f32x4*)(convw + tp * CONVDIM); R_.wq[tp][1] = *(const f32x4*)(convw + tp * CONVDIM + 4); }
    R_.bq[0] = *(const f32x4*)convb; R_.bq[1] = *(const f32x4*)(convb + 4);
}
__device__ __forceinline__ void ssd_bc_unit(const Frame& F, int u, const BcRegs& R_) {
    const int sl = (u / NCHUNK) % NSEQ_MB, ck = u % NCHUNK, g = u / (NCHUNK * NSEQ_MB);
    const int tid = F.tid, lane = F.lane, w = F.wave, fr = lane & 15, fq = lane >> 4;
    LAS bf16_t* Bm = (LAS bf16_t*)(F.lds + BL_BM); LAS bf16_t* Cm = (LAS bf16_t*)(F.lds + BL_CM); LAS bf16_t* CBs = (LAS bf16_t*)(F.lds + BL_CB);
    const size_t rowg = (size_t)sl * SEQ + (size_t)ck * 64; const size_t tix = ((size_t)sl * NCHUNK + ck) * 8 + g;
    const int cgi = tid & 31, rb = tid >> 5; const bool isB = cgi < 16; const int n0 = 8 * (cgi & 15);
    const u32x4 (&raw)[7] = R_.raw; const f32x4 (&wq)[4][2] = R_.wq; const f32x4 (&bq)[2] = R_.bq;
    __syncthreads();
    { float val[4][8];
#pragma unroll
      for (int r = 0; r < 4; ++r) { float a[8] = {bq[0][0], bq[0][1], bq[0][2], bq[0][3], bq[1][0], bq[1][1], bq[1][2], bq[1][3]};
#pragma unroll
          for (int tp = 0; tp < 4; ++tp) { float f[8]; unpack8(raw[r + tp], f);
#pragma unroll
              for (int i = 0; i < 4; ++i) { a[i] += f[i] * wq[tp][0][i]; a[4 + i] += f[4 + i] * wq[tp][1][i]; } }
#pragma unroll
          for (int i = 0; i < 8; ++i) val[r][i] = fsilu(a[i]); }
      if (isB) { bf16_t* bt = ws_bf(F, WS_BTG) + tix * 8192 + (size_t)n0 * 64 + 4 * rb;
#pragma unroll
          for (int r = 0; r < 4; ++r) *(LAS u32x4*)(Bm + (4 * rb + r) * S128 + n0) = pack8(val[r]);
#pragma unroll
          for (int i = 0; i < 8; ++i) { u32x2 wv; wv.x = pk2(val[0][i], val[1][i]); wv.y = pk2(val[2][i], val[3][i]); *(u32x2*)(bt + (size_t)i * 64) = wv; } }
      else { bf16_t* cmc = ws_bf(F, WS_CMC) + (rowg + 4 * rb) * 1024 + g * 128 + n0;
#pragma unroll
          for (int r = 0; r < 4; ++r) { const u32x4 pk = pack8(val[r]); *(LAS u32x4*)(Cm + (4 * rb + r) * S128 + n0) = pk; *(u32x4*)(cmc + (size_t)r * 1024) = pk; } } }
    __syncthreads();
    { const int ti = w >> 1;
#pragma unroll
      for (int jj = 0; jj < 2; ++jj) { const int tj = 2 * (w & 1) + jj; f32x4 cb = (f32x4){0.f, 0.f, 0.f, 0.f};
          if (tj <= ti) {
#pragma unroll
              for (int ks = 0; ks < 4; ++ks) { const bf16x8 a = *(const LAS bf16x8*)(Cm + (16 * ti + fr) * S128 + 32 * ks + 8 * fq); const bf16x8 b = *(const LAS bf16x8*)(Bm + (16 * tj + fr) * S128 + 32 * ks + 8 * fq);
                  cb = __builtin_amdgcn_mfma_f32_16x16x32_bf16(a, b, cb, 0, 0, 0); } }
#pragma unroll
          for (int r = 0; r < 4; ++r) CBs[(16 * ti + 4 * fq + r) * S64 + 16 * tj + fr] = bf1(cb[r]); } }
    __syncthreads();
    { const int row = tid >> 3, cc = tid & 7; *(u32x4*)(ws_bf(F, WS_CBG) + tix * 4096 + row * 64 + 8 * cc) = *(const LAS u32x4*)(CBs + row * S64 + 8 * cc); }
}

constexpr int SL_CM = 0, SL_BT = SL_CM + 64 * S128 * 2, SL_CB = SL_BT + 128 * S64 * 2, SL_DMA_SZ = SL_CB + 64 * S64 * 2, SL_DMA_END = 2 * SL_DMA_SZ;
constexpr int SL_XT = SL_DMA_END  , SL_XTW = SL_XT + 2 * 64 * S64 * 2, SL_MM = SL_XTW + 64 * S64 * 2, SL_SB = SL_MM + 64 * S64 * 2,
    SL_SM = SL_SB + 64 * S128 * 2, SL_END = SL_SM + 2 * 384 * 4;
static_assert(SL_END <= SCR_BYTES && SL_DMA_SZ == 2816 * 16, "ssd LDS map");
#ifdef EMU
#define SSD_DMA_ONE(gp_, dst_) memcpy((unsigned char*)(dst_) + lane * 16, (gp_), 16)
#else
#define SSD_DMA_ONE(gp_, dst_) __builtin_amdgcn_global_load_lds((const unsigned*)(gp_), (LAS unsigned*)(dst_), 16, 0, 0)
#endif
#define SSD_DMA_SETUP() do { _Pragma("unroll") for (int j_ = 0; j_ < 6; ++j_) { const int pc_ = w * 6 + j_; const int q_ = pc_ * 64 + lane; const size_t tx0_ = ((size_t)sl * NCHUNK) * 8 + g; \
        if (pc_ < 17) { const int r_ = q_ / 17; int c_ = q_ % 17; c_ = c_ < 16 ? c_ : 15; dsrc[j_] = cmc + (size_t)r_ * 1024 + 8 * c_; } \
        else if (pc_ < 35) { const int q2_ = q_ - 1088, r_ = q2_ / 9; int c_ = q2_ % 9; c_ = c_ < 8 ? c_ : 7; dsrc[j_] = btg + tx0_ * 8192 + r_ * 64 + 8 * c_; } \
        else { const int q3_ = q_ - 2240, r_ = q3_ / 9; int c_ = q3_ % 9; c_ = c_ < 8 ? c_ : 7; dsrc[j_] = cbg + tx0_ * 4096 + r_ * 64 + 8 * c_; } } } while (0)
#define SSD_DMA(ck_) do { _Pragma("unroll") for (int j_ = 0; j_ < 6; ++j_) { const int pc_ = w * 6 + j_; if (pc_ < 44) { \
        SSD_DMA_ONE(dsrc[j_], L + ((ck_) & 1) * SL_DMA_SZ + SL_CM + pc_ * 1024); dsrc[j_] += pc_ < 17 ? (size_t)64 * 1024 : (pc_ < 35 ? (size_t)8 * 8192 : (size_t)8 * 4096); } } } while (0)
#define SSD_LOAD_X(ck_) do { _Pragma("unroll") for (int i = 0; i < 11; ++i) { const int t_ = (ck_) * 64 + 8 * w - 3 + i; rawx[i] = t_ >= 0 ? (unsigned)H[(size_t)t_ * DINP + C_X + hd * 64 + lane] : 0u; } } while (0)
#define SSD_LOAD_XN(ck_) do { const bf16_t* px_ = H + ((size_t)(ck_) * 64 + 8 * w - 3) * DINP + C_X + hd * 64 + lane; _Pragma("unroll") for (int i = 0; i < 11; ++i) rawx[i] = (unsigned)px_[(size_t)i * DINP]; } while (0)
#define SSD_TABLE(tb_, dtr_) do { const float dt_ = softplus_f(bf2f(dtr_) + dtb); \
        float cs_ = Ah * dt_; _Pragma("unroll") for (int o = 1; o < 64; o <<= 1) { const float t2_ = __shfl(cs_, lane - o < 0 ? 0 : lane - o); if (lane >= o) cs_ += t2_; } \
        const float tot_ = __shfl(cs_, 63); (tb_)[lane] = dt_; (tb_)[64 + lane] = cs_; (tb_)[128 + lane] = fexp(tot_ - cs_); (tb_)[192 + lane] = fexp(cs_); if (lane == 0) (tb_)[256] = fexp(tot_); } while (0)

__device__ __forceinline__ void ssd_prompt_unit(const Frame& F, int layer, int mb, int sl, int hd) {
    const int tid = F.tid, lane = F.lane, w = F.wave, fr = lane & 15, fq = lane >> 4;
    LAS unsigned char* L = F.lds;
    LAS bf16_t* XT0 = (LAS bf16_t*)(L + SL_XT);
    LAS bf16_t* XTW = (LAS bf16_t*)(L + SL_XTW); LAS bf16_t* Mm = (LAS bf16_t*)(L + SL_MM); LAS bf16_t* Sb = (LAS bf16_t*)(L + SL_SB);
    LAS float* smb = (LAS float*)(L + SL_SM);
    const int g = hd >> 2;
    bf16_t* H = ws_bf(F, WS_H) + (size_t)sl * SEQ * DINP;
    const bf16_t* cmc = ws_bf(F, WS_CMC) + (size_t)sl * SEQ * 1024 + g * 128; const bf16_t* btg = ws_bf(F, WS_BTG); const bf16_t* cbg = ws_bf(F, WS_CBG);
    const float* convw = F.in[I_CONVW] + (size_t)layer * 4 * CONVDIM + hd * 64; const float* convb = F.in[I_CONVB] + (size_t)layer * CONVDIM + hd * 64;
    const float cw0 = convw[lane], cw1 = convw[CONVDIM + lane], cw2 = convw[2 * CONVDIM + lane], cw3 = convw[3 * CONVDIM + lane], cwb = convb[lane];
    __syncthreads();
    const float dtb = F.in[I_DTB][layer * 32 + hd], Ah = -fexp(F.in[I_ALOG][layer * 32 + hd]), Dh = F.in[I_SD][layer * 32 + hd];
    const int xl = tid >> 3, xcg = tid & 7;
    f32x4 S[4];
#pragma unroll
    for (int j = 0; j < 4; ++j) S[j] = (f32x4){0.f, 0.f, 0.f, 0.f};
    const int ti = w >> 1, tj0 = 2 * (w & 1);
    const int pi = w & 3, nb = w >> 2;
    bf16_t* pz = H + (size_t)(16 * ti + fr) * DINP + C_Z + hd * 64 + 16 * tj0 + 4 * fq; float* pss = ws_f(F, WS_SSQ) + ((size_t)sl * SEQ + 16 * ti + fr) * 64 + hd * 2 + (w & 1);
    unsigned rawx[11]; u32x2 zraw[2]; unsigned dtr_next;
    const bf16_t* dsrc[6]; SSD_DMA_SETUP();
    SSD_DMA(0); SSD_LOAD_X(0);
    zraw[0] = *(const u32x2*)pz; zraw[1] = *(const u32x2*)(pz + 16);
    { const unsigned d0 = H[(size_t)lane * DINP + C_DT + hd]; dtr_next = H[(size_t)(64 + lane) * DINP + C_DT + hd]; if (w == 7) { SSD_TABLE(smb, d0); smb[320 + lane] = Dh * __builtin_amdgcn_rcpf(smb[lane]); } }
    VM_WAIT(0);
    __syncthreads();
    for (int ck = 0; ck < NCHUNK; ++ck) {
        LAS float* sm = smb + (ck & 1) * 384; LAS float* smn = smb + ((ck + 1) & 1) * 384; LAS bf16_t* XT = XT0 + (ck & 1) * 64 * S64;
        LAS unsigned char* Ld = L + (ck & 1) * SL_DMA_SZ; LAS bf16_t* Cm = (LAS bf16_t*)(Ld + SL_CM); LAS bf16_t* BT = (LAS bf16_t*)(Ld + SL_BT); LAS bf16_t* CBl = (LAS bf16_t*)(Ld + SL_CB);
        { const f32x4 d0 = *(const LAS f32x4*)(sm + 8 * w), d1 = *(const LAS f32x4*)(sm + 8 * w + 4), e0 = *(const LAS f32x4*)(sm + 128 + 8 * w), e1 = *(const LAS f32x4*)(sm + 128 + 8 * w + 4);
          const float dtv[8] = {d0[0], d0[1], d0[2], d0[3], d1[0], d1[1], d1[2], d1[3]}, wdv[8] = {e0[0], e0[1], e0[2], e0[3], e1[0], e1[1], e1[2], e1[3]}; float xr[11], xa[8], xb[8];
#pragma unroll
          for (int i = 0; i < 11; ++i) xr[i] = blo(rawx[i]);
#pragma unroll
          for (int r = 0; r < 8; ++r) { const float xd = fsilu(cwb + xr[r] * cw0 + xr[r + 1] * cw1 + xr[r + 2] * cw2 + xr[r + 3] * cw3) * dtv[r]; xa[r] = xd; xb[r] = xd * wdv[r]; }
          *(LAS u32x4*)(XT + lane * S64 + 8 * w) = pack8(xa); *(LAS u32x4*)(XTW + lane * S64 + 8 * w) = pack8(xb); }
#pragma unroll
        for (int jj = 0; jj < 4; ++jj) { u32x2 wv; wv.x = pk2(S[jj][0], S[jj][1]); wv.y = pk2(S[jj][2], S[jj][3]); *(LAS u32x2*)(Sb + (16 * pi + fr) * S128 + 64 * nb + 16 * jj + 4 * fq) = wv; }
        if (ck > 0) VM_WAIT(2);
        LBAR();
        const u32x2 z0 = zraw[0], z1 = zraw[1]; const unsigned dtr_cur = dtr_next;
        if (ck + 1 < NCHUNK) SSD_DMA(ck + 1);
        if (ck + 1 < NCHUNK) { SSD_LOAD_XN(ck + 1); zraw[0] = *(const u32x2*)(pz + (size_t)64 * DINP); zraw[1] = *(const u32x2*)(pz + (size_t)64 * DINP + 16);
            dtr_next = H[((size_t)ck * 64 + (ck + 2 < NCHUNK ? 128 : 64) + lane) * DINP + C_DT + hd]; }
        asm volatile("" ::: "memory");
        if (w == 7 && ck + 1 < NCHUNK) { SSD_TABLE(smn, dtr_cur); smn[320 + lane] = Dh * __builtin_amdgcn_rcpf(smn[lane]); }
        { const int s0 = 8 * xcg; float mv[8];
          if (s0 <= xl) { float cbv[8]; unpack8(*(const LAS u32x4*)(CBl + xl * S64 + s0), cbv); const float al = sm[64 + xl]; const f32x4 a0 = *(const LAS f32x4*)(sm + 64 + s0), a1 = *(const LAS f32x4*)(sm + 64 + s0 + 4);
#pragma unroll
              for (int i = 0; i < 4; ++i) { mv[i] = (xl >= s0 + i) ? cbv[i] * fexp(fminf(al - a0[i], 0.f)) : 0.f; mv[4 + i] = (xl >= s0 + 4 + i) ? cbv[4 + i] * fexp(fminf(al - a1[i], 0.f)) : 0.f; }
              if ((xl >> 3) == xcg) { const float dd = sm[320 + xl];
#pragma unroll
                  for (int i = 0; i < 8; ++i) if (i == (xl & 7)) mv[i] += dd; } }
          else {
#pragma unroll
              for (int i = 0; i < 8; ++i) mv[i] = 0.f; }
          *(LAS u32x4*)(Mm + xl * S64 + s0) = pack8(mv); }
        f32x4 yo[2];
#pragma unroll
        for (int jj = 0; jj < 2; ++jj) { const int tj = tj0 + jj; yo[jj] = (f32x4){0.f, 0.f, 0.f, 0.f};
#pragma unroll
            for (int ks = 0; ks < 4; ++ks) { const bf16x8 sb = *(const LAS bf16x8*)(Sb + (16 * tj + fr) * S128 + 32 * ks + 8 * fq); const bf16x8 c = *(const LAS bf16x8*)(Cm + (16 * ti + fr) * S128 + 32 * ks + 8 * fq);
                yo[jj] = __builtin_amdgcn_mfma_f32_16x16x32_bf16(sb, c, yo[jj], 0, 0, 0); } }
        { const float cd = sm[256];
#pragma unroll
          for (int jj = 0; jj < 4; ++jj) { S[jj] = S[jj] * cd;
#pragma unroll
            for (int ks = 0; ks < 2; ++ks) { const bf16x8 a = *(const LAS bf16x8*)(BT + (64 * nb + 16 * jj + fr) * S64 + 32 * ks + 8 * fq); const bf16x8 b = *(const LAS bf16x8*)(XTW + (16 * pi + fr) * S64 + 32 * ks + 8 * fq);
                S[jj] = __builtin_amdgcn_mfma_f32_16x16x32_bf16(a, b, S[jj], 0, 0, 0); }
            if (jj & 1) asm volatile("" ::: "memory"); } }
        const float ec = sm[192 + 16 * ti + fr];
        LBAR();
        { float ss = 0.f; const u32x2 zz[2] = {z0, z1};
#pragma unroll
          for (int jj = 0; jj < 2; ++jj) { const int tj = tj0 + jj; f32x4 yd = (f32x4){0.f, 0.f, 0.f, 0.f};
#pragma unroll
              for (int ks = 0; ks < 2; ++ks) { const bf16x8 a = *(const LAS bf16x8*)(XT + (16 * tj + fr) * S64 + 32 * ks + 8 * fq); const bf16x8 b = *(const LAS bf16x8*)(Mm + (16 * ti + fr) * S64 + 32 * ks + 8 * fq);
                  yd = __builtin_amdgcn_mfma_f32_16x16x32_bf16(a, b, yd, 0, 0, 0); }
              const float z[4] = {blo(zz[jj].x), bhi(zz[jj].x), blo(zz[jj].y), bhi(zz[jj].y)}; float v[4];
#pragma unroll
              for (int r = 0; r < 4; ++r) { v[r] = (yd[r] + ec * yo[jj][r]) * fsilu(z[r]); ss += v[r] * v[r]; }
              u32x2 ov; ov.x = pk2(v[0], v[1]); ov.y = pk2(v[2], v[3]); *(u32x2*)(pz + 16 * jj) = ov; }
          ss += __shfl_xor(ss, 16); ss += __shfl_xor(ss, 32);
          if (fq == 0) *pss = ss;
          pz += (size_t)64 * DINP; pss += 64 * 64; }
    }
    float* so = F.out + O_SSP + ((((size_t)layer * BATCH + mb * NSEQ_MB + sl) * 32 + hd) * 64) * 128;
#pragma unroll
    for (int jj = 0; jj < 4; ++jj) *(f32x4*)(so + (size_t)(16 * pi + fr) * 128 + 64 * nb + 16 * jj + 4 * fq) = S[jj];
    VM_WAIT(0); __syncthreads();
}

__device__ __forceinline__ void ssd_sample_unit(const Frame& F, int layer, int sq, int hd) {
    const int tid = F.tid, lane = F.lane; LAS float* L = (LAS float*)F.lds;
    LAS float* xs = L; LAS float* Bs = L + 16 * 64; LAS float* Cs = Bs + 16 * 128; LAS float* dts = Cs + 16 * 128; LAS float* das = dts + 16; LAS float* Yl = das + 16;
    const int g = hd >> 2;
    bf16_t* H = ws_bf(F, WS_H) + (size_t)(NP + sq * 16) * DINP;
    const float* hist = F.in[I_SCV] + ((size_t)layer * DECB + sq) * 3 * CONVDIM;
    const float* convw = F.in[I_CONVW] + (size_t)layer * 4 * CONVDIM; const float* convb = F.in[I_CONVB] + (size_t)layer * CONVDIM;
    __syncthreads();
    if (tid < 320) { const int c = tid; const int xc = c < 64 ? hd * 64 + c : (c < 192 ? 2048 + g * 128 + (c - 64) : 3072 + g * 128 + (c - 192));
        float win[19];
#pragma unroll
        for (int i = 0; i < 3; ++i) win[i] = hist[i * CONVDIM + xc];
#pragma unroll
        for (int t = 0; t < 16; ++t) win[3 + t] = bf2f(H[(size_t)t * DINP + C_X + xc]);
        const float w0 = convw[xc], w1 = convw[CONVDIM + xc], w2 = convw[2 * CONVDIM + xc], w3 = convw[3 * CONVDIM + xc], bb = convb[xc];
#pragma unroll
        for (int t = 0; t < 16; ++t) { const float a = fsilu(bb + win[t] * w0 + win[t + 1] * w1 + win[t + 2] * w2 + win[t + 3] * w3);
            if (c < 64) xs[t * 64 + c] = a; else if (c < 192) Bs[t * 128 + c - 64] = a; else Cs[t * 128 + c - 192] = a; } }
    if (tid < 16) { const float dt = softplus_f(bf2f(H[(size_t)tid * DINP + C_DT + hd]) + F.in[I_DTB][layer * 32 + hd]); dts[tid] = dt; das[tid] = fexp(-fexp(F.in[I_ALOG][layer * 32 + hd]) * dt); }
    __syncthreads();
    const int p = tid >> 3, n0 = (tid & 7) * 16;
    const size_t sbase = ((((size_t)layer * DECB + sq) * 32 + hd) * 64 + p) * 128 + n0;
    float S[16];
#pragma unroll
    for (int i = 0; i < 16; ++i) S[i] = F.in[I_SST][sbase + i];
    for (int t = 0; t < 16; ++t) { const float dec = das[t], xv = xs[t * 64 + p] * dts[t]; float part = 0.f;
#pragma unroll
        for (int i = 0; i < 16; ++i) { S[i] = S[i] * dec + xv * Bs[t * 128 + n0 + i]; part += Cs[t * 128 + n0 + i] * S[i]; }
        part += __shfl_xor(part, 1); part += __shfl_xor(part, 2); part += __shfl_xor(part, 4);
        if ((tid & 7) == 0) Yl[t * 64 + p] = part; }
#pragma unroll
    for (int i = 0; i < 16; ++i) F.out[O_SSS + sbase + i] = S[i];
    __syncthreads();
    const float Dh = F.in[I_SD][layer * 32 + hd];
#pragma unroll
    for (int j = 0; j < 2; ++j) { const int it = tid + 512 * j, t = it >> 6, pp = it & 63;
        const float z = bf2f(H[(size_t)t * DINP + C_Z + hd * 64 + pp]); const float v = (Yl[t * 64 + pp] + Dh * xs[t * 64 + pp]) * fsilu(z);
        H[(size_t)t * DINP + C_Z + hd * 64 + pp] = bf1(v);
        const float ss = wave_sum(v * v);
        if (lane < 2) ws_f(F, WS_SSQ)[((size_t)NP + sq * 16 + t) * 64 + hd * 2 + lane] = lane == 0 ? ss : 0.f; }
}

__device__ __forceinline__ int t5_bucket(int rel) {
    const int n = rel < 0 ? -rel : rel; const int b = rel > 0 ? 16 : 0;
    if (n < 8) return b + n;
    int v = 8; v += n >= 12; v += n >= 16; v += n >= 23; v += n >= 32; v += n >= 46; v += n >= 64; v += n >= 91;
    return b + v;
}
constexpr int AK_P = 72, AV_P = 200;
constexpr int AL_K = 0, AL_VT = AL_K + 192 * AK_P * 2, AL_LUT = AL_VT + 64 * AV_P * 2, AL_END = AL_LUT + 4 * 256 * 4;
static_assert(AL_END <= RING_BYTES, "attention LDS map");
__device__ __forceinline__ void attn_prompt_unit(const Frame& F, int layer, int sl, int ck, int kh) {
    const int tid = F.tid, lane = F.lane, w = F.wave, q32 = lane & 31, hi = lane >> 5;
    LAS bf16_t* Kl = (LAS bf16_t*)(F.lds + AL_K); LAS bf16_t* VT = (LAS bf16_t*)(F.lds + AL_VT); LAS float* lut = (LAS float*)(F.lds + AL_LUT);
    bf16_t* H = ws_bf(F, WS_H) + (size_t)sl * SEQ * DINP;
    const int gq = w >> 1, qh = w & 1, head = kh * 4 + gq;
    const size_t qrow = (size_t)ck * 64 + 32 * qh + q32;
    bf16x8 qf[4];
#pragma unroll
    for (int ds = 0; ds < 4; ++ds) qf[ds] = *(const bf16x8*)(H + qrow * DINP + C_Q + head * 64 + 16 * ds + 8 * hi);
    __syncthreads();
#pragma unroll
    for (int j = 0; j < 3; ++j) { const int id = tid + 512 * j, key = id >> 3, cg = id & 7; const int t = 64 * (ck - 2) + key;
        u32x4 kv = (u32x4){0u, 0u, 0u, 0u}, vv = kv;
        if (t >= 0) { kv = *(const u32x4*)(H + (size_t)t * DINP + C_K + kh * 64 + 8 * cg); vv = *(const u32x4*)(H + (size_t)t * DINP + C_V + kh * 64 + 8 * cg); }
        *(LAS u32x4*)(Kl + key * AK_P + 8 * cg) = kv;
        VT[(8 * cg + 0) * AV_P + key] = (bf16_t)(vv.x & 0xffffu); VT[(8 * cg + 1) * AV_P + key] = (bf16_t)(vv.x >> 16); VT[(8 * cg + 2) * AV_P + key] = (bf16_t)(vv.y & 0xffffu); VT[(8 * cg + 3) * AV_P + key] = (bf16_t)(vv.y >> 16);
        VT[(8 * cg + 4) * AV_P + key] = (bf16_t)(vv.z & 0xffffu); VT[(8 * cg + 5) * AV_P + key] = (bf16_t)(vv.z >> 16); VT[(8 * cg + 6) * AV_P + key] = (bf16_t)(vv.w & 0xffffu); VT[(8 * cg + 7) * AV_P + key] = (bf16_t)(vv.w >> 16); }
    for (int e = tid; e < 4 * 255; e += NTHREADS) { const int gg = e / 255, idx = e % 255; lut[gg * 256 + idx] = F.in[I_RELB][t5_bucket(idx - 191) * 16 + kh * 4 + gg]; }
    __syncthreads();
    f32x16 sc[6];
#pragma unroll
    for (int kt = 0; kt < 6; ++kt) {
#pragma unroll
        for (int r = 0; r < 16; ++r) sc[kt][r] = 0.f;
#pragma unroll
        for (int ds = 0; ds < 4; ++ds) { const bf16x8 a = *(const LAS bf16x8*)(Kl + (32 * kt + q32) * AK_P + 16 * ds + 8 * hi); sc[kt] = __builtin_amdgcn_mfma_f32_32x32x16_bf16(a, qf[ds], sc[kt], 0, 0, 0); } }
    const int qidx = 32 * qh + q32; const float sink = F.in[I_SINK][layer * 16 + head];
    float mx = -3.0e38f;
#pragma unroll
    for (int kt = 0; kt < 6; ++kt)
#pragma unroll
        for (int r = 0; r < 16; ++r) { const int key = 32 * kt + (r & 3) + 8 * (r >> 2) + 4 * hi; const int rel = key - 128 - qidx;
            float s = sc[kt][r] * 0.125f + lut[gq * 256 + rel + 191]; if (ck < 2 && 64 * ck + key - 128 < 0) s = -1e30f; sc[kt][r] = s; mx = fmaxf(mx, s); }
    mx = fmaxf(mx, __shfl_xor(mx, 32)); mx = fmaxf(mx, sink);
    float sum = 0.f;
#pragma unroll
    for (int kt = 0; kt < 6; ++kt)
#pragma unroll
        for (int r = 0; r < 16; ++r) { const float e = fexp(sc[kt][r] - mx); sc[kt][r] = e; sum += e; }
    sum += __shfl_xor(sum, 32);
    const float inv = 1.0f / (sum + fexp(sink - mx));
    f32x16 o[2];
#pragma unroll
    for (int d2 = 0; d2 < 2; ++d2)
#pragma unroll
        for (int r = 0; r < 16; ++r) o[d2][r] = 0.f;
#pragma unroll
    for (int kt = 0; kt < 6; ++kt)
#pragma unroll
        for (int s = 0; s < 2; ++s) {
            u32x4 pw; pw.x = pk2(sc[kt][8 * s + 0], sc[kt][8 * s + 1]); pw.y = pk2(sc[kt][8 * s + 2], sc[kt][8 * s + 3]); pw.z = pk2(sc[kt][8 * s + 4], sc[kt][8 * s + 5]); pw.w = pk2(sc[kt][8 * s + 6], sc[kt][8 * s + 7]);
            const bf16x8 pa = __builtin_bit_cast(bf16x8, pw);
#pragma unroll
            for (int d2 = 0; d2 < 2; ++d2) { const LAS bf16_t* vp = VT + (32 * d2 + q32) * AV_P + 32 * kt + 16 * s + 4 * hi;
                const u32x2 lo = *(const LAS u32x2*)vp, hh = *(const LAS u32x2*)(vp + 8); u32x4 vw; vw.x = lo.x; vw.y = lo.y; vw.z = hh.x; vw.w = hh.y;
                o[d2] = __builtin_amdgcn_mfma_f32_32x32x16_bf16(pa, __builtin_bit_cast(bf16x8, vw), o[d2], 0, 0, 0); } }
#pragma unroll
    for (int r = 0; r < 16; ++r) { const int q = (r & 3) + 8 * (r >> 2) + 4 * hi; const float iv = __shfl(inv, q);
        bf16_t* op = H + ((size_t)ck * 64 + 32 * qh + q) * DINP + C_Q + head * 64 + q32;
        op[0] = bf1(o[0][r] * iv); op[32] = bf1(o[1][r] * iv); }
}
__device__ __forceinline__ void attn_sample_unit(const Frame& F, int layer, int sq, int kh) {
    const int tid = F.tid; LAS float* L = (LAS float*)F.lds;
    LAS float* Kf = L; LAS float* Vf = Kf + 144 * 65; LAS float* Qf = Vf + 144 * 64; LAS float* P = Qf + 64 * 65; LAS float* Pinv = P + 64 * 145;
    static_assert((144 * 65 + 144 * 64 + 64 * 65 + 64 * 145 + 64) * 4 <= RING_BYTES, "sample attention LDS map");
    bf16_t* H = ws_bf(F, WS_H) + (size_t)(NP + sq * 16) * DINP;
    const float* ck = F.in[I_CK] + ((size_t)layer * DECB + sq) * WINDOW * 256; const float* cv = F.in[I_CV] + ((size_t)layer * DECB + sq) * WINDOW * 256;
    __syncthreads();
    for (int i = tid; i < 144 * 64; i += NTHREADS) { const int key = i >> 6, d = i & 63;
        Kf[key * 65 + d] = key < 128 ? ck[(size_t)key * 256 + kh * 64 + d] : bf2f(H[(size_t)(key - 128) * DINP + C_K + kh * 64 + d]);
        Vf[key * 64 + d] = key < 128 ? cv[(size_t)key * 256 + kh * 64 + d] : bf2f(H[(size_t)(key - 128) * DINP + C_V + kh * 64 + d]); }
    for (int i = tid; i < 64 * 64; i += NTHREADS) { const int row = i >> 6, d = i & 63; Qf[row * 65 + d] = bf2f(H[(size_t)(row & 15) * DINP + C_Q + (kh * 4 + (row >> 4)) * 64 + d]); }
    __syncthreads();
    for (int i = tid; i < 64 * 144; i += NTHREADS) { const int row = i / 144, key = i % 144; float s = 0.f;
        for (int d = 0; d < 64; ++d) s += Qf[row * 65 + d] * Kf[key * 65 + d];
        P[row * 145 + key] = s * 0.125f + F.in[I_RELB][t5_bucket(key - 128 - (row & 15)) * 16 + kh * 4 + (row >> 4)]; }
    __syncthreads();
    { const int row = tid >> 3, sub = tid & 7; const float sink = F.in[I_SINK][layer * 16 + kh * 4 + (row >> 4)]; float mx = -3.0e38f;
      for (int k = sub; k < 144; k += 8) mx = fmaxf(mx, P[row * 145 + k]);
      mx = fmaxf(mx, __shfl_xor(mx, 1)); mx = fmaxf(mx, __shfl_xor(mx, 2)); mx = fmaxf(mx, __shfl_xor(mx, 4)); mx = fmaxf(mx, sink);
      float sum = 0.f;
      for (int k = sub; k < 144; k += 8) { const float e = fexp(P[row * 145 + k] - mx); P[row * 145 + k] = e; sum += e; }
      sum += __shfl_xor(sum, 1); sum += __shfl_xor(sum, 2); sum += __shfl_xor(sum, 4);
      if (sub == 0) Pinv[row] = 1.0f / (sum + fexp(sink - mx)); }
    __syncthreads();
    { const int row = tid >> 3, d0 = (tid & 7) * 8; float o[8] = {0.f, 0.f, 0.f, 0.f, 0.f, 0.f, 0.f, 0.f};
      for (int k = 0; k < 144; ++k) { const float pv = P[row * 145 + k];
#pragma unroll
          for (int i = 0; i < 8; ++i) o[i] += pv * Vf[k * 64 + d0 + i]; }
      const float iv = Pinv[row];
#pragma unroll
      for (int i = 0; i < 8; ++i) o[i] *= iv;
      *(u32x4*)(H + (size_t)(row & 15) * DINP + C_Q + (kh * 4 + (row >> 4)) * 64 + d0) = pack8(o); }
}
__device__ __forceinline__ void sc_unit(const Frame& F, int layer, int tile) {
    const int tid = F.tid, cg = tid & 127, rs = tid >> 7; bf16_t* H = ws_bf(F, WS_H);
    const float* wsc = F.in[I_SCW] + (size_t)layer * 3 * D + 8 * cg; float wt[3][8];
#pragma unroll
    for (int i = 0; i < 3; ++i)
#pragma unroll
        for (int c = 0; c < 8; ++c) wt[i][c] = wsc[i * D + c];
    const int row0 = tile * 64 + 16 * rs; const bool smp = row0 >= NP; const int tt0 = smp ? 0 : row0 % SEQ;
    float u1[8], u2[8];
    if (tt0 >= 2) { float c8[8], h8[8];
        unpack8(*(const u32x4*)(H + (size_t)(row0 - 2) * DINP + C_SCC + 8 * cg), c8); unpack8(*(const u32x4*)(H + (size_t)(row0 - 2) * DINP + C_SCH + 8 * cg), h8);
#pragma unroll
        for (int c = 0; c < 8; ++c) u2[c] = c8[c] * h8[c];
        unpack8(*(const u32x4*)(H + (size_t)(row0 - 1) * DINP + C_SCC + 8 * cg), c8); unpack8(*(const u32x4*)(H + (size_t)(row0 - 1) * DINP + C_SCH + 8 * cg), h8);
#pragma unroll
        for (int c = 0; c < 8; ++c) u1[c] = c8[c] * h8[c]; }
    else if (smp) { const float* hp = F.in[I_SSC] + (((size_t)layer * DECB + ((row0 - NP) >> 4)) * 2) * D + 8 * cg;
#pragma unroll
        for (int c = 0; c < 8; ++c) { u2[c] = hp[c]; u1[c] = hp[D + c]; } }
    else {
#pragma unroll
        for (int c = 0; c < 8; ++c) { u2[c] = 0.f; u1[c] = 0.f; } }
#pragma unroll 1
    for (int q = 0; q < 4; ++q) {
        u32x4 cw_[4], hw_[4], bw_[4];
#pragma unroll
        for (int i = 0; i < 4; ++i) { const bf16_t* hp = H + (size_t)(row0 + 4 * q + i) * DINP + 8 * cg; cw_[i] = *(const u32x4*)(hp + C_SCC); hw_[i] = *(const u32x4*)(hp + C_SCH); bw_[i] = *(const u32x4*)(hp + C_SCB); }
        asm volatile("" ::: "memory");
#pragma unroll
        for (int i = 0; i < 4; ++i) { float c8[8], h8[8], b8[8], a[8]; unpack8(cw_[i], c8); unpack8(hw_[i], h8); unpack8(bw_[i], b8);
#pragma unroll
            for (int c = 0; c < 8; ++c) { const float u0 = c8[c] * h8[c]; a[c] = (u2[c] * wt[0][c] + u1[c] * wt[1][c] + u0 * wt[2][c]) * b8[c]; u2[c] = u1[c]; u1[c] = u0; }
            *(u32x4*)(H + (size_t)(row0 + 4 * q + i) * DINP + C_SCB + 8 * cg) = pack8(a); }
    }
}
__device__ __forceinline__ void state_out_unit(const Frame& F, int layer, int mb, int sl, bool smp) {
    const int tid = F.tid; const bf16_t* H = ws_bf(F, WS_H);
    const int nkv = smp ? DECS : WINDOW, len = smp ? DECS : SEQ; const size_t row0 = smp ? (size_t)NP + sl * 16 : (size_t)sl * SEQ; const int sg = smp ? sl : mb * NSEQ_MB + sl;
    const size_t nb_ = smp ? DECB : BATCH;
    float* ko = F.out + (smp ? O_KS : O_KP) + ((size_t)layer * nb_ + sg) * nkv * 256; float* vo = F.out + (smp ? O_VS : O_VP) + ((size_t)layer * nb_ + sg) * nkv * 256;
    for (int i = tid; i < nkv * 32; i += NTHREADS) { const int j = i >> 5, c8 = (i & 31) * 8; const bf16_t* hp = H + (row0 + len - nkv + j) * DINP; float f[8];
        unpack8(*(const u32x4*)(hp + C_K + c8), f); *(f32x4*)(ko + (size_t)j * 256 + c8) = (f32x4){f[0], f[1], f[2], f[3]}; *(f32x4*)(ko + (size_t)j * 256 + c8 + 4) = (f32x4){f[4], f[5], f[6], f[7]};
        unpack8(*(const u32x4*)(hp + C_V + c8), f); *(f32x4*)(vo + (size_t)j * 256 + c8) = (f32x4){f[0], f[1], f[2], f[3]}; *(f32x4*)(vo + (size_t)j * 256 + c8 + 4) = (f32x4){f[4], f[5], f[6], f[7]}; }
    float* co = F.out + (smp ? O_CVS : O_CVP) + ((size_t)layer * nb_ + sg) * 3 * CONVDIM;
    for (int i = tid; i < 3 * 512; i += NTHREADS) { const int j = i / 512, c8 = (i % 512) * 8; float f[8]; unpack8(*(const u32x4*)(H + (row0 + len - 3 + j) * DINP + C_X + c8), f);
        *(f32x4*)(co + (size_t)j * CONVDIM + c8) = (f32x4){f[0], f[1], f[2], f[3]}; *(f32x4*)(co + (size_t)j * CONVDIM + c8 + 4) = (f32x4){f[4], f[5], f[6], f[7]}; }
    float* so = F.out + (smp ? O_SCS : O_SCP) + ((size_t)layer * nb_ + sg) * 2 * D;
    for (int i = tid; i < 2 * 128; i += NTHREADS) { const int j = i >> 7, c8 = (i & 127) * 8; float c[8], h[8]; const bf16_t* hp = H + (row0 + len - 2 + j) * DINP;
        unpack8(*(const u32x4*)(hp + C_SCC + c8), c); unpack8(*(const u32x4*)(hp + C_SCH + c8), h);
        *(f32x4*)(so + (size_t)j * D + c8) = (f32x4){c[0] * h[0], c[1] * h[1], c[2] * h[2], c[3] * h[3]}; *(f32x4*)(so + (size_t)j * D + c8 + 4) = (f32x4){c[4] * h[4], c[5] * h[5], c[6] * h[6], c[7] * h[7]}; }
}
#ifndef MIX_MASK
#define MIX_MASK 0xFF
#endif
#define MIXON(b) ((MIX_MASK >> (b)) & 1)
__device__ __forceinline__ void step_premix(const Frame& F, int layer, int mb) {
    const int n_bc = NSEQ_MB * NCHUNK * 8, n_att = NSEQ_MB * NCHUNK * NKV, n_sc = rows_of(mb) / 64, n_so = NSEQ_MB + (mb == 0 ? DECB : 0);
    const int n_ss = mb == 0 ? DECB * 32 : 0, n_as = mb == 0 ? DECB * NKV : 0;
    const int total = n_bc + n_att + n_sc + n_so + n_ss + n_as;
#define UF(Fu) Frame Fu = F; Fu.lane = opq(lane_id()); Fu.tid = Fu.wave * 64 + Fu.lane
    PROBE_T0(14) if constexpr (MIXON(0)) { UF(Fu); BcRegs ra, rn_;
        if (F.bid < n_bc) ssd_bc_load(Fu, layer, F.bid, ra);
        for (int u = F.bid; u < n_bc; u += F.G) { const bool more = u + F.G < n_bc; if (more) ssd_bc_load(Fu, layer, u + F.G, rn_);
            ssd_bc_unit(Fu, u, ra);
            if (more) ra = rn_; } }
    PROBE_T1(14)
    for (int un = F.bid; un < total; un += F.G) { int r = un;
        if (r < n_bc) continue;
        r -= n_bc;
        if (r < n_att) { PROBE_T0(15) if constexpr (MIXON(1)) { UF(Fu);
                const int ra = (n_att % 8 == 0 && F.G % 8 == 0 && n_bc % F.G == 0) ? (r & 7) * (n_att >> 3) + (r >> 3) : r;
                attn_prompt_unit(Fu, layer, ra / (NCHUNK * NKV), (ra / NKV) % NCHUNK, ra % NKV); } PROBE_T1(15) continue; } r -= n_att;
        if (r < n_sc) { PROBE_T0(16) if constexpr (MIXON(2)) { UF(Fu); sc_unit(Fu, layer, r); } PROBE_T1(16) continue; } r -= n_sc;
        if (r < n_so) { PROBE_T0(17) if constexpr (MIXON(3)) { UF(Fu); state_out_unit(Fu, layer, mb, r < NSEQ_MB ? r : r - NSEQ_MB, r >= NSEQ_MB); } PROBE_T1(17) continue; } r -= n_so;
        if (r < n_ss) { PROBE_T0(18) if constexpr (MIXON(4)) { UF(Fu); ssd_sample_unit(Fu, layer, r >> 5, r & 31); } PROBE_T1(18) continue; } r -= n_ss;
        { PROBE_T0(19) if constexpr (MIXON(5)) { UF(Fu); attn_sample_unit(Fu, layer, r >> 2, r & 3); } PROBE_T1(19) }
    }
}
__device__ __forceinline__ void step_mixers(const Frame& F, int layer, int mb) {
    for (int v = F.bid; v < NSEQ_MB * 32; v += F.G) { const int un = (NSEQ_MB == 8 && F.G == 256) ? (v & 7) * 32 + (v >> 3) : v; UF(Fu); ssd_prompt_unit(Fu, layer, mb, un >> 5, un & 31); }
}
__device__ __forceinline__ void step_gnorm(const Frame& F, int mb) {
    const int gw = F.bid * NWAVES + F.wave, NGW = F.G * NWAVES, nr = rows_of(mb); bf16_t* H = ws_bf(F, WS_H); const float* ssq = ws_f(F, WS_SSQ);
    constexpr int RB = 4; const int g = F.lane >> 3;
    for (int r0 = gw; r0 < nr; r0 += RB * NGW) {
        u32x4 d[RB][4]; f32x4 q[RB];
#pragma unroll
        for (int i = 0; i < RB; ++i) { const int r = r0 + i * NGW < nr ? r0 + i * NGW : r0; { const f32x4 qa = *(const f32x4*)(ssq + (size_t)r * 64 + 8 * g), qb = *(const f32x4*)(ssq + (size_t)r * 64 + 8 * g + 4); q[i] = qa + qb; } const u32x4* p = (const u32x4*)(H + (size_t)r * DINP + C_Z + 32 * F.lane);
#pragma unroll
            for (int j = 0; j < 4; ++j) d[i][j] = p[j]; }
        asm volatile("" ::: "memory");
#pragma unroll
        for (int i = 0; i < RB; ++i) { const int r = r0 + i * NGW; if (r >= nr) continue;
            const float rstd = 1.0f / sqrtf(((q[i][0] + q[i][1]) + (q[i][2] + q[i][3])) * (1.0f / 256.0f) + LN_EPS); u32x4* p = (u32x4*)(H + (size_t)r * DINP + C_Z + 32 * F.lane);
#pragma unroll
            for (int j = 0; j < 4; ++j) { float f[8]; unpack8(d[i][j], f);
#pragma unroll
                for (int k = 0; k < 8; ++k) f[k] *= rstd;
                p[j] = pack8(f); } }
    }
}
constexpr int LOG_NEXP = NEXP == 32 ? 5 : (NEXP == 16 ? 4 : (NEXP == 8 ? 3 : 2));
template <int N, int MASK> struct RedStep {
    static __device__ __forceinline__ void run(float* v, int lane) {
        constexpr int Hn = N / 2; const bool up = (lane & MASK) != 0;
#pragma unroll
        for (int i = 0; i < Hn; ++i) { const float keep = up ? v[i + Hn] : v[i], send = up ? v[i] : v[i + Hn]; v[i] = keep + xshfl<MASK>(send); }
        if constexpr (Hn > 1) RedStep<Hn, (MASK >> 1)>::run(v, lane);
    }
};
constexpr int RW_P = D + 8;
__device__ __forceinline__ void step_ln1_router_mfma(const Frame& F, int layer, int mb) {
    LAS bf16_t* WH = (LAS bf16_t*)F.lds; LAS bf16_t* WL = WH + NTE * 16 * RW_P; LAS float* GB = (LAS float*)(WL + NTE * 16 * RW_P);
    static_assert((size_t)2 * NTE * 16 * RW_P * 2 + 2 * D * 4 <= (size_t)SCR_BYTES, "router LDS map");
    const int lane = F.lane, fr = lane & 15, fq = lane >> 4;
    __syncthreads();
    { const bf16_t* rwh = ws_bf(F, WS_RWH) + (size_t)layer * NTE * 16 * D; const bf16_t* rwl = ws_bf(F, WS_RWL) + (size_t)layer * NTE * 16 * D;
      for (int i = F.tid; i < NTE * 16 * (D / 8); i += NTHREADS) { const int e = i / (D / 8), c = i % (D / 8); *(LAS u32x4*)(WH + e * RW_P + 8 * c) = *(const u32x4*)(rwh + (size_t)e * D + 8 * c); *(LAS u32x4*)(WL + e * RW_P + 8 * c) = *(const u32x4*)(rwl + (size_t)e * D + 8 * c); }
      for (int i = F.tid; i < D; i += NTHREADS) { GB[i] = F.in[I_LN1G][(size_t)layer * D + i]; GB[D + i] = F.in[I_LN1B][(size_t)layer * D + i]; } }
    unsigned* cnt = F.ctl + CW_CNT + (mb * DEPTH + layer) * 64;
    LAS unsigned* lcnt = (LAS unsigned*)(F.lds + MISC_OFF) + 128;
    if (F.tid < 64) lcnt[F.tid] = 0u;
    __syncthreads();
    const int gw = F.bid * NWAVES + F.wave, NGW = F.G * NWAVES, nr = rows_of(mb);
    const float* rb = F.in[I_RB] + (size_t)layer * NEXP;
    bf16_t* XB = ws_bf(F, WS_XB); int* topi = (int*)(F.ws + WS_TOPI); float* gate = ws_f(F, WS_GATE); int* pos = (int*)(F.ws + WS_POS);
    float rbv[NTE];
#pragma unroll
    for (int t = 0; t < NTE; ++t) rbv[t] = 16 * t + fr < NEXP ? rb[16 * t + fr] : 0.f;
    for (int blk = gw; blk < nr / 16; blk += NGW) {
        const int row = 16 * blk + fr; const float* xr = x_out_row(F, mb, row) + 8 * fq;
        float s1, s2;
        { const float* stp = ws_f(F, WS_STAT) + (size_t)row * 32 + 8 * fq; const f32x4 a = *(const f32x4*)stp, b = *(const f32x4*)(stp + 4); s1 = (a[0] + a[2]) + (b[0] + b[2]); s2 = (a[1] + a[3]) + (b[1] + b[3]); }
        s1 += xshfl<16>(s1); s1 += xshfl<32>(s1); s2 += xshfl<16>(s2); s2 += xshfl<32>(s2);
        const float mean = s1 * (1.0f / D); const float rstd = 1.0f / sqrtf(fmaxf(s2 * (1.0f / D) - mean * mean, 0.f) + LN_EPS);
        f32x4 acc[NTE];
#pragma unroll
        for (int t = 0; t < NTE; ++t) acc[t] = (f32x4){0.f, 0.f, 0.f, 0.f};
        bf16_t* xo = XB + (size_t)row * D + 8 * fq;
#pragma unroll 4
        for (int sI = 0; sI < D / 32; ++sI) { const f32x4 a = *(const f32x4*)(xr + 32 * sI), b = *(const f32x4*)(xr + 32 * sI + 4);
            const f32x4 g0 = *(const LAS f32x4*)(GB + 32 * sI + 8 * fq), g1 = *(const LAS f32x4*)(GB + 32 * sI + 8 * fq + 4), b0 = *(const LAS f32x4*)(GB + D + 32 * sI + 8 * fq), b1 = *(const LAS f32x4*)(GB + D + 32 * sI + 8 * fq + 4);
            const f32x4 n0 = (a - mean) * rstd * g0 + b0, n1 = (b - mean) * rstd * g1 + b1;
            u32x4 hw; hw.x = pk2(n0[0], n0[1]); hw.y = pk2(n0[2], n0[3]); hw.z = pk2(n1[0], n1[1]); hw.w = pk2(n1[2], n1[3]);
            *(u32x4*)(xo + 32 * sI) = hw;
            u32x4 lw; lw.x = pk2(n0[0] - blo(hw.x), n0[1] - bhi(hw.x)); lw.y = pk2(n0[2] - blo(hw.y), n0[3] - bhi(hw.y)); lw.z = pk2(n1[0] - blo(hw.z), n1[1] - bhi(hw.z)); lw.w = pk2(n1[2] - blo(hw.w), n1[3] - bhi(hw.w));
            const bf16x8 ah = __builtin_bit_cast(bf16x8, hw), al = __builtin_bit_cast(bf16x8, lw);
#pragma unroll
            for (int t = 0; t < NTE; ++t) { const bf16x8 wh = *(const LAS bf16x8*)(WH + (16 * t + fr) * RW_P + 32 * sI + 8 * fq), wl = *(const LAS bf16x8*)(WL + (16 * t + fr) * RW_P + 32 * sI + 8 * fq);
                acc[t] = __builtin_amdgcn_mfma_f32_16x16x32_bf16(ah, wh, acc[t], 0, 0, 0); acc[t] = __builtin_amdgcn_mfma_f32_16x16x32_bf16(al, wh, acc[t], 0, 0, 0); acc[t] = __builtin_amdgcn_mfma_f32_16x16x32_bf16(ah, wl, acc[t], 0, 0, 0); } }
#pragma unroll
        for (int r = 0; r < 4; ++r) { float val[NTE];
#pragma unroll
            for (int t = 0; t < NTE; ++t) val[t] = 16 * t + fr < NEXP ? acc[t][r] + rbv[t] : -3.0e38f;
            float tv[4]; int te[4];
#pragma unroll
            for (int k = 0; k < 4; ++k) { float m = val[0];
#pragma unroll
                for (int t = 1; t < NTE; ++t) m = fmaxf(m, val[t]);
                m = fmaxf(m, xshfl<1>(m)); m = fmaxf(m, xshfl<2>(m)); m = fmaxf(m, xshfl<4>(m)); m = fmaxf(m, xshfl<8>(m));
                int ce = 9999;
#pragma unroll
                for (int t = NTE - 1; t >= 0; --t) ce = val[t] == m ? 16 * t + fr : ce;
                { int o = xshfl<1>(ce); ce = o < ce ? o : ce; o = xshfl<2>(ce); ce = o < ce ? o : ce; o = xshfl<4>(ce); ce = o < ce ? o : ce; o = xshfl<8>(ce); ce = o < ce ? o : ce; }
                tv[k] = m; te[k] = ce;
#pragma unroll
                for (int t = 0; t < NTE; ++t) if (16 * t + fr == ce) val[t] = -3.0e38f; }
            const float e1 = fexp(tv[1] - tv[0]), e2 = fexp(tv[2] - tv[0]), e3 = fexp(tv[3] - tv[0]); const float inv = 1.0f / (1.0f + e1 + e2 + e3);
            if (fr < 4) { const int e = fr == 0 ? te[0] : (fr == 1 ? te[1] : (fr == 2 ? te[2] : te[3])); const float gv = (fr == 0 ? 1.0f : (fr == 1 ? e1 : (fr == 2 ? e2 : e3))) * inv;
                const size_t tok = (size_t)16 * blk + 4 * fq + r;
                const unsigned rk = __hip_atomic_fetch_add(lcnt + e, 1u, __ATOMIC_RELAXED, __HIP_MEMORY_SCOPE_WORKGROUP);
                topi[tok * 4 + fr] = e; gate[tok * 4 + fr] = gv; pos[tok * 4 + fr] = (int)rk; } }
    }
    __syncthreads();
    if (F.tid < NEXP) lcnt[32 + F.tid] = __hip_atomic_fetch_add(cnt + F.tid, lcnt[F.tid], __ATOMIC_RELAXED, __HIP_MEMORY_SCOPE_AGENT);
    __syncthreads();
    for (int blk = gw; blk < nr / 16; blk += NGW) pos[(size_t)16 * blk * 4 + lane] += (int)lcnt[32 + topi[(size_t)16 * blk * 4 + lane]];
}
__device__ __forceinline__ void step_ln1_router(const Frame& F, int layer, int mb) {
    LAS float* wT = (LAS float*)F.lds;
    const float* rw = F.in[I_RW] + (size_t)layer * D * NEXP;
    __syncthreads();
    for (int i = F.tid; i < D * NEXP; i += NTHREADS) { const int e = i / D, k = i % D; wT[i] = rw[(size_t)k * NEXP + e]; }
    unsigned* cnt = F.ctl + CW_CNT + (mb * DEPTH + layer) * 64;
    LAS unsigned* lcnt = (LAS unsigned*)(F.lds + MISC_OFF) + 128;
    if (F.tid < 64) lcnt[F.tid] = 0u;
    __syncthreads();
    const int gw = F.bid * NWAVES + F.wave, NGW = F.G * NWAVES, nr = rows_of(mb), lane = F.lane;
    const float* lg = F.in[I_LN1G] + (size_t)layer * D; const float* lb = F.in[I_LN1B] + (size_t)layer * D; const float* rb = F.in[I_RB] + (size_t)layer * NEXP;
    bf16_t* XB = ws_bf(F, WS_XB); int* topi = (int*)(F.ws + WS_TOPI); float* gate = ws_f(F, WS_GATE); int* pos = (int*)(F.ws + WS_POS);
    constexpr int RB = 4, NH = NEXP / 2, LOGH = LOG_NEXP - 1;
    const int myexp = ((lane & 1) * NH) | ((lane >> (6 - LOGH)) & (NH - 1));
    const float myb = rb[myexp];
    for (int r0 = gw; r0 < nr; r0 += RB * NGW) {
        f32x4 v[RB][4]; int rr[RB]; bool ok[RB];
#pragma unroll
        for (int i = 0; i < RB; ++i) { const int r = r0 + i * NGW; ok[i] = r < nr; rr[i] = ok[i] ? r : r0; const float* xr = x_out_row(F, mb, rr[i]);
#pragma unroll
            for (int j = 0; j < 4; ++j) v[i][j] = *((const f32x4*)xr + lane + 64 * j); }
        asm volatile("" ::: "memory");
#pragma unroll
        for (int i = 0; i < RB; ++i) {
            float s = 0.f;
#pragma unroll
            for (int j = 0; j < 4; ++j) s += (v[i][j][0] + v[i][j][1]) + (v[i][j][2] + v[i][j][3]);
            const float mean = wave_sum(s) * (1.0f / D); float s2 = 0.f;
#pragma unroll
            for (int j = 0; j < 4; ++j) { v[i][j] = v[i][j] - mean; s2 += (v[i][j][0] * v[i][j][0] + v[i][j][1] * v[i][j][1]) + (v[i][j][2] * v[i][j][2] + v[i][j][3] * v[i][j][3]); }
            const float rstd = 1.0f / sqrtf(wave_sum(s2) * (1.0f / D) + LN_EPS);
#pragma unroll
            for (int j = 0; j < 4; ++j) { const f32x4 gg = *((const f32x4*)lg + lane + 64 * j), bb = *((const f32x4*)lb + lane + 64 * j); v[i][j] = v[i][j] * rstd * gg + bb;
                if (ok[i]) { u32x2 w; w.x = pk2(v[i][j][0], v[i][j][1]); w.y = pk2(v[i][j][2], v[i][j][3]); *((u32x2*)(XB + (size_t)rr[i] * D) + lane + 64 * j) = w; } }
        }
        typedef float f32x2v __attribute__((ext_vector_type(2)));
        float val[RB];
#pragma unroll
        for (int hf = 0; hf < 2; ++hf) {
            float lgt[RB][NH];
#pragma unroll
            for (int e = 0; e < NH; ++e) { f32x2v a2[RB / 2];
#pragma unroll
                for (int i = 0; i < RB / 2; ++i) a2[i] = (f32x2v){0.f, 0.f};
#pragma unroll
                for (int j = 0; j < 4; ++j) { const f32x4 wv = *((const LAS f32x4*)(wT + (hf * NH + e) * D) + lane + 64 * j);
#pragma unroll
                    for (int c = 0; c < 4; ++c) { const f32x2v w2 = (f32x2v){wv[c], wv[c]};
#pragma unroll
                        for (int i = 0; i < RB / 2; ++i) a2[i] = __builtin_elementwise_fma((f32x2v){v[2 * i][j][c], v[2 * i + 1][j][c]}, w2, a2[i]); } }
#pragma unroll
                for (int i = 0; i < RB / 2; ++i) { lgt[2 * i][e] = a2[i].x; lgt[2 * i + 1][e] = a2[i].y; }
                if ((e & 1) == 1) asm volatile("" ::: "memory"); }
#pragma unroll
            for (int i = 0; i < RB; ++i) { RedStep<NH, 32>::run(lgt[i], lane); float tot = lgt[i][0];
                if constexpr ((32 >> LOGH) >= 8) tot += xshfl<8>(tot);
                if constexpr ((32 >> LOGH) >= 4) tot += xshfl<4>(tot);
                if constexpr ((32 >> LOGH) >= 2) tot += xshfl<2>(tot);
                tot += xshfl<1>(tot);
                if ((lane & 1) == hf) val[i] = tot + myb; }
        }
#pragma unroll
        for (int i = 0; i < RB; ++i) {
            float tv[4]; int te[4]; float vv = val[i];
#pragma unroll
            for (int k = 0; k < 4; ++k) { float m = vv; m = fmaxf(m, xshfl<1>(m)); m = fmaxf(m, xshfl<2>(m)); m = fmaxf(m, xshfl<4>(m)); m = fmaxf(m, xshfl<8>(m)); m = fmaxf(m, xshfl<16>(m)); m = fmaxf(m, xshfl<32>(m));
                const unsigned long long bal = __ballot(vv == m); const int wl = __builtin_ctzll(bal);
                const int be = ((wl & 1) * NH) | ((wl >> (6 - LOGH)) & (NH - 1));
                tv[k] = m; te[k] = be; if (myexp == be) vv = -3.0e38f; }
            const float e1 = fexp(tv[1] - tv[0]), e2 = fexp(tv[2] - tv[0]), e3 = fexp(tv[3] - tv[0]); const float inv = 1.0f / (1.0f + e1 + e2 + e3);
            if (lane < 4 && ok[i]) { const int e = lane == 0 ? te[0] : (lane == 1 ? te[1] : (lane == 2 ? te[2] : te[3])); const float gv = (lane == 0 ? 1.0f : (lane == 1 ? e1 : (lane == 2 ? e2 : e3))) * inv;
                const unsigned rk = __hip_atomic_fetch_add(lcnt + e, 1u, __ATOMIC_RELAXED, __HIP_MEMORY_SCOPE_WORKGROUP);
                topi[(size_t)rr[i] * 4 + lane] = e; gate[(size_t)rr[i] * 4 + lane] = gv; pos[(size_t)rr[i] * 4 + lane] = (int)rk; }
        }
    }
    __syncthreads();
    if (F.tid < NEXP) lcnt[32 + F.tid] = __hip_atomic_fetch_add(cnt + F.tid, lcnt[F.tid], __ATOMIC_RELAXED, __HIP_MEMORY_SCOPE_AGENT);
    __syncthreads();
    for (int r = gw; r < nr; r += NGW) if (lane < 4) pos[(size_t)r * 4 + lane] += (int)lcnt[32 + topi[(size_t)r * 4 + lane]];
}
__device__ __forceinline__ int moe_table(const Frame& F, int layer, int mb) {
    LAS int* M = (LAS int*)(F.lds + MISC_OFF);
    __syncthreads();
    if (F.tid == 0) { unsigned* cnt = F.ctl + CW_CNT + (mb * DEPTH + layer) * 64; int acc = 0;
        for (int e = 0; e < NEXP; ++e) { const int c = (int)__hip_atomic_load(cnt + e, __ATOMIC_RELAXED, __HIP_MEMORY_SCOPE_AGENT); M[64 + e] = acc * 256; acc += (c + 255) / 256; M[16 + e] = acc; } }
    __syncthreads();
    return M[16 + NEXP - 1];
}
__device__ __forceinline__ void step_gather(const Frame& F, int layer, int mb) {
    (void)moe_table(F, layer, mb); const LAS int* M = (const LAS int*)(F.lds + MISC_OFF);
    const int nr = rows_of(mb);
    const int* topi = (const int*)(F.ws + WS_TOPI); const float* gate = ws_f(F, WS_GATE); int* pos = (int*)(F.ws + WS_POS); float* gs = ws_f(F, WS_GSORT); int* rtok = (int*)(F.ws + WS_RTOK);
#pragma nounroll
    for (int i = F.bid * NTHREADS + F.tid; i < nr * 4; i += F.G * NTHREADS) { const int p = M[64 + topi[i]] + pos[i]; pos[i] = p; rtok[p] = i >> 2; gs[p] = gate[i]; }
}
__device__ __forceinline__ void step_ln2(const Frame& F, int layer, int mb) {
    const int gw = F.bid * NWAVES + F.wave, NGW = F.G * NWAVES, nr = rows_of(mb), lane = F.lane;
    const float* lg = F.in[I_LN2G] + (size_t)layer * D; const float* lb = F.in[I_LN2B] + (size_t)layer * D;
    const bf16_t* OUTS = ws_bf(F, WS_H) + (size_t)2 * RP * D; const int* pos = (const int*)(F.ws + WS_POS); bf16_t* XB = ws_bf(F, WS_XB);
    constexpr int RB = 2;
    for (int r0 = gw; r0 < nr; r0 += RB * NGW) {
        f32x4 v[RB][4]; u32x2 ow[RB][4][4]; int rr[RB];
#pragma unroll
        for (int i = 0; i < RB; ++i) { rr[i] = r0 + i * NGW < nr ? r0 + i * NGW : r0; const u32x2* xr = (const u32x2*)(XB + (size_t)rr[i] * D); int p[4];
#pragma unroll
            for (int k = 0; k < 4; ++k) p[k] = pos[(size_t)rr[i] * 4 + k];
#pragma unroll
            for (int j = 0; j < 4; ++j) { { const u32x2 w = xr[lane + 64 * j]; v[i][j] = (f32x4){blo(w.x), bhi(w.x), blo(w.y), bhi(w.y)}; }
#pragma unroll
                for (int k = 0; k < 4; ++k) ow[i][k][j] = *((const u32x2*)(OUTS + (size_t)p[k] * D) + lane + 64 * j); } }
        asm volatile("" ::: "memory");
#pragma unroll
        for (int i = 0; i < RB; ++i) { if (r0 + i * NGW >= nr) continue;
            float* xr = x_out_row(F, mb, rr[i]); float s = 0.f;
#pragma unroll
            for (int j = 0; j < 4; ++j) { v[i][j] = v[i][j] * ALPHA;
#pragma unroll
                for (int k = 0; k < 4; ++k) { const u32x2 w = ow[i][k][j]; v[i][j] = v[i][j] + (f32x4){blo(w.x), bhi(w.x), blo(w.y), bhi(w.y)}; }
                s += (v[i][j][0] + v[i][j][1]) + (v[i][j][2] + v[i][j][3]); }
            const float mean = wave_sum(s) * (1.0f / D); float s2 = 0.f;
#pragma unroll
            for (int j = 0; j < 4; ++j) { v[i][j] = v[i][j] - mean; s2 += (v[i][j][0] * v[i][j][0] + v[i][j][1] * v[i][j][1]) + (v[i][j][2] * v[i][j][2] + v[i][j][3] * v[i][j][3]); }
            const float rstd = 1.0f / sqrtf(wave_sum(s2) * (1.0f / D) + LN_EPS);
#pragma unroll
            for (int j = 0; j < 4; ++j) { const f32x4 gg = *((const f32x4*)lg + lane + 64 * j), bb = *((const f32x4*)lb + lane + 64 * j); v[i][j] = v[i][j] * rstd * gg + bb;
                *((f32x4*)xr + lane + 64 * j) = v[i][j]; u32x2 w; w.x = pk2(v[i][j][0], v[i][j][1]); w.y = pk2(v[i][j][2], v[i][j][3]); *((u32x2*)(XB + (size_t)rr[i] * D) + lane + 64 * j) = w; } }
    }
}

constexpr int SP_P = 68;
template <int KS  > __device__ __forceinline__ void small_mma(const bf16_t* A, int lda, const bf16_t* Bt, int K, int tok0, int n0, int k0, int fr, int fq, f32x4 (&acc)[4]) {
    const bf16_t* ap = A + (size_t)(tok0 + fr) * lda + k0 + 8 * fq; const bf16_t* bp = Bt + (size_t)(n0 + fr) * K + k0 + 8 * fq;
#pragma unroll
    for (int k = 0; k < KS; k += 32) { const bf16x8 a = *(const bf16x8*)(ap + k);
#pragma unroll
        for (int jj = 0; jj < 4; ++jj) { const bf16x8 x = *(const bf16x8*)(bp + (size_t)16 * jj * K + k); acc[jj] = __builtin_amdgcn_mfma_f32_16x16x32_bf16(x, a, acc[jj], 0, 0, 0); } }
}
template <int MODE  >
__device__ __forceinline__ void sample_unit(const Frame& F, int layer, int u) {
    const int tid = F.tid, lane = F.lane, w = F.wave, fr = lane & 15, fq = lane >> 4; const int tok0 = NP + 16 * (u >> 4), n0 = 64 * (u & 15);
    LAS float* P = (LAS float*)F.lds;
    const bf16_t* H = ws_bf(F, WS_H); const size_t trow = (size_t)(tok0 + fr);
    f32x4 v[4];
#pragma unroll
    for (int jj = 0; jj < 4; ++jj) v[jj] = (f32x4){0.f, 0.f, 0.f, 0.f};
    if constexpr (MODE == 0) {
#pragma unroll
        for (int b = 0; b < 3; ++b) { f32x4 acc[4] = {(f32x4){0.f, 0.f, 0.f, 0.f}, (f32x4){0.f, 0.f, 0.f, 0.f}, (f32x4){0.f, 0.f, 0.f, 0.f}, (f32x4){0.f, 0.f, 0.f, 0.f}};
            if (b == 0) { small_mma<DINNER / 8>(H + C_Z, DINP, wl_ptr(F, layer, WL_SSD), DINNER, tok0, n0, w * (DINNER / 8), fr, fq, acc);
                const float* sq = ws_f(F, WS_SSQ) + trow * 64 + 8 * w; const f32x4 qa = *(const f32x4*)sq + *(const f32x4*)(sq + 4); const float rs = 1.0f / sqrtf(((qa[0] + qa[1]) + (qa[2] + qa[3])) * (1.0f / 256.0f) + LN_EPS);
#pragma unroll
                for (int jj = 0; jj < 4; ++jj) acc[jj] = acc[jj] * rs; }
            else small_mma<D / 8>(H + (b == 1 ? C_Q : C_SCB), DINP, wl_ptr(F, layer, b == 1 ? WL_ATT : WL_SC), D, tok0, n0, w * (D / 8), fr, fq, acc);
#pragma unroll
            for (int jj = 0; jj < 4; ++jj) { const u32x2 gw = *(const u32x2*)(H + trow * DINP + (b == 0 ? C_GSSD : (b == 1 ? C_GATT : C_GSC)) + n0 + 16 * jj + 4 * fq);
                v[jj] = v[jj] + acc[jj] * (f32x4){fsigmoid(blo(gw.x)), fsigmoid(bhi(gw.x)), fsigmoid(blo(gw.y)), fsigmoid(bhi(gw.y))}; } }
    } else small_mma<D / 8>(ws_bf(F, WS_XB), D, wl_ptr(F, layer, WL_O), D, tok0, n0, w * (D / 8), fr, fq, v);
    __syncthreads();
#pragma unroll
    for (int jj = 0; jj < 4; ++jj) *(LAS f32x4*)(P + (w * 16 + fr) * SP_P + 16 * jj + 4 * fq) = v[jj];
    __syncthreads();
    { const int tk = tid >> 5, c2 = 2 * (tid & 31); float s0 = 0.f, s1 = 0.f;
#pragma unroll
      for (int ww = 0; ww < 8; ++ww) { s0 += P[(ww * 16 + tk) * SP_P + c2]; s1 += P[(ww * 16 + tk) * SP_P + c2 + 1]; }
      const size_t orow = (size_t)(tok0 + tk);
      if constexpr (MODE == 0) *(unsigned*)(ws_bf(F, WS_XB) + orow * D + n0 + c2) = pk2(s0, s1);
      else { const float* xs = (layer == 0 ? F.in[I_XS] : F.out + O_YS) + (orow - NP) * D + n0 + c2; float* os = F.out + O_YS + (orow - NP) * D + n0 + c2; const float v0 = xs[0] * ALPHA + s0, v1 = xs[1] * ALPHA + s1; os[0] = v0; os[1] = v1;
          float t1 = v0 + v1, t2 = v0 * v0 + v1 * v1;
          t1 += xshfl<1>(t1); t1 += xshfl<2>(t1); t1 += xshfl<4>(t1); t1 += xshfl<8>(t1); t1 += xshfl<16>(t1); t2 += xshfl<1>(t2); t2 += xshfl<2>(t2); t2 += xshfl<4>(t2); t2 += xshfl<8>(t2); t2 += xshfl<16>(t2);
          if ((tid & 31) == 0) { float* sp = ws_f(F, WS_STAT) + orow * 32 + 2 * (u & 15); sp[0] = t1; sp[1] = t2; } } }
}

constexpr int PH_PER = 10, NSTEPS = 1 + NMB * DEPTH * PH_PER;
__global__ void __launch_bounds__(NTHREADS, 2) fwd(Args args) {
#ifdef EMU
    unsigned char* lds = emu_wg->lds;
#else
    extern __shared__ __attribute__((aligned(16))) unsigned char lds[];
#endif
    Frame F0; F0.lds = (LAS unsigned char*)lds; F0.tid = threadIdx.x; F0.lane = F0.tid & 63; F0.wave = __builtin_amdgcn_readfirstlane(F0.tid >> 6); F0.G = gridDim.x; F0.bid = blockIdx.x;
#ifdef EMU
    F0.in = args.in;
#else
    F0.in = (ArgTab)__builtin_amdgcn_kernarg_segment_ptr();
    static_assert(offsetof(Args, out) == 248 && offsetof(Args, ws) == 256 && offsetof(Args, in) == 0, "PF() reads the argument struct by offset");
#endif
    F0.out = args.out; F0.ws = args.ws; F0.ctl = (unsigned*)(args.ws + WS_CTL);
    const Frame& F = F0;
    const int lo = args.lo, hi = args.hi;
#ifndef EMU
    for (int u = F.tid; u < (LDS_BYTES - MISC_OFF) / 4; u += NTHREADS) ((LAS unsigned*)(F.lds + MISC_OFF))[u] = 0u;
    __syncthreads();
    XcdBarrier bar; bar.bar = F.ctl + CW_BAR; bar.x = 0; bar.st = nullptr;
    if (hi - lo > 1) bar = xcd_barrier_post(F.ctl + CW_BAR, (volatile LAS unsigned*)(F.lds + MISC_OFF) + 8);
#define SEAM(s) do { if ((s) + 1 < hi) { XcdBarrier b2_ = bar; unsigned long long bp_ = (unsigned long long)b2_.bar; asm volatile("" : "+s"(bp_)); b2_.bar = (unsigned*)bp_; xcd_barrier(b2_); } } while (0)
#else
#define SEAM(s) do { } while (0)
#endif
#ifndef PH_MASK
#define PH_MASK 0xFFFFFFFF
#endif
#define IN(s) (lo <= (s) && (s) < hi)
#define PHON(b) ((PH_MASK >> (b)) & 1)
#ifdef EMU
#define PF(Fp) Frame Fp = F0
#else
#define PF(Fp) Frame Fp; { unsigned long long kp_ = (unsigned long long)__builtin_amdgcn_kernarg_segment_ptr(); asm volatile("" : "+s"(kp_)); \
    Fp.in = (ArgTab)kp_; Fp.out = *(float* const __attribute__((address_space(4)))*)(kp_ + 248); Fp.ws = *(unsigned char* const __attribute__((address_space(4)))*)(kp_ + 256); Fp.ctl = (unsigned*)Fp.ws; \
    Fp.lds = F0.lds; Fp.G = F0.G; Fp.bid = F0.bid; Fp.wave = F0.wave; Fp.lane = opq(lane_id()); Fp.tid = Fp.wave * 64 + Fp.lane; }
#endif
    int step = 0;
    if (IN(step)) { PROBE_T0(0) if constexpr (PHON(0)) { PF(F); step_weights(F); for (int m = 0; m < NMB; ++m) step_xb(F, m);
        { bf16_t* rwh = ws_bf(F, WS_RWH); bf16_t* rwl = ws_bf(F, WS_RWL); const float* rw = F.in[I_RW];
#pragma nounroll
          for (int i = F.bid * NTHREADS + F.tid; i < DEPTH * NTE * 16 * D; i += F.G * NTHREADS) { const int l = i / (NTE * 16 * D), e = (i / D) % (NTE * 16), k = i % D;
              const float wv = e < NEXP ? rw[((size_t)l * D + k) * NEXP + e] : 0.f; const unsigned hi = f2bf(wv); rwh[i] = (bf16_t)hi; rwl[i] = (bf16_t)f2bf(wv - bf2f(hi)); } } } PROBE_T1(0) SEAM(step); }
    ++step;
#define PHV const int mb = opqs(mb0), layer = opqs(layer0), nr = rows_of(mb); (void)nr; (void)layer
    for (int mb0 = 0; mb0 < NMB; ++mb0)
        for (int layer0 = 0; layer0 < DEPTH; ++layer0) {
            if (IN(step)) { PROBE_T0(2) if constexpr (PHON(2)) { PF(F); PHV; pg8::Gemm g{layer == 0 ? ws_bf(F, WS_XB0) + (size_t)mb * R * D : ws_bf(F, WS_XB), wl_ptr(F, layer, WL_IN), nr, DINP, D, D, nullptr}; pg8::StaticOrder S; S.init(nr, DINP, F.G, F.bid, 2);
                pg8::EpiStoreBf16 E{ws_bf(F, WS_H), DINP}; pg8::gemm_phase(F.lds, g, S, E, F.wave); } PROBE_T1(2) SEAM(step); }
            ++step;
            if (IN(step)) { PROBE_T0(13) if constexpr (PHON(13)) { PF(F); PHV; step_premix(F, layer, mb); } PROBE_T1(13) SEAM(step); }
            ++step;
            if (IN(step)) { PROBE_T0(3) if constexpr (PHON(3)) { PF(F); PHV; step_mixers(F, layer, mb); } PROBE_T1(3) SEAM(step); }
            ++step;
            if (IN(step)) { PROBE_T0(5) if constexpr (PHON(5)) { PF(F); PHV; pg8::StaticOrder S; S.init(NP, D, F.G, F.bid); bf16_t* H = ws_bf(F, WS_H); bf16_t* MGb = ws_bf(F, WS_XB);
#ifndef MERGE_MASK
#define MERGE_MASK 7
#endif
                if constexpr (MERGE_MASK & 1) { pg8::Gemm g{H + C_Z, wl_ptr(F, layer, WL_SSD), NP, D, DINNER, DINP, nullptr, ws_f(F, WS_SSQ)}; pg8::EpiGate<0> E{H + C_GSSD, MGb}; pg8::gemm_phase<pg8::EpiGate<0>, pg8::StaticOrder, false, true>(F.lds, g, S, E, F.wave); }
                if constexpr (MERGE_MASK & 2) { pg8::Gemm g{H + C_Q, wl_ptr(F, layer, WL_ATT), NP, D, D, DINP, nullptr}; pg8::EpiGate<1> E{H + C_GATT, MGb}; pg8::gemm_phase(F.lds, g, S, E, F.wave); }
                if constexpr (MERGE_MASK & 4) { pg8::Gemm g{H + C_SCB, wl_ptr(F, layer, WL_SC), NP, D, D, DINP, nullptr}; pg8::EpiGate<1> E{H + C_GSC, MGb}; pg8::gemm_phase(F.lds, g, S, E, F.wave); }
                if (mb == 0) for (int u = F.bid; u < 256; u += F.G) sample_unit<0>(F, layer, u); }
                PROBE_T1(5) SEAM(step); }
            ++step;
            if (IN(step)) { PROBE_T0(6) if constexpr (PHON(6)) { PF(F); PHV; pg8::Gemm g{ws_bf(F, WS_XB), wl_ptr(F, layer, WL_O), NP, D, D, D, nullptr}; pg8::StaticOrder S; S.init(NP, D, F.G, F.bid);
                pg8::EpiResid E{layer == 0 ? F.in[I_XP] + (size_t)mb * NP * D : F.out + O_YP + (size_t)mb * NP * D, layer == 0 ? F.in[I_XS] : F.out + O_YS, F.out + O_YP + (size_t)mb * NP * D, F.out + O_YS, ws_f(F, WS_STAT)};
                pg8::gemm_phase(F.lds, g, S, E, F.wave);
                if (mb == 0) for (int u = F.bid; u < 256; u += F.G) sample_unit<1>(F, layer, u); } PROBE_T1(6) SEAM(step); }
            ++step;
            if (IN(step)) { PROBE_T0(7) if constexpr (PHON(7)) { PF(F); PHV; step_ln1_router_mfma(F, layer, mb); } PROBE_T1(7) SEAM(step); }
            ++step;
            if (IN(step)) { PROBE_T0(8) if constexpr (PHON(8)) { PF(F); PHV; step_gather(F, layer, mb); } PROBE_T1(8) SEAM(step); }
            ++step;
            if (IN(step)) { PROBE_T0(9) if constexpr (PHON(9)) { PF(F); PHV; const int nt = moe_table(F, layer, mb); pg8::MoeOrder S{(const LAS int*)(F.lds + MISC_OFF) + 16, 8, nt * 8, F.G, F.bid};
                pg8::Gemm g{ws_bf(F, WS_XB), wl_ptr(F, layer, WL_UP), nr  , 2048, D, D, (const int*)(F.ws + WS_RTOK)}; pg8::EpiSwiglu E{ws_bf(F, WS_H) + (size_t)RP * D, F.in[I_BUP] + (size_t)layer * NEXP * 2048};
                pg8::gemm_phase<pg8::EpiSwiglu, pg8::MoeOrder, true>(F.lds, g, S, E, F.wave); } PROBE_T1(9) SEAM(step); }
            ++step;
            if (IN(step)) { PROBE_T0(10) if constexpr (PHON(10)) { PF(F); PHV; const int nt = moe_table(F, layer, mb); pg8::MoeOrder S{(const LAS int*)(F.lds + MISC_OFF) + 16, 4, nt * 4, F.G, F.bid};
                pg8::Gemm g{ws_bf(F, WS_H) + (size_t)RP * D, wl_ptr(F, layer, WL_DN), nt * 256, D, D, D, nullptr}; pg8::EpiDown E{ws_bf(F, WS_H) + (size_t)2 * RP * D, F.in[I_BDN] + (size_t)layer * NEXP * D, ws_f(F, WS_GSORT)};
                pg8::gemm_phase(F.lds, g, S, E, F.wave); } PROBE_T1(10) SEAM(step); }
            ++step;
            if (IN(step)) { PROBE_T0(11) if constexpr (PHON(11)) { PF(F); PHV; step_ln2(F, layer, mb); } PROBE_T1(11) SEAM(step); }
            ++step;
        }
}

#ifdef EMU
extern int emu_grid, emu_step_lo, emu_step_hi;
#endif
extern "C" void kernel_launch(void* const* d_in, const int* in_sizes, int n_in, void* d_out, int out_size, void* d_ws, size_t ws_size, hipStream_t stream) {
    (void)in_sizes; (void)out_size;
    if (n_in != 31 || ws_size < WS_END) { fprintf(stderr, "kernel_launch: expected 31 inputs and >= %zu bytes of workspace (got %d, %zu)\n", (size_t)WS_END, n_in, ws_size); return; }
    Args a; memset(&a, 0, sizeof(a));
    for (int i = 0; i < 31; ++i) a.in[i] = (const float*)d_in[i];
    a.out = (float*)d_out; a.ws = (unsigned char*)d_ws;
#ifdef EMU
    if (emu_step_lo == 0) memset((char*)d_ws + WS_CTL, 0, CTL_BYTES);
    for (int s = emu_step_lo; s < emu_step_hi && s < NSTEPS; ++s) { a.lo = s; a.hi = s + 1; emu_launch(fwd, emu_grid, NTHREADS, LDS_BYTES, a); fprintf(stderr, "step %d done\n", s); }
#else
    (void)hipMemsetAsync((char*)d_ws + WS_CTL, 0, CTL_BYTES, stream);
    static int grid = 0;
    if (grid == 0) {
        int dev = 0, cus = 0;
        if (hipGetDevice(&dev) != hipSuccess || hipDeviceGetAttribute(&cus, hipDeviceAttributeMultiprocessorCount, dev) != hipSuccess) { grid = -1; return; }
        if (hipFuncSetAttribute((const void*)fwd, hipFuncAttributeMaxDynamicSharedMemorySize, LDS_BYTES) != hipSuccess) { grid = -1; return; }
        int per_cu = 0; (void)hipOccupancyMaxActiveBlocksPerMultiprocessor(&per_cu, (const void*)fwd, NTHREADS, LDS_BYTES); (void)hipGetLastError();
        grid = cus / 64 * 64;
        if (grid < 64) { grid = -1; return; }
    }
    if (grid < 0) return;
#if CFG_ONE_LAUNCH
    a.lo = 0; a.hi = NSTEPS; hipLaunchKernelGGL(fwd, dim3(grid), dim3(NTHREADS), LDS_BYTES, stream, a);
#else
    for (int s = 0; s < NSTEPS; ++s) { a.lo = s; a.hi = s + 1; hipLaunchKernelGGL(fwd, dim3(grid), dim3(NTHREADS), LDS_BYTES, stream, a); }
#endif
#endif
}
```

```cpp
#ifdef EMU
#include "emu.h"
#else
#include <hip/hip_runtime.h>
#endif
#include <cstdio>
#include <cstdint>
#include <cstring>
#include <cstddef>
#include <cmath>

#ifndef CFG_BATCH
#define CFG_BATCH 16
#endif
#ifndef CFG_SEQ
#define CFG_SEQ 4096
#endif
#ifndef CFG_NSEQ_MB
#define CFG_NSEQ_MB 8
#endif
#ifndef CFG_NEXP
#define CFG_NEXP 32
#endif
#ifndef CFG_ONE_LAUNCH
#define CFG_ONE_LAUNCH 1
#endif

constexpr int BATCH = CFG_BATCH, SEQ = CFG_SEQ, NSEQ_MB = CFG_NSEQ_MB, NEXP = CFG_NEXP, NMB = BATCH / NSEQ_MB;
constexpr int D = 1024, DEPTH = 2, DECB = 16, DECS = 16, NS = DECB * DECS;
constexpr int DINNER = 2048, CONVDIM = 4096;
constexpr int NKV = 4, WINDOW = 128, CHUNK = 64;
constexpr int DIN = 13856, DINP = 14080;
constexpr int NP = NSEQ_MB * SEQ, R = NP + NS;
constexpr int NTE = (NEXP + 15) / 16;
constexpr int RP = ((4 * R + NEXP * 255) + 255) / 256 * 256;
constexpr int NCHUNK = SEQ / CHUNK;
constexpr int C_Z = 0, C_X = 2048, C_B = 4096, C_C = 5120, C_Q = 6144, C_K = 7168, C_V = 7424, C_SCB = 7680, C_SCC = 8704, C_SCH = 9728, C_GSSD = 10752, C_GATT = 11776, C_GSC = 12800, C_DT = 13824;
constexpr float LN_EPS = 1e-5f, ALPHA = 1.41421356237309515f  , SW_LIMIT = 7.0f, SW_ALPHA = 1.702f;
static_assert(BATCH % NSEQ_MB == 0 && SEQ % 256 == 0 && (NEXP & (NEXP - 1)) == 0 && NEXP <= 32 && NEXP >= 4, "config");

constexpr size_t O_YP = 0, O_YS = O_YP + (size_t)BATCH * SEQ * D, O_KP = O_YS + (size_t)NS * D, O_VP = O_KP + (size_t)DEPTH * BATCH * WINDOW * 256,
    O_SSP = O_VP + (size_t)DEPTH * BATCH * WINDOW * 256, O_CVP = O_SSP + (size_t)DEPTH * BATCH * 32 * 64 * 128, O_SCP = O_CVP + (size_t)DEPTH * BATCH * 3 * CONVDIM,
    O_KS = O_SCP + (size_t)DEPTH * BATCH * 2 * D, O_VS = O_KS + (size_t)DEPTH * DECB * DECS * 256, O_SSS = O_VS + (size_t)DEPTH * DECB * DECS * 256,
    O_CVS = O_SSS + (size_t)DEPTH * DECB * 32 * 64 * 128, O_SCS = O_CVS + (size_t)DEPTH * DECB * 3 * CONVDIM, O_END = O_SCS + (size_t)DEPTH * DECB * 2 * D;

constexpr size_t al256(size_t x) { return (x + 255) / 256 * 256; }
constexpr size_t WS_CTL = 0, CTL_BYTES = 1u << 20;
constexpr size_t WS_SSQ = CTL_BYTES, WS_TOPI = WS_SSQ + al256((size_t)R * 128 * 4)  , WS_GATE = WS_TOPI + al256((size_t)R * 16), WS_POS = WS_GATE + al256((size_t)R * 16),
    WS_GSORT = WS_POS + al256((size_t)R * 16), WS_RTOK = WS_GSORT + al256((size_t)RP * 4),
    WS_RWH = WS_RTOK + al256((size_t)RP * 4)  , WS_RWL = WS_RWH + (size_t)DEPTH * NTE * 16 * D * 2  , WS_W = WS_RWL + (size_t)DEPTH * NTE * 16 * D * 2;
constexpr size_t WL_IN = 0, WL_SSD = WL_IN + (size_t)DINP * D * 2, WL_ATT = WL_SSD + (size_t)D * DINNER * 2, WL_SC = WL_ATT + (size_t)D * D * 2, WL_O = WL_SC + (size_t)D * D * 2,
    WL_UP = WL_O + (size_t)D * D * 2, WL_DN = WL_UP + (size_t)NEXP * 2048 * D * 2, WL_BYTES = WL_DN + (size_t)NEXP * D * D * 2;
constexpr size_t WS_XB = WS_W + DEPTH * WL_BYTES, WS_XB0 = WS_XB + (size_t)R * D * 2  , WS_PRE = WS_XB0 + (size_t)NMB * R * D * 2  , WS_H = WS_PRE + (size_t)R * D * 2;
constexpr size_t WS_STAT = WS_PRE;
constexpr size_t H_BYTES = (size_t)R * DINP * 2, MOE_BYTES = (size_t)3 * RP * D * 2, U_BYTES = H_BYTES > MOE_BYTES ? H_BYTES : MOE_BYTES;
constexpr size_t WS_CMC = WS_H + U_BYTES, WS_BTG = WS_CMC + (size_t)NP * 1024 * 2, WS_CBG = WS_BTG + (size_t)NSEQ_MB * NCHUNK * 8 * 8192 * 2, WS_END = WS_CBG + (size_t)NSEQ_MB * NCHUNK * 8 * 4096 * 2;
static_assert(WS_END <= ((size_t)2 << 30), "workspace map exceeds 2 GiB");
constexpr int CW_BAR = 4096, CW_CNT = 16384;

constexpr int RING_BYTES = 131072, LDS_BYTES = 163840  , MISC_OFF = LDS_BYTES - 1024, SCR_BYTES = MISC_OFF;
constexpr int NWAVES = 8, NTHREADS = 512;

#ifdef EMU
#define LAS
#define WAVE_SYNC() emu_wave_barrier()
#else
#define LAS __attribute__((address_space(3)))
#define WAVE_SYNC() asm volatile("s_waitcnt lgkmcnt(0)" ::: "memory")
#endif
#ifdef EMU
#define LBAR() emu_wg_barrier()
#define VM_WAIT(n) do { } while (0)
#else
#define LBAR() do { asm volatile("s_waitcnt lgkmcnt(0)" ::: "memory"); __builtin_amdgcn_s_barrier(); asm volatile("" ::: "memory"); } while (0)
#define VM_WAIT(n) asm volatile("s_waitcnt vmcnt(" #n ")" ::: "memory")
#endif
typedef unsigned short bf16_t;
typedef short bf16x8 __attribute__((ext_vector_type(8)));
typedef float f32x4 __attribute__((ext_vector_type(4)));
typedef float f32x16 __attribute__((ext_vector_type(16)));
typedef unsigned u32x4 __attribute__((ext_vector_type(4)));
typedef unsigned u32x2 __attribute__((ext_vector_type(2)));

__device__ __forceinline__ unsigned f2bf(float f) { unsigned u = __builtin_bit_cast(unsigned, f); return (u + 0x7fffu + ((u >> 16) & 1u)) >> 16; }
__device__ __forceinline__ float bf2f(unsigned h) { return __builtin_bit_cast(float, (h & 0xffffu) << 16); }
#ifdef EMU
__device__ __forceinline__ unsigned pk2(float lo, float hi) { return f2bf(lo) | (f2bf(hi) << 16); }
#else
typedef float f32x2_t __attribute__((ext_vector_type(2))); typedef __bf16 bf16x2_t __attribute__((ext_vector_type(2)));
__device__ __forceinline__ unsigned pk2(float lo, float hi) { f32x2_t v = {lo, hi}; bf16x2_t b = __builtin_convertvector(v, bf16x2_t); return __builtin_bit_cast(unsigned, b); }
#endif
#ifdef EMU
__device__ __forceinline__ unsigned short bf1(float f) { return (unsigned short)f2bf(f); }
#else
__device__ __forceinline__ unsigned short bf1(float f) { return (unsigned short)pk2(f, f); }
#endif
__device__ __forceinline__ float blo(unsigned w) { return __builtin_bit_cast(float, w << 16); }
__device__ __forceinline__ float bhi(unsigned w) { return __builtin_bit_cast(float, w & 0xffff0000u); }
__device__ __forceinline__ void unpack8(const u32x4 w, float* f) { f[0] = blo(w.x); f[1] = bhi(w.x); f[2] = blo(w.y); f[3] = bhi(w.y); f[4] = blo(w.z); f[5] = bhi(w.z); f[6] = blo(w.w); f[7] = bhi(w.w); }
__device__ __forceinline__ u32x4 pack8(const float* f) { u32x4 w; w.x = pk2(f[0], f[1]); w.y = pk2(f[2], f[3]); w.z = pk2(f[4], f[5]); w.w = pk2(f[6], f[7]); return w; }
__device__ __forceinline__ float fexp(float x) { return __builtin_amdgcn_exp2f(x * 1.4426950408889634f); }
__device__ __forceinline__ float fsigmoid(float x) { return __builtin_amdgcn_rcpf(1.0f + __builtin_amdgcn_exp2f(-1.4426950408889634f * x)); }
__device__ __forceinline__ float fsilu(float x) { return x * fsigmoid(x); }
#ifdef EMU
__device__ __forceinline__ int opq(int x) { return x; }
#else
__device__ __forceinline__ int opq(int x) { asm volatile("" : "+v"(x)); return x; }
#endif
#ifdef EMU
__device__ __forceinline__ int opqs(int x) { return x; }
#else
__device__ __forceinline__ int opqs(int x) { asm volatile("" : "+s"(x)); return x; }
#endif
#ifdef EMU
__device__ __forceinline__ int lane_id() { return (int)(threadIdx.x & 63); }
#else
__device__ __forceinline__ int lane_id() { return (int)__builtin_amdgcn_mbcnt_hi(~0u, __builtin_amdgcn_mbcnt_lo(~0u, 0u)); }
#endif
#ifdef EMU
template <int MASK> __device__ __forceinline__ unsigned xshfl_u(unsigned x) { return __shfl_xor(x, MASK); }
#else
template <int MASK> __device__ __forceinline__ unsigned xshfl_u(unsigned x) {
    if constexpr (MASK == 1) return (unsigned)__builtin_amdgcn_update_dpp((int)x, (int)x, 0xB1, 0xF, 0xF, false);
    else if constexpr (MASK == 2) return (unsigned)__builtin_amdgcn_update_dpp((int)x, (int)x, 0x4E, 0xF, 0xF, false);
    else if constexpr (MASK == 4) { const int t = __builtin_amdgcn_update_dpp((int)x, (int)x, 0x114, 0xF, 0xA, false);
        return (unsigned)__builtin_amdgcn_update_dpp(t, (int)x, 0x104, 0xF, 0x5, false); }
    else if constexpr (MASK == 8) return (unsigned)__builtin_amdgcn_update_dpp((int)x, (int)x, 0x128, 0xF, 0xF, false);
    else if constexpr (MASK == 16) { const auto rr = __builtin_amdgcn_permlane16_swap(x, x, false, false); return (lane_id() & 16) ? rr[0] : rr[1]; }
    else { const auto rr = __builtin_amdgcn_permlane32_swap(x, x, false, false); return (lane_id() & 32) ? rr[0] : rr[1]; }
}
#endif
template <int MASK> __device__ __forceinline__ float xshfl(float x) { return __builtin_bit_cast(float, xshfl_u<MASK>(__builtin_bit_cast(unsigned, x))); }
template <int MASK> __device__ __forceinline__ int xshfl(int x) { return (int)xshfl_u<MASK>((unsigned)x); }
__device__ __forceinline__ float wave_sum(float v) { v += xshfl<1>(v); v += xshfl<2>(v); v += xshfl<4>(v); v += xshfl<8>(v); v += xshfl<16>(v); v += xshfl<32>(v); return v; }

#ifndef PROBE_MASK
#define PROBE_MASK 0
#endif
#if PROBE_MASK && !defined(EMU)
#define PROBE_T0(b) unsigned long long pt0_ = 0; if constexpr ((PROBE_MASK >> (b)) & 1) pt0_ = __builtin_amdgcn_s_memrealtime();
#define PROBE_T1(b) if constexpr ((PROBE_MASK >> (b)) & 1) { asm volatile("s_waitcnt vmcnt(0) lgkmcnt(0)" ::: "memory"); const unsigned long long pt1_ = __builtin_amdgcn_s_memrealtime(); \
    while (__builtin_amdgcn_s_memrealtime() < pt1_ + (pt1_ - pt0_)) __builtin_amdgcn_s_sleep(8); }
#else
#define PROBE_T0(b)
#define PROBE_T1(b)
#endif
namespace pg8 {
constexpr int BM = 256, BK = 64, HALF = 128, HTB = HALF * BK * 2, NXCD = 8, WGM = 8;
struct Unit { int pm, pn, bt, e; };
struct Gemm { const bf16_t* A; const bf16_t* Bt; int M, N, K, lda; const int* tok; const float* ssq = nullptr; };
struct StaticOrder {
    int nM, nN, nwg, G, c, wgm;
    __host__ __device__ void init(int M, int N, int G_, int c_, int wgm_ = WGM) { nM = M / BM; nN = N / BM; nwg = nM * nN; G = G_; c = c_; wgm = wgm_; }
    __host__ __device__ bool next(int i, Unit& u) const {
        const long L = (long)i * G + c; if (L >= nwg) return false;
        int wgid = (int)L; { const int q = nwg / NXCD, r = nwg % NXCD, xcd = wgid % NXCD, off = wgid / NXCD; wgid = (xcd < r ? xcd * (q + 1) : r * (q + 1) + (xcd - r) * q) + off; }
        const int nig = wgm * nN, gid = wgid / nig, fm = gid * wgm, gsz = (nM - fm) < wgm ? (nM - fm) : wgm;
        u.pm = fm + ((wgid % nig) % gsz); u.pn = (wgid % nig) / gsz; u.bt = u.pn; u.e = 0; return true;
    }
    __device__ __forceinline__ void a_ready(const Unit&) const {}
    __device__ __forceinline__ void done(const Unit&) const {}
};
struct MoeOrder {
    const LAS int* tend; int npn, ntot, G, c;
    __device__ __forceinline__ bool next(int i, Unit& u) const {
        int rt, pn;
        {
            const int xcd = c & 7, j = c >> 3, rpx = (G >> 3) / npn; rt = (i * 8 + xcd) * rpx + j / npn; pn = j % npn; if (rt >= ntot / npn) return false; }
        int e = 0;
#pragma unroll
        for (int j = 0; j < NEXP; ++j) e += (tend[j] <= rt) ? 1 : 0;
        u.pm = rt; u.pn = pn; u.e = e; u.bt = e * npn + pn; return true;
    }
    __device__ __forceinline__ void a_ready(const Unit&) const {}
    __device__ __forceinline__ void done(const Unit&) const {}
};
#ifdef EMU
template <class Epi, class Sched, bool GATHER = false, bool GSCALE = false>
__device__ void gemm_phase(LAS unsigned char* lds, const Gemm g, const Sched& S, const Epi& E, int  ) {
    const int tid = threadIdx.x, wid = tid >> 6, lane = tid & 63, wr = wid >> 2, wc = wid & 3, fr = lane & 15, fq = lane >> 4;
    Unit u;
    for (int i = 0; S.next(i, u); ++i) {
        f32x4 acc[2][2][4][2];
        for (int ai = 0; ai < 2; ++ai) for (int bj = 0; bj < 2; ++bj) for (int m = 0; m < 4; ++m) for (int n = 0; n < 2; ++n) for (int q = 0; q < 4; ++q) {
            const int row = u.pm * 256 + ai * 128 + wr * 64 + m * 16 + fr, col = u.bt * 256 + bj * 128 + wc * 32 + 8 * fq + 4 * n + q;
            const bf16_t* a = g.A + (size_t)(GATHER ? ((unsigned)g.tok[row] < (unsigned)g.M ? g.tok[row] : 0) : row) * g.lda; const bf16_t* b = g.Bt + (size_t)col * g.K; float s = 0.f;
            if constexpr (GSCALE) {
                float rs[9]; for (int j = 0; j < 8; ++j) { float q2 = 0.f; for (int i = 0; i < 16; ++i) q2 += g.ssq[(size_t)row * 128 + 16 * j + i]; rs[j] = 1.0f / sqrtf(q2 * (1.0f / 256.0f) + LN_EPS); } rs[8] = 1.f;
                for (int j = 0; j < 8; ++j) { for (int k = 256 * j; k < 256 * j + 256; ++k) s += bf2f(a[k]) * bf2f(b[k]); s *= rs[j] * (1.0f / rs[j + 1]); } }
            else for (int k = 0; k < g.K; ++k) s += bf2f(a[k]) * bf2f(b[k]);
            acc[ai][bj][m][n][q] = s; }
        E(acc, u, wr, wc, fr, fq);
    }
    __syncthreads();
}
#else
#define PG8_LAS __attribute__((address_space(3)))
__host__ __device__ __forceinline__ int lds_byte(int r, int c) { const int st = (r >> 4) * 2 + (c >> 5), rr = r & 15, cc = c & 31, ob = rr * 64 + cc * 2; return st * 1024 + (ob ^ (((ob >> 9) & 1) << 5)); }
__host__ __device__ __forceinline__ void stage_rc(int b, int& R_, int& C_) { const int st = b / 1024, sb = b % 1024, swz = sb ^ (((sb >> 9) & 1) << 5); R_ = (st >> 1) * 16 + swz / 64; C_ = (st & 1) * 32 + (swz % 64) / 2; }
__host__ __device__ __forceinline__ int perm32(int rho) { const int n = rho >> 4, i = rho & 15; return 8 * (i >> 2) + 4 * n + (i & 3); }
template <class Epi, class Sched, bool GATHER = false, bool GSCALE = false>
__device__ __forceinline__ void gemm_phase(PG8_LAS unsigned char* lds, const Gemm g, const Sched& S, const Epi& E, int wave_id) {
    const int lane = opq(lane_id()), wid = opqs(wave_id), tid = wid * 64 + lane, wr = wid >> 2, wc = wid & 3, fr = lane & 15, fq = lane >> 4;
    const int K = g.K, nt = K / BK, lda = g.lda;
    unsigned voffA[2], voffB[2];
#pragma unroll
    for (int i = 0; i < 2; ++i) { int R_, C_; stage_rc(tid * 16 + i * 8192, R_, C_); const int Rb = (R_ & ~31) + perm32(R_ & 31);
        voffA[i] = (unsigned)(R_ * lda + C_) * 2u; voffB[i] = (unsigned)(Rb * K + C_) * 2u; }
    unsigned vG[2][2], vN[2][2];
#define PG8_TOK(dst, pm_) do { _Pragma("unroll") for (int i_ = 0; i_ < 2; ++i_) { int R_, C_; stage_rc(opq(tid) * 16 + i_ * 8192, R_, C_); _Pragma("unroll") for (int h_ = 0; h_ < 2; ++h_) \
        { unsigned tk_ = (unsigned)g.tok[(pm_) * 256 + h_ * 128 + R_]; tk_ = tk_ < (unsigned)g.M ? tk_ : 0u; dst[h_][i_] = tk_ * (unsigned)(lda * 2) + (unsigned)(C_ * 2); } } } while (0)
#define PG8_STAGE_A(bufoff, base_, h_, nx_) do { if constexpr (GATHER) { unsigned vs_[2] = {(nx_) ? vN[h_][0] : vG[h_][0], (nx_) ? vN[h_][1] : vG[h_][1]}; PG8_STAGE(bufoff, base_, vs_); } \
        else { PG8_STAGE(bufoff, (base_) + ((h_) ? hstepA : 0), voffA); } } while (0)
    const size_t kstep = (size_t)(BK * 2);
    const size_t hstepA = (size_t)HALF * lda * 2, tstepA = 2 * hstepA;
    const size_t hstepB = (size_t)HALF * K * 2, tstepB = 2 * hstepB;
    const unsigned ldsw = (unsigned)wid * 1024u;
    const int aoff = lds_byte(wr * 64 + fr, fq * 8), boff = lds_byte(wc * 32 + fr, fq * 8);
#define PG8_SA(b, h) (((b) * 2 + (h)) * HTB)
#define PG8_SB(b, h) ((4 + (b) * 2 + (h)) * HTB)
#define PG8_STAGE(bufoff, gbase, voff) do { _Pragma("unroll") for (int _i = 0; _i < 2; ++_i) \
        __builtin_amdgcn_global_load_lds((const unsigned*)((const char*)(gbase) + (voff)[_i]), (PG8_LAS unsigned*)(lds + (bufoff) + ldsw + _i * 8192), 16, 0, 0); } while (0)
#define PG8_LDA(dst, b, h) do { _Pragma("unroll") for (int m = 0; m < 4; ++m) _Pragma("unroll") for (int k = 0; k < 2; ++k) dst[m][k] = *(const PG8_LAS bf16x8*)(lds + PG8_SA(b, h) + aoff + m * 2048 + k * 1024); } while (0)
#define PG8_LDB(dst, b, h) do { _Pragma("unroll") for (int n = 0; n < 2; ++n) _Pragma("unroll") for (int k = 0; k < 2; ++k) dst[n][k] = *(const PG8_LAS bf16x8*)(lds + PG8_SB(b, h) + boff + n * 2048 + k * 1024); } while (0)
#define PG8_MMA(ai, bj, At, Bt) do { __builtin_amdgcn_s_setprio(1); _Pragma("unroll") for (int m = 0; m < 4; ++m) _Pragma("unroll") for (int n = 0; n < 2; ++n) _Pragma("unroll") for (int k = 0; k < 2; ++k) \
        acc[ai][bj][m][n] = __builtin_amdgcn_mfma_f32_16x16x32_bf16(Bt[n][k], At[m][k], acc[ai][bj][m][n], 0, 0, 0); __builtin_amdgcn_s_setprio(0); } while (0)
#define PG8_WAIT_V(n) asm volatile("s_waitcnt vmcnt(" #n ")" ::: "memory")
#define PG8_WAIT_L(n) asm volatile("s_waitcnt lgkmcnt(" #n ")" ::: "memory")
#define PG8_BAR __builtin_amdgcn_s_barrier()
#define PG8_SCHED __builtin_amdgcn_sched_barrier(0)
    Unit cur, nxt; int ui = 0;
    if (!S.next(0, cur)) return;
    if constexpr (GSCALE) {
        static_assert(RING_BYTES + 3 * 8192 <= MISC_OFF, "group-norm factor tables");
        Unit tu;
        if (S.next(3, tu)) __builtin_trap();
#pragma unroll 1
        for (int q = 0; q < 3 && S.next(q, tu); ++q) { const int row = tid & 255, h = tid >> 8;
            const float* sp = g.ssq + (size_t)(tu.pm * 256 + row) * 128 + 64 * h; float qv[5];
#pragma unroll
            for (int gi = 0; gi < 5; ++gi) { f32x4 a_ = (f32x4){0.f, 0.f, 0.f, 0.f}, b_ = a_; if (gi < 4 || h == 0) { a_ = *(const f32x4*)(sp + 16 * gi) + *(const f32x4*)(sp + 16 * gi + 8); b_ = *(const f32x4*)(sp + 16 * gi + 4) + *(const f32x4*)(sp + 16 * gi + 12); }
                a_ = a_ + b_; qv[gi] = sqrtf(((a_[0] + a_[1]) + (a_[2] + a_[3])) * (1.0f / 256.0f) + LN_EPS); }
            PG8_LAS float* ct = (PG8_LAS float*)(lds + RING_BYTES) + q * 2048 + 4 * h * 256 + row;
#pragma unroll
            for (int j = 0; j < 4; ++j) ct[j * 256] = (h == 1 && j == 3) ? 1.0f / qv[3] : qv[j + 1] / qv[j]; }
        __syncthreads();
    }
    f32x4 acc[2][2][4][2];
#pragma unroll
    for (int a = 0; a < 2; ++a)
#pragma unroll
        for (int b = 0; b < 2; ++b)
#pragma unroll
            for (int m = 0; m < 4; ++m)
#pragma unroll
                for (int n = 0; n < 2; ++n) acc[a][b][m][n] = (f32x4){0.f, 0.f, 0.f, 0.f};
    bf16x8 At[4][2], B0[2][2], B1[2][2];
    const char* cA = (const char*)g.A + (GATHER ? (size_t)0 : (size_t)cur.pm * tstepA); const char* cB = (const char*)g.Bt + (size_t)cur.bt * tstepB;
    if constexpr (GATHER) { PG8_TOK(vG, cur.pm); }
    S.a_ready(cur);
    PG8_STAGE(PG8_SB(0, 0), cB, voffB); PG8_STAGE(PG8_SB(0, 1), cB + hstepB, voffB); PG8_STAGE_A(PG8_SA(0, 0), cA, 0, false); PG8_STAGE_A(PG8_SA(0, 1), cA, 1, false);
    if (wr == 1) PG8_BAR;
    PG8_WAIT_V(2); PG8_BAR;
    PG8_STAGE(PG8_SB(1, 0), cB + kstep, voffB); PG8_STAGE_A(PG8_SA(1, 0), cA + kstep, 0, false); PG8_STAGE(PG8_SB(1, 1), cB + hstepB + kstep, voffB);
    PG8_WAIT_V(6); PG8_BAR;
    for (;;) {
        const bool has_next = S.next(ui + 1, nxt);
        const char* nA = has_next ? (const char*)g.A + (GATHER ? (size_t)0 : (size_t)nxt.pm * tstepA) : cA; const char* nB = has_next ? (const char*)g.Bt + (size_t)nxt.bt * tstepB : cB;
        if constexpr (GATHER) {
#pragma unroll
            for (int h_ = 0; h_ < 2; ++h_) { vN[h_][0] = vG[h_][0]; vN[h_][1] = vG[h_][1]; }
            if (has_next) {
#pragma unroll
                for (int i_ = 0; i_ < 2; ++i_) { int R_, C_; stage_rc(opq(tid) * 16 + i_ * 8192, R_, C_);
#pragma unroll
                    for (int h_ = 0; h_ < 2; ++h_) { const int* tp_ = g.tok + nxt.pm * 256 + h_ * 128 + R_;
                        asm volatile("global_load_dword %0, %1, off" : "=v"(vN[h_][i_]) : "v"(tp_) : "memory"); } } } }
        for (int t = 0; t < nt; t += 2) {
            const bool last = (t == nt - 2);
            const char* a1 = cA + (size_t)(t + 1) * kstep;
            const char* a2 = last ? nA : cA + (size_t)(t + 2) * kstep; const char* b2 = last ? nB : cB + (size_t)(t + 2) * kstep;
            const char* a3 = a2 + kstep; const char* b3 = b2 + kstep;
            if (last && has_next) S.a_ready(nxt);
            if constexpr (GATHER) { if (last && has_next) {
#pragma unroll
                for (int i_ = 0; i_ < 2; ++i_) { int R_, C_; stage_rc(opq(tid) * 16 + i_ * 8192, R_, C_);
#pragma unroll
                    for (int h_ = 0; h_ < 2; ++h_) { unsigned tk_ = vN[h_][i_]; asm volatile("" : "+v"(tk_)); tk_ = tk_ < (unsigned)g.M ? tk_ : 0u; vN[h_][i_] = tk_ * (unsigned)(lda * 2) + (unsigned)(C_ * 2); } } } }
            PG8_LDB(B0, 0, 0); PG8_LDB(B1, 0, 1); PG8_SCHED; PG8_LDA(At, 0, 0); PG8_STAGE_A(PG8_SA(1, 1), a1, 1, false);
            PG8_WAIT_V(8); PG8_WAIT_L(0); PG8_BAR; PG8_MMA(0, 0, At, B0); PG8_MMA(0, 1, At, B1); PG8_BAR; PG8_SCHED;
            PG8_LDA(At, 0, 1); PG8_STAGE(PG8_SB(0, 0), b2, voffB); PG8_STAGE(PG8_SB(0, 1), b2 + hstepB, voffB); PG8_STAGE_A(PG8_SA(0, 0), a2, 0, last);
            PG8_WAIT_V(8); PG8_WAIT_L(0); PG8_BAR; PG8_MMA(1, 0, At, B0); PG8_MMA(1, 1, At, B1); PG8_BAR; PG8_SCHED;
            PG8_LDB(B0, 1, 0); PG8_LDB(B1, 1, 1); PG8_SCHED; PG8_LDA(At, 1, 0); PG8_STAGE_A(PG8_SA(0, 1), a2, 1, last);
            PG8_WAIT_V(8); PG8_WAIT_L(0); PG8_BAR; PG8_MMA(0, 0, At, B0); PG8_MMA(0, 1, At, B1); PG8_BAR; PG8_SCHED;
            PG8_LDA(At, 1, 1); PG8_STAGE(PG8_SB(1, 0), b3, voffB); PG8_STAGE(PG8_SB(1, 1), b3 + hstepB, voffB); PG8_STAGE_A(PG8_SA(1, 0), a3, 0, last);
            PG8_WAIT_V(8); PG8_WAIT_L(0); PG8_BAR; PG8_MMA(1, 0, At, B0); PG8_MMA(1, 1, At, B1); PG8_BAR; PG8_SCHED;
            if constexpr (GSCALE) { if (t & 2) {
                const PG8_LAS float* cp = (const PG8_LAS float*)(lds + RING_BYTES) + ui * 2048 + (t >> 2) * 256 + wr * 64 + fr; float cv[2][4];
#pragma unroll
                for (int a = 0; a < 2; ++a)
#pragma unroll
                    for (int m = 0; m < 4; ++m) cv[a][m] = cp[a * 128 + m * 16];
#pragma unroll
                for (int a = 0; a < 2; ++a)
#pragma unroll
                    for (int b = 0; b < 2; ++b)
#pragma unroll
                        for (int m = 0; m < 4; ++m)
#pragma unroll
                            for (int n = 0; n < 2; ++n) acc[a][b][m][n] = acc[a][b][m][n] * cv[a][m];
                PG8_SCHED; } }
        }
        if (wr == 0) PG8_BAR;
        E(acc, cur, wr, wc, fr, fq); S.done(cur);
        if (!has_next) break;
#pragma unroll
        for (int a = 0; a < 2; ++a)
#pragma unroll
            for (int b = 0; b < 2; ++b)
#pragma unroll
                for (int m = 0; m < 4; ++m)
#pragma unroll
                    for (int n = 0; n < 2; ++n) acc[a][b][m][n] = (f32x4){0.f, 0.f, 0.f, 0.f};
        cur = nxt; cA = nA; cB = nB; ++ui;
        if constexpr (GATHER) {
#pragma unroll
            for (int h_ = 0; h_ < 2; ++h_) { vG[h_][0] = vN[h_][0]; vG[h_][1] = vN[h_][1]; } }
        if (wr == 1) PG8_BAR;
    }
    PG8_WAIT_V(0);
    PG8_BAR;
#undef PG8_SA
#undef PG8_SB
#undef PG8_STAGE
#undef PG8_STAGE_A
#undef PG8_TOK
#undef PG8_LDA
#undef PG8_LDB
#undef PG8_MMA
#undef PG8_WAIT_V
#undef PG8_WAIT_L
#undef PG8_BAR
#undef PG8_SCHED
}
#endif

struct EpiStoreBf16 {
    bf16_t* O; int ldc;
    __device__ __forceinline__ void operator()(const f32x4 (&acc)[2][2][4][2], const Unit& u, int wr, int wc, int fr, int fq) const {
        const int row0 = u.pm * 256 + wr * 64 + fr, col0 = u.pn * 256 + wc * 32 + 8 * fq;
#pragma unroll
        for (int ai = 0; ai < 2; ++ai)
#pragma unroll
            for (int m = 0; m < 4; ++m)
#pragma unroll
                for (int bj = 0; bj < 2; ++bj) { const f32x4 v0 = acc[ai][bj][m][0], v1 = acc[ai][bj][m][1];
                    u32x4 w; w.x = pk2(v0[0], v0[1]); w.y = pk2(v0[2], v0[3]); w.z = pk2(v1[0], v1[1]); w.w = pk2(v1[2], v1[3]);
                    *(u32x4*)(O + (size_t)(row0 + ai * 128 + m * 16) * ldc + col0 + bj * 128) = w; }
    }
};
template <int MODE> struct EpiGate {
    const bf16_t* Hg; bf16_t* MGb;
    __device__ __forceinline__ void operator()(const f32x4 (&acc)[2][2][4][2], const Unit& u, int wr, int wc, int fr, int fq) const {
        const int row0 = u.pm * 256 + wr * 64 + fr, col0 = u.pn * 256 + wc * 32 + 8 * fq;
#pragma unroll
        for (int ai = 0; ai < 2; ++ai) {
            u32x4 gw[4][2], pw[4][2];
#pragma unroll
            for (int m = 0; m < 4; ++m)
#pragma unroll
                for (int bj = 0; bj < 2; ++bj) { const int row = row0 + ai * 128 + m * 16, col = col0 + bj * 128;
                    gw[m][bj] = *(const u32x4*)(Hg + (size_t)row * DINP + col); if (MODE != 0) pw[m][bj] = *(const u32x4*)(MGb + (size_t)row * D + col); }
            asm volatile("" ::: "memory");
#pragma unroll
            for (int m = 0; m < 4; ++m)
#pragma unroll
                for (int bj = 0; bj < 2; ++bj) { const int row = row0 + ai * 128 + m * 16, col = col0 + bj * 128; const f32x4 v0 = acc[ai][bj][m][0], v1 = acc[ai][bj][m][1];
                    float g[8], p[8], v[8] = {v0[0], v0[1], v0[2], v0[3], v1[0], v1[1], v1[2], v1[3]}; unpack8(gw[m][bj], g);
                    if (MODE != 0) { unpack8(pw[m][bj], p);
#pragma unroll
                        for (int i = 0; i < 8; ++i) v[i] = p[i] + v[i] * fsigmoid(g[i]); }
                    else {
#pragma unroll
                        for (int i = 0; i < 8; ++i) v[i] = v[i] * fsigmoid(g[i]); }
                    *(u32x4*)(MGb + (size_t)row * D + col) = pack8(v); }
            asm volatile("" ::: "memory");
        }
    }
};
struct EpiResid {
    const float* xp; const float* xs; float* op; float* os;
    float* st;
    __device__ __forceinline__ void operator()(const f32x4 (&acc)[2][2][4][2], const Unit& u, int wr, int wc, int fr, int fq) const {
        const int row0 = u.pm * 256 + wr * 64 + fr, col0 = u.pn * 256 + wc * 32 + 8 * fq;
        const bool smp = u.pm * 256 >= NP;
        const float* xb = smp ? xs - (size_t)NP * D : xp; float* ob = smp ? os - (size_t)NP * D : op;
#pragma unroll
        for (int ai = 0; ai < 2; ++ai) {
            f32x4 xa[4][2][2];
#pragma unroll
            for (int m = 0; m < 4; ++m)
#pragma unroll
                for (int bj = 0; bj < 2; ++bj) { const float* xi = xb + (size_t)(row0 + ai * 128 + m * 16) * D + col0 + bj * 128; xa[m][bj][0] = *(const f32x4*)xi; xa[m][bj][1] = *(const f32x4*)(xi + 4); }
            asm volatile("" ::: "memory");
#pragma unroll
            for (int m = 0; m < 4; ++m) { float s1 = 0.f, s2 = 0.f;
#pragma unroll
                for (int bj = 0; bj < 2; ++bj) { float* xo = ob + (size_t)(row0 + ai * 128 + m * 16) * D + col0 + bj * 128;
                    const f32x4 o0 = xa[m][bj][0] * ALPHA + acc[ai][bj][m][0], o1 = xa[m][bj][1] * ALPHA + acc[ai][bj][m][1]; *(f32x4*)xo = o0; *(f32x4*)(xo + 4) = o1;
                    s1 += ((o0[0] + o0[1]) + (o0[2] + o0[3])) + ((o1[0] + o1[1]) + (o1[2] + o1[3])); s2 += ((o0[0] * o0[0] + o0[1] * o0[1]) + (o0[2] * o0[2] + o0[3] * o0[3])) + ((o1[0] * o1[0] + o1[1] * o1[1]) + (o1[2] * o1[2] + o1[3] * o1[3])); }
                s1 += xshfl<16>(s1); s1 += xshfl<32>(s1); s2 += xshfl<16>(s2); s2 += xshfl<32>(s2);
                if (fq == 0) { float* sp = st + (size_t)(row0 + ai * 128 + m * 16) * 32 + 2 * (u.pn * 4 + wc); sp[0] = s1; sp[1] = s2; } }
            asm volatile("" ::: "memory");
        }
    }
};
struct EpiSwiglu {
    bf16_t* ACT; const float* bup;
    __device__ __forceinline__ void operator()(const f32x4 (&acc)[2][2][4][2], const Unit& u, int wr, int wc, int fr, int fq) const {
        const int row0_ = u.pm * 256 + wr * 64 + fr, j0 = u.pn * 128 + wc * 32 + 8 * fq;
        const float* bg = bup + (size_t)u.e * 2048 + j0; const f32x4 bg0 = *(const f32x4*)bg, bg1 = *(const f32x4*)(bg + 4), bu0 = *(const f32x4*)(bg + 1024), bu1 = *(const f32x4*)(bg + 1028);
#pragma unroll
        for (int ai = 0; ai < 2; ++ai)
#pragma unroll
            for (int m = 0; m < 4; ++m) { const int row = row0_ + ai * 128 + m * 16;
                const f32x4 g0 = acc[ai][0][m][0] + bg0, g1 = acc[ai][0][m][1] + bg1, u0 = acc[ai][1][m][0] + bu0, u1 = acc[ai][1][m][1] + bu1; float o[8];
#pragma unroll
                for (int i = 0; i < 4; ++i) { const float ga = fminf(g0[i], SW_LIMIT), ua = fminf(fmaxf(u0[i], -SW_LIMIT), SW_LIMIT); o[i] = (ua + 1.0f) * ga * fsigmoid(SW_ALPHA * ga);
                    const float gb = fminf(g1[i], SW_LIMIT), ub = fminf(fmaxf(u1[i], -SW_LIMIT), SW_LIMIT); o[4 + i] = (ub + 1.0f) * gb * fsigmoid(SW_ALPHA * gb); }
                *(u32x4*)(ACT + (size_t)row * D + j0) = pack8(o); }
    }
};
struct EpiDown {
    bf16_t* O; const float* bdn; const float* gs;
    __device__ __forceinline__ void operator()(const f32x4 (&acc)[2][2][4][2], const Unit& u, int wr, int wc, int fr, int fq) const {
        const int row0 = u.pm * 256 + wr * 64 + fr, col0 = u.pn * 256 + wc * 32 + 8 * fq;
#pragma unroll
        for (int ai = 0; ai < 2; ++ai) {
            float gt[4];
#pragma unroll
            for (int m = 0; m < 4; ++m) gt[m] = gs[row0 + ai * 128 + m * 16];
#pragma unroll
            for (int bj = 0; bj < 2; ++bj) { const float* bp = bdn + (size_t)u.e * D + col0 + bj * 128; const f32x4 b0 = *(const f32x4*)bp, b1 = *(const f32x4*)(bp + 4);
#pragma unroll
                for (int m = 0; m < 4; ++m) { const f32x4 a0 = (acc[ai][bj][m][0] + b0) * gt[m], a1 = (acc[ai][bj][m][1] + b1) * gt[m];
                    u32x4 w; w.x = pk2(a0[0], a0[1]); w.y = pk2(a0[2], a0[3]); w.z = pk2(a1[0], a1[1]); w.w = pk2(a1[2], a1[3]);
                    *(u32x4*)(O + (size_t)(row0 + ai * 128 + m * 16) * D + col0 + bj * 128) = w; } }
            asm volatile("" ::: "memory");
        }
    }
};
}

#ifndef EMU
#define XB_TMO      128
#define XB_XCNT(j)  (256  + 64 * (j))
#define XB_XSUB(j)  (1280 + 64 * (j))
#define XB_XGEN(j)  (2304 + 64 * (j))
#define XB_TOP      3328
#define XB_TOPGEN   3392
#define XCD_BAR_WORDS 3456
#define XB_SPIN_CAP (1u << 27)
__device__ __forceinline__ unsigned xb_ld(unsigned* p)              { return __hip_atomic_load(p, __ATOMIC_RELAXED, __HIP_MEMORY_SCOPE_AGENT); }
__device__ __forceinline__ unsigned xb_add(unsigned* p, unsigned v) { return __hip_atomic_fetch_add(p, v, __ATOMIC_RELAXED, __HIP_MEMORY_SCOPE_AGENT); }
__device__ __forceinline__ unsigned xb_xcc_id() { return (unsigned)__builtin_amdgcn_s_getreg((3 << 11) | 20) & 0xFu; }
#define XB_SPIN(cond, bar) do { unsigned _sp = 0; while (cond) { __builtin_amdgcn_s_sleep(1); \
    if ((++_sp & 255u) == 0u) { if (xb_ld(&(bar)[XB_TMO])) break; if (_sp > XB_SPIN_CAP) { atomicAdd(&(bar)[XB_TMO], 1u); break; } } } } while (0)
struct XcdBarrier { unsigned* bar; unsigned x; volatile LAS unsigned* st; };
__device__ __forceinline__ XcdBarrier xcd_barrier_post(unsigned* bar, volatile LAS unsigned* st) {
    XcdBarrier b; b.bar = bar; b.x = xb_xcc_id(); b.st = st;
    if (threadIdx.x == 0) (void)xb_add(&bar[XB_XCNT(b.x)], 1u);
    return b;
}
__device__ __forceinline__ void xcd_barrier_complete(unsigned* bar, unsigned x, unsigned& nloc, unsigned& nx) {
    const unsigned G = gridDim.x * gridDim.y * gridDim.z;
    unsigned sum, cnt, mine, sp = 0u;
    for (;;) {
        sum = 0u; cnt = 0u; mine = 0u;
#pragma unroll
        for (unsigned j = 0; j < 16; ++j) { const unsigned c = xb_ld(&bar[XB_XCNT(j)]); sum += c; cnt += (c > 0u) ? 1u : 0u; mine = (j == x) ? c : mine; }
        if (sum == G) break;
        __builtin_amdgcn_s_sleep(1);
        if ((++sp & 255u) == 0u) { if (xb_ld(&bar[XB_TMO])) break; if (sp > XB_SPIN_CAP) { atomicAdd(&bar[XB_TMO], 1u); break; } }
    }
    nloc = mine > 0u ? mine : 1u; nx = cnt > 0u ? cnt : 1u;
}
__device__ __forceinline__ void xcd_barrier(const XcdBarrier& b) {
    asm volatile("s_waitcnt vmcnt(0)" ::: "memory");
    __syncthreads();
    if (threadIdx.x == 0) {
        unsigned* bar = b.bar;
        __builtin_amdgcn_s_waitcnt(0);
        unsigned nloc = b.st[0], nx = b.st[1];
        if (nloc == 0u) { xcd_barrier_complete(bar, b.x, nloc, nx); b.st[0] = nloc; b.st[1] = nx; }
        const unsigned old = xb_add(&bar[XB_XSUB(b.x)], 1u);
        const unsigned gen = old / nloc;
        if (old + 1u == (gen + 1u) * nloc) {
            __builtin_amdgcn_fence(__ATOMIC_RELEASE, "agent");
            asm volatile("s_waitcnt vmcnt(0)" ::: "memory");
            const unsigned og = xb_add(&bar[XB_TOP], 1u);
            const unsigned tg = og / nx;
            if (og + 1u == (tg + 1u) * nx) xb_add(&bar[XB_TOPGEN], 1u);
            else XB_SPIN(xb_ld(&bar[XB_TOPGEN]) == tg, bar);
            __builtin_amdgcn_fence(__ATOMIC_ACQUIRE, "agent");
            xb_add(&bar[XB_XGEN(b.x)], 1u);
            asm volatile("s_waitcnt vmcnt(0)" ::: "memory");
        } else {
            XB_SPIN(xb_ld(&bar[XB_XGEN(b.x)]) == gen, bar);
            __builtin_amdgcn_fence(__ATOMIC_ACQUIRE, "agent");
            asm volatile("s_waitcnt vmcnt(0)" ::: "memory");
        }
    }
    __syncthreads();
}
#endif

struct Args { const float* in[31]; float* out; unsigned char* ws; int lo, hi; };
typedef const float* FPtr;
#ifdef EMU
typedef const FPtr* ArgTab;
#else
typedef const __attribute__((address_space(4))) FPtr* ArgTab;
#endif
struct Frame {
    LAS unsigned char* lds; int tid, lane, wave, G, bid;
    ArgTab in; float* out; unsigned char* ws; unsigned* ctl;
};
enum { I_XP = 0, I_XS, I_CK, I_CV, I_SST, I_SCV, I_SSC, I_WIN, I_CONVW, I_CONVB, I_DTB, I_ALOG, I_SD, I_NORMW, I_WSSD, I_SINK, I_WATT, I_RELB, I_SCW, I_WSC, I_WO, I_LN1G, I_LN1B,
       I_RW, I_RB, I_WUP, I_BUP, I_WDN, I_BDN, I_LN2G, I_LN2B };

__device__ __forceinline__ bf16_t* ws_bf(const Frame& F, size_t off) { return (bf16_t*)(F.ws + off); }
__device__ __forceinline__ float* ws_f(const Frame& F, size_t off) { return (float*)(F.ws + off); }
__device__ __forceinline__ bf16_t* wl_ptr(const Frame& F, int layer, size_t off) { return (bf16_t*)(F.ws + WS_W + (size_t)layer * WL_BYTES + off); }

__device__ __forceinline__ void wt_item(const float* W, int ldw, int K, int k0, int nsrc0, const float* kscale, bf16_t* WT, int ndst0, LAS float* scr, int lane) {
    if (nsrc0 < 0) {
#pragma unroll
        for (int j = 0; j < 4; ++j) { const int n = (lane >> 3) + 8 * j; *(u32x4*)(WT + (size_t)(ndst0 + n) * K + k0 + 8 * (lane & 7)) = (u32x4){0u, 0u, 0u, 0u}; }
        return;
    }
#pragma unroll 8
    for (int i = 0; i < 32; ++i) { const int kk = 2 * i + (lane >> 5); float v = W[(size_t)(k0 + kk) * ldw + nsrc0 + (lane & 31)]; if (kscale) v *= kscale[k0 + kk]; scr[kk * 33 + (lane & 31)] = v; }
    WAVE_SYNC();
    const int c = lane & 7;
#pragma unroll
    for (int j = 0; j < 4; ++j) { const int n = (lane >> 3) + 8 * j; const LAS float* s = scr + (8 * c) * 33 + n;
        u32x4 o; o.x = pk2(s[0 * 33], s[1 * 33]); o.y = pk2(s[2 * 33], s[3 * 33]); o.z = pk2(s[4 * 33], s[5 * 33]); o.w = pk2(s[6 * 33], s[7 * 33]);
        *(u32x4*)(WT + (size_t)(ndst0 + n) * K + k0 + 8 * c) = o; }
    WAVE_SYNC();
}
__device__ __forceinline__ void step_weights(const Frame& F) {
    LAS float* scr = (LAS float*)(F.lds + F.wave * 16384);
    const int gw = F.bid * NWAVES + F.wave, NGW = F.G * NWAVES;
    constexpr int I_IN = (DINP / 32) * (D / 64), I_SSD = (D / 32) * (DINNER / 64), I_SQ = (D / 32) * (D / 64), I_UP = NEXP * (2048 / 32) * (D / 64), I_DN = NEXP * (D / 32) * (D / 64);
    constexpr int PER_LAYER = I_IN + I_SSD + 3 * I_SQ + I_UP + I_DN;
    for (int it = gw; it < DEPTH * PER_LAYER; it += NGW) {
        const int layer = it / PER_LAYER; int r = it % PER_LAYER;
        if (r < I_IN) { const int nb = r / (D / 64), kb = r % (D / 64), n0 = nb * 32;
            const int ns = n0 < 6144 ? n0 : (n0 < 13824 ? n0 + 32 : (n0 < 13856 ? n0 - 13824 + 6144 : -1));
            wt_item(F.in[I_WIN] + (size_t)layer * D * DIN, DIN, D, kb * 64, ns, nullptr, wl_ptr(F, layer, WL_IN), n0, scr, F.lane); continue; }
        r -= I_IN;
        if (r < I_SSD) { const int nb = r / (DINNER / 64), kb = r % (DINNER / 64);
            wt_item(F.in[I_WSSD] + (size_t)layer * DINNER * D, D, DINNER, kb * 64, nb * 32, F.in[I_NORMW] + (size_t)layer * DINNER, wl_ptr(F, layer, WL_SSD), nb * 32, scr, F.lane); continue; }
        r -= I_SSD;
        if (r < I_SQ) { const int nb = r / (D / 64), kb = r % (D / 64); wt_item(F.in[I_WATT] + (size_t)layer * D * D, D, D, kb * 64, nb * 32, nullptr, wl_ptr(F, layer, WL_ATT), nb * 32, scr, F.lane); continue; }
        r -= I_SQ;
        if (r < I_SQ) { const int nb = r / (D / 64), kb = r % (D / 64); wt_item(F.in[I_WSC] + (size_t)layer * D * D, D, D, kb * 64, nb * 32, nullptr, wl_ptr(F, layer, WL_SC), nb * 32, scr, F.lane); continue; }
        r -= I_SQ;
        if (r < I_SQ) { const int nb = r / (D / 64), kb = r % (D / 64); wt_item(F.in[I_WO] + (size_t)layer * D * D, D, D, kb * 64, nb * 32, nullptr, wl_ptr(F, layer, WL_O), nb * 32, scr, F.lane); continue; }
        r -= I_SQ;
        if (r < I_UP) { const int e = r / ((2048 / 32) * (D / 64)), q = r % ((2048 / 32) * (D / 64)), nb = q / (D / 64), kb = q % (D / 64), n0 = nb * 32;
            const int pn = n0 >> 8, bj = (n0 >> 7) & 1, jj = n0 & 127, ns = bj * 1024 + pn * 128 + jj;
            wt_item(F.in[I_WUP] + ((size_t)layer * NEXP + e) * D * 2048, 2048, D, kb * 64, ns, nullptr, wl_ptr(F, layer, WL_UP) + (size_t)e * 2048 * D, n0, scr, F.lane); continue; }
        r -= I_UP;
        { const int e = r / ((D / 32) * (D / 64)), q = r % ((D / 32) * (D / 64)), nb = q / (D / 64), kb = q % (D / 64);
            wt_item(F.in[I_WDN] + ((size_t)layer * NEXP + e) * D * D, D, D, kb * 64, nb * 32, nullptr, wl_ptr(F, layer, WL_DN) + (size_t)e * D * D, nb * 32, scr, F.lane); }
    }
}

__device__ __forceinline__ const float* x_in_row(const Frame& F, int layer, int mb, int r) {
    if (layer == 0) return r < NP ? F.in[I_XP] + ((size_t)mb * NP + r) * D : F.in[I_XS] + (size_t)(r - NP) * D;
    return r < NP ? F.out + O_YP + ((size_t)mb * NP + r) * D : F.out + O_YS + (size_t)(r - NP) * D;
}
__device__ __forceinline__ float* x_out_row(const Frame& F, int mb, int r) { return r < NP ? F.out + O_YP + ((size_t)mb * NP + r) * D : F.out + O_YS + (size_t)(r - NP) * D; }
__device__ __forceinline__ int rows_of(int mb) { return mb == 0 ? R : NP; }

__device__ __forceinline__ void step_xb(const Frame& F, int mb) {
    const int gw = F.bid * NWAVES + F.wave, NGW = F.G * NWAVES, nr = rows_of(mb);
    bf16_t* XB = ws_bf(F, WS_XB0) + (size_t)mb * R * D;
    for (int r = gw; r < nr; r += NGW) {
        const f32x4* xr = (const f32x4*)x_in_row(F, 0, mb, r) + F.lane; u32x2* o = (u32x2*)(XB + (size_t)r * D) + F.lane;
#pragma unroll
        for (int j = 0; j < 4; ++j) { const f32x4 v = xr[64 * j]; u32x2 w; w.x = pk2(v[0], v[1]); w.y = pk2(v[2], v[3]); o[64 * j] = w; }
    }
}

__device__ __forceinline__ float softplus_f(float x) { const float e = fexp(x); return x > 20.f ? x : (e < 0.01f ? e * (1.0f - e * (0.5f - e * 0.33333333f)) : __builtin_amdgcn_logf(1.0f + e) * 0.69314718056f); }
constexpr int S128 = 136, S64 = 72;
constexpr int BL_BM = 0, BL_CM = BL_BM + 64 * S128 * 2, BL_CB = BL_CM + 64 * S128 * 2, BL_END = BL_CB + 64 * S64 * 2;
struct BcRegs { u32x4 raw[7]; f32x4 wq[4][2], bq[2]; };
__device__ __forceinline__ void ssd_bc_load(const Frame& F, int layer, int u, BcRegs& R_) {
    const int sl = (u / NCHUNK) % NSEQ_MB, ck = u % NCHUNK, g = u / (NCHUNK * NSEQ_MB); const int tid = F.tid;
    const bf16_t* H = ws_bf(F, WS_H) + (size_t)sl * SEQ * DINP; const int cgi = tid & 31, rb = tid >> 5; const int xc = (cgi < 16 ? 2048 : 3072) + g * 128 + 8 * (cgi & 15);
#pragma unroll
    for (int i = 0; i < 7; ++i) { const int t = ck * 64 + 4 * rb - 3 + i; R_.raw[i] = t >= 0 ? *(const u32x4*)(H + (size_t)t * DINP + C_X + xc) : (u32x4){0u, 0u, 0u, 0u}; }
    const float* convw = F.in[I_CONVW] + (size_t)layer * 4 * CONVDIM + xc; const float* convb = F.in[I_CONVB] + (size_t)layer * CONVDIM + xc;
#pragma unroll
    for (int tp = 0; tp < 4; ++tp) { R_.wq[tp][0] = *(const f32x4*)(convw + tp * CONVDIM); R_.wq[tp][1] = *(const f32x4*)(convw + tp * CONVDIM + 4); }
    R_.bq[0] = *(const f32x4*)convb; R_.bq[1] = *(const f32x4*)(convb + 4);
}
__device__ __forceinline__ void ssd_bc_unit(const Frame& F, int u, const BcRegs& R_) {
    const int sl = (u / NCHUNK) % NSEQ_MB, ck = u % NCHUNK, g = u / (NCHUNK * NSEQ_MB);
    const int tid = F.tid, lane = F.lane, w = F.wave, fr = lane & 15, fq = lane >> 4;
    LAS bf16_t* Bm = (LAS bf16_t*)(F.lds + BL_BM); LAS bf16_t* Cm = (LAS bf16_t*)(F.lds + BL_CM); LAS bf16_t* CBs = (LAS bf16_t*)(F.lds + BL_CB);
    const size_t rowg = (size_t)sl * SEQ + (size_t)ck * 64; const size_t tix = ((size_t)sl * NCHUNK + ck) * 8 + g;
    const int cgi = tid & 31, rb = tid >> 5; const bool isB = cgi < 16; const int n0 = 8 * (cgi & 15);
    const u32x4 (&raw)[7] = R_.raw; const f32x4 (&wq)[4][2] = R_.wq; const f32x4 (&bq)[2] = R_.bq;
    __syncthreads();
    { float val[4][8];
#pragma unroll
      for (int r = 0; r < 4; ++r) { float a[8] = {bq[0][0], bq[0][1], bq[0][2], bq[0][3], bq[1][0], bq[1][1], bq[1][2], bq[1][3]};
#pragma unroll
          for (int tp = 0; tp < 4; ++tp) { float f[8]; unpack8(raw[r + tp], f);
#pragma unroll
              for (int i = 0; i < 4; ++i) { a[i] += f[i] * wq[tp][0][i]; a[4 + i] += f[4 + i] * wq[tp][1][i]; } }
#pragma unroll
          for (int i = 0; i < 8; ++i) val[r][i] = fsilu(a[i]); }
      if (isB) { bf16_t* bt = ws_bf(F, WS_BTG) + tix * 8192 + (size_t)n0 * 64 + 4 * rb;
#pragma unroll
          for (int r = 0; r < 4; ++r) *(LAS u32x4*)(Bm + (4 * rb + r) * S128 + n0) = pack8(val[r]);
#pragma unroll
          for (int i = 0; i < 8; ++i) { u32x2 wv; wv.x = pk2(val[0][i], val[1][i]); wv.y = pk2(val[2][i], val[3][i]); *(u32x2*)(bt + (size_t)i * 64) = wv; } }
      else { bf16_t* cmc = ws_bf(F, WS_CMC) + (rowg + 4 * rb) * 1024 + g * 128 + n0;
#pragma unroll
          for (int r = 0; r < 4; ++r) { const u32x4 pk = pack8(val[r]); *(LAS u32x4*)(Cm + (4 * rb + r) * S128 + n0) = pk; *(u32x4*)(cmc + (size_t)r * 1024) = pk; } } }
    __syncthreads();
    { const int ti = w >> 1;
#pragma unroll
      for (int jj = 0; jj < 2; ++jj) { const int tj = 2 * (w & 1) + jj; f32x4 cb = (f32x4){0.f, 0.f, 0.f, 0.f};
          if (tj <= ti) {
#pragma unroll
              for (int ks = 0; ks < 4; ++ks) { const bf16x8 a = *(const LAS bf16x8*)(Cm + (16 * ti + fr) * S128 + 32 * ks + 8 * fq); const bf16x8 b = *(const LAS bf16x8*)(Bm + (16 * tj + fr) * S128 + 32 * ks + 8 * fq);
                  cb = __builtin_amdgcn_mfma_f32_16x16x32_bf16(a, b, cb, 0, 0, 0); } }
#pragma unroll
          for (int r = 0; r < 4; ++r) CBs[(16 * ti + 4 * fq + r) * S64 + 16 * tj + fr] = bf1(cb[r]); } }
    __syncthreads();
    { const int row = tid >> 3, cc = tid & 7; *(u32x4*)(ws_bf(F, WS_CBG) + tix * 4096 + row * 64 + 8 * cc) = *(const LAS u32x4*)(CBs + row * S64 + 8 * cc); }
}

constexpr int SL_CM = 0, SL_BT = SL_CM + 64 * S128 * 2, SL_CB = SL_BT + 128 * S64 * 2, SL_DMA_SZ = SL_CB + 64 * S64 * 2, SL_DMA_END = 2 * SL_DMA_SZ;
constexpr int SL_XT = SL_DMA_END, SL_XTW = SL_XT + 2 * 64 * S64 * 2, SL_MM = SL_XTW + 2 * 64 * S64 * 2, SL_SM = SL_MM + 2 * 64 * S64 * 2, SL_END = SL_SM + 3 * 384 * 4;
static_assert(SL_END <= SCR_BYTES && SL_DMA_SZ == 2816 * 16, "ssd LDS map");
#ifdef EMU
#define SSD_DMA_ONE(gp_, dst_) memcpy((unsigned char*)(dst_) + lane * 16, (gp_), 16)
#else
#define SSD_DMA_ONE(gp_, dst_) __builtin_amdgcn_global_load_lds((const unsigned*)(gp_), (LAS unsigned*)(dst_), 16, 0, 0)
#endif
#define SSD_DMA_SETUP() do { _Pragma("unroll") for (int j_ = 0; j_ < 6; ++j_) { const int pc_ = w * 6 + j_; const int q_ = pc_ * 64 + lane; const size_t tx0_ = ((size_t)sl * NCHUNK) * 8 + g; \
        if (pc_ < 17) { const int r_ = q_ / 17; int c_ = q_ % 17; c_ = c_ < 16 ? c_ : 15; dsrc[j_] = cmc + (size_t)r_ * 1024 + 8 * c_; } \
        else if (pc_ < 35) { const int q2_ = q_ - 1088, r_ = q2_ / 9; int c_ = q2_ % 9; c_ = c_ < 8 ? c_ : 7; dsrc[j_] = btg + tx0_ * 8192 + r_ * 64 + 8 * c_; } \
        else { const int q3_ = q_ - 2240, r_ = q3_ / 9; int c_ = q3_ % 9; c_ = c_ < 8 ? c_ : 7; dsrc[j_] = cbg + tx0_ * 4096 + r_ * 64 + 8 * c_; } } } while (0)
#define SSD_DMA2(ca_, cb_) do { _Pragma("unroll") for (int j_ = 0; j_ < 6; ++j_) { const int pc_ = w * 6 + j_; \
        if (pc_ < 35) { if ((ca_) < NCHUNK) { SSD_DMA_ONE(dsrc[j_], L + ((ca_) & 1) * SL_DMA_SZ + SL_CM + pc_ * 1024); dsrc[j_] += pc_ < 17 ? (size_t)64 * 1024 : (size_t)8 * 8192; } } \
        else if (pc_ < 44) { if ((cb_) < NCHUNK) { SSD_DMA_ONE(dsrc[j_], L + ((cb_) & 1) * SL_DMA_SZ + SL_CM + pc_ * 1024); dsrc[j_] += (size_t)8 * 4096; } } } } while (0)
#define SSD_TABLE(tb_, dtr_) do { const float dt_ = softplus_f(bf2f(dtr_) + dtb); \
        float cs_ = Ah * dt_; _Pragma("unroll") for (int o = 1; o < 64; o <<= 1) { const float t2_ = __shfl(cs_, lane - o < 0 ? 0 : lane - o); if (lane >= o) cs_ += t2_; } \
        const float tot_ = __shfl(cs_, 63); (tb_)[lane] = dt_; (tb_)[64 + lane] = cs_; (tb_)[128 + lane] = fexp(tot_ - cs_); (tb_)[192 + lane] = fexp(cs_); if (lane == 0) (tb_)[256] = fexp(tot_); (tb_)[320 + lane] = Dh * __builtin_amdgcn_rcpf(dt_); } while (0)

__device__ __forceinline__ void ssd_prompt_unit(const Frame& F, int layer, int mb, int sl, int hd) {
    const int tid = F.tid, lane = F.lane, w = F.wave, fr = lane & 15, fq = lane >> 4;
    LAS unsigned char* L = F.lds;
    LAS bf16_t* XT0 = (LAS bf16_t*)(L + SL_XT); LAS bf16_t* XTW0 = (LAS bf16_t*)(L + SL_XTW); LAS bf16_t* Mm0 = (LAS bf16_t*)(L + SL_MM);
    LAS float* smb = (LAS float*)(L + SL_SM);
    const int g = hd >> 2;
    bf16_t* H = ws_bf(F, WS_H) + (size_t)sl * SEQ * DINP;
    const bf16_t* cmc = ws_bf(F, WS_CMC) + (size_t)sl * SEQ * 1024 + g * 128; const bf16_t* btg = ws_bf(F, WS_BTG); const bf16_t* cbg = ws_bf(F, WS_CBG);
    __syncthreads();
    const bf16_t* dsrc[6]; SSD_DMA_SETUP();
    SSD_DMA2(NCHUNK, 0);
    if (w < 4) {
        const int pb = w;
        f32x4 St[8];
#pragma unroll
        for (int t = 0; t < 8; ++t) St[t] = (f32x4){0.f, 0.f, 0.f, 0.f};
        bf16_t* pz = H + (size_t)fr * DINP + C_Z + hd * 64 + 16 * pb + 4 * fq; float* pss = ws_f(F, WS_SSQ) + ((size_t)sl * SEQ + fr) * 128 + hd * 4 + pb;
        u32x2 zraw[4];
        VM_WAIT(0); __syncthreads();
        for (int it = -1; it < NCHUNK; ++it) {
            u32x2 zc[4];
#pragma unroll
            for (int lb = 0; lb < 4; ++lb) zc[lb] = zraw[lb];
            SSD_DMA2(it + 1, it + 2);
            if (it + 1 < NCHUNK) {
#pragma unroll
                for (int lb = 0; lb < 4; ++lb) zraw[lb] = *(const u32x2*)(pz + (size_t)(it >= 0 ? 64 : 0) * DINP + (size_t)lb * 16 * DINP); }
            asm volatile("" ::: "memory");
            if (it >= 0) { const int par = it & 1; LAS float* sm = smb + (it % 3) * 384;
                LAS bf16_t* Cm = (LAS bf16_t*)(L + par * SL_DMA_SZ + SL_CM); LAS bf16_t* BT = (LAS bf16_t*)(L + par * SL_DMA_SZ + SL_BT);
                LAS bf16_t* XT = XT0 + par * 64 * S64; LAS bf16_t* XTW = XTW0 + par * 64 * S64; LAS bf16_t* Mm = Mm0 + par * 64 * S64;
                bf16x8 sa[4];
#pragma unroll
                for (int ks = 0; ks < 4; ++ks) { u32x4 wv; wv.x = pk2(St[2 * ks][0], St[2 * ks][1]); wv.y = pk2(St[2 * ks][2], St[2 * ks][3]); wv.z = pk2(St[2 * ks + 1][0], St[2 * ks + 1][1]); wv.w = pk2(St[2 * ks + 1][2], St[2 * ks + 1][3]);
                    sa[ks] = __builtin_bit_cast(bf16x8, wv); }
                f32x4 yo[4];
#pragma unroll
                for (int lb = 0; lb < 4; ++lb) { yo[lb] = (f32x4){0.f, 0.f, 0.f, 0.f};
#pragma unroll
                    for (int ks = 0; ks < 4; ++ks) { const LAS bf16_t* cp = Cm + (16 * lb + fr) * S128 + 32 * ks + 4 * fq; const u32x2 c0 = *(const LAS u32x2*)cp, c1 = *(const LAS u32x2*)(cp + 16);
                        u32x4 cw; cw.x = c0.x; cw.y = c0.y; cw.z = c1.x; cw.w = c1.y; yo[lb] = __builtin_amdgcn_mfma_f32_16x16x32_bf16(sa[ks], __builtin_bit_cast(bf16x8, cw), yo[lb], 0, 0, 0); } }
                { const float cd = sm[256]; bf16x8 bx[2];
#pragma unroll
                  for (int ks = 0; ks < 2; ++ks) bx[ks] = *(const LAS bf16x8*)(XTW + (16 * pb + fr) * S64 + 32 * ks + 8 * fq);
#pragma unroll
                  for (int t = 0; t < 8; ++t) { St[t] = St[t] * cd;
#pragma unroll
                    for (int ks = 0; ks < 2; ++ks) { const bf16x8 a = *(const LAS bf16x8*)(BT + (16 * t + fr) * S64 + 32 * ks + 8 * fq); St[t] = __builtin_amdgcn_mfma_f32_16x16x32_bf16(a, bx[ks], St[t], 0, 0, 0); } } }
                { bf16x8 xa[2];
#pragma unroll
                  for (int ks = 0; ks < 2; ++ks) xa[ks] = *(const LAS bf16x8*)(XT + (16 * pb + fr) * S64 + 32 * ks + 8 * fq);
#pragma unroll
                  for (int lb = 0; lb < 4; ++lb) { f32x4 yd = (f32x4){0.f, 0.f, 0.f, 0.f};
#pragma unroll
                    for (int ks = 0; ks < 2; ++ks) { const bf16x8 b = *(const LAS bf16x8*)(Mm + (16 * lb + fr) * S64 + 32 * ks + 8 * fq); yd = __builtin_amdgcn_mfma_f32_16x16x32_bf16(xa[ks], b, yd, 0, 0, 0); }
                    const float ec = sm[192 + 16 * lb + fr]; const float z[4] = {blo(zc[lb].x), bhi(zc[lb].x), blo(zc[lb].y), bhi(zc[lb].y)}; float v[4], ss = 0.f;
#pragma unroll
                    for (int r = 0; r < 4; ++r) { v[r] = (yd[r] + ec * yo[lb][r]) * fsilu(z[r]); ss += v[r] * v[r]; }
                    u32x2 ov; ov.x = pk2(v[0], v[1]); ov.y = pk2(v[2], v[3]); *(u32x2*)(pz + (size_t)lb * 16 * DINP) = ov;
                    ss += xshfl<16>(ss); ss += xshfl<32>(ss);
                    if (fq == 0) pss[(size_t)lb * 16 * 128] = ss; } }
                pz += (size_t)64 * DINP; pss += 64 * 128; }
            if (it < 0) VM_WAIT(0); else VM_WAIT(7);
            LBAR();
        }
        float* so = F.out + O_SSP + ((((size_t)layer * BATCH + mb * NSEQ_MB + sl) * 32 + hd) * 64) * 128;
#pragma unroll
        for (int t = 0; t < 8; ++t) *(f32x4*)(so + (size_t)(16 * pb + fr) * 128 + 16 * t + 4 * fq) = St[t];
    } else {
        const int pw = w - 4, pt = tid - 256;
        const float* convw = F.in[I_CONVW] + (size_t)layer * 4 * CONVDIM + hd * 64; const float* convb = F.in[I_CONVB] + (size_t)layer * CONVDIM + hd * 64;
        const float cw0 = convw[lane], cw1 = convw[CONVDIM + lane], cw2 = convw[2 * CONVDIM + lane], cw3 = convw[3 * CONVDIM + lane], cwb = convb[lane];
        const float dtb = F.in[I_DTB][layer * 32 + hd], Ah = -fexp(F.in[I_ALOG][layer * 32 + hd]), Dh = F.in[I_SD][layer * 32 + hd];
        const int ml = pt >> 2, ms0 = 16 * (pt & 3);
        unsigned rawx[19]; unsigned dtr_next = 0u;
#pragma unroll
        for (int i = 0; i < 19; ++i) { const int t_ = 16 * pw - 3 + i; rawx[i] = t_ >= 0 ? (unsigned)H[(size_t)t_ * DINP + C_X + hd * 64 + lane] : 0u; }
        if (pw == 3) { const unsigned d0 = H[(size_t)lane * DINP + C_DT + hd]; if (NCHUNK > 1) dtr_next = H[(size_t)(64 + lane) * DINP + C_DT + hd]; SSD_TABLE(smb, d0); }
        VM_WAIT(0); __syncthreads();
        for (int it = -1; it < NCHUNK; ++it) { const int pc = it + 1;
            SSD_DMA2(it + 1, it + 2);
            const unsigned dtr_cur = dtr_next;
            if (pc < NCHUNK) { const int par = pc & 1; LAS float* sm = smb + (pc % 3) * 384; const LAS bf16_t* CBl = (const LAS bf16_t*)(L + par * SL_DMA_SZ + SL_CB);
                LAS bf16_t* XT = XT0 + par * 64 * S64; LAS bf16_t* XTW = XTW0 + par * 64 * S64; LAS bf16_t* Mm = Mm0 + par * 64 * S64;
                { float xr[19];
#pragma unroll
                  for (int i = 0; i < 19; ++i) xr[i] = blo(rawx[i]);
                  if (pc + 1 < NCHUNK) { const bf16_t* px_ = H + ((size_t)(pc + 1) * 64 + 16 * pw - 3) * DINP + C_X + hd * 64 + lane;
#pragma unroll
                      for (int i = 0; i < 19; ++i) rawx[i] = (unsigned)px_[(size_t)i * DINP]; }
                  if (pw == 3 && pc + 2 < NCHUNK) dtr_next = H[((size_t)(pc + 2) * 64 + lane) * DINP + C_DT + hd];
                  asm volatile("" ::: "memory");
#pragma unroll
                  for (int hq = 0; hq < 2; ++hq) { const f32x4 d0 = *(const LAS f32x4*)(sm + 16 * pw + 8 * hq), d1 = *(const LAS f32x4*)(sm + 16 * pw + 8 * hq + 4), e0 = *(const LAS f32x4*)(sm + 128 + 16 * pw + 8 * hq), e1 = *(const LAS f32x4*)(sm + 128 + 16 * pw + 8 * hq + 4);
                      const float dtv[8] = {d0[0], d0[1], d0[2], d0[3], d1[0], d1[1], d1[2], d1[3]}, wdv[8] = {e0[0], e0[1], e0[2], e0[3], e1[0], e1[1], e1[2], e1[3]}; float xa[8], xb[8];
#pragma unroll
                      for (int r = 0; r < 8; ++r) { const int q = 8 * hq + r; const float xd = fsilu(cwb + xr[q] * cw0 + xr[q + 1] * cw1 + xr[q + 2] * cw2 + xr[q + 3] * cw3) * dtv[r]; xa[r] = xd; xb[r] = xd * wdv[r]; }
                      *(LAS u32x4*)(XT + lane * S64 + 16 * pw + 8 * hq) = pack8(xa); *(LAS u32x4*)(XTW + lane * S64 + 16 * pw + 8 * hq) = pack8(xb); } }
#pragma unroll
                for (int hq = 0; hq < 2; ++hq) { const int s0 = ms0 + 8 * hq; float mv[8];
                    if (s0 <= ml) { float cbv[8]; unpack8(*(const LAS u32x4*)(CBl + ml * S64 + s0), cbv); const float al = sm[64 + ml]; const f32x4 a0 = *(const LAS f32x4*)(sm + 64 + s0), a1 = *(const LAS f32x4*)(sm + 64 + s0 + 4);
#pragma unroll
                        for (int i = 0; i < 4; ++i) { mv[i] = (ml >= s0 + i) ? cbv[i] * fexp(fminf(al - a0[i], 0.f)) : 0.f; mv[4 + i] = (ml >= s0 + 4 + i) ? cbv[4 + i] * fexp(fminf(al - a1[i], 0.f)) : 0.f; }
                        if ((ml >> 3) == (s0 >> 3)) { const float dd = sm[320 + ml];
#pragma unroll
                            for (int i = 0; i < 8; ++i) if (i == (ml & 7)) mv[i] += dd; } }
                    else {
#pragma unroll
                        for (int i = 0; i < 8; ++i) mv[i] = 0.f; }
                    *(LAS u32x4*)(Mm + ml * S64 + s0) = pack8(mv); } }
            if (pw == 3 && it + 2 < NCHUNK) { LAS float* smn = smb + ((it + 2) % 3) * 384; SSD_TABLE(smn, dtr_cur); }
            VM_WAIT(0);
            LBAR();
        }
    }
    VM_WAIT(0); __syncthreads();
}

__device__ __forceinline__ void ssd_sample_unit(const Frame& F, int layer, int sq, int hd) {
    const int tid = F.tid, lane = F.lane; LAS float* L = (LAS float*)F.lds;
    LAS float* xs = L; LAS float* Bs = L + 16 * 64; LAS float* Cs = Bs + 16 * 128; LAS float* dts = Cs + 16 * 128; LAS float* das = dts + 16; LAS float* Yl = das + 16;
    const int g = hd >> 2;
    bf16_t* H = ws_bf(F, WS_H) + (size_t)(NP + sq * 16) * DINP;
    const float* hist = F.in[I_SCV] + ((size_t)layer * DECB + sq) * 3 * CONVDIM;
    const float* convw = F.in[I_CONVW] + (size_t)layer * 4 * CONVDIM; const float* convb = F.in[I_CONVB] + (size_t)layer * CONVDIM;
    __syncthreads();
    if (tid < 320) { const int c = tid; const int xc = c < 64 ? hd * 64 + c : (c < 192 ? 2048 + g * 128 + (c - 64) : 3072 + g * 128 + (c - 192));
        float win[19];
#pragma unroll
        for (int i = 0; i < 3; ++i) win[i] = hist[i * CONVDIM + xc];
#pragma unroll
        for (int t = 0; t < 16; ++t) win[3 + t] = bf2f(H[(size_t)t * DINP + C_X + xc]);
        const float w0 = convw[xc], w1 = convw[CONVDIM + xc], w2 = convw[2 * CONVDIM + xc], w3 = convw[3 * CONVDIM + xc], bb = convb[xc];
#pragma unroll
        for (int t = 0; t < 16; ++t) { const float a = fsilu(bb + win[t] * w0 + win[t + 1] * w1 + win[t + 2] * w2 + win[t + 3] * w3);
            if (c < 64) xs[t * 64 + c] = a; else if (c < 192) Bs[t * 128 + c - 64] = a; else Cs[t * 128 + c - 192] = a; } }
    if (tid < 16) { const float dt = softplus_f(bf2f(H[(size_t)tid * DINP + C_DT + hd]) + F.in[I_DTB][layer * 32 + hd]); dts[tid] = dt; das[tid] = fexp(-fexp(F.in[I_ALOG][layer * 32 + hd]) * dt); }
    __syncthreads();
    const int p = tid >> 3, n0 = (tid & 7) * 16;
    const size_t sbase = ((((size_t)layer * DECB + sq) * 32 + hd) * 64 + p) * 128 + n0;
    float S[16];
#pragma unroll
    for (int i = 0; i < 16; ++i) S[i] = F.in[I_SST][sbase + i];
    for (int t = 0; t < 16; ++t) { const float dec = das[t], xv = xs[t * 64 + p] * dts[t]; float part = 0.f;
#pragma unroll
        for (int i = 0; i < 16; ++i) { S[i] = S[i] * dec + xv * Bs[t * 128 + n0 + i]; part += Cs[t * 128 + n0 + i] * S[i]; }
        part += __shfl_xor(part, 1); part += __shfl_xor(part, 2); part += __shfl_xor(part, 4);
        if ((tid & 7) == 0) Yl[t * 64 + p] = part; }
#pragma unroll
    for (int i = 0; i < 16; ++i) F.out[O_SSS + sbase + i] = S[i];
    __syncthreads();
    const float Dh = F.in[I_SD][layer * 32 + hd];
#pragma unroll
    for (int j = 0; j < 2; ++j) { const int it = tid + 512 * j, t = it >> 6, pp = it & 63;
        const float z = bf2f(H[(size_t)t * DINP + C_Z + hd * 64 + pp]); const float v = (Yl[t * 64 + pp] + Dh * xs[t * 64 + pp]) * fsilu(z);
        H[(size_t)t * DINP + C_Z + hd * 64 + pp] = bf1(v);
        const float ss = wave_sum(v * v);
        if (lane < 4) ws_f(F, WS_SSQ)[((size_t)NP + sq * 16 + t) * 128 + hd * 4 + lane] = lane == 0 ? ss : 0.f; }
}

__device__ __forceinline__ int t5_bucket(int rel) {
    const int n = rel < 0 ? -rel : rel; const int b = rel > 0 ? 16 : 0;
    if (n < 8) return b + n;
    int v = 8; v += n >= 12; v += n >= 16; v += n >= 23; v += n >= 32; v += n >= 46; v += n >= 64; v += n >= 91;
    return b + v;
}
constexpr int AK_P = 72, AV_P = 200;
constexpr int AL_K = 0, AL_VT = AL_K + 192 * AK_P * 2, AL_LUT = AL_VT + 64 * AV_P * 2, AL_END = AL_LUT + 4 * 256 * 4;
static_assert(AL_END <= RING_BYTES, "attention LDS map");
__device__ __forceinline__ void attn_prompt_unit(const Frame& F, int layer, int sl, int ck, int kh) {
    const int tid = F.tid, lane = F.lane, w = F.wave, q32 = lane & 31, hi = lane >> 5;
    LAS bf16_t* Kl = (LAS bf16_t*)(F.lds + AL_K); LAS bf16_t* VT = (LAS bf16_t*)(F.lds + AL_VT); LAS float* lut = (LAS float*)(F.lds + AL_LUT);
    bf16_t* H = ws_bf(F, WS_H) + (size_t)sl * SEQ * DINP;
    const int gq = w >> 1, qh = w & 1, head = kh * 4 + gq;
    const size_t qrow = (size_t)ck * 64 + 32 * qh + q32;
    bf16x8 qf[4];
#pragma unroll
    for (int ds = 0; ds < 4; ++ds) qf[ds] = *(const bf16x8*)(H + qrow * DINP + C_Q + head * 64 + 16 * ds + 8 * hi);
    __syncthreads();
#pragma unroll
    for (int j = 0; j < 3; ++j) { const int id = tid + 512 * j, key = id >> 3, cg = id & 7; const int t = 64 * (ck - 2) + key;
        u32x4 kv = (u32x4){0u, 0u, 0u, 0u}, vv = kv;
        if (t >= 0) { kv = *(const u32x4*)(H + (size_t)t * DINP + C_K + kh * 64 + 8 * cg); vv = *(const u32x4*)(H + (size_t)t * DINP + C_V + kh * 64 + 8 * cg); }
        *(LAS u32x4*)(Kl + key * AK_P + 8 * cg) = kv;
        VT[(8 * cg + 0) * AV_P + key] = (bf16_t)(vv.x & 0xffffu); VT[(8 * cg + 1) * AV_P + key] = (bf16_t)(vv.x >> 16); VT[(8 * cg + 2) * AV_P + key] = (bf16_t)(vv.y & 0xffffu); VT[(8 * cg + 3) * AV_P + key] = (bf16_t)(vv.y >> 16);
        VT[(8 * cg + 4) * AV_P + key] = (bf16_t)(vv.z & 0xffffu); VT[(8 * cg + 5) * AV_P + key] = (bf16_t)(vv.z >> 16); VT[(8 * cg + 6) * AV_P + key] = (bf16_t)(vv.w & 0xffffu); VT[(8 * cg + 7) * AV_P + key] = (bf16_t)(vv.w >> 16); }
    for (int e = tid; e < 4 * 255; e += NTHREADS) { const int gg = e / 255, idx = e % 255; lut[gg * 256 + idx] = F.in[I_RELB][t5_bucket(idx - 191) * 16 + kh * 4 + gg]; }
    __syncthreads();
    f32x16 sc[6];
#pragma unroll
    for (int kt = 0; kt < 6; ++kt) {
#pragma unroll
        for (int r = 0; r < 16; ++r) sc[kt][r] = 0.f;
#pragma unroll
        for (int ds = 0; ds < 4; ++ds) { const bf16x8 a = *(const LAS bf16x8*)(Kl + (32 * kt + q32) * AK_P + 16 * ds + 8 * hi); sc[kt] = __builtin_amdgcn_mfma_f32_32x32x16_bf16(a, qf[ds], sc[kt], 0, 0, 0); } }
    const int qidx = 32 * qh + q32; const float sink = F.in[I_SINK][layer * 16 + head];
    float mx = -3.0e38f;
#pragma unroll
    for (int kt = 0; kt < 6; ++kt)
#pragma unroll
        for (int r = 0; r < 16; ++r) { const int key = 32 * kt + (r & 3) + 8 * (r >> 2) + 4 * hi; const int rel = key - 128 - qidx;
            float s = sc[kt][r] * 0.125f + lut[gq * 256 + rel + 191]; if (ck < 2 && 64 * ck + key - 128 < 0) s = -1e30f; sc[kt][r] = s; mx = fmaxf(mx, s); }
    mx = fmaxf(mx, __shfl_xor(mx, 32)); mx = fmaxf(mx, sink);
    float sum = 0.f;
#pragma unroll
    for (int kt = 0; kt < 6; ++kt)
#pragma unroll
        for (int r = 0; r < 16; ++r) { const float e = fexp(sc[kt][r] - mx); sc[kt][r] = e; sum += e; }
    sum += __shfl_xor(sum, 32);
    const float inv = 1.0f / (sum + fexp(sink - mx));
    f32x16 o[2];
#pragma unroll
    for (int d2 = 0; d2 < 2; ++d2)
#pragma unroll
        for (int r = 0; r < 16; ++r) o[d2][r] = 0.f;
#pragma unroll
    for (int kt = 0; kt < 6; ++kt)
#pragma unroll
        for (int s = 0; s < 2; ++s) {
            u32x4 pw; pw.x = pk2(sc[kt][8 * s + 0], sc[kt][8 * s + 1]); pw.y = pk2(sc[kt][8 * s + 2], sc[kt][8 * s + 3]); pw.z = pk2(sc[kt][8 * s + 4], sc[kt][8 * s + 5]); pw.w = pk2(sc[kt][8 * s + 6], sc[kt][8 * s + 7]);
            const bf16x8 pa = __builtin_bit_cast(bf16x8, pw);
#pragma unroll
            for (int d2 = 0; d2 < 2; ++d2) { const LAS bf16_t* vp = VT + (32 * d2 + q32) * AV_P + 32 * kt + 16 * s + 4 * hi;
                const u32x2 lo = *(const LAS u32x2*)vp, hh = *(const LAS u32x2*)(vp + 8); u32x4 vw; vw.x = lo.x; vw.y = lo.y; vw.z = hh.x; vw.w = hh.y;
                o[d2] = __builtin_amdgcn_mfma_f32_32x32x16_bf16(pa, __builtin_bit_cast(bf16x8, vw), o[d2], 0, 0, 0); } }
#pragma unroll
    for (int r = 0; r < 16; ++r) { const int q = (r & 3) + 8 * (r >> 2) + 4 * hi; const float iv = __shfl(inv, q);
        bf16_t* op = H + ((size_t)ck * 64 + 32 * qh + q) * DINP + C_Q + head * 64 + q32;
        op[0] = bf1(o[0][r] * iv); op[32] = bf1(o[1][r] * iv); }
}
__device__ __forceinline__ void attn_sample_unit(const Frame& F, int layer, int sq, int kh) {
    const int tid = F.tid; LAS float* L = (LAS float*)F.lds;
    LAS float* Kf = L; LAS float* Vf = Kf + 144 * 65; LAS float* Qf = Vf + 144 * 64; LAS float* P = Qf + 64 * 65; LAS float* Pinv = P + 64 * 145;
    static_assert((144 * 65 + 144 * 64 + 64 * 65 + 64 * 145 + 64) * 4 <= RING_BYTES, "sample attention LDS map");
    bf16_t* H = ws_bf(F, WS_H) + (size_t)(NP + sq * 16) * DINP;
    const float* ck = F.in[I_CK] + ((size_t)layer * DECB + sq) * WINDOW * 256; const float* cv = F.in[I_CV] + ((size_t)layer * DECB + sq) * WINDOW * 256;
    __syncthreads();
    for (int i = tid; i < 144 * 64; i += NTHREADS) { const int key = i >> 6, d = i & 63;
        Kf[key * 65 + d] = key < 128 ? ck[(size_t)key * 256 + kh * 64 + d] : bf2f(H[(size_t)(key - 128) * DINP + C_K + kh * 64 + d]);
        Vf[key * 64 + d] = key < 128 ? cv[(size_t)key * 256 + kh * 64 + d] : bf2f(H[(size_t)(key - 128) * DINP + C_V + kh * 64 + d]); }
    for (int i = tid; i < 64 * 64; i += NTHREADS) { const int row = i >> 6, d = i & 63; Qf[row * 65 + d] = bf2f(H[(size_t)(row & 15) * DINP + C_Q + (kh * 4 + (row >> 4)) * 64 + d]); }
    __syncthreads();
    for (int i = tid; i < 64 * 144; i += NTHREADS) { const int row = i / 144, key = i % 144; float s = 0.f;
        for (int d = 0; d < 64; ++d) s += Qf[row * 65 + d] * Kf[key * 65 + d];
        P[row * 145 + key] = s * 0.125f + F.in[I_RELB][t5_bucket(key - 128 - (row & 15)) * 16 + kh * 4 + (row >> 4)]; }
    __syncthreads();
    { const int row = tid >> 3, sub = tid & 7; const float sink = F.in[I_SINK][layer * 16 + kh * 4 + (row >> 4)]; float mx = -3.0e38f;
      for (int k = sub; k < 144; k += 8) mx = fmaxf(mx, P[row * 145 + k]);
      mx = fmaxf(mx, __shfl_xor(mx, 1)); mx = fmaxf(mx, __shfl_xor(mx, 2)); mx = fmaxf(mx, __shfl_xor(mx, 4)); mx = fmaxf(mx, sink);
      float sum = 0.f;
      for (int k = sub; k < 144; k += 8) { const float e = fexp(P[row * 145 + k] - mx); P[row * 145 + k] = e; sum += e; }
      sum += __shfl_xor(sum, 1); sum += __shfl_xor(sum, 2); sum += __shfl_xor(sum, 4);
      if (sub == 0) Pinv[row] = 1.0f / (sum + fexp(sink - mx)); }
    __syncthreads();
    { const int row = tid >> 3, d0 = (tid & 7) * 8; float o[8] = {0.f, 0.f, 0.f, 0.f, 0.f, 0.f, 0.f, 0.f};
      for (int k = 0; k < 144; ++k) { const float pv = P[row * 145 + k];
#pragma unroll
          for (int i = 0; i < 8; ++i) o[i] += pv * Vf[k * 64 + d0 + i]; }
      const float iv = Pinv[row];
#pragma unroll
      for (int i = 0; i < 8; ++i) o[i] *= iv;
      *(u32x4*)(H + (size_t)(row & 15) * DINP + C_Q + (kh * 4 + (row >> 4)) * 64 + d0) = pack8(o); }
}
__device__ __forceinline__ void sc_unit(const Frame& F, int layer, int tile) {
    const int tid = F.tid, cg = tid & 127, rs = tid >> 7; bf16_t* H = ws_bf(F, WS_H);
    const float* wsc = F.in[I_SCW] + (size_t)layer * 3 * D + 8 * cg; float wt[3][8];
#pragma unroll
    for (int i = 0; i < 3; ++i)
#pragma unroll
        for (int c = 0; c < 8; ++c) wt[i][c] = wsc[i * D + c];
    const int row0 = tile * 64 + 16 * rs; const bool smp = row0 >= NP; const int tt0 = smp ? 0 : row0 % SEQ;
    float u1[8], u2[8];
    if (tt0 >= 2) { float c8[8], h8[8];
        unpack8(*(const u32x4*)(H + (size_t)(row0 - 2) * DINP + C_SCC + 8 * cg), c8); unpack8(*(const u32x4*)(H + (size_t)(row0 - 2) * DINP + C_SCH + 8 * cg), h8);
#pragma unroll
        for (int c = 0; c < 8; ++c) u2[c] = c8[c] * h8[c];
        unpack8(*(const u32x4*)(H + (size_t)(row0 - 1) * DINP + C_SCC + 8 * cg), c8); unpack8(*(const u32x4*)(H + (size_t)(row0 - 1) * DINP + C_SCH + 8 * cg), h8);
#pragma unroll
        for (int c = 0; c < 8; ++c) u1[c] = c8[c] * h8[c]; }
    else if (smp) { const float* hp = F.in[I_SSC] + (((size_t)layer * DECB + ((row0 - NP) >> 4)) * 2) * D + 8 * cg;
#pragma unroll
        for (int c = 0; c < 8; ++c) { u2[c] = hp[c]; u1[c] = hp[D + c]; } }
    else {
#pragma unroll
        for (int c = 0; c < 8; ++c) { u2[c] = 0.f; u1[c] = 0.f; } }
#pragma unroll 1
    for (int q = 0; q < 4; ++q) {
        u32x4 cw_[4], hw_[4], bw_[4];
#pragma unroll
        for (int i = 0; i < 4; ++i) { const bf16_t* hp = H + (size_t)(row0 + 4 * q + i) * DINP + 8 * cg; cw_[i] = *(const u32x4*)(hp + C_SCC); hw_[i] = *(const u32x4*)(hp + C_SCH); bw_[i] = *(const u32x4*)(hp + C_SCB); }
        asm volatile("" ::: "memory");
#pragma unroll
        for (int i = 0; i < 4; ++i) { float c8[8], h8[8], b8[8], a[8]; unpack8(cw_[i], c8); unpack8(hw_[i], h8); unpack8(bw_[i], b8);
#pragma unroll
            for (int c = 0; c < 8; ++c) { const float u0 = c8[c] * h8[c]; a[c] = (u2[c] * wt[0][c] + u1[c] * wt[1][c] + u0 * wt[2][c]) * b8[c]; u2[c] = u1[c]; u1[c] = u0; }
            *(u32x4*)(H + (size_t)(row0 + 4 * q + i) * DINP + C_SCB + 8 * cg) = pack8(a); }
    }
}
__device__ __forceinline__ void state_out_unit(const Frame& F, int layer, int mb, int sl, bool smp) {
    const int tid = F.tid; const bf16_t* H = ws_bf(F, WS_H);
    const int nkv = smp ? DECS : WINDOW, len = smp ? DECS : SEQ; const size_t row0 = smp ? (size_t)NP + sl * 16 : (size_t)sl * SEQ; const int sg = smp ? sl : mb * NSEQ_MB + sl;
    const size_t nb_ = smp ? DECB : BATCH;
    float* ko = F.out + (smp ? O_KS : O_KP) + ((size_t)layer * nb_ + sg) * nkv * 256; float* vo = F.out + (smp ? O_VS : O_VP) + ((size_t)layer * nb_ + sg) * nkv * 256;
    for (int i = tid; i < nkv * 32; i += NTHREADS) { const int j = i >> 5, c8 = (i & 31) * 8; const bf16_t* hp = H + (row0 + len - nkv + j) * DINP; float f[8];
        unpack8(*(const u32x4*)(hp + C_K + c8), f); *(f32x4*)(ko + (size_t)j * 256 + c8) = (f32x4){f[0], f[1], f[2], f[3]}; *(f32x4*)(ko + (size_t)j * 256 + c8 + 4) = (f32x4){f[4], f[5], f[6], f[7]};
        unpack8(*(const u32x4*)(hp + C_V + c8), f); *(f32x4*)(vo + (size_t)j * 256 + c8) = (f32x4){f[0], f[1], f[2], f[3]}; *(f32x4*)(vo + (size_t)j * 256 + c8 + 4) = (f32x4){f[4], f[5], f[6], f[7]}; }
    float* co = F.out + (smp ? O_CVS : O_CVP) + ((size_t)layer * nb_ + sg) * 3 * CONVDIM;
    for (int i = tid; i < 3 * 512; i += NTHREADS) { const int j = i / 512, c8 = (i % 512) * 8; float f[8]; unpack8(*(const u32x4*)(H + (row0 + len - 3 + j) * DINP + C_X + c8), f);
        *(f32x4*)(co + (size_t)j * CONVDIM + c8) = (f32x4){f[0], f[1], f[2], f[3]}; *(f32x4*)(co + (size_t)j * CONVDIM + c8 + 4) = (f32x4){f[4], f[5], f[6], f[7]}; }
    float* so = F.out + (smp ? O_SCS : O_SCP) + ((size_t)layer * nb_ + sg) * 2 * D;
    for (int i = tid; i < 2 * 128; i += NTHREADS) { const int j = i >> 7, c8 = (i & 127) * 8; float c[8], h[8]; const bf16_t* hp = H + (row0 + len - 2 + j) * DINP;
        unpack8(*(const u32x4*)(hp + C_SCC + c8), c); unpack8(*(const u32x4*)(hp + C_SCH + c8), h);
        *(f32x4*)(so + (size_t)j * D + c8) = (f32x4){c[0] * h[0], c[1] * h[1], c[2] * h[2], c[3] * h[3]}; *(f32x4*)(so + (size_t)j * D + c8 + 4) = (f32x4){c[4] * h[4], c[5] * h[5], c[6] * h[6], c[7] * h[7]}; }
}
#ifndef MIX_MASK
#define MIX_MASK 0xFF
#endif
#define MIXON(b) ((MIX_MASK >> (b)) & 1)
__device__ __forceinline__ void step_premix(const Frame& F, int layer, int mb) {
    const int n_bc = NSEQ_MB * NCHUNK * 8, n_att = NSEQ_MB * NCHUNK * NKV, n_sc = rows_of(mb) / 64, n_so = NSEQ_MB + (mb == 0 ? DECB : 0);
    const int n_ss = mb == 0 ? DECB * 32 : 0, n_as = mb == 0 ? DECB * NKV : 0;
    const int total = n_bc + n_att + n_sc + n_so + n_ss + n_as;
#define UF(Fu) Frame Fu = F; Fu.lane = opq(lane_id()); Fu.tid = Fu.wave * 64 + Fu.lane
    PROBE_T0(14) if constexpr (MIXON(0)) { UF(Fu); BcRegs ra, rn_;
        if (F.bid < n_bc) ssd_bc_load(Fu, layer, F.bid, ra);
        for (int u = F.bid; u < n_bc; u += F.G) { const bool more = u + F.G < n_bc; if (more) ssd_bc_load(Fu, layer, u + F.G, rn_);
            ssd_bc_unit(Fu, u, ra);
            if (more) ra = rn_; } }
    PROBE_T1(14)
    for (int un = F.bid; un < total; un += F.G) { int r = un;
        if (r < n_bc) continue;
        r -= n_bc;
        if (r < n_att) { PROBE_T0(15) if constexpr (MIXON(1)) { UF(Fu);
                const int ra = (n_att % 8 == 0 && F.G % 8 == 0 && n_bc % F.G == 0) ? (r & 7) * (n_att >> 3) + (r >> 3) : r;
                attn_prompt_unit(Fu, layer, ra / (NCHUNK * NKV), (ra / NKV) % NCHUNK, ra % NKV); } PROBE_T1(15) continue; } r -= n_att;
        if (r < n_sc) { PROBE_T0(16) if constexpr (MIXON(2)) { UF(Fu); sc_unit(Fu, layer, r); } PROBE_T1(16) continue; } r -= n_sc;
        if (r < n_so) { PROBE_T0(17) if constexpr (MIXON(3)) { UF(Fu); state_out_unit(Fu, layer, mb, r < NSEQ_MB ? r : r - NSEQ_MB, r >= NSEQ_MB); } PROBE_T1(17) continue; } r -= n_so;
        if (r < n_ss) { PROBE_T0(18) if constexpr (MIXON(4)) { UF(Fu); ssd_sample_unit(Fu, layer, r >> 5, r & 31); } PROBE_T1(18) continue; } r -= n_ss;
        { PROBE_T0(19) if constexpr (MIXON(5)) { UF(Fu); attn_sample_unit(Fu, layer, r >> 2, r & 3); } PROBE_T1(19) }
    }
}
__device__ __forceinline__ void step_mixers(const Frame& F, int layer, int mb) {
    for (int v = F.bid; v < NSEQ_MB * 32; v += F.G) { const int un = (NSEQ_MB == 8 && F.G == 256) ? (v & 7) * 32 + (v >> 3) : v; UF(Fu); ssd_prompt_unit(Fu, layer, mb, un >> 5, un & 31); }
}
__device__ __forceinline__ void step_gnorm(const Frame& F, int mb) {
    const int gw = F.bid * NWAVES + F.wave, NGW = F.G * NWAVES, nr = rows_of(mb); bf16_t* H = ws_bf(F, WS_H); const float* ssq = ws_f(F, WS_SSQ);
    constexpr int RB = 4; const int g = F.lane >> 3;
    for (int r0 = gw; r0 < nr; r0 += RB * NGW) {
        u32x4 d[RB][4]; f32x4 q[RB];
#pragma unroll
        for (int i = 0; i < RB; ++i) { const int r = r0 + i * NGW < nr ? r0 + i * NGW : r0; { const f32x4 qa = *(const f32x4*)(ssq + (size_t)r * 64 + 8 * g), qb = *(const f32x4*)(ssq + (size_t)r * 64 + 8 * g + 4); q[i] = qa + qb; } const u32x4* p = (const u32x4*)(H + (size_t)r * DINP + C_Z + 32 * F.lane);
#pragma unroll
            for (int j = 0; j < 4; ++j) d[i][j] = p[j]; }
        asm volatile("" ::: "memory");
#pragma unroll
        for (int i = 0; i < RB; ++i) { const int r = r0 + i * NGW; if (r >= nr) continue;
            const float rstd = 1.0f / sqrtf(((q[i][0] + q[i][1]) + (q[i][2] + q[i][3])) * (1.0f / 256.0f) + LN_EPS); u32x4* p = (u32x4*)(H + (size_t)r * DINP + C_Z + 32 * F.lane);
#pragma unroll
            for (int j = 0; j < 4; ++j) { float f[8]; unpack8(d[i][j], f);
#pragma unroll
                for (int k = 0; k < 8; ++k) f[k] *= rstd;
                p[j] = pack8(f); } }
    }
}
constexpr int LOG_NEXP = NEXP == 32 ? 5 : (NEXP == 16 ? 4 : (NEXP == 8 ? 3 : 2));
template <int N, int MASK> struct RedStep {
    static __device__ __forceinline__ void run(float* v, int lane) {
        constexpr int Hn = N / 2; const bool up = (lane & MASK) != 0;
#pragma unroll
        for (int i = 0; i < Hn; ++i) { const float keep = up ? v[i + Hn] : v[i], send = up ? v[i] : v[i + Hn]; v[i] = keep + xshfl<MASK>(send); }
        if constexpr (Hn > 1) RedStep<Hn, (MASK >> 1)>::run(v, lane);
    }
};
constexpr int RW_P = D + 8;
__device__ __forceinline__ void step_ln1_router_mfma(const Frame& F, int layer, int mb) {
    LAS bf16_t* WH = (LAS bf16_t*)F.lds; LAS bf16_t* WL = WH + NTE * 16 * RW_P; LAS float* GB = (LAS float*)(WL + NTE * 16 * RW_P);
    static_assert((size_t)2 * NTE * 16 * RW_P * 2 + 2 * D * 4 <= (size_t)SCR_BYTES, "router LDS map");
    const int lane = F.lane, fr = lane & 15, fq = lane >> 4;
    __syncthreads();
    { const bf16_t* rwh = ws_bf(F, WS_RWH) + (size_t)layer * NTE * 16 * D; const bf16_t* rwl = ws_bf(F, WS_RWL) + (size_t)layer * NTE * 16 * D;
      for (int i = F.tid; i < NTE * 16 * (D / 8); i += NTHREADS) { const int e = i / (D / 8), c = i % (D / 8); *(LAS u32x4*)(WH + e * RW_P + 8 * c) = *(const u32x4*)(rwh + (size_t)e * D + 8 * c); *(LAS u32x4*)(WL + e * RW_P + 8 * c) = *(const u32x4*)(rwl + (size_t)e * D + 8 * c); }
      for (int i = F.tid; i < D; i += NTHREADS) { GB[i] = F.in[I_LN1G][(size_t)layer * D + i]; GB[D + i] = F.in[I_LN1B][(size_t)layer * D + i]; } }
    unsigned* cnt = F.ctl + CW_CNT + (mb * DEPTH + layer) * 64;
    LAS unsigned* lcnt = (LAS unsigned*)(F.lds + MISC_OFF) + 128;
    if (F.tid < 64) lcnt[F.tid] = 0u;
    __syncthreads();
    const int gw = F.bid * NWAVES + F.wave, NGW = F.G * NWAVES, nr = rows_of(mb);
    const float* rb = F.in[I_RB] + (size_t)layer * NEXP;
    bf16_t* XB = ws_bf(F, WS_XB); int* topi = (int*)(F.ws + WS_TOPI); float* gate = ws_f(F, WS_GATE); int* pos = (int*)(F.ws + WS_POS);
    float rbv[NTE];
#pragma unroll
    for (int t = 0; t < NTE; ++t) rbv[t] = 16 * t + fr < NEXP ? rb[16 * t + fr] : 0.f;
    for (int blk = gw; blk < nr / 16; blk += NGW) {
        const int row = 16 * blk + fr; const float* xr = x_out_row(F, mb, row) + 8 * fq;
        float s1, s2;
        { const float* stp = ws_f(F, WS_STAT) + (size_t)row * 32 + 8 * fq; const f32x4 a = *(const f32x4*)stp, b = *(const f32x4*)(stp + 4); s1 = (a[0] + a[2]) + (b[0] + b[2]); s2 = (a[1] + a[3]) + (b[1] + b[3]); }
        s1 += xshfl<16>(s1); s1 += xshfl<32>(s1); s2 += xshfl<16>(s2); s2 += xshfl<32>(s2);
        const float mean = s1 * (1.0f / D); const float rstd = 1.0f / sqrtf(fmaxf(s2 * (1.0f / D) - mean * mean, 0.f) + LN_EPS);
        f32x4 acc[NTE];
#pragma unroll
        for (int t = 0; t < NTE; ++t) acc[t] = (f32x4){0.f, 0.f, 0.f, 0.f};
        bf16_t* xo = XB + (size_t)row * D + 8 * fq;
#pragma unroll 4
        for (int sI = 0; sI < D / 32; ++sI) { const f32x4 a = *(const f32x4*)(xr + 32 * sI), b = *(const f32x4*)(xr + 32 * sI + 4);
            const f32x4 g0 = *(const LAS f32x4*)(GB + 32 * sI + 8 * fq), g1 = *(const LAS f32x4*)(GB + 32 * sI + 8 * fq + 4), b0 = *(const LAS f32x4*)(GB + D + 32 * sI + 8 * fq), b1 = *(const LAS f32x4*)(GB + D + 32 * sI + 8 * fq + 4);
            const f32x4 n0 = (a - mean) * rstd * g0 + b0, n1 = (b - mean) * rstd * g1 + b1;
            u32x4 hw; hw.x = pk2(n0[0], n0[1]); hw.y = pk2(n0[2], n0[3]); hw.z = pk2(n1[0], n1[1]); hw.w = pk2(n1[2], n1[3]);
            *(u32x4*)(xo + 32 * sI) = hw;
            u32x4 lw; lw.x = pk2(n0[0] - blo(hw.x), n0[1] - bhi(hw.x)); lw.y = pk2(n0[2] - blo(hw.y), n0[3] - bhi(hw.y)); lw.z = pk2(n1[0] - blo(hw.z), n1[1] - bhi(hw.z)); lw.w = pk2(n1[2] - blo(hw.w), n1[3] - bhi(hw.w));
            const bf16x8 ah = __builtin_bit_cast(bf16x8, hw), al = __builtin_bit_cast(bf16x8, lw);
#pragma unroll
            for (int t = 0; t < NTE; ++t) { const bf16x8 wh = *(const LAS bf16x8*)(WH + (16 * t + fr) * RW_P + 32 * sI + 8 * fq), wl = *(const LAS bf16x8*)(WL + (16 * t + fr) * RW_P + 32 * sI + 8 * fq);
                acc[t] = __builtin_amdgcn_mfma_f32_16x16x32_bf16(ah, wh, acc[t], 0, 0, 0); acc[t] = __builtin_amdgcn_mfma_f32_16x16x32_bf16(al, wh, acc[t], 0, 0, 0); acc[t] = __builtin_amdgcn_mfma_f32_16x16x32_bf16(ah, wl, acc[t], 0, 0, 0); } }
#pragma unroll
        for (int r = 0; r < 4; ++r) { float val[NTE];
#pragma unroll
            for (int t = 0; t < NTE; ++t) val[t] = 16 * t + fr < NEXP ? acc[t][r] + rbv[t] : -3.0e38f;
            float tv[4]; int te[4];
#pragma unroll
            for (int k = 0; k < 4; ++k) { float m = val[0];
#pragma unroll
                for (int t = 1; t < NTE; ++t) m = fmaxf(m, val[t]);
                m = fmaxf(m, xshfl<1>(m)); m = fmaxf(m, xshfl<2>(m)); m = fmaxf(m, xshfl<4>(m)); m = fmaxf(m, xshfl<8>(m));
                int ce = 9999;
#pragma unroll
                for (int t = NTE - 1; t >= 0; --t) ce = val[t] == m ? 16 * t + fr : ce;
                { int o = xshfl<1>(ce); ce = o < ce ? o : ce; o = xshfl<2>(ce); ce = o < ce ? o : ce; o = xshfl<4>(ce); ce = o < ce ? o : ce; o = xshfl<8>(ce); ce = o < ce ? o : ce; }
                tv[k] = m; te[k] = ce;
#pragma unroll
                for (int t = 0; t < NTE; ++t) if (16 * t + fr == ce) val[t] = -3.0e38f; }
            const float e1 = fexp(tv[1] - tv[0]), e2 = fexp(tv[2] - tv[0]), e3 = fexp(tv[3] - tv[0]); const float inv = 1.0f / (1.0f + e1 + e2 + e3);
            if (fr < 4) { const int e = fr == 0 ? te[0] : (fr == 1 ? te[1] : (fr == 2 ? te[2] : te[3])); const float gv = (fr == 0 ? 1.0f : (fr == 1 ? e1 : (fr == 2 ? e2 : e3))) * inv;
                const size_t tok = (size_t)16 * blk + 4 * fq + r;
                const unsigned rk = __hip_atomic_fetch_add(lcnt + e, 1u, __ATOMIC_RELAXED, __HIP_MEMORY_SCOPE_WORKGROUP);
                topi[tok * 4 + fr] = e; gate[tok * 4 + fr] = gv; pos[tok * 4 + fr] = (int)rk; } }
    }
    __syncthreads();
    if (F.tid < NEXP) lcnt[32 + F.tid] = __hip_atomic_fetch_add(cnt + F.tid, lcnt[F.tid], __ATOMIC_RELAXED, __HIP_MEMORY_SCOPE_AGENT);
    __syncthreads();
    for (int blk = gw; blk < nr / 16; blk += NGW) pos[(size_t)16 * blk * 4 + lane] += (int)lcnt[32 + topi[(size_t)16 * blk * 4 + lane]];
}
__device__ __forceinline__ void step_ln1_router(const Frame& F, int layer, int mb) {
    LAS float* wT = (LAS float*)F.lds;
    const float* rw = F.in[I_RW] + (size_t)layer * D * NEXP;
    __syncthreads();
    for (int i = F.tid; i < D * NEXP; i += NTHREADS) { const int e = i / D, k = i % D; wT[i] = rw[(size_t)k * NEXP + e]; }
    unsigned* cnt = F.ctl + CW_CNT + (mb * DEPTH + layer) * 64;
    LAS unsigned* lcnt = (LAS unsigned*)(F.lds + MISC_OFF) + 128;
    if (F.tid < 64) lcnt[F.tid] = 0u;
    __syncthreads();
    const int gw = F.bid * NWAVES + F.wave, NGW = F.G * NWAVES, nr = rows_of(mb), lane = F.lane;
    const float* lg = F.in[I_LN1G] + (size_t)layer * D; const float* lb = F.in[I_LN1B] + (size_t)layer * D; const float* rb = F.in[I_RB] + (size_t)layer * NEXP;
    bf16_t* XB = ws_bf(F, WS_XB); int* topi = (int*)(F.ws + WS_TOPI); float* gate = ws_f(F, WS_GATE); int* pos = (int*)(F.ws + WS_POS);
    constexpr int RB = 4, NH = NEXP / 2, LOGH = LOG_NEXP - 1;
    const int myexp = ((lane & 1) * NH) | ((lane >> (6 - LOGH)) & (NH - 1));
    const float myb = rb[myexp];
    for (int r0 = gw; r0 < nr; r0 += RB * NGW) {
        f32x4 v[RB][4]; int rr[RB]; bool ok[RB];
#pragma unroll
        for (int i = 0; i < RB; ++i) { const int r = r0 + i * NGW; ok[i] = r < nr; rr[i] = ok[i] ? r : r0; const float* xr = x_out_row(F, mb, rr[i]);
#pragma unroll
            for (int j = 0; j < 4; ++j) v[i][j] = *((const f32x4*)xr + lane + 64 * j); }
        asm volatile("" ::: "memory");
#pragma unroll
        for (int i = 0; i < RB; ++i) {
            float s = 0.f;
#pragma unroll
            for (int j = 0; j < 4; ++j) s += (v[i][j][0] + v[i][j][1]) + (v[i][j][2] + v[i][j][3]);
            const float mean = wave_sum(s) * (1.0f / D); float s2 = 0.f;
#pragma unroll
            for (int j = 0; j < 4; ++j) { v[i][j] = v[i][j] - mean; s2 += (v[i][j][0] * v[i][j][0] + v[i][j][1] * v[i][j][1]) + (v[i][j][2] * v[i][j][2] + v[i][j][3] * v[i][j][3]); }
            const float rstd = 1.0f / sqrtf(wave_sum(s2) * (1.0f / D) + LN_EPS);
#pragma unroll
            for (int j = 0; j < 4; ++j) { const f32x4 gg = *((const f32x4*)lg + lane + 64 * j), bb = *((const f32x4*)lb + lane + 64 * j); v[i][j] = v[i][j] * rstd * gg + bb;
                if (ok[i]) { u32x2 w; w.x = pk2(v[i][j][0], v[i][j][1]); w.y = pk2(v[i][j][2], v[i][j][3]); *((u32x2*)(XB + (size_t)rr[i] * D) + lane + 64 * j) = w; } }
        }
        typedef float f32x2v __attribute__((ext_vector_type(2)));
        float val[RB];
#pragma unroll
        for (int hf = 0; hf < 2; ++hf) {
            float lgt[RB][NH];
#pragma unroll
            for (int e = 0; e < NH; ++e) { f32x2v a2[RB / 2];
#pragma unroll
                for (int i = 0; i < RB / 2; ++i) a2[i] = (f32x2v){0.f, 0.f};
#pragma unroll
                for (int j = 0; j < 4; ++j) { const f32x4 wv = *((const LAS f32x4*)(wT + (hf * NH + e) * D) + lane + 64 * j);
#pragma unroll
                    for (int c = 0; c < 4; ++c) { const f32x2v w2 = (f32x2v){wv[c], wv[c]};
#pragma unroll
                        for (int i = 0; i < RB / 2; ++i) a2[i] = __builtin_elementwise_fma((f32x2v){v[2 * i][j][c], v[2 * i + 1][j][c]}, w2, a2[i]); } }
#pragma unroll
                for (int i = 0; i < RB / 2; ++i) { lgt[2 * i][e] = a2[i].x; lgt[2 * i + 1][e] = a2[i].y; }
                if ((e & 1) == 1) asm volatile("" ::: "memory"); }
#pragma unroll
            for (int i = 0; i < RB; ++i) { RedStep<NH, 32>::run(lgt[i], lane); float tot = lgt[i][0];
                if constexpr ((32 >> LOGH) >= 8) tot += xshfl<8>(tot);
                if constexpr ((32 >> LOGH) >= 4) tot += xshfl<4>(tot);
                if constexpr ((32 >> LOGH) >= 2) tot += xshfl<2>(tot);
                tot += xshfl<1>(tot);
                if ((lane & 1) == hf) val[i] = tot + myb; }
        }
#pragma unroll
        for (int i = 0; i < RB; ++i) {
            float tv[4]; int te[4]; float vv = val[i];
#pragma unroll
            for (int k = 0; k < 4; ++k) { float m = vv; m = fmaxf(m, xshfl<1>(m)); m = fmaxf(m, xshfl<2>(m)); m = fmaxf(m, xshfl<4>(m)); m = fmaxf(m, xshfl<8>(m)); m = fmaxf(m, xshfl<16>(m)); m = fmaxf(m, xshfl<32>(m));
                const unsigned long long bal = __ballot(vv == m); const int wl = __builtin_ctzll(bal);
                const int be = ((wl & 1) * NH) | ((wl >> (6 - LOGH)) & (NH - 1));
                tv[k] = m; te[k] = be; if (myexp == be) vv = -3.0e38f; }
            const float e1 = fexp(tv[1] - tv[0]), e2 = fexp(tv[2] - tv[0]), e3 = fexp(tv[3] - tv[0]); const float inv = 1.0f / (1.0f + e1 + e2 + e3);
            if (lane < 4 && ok[i]) { const int e = lane == 0 ? te[0] : (lane == 1 ? te[1] : (lane == 2 ? te[2] : te[3])); const float gv = (lane == 0 ? 1.0f : (lane == 1 ? e1 : (lane == 2 ? e2 : e3))) * inv;
                const unsigned rk = __hip_atomic_fetch_add(lcnt + e, 1u, __ATOMIC_RELAXED, __HIP_MEMORY_SCOPE_WORKGROUP);
                topi[(size_t)rr[i] * 4 + lane] = e; gate[(size_t)rr[i] * 4 + lane] = gv; pos[(size_t)rr[i] * 4 + lane] = (int)rk; }
        }
    }
    __syncthreads();
    if (F.tid < NEXP) lcnt[32 + F.tid] = __hip_atomic_fetch_add(cnt + F.tid, lcnt[F.tid], __ATOMIC_RELAXED, __HIP_MEMORY_SCOPE_AGENT);
    __syncthreads();
    for (int r = gw; r < nr; r += NGW) if (lane < 4) pos[(size_t)r * 4 + lane] += (int)lcnt[32 + topi[(size_t)r * 4 + lane]];
}
__device__ __forceinline__ int moe_table(const Frame& F, int layer, int mb) {
    LAS int* M = (LAS int*)(F.lds + MISC_OFF);
    __syncthreads();
    if (F.tid == 0) { unsigned* cnt = F.ctl + CW_CNT + (mb * DEPTH + layer) * 64; int acc = 0;
        for (int e = 0; e < NEXP; ++e) { const int c = (int)__hip_atomic_load(cnt + e, __ATOMIC_RELAXED, __HIP_MEMORY_SCOPE_AGENT); M[64 + e] = acc * 256; acc += (c + 255) / 256; M[16 + e] = acc; } }
    __syncthreads();
    return M[16 + NEXP - 1];
}
__device__ __forceinline__ void step_gather(const Frame& F, int layer, int mb) {
    (void)moe_table(F, layer, mb); const LAS int* M = (const LAS int*)(F.lds + MISC_OFF);
    const int nr = rows_of(mb);
    const int* topi = (const int*)(F.ws + WS_TOPI); const float* gate = ws_f(F, WS_GATE); int* pos = (int*)(F.ws + WS_POS); float* gs = ws_f(F, WS_GSORT); int* rtok = (int*)(F.ws + WS_RTOK);
#pragma nounroll
    for (int i = F.bid * NTHREADS + F.tid; i < nr * 4; i += F.G * NTHREADS) { const int p = M[64 + topi[i]] + pos[i]; pos[i] = p; rtok[p] = i >> 2; gs[p] = gate[i]; }
}
__device__ __forceinline__ void step_ln2(const Frame& F, int layer, int mb) {
    const int gw = F.bid * NWAVES + F.wave, NGW = F.G * NWAVES, nr = rows_of(mb), lane = F.lane;
    const float* lg = F.in[I_LN2G] + (size_t)layer * D; const float* lb = F.in[I_LN2B] + (size_t)layer * D;
    const bf16_t* OUTS = ws_bf(F, WS_H) + (size_t)2 * RP * D; const int* pos = (const int*)(F.ws + WS_POS); bf16_t* XB = ws_bf(F, WS_XB);
    constexpr int RB = 2;
    for (int r0 = gw; r0 < nr; r0 += RB * NGW) {
        f32x4 v[RB][4]; u32x2 ow[RB][4][4]; int rr[RB];
#pragma unroll
        for (int i = 0; i < RB; ++i) { rr[i] = r0 + i * NGW < nr ? r0 + i * NGW : r0; const u32x2* xr = (const u32x2*)(XB + (size_t)rr[i] * D); int p[4];
#pragma unroll
            for (int k = 0; k < 4; ++k) p[k] = pos[(size_t)rr[i] * 4 + k];
#pragma unroll
            for (int j = 0; j < 4; ++j) { { const u32x2 w = xr[lane + 64 * j]; v[i][j] = (f32x4){blo(w.x), bhi(w.x), blo(w.y), bhi(w.y)}; }
#pragma unroll
                for (int k = 0; k < 4; ++k) ow[i][k][j] = *((const u32x2*)(OUTS + (size_t)p[k] * D) + lane + 64 * j); } }
        asm volatile("" ::: "memory");
#pragma unroll
        for (int i = 0; i < RB; ++i) { if (r0 + i * NGW >= nr) continue;
            float* xr = x_out_row(F, mb, rr[i]); float s = 0.f;
#pragma unroll
            for (int j = 0; j < 4; ++j) { v[i][j] = v[i][j] * ALPHA;
#pragma unroll
                for (int k = 0; k < 4; ++k) { const u32x2 w = ow[i][k][j]; v[i][j] = v[i][j] + (f32x4){blo(w.x), bhi(w.x), blo(w.y), bhi(w.y)}; }
                s += (v[i][j][0] + v[i][j][1]) + (v[i][j][2] + v[i][j][3]); }
            const float mean = wave_sum(s) * (1.0f / D); float s2 = 0.f;
#pragma unroll
            for (int j = 0; j < 4; ++j) { v[i][j] = v[i][j] - mean; s2 += (v[i][j][0] * v[i][j][0] + v[i][j][1] * v[i][j][1]) + (v[i][j][2] * v[i][j][2] + v[i][j][3] * v[i][j][3]); }
            const float rstd = 1.0f / sqrtf(wave_sum(s2) * (1.0f / D) + LN_EPS);
#pragma unroll
            for (int j = 0; j < 4; ++j) { const f32x4 gg = *((const f32x4*)lg + lane + 64 * j), bb = *((const f32x4*)lb + lane + 64 * j); v[i][j] = v[i][j] * rstd * gg + bb;
                *((f32x4*)xr + lane + 64 * j) = v[i][j]; u32x2 w; w.x = pk2(v[i][j][0], v[i][j][1]); w.y = pk2(v[i][j][2], v[i][j][3]); *((u32x2*)(XB + (size_t)rr[i] * D) + lane + 64 * j) = w; } }
    }
}

constexpr int SP_P = 68;
template <int KS  > __device__ __forceinline__ void small_mma(const bf16_t* A, int lda, const bf16_t* Bt, int K, int tok0, int n0, int k0, int fr, int fq, f32x4 (&acc)[4]) {
    const bf16_t* ap = A + (size_t)(tok0 + fr) * lda + k0 + 8 * fq; const bf16_t* bp = Bt + (size_t)(n0 + fr) * K + k0 + 8 * fq;
#pragma unroll
    for (int k = 0; k < KS; k += 32) { const bf16x8 a = *(const bf16x8*)(ap + k);
#pragma unroll
        for (int jj = 0; jj < 4; ++jj) { const bf16x8 x = *(const bf16x8*)(bp + (size_t)16 * jj * K + k); acc[jj] = __builtin_amdgcn_mfma_f32_16x16x32_bf16(x, a, acc[jj], 0, 0, 0); } }
}
template <int MODE  >
__device__ __forceinline__ void sample_unit(const Frame& F, int layer, int u) {
    const int tid = F.tid, lane = F.lane, w = F.wave, fr = lane & 15, fq = lane >> 4; const int tok0 = NP + 16 * (u >> 4), n0 = 64 * (u & 15);
    LAS float* P = (LAS float*)F.lds;
    const bf16_t* H = ws_bf(F, WS_H); const size_t trow = (size_t)(tok0 + fr);
    f32x4 v[4];
#pragma unroll
    for (int jj = 0; jj < 4; ++jj) v[jj] = (f32x4){0.f, 0.f, 0.f, 0.f};
    if constexpr (MODE == 0) {
#pragma unroll
        for (int b = 0; b < 3; ++b) { f32x4 acc[4] = {(f32x4){0.f, 0.f, 0.f, 0.f}, (f32x4){0.f, 0.f, 0.f, 0.f}, (f32x4){0.f, 0.f, 0.f, 0.f}, (f32x4){0.f, 0.f, 0.f, 0.f}};
            if (b == 0) { small_mma<DINNER / 8>(H + C_Z, DINP, wl_ptr(F, layer, WL_SSD), DINNER, tok0, n0, w * (DINNER / 8), fr, fq, acc);
                const float* sq = ws_f(F, WS_SSQ) + trow * 128 + 16 * w; const f32x4 qa = (*(const f32x4*)sq + *(const f32x4*)(sq + 4)) + (*(const f32x4*)(sq + 8) + *(const f32x4*)(sq + 12)); const float rs = 1.0f / sqrtf(((qa[0] + qa[1]) + (qa[2] + qa[3])) * (1.0f / 256.0f) + LN_EPS);
#pragma unroll
                for (int jj = 0; jj < 4; ++jj) acc[jj] = acc[jj] * rs; }
            else small_mma<D / 8>(H + (b == 1 ? C_Q : C_SCB), DINP, wl_ptr(F, layer, b == 1 ? WL_ATT : WL_SC), D, tok0, n0, w * (D / 8), fr, fq, acc);
#pragma unroll
            for (int jj = 0; jj < 4; ++jj) { const u32x2 gw = *(const u32x2*)(H + trow * DINP + (b == 0 ? C_GSSD : (b == 1 ? C_GATT : C_GSC)) + n0 + 16 * jj + 4 * fq);
                v[jj] = v[jj] + acc[jj] * (f32x4){fsigmoid(blo(gw.x)), fsigmoid(bhi(gw.x)), fsigmoid(blo(gw.y)), fsigmoid(bhi(gw.y))}; } }
    } else small_mma<D / 8>(ws_bf(F, WS_XB), D, wl_ptr(F, layer, WL_O), D, tok0, n0, w * (D / 8), fr, fq, v);
    __syncthreads();
#pragma unroll
    for (int jj = 0; jj < 4; ++jj) *(LAS f32x4*)(P + (w * 16 + fr) * SP_P + 16 * jj + 4 * fq) = v[jj];
    __syncthreads();
    { const int tk = tid >> 5, c2 = 2 * (tid & 31); float s0 = 0.f, s1 = 0.f;
#pragma unroll
      for (int ww = 0; ww < 8; ++ww) { s0 += P[(ww * 16 + tk) * SP_P + c2]; s1 += P[(ww * 16 + tk) * SP_P + c2 + 1]; }
      const size_t orow = (size_t)(tok0 + tk);
      if constexpr (MODE == 0) *(unsigned*)(ws_bf(F, WS_XB) + orow * D + n0 + c2) = pk2(s0, s1);
      else { const float* xs = (layer == 0 ? F.in[I_XS] : F.out + O_YS) + (orow - NP) * D + n0 + c2; float* os = F.out + O_YS + (orow - NP) * D + n0 + c2; const float v0 = xs[0] * ALPHA + s0, v1 = xs[1] * ALPHA + s1; os[0] = v0; os[1] = v1;
          float t1 = v0 + v1, t2 = v0 * v0 + v1 * v1;
          t1 += xshfl<1>(t1); t1 += xshfl<2>(t1); t1 += xshfl<4>(t1); t1 += xshfl<8>(t1); t1 += xshfl<16>(t1); t2 += xshfl<1>(t2); t2 += xshfl<2>(t2); t2 += xshfl<4>(t2); t2 += xshfl<8>(t2); t2 += xshfl<16>(t2);
          if ((tid & 31) == 0) { float* sp = ws_f(F, WS_STAT) + orow * 32 + 2 * (u & 15); sp[0] = t1; sp[1] = t2; } } }
}

constexpr int PH_PER = 10, NSTEPS = 1 + NMB * DEPTH * PH_PER;
__global__ void __launch_bounds__(NTHREADS, 2) fwd(Args args) {
#ifdef EMU
    unsigned char* lds = emu_wg->lds;
#else
    extern __shared__ __attribute__((aligned(16))) unsigned char lds[];
#endif
    Frame F0; F0.lds = (LAS unsigned char*)lds; F0.tid = threadIdx.x; F0.lane = F0.tid & 63; F0.wave = __builtin_amdgcn_readfirstlane(F0.tid >> 6); F0.G = gridDim.x; F0.bid = blockIdx.x;
#ifdef EMU
    F0.in = args.in;
#else
    F0.in = (ArgTab)__builtin_amdgcn_kernarg_segment_ptr();
    static_assert(offsetof(Args, out) == 248 && offsetof(Args, ws) == 256 && offsetof(Args, in) == 0, "PF() reads the argument struct by offset");
#endif
    F0.out = args.out; F0.ws = args.ws; F0.ctl = (unsigned*)(args.ws + WS_CTL);
    const Frame& F = F0;
    const int lo = args.lo, hi = args.hi;
#ifndef EMU
    for (int u = F.tid; u < (LDS_BYTES - MISC_OFF) / 4; u += NTHREADS) ((LAS unsigned*)(F.lds + MISC_OFF))[u] = 0u;
    __syncthreads();
    XcdBarrier bar; bar.bar = F.ctl + CW_BAR; bar.x = 0; bar.st = nullptr;
    if (hi - lo > 1) bar = xcd_barrier_post(F.ctl + CW_BAR, (volatile LAS unsigned*)(F.lds + MISC_OFF) + 8);
#define SEAM(s) do { if ((s) + 1 < hi) { XcdBarrier b2_ = bar; unsigned long long bp_ = (unsigned long long)b2_.bar; asm volatile("" : "+s"(bp_)); b2_.bar = (unsigned*)bp_; xcd_barrier(b2_); } } while (0)
#else
#define SEAM(s) do { } while (0)
#endif
#ifndef PH_MASK
#define PH_MASK 0xFFFFFFFF
#endif
#define IN(s) (lo <= (s) && (s) < hi)
#define PHON(b) ((PH_MASK >> (b)) & 1)
#ifdef EMU
#define PF(Fp) Frame Fp = F0
#else
#define PF(Fp) Frame Fp; { unsigned long long kp_ = (unsigned long long)__builtin_amdgcn_kernarg_segment_ptr(); asm volatile("" : "+s"(kp_)); \
    Fp.in = (ArgTab)kp_; Fp.out = *(float* const __attribute__((address_space(4)))*)(kp_ + 248); Fp.ws = *(unsigned char* const __attribute__((address_space(4)))*)(kp_ + 256); Fp.ctl = (unsigned*)Fp.ws; \
    Fp.lds = F0.lds; Fp.G = F0.G; Fp.bid = F0.bid; Fp.wave = F0.wave; Fp.lane = opq(lane_id()); Fp.tid = Fp.wave * 64 + Fp.lane; }
#endif
    int step = 0;
    if (IN(step)) { PROBE_T0(0) if constexpr (PHON(0)) { PF(F); step_weights(F); for (int m = 0; m < NMB; ++m) step_xb(F, m);
        { bf16_t* rwh = ws_bf(F, WS_RWH); bf16_t* rwl = ws_bf(F, WS_RWL); const float* rw = F.in[I_RW];
#pragma nounroll
          for (int i = F.bid * NTHREADS + F.tid; i < DEPTH * NTE * 16 * D; i += F.G * NTHREADS) { const int l = i / (NTE * 16 * D), e = (i / D) % (NTE * 16), k = i % D;
              const float wv = e < NEXP ? rw[((size_t)l * D + k) * NEXP + e] : 0.f; const unsigned hi = f2bf(wv); rwh[i] = (bf16_t)hi; rwl[i] = (bf16_t)f2bf(wv - bf2f(hi)); } } } PROBE_T1(0) SEAM(step); }
    ++step;
#define PHV const int mb = opqs(mb0), layer = opqs(layer0), nr = rows_of(mb); (void)nr; (void)layer
    for (int mb0 = 0; mb0 < NMB; ++mb0)
        for (int layer0 = 0; layer0 < DEPTH; ++layer0) {
            if (IN(step)) { PROBE_T0(2) if constexpr (PHON(2)) { PF(F); PHV; pg8::Gemm g{layer == 0 ? ws_bf(F, WS_XB0) + (size_t)mb * R * D : ws_bf(F, WS_XB), wl_ptr(F, layer, WL_IN), nr, DINP, D, D, nullptr}; pg8::StaticOrder S; S.init(nr, DINP, F.G, F.bid, 2);
                pg8::EpiStoreBf16 E{ws_bf(F, WS_H), DINP}; pg8::gemm_phase(F.lds, g, S, E, F.wave); } PROBE_T1(2) SEAM(step); }
            ++step;
            if (IN(step)) { PROBE_T0(13) if constexpr (PHON(13)) { PF(F); PHV; step_premix(F, layer, mb); } PROBE_T1(13) SEAM(step); }
            ++step;
            if (IN(step)) { PROBE_T0(3) if constexpr (PHON(3)) { PF(F); PHV; step_mixers(F, layer, mb); } PROBE_T1(3) SEAM(step); }
            ++step;
            if (IN(step)) { PROBE_T0(5) if constexpr (PHON(5)) { PF(F); PHV; pg8::StaticOrder S; S.init(NP, D, F.G, F.bid); bf16_t* H = ws_bf(F, WS_H); bf16_t* MGb = ws_bf(F, WS_XB);
#ifndef MERGE_MASK
#define MERGE_MASK 7
#endif
                if constexpr (MERGE_MASK & 1) { pg8::Gemm g{H + C_Z, wl_ptr(F, layer, WL_SSD), NP, D, DINNER, DINP, nullptr, ws_f(F, WS_SSQ)}; pg8::EpiGate<0> E{H + C_GSSD, MGb}; pg8::gemm_phase<pg8::EpiGate<0>, pg8::StaticOrder, false, true>(F.lds, g, S, E, F.wave); }
                if constexpr (MERGE_MASK & 2) { pg8::Gemm g{H + C_Q, wl_ptr(F, layer, WL_ATT), NP, D, D, DINP, nullptr}; pg8::EpiGate<1> E{H + C_GATT, MGb}; pg8::gemm_phase(F.lds, g, S, E, F.wave); }
                if constexpr (MERGE_MASK & 4) { pg8::Gemm g{H + C_SCB, wl_ptr(F, layer, WL_SC), NP, D, D, DINP, nullptr}; pg8::EpiGate<1> E{H + C_GSC, MGb}; pg8::gemm_phase(F.lds, g, S, E, F.wave); }
                if (mb == 0) for (int u = F.bid; u < 256; u += F.G) sample_unit<0>(F, layer, u); }
                PROBE_T1(5) SEAM(step); }
            ++step;
            if (IN(step)) { PROBE_T0(6) if constexpr (PHON(6)) { PF(F); PHV; pg8::Gemm g{ws_bf(F, WS_XB), wl_ptr(F, layer, WL_O), NP, D, D, D, nullptr}; pg8::StaticOrder S; S.init(NP, D, F.G, F.bid);
                pg8::EpiResid E{layer == 0 ? F.in[I_XP] + (size_t)mb * NP * D : F.out + O_YP + (size_t)mb * NP * D, layer == 0 ? F.in[I_XS] : F.out + O_YS, F.out + O_YP + (size_t)mb * NP * D, F.out + O_YS, ws_f(F, WS_STAT)};
                pg8::gemm_phase(F.lds, g, S, E, F.wave);
                if (mb == 0) for (int u = F.bid; u < 256; u += F.G) sample_unit<1>(F, layer, u); } PROBE_T1(6) SEAM(step); }
            ++step;
            if (IN(step)) { PROBE_T0(7) if constexpr (PHON(7)) { PF(F); PHV; step_ln1_router_mfma(F, layer, mb); } PROBE_T1(7) SEAM(step); }
            ++step;
            if (IN(step)) { PROBE_T0(8) if constexpr (PHON(8)) { PF(F); PHV; step_gather(F, layer, mb); } PROBE_T1(8) SEAM(step); }
            ++step;
            if (IN(step)) { PROBE_T0(9) if constexpr (PHON(9)) { PF(F); PHV; const int nt = moe_table(F, layer, mb); pg8::MoeOrder S{(const LAS int*)(F.lds + MISC_OFF) + 16, 8, nt * 8, F.G, F.bid};
                pg8::Gemm g{ws_bf(F, WS_XB), wl_ptr(F, layer, WL_UP), nr  , 2048, D, D, (const int*)(F.ws + WS_RTOK)}; pg8::EpiSwiglu E{ws_bf(F, WS_H) + (size_t)RP * D, F.in[I_BUP] + (size_t)layer * NEXP * 2048};
                pg8::gemm_phase<pg8::EpiSwiglu, pg8::MoeOrder, true>(F.lds, g, S, E, F.wave); } PROBE_T1(9) SEAM(step); }
            ++step;
            if (IN(step)) { PROBE_T0(10) if constexpr (PHON(10)) { PF(F); PHV; const int nt = moe_table(F, layer, mb); pg8::MoeOrder S{(const LAS int*)(F.lds + MISC_OFF) + 16, 4, nt * 4, F.G, F.bid};
                pg8::Gemm g{ws_bf(F, WS_H) + (size_t)RP * D, wl_ptr(F, layer, WL_DN), nt * 256, D, D, D, nullptr}; pg8::EpiDown E{ws_bf(F, WS_H) + (size_t)2 * RP * D, F.in[I_BDN] + (size_t)layer * NEXP * D, ws_f(F, WS_GSORT)};
                pg8::gemm_phase(F.lds, g, S, E, F.wave); } PROBE_T1(10) SEAM(step); }
            ++step;
            if (IN(step)) { PROBE_T0(11) if constexpr (PHON(11)) { PF(F); PHV; step_ln2(F, layer, mb); } PROBE_T1(11) SEAM(step); }
            ++step;
        }
}

#ifdef EMU
extern int emu_grid, emu_step_lo, emu_step_hi;
#endif
extern "C" void kernel_launch(void* const* d_in, const int* in_sizes, int n_in, void* d_out, int out_size, void* d_ws, size_t ws_size, hipStream_t stream) {
    (void)in_sizes; (void)out_size;
    if (n_in != 31 || ws_size < WS_END) { fprintf(stderr, "kernel_launch: expected 31 inputs and >= %zu bytes of workspace (got %d, %zu)\n", (size_t)WS_END, n_in, ws_size); return; }
    Args a; memset(&a, 0, sizeof(a));
    for (int i = 0; i < 31; ++i) a.in[i] = (const float*)d_in[i];
    a.out = (float*)d_out; a.ws = (unsigned char*)d_ws;
#ifdef EMU
    if (emu_step_lo == 0) memset((char*)d_ws + WS_CTL, 0, CTL_BYTES);
    for (int s = emu_step_lo; s < emu_step_hi && s < NSTEPS; ++s) { a.lo = s; a.hi = s + 1; emu_launch(fwd, emu_grid, NTHREADS, LDS_BYTES, a); fprintf(stderr, "step %d done\n", s); }
#else
    (void)hipMemsetAsync((char*)d_ws + WS_CTL, 0, CTL_BYTES, stream);
    static int grid = 0;
    if (grid == 0) {
        int dev = 0, cus = 0;
        if (hipGetDevice(&dev) != hipSuccess || hipDeviceGetAttribute(&cus, hipDeviceAttributeMultiprocessorCount, dev) != hipSuccess) { grid = -1; return; }
        if (hipFuncSetAttribute((const void*)fwd, hipFuncAttributeMaxDynamicSharedMemorySize, LDS_BYTES) != hipSuccess) { grid = -1; return; }
        int per_cu = 0; (void)hipOccupancyMaxActiveBlocksPerMultiprocessor(&per_cu, (const void*)fwd, NTHREADS, LDS_BYTES); (void)hipGetLastError();
        grid = cus / 64 * 64;
        if (grid < 64) { grid = -1; return; }
    }
    if (grid < 0) return;
#if CFG_ONE_LAUNCH
    a.lo = 0; a.hi = NSTEPS; hipLaunchKernelGGL(fwd, dim3(grid), dim3(NTHREADS), LDS_BYTES, stream, a);
#else
    for (int s = 0; s < NSTEPS; ++s) { a.lo = s; a.hi = s + 1; hipLaunchKernelGGL(fwd, dim3(grid), dim3(NTHREADS), LDS_BYTES, stream, a); }
#endif
#endif
}
```

```cpp
#ifdef EMU
#include "emu.h"
#else
#include <hip/hip_runtime.h>
#endif
#include <cstdio>
#include <cstdint>
#include <cstring>
#include <cstddef>
#include <cmath>

#ifndef CFG_BATCH
#define CFG_BATCH 16
#endif
#ifndef CFG_SEQ
#define CFG_SEQ 4096
#endif
#ifndef CFG_NSEQ_MB
#define CFG_NSEQ_MB 8
#endif
#ifndef CFG_NEXP
#define CFG_NEXP 32
#endif
#ifndef CFG_ONE_LAUNCH
#define CFG_ONE_LAUNCH 1
#endif

constexpr int BATCH = CFG_BATCH, SEQ = CFG_SEQ, NSEQ_MB = CFG_NSEQ_MB, NEXP = CFG_NEXP, NMB = BATCH / NSEQ_MB;
constexpr int D = 1024, DEPTH = 2, DECB = 16, DECS = 16, NS = DECB * DECS;
constexpr int DINNER = 2048, CONVDIM = 4096;
constexpr int NKV = 4, WINDOW = 128, CHUNK = 64;
constexpr int DIN = 13856, DINP = 14080;
constexpr int NP = NSEQ_MB * SEQ, R = NP + NS;
constexpr int NTE = (NEXP + 15) / 16;
constexpr int RP = ((4 * R + NEXP * 255) + 255) / 256 * 256;
constexpr int NCHUNK = SEQ / CHUNK;
constexpr int C_Z = 0, C_X = 2048, C_B = 4096, C_C = 5120, C_Q = 6144, C_K = 7168, C_V = 7424, C_SCB = 7680, C_SCC = 8704, C_SCH = 9728, C_GSSD = 10752, C_GATT = 11776, C_GSC = 12800, C_DT = 13824;
constexpr float LN_EPS = 1e-5f, ALPHA = 1.41421356237309515f  , SW_LIMIT = 7.0f, SW_ALPHA = 1.702f;
static_assert(BATCH % NSEQ_MB == 0 && SEQ % 256 == 0 && (NEXP & (NEXP - 1)) == 0 && NEXP <= 32 && NEXP >= 4, "config");

constexpr size_t O_YP = 0, O_YS = O_YP + (size_t)BATCH * SEQ * D, O_KP = O_YS + (size_t)NS * D, O_VP = O_KP + (size_t)DEPTH * BATCH * WINDOW * 256,
    O_SSP = O_VP + (size_t)DEPTH * BATCH * WINDOW * 256, O_CVP = O_SSP + (size_t)DEPTH * BATCH * 32 * 64 * 128, O_SCP = O_CVP + (size_t)DEPTH * BATCH * 3 * CONVDIM,
    O_KS = O_SCP + (size_t)DEPTH * BATCH * 2 * D, O_VS = O_KS + (size_t)DEPTH * DECB * DECS * 256, O_SSS = O_VS + (size_t)DEPTH * DECB * DECS * 256,
    O_CVS = O_SSS + (size_t)DEPTH * DECB * 32 * 64 * 128, O_SCS = O_CVS + (size_t)DEPTH * DECB * 3 * CONVDIM, O_END = O_SCS + (size_t)DEPTH * DECB * 2 * D;

constexpr size_t al256(size_t x) { return (x + 255) / 256 * 256; }
constexpr size_t WS_CTL = 0, CTL_BYTES = 1u << 20;
constexpr size_t WS_SSQ = CTL_BYTES, WS_TOPI = WS_SSQ + al256((size_t)R * 128 * 4)  , WS_GATE = WS_TOPI + al256((size_t)R * 16), WS_POS = WS_GATE + al256((size_t)R * 16),
    WS_GSORT = WS_POS + al256((size_t)R * 16), WS_RTOK = WS_GSORT + al256((size_t)RP * 4),
    WS_RWH = WS_RTOK + al256((size_t)RP * 4)  , WS_RWL = WS_RWH + (size_t)DEPTH * NTE * 16 * D * 2  , WS_W = WS_RWL + (size_t)DEPTH * NTE * 16 * D * 2;
constexpr size_t WL_IN = 0, WL_SSD = WL_IN + (size_t)DINP * D * 2, WL_ATT = WL_SSD + (size_t)D * DINNER * 2, WL_SC = WL_ATT + (size_t)D * D * 2, WL_O = WL_SC + (size_t)D * D * 2,
    WL_UP = WL_O + (size_t)D * D * 2, WL_DN = WL_UP + (size_t)NEXP * 2048 * D * 2, WL_BYTES = WL_DN + (size_t)NEXP * D * D * 2;
constexpr size_t WS_XB = WS_W + DEPTH * WL_BYTES, WS_XB0 = WS_XB + (size_t)R * D * 2  , WS_PRE = WS_XB0 + (size_t)NMB * R * D * 2  , WS_H = WS_PRE + (size_t)R * D * 2;
constexpr size_t WS_STAT = WS_PRE;
constexpr size_t H_BYTES = (size_t)R * DINP * 2, MOE_BYTES = (size_t)3 * RP * D * 2, U_BYTES = H_BYTES > MOE_BYTES ? H_BYTES : MOE_BYTES;
constexpr size_t WS_CMC = WS_H + U_BYTES, WS_BTG = WS_CMC + (size_t)NP * 1024 * 2, WS_CBG = WS_BTG + (size_t)NSEQ_MB * NCHUNK * 8 * 8192 * 2, WS_END = WS_CBG + (size_t)NSEQ_MB * NCHUNK * 8 * 4096 * 2;
static_assert(WS_END <= ((size_t)2 << 30), "workspace map exceeds 2 GiB");
constexpr int CW_BAR = 4096, CW_CNT = 16384;

constexpr int RING_BYTES = 131072, LDS_BYTES = 163840  , MISC_OFF = LDS_BYTES - 1024, SCR_BYTES = MISC_OFF;
constexpr int NWAVES = 8, NTHREADS = 512;

#ifdef EMU
#define LAS
#define WAVE_SYNC() emu_wave_barrier()
#else
#define LAS __attribute__((address_space(3)))
#define WAVE_SYNC() asm volatile("s_waitcnt lgkmcnt(0)" ::: "memory")
#endif
#ifdef EMU
#define LBAR() emu_wg_barrier()
#define VM_WAIT(n) do { } while (0)
#else
#define LBAR() do { asm volatile("s_waitcnt lgkmcnt(0)" ::: "memory"); __builtin_amdgcn_s_barrier(); asm volatile("" ::: "memory"); } while (0)
#define VM_WAIT(n) asm volatile("s_waitcnt vmcnt(" #n ")" ::: "memory")
#endif
typedef unsigned short bf16_t;
typedef short bf16x8 __attribute__((ext_vector_type(8)));
typedef float f32x4 __attribute__((ext_vector_type(4)));
typedef float f32x16 __attribute__((ext_vector_type(16)));
typedef unsigned u32x4 __attribute__((ext_vector_type(4)));
typedef unsigned u32x2 __attribute__((ext_vector_type(2)));

__device__ __forceinline__ unsigned f2bf(float f) { unsigned u = __builtin_bit_cast(unsigned, f); return (u + 0x7fffu + ((u >> 16) & 1u)) >> 16; }
__device__ __forceinline__ float bf2f(unsigned h) { return __builtin_bit_cast(float, (h & 0xffffu) << 16); }
#ifdef EMU
__device__ __forceinline__ unsigned pk2(float lo, float hi) { return f2bf(lo) | (f2bf(hi) << 16); }
#else
typedef float f32x2_t __attribute__((ext_vector_type(2))); typedef __bf16 bf16x2_t __attribute__((ext_vector_type(2)));
__device__ __forceinline__ unsigned pk2(float lo, float hi) { f32x2_t v = {lo, hi}; bf16x2_t b = __builtin_convertvector(v, bf16x2_t); return __builtin_bit_cast(unsigned, b); }
#endif
#ifdef EMU
__device__ __forceinline__ unsigned short bf1(float f) { return (unsigned short)f2bf(f); }
#else
__device__ __forceinline__ unsigned short bf1(float f) { return (unsigned short)pk2(f, f); }
#endif
__device__ __forceinline__ float blo(unsigned w) { return __builtin_bit_cast(float, w << 16); }
__device__ __forceinline__ float bhi(unsigned w) { return __builtin_bit_cast(float, w & 0xffff0000u); }
__device__ __forceinline__ void unpack8(const u32x4 w, float* f) { f[0] = blo(w.x); f[1] = bhi(w.x); f[2] = blo(w.y); f[3] = bhi(w.y); f[4] = blo(w.z); f[5] = bhi(w.z); f[6] = blo(w.w); f[7] = bhi(w.w); }
__device__ __forceinline__ u32x4 pack8(const float* f) { u32x4 w; w.x = pk2(f[0], f[1]); w.y = pk2(f[2], f[3]); w.z = pk2(f[4], f[5]); w.w = pk2(f[6], f[7]); return w; }
__device__ __forceinline__ float fexp(float x) { return __builtin_amdgcn_exp2f(x * 1.4426950408889634f); }
__device__ __forceinline__ float fsigmoid(float x) { return __builtin_amdgcn_rcpf(1.0f + __builtin_amdgcn_exp2f(-1.4426950408889634f * x)); }
__device__ __forceinline__ float fsilu(float x) { return x * fsigmoid(x); }
#ifdef EMU
__device__ __forceinline__ int opq(int x) { return x; }
#else
__device__ __forceinline__ int opq(int x) { asm volatile("" : "+v"(x)); return x; }
#endif
#ifdef EMU
__device__ __forceinline__ int opqs(int x) { return x; }
#else
__device__ __forceinline__ int opqs(int x) { asm volatile("" : "+s"(x)); return x; }
#endif
#ifdef EMU
__device__ __forceinline__ int lane_id() { return (int)(threadIdx.x & 63); }
#else
__device__ __forceinline__ int lane_id() { return (int)__builtin_amdgcn_mbcnt_hi(~0u, __builtin_amdgcn_mbcnt_lo(~0u, 0u)); }
#endif
#ifdef EMU
template <int MASK> __device__ __forceinline__ unsigned xshfl_u(unsigned x) { return __shfl_xor(x, MASK); }
#else
template <int MASK> __device__ __forceinline__ unsigned xshfl_u(unsigned x) {
    if constexpr (MASK == 1) return (unsigned)__builtin_amdgcn_update_dpp((int)x, (int)x, 0xB1, 0xF, 0xF, false);
    else if constexpr (MASK == 2) return (unsigned)__builtin_amdgcn_update_dpp((int)x, (int)x, 0x4E, 0xF, 0xF, false);
    else if constexpr (MASK == 4) { const int t = __builtin_amdgcn_update_dpp((int)x, (int)x, 0x114, 0xF, 0xA, false);
        return (unsigned)__builtin_amdgcn_update_dpp(t, (int)x, 0x104, 0xF, 0x5, false); }
    else if constexpr (MASK == 8) return (unsigned)__builtin_amdgcn_update_dpp((int)x, (int)x, 0x128, 0xF, 0xF, false);
    else if constexpr (MASK == 16) { const auto rr = __builtin_amdgcn_permlane16_swap(x, x, false, false); return (lane_id() & 16) ? rr[0] : rr[1]; }
    else { const auto rr = __builtin_amdgcn_permlane32_swap(x, x, false, false); return (lane_id() & 32) ? rr[0] : rr[1]; }
}
#endif
template <int MASK> __device__ __forceinline__ float xshfl(float x) { return __builtin_bit_cast(float, xshfl_u<MASK>(__builtin_bit_cast(unsigned, x))); }
template <int MASK> __device__ __forceinline__ int xshfl(int x) { return (int)xshfl_u<MASK>((unsigned)x); }
__device__ __forceinline__ float wave_sum(float v) { v += xshfl<1>(v); v += xshfl<2>(v); v += xshfl<4>(v); v += xshfl<8>(v); v += xshfl<16>(v); v += xshfl<32>(v); return v; }
#ifdef EMU
__device__ __forceinline__ float wave_scan_incl(float v, int lane) { for (int o = 1; o < 64; o <<= 1) { const float t = __shfl(v, lane - o < 0 ? 0 : lane - o); if (lane >= o) v += t; } return v; }
__device__ __forceinline__ float wave_last(float v) { return __shfl(v, 63); }
#else
__device__ __forceinline__ float wave_scan_incl(float v, int) {
#define WSC_STEP(ctrl_, rm_) v += __builtin_bit_cast(float, __builtin_amdgcn_update_dpp(0, __builtin_bit_cast(int, v), ctrl_, rm_, 0xF, false))
    WSC_STEP(0x111, 0xF); WSC_STEP(0x112, 0xF); WSC_STEP(0x114, 0xF); WSC_STEP(0x118, 0xF); WSC_STEP(0x142, 0xA); WSC_STEP(0x143, 0xC);
#undef WSC_STEP
    return v;
}
__device__ __forceinline__ float wave_last(float v) { return __builtin_bit_cast(float, __builtin_amdgcn_readlane(__builtin_bit_cast(int, v), 63)); }
#endif

#ifndef PROBE_MASK
#define PROBE_MASK 0
#endif
#if PROBE_MASK && !defined(EMU)
#define PROBE_T0(b) unsigned long long pt0_ = 0; if constexpr ((PROBE_MASK >> (b)) & 1) pt0_ = __builtin_amdgcn_s_memrealtime();
#define PROBE_T1(b) if constexpr ((PROBE_MASK >> (b)) & 1) { asm volatile("s_waitcnt vmcnt(0) lgkmcnt(0)" ::: "memory"); const unsigned long long pt1_ = __builtin_amdgcn_s_memrealtime(); \
    while (__builtin_amdgcn_s_memrealtime() < pt1_ + (pt1_ - pt0_)) __builtin_amdgcn_s_sleep(8); }
#else
#define PROBE_T0(b)
#define PROBE_T1(b)
#endif
namespace pg8 {
constexpr int BM = 256, BK = 64, HALF = 128, HTB = HALF * BK * 2, NXCD = 8, WGM = 8;
struct Unit { int pm, pn, bt, e; };
struct Gemm { const bf16_t* A; const bf16_t* Bt; int M, N, K, lda; const int* tok; const float* ssq = nullptr; };
struct StaticOrder {
    int nM, nN, nwg, G, c, wgm;
    __host__ __device__ void init(int M, int N, int G_, int c_, int wgm_ = WGM) { nM = M / BM; nN = N / BM; nwg = nM * nN; G = G_; c = c_; wgm = wgm_; }
    __host__ __device__ bool next(int i, Unit& u) const {
        const long L = (long)i * G + c; if (L >= nwg) return false;
        int wgid = (int)L; { const int q = nwg / NXCD, r = nwg % NXCD, xcd = wgid % NXCD, off = wgid / NXCD; wgid = (xcd < r ? xcd * (q + 1) : r * (q + 1) + (xcd - r) * q) + off; }
        const int nig = wgm * nN, gid = wgid / nig, fm = gid * wgm, gsz = (nM - fm) < wgm ? (nM - fm) : wgm;
        u.pm = fm + ((wgid % nig) % gsz); u.pn = (wgid % nig) / gsz; u.bt = u.pn; u.e = 0; return true;
    }
    __device__ __forceinline__ void a_ready(const Unit&) const {}
    __device__ __forceinline__ void done(const Unit&) const {}
};
struct MoeOrder {
    const LAS int* tend; int npn, ntot, G, c;
    __device__ __forceinline__ bool next(int i, Unit& u) const {
        int rt, pn;
        {
            const int xcd = c & 7, j = c >> 3, rpx = (G >> 3) / npn; rt = (i * 8 + xcd) * rpx + j / npn; pn = j % npn; if (rt >= ntot / npn) return false; }
        int e = 0;
#pragma unroll
        for (int j = 0; j < NEXP; ++j) e += (tend[j] <= rt) ? 1 : 0;
        u.pm = rt; u.pn = pn; u.e = e; u.bt = e * npn + pn; return true;
    }
    __device__ __forceinline__ void a_ready(const Unit&) const {}
    __device__ __forceinline__ void done(const Unit&) const {}
};
#ifdef EMU
template <class Epi, class Sched, bool GATHER = false, bool GSCALE = false>
__device__ void gemm_phase(LAS unsigned char* lds, const Gemm g, const Sched& S, const Epi& E, int  ) {
    const int tid = threadIdx.x, wid = tid >> 6, lane = tid & 63, wr = wid >> 2, wc = wid & 3, fr = lane & 15, fq = lane >> 4;
    Unit u;
    for (int i = 0; S.next(i, u); ++i) {
        f32x4 acc[2][2][4][2];
        for (int ai = 0; ai < 2; ++ai) for (int bj = 0; bj < 2; ++bj) for (int m = 0; m < 4; ++m) for (int n = 0; n < 2; ++n) for (int q = 0; q < 4; ++q) {
            const int row = u.pm * 256 + ai * 128 + wr * 64 + m * 16 + fr, col = u.bt * 256 + bj * 128 + wc * 32 + 8 * fq + 4 * n + q;
            const bf16_t* a = g.A + (size_t)(GATHER ? ((unsigned)g.tok[row] < (unsigned)g.M ? g.tok[row] : 0) : row) * g.lda; const bf16_t* b = g.Bt + (size_t)col * g.K; float s = 0.f;
            if constexpr (GSCALE) {
                float rs[9]; for (int j = 0; j < 8; ++j) { float q2 = 0.f; for (int i = 0; i < 16; ++i) q2 += g.ssq[(size_t)row * 128 + 16 * j + i]; rs[j] = 1.0f / sqrtf(q2 * (1.0f / 256.0f) + LN_EPS); } rs[8] = 1.f;
                for (int j = 0; j < 8; ++j) { for (int k = 256 * j; k < 256 * j + 256; ++k) s += bf2f(a[k]) * bf2f(b[k]); s *= rs[j] * (1.0f / rs[j + 1]); } }
            else for (int k = 0; k < g.K; ++k) s += bf2f(a[k]) * bf2f(b[k]);
            acc[ai][bj][m][n][q] = s; }
        E(acc, u, wr, wc, fr, fq);
    }
    __syncthreads();
}
#else
#define PG8_LAS __attribute__((address_space(3)))
__host__ __device__ __forceinline__ int lds_byte(int r, int c) { const int st = (r >> 4) * 2 + (c >> 5), rr = r & 15, cc = c & 31, ob = rr * 64 + cc * 2; return st * 1024 + (ob ^ (((ob >> 9) & 1) << 5)); }
__host__ __device__ __forceinline__ void stage_rc(int b, int& R_, int& C_) { const int st = b / 1024, sb = b % 1024, swz = sb ^ (((sb >> 9) & 1) << 5); R_ = (st >> 1) * 16 + swz / 64; C_ = (st & 1) * 32 + (swz % 64) / 2; }
__host__ __device__ __forceinline__ int perm32(int rho) { const int n = rho >> 4, i = rho & 15; return 8 * (i >> 2) + 4 * n + (i & 3); }
template <class Epi, class Sched, bool GATHER = false, bool GSCALE = false>
__device__ __forceinline__ void gemm_phase(PG8_LAS unsigned char* lds, const Gemm g, const Sched& S, const Epi& E, int wave_id) {
    const int lane = opq(lane_id()), wid = opqs(wave_id), tid = wid * 64 + lane, wr = wid >> 2, wc = wid & 3, fr = lane & 15, fq = lane >> 4;
    const int K = g.K, nt = K / BK, lda = g.lda;
    unsigned voffA[2], voffB[2];
#pragma unroll
    for (int i = 0; i < 2; ++i) { int R_, C_; stage_rc(tid * 16 + i * 8192, R_, C_); const int Rb = (R_ & ~31) + perm32(R_ & 31);
        voffA[i] = (unsigned)(R_ * lda + C_) * 2u; voffB[i] = (unsigned)(Rb * K + C_) * 2u; }
    unsigned vG[2][2], vN[2][2];
#define PG8_TOK(dst, pm_) do { _Pragma("unroll") for (int i_ = 0; i_ < 2; ++i_) { int R_, C_; stage_rc(opq(tid) * 16 + i_ * 8192, R_, C_); _Pragma("unroll") for (int h_ = 0; h_ < 2; ++h_) \
        { unsigned tk_ = (unsigned)g.tok[(pm_) * 256 + h_ * 128 + R_]; tk_ = tk_ < (unsigned)g.M ? tk_ : 0u; dst[h_][i_] = tk_ * (unsigned)(lda * 2) + (unsigned)(C_ * 2); } } } while (0)
#define PG8_STAGE_A(bufoff, base_, h_, nx_) do { if constexpr (GATHER) { unsigned vs_[2] = {(nx_) ? vN[h_][0] : vG[h_][0], (nx_) ? vN[h_][1] : vG[h_][1]}; PG8_STAGE(bufoff, base_, vs_); } \
        else { PG8_STAGE(bufoff, (base_) + ((h_) ? hstepA : 0), voffA); } } while (0)
    const size_t kstep = (size_t)(BK * 2);
    const size_t hstepA = (size_t)HALF * lda * 2, tstepA = 2 * hstepA;
    const size_t hstepB = (size_t)HALF * K * 2, tstepB = 2 * hstepB;
    const unsigned ldsw = (unsigned)wid * 1024u;
    const int aoff = lds_byte(wr * 64 + fr, fq * 8), boff = lds_byte(wc * 32 + fr, fq * 8);
#define PG8_SA(b, h) (((b) * 2 + (h)) * HTB)
#define PG8_SB(b, h) ((4 + (b) * 2 + (h)) * HTB)
#define PG8_STAGE(bufoff, gbase, voff) do { _Pragma("unroll") for (int _i = 0; _i < 2; ++_i) \
        __builtin_amdgcn_global_load_lds((const unsigned*)((const char*)(gbase) + (voff)[_i]), (PG8_LAS unsigned*)(lds + (bufoff) + ldsw + _i * 8192), 16, 0, 0); } while (0)
#define PG8_LDA(dst, b, h) do { _Pragma("unroll") for (int m = 0; m < 4; ++m) _Pragma("unroll") for (int k = 0; k < 2; ++k) dst[m][k] = *(const PG8_LAS bf16x8*)(lds + PG8_SA(b, h) + aoff + m * 2048 + k * 1024); } while (0)
#define PG8_LDB(dst, b, h) do { _Pragma("unroll") for (int n = 0; n < 2; ++n) _Pragma("unroll") for (int k = 0; k < 2; ++k) dst[n][k] = *(const PG8_LAS bf16x8*)(lds + PG8_SB(b, h) + boff + n * 2048 + k * 1024); } while (0)
#define PG8_MMA(ai, bj, At, Bt) do { __builtin_amdgcn_s_setprio(1); _Pragma("unroll") for (int m = 0; m < 4; ++m) _Pragma("unroll") for (int n = 0; n < 2; ++n) _Pragma("unroll") for (int k = 0; k < 2; ++k) \
        acc[ai][bj][m][n] = __builtin_amdgcn_mfma_f32_16x16x32_bf16(Bt[n][k], At[m][k], acc[ai][bj][m][n], 0, 0, 0); __builtin_amdgcn_s_setprio(0); } while (0)
#define PG8_WAIT_V(n) asm volatile("s_waitcnt vmcnt(" #n ")" ::: "memory")
#define PG8_WAIT_L(n) asm volatile("s_waitcnt lgkmcnt(" #n ")" ::: "memory")
#define PG8_BAR __builtin_amdgcn_s_barrier()
#define PG8_SCHED __builtin_amdgcn_sched_barrier(0)
    Unit cur, nxt; int ui = 0;
    if (!S.next(0, cur)) return;
    if constexpr (GSCALE) {
        static_assert(RING_BYTES + 3 * 8192 <= MISC_OFF, "group-norm factor tables");
        Unit tu;
        if (S.next(3, tu)) __builtin_trap();
#pragma unroll 1
        for (int q = 0; q < 3 && S.next(q, tu); ++q) { const int row = tid & 255, h = tid >> 8;
            const float* sp = g.ssq + (size_t)(tu.pm * 256 + row) * 128 + 64 * h; float qv[5];
#pragma unroll
            for (int gi = 0; gi < 5; ++gi) { f32x4 a_ = (f32x4){0.f, 0.f, 0.f, 0.f}, b_ = a_; if (gi < 4 || h == 0) { a_ = *(const f32x4*)(sp + 16 * gi) + *(const f32x4*)(sp + 16 * gi + 8); b_ = *(const f32x4*)(sp + 16 * gi + 4) + *(const f32x4*)(sp + 16 * gi + 12); }
                a_ = a_ + b_; qv[gi] = sqrtf(((a_[0] + a_[1]) + (a_[2] + a_[3])) * (1.0f / 256.0f) + LN_EPS); }
            PG8_LAS float* ct = (PG8_LAS float*)(lds + RING_BYTES) + q * 2048 + 4 * h * 256 + row;
#pragma unroll
            for (int j = 0; j < 4; ++j) ct[j * 256] = (h == 1 && j == 3) ? 1.0f / qv[3] : qv[j + 1] / qv[j]; }
        __syncthreads();
    }
    f32x4 acc[2][2][4][2];
#pragma unroll
    for (int a = 0; a < 2; ++a)
#pragma unroll
        for (int b = 0; b < 2; ++b)
#pragma unroll
            for (int m = 0; m < 4; ++m)
#pragma unroll
                for (int n = 0; n < 2; ++n) acc[a][b][m][n] = (f32x4){0.f, 0.f, 0.f, 0.f};
    bf16x8 At[4][2], B0[2][2], B1[2][2];
    const char* cA = (const char*)g.A + (GATHER ? (size_t)0 : (size_t)cur.pm * tstepA); const char* cB = (const char*)g.Bt + (size_t)cur.bt * tstepB;
    if constexpr (GATHER) { PG8_TOK(vG, cur.pm); }
    S.a_ready(cur);
    PG8_STAGE(PG8_SB(0, 0), cB, voffB); PG8_STAGE(PG8_SB(0, 1), cB + hstepB, voffB); PG8_STAGE_A(PG8_SA(0, 0), cA, 0, false); PG8_STAGE_A(PG8_SA(0, 1), cA, 1, false);
    if (wr == 1) PG8_BAR;
    PG8_WAIT_V(2); PG8_BAR;
    PG8_STAGE(PG8_SB(1, 0), cB + kstep, voffB); PG8_STAGE_A(PG8_SA(1, 0), cA + kstep, 0, false); PG8_STAGE(PG8_SB(1, 1), cB + hstepB + kstep, voffB);
    PG8_WAIT_V(6); PG8_BAR;
    for (;;) {
        const bool has_next = S.next(ui + 1, nxt);
        const char* nA = has_next ? (const char*)g.A + (GATHER ? (size_t)0 : (size_t)nxt.pm * tstepA) : cA; const char* nB = has_next ? (const char*)g.Bt + (size_t)nxt.bt * tstepB : cB;
        if constexpr (GATHER) {
#pragma unroll
            for (int h_ = 0; h_ < 2; ++h_) { vN[h_][0] = vG[h_][0]; vN[h_][1] = vG[h_][1]; }
            if (has_next) {
#pragma unroll
                for (int i_ = 0; i_ < 2; ++i_) { int R_, C_; stage_rc(opq(tid) * 16 + i_ * 8192, R_, C_);
#pragma unroll
                    for (int h_ = 0; h_ < 2; ++h_) { const int* tp_ = g.tok + nxt.pm * 256 + h_ * 128 + R_;
                        asm volatile("global_load_dword %0, %1, off" : "=v"(vN[h_][i_]) : "v"(tp_) : "memory"); } } } }
        for (int t = 0; t < nt; t += 2) {
            const bool last = (t == nt - 2);
            const char* a1 = cA + (size_t)(t + 1) * kstep;
            const char* a2 = last ? nA : cA + (size_t)(t + 2) * kstep; const char* b2 = last ? nB : cB + (size_t)(t + 2) * kstep;
            const char* a3 = a2 + kstep; const char* b3 = b2 + kstep;
            if (last && has_next) S.a_ready(nxt);
            if constexpr (GATHER) { if (last && has_next) {
#pragma unroll
                for (int i_ = 0; i_ < 2; ++i_) { int R_, C_; stage_rc(opq(tid) * 16 + i_ * 8192, R_, C_);
#pragma unroll
                    for (int h_ = 0; h_ < 2; ++h_) { unsigned tk_ = vN[h_][i_]; asm volatile("" : "+v"(tk_)); tk_ = tk_ < (unsigned)g.M ? tk_ : 0u; vN[h_][i_] = tk_ * (unsigned)(lda * 2) + (unsigned)(C_ * 2); } } } }
            PG8_LDB(B0, 0, 0); PG8_LDB(B1, 0, 1); PG8_SCHED; PG8_LDA(At, 0, 0); PG8_STAGE_A(PG8_SA(1, 1), a1, 1, false);
            PG8_WAIT_V(8); PG8_WAIT_L(0); PG8_BAR; PG8_MMA(0, 0, At, B0); PG8_MMA(0, 1, At, B1); PG8_BAR; PG8_SCHED;
            PG8_LDA(At, 0, 1); PG8_STAGE(PG8_SB(0, 0), b2, voffB); PG8_STAGE(PG8_SB(0, 1), b2 + hstepB, voffB); PG8_STAGE_A(PG8_SA(0, 0), a2, 0, last);
            PG8_WAIT_V(8); PG8_WAIT_L(0); PG8_BAR; PG8_MMA(1, 0, At, B0); PG8_MMA(1, 1, At, B1); PG8_BAR; PG8_SCHED;
            PG8_LDB(B0, 1, 0); PG8_LDB(B1, 1, 1); PG8_SCHED; PG8_LDA(At, 1, 0); PG8_STAGE_A(PG8_SA(0, 1), a2, 1, last);
            PG8_WAIT_V(8); PG8_WAIT_L(0); PG8_BAR; PG8_MMA(0, 0, At, B0); PG8_MMA(0, 1, At, B1); PG8_BAR; PG8_SCHED;
            PG8_LDA(At, 1, 1); PG8_STAGE(PG8_SB(1, 0), b3, voffB); PG8_STAGE(PG8_SB(1, 1), b3 + hstepB, voffB); PG8_STAGE_A(PG8_SA(1, 0), a3, 0, last);
            PG8_WAIT_V(8); PG8_WAIT_L(0); PG8_BAR; PG8_MMA(1, 0, At, B0); PG8_MMA(1, 1, At, B1); PG8_BAR; PG8_SCHED;
            if constexpr (GSCALE) { if (t & 2) {
                const PG8_LAS float* cp = (const PG8_LAS float*)(lds + RING_BYTES) + ui * 2048 + (t >> 2) * 256 + wr * 64 + fr; float cv[2][4];
#pragma unroll
                for (int a = 0; a < 2; ++a)
#pragma unroll
                    for (int m = 0; m < 4; ++m) cv[a][m] = cp[a * 128 + m * 16];
#pragma unroll
                for (int a = 0; a < 2; ++a)
#pragma unroll
                    for (int b = 0; b < 2; ++b)
#pragma unroll
                        for (int m = 0; m < 4; ++m)
#pragma unroll
                            for (int n = 0; n < 2; ++n) acc[a][b][m][n] = acc[a][b][m][n] * cv[a][m];
                PG8_SCHED; } }
        }
        if (wr == 0) PG8_BAR;
        E(acc, cur, wr, wc, fr, fq); S.done(cur);
        if (!has_next) break;
#pragma unroll
        for (int a = 0; a < 2; ++a)
#pragma unroll
            for (int b = 0; b < 2; ++b)
#pragma unroll
                for (int m = 0; m < 4; ++m)
#pragma unroll
                    for (int n = 0; n < 2; ++n) acc[a][b][m][n] = (f32x4){0.f, 0.f, 0.f, 0.f};
        cur = nxt; cA = nA; cB = nB; ++ui;
        if constexpr (GATHER) {
#pragma unroll
            for (int h_ = 0; h_ < 2; ++h_) { vG[h_][0] = vN[h_][0]; vG[h_][1] = vN[h_][1]; } }
        if (wr == 1) PG8_BAR;
    }
    PG8_WAIT_V(0);
    PG8_BAR;
#undef PG8_SA
#undef PG8_SB
#undef PG8_STAGE
#undef PG8_STAGE_A
#undef PG8_TOK
#undef PG8_LDA
#undef PG8_LDB
#undef PG8_MMA
#undef PG8_WAIT_V
#undef PG8_WAIT_L
#undef PG8_BAR
#undef PG8_SCHED
}
#endif

struct EpiStoreBf16 {
    bf16_t* O; int ldc;
    __device__ __forceinline__ void operator()(const f32x4 (&acc)[2][2][4][2], const Unit& u, int wr, int wc, int fr, int fq) const {
        const int row0 = u.pm * 256 + wr * 64 + fr, col0 = u.pn * 256 + wc * 32 + 8 * fq;
#pragma unroll
        for (int ai = 0; ai < 2; ++ai)
#pragma unroll
            for (int m = 0; m < 4; ++m)
#pragma unroll
                for (int bj = 0; bj < 2; ++bj) { const f32x4 v0 = acc[ai][bj][m][0], v1 = acc[ai][bj][m][1];
                    u32x4 w; w.x = pk2(v0[0], v0[1]); w.y = pk2(v0[2], v0[3]); w.z = pk2(v1[0], v1[1]); w.w = pk2(v1[2], v1[3]);
                    *(u32x4*)(O + (size_t)(row0 + ai * 128 + m * 16) * ldc + col0 + bj * 128) = w; }
    }
};
template <int MODE> struct EpiGate {
    const bf16_t* Hg; bf16_t* MGb;
    __device__ __forceinline__ void operator()(const f32x4 (&acc)[2][2][4][2], const Unit& u, int wr, int wc, int fr, int fq) const {
        const int row0 = u.pm * 256 + wr * 64 + fr, col0 = u.pn * 256 + wc * 32 + 8 * fq;
#pragma unroll
        for (int ai = 0; ai < 2; ++ai) {
            u32x4 gw[4][2], pw[4][2];
#pragma unroll
            for (int m = 0; m < 4; ++m)
#pragma unroll
                for (int bj = 0; bj < 2; ++bj) { const int row = row0 + ai * 128 + m * 16, col = col0 + bj * 128;
                    gw[m][bj] = *(const u32x4*)(Hg + (size_t)row * DINP + col); if (MODE != 0) pw[m][bj] = *(const u32x4*)(MGb + (size_t)row * D + col); }
            asm volatile("" ::: "memory");
#pragma unroll
            for (int m = 0; m < 4; ++m)
#pragma unroll
                for (int bj = 0; bj < 2; ++bj) { const int row = row0 + ai * 128 + m * 16, col = col0 + bj * 128; const f32x4 v0 = acc[ai][bj][m][0], v1 = acc[ai][bj][m][1];
                    float g[8], p[8], v[8] = {v0[0], v0[1], v0[2], v0[3], v1[0], v1[1], v1[2], v1[3]}; unpack8(gw[m][bj], g);
                    if (MODE != 0) { unpack8(pw[m][bj], p);
#pragma unroll
                        for (int i = 0; i < 8; ++i) v[i] = p[i] + v[i] * fsigmoid(g[i]); }
                    else {
#pragma unroll
                        for (int i = 0; i < 8; ++i) v[i] = v[i] * fsigmoid(g[i]); }
                    *(u32x4*)(MGb + (size_t)row * D + col) = pack8(v); }
            asm volatile("" ::: "memory");
        }
    }
};
struct EpiResid {
    const float* xp; const float* xs; float* op; float* os;
    float* st;
    __device__ __forceinline__ void operator()(const f32x4 (&acc)[2][2][4][2], const Unit& u, int wr, int wc, int fr, int fq) const {
        const int row0 = u.pm * 256 + wr * 64 + fr, col0 = u.pn * 256 + wc * 32 + 8 * fq;
        const bool smp = u.pm * 256 >= NP;
        const float* xb = smp ? xs - (size_t)NP * D : xp; float* ob = smp ? os - (size_t)NP * D : op;
#pragma unroll
        for (int ai = 0; ai < 2; ++ai) {
            f32x4 xa[4][2][2];
#pragma unroll
            for (int m = 0; m < 4; ++m)
#pragma unroll
                for (int bj = 0; bj < 2; ++bj) { const float* xi = xb + (size_t)(row0 + ai * 128 + m * 16) * D + col0 + bj * 128; xa[m][bj][0] = *(const f32x4*)xi; xa[m][bj][1] = *(const f32x4*)(xi + 4); }
            asm volatile("" ::: "memory");
#pragma unroll
            for (int m = 0; m < 4; ++m) { float s1 = 0.f, s2 = 0.f;
#pragma unroll
                for (int bj = 0; bj < 2; ++bj) { float* xo = ob + (size_t)(row0 + ai * 128 + m * 16) * D + col0 + bj * 128;
                    const f32x4 o0 = xa[m][bj][0] * ALPHA + acc[ai][bj][m][0], o1 = xa[m][bj][1] * ALPHA + acc[ai][bj][m][1]; *(f32x4*)xo = o0; *(f32x4*)(xo + 4) = o1;
                    s1 += ((o0[0] + o0[1]) + (o0[2] + o0[3])) + ((o1[0] + o1[1]) + (o1[2] + o1[3])); s2 += ((o0[0] * o0[0] + o0[1] * o0[1]) + (o0[2] * o0[2] + o0[3] * o0[3])) + ((o1[0] * o1[0] + o1[1] * o1[1]) + (o1[2] * o1[2] + o1[3] * o1[3])); }
                s1 += xshfl<16>(s1); s1 += xshfl<32>(s1); s2 += xshfl<16>(s2); s2 += xshfl<32>(s2);
                if (fq == 0) { float* sp = st + (size_t)(row0 + ai * 128 + m * 16) * 32 + 2 * (u.pn * 4 + wc); sp[0] = s1; sp[1] = s2; } }
            asm volatile("" ::: "memory");
        }
    }
};
struct EpiSwiglu {
    bf16_t* ACT; const float* bup;
    __device__ __forceinline__ void operator()(const f32x4 (&acc)[2][2][4][2], const Unit& u, int wr, int wc, int fr, int fq) const {
        const int row0_ = u.pm * 256 + wr * 64 + fr, j0 = u.pn * 128 + wc * 32 + 8 * fq;
        const float* bg = bup + (size_t)u.e * 2048 + j0; const f32x4 bg0 = *(const f32x4*)bg, bg1 = *(const f32x4*)(bg + 4), bu0 = *(const f32x4*)(bg + 1024), bu1 = *(const f32x4*)(bg + 1028);
#pragma unroll
        for (int ai = 0; ai < 2; ++ai)
#pragma unroll
            for (int m = 0; m < 4; ++m) { const int row = row0_ + ai * 128 + m * 16;
                const f32x4 g0 = acc[ai][0][m][0] + bg0, g1 = acc[ai][0][m][1] + bg1, u0 = acc[ai][1][m][0] + bu0, u1 = acc[ai][1][m][1] + bu1; float o[8];
#pragma unroll
                for (int i = 0; i < 4; ++i) { const float ga = fminf(g0[i], SW_LIMIT), ua = fminf(fmaxf(u0[i], -SW_LIMIT), SW_LIMIT); o[i] = (ua + 1.0f) * ga * fsigmoid(SW_ALPHA * ga);
                    const float gb = fminf(g1[i], SW_LIMIT), ub = fminf(fmaxf(u1[i], -SW_LIMIT), SW_LIMIT); o[4 + i] = (ub + 1.0f) * gb * fsigmoid(SW_ALPHA * gb); }
                *(u32x4*)(ACT + (size_t)row * D + j0) = pack8(o); }
    }
};
struct EpiDown {
    bf16_t* O; const float* bdn; const float* gs;
    __device__ __forceinline__ void operator()(const f32x4 (&acc)[2][2][4][2], const Unit& u, int wr, int wc, int fr, int fq) const {
        const int row0 = u.pm * 256 + wr * 64 + fr, col0 = u.pn * 256 + wc * 32 + 8 * fq;
#pragma unroll
        for (int ai = 0; ai < 2; ++ai) {
            float gt[4];
#pragma unroll
            for (int m = 0; m < 4; ++m) gt[m] = gs[row0 + ai * 128 + m * 16];
#pragma unroll
            for (int bj = 0; bj < 2; ++bj) { const float* bp = bdn + (size_t)u.e * D + col0 + bj * 128; const f32x4 b0 = *(const f32x4*)bp, b1 = *(const f32x4*)(bp + 4);
#pragma unroll
                for (int m = 0; m < 4; ++m) { const f32x4 a0 = (acc[ai][bj][m][0] + b0) * gt[m], a1 = (acc[ai][bj][m][1] + b1) * gt[m];
                    u32x4 w; w.x = pk2(a0[0], a0[1]); w.y = pk2(a0[2], a0[3]); w.z = pk2(a1[0], a1[1]); w.w = pk2(a1[2], a1[3]);
                    *(u32x4*)(O + (size_t)(row0 + ai * 128 + m * 16) * D + col0 + bj * 128) = w; } }
            asm volatile("" ::: "memory");
        }
    }
};
}

#ifndef EMU
#define XB_TMO      128
#define XB_XCNT(j)  (256  + 64 * (j))
#define XB_XSUB(j)  (1280 + 64 * (j))
#define XB_XGEN(j)  (2304 + 64 * (j))
#define XB_TOP      3328
#define XB_TOPGEN   3392
#define XCD_BAR_WORDS 3456
#define XB_SPIN_CAP (1u << 27)
__device__ __forceinline__ unsigned xb_ld(unsigned* p)              { return __hip_atomic_load(p, __ATOMIC_RELAXED, __HIP_MEMORY_SCOPE_AGENT); }
__device__ __forceinline__ unsigned xb_add(unsigned* p, unsigned v) { return __hip_atomic_fetch_add(p, v, __ATOMIC_RELAXED, __HIP_MEMORY_SCOPE_AGENT); }
__device__ __forceinline__ unsigned xb_xcc_id() { return (unsigned)__builtin_amdgcn_s_getreg((3 << 11) | 20) & 0xFu; }
#define XB_SPIN(cond, bar) do { unsigned _sp = 0; while (cond) { __builtin_amdgcn_s_sleep(1); \
    if ((++_sp & 255u) == 0u) { if (xb_ld(&(bar)[XB_TMO])) break; if (_sp > XB_SPIN_CAP) { atomicAdd(&(bar)[XB_TMO], 1u); break; } } } } while (0)
struct XcdBarrier { unsigned* bar; unsigned x; volatile LAS unsigned* st; };
__device__ __forceinline__ XcdBarrier xcd_barrier_post(unsigned* bar, volatile LAS unsigned* st) {
    XcdBarrier b; b.bar = bar; b.x = xb_xcc_id(); b.st = st;
    if (threadIdx.x == 0) (void)xb_add(&bar[XB_XCNT(b.x)], 1u);
    return b;
}
__device__ __forceinline__ void xcd_barrier_complete(unsigned* bar, unsigned x, unsigned& nloc, unsigned& nx) {
    const unsigned G = gridDim.x * gridDim.y * gridDim.z;
    unsigned sum, cnt, mine, sp = 0u;
    for (;;) {
        sum = 0u; cnt = 0u; mine = 0u;
#pragma unroll
        for (unsigned j = 0; j < 16; ++j) { const unsigned c = xb_ld(&bar[XB_XCNT(j)]); sum += c; cnt += (c > 0u) ? 1u : 0u; mine = (j == x) ? c : mine; }
        if (sum == G) break;
        __builtin_amdgcn_s_sleep(1);
        if ((++sp & 255u) == 0u) { if (xb_ld(&bar[XB_TMO])) break; if (sp > XB_SPIN_CAP) { atomicAdd(&bar[XB_TMO], 1u); break; } }
    }
    nloc = mine > 0u ? mine : 1u; nx = cnt > 0u ? cnt : 1u;
}
__device__ __forceinline__ void xcd_barrier(const XcdBarrier& b) {
    asm volatile("s_waitcnt vmcnt(0)" ::: "memory");
    __syncthreads();
    if (threadIdx.x == 0) {
        unsigned* bar = b.bar;
        __builtin_amdgcn_s_waitcnt(0);
        unsigned nloc = b.st[0], nx = b.st[1];
        if (nloc == 0u) { xcd_barrier_complete(bar, b.x, nloc, nx); b.st[0] = nloc; b.st[1] = nx; }
        const unsigned old = xb_add(&bar[XB_XSUB(b.x)], 1u);
        const unsigned gen = old / nloc;
        if (old + 1u == (gen + 1u) * nloc) {
            __builtin_amdgcn_fence(__ATOMIC_RELEASE, "agent");
            asm volatile("s_waitcnt vmcnt(0)" ::: "memory");
            const unsigned og = xb_add(&bar[XB_TOP], 1u);
            const unsigned tg = og / nx;
            if (og + 1u == (tg + 1u) * nx) xb_add(&bar[XB_TOPGEN], 1u);
            else XB_SPIN(xb_ld(&bar[XB_TOPGEN]) == tg, bar);
            __builtin_amdgcn_fence(__ATOMIC_ACQUIRE, "agent");
            xb_add(&bar[XB_XGEN(b.x)], 1u);
            asm volatile("s_waitcnt vmcnt(0)" ::: "memory");
        } else {
            XB_SPIN(xb_ld(&bar[XB_XGEN(b.x)]) == gen, bar);
            __builtin_amdgcn_fence(__ATOMIC_ACQUIRE, "agent");
            asm volatile("s_waitcnt vmcnt(0)" ::: "memory");
        }
    }
    __syncthreads();
}
#endif

struct Args { const float* in[31]; float* out; unsigned char* ws; int lo, hi; };
typedef const float* FPtr;
#ifdef EMU
typedef const FPtr* ArgTab;
#else
typedef const __attribute__((address_space(4))) FPtr* ArgTab;
#endif
struct Frame {
    LAS unsigned char* lds; int tid, lane, wave, G, bid;
    ArgTab in; float* out; unsigned char* ws; unsigned* ctl;
};
enum { I_XP = 0, I_XS, I_CK, I_CV, I_SST, I_SCV, I_SSC, I_WIN, I_CONVW, I_CONVB, I_DTB, I_ALOG, I_SD, I_NORMW, I_WSSD, I_SINK, I_WATT, I_RELB, I_SCW, I_WSC, I_WO, I_LN1G, I_LN1B,
       I_RW, I_RB, I_WUP, I_BUP, I_WDN, I_BDN, I_LN2G, I_LN2B };

__device__ __forceinline__ bf16_t* ws_bf(const Frame& F, size_t off) { return (bf16_t*)(F.ws + off); }
__device__ __forceinline__ float* ws_f(const Frame& F, size_t off) { return (float*)(F.ws + off); }
__device__ __forceinline__ bf16_t* wl_ptr(const Frame& F, int layer, size_t off) { return (bf16_t*)(F.ws + WS_W + (size_t)layer * WL_BYTES + off); }

__device__ __forceinline__ void wt_item(const float* W, int ldw, int K, int k0, int nsrc0, const float* kscale, bf16_t* WT, int ndst0, LAS float* scr, int lane) {
    if (nsrc0 < 0) {
#pragma unroll
        for (int j = 0; j < 4; ++j) { const int n = (lane >> 3) + 8 * j; *(u32x4*)(WT + (size_t)(ndst0 + n) * K + k0 + 8 * (lane & 7)) = (u32x4){0u, 0u, 0u, 0u}; }
        return;
    }
#pragma unroll 8
    for (int i = 0; i < 32; ++i) { const int kk = 2 * i + (lane >> 5); float v = W[(size_t)(k0 + kk) * ldw + nsrc0 + (lane & 31)]; if (kscale) v *= kscale[k0 + kk]; scr[kk * 33 + (lane & 31)] = v; }
    WAVE_SYNC();
    const int c = lane & 7;
#pragma unroll
    for (int j = 0; j < 4; ++j) { const int n = (lane >> 3) + 8 * j; const LAS float* s = scr + (8 * c) * 33 + n;
        u32x4 o; o.x = pk2(s[0 * 33], s[1 * 33]); o.y = pk2(s[2 * 33], s[3 * 33]); o.z = pk2(s[4 * 33], s[5 * 33]); o.w = pk2(s[6 * 33], s[7 * 33]);
        *(u32x4*)(WT + (size_t)(ndst0 + n) * K + k0 + 8 * c) = o; }
    WAVE_SYNC();
}
__device__ __forceinline__ void step_weights(const Frame& F) {
    LAS float* scr = (LAS float*)(F.lds + F.wave * 16384);
    const int gw = F.bid * NWAVES + F.wave, NGW = F.G * NWAVES;
    constexpr int I_IN = (DINP / 32) * (D / 64), I_SSD = (D / 32) * (DINNER / 64), I_SQ = (D / 32) * (D / 64), I_UP = NEXP * (2048 / 32) * (D / 64), I_DN = NEXP * (D / 32) * (D / 64);
    constexpr int PER_LAYER = I_IN + I_SSD + 3 * I_SQ + I_UP + I_DN;
    for (int it = gw; it < DEPTH * PER_LAYER; it += NGW) {
        const int layer = it / PER_LAYER; int r = it % PER_LAYER;
        if (r < I_IN) { const int nb = r / (D / 64), kb = r % (D / 64), n0 = nb * 32;
            const int ns = n0 < 6144 ? n0 : (n0 < 13824 ? n0 + 32 : (n0 < 13856 ? n0 - 13824 + 6144 : -1));
            wt_item(F.in[I_WIN] + (size_t)layer * D * DIN, DIN, D, kb * 64, ns, nullptr, wl_ptr(F, layer, WL_IN), n0, scr, F.lane); continue; }
        r -= I_IN;
        if (r < I_SSD) { const int nb = r / (DINNER / 64), kb = r % (DINNER / 64);
            wt_item(F.in[I_WSSD] + (size_t)layer * DINNER * D, D, DINNER, kb * 64, nb * 32, F.in[I_NORMW] + (size_t)layer * DINNER, wl_ptr(F, layer, WL_SSD), nb * 32, scr, F.lane); continue; }
        r -= I_SSD;
        if (r < I_SQ) { const int nb = r / (D / 64), kb = r % (D / 64); wt_item(F.in[I_WATT] + (size_t)layer * D * D, D, D, kb * 64, nb * 32, nullptr, wl_ptr(F, layer, WL_ATT), nb * 32, scr, F.lane); continue; }
        r -= I_SQ;
        if (r < I_SQ) { const int nb = r / (D / 64), kb = r % (D / 64); wt_item(F.in[I_WSC] + (size_t)layer * D * D, D, D, kb * 64, nb * 32, nullptr, wl_ptr(F, layer, WL_SC), nb * 32, scr, F.lane); continue; }
        r -= I_SQ;
        if (r < I_SQ) { const int nb = r / (D / 64), kb = r % (D / 64); wt_item(F.in[I_WO] + (size_t)layer * D * D, D, D, kb * 64, nb * 32, nullptr, wl_ptr(F, layer, WL_O), nb * 32, scr, F.lane); continue; }
        r -= I_SQ;
        if (r < I_UP) { const int e = r / ((2048 / 32) * (D / 64)), q = r % ((2048 / 32) * (D / 64)), nb = q / (D / 64), kb = q % (D / 64), n0 = nb * 32;
            const int pn = n0 >> 8, bj = (n0 >> 7) & 1, jj = n0 & 127, ns = bj * 1024 + pn * 128 + jj;
            wt_item(F.in[I_WUP] + ((size_t)layer * NEXP + e) * D * 2048, 2048, D, kb * 64, ns, nullptr, wl_ptr(F, layer, WL_UP) + (size_t)e * 2048 * D, n0, scr, F.lane); continue; }
        r -= I_UP;
        { const int e = r / ((D / 32) * (D / 64)), q = r % ((D / 32) * (D / 64)), nb = q / (D / 64), kb = q % (D / 64);
            wt_item(F.in[I_WDN] + ((size_t)layer * NEXP + e) * D * D, D, D, kb * 64, nb * 32, nullptr, wl_ptr(F, layer, WL_DN) + (size_t)e * D * D, nb * 32, scr, F.lane); }
    }
}

__device__ __forceinline__ const float* x_in_row(const Frame& F, int layer, int mb, int r) {
    if (layer == 0) return r < NP ? F.in[I_XP] + ((size_t)mb * NP + r) * D : F.in[I_XS] + (size_t)(r - NP) * D;
    return r < NP ? F.out + O_YP + ((size_t)mb * NP + r) * D : F.out + O_YS + (size_t)(r - NP) * D;
}
__device__ __forceinline__ float* x_out_row(const Frame& F, int mb, int r) { return r < NP ? F.out + O_YP + ((size_t)mb * NP + r) * D : F.out + O_YS + (size_t)(r - NP) * D; }
__device__ __forceinline__ int rows_of(int mb) { return mb == 0 ? R : NP; }

__device__ __forceinline__ void step_xb(const Frame& F, int mb) {
    const int gw = F.bid * NWAVES + F.wave, NGW = F.G * NWAVES, nr = rows_of(mb);
    bf16_t* XB = ws_bf(F, WS_XB0) + (size_t)mb * R * D;
    for (int r = gw; r < nr; r += NGW) {
        const f32x4* xr = (const f32x4*)x_in_row(F, 0, mb, r) + F.lane; u32x2* o = (u32x2*)(XB + (size_t)r * D) + F.lane;
#pragma unroll
        for (int j = 0; j < 4; ++j) { const f32x4 v = xr[64 * j]; u32x2 w; w.x = pk2(v[0], v[1]); w.y = pk2(v[2], v[3]); o[64 * j] = w; }
    }
}

__device__ __forceinline__ float softplus_f(float x) { const float e = fexp(x); return x > 20.f ? x : (e < 0.01f ? e * (1.0f - e * (0.5f - e * 0.33333333f)) : __builtin_amdgcn_logf(1.0f + e) * 0.69314718056f); }
constexpr int S128 = 136, S64 = 72;
constexpr int BL_BM = 0, BL_CM = BL_BM + 64 * S128 * 2, BL_CB = BL_CM + 64 * S128 * 2, BL_END = BL_CB + 64 * S64 * 2;
struct BcRegs { u32x4 raw[7]; f32x4 wq[4][2], bq[2]; };
__device__ __forceinline__ void ssd_bc_load(const Frame& F, int layer, int u, BcRegs& R_) {
    const int sl = (u / NCHUNK) % NSEQ_MB, ck = u % NCHUNK, g = u / (NCHUNK * NSEQ_MB); const int tid = F.tid;
    const bf16_t* H = ws_bf(F, WS_H) + (size_t)sl * SEQ * DINP; const int cgi = tid & 31, rb = tid >> 5; const int xc = (cgi < 16 ? 2048 : 3072) + g * 128 + 8 * (cgi & 15);
#pragma unroll
    for (int i = 0; i < 7; ++i) { const int t = ck * 64 + 4 * rb - 3 + i; R_.raw[i] = t >= 0 ? *(const u32x4*)(H + (size_t)t * DINP + C_X + xc) : (u32x4){0u, 0u, 0u, 0u}; }
    const float* convw = F.in[I_CONVW] + (size_t)layer * 4 * CONVDIM + xc; const float* convb = F.in[I_CONVB] + (size_t)layer * CONVDIM + xc;
#pragma unroll
    for (int tp = 0; tp < 4; ++tp) { R_.wq[tp][0] = *(const f32x4*)(convw + tp * CONVDIM); R_.wq[tp][1] = *(const f32x4*)(convw + tp * CONVDIM + 4); }
    R_.bq[0] = *(const f32x4*)convb; R_.bq[1] = *(const f32x4*)(convb + 4);
}
__device__ __forceinline__ void ssd_bc_unit(const Frame& F, int u, const BcRegs& R_) {
    const int sl = (u / NCHUNK) % NSEQ_MB, ck = u % NCHUNK, g = u / (NCHUNK * NSEQ_MB);
    const int tid = F.tid, lane = F.lane, w = F.wave, fr = lane & 15, fq = lane >> 4;
    LAS bf16_t* Bm = (LAS bf16_t*)(F.lds + BL_BM); LAS bf16_t* Cm = (LAS bf16_t*)(F.lds + BL_CM); LAS bf16_t* CBs = (LAS bf16_t*)(F.lds + BL_CB);
    const size_t rowg = (size_t)sl * SEQ + (size_t)ck * 64; const size_t tix = ((size_t)sl * NCHUNK + ck) * 8 + g;
    const int cgi = tid & 31, rb = tid >> 5; const bool isB = cgi < 16; const int n0 = 8 * (cgi & 15);
    const u32x4 (&raw)[7] = R_.raw; const f32x4 (&wq)[4][2] = R_.wq; const f32x4 (&bq)[2] = R_.bq;
    __syncthreads();
    { float val[4][8];
#pragma unroll
      for (int r = 0; r < 4; ++r) { float a[8] = {bq[0][0], bq[0][1], bq[0][2], bq[0][3], bq[1][0], bq[1][1], bq[1][2], bq[1][3]};
#pragma unroll
          for (int tp = 0; tp < 4; ++tp) { float f[8]; unpack8(raw[r + tp], f);
#pragma unroll
              for (int i = 0; i < 4; ++i) { a[i] += f[i] * wq[tp][0][i]; a[4 + i] += f[4 + i] * wq[tp][1][i]; } }
#pragma unroll
          for (int i = 0; i < 8; ++i) val[r][i] = fsilu(a[i]); }
      if (isB) { bf16_t* bt = ws_bf(F, WS_BTG) + tix * 8192 + (size_t)n0 * 64 + 4 * rb;
#pragma unroll
          for (int r = 0; r < 4; ++r) *(LAS u32x4*)(Bm + (4 * rb + r) * S128 + n0) = pack8(val[r]);
#pragma unroll
          for (int i = 0; i < 8; ++i) { u32x2 wv; wv.x = pk2(val[0][i], val[1][i]); wv.y = pk2(val[2][i], val[3][i]); *(u32x2*)(bt + (size_t)i * 64) = wv; } }
      else { bf16_t* cmc = ws_bf(F, WS_CMC) + (rowg + 4 * rb) * 1024 + g * 128 + n0;
#pragma unroll
          for (int r = 0; r < 4; ++r) { const u32x4 pk = pack8(val[r]); *(LAS u32x4*)(Cm + (4 * rb + r) * S128 + n0) = pk; *(u32x4*)(cmc + (size_t)r * 1024) = pk; } } }
    __syncthreads();
    { const int ti = w >> 1;
#pragma unroll
      for (int jj = 0; jj < 2; ++jj) { const int tj = 2 * (w & 1) + jj; f32x4 cb = (f32x4){0.f, 0.f, 0.f, 0.f};
          if (tj <= ti) {
#pragma unroll
              for (int ks = 0; ks < 4; ++ks) { const bf16x8 a = *(const LAS bf16x8*)(Cm + (16 * ti + fr) * S128 + 32 * ks + 8 * fq); const bf16x8 b = *(const LAS bf16x8*)(Bm + (16 * tj + fr) * S128 + 32 * ks + 8 * fq);
                  cb = __builtin_amdgcn_mfma_f32_16x16x32_bf16(a, b, cb, 0, 0, 0); } }
#pragma unroll
          for (int r = 0; r < 4; ++r) CBs[(16 * ti + 4 * fq + r) * S64 + 16 * tj + fr] = bf1(cb[r]); } }
    __syncthreads();
    { const int row = tid >> 3, cc = tid & 7; *(u32x4*)(ws_bf(F, WS_CBG) + tix * 4096 + row * 64 + 8 * cc) = *(const LAS u32x4*)(CBs + row * S64 + 8 * cc); }
}

constexpr int SL_CM = 0, SL_BT = SL_CM + 64 * S128 * 2, SL_CB = SL_BT + 128 * S64 * 2, SL_DMA_SZ = SL_CB + 64 * S64 * 2, SL_DMA_END = 2 * SL_DMA_SZ;
constexpr int SL_XT = SL_DMA_END, SL_XTW = SL_XT + 2 * 64 * S64 * 2, SL_MM = SL_XTW + 2 * 64 * S64 * 2, SL_SM = SL_MM + 2 * 64 * S64 * 2, SL_END = SL_SM + 3 * 384 * 4;
static_assert(SL_END <= SCR_BYTES && SL_DMA_SZ == 2816 * 16, "ssd LDS map");
#ifdef EMU
#define SSD_DMA_ONE(gp_, dst_) memcpy((unsigned char*)(dst_) + lane * 16, (gp_), 16)
#else
#define SSD_DMA_ONE(gp_, dst_) __builtin_amdgcn_global_load_lds((const unsigned*)(gp_), (LAS unsigned*)(dst_), 16, 0, 0)
#endif
#define SSD_DMA_SETUP() do { _Pragma("unroll") for (int j_ = 0; j_ < 6; ++j_) { const int pc_ = w * 6 + j_; const int q_ = pc_ * 64 + lane; const size_t tx0_ = ((size_t)sl * NCHUNK) * 8 + g; \
        if (pc_ < 17) { const int r_ = q_ / 17; int c_ = q_ % 17; c_ = c_ < 16 ? c_ : 15; dsrc[j_] = cmc + (size_t)r_ * 1024 + 8 * c_; } \
        else if (pc_ < 35) { const int q2_ = q_ - 1088, r_ = q2_ / 9; int c_ = q2_ % 9; c_ = c_ < 8 ? c_ : 7; dsrc[j_] = btg + tx0_ * 8192 + r_ * 64 + 8 * c_; } \
        else { const int q3_ = q_ - 2240, r_ = q3_ / 9; int c_ = q3_ % 9; c_ = c_ < 8 ? c_ : 7; dsrc[j_] = cbg + tx0_ * 4096 + r_ * 64 + 8 * c_; } } } while (0)
#define SSD_DMA2(ca_, cb_) do { _Pragma("unroll") for (int j_ = 0; j_ < 6; ++j_) { const int pc_ = w * 6 + j_; \
        if (pc_ < 35) { if ((ca_) < NCHUNK) { SSD_DMA_ONE(dsrc[j_], L + ((ca_) & 1) * SL_DMA_SZ + SL_CM + pc_ * 1024); dsrc[j_] += pc_ < 17 ? (size_t)64 * 1024 : (size_t)8 * 8192; } } \
        else if (pc_ < 44) { if ((cb_) < NCHUNK) { SSD_DMA_ONE(dsrc[j_], L + ((cb_) & 1) * SL_DMA_SZ + SL_CM + pc_ * 1024); dsrc[j_] += (size_t)8 * 4096; } } } } while (0)
#define SSD_TABLE(tb_, dtr_) do { const float dt_ = softplus_f(bf2f(dtr_) + dtb); \
        const float cs_ = wave_scan_incl(Ah * dt_, lane); \
        const float tot_ = wave_last(cs_); (tb_)[lane] = dt_; (tb_)[64 + lane] = cs_; (tb_)[128 + lane] = fexp(tot_ - cs_); (tb_)[192 + lane] = fexp(cs_); if (lane == 0) (tb_)[256] = fexp(tot_); (tb_)[320 + lane] = Dh * __builtin_amdgcn_rcpf(dt_); } while (0)

__device__ __forceinline__ void ssd_prompt_unit(const Frame& F, int layer, int mb, int sl, int hd) {
    const int tid = F.tid, lane = F.lane, w = F.wave, fr = lane & 15, fq = lane >> 4;
    LAS unsigned char* L = F.lds;
    LAS bf16_t* XT0 = (LAS bf16_t*)(L + SL_XT); LAS bf16_t* XTW0 = (LAS bf16_t*)(L + SL_XTW); LAS bf16_t* Mm0 = (LAS bf16_t*)(L + SL_MM);
    LAS float* smb = (LAS float*)(L + SL_SM);
    const int g = hd >> 2;
    bf16_t* H = ws_bf(F, WS_H) + (size_t)sl * SEQ * DINP;
    const bf16_t* cmc = ws_bf(F, WS_CMC) + (size_t)sl * SEQ * 1024 + g * 128; const bf16_t* btg = ws_bf(F, WS_BTG); const bf16_t* cbg = ws_bf(F, WS_CBG);
    __syncthreads();
    const bf16_t* dsrc[6]; SSD_DMA_SETUP();
    SSD_DMA2(NCHUNK, 0);
    if (w < 4) {
        const int pb = w;
        f32x4 St[8];
#pragma unroll
        for (int t = 0; t < 8; ++t) St[t] = (f32x4){0.f, 0.f, 0.f, 0.f};
        bf16_t* pz = H + (size_t)fr * DINP + C_Z + hd * 64 + 16 * pb + 4 * fq; float* pss = ws_f(F, WS_SSQ) + ((size_t)sl * SEQ + fr) * 128 + hd * 4 + pb;
        u32x2 zraw[4];
        VM_WAIT(0); __syncthreads();
        for (int it = -1; it < NCHUNK; ++it) {
            u32x2 zc[4];
#pragma unroll
            for (int lb = 0; lb < 4; ++lb) zc[lb] = zraw[lb];
            SSD_DMA2(it + 1, it + 2);
            if (it + 1 < NCHUNK) {
#pragma unroll
                for (int lb = 0; lb < 4; ++lb) zraw[lb] = *(const u32x2*)(pz + (size_t)(it >= 0 ? 64 : 0) * DINP + (size_t)lb * 16 * DINP); }
            asm volatile("" ::: "memory");
            if (it >= 0) { const int par = it & 1; LAS float* sm = smb + (it % 3) * 384;
                LAS bf16_t* Cm = (LAS bf16_t*)(L + par * SL_DMA_SZ + SL_CM); LAS bf16_t* BT = (LAS bf16_t*)(L + par * SL_DMA_SZ + SL_BT);
                LAS bf16_t* XT = XT0 + par * 64 * S64; LAS bf16_t* XTW = XTW0 + par * 64 * S64; LAS bf16_t* Mm = Mm0 + par * 64 * S64;
                bf16x8 sa[4];
#pragma unroll
                for (int ks = 0; ks < 4; ++ks) { u32x4 wv; wv.x = pk2(St[2 * ks][0], St[2 * ks][1]); wv.y = pk2(St[2 * ks][2], St[2 * ks][3]); wv.z = pk2(St[2 * ks + 1][0], St[2 * ks + 1][1]); wv.w = pk2(St[2 * ks + 1][2], St[2 * ks + 1][3]);
                    sa[ks] = __builtin_bit_cast(bf16x8, wv); }
                f32x4 yo[4];
#pragma unroll
                for (int lb = 0; lb < 4; ++lb) yo[lb] = (f32x4){0.f, 0.f, 0.f, 0.f};
#pragma unroll
                for (int ks = 0; ks < 4; ++ks)
#pragma unroll
                    for (int lb = 0; lb < 4; ++lb) { const LAS bf16_t* cp = Cm + (16 * lb + fr) * S128 + 32 * ks + 4 * fq; const u32x2 c0 = *(const LAS u32x2*)cp, c1 = *(const LAS u32x2*)(cp + 16);
                        u32x4 cw; cw.x = c0.x; cw.y = c0.y; cw.z = c1.x; cw.w = c1.y; yo[lb] = __builtin_amdgcn_mfma_f32_16x16x32_bf16(sa[ks], __builtin_bit_cast(bf16x8, cw), yo[lb], 0, 0, 0); }
                { const float cd = sm[256]; bf16x8 bx[2];
#pragma unroll
                  for (int ks = 0; ks < 2; ++ks) bx[ks] = *(const LAS bf16x8*)(XTW + (16 * pb + fr) * S64 + 32 * ks + 8 * fq);
#pragma unroll
                  for (int t = 0; t < 8; ++t) St[t] = St[t] * cd;
#pragma unroll
                  for (int ks = 0; ks < 2; ++ks)
#pragma unroll
                    for (int t = 0; t < 8; ++t) { const bf16x8 a = *(const LAS bf16x8*)(BT + (16 * t + fr) * S64 + 32 * ks + 8 * fq); St[t] = __builtin_amdgcn_mfma_f32_16x16x32_bf16(a, bx[ks], St[t], 0, 0, 0); } }
                { bf16x8 xa[2];
#pragma unroll
                  for (int ks = 0; ks < 2; ++ks) xa[ks] = *(const LAS bf16x8*)(XT + (16 * pb + fr) * S64 + 32 * ks + 8 * fq);
                  f32x4 ydv[4];
#pragma unroll
                  for (int lb = 0; lb < 4; ++lb) ydv[lb] = (f32x4){0.f, 0.f, 0.f, 0.f};
#pragma unroll
                  for (int ks = 0; ks < 2; ++ks)
#pragma unroll
                    for (int lb = 0; lb < 4; ++lb) { const bf16x8 b = *(const LAS bf16x8*)(Mm + (16 * lb + fr) * S64 + 32 * ks + 8 * fq); ydv[lb] = __builtin_amdgcn_mfma_f32_16x16x32_bf16(xa[ks], b, ydv[lb], 0, 0, 0); }
#pragma unroll
                  for (int lb = 0; lb < 4; ++lb) { const f32x4 yd = ydv[lb];
                    const float ec = sm[192 + 16 * lb + fr]; const float z[4] = {blo(zc[lb].x), bhi(zc[lb].x), blo(zc[lb].y), bhi(zc[lb].y)}; float v[4], ss = 0.f;
#pragma unroll
                    for (int r = 0; r < 4; ++r) { v[r] = (yd[r] + ec * yo[lb][r]) * fsilu(z[r]); ss += v[r] * v[r]; }
                    u32x2 ov; ov.x = pk2(v[0], v[1]); ov.y = pk2(v[2], v[3]); *(u32x2*)(pz + (size_t)lb * 16 * DINP) = ov;
                    ss += xshfl<16>(ss); ss += xshfl<32>(ss);
                    if (fq == 0) pss[(size_t)lb * 16 * 128] = ss; } }
                pz += (size_t)64 * DINP; pss += 64 * 128; }
            if (it < 0) VM_WAIT(0); else VM_WAIT(7);
            LBAR();
        }
        float* so = F.out + O_SSP + ((((size_t)layer * BATCH + mb * NSEQ_MB + sl) * 32 + hd) * 64) * 128;
#pragma unroll
        for (int t = 0; t < 8; ++t) *(f32x4*)(so + (size_t)(16 * pb + fr) * 128 + 16 * t + 4 * fq) = St[t];
    } else {
        const int pw = w - 4, pt = tid - 256;
        const float* convw = F.in[I_CONVW] + (size_t)layer * 4 * CONVDIM + hd * 64; const float* convb = F.in[I_CONVB] + (size_t)layer * CONVDIM + hd * 64;
        const float cw0 = convw[lane], cw1 = convw[CONVDIM + lane], cw2 = convw[2 * CONVDIM + lane], cw3 = convw[3 * CONVDIM + lane], cwb = convb[lane];
        const float dtb = F.in[I_DTB][layer * 32 + hd], Ah = -fexp(F.in[I_ALOG][layer * 32 + hd]), Dh = F.in[I_SD][layer * 32 + hd];
        const int ml = pt >> 2, ms0 = 16 * (pt & 3);
        unsigned rawx[19]; unsigned dtr_next = 0u;
#pragma unroll
        for (int i = 0; i < 19; ++i) { const int t_ = 16 * pw - 3 + i; rawx[i] = t_ >= 0 ? (unsigned)H[(size_t)t_ * DINP + C_X + hd * 64 + lane] : 0u; }
        if (pw == 3) { const unsigned d0 = H[(size_t)lane * DINP + C_DT + hd]; if (NCHUNK > 1) dtr_next = H[(size_t)(64 + lane) * DINP + C_DT + hd]; SSD_TABLE(smb, d0); }
        VM_WAIT(0); __syncthreads();
        for (int it = -1; it < NCHUNK; ++it) { const int pc = it + 1;
            SSD_DMA2(it + 1, it + 2);
            const unsigned dtr_cur = dtr_next;
            if (pc < NCHUNK) { const int par = pc & 1; LAS float* sm = smb + (pc % 3) * 384; const LAS bf16_t* CBl = (const LAS bf16_t*)(L + par * SL_DMA_SZ + SL_CB);
                LAS bf16_t* XT = XT0 + par * 64 * S64; LAS bf16_t* XTW = XTW0 + par * 64 * S64; LAS bf16_t* Mm = Mm0 + par * 64 * S64;
                { float xr[19];
#pragma unroll
                  for (int i = 0; i < 19; ++i) xr[i] = blo(rawx[i]);
                  if (pc + 1 < NCHUNK) { const bf16_t* px_ = H + ((size_t)(pc + 1) * 64 + 16 * pw - 3) * DINP + C_X + hd * 64 + lane;
#pragma unroll
                      for (int i = 0; i < 19; ++i) rawx[i] = (unsigned)px_[(size_t)i * DINP]; }
                  if (pw == 3 && pc + 2 < NCHUNK) dtr_next = H[((size_t)(pc + 2) * 64 + lane) * DINP + C_DT + hd];
                  asm volatile("" ::: "memory");
#pragma unroll
                  for (int hq = 0; hq < 2; ++hq) { const f32x4 d0 = *(const LAS f32x4*)(sm + 16 * pw + 8 * hq), d1 = *(const LAS f32x4*)(sm + 16 * pw + 8 * hq + 4), e0 = *(const LAS f32x4*)(sm + 128 + 16 * pw + 8 * hq), e1 = *(const LAS f32x4*)(sm + 128 + 16 * pw + 8 * hq + 4);
                      const float dtv[8] = {d0[0], d0[1], d0[2], d0[3], d1[0], d1[1], d1[2], d1[3]}, wdv[8] = {e0[0], e0[1], e0[2], e0[3], e1[0], e1[1], e1[2], e1[3]}; float xa[8], xb[8];
#pragma unroll
                      for (int r = 0; r < 8; ++r) { const int q = 8 * hq + r; const float xd = fsilu(cwb + xr[q] * cw0 + xr[q + 1] * cw1 + xr[q + 2] * cw2 + xr[q + 3] * cw3) * dtv[r]; xa[r] = xd; xb[r] = xd * wdv[r]; }
                      *(LAS u32x4*)(XT + lane * S64 + 16 * pw + 8 * hq) = pack8(xa); *(LAS u32x4*)(XTW + lane * S64 + 16 * pw + 8 * hq) = pack8(xb); } }
#pragma unroll
                for (int hq = 0; hq < 2; ++hq) { const int s0 = ms0 + 8 * hq; float mv[8];
                    if (s0 <= ml) { float cbv[8]; unpack8(*(const LAS u32x4*)(CBl + ml * S64 + s0), cbv); const float al = sm[64 + ml]; const f32x4 a0 = *(const LAS f32x4*)(sm + 64 + s0), a1 = *(const LAS f32x4*)(sm + 64 + s0 + 4);
#pragma unroll
                        for (int i = 0; i < 4; ++i) { mv[i] = (ml >= s0 + i) ? cbv[i] * fexp(fminf(al - a0[i], 0.f)) : 0.f; mv[4 + i] = (ml >= s0 + 4 + i) ? cbv[4 + i] * fexp(fminf(al - a1[i], 0.f)) : 0.f; }
                        if ((ml >> 3) == (s0 >> 3)) { const float dd = sm[320 + ml];
#pragma unroll
                            for (int i = 0; i < 8; ++i) if (i == (ml & 7)) mv[i] += dd; } }
                    else {
#pragma unroll
                        for (int i = 0; i < 8; ++i) mv[i] = 0.f; }
                    *(LAS u32x4*)(Mm + ml * S64 + s0) = pack8(mv); } }
            if (pw == 3 && it + 2 < NCHUNK) { LAS float* smn = smb + ((it + 2) % 3) * 384; SSD_TABLE(smn, dtr_cur); }
            VM_WAIT(0);
            LBAR();
        }
    }
    VM_WAIT(0); __syncthreads();
}

__device__ __forceinline__ void ssd_sample_unit(const Frame& F, int layer, int sq, int hd) {
    const int tid = F.tid, lane = F.lane; LAS float* L = (LAS float*)F.lds;
    LAS float* xs = L; LAS float* Bs = L + 16 * 64; LAS float* Cs = Bs + 16 * 128; LAS float* dts = Cs + 16 * 128; LAS float* das = dts + 16; LAS float* Yl = das + 16;
    const int g = hd >> 2;
    bf16_t* H = ws_bf(F, WS_H) + (size_t)(NP + sq * 16) * DINP;
    const float* hist = F.in[I_SCV] + ((size_t)layer * DECB + sq) * 3 * CONVDIM;
    const float* convw = F.in[I_CONVW] + (size_t)layer * 4 * CONVDIM; const float* convb = F.in[I_CONVB] + (size_t)layer * CONVDIM;
    __syncthreads();
    if (tid < 320) { const int c = tid; const int xc = c < 64 ? hd * 64 + c : (c < 192 ? 2048 + g * 128 + (c - 64) : 3072 + g * 128 + (c - 192));
        float win[19];
#pragma unroll
        for (int i = 0; i < 3; ++i) win[i] = hist[i * CONVDIM + xc];
#pragma unroll
        for (int t = 0; t < 16; ++t) win[3 + t] = bf2f(H[(size_t)t * DINP + C_X + xc]);
        const float w0 = convw[xc], w1 = convw[CONVDIM + xc], w2 = convw[2 * CONVDIM + xc], w3 = convw[3 * CONVDIM + xc], bb = convb[xc];
#pragma unroll
        for (int t = 0; t < 16; ++t) { const float a = fsilu(bb + win[t] * w0 + win[t + 1] * w1 + win[t + 2] * w2 + win[t + 3] * w3);
            if (c < 64) xs[t * 64 + c] = a; else if (c < 192) Bs[t * 128 + c - 64] = a; else Cs[t * 128 + c - 192] = a; } }
    if (tid < 16) { const float dt = softplus_f(bf2f(H[(size_t)tid * DINP + C_DT + hd]) + F.in[I_DTB][layer * 32 + hd]); dts[tid] = dt; das[tid] = fexp(-fexp(F.in[I_ALOG][layer * 32 + hd]) * dt); }
    __syncthreads();
    const int p = tid >> 3, n0 = (tid & 7) * 16;
    const size_t sbase = ((((size_t)layer * DECB + sq) * 32 + hd) * 64 + p) * 128 + n0;
    float S[16];
#pragma unroll
    for (int i = 0; i < 16; ++i) S[i] = F.in[I_SST][sbase + i];
    for (int t = 0; t < 16; ++t) { const float dec = das[t], xv = xs[t * 64 + p] * dts[t]; float part = 0.f;
#pragma unroll
        for (int i = 0; i < 16; ++i) { S[i] = S[i] * dec + xv * Bs[t * 128 + n0 + i]; part += Cs[t * 128 + n0 + i] * S[i]; }
        part += __shfl_xor(part, 1); part += __shfl_xor(part, 2); part += __shfl_xor(part, 4);
        if ((tid & 7) == 0) Yl[t * 64 + p] = part; }
#pragma unroll
    for (int i = 0; i < 16; ++i) F.out[O_SSS + sbase + i] = S[i];
    __syncthreads();
    const float Dh = F.in[I_SD][layer * 32 + hd];
#pragma unroll
    for (int j = 0; j < 2; ++j) { const int it = tid + 512 * j, t = it >> 6, pp = it & 63;
        const float z = bf2f(H[(size_t)t * DINP + C_Z + hd * 64 + pp]); const float v = (Yl[t * 64 + pp] + Dh * xs[t * 64 + pp]) * fsilu(z);
        H[(size_t)t * DINP + C_Z + hd * 64 + pp] = bf1(v);
        const float ss = wave_sum(v * v);
        if (lane < 4) ws_f(F, WS_SSQ)[((size_t)NP + sq * 16 + t) * 128 + hd * 4 + lane] = lane == 0 ? ss : 0.f; }
}

__device__ __forceinline__ int t5_bucket(int rel) {
    const int n = rel < 0 ? -rel : rel; const int b = rel > 0 ? 16 : 0;
    if (n < 8) return b + n;
    int v = 8; v += n >= 12; v += n >= 16; v += n >= 23; v += n >= 32; v += n >= 46; v += n >= 64; v += n >= 91;
    return b + v;
}
constexpr int AK_P = 72, AV_P = 200;
constexpr int AL_K = 0, AL_VT = AL_K + 192 * AK_P * 2, AL_LUT = AL_VT + 64 * AV_P * 2, AL_END = AL_LUT + 4 * 256 * 4;
static_assert(AL_END <= RING_BYTES, "attention LDS map");
__device__ __forceinline__ void attn_prompt_unit(const Frame& F, int layer, int sl, int ck, int kh) {
    const int tid = F.tid, lane = F.lane, w = F.wave, q32 = lane & 31, hi = lane >> 5;
    LAS bf16_t* Kl = (LAS bf16_t*)(F.lds + AL_K); LAS bf16_t* VT = (LAS bf16_t*)(F.lds + AL_VT); LAS float* lut = (LAS float*)(F.lds + AL_LUT);
    bf16_t* H = ws_bf(F, WS_H) + (size_t)sl * SEQ * DINP;
    const int gq = w >> 1, qh = w & 1, head = kh * 4 + gq;
    const size_t qrow = (size_t)ck * 64 + 32 * qh + q32;
    bf16x8 qf[4];
#pragma unroll
    for (int ds = 0; ds < 4; ++ds) qf[ds] = *(const bf16x8*)(H + qrow * DINP + C_Q + head * 64 + 16 * ds + 8 * hi);
    __syncthreads();
#pragma unroll
    for (int j = 0; j < 3; ++j) { const int id = tid + 512 * j, key = id >> 3, cg = id & 7; const int t = 64 * (ck - 2) + key;
        u32x4 kv = (u32x4){0u, 0u, 0u, 0u}, vv = kv;
        if (t >= 0) { kv = *(const u32x4*)(H + (size_t)t * DINP + C_K + kh * 64 + 8 * cg); vv = *(const u32x4*)(H + (size_t)t * DINP + C_V + kh * 64 + 8 * cg); }
        *(LAS u32x4*)(Kl + key * AK_P + 8 * cg) = kv;
        VT[(8 * cg + 0) * AV_P + key] = (bf16_t)(vv.x & 0xffffu); VT[(8 * cg + 1) * AV_P + key] = (bf16_t)(vv.x >> 16); VT[(8 * cg + 2) * AV_P + key] = (bf16_t)(vv.y & 0xffffu); VT[(8 * cg + 3) * AV_P + key] = (bf16_t)(vv.y >> 16);
        VT[(8 * cg + 4) * AV_P + key] = (bf16_t)(vv.z & 0xffffu); VT[(8 * cg + 5) * AV_P + key] = (bf16_t)(vv.z >> 16); VT[(8 * cg + 6) * AV_P + key] = (bf16_t)(vv.w & 0xffffu); VT[(8 * cg + 7) * AV_P + key] = (bf16_t)(vv.w >> 16); }
    for (int e = tid; e < 4 * 255; e += NTHREADS) { const int gg = e / 255, idx = e % 255; lut[gg * 256 + idx] = F.in[I_RELB][t5_bucket(idx - 191) * 16 + kh * 4 + gg]; }
    __syncthreads();
    f32x16 sc[6];
#pragma unroll
    for (int kt = 0; kt < 6; ++kt) {
#pragma unroll
        for (int r = 0; r < 16; ++r) sc[kt][r] = 0.f;
#pragma unroll
        for (int ds = 0; ds < 4; ++ds) { const bf16x8 a = *(const LAS bf16x8*)(Kl + (32 * kt + q32) * AK_P + 16 * ds + 8 * hi); sc[kt] = __builtin_amdgcn_mfma_f32_32x32x16_bf16(a, qf[ds], sc[kt], 0, 0, 0); } }
    const int qidx = 32 * qh + q32; const float sink = F.in[I_SINK][layer * 16 + head];
    float mx = -3.0e38f;
#pragma unroll
    for (int kt = 0; kt < 6; ++kt)
#pragma unroll
        for (int r = 0; r < 16; ++r) { const int key = 32 * kt + (r & 3) + 8 * (r >> 2) + 4 * hi; const int rel = key - 128 - qidx;
            float s = sc[kt][r] * 0.125f + lut[gq * 256 + rel + 191]; if (ck < 2 && 64 * ck + key - 128 < 0) s = -1e30f; sc[kt][r] = s; mx = fmaxf(mx, s); }
    mx = fmaxf(mx, __shfl_xor(mx, 32)); mx = fmaxf(mx, sink);
    float sum = 0.f;
#pragma unroll
    for (int kt = 0; kt < 6; ++kt)
#pragma unroll
        for (int r = 0; r < 16; ++r) { const float e = fexp(sc[kt][r] - mx); sc[kt][r] = e; sum += e; }
    sum += __shfl_xor(sum, 32);
    const float inv = 1.0f / (sum + fexp(sink - mx));
    f32x16 o[2];
#pragma unroll
    for (int d2 = 0; d2 < 2; ++d2)
#pragma unroll
        for (int r = 0; r < 16; ++r) o[d2][r] = 0.f;
#pragma unroll
    for (int kt = 0; kt < 6; ++kt)
#pragma unroll
        for (int s = 0; s < 2; ++s) {
            u32x4 pw; pw.x = pk2(sc[kt][8 * s + 0], sc[kt][8 * s + 1]); pw.y = pk2(sc[kt][8 * s + 2], sc[kt][8 * s + 3]); pw.z = pk2(sc[kt][8 * s + 4], sc[kt][8 * s + 5]); pw.w = pk2(sc[kt][8 * s + 6], sc[kt][8 * s + 7]);
            const bf16x8 pa = __builtin_bit_cast(bf16x8, pw);
#pragma unroll
            for (int d2 = 0; d2 < 2; ++d2) { const LAS bf16_t* vp = VT + (32 * d2 + q32) * AV_P + 32 * kt + 16 * s + 4 * hi;
                const u32x2 lo = *(const LAS u32x2*)vp, hh = *(const LAS u32x2*)(vp + 8); u32x4 vw; vw.x = lo.x; vw.y = lo.y; vw.z = hh.x; vw.w = hh.y;
                o[d2] = __builtin_amdgcn_mfma_f32_32x32x16_bf16(pa, __builtin_bit_cast(bf16x8, vw), o[d2], 0, 0, 0); } }
#pragma unroll
    for (int r = 0; r < 16; ++r) { const int q = (r & 3) + 8 * (r >> 2) + 4 * hi; const float iv = __shfl(inv, q);
        bf16_t* op = H + ((size_t)ck * 64 + 32 * qh + q) * DINP + C_Q + head * 64 + q32;
        op[0] = bf1(o[0][r] * iv); op[32] = bf1(o[1][r] * iv); }
}
__device__ __forceinline__ void attn_sample_unit(const Frame& F, int layer, int sq, int kh) {
    const int tid = F.tid; LAS float* L = (LAS float*)F.lds;
    LAS float* Kf = L; LAS float* Vf = Kf + 144 * 65; LAS float* Qf = Vf + 144 * 64; LAS float* P = Qf + 64 * 65; LAS float* Pinv = P + 64 * 145;
    static_assert((144 * 65 + 144 * 64 + 64 * 65 + 64 * 145 + 64) * 4 <= RING_BYTES, "sample attention LDS map");
    bf16_t* H = ws_bf(F, WS_H) + (size_t)(NP + sq * 16) * DINP;
    const float* ck = F.in[I_CK] + ((size_t)layer * DECB + sq) * WINDOW * 256; const float* cv = F.in[I_CV] + ((size_t)layer * DECB + sq) * WINDOW * 256;
    __syncthreads();
    for (int i = tid; i < 144 * 64; i += NTHREADS) { const int key = i >> 6, d = i & 63;
        Kf[key * 65 + d] = key < 128 ? ck[(size_t)key * 256 + kh * 64 + d] : bf2f(H[(size_t)(key - 128) * DINP + C_K + kh * 64 + d]);
        Vf[key * 64 + d] = key < 128 ? cv[(size_t)key * 256 + kh * 64 + d] : bf2f(H[(size_t)(key - 128) * DINP + C_V + kh * 64 + d]); }
    for (int i = tid; i < 64 * 64; i += NTHREADS) { const int row = i >> 6, d = i & 63; Qf[row * 65 + d] = bf2f(H[(size_t)(row & 15) * DINP + C_Q + (kh * 4 + (row >> 4)) * 64 + d]); }
    __syncthreads();
    for (int i = tid; i < 64 * 144; i += NTHREADS) { const int row = i / 144, key = i % 144; float s = 0.f;
        for (int d = 0; d < 64; ++d) s += Qf[row * 65 + d] * Kf[key * 65 + d];
        P[row * 145 + key] = s * 0.125f + F.in[I_RELB][t5_bucket(key - 128 - (row & 15)) * 16 + kh * 4 + (row >> 4)]; }
    __syncthreads();
    { const int row = tid >> 3, sub = tid & 7; const float sink = F.in[I_SINK][layer * 16 + kh * 4 + (row >> 4)]; float mx = -3.0e38f;
      for (int k = sub; k < 144; k += 8) mx = fmaxf(mx, P[row * 145 + k]);
      mx = fmaxf(mx, __shfl_xor(mx, 1)); mx = fmaxf(mx, __shfl_xor(mx, 2)); mx = fmaxf(mx, __shfl_xor(mx, 4)); mx = fmaxf(mx, sink);
      float sum = 0.f;
      for (int k = sub; k < 144; k += 8) { const float e = fexp(P[row * 145 + k] - mx); P[row * 145 + k] = e; sum += e; }
      sum += __shfl_xor(sum, 1); sum += __shfl_xor(sum, 2); sum += __shfl_xor(sum, 4);
      if (sub == 0) Pinv[row] = 1.0f / (sum + fexp(sink - mx)); }
    __syncthreads();
    { const int row = tid >> 3, d0 = (tid & 7) * 8; float o[8] = {0.f, 0.f, 0.f, 0.f, 0.f, 0.f, 0.f, 0.f};
      for (int k = 0; k < 144; ++k) { const float pv = P[row * 145 + k];
#pragma unroll
          for (int i = 0; i < 8; ++i) o[i] += pv * Vf[k * 64 + d0 + i]; }
      const float iv = Pinv[row];
#pragma unroll
      for (int i = 0; i < 8; ++i) o[i] *= iv;
      *(u32x4*)(H + (size_t)(row & 15) * DINP + C_Q + (kh * 4 + (row >> 4)) * 64 + d0) = pack8(o); }
}
__device__ __forceinline__ void sc_unit(const Frame& F, int layer, int tile) {
    const int tid = F.tid, cg = tid & 127, rs = tid >> 7; bf16_t* H = ws_bf(F, WS_H);
    const float* wsc = F.in[I_SCW] + (size_t)layer * 3 * D + 8 * cg; float wt[3][8];
#pragma unroll
    for (int i = 0; i < 3; ++i)
#pragma unroll
        for (int c = 0; c < 8; ++c) wt[i][c] = wsc[i * D + c];
    const int row0 = tile * 64 + 16 * rs; const bool smp = row0 >= NP; const int tt0 = smp ? 0 : row0 % SEQ;
    float u1[8], u2[8];
    if (tt0 >= 2) { float c8[8], h8[8];
        unpack8(*(const u32x4*)(H + (size_t)(row0 - 2) * DINP + C_SCC + 8 * cg), c8); unpack8(*(const u32x4*)(H + (size_t)(row0 - 2) * DINP + C_SCH + 8 * cg), h8);
#pragma unroll
        for (int c = 0; c < 8; ++c) u2[c] = c8[c] * h8[c];
        unpack8(*(const u32x4*)(H + (size_t)(row0 - 1) * DINP + C_SCC + 8 * cg), c8); unpack8(*(const u32x4*)(H + (size_t)(row0 - 1) * DINP + C_SCH + 8 * cg), h8);
#pragma unroll
        for (int c = 0; c < 8; ++c) u1[c] = c8[c] * h8[c]; }
    else if (smp) { const float* hp = F.in[I_SSC] + (((size_t)layer * DECB + ((row0 - NP) >> 4)) * 2) * D + 8 * cg;
#pragma unroll
        for (int c = 0; c < 8; ++c) { u2[c] = hp[c]; u1[c] = hp[D + c]; } }
    else {
#pragma unroll
        for (int c = 0; c < 8; ++c) { u2[c] = 0.f; u1[c] = 0.f; } }
#pragma unroll 1
    for (int q = 0; q < 4; ++q) {
        u32x4 cw_[4], hw_[4], bw_[4];
#pragma unroll
        for (int i = 0; i < 4; ++i) { const bf16_t* hp = H + (size_t)(row0 + 4 * q + i) * DINP + 8 * cg; cw_[i] = *(const u32x4*)(hp + C_SCC); hw_[i] = *(const u32x4*)(hp + C_SCH); bw_[i] = *(const u32x4*)(hp + C_SCB); }
        asm volatile("" ::: "memory");
#pragma unroll
        for (int i = 0; i < 4; ++i) { float c8[8], h8[8], b8[8], a[8]; unpack8(cw_[i], c8); unpack8(hw_[i], h8); unpack8(bw_[i], b8);
#pragma unroll
            for (int c = 0; c < 8; ++c) { const float u0 = c8[c] * h8[c]; a[c] = (u2[c] * wt[0][c] + u1[c] * wt[1][c] + u0 * wt[2][c]) * b8[c]; u2[c] = u1[c]; u1[c] = u0; }
            *(u32x4*)(H + (size_t)(row0 + 4 * q + i) * DINP + C_SCB + 8 * cg) = pack8(a); }
    }
}
__device__ __forceinline__ void state_out_unit(const Frame& F, int layer, int mb, int sl, bool smp) {
    const int tid = F.tid; const bf16_t* H = ws_bf(F, WS_H);
    const int nkv = smp ? DECS : WINDOW, len = smp ? DECS : SEQ; const size_t row0 = smp ? (size_t)NP + sl * 16 : (size_t)sl * SEQ; const int sg = smp ? sl : mb * NSEQ_MB + sl;
    const size_t nb_ = smp ? DECB : BATCH;
    float* ko = F.out + (smp ? O_KS : O_KP) + ((size_t)layer * nb_ + sg) * nkv * 256; float* vo = F.out + (smp ? O_VS : O_VP) + ((size_t)layer * nb_ + sg) * nkv * 256;
    for (int i = tid; i < nkv * 32; i += NTHREADS) { const int j = i >> 5, c8 = (i & 31) * 8; const bf16_t* hp = H + (row0 + len - nkv + j) * DINP; float f[8];
        unpack8(*(const u32x4*)(hp + C_K + c8), f); *(f32x4*)(ko + (size_t)j * 256 + c8) = (f32x4){f[0], f[1], f[2], f[3]}; *(f32x4*)(ko + (size_t)j * 256 + c8 + 4) = (f32x4){f[4], f[5], f[6], f[7]};
        unpack8(*(const u32x4*)(hp + C_V + c8), f); *(f32x4*)(vo + (size_t)j * 256 + c8) = (f32x4){f[0], f[1], f[2], f[3]}; *(f32x4*)(vo + (size_t)j * 256 + c8 + 4) = (f32x4){f[4], f[5], f[6], f[7]}; }
    float* co = F.out + (smp ? O_CVS : O_CVP) + ((size_t)layer * nb_ + sg) * 3 * CONVDIM;
    for (int i = tid; i < 3 * 512; i += NTHREADS) { const int j = i / 512, c8 = (i % 512) * 8; float f[8]; unpack8(*(const u32x4*)(H + (row0 + len - 3 + j) * DINP + C_X + c8), f);
        *(f32x4*)(co + (size_t)j * CONVDIM + c8) = (f32x4){f[0], f[1], f[2], f[3]}; *(f32x4*)(co + (size_t)j * CONVDIM + c8 + 4) = (f32x4){f[4], f[5], f[6], f[7]}; }
    float* so = F.out + (smp ? O_SCS : O_SCP) + ((size_t)layer * nb_ + sg) * 2 * D;
    for (int i = tid; i < 2 * 128; i += NTHREADS) { const int j = i >> 7, c8 = (i & 127) * 8; float c[8], h[8]; const bf16_t* hp = H + (row0 + len - 2 + j) * DINP;
        unpack8(*(const u32x4*)(hp + C_SCC + c8), c); unpack8(*(const u32x4*)(hp + C_SCH + c8), h);
        *(f32x4*)(so + (size_t)j * D + c8) = (f32x4){c[0] * h[0], c[1] * h[1], c[2] * h[2], c[3] * h[3]}; *(f32x4*)(so + (size_t)j * D + c8 + 4) = (f32x4){c[4] * h[4], c[5] * h[5], c[6] * h[6], c[7] * h[7]}; }
}
#ifndef MIX_MASK
#define MIX_MASK 0xFF
#endif
#define MIXON(b) ((MIX_MASK >> (b)) & 1)
__device__ __forceinline__ void step_premix(const Frame& F, int layer, int mb) {
    const int n_bc = NSEQ_MB * NCHUNK * 8, n_att = NSEQ_MB * NCHUNK * NKV, n_sc = rows_of(mb) / 64, n_so = NSEQ_MB + (mb == 0 ? DECB : 0);
    const int n_ss = mb == 0 ? DECB * 32 : 0, n_as = mb == 0 ? DECB * NKV : 0;
    const int total = n_bc + n_att + n_sc + n_so + n_ss + n_as;
#define UF(Fu) Frame Fu = F; Fu.lane = opq(lane_id()); Fu.tid = Fu.wave * 64 + Fu.lane
    PROBE_T0(14) if constexpr (MIXON(0)) { UF(Fu); BcRegs ra, rn_;
        if (F.bid < n_bc) ssd_bc_load(Fu, layer, F.bid, ra);
        for (int u = F.bid; u < n_bc; u += F.G) { const bool more = u + F.G < n_bc; if (more) ssd_bc_load(Fu, layer, u + F.G, rn_);
            ssd_bc_unit(Fu, u, ra);
            if (more) ra = rn_; } }
    PROBE_T1(14)
    for (int un = F.bid; un < total; un += F.G) { int r = un;
        if (r < n_bc) continue;
        r -= n_bc;
        if (r < n_att) { PROBE_T0(15) if constexpr (MIXON(1)) { UF(Fu);
                const int ra = (n_att % 8 == 0 && F.G % 8 == 0 && n_bc % F.G == 0) ? (r & 7) * (n_att >> 3) + (r >> 3) : r;
                attn_prompt_unit(Fu, layer, ra / (NCHUNK * NKV), (ra / NKV) % NCHUNK, ra % NKV); } PROBE_T1(15) continue; } r -= n_att;
        if (r < n_sc) { PROBE_T0(16) if constexpr (MIXON(2)) { UF(Fu); sc_unit(Fu, layer, r); } PROBE_T1(16) continue; } r -= n_sc;
        if (r < n_so) { PROBE_T0(17) if constexpr (MIXON(3)) { UF(Fu); state_out_unit(Fu, layer, mb, r < NSEQ_MB ? r : r - NSEQ_MB, r >= NSEQ_MB); } PROBE_T1(17) continue; } r -= n_so;
        if (r < n_ss) { PROBE_T0(18) if constexpr (MIXON(4)) { UF(Fu); ssd_sample_unit(Fu, layer, r >> 5, r & 31); } PROBE_T1(18) continue; } r -= n_ss;
        { PROBE_T0(19) if constexpr (MIXON(5)) { UF(Fu); attn_sample_unit(Fu, layer, r >> 2, r & 3); } PROBE_T1(19) }
    }
}
__device__ __forceinline__ void step_mixers(const Frame& F, int layer, int mb) {
    for (int v = F.bid; v < NSEQ_MB * 32; v += F.G) { const int un = (NSEQ_MB == 8 && F.G == 256) ? (v & 7) * 32 + (v >> 3) : v; UF(Fu); ssd_prompt_unit(Fu, layer, mb, un >> 5, un & 31); }
}
__device__ __forceinline__ void step_gnorm(const Frame& F, int mb) {
    const int gw = F.bid * NWAVES + F.wave, NGW = F.G * NWAVES, nr = rows_of(mb); bf16_t* H = ws_bf(F, WS_H); const float* ssq = ws_f(F, WS_SSQ);
    constexpr int RB = 4; const int g = F.lane >> 3;
    for (int r0 = gw; r0 < nr; r0 += RB * NGW) {
        u32x4 d[RB][4]; f32x4 q[RB];
#pragma unroll
        for (int i = 0; i < RB; ++i) { const int r = r0 + i * NGW < nr ? r0 + i * NGW : r0; { const f32x4 qa = *(const f32x4*)(ssq + (size_t)r * 64 + 8 * g), qb = *(const f32x4*)(ssq + (size_t)r * 64 + 8 * g + 4); q[i] = qa + qb; } const u32x4* p = (const u32x4*)(H + (size_t)r * DINP + C_Z + 32 * F.lane);
#pragma unroll
            for (int j = 0; j < 4; ++j) d[i][j] = p[j]; }
        asm volatile("" ::: "memory");
#pragma unroll
        for (int i = 0; i < RB; ++i) { const int r = r0 + i * NGW; if (r >= nr) continue;
            const float rstd = 1.0f / sqrtf(((q[i][0] + q[i][1]) + (q[i][2] + q[i][3])) * (1.0f / 256.0f) + LN_EPS); u32x4* p = (u32x4*)(H + (size_t)r * DINP + C_Z + 32 * F.lane);
#pragma unroll
            for (int j = 0; j < 4; ++j) { float f[8]; unpack8(d[i][j], f);
#pragma unroll
                for (int k = 0; k < 8; ++k) f[k] *= rstd;
                p[j] = pack8(f); } }
    }
}
constexpr int LOG_NEXP = NEXP == 32 ? 5 : (NEXP == 16 ? 4 : (NEXP == 8 ? 3 : 2));
template <int N, int MASK> struct RedStep {
    static __device__ __forceinline__ void run(float* v, int lane) {
        constexpr int Hn = N / 2; const bool up = (lane & MASK) != 0;
#pragma unroll
        for (int i = 0; i < Hn; ++i) { const float keep = up ? v[i + Hn] : v[i], send = up ? v[i] : v[i + Hn]; v[i] = keep + xshfl<MASK>(send); }
        if constexpr (Hn > 1) RedStep<Hn, (MASK >> 1)>::run(v, lane);
    }
};
constexpr int RW_P = D + 8;
__device__ __forceinline__ void step_ln1_router_mfma(const Frame& F, int layer, int mb) {
    LAS bf16_t* WH = (LAS bf16_t*)F.lds; LAS bf16_t* WL = WH + NTE * 16 * RW_P; LAS float* GB = (LAS float*)(WL + NTE * 16 * RW_P);
    static_assert((size_t)2 * NTE * 16 * RW_P * 2 + 2 * D * 4 <= (size_t)SCR_BYTES, "router LDS map");
    const int lane = F.lane, fr = lane & 15, fq = lane >> 4;
    __syncthreads();
    { const bf16_t* rwh = ws_bf(F, WS_RWH) + (size_t)layer * NTE * 16 * D; const bf16_t* rwl = ws_bf(F, WS_RWL) + (size_t)layer * NTE * 16 * D;
      for (int i = F.tid; i < NTE * 16 * (D / 8); i += NTHREADS) { const int e = i / (D / 8), c = i % (D / 8); *(LAS u32x4*)(WH + e * RW_P + 8 * c) = *(const u32x4*)(rwh + (size_t)e * D + 8 * c); *(LAS u32x4*)(WL + e * RW_P + 8 * c) = *(const u32x4*)(rwl + (size_t)e * D + 8 * c); }
      for (int i = F.tid; i < D; i += NTHREADS) { GB[i] = F.in[I_LN1G][(size_t)layer * D + i]; GB[D + i] = F.in[I_LN1B][(size_t)layer * D + i]; } }
    unsigned* cnt = F.ctl + CW_CNT + (mb * DEPTH + layer) * 64;
    LAS unsigned* lcnt = (LAS unsigned*)(F.lds + MISC_OFF) + 128;
    if (F.tid < 64) lcnt[F.tid] = 0u;
    __syncthreads();
    const int gw = F.bid * NWAVES + F.wave, NGW = F.G * NWAVES, nr = rows_of(mb);
    const float* rb = F.in[I_RB] + (size_t)layer * NEXP;
    bf16_t* XB = ws_bf(F, WS_XB); int* topi = (int*)(F.ws + WS_TOPI); float* gate = ws_f(F, WS_GATE); int* pos = (int*)(F.ws + WS_POS);
    float rbv[NTE];
#pragma unroll
    for (int t = 0; t < NTE; ++t) rbv[t] = 16 * t + fr < NEXP ? rb[16 * t + fr] : 0.f;
    for (int blk = gw; blk < nr / 16; blk += NGW) {
        const int row = 16 * blk + fr; const float* xr = x_out_row(F, mb, row) + 8 * fq;
        float s1, s2;
        { const float* stp = ws_f(F, WS_STAT) + (size_t)row * 32 + 8 * fq; const f32x4 a = *(const f32x4*)stp, b = *(const f32x4*)(stp + 4); s1 = (a[0] + a[2]) + (b[0] + b[2]); s2 = (a[1] + a[3]) + (b[1] + b[3]); }
        s1 += xshfl<16>(s1); s1 += xshfl<32>(s1); s2 += xshfl<16>(s2); s2 += xshfl<32>(s2);
        const float mean = s1 * (1.0f / D); const float rstd = 1.0f / sqrtf(fmaxf(s2 * (1.0f / D) - mean * mean, 0.f) + LN_EPS);
        f32x4 acc[NTE];
#pragma unroll
        for (int t = 0; t < NTE; ++t) acc[t] = (f32x4){0.f, 0.f, 0.f, 0.f};
        bf16_t* xo = XB + (size_t)row * D + 8 * fq;
#pragma unroll 4
        for (int sI = 0; sI < D / 32; ++sI) { const f32x4 a = *(const f32x4*)(xr + 32 * sI), b = *(const f32x4*)(xr + 32 * sI + 4);
            const f32x4 g0 = *(const LAS f32x4*)(GB + 32 * sI + 8 * fq), g1 = *(const LAS f32x4*)(GB + 32 * sI + 8 * fq + 4), b0 = *(const LAS f32x4*)(GB + D + 32 * sI + 8 * fq), b1 = *(const LAS f32x4*)(GB + D + 32 * sI + 8 * fq + 4);
            const f32x4 n0 = (a - mean) * rstd * g0 + b0, n1 = (b - mean) * rstd * g1 + b1;
            u32x4 hw; hw.x = pk2(n0[0], n0[1]); hw.y = pk2(n0[2], n0[3]); hw.z = pk2(n1[0], n1[1]); hw.w = pk2(n1[2], n1[3]);
            *(u32x4*)(xo + 32 * sI) = hw;
            u32x4 lw; lw.x = pk2(n0[0] - blo(hw.x), n0[1] - bhi(hw.x)); lw.y = pk2(n0[2] - blo(hw.y), n0[3] - bhi(hw.y)); lw.z = pk2(n1[0] - blo(hw.z), n1[1] - bhi(hw.z)); lw.w = pk2(n1[2] - blo(hw.w), n1[3] - bhi(hw.w));
            const bf16x8 ah = __builtin_bit_cast(bf16x8, hw), al = __builtin_bit_cast(bf16x8, lw);
#pragma unroll
            for (int t = 0; t < NTE; ++t) { const bf16x8 wh = *(const LAS bf16x8*)(WH + (16 * t + fr) * RW_P + 32 * sI + 8 * fq), wl = *(const LAS bf16x8*)(WL + (16 * t + fr) * RW_P + 32 * sI + 8 * fq);
                acc[t] = __builtin_amdgcn_mfma_f32_16x16x32_bf16(ah, wh, acc[t], 0, 0, 0); acc[t] = __builtin_amdgcn_mfma_f32_16x16x32_bf16(al, wh, acc[t], 0, 0, 0); acc[t] = __builtin_amdgcn_mfma_f32_16x16x32_bf16(ah, wl, acc[t], 0, 0, 0); } }
#pragma unroll
        for (int r = 0; r < 4; ++r) { float val[NTE];
#pragma unroll
            for (int t = 0; t < NTE; ++t) val[t] = 16 * t + fr < NEXP ? acc[t][r] + rbv[t] : -3.0e38f;
            float tv[4]; int te[4];
#pragma unroll
            for (int k = 0; k < 4; ++k) { float m = val[0];
#pragma unroll
                for (int t = 1; t < NTE; ++t) m = fmaxf(m, val[t]);
                m = fmaxf(m, xshfl<1>(m)); m = fmaxf(m, xshfl<2>(m)); m = fmaxf(m, xshfl<4>(m)); m = fmaxf(m, xshfl<8>(m));
                int ce = 9999;
#pragma unroll
                for (int t = NTE - 1; t >= 0; --t) ce = val[t] == m ? 16 * t + fr : ce;
                { int o = xshfl<1>(ce); ce = o < ce ? o : ce; o = xshfl<2>(ce); ce = o < ce ? o : ce; o = xshfl<4>(ce); ce = o < ce ? o : ce; o = xshfl<8>(ce); ce = o < ce ? o : ce; }
                tv[k] = m; te[k] = ce;
#pragma unroll
                for (int t = 0; t < NTE; ++t) if (16 * t + fr == ce) val[t] = -3.0e38f; }
            const float e1 = fexp(tv[1] - tv[0]), e2 = fexp(tv[2] - tv[0]), e3 = fexp(tv[3] - tv[0]); const float inv = 1.0f / (1.0f + e1 + e2 + e3);
            if (fr < 4) { const int e = fr == 0 ? te[0] : (fr == 1 ? te[1] : (fr == 2 ? te[2] : te[3])); const float gv = (fr == 0 ? 1.0f : (fr == 1 ? e1 : (fr == 2 ? e2 : e3))) * inv;
                const size_t tok = (size_t)16 * blk + 4 * fq + r;
                const unsigned rk = __hip_atomic_fetch_add(lcnt + e, 1u, __ATOMIC_RELAXED, __HIP_MEMORY_SCOPE_WORKGROUP);
                topi[tok * 4 + fr] = e; gate[tok * 4 + fr] = gv; pos[tok * 4 + fr] = (int)rk; } }
    }
    __syncthreads();
    if (F.tid < NEXP) lcnt[32 + F.tid] = __hip_atomic_fetch_add(cnt + F.tid, lcnt[F.tid], __ATOMIC_RELAXED, __HIP_MEMORY_SCOPE_AGENT);
    __syncthreads();
    for (int blk = gw; blk < nr / 16; blk += NGW) pos[(size_t)16 * blk * 4 + lane] += (int)lcnt[32 + topi[(size_t)16 * blk * 4 + lane]];
}
__device__ __forceinline__ void step_ln1_router(const Frame& F, int layer, int mb) {
    LAS float* wT = (LAS float*)F.lds;
    const float* rw = F.in[I_RW] + (size_t)layer * D * NEXP;
    __syncthreads();
    for (int i = F.tid; i < D * NEXP; i += NTHREADS) { const int e = i / D, k = i % D; wT[i] = rw[(size_t)k * NEXP + e]; }
    unsigned* cnt = F.ctl + CW_CNT + (mb * DEPTH + layer) * 64;
    LAS unsigned* lcnt = (LAS unsigned*)(F.lds + MISC_OFF) + 128;
    if (F.tid < 64) lcnt[F.tid] = 0u;
    __syncthreads();
    const int gw = F.bid * NWAVES + F.wave, NGW = F.G * NWAVES, nr = rows_of(mb), lane = F.lane;
    const float* lg = F.in[I_LN1G] + (size_t)layer * D; const float* lb = F.in[I_LN1B] + (size_t)layer * D; const float* rb = F.in[I_RB] + (size_t)layer * NEXP;
    bf16_t* XB = ws_bf(F, WS_XB); int* topi = (int*)(F.ws + WS_TOPI); float* gate = ws_f(F, WS_GATE); int* pos = (int*)(F.ws + WS_POS);
    constexpr int RB = 4, NH = NEXP / 2, LOGH = LOG_NEXP - 1;
    const int myexp = ((lane & 1) * NH) | ((lane >> (6 - LOGH)) & (NH - 1));
    const float myb = rb[myexp];
    for (int r0 = gw; r0 < nr; r0 += RB * NGW) {
        f32x4 v[RB][4]; int rr[RB]; bool ok[RB];
#pragma unroll
        for (int i = 0; i < RB; ++i) { const int r = r0 + i * NGW; ok[i] = r < nr; rr[i] = ok[i] ? r : r0; const float* xr = x_out_row(F, mb, rr[i]);
#pragma unroll
            for (int j = 0; j < 4; ++j) v[i][j] = *((const f32x4*)xr + lane + 64 * j); }
        asm volatile("" ::: "memory");
#pragma unroll
        for (int i = 0; i < RB; ++i) {
            float s = 0.f;
#pragma unroll
            for (int j = 0; j < 4; ++j) s += (v[i][j][0] + v[i][j][1]) + (v[i][j][2] + v[i][j][3]);
            const float mean = wave_sum(s) * (1.0f / D); float s2 = 0.f;
#pragma unroll
            for (int j = 0; j < 4; ++j) { v[i][j] = v[i][j] - mean; s2 += (v[i][j][0] * v[i][j][0] + v[i][j][1] * v[i][j][1]) + (v[i][j][2] * v[i][j][2] + v[i][j][3] * v[i][j][3]); }
            const float rstd = 1.0f / sqrtf(wave_sum(s2) * (1.0f / D) + LN_EPS);
#pragma unroll
            for (int j = 0; j < 4; ++j) { const f32x4 gg = *((const f32x4*)lg + lane + 64 * j), bb = *((const f32x4*)lb + lane + 64 * j); v[i][j] = v[i][j] * rstd * gg + bb;
                if (ok[i]) { u32x2 w; w.x = pk2(v[i][j][0], v[i][j][1]); w.y = pk2(v[i][j][2], v[i][j][3]); *((u32x2*)(XB + (size_t)rr[i] * D) + lane + 64 * j) = w; } }
        }
        typedef float f32x2v __attribute__((ext_vector_type(2)));
        float val[RB];
#pragma unroll
        for (int hf = 0; hf < 2; ++hf) {
            float lgt[RB][NH];
#pragma unroll
            for (int e = 0; e < NH; ++e) { f32x2v a2[RB / 2];
#pragma unroll
                for (int i = 0; i < RB / 2; ++i) a2[i] = (f32x2v){0.f, 0.f};
#pragma unroll
                for (int j = 0; j < 4; ++j) { const f32x4 wv = *((const LAS f32x4*)(wT + (hf * NH + e) * D) + lane + 64 * j);
#pragma unroll
                    for (int c = 0; c < 4; ++c) { const f32x2v w2 = (f32x2v){wv[c], wv[c]};
#pragma unroll
                        for (int i = 0; i < RB / 2; ++i) a2[i] = __builtin_elementwise_fma((f32x2v){v[2 * i][j][c], v[2 * i + 1][j][c]}, w2, a2[i]); } }
#pragma unroll
                for (int i = 0; i < RB / 2; ++i) { lgt[2 * i][e] = a2[i].x; lgt[2 * i + 1][e] = a2[i].y; }
                if ((e & 1) == 1) asm volatile("" ::: "memory"); }
#pragma unroll
            for (int i = 0; i < RB; ++i) { RedStep<NH, 32>::run(lgt[i], lane); float tot = lgt[i][0];
                if constexpr ((32 >> LOGH) >= 8) tot += xshfl<8>(tot);
                if constexpr ((32 >> LOGH) >= 4) tot += xshfl<4>(tot);
                if constexpr ((32 >> LOGH) >= 2) tot += xshfl<2>(tot);
                tot += xshfl<1>(tot);
                if ((lane & 1) == hf) val[i] = tot + myb; }
        }
#pragma unroll
        for (int i = 0; i < RB; ++i) {
            float tv[4]; int te[4]; float vv = val[i];
#pragma unroll
            for (int k = 0; k < 4; ++k) { float m = vv; m = fmaxf(m, xshfl<1>(m)); m = fmaxf(m, xshfl<2>(m)); m = fmaxf(m, xshfl<4>(m)); m = fmaxf(m, xshfl<8>(m)); m = fmaxf(m, xshfl<16>(m)); m = fmaxf(m, xshfl<32>(m));
                const unsigned long long bal = __ballot(vv == m); const int wl = __builtin_ctzll(bal);
                const int be = ((wl & 1) * NH) | ((wl >> (6 - LOGH)) & (NH - 1));
                tv[k] = m; te[k] = be; if (myexp == be) vv = -3.0e38f; }
            const float e1 = fexp(tv[1] - tv[0]), e2 = fexp(tv[2] - tv[0]), e3 = fexp(tv[3] - tv[0]); const float inv = 1.0f / (1.0f + e1 + e2 + e3);
            if (lane < 4 && ok[i]) { const int e = lane == 0 ? te[0] : (lane == 1 ? te[1] : (lane == 2 ? te[2] : te[3])); const float gv = (lane == 0 ? 1.0f : (lane == 1 ? e1 : (lane == 2 ? e2 : e3))) * inv;
                const unsigned rk = __hip_atomic_fetch_add(lcnt + e, 1u, __ATOMIC_RELAXED, __HIP_MEMORY_SCOPE_WORKGROUP);
                topi[(size_t)rr[i] * 4 + lane] = e; gate[(size_t)rr[i] * 4 + lane] = gv; pos[(size_t)rr[i] * 4 + lane] = (int)rk; }
        }
    }
    __syncthreads();
    if (F.tid < NEXP) lcnt[32 + F.tid] = __hip_atomic_fetch_add(cnt + F.tid, lcnt[F.tid], __ATOMIC_RELAXED, __HIP_MEMORY_SCOPE_AGENT);
    __syncthreads();
    for (int r = gw; r < nr; r += NGW) if (lane < 4) pos[(size_t)r * 4 + lane] += (int)lcnt[32 + topi[(size_t)r * 4 + lane]];
}
__device__ __forceinline__ int moe_table(const Frame& F, int layer, int mb) {
    LAS int* M = (LAS int*)(F.lds + MISC_OFF);
    __syncthreads();
    if (F.tid == 0) { unsigned* cnt = F.ctl + CW_CNT + (mb * DEPTH + layer) * 64; int acc = 0;
        for (int e = 0; e < NEXP; ++e) { const int c = (int)__hip_atomic_load(cnt + e, __ATOMIC_RELAXED, __HIP_MEMORY_SCOPE_AGENT); M[64 + e] = acc * 256; acc += (c + 255) / 256; M[16 + e] = acc; } }
    __syncthreads();
    return M[16 + NEXP - 1];
}
__device__ __forceinline__ void step_gather(const Frame& F, int layer, int mb) {
    (void)moe_table(F, layer, mb); const LAS int* M = (const LAS int*)(F.lds + MISC_OFF);
    const int nr = rows_of(mb);
    const int* topi = (const int*)(F.ws + WS_TOPI); const float* gate = ws_f(F, WS_GATE); int* pos = (int*)(F.ws + WS_POS); float* gs = ws_f(F, WS_GSORT); int* rtok = (int*)(F.ws + WS_RTOK);
#pragma nounroll
    for (int i = F.bid * NTHREADS + F.tid; i < nr * 4; i += F.G * NTHREADS) { const int p = M[64 + topi[i]] + pos[i]; pos[i] = p; rtok[p] = i >> 2; gs[p] = gate[i]; }
}
__device__ __forceinline__ void step_ln2(const Frame& F, int layer, int mb) {
    const int gw = F.bid * NWAVES + F.wave, NGW = F.G * NWAVES, nr = rows_of(mb), lane = F.lane;
    const float* lg = F.in[I_LN2G] + (size_t)layer * D; const float* lb = F.in[I_LN2B] + (size_t)layer * D;
    const bf16_t* OUTS = ws_bf(F, WS_H) + (size_t)2 * RP * D; const int* pos = (const int*)(F.ws + WS_POS); bf16_t* XB = ws_bf(F, WS_XB);
    constexpr int RB = 2;
    for (int r0 = gw; r0 < nr; r0 += RB * NGW) {
        f32x4 v[RB][4]; u32x2 ow[RB][4][4]; int rr[RB];
#pragma unroll
        for (int i = 0; i < RB; ++i) { rr[i] = r0 + i * NGW < nr ? r0 + i * NGW : r0; const u32x2* xr = (const u32x2*)(XB + (size_t)rr[i] * D); int p[4];
#pragma unroll
            for (int k = 0; k < 4; ++k) p[k] = pos[(size_t)rr[i] * 4 + k];
#pragma unroll
            for (int j = 0; j < 4; ++j) { { const u32x2 w = xr[lane + 64 * j]; v[i][j] = (f32x4){blo(w.x), bhi(w.x), blo(w.y), bhi(w.y)}; }
#pragma unroll
                for (int k = 0; k < 4; ++k) ow[i][k][j] = *((const u32x2*)(OUTS + (size_t)p[k] * D) + lane + 64 * j); } }
        asm volatile("" ::: "memory");
#pragma unroll
        for (int i = 0; i < RB; ++i) { if (r0 + i * NGW >= nr) continue;
            float* xr = x_out_row(F, mb, rr[i]); float s = 0.f;
#pragma unroll
            for (int j = 0; j < 4; ++j) { v[i][j] = v[i][j] * ALPHA;
#pragma unroll
                for (int k = 0; k < 4; ++k) { const u32x2 w = ow[i][k][j]; v[i][j] = v[i][j] + (f32x4){blo(w.x), bhi(w.x), blo(w.y), bhi(w.y)}; }
                s += (v[i][j][0] + v[i][j][1]) + (v[i][j][2] + v[i][j][3]); }
            const float mean = wave_sum(s) * (1.0f / D); float s2 = 0.f;
#pragma unroll
            for (int j = 0; j < 4; ++j) { v[i][j] = v[i][j] - mean; s2 += (v[i][j][0] * v[i][j][0] + v[i][j][1] * v[i][j][1]) + (v[i][j][2] * v[i][j][2] + v[i][j][3] * v[i][j][3]); }
            const float rstd = 1.0f / sqrtf(wave_sum(s2) * (1.0f / D) + LN_EPS);
#pragma unroll
            for (int j = 0; j < 4; ++j) { const f32x4 gg = *((const f32x4*)lg + lane + 64 * j), bb = *((const f32x4*)lb + lane + 64 * j); v[i][j] = v[i][j] * rstd * gg + bb;
                *((f32x4*)xr + lane + 64 * j) = v[i][j]; u32x2 w; w.x = pk2(v[i][j][0], v[i][j][1]); w.y = pk2(v[i][j][2], v[i][j][3]); *((u32x2*)(XB + (size_t)rr[i] * D) + lane + 64 * j) = w; } }
    }
}

constexpr int SP_P = 68;
template <int KS  > __device__ __forceinline__ void small_mma(const bf16_t* A, int lda, const bf16_t* Bt, int K, int tok0, int n0, int k0, int fr, int fq, f32x4 (&acc)[4]) {
    const bf16_t* ap = A + (size_t)(tok0 + fr) * lda + k0 + 8 * fq; const bf16_t* bp = Bt + (size_t)(n0 + fr) * K + k0 + 8 * fq;
#pragma unroll
    for (int k = 0; k < KS; k += 32) { const bf16x8 a = *(const bf16x8*)(ap + k);
#pragma unroll
        for (int jj = 0; jj < 4; ++jj) { const bf16x8 x = *(const bf16x8*)(bp + (size_t)16 * jj * K + k); acc[jj] = __builtin_amdgcn_mfma_f32_16x16x32_bf16(x, a, acc[jj], 0, 0, 0); } }
}
template <int MODE  >
__device__ __forceinline__ void sample_unit(const Frame& F, int layer, int u) {
    const int tid = F.tid, lane = F.lane, w = F.wave, fr = lane & 15, fq = lane >> 4; const int tok0 = NP + 16 * (u >> 4), n0 = 64 * (u & 15);
    LAS float* P = (LAS float*)F.lds;
    const bf16_t* H = ws_bf(F, WS_H); const size_t trow = (size_t)(tok0 + fr);
    f32x4 v[4];
#pragma unroll
    for (int jj = 0; jj < 4; ++jj) v[jj] = (f32x4){0.f, 0.f, 0.f, 0.f};
    if constexpr (MODE == 0) {
#pragma unroll
        for (int b = 0; b < 3; ++b) { f32x4 acc[4] = {(f32x4){0.f, 0.f, 0.f, 0.f}, (f32x4){0.f, 0.f, 0.f, 0.f}, (f32x4){0.f, 0.f, 0.f, 0.f}, (f32x4){0.f, 0.f, 0.f, 0.f}};
            if (b == 0) { small_mma<DINNER / 8>(H + C_Z, DINP, wl_ptr(F, layer, WL_SSD), DINNER, tok0, n0, w * (DINNER / 8), fr, fq, acc);
                const float* sq = ws_f(F, WS_SSQ) + trow * 128 + 16 * w; const f32x4 qa = (*(const f32x4*)sq + *(const f32x4*)(sq + 4)) + (*(const f32x4*)(sq + 8) + *(const f32x4*)(sq + 12)); const float rs = 1.0f / sqrtf(((qa[0] + qa[1]) + (qa[2] + qa[3])) * (1.0f / 256.0f) + LN_EPS);
#pragma unroll
                for (int jj = 0; jj < 4; ++jj) acc[jj] = acc[jj] * rs; }
            else small_mma<D / 8>(H + (b == 1 ? C_Q : C_SCB), DINP, wl_ptr(F, layer, b == 1 ? WL_ATT : WL_SC), D, tok0, n0, w * (D / 8), fr, fq, acc);
#pragma unroll
            for (int jj = 0; jj < 4; ++jj) { const u32x2 gw = *(const u32x2*)(H + trow * DINP + (b == 0 ? C_GSSD : (b == 1 ? C_GATT : C_GSC)) + n0 + 16 * jj + 4 * fq);
                v[jj] = v[jj] + acc[jj] * (f32x4){fsigmoid(blo(gw.x)), fsigmoid(bhi(gw.x)), fsigmoid(blo(gw.y)), fsigmoid(bhi(gw.y))}; } }
    } else small_mma<D / 8>(ws_bf(F, WS_XB), D, wl_ptr(F, layer, WL_O), D, tok0, n0, w * (D / 8), fr, fq, v);
    __syncthreads();
#pragma unroll
    for (int jj = 0; jj < 4; ++jj) *(LAS f32x4*)(P + (w * 16 + fr) * SP_P + 16 * jj + 4 * fq) = v[jj];
    __syncthreads();
    { const int tk = tid >> 5, c2 = 2 * (tid & 31); float s0 = 0.f, s1 = 0.f;
#pragma unroll
      for (int ww = 0; ww < 8; ++ww) { s0 += P[(ww * 16 + tk) * SP_P + c2]; s1 += P[(ww * 16 + tk) * SP_P + c2 + 1]; }
      const size_t orow = (size_t)(tok0 + tk);
      if constexpr (MODE == 0) *(unsigned*)(ws_bf(F, WS_XB) + orow * D + n0 + c2) = pk2(s0, s1);
      else { const float* xs = (layer == 0 ? F.in[I_XS] : F.out + O_YS) + (orow - NP) * D + n0 + c2; float* os = F.out + O_YS + (orow - NP) * D + n0 + c2; const float v0 = xs[0] * ALPHA + s0, v1 = xs[1] * ALPHA + s1; os[0] = v0; os[1] = v1;
          float t1 = v0 + v1, t2 = v0 * v0 + v1 * v1;
          t1 += xshfl<1>(t1); t1 += xshfl<2>(t1); t1 += xshfl<4>(t1); t1 += xshfl<8>(t1); t1 += xshfl<16>(t1); t2 += xshfl<1>(t2); t2 += xshfl<2>(t2); t2 += xshfl<4>(t2); t2 += xshfl<8>(t2); t2 += xshfl<16>(t2);
          if ((tid & 31) == 0) { float* sp = ws_f(F, WS_STAT) + orow * 32 + 2 * (u & 15); sp[0] = t1; sp[1] = t2; } } }
}

constexpr int PH_PER = 10, NSTEPS = 1 + NMB * DEPTH * PH_PER;
__global__ void __launch_bounds__(NTHREADS, 2) fwd(Args args) {
#ifdef EMU
    unsigned char* lds = emu_wg->lds;
#else
    extern __shared__ __attribute__((aligned(16))) unsigned char lds[];
#endif
    Frame F0; F0.lds = (LAS unsigned char*)lds; F0.tid = threadIdx.x; F0.lane = F0.tid & 63; F0.wave = __builtin_amdgcn_readfirstlane(F0.tid >> 6); F0.G = gridDim.x; F0.bid = blockIdx.x;
#ifdef EMU
    F0.in = args.in;
#else
    F0.in = (ArgTab)__builtin_amdgcn_kernarg_segment_ptr();
    static_assert(offsetof(Args, out) == 248 && offsetof(Args, ws) == 256 && offsetof(Args, in) == 0, "PF() reads the argument struct by offset");
#endif
    F0.out = args.out; F0.ws = args.ws; F0.ctl = (unsigned*)(args.ws + WS_CTL);
    const Frame& F = F0;
    const int lo = args.lo, hi = args.hi;
#ifndef EMU
    for (int u = F.tid; u < (LDS_BYTES - MISC_OFF) / 4; u += NTHREADS) ((LAS unsigned*)(F.lds + MISC_OFF))[u] = 0u;
    __syncthreads();
    XcdBarrier bar; bar.bar = F.ctl + CW_BAR; bar.x = 0; bar.st = nullptr;
    if (hi - lo > 1) bar = xcd_barrier_post(F.ctl + CW_BAR, (volatile LAS unsigned*)(F.lds + MISC_OFF) + 8);
#define SEAM(s) do { if ((s) + 1 < hi) { XcdBarrier b2_ = bar; unsigned long long bp_ = (unsigned long long)b2_.bar; asm volatile("" : "+s"(bp_)); b2_.bar = (unsigned*)bp_; xcd_barrier(b2_); } } while (0)
#else
#define SEAM(s) do { } while (0)
#endif
#ifndef PH_MASK
#define PH_MASK 0xFFFFFFFF
#endif
#define IN(s) (lo <= (s) && (s) < hi)
#define PHON(b) ((PH_MASK >> (b)) & 1)
#ifdef EMU
#define PF(Fp) Frame Fp = F0
#else
#define PF(Fp) Frame Fp; { unsigned long long kp_ = (unsigned long long)__builtin_amdgcn_kernarg_segment_ptr(); asm volatile("" : "+s"(kp_)); \
    Fp.in = (ArgTab)kp_; Fp.out = *(float* const __attribute__((address_space(4)))*)(kp_ + 248); Fp.ws = *(unsigned char* const __attribute__((address_space(4)))*)(kp_ + 256); Fp.ctl = (unsigned*)Fp.ws; \
    Fp.lds = F0.lds; Fp.G = F0.G; Fp.bid = F0.bid; Fp.wave = F0.wave; Fp.lane = opq(lane_id()); Fp.tid = Fp.wave * 64 + Fp.lane; }
#endif
    int step = 0;
    if (IN(step)) { PROBE_T0(0) if constexpr (PHON(0)) { PF(F); step_weights(F); for (int m = 0; m < NMB; ++m) step_xb(F, m);
        { bf16_t* rwh = ws_bf(F, WS_RWH); bf16_t* rwl = ws_bf(F, WS_RWL); const float* rw = F.in[I_RW];
#pragma nounroll
          for (int i = F.bid * NTHREADS + F.tid; i < DEPTH * NTE * 16 * D; i += F.G * NTHREADS) { const int l = i / (NTE * 16 * D), e = (i / D) % (NTE * 16), k = i % D;
              const float wv = e < NEXP ? rw[((size_t)l * D + k) * NEXP + e] : 0.f; const unsigned hi = f2bf(wv); rwh[i] = (bf16_t)hi; rwl[i] = (bf16_t)f2bf(wv - bf2f(hi)); } } } PROBE_T1(0) SEAM(step); }
    ++step;
#define PHV const int mb = opqs(mb0), layer = opqs(layer0), nr = rows_of(mb); (void)nr; (void)layer
    for (int mb0 = 0; mb0 < NMB; ++mb0)
        for (int layer0 = 0; layer0 < DEPTH; ++layer0) {
            if (IN(step)) { PROBE_T0(2) if constexpr (PHON(2)) { PF(F); PHV; pg8::Gemm g{layer == 0 ? ws_bf(F, WS_XB0) + (size_t)mb * R * D : ws_bf(F, WS_XB), wl_ptr(F, layer, WL_IN), nr, DINP, D, D, nullptr}; pg8::StaticOrder S; S.init(nr, DINP, F.G, F.bid, 2);
                pg8::EpiStoreBf16 E{ws_bf(F, WS_H), DINP}; pg8::gemm_phase(F.lds, g, S, E, F.wave); } PROBE_T1(2) SEAM(step); }
            ++step;
            if (IN(step)) { PROBE_T0(13) if constexpr (PHON(13)) { PF(F); PHV; step_premix(F, layer, mb); } PROBE_T1(13) SEAM(step); }
            ++step;
            if (IN(step)) { PROBE_T0(3) if constexpr (PHON(3)) { PF(F); PHV; step_mixers(F, layer, mb); } PROBE_T1(3) SEAM(step); }
            ++step;
            if (IN(step)) { PROBE_T0(5) if constexpr (PHON(5)) { PF(F); PHV; pg8::StaticOrder S; S.init(NP, D, F.G, F.bid); bf16_t* H = ws_bf(F, WS_H); bf16_t* MGb = ws_bf(F, WS_XB);
#ifndef MERGE_MASK
#define MERGE_MASK 7
#endif
                if constexpr (MERGE_MASK & 1) { pg8::Gemm g{H + C_Z, wl_ptr(F, layer, WL_SSD), NP, D, DINNER, DINP, nullptr, ws_f(F, WS_SSQ)}; pg8::EpiGate<0> E{H + C_GSSD, MGb}; pg8::gemm_phase<pg8::EpiGate<0>, pg8::StaticOrder, false, true>(F.lds, g, S, E, F.wave); }
                if constexpr (MERGE_MASK & 2) { pg8::Gemm g{H + C_Q, wl_ptr(F, layer, WL_ATT), NP, D, D, DINP, nullptr}; pg8::EpiGate<1> E{H + C_GATT, MGb}; pg8::gemm_phase(F.lds, g, S, E, F.wave); }
                if constexpr (MERGE_MASK & 4) { pg8::Gemm g{H + C_SCB, wl_ptr(F, layer, WL_SC), NP, D, D, DINP, nullptr}; pg8::EpiGate<1> E{H + C_GSC, MGb}; pg8::gemm_phase(F.lds, g, S, E, F.wave); }
                if (mb == 0) for (int u = F.bid; u < 256; u += F.G) sample_unit<0>(F, layer, u); }
                PROBE_T1(5) SEAM(step); }
            ++step;
            if (IN(step)) { PROBE_T0(6) if constexpr (PHON(6)) { PF(F); PHV; pg8::Gemm g{ws_bf(F, WS_XB), wl_ptr(F, layer, WL_O), NP, D, D, D, nullptr}; pg8::StaticOrder S; S.init(NP, D, F.G, F.bid);
                pg8::EpiResid E{layer == 0 ? F.in[I_XP] + (size_t)mb * NP * D : F.out + O_YP + (size_t)mb * NP * D, layer == 0 ? F.in[I_XS] : F.out + O_YS, F.out + O_YP + (size_t)mb * NP * D, F.out + O_YS, ws_f(F, WS_STAT)};
                pg8::gemm_phase(F.lds, g, S, E, F.wave);
                if (mb == 0) for (int u = F.bid; u < 256; u += F.G) sample_unit<1>(F, layer, u); } PROBE_T1(6) SEAM(step); }
            ++step;
            if (IN(step)) { PROBE_T0(7) if constexpr (PHON(7)) { PF(F); PHV; step_ln1_router_mfma(F, layer, mb); } PROBE_T1(7) SEAM(step); }
            ++step;
            if (IN(step)) { PROBE_T0(8) if constexpr (PHON(8)) { PF(F); PHV; step_gather(F, layer, mb); } PROBE_T1(8) SEAM(step); }
            ++step;
            if (IN(step)) { PROBE_T0(9) if constexpr (PHON(9)) { PF(F); PHV; const int nt = moe_table(F, layer, mb); pg8::MoeOrder S{(const LAS int*)(F.lds + MISC_OFF) + 16, 8, nt * 8, F.G, F.bid};
                pg8::Gemm g{ws_bf(F, WS_XB), wl_ptr(F, layer, WL_UP), nr  , 2048, D, D, (const int*)(F.ws + WS_RTOK)}; pg8::EpiSwiglu E{ws_bf(F, WS_H) + (size_t)RP * D, F.in[I_BUP] + (size_t)layer * NEXP * 2048};
                pg8::gemm_phase<pg8::EpiSwiglu, pg8::MoeOrder, true>(F.lds, g, S, E, F.wave); } PROBE_T1(9) SEAM(step); }
            ++step;
            if (IN(step)) { PROBE_T0(10) if constexpr (PHON(10)) { PF(F); PHV; const int nt = moe_table(F, layer, mb); pg8::MoeOrder S{(const LAS int*)(F.lds + MISC_OFF) + 16, 4, nt * 4, F.G, F.bid};
                pg8::Gemm g{ws_bf(F, WS_H) + (size_t)RP * D, wl_ptr(F, layer, WL_DN), nt * 256, D, D, D, nullptr}; pg8::EpiDown E{ws_bf(F, WS_H) + (size_t)2 * RP * D, F.in[I_BDN] + (size_t)layer * NEXP * D, ws_f(F, WS_GSORT)};
                pg8::gemm_phase(F.lds, g, S, E, F.wave); } PROBE_T1(10) SEAM(step); }
            ++step;
            if (IN(step)) { PROBE_T0(11) if constexpr (PHON(11)) { PF(F); PHV; step_ln2(F, layer, mb); } PROBE_T1(11) SEAM(step); }
            ++step;
        }
}

#ifdef EMU
extern int emu_grid, emu_step_lo, emu_step_hi;
#endif
extern "C" void kernel_launch(void* const* d_in, const int* in_sizes, int n_in, void* d_out, int out_size, void* d_ws, size_t ws_size, hipStream_t stream) {
    (void)in_sizes; (void)out_size;
    if (n_in != 31 || ws_size < WS_END) { fprintf(stderr, "kernel_launch: expected 31 inputs and >= %zu bytes of workspace (got %d, %zu)\n", (size_t)WS_END, n_in, ws_size); return; }
    Args a; memset(&a, 0, sizeof(a));
    for (int i = 0; i < 31; ++i) a.in[i] = (const float*)d_in[i];
    a.out = (float*)d_out; a.ws = (unsigned char*)d_ws;
#ifdef EMU
    if (emu_step_lo == 0) memset((char*)d_ws + WS_CTL, 0, CTL_BYTES);
    for (int s = emu_step_lo; s < emu_step_hi && s < NSTEPS; ++s) { a.lo = s; a.hi = s + 1; emu_launch(fwd, emu_grid, NTHREADS, LDS_BYTES, a); fprintf(stderr, "step %d done\n", s); }
#else
    (void)hipMemsetAsync((char*)d_ws + WS_CTL, 0, CTL_BYTES, stream);
    static int grid = 0;
    if (grid == 0) {
        int dev = 0, cus = 0;
        if (hipGetDevice(&dev) != hipSuccess || hipDeviceGetAttribute(&cus, hipDeviceAttributeMultiprocessorCount, dev) != hipSuccess) { grid = -1; return; }
        if (hipFuncSetAttribute((const void*)fwd, hipFuncAttributeMaxDynamicSharedMemorySize, LDS_BYTES) != hipSuccess) { grid = -1; return; }
        int per_cu = 0; (void)hipOccupancyMaxActiveBlocksPerMultiprocessor(&per_cu, (const void*)fwd, NTHREADS, LDS_BYTES); (void)hipGetLastError();
        grid = cus / 64 * 64;
        if (grid < 64) { grid = -1; return; }
    }
    if (grid < 0) return;
#if CFG_ONE_LAUNCH
    a.lo = 0; a.hi = NSTEPS; hipLaunchKernelGGL(fwd, dim3(grid), dim3(NTHREADS), LDS_BYTES, stream, a);
#else
    for (int s = 0; s < NSTEPS; ++s) { a.lo = s; a.hi = s + 1; hipLaunchKernelGGL(fwd, dim3(grid), dim3(NTHREADS), LDS_BYTES, stream, a); }
#endif
#endif
}
```

```cpp
#ifdef EMU
#include "emu.h"
#else
#include <hip/hip_runtime.h>
#endif
#include <cstdio>
#include <cstdint>
#include <cstring>
#include <cstddef>
#include <cmath>

#ifndef CFG_BATCH
#define CFG_BATCH 16
#endif
#ifndef CFG_SEQ
#define CFG_SEQ 4096
#endif
#ifndef CFG_NSEQ_MB
#define CFG_NSEQ_MB 8
#endif
#ifndef CFG_NEXP
#define CFG_NEXP 32
#endif
#ifndef CFG_ONE_LAUNCH
#define CFG_ONE_LAUNCH 1
#endif

constexpr int BATCH = CFG_BATCH, SEQ = CFG_SEQ, NSEQ_MB = CFG_NSEQ_MB, NEXP = CFG_NEXP, NMB = BATCH / NSEQ_MB;
constexpr int D = 1024, DEPTH = 2, DECB = 16, DECS = 16, NS = DECB * DECS;
constexpr int DINNER = 2048, CONVDIM = 4096;
constexpr int NKV = 4, WINDOW = 128, CHUNK = 64;
constexpr int DIN = 13856, DINP = 14080;
constexpr int NP = NSEQ_MB * SEQ, R = NP + NS;
constexpr int NTE = (NEXP + 15) / 16;
constexpr int RP = ((4 * R + NEXP * 255) + 255) / 256 * 256;
constexpr int NCHUNK = SEQ / CHUNK;
constexpr int C_Z = 0, C_X = 2048, C_B = 4096, C_C = 5120, C_Q = 6144, C_K = 7168, C_V = 7424, C_SCB = 7680, C_SCC = 8704, C_SCH = 9728, C_GSSD = 10752, C_GATT = 11776, C_GSC = 12800, C_DT = 13824;
constexpr float LN_EPS = 1e-5f, ALPHA = 1.41421356237309515f  , SW_LIMIT = 7.0f, SW_ALPHA = 1.702f;
static_assert(BATCH % NSEQ_MB == 0 && SEQ % 256 == 0 && (NEXP & (NEXP - 1)) == 0 && NEXP <= 32 && NEXP >= 4, "config");

constexpr size_t O_YP = 0, O_YS = O_YP + (size_t)BATCH * SEQ * D, O_KP = O_YS + (size_t)NS * D, O_VP = O_KP + (size_t)DEPTH * BATCH * WINDOW * 256,
    O_SSP = O_VP + (size_t)DEPTH * BATCH * WINDOW * 256, O_CVP = O_SSP + (size_t)DEPTH * BATCH * 32 * 64 * 128, O_SCP = O_CVP + (size_t)DEPTH * BATCH * 3 * CONVDIM,
    O_KS = O_SCP + (size_t)DEPTH * BATCH * 2 * D, O_VS = O_KS + (size_t)DEPTH * DECB * DECS * 256, O_SSS = O_VS + (size_t)DEPTH * DECB * DECS * 256,
    O_CVS = O_SSS + (size_t)DEPTH * DECB * 32 * 64 * 128, O_SCS = O_CVS + (size_t)DEPTH * DECB * 3 * CONVDIM, O_END = O_SCS + (size_t)DEPTH * DECB * 2 * D;

constexpr size_t al256(size_t x) { return (x + 255) / 256 * 256; }
constexpr size_t WS_CTL = 0, CTL_BYTES = 1u << 20;
constexpr size_t WS_SSQ = CTL_BYTES, WS_TOPI = WS_SSQ + al256((size_t)R * 128 * 4)  , WS_GATE = WS_TOPI + al256((size_t)R * 16), WS_POS = WS_GATE + al256((size_t)R * 16),
    WS_GSORT = WS_POS + al256((size_t)R * 16), WS_RTOK = WS_GSORT + al256((size_t)RP * 4),
    WS_RWH = WS_RTOK + al256((size_t)RP * 4)  , WS_RWL = WS_RWH + (size_t)DEPTH * NTE * 16 * D * 2  , WS_W = WS_RWL + (size_t)DEPTH * NTE * 16 * D * 2;
constexpr size_t WL_IN = 0, WL_SSD = WL_IN + (size_t)DINP * D * 2, WL_ATT = WL_SSD + (size_t)D * DINNER * 2, WL_SC = WL_ATT + (size_t)D * D * 2, WL_O = WL_SC + (size_t)D * D * 2,
    WL_UP = WL_O + (size_t)D * D * 2, WL_DN = WL_UP + (size_t)NEXP * 2048 * D * 2, WL_BYTES = WL_DN + (size_t)NEXP * D * D * 2;
constexpr size_t WS_XB = WS_W + DEPTH * WL_BYTES, WS_XB0 = WS_XB + (size_t)R * D * 2  , WS_PRE = WS_XB0 + (size_t)NMB * R * D * 2  , WS_H = WS_PRE + (size_t)R * D * 2;
constexpr size_t WS_STAT = WS_PRE;
constexpr size_t H_BYTES = (size_t)R * DINP * 2, MOE_BYTES = (size_t)3 * RP * D * 2, U_BYTES = H_BYTES > MOE_BYTES ? H_BYTES : MOE_BYTES;
constexpr size_t WS_CMC = WS_H + U_BYTES, WS_BTG = WS_CMC + (size_t)NP * 1024 * 2, WS_CBG = WS_BTG + (size_t)NSEQ_MB * NCHUNK * 8 * 8192 * 2, WS_END = WS_CBG + (size_t)NSEQ_MB * NCHUNK * 8 * 4096 * 2;
static_assert(WS_END <= ((size_t)2 << 30), "workspace map exceeds 2 GiB");
constexpr int CW_BAR = 4096, CW_CNT = 16384;

constexpr int RING_BYTES = 131072, LDS_BYTES = 163840  , MISC_OFF = LDS_BYTES - 1024, SCR_BYTES = MISC_OFF;
constexpr int NWAVES = 8, NTHREADS = 512;

#ifdef EMU
#define LAS
#define WAVE_SYNC() emu_wave_barrier()
#else
#define LAS __attribute__((address_space(3)))
#define WAVE_SYNC() asm volatile("s_waitcnt lgkmcnt(0)" ::: "memory")
#endif
#ifdef EMU
#define LBAR() emu_wg_barrier()
#define VM_WAIT(n) do { } while (0)
#else
#define LBAR() do { asm volatile("s_waitcnt lgkmcnt(0)" ::: "memory"); __builtin_amdgcn_s_barrier(); asm volatile("" ::: "memory"); } while (0)
#define VM_WAIT(n) asm volatile("s_waitcnt vmcnt(" #n ")" ::: "memory")
#endif
typedef unsigned short bf16_t;
typedef short bf16x8 __attribute__((ext_vector_type(8)));
typedef float f32x4 __attribute__((ext_vector_type(4)));
typedef float f32x16 __attribute__((ext_vector_type(16)));
typedef unsigned u32x4 __attribute__((ext_vector_type(4)));
typedef unsigned u32x2 __attribute__((ext_vector_type(2)));

__device__ __forceinline__ unsigned f2bf(float f) { unsigned u = __builtin_bit_cast(unsigned, f); return (u + 0x7fffu + ((u >> 16) & 1u)) >> 16; }
__device__ __forceinline__ float bf2f(unsigned h) { return __builtin_bit_cast(float, (h & 0xffffu) << 16); }
#ifdef EMU
__device__ __forceinline__ unsigned pk2(float lo, float hi) { return f2bf(lo) | (f2bf(hi) << 16); }
#else
typedef float f32x2_t __attribute__((ext_vector_type(2))); typedef __bf16 bf16x2_t __attribute__((ext_vector_type(2)));
__device__ __forceinline__ unsigned pk2(float lo, float hi) { f32x2_t v = {lo, hi}; bf16x2_t b = __builtin_convertvector(v, bf16x2_t); return __builtin_bit_cast(unsigned, b); }
#endif
#ifdef EMU
__device__ __forceinline__ unsigned short bf1(float f) { return (unsigned short)f2bf(f); }
#else
__device__ __forceinline__ unsigned short bf1(float f) { return (unsigned short)pk2(f, f); }
#endif
__device__ __forceinline__ float blo(unsigned w) { return __builtin_bit_cast(float, w << 16); }
__device__ __forceinline__ float bhi(unsigned w) { return __builtin_bit_cast(float, w & 0xffff0000u); }
__device__ __forceinline__ void unpack8(const u32x4 w, float* f) { f[0] = blo(w.x); f[1] = bhi(w.x); f[2] = blo(w.y); f[3] = bhi(w.y); f[4] = blo(w.z); f[5] = bhi(w.z); f[6] = blo(w.w); f[7] = bhi(w.w); }
__device__ __forceinline__ u32x4 pack8(const float* f) { u32x4 w; w.x = pk2(f[0], f[1]); w.y = pk2(f[2], f[3]); w.z = pk2(f[4], f[5]); w.w = pk2(f[6], f[7]); return w; }
__device__ __forceinline__ float fexp(float x) { return __builtin_amdgcn_exp2f(x * 1.4426950408889634f); }
__device__ __forceinline__ float fsigmoid(float x) { return __builtin_amdgcn_rcpf(1.0f + __builtin_amdgcn_exp2f(-1.4426950408889634f * x)); }
__device__ __forceinline__ float fsilu(float x) { return x * fsigmoid(x); }
#ifdef EMU
__device__ __forceinline__ int opq(int x) { return x; }
#else
__device__ __forceinline__ int opq(int x) { asm volatile("" : "+v"(x)); return x; }
#endif
#ifdef EMU
__device__ __forceinline__ int opqs(int x) { return x; }
#else
__device__ __forceinline__ int opqs(int x) { asm volatile("" : "+s"(x)); return x; }
#endif
#ifdef EMU
__device__ __forceinline__ int lane_id() { return (int)(threadIdx.x & 63); }
#else
__device__ __forceinline__ int lane_id() { return (int)__builtin_amdgcn_mbcnt_hi(~0u, __builtin_amdgcn_mbcnt_lo(~0u, 0u)); }
#endif
#ifdef EMU
template <int MASK> __device__ __forceinline__ unsigned xshfl_u(unsigned x) { return __shfl_xor(x, MASK); }
#else
template <int MASK> __device__ __forceinline__ unsigned xshfl_u(unsigned x) {
    if constexpr (MASK == 1) return (unsigned)__builtin_amdgcn_update_dpp((int)x, (int)x, 0xB1, 0xF, 0xF, false);
    else if constexpr (MASK == 2) return (unsigned)__builtin_amdgcn_update_dpp((int)x, (int)x, 0x4E, 0xF, 0xF, false);
    else if constexpr (MASK == 4) { const int t = __builtin_amdgcn_update_dpp((int)x, (int)x, 0x114, 0xF, 0xA, false);
        return (unsigned)__builtin_amdgcn_update_dpp(t, (int)x, 0x104, 0xF, 0x5, false); }
    else if constexpr (MASK == 8) return (unsigned)__builtin_amdgcn_update_dpp((int)x, (int)x, 0x128, 0xF, 0xF, false);
    else if constexpr (MASK == 16) { const auto rr = __builtin_amdgcn_permlane16_swap(x, x, false, false); return (lane_id() & 16) ? rr[0] : rr[1]; }
    else { const auto rr = __builtin_amdgcn_permlane32_swap(x, x, false, false); return (lane_id() & 32) ? rr[0] : rr[1]; }
}
#endif
template <int MASK> __device__ __forceinline__ float xshfl(float x) { return __builtin_bit_cast(float, xshfl_u<MASK>(__builtin_bit_cast(unsigned, x))); }
template <int MASK> __device__ __forceinline__ int xshfl(int x) { return (int)xshfl_u<MASK>((unsigned)x); }
__device__ __forceinline__ float wave_sum(float v) { v += xshfl<1>(v); v += xshfl<2>(v); v += xshfl<4>(v); v += xshfl<8>(v); v += xshfl<16>(v); v += xshfl<32>(v); return v; }
#ifdef EMU
__device__ __forceinline__ float wave_scan_incl(float v, int lane) { for (int o = 1; o < 64; o <<= 1) { const float t = __shfl(v, lane - o < 0 ? 0 : lane - o); if (lane >= o) v += t; } return v; }
__device__ __forceinline__ float wave_last(float v) { return __shfl(v, 63); }
__device__ __forceinline__ int wave_scan_incl_i(int v, int lane) { for (int o = 1; o < 64; o <<= 1) { const int t = __shfl(v, lane - o < 0 ? 0 : lane - o); if (lane >= o) v += t; } return v; }
#else
__device__ __forceinline__ int wave_scan_incl_i(int v, int) {
#define WSC_STEP(ctrl_, rm_) v += __builtin_amdgcn_update_dpp(0, v, ctrl_, rm_, 0xF, false)
    WSC_STEP(0x111, 0xF); WSC_STEP(0x112, 0xF); WSC_STEP(0x114, 0xF); WSC_STEP(0x118, 0xF); WSC_STEP(0x142, 0xA); WSC_STEP(0x143, 0xC);
#undef WSC_STEP
    return v;
}
__device__ __forceinline__ float wave_scan_incl(float v, int) {
#define WSC_STEP(ctrl_, rm_) v += __builtin_bit_cast(float, __builtin_amdgcn_update_dpp(0, __builtin_bit_cast(int, v), ctrl_, rm_, 0xF, false))
    WSC_STEP(0x111, 0xF); WSC_STEP(0x112, 0xF); WSC_STEP(0x114, 0xF); WSC_STEP(0x118, 0xF); WSC_STEP(0x142, 0xA); WSC_STEP(0x143, 0xC);
#undef WSC_STEP
    return v;
}
__device__ __forceinline__ float wave_last(float v) { return __builtin_bit_cast(float, __builtin_amdgcn_readlane(__builtin_bit_cast(int, v), 63)); }
#endif

#ifndef PROBE_MASK
#define PROBE_MASK 0
#endif
#if PROBE_MASK && !defined(EMU)
#define PROBE_T0(b) unsigned long long pt0_ = 0; if constexpr ((PROBE_MASK >> (b)) & 1) pt0_ = __builtin_amdgcn_s_memrealtime();
#define PROBE_T1(b) if constexpr ((PROBE_MASK >> (b)) & 1) { asm volatile("s_waitcnt vmcnt(0) lgkmcnt(0)" ::: "memory"); const unsigned long long pt1_ = __builtin_amdgcn_s_memrealtime(); \
    while (__builtin_amdgcn_s_memrealtime() < pt1_ + (pt1_ - pt0_)) __builtin_amdgcn_s_sleep(8); }
#else
#define PROBE_T0(b)
#define PROBE_T1(b)
#endif
namespace pg8 {
constexpr int BM = 256, BK = 64, HALF = 128, HTB = HALF * BK * 2, NXCD = 8, WGM = 8;
struct Unit { int pm, pn, bt, e; int par = 0; };
struct Gemm { const bf16_t* A; const bf16_t* Bt; int M, N, K, lda; const int* tok; const float* ssq = nullptr; };
struct StaticOrder {
    int nM, nN, nwg, G, c, wgm;
    __host__ __device__ void init(int M, int N, int G_, int c_, int wgm_ = WGM) { nM = M / BM; nN = N / BM; nwg = nM * nN; G = G_; c = c_; wgm = wgm_; }
    __host__ __device__ bool next(int i, Unit& u) const {
        const long L = (long)i * G + c; if (L >= nwg) return false;
        int wgid = (int)L; { const int q = nwg / NXCD, r = nwg % NXCD, xcd = wgid % NXCD, off = wgid / NXCD; wgid = (xcd < r ? xcd * (q + 1) : r * (q + 1) + (xcd - r) * q) + off; }
        const int nig = wgm * nN, gid = wgid / nig, fm = gid * wgm, gsz = (nM - fm) < wgm ? (nM - fm) : wgm;
        u.pm = fm + ((wgid % nig) % gsz); u.pn = (wgid % nig) / gsz; u.bt = u.pn; u.e = 0; return true;
    }
    __device__ __forceinline__ void a_ready(const Unit&) const {}
    __device__ __forceinline__ void done(const Unit&) const {}
};
struct MoeOrder {
    const LAS int* tend; int npn, ntot, G, c;
    __device__ __forceinline__ bool next(int i, Unit& u) const {
        int rt, pn;
        {
            const int xcd = c & 7, j = c >> 3, rpx = (G >> 3) / npn; rt = (i * 8 + xcd) * rpx + j / npn; pn = j % npn; if (rt >= ntot / npn) return false; }
        int e = 0;
#pragma unroll
        for (int j = 0; j < NEXP; ++j) e += (tend[j] <= rt) ? 1 : 0;
        u.pm = rt; u.pn = pn; u.e = e; u.bt = e * npn + pn; return true;
    }
    __device__ __forceinline__ void a_ready(const Unit&) const {}
    __device__ __forceinline__ void done(const Unit&) const {}
};
#ifdef EMU
template <class Epi, class Sched, bool GATHER = false, bool GSCALE = false>
__device__ void gemm_phase(LAS unsigned char* lds, const Gemm g, const Sched& S, const Epi& E, int  ) {
    const int tid = threadIdx.x, wid = tid >> 6, lane = tid & 63, wr = wid >> 2, wc = wid & 3, fr = lane & 15, fq = lane >> 4;
    Unit u;
    for (int i = 0; S.next(i, u); ++i) {
        f32x4 acc[2][2][4][2];
        for (int ai = 0; ai < 2; ++ai) for (int bj = 0; bj < 2; ++bj) for (int m = 0; m < 4; ++m) for (int n = 0; n < 2; ++n) for (int q = 0; q < 4; ++q) {
            const int row = u.pm * 256 + ai * 128 + wr * 64 + m * 16 + fr, col = u.bt * 256 + bj * 128 + wc * 32 + 8 * fq + 4 * n + q;
            const bf16_t* a = g.A + (size_t)(GATHER ? ((unsigned)g.tok[row] < (unsigned)g.M ? g.tok[row] : 0) : row) * g.lda; const bf16_t* b = g.Bt + (size_t)col * g.K; float s = 0.f;
            if constexpr (GSCALE) {
                float rs[9]; for (int j = 0; j < 8; ++j) { float q2 = 0.f; for (int i = 0; i < 16; ++i) q2 += g.ssq[(size_t)row * 128 + 16 * j + i]; rs[j] = 1.0f / sqrtf(q2 * (1.0f / 256.0f) + LN_EPS); } rs[8] = 1.f;
                for (int j = 0; j < 8; ++j) { for (int k = 256 * j; k < 256 * j + 256; ++k) s += bf2f(a[k]) * bf2f(b[k]); s *= rs[j] * (1.0f / rs[j + 1]); } }
            else for (int k = 0; k < g.K; ++k) s += bf2f(a[k]) * bf2f(b[k]);
            acc[ai][bj][m][n][q] = s; }
        u.par = i & 1; __syncthreads(); E.pre(u, lds, wid, lane); __syncthreads();
        E(acc, u, wr, wc, fr, fq);
    }
    __syncthreads();
}
#else
#define PG8_LAS __attribute__((address_space(3)))
__host__ __device__ __forceinline__ int lds_byte(int r, int c) { const int st = (r >> 4) * 2 + (c >> 5), rr = r & 15, cc = c & 31, ob = rr * 64 + cc * 2; return st * 1024 + (ob ^ (((ob >> 9) & 1) << 5)); }
__host__ __device__ __forceinline__ void stage_rc(int b, int& R_, int& C_) { const int st = b / 1024, sb = b % 1024, swz = sb ^ (((sb >> 9) & 1) << 5); R_ = (st >> 1) * 16 + swz / 64; C_ = (st & 1) * 32 + (swz % 64) / 2; }
__host__ __device__ __forceinline__ int perm32(int rho) { const int n = rho >> 4, i = rho & 15; return 8 * (i >> 2) + 4 * n + (i & 3); }
template <class Epi, class Sched, bool GATHER = false, bool GSCALE = false>
__device__ __forceinline__ void gemm_phase(PG8_LAS unsigned char* lds, const Gemm g, const Sched& S, const Epi& E, int wave_id) {
    const int lane = opq(lane_id()), wid = opqs(wave_id), tid = wid * 64 + lane, wr = wid >> 2, wc = wid & 3, fr = lane & 15, fq = lane >> 4;
    const int K = g.K, nt = K / BK, lda = g.lda;
    unsigned voffA[2], voffB[2];
#pragma unroll
    for (int i = 0; i < 2; ++i) { int R_, C_; stage_rc(tid * 16 + i * 8192, R_, C_); const int Rb = (R_ & ~31) + perm32(R_ & 31);
        voffA[i] = (unsigned)(R_ * lda + C_) * 2u; voffB[i] = (unsigned)(Rb * K + C_) * 2u; }
    unsigned vG[2][2], vN[2][2];
#define PG8_TOK(dst, pm_) do { _Pragma("unroll") for (int i_ = 0; i_ < 2; ++i_) { int R_, C_; stage_rc(opq(tid) * 16 + i_ * 8192, R_, C_); _Pragma("unroll") for (int h_ = 0; h_ < 2; ++h_) \
        { unsigned tk_ = (unsigned)g.tok[(pm_) * 256 + h_ * 128 + R_]; tk_ = tk_ < (unsigned)g.M ? tk_ : 0u; dst[h_][i_] = tk_ * (unsigned)(lda * 2) + (unsigned)(C_ * 2); } } } while (0)
#define PG8_STAGE_A(bufoff, base_, h_, nx_) do { if constexpr (GATHER) { unsigned vs_[2] = {(nx_) ? vN[h_][0] : vG[h_][0], (nx_) ? vN[h_][1] : vG[h_][1]}; PG8_STAGE(bufoff, base_, vs_); } \
        else { PG8_STAGE(bufoff, (base_) + ((h_) ? hstepA : 0), voffA); } } while (0)
    const size_t kstep = (size_t)(BK * 2);
    const size_t hstepA = (size_t)HALF * lda * 2, tstepA = 2 * hstepA;
    const size_t hstepB = (size_t)HALF * K * 2, tstepB = 2 * hstepB;
    const unsigned ldsw = (unsigned)wid * 1024u;
    const int aoff = lds_byte(wr * 64 + fr, fq * 8), boff = lds_byte(wc * 32 + fr, fq * 8);
#define PG8_SA(b, h) (((b) * 2 + (h)) * HTB)
#define PG8_SB(b, h) ((4 + (b) * 2 + (h)) * HTB)
#define PG8_STAGE(bufoff, gbase, voff) do { _Pragma("unroll") for (int _i = 0; _i < 2; ++_i) \
        __builtin_amdgcn_global_load_lds((const unsigned*)((const char*)(gbase) + (voff)[_i]), (PG8_LAS unsigned*)(lds + (bufoff) + ldsw + _i * 8192), 16, 0, 0); } while (0)
#define PG8_LDA(dst, b, h) do { _Pragma("unroll") for (int m = 0; m < 4; ++m) _Pragma("unroll") for (int k = 0; k < 2; ++k) dst[m][k] = *(const PG8_LAS bf16x8*)(lds + PG8_SA(b, h) + aoff + m * 2048 + k * 1024); } while (0)
#define PG8_LDB(dst, b, h) do { _Pragma("unroll") for (int n = 0; n < 2; ++n) _Pragma("unroll") for (int k = 0; k < 2; ++k) dst[n][k] = *(const PG8_LAS bf16x8*)(lds + PG8_SB(b, h) + boff + n * 2048 + k * 1024); } while (0)
#define PG8_MMA(ai, bj, At, Bt) do { __builtin_amdgcn_s_setprio(1); _Pragma("unroll") for (int m = 0; m < 4; ++m) _Pragma("unroll") for (int n = 0; n < 2; ++n) _Pragma("unroll") for (int k = 0; k < 2; ++k) \
        acc[ai][bj][m][n] = __builtin_amdgcn_mfma_f32_16x16x32_bf16(Bt[n][k], At[m][k], acc[ai][bj][m][n], 0, 0, 0); __builtin_amdgcn_s_setprio(0); } while (0)
#define PG8_WAIT_V(n) asm volatile("s_waitcnt vmcnt(" #n ")" ::: "memory")
#define PG8_WAIT_L(n) asm volatile("s_waitcnt lgkmcnt(" #n ")" ::: "memory")
#define PG8_BAR __builtin_amdgcn_s_barrier()
#define PG8_SCHED __builtin_amdgcn_sched_barrier(0)
    Unit cur, nxt; int ui = 0;
    if (!S.next(0, cur)) return;
    if constexpr (GSCALE) {
        static_assert(RING_BYTES + 3 * 8192 <= MISC_OFF, "group-norm factor tables");
        Unit tu;
        if (S.next(3, tu)) __builtin_trap();
#pragma unroll 1
        for (int q = 0; q < 3 && S.next(q, tu); ++q) { const int row = tid & 255, h = tid >> 8;
            const float* sp = g.ssq + (size_t)(tu.pm * 256 + row) * 128 + 64 * h; float qv[5];
#pragma unroll
            for (int gi = 0; gi < 5; ++gi) { f32x4 a_ = (f32x4){0.f, 0.f, 0.f, 0.f}, b_ = a_; if (gi < 4 || h == 0) { a_ = *(const f32x4*)(sp + 16 * gi) + *(const f32x4*)(sp + 16 * gi + 8); b_ = *(const f32x4*)(sp + 16 * gi + 4) + *(const f32x4*)(sp + 16 * gi + 12); }
                a_ = a_ + b_; qv[gi] = sqrtf(((a_[0] + a_[1]) + (a_[2] + a_[3])) * (1.0f / 256.0f) + LN_EPS); }
            PG8_LAS float* ct = (PG8_LAS float*)(lds + RING_BYTES) + q * 2048 + 4 * h * 256 + row;
#pragma unroll
            for (int j = 0; j < 4; ++j) ct[j * 256] = (h == 1 && j == 3) ? 1.0f / qv[3] : qv[j + 1] / qv[j]; }
        __syncthreads();
    }
    f32x4 acc[2][2][4][2];
#pragma unroll
    for (int a = 0; a < 2; ++a)
#pragma unroll
        for (int b = 0; b < 2; ++b)
#pragma unroll
            for (int m = 0; m < 4; ++m)
#pragma unroll
                for (int n = 0; n < 2; ++n) acc[a][b][m][n] = (f32x4){0.f, 0.f, 0.f, 0.f};
    bf16x8 At[4][2], B0[2][2], B1[2][2];
    const char* cA = (const char*)g.A + (GATHER ? (size_t)0 : (size_t)cur.pm * tstepA); const char* cB = (const char*)g.Bt + (size_t)cur.bt * tstepB;
    if constexpr (GATHER) { PG8_TOK(vG, cur.pm); }
    S.a_ready(cur);
    PG8_STAGE(PG8_SB(0, 0), cB, voffB); PG8_STAGE(PG8_SB(0, 1), cB + hstepB, voffB); PG8_STAGE_A(PG8_SA(0, 0), cA, 0, false); PG8_STAGE_A(PG8_SA(0, 1), cA, 1, false);
    if (wr == 1) PG8_BAR;
    PG8_WAIT_V(2); PG8_BAR;
    PG8_STAGE(PG8_SB(1, 0), cB + kstep, voffB); PG8_STAGE_A(PG8_SA(1, 0), cA + kstep, 0, false); PG8_STAGE(PG8_SB(1, 1), cB + hstepB + kstep, voffB);
    PG8_WAIT_V(6); PG8_BAR;
    for (;;) {
        cur.par = ui & 1; E.pre(cur, lds, wid, lane);
        const bool has_next = S.next(ui + 1, nxt);
        const char* nA = has_next ? (const char*)g.A + (GATHER ? (size_t)0 : (size_t)nxt.pm * tstepA) : cA; const char* nB = has_next ? (const char*)g.Bt + (size_t)nxt.bt * tstepB : cB;
        if constexpr (GATHER) {
#pragma unroll
            for (int h_ = 0; h_ < 2; ++h_) { vN[h_][0] = vG[h_][0]; vN[h_][1] = vG[h_][1]; }
            if (has_next) {
#pragma unroll
                for (int i_ = 0; i_ < 2; ++i_) { int R_, C_; stage_rc(opq(tid) * 16 + i_ * 8192, R_, C_);
#pragma unroll
                    for (int h_ = 0; h_ < 2; ++h_) { const int* tp_ = g.tok + nxt.pm * 256 + h_ * 128 + R_;
                        asm volatile("global_load_dword %0, %1, off" : "=v"(vN[h_][i_]) : "v"(tp_) : "memory"); } } } }
        for (int t = 0; t < nt; t += 2) {
            const bool last = (t == nt - 2);
            const char* a1 = cA + (size_t)(t + 1) * kstep;
            const char* a2 = last ? nA : cA + (size_t)(t + 2) * kstep; const char* b2 = last ? nB : cB + (size_t)(t + 2) * kstep;
            const char* a3 = a2 + kstep; const char* b3 = b2 + kstep;
            if (last && has_next) S.a_ready(nxt);
            if constexpr (GATHER) { if (last && has_next) {
#pragma unroll
                for (int i_ = 0; i_ < 2; ++i_) { int R_, C_; stage_rc(opq(tid) * 16 + i_ * 8192, R_, C_);
#pragma unroll
                    for (int h_ = 0; h_ < 2; ++h_) { unsigned tk_ = vN[h_][i_]; asm volatile("" : "+v"(tk_)); tk_ = tk_ < (unsigned)g.M ? tk_ : 0u; vN[h_][i_] = tk_ * (unsigned)(lda * 2) + (unsigned)(C_ * 2); } } } }
            PG8_LDB(B0, 0, 0); PG8_LDB(B1, 0, 1); PG8_SCHED; PG8_LDA(At, 0, 0); PG8_STAGE_A(PG8_SA(1, 1), a1, 1, false);
            PG8_WAIT_V(8); PG8_WAIT_L(0); PG8_BAR; PG8_MMA(0, 0, At, B0); PG8_MMA(0, 1, At, B1); PG8_BAR; PG8_SCHED;
            PG8_LDA(At, 0, 1); PG8_STAGE(PG8_SB(0, 0), b2, voffB); PG8_STAGE(PG8_SB(0, 1), b2 + hstepB, voffB); PG8_STAGE_A(PG8_SA(0, 0), a2, 0, last);
            PG8_WAIT_V(8); PG8_WAIT_L(0); PG8_BAR; PG8_MMA(1, 0, At, B0); PG8_MMA(1, 1, At, B1); PG8_BAR; PG8_SCHED;
            PG8_LDB(B0, 1, 0); PG8_LDB(B1, 1, 1); PG8_SCHED; PG8_LDA(At, 1, 0); PG8_STAGE_A(PG8_SA(0, 1), a2, 1, last);
            PG8_WAIT_V(8); PG8_WAIT_L(0); PG8_BAR; PG8_MMA(0, 0, At, B0); PG8_MMA(0, 1, At, B1); PG8_BAR; PG8_SCHED;
            PG8_LDA(At, 1, 1); PG8_STAGE(PG8_SB(1, 0), b3, voffB); PG8_STAGE(PG8_SB(1, 1), b3 + hstepB, voffB); PG8_STAGE_A(PG8_SA(1, 0), a3, 0, last);
            PG8_WAIT_V(8); PG8_WAIT_L(0); PG8_BAR; PG8_MMA(1, 0, At, B0); PG8_MMA(1, 1, At, B1); PG8_BAR; PG8_SCHED;
            if constexpr (GSCALE) { if (t & 2) {
                const PG8_LAS float* cp = (const PG8_LAS float*)(lds + RING_BYTES) + ui * 2048 + (t >> 2) * 256 + wr * 64 + fr; float cv[2][4];
#pragma unroll
                for (int a = 0; a < 2; ++a)
#pragma unroll
                    for (int m = 0; m < 4; ++m) cv[a][m] = cp[a * 128 + m * 16];
#pragma unroll
                for (int a = 0; a < 2; ++a)
#pragma unroll
                    for (int b = 0; b < 2; ++b)
#pragma unroll
                        for (int m = 0; m < 4; ++m)
#pragma unroll
                            for (int n = 0; n < 2; ++n) acc[a][b][m][n] = acc[a][b][m][n] * cv[a][m];
                PG8_SCHED; } }
        }
        if (wr == 0) PG8_BAR;
        E(acc, cur, wr, wc, fr, fq); S.done(cur);
        if (!has_next) break;
#pragma unroll
        for (int a = 0; a < 2; ++a)
#pragma unroll
            for (int b = 0; b < 2; ++b)
#pragma unroll
                for (int m = 0; m < 4; ++m)
#pragma unroll
                    for (int n = 0; n < 2; ++n) acc[a][b][m][n] = (f32x4){0.f, 0.f, 0.f, 0.f};
        cur = nxt; cA = nA; cB = nB; ++ui;
        if constexpr (GATHER) {
#pragma unroll
            for (int h_ = 0; h_ < 2; ++h_) { vG[h_][0] = vN[h_][0]; vG[h_][1] = vN[h_][1]; } }
        if (wr == 1) PG8_BAR;
    }
    PG8_WAIT_V(0);
    PG8_BAR;
#undef PG8_SA
#undef PG8_SB
#undef PG8_STAGE
#undef PG8_STAGE_A
#undef PG8_TOK
#undef PG8_LDA
#undef PG8_LDB
#undef PG8_MMA
#undef PG8_WAIT_V
#undef PG8_WAIT_L
#undef PG8_BAR
#undef PG8_SCHED
}
#endif

struct EpiStoreBf16 {
    __device__ __forceinline__ void pre(const Unit&, LAS unsigned char*, int, int) const {}
    bf16_t* O; int ldc;
    __device__ __forceinline__ void operator()(const f32x4 (&acc)[2][2][4][2], const Unit& u, int wr, int wc, int fr, int fq) const {
        const int row0 = u.pm * 256 + wr * 64 + fr, col0 = u.pn * 256 + wc * 32 + 8 * fq;
#pragma unroll
        for (int ai = 0; ai < 2; ++ai)
#pragma unroll
            for (int m = 0; m < 4; ++m)
#pragma unroll
                for (int bj = 0; bj < 2; ++bj) { const f32x4 v0 = acc[ai][bj][m][0], v1 = acc[ai][bj][m][1];
                    u32x4 w; w.x = pk2(v0[0], v0[1]); w.y = pk2(v0[2], v0[3]); w.z = pk2(v1[0], v1[1]); w.w = pk2(v1[2], v1[3]);
                    *(u32x4*)(O + (size_t)(row0 + ai * 128 + m * 16) * ldc + col0 + bj * 128) = w; }
    }
};
template <int MODE> struct EpiGate {
    const bf16_t* Hg; bf16_t* MGb;
    __device__ __forceinline__ void pre(const Unit&, LAS unsigned char*, int, int) const {}
    __device__ __forceinline__ void operator()(const f32x4 (&acc)[2][2][4][2], const Unit& u, int wr, int wc, int fr, int fq) const {
        const int row0 = u.pm * 256 + wr * 64 + fr, col0 = u.pn * 256 + wc * 32 + 8 * fq;
        u32x4 gw[2][2][2], pw[2][2][2];
#define EG_LOAD(s_) do { const int ai_ = (s_) >> 1, m0_ = 2 * ((s_) & 1); _Pragma("unroll") for (int mm = 0; mm < 2; ++mm) _Pragma("unroll") for (int bj = 0; bj < 2; ++bj) { \
            const int row = row0 + ai_ * 128 + (m0_ + mm) * 16, col = col0 + bj * 128; gw[(s_) & 1][mm][bj] = *(const u32x4*)(Hg + (size_t)row * DINP + col); if (MODE != 0) pw[(s_) & 1][mm][bj] = *(const u32x4*)(MGb + (size_t)row * D + col); } } while (0)
#define EG_COMP(s_) do { const int ai_ = (s_) >> 1, m0_ = 2 * ((s_) & 1); _Pragma("unroll") for (int mm = 0; mm < 2; ++mm) _Pragma("unroll") for (int bj = 0; bj < 2; ++bj) { \
            const int row = row0 + ai_ * 128 + (m0_ + mm) * 16, col = col0 + bj * 128; const f32x4 v0 = acc[ai_][bj][m0_ + mm][0], v1 = acc[ai_][bj][m0_ + mm][1]; \
            float g[8], p[8], v[8] = {v0[0], v0[1], v0[2], v0[3], v1[0], v1[1], v1[2], v1[3]}; unpack8(gw[(s_) & 1][mm][bj], g); \
            if (MODE != 0) { unpack8(pw[(s_) & 1][mm][bj], p); _Pragma("unroll") for (int i = 0; i < 8; ++i) v[i] = p[i] + v[i] * fsigmoid(g[i]); } \
            else { _Pragma("unroll") for (int i = 0; i < 8; ++i) v[i] = v[i] * fsigmoid(g[i]); } \
            *(u32x4*)(MGb + (size_t)row * D + col) = pack8(v); } } while (0)
        EG_LOAD(0); EG_LOAD(1); asm volatile("" ::: "memory");
        EG_COMP(0); asm volatile("" ::: "memory"); EG_LOAD(2); asm volatile("" ::: "memory");
        EG_COMP(1); asm volatile("" ::: "memory"); EG_LOAD(3); asm volatile("" ::: "memory");
        EG_COMP(2); asm volatile("" ::: "memory");
        EG_COMP(3); asm volatile("" ::: "memory");
#undef EG_LOAD
#undef EG_COMP
    }
};
struct EpiResid {
    const float* xp; const float* xs; float* op; float* os;
    float* st;
    __device__ __forceinline__ void pre(const Unit&, LAS unsigned char*, int, int) const {}
    __device__ __forceinline__ void operator()(const f32x4 (&acc)[2][2][4][2], const Unit& u, int wr, int wc, int fr, int fq) const {
        const int row0 = u.pm * 256 + wr * 64 + fr, col0 = u.pn * 256 + wc * 32 + 8 * fq;
        const bool smp = u.pm * 256 >= NP;
        const float* xb = smp ? xs - (size_t)NP * D : xp; float* ob = smp ? os - (size_t)NP * D : op;
        f32x4 xa[2][2][2][2];
#define ER_LOAD(s_) do { const int ai_ = (s_) >> 1, m0_ = 2 * ((s_) & 1); _Pragma("unroll") for (int mm = 0; mm < 2; ++mm) _Pragma("unroll") for (int bj = 0; bj < 2; ++bj) { \
            const float* xi = xb + (size_t)(row0 + ai_ * 128 + (m0_ + mm) * 16) * D + col0 + bj * 128; xa[(s_) & 1][mm][bj][0] = *(const f32x4*)xi; xa[(s_) & 1][mm][bj][1] = *(const f32x4*)(xi + 4); } } while (0)
#define ER_COMP(s_) do { const int ai_ = (s_) >> 1, m0_ = 2 * ((s_) & 1); _Pragma("unroll") for (int mm = 0; mm < 2; ++mm) { float s1 = 0.f, s2 = 0.f; const int row = row0 + ai_ * 128 + (m0_ + mm) * 16; \
            _Pragma("unroll") for (int bj = 0; bj < 2; ++bj) { float* xo = ob + (size_t)row * D + col0 + bj * 128; \
                const f32x4 o0 = xa[(s_) & 1][mm][bj][0] * ALPHA + acc[ai_][bj][m0_ + mm][0], o1 = xa[(s_) & 1][mm][bj][1] * ALPHA + acc[ai_][bj][m0_ + mm][1]; *(f32x4*)xo = o0; *(f32x4*)(xo + 4) = o1; \
                s1 += ((o0[0] + o0[1]) + (o0[2] + o0[3])) + ((o1[0] + o1[1]) + (o1[2] + o1[3])); s2 += ((o0[0] * o0[0] + o0[1] * o0[1]) + (o0[2] * o0[2] + o0[3] * o0[3])) + ((o1[0] * o1[0] + o1[1] * o1[1]) + (o1[2] * o1[2] + o1[3] * o1[3])); } \
            s1 += xshfl<16>(s1); s1 += xshfl<32>(s1); s2 += xshfl<16>(s2); s2 += xshfl<32>(s2); \
            if (fq == 0) { float* sp = st + (size_t)row * 32 + 2 * (u.pn * 4 + wc); sp[0] = s1; sp[1] = s2; } } } while (0)
        ER_LOAD(0); ER_LOAD(1); asm volatile("" ::: "memory");
        ER_COMP(0); asm volatile("" ::: "memory"); ER_LOAD(2); asm volatile("" ::: "memory");
        ER_COMP(1); asm volatile("" ::: "memory"); ER_LOAD(3); asm volatile("" ::: "memory");
        ER_COMP(2); asm volatile("" ::: "memory");
        ER_COMP(3); asm volatile("" ::: "memory");
#undef ER_LOAD
#undef ER_COMP
    }
};
struct EpiSwiglu {
    bf16_t* ACT; const float* bup;
    LAS unsigned char* el;
    __device__ __forceinline__ void pre(const Unit& u, LAS unsigned char* lds, int wid, int lane) const {
        const float* src = bup + (size_t)u.e * 2048 + (wid * 64 + lane) * 4;
#ifdef EMU
        memcpy(lds + RING_BYTES + u.par * 8192 + (wid * 64 + lane) * 16, src, 16);
#else
        __builtin_amdgcn_global_load_lds((const unsigned*)src, (LAS unsigned*)(lds + RING_BYTES + u.par * 8192 + wid * 1024), 16, 0, 0);
#endif
    }
    static __device__ __forceinline__ f32x4 glu4(f32x4 g, f32x4 u1) {
        const f32x4 ga = __builtin_elementwise_min(g, (f32x4){SW_LIMIT, SW_LIMIT, SW_LIMIT, SW_LIMIT});
        const f32x4 ua = __builtin_elementwise_min(__builtin_elementwise_max(u1, (f32x4){1.0f - SW_LIMIT, 1.0f - SW_LIMIT, 1.0f - SW_LIMIT, 1.0f - SW_LIMIT}), (f32x4){1.0f + SW_LIMIT, 1.0f + SW_LIMIT, 1.0f + SW_LIMIT, 1.0f + SW_LIMIT});
        const f32x4 t = ga * (-SW_ALPHA * 1.4426950408889634f); f32x4 e;
        e[0] = __builtin_amdgcn_exp2f(t[0]); e[1] = __builtin_amdgcn_exp2f(t[1]); e[2] = __builtin_amdgcn_exp2f(t[2]); e[3] = __builtin_amdgcn_exp2f(t[3]);
        e = e + 1.0f; f32x4 r;
        r[0] = __builtin_amdgcn_rcpf(e[0]); r[1] = __builtin_amdgcn_rcpf(e[1]); r[2] = __builtin_amdgcn_rcpf(e[2]); r[3] = __builtin_amdgcn_rcpf(e[3]);
        return (ua * ga) * r;
    }
    __device__ __forceinline__ void operator()(const f32x4 (&acc)[2][2][4][2], const Unit& u, int wr, int wc, int fr, int fq) const {
        const int row0_ = u.pm * 256 + wr * 64 + fr, j0 = u.pn * 128 + wc * 32 + 8 * fq;
        const LAS float* bg = (const LAS float*)(el + RING_BYTES + u.par * 8192) + j0; const f32x4 bg0 = *(const LAS f32x4*)bg, bg1 = *(const LAS f32x4*)(bg + 4), bu0 = *(const LAS f32x4*)(bg + 1024) + 1.0f, bu1 = *(const LAS f32x4*)(bg + 1028) + 1.0f;
#pragma unroll
        for (int ai = 0; ai < 2; ++ai)
#pragma unroll
            for (int m = 0; m < 4; ++m) { const int row = row0_ + ai * 128 + m * 16;
                const f32x4 o0 = glu4(acc[ai][0][m][0] + bg0, acc[ai][1][m][0] + bu0), o1 = glu4(acc[ai][0][m][1] + bg1, acc[ai][1][m][1] + bu1);
                u32x4 w; w.x = pk2(o0[0], o0[1]); w.y = pk2(o0[2], o0[3]); w.z = pk2(o1[0], o1[1]); w.w = pk2(o1[2], o1[3]);
                *(u32x4*)(ACT + (size_t)row * D + j0) = w; }
    }
};
struct EpiDown {
    bf16_t* O; const float* bdn; const float* gs;
    LAS unsigned char* el;
    __device__ __forceinline__ void pre(const Unit& u, LAS unsigned char* lds, int wid, int lane) const {
        if (wid > 4) return;
        const float* src = wid < 4 ? bdn + (size_t)u.e * D + (wid * 64 + lane) * 4 : gs + (size_t)u.pm * 256 + lane * 4;
#ifdef EMU
        memcpy(lds + RING_BYTES + u.par * 8192 + (wid * 64 + lane) * 16, src, 16);
#else
        __builtin_amdgcn_global_load_lds((const unsigned*)src, (LAS unsigned*)(lds + RING_BYTES + u.par * 8192 + wid * 1024), 16, 0, 0);
#endif
    }
    __device__ __forceinline__ void operator()(const f32x4 (&acc)[2][2][4][2], const Unit& u, int wr, int wc, int fr, int fq) const {
        const int row0 = u.pm * 256 + wr * 64 + fr, col0 = u.pn * 256 + wc * 32 + 8 * fq;
        float gt[2][4]; f32x4 bv[2][2];
#pragma unroll
        for (int ai = 0; ai < 2; ++ai)
#pragma unroll
            for (int m = 0; m < 4; ++m) gt[ai][m] = ((const LAS float*)(el + RING_BYTES + u.par * 8192) + 1024)[wr * 64 + fr + ai * 128 + m * 16];
#pragma unroll
        for (int bj = 0; bj < 2; ++bj) { const LAS float* bp = (const LAS float*)(el + RING_BYTES + u.par * 8192) + col0 + bj * 128; bv[bj][0] = *(const LAS f32x4*)bp; bv[bj][1] = *(const LAS f32x4*)(bp + 4); }
#pragma unroll
        for (int ai = 0; ai < 2; ++ai) {
#pragma unroll
            for (int bj = 0; bj < 2; ++bj) {
#pragma unroll
                for (int m = 0; m < 4; ++m) { const f32x4 a0 = (acc[ai][bj][m][0] + bv[bj][0]) * gt[ai][m], a1 = (acc[ai][bj][m][1] + bv[bj][1]) * gt[ai][m];
                    u32x4 w; w.x = pk2(a0[0], a0[1]); w.y = pk2(a0[2], a0[3]); w.z = pk2(a1[0], a1[1]); w.w = pk2(a1[2], a1[3]);
                    *(u32x4*)(O + (size_t)(row0 + ai * 128 + m * 16) * D + col0 + bj * 128) = w; } }
            asm volatile("" ::: "memory");
        }
    }
};
}

#ifndef EMU
#define XB_TMO      128
#define XB_XCNT(j)  (256  + 64 * (j))
#define XB_XSUB(j)  (1280 + 64 * (j))
#define XB_XGEN(j)  (2304 + 64 * (j))
#define XB_TOP      3328
#define XB_TOPGEN   3392
#define XCD_BAR_WORDS 3456
#define XB_SPIN_CAP (1u << 27)
__device__ __forceinline__ unsigned xb_ld(unsigned* p)              { return __hip_atomic_load(p, __ATOMIC_RELAXED, __HIP_MEMORY_SCOPE_AGENT); }
__device__ __forceinline__ unsigned xb_add(unsigned* p, unsigned v) { return __hip_atomic_fetch_add(p, v, __ATOMIC_RELAXED, __HIP_MEMORY_SCOPE_AGENT); }
__device__ __forceinline__ unsigned xb_xcc_id() { return (unsigned)__builtin_amdgcn_s_getreg((3 << 11) | 20) & 0xFu; }
#define XB_SPIN(cond, bar) do { unsigned _sp = 0; while (cond) { __builtin_amdgcn_s_sleep(1); \
    if ((++_sp & 255u) == 0u) { if (xb_ld(&(bar)[XB_TMO])) break; if (_sp > XB_SPIN_CAP) { atomicAdd(&(bar)[XB_TMO], 1u); break; } } } } while (0)
struct XcdBarrier { unsigned* bar; unsigned x; volatile LAS unsigned* st; };
__device__ __forceinline__ XcdBarrier xcd_barrier_post(unsigned* bar, volatile LAS unsigned* st) {
    XcdBarrier b; b.bar = bar; b.x = xb_xcc_id(); b.st = st;
    if (threadIdx.x == 0) (void)xb_add(&bar[XB_XCNT(b.x)], 1u);
    return b;
}
__device__ __forceinline__ void xcd_barrier_complete(unsigned* bar, unsigned x, unsigned& nloc, unsigned& nx) {
    const unsigned G = gridDim.x * gridDim.y * gridDim.z;
    unsigned sum, cnt, mine, sp = 0u;
    for (;;) {
        sum = 0u; cnt = 0u; mine = 0u;
#pragma unroll
        for (unsigned j = 0; j < 16; ++j) { const unsigned c = xb_ld(&bar[XB_XCNT(j)]); sum += c; cnt += (c > 0u) ? 1u : 0u; mine = (j == x) ? c : mine; }
        if (sum == G) break;
        __builtin_amdgcn_s_sleep(1);
        if ((++sp & 255u) == 0u) { if (xb_ld(&bar[XB_TMO])) break; if (sp > XB_SPIN_CAP) { atomicAdd(&bar[XB_TMO], 1u); break; } }
    }
    nloc = mine > 0u ? mine : 1u; nx = cnt > 0u ? cnt : 1u;
}
__device__ __forceinline__ void xcd_barrier(const XcdBarrier& b) {
    asm volatile("s_waitcnt vmcnt(0)" ::: "memory");
    __syncthreads();
    if (threadIdx.x == 0) {
        unsigned* bar = b.bar;
        __builtin_amdgcn_s_waitcnt(0);
        unsigned nloc = b.st[0], nx = b.st[1];
        if (nloc == 0u) { xcd_barrier_complete(bar, b.x, nloc, nx); b.st[0] = nloc; b.st[1] = nx; }
        const unsigned old = xb_add(&bar[XB_XSUB(b.x)], 1u);
        const unsigned gen = old / nloc;
        if (old + 1u == (gen + 1u) * nloc) {
            __builtin_amdgcn_fence(__ATOMIC_RELEASE, "agent");
            asm volatile("s_waitcnt vmcnt(0)" ::: "memory");
            const unsigned og = xb_add(&bar[XB_TOP], 1u);
            const unsigned tg = og / nx;
            if (og + 1u == (tg + 1u) * nx) xb_add(&bar[XB_TOPGEN], 1u);
            else XB_SPIN(xb_ld(&bar[XB_TOPGEN]) == tg, bar);
            __builtin_amdgcn_fence(__ATOMIC_ACQUIRE, "agent");
            xb_add(&bar[XB_XGEN(b.x)], 1u);
            asm volatile("s_waitcnt vmcnt(0)" ::: "memory");
        } else {
            XB_SPIN(xb_ld(&bar[XB_XGEN(b.x)]) == gen, bar);
            __builtin_amdgcn_fence(__ATOMIC_ACQUIRE, "agent");
            asm volatile("s_waitcnt vmcnt(0)" ::: "memory");
        }
    }
    __syncthreads();
}
#endif

struct Args { const float* in[31]; float* out; unsigned char* ws; int lo, hi; };
typedef const float* FPtr;
#ifdef EMU
typedef const FPtr* ArgTab;
#else
typedef const __attribute__((address_space(4))) FPtr* ArgTab;
#endif
struct Frame {
    LAS unsigned char* lds; int tid, lane, wave, G, bid;
    ArgTab in; float* out; unsigned char* ws; unsigned* ctl;
};
enum { I_XP = 0, I_XS, I_CK, I_CV, I_SST, I_SCV, I_SSC, I_WIN, I_CONVW, I_CONVB, I_DTB, I_ALOG, I_SD, I_NORMW, I_WSSD, I_SINK, I_WATT, I_RELB, I_SCW, I_WSC, I_WO, I_LN1G, I_LN1B,
       I_RW, I_RB, I_WUP, I_BUP, I_WDN, I_BDN, I_LN2G, I_LN2B };

__device__ __forceinline__ bf16_t* ws_bf(const Frame& F, size_t off) { return (bf16_t*)(F.ws + off); }
__device__ __forceinline__ float* ws_f(const Frame& F, size_t off) { return (float*)(F.ws + off); }
__device__ __forceinline__ bf16_t* wl_ptr(const Frame& F, int layer, size_t off) { return (bf16_t*)(F.ws + WS_W + (size_t)layer * WL_BYTES + off); }

__device__ __forceinline__ void wt_item(const float* W, int ldw, int K, int k0, int nsrc0, const float* kscale, bf16_t* WT, int ndst0, LAS float* scr, int lane) {
    if (nsrc0 < 0) {
#pragma unroll
        for (int j = 0; j < 4; ++j) { const int n = (lane >> 3) + 8 * j; *(u32x4*)(WT + (size_t)(ndst0 + n) * K + k0 + 8 * (lane & 7)) = (u32x4){0u, 0u, 0u, 0u}; }
        return;
    }
#pragma unroll 8
    for (int i = 0; i < 32; ++i) { const int kk = 2 * i + (lane >> 5); float v = W[(size_t)(k0 + kk) * ldw + nsrc0 + (lane & 31)]; if (kscale) v *= kscale[k0 + kk]; scr[kk * 33 + (lane & 31)] = v; }
    WAVE_SYNC();
    const int c = lane & 7;
#pragma unroll
    for (int j = 0; j < 4; ++j) { const int n = (lane >> 3) + 8 * j; const LAS float* s = scr + (8 * c) * 33 + n;
        u32x4 o; o.x = pk2(s[0 * 33], s[1 * 33]); o.y = pk2(s[2 * 33], s[3 * 33]); o.z = pk2(s[4 * 33], s[5 * 33]); o.w = pk2(s[6 * 33], s[7 * 33]);
        *(u32x4*)(WT + (size_t)(ndst0 + n) * K + k0 + 8 * c) = o; }
    WAVE_SYNC();
}
__device__ __forceinline__ void step_weights(const Frame& F) {
    LAS float* scr = (LAS float*)(F.lds + F.wave * 16384);
    const int gw = F.bid * NWAVES + F.wave, NGW = F.G * NWAVES;
    constexpr int I_IN = (DINP / 32) * (D / 64), I_SSD = (D / 32) * (DINNER / 64), I_SQ = (D / 32) * (D / 64), I_UP = NEXP * (2048 / 32) * (D / 64), I_DN = NEXP * (D / 32) * (D / 64);
    constexpr int PER_LAYER = I_IN + I_SSD + 3 * I_SQ + I_UP + I_DN;
    for (int it = gw; it < DEPTH * PER_LAYER; it += NGW) {
        const int layer = it / PER_LAYER; int r = it % PER_LAYER;
        if (r < I_IN) { const int nb = r / (D / 64), kb = r % (D / 64), n0 = nb * 32;
            const int ns = n0 < 6144 ? n0 : (n0 < 13824 ? n0 + 32 : (n0 < 13856 ? n0 - 13824 + 6144 : -1));
            wt_item(F.in[I_WIN] + (size_t)layer * D * DIN, DIN, D, kb * 64, ns, nullptr, wl_ptr(F, layer, WL_IN), n0, scr, F.lane); continue; }
        r -= I_IN;
        if (r < I_SSD) { const int nb = r / (DINNER / 64), kb = r % (DINNER / 64);
            wt_item(F.in[I_WSSD] + (size_t)layer * DINNER * D, D, DINNER, kb * 64, nb * 32, F.in[I_NORMW] + (size_t)layer * DINNER, wl_ptr(F, layer, WL_SSD), nb * 32, scr, F.lane); continue; }
        r -= I_SSD;
        if (r < I_SQ) { const int nb = r / (D / 64), kb = r % (D / 64); wt_item(F.in[I_WATT] + (size_t)layer * D * D, D, D, kb * 64, nb * 32, nullptr, wl_ptr(F, layer, WL_ATT), nb * 32, scr, F.lane); continue; }
        r -= I_SQ;
        if (r < I_SQ) { const int nb = r / (D / 64), kb = r % (D / 64); wt_item(F.in[I_WSC] + (size_t)layer * D * D, D, D, kb * 64, nb * 32, nullptr, wl_ptr(F, layer, WL_SC), nb * 32, scr, F.lane); continue; }
        r -= I_SQ;
        if (r < I_SQ) { const int nb = r / (D / 64), kb = r % (D / 64); wt_item(F.in[I_WO] + (size_t)layer * D * D, D, D, kb * 64, nb * 32, nullptr, wl_ptr(F, layer, WL_O), nb * 32, scr, F.lane); continue; }
        r -= I_SQ;
        if (r < I_UP) { const int e = r / ((2048 / 32) * (D / 64)), q = r % ((2048 / 32) * (D / 64)), nb = q / (D / 64), kb = q % (D / 64), n0 = nb * 32;
            const int pn = n0 >> 8, bj = (n0 >> 7) & 1, jj = n0 & 127, ns = bj * 1024 + pn * 128 + jj;
            wt_item(F.in[I_WUP] + ((size_t)layer * NEXP + e) * D * 2048, 2048, D, kb * 64, ns, nullptr, wl_ptr(F, layer, WL_UP) + (size_t)e * 2048 * D, n0, scr, F.lane); continue; }
        r -= I_UP;
        { const int e = r / ((D / 32) * (D / 64)), q = r % ((D / 32) * (D / 64)), nb = q / (D / 64), kb = q % (D / 64);
            wt_item(F.in[I_WDN] + ((size_t)layer * NEXP + e) * D * D, D, D, kb * 64, nb * 32, nullptr, wl_ptr(F, layer, WL_DN) + (size_t)e * D * D, nb * 32, scr, F.lane); }
    }
}

__device__ __forceinline__ const float* x_in_row(const Frame& F, int layer, int mb, int r) {
    if (layer == 0) return r < NP ? F.in[I_XP] + ((size_t)mb * NP + r) * D : F.in[I_XS] + (size_t)(r - NP) * D;
    return r < NP ? F.out + O_YP + ((size_t)mb * NP + r) * D : F.out + O_YS + (size_t)(r - NP) * D;
}
__device__ __forceinline__ float* x_out_row(const Frame& F, int mb, int r) { return r < NP ? F.out + O_YP + ((size_t)mb * NP + r) * D : F.out + O_YS + (size_t)(r - NP) * D; }
__device__ __forceinline__ int rows_of(int mb) { return mb == 0 ? R : NP; }

__device__ __forceinline__ void step_xb(const Frame& F, int mb) {
    const int gw = F.bid * NWAVES + F.wave, NGW = F.G * NWAVES, nr = rows_of(mb);
    bf16_t* XB = ws_bf(F, WS_XB0) + (size_t)mb * R * D;
    for (int r = gw; r < nr; r += NGW) {
        const f32x4* xr = (const f32x4*)x_in_row(F, 0, mb, r) + F.lane; u32x2* o = (u32x2*)(XB + (size_t)r * D) + F.lane;
#pragma unroll
        for (int j = 0; j < 4; ++j) { const f32x4 v = xr[64 * j]; u32x2 w; w.x = pk2(v[0], v[1]); w.y = pk2(v[2], v[3]); o[64 * j] = w; }
    }
}

__device__ __forceinline__ float softplus_f(float x) { const float e = fexp(x); return x > 20.f ? x : (e < 0.01f ? e * (1.0f - e * (0.5f - e * 0.33333333f)) : __builtin_amdgcn_logf(1.0f + e) * 0.69314718056f); }
constexpr int S128 = 136, S64 = 72;
constexpr int BL_BM = 0, BL_CM = BL_BM + 64 * S128 * 2, BL_CB = BL_CM + 64 * S128 * 2, BL_END = BL_CB + 64 * S64 * 2;
struct BcRegs { u32x4 raw[7]; f32x4 wq[4][2], bq[2]; };
__device__ __forceinline__ void ssd_bc_load(const Frame& F, int layer, int u, BcRegs& R_) {
    const int sl = (u / NCHUNK) % NSEQ_MB, ck = u % NCHUNK, g = u / (NCHUNK * NSEQ_MB); const int tid = F.tid;
    const bf16_t* H = ws_bf(F, WS_H) + (size_t)sl * SEQ * DINP; const int cgi = tid & 31, rb = tid >> 5; const int xc = (cgi < 16 ? 2048 : 3072) + g * 128 + 8 * (cgi & 15);
#pragma unroll
    for (int i = 0; i < 7; ++i) { const int t = ck * 64 + 4 * rb - 3 + i; R_.raw[i] = t >= 0 ? *(const u32x4*)(H + (size_t)t * DINP + C_X + xc) : (u32x4){0u, 0u, 0u, 0u}; }
    const float* convw = F.in[I_CONVW] + (size_t)layer * 4 * CONVDIM + xc; const float* convb = F.in[I_CONVB] + (size_t)layer * CONVDIM + xc;
#pragma unroll
    for (int tp = 0; tp < 4; ++tp) { R_.wq[tp][0] = *(const f32x4*)(convw + tp * CONVDIM); R_.wq[tp][1] = *(const f32x4*)(convw + tp * CONVDIM + 4); }
    R_.bq[0] = *(const f32x4*)convb; R_.bq[1] = *(const f32x4*)(convb + 4);
}
__device__ __forceinline__ void ssd_bc_unit(const Frame& F, int u, const BcRegs& R_) {
    const int sl = (u / NCHUNK) % NSEQ_MB, ck = u % NCHUNK, g = u / (NCHUNK * NSEQ_MB);
    const int tid = F.tid, lane = F.lane, w = F.wave, fr = lane & 15, fq = lane >> 4;
    LAS bf16_t* Bm = (LAS bf16_t*)(F.lds + BL_BM); LAS bf16_t* Cm = (LAS bf16_t*)(F.lds + BL_CM); LAS bf16_t* CBs = (LAS bf16_t*)(F.lds + BL_CB);
    const size_t rowg = (size_t)sl * SEQ + (size_t)ck * 64; const size_t tix = ((size_t)sl * NCHUNK + ck) * 8 + g;
    const int cgi = tid & 31, rb = tid >> 5; const bool isB = cgi < 16; const int n0 = 8 * (cgi & 15);
    const u32x4 (&raw)[7] = R_.raw; const f32x4 (&wq)[4][2] = R_.wq; const f32x4 (&bq)[2] = R_.bq;
    __syncthreads();
    { float val[4][8];
#pragma unroll
      for (int r = 0; r < 4; ++r) { float a[8] = {bq[0][0], bq[0][1], bq[0][2], bq[0][3], bq[1][0], bq[1][1], bq[1][2], bq[1][3]};
#pragma unroll
          for (int tp = 0; tp < 4; ++tp) { float f[8]; unpack8(raw[r + tp], f);
#pragma unroll
              for (int i = 0; i < 4; ++i) { a[i] += f[i] * wq[tp][0][i]; a[4 + i] += f[4 + i] * wq[tp][1][i]; } }
#pragma unroll
          for (int i = 0; i < 8; ++i) val[r][i] = fsilu(a[i]); }
      if (isB) { bf16_t* bt = ws_bf(F, WS_BTG) + tix * 8192 + (size_t)n0 * 64 + 4 * rb;
#pragma unroll
          for (int r = 0; r < 4; ++r) *(LAS u32x4*)(Bm + (4 * rb + r) * S128 + n0) = pack8(val[r]);
#pragma unroll
          for (int i = 0; i < 8; ++i) { u32x2 wv; wv.x = pk2(val[0][i], val[1][i]); wv.y = pk2(val[2][i], val[3][i]); *(u32x2*)(bt + (size_t)i * 64) = wv; } }
      else { bf16_t* cmc = ws_bf(F, WS_CMC) + (rowg + 4 * rb) * 1024 + g * 128 + n0;
#pragma unroll
          for (int r = 0; r < 4; ++r) { const u32x4 pk = pack8(val[r]); *(LAS u32x4*)(Cm + (4 * rb + r) * S128 + n0) = pk; *(u32x4*)(cmc + (size_t)r * 1024) = pk; } } }
    __syncthreads();
    { const int ti = w >> 1;
#pragma unroll
      for (int jj = 0; jj < 2; ++jj) { const int tj = 2 * (w & 1) + jj; f32x4 cb = (f32x4){0.f, 0.f, 0.f, 0.f};
          if (tj <= ti) {
#pragma unroll
              for (int ks = 0; ks < 4; ++ks) { const bf16x8 a = *(const LAS bf16x8*)(Cm + (16 * ti + fr) * S128 + 32 * ks + 8 * fq); const bf16x8 b = *(const LAS bf16x8*)(Bm + (16 * tj + fr) * S128 + 32 * ks + 8 * fq);
                  cb = __builtin_amdgcn_mfma_f32_16x16x32_bf16(a, b, cb, 0, 0, 0); } }
#pragma unroll
          for (int r = 0; r < 4; ++r) CBs[(16 * ti + 4 * fq + r) * S64 + 16 * tj + fr] = bf1(cb[r]); } }
    __syncthreads();
    { const int row = tid >> 3, cc = tid & 7; *(u32x4*)(ws_bf(F, WS_CBG) + tix * 4096 + row * 64 + 8 * cc) = *(const LAS u32x4*)(CBs + row * S64 + 8 * cc); }
}

constexpr int SL_CM = 0, SL_BT = SL_CM + 64 * S128 * 2, SL_CB = SL_BT + 128 * S64 * 2, SL_DMA_SZ = SL_CB + 64 * S64 * 2, SL_DMA_END = 2 * SL_DMA_SZ;
constexpr int SL_XT = SL_DMA_END, SL_XTW = SL_XT + 2 * 64 * S64 * 2, SL_MM = SL_XTW + 2 * 64 * S64 * 2, SL_SM = SL_MM + 2 * 64 * S64 * 2, SL_END = SL_SM + 3 * 384 * 4;
static_assert(SL_END <= SCR_BYTES && SL_DMA_SZ == 2816 * 16, "ssd LDS map");
#ifdef EMU
#define SSD_DMA_ONE(gp_, dst_) memcpy((unsigned char*)(dst_) + lane * 16, (gp_), 16)
#else
#define SSD_DMA_ONE(gp_, dst_) __builtin_amdgcn_global_load_lds((const unsigned*)(gp_), (LAS unsigned*)(dst_), 16, 0, 0)
#endif
#define SSD_DMA_SETUP() do { _Pragma("unroll") for (int j_ = 0; j_ < 6; ++j_) { const int pc_ = w * 6 + j_; const int q_ = pc_ * 64 + lane; const size_t tx0_ = ((size_t)sl * NCHUNK) * 8 + g; \
        if (pc_ < 17) { const int r_ = q_ / 17; int c_ = q_ % 17; c_ = c_ < 16 ? c_ : 15; dsrc[j_] = cmc + (size_t)r_ * 1024 + 8 * c_; } \
        else if (pc_ < 35) { const int q2_ = q_ - 1088, r_ = q2_ / 9; int c_ = q2_ % 9; c_ = c_ < 8 ? c_ : 7; dsrc[j_] = btg + tx0_ * 8192 + r_ * 64 + 8 * c_; } \
        else { const int q3_ = q_ - 2240, r_ = q3_ / 9; int c_ = q3_ % 9; c_ = c_ < 8 ? c_ : 7; dsrc[j_] = cbg + tx0_ * 4096 + r_ * 64 + 8 * c_; } } } while (0)
#define SSD_DMA2(ca_, cb_) do { _Pragma("unroll") for (int j_ = 0; j_ < 6; ++j_) { const int pc_ = w * 6 + j_; \
        if (pc_ < 35) { if ((ca_) < NCHUNK) { SSD_DMA_ONE(dsrc[j_], L + ((ca_) & 1) * SL_DMA_SZ + SL_CM + pc_ * 1024); dsrc[j_] += pc_ < 17 ? (size_t)64 * 1024 : (size_t)8 * 8192; } } \
        else if (pc_ < 44) { if ((cb_) < NCHUNK) { SSD_DMA_ONE(dsrc[j_], L + ((cb_) & 1) * SL_DMA_SZ + SL_CM + pc_ * 1024); dsrc[j_] += (size_t)8 * 4096; } } } } while (0)
#define SSD_TABLE(tb_, dtr_) do { const float dt_ = softplus_f(bf2f(dtr_) + dtb); \
        const float cs_ = wave_scan_incl(Ah * dt_, lane); \
        const float tot_ = wave_last(cs_); (tb_)[lane] = dt_; (tb_)[64 + lane] = cs_; (tb_)[128 + lane] = fexp(tot_ - cs_); (tb_)[192 + lane] = fexp(cs_); if (lane == 0) (tb_)[256] = fexp(tot_); (tb_)[320 + lane] = Dh * __builtin_amdgcn_rcpf(dt_); } while (0)

__device__ __forceinline__ void ssd_prompt_unit(const Frame& F, int layer, int mb, int sl, int hd) {
    const int tid = F.tid, lane = F.lane, w = F.wave, fr = lane & 15, fq = lane >> 4;
    LAS unsigned char* L = F.lds;
    LAS bf16_t* XT0 = (LAS bf16_t*)(L + SL_XT); LAS bf16_t* XTW0 = (LAS bf16_t*)(L + SL_XTW); LAS bf16_t* Mm0 = (LAS bf16_t*)(L + SL_MM);
    LAS float* smb = (LAS float*)(L + SL_SM);
    const int g = hd >> 2;
    bf16_t* H = ws_bf(F, WS_H) + (size_t)sl * SEQ * DINP;
    const bf16_t* cmc = ws_bf(F, WS_CMC) + (size_t)sl * SEQ * 1024 + g * 128; const bf16_t* btg = ws_bf(F, WS_BTG); const bf16_t* cbg = ws_bf(F, WS_CBG);
    __syncthreads();
    const bf16_t* dsrc[6]; SSD_DMA_SETUP();
    SSD_DMA2(NCHUNK, 0);
    if (w < 4) {
        const int pb = w;
        f32x4 St[8];
#pragma unroll
        for (int t = 0; t < 8; ++t) St[t] = (f32x4){0.f, 0.f, 0.f, 0.f};
        bf16_t* pz = H + (size_t)fr * DINP + C_Z + hd * 64 + 16 * pb + 4 * fq; float* pss = ws_f(F, WS_SSQ) + ((size_t)sl * SEQ + fr) * 128 + hd * 4 + pb;
        u32x2 zraw[4];
        VM_WAIT(0); __syncthreads();
        for (int it = -1; it < NCHUNK; ++it) {
            u32x2 zc[4];
#pragma unroll
            for (int lb = 0; lb < 4; ++lb) zc[lb] = zraw[lb];
            SSD_DMA2(it + 1, it + 2);
            if (it + 1 < NCHUNK) {
#pragma unroll
                for (int lb = 0; lb < 4; ++lb) zraw[lb] = *(const u32x2*)(pz + (size_t)(it >= 0 ? 64 : 0) * DINP + (size_t)lb * 16 * DINP); }
            asm volatile("" ::: "memory");
            if (it >= 0) { const int par = it & 1; LAS float* sm = smb + (it % 3) * 384;
                LAS bf16_t* Cm = (LAS bf16_t*)(L + par * SL_DMA_SZ + SL_CM); LAS bf16_t* BT = (LAS bf16_t*)(L + par * SL_DMA_SZ + SL_BT);
                LAS bf16_t* XT = XT0 + par * 64 * S64; LAS bf16_t* XTW = XTW0 + par * 64 * S64; LAS bf16_t* Mm = Mm0 + par * 64 * S64;
                bf16x8 sa[4];
#pragma unroll
                for (int ks = 0; ks < 4; ++ks) { u32x4 wv; wv.x = pk2(St[2 * ks][0], St[2 * ks][1]); wv.y = pk2(St[2 * ks][2], St[2 * ks][3]); wv.z = pk2(St[2 * ks + 1][0], St[2 * ks + 1][1]); wv.w = pk2(St[2 * ks + 1][2], St[2 * ks + 1][3]);
                    sa[ks] = __builtin_bit_cast(bf16x8, wv); }
                f32x4 yo[4];
#pragma unroll
                for (int lb = 0; lb < 4; ++lb) yo[lb] = (f32x4){0.f, 0.f, 0.f, 0.f};
#pragma unroll
                for (int ks = 0; ks < 4; ++ks)
#pragma unroll
                    for (int lb = 0; lb < 4; ++lb) { const LAS bf16_t* cp = Cm + (16 * lb + fr) * S128 + 32 * ks + 4 * fq; const u32x2 c0 = *(const LAS u32x2*)cp, c1 = *(const LAS u32x2*)(cp + 16);
                        u32x4 cw; cw.x = c0.x; cw.y = c0.y; cw.z = c1.x; cw.w = c1.y; yo[lb] = __builtin_amdgcn_mfma_f32_16x16x32_bf16(sa[ks], __builtin_bit_cast(bf16x8, cw), yo[lb], 0, 0, 0); }
                { const float cd = sm[256]; bf16x8 bx[2];
#pragma unroll
                  for (int ks = 0; ks < 2; ++ks) bx[ks] = *(const LAS bf16x8*)(XTW + (16 * pb + fr) * S64 + 32 * ks + 8 * fq);
#pragma unroll
                  for (int t = 0; t < 8; ++t) St[t] = St[t] * cd;
#pragma unroll
                  for (int ks = 0; ks < 2; ++ks)
#pragma unroll
                    for (int t = 0; t < 8; ++t) { const bf16x8 a = *(const LAS bf16x8*)(BT + (16 * t + fr) * S64 + 32 * ks + 8 * fq); St[t] = __builtin_amdgcn_mfma_f32_16x16x32_bf16(a, bx[ks], St[t], 0, 0, 0); } }
                { bf16x8 xa[2];
#pragma unroll
                  for (int ks = 0; ks < 2; ++ks) xa[ks] = *(const LAS bf16x8*)(XT + (16 * pb + fr) * S64 + 32 * ks + 8 * fq);
                  f32x4 ydv[4];
#pragma unroll
                  for (int lb = 0; lb < 4; ++lb) ydv[lb] = (f32x4){0.f, 0.f, 0.f, 0.f};
#pragma unroll
                  for (int ks = 0; ks < 2; ++ks)
#pragma unroll
                    for (int lb = 0; lb < 4; ++lb) { const bf16x8 b = *(const LAS bf16x8*)(Mm + (16 * lb + fr) * S64 + 32 * ks + 8 * fq); ydv[lb] = __builtin_amdgcn_mfma_f32_16x16x32_bf16(xa[ks], b, ydv[lb], 0, 0, 0); }
#pragma unroll
                  for (int lb = 0; lb < 4; ++lb) { const f32x4 yd = ydv[lb];
                    const float ec = sm[192 + 16 * lb + fr]; const float z[4] = {blo(zc[lb].x), bhi(zc[lb].x), blo(zc[lb].y), bhi(zc[lb].y)}; float v[4], ss = 0.f;
#pragma unroll
                    for (int r = 0; r < 4; ++r) { v[r] = (yd[r] + ec * yo[lb][r]) * fsilu(z[r]); ss += v[r] * v[r]; }
                    u32x2 ov; ov.x = pk2(v[0], v[1]); ov.y = pk2(v[2], v[3]); *(u32x2*)(pz + (size_t)lb * 16 * DINP) = ov;
                    ss += xshfl<16>(ss); ss += xshfl<32>(ss);
                    pss[(size_t)lb * 16 * 128] = ss; } }
                pz += (size_t)64 * DINP; pss += 64 * 128; }
            if (it < 0) VM_WAIT(0); else VM_WAIT(7);
#ifndef EMU
            asm volatile("" : "+v"(zraw[0].x), "+v"(zraw[0].y), "+v"(zraw[1].x), "+v"(zraw[1].y), "+v"(zraw[2].x), "+v"(zraw[2].y), "+v"(zraw[3].x), "+v"(zraw[3].y));
#endif
            LBAR();
        }
        float* so = F.out + O_SSP + ((((size_t)layer * BATCH + mb * NSEQ_MB + sl) * 32 + hd) * 64) * 128;
#pragma unroll
        for (int t = 0; t < 8; ++t) *(f32x4*)(so + (size_t)(16 * pb + fr) * 128 + 16 * t + 4 * fq) = St[t];
    } else {
        const int pw = w - 4, pt = tid - 256;
        const float* convw = F.in[I_CONVW] + (size_t)layer * 4 * CONVDIM + hd * 64; const float* convb = F.in[I_CONVB] + (size_t)layer * CONVDIM + hd * 64;
        const float cw0 = convw[lane], cw1 = convw[CONVDIM + lane], cw2 = convw[2 * CONVDIM + lane], cw3 = convw[3 * CONVDIM + lane], cwb = convb[lane];
        const float dtb = F.in[I_DTB][layer * 32 + hd], Ah = -fexp(F.in[I_ALOG][layer * 32 + hd]), Dh = F.in[I_SD][layer * 32 + hd];
        const int ml = pt >> 2, ms0 = 16 * (pt & 3);
        unsigned rawx[19]; unsigned dtr_next = 0u;
#pragma unroll
        for (int i = 0; i < 19; ++i) { const int t_ = 16 * pw - 3 + i; rawx[i] = t_ >= 0 ? (unsigned)H[(size_t)t_ * DINP + C_X + hd * 64 + lane] : 0u; }
        if (pw == 3) { const unsigned d0 = H[(size_t)lane * DINP + C_DT + hd]; if (NCHUNK > 1) dtr_next = H[(size_t)(64 + lane) * DINP + C_DT + hd]; SSD_TABLE(smb, d0); }
        VM_WAIT(0); __syncthreads();
        for (int it = -1; it < NCHUNK; ++it) { const int pc = it + 1;
            SSD_DMA2(it + 1, it + 2);
            const unsigned dtr_cur = dtr_next;
            if (pc < NCHUNK) { const int par = pc & 1; LAS float* sm = smb + (pc % 3) * 384; const LAS bf16_t* CBl = (const LAS bf16_t*)(L + par * SL_DMA_SZ + SL_CB);
                LAS bf16_t* XT = XT0 + par * 64 * S64; LAS bf16_t* XTW = XTW0 + par * 64 * S64; LAS bf16_t* Mm = Mm0 + par * 64 * S64;
                { float xr[19];
#pragma unroll
                  for (int i = 0; i < 19; ++i) xr[i] = blo(rawx[i]);
                  if (pc + 1 < NCHUNK) { const bf16_t* px_ = H + ((size_t)(pc + 1) * 64 + 16 * pw - 3) * DINP + C_X + hd * 64 + lane;
#pragma unroll
                      for (int i = 0; i < 19; ++i) rawx[i] = (unsigned)px_[(size_t)i * DINP]; }
                  if (pw == 3 && pc + 2 < NCHUNK) dtr_next = H[((size_t)(pc + 2) * 64 + lane) * DINP + C_DT + hd];
                  asm volatile("" ::: "memory");
#pragma unroll
                  for (int hq = 0; hq < 2; ++hq) { const f32x4 d0 = *(const LAS f32x4*)(sm + 16 * pw + 8 * hq), d1 = *(const LAS f32x4*)(sm + 16 * pw + 8 * hq + 4), e0 = *(const LAS f32x4*)(sm + 128 + 16 * pw + 8 * hq), e1 = *(const LAS f32x4*)(sm + 128 + 16 * pw + 8 * hq + 4);
                      const float dtv[8] = {d0[0], d0[1], d0[2], d0[3], d1[0], d1[1], d1[2], d1[3]}, wdv[8] = {e0[0], e0[1], e0[2], e0[3], e1[0], e1[1], e1[2], e1[3]}; float xa[8], xb[8];
#pragma unroll
                      for (int r = 0; r < 8; ++r) { const int q = 8 * hq + r; const float xd = fsilu(cwb + xr[q] * cw0 + xr[q + 1] * cw1 + xr[q + 2] * cw2 + xr[q + 3] * cw3) * dtv[r]; xa[r] = xd; xb[r] = xd * wdv[r]; }
                      *(LAS u32x4*)(XT + lane * S64 + 16 * pw + 8 * hq) = pack8(xa); *(LAS u32x4*)(XTW + lane * S64 + 16 * pw + 8 * hq) = pack8(xb); } }
#pragma unroll
                for (int hq = 0; hq < 2; ++hq) { const int s0 = ms0 + 8 * hq; float mv[8];
                    if (s0 <= ml) { float cbv[8]; unpack8(*(const LAS u32x4*)(CBl + ml * S64 + s0), cbv); const float al = sm[64 + ml]; const f32x4 a0 = *(const LAS f32x4*)(sm + 64 + s0), a1 = *(const LAS f32x4*)(sm + 64 + s0 + 4);
#pragma unroll
                        for (int i = 0; i < 4; ++i) { mv[i] = (ml >= s0 + i) ? cbv[i] * fexp(fminf(al - a0[i], 0.f)) : 0.f; mv[4 + i] = (ml >= s0 + 4 + i) ? cbv[4 + i] * fexp(fminf(al - a1[i], 0.f)) : 0.f; }
                        if ((ml >> 3) == (s0 >> 3)) { const float dd = sm[320 + ml];
#pragma unroll
                            for (int i = 0; i < 8; ++i) if (i == (ml & 7)) mv[i] += dd; } }
                    else {
#pragma unroll
                        for (int i = 0; i < 8; ++i) mv[i] = 0.f; }
                    *(LAS u32x4*)(Mm + ml * S64 + s0) = pack8(mv); } }
            if (pw == 3 && it + 2 < NCHUNK) { LAS float* smn = smb + ((it + 2) % 3) * 384; SSD_TABLE(smn, dtr_cur); }
            VM_WAIT(0);
#ifndef EMU
#pragma unroll
            for (int i = 0; i < 19; ++i) asm volatile("" : "+v"(rawx[i]));
            asm volatile("" : "+v"(dtr_next));
#endif
            LBAR();
        }
    }
    VM_WAIT(0); __syncthreads();
}

__device__ __forceinline__ void ssd_sample_unit(const Frame& F, int layer, int sq, int hd) {
    const int tid = F.tid, lane = F.lane; LAS float* L = (LAS float*)F.lds;
    LAS float* xs = L; LAS float* Bs = L + 16 * 64; LAS float* Cs = Bs + 16 * 128; LAS float* dts = Cs + 16 * 128; LAS float* das = dts + 16; LAS float* Yl = das + 16;
    const int g = hd >> 2;
    bf16_t* H = ws_bf(F, WS_H) + (size_t)(NP + sq * 16) * DINP;
    const float* hist = F.in[I_SCV] + ((size_t)layer * DECB + sq) * 3 * CONVDIM;
    const float* convw = F.in[I_CONVW] + (size_t)layer * 4 * CONVDIM; const float* convb = F.in[I_CONVB] + (size_t)layer * CONVDIM;
    const int p = tid >> 3, n0 = (tid & 7) * 16;
    const size_t sbase = ((((size_t)layer * DECB + sq) * 32 + hd) * 64 + p) * 128 + n0;
    float S[16];
#pragma unroll
    for (int i = 0; i < 16; ++i) S[i] = F.in[I_SST][sbase + i];
    bf16_t zr[2];
#pragma unroll
    for (int j = 0; j < 2; ++j) { const int it = tid + 512 * j; zr[j] = H[(size_t)(it >> 6) * DINP + C_Z + hd * 64 + (it & 63)]; }
    __syncthreads();
    if (tid < 320) { const int c = tid; const int xc = c < 64 ? hd * 64 + c : (c < 192 ? 2048 + g * 128 + (c - 64) : 3072 + g * 128 + (c - 192));
        float win[19];
#pragma unroll
        for (int i = 0; i < 3; ++i) win[i] = hist[i * CONVDIM + xc];
#pragma unroll
        for (int t = 0; t < 16; ++t) win[3 + t] = bf2f(H[(size_t)t * DINP + C_X + xc]);
        const float w0 = convw[xc], w1 = convw[CONVDIM + xc], w2 = convw[2 * CONVDIM + xc], w3 = convw[3 * CONVDIM + xc], bb = convb[xc];
#pragma unroll
        for (int t = 0; t < 16; ++t) { const float a = fsilu(bb + win[t] * w0 + win[t + 1] * w1 + win[t + 2] * w2 + win[t + 3] * w3);
            if (c < 64) xs[t * 64 + c] = a; else if (c < 192) Bs[t * 128 + c - 64] = a; else Cs[t * 128 + c - 192] = a; } }
    if (tid < 16) { const float dt = softplus_f(bf2f(H[(size_t)tid * DINP + C_DT + hd]) + F.in[I_DTB][layer * 32 + hd]); dts[tid] = dt; das[tid] = fexp(-fexp(F.in[I_ALOG][layer * 32 + hd]) * dt); }
    __syncthreads();
    for (int t = 0; t < 16; ++t) { const float dec = das[t], xv = xs[t * 64 + p] * dts[t]; float part = 0.f;
#pragma unroll
        for (int i = 0; i < 16; ++i) { S[i] = S[i] * dec + xv * Bs[t * 128 + n0 + i]; part += Cs[t * 128 + n0 + i] * S[i]; }
        part += xshfl<1>(part); part += xshfl<2>(part); part += xshfl<4>(part);
        if ((tid & 7) == 0) Yl[t * 64 + p] = part; }
#pragma unroll
    for (int i = 0; i < 16; ++i) F.out[O_SSS + sbase + i] = S[i];
    __syncthreads();
    const float Dh = F.in[I_SD][layer * 32 + hd];
#pragma unroll
    for (int j = 0; j < 2; ++j) { const int it = tid + 512 * j, t = it >> 6, pp = it & 63;
        const float z = bf2f(zr[j]); const float v = (Yl[t * 64 + pp] + Dh * xs[t * 64 + pp]) * fsilu(z);
        H[(size_t)t * DINP + C_Z + hd * 64 + pp] = bf1(v);
        const float ss = wave_sum(v * v);
        if (lane < 4) ws_f(F, WS_SSQ)[((size_t)NP + sq * 16 + t) * 128 + hd * 4 + lane] = lane == 0 ? ss : 0.f; }
}

__device__ __forceinline__ int t5_bucket(int rel) {
    const int n = rel < 0 ? -rel : rel; const int b = rel > 0 ? 16 : 0;
    if (n < 8) return b + n;
    int v = 8; v += n >= 12; v += n >= 16; v += n >= 23; v += n >= 32; v += n >= 46; v += n >= 64; v += n >= 91;
    return b + v;
}
constexpr int AK_P = 72, AV_P = 200;
constexpr int AL_K = 0, AL_VT = AL_K + 192 * AK_P * 2, AL_LUT = AL_VT + 64 * AV_P * 2, AL_END = AL_LUT + 4 * 256 * 4;
static_assert(AL_END <= RING_BYTES, "attention LDS map");
__device__ __forceinline__ void attn_prompt_unit(const Frame& F, int layer, int sl, int ck, int kh, bool build_lut) {
    const int tid = F.tid, lane = F.lane, w = F.wave, q32 = lane & 31, hi = lane >> 5;
    LAS bf16_t* Kl = (LAS bf16_t*)(F.lds + AL_K); LAS bf16_t* VT = (LAS bf16_t*)(F.lds + AL_VT); LAS float* lut = (LAS float*)(F.lds + AL_LUT);
    bf16_t* H = ws_bf(F, WS_H) + (size_t)sl * SEQ * DINP;
    const int gq = w >> 1, qh = w & 1, head = kh * 4 + gq;
    const size_t qrow = (size_t)ck * 64 + 32 * qh + q32;
    bf16x8 qf[4];
#pragma unroll
    for (int ds = 0; ds < 4; ++ds) qf[ds] = *(const bf16x8*)(H + qrow * DINP + C_Q + head * 64 + 16 * ds + 8 * hi);
    __syncthreads();
#pragma unroll
    for (int j = 0; j < 3; ++j) { const int id = tid + 512 * j, key = id >> 3, cg = id & 7; const int t = 64 * (ck - 2) + key;
        u32x4 kv = (u32x4){0u, 0u, 0u, 0u}, vv = kv;
        if (t >= 0) { kv = *(const u32x4*)(H + (size_t)t * DINP + C_K + kh * 64 + 8 * cg); vv = *(const u32x4*)(H + (size_t)t * DINP + C_V + kh * 64 + 8 * cg); }
        *(LAS u32x4*)(Kl + key * AK_P + 8 * cg) = kv;
        VT[(8 * cg + 0) * AV_P + key] = (bf16_t)(vv.x & 0xffffu); VT[(8 * cg + 1) * AV_P + key] = (bf16_t)(vv.x >> 16); VT[(8 * cg + 2) * AV_P + key] = (bf16_t)(vv.y & 0xffffu); VT[(8 * cg + 3) * AV_P + key] = (bf16_t)(vv.y >> 16);
        VT[(8 * cg + 4) * AV_P + key] = (bf16_t)(vv.z & 0xffffu); VT[(8 * cg + 5) * AV_P + key] = (bf16_t)(vv.z >> 16); VT[(8 * cg + 6) * AV_P + key] = (bf16_t)(vv.w & 0xffffu); VT[(8 * cg + 7) * AV_P + key] = (bf16_t)(vv.w >> 16); }
    if (build_lut) for (int e = tid; e < 4 * 255; e += NTHREADS) { const int gg = e / 255, idx = e % 255; lut[gg * 256 + idx] = F.in[I_RELB][t5_bucket(idx - 191) * 16 + kh * 4 + gg]; }
    __syncthreads();
    f32x16 sc[6];
#pragma unroll
    for (int kt = 0; kt < 6; ++kt) {
#pragma unroll
        for (int r = 0; r < 16; ++r) sc[kt][r] = 0.f;
#pragma unroll
        for (int ds = 0; ds < 4; ++ds) { const bf16x8 a = *(const LAS bf16x8*)(Kl + (32 * kt + q32) * AK_P + 16 * ds + 8 * hi); sc[kt] = __builtin_amdgcn_mfma_f32_32x32x16_bf16(a, qf[ds], sc[kt], 0, 0, 0); } }
    const int qidx = 32 * qh + q32; const float sink = F.in[I_SINK][layer * 16 + head];
    float mx = -3.0e38f;
#pragma unroll
    for (int kt = 0; kt < 6; ++kt)
#pragma unroll
        for (int r = 0; r < 16; ++r) { const int key = 32 * kt + (r & 3) + 8 * (r >> 2) + 4 * hi; const int rel = key - 128 - qidx;
            float s = sc[kt][r] * 0.125f + lut[gq * 256 + rel + 191]; if (ck < 2 && 64 * ck + key - 128 < 0) s = -1e30f; sc[kt][r] = s; mx = fmaxf(mx, s); }
    mx = fmaxf(mx, __shfl_xor(mx, 32)); mx = fmaxf(mx, sink);
    float sum = 0.f;
#pragma unroll
    for (int kt = 0; kt < 6; ++kt)
#pragma unroll
        for (int r = 0; r < 16; ++r) { const float e = fexp(sc[kt][r] - mx); sc[kt][r] = e; sum += e; }
    sum += __shfl_xor(sum, 32);
    const float inv = 1.0f / (sum + fexp(sink - mx));
    f32x16 o[2];
#pragma unroll
    for (int d2 = 0; d2 < 2; ++d2)
#pragma unroll
        for (int r = 0; r < 16; ++r) o[d2][r] = 0.f;
#pragma unroll
    for (int kt = 0; kt < 6; ++kt)
#pragma unroll
        for (int s = 0; s < 2; ++s) {
            u32x4 pw; pw.x = pk2(sc[kt][8 * s + 0], sc[kt][8 * s + 1]); pw.y = pk2(sc[kt][8 * s + 2], sc[kt][8 * s + 3]); pw.z = pk2(sc[kt][8 * s + 4], sc[kt][8 * s + 5]); pw.w = pk2(sc[kt][8 * s + 6], sc[kt][8 * s + 7]);
            const bf16x8 pa = __builtin_bit_cast(bf16x8, pw);
#pragma unroll
            for (int d2 = 0; d2 < 2; ++d2) { const LAS bf16_t* vp = VT + (32 * d2 + q32) * AV_P + 32 * kt + 16 * s + 4 * hi;
                const u32x2 lo = *(const LAS u32x2*)vp, hh = *(const LAS u32x2*)(vp + 8); u32x4 vw; vw.x = lo.x; vw.y = lo.y; vw.z = hh.x; vw.w = hh.y;
                o[d2] = __builtin_amdgcn_mfma_f32_32x32x16_bf16(pa, __builtin_bit_cast(bf16x8, vw), o[d2], 0, 0, 0); } }
#pragma unroll
    for (int r = 0; r < 16; ++r) { const int q = (r & 3) + 8 * (r >> 2) + 4 * hi; const float iv = __shfl(inv, q);
        bf16_t* op = H + ((size_t)ck * 64 + 32 * qh + q) * DINP + C_Q + head * 64 + q32;
        op[0] = bf1(o[0][r] * iv); op[32] = bf1(o[1][r] * iv); }
}
__device__ __forceinline__ void attn_sample_unit(const Frame& F, int layer, int sq, int kh, int gq) {
    const int tid = F.tid; LAS float* L = (LAS float*)F.lds; const int head = kh * 4 + gq;
    LAS float* Kf = L; LAS float* Vf = Kf + 144 * 65; LAS float* Qf = Vf + 144 * 64; LAS float* P = Qf + 16 * 65; LAS float* Pinv = P + 16 * 145;
    static_assert((144 * 65 + 144 * 64 + 16 * 65 + 16 * 145 + 16) * 4 <= RING_BYTES, "sample attention LDS map");
    bf16_t* H = ws_bf(F, WS_H) + (size_t)(NP + sq * 16) * DINP;
    const float* ck = F.in[I_CK] + ((size_t)layer * DECB + sq) * WINDOW * 256; const float* cv = F.in[I_CV] + ((size_t)layer * DECB + sq) * WINDOW * 256;
    __syncthreads();
    {
        f32x4 kc[4], vc[4]; u32x4 nw = (u32x4){0u, 0u, 0u, 0u};
#pragma unroll
        for (int k = 0; k < 4; ++k) { const int i = tid + k * NTHREADS, key = i >> 4, d4 = (i & 15) * 4; kc[k] = *(const f32x4*)(ck + (size_t)key * 256 + kh * 64 + d4); vc[k] = *(const f32x4*)(cv + (size_t)key * 256 + kh * 64 + d4); }
        const int which = tid >> 7, r16 = (tid >> 3) & 15, c8 = (tid & 7) * 8;
        if (which < 3) nw = *(const u32x4*)(H + (size_t)r16 * DINP + (which == 0 ? C_K + kh * 64 : (which == 1 ? C_V + kh * 64 : C_Q + head * 64)) + c8);
        asm volatile("" ::: "memory");
#pragma unroll
        for (int k = 0; k < 4; ++k) { const int i = tid + k * NTHREADS, key = i >> 4, d4 = (i & 15) * 4;
#pragma unroll
            for (int j = 0; j < 4; ++j) { Kf[key * 65 + d4 + j] = kc[k][j]; Vf[key * 64 + d4 + j] = vc[k][j]; } }
        if (which < 3) { float f[8]; unpack8(nw, f); LAS float* dst = which == 0 ? Kf + (128 + r16) * 65 + c8 : (which == 1 ? Vf + (128 + r16) * 64 + c8 : Qf + r16 * 65 + c8);
#pragma unroll
            for (int j = 0; j < 8; ++j) dst[j] = f[j]; } }
    __syncthreads();
    for (int i = tid; i < 16 * 144; i += NTHREADS) { const int row = i / 144, key = i % 144; float s = 0.f;
        for (int d = 0; d < 64; ++d) s += Qf[row * 65 + d] * Kf[key * 65 + d];
        P[row * 145 + key] = s * 0.125f + F.in[I_RELB][t5_bucket(key - 128 - row) * 16 + head]; }
    __syncthreads();
    { const int row = tid >> 5, sub = tid & 31; const float sink = F.in[I_SINK][layer * 16 + head]; float mx = -3.0e38f;
      for (int k = sub; k < 144; k += 32) mx = fmaxf(mx, P[row * 145 + k]);
      mx = fmaxf(mx, xshfl<1>(mx)); mx = fmaxf(mx, xshfl<2>(mx)); mx = fmaxf(mx, xshfl<4>(mx)); mx = fmaxf(mx, xshfl<8>(mx)); mx = fmaxf(mx, xshfl<16>(mx)); mx = fmaxf(mx, sink);
      float sum = 0.f;
      for (int k = sub; k < 144; k += 32) { const float e = fexp(P[row * 145 + k] - mx); P[row * 145 + k] = e; sum += e; }
      sum += xshfl<1>(sum); sum += xshfl<2>(sum); sum += xshfl<4>(sum); sum += xshfl<8>(sum); sum += xshfl<16>(sum);
      if (sub == 0) Pinv[row] = 1.0f / (sum + fexp(sink - mx)); }
    __syncthreads();
    { const int row = tid >> 5, d0 = (tid & 31) * 2; float o0 = 0.f, o1 = 0.f;
      for (int k = 0; k < 144; ++k) { const float pv = P[row * 145 + k]; o0 += pv * Vf[k * 64 + d0]; o1 += pv * Vf[k * 64 + d0 + 1]; }
      const float iv = Pinv[row];
      *(unsigned*)(H + (size_t)row * DINP + C_Q + head * 64 + d0) = pk2(o0 * iv, o1 * iv); }
}
__device__ __forceinline__ void sc_unit(const Frame& F, int layer, int tile) {
    const int tid = F.tid, cg = tid & 127, rs = tid >> 7; bf16_t* H = ws_bf(F, WS_H);
    const float* wsc = F.in[I_SCW] + (size_t)layer * 3 * D + 8 * cg; float wt[3][8];
#pragma unroll
    for (int i = 0; i < 3; ++i)
#pragma unroll
        for (int c = 0; c < 8; ++c) wt[i][c] = wsc[i * D + c];
    const int row0 = tile * 64 + 16 * rs; const bool smp = row0 >= NP; const int tt0 = smp ? 0 : row0 % SEQ;
    u32x4 cw_[2][4], hw_[2][4], bw_[2][4];
#define SC_LOAD(q_) do { _Pragma("unroll") for (int i = 0; i < 4; ++i) { const bf16_t* hp = H + (size_t)(row0 + 4 * (q_) + i) * DINP + 8 * cg; cw_[(q_) & 1][i] = *(const u32x4*)(hp + C_SCC); hw_[(q_) & 1][i] = *(const u32x4*)(hp + C_SCH); bw_[(q_) & 1][i] = *(const u32x4*)(hp + C_SCB); } } while (0)
#define SC_COMP(q_) do { _Pragma("unroll") for (int i = 0; i < 4; ++i) { float c8[8], h8[8], b8[8], a[8]; unpack8(cw_[(q_) & 1][i], c8); unpack8(hw_[(q_) & 1][i], h8); unpack8(bw_[(q_) & 1][i], b8); \
            _Pragma("unroll") for (int c = 0; c < 8; ++c) { const float u0 = c8[c] * h8[c]; a[c] = (u2[c] * wt[0][c] + u1[c] * wt[1][c] + u0 * wt[2][c]) * b8[c]; u2[c] = u1[c]; u1[c] = u0; } \
            *(u32x4*)(H + (size_t)(row0 + 4 * (q_) + i) * DINP + C_SCB + 8 * cg) = pack8(a); } } while (0)
    SC_LOAD(0); asm volatile("" ::: "memory"); SC_LOAD(1); asm volatile("" ::: "memory");
    float u1[8], u2[8];
    if (tt0 >= 2) { float c8[8], h8[8];
        unpack8(*(const u32x4*)(H + (size_t)(row0 - 2) * DINP + C_SCC + 8 * cg), c8); unpack8(*(const u32x4*)(H + (size_t)(row0 - 2) * DINP + C_SCH + 8 * cg), h8);
#pragma unroll
        for (int c = 0; c < 8; ++c) u2[c] = c8[c] * h8[c];
        unpack8(*(const u32x4*)(H + (size_t)(row0 - 1) * DINP + C_SCC + 8 * cg), c8); unpack8(*(const u32x4*)(H + (size_t)(row0 - 1) * DINP + C_SCH + 8 * cg), h8);
#pragma unroll
        for (int c = 0; c < 8; ++c) u1[c] = c8[c] * h8[c]; }
    else if (smp) { const float* hp = F.in[I_SSC] + (((size_t)layer * DECB + ((row0 - NP) >> 4)) * 2) * D + 8 * cg;
#pragma unroll
        for (int c = 0; c < 8; ++c) { u2[c] = hp[c]; u1[c] = hp[D + c]; } }
    else {
#pragma unroll
        for (int c = 0; c < 8; ++c) { u2[c] = 0.f; u1[c] = 0.f; } }
    SC_COMP(0); asm volatile("" ::: "memory"); SC_LOAD(2); asm volatile("" ::: "memory");
    SC_COMP(1); asm volatile("" ::: "memory"); SC_LOAD(3); asm volatile("" ::: "memory");
    SC_COMP(2); asm volatile("" ::: "memory");
    SC_COMP(3);
#undef SC_LOAD
#undef SC_COMP
    {
    }
}
__device__ __forceinline__ void state_out_unit(const Frame& F, int layer, int mb, int sl, bool smp, int part) {
    const int tid = F.tid; const bf16_t* H = ws_bf(F, WS_H);
    const int nkv = smp ? DECS : WINDOW, len = smp ? DECS : SEQ; const size_t row0 = smp ? (size_t)NP + sl * 16 : (size_t)sl * SEQ; const int sg = smp ? sl : mb * NSEQ_MB + sl;
    const size_t nb_ = smp ? DECB : BATCH;
    float* ko = F.out + (smp ? O_KS : O_KP) + ((size_t)layer * nb_ + sg) * nkv * 256; float* vo = F.out + (smp ? O_VS : O_VP) + ((size_t)layer * nb_ + sg) * nkv * 256;
    const int kv0 = part < 0 ? 0 : part * (nkv * 32 / 8), kv1 = part < 0 ? nkv * 32 : kv0 + nkv * 32 / 8;
    for (int i = kv0 + tid; i < kv1; i += NTHREADS) { const int j = i >> 5, c8 = (i & 31) * 8; const bf16_t* hp = H + (row0 + len - nkv + j) * DINP; float f[8];
        unpack8(*(const u32x4*)(hp + C_K + c8), f); *(f32x4*)(ko + (size_t)j * 256 + c8) = (f32x4){f[0], f[1], f[2], f[3]}; *(f32x4*)(ko + (size_t)j * 256 + c8 + 4) = (f32x4){f[4], f[5], f[6], f[7]};
        unpack8(*(const u32x4*)(hp + C_V + c8), f); *(f32x4*)(vo + (size_t)j * 256 + c8) = (f32x4){f[0], f[1], f[2], f[3]}; *(f32x4*)(vo + (size_t)j * 256 + c8 + 4) = (f32x4){f[4], f[5], f[6], f[7]}; }
    float* co = F.out + (smp ? O_CVS : O_CVP) + ((size_t)layer * nb_ + sg) * 3 * CONVDIM;
    const int cv0 = part < 0 ? 0 : (part < 3 ? part * 512 : 3 * 512), cv1 = part < 0 ? 3 * 512 : (part < 3 ? cv0 + 512 : 3 * 512);
    for (int i = cv0 + tid; i < cv1; i += NTHREADS) { const int j = i / 512, c8 = (i % 512) * 8; float f[8]; unpack8(*(const u32x4*)(H + (row0 + len - 3 + j) * DINP + C_X + c8), f);
        *(f32x4*)(co + (size_t)j * CONVDIM + c8) = (f32x4){f[0], f[1], f[2], f[3]}; *(f32x4*)(co + (size_t)j * CONVDIM + c8 + 4) = (f32x4){f[4], f[5], f[6], f[7]}; }
    float* so = F.out + (smp ? O_SCS : O_SCP) + ((size_t)layer * nb_ + sg) * 2 * D;
    if (part < 0 || part == 3)
    for (int i = tid; i < 2 * 128; i += NTHREADS) { const int j = i >> 7, c8 = (i & 127) * 8; float c[8], h[8]; const bf16_t* hp = H + (row0 + len - 2 + j) * DINP;
        unpack8(*(const u32x4*)(hp + C_SCC + c8), c); unpack8(*(const u32x4*)(hp + C_SCH + c8), h);
        *(f32x4*)(so + (size_t)j * D + c8) = (f32x4){c[0] * h[0], c[1] * h[1], c[2] * h[2], c[3] * h[3]}; *(f32x4*)(so + (size_t)j * D + c8 + 4) = (f32x4){c[4] * h[4], c[5] * h[5], c[6] * h[6], c[7] * h[7]}; }
}
#ifndef MIX_MASK
#define MIX_MASK 0xFF
#endif
#define MIXON(b) ((MIX_MASK >> (b)) & 1)
__device__ __forceinline__ void step_premix(const Frame& F, int layer, int mb) {
    const int n_bc = NSEQ_MB * NCHUNK * 8, n_att = NSEQ_MB * NCHUNK * NKV, n_sc = rows_of(mb) / 64, n_so = NSEQ_MB * 8 + (mb == 0 ? DECB : 0);
    const int n_ss = mb == 0 ? DECB * 32 : 0, n_as = mb == 0 ? DECB * NKV * 4 : 0;
    const int total = n_bc + n_att + n_sc + n_so + n_ss + n_as;
#define UF(Fu) Frame Fu = F; Fu.lane = opq(lane_id()); Fu.tid = Fu.wave * 64 + Fu.lane
    PROBE_T0(14) if constexpr (MIXON(0)) { UF(Fu); BcRegs ra, rn_;
        if (F.bid < n_bc) ssd_bc_load(Fu, layer, F.bid, ra);
        for (int u = F.bid; u < n_bc; u += F.G) { const bool more = u + F.G < n_bc; if (more) ssd_bc_load(Fu, layer, u + F.G, rn_);
            ssd_bc_unit(Fu, u, ra);
            if (more) ra = rn_; } }
    PROBE_T1(14)
    for (int un = F.bid; un < total; un += F.G) { int r = un;
        if (r < n_bc) continue;
        r -= n_bc;
        if (r < n_att) { PROBE_T0(15) if constexpr (MIXON(1)) { UF(Fu);
                const bool xo = (n_att % 8 == 0 && F.G % 8 == 0 && n_bc % F.G == 0 && (n_att >> 3) % NKV == 0 && (F.G >> 3) % NKV == 0); const int ra = xo ? (r & 7) * (n_att >> 3) + (r >> 3) : r;
                attn_prompt_unit(Fu, layer, ra / (NCHUNK * NKV), (ra / NKV) % NCHUNK, ra % NKV, !xo || r < F.G); } PROBE_T1(15) continue; } r -= n_att;
        if (r < n_sc) { PROBE_T0(16) if constexpr (MIXON(2)) { UF(Fu); sc_unit(Fu, layer, r); } PROBE_T1(16) continue; } r -= n_sc;
        if (r < n_so) { PROBE_T0(17) if constexpr (MIXON(3)) { UF(Fu); state_out_unit(Fu, layer, mb, r < NSEQ_MB * 8 ? r >> 3 : r - NSEQ_MB * 8, r >= NSEQ_MB * 8, r < NSEQ_MB * 8 ? (r & 7) : -1); } PROBE_T1(17) continue; } r -= n_so;
        if (r < n_ss) { PROBE_T0(18) if constexpr (MIXON(4)) { UF(Fu); ssd_sample_unit(Fu, layer, r >> 5, r & 31); } PROBE_T1(18) continue; } r -= n_ss;
        { PROBE_T0(19) if constexpr (MIXON(5)) { UF(Fu); attn_sample_unit(Fu, layer, r >> 4, (r >> 2) & 3, r & 3); } PROBE_T1(19) }
    }
}
__device__ __forceinline__ void step_mixers(const Frame& F, int layer, int mb) {
    for (int v = F.bid; v < NSEQ_MB * 32; v += F.G) { const int un = (NSEQ_MB == 8 && F.G == 256) ? (v & 7) * 32 + (v >> 3) : v; UF(Fu); ssd_prompt_unit(Fu, layer, mb, un >> 5, un & 31); }
}
constexpr int RW_P = D + 8;
__device__ __forceinline__ void step_ln1_router_mfma(const Frame& F, int layer, int mb) {
    LAS bf16_t* WH = (LAS bf16_t*)F.lds; LAS bf16_t* WL = WH + NTE * 16 * RW_P; LAS float* GB = (LAS float*)(WL + NTE * 16 * RW_P);
    static_assert((size_t)2 * NTE * 16 * RW_P * 2 + 2 * D * 4 <= (size_t)SCR_BYTES, "router LDS map");
    const int lane = F.lane, fr = lane & 15, fq = lane >> 4;
    __syncthreads();
    { const bf16_t* rwh = ws_bf(F, WS_RWH) + (size_t)layer * NTE * 16 * D; const bf16_t* rwl = ws_bf(F, WS_RWL) + (size_t)layer * NTE * 16 * D;
      constexpr int NIT = NTE * 16 * (D / 8) / NTHREADS; static_assert(NTE * 16 * (D / 8) % NTHREADS == 0 && NIT <= 8, "router weight staging");
      u32x4 th[NIT], tl[NIT];
#pragma unroll
      for (int k = 0; k < NIT; ++k) { const int i = F.tid + k * NTHREADS, e = i / (D / 8), c = i % (D / 8); th[k] = *(const u32x4*)(rwh + (size_t)e * D + 8 * c); tl[k] = *(const u32x4*)(rwl + (size_t)e * D + 8 * c); }
      asm volatile("" ::: "memory");
#pragma unroll
      for (int k = 0; k < NIT; ++k) { const int i = F.tid + k * NTHREADS, e = i / (D / 8), c = i % (D / 8); *(LAS u32x4*)(WH + e * RW_P + 8 * c) = th[k]; *(LAS u32x4*)(WL + e * RW_P + 8 * c) = tl[k]; }
      for (int i = F.tid; i < D; i += NTHREADS) { GB[i] = F.in[I_LN1G][(size_t)layer * D + i]; GB[D + i] = F.in[I_LN1B][(size_t)layer * D + i]; } }
    unsigned* cnt = F.ctl + CW_CNT + (mb * DEPTH + layer) * 64;
    LAS unsigned* lcnt = (LAS unsigned*)(F.lds + MISC_OFF) + 128;
    if (F.tid < 64) lcnt[F.tid] = 0u;
    __syncthreads();
    const int gw = F.bid * NWAVES + F.wave, NGW = F.G * NWAVES, nr = rows_of(mb);
    const float* rb = F.in[I_RB] + (size_t)layer * NEXP;
    bf16_t* XB = ws_bf(F, WS_XB); int* topi = (int*)(F.ws + WS_TOPI); float* gate = ws_f(F, WS_GATE); int* pos = (int*)(F.ws + WS_POS);
    float rbv[NTE];
#pragma unroll
    for (int t = 0; t < NTE; ++t) rbv[t] = 16 * t + fr < NEXP ? rb[16 * t + fr] : 0.f;
    for (int blk = gw; blk < nr / 16; blk += NGW) {
        const int row = 16 * blk + fr; const float* xr = x_out_row(F, mb, row) + 8 * fq;
        float s1, s2;
        { const float* stp = ws_f(F, WS_STAT) + (size_t)row * 32 + 8 * fq; const f32x4 a = *(const f32x4*)stp, b = *(const f32x4*)(stp + 4); s1 = (a[0] + a[2]) + (b[0] + b[2]); s2 = (a[1] + a[3]) + (b[1] + b[3]); }
        s1 += xshfl<16>(s1); s1 += xshfl<32>(s1); s2 += xshfl<16>(s2); s2 += xshfl<32>(s2);
        const float mean = s1 * (1.0f / D); const float rstd = 1.0f / sqrtf(fmaxf(s2 * (1.0f / D) - mean * mean, 0.f) + LN_EPS);
        f32x4 acc[NTE];
#pragma unroll
        for (int t = 0; t < NTE; ++t) acc[t] = (f32x4){0.f, 0.f, 0.f, 0.f};
        bf16_t* xo = XB + (size_t)row * D + 8 * fq;
        f32x4 xa[2][8], xb[2][8];
#define L1_LOAD(g_) do { _Pragma("unroll") for (int u_ = 0; u_ < 8; ++u_) { xa[(g_) & 1][u_] = *(const f32x4*)(xr + 32 * (8 * (g_) + u_)); xb[(g_) & 1][u_] = *(const f32x4*)(xr + 32 * (8 * (g_) + u_) + 4); } } while (0)
#define L1_COMP(g_) do { _Pragma("unroll") for (int u_ = 0; u_ < 8; ++u_) { const int sI = 8 * (g_) + u_; const f32x4 a = xa[(g_) & 1][u_], b = xb[(g_) & 1][u_]; \
            const f32x4 g0 = *(const LAS f32x4*)(GB + 32 * sI + 8 * fq), g1 = *(const LAS f32x4*)(GB + 32 * sI + 8 * fq + 4), b0 = *(const LAS f32x4*)(GB + D + 32 * sI + 8 * fq), b1 = *(const LAS f32x4*)(GB + D + 32 * sI + 8 * fq + 4); \
            const f32x4 n0 = (a - mean) * rstd * g0 + b0, n1 = (b - mean) * rstd * g1 + b1; \
            u32x4 hw; hw.x = pk2(n0[0], n0[1]); hw.y = pk2(n0[2], n0[3]); hw.z = pk2(n1[0], n1[1]); hw.w = pk2(n1[2], n1[3]); \
            *(u32x4*)(xo + 32 * sI) = hw; \
            u32x4 lw; lw.x = pk2(n0[0] - blo(hw.x), n0[1] - bhi(hw.x)); lw.y = pk2(n0[2] - blo(hw.y), n0[3] - bhi(hw.y)); lw.z = pk2(n1[0] - blo(hw.z), n1[1] - bhi(hw.z)); lw.w = pk2(n1[2] - blo(hw.w), n1[3] - bhi(hw.w)); \
            const bf16x8 ah = __builtin_bit_cast(bf16x8, hw), al = __builtin_bit_cast(bf16x8, lw); \
            _Pragma("unroll") for (int t = 0; t < NTE; ++t) { const bf16x8 wh = *(const LAS bf16x8*)(WH + (16 * t + fr) * RW_P + 32 * sI + 8 * fq), wl = *(const LAS bf16x8*)(WL + (16 * t + fr) * RW_P + 32 * sI + 8 * fq); \
                acc[t] = __builtin_amdgcn_mfma_f32_16x16x32_bf16(ah, wh, acc[t], 0, 0, 0); acc[t] = __builtin_amdgcn_mfma_f32_16x16x32_bf16(al, wh, acc[t], 0, 0, 0); acc[t] = __builtin_amdgcn_mfma_f32_16x16x32_bf16(ah, wl, acc[t], 0, 0, 0); } } } while (0)
        static_assert(D / 32 == 32, "LayerNorm-1 K-step groups");
        L1_LOAD(0); asm volatile("" ::: "memory"); L1_LOAD(1); asm volatile("" ::: "memory");
        L1_COMP(0); asm volatile("" ::: "memory"); L1_LOAD(2); asm volatile("" ::: "memory");
        L1_COMP(1); asm volatile("" ::: "memory"); L1_LOAD(3); asm volatile("" ::: "memory");
        L1_COMP(2); asm volatile("" ::: "memory");
        L1_COMP(3);
#undef L1_LOAD
#undef L1_COMP
#pragma unroll
        for (int r = 0; r < 4; ++r) { float val[NTE];
#pragma unroll
            for (int t = 0; t < NTE; ++t) val[t] = 16 * t + fr < NEXP ? acc[t][r] + rbv[t] : -3.0e38f;
            float tv[4]; int te[4];
#pragma unroll
            for (int k = 0; k < 4; ++k) { float m = val[0];
#pragma unroll
                for (int t = 1; t < NTE; ++t) m = fmaxf(m, val[t]);
                m = fmaxf(m, xshfl<1>(m)); m = fmaxf(m, xshfl<2>(m)); m = fmaxf(m, xshfl<4>(m)); m = fmaxf(m, xshfl<8>(m));
                int ce = 9999;
#pragma unroll
                for (int t = NTE - 1; t >= 0; --t) ce = val[t] == m ? 16 * t + fr : ce;
                { int o = xshfl<1>(ce); ce = o < ce ? o : ce; o = xshfl<2>(ce); ce = o < ce ? o : ce; o = xshfl<4>(ce); ce = o < ce ? o : ce; o = xshfl<8>(ce); ce = o < ce ? o : ce; }
                tv[k] = m; te[k] = ce;
#pragma unroll
                for (int t = 0; t < NTE; ++t) if (16 * t + fr == ce) val[t] = -3.0e38f; }
            const float e1 = fexp(tv[1] - tv[0]), e2 = fexp(tv[2] - tv[0]), e3 = fexp(tv[3] - tv[0]); const float inv = 1.0f / (1.0f + e1 + e2 + e3);
            if (fr < 4) { const int e = fr == 0 ? te[0] : (fr == 1 ? te[1] : (fr == 2 ? te[2] : te[3])); const float gv = (fr == 0 ? 1.0f : (fr == 1 ? e1 : (fr == 2 ? e2 : e3))) * inv;
                const size_t tok = (size_t)16 * blk + 4 * fq + r;
                const unsigned rk = __hip_atomic_fetch_add(lcnt + e, 1u, __ATOMIC_RELAXED, __HIP_MEMORY_SCOPE_WORKGROUP);
                topi[tok * 4 + fr] = e; gate[tok * 4 + fr] = gv; pos[tok * 4 + fr] = (int)rk; } }
    }
    __syncthreads();
    if (F.tid < NEXP) lcnt[32 + F.tid] = __hip_atomic_fetch_add(cnt + F.tid, lcnt[F.tid], __ATOMIC_RELAXED, __HIP_MEMORY_SCOPE_AGENT);
    __syncthreads();
    for (int blk = gw; blk < nr / 16; blk += NGW) pos[(size_t)16 * blk * 4 + lane] += (int)lcnt[32 + topi[(size_t)16 * blk * 4 + lane]];
}
__device__ __forceinline__ int moe_table(const Frame& F, int layer, int mb) {
    LAS int* M = (LAS int*)(F.lds + MISC_OFF);
    __syncthreads();
    if (F.tid < 64) { unsigned* cnt = F.ctl + CW_CNT + (mb * DEPTH + layer) * 64; const int e = F.tid;
        const int c = e < NEXP ? (int)__hip_atomic_load(cnt + e, __ATOMIC_RELAXED, __HIP_MEMORY_SCOPE_AGENT) : 0; const int t = (c + 255) / 256; const int incl = wave_scan_incl_i(t, e);
        if (e < NEXP) { M[64 + e] = (incl - t) * 256; M[16 + e] = incl; } }
    __syncthreads();
    return M[16 + NEXP - 1];
}
__device__ __forceinline__ void step_gather(const Frame& F, int layer, int mb) {
    (void)moe_table(F, layer, mb); const LAS int* M = (const LAS int*)(F.lds + MISC_OFF);
    const int nr = rows_of(mb);
    const int* topi = (const int*)(F.ws + WS_TOPI); const float* gate = ws_f(F, WS_GATE); int* pos = (int*)(F.ws + WS_POS); float* gs = ws_f(F, WS_GSORT); int* rtok = (int*)(F.ws + WS_RTOK);
#pragma nounroll
    for (int i = F.bid * NTHREADS + F.tid; i < nr * 4; i += F.G * NTHREADS) { const int p = M[64 + topi[i]] + pos[i]; pos[i] = p; rtok[p] = i >> 2; gs[p] = gate[i]; }
}
__device__ __forceinline__ void step_ln2(const Frame& F, int layer, int mb) {
    const int gw = F.bid * NWAVES + F.wave, NGW = F.G * NWAVES, nr = rows_of(mb), lane = F.lane;
    const float* lg = F.in[I_LN2G] + (size_t)layer * D; const float* lb = F.in[I_LN2B] + (size_t)layer * D;
    const bf16_t* OUTS = ws_bf(F, WS_H) + (size_t)2 * RP * D; const int* pos = (const int*)(F.ws + WS_POS); bf16_t* XB = ws_bf(F, WS_XB);
    constexpr int RB = 2;
    f32x4 gg[4], bb[4];
#pragma unroll
    for (int j = 0; j < 4; ++j) { gg[j] = *((const f32x4*)lg + lane + 64 * j); bb[j] = *((const f32x4*)lb + lane + 64 * j); }
    int pn[RB][4];
#pragma unroll
    for (int i = 0; i < RB; ++i) { const int rq = gw + i * NGW < nr ? gw + i * NGW : (gw < nr ? gw : 0);
#pragma unroll
        for (int k = 0; k < 4; ++k) pn[i][k] = pos[(size_t)rq * 4 + k]; }
    for (int r0 = gw; r0 < nr; r0 += RB * NGW) {
        f32x4 v[RB][4]; u32x2 ow[RB][4][4]; int rr[RB];
#pragma unroll
        for (int i = 0; i < RB; ++i) { rr[i] = r0 + i * NGW < nr ? r0 + i * NGW : r0; const u32x2* xr = (const u32x2*)(XB + (size_t)rr[i] * D); int p[4];
#pragma unroll
            for (int k = 0; k < 4; ++k) p[k] = pn[i][k];
#pragma unroll
            for (int j = 0; j < 4; ++j) { { const u32x2 w = xr[lane + 64 * j]; v[i][j] = (f32x4){blo(w.x), bhi(w.x), blo(w.y), bhi(w.y)}; }
#pragma unroll
                for (int k = 0; k < 4; ++k) ow[i][k][j] = *((const u32x2*)(OUTS + (size_t)p[k] * D) + lane + 64 * j); } }
        { const int rn = r0 + RB * NGW;
#pragma unroll
          for (int i = 0; i < RB; ++i) { const int rq = rn + i * NGW < nr ? rn + i * NGW : (rn < nr ? rn : r0);
#pragma unroll
              for (int k = 0; k < 4; ++k) pn[i][k] = pos[(size_t)rq * 4 + k]; } }
        asm volatile("" ::: "memory");
#pragma unroll
        for (int i = 0; i < RB; ++i) { if (r0 + i * NGW >= nr) continue;
            float* xr = x_out_row(F, mb, rr[i]); float s = 0.f;
#pragma unroll
            for (int j = 0; j < 4; ++j) { v[i][j] = v[i][j] * ALPHA;
#pragma unroll
                for (int k = 0; k < 4; ++k) { const u32x2 w = ow[i][k][j]; v[i][j] = v[i][j] + (f32x4){blo(w.x), bhi(w.x), blo(w.y), bhi(w.y)}; }
                s += (v[i][j][0] + v[i][j][1]) + (v[i][j][2] + v[i][j][3]); }
            const float mean = wave_sum(s) * (1.0f / D); float s2 = 0.f;
#pragma unroll
            for (int j = 0; j < 4; ++j) { v[i][j] = v[i][j] - mean; s2 += (v[i][j][0] * v[i][j][0] + v[i][j][1] * v[i][j][1]) + (v[i][j][2] * v[i][j][2] + v[i][j][3] * v[i][j][3]); }
            const float rstd = 1.0f / sqrtf(wave_sum(s2) * (1.0f / D) + LN_EPS);
#pragma unroll
            for (int j = 0; j < 4; ++j) { v[i][j] = v[i][j] * rstd * gg[j] + bb[j];
                *((f32x4*)xr + lane + 64 * j) = v[i][j]; u32x2 w; w.x = pk2(v[i][j][0], v[i][j][1]); w.y = pk2(v[i][j][2], v[i][j][3]); *((u32x2*)(XB + (size_t)rr[i] * D) + lane + 64 * j) = w; } }
#ifndef EMU
#pragma unroll
        for (int i = 0; i < RB; ++i) asm volatile("" : "+v"(pn[i][0]), "+v"(pn[i][1]), "+v"(pn[i][2]), "+v"(pn[i][3]));
#endif
    }
}

constexpr int SP_P = 68;
template <int KS  > __device__ __forceinline__ void small_mma(const bf16_t* A, int lda, const bf16_t* Bt, int K, int tok0, int n0, int k0, int fr, int fq, f32x4 (&acc)[4]) {
    const bf16_t* ap = A + (size_t)(tok0 + fr) * lda + k0 + 8 * fq; const bf16_t* bp = Bt + (size_t)(n0 + fr) * K + k0 + 8 * fq;
#pragma unroll
    for (int k = 0; k < KS; k += 32) { const bf16x8 a = *(const bf16x8*)(ap + k);
#pragma unroll
        for (int jj = 0; jj < 4; ++jj) { const bf16x8 x = *(const bf16x8*)(bp + (size_t)16 * jj * K + k); acc[jj] = __builtin_amdgcn_mfma_f32_16x16x32_bf16(x, a, acc[jj], 0, 0, 0); } }
}
template <int MODE  >
__device__ __forceinline__ void sample_unit(const Frame& F, int layer, int u) {
    const int tid = F.tid, lane = F.lane, w = F.wave, fr = lane & 15, fq = lane >> 4; const int tok0 = NP + 16 * (u >> 4), n0 = 64 * (u & 15);
    LAS float* P = (LAS float*)F.lds;
    const bf16_t* H = ws_bf(F, WS_H); const size_t trow = (size_t)(tok0 + fr);
    f32x4 v[4];
#pragma unroll
    for (int jj = 0; jj < 4; ++jj) v[jj] = (f32x4){0.f, 0.f, 0.f, 0.f};
    if constexpr (MODE == 0) {
#pragma unroll
        for (int b = 0; b < 3; ++b) { f32x4 acc[4] = {(f32x4){0.f, 0.f, 0.f, 0.f}, (f32x4){0.f, 0.f, 0.f, 0.f}, (f32x4){0.f, 0.f, 0.f, 0.f}, (f32x4){0.f, 0.f, 0.f, 0.f}};
            if (b == 0) { small_mma<DINNER / 8>(H + C_Z, DINP, wl_ptr(F, layer, WL_SSD), DINNER, tok0, n0, w * (DINNER / 8), fr, fq, acc);
                const float* sq = ws_f(F, WS_SSQ) + trow * 128 + 16 * w; const f32x4 qa = (*(const f32x4*)sq + *(const f32x4*)(sq + 4)) + (*(const f32x4*)(sq + 8) + *(const f32x4*)(sq + 12)); const float rs = 1.0f / sqrtf(((qa[0] + qa[1]) + (qa[2] + qa[3])) * (1.0f / 256.0f) + LN_EPS);
#pragma unroll
                for (int jj = 0; jj < 4; ++jj) acc[jj] = acc[jj] * rs; }
            else small_mma<D / 8>(H + (b == 1 ? C_Q : C_SCB), DINP, wl_ptr(F, layer, b == 1 ? WL_ATT : WL_SC), D, tok0, n0, w * (D / 8), fr, fq, acc);
#pragma unroll
            for (int jj = 0; jj < 4; ++jj) { const u32x2 gw = *(const u32x2*)(H + trow * DINP + (b == 0 ? C_GSSD : (b == 1 ? C_GATT : C_GSC)) + n0 + 16 * jj + 4 * fq);
                v[jj] = v[jj] + acc[jj] * (f32x4){fsigmoid(blo(gw.x)), fsigmoid(bhi(gw.x)), fsigmoid(blo(gw.y)), fsigmoid(bhi(gw.y))}; } }
    } else small_mma<D / 8>(ws_bf(F, WS_XB), D, wl_ptr(F, layer, WL_O), D, tok0, n0, w * (D / 8), fr, fq, v);
    __syncthreads();
#pragma unroll
    for (int jj = 0; jj < 4; ++jj) *(LAS f32x4*)(P + (w * 16 + fr) * SP_P + 16 * jj + 4 * fq) = v[jj];
    __syncthreads();
    { const int tk = tid >> 5, c2 = 2 * (tid & 31); float s0 = 0.f, s1 = 0.f;
#pragma unroll
      for (int ww = 0; ww < 8; ++ww) { s0 += P[(ww * 16 + tk) * SP_P + c2]; s1 += P[(ww * 16 + tk) * SP_P + c2 + 1]; }
      const size_t orow = (size_t)(tok0 + tk);
      if constexpr (MODE == 0) *(unsigned*)(ws_bf(F, WS_XB) + orow * D + n0 + c2) = pk2(s0, s1);
      else { const float* xs = (layer == 0 ? F.in[I_XS] : F.out + O_YS) + (orow - NP) * D + n0 + c2; float* os = F.out + O_YS + (orow - NP) * D + n0 + c2; const float v0 = xs[0] * ALPHA + s0, v1 = xs[1] * ALPHA + s1; os[0] = v0; os[1] = v1;
          float t1 = v0 + v1, t2 = v0 * v0 + v1 * v1;
          t1 += xshfl<1>(t1); t1 += xshfl<2>(t1); t1 += xshfl<4>(t1); t1 += xshfl<8>(t1); t1 += xshfl<16>(t1); t2 += xshfl<1>(t2); t2 += xshfl<2>(t2); t2 += xshfl<4>(t2); t2 += xshfl<8>(t2); t2 += xshfl<16>(t2);
          if ((tid & 31) == 0) { float* sp = ws_f(F, WS_STAT) + orow * 32 + 2 * (u & 15); sp[0] = t1; sp[1] = t2; } } }
}

constexpr int PH_PER = 10, NSTEPS = 1 + NMB * DEPTH * PH_PER;
__global__ void __launch_bounds__(NTHREADS, 2) fwd(Args args) {
#ifdef EMU
    unsigned char* lds = emu_wg->lds;
#else
    extern __shared__ __attribute__((aligned(16))) unsigned char lds[];
#endif
    Frame F0; F0.lds = (LAS unsigned char*)lds; F0.tid = threadIdx.x; F0.lane = F0.tid & 63; F0.wave = __builtin_amdgcn_readfirstlane(F0.tid >> 6); F0.G = gridDim.x; F0.bid = blockIdx.x;
#ifdef EMU
    F0.in = args.in;
#else
    F0.in = (ArgTab)__builtin_amdgcn_kernarg_segment_ptr();
    static_assert(offsetof(Args, out) == 248 && offsetof(Args, ws) == 256 && offsetof(Args, in) == 0, "PF() reads the argument struct by offset");
#endif
    F0.out = args.out; F0.ws = args.ws; F0.ctl = (unsigned*)(args.ws + WS_CTL);
    const Frame& F = F0;
    const int lo = args.lo, hi = args.hi;
#ifndef EMU
    for (int u = F.tid; u < (LDS_BYTES - MISC_OFF) / 4; u += NTHREADS) ((LAS unsigned*)(F.lds + MISC_OFF))[u] = 0u;
    __syncthreads();
    XcdBarrier bar; bar.bar = F.ctl + CW_BAR; bar.x = 0; bar.st = nullptr;
    if (hi - lo > 1) bar = xcd_barrier_post(F.ctl + CW_BAR, (volatile LAS unsigned*)(F.lds + MISC_OFF) + 8);
#define SEAM(s) do { if ((s) + 1 < hi) { XcdBarrier b2_ = bar; unsigned long long bp_ = (unsigned long long)b2_.bar; asm volatile("" : "+s"(bp_)); b2_.bar = (unsigned*)bp_; xcd_barrier(b2_); } } while (0)
#else
#define SEAM(s) do { } while (0)
#endif
#ifndef PH_MASK
#define PH_MASK 0xFFFFFFFF
#endif
#define IN(s) (lo <= (s) && (s) < hi)
#define PHON(b) ((PH_MASK >> (b)) & 1)
#ifdef EMU
#define PF(Fp) Frame Fp = F0
#else
#define PF(Fp) Frame Fp; { unsigned long long kp_ = (unsigned long long)__builtin_amdgcn_kernarg_segment_ptr(); asm volatile("" : "+s"(kp_)); \
    Fp.in = (ArgTab)kp_; Fp.out = *(float* const __attribute__((address_space(4)))*)(kp_ + 248); Fp.ws = *(unsigned char* const __attribute__((address_space(4)))*)(kp_ + 256); Fp.ctl = (unsigned*)Fp.ws; \
    Fp.lds = F0.lds; Fp.G = F0.G; Fp.bid = F0.bid; Fp.wave = F0.wave; Fp.lane = opq(lane_id()); Fp.tid = Fp.wave * 64 + Fp.lane; }
#endif
    int step = 0;
    if (IN(step)) { PROBE_T0(0) if constexpr (PHON(0)) { PF(F); step_weights(F); for (int m = 0; m < NMB; ++m) step_xb(F, m);
        { bf16_t* rwh = ws_bf(F, WS_RWH); bf16_t* rwl = ws_bf(F, WS_RWL); const float* rw = F.in[I_RW];
#pragma nounroll
          for (int i = F.bid * NTHREADS + F.tid; i < DEPTH * NTE * 16 * D; i += F.G * NTHREADS) { const int l = i / (NTE * 16 * D), e = (i / D) % (NTE * 16), k = i % D;
              const float wv = e < NEXP ? rw[((size_t)l * D + k) * NEXP + e] : 0.f; const unsigned hi = f2bf(wv); rwh[i] = (bf16_t)hi; rwl[i] = (bf16_t)f2bf(wv - bf2f(hi)); } } } PROBE_T1(0) SEAM(step); }
    ++step;
#define PHV const int mb = opqs(mb0), layer = opqs(layer0), nr = rows_of(mb); (void)nr; (void)layer
    for (int mb0 = 0; mb0 < NMB; ++mb0)
        for (int layer0 = 0; layer0 < DEPTH; ++layer0) {
            if (IN(step)) { PROBE_T0(2) if constexpr (PHON(2)) { PF(F); PHV; pg8::Gemm g{layer == 0 ? ws_bf(F, WS_XB0) + (size_t)mb * R * D : ws_bf(F, WS_XB), wl_ptr(F, layer, WL_IN), nr, DINP, D, D, nullptr}; pg8::StaticOrder S; S.init(nr, DINP, F.G, F.bid, 2);
                pg8::EpiStoreBf16 E{ws_bf(F, WS_H), DINP}; pg8::gemm_phase(F.lds, g, S, E, F.wave); } PROBE_T1(2) SEAM(step); }
            ++step;
            if (IN(step)) { PROBE_T0(13) if constexpr (PHON(13)) { PF(F); PHV; step_premix(F, layer, mb); } PROBE_T1(13) SEAM(step); }
            ++step;
            if (IN(step)) { PROBE_T0(3) if constexpr (PHON(3)) { PF(F); PHV; step_mixers(F, layer, mb); } PROBE_T1(3) SEAM(step); }
            ++step;
            if (IN(step)) { PROBE_T0(5) if constexpr (PHON(5)) { PF(F); PHV; pg8::StaticOrder S; S.init(NP, D, F.G, F.bid); bf16_t* H = ws_bf(F, WS_H); bf16_t* MGb = ws_bf(F, WS_XB);
#ifndef MERGE_MASK
#define MERGE_MASK 7
#endif
                if constexpr (MERGE_MASK & 1) { pg8::Gemm g{H + C_Z, wl_ptr(F, layer, WL_SSD), NP, D, DINNER, DINP, nullptr, ws_f(F, WS_SSQ)}; pg8::EpiGate<0> E{H + C_GSSD, MGb}; pg8::gemm_phase<pg8::EpiGate<0>, pg8::StaticOrder, false, true>(F.lds, g, S, E, F.wave); }
                if constexpr (MERGE_MASK & 2) { pg8::Gemm g{H + C_Q, wl_ptr(F, layer, WL_ATT), NP, D, D, DINP, nullptr}; pg8::EpiGate<1> E{H + C_GATT, MGb}; pg8::gemm_phase(F.lds, g, S, E, F.wave); }
                if constexpr (MERGE_MASK & 4) { pg8::Gemm g{H + C_SCB, wl_ptr(F, layer, WL_SC), NP, D, D, DINP, nullptr}; pg8::EpiGate<1> E{H + C_GSC, MGb}; pg8::gemm_phase(F.lds, g, S, E, F.wave); }
                if (mb == 0) for (int u = F.bid; u < 256; u += F.G) sample_unit<0>(F, layer, u); }
                PROBE_T1(5) SEAM(step); }
            ++step;
            if (IN(step)) { PROBE_T0(6) if constexpr (PHON(6)) { PF(F); PHV; pg8::Gemm g{ws_bf(F, WS_XB), wl_ptr(F, layer, WL_O), NP, D, D, D, nullptr}; pg8::StaticOrder S; S.init(NP, D, F.G, F.bid);
                pg8::EpiResid E{layer == 0 ? F.in[I_XP] + (size_t)mb * NP * D : F.out + O_YP + (size_t)mb * NP * D, layer == 0 ? F.in[I_XS] : F.out + O_YS, F.out + O_YP + (size_t)mb * NP * D, F.out + O_YS, ws_f(F, WS_STAT)};
                pg8::gemm_phase(F.lds, g, S, E, F.wave);
                if (mb == 0) for (int u = F.bid; u < 256; u += F.G) sample_unit<1>(F, layer, u); } PROBE_T1(6) SEAM(step); }
            ++step;
            if (IN(step)) { PROBE_T0(7) if constexpr (PHON(7)) { PF(F); PHV; step_ln1_router_mfma(F, layer, mb); } PROBE_T1(7) SEAM(step); }
            ++step;
            if (IN(step)) { PROBE_T0(8) if constexpr (PHON(8)) { PF(F); PHV; step_gather(F, layer, mb); } PROBE_T1(8) SEAM(step); }
            ++step;
            if (IN(step)) { PROBE_T0(9) if constexpr (PHON(9)) { PF(F); PHV; const int nt = moe_table(F, layer, mb); pg8::MoeOrder S{(const LAS int*)(F.lds + MISC_OFF) + 16, 8, nt * 8, F.G, F.bid};
                pg8::Gemm g{ws_bf(F, WS_XB), wl_ptr(F, layer, WL_UP), nr  , 2048, D, D, (const int*)(F.ws + WS_RTOK)}; pg8::EpiSwiglu E{ws_bf(F, WS_H) + (size_t)RP * D, F.in[I_BUP] + (size_t)layer * NEXP * 2048, F.lds};
                pg8::gemm_phase<pg8::EpiSwiglu, pg8::MoeOrder, true>(F.lds, g, S, E, F.wave); } PROBE_T1(9) SEAM(step); }
            ++step;
            if (IN(step)) { PROBE_T0(10) if constexpr (PHON(10)) { PF(F); PHV; const int nt = moe_table(F, layer, mb); pg8::MoeOrder S{(const LAS int*)(F.lds + MISC_OFF) + 16, 4, nt * 4, F.G, F.bid};
                pg8::Gemm g{ws_bf(F, WS_H) + (size_t)RP * D, wl_ptr(F, layer, WL_DN), nt * 256, D, D, D, nullptr}; pg8::EpiDown E{ws_bf(F, WS_H) + (size_t)2 * RP * D, F.in[I_BDN] + (size_t)layer * NEXP * D, ws_f(F, WS_GSORT), F.lds};
                pg8::gemm_phase(F.lds, g, S, E, F.wave); } PROBE_T1(10) SEAM(step); }
            ++step;
            if (IN(step)) { PROBE_T0(11) if constexpr (PHON(11)) { PF(F); PHV; step_ln2(F, layer, mb); } PROBE_T1(11) SEAM(step); }
            ++step;
        }
}

#ifdef EMU
extern int emu_grid, emu_step_lo, emu_step_hi;
#endif
extern "C" void kernel_launch(void* const* d_in, const int* in_sizes, int n_in, void* d_out, int out_size, void* d_ws, size_t ws_size, hipStream_t stream) {
    (void)in_sizes; (void)out_size;
    if (n_in != 31 || ws_size < WS_END) { fprintf(stderr, "kernel_launch: expected 31 inputs and >= %zu bytes of workspace (got %d, %zu)\n", (size_t)WS_END, n_in, ws_size); return; }
    Args a; memset(&a, 0, sizeof(a));
    for (int i = 0; i < 31; ++i) a.in[i] = (const float*)d_in[i];
    a.out = (float*)d_out; a.ws = (unsigned char*)d_ws;
#ifdef EMU
    if (emu_step_lo == 0) memset((char*)d_ws + WS_CTL, 0, CTL_BYTES);
    for (int s = emu_step_lo; s < emu_step_hi && s < NSTEPS; ++s) { a.lo = s; a.hi = s + 1; emu_launch(fwd, emu_grid, NTHREADS, LDS_BYTES, a); fprintf(stderr, "step %d done\n", s); }
#else
    (void)hipMemsetAsync((char*)d_ws + WS_CTL, 0, CTL_BYTES, stream);
    static int grid = 0;
    if (grid == 0) {
        int dev = 0, cus = 0;
        if (hipGetDevice(&dev) != hipSuccess || hipDeviceGetAttribute(&cus, hipDeviceAttributeMultiprocessorCount, dev) != hipSuccess) { grid = -1; return; }
        if (hipFuncSetAttribute((const void*)fwd, hipFuncAttributeMaxDynamicSharedMemorySize, LDS_BYTES) != hipSuccess) { grid = -1; return; }
        int per_cu = 0; (void)hipOccupancyMaxActiveBlocksPerMultiprocessor(&per_cu, (const void*)fwd, NTHREADS, LDS_BYTES); (void)hipGetLastError();
        grid = cus / 64 * 64;
        if (grid < 64) { grid = -1; return; }
    }
    if (grid < 0) return;
#if CFG_ONE_LAUNCH
    a.lo = 0; a.hi = NSTEPS; hipLaunchKernelGGL(fwd, dim3(grid), dim3(NTHREADS), LDS_BYTES, stream, a);
#else
    for (int s = 0; s < NSTEPS; ++s) { a.lo = s; a.hi = s + 1; hipLaunchKernelGGL(fwd, dim3(grid), dim3(NTHREADS), LDS_BYTES, stream, a); }
#endif
#endif
}
```

```cpp
#ifdef EMU
#include "emu.h"
#else
#include <hip/hip_runtime.h>
#endif
#include <cstdio>
#include <cstdint>
#include <cstring>
#include <cstddef>
#include <cmath>

#ifndef CFG_BATCH
#define CFG_BATCH 16
#endif
#ifndef CFG_SEQ
#define CFG_SEQ 4096
#endif
#ifndef CFG_NSEQ_MB
#define CFG_NSEQ_MB 8
#endif
#ifndef CFG_NEXP
#define CFG_NEXP 32
#endif
#ifndef CFG_ONE_LAUNCH
#define CFG_ONE_LAUNCH 1
#endif

constexpr int BATCH = CFG_BATCH, SEQ = CFG_SEQ, NSEQ_MB = CFG_NSEQ_MB, NEXP = CFG_NEXP, NMB = BATCH / NSEQ_MB;
constexpr int D = 1024, DEPTH = 2, DECB = 16, DECS = 16, NS = DECB * DECS;
constexpr int DINNER = 2048, CONVDIM = 4096;
constexpr int NKV = 4, WINDOW = 128, CHUNK = 64;
constexpr int DIN = 13856, DINP = 14080;
constexpr int NP = NSEQ_MB * SEQ, R = NP + NS;
constexpr int NTE = (NEXP + 15) / 16;
constexpr int RP = ((4 * R + NEXP * 255) + 255) / 256 * 256;
constexpr int NCHUNK = SEQ / CHUNK;
constexpr int C_Z = 0, C_X = 2048, C_B = 4096, C_C = 5120, C_Q = 6144, C_K = 7168, C_V = 7424, C_SCB = 7680, C_SCC = 8704, C_SCH = 9728, C_GSSD = 10752, C_GATT = 11776, C_GSC = 12800, C_DT = 13824;
constexpr float LN_EPS = 1e-5f, ALPHA = 1.41421356237309515f  , SW_LIMIT = 7.0f, SW_ALPHA = 1.702f;
static_assert(BATCH % NSEQ_MB == 0 && SEQ % 256 == 0 && (NEXP & (NEXP - 1)) == 0 && NEXP <= 32 && NEXP >= 4, "config");

constexpr size_t O_YP = 0, O_YS = O_YP + (size_t)BATCH * SEQ * D, O_KP = O_YS + (size_t)NS * D, O_VP = O_KP + (size_t)DEPTH * BATCH * WINDOW * 256,
    O_SSP = O_VP + (size_t)DEPTH * BATCH * WINDOW * 256, O_CVP = O_SSP + (size_t)DEPTH * BATCH * 32 * 64 * 128, O_SCP = O_CVP + (size_t)DEPTH * BATCH * 3 * CONVDIM,
    O_KS = O_SCP + (size_t)DEPTH * BATCH * 2 * D, O_VS = O_KS + (size_t)DEPTH * DECB * DECS * 256, O_SSS = O_VS + (size_t)DEPTH * DECB * DECS * 256,
    O_CVS = O_SSS + (size_t)DEPTH * DECB * 32 * 64 * 128, O_SCS = O_CVS + (size_t)DEPTH * DECB * 3 * CONVDIM, O_END = O_SCS + (size_t)DEPTH * DECB * 2 * D;

constexpr size_t al256(size_t x) { return (x + 255) / 256 * 256; }
constexpr size_t WS_CTL = 0, CTL_BYTES = 1u << 20;
constexpr size_t WS_SSQ = CTL_BYTES, WS_TOPI = WS_SSQ + al256((size_t)R * 128 * 4)  , WS_GATE = WS_TOPI + al256((size_t)R * 16), WS_POS = WS_GATE + al256((size_t)R * 16),
    WS_GSORT = WS_POS + al256((size_t)R * 16), WS_RTOK = WS_GSORT + al256((size_t)RP * 4),
    WS_RWH = WS_RTOK + al256((size_t)RP * 4)  , WS_RWL = WS_RWH + (size_t)DEPTH * NTE * 16 * D * 2  , WS_W = WS_RWL + (size_t)DEPTH * NTE * 16 * D * 2;
constexpr size_t WL_IN = 0, WL_SSD = WL_IN + (size_t)DINP * D * 2, WL_ATT = WL_SSD + (size_t)D * DINNER * 2, WL_SC = WL_ATT + (size_t)D * D * 2, WL_O = WL_SC + (size_t)D * D * 2,
    WL_UP = WL_O + (size_t)D * D * 2, WL_DN = WL_UP + (size_t)NEXP * 2048 * D * 2, WL_BYTES = WL_DN + (size_t)NEXP * D * D * 2;
constexpr size_t WS_XB = WS_W + DEPTH * WL_BYTES, WS_XB0 = WS_XB + (size_t)R * D * 2  , WS_PRE = WS_XB0 + (size_t)NMB * R * D * 2  , WS_H = WS_PRE + (size_t)R * D * 2;
constexpr size_t WS_STAT = WS_PRE;
constexpr size_t H_BYTES = (size_t)R * DINP * 2, MOE_BYTES = (size_t)3 * RP * D * 2, U_BYTES = H_BYTES > MOE_BYTES ? H_BYTES : MOE_BYTES;
constexpr size_t WS_CMC = WS_H + U_BYTES, WS_BTG = WS_CMC + (size_t)NP * 1024 * 2, WS_CBG = WS_BTG + (size_t)NSEQ_MB * NCHUNK * 8 * 8192 * 2, WS_END = WS_CBG + (size_t)NSEQ_MB * NCHUNK * 8 * 4096 * 2;
static_assert(WS_END <= ((size_t)2 << 30), "workspace map exceeds 2 GiB");
constexpr int CW_BAR = 4096, CW_CNT = 16384;

constexpr int RING_BYTES = 131072, LDS_BYTES = 163840  , MISC_OFF = LDS_BYTES - 1024, SCR_BYTES = MISC_OFF;
constexpr int NWAVES = 8, NTHREADS = 512;

#ifdef EMU
#define LAS
#define WAVE_SYNC() emu_wave_barrier()
#else
#define LAS __attribute__((address_space(3)))
#define WAVE_SYNC() asm volatile("s_waitcnt lgkmcnt(0)" ::: "memory")
#endif
#ifdef EMU
#define LBAR() emu_wg_barrier()
#define VM_WAIT(n) do { } while (0)
#else
#define LBAR() do { asm volatile("s_waitcnt lgkmcnt(0)" ::: "memory"); __builtin_amdgcn_s_barrier(); asm volatile("" ::: "memory"); } while (0)
#define VM_WAIT(n) asm volatile("s_waitcnt vmcnt(" #n ")" ::: "memory")
#endif
typedef unsigned short bf16_t;
typedef short bf16x8 __attribute__((ext_vector_type(8)));
typedef float f32x4 __attribute__((ext_vector_type(4)));
typedef float f32x16 __attribute__((ext_vector_type(16)));
typedef unsigned u32x4 __attribute__((ext_vector_type(4)));
typedef unsigned u32x2 __attribute__((ext_vector_type(2)));

__device__ __forceinline__ unsigned f2bf(float f) { unsigned u = __builtin_bit_cast(unsigned, f); return (u + 0x7fffu + ((u >> 16) & 1u)) >> 16; }
__device__ __forceinline__ float bf2f(unsigned h) { return __builtin_bit_cast(float, (h & 0xffffu) << 16); }
#ifdef EMU
__device__ __forceinline__ unsigned pk2(float lo, float hi) { return f2bf(lo) | (f2bf(hi) << 16); }
#else
typedef float f32x2_t __attribute__((ext_vector_type(2))); typedef __bf16 bf16x2_t __attribute__((ext_vector_type(2)));
__device__ __forceinline__ unsigned pk2(float lo, float hi) { f32x2_t v = {lo, hi}; bf16x2_t b = __builtin_convertvector(v, bf16x2_t); return __builtin_bit_cast(unsigned, b); }
#endif
#ifdef EMU
__device__ __forceinline__ unsigned short bf1(float f) { return (unsigned short)f2bf(f); }
#else
__device__ __forceinline__ unsigned short bf1(float f) { return (unsigned short)pk2(f, f); }
#endif
__device__ __forceinline__ float blo(unsigned w) { return __builtin_bit_cast(float, w << 16); }
__device__ __forceinline__ float bhi(unsigned w) { return __builtin_bit_cast(float, w & 0xffff0000u); }
__device__ __forceinline__ void unpack8(const u32x4 w, float* f) { f[0] = blo(w.x); f[1] = bhi(w.x); f[2] = blo(w.y); f[3] = bhi(w.y); f[4] = blo(w.z); f[5] = bhi(w.z); f[6] = blo(w.w); f[7] = bhi(w.w); }
__device__ __forceinline__ u32x4 pack8(const float* f) { u32x4 w; w.x = pk2(f[0], f[1]); w.y = pk2(f[2], f[3]); w.z = pk2(f[4], f[5]); w.w = pk2(f[6], f[7]); return w; }
__device__ __forceinline__ float fexp(float x) { return __builtin_amdgcn_exp2f(x * 1.4426950408889634f); }
__device__ __forceinline__ float fsigmoid(float x) { return __builtin_amdgcn_rcpf(1.0f + __builtin_amdgcn_exp2f(-1.4426950408889634f * x)); }
__device__ __forceinline__ float fsilu(float x) { return x * fsigmoid(x); }
#ifdef EMU
__device__ __forceinline__ int opq(int x) { return x; }
#else
__device__ __forceinline__ int opq(int x) { asm volatile("" : "+v"(x)); return x; }
#endif
#ifdef EMU
__device__ __forceinline__ int opqs(int x) { return x; }
#else
__device__ __forceinline__ int opqs(int x) { asm volatile("" : "+s"(x)); return x; }
#endif
#ifdef EMU
__device__ __forceinline__ int lane_id() { return (int)(threadIdx.x & 63); }
#else
__device__ __forceinline__ int lane_id() { return (int)__builtin_amdgcn_mbcnt_hi(~0u, __builtin_amdgcn_mbcnt_lo(~0u, 0u)); }
#endif
#ifdef EMU
template <int MASK> __device__ __forceinline__ unsigned xshfl_u(unsigned x) { return __shfl_xor(x, MASK); }
#else
template <int MASK> __device__ __forceinline__ unsigned xshfl_u(unsigned x) {
    if constexpr (MASK == 1) return (unsigned)__builtin_amdgcn_update_dpp((int)x, (int)x, 0xB1, 0xF, 0xF, false);
    else if constexpr (MASK == 2) return (unsigned)__builtin_amdgcn_update_dpp((int)x, (int)x, 0x4E, 0xF, 0xF, false);
    else if constexpr (MASK == 4) { const int t = __builtin_amdgcn_update_dpp((int)x, (int)x, 0x114, 0xF, 0xA, false);
        return (unsigned)__builtin_amdgcn_update_dpp(t, (int)x, 0x104, 0xF, 0x5, false); }
    else if constexpr (MASK == 8) return (unsigned)__builtin_amdgcn_update_dpp((int)x, (int)x, 0x128, 0xF, 0xF, false);
    else if constexpr (MASK == 16) { const auto rr = __builtin_amdgcn_permlane16_swap(x, x, false, false); return (lane_id() & 16) ? rr[0] : rr[1]; }
    else { const auto rr = __builtin_amdgcn_permlane32_swap(x, x, false, false); return (lane_id() & 32) ? rr[0] : rr[1]; }
}
#endif
template <int MASK> __device__ __forceinline__ float xshfl(float x) { return __builtin_bit_cast(float, xshfl_u<MASK>(__builtin_bit_cast(unsigned, x))); }
template <int MASK> __device__ __forceinline__ int xshfl(int x) { return (int)xshfl_u<MASK>((unsigned)x); }
__device__ __forceinline__ float wave_sum(float v) { v += xshfl<1>(v); v += xshfl<2>(v); v += xshfl<4>(v); v += xshfl<8>(v); v += xshfl<16>(v); v += xshfl<32>(v); return v; }
#ifdef EMU
__device__ __forceinline__ float wave_scan_incl(float v, int lane) { for (int o = 1; o < 64; o <<= 1) { const float t = __shfl(v, lane - o < 0 ? 0 : lane - o); if (lane >= o) v += t; } return v; }
__device__ __forceinline__ float wave_last(float v) { return __shfl(v, 63); }
__device__ __forceinline__ int wave_scan_incl_i(int v, int lane) { for (int o = 1; o < 64; o <<= 1) { const int t = __shfl(v, lane - o < 0 ? 0 : lane - o); if (lane >= o) v += t; } return v; }
#else
__device__ __forceinline__ int wave_scan_incl_i(int v, int) {
#define WSC_STEP(ctrl_, rm_) v += __builtin_amdgcn_update_dpp(0, v, ctrl_, rm_, 0xF, false)
    WSC_STEP(0x111, 0xF); WSC_STEP(0x112, 0xF); WSC_STEP(0x114, 0xF); WSC_STEP(0x118, 0xF); WSC_STEP(0x142, 0xA); WSC_STEP(0x143, 0xC);
#undef WSC_STEP
    return v;
}
__device__ __forceinline__ float wave_scan_incl(float v, int) {
#define WSC_STEP(ctrl_, rm_) v += __builtin_bit_cast(float, __builtin_amdgcn_update_dpp(0, __builtin_bit_cast(int, v), ctrl_, rm_, 0xF, false))
    WSC_STEP(0x111, 0xF); WSC_STEP(0x112, 0xF); WSC_STEP(0x114, 0xF); WSC_STEP(0x118, 0xF); WSC_STEP(0x142, 0xA); WSC_STEP(0x143, 0xC);
#undef WSC_STEP
    return v;
}
__device__ __forceinline__ float wave_last(float v) { return __builtin_bit_cast(float, __builtin_amdgcn_readlane(__builtin_bit_cast(int, v), 63)); }
#endif

#ifndef PROBE_MASK
#define PROBE_MASK 0
#endif
#if PROBE_MASK && !defined(EMU)
#define PROBE_T0(b) unsigned long long pt0_ = 0; if constexpr ((PROBE_MASK >> (b)) & 1) pt0_ = __builtin_amdgcn_s_memrealtime();
#define PROBE_T1(b) if constexpr ((PROBE_MASK >> (b)) & 1) { asm volatile("s_waitcnt vmcnt(0) lgkmcnt(0)" ::: "memory"); const unsigned long long pt1_ = __builtin_amdgcn_s_memrealtime(); \
    while (__builtin_amdgcn_s_memrealtime() < pt1_ + (pt1_ - pt0_)) __builtin_amdgcn_s_sleep(8); }
#else
#define PROBE_T0(b)
#define PROBE_T1(b)
#endif
namespace pg8 {
constexpr int BM = 256, BK = 64, HALF = 128, HTB = HALF * BK * 2, NXCD = 8, WGM = 8;
struct Unit { int pm, pn, bt, e; int par = 0; };
struct Gemm { const bf16_t* A; const bf16_t* Bt; int M, N, K, lda; const int* tok; const float* ssq = nullptr; };
struct StaticOrder {
    int nM, nN, nwg, G, c, wgm;
    __host__ __device__ void init(int M, int N, int G_, int c_, int wgm_ = WGM) { nM = M / BM; nN = N / BM; nwg = nM * nN; G = G_; c = c_; wgm = wgm_; }
    __host__ __device__ bool next(int i, Unit& u) const {
        const long L = (long)i * G + c; if (L >= nwg) return false;
        int wgid = (int)L; { const int q = nwg / NXCD, r = nwg % NXCD, xcd = wgid % NXCD, off = wgid / NXCD; wgid = (xcd < r ? xcd * (q + 1) : r * (q + 1) + (xcd - r) * q) + off; }
        const int nig = wgm * nN, gid = wgid / nig, fm = gid * wgm, gsz = (nM - fm) < wgm ? (nM - fm) : wgm;
        u.pm = fm + ((wgid % nig) % gsz); u.pn = (wgid % nig) / gsz; u.bt = u.pn; u.e = 0; return true;
    }
    __device__ __forceinline__ void a_ready(const Unit&) const {}
    __device__ __forceinline__ void done(const Unit&) const {}
};
struct MoeOrder {
    const LAS int* tend; int npn, ntot, G, c;
    __device__ __forceinline__ bool next(int i, Unit& u) const {
        int rt, pn;
        {
            const int xcd = c & 7, j = c >> 3, rpx = (G >> 3) / npn; rt = (i * 8 + xcd) * rpx + j / npn; pn = j % npn; if (rt >= ntot / npn) return false; }
        int e = 0;
#pragma unroll
        for (int j = 0; j < NEXP; ++j) e += (tend[j] <= rt) ? 1 : 0;
        u.pm = rt; u.pn = pn; u.e = e; u.bt = e * npn + pn; return true;
    }
    __device__ __forceinline__ void a_ready(const Unit&) const {}
    __device__ __forceinline__ void done(const Unit&) const {}
};
#ifdef EMU
template <class Epi, class Sched, bool GATHER = false, bool GSCALE = false>
__device__ void gemm_phase(LAS unsigned char* lds, const Gemm g, const Sched& S, const Epi& E, int  ) {
    const int tid = threadIdx.x, wid = tid >> 6, lane = tid & 63, wr = wid >> 2, wc = wid & 3, fr = lane & 15, fq = lane >> 4;
    Unit u;
    for (int i = 0; S.next(i, u); ++i) {
        f32x4 acc[2][2][4][2];
        for (int ai = 0; ai < 2; ++ai) for (int bj = 0; bj < 2; ++bj) for (int m = 0; m < 4; ++m) for (int n = 0; n < 2; ++n) for (int q = 0; q < 4; ++q) {
            const int row = u.pm * 256 + ai * 128 + wr * 64 + m * 16 + fr, col = u.bt * 256 + bj * 128 + wc * 32 + 8 * fq + 4 * n + q;
            const bf16_t* a = g.A + (size_t)(GATHER ? ((unsigned)g.tok[row] < (unsigned)g.M ? g.tok[row] : 0) : row) * g.lda; const bf16_t* b = g.Bt + (size_t)col * g.K; float s = 0.f;
            if constexpr (GSCALE) {
                float rs[9]; for (int j = 0; j < 8; ++j) { float q2 = 0.f; for (int i = 0; i < 16; ++i) q2 += g.ssq[(size_t)row * 128 + 16 * j + i]; rs[j] = 1.0f / sqrtf(q2 * (1.0f / 256.0f) + LN_EPS); } rs[8] = 1.f;
                for (int j = 0; j < 8; ++j) { for (int k = 256 * j; k < 256 * j + 256; ++k) s += bf2f(a[k]) * bf2f(b[k]); s *= rs[j] * (1.0f / rs[j + 1]); } }
            else for (int k = 0; k < g.K; ++k) s += bf2f(a[k]) * bf2f(b[k]);
            acc[ai][bj][m][n][q] = s; }
        u.par = i & 1; __syncthreads(); E.pre(u, lds, wid, lane); __syncthreads();
        E(acc, u, wr, wc, fr, fq);
    }
    __syncthreads();
}
#else
#define PG8_LAS __attribute__((address_space(3)))
__host__ __device__ __forceinline__ int lds_byte(int r, int c) { const int st = (r >> 4) * 2 + (c >> 5), rr = r & 15, cc = c & 31, ob = rr * 64 + cc * 2; return st * 1024 + (ob ^ (((ob >> 9) & 1) << 5)); }
__host__ __device__ __forceinline__ void stage_rc(int b, int& R_, int& C_) { const int st = b / 1024, sb = b % 1024, swz = sb ^ (((sb >> 9) & 1) << 5); R_ = (st >> 1) * 16 + swz / 64; C_ = (st & 1) * 32 + (swz % 64) / 2; }
__host__ __device__ __forceinline__ int perm32(int rho) { const int n = rho >> 4, i = rho & 15; return 8 * (i >> 2) + 4 * n + (i & 3); }
template <class Epi, class Sched, bool GATHER = false, bool GSCALE = false>
__device__ __forceinline__ void gemm_phase(PG8_LAS unsigned char* lds, const Gemm g, const Sched& S, const Epi& E, int wave_id) {
    const int lane = opq(lane_id()), wid = opqs(wave_id), tid = wid * 64 + lane, wr = wid >> 2, wc = wid & 3, fr = lane & 15, fq = lane >> 4;
    const int K = g.K, nt = K / BK, lda = g.lda;
    unsigned voffA[2], voffB[2];
#pragma unroll
    for (int i = 0; i < 2; ++i) { int R_, C_; stage_rc(tid * 16 + i * 8192, R_, C_); const int Rb = (R_ & ~31) + perm32(R_ & 31);
        voffA[i] = (unsigned)(R_ * lda + C_) * 2u; voffB[i] = (unsigned)(Rb * K + C_) * 2u; }
    unsigned vG[2][2], vN[2][2];
#define PG8_TOK(dst, pm_) do { _Pragma("unroll") for (int i_ = 0; i_ < 2; ++i_) { int R_, C_; stage_rc(opq(tid) * 16 + i_ * 8192, R_, C_); _Pragma("unroll") for (int h_ = 0; h_ < 2; ++h_) \
        { unsigned tk_ = (unsigned)g.tok[(pm_) * 256 + h_ * 128 + R_]; tk_ = tk_ < (unsigned)g.M ? tk_ : 0u; dst[h_][i_] = tk_ * (unsigned)(lda * 2) + (unsigned)(C_ * 2); } } } while (0)
#define PG8_STAGE_A(bufoff, base_, h_, nx_) do { if constexpr (GATHER) { unsigned vs_[2] = {(nx_) ? vN[h_][0] : vG[h_][0], (nx_) ? vN[h_][1] : vG[h_][1]}; PG8_STAGE(bufoff, base_, vs_); } \
        else { PG8_STAGE(bufoff, (base_) + ((h_) ? hstepA : 0), voffA); } } while (0)
    const size_t kstep = (size_t)(BK * 2);
    const size_t hstepA = (size_t)HALF * lda * 2, tstepA = 2 * hstepA;
    const size_t hstepB = (size_t)HALF * K * 2, tstepB = 2 * hstepB;
    const unsigned ldsw = (unsigned)wid * 1024u;
    const int aoff = lds_byte(wr * 64 + fr, fq * 8), boff = lds_byte(wc * 32 + fr, fq * 8);
#define PG8_SA(b, h) (((b) * 2 + (h)) * HTB)
#define PG8_SB(b, h) ((4 + (b) * 2 + (h)) * HTB)
#define PG8_STAGE(bufoff, gbase, voff) do { _Pragma("unroll") for (int _i = 0; _i < 2; ++_i) \
        __builtin_amdgcn_global_load_lds((const unsigned*)((const char*)(gbase) + (voff)[_i]), (PG8_LAS unsigned*)(lds + (bufoff) + ldsw + _i * 8192), 16, 0, 0); } while (0)
#define PG8_LDA(dst, b, h) do { _Pragma("unroll") for (int m = 0; m < 4; ++m) _Pragma("unroll") for (int k = 0; k < 2; ++k) dst[m][k] = *(const PG8_LAS bf16x8*)(lds + PG8_SA(b, h) + aoff + m * 2048 + k * 1024); } while (0)
#define PG8_LDB(dst, b, h) do { _Pragma("unroll") for (int n = 0; n < 2; ++n) _Pragma("unroll") for (int k = 0; k < 2; ++k) dst[n][k] = *(const PG8_LAS bf16x8*)(lds + PG8_SB(b, h) + boff + n * 2048 + k * 1024); } while (0)
#define PG8_MMA(ai, bj, At, Bt) do { __builtin_amdgcn_s_setprio(1); _Pragma("unroll") for (int m = 0; m < 4; ++m) _Pragma("unroll") for (int n = 0; n < 2; ++n) _Pragma("unroll") for (int k = 0; k < 2; ++k) \
        acc[ai][bj][m][n] = __builtin_amdgcn_mfma_f32_16x16x32_bf16(Bt[n][k], At[m][k], acc[ai][bj][m][n], 0, 0, 0); __builtin_amdgcn_s_setprio(0); } while (0)
#define PG8_WAIT_V(n) asm volatile("s_waitcnt vmcnt(" #n ")" ::: "memory")
#define PG8_WAIT_L(n) asm volatile("s_waitcnt lgkmcnt(" #n ")" ::: "memory")
#define PG8_BAR __builtin_amdgcn_s_barrier()
#define PG8_SCHED __builtin_amdgcn_sched_barrier(0)
    Unit cur, nxt; int ui = 0;
    if (!S.next(0, cur)) return;
    if constexpr (GSCALE) {
        static_assert(RING_BYTES + 3 * 8192 <= MISC_OFF, "group-norm factor tables");
        Unit tu;
        if (S.next(3, tu)) __builtin_trap();
#pragma unroll 1
        for (int q = 0; q < 3 && S.next(q, tu); ++q) { const int row = tid & 255, h = tid >> 8;
            const float* sp = g.ssq + (size_t)(tu.pm * 256 + row) * 128 + 64 * h; float qv[5];
#pragma unroll
            for (int gi = 0; gi < 5; ++gi) { f32x4 a_ = (f32x4){0.f, 0.f, 0.f, 0.f}, b_ = a_; if (gi < 4 || h == 0) { a_ = *(const f32x4*)(sp + 16 * gi) + *(const f32x4*)(sp + 16 * gi + 8); b_ = *(const f32x4*)(sp + 16 * gi + 4) + *(const f32x4*)(sp + 16 * gi + 12); }
                a_ = a_ + b_; qv[gi] = sqrtf(((a_[0] + a_[1]) + (a_[2] + a_[3])) * (1.0f / 256.0f) + LN_EPS); }
            PG8_LAS float* ct = (PG8_LAS float*)(lds + RING_BYTES) + q * 2048 + 4 * h * 256 + row;
#pragma unroll
            for (int j = 0; j < 4; ++j) ct[j * 256] = (h == 1 && j == 3) ? 1.0f / qv[3] : qv[j + 1] / qv[j]; }
        __syncthreads();
    }
    f32x4 acc[2][2][4][2];
#pragma unroll
    for (int a = 0; a < 2; ++a)
#pragma unroll
        for (int b = 0; b < 2; ++b)
#pragma unroll
            for (int m = 0; m < 4; ++m)
#pragma unroll
                for (int n = 0; n < 2; ++n) acc[a][b][m][n] = (f32x4){0.f, 0.f, 0.f, 0.f};
    bf16x8 At[4][2], B0[2][2], B1[2][2];
    const char* cA = (const char*)g.A + (GATHER ? (size_t)0 : (size_t)cur.pm * tstepA); const char* cB = (const char*)g.Bt + (size_t)cur.bt * tstepB;
    if constexpr (GATHER) { PG8_TOK(vG, cur.pm); }
    S.a_ready(cur);
    PG8_STAGE(PG8_SB(0, 0), cB, voffB); PG8_STAGE(PG8_SB(0, 1), cB + hstepB, voffB); PG8_STAGE_A(PG8_SA(0, 0), cA, 0, false); PG8_STAGE_A(PG8_SA(0, 1), cA, 1, false);
    if (wr == 1) PG8_BAR;
    PG8_WAIT_V(2); PG8_BAR;
    PG8_STAGE(PG8_SB(1, 0), cB + kstep, voffB); PG8_STAGE_A(PG8_SA(1, 0), cA + kstep, 0, false); PG8_STAGE(PG8_SB(1, 1), cB + hstepB + kstep, voffB);
    PG8_WAIT_V(6); PG8_BAR;
    for (;;) {
        cur.par = ui & 1; E.pre(cur, lds, wid, lane);
        const bool has_next = S.next(ui + 1, nxt);
        const char* nA = has_next ? (const char*)g.A + (GATHER ? (size_t)0 : (size_t)nxt.pm * tstepA) : cA; const char* nB = has_next ? (const char*)g.Bt + (size_t)nxt.bt * tstepB : cB;
        if constexpr (GATHER) {
#pragma unroll
            for (int h_ = 0; h_ < 2; ++h_) { vN[h_][0] = vG[h_][0]; vN[h_][1] = vG[h_][1]; }
            if (has_next) {
#pragma unroll
                for (int i_ = 0; i_ < 2; ++i_) { int R_, C_; stage_rc(opq(tid) * 16 + i_ * 8192, R_, C_);
#pragma unroll
                    for (int h_ = 0; h_ < 2; ++h_) { const int* tp_ = g.tok + nxt.pm * 256 + h_ * 128 + R_;
                        asm volatile("global_load_dword %0, %1, off" : "=v"(vN[h_][i_]) : "v"(tp_) : "memory"); } } } }
        for (int t = 0; t < nt; t += 2) {
            const bool last = (t == nt - 2);
            const char* a1 = cA + (size_t)(t + 1) * kstep;
            const char* a2 = last ? nA : cA + (size_t)(t + 2) * kstep; const char* b2 = last ? nB : cB + (size_t)(t + 2) * kstep;
            const char* a3 = a2 + kstep; const char* b3 = b2 + kstep;
            if (last && has_next) S.a_ready(nxt);
            if constexpr (GATHER) { if (last && has_next) {
#pragma unroll
                for (int i_ = 0; i_ < 2; ++i_) { int R_, C_; stage_rc(opq(tid) * 16 + i_ * 8192, R_, C_);
#pragma unroll
                    for (int h_ = 0; h_ < 2; ++h_) { unsigned tk_ = vN[h_][i_]; asm volatile("" : "+v"(tk_)); tk_ = tk_ < (unsigned)g.M ? tk_ : 0u; vN[h_][i_] = tk_ * (unsigned)(lda * 2) + (unsigned)(C_ * 2); } } } }
            PG8_LDB(B0, 0, 0); PG8_LDB(B1, 0, 1); PG8_SCHED; PG8_LDA(At, 0, 0); PG8_STAGE_A(PG8_SA(1, 1), a1, 1, false);
            PG8_WAIT_V(8); PG8_WAIT_L(0); PG8_BAR; PG8_MMA(0, 0, At, B0); PG8_MMA(0, 1, At, B1); PG8_BAR; PG8_SCHED;
            PG8_LDA(At, 0, 1); PG8_STAGE(PG8_SB(0, 0), b2, voffB); PG8_STAGE(PG8_SB(0, 1), b2 + hstepB, voffB); PG8_STAGE_A(PG8_SA(0, 0), a2, 0, last);
            PG8_WAIT_V(8); PG8_WAIT_L(0); PG8_BAR; PG8_MMA(1, 0, At, B0); PG8_MMA(1, 1, At, B1); PG8_BAR; PG8_SCHED;
            PG8_LDB(B0, 1, 0); PG8_LDB(B1, 1, 1); PG8_SCHED; PG8_LDA(At, 1, 0); PG8_STAGE_A(PG8_SA(0, 1), a2, 1, last);
            PG8_WAIT_V(8); PG8_WAIT_L(0); PG8_BAR; PG8_MMA(0, 0, At, B0); PG8_MMA(0, 1, At, B1); PG8_BAR; PG8_SCHED;
            PG8_LDA(At, 1, 1); PG8_STAGE(PG8_SB(1, 0), b3, voffB); PG8_STAGE(PG8_SB(1, 1), b3 + hstepB, voffB); PG8_STAGE_A(PG8_SA(1, 0), a3, 0, last);
            PG8_WAIT_V(8); PG8_WAIT_L(0); PG8_BAR; PG8_MMA(1, 0, At, B0); PG8_MMA(1, 1, At, B1); PG8_BAR; PG8_SCHED;
            if constexpr (GSCALE) { if (t & 2) {
                const PG8_LAS float* cp = (const PG8_LAS float*)(lds + RING_BYTES) + ui * 2048 + (t >> 2) * 256 + wr * 64 + fr; float cv[2][4];
#pragma unroll
                for (int a = 0; a < 2; ++a)
#pragma unroll
                    for (int m = 0; m < 4; ++m) cv[a][m] = cp[a * 128 + m * 16];
#pragma unroll
                for (int a = 0; a < 2; ++a)
#pragma unroll
                    for (int b = 0; b < 2; ++b)
#pragma unroll
                        for (int m = 0; m < 4; ++m)
#pragma unroll
                            for (int n = 0; n < 2; ++n) acc[a][b][m][n] = acc[a][b][m][n] * cv[a][m];
                PG8_SCHED; } }
        }
        if (wr == 0) PG8_BAR;
        E(acc, cur, wr, wc, fr, fq); S.done(cur);
        if (!has_next) break;
#pragma unroll
        for (int a = 0; a < 2; ++a)
#pragma unroll
            for (int b = 0; b < 2; ++b)
#pragma unroll
                for (int m = 0; m < 4; ++m)
#pragma unroll
                    for (int n = 0; n < 2; ++n) acc[a][b][m][n] = (f32x4){0.f, 0.f, 0.f, 0.f};
        cur = nxt; cA = nA; cB = nB; ++ui;
        if constexpr (GATHER) {
#pragma unroll
            for (int h_ = 0; h_ < 2; ++h_) { vG[h_][0] = vN[h_][0]; vG[h_][1] = vN[h_][1]; } }
        if (wr == 1) PG8_BAR;
    }
    PG8_WAIT_V(0);
    PG8_BAR;
#undef PG8_SA
#undef PG8_SB
#undef PG8_STAGE
#undef PG8_STAGE_A
#undef PG8_TOK
#undef PG8_LDA
#undef PG8_LDB
#undef PG8_MMA
#undef PG8_WAIT_V
#undef PG8_WAIT_L
#undef PG8_BAR
#undef PG8_SCHED
}
#endif

struct EpiStoreBf16 {
    __device__ __forceinline__ void pre(const Unit&, LAS unsigned char*, int, int) const {}
    bf16_t* O; int ldc;
    __device__ __forceinline__ void operator()(const f32x4 (&acc)[2][2][4][2], const Unit& u, int wr, int wc, int fr, int fq) const {
        const int row0 = u.pm * 256 + wr * 64 + fr, col0 = u.pn * 256 + wc * 32 + 8 * fq;
#pragma unroll
        for (int ai = 0; ai < 2; ++ai)
#pragma unroll
            for (int m = 0; m < 4; ++m)
#pragma unroll
                for (int bj = 0; bj < 2; ++bj) { const f32x4 v0 = acc[ai][bj][m][0], v1 = acc[ai][bj][m][1];
                    u32x4 w; w.x = pk2(v0[0], v0[1]); w.y = pk2(v0[2], v0[3]); w.z = pk2(v1[0], v1[1]); w.w = pk2(v1[2], v1[3]);
                    *(u32x4*)(O + (size_t)(row0 + ai * 128 + m * 16) * ldc + col0 + bj * 128) = w; }
    }
};
template <int MODE> struct EpiGate {
    const bf16_t* Hg; bf16_t* MGb;
    __device__ __forceinline__ void pre(const Unit&, LAS unsigned char*, int, int) const {}
    __device__ __forceinline__ void operator()(const f32x4 (&acc)[2][2][4][2], const Unit& u, int wr, int wc, int fr, int fq) const {
        const int row0 = u.pm * 256 + wr * 64 + fr, col0 = u.pn * 256 + wc * 32 + 8 * fq;
        u32x4 gw[2][2][2], pw[2][2][2];
#define EG_LOAD(s_) do { const int ai_ = (s_) >> 1, m0_ = 2 * ((s_) & 1); _Pragma("unroll") for (int mm = 0; mm < 2; ++mm) _Pragma("unroll") for (int bj = 0; bj < 2; ++bj) { \
            const int row = row0 + ai_ * 128 + (m0_ + mm) * 16, col = col0 + bj * 128; gw[(s_) & 1][mm][bj] = *(const u32x4*)(Hg + (size_t)row * DINP + col); if (MODE != 0) pw[(s_) & 1][mm][bj] = *(const u32x4*)(MGb + (size_t)row * D + col); } } while (0)
#define EG_COMP(s_) do { const int ai_ = (s_) >> 1, m0_ = 2 * ((s_) & 1); _Pragma("unroll") for (int mm = 0; mm < 2; ++mm) _Pragma("unroll") for (int bj = 0; bj < 2; ++bj) { \
            const int row = row0 + ai_ * 128 + (m0_ + mm) * 16, col = col0 + bj * 128; const f32x4 v0 = acc[ai_][bj][m0_ + mm][0], v1 = acc[ai_][bj][m0_ + mm][1]; \
            float g[8], p[8], v[8] = {v0[0], v0[1], v0[2], v0[3], v1[0], v1[1], v1[2], v1[3]}; unpack8(gw[(s_) & 1][mm][bj], g); \
            if (MODE != 0) { unpack8(pw[(s_) & 1][mm][bj], p); _Pragma("unroll") for (int i = 0; i < 8; ++i) v[i] = p[i] + v[i] * fsigmoid(g[i]); } \
            else { _Pragma("unroll") for (int i = 0; i < 8; ++i) v[i] = v[i] * fsigmoid(g[i]); } \
            *(u32x4*)(MGb + (size_t)row * D + col) = pack8(v); } } while (0)
        EG_LOAD(0); EG_LOAD(1); asm volatile("" ::: "memory");
        EG_COMP(0); asm volatile("" ::: "memory"); EG_LOAD(2); asm volatile("" ::: "memory");
        EG_COMP(1); asm volatile("" ::: "memory"); EG_LOAD(3); asm volatile("" ::: "memory");
        EG_COMP(2); asm volatile("" ::: "memory");
        EG_COMP(3); asm volatile("" ::: "memory");
#undef EG_LOAD
#undef EG_COMP
    }
};
struct EpiResid {
    const float* xp; const float* xs; float* op; float* os;
    float* st;
    __device__ __forceinline__ void pre(const Unit&, LAS unsigned char*, int, int) const {}
    __device__ __forceinline__ void operator()(const f32x4 (&acc)[2][2][4][2], const Unit& u, int wr, int wc, int fr, int fq) const {
        const int row0 = u.pm * 256 + wr * 64 + fr, col0 = u.pn * 256 + wc * 32 + 8 * fq;
        const bool smp = u.pm * 256 >= NP;
        const float* xb = smp ? xs - (size_t)NP * D : xp; float* ob = smp ? os - (size_t)NP * D : op;
        f32x4 xa[2][2][2][2];
#define ER_LOAD(s_) do { const int ai_ = (s_) >> 1, m0_ = 2 * ((s_) & 1); _Pragma("unroll") for (int mm = 0; mm < 2; ++mm) _Pragma("unroll") for (int bj = 0; bj < 2; ++bj) { \
            const float* xi = xb + (size_t)(row0 + ai_ * 128 + (m0_ + mm) * 16) * D + col0 + bj * 128; xa[(s_) & 1][mm][bj][0] = *(const f32x4*)xi; xa[(s_) & 1][mm][bj][1] = *(const f32x4*)(xi + 4); } } while (0)
#define ER_COMP(s_) do { const int ai_ = (s_) >> 1, m0_ = 2 * ((s_) & 1); _Pragma("unroll") for (int mm = 0; mm < 2; ++mm) { float s1 = 0.f, s2 = 0.f; const int row = row0 + ai_ * 128 + (m0_ + mm) * 16; \
            _Pragma("unroll") for (int bj = 0; bj < 2; ++bj) { float* xo = ob + (size_t)row * D + col0 + bj * 128; \
                const f32x4 o0 = xa[(s_) & 1][mm][bj][0] * ALPHA + acc[ai_][bj][m0_ + mm][0], o1 = xa[(s_) & 1][mm][bj][1] * ALPHA + acc[ai_][bj][m0_ + mm][1]; *(f32x4*)xo = o0; *(f32x4*)(xo + 4) = o1; \
                s1 += ((o0[0] + o0[1]) + (o0[2] + o0[3])) + ((o1[0] + o1[1]) + (o1[2] + o1[3])); s2 += ((o0[0] * o0[0] + o0[1] * o0[1]) + (o0[2] * o0[2] + o0[3] * o0[3])) + ((o1[0] * o1[0] + o1[1] * o1[1]) + (o1[2] * o1[2] + o1[3] * o1[3])); } \
            s1 += xshfl<16>(s1); s1 += xshfl<32>(s1); s2 += xshfl<16>(s2); s2 += xshfl<32>(s2); \
            if (fq == 0) { float* sp = st + (size_t)row * 32 + 2 * (u.pn * 4 + wc); sp[0] = s1; sp[1] = s2; } } } while (0)
        ER_LOAD(0); ER_LOAD(1); asm volatile("" ::: "memory");
        ER_COMP(0); asm volatile("" ::: "memory"); ER_LOAD(2); asm volatile("" ::: "memory");
        ER_COMP(1); asm volatile("" ::: "memory"); ER_LOAD(3); asm volatile("" ::: "memory");
        ER_COMP(2); asm volatile("" ::: "memory");
        ER_COMP(3); asm volatile("" ::: "memory");
#undef ER_LOAD
#undef ER_COMP
    }
};
struct EpiSwiglu {
    bf16_t* ACT; const float* bup;
    LAS unsigned char* el;
    __device__ __forceinline__ void pre(const Unit& u, LAS unsigned char* lds, int wid, int lane) const {
        const float* src = bup + (size_t)u.e * 2048 + (wid * 64 + lane) * 4;
#ifdef EMU
        memcpy(lds + RING_BYTES + u.par * 8192 + (wid * 64 + lane) * 16, src, 16);
#else
        __builtin_amdgcn_global_load_lds((const unsigned*)src, (LAS unsigned*)(lds + RING_BYTES + u.par * 8192 + wid * 1024), 16, 0, 0);
#endif
    }
    static __device__ __forceinline__ f32x4 glu4(f32x4 g, f32x4 u1) {
        const f32x4 ga = __builtin_elementwise_min(g, (f32x4){SW_LIMIT, SW_LIMIT, SW_LIMIT, SW_LIMIT});
        const f32x4 ua = __builtin_elementwise_min(__builtin_elementwise_max(u1, (f32x4){1.0f - SW_LIMIT, 1.0f - SW_LIMIT, 1.0f - SW_LIMIT, 1.0f - SW_LIMIT}), (f32x4){1.0f + SW_LIMIT, 1.0f + SW_LIMIT, 1.0f + SW_LIMIT, 1.0f + SW_LIMIT});
        const f32x4 t = ga * (-SW_ALPHA * 1.4426950408889634f); f32x4 e;
        e[0] = __builtin_amdgcn_exp2f(t[0]); e[1] = __builtin_amdgcn_exp2f(t[1]); e[2] = __builtin_amdgcn_exp2f(t[2]); e[3] = __builtin_amdgcn_exp2f(t[3]);
        e = e + 1.0f; f32x4 r;
        r[0] = __builtin_amdgcn_rcpf(e[0]); r[1] = __builtin_amdgcn_rcpf(e[1]); r[2] = __builtin_amdgcn_rcpf(e[2]); r[3] = __builtin_amdgcn_rcpf(e[3]);
        return (ua * ga) * r;
    }
    __device__ __forceinline__ void operator()(const f32x4 (&acc)[2][2][4][2], const Unit& u, int wr, int wc, int fr, int fq) const {
        const int row0_ = u.pm * 256 + wr * 64 + fr, j0 = u.pn * 128 + wc * 32 + 8 * fq;
        const LAS float* bg = (const LAS float*)(el + RING_BYTES + u.par * 8192) + j0; const f32x4 bg0 = *(const LAS f32x4*)bg, bg1 = *(const LAS f32x4*)(bg + 4), bu0 = *(const LAS f32x4*)(bg + 1024) + 1.0f, bu1 = *(const LAS f32x4*)(bg + 1028) + 1.0f;
#pragma unroll
        for (int ai = 0; ai < 2; ++ai)
#pragma unroll
            for (int m = 0; m < 4; ++m) { const int row = row0_ + ai * 128 + m * 16;
                const f32x4 o0 = glu4(acc[ai][0][m][0] + bg0, acc[ai][1][m][0] + bu0), o1 = glu4(acc[ai][0][m][1] + bg1, acc[ai][1][m][1] + bu1);
                u32x4 w; w.x = pk2(o0[0], o0[1]); w.y = pk2(o0[2], o0[3]); w.z = pk2(o1[0], o1[1]); w.w = pk2(o1[2], o1[3]);
                *(u32x4*)(ACT + (size_t)row * D + j0) = w; }
    }
};
struct EpiDown {
    bf16_t* O; const float* bdn; const float* gs;
    LAS unsigned char* el;
    __device__ __forceinline__ void pre(const Unit& u, LAS unsigned char* lds, int wid, int lane) const {
        if (wid > 4) return;
        const float* src = wid < 4 ? bdn + (size_t)u.e * D + (wid * 64 + lane) * 4 : gs + (size_t)u.pm * 256 + lane * 4;
#ifdef EMU
        memcpy(lds + RING_BYTES + u.par * 8192 + (wid * 64 + lane) * 16, src, 16);
#else
        __builtin_amdgcn_global_load_lds((const unsigned*)src, (LAS unsigned*)(lds + RING_BYTES + u.par * 8192 + wid * 1024), 16, 0, 0);
#endif
    }
    __device__ __forceinline__ void operator()(const f32x4 (&acc)[2][2][4][2], const Unit& u, int wr, int wc, int fr, int fq) const {
        const int row0 = u.pm * 256 + wr * 64 + fr, col0 = u.pn * 256 + wc * 32 + 8 * fq;
        float gt[2][4]; f32x4 bv[2][2];
#pragma unroll
        for (int ai = 0; ai < 2; ++ai)
#pragma unroll
            for (int m = 0; m < 4; ++m) gt[ai][m] = ((const LAS float*)(el + RING_BYTES + u.par * 8192) + 1024)[wr * 64 + fr + ai * 128 + m * 16];
#pragma unroll
        for (int bj = 0; bj < 2; ++bj) { const LAS float* bp = (const LAS float*)(el + RING_BYTES + u.par * 8192) + col0 + bj * 128; bv[bj][0] = *(const LAS f32x4*)bp; bv[bj][1] = *(const LAS f32x4*)(bp + 4); }
#pragma unroll
        for (int ai = 0; ai < 2; ++ai) {
#pragma unroll
            for (int bj = 0; bj < 2; ++bj) {
#pragma unroll
                for (int m = 0; m < 4; ++m) { const f32x4 a0 = (acc[ai][bj][m][0] + bv[bj][0]) * gt[ai][m], a1 = (acc[ai][bj][m][1] + bv[bj][1]) * gt[ai][m];
                    u32x4 w; w.x = pk2(a0[0], a0[1]); w.y = pk2(a0[2], a0[3]); w.z = pk2(a1[0], a1[1]); w.w = pk2(a1[2], a1[3]);
                    *(u32x4*)(O + (size_t)(row0 + ai * 128 + m * 16) * D + col0 + bj * 128) = w; } }
            asm volatile("" ::: "memory");
        }
    }
};
}

#ifndef EMU
#define XB_TMO      128
#define XB_XCNT(j)  (256  + 64 * (j))
#define XB_XSUB(j)  (1280 + 64 * (j))
#define XB_XGEN(j)  (2304 + 64 * (j))
#define XB_TOP      3328
#define XB_TOPGEN   3392
#define XCD_BAR_WORDS 3456
#define XB_SPIN_CAP (1u << 27)
__device__ __forceinline__ unsigned xb_ld(unsigned* p)              { return __hip_atomic_load(p, __ATOMIC_RELAXED, __HIP_MEMORY_SCOPE_AGENT); }
__device__ __forceinline__ unsigned xb_add(unsigned* p, unsigned v) { return __hip_atomic_fetch_add(p, v, __ATOMIC_RELAXED, __HIP_MEMORY_SCOPE_AGENT); }
__device__ __forceinline__ unsigned xb_xcc_id() { return (unsigned)__builtin_amdgcn_s_getreg((3 << 11) | 20) & 0xFu; }
#define XB_SPIN(cond, bar) do { unsigned _sp = 0; while (cond) { __builtin_amdgcn_s_sleep(1); \
    if ((++_sp & 255u) == 0u) { if (xb_ld(&(bar)[XB_TMO])) break; if (_sp > XB_SPIN_CAP) { atomicAdd(&(bar)[XB_TMO], 1u); break; } } } } while (0)
struct XcdBarrier { unsigned* bar; unsigned x; volatile LAS unsigned* st; };
__device__ __forceinline__ XcdBarrier xcd_barrier_post(unsigned* bar, volatile LAS unsigned* st) {
    XcdBarrier b; b.bar = bar; b.x = xb_xcc_id(); b.st = st;
    if (threadIdx.x == 0) (void)xb_add(&bar[XB_XCNT(b.x)], 1u);
    return b;
}
__device__ __forceinline__ void xcd_barrier_complete(unsigned* bar, unsigned x, unsigned& nloc, unsigned& nx) {
    const unsigned G = gridDim.x * gridDim.y * gridDim.z;
    unsigned sum, cnt, mine, sp = 0u;
    for (;;) {
        sum = 0u; cnt = 0u; mine = 0u;
#pragma unroll
        for (unsigned j = 0; j < 16; ++j) { const unsigned c = xb_ld(&bar[XB_XCNT(j)]); sum += c; cnt += (c > 0u) ? 1u : 0u; mine = (j == x) ? c : mine; }
        if (sum == G) break;
        __builtin_amdgcn_s_sleep(1);
        if ((++sp & 255u) == 0u) { if (xb_ld(&bar[XB_TMO])) break; if (sp > XB_SPIN_CAP) { atomicAdd(&bar[XB_TMO], 1u); break; } }
    }
    nloc = mine > 0u ? mine : 1u; nx = cnt > 0u ? cnt : 1u;
}
__device__ __forceinline__ void xcd_barrier(const XcdBarrier& b) {
    asm volatile("s_waitcnt vmcnt(0)" ::: "memory");
    __syncthreads();
    if (threadIdx.x == 0) {
        unsigned* bar = b.bar;
        __builtin_amdgcn_s_waitcnt(0);
        unsigned nloc = b.st[0], nx = b.st[1];
        if (nloc == 0u) { xcd_barrier_complete(bar, b.x, nloc, nx); b.st[0] = nloc; b.st[1] = nx; }
        const unsigned old = xb_add(&bar[XB_XSUB(b.x)], 1u);
        const unsigned gen = old / nloc;
        if (old + 1u == (gen + 1u) * nloc) {
            __builtin_amdgcn_fence(__ATOMIC_RELEASE, "agent");
            asm volatile("s_waitcnt vmcnt(0)" ::: "memory");
            const unsigned og = xb_add(&bar[XB_TOP], 1u);
            const unsigned tg = og / nx;
            if (og + 1u == (tg + 1u) * nx) xb_add(&bar[XB_TOPGEN], 1u);
            else XB_SPIN(xb_ld(&bar[XB_TOPGEN]) == tg, bar);
            __builtin_amdgcn_fence(__ATOMIC_ACQUIRE, "agent");
            xb_add(&bar[XB_XGEN(b.x)], 1u);
            asm volatile("s_waitcnt vmcnt(0)" ::: "memory");
        } else {
            XB_SPIN(xb_ld(&bar[XB_XGEN(b.x)]) == gen, bar);
            __builtin_amdgcn_fence(__ATOMIC_ACQUIRE, "agent");
            asm volatile("s_waitcnt vmcnt(0)" ::: "memory");
        }
    }
    __syncthreads();
}
#endif

struct Args { const float* in[31]; float* out; unsigned char* ws; int lo, hi; };
typedef const float* FPtr;
#ifdef EMU
typedef const FPtr* ArgTab;
#else
typedef const __attribute__((address_space(4))) FPtr* ArgTab;
#endif
struct Frame {
    LAS unsigned char* lds; int tid, lane, wave, G, bid;
    ArgTab in; float* out; unsigned char* ws; unsigned* ctl;
};
enum { I_XP = 0, I_XS, I_CK, I_CV, I_SST, I_SCV, I_SSC, I_WIN, I_CONVW, I_CONVB, I_DTB, I_ALOG, I_SD, I_NORMW, I_WSSD, I_SINK, I_WATT, I_RELB, I_SCW, I_WSC, I_WO, I_LN1G, I_LN1B,
       I_RW, I_RB, I_WUP, I_BUP, I_WDN, I_BDN, I_LN2G, I_LN2B };

__device__ __forceinline__ bf16_t* ws_bf(const Frame& F, size_t off) { return (bf16_t*)(F.ws + off); }
__device__ __forceinline__ float* ws_f(const Frame& F, size_t off) { return (float*)(F.ws + off); }
__device__ __forceinline__ bf16_t* wl_ptr(const Frame& F, int layer, size_t off) { return (bf16_t*)(F.ws + WS_W + (size_t)layer * WL_BYTES + off); }

__device__ __forceinline__ void wt_item(const float* W, int ldw, int K, int k0, int nsrc0, const float* kscale, bf16_t* WT, int ndst0, LAS float* scr, int lane) {
    if (nsrc0 < 0) {
#pragma unroll
        for (int j = 0; j < 4; ++j) { const int n = (lane >> 3) + 8 * j; *(u32x4*)(WT + (size_t)(ndst0 + n) * K + k0 + 8 * (lane & 7)) = (u32x4){0u, 0u, 0u, 0u}; }
        return;
    }
#pragma unroll 8
    for (int i = 0; i < 32; ++i) { const int kk = 2 * i + (lane >> 5); float v = W[(size_t)(k0 + kk) * ldw + nsrc0 + (lane & 31)]; if (kscale) v *= kscale[k0 + kk]; scr[kk * 33 + (lane & 31)] = v; }
    WAVE_SYNC();
    const int c = lane & 7;
#pragma unroll
    for (int j = 0; j < 4; ++j) { const int n = (lane >> 3) + 8 * j; const LAS float* s = scr + (8 * c) * 33 + n;
        u32x4 o; o.x = pk2(s[0 * 33], s[1 * 33]); o.y = pk2(s[2 * 33], s[3 * 33]); o.z = pk2(s[4 * 33], s[5 * 33]); o.w = pk2(s[6 * 33], s[7 * 33]);
        *(u32x4*)(WT + (size_t)(ndst0 + n) * K + k0 + 8 * c) = o; }
    WAVE_SYNC();
}
__device__ __forceinline__ void step_weights(const Frame& F) {
    LAS float* scr = (LAS float*)(F.lds + F.wave * 16384);
    const int gw = F.bid * NWAVES + F.wave, NGW = F.G * NWAVES;
    constexpr int I_IN = (DINP / 32) * (D / 64), I_SSD = (D / 32) * (DINNER / 64), I_SQ = (D / 32) * (D / 64), I_UP = NEXP * (2048 / 32) * (D / 64), I_DN = NEXP * (D / 32) * (D / 64);
    constexpr int PER_LAYER = I_IN + I_SSD + 3 * I_SQ + I_UP + I_DN;
    for (int it = gw; it < DEPTH * PER_LAYER; it += NGW) {
        const int layer = it / PER_LAYER; int r = it % PER_LAYER;
        if (r < I_IN) { const int nb = r / (D / 64), kb = r % (D / 64), n0 = nb * 32;
            const int ns = n0 < 6144 ? n0 : (n0 < 13824 ? n0 + 32 : (n0 < 13856 ? n0 - 13824 + 6144 : -1));
            wt_item(F.in[I_WIN] + (size_t)layer * D * DIN, DIN, D, kb * 64, ns, nullptr, wl_ptr(F, layer, WL_IN), n0, scr, F.lane); continue; }
        r -= I_IN;
        if (r < I_SSD) { const int nb = r / (DINNER / 64), kb = r % (DINNER / 64);
            wt_item(F.in[I_WSSD] + (size_t)layer * DINNER * D, D, DINNER, kb * 64, nb * 32, F.in[I_NORMW] + (size_t)layer * DINNER, wl_ptr(F, layer, WL_SSD), nb * 32, scr, F.lane); continue; }
        r -= I_SSD;
        if (r < I_SQ) { const int nb = r / (D / 64), kb = r % (D / 64); wt_item(F.in[I_WATT] + (size_t)layer * D * D, D, D, kb * 64, nb * 32, nullptr, wl_ptr(F, layer, WL_ATT), nb * 32, scr, F.lane); continue; }
        r -= I_SQ;
        if (r < I_SQ) { const int nb = r / (D / 64), kb = r % (D / 64); wt_item(F.in[I_WSC] + (size_t)layer * D * D, D, D, kb * 64, nb * 32, nullptr, wl_ptr(F, layer, WL_SC), nb * 32, scr, F.lane); continue; }
        r -= I_SQ;
        if (r < I_SQ) { const int nb = r / (D / 64), kb = r % (D / 64); wt_item(F.in[I_WO] + (size_t)layer * D * D, D, D, kb * 64, nb * 32, nullptr, wl_ptr(F, layer, WL_O), nb * 32, scr, F.lane); continue; }
        r -= I_SQ;
        if (r < I_UP) { const int e = r / ((2048 / 32) * (D / 64)), q = r % ((2048 / 32) * (D / 64)), nb = q / (D / 64), kb = q % (D / 64), n0 = nb * 32;
            const int pn = n0 >> 8, bj = (n0 >> 7) & 1, jj = n0 & 127, ns = bj * 1024 + pn * 128 + jj;
            wt_item(F.in[I_WUP] + ((size_t)layer * NEXP + e) * D * 2048, 2048, D, kb * 64, ns, nullptr, wl_ptr(F, layer, WL_UP) + (size_t)e * 2048 * D, n0, scr, F.lane); continue; }
        r -= I_UP;
        { const int e = r / ((D / 32) * (D / 64)), q = r % ((D / 32) * (D / 64)), nb = q / (D / 64), kb = q % (D / 64);
            wt_item(F.in[I_WDN] + ((size_t)layer * NEXP + e) * D * D, D, D, kb * 64, nb * 32, nullptr, wl_ptr(F, layer, WL_DN) + (size_t)e * D * D, nb * 32, scr, F.lane); }
    }
}

__device__ __forceinline__ const float* x_in_row(const Frame& F, int layer, int mb, int r) {
    if (layer == 0) return r < NP ? F.in[I_XP] + ((size_t)mb * NP + r) * D : F.in[I_XS] + (size_t)(r - NP) * D;
    return r < NP ? F.out + O_YP + ((size_t)mb * NP + r) * D : F.out + O_YS + (size_t)(r - NP) * D;
}
__device__ __forceinline__ float* x_out_row(const Frame& F, int mb, int r) { return r < NP ? F.out + O_YP + ((size_t)mb * NP + r) * D : F.out + O_YS + (size_t)(r - NP) * D; }
__device__ __forceinline__ int rows_of(int mb) { return mb == 0 ? R : NP; }

__device__ __forceinline__ void step_xb(const Frame& F, int mb) {
    const int gw = F.bid * NWAVES + F.wave, NGW = F.G * NWAVES, nr = rows_of(mb);
    bf16_t* XB = ws_bf(F, WS_XB0) + (size_t)mb * R * D;
    for (int r0 = gw; r0 < nr; r0 += 4 * NGW) {
        f32x4 v[4][4];
#pragma unroll
        for (int i = 0; i < 4; ++i) { const int r = r0 + i * NGW < nr ? r0 + i * NGW : r0; const f32x4* xr = (const f32x4*)x_in_row(F, 0, mb, r) + F.lane;
#pragma unroll
            for (int j = 0; j < 4; ++j) v[i][j] = xr[64 * j]; }
        asm volatile("" ::: "memory");
#pragma unroll
        for (int i = 0; i < 4; ++i) { const int r = r0 + i * NGW; if (r >= nr) continue; u32x2* o = (u32x2*)(XB + (size_t)r * D) + F.lane;
#pragma unroll
            for (int j = 0; j < 4; ++j) { u32x2 w; w.x = pk2(v[i][j][0], v[i][j][1]); w.y = pk2(v[i][j][2], v[i][j][3]); o[64 * j] = w; } }
    }
}

__device__ __forceinline__ float softplus_f(float x) { const float e = fexp(x); return x > 20.f ? x : (e < 0.01f ? e * (1.0f - e * (0.5f - e * 0.33333333f)) : __builtin_amdgcn_logf(1.0f + e) * 0.69314718056f); }
constexpr int S128 = 136, S64 = 72;
constexpr int BL_BM = 0, BL_CM = BL_BM + 64 * S128 * 2, BL_CB = BL_CM + 64 * S128 * 2, BL_END = BL_CB + 64 * S64 * 2;
struct BcRegs { u32x4 raw[7]; f32x4 wq[4][2], bq[2]; };
__device__ __forceinline__ void ssd_bc_load(const Frame& F, int layer, int u, BcRegs& R_) {
    const int sl = (u / NCHUNK) % NSEQ_MB, ck = u % NCHUNK, g = u / (NCHUNK * NSEQ_MB); const int tid = F.tid;
    const bf16_t* H = ws_bf(F, WS_H) + (size_t)sl * SEQ * DINP; const int cgi = tid & 31, rb = tid >> 5; const int xc = (cgi < 16 ? 2048 : 3072) + g * 128 + 8 * (cgi & 15);
#pragma unroll
    for (int i = 0; i < 7; ++i) { const int t = ck * 64 + 4 * rb - 3 + i; R_.raw[i] = t >= 0 ? *(const u32x4*)(H + (size_t)t * DINP + C_X + xc) : (u32x4){0u, 0u, 0u, 0u}; }
    const float* convw = F.in[I_CONVW] + (size_t)layer * 4 * CONVDIM + xc; const float* convb = F.in[I_CONVB] + (size_t)layer * CONVDIM + xc;
#pragma unroll
    for (int tp = 0; tp < 4; ++tp) { R_.wq[tp][0] = *(const f32x4*)(convw + tp * CONVDIM); R_.wq[tp][1] = *(const f32x4*)(convw + tp * CONVDIM + 4); }
    R_.bq[0] = *(const f32x4*)convb; R_.bq[1] = *(const f32x4*)(convb + 4);
}
__device__ __forceinline__ void ssd_bc_unit(const Frame& F, int u, const BcRegs& R_) {
    const int sl = (u / NCHUNK) % NSEQ_MB, ck = u % NCHUNK, g = u / (NCHUNK * NSEQ_MB);
    const int tid = F.tid, lane = F.lane, w = F.wave, fr = lane & 15, fq = lane >> 4;
    LAS bf16_t* Bm = (LAS bf16_t*)(F.lds + BL_BM); LAS bf16_t* Cm = (LAS bf16_t*)(F.lds + BL_CM); LAS bf16_t* CBs = (LAS bf16_t*)(F.lds + BL_CB);
    const size_t rowg = (size_t)sl * SEQ + (size_t)ck * 64; const size_t tix = ((size_t)sl * NCHUNK + ck) * 8 + g;
    const int cgi = tid & 31, rb = tid >> 5; const bool isB = cgi < 16; const int n0 = 8 * (cgi & 15);
    const u32x4 (&raw)[7] = R_.raw; const f32x4 (&wq)[4][2] = R_.wq; const f32x4 (&bq)[2] = R_.bq;
    __syncthreads();
    { float val[4][8];
#pragma unroll
      for (int r = 0; r < 4; ++r) { float a[8] = {bq[0][0], bq[0][1], bq[0][2], bq[0][3], bq[1][0], bq[1][1], bq[1][2], bq[1][3]};
#pragma unroll
          for (int tp = 0; tp < 4; ++tp) { float f[8]; unpack8(raw[r + tp], f);
#pragma unroll
              for (int i = 0; i < 4; ++i) { a[i] += f[i] * wq[tp][0][i]; a[4 + i] += f[4 + i] * wq[tp][1][i]; } }
#pragma unroll
          for (int i = 0; i < 8; ++i) val[r][i] = fsilu(a[i]); }
      if (isB) { bf16_t* bt = ws_bf(F, WS_BTG) + tix * 8192 + (size_t)n0 * 64 + 4 * rb;
#pragma unroll
          for (int r = 0; r < 4; ++r) *(LAS u32x4*)(Bm + (4 * rb + r) * S128 + n0) = pack8(val[r]);
#pragma unroll
          for (int i = 0; i < 8; ++i) { u32x2 wv; wv.x = pk2(val[0][i], val[1][i]); wv.y = pk2(val[2][i], val[3][i]); *(u32x2*)(bt + (size_t)i * 64) = wv; } }
      else { bf16_t* cmc = ws_bf(F, WS_CMC) + (rowg + 4 * rb) * 1024 + g * 128 + n0;
#pragma unroll
          for (int r = 0; r < 4; ++r) { const u32x4 pk = pack8(val[r]); *(LAS u32x4*)(Cm + (4 * rb + r) * S128 + n0) = pk; *(u32x4*)(cmc + (size_t)r * 1024) = pk; } } }
    __syncthreads();
    { const int ti = w >> 1;
#pragma unroll
      for (int jj = 0; jj < 2; ++jj) { const int tj = 2 * (w & 1) + jj; f32x4 cb = (f32x4){0.f, 0.f, 0.f, 0.f};
          if (tj <= ti) {
#pragma unroll
              for (int ks = 0; ks < 4; ++ks) { const bf16x8 a = *(const LAS bf16x8*)(Cm + (16 * ti + fr) * S128 + 32 * ks + 8 * fq); const bf16x8 b = *(const LAS bf16x8*)(Bm + (16 * tj + fr) * S128 + 32 * ks + 8 * fq);
                  cb = __builtin_amdgcn_mfma_f32_16x16x32_bf16(a, b, cb, 0, 0, 0); } }
#pragma unroll
          for (int r = 0; r < 4; ++r) CBs[(16 * ti + 4 * fq + r) * S64 + 16 * tj + fr] = bf1(cb[r]); } }
    __syncthreads();
    { const int row = tid >> 3, cc = tid & 7; *(u32x4*)(ws_bf(F, WS_CBG) + tix * 4096 + row * 64 + 8 * cc) = *(const LAS u32x4*)(CBs + row * S64 + 8 * cc); }
}

constexpr int SL_CM = 0, SL_BT = SL_CM + 64 * S128 * 2, SL_CB = SL_BT + 128 * S64 * 2, SL_DMA_SZ = SL_CB + 64 * S64 * 2, SL_DMA_END = 2 * SL_DMA_SZ;
constexpr int SL_XT = SL_DMA_END, SL_XTW = SL_XT + 2 * 64 * S64 * 2, SL_MM = SL_XTW + 2 * 64 * S64 * 2, SL_SM = SL_MM + 2 * 64 * S64 * 2, SL_END = SL_SM + 3 * 384 * 4;
static_assert(SL_END <= SCR_BYTES && SL_DMA_SZ == 2816 * 16, "ssd LDS map");
#ifdef EMU
#define SSD_DMA_ONE(gp_, dst_) memcpy((unsigned char*)(dst_) + lane * 16, (gp_), 16)
#else
#define SSD_DMA_ONE(gp_, dst_) __builtin_amdgcn_global_load_lds((const unsigned*)(gp_), (LAS unsigned*)(dst_), 16, 0, 0)
#endif
#define SSD_DMA_SETUP() do { _Pragma("unroll") for (int j_ = 0; j_ < 6; ++j_) { const int pc_ = w * 6 + j_; const int q_ = pc_ * 64 + lane; const size_t tx0_ = ((size_t)sl * NCHUNK) * 8 + g; \
        if (pc_ < 17) { const int r_ = q_ / 17; int c_ = q_ % 17; c_ = c_ < 16 ? c_ : 15; dsrc[j_] = cmc + (size_t)r_ * 1024 + 8 * c_; } \
        else if (pc_ < 35) { const int q2_ = q_ - 1088, r_ = q2_ / 9; int c_ = q2_ % 9; c_ = c_ < 8 ? c_ : 7; dsrc[j_] = btg + tx0_ * 8192 + r_ * 64 + 8 * c_; } \
        else { const int q3_ = q_ - 2240, r_ = q3_ / 9; int c_ = q3_ % 9; c_ = c_ < 8 ? c_ : 7; dsrc[j_] = cbg + tx0_ * 4096 + r_ * 64 + 8 * c_; } } } while (0)
#define SSD_DMA2(ca_, cb_) do { _Pragma("unroll") for (int j_ = 0; j_ < 6; ++j_) { const int pc_ = w * 6 + j_; \
        if (pc_ < 35) { if ((ca_) < NCHUNK) { SSD_DMA_ONE(dsrc[j_], L + ((ca_) & 1) * SL_DMA_SZ + SL_CM + pc_ * 1024); dsrc[j_] += pc_ < 17 ? (size_t)64 * 1024 : (size_t)8 * 8192; } } \
        else if (pc_ < 44) { if ((cb_) < NCHUNK) { SSD_DMA_ONE(dsrc[j_], L + ((cb_) & 1) * SL_DMA_SZ + SL_CM + pc_ * 1024); dsrc[j_] += (size_t)8 * 4096; } } } } while (0)
#define SSD_TABLE(tb_, dtr_) do { const float dt_ = softplus_f(bf2f(dtr_) + dtb); \
        const float cs_ = wave_scan_incl(Ah * dt_, lane); \
        const float tot_ = wave_last(cs_); (tb_)[lane] = dt_; (tb_)[64 + lane] = cs_; (tb_)[128 + lane] = fexp(tot_ - cs_); (tb_)[192 + lane] = fexp(cs_); if (lane == 0) (tb_)[256] = fexp(tot_); (tb_)[320 + lane] = Dh * __builtin_amdgcn_rcpf(dt_); } while (0)

__device__ __forceinline__ void ssd_prompt_unit(const Frame& F, int layer, int mb, int sl, int hd) {
    const int tid = F.tid, lane = F.lane, w = F.wave, fr = lane & 15, fq = lane >> 4;
    LAS unsigned char* L = F.lds;
    LAS bf16_t* XT0 = (LAS bf16_t*)(L + SL_XT); LAS bf16_t* XTW0 = (LAS bf16_t*)(L + SL_XTW); LAS bf16_t* Mm0 = (LAS bf16_t*)(L + SL_MM);
    LAS float* smb = (LAS float*)(L + SL_SM);
    const int g = hd >> 2;
    bf16_t* H = ws_bf(F, WS_H) + (size_t)sl * SEQ * DINP;
    const bf16_t* cmc = ws_bf(F, WS_CMC) + (size_t)sl * SEQ * 1024 + g * 128; const bf16_t* btg = ws_bf(F, WS_BTG); const bf16_t* cbg = ws_bf(F, WS_CBG);
    __syncthreads();
    const bf16_t* dsrc[6]; SSD_DMA_SETUP();
    SSD_DMA2(NCHUNK, 0);
    if (w < 4) {
        const int pb = w;
        f32x4 St[8];
#pragma unroll
        for (int t = 0; t < 8; ++t) St[t] = (f32x4){0.f, 0.f, 0.f, 0.f};
        bf16_t* pz = H + (size_t)fr * DINP + C_Z + hd * 64 + 16 * pb + 4 * fq; float* pss = ws_f(F, WS_SSQ) + ((size_t)sl * SEQ + fr) * 128 + hd * 4 + pb;
        u32x2 zraw[4];
        VM_WAIT(0); __syncthreads();
        for (int it = -1; it < NCHUNK; ++it) {
            u32x2 zc[4];
#pragma unroll
            for (int lb = 0; lb < 4; ++lb) zc[lb] = zraw[lb];
            SSD_DMA2(it + 1, it + 2);
            if (it + 1 < NCHUNK) {
#pragma unroll
                for (int lb = 0; lb < 4; ++lb) zraw[lb] = *(const u32x2*)(pz + (size_t)(it >= 0 ? 64 : 0) * DINP + (size_t)lb * 16 * DINP); }
            asm volatile("" ::: "memory");
            if (it >= 0) { const int par = it & 1; LAS float* sm = smb + (it % 3) * 384;
                LAS bf16_t* Cm = (LAS bf16_t*)(L + par * SL_DMA_SZ + SL_CM); LAS bf16_t* BT = (LAS bf16_t*)(L + par * SL_DMA_SZ + SL_BT);
                LAS bf16_t* XT = XT0 + par * 64 * S64; LAS bf16_t* XTW = XTW0 + par * 64 * S64; LAS bf16_t* Mm = Mm0 + par * 64 * S64;
                bf16x8 sa[4];
#pragma unroll
                for (int ks = 0; ks < 4; ++ks) { u32x4 wv; wv.x = pk2(St[2 * ks][0], St[2 * ks][1]); wv.y = pk2(St[2 * ks][2], St[2 * ks][3]); wv.z = pk2(St[2 * ks + 1][0], St[2 * ks + 1][1]); wv.w = pk2(St[2 * ks + 1][2], St[2 * ks + 1][3]);
                    sa[ks] = __builtin_bit_cast(bf16x8, wv); }
                f32x4 yo[4];
#pragma unroll
                for (int lb = 0; lb < 4; ++lb) yo[lb] = (f32x4){0.f, 0.f, 0.f, 0.f};
#pragma unroll
                for (int ks = 0; ks < 4; ++ks)
#pragma unroll
                    for (int lb = 0; lb < 4; ++lb) { const LAS bf16_t* cp = Cm + (16 * lb + fr) * S128 + 32 * ks + 4 * fq; const u32x2 c0 = *(const LAS u32x2*)cp, c1 = *(const LAS u32x2*)(cp + 16);
                        u32x4 cw; cw.x = c0.x; cw.y = c0.y; cw.z = c1.x; cw.w = c1.y; yo[lb] = __builtin_amdgcn_mfma_f32_16x16x32_bf16(sa[ks], __builtin_bit_cast(bf16x8, cw), yo[lb], 0, 0, 0); }
                { const float cd = sm[256]; bf16x8 bx[2];
#pragma unroll
                  for (int ks = 0; ks < 2; ++ks) bx[ks] = *(const LAS bf16x8*)(XTW + (16 * pb + fr) * S64 + 32 * ks + 8 * fq);
#pragma unroll
                  for (int t = 0; t < 8; ++t) St[t] = St[t] * cd;
#pragma unroll
                  for (int ks = 0; ks < 2; ++ks)
#pragma unroll
                    for (int t = 0; t < 8; ++t) { const bf16x8 a = *(const LAS bf16x8*)(BT + (16 * t + fr) * S64 + 32 * ks + 8 * fq); St[t] = __builtin_amdgcn_mfma_f32_16x16x32_bf16(a, bx[ks], St[t], 0, 0, 0); } }
                { bf16x8 xa[2];
#pragma unroll
                  for (int ks = 0; ks < 2; ++ks) xa[ks] = *(const LAS bf16x8*)(XT + (16 * pb + fr) * S64 + 32 * ks + 8 * fq);
                  f32x4 ydv[4];
#pragma unroll
                  for (int lb = 0; lb < 4; ++lb) ydv[lb] = (f32x4){0.f, 0.f, 0.f, 0.f};
#pragma unroll
                  for (int ks = 0; ks < 2; ++ks)
#pragma unroll
                    for (int lb = 0; lb < 4; ++lb) { const bf16x8 b = *(const LAS bf16x8*)(Mm + (16 * lb + fr) * S64 + 32 * ks + 8 * fq); ydv[lb] = __builtin_amdgcn_mfma_f32_16x16x32_bf16(xa[ks], b, ydv[lb], 0, 0, 0); }
#pragma unroll
                  for (int lb = 0; lb < 4; ++lb) { const f32x4 yd = ydv[lb];
                    const float ec = sm[192 + 16 * lb + fr]; const float z[4] = {blo(zc[lb].x), bhi(zc[lb].x), blo(zc[lb].y), bhi(zc[lb].y)}; float v[4], ss = 0.f;
#pragma unroll
                    for (int r = 0; r < 4; ++r) { v[r] = (yd[r] + ec * yo[lb][r]) * fsilu(z[r]); ss += v[r] * v[r]; }
                    u32x2 ov; ov.x = pk2(v[0], v[1]); ov.y = pk2(v[2], v[3]); *(u32x2*)(pz + (size_t)lb * 16 * DINP) = ov;
                    ss += xshfl<16>(ss); ss += xshfl<32>(ss);
                    pss[(size_t)lb * 16 * 128] = ss; } }
                pz += (size_t)64 * DINP; pss += 64 * 128; }
            if (it < 0) VM_WAIT(0); else VM_WAIT(7);
#ifndef EMU
            asm volatile("" : "+v"(zraw[0].x), "+v"(zraw[0].y), "+v"(zraw[1].x), "+v"(zraw[1].y), "+v"(zraw[2].x), "+v"(zraw[2].y), "+v"(zraw[3].x), "+v"(zraw[3].y));
#endif
            LBAR();
        }
        float* so = F.out + O_SSP + ((((size_t)layer * BATCH + mb * NSEQ_MB + sl) * 32 + hd) * 64) * 128;
#pragma unroll
        for (int t = 0; t < 8; ++t) *(f32x4*)(so + (size_t)(16 * pb + fr) * 128 + 16 * t + 4 * fq) = St[t];
    } else {
        const int pw = w - 4, pt = tid - 256;
        const float* convw = F.in[I_CONVW] + (size_t)layer * 4 * CONVDIM + hd * 64; const float* convb = F.in[I_CONVB] + (size_t)layer * CONVDIM + hd * 64;
        const float cw0 = convw[lane], cw1 = convw[CONVDIM + lane], cw2 = convw[2 * CONVDIM + lane], cw3 = convw[3 * CONVDIM + lane], cwb = convb[lane];
        const float dtb = F.in[I_DTB][layer * 32 + hd], Ah = -fexp(F.in[I_ALOG][layer * 32 + hd]), Dh = F.in[I_SD][layer * 32 + hd];
        const int ml = pt >> 2, ms0 = 16 * (pt & 3);
        unsigned rawx[19]; unsigned dtr_next = 0u;
#pragma unroll
        for (int i = 0; i < 19; ++i) { const int t_ = 16 * pw - 3 + i; rawx[i] = t_ >= 0 ? (unsigned)H[(size_t)t_ * DINP + C_X + hd * 64 + lane] : 0u; }
        if (pw == 3) { const unsigned d0 = H[(size_t)lane * DINP + C_DT + hd]; if (NCHUNK > 1) dtr_next = H[(size_t)(64 + lane) * DINP + C_DT + hd]; SSD_TABLE(smb, d0); }
        VM_WAIT(0); __syncthreads();
        for (int it = -1; it < NCHUNK; ++it) { const int pc = it + 1;
            SSD_DMA2(it + 1, it + 2);
            const unsigned dtr_cur = dtr_next;
            if (pc < NCHUNK) { const int par = pc & 1; LAS float* sm = smb + (pc % 3) * 384; const LAS bf16_t* CBl = (const LAS bf16_t*)(L + par * SL_DMA_SZ + SL_CB);
                LAS bf16_t* XT = XT0 + par * 64 * S64; LAS bf16_t* XTW = XTW0 + par * 64 * S64; LAS bf16_t* Mm = Mm0 + par * 64 * S64;
                { float xr[19];
#pragma unroll
                  for (int i = 0; i < 19; ++i) xr[i] = blo(rawx[i]);
                  if (pc + 1 < NCHUNK) { const bf16_t* px_ = H + ((size_t)(pc + 1) * 64 + 16 * pw - 3) * DINP + C_X + hd * 64 + lane;
#pragma unroll
                      for (int i = 0; i < 19; ++i) rawx[i] = (unsigned)px_[(size_t)i * DINP]; }
                  if (pw == 3 && pc + 2 < NCHUNK) dtr_next = H[((size_t)(pc + 2) * 64 + lane) * DINP + C_DT + hd];
                  asm volatile("" ::: "memory");
#pragma unroll
                  for (int hq = 0; hq < 2; ++hq) { const f32x4 d0 = *(const LAS f32x4*)(sm + 16 * pw + 8 * hq), d1 = *(const LAS f32x4*)(sm + 16 * pw + 8 * hq + 4), e0 = *(const LAS f32x4*)(sm + 128 + 16 * pw + 8 * hq), e1 = *(const LAS f32x4*)(sm + 128 + 16 * pw + 8 * hq + 4);
                      const float dtv[8] = {d0[0], d0[1], d0[2], d0[3], d1[0], d1[1], d1[2], d1[3]}, wdv[8] = {e0[0], e0[1], e0[2], e0[3], e1[0], e1[1], e1[2], e1[3]}; float xa[8], xb[8];
#pragma unroll
                      for (int r = 0; r < 8; ++r) { const int q = 8 * hq + r; const float xd = fsilu(cwb + xr[q] * cw0 + xr[q + 1] * cw1 + xr[q + 2] * cw2 + xr[q + 3] * cw3) * dtv[r]; xa[r] = xd; xb[r] = xd * wdv[r]; }
                      *(LAS u32x4*)(XT + lane * S64 + 16 * pw + 8 * hq) = pack8(xa); *(LAS u32x4*)(XTW + lane * S64 + 16 * pw + 8 * hq) = pack8(xb); } }
#pragma unroll
                for (int hq = 0; hq < 2; ++hq) { const int s0 = ms0 + 8 * hq; float mv[8];
                    if (s0 <= ml) { float cbv[8]; unpack8(*(const LAS u32x4*)(CBl + ml * S64 + s0), cbv); const float al = sm[64 + ml]; const f32x4 a0 = *(const LAS f32x4*)(sm + 64 + s0), a1 = *(const LAS f32x4*)(sm + 64 + s0 + 4);
#pragma unroll
                        for (int i = 0; i < 4; ++i) { mv[i] = (ml >= s0 + i) ? cbv[i] * fexp(fminf(al - a0[i], 0.f)) : 0.f; mv[4 + i] = (ml >= s0 + 4 + i) ? cbv[4 + i] * fexp(fminf(al - a1[i], 0.f)) : 0.f; }
                        if ((ml >> 3) == (s0 >> 3)) { const float dd = sm[320 + ml];
#pragma unroll
                            for (int i = 0; i < 8; ++i) if (i == (ml & 7)) mv[i] += dd; } }
                    else {
#pragma unroll
                        for (int i = 0; i < 8; ++i) mv[i] = 0.f; }
                    *(LAS u32x4*)(Mm + ml * S64 + s0) = pack8(mv); } }
            if (pw == 3 && it + 2 < NCHUNK) { LAS float* smn = smb + ((it + 2) % 3) * 384; SSD_TABLE(smn, dtr_cur); }
            VM_WAIT(0);
#ifndef EMU
#pragma unroll
            for (int i = 0; i < 19; ++i) asm volatile("" : "+v"(rawx[i]));
            asm volatile("" : "+v"(dtr_next));
#endif
            LBAR();
        }
    }
    VM_WAIT(0); __syncthreads();
}

__device__ __forceinline__ void ssd_sample_unit(const Frame& F, int layer, int sq, int hd) {
    const int tid = F.tid, lane = F.lane; LAS float* L = (LAS float*)F.lds;
    LAS float* xs = L; LAS float* Bs = L + 16 * 64; LAS float* Cs = Bs + 16 * 128; LAS float* dts = Cs + 16 * 128; LAS float* das = dts + 16; LAS float* Yl = das + 16;
    const int g = hd >> 2;
    bf16_t* H = ws_bf(F, WS_H) + (size_t)(NP + sq * 16) * DINP;
    const float* hist = F.in[I_SCV] + ((size_t)layer * DECB + sq) * 3 * CONVDIM;
    const float* convw = F.in[I_CONVW] + (size_t)layer * 4 * CONVDIM; const float* convb = F.in[I_CONVB] + (size_t)layer * CONVDIM;
    const int p = tid >> 3, n0 = (tid & 7) * 16;
    const size_t sbase = ((((size_t)layer * DECB + sq) * 32 + hd) * 64 + p) * 128 + n0;
    float S[16];
#pragma unroll
    for (int i = 0; i < 16; ++i) S[i] = F.in[I_SST][sbase + i];
    bf16_t zr[2];
#pragma unroll
    for (int j = 0; j < 2; ++j) { const int it = tid + 512 * j; zr[j] = H[(size_t)(it >> 6) * DINP + C_Z + hd * 64 + (it & 63)]; }
    __syncthreads();
    if (tid < 320) { const int c = tid; const int xc = c < 64 ? hd * 64 + c : (c < 192 ? 2048 + g * 128 + (c - 64) : 3072 + g * 128 + (c - 192));
        float win[19];
#pragma unroll
        for (int i = 0; i < 3; ++i) win[i] = hist[i * CONVDIM + xc];
#pragma unroll
        for (int t = 0; t < 16; ++t) win[3 + t] = bf2f(H[(size_t)t * DINP + C_X + xc]);
        const float w0 = convw[xc], w1 = convw[CONVDIM + xc], w2 = convw[2 * CONVDIM + xc], w3 = convw[3 * CONVDIM + xc], bb = convb[xc];
#pragma unroll
        for (int t = 0; t < 16; ++t) { const float a = fsilu(bb + win[t] * w0 + win[t + 1] * w1 + win[t + 2] * w2 + win[t + 3] * w3);
            if (c < 64) xs[t * 64 + c] = a; else if (c < 192) Bs[t * 128 + c - 64] = a; else Cs[t * 128 + c - 192] = a; } }
    if (tid < 16) { const float dt = softplus_f(bf2f(H[(size_t)tid * DINP + C_DT + hd]) + F.in[I_DTB][layer * 32 + hd]); dts[tid] = dt; das[tid] = fexp(-fexp(F.in[I_ALOG][layer * 32 + hd]) * dt); }
    __syncthreads();
    for (int t = 0; t < 16; ++t) { const float dec = das[t], xv = xs[t * 64 + p] * dts[t]; float part = 0.f;
#pragma unroll
        for (int i = 0; i < 16; ++i) { S[i] = S[i] * dec + xv * Bs[t * 128 + n0 + i]; part += Cs[t * 128 + n0 + i] * S[i]; }
        part += xshfl<1>(part); part += xshfl<2>(part); part += xshfl<4>(part);
        if ((tid & 7) == 0) Yl[t * 64 + p] = part; }
#pragma unroll
    for (int i = 0; i < 16; ++i) F.out[O_SSS + sbase + i] = S[i];
    __syncthreads();
    const float Dh = F.in[I_SD][layer * 32 + hd];
#pragma unroll
    for (int j = 0; j < 2; ++j) { const int it = tid + 512 * j, t = it >> 6, pp = it & 63;
        const float z = bf2f(zr[j]); const float v = (Yl[t * 64 + pp] + Dh * xs[t * 64 + pp]) * fsilu(z);
        H[(size_t)t * DINP + C_Z + hd * 64 + pp] = bf1(v);
        const float ss = wave_sum(v * v);
        if (lane < 4) ws_f(F, WS_SSQ)[((size_t)NP + sq * 16 + t) * 128 + hd * 4 + lane] = lane == 0 ? ss : 0.f; }
}

__device__ __forceinline__ int t5_bucket(int rel) {
    const int n = rel < 0 ? -rel : rel; const int b = rel > 0 ? 16 : 0;
    if (n < 8) return b + n;
    int v = 8; v += n >= 12; v += n >= 16; v += n >= 23; v += n >= 32; v += n >= 46; v += n >= 64; v += n >= 91;
    return b + v;
}
constexpr int AK_P = 72, AV_P = 200;
constexpr int AL_K = 0, AL_VT = AL_K + 192 * AK_P * 2, AL_LUT = AL_VT + 64 * AV_P * 2, AL_END = AL_LUT + 4 * 256 * 4;
static_assert(AL_END <= RING_BYTES, "attention LDS map");
__device__ __forceinline__ void attn_prompt_unit(const Frame& F, int layer, int sl, int ck, int kh, bool build_lut) {
    const int tid = F.tid, lane = F.lane, w = F.wave, q32 = lane & 31, hi = lane >> 5;
    LAS bf16_t* Kl = (LAS bf16_t*)(F.lds + AL_K); LAS bf16_t* VT = (LAS bf16_t*)(F.lds + AL_VT); LAS float* lut = (LAS float*)(F.lds + AL_LUT);
    bf16_t* H = ws_bf(F, WS_H) + (size_t)sl * SEQ * DINP;
    const int gq = w >> 1, qh = w & 1, head = kh * 4 + gq;
    const size_t qrow = (size_t)ck * 64 + 32 * qh + q32;
    bf16x8 qf[4];
#pragma unroll
    for (int ds = 0; ds < 4; ++ds) qf[ds] = *(const bf16x8*)(H + qrow * DINP + C_Q + head * 64 + 16 * ds + 8 * hi);
    __syncthreads();
#pragma unroll
    for (int j = 0; j < 3; ++j) { const int id = tid + 512 * j, key = id >> 3, cg = id & 7; const int t = 64 * (ck - 2) + key;
        u32x4 kv = (u32x4){0u, 0u, 0u, 0u}, vv = kv;
        if (t >= 0) { kv = *(const u32x4*)(H + (size_t)t * DINP + C_K + kh * 64 + 8 * cg); vv = *(const u32x4*)(H + (size_t)t * DINP + C_V + kh * 64 + 8 * cg); }
        *(LAS u32x4*)(Kl + key * AK_P + 8 * cg) = kv;
        VT[(8 * cg + 0) * AV_P + key] = (bf16_t)(vv.x & 0xffffu); VT[(8 * cg + 1) * AV_P + key] = (bf16_t)(vv.x >> 16); VT[(8 * cg + 2) * AV_P + key] = (bf16_t)(vv.y & 0xffffu); VT[(8 * cg + 3) * AV_P + key] = (bf16_t)(vv.y >> 16);
        VT[(8 * cg + 4) * AV_P + key] = (bf16_t)(vv.z & 0xffffu); VT[(8 * cg + 5) * AV_P + key] = (bf16_t)(vv.z >> 16); VT[(8 * cg + 6) * AV_P + key] = (bf16_t)(vv.w & 0xffffu); VT[(8 * cg + 7) * AV_P + key] = (bf16_t)(vv.w >> 16); }
    if (build_lut) for (int e = tid; e < 4 * 255; e += NTHREADS) { const int gg = e / 255, idx = e % 255; lut[gg * 256 + idx] = F.in[I_RELB][t5_bucket(idx - 191) * 16 + kh * 4 + gg]; }
    __syncthreads();
    f32x16 sc[6];
#pragma unroll
    for (int kt = 0; kt < 6; ++kt) {
#pragma unroll
        for (int r = 0; r < 16; ++r) sc[kt][r] = 0.f;
#pragma unroll
        for (int ds = 0; ds < 4; ++ds) { const bf16x8 a = *(const LAS bf16x8*)(Kl + (32 * kt + q32) * AK_P + 16 * ds + 8 * hi); sc[kt] = __builtin_amdgcn_mfma_f32_32x32x16_bf16(a, qf[ds], sc[kt], 0, 0, 0); } }
    const int qidx = 32 * qh + q32; const float sink = F.in[I_SINK][layer * 16 + head];
    float mx = -3.0e38f;
#pragma unroll
    for (int kt = 0; kt < 6; ++kt)
#pragma unroll
        for (int r = 0; r < 16; ++r) { const int key = 32 * kt + (r & 3) + 8 * (r >> 2) + 4 * hi; const int rel = key - 128 - qidx;
            float s = sc[kt][r] * 0.125f + lut[gq * 256 + rel + 191]; if (ck < 2 && 64 * ck + key - 128 < 0) s = -1e30f; sc[kt][r] = s; mx = fmaxf(mx, s); }
    mx = fmaxf(mx, __shfl_xor(mx, 32)); mx = fmaxf(mx, sink);
    float sum = 0.f;
#pragma unroll
    for (int kt = 0; kt < 6; ++kt)
#pragma unroll
        for (int r = 0; r < 16; ++r) { const float e = fexp(sc[kt][r] - mx); sc[kt][r] = e; sum += e; }
    sum += __shfl_xor(sum, 32);
    const float inv = 1.0f / (sum + fexp(sink - mx));
    f32x16 o[2];
#pragma unroll
    for (int d2 = 0; d2 < 2; ++d2)
#pragma unroll
        for (int r = 0; r < 16; ++r) o[d2][r] = 0.f;
#pragma unroll
    for (int kt = 0; kt < 6; ++kt)
#pragma unroll
        for (int s = 0; s < 2; ++s) {
            u32x4 pw; pw.x = pk2(sc[kt][8 * s + 0], sc[kt][8 * s + 1]); pw.y = pk2(sc[kt][8 * s + 2], sc[kt][8 * s + 3]); pw.z = pk2(sc[kt][8 * s + 4], sc[kt][8 * s + 5]); pw.w = pk2(sc[kt][8 * s + 6], sc[kt][8 * s + 7]);
            const bf16x8 pa = __builtin_bit_cast(bf16x8, pw);
#pragma unroll
            for (int d2 = 0; d2 < 2; ++d2) { const LAS bf16_t* vp = VT + (32 * d2 + q32) * AV_P + 32 * kt + 16 * s + 4 * hi;
                const u32x2 lo = *(const LAS u32x2*)vp, hh = *(const LAS u32x2*)(vp + 8); u32x4 vw; vw.x = lo.x; vw.y = lo.y; vw.z = hh.x; vw.w = hh.y;
                o[d2] = __builtin_amdgcn_mfma_f32_32x32x16_bf16(pa, __builtin_bit_cast(bf16x8, vw), o[d2], 0, 0, 0); } }
#pragma unroll
    for (int r = 0; r < 16; ++r) { const int q = (r & 3) + 8 * (r >> 2) + 4 * hi; const float iv = __shfl(inv, q);
        bf16_t* op = H + ((size_t)ck * 64 + 32 * qh + q) * DINP + C_Q + head * 64 + q32;
        op[0] = bf1(o[0][r] * iv); op[32] = bf1(o[1][r] * iv); }
}
__device__ __forceinline__ void attn_sample_unit(const Frame& F, int layer, int sq, int kh, int gq) {
    const int tid = F.tid; LAS float* L = (LAS float*)F.lds; const int head = kh * 4 + gq;
    LAS float* Kf = L; LAS float* Vf = Kf + 144 * 65; LAS float* Qf = Vf + 144 * 64; LAS float* P = Qf + 16 * 65; LAS float* Pinv = P + 16 * 145;
    static_assert((144 * 65 + 144 * 64 + 16 * 65 + 16 * 145 + 16) * 4 <= RING_BYTES, "sample attention LDS map");
    bf16_t* H = ws_bf(F, WS_H) + (size_t)(NP + sq * 16) * DINP;
    const float* ck = F.in[I_CK] + ((size_t)layer * DECB + sq) * WINDOW * 256; const float* cv = F.in[I_CV] + ((size_t)layer * DECB + sq) * WINDOW * 256;
    __syncthreads();
    {
        f32x4 kc[4], vc[4]; u32x4 nw = (u32x4){0u, 0u, 0u, 0u};
#pragma unroll
        for (int k = 0; k < 4; ++k) { const int i = tid + k * NTHREADS, key = i >> 4, d4 = (i & 15) * 4; kc[k] = *(const f32x4*)(ck + (size_t)key * 256 + kh * 64 + d4); vc[k] = *(const f32x4*)(cv + (size_t)key * 256 + kh * 64 + d4); }
        const int which = tid >> 7, r16 = (tid >> 3) & 15, c8 = (tid & 7) * 8;
        if (which < 3) nw = *(const u32x4*)(H + (size_t)r16 * DINP + (which == 0 ? C_K + kh * 64 : (which == 1 ? C_V + kh * 64 : C_Q + head * 64)) + c8);
        asm volatile("" ::: "memory");
#pragma unroll
        for (int k = 0; k < 4; ++k) { const int i = tid + k * NTHREADS, key = i >> 4, d4 = (i & 15) * 4;
#pragma unroll
            for (int j = 0; j < 4; ++j) { Kf[key * 65 + d4 + j] = kc[k][j]; Vf[key * 64 + d4 + j] = vc[k][j]; } }
        if (which < 3) { float f[8]; unpack8(nw, f); LAS float* dst = which == 0 ? Kf + (128 + r16) * 65 + c8 : (which == 1 ? Vf + (128 + r16) * 64 + c8 : Qf + r16 * 65 + c8);
#pragma unroll
            for (int j = 0; j < 8; ++j) dst[j] = f[j]; } }
    __syncthreads();
    for (int i = tid; i < 16 * 144; i += NTHREADS) { const int row = i / 144, key = i % 144; float s = 0.f;
        for (int d = 0; d < 64; ++d) s += Qf[row * 65 + d] * Kf[key * 65 + d];
        P[row * 145 + key] = s * 0.125f + F.in[I_RELB][t5_bucket(key - 128 - row) * 16 + head]; }
    __syncthreads();
    { const int row = tid >> 5, sub = tid & 31; const float sink = F.in[I_SINK][layer * 16 + head]; float mx = -3.0e38f;
      for (int k = sub; k < 144; k += 32) mx = fmaxf(mx, P[row * 145 + k]);
      mx = fmaxf(mx, xshfl<1>(mx)); mx = fmaxf(mx, xshfl<2>(mx)); mx = fmaxf(mx, xshfl<4>(mx)); mx = fmaxf(mx, xshfl<8>(mx)); mx = fmaxf(mx, xshfl<16>(mx)); mx = fmaxf(mx, sink);
      float sum = 0.f;
      for (int k = sub; k < 144; k += 32) { const float e = fexp(P[row * 145 + k] - mx); P[row * 145 + k] = e; sum += e; }
      sum += xshfl<1>(sum); sum += xshfl<2>(sum); sum += xshfl<4>(sum); sum += xshfl<8>(sum); sum += xshfl<16>(sum);
      if (sub == 0) Pinv[row] = 1.0f / (sum + fexp(sink - mx)); }
    __syncthreads();
    { const int row = tid >> 5, d0 = (tid & 31) * 2; float o0 = 0.f, o1 = 0.f;
      for (int k = 0; k < 144; ++k) { const float pv = P[row * 145 + k]; o0 += pv * Vf[k * 64 + d0]; o1 += pv * Vf[k * 64 + d0 + 1]; }
      const float iv = Pinv[row];
      *(unsigned*)(H + (size_t)row * DINP + C_Q + head * 64 + d0) = pk2(o0 * iv, o1 * iv); }
}
__device__ __forceinline__ void sc_unit(const Frame& F, int layer, int tile) {
    const int tid = F.tid, cg = tid & 127, rs = tid >> 7; bf16_t* H = ws_bf(F, WS_H);
    const float* wsc = F.in[I_SCW] + (size_t)layer * 3 * D + 8 * cg; float wt[3][8];
#pragma unroll
    for (int i = 0; i < 3; ++i)
#pragma unroll
        for (int c = 0; c < 8; ++c) wt[i][c] = wsc[i * D + c];
    const int row0 = tile * 64 + 16 * rs; const bool smp = row0 >= NP; const int tt0 = smp ? 0 : row0 % SEQ;
    u32x4 cw_[2][4], hw_[2][4], bw_[2][4];
#define SC_LOAD(q_) do { _Pragma("unroll") for (int i = 0; i < 4; ++i) { const bf16_t* hp = H + (size_t)(row0 + 4 * (q_) + i) * DINP + 8 * cg; cw_[(q_) & 1][i] = *(const u32x4*)(hp + C_SCC); hw_[(q_) & 1][i] = *(const u32x4*)(hp + C_SCH); bw_[(q_) & 1][i] = *(const u32x4*)(hp + C_SCB); } } while (0)
#define SC_COMP(q_) do { _Pragma("unroll") for (int i = 0; i < 4; ++i) { float c8[8], h8[8], b8[8], a[8]; unpack8(cw_[(q_) & 1][i], c8); unpack8(hw_[(q_) & 1][i], h8); unpack8(bw_[(q_) & 1][i], b8); \
            _Pragma("unroll") for (int c = 0; c < 8; ++c) { const float u0 = c8[c] * h8[c]; a[c] = (u2[c] * wt[0][c] + u1[c] * wt[1][c] + u0 * wt[2][c]) * b8[c]; u2[c] = u1[c]; u1[c] = u0; } \
            *(u32x4*)(H + (size_t)(row0 + 4 * (q_) + i) * DINP + C_SCB + 8 * cg) = pack8(a); } } while (0)
    SC_LOAD(0); asm volatile("" ::: "memory"); SC_LOAD(1); asm volatile("" ::: "memory");
    float u1[8], u2[8];
    if (tt0 >= 2) { float c8[8], h8[8];
        unpack8(*(const u32x4*)(H + (size_t)(row0 - 2) * DINP + C_SCC + 8 * cg), c8); unpack8(*(const u32x4*)(H + (size_t)(row0 - 2) * DINP + C_SCH + 8 * cg), h8);
#pragma unroll
        for (int c = 0; c < 8; ++c) u2[c] = c8[c] * h8[c];
        unpack8(*(const u32x4*)(H + (size_t)(row0 - 1) * DINP + C_SCC + 8 * cg), c8); unpack8(*(const u32x4*)(H + (size_t)(row0 - 1) * DINP + C_SCH + 8 * cg), h8);
#pragma unroll
        for (int c = 0; c < 8; ++c) u1[c] = c8[c] * h8[c]; }
    else if (smp) { const float* hp = F.in[I_SSC] + (((size_t)layer * DECB + ((row0 - NP) >> 4)) * 2) * D + 8 * cg;
#pragma unroll
        for (int c = 0; c < 8; ++c) { u2[c] = hp[c]; u1[c] = hp[D + c]; } }
    else {
#pragma unroll
        for (int c = 0; c < 8; ++c) { u2[c] = 0.f; u1[c] = 0.f; } }
    SC_COMP(0); asm volatile("" ::: "memory"); SC_LOAD(2); asm volatile("" ::: "memory");
    SC_COMP(1); asm volatile("" ::: "memory"); SC_LOAD(3); asm volatile("" ::: "memory");
    SC_COMP(2); asm volatile("" ::: "memory");
    SC_COMP(3);
#undef SC_LOAD
#undef SC_COMP
    {
    }
}
__device__ __forceinline__ void state_out_unit(const Frame& F, int layer, int mb, int sl, bool smp, int part) {
    const int tid = F.tid; const bf16_t* H = ws_bf(F, WS_H);
    const int nkv = smp ? DECS : WINDOW, len = smp ? DECS : SEQ; const size_t row0 = smp ? (size_t)NP + sl * 16 : (size_t)sl * SEQ; const int sg = smp ? sl : mb * NSEQ_MB + sl;
    const size_t nb_ = smp ? DECB : BATCH;
    float* ko = F.out + (smp ? O_KS : O_KP) + ((size_t)layer * nb_ + sg) * nkv * 256; float* vo = F.out + (smp ? O_VS : O_VP) + ((size_t)layer * nb_ + sg) * nkv * 256;
    const int kv0 = part < 0 ? 0 : part * (nkv * 32 / 8), kv1 = part < 0 ? nkv * 32 : kv0 + nkv * 32 / 8;
    for (int i = kv0 + tid; i < kv1; i += NTHREADS) { const int j = i >> 5, c8 = (i & 31) * 8; const bf16_t* hp = H + (row0 + len - nkv + j) * DINP; float f[8];
        unpack8(*(const u32x4*)(hp + C_K + c8), f); *(f32x4*)(ko + (size_t)j * 256 + c8) = (f32x4){f[0], f[1], f[2], f[3]}; *(f32x4*)(ko + (size_t)j * 256 + c8 + 4) = (f32x4){f[4], f[5], f[6], f[7]};
        unpack8(*(const u32x4*)(hp + C_V + c8), f); *(f32x4*)(vo + (size_t)j * 256 + c8) = (f32x4){f[0], f[1], f[2], f[3]}; *(f32x4*)(vo + (size_t)j * 256 + c8 + 4) = (f32x4){f[4], f[5], f[6], f[7]}; }
    float* co = F.out + (smp ? O_CVS : O_CVP) + ((size_t)layer * nb_ + sg) * 3 * CONVDIM;
    const int cv0 = part < 0 ? 0 : (part < 3 ? part * 512 : 3 * 512), cv1 = part < 0 ? 3 * 512 : (part < 3 ? cv0 + 512 : 3 * 512);
    for (int i = cv0 + tid; i < cv1; i += NTHREADS) { const int j = i / 512, c8 = (i % 512) * 8; float f[8]; unpack8(*(const u32x4*)(H + (row0 + len - 3 + j) * DINP + C_X + c8), f);
        *(f32x4*)(co + (size_t)j * CONVDIM + c8) = (f32x4){f[0], f[1], f[2], f[3]}; *(f32x4*)(co + (size_t)j * CONVDIM + c8 + 4) = (f32x4){f[4], f[5], f[6], f[7]}; }
    float* so = F.out + (smp ? O_SCS : O_SCP) + ((size_t)layer * nb_ + sg) * 2 * D;
    if (part < 0 || part == 3)
    for (int i = tid; i < 2 * 128; i += NTHREADS) { const int j = i >> 7, c8 = (i & 127) * 8; float c[8], h[8]; const bf16_t* hp = H + (row0 + len - 2 + j) * DINP;
        unpack8(*(const u32x4*)(hp + C_SCC + c8), c); unpack8(*(const u32x4*)(hp + C_SCH + c8), h);
        *(f32x4*)(so + (size_t)j * D + c8) = (f32x4){c[0] * h[0], c[1] * h[1], c[2] * h[2], c[3] * h[3]}; *(f32x4*)(so + (size_t)j * D + c8 + 4) = (f32x4){c[4] * h[4], c[5] * h[5], c[6] * h[6], c[7] * h[7]}; }
}
#ifndef MIX_MASK
#define MIX_MASK 0xFF
#endif
#define MIXON(b) ((MIX_MASK >> (b)) & 1)
__device__ __forceinline__ void step_premix(const Frame& F, int layer, int mb) {
    const int n_bc = NSEQ_MB * NCHUNK * 8, n_att = NSEQ_MB * NCHUNK * NKV, n_sc = rows_of(mb) / 64, n_so = NSEQ_MB * 8 + (mb == 0 ? DECB : 0);
    const int n_ss = mb == 0 ? DECB * 32 : 0, n_as = mb == 0 ? DECB * NKV * 4 : 0;
    const int total = n_bc + n_att + n_sc + n_so + n_ss + n_as;
#define UF(Fu) Frame Fu = F; Fu.lane = opq(lane_id()); Fu.tid = Fu.wave * 64 + Fu.lane
    PROBE_T0(14) if constexpr (MIXON(0)) { UF(Fu); BcRegs ra, rn_;
        if (F.bid < n_bc) ssd_bc_load(Fu, layer, F.bid, ra);
        for (int u = F.bid; u < n_bc; u += F.G) { const bool more = u + F.G < n_bc; if (more) ssd_bc_load(Fu, layer, u + F.G, rn_);
            ssd_bc_unit(Fu, u, ra);
            if (more) ra = rn_; } }
    PROBE_T1(14)
    for (int un = F.bid; un < total; un += F.G) { int r = un;
        if (r < n_bc) continue;
        r -= n_bc;
        if (r < n_att) { PROBE_T0(15) if constexpr (MIXON(1)) { UF(Fu);
                const bool xo = (n_att % 8 == 0 && F.G % 8 == 0 && n_bc % F.G == 0 && (n_att >> 3) % NKV == 0 && (F.G >> 3) % NKV == 0); const int ra = xo ? (r & 7) * (n_att >> 3) + (r >> 3) : r;
                attn_prompt_unit(Fu, layer, ra / (NCHUNK * NKV), (ra / NKV) % NCHUNK, ra % NKV, !xo || r < F.G); } PROBE_T1(15) continue; } r -= n_att;
        if (r < n_sc) { PROBE_T0(16) if constexpr (MIXON(2)) { UF(Fu); sc_unit(Fu, layer, r); } PROBE_T1(16) continue; } r -= n_sc;
        if (r < n_so) { PROBE_T0(17) if constexpr (MIXON(3)) { UF(Fu); state_out_unit(Fu, layer, mb, r < NSEQ_MB * 8 ? r >> 3 : r - NSEQ_MB * 8, r >= NSEQ_MB * 8, r < NSEQ_MB * 8 ? (r & 7) : -1); } PROBE_T1(17) continue; } r -= n_so;
        if (r < n_ss) { PROBE_T0(18) if constexpr (MIXON(4)) { UF(Fu); ssd_sample_unit(Fu, layer, r >> 5, r & 31); } PROBE_T1(18) continue; } r -= n_ss;
        { PROBE_T0(19) if constexpr (MIXON(5)) { UF(Fu); attn_sample_unit(Fu, layer, r >> 4, (r >> 2) & 3, r & 3); } PROBE_T1(19) }
    }
}
__device__ __forceinline__ void step_mixers(const Frame& F, int layer, int mb) {
    for (int v = F.bid; v < NSEQ_MB * 32; v += F.G) { const int un = (NSEQ_MB == 8 && F.G == 256) ? (v & 7) * 32 + (v >> 3) : v; UF(Fu); ssd_prompt_unit(Fu, layer, mb, un >> 5, un & 31); }
}
constexpr int RW_P = D + 8;
__device__ __forceinline__ void step_ln1_router_mfma(const Frame& F, int layer, int mb) {
    LAS bf16_t* WH = (LAS bf16_t*)F.lds; LAS bf16_t* WL = WH + NTE * 16 * RW_P; LAS float* GB = (LAS float*)(WL + NTE * 16 * RW_P);
    static_assert((size_t)2 * NTE * 16 * RW_P * 2 + 2 * D * 4 <= (size_t)SCR_BYTES, "router LDS map");
    const int lane = F.lane, fr = lane & 15, fq = lane >> 4;
    __syncthreads();
    { const bf16_t* rwh = ws_bf(F, WS_RWH) + (size_t)layer * NTE * 16 * D; const bf16_t* rwl = ws_bf(F, WS_RWL) + (size_t)layer * NTE * 16 * D;
      constexpr int NIT = NTE * 16 * (D / 8) / NTHREADS; static_assert(NTE * 16 * (D / 8) % NTHREADS == 0 && NIT <= 8, "router weight staging");
      u32x4 th[NIT], tl[NIT];
#pragma unroll
      for (int k = 0; k < NIT; ++k) { const int i = F.tid + k * NTHREADS, e = i / (D / 8), c = i % (D / 8); th[k] = *(const u32x4*)(rwh + (size_t)e * D + 8 * c); tl[k] = *(const u32x4*)(rwl + (size_t)e * D + 8 * c); }
      asm volatile("" ::: "memory");
#pragma unroll
      for (int k = 0; k < NIT; ++k) { const int i = F.tid + k * NTHREADS, e = i / (D / 8), c = i % (D / 8); *(LAS u32x4*)(WH + e * RW_P + 8 * c) = th[k]; *(LAS u32x4*)(WL + e * RW_P + 8 * c) = tl[k]; }
      for (int i = F.tid; i < D; i += NTHREADS) { GB[i] = F.in[I_LN1G][(size_t)layer * D + i]; GB[D + i] = F.in[I_LN1B][(size_t)layer * D + i]; } }
    unsigned* cnt = F.ctl + CW_CNT + (mb * DEPTH + layer) * 64;
    LAS unsigned* lcnt = (LAS unsigned*)(F.lds + MISC_OFF) + 128;
    if (F.tid < 64) lcnt[F.tid] = 0u;
    __syncthreads();
    const int gw = F.bid * NWAVES + F.wave, NGW = F.G * NWAVES, nr = rows_of(mb);
    const float* rb = F.in[I_RB] + (size_t)layer * NEXP;
    bf16_t* XB = ws_bf(F, WS_XB); int* topi = (int*)(F.ws + WS_TOPI); float* gate = ws_f(F, WS_GATE); int* pos = (int*)(F.ws + WS_POS);
    float rbv[NTE];
#pragma unroll
    for (int t = 0; t < NTE; ++t) rbv[t] = 16 * t + fr < NEXP ? rb[16 * t + fr] : 0.f;
    for (int blk = gw; blk < nr / 16; blk += NGW) {
        const int row = 16 * blk + fr; const float* xr = x_out_row(F, mb, row) + 8 * fq;
        float s1, s2;
        { const float* stp = ws_f(F, WS_STAT) + (size_t)row * 32 + 8 * fq; const f32x4 a = *(const f32x4*)stp, b = *(const f32x4*)(stp + 4); s1 = (a[0] + a[2]) + (b[0] + b[2]); s2 = (a[1] + a[3]) + (b[1] + b[3]); }
        s1 += xshfl<16>(s1); s1 += xshfl<32>(s1); s2 += xshfl<16>(s2); s2 += xshfl<32>(s2);
        const float mean = s1 * (1.0f / D); const float rstd = 1.0f / sqrtf(fmaxf(s2 * (1.0f / D) - mean * mean, 0.f) + LN_EPS);
        f32x4 acc[NTE];
#pragma unroll
        for (int t = 0; t < NTE; ++t) acc[t] = (f32x4){0.f, 0.f, 0.f, 0.f};
        bf16_t* xo = XB + (size_t)row * D + 8 * fq;
#pragma unroll 4
        for (int sI = 0; sI < D / 32; ++sI) { const f32x4 a = *(const f32x4*)(xr + 32 * sI), b = *(const f32x4*)(xr + 32 * sI + 4);
            const f32x4 g0 = *(const LAS f32x4*)(GB + 32 * sI + 8 * fq), g1 = *(const LAS f32x4*)(GB + 32 * sI + 8 * fq + 4), b0 = *(const LAS f32x4*)(GB + D + 32 * sI + 8 * fq), b1 = *(const LAS f32x4*)(GB + D + 32 * sI + 8 * fq + 4);
            const f32x4 n0 = (a - mean) * rstd * g0 + b0, n1 = (b - mean) * rstd * g1 + b1;
            u32x4 hw; hw.x = pk2(n0[0], n0[1]); hw.y = pk2(n0[2], n0[3]); hw.z = pk2(n1[0], n1[1]); hw.w = pk2(n1[2], n1[3]);
            *(u32x4*)(xo + 32 * sI) = hw;
            u32x4 lw; lw.x = pk2(n0[0] - blo(hw.x), n0[1] - bhi(hw.x)); lw.y = pk2(n0[2] - blo(hw.y), n0[3] - bhi(hw.y)); lw.z = pk2(n1[0] - blo(hw.z), n1[1] - bhi(hw.z)); lw.w = pk2(n1[2] - blo(hw.w), n1[3] - bhi(hw.w));
            const bf16x8 ah = __builtin_bit_cast(bf16x8, hw), al = __builtin_bit_cast(bf16x8, lw);
#pragma unroll
            for (int t = 0; t < NTE; ++t) { const bf16x8 wh = *(const LAS bf16x8*)(WH + (16 * t + fr) * RW_P + 32 * sI + 8 * fq), wl = *(const LAS bf16x8*)(WL + (16 * t + fr) * RW_P + 32 * sI + 8 * fq);
                acc[t] = __builtin_amdgcn_mfma_f32_16x16x32_bf16(ah, wh, acc[t], 0, 0, 0); acc[t] = __builtin_amdgcn_mfma_f32_16x16x32_bf16(al, wh, acc[t], 0, 0, 0); acc[t] = __builtin_amdgcn_mfma_f32_16x16x32_bf16(ah, wl, acc[t], 0, 0, 0); } }
#pragma unroll
        for (int r = 0; r < 4; ++r) { float val[NTE];
#pragma unroll
            for (int t = 0; t < NTE; ++t) val[t] = 16 * t + fr < NEXP ? acc[t][r] + rbv[t] : -3.0e38f;
            float tv[4]; int te[4];
#pragma unroll
            for (int k = 0; k < 4; ++k) { float m = val[0];
#pragma unroll
                for (int t = 1; t < NTE; ++t) m = fmaxf(m, val[t]);
                m = fmaxf(m, xshfl<1>(m)); m = fmaxf(m, xshfl<2>(m)); m = fmaxf(m, xshfl<4>(m)); m = fmaxf(m, xshfl<8>(m));
                int ce = 9999;
#pragma unroll
                for (int t = NTE - 1; t >= 0; --t) ce = val[t] == m ? 16 * t + fr : ce;
                { int o = xshfl<1>(ce); ce = o < ce ? o : ce; o = xshfl<2>(ce); ce = o < ce ? o : ce; o = xshfl<4>(ce); ce = o < ce ? o : ce; o = xshfl<8>(ce); ce = o < ce ? o : ce; }
                tv[k] = m; te[k] = ce;
#pragma unroll
                for (int t = 0; t < NTE; ++t) if (16 * t + fr == ce) val[t] = -3.0e38f; }
            const float e1 = fexp(tv[1] - tv[0]), e2 = fexp(tv[2] - tv[0]), e3 = fexp(tv[3] - tv[0]); const float inv = 1.0f / (1.0f + e1 + e2 + e3);
            if (fr < 4) { const int e = fr == 0 ? te[0] : (fr == 1 ? te[1] : (fr == 2 ? te[2] : te[3])); const float gv = (fr == 0 ? 1.0f : (fr == 1 ? e1 : (fr == 2 ? e2 : e3))) * inv;
                const size_t tok = (size_t)16 * blk + 4 * fq + r;
                const unsigned rk = __hip_atomic_fetch_add(lcnt + e, 1u, __ATOMIC_RELAXED, __HIP_MEMORY_SCOPE_WORKGROUP);
                topi[tok * 4 + fr] = e; gate[tok * 4 + fr] = gv; pos[tok * 4 + fr] = (int)rk; } }
    }
    __syncthreads();
    if (F.tid < NEXP) lcnt[32 + F.tid] = __hip_atomic_fetch_add(cnt + F.tid, lcnt[F.tid], __ATOMIC_RELAXED, __HIP_MEMORY_SCOPE_AGENT);
    __syncthreads();
    for (int blk = gw; blk < nr / 16; blk += NGW) pos[(size_t)16 * blk * 4 + lane] += (int)lcnt[32 + topi[(size_t)16 * blk * 4 + lane]];
}
__device__ __forceinline__ int moe_table(const Frame& F, int layer, int mb) {
    LAS int* M = (LAS int*)(F.lds + MISC_OFF);
    __syncthreads();
    if (F.tid < 64) { unsigned* cnt = F.ctl + CW_CNT + (mb * DEPTH + layer) * 64; const int e = F.tid;
        const int c = e < NEXP ? (int)__hip_atomic_load(cnt + e, __ATOMIC_RELAXED, __HIP_MEMORY_SCOPE_AGENT) : 0; const int t = (c + 255) / 256; const int incl = wave_scan_incl_i(t, e);
        if (e < NEXP) { M[64 + e] = (incl - t) * 256; M[16 + e] = incl; } }
    __syncthreads();
    return M[16 + NEXP - 1];
}
__device__ __forceinline__ void step_gather(const Frame& F, int layer, int mb) {
    (void)moe_table(F, layer, mb); const LAS int* M = (const LAS int*)(F.lds + MISC_OFF);
    const int nr = rows_of(mb);
    const int* topi = (const int*)(F.ws + WS_TOPI); const float* gate = ws_f(F, WS_GATE); int* pos = (int*)(F.ws + WS_POS); float* gs = ws_f(F, WS_GSORT); int* rtok = (int*)(F.ws + WS_RTOK);
#pragma nounroll
    for (int i = F.bid * NTHREADS + F.tid; i < nr * 4; i += F.G * NTHREADS) { const int p = M[64 + topi[i]] + pos[i]; pos[i] = p; rtok[p] = i >> 2; gs[p] = gate[i]; }
}
__device__ __forceinline__ void step_ln2(const Frame& F, int layer, int mb) {
    const int gw = F.bid * NWAVES + F.wave, NGW = F.G * NWAVES, nr = rows_of(mb), lane = F.lane;
    const float* lg = F.in[I_LN2G] + (size_t)layer * D; const float* lb = F.in[I_LN2B] + (size_t)layer * D;
    const bf16_t* OUTS = ws_bf(F, WS_H) + (size_t)2 * RP * D; const int* pos = (const int*)(F.ws + WS_POS); bf16_t* XB = ws_bf(F, WS_XB);
    constexpr int RB = 2;
    f32x4 gg[4], bb[4];
#pragma unroll
    for (int j = 0; j < 4; ++j) { gg[j] = *((const f32x4*)lg + lane + 64 * j); bb[j] = *((const f32x4*)lb + lane + 64 * j); }
    int pn[RB][4];
#pragma unroll
    for (int i = 0; i < RB; ++i) { const int rq = gw + i * NGW < nr ? gw + i * NGW : (gw < nr ? gw : 0);
#pragma unroll
        for (int k = 0; k < 4; ++k) pn[i][k] = pos[(size_t)rq * 4 + k]; }
    for (int r0 = gw; r0 < nr; r0 += RB * NGW) {
        f32x4 v[RB][4]; u32x2 ow[RB][4][4]; int rr[RB];
#pragma unroll
        for (int i = 0; i < RB; ++i) { rr[i] = r0 + i * NGW < nr ? r0 + i * NGW : r0; const u32x2* xr = (const u32x2*)(XB + (size_t)rr[i] * D); int p[4];
#pragma unroll
            for (int k = 0; k < 4; ++k) p[k] = pn[i][k];
#pragma unroll
            for (int j = 0; j < 4; ++j) { { const u32x2 w = xr[lane + 64 * j]; v[i][j] = (f32x4){blo(w.x), bhi(w.x), blo(w.y), bhi(w.y)}; }
#pragma unroll
                for (int k = 0; k < 4; ++k) ow[i][k][j] = *((const u32x2*)(OUTS + (size_t)p[k] * D) + lane + 64 * j); } }
        { const int rn = r0 + RB * NGW;
#pragma unroll
          for (int i = 0; i < RB; ++i) { const int rq = rn + i * NGW < nr ? rn + i * NGW : (rn < nr ? rn : r0);
#pragma unroll
              for (int k = 0; k < 4; ++k) pn[i][k] = pos[(size_t)rq * 4 + k]; } }
        asm volatile("" ::: "memory");
#pragma unroll
        for (int i = 0; i < RB; ++i) { if (r0 + i * NGW >= nr) continue;
            float* xr = x_out_row(F, mb, rr[i]); float s = 0.f;
#pragma unroll
            for (int j = 0; j < 4; ++j) { v[i][j] = v[i][j] * ALPHA;
#pragma unroll
                for (int k = 0; k < 4; ++k) { const u32x2 w = ow[i][k][j]; v[i][j] = v[i][j] + (f32x4){blo(w.x), bhi(w.x), blo(w.y), bhi(w.y)}; }
                s += (v[i][j][0] + v[i][j][1]) + (v[i][j][2] + v[i][j][3]); }
            const float mean = wave_sum(s) * (1.0f / D); float s2 = 0.f;
#pragma unroll
            for (int j = 0; j < 4; ++j) { v[i][j] = v[i][j] - mean; s2 += (v[i][j][0] * v[i][j][0] + v[i][j][1] * v[i][j][1]) + (v[i][j][2] * v[i][j][2] + v[i][j][3] * v[i][j][3]); }
            const float rstd = 1.0f / sqrtf(wave_sum(s2) * (1.0f / D) + LN_EPS);
#pragma unroll
            for (int j = 0; j < 4; ++j) { v[i][j] = v[i][j] * rstd * gg[j] + bb[j];
                *((f32x4*)xr + lane + 64 * j) = v[i][j]; u32x2 w; w.x = pk2(v[i][j][0], v[i][j][1]); w.y = pk2(v[i][j][2], v[i][j][3]); *((u32x2*)(XB + (size_t)rr[i] * D) + lane + 64 * j) = w; } }
#ifndef EMU
#pragma unroll
        for (int i = 0; i < RB; ++i) asm volatile("" : "+v"(pn[i][0]), "+v"(pn[i][1]), "+v"(pn[i][2]), "+v"(pn[i][3]));
#endif
    }
}

constexpr int SP_P = 68;
template <int KS  > __device__ __forceinline__ void small_mma(const bf16_t* A, int lda, const bf16_t* Bt, int K, int tok0, int n0, int k0, int fr, int fq, f32x4 (&acc)[4]) {
    const bf16_t* ap = A + (size_t)(tok0 + fr) * lda + k0 + 8 * fq; const bf16_t* bp = Bt + (size_t)(n0 + fr) * K + k0 + 8 * fq;
#pragma unroll
    for (int k = 0; k < KS; k += 32) { const bf16x8 a = *(const bf16x8*)(ap + k);
#pragma unroll
        for (int jj = 0; jj < 4; ++jj) { const bf16x8 x = *(const bf16x8*)(bp + (size_t)16 * jj * K + k); acc[jj] = __builtin_amdgcn_mfma_f32_16x16x32_bf16(x, a, acc[jj], 0, 0, 0); } }
}
template <int MODE  >
__device__ __forceinline__ void sample_unit(const Frame& F, int layer, int u) {
    const int tid = F.tid, lane = F.lane, w = F.wave, fr = lane & 15, fq = lane >> 4; const int tok0 = NP + 16 * (u >> 4), n0 = 64 * (u & 15);
    LAS float* P = (LAS float*)F.lds;
    const bf16_t* H = ws_bf(F, WS_H); const size_t trow = (size_t)(tok0 + fr);
    f32x4 v[4];
#pragma unroll
    for (int jj = 0; jj < 4; ++jj) v[jj] = (f32x4){0.f, 0.f, 0.f, 0.f};
    if constexpr (MODE == 0) {
#pragma unroll
        for (int b = 0; b < 3; ++b) { f32x4 acc[4] = {(f32x4){0.f, 0.f, 0.f, 0.f}, (f32x4){0.f, 0.f, 0.f, 0.f}, (f32x4){0.f, 0.f, 0.f, 0.f}, (f32x4){0.f, 0.f, 0.f, 0.f}};
            if (b == 0) { small_mma<DINNER / 8>(H + C_Z, DINP, wl_ptr(F, layer, WL_SSD), DINNER, tok0, n0, w * (DINNER / 8), fr, fq, acc);
                const float* sq = ws_f(F, WS_SSQ) + trow * 128 + 16 * w; const f32x4 qa = (*(const f32x4*)sq + *(const f32x4*)(sq + 4)) + (*(const f32x4*)(sq + 8) + *(const f32x4*)(sq + 12)); const float rs = 1.0f / sqrtf(((qa[0] + qa[1]) + (qa[2] + qa[3])) * (1.0f / 256.0f) + LN_EPS);
#pragma unroll
                for (int jj = 0; jj < 4; ++jj) acc[jj] = acc[jj] * rs; }
            else small_mma<D / 8>(H + (b == 1 ? C_Q : C_SCB), DINP, wl_ptr(F, layer, b == 1 ? WL_ATT : WL_SC), D, tok0, n0, w * (D / 8), fr, fq, acc);
#pragma unroll
            for (int jj = 0; jj < 4; ++jj) { const u32x2 gw = *(const u32x2*)(H + trow * DINP + (b == 0 ? C_GSSD : (b == 1 ? C_GATT : C_GSC)) + n0 + 16 * jj + 4 * fq);
                v[jj] = v[jj] + acc[jj] * (f32x4){fsigmoid(blo(gw.x)), fsigmoid(bhi(gw.x)), fsigmoid(blo(gw.y)), fsigmoid(bhi(gw.y))}; } }
    } else small_mma<D / 8>(ws_bf(F, WS_XB), D, wl_ptr(F, layer, WL_O), D, tok0, n0, w * (D / 8), fr, fq, v);
    __syncthreads();
#pragma unroll
    for (int jj = 0; jj < 4; ++jj) *(LAS f32x4*)(P + (w * 16 + fr) * SP_P + 16 * jj + 4 * fq) = v[jj];
    __syncthreads();
    { const int tk = tid >> 5, c2 = 2 * (tid & 31); float s0 = 0.f, s1 = 0.f;
#pragma unroll
      for (int ww = 0; ww < 8; ++ww) { s0 += P[(ww * 16 + tk) * SP_P + c2]; s1 += P[(ww * 16 + tk) * SP_P + c2 + 1]; }
      const size_t orow = (size_t)(tok0 + tk);
      if constexpr (MODE == 0) *(unsigned*)(ws_bf(F, WS_XB) + orow * D + n0 + c2) = pk2(s0, s1);
      else { const float* xs = (layer == 0 ? F.in[I_XS] : F.out + O_YS) + (orow - NP) * D + n0 + c2; float* os = F.out + O_YS + (orow - NP) * D + n0 + c2; const float v0 = xs[0] * ALPHA + s0, v1 = xs[1] * ALPHA + s1; os[0] = v0; os[1] = v1;
          float t1 = v0 + v1, t2 = v0 * v0 + v1 * v1;
          t1 += xshfl<1>(t1); t1 += xshfl<2>(t1); t1 += xshfl<4>(t1); t1 += xshfl<8>(t1); t1 += xshfl<16>(t1); t2 += xshfl<1>(t2); t2 += xshfl<2>(t2); t2 += xshfl<4>(t2); t2 += xshfl<8>(t2); t2 += xshfl<16>(t2);
          if ((tid & 31) == 0) { float* sp = ws_f(F, WS_STAT) + orow * 32 + 2 * (u & 15); sp[0] = t1; sp[1] = t2; } } }
}

constexpr int PH_PER = 10, NSTEPS = 1 + NMB * DEPTH * PH_PER;
__global__ void __launch_bounds__(NTHREADS, 2) fwd(Args args) {
#ifdef EMU
    unsigned char* lds = emu_wg->lds;
#else
    extern __shared__ __attribute__((aligned(16))) unsigned char lds[];
#endif
    Frame F0; F0.lds = (LAS unsigned char*)lds; F0.tid = threadIdx.x; F0.lane = F0.tid & 63; F0.wave = __builtin_amdgcn_readfirstlane(F0.tid >> 6); F0.G = gridDim.x; F0.bid = blockIdx.x;
#ifdef EMU
    F0.in = args.in;
#else
    F0.in = (ArgTab)__builtin_amdgcn_kernarg_segment_ptr();
    static_assert(offsetof(Args, out) == 248 && offsetof(Args, ws) == 256 && offsetof(Args, in) == 0, "PF() reads the argument struct by offset");
#endif
    F0.out = args.out; F0.ws = args.ws; F0.ctl = (unsigned*)(args.ws + WS_CTL);
    const Frame& F = F0;
    const int lo = args.lo, hi = args.hi;
#ifndef EMU
    for (int u = F.tid; u < (LDS_BYTES - MISC_OFF) / 4; u += NTHREADS) ((LAS unsigned*)(F.lds + MISC_OFF))[u] = 0u;
    __syncthreads();
    XcdBarrier bar; bar.bar = F.ctl + CW_BAR; bar.x = 0; bar.st = nullptr;
    if (hi - lo > 1) bar = xcd_barrier_post(F.ctl + CW_BAR, (volatile LAS unsigned*)(F.lds + MISC_OFF) + 8);
#define SEAM(s) do { if ((s) + 1 < hi) { XcdBarrier b2_ = bar; unsigned long long bp_ = (unsigned long long)b2_.bar; asm volatile("" : "+s"(bp_)); b2_.bar = (unsigned*)bp_; xcd_barrier(b2_); } } while (0)
#else
#define SEAM(s) do { } while (0)
#endif
#ifndef PH_MASK
#define PH_MASK 0xFFFFFFFF
#endif
#define IN(s) (lo <= (s) && (s) < hi)
#define PHON(b) ((PH_MASK >> (b)) & 1)
#ifdef EMU
#define PF(Fp) Frame Fp = F0
#else
#define PF(Fp) Frame Fp; { unsigned long long kp_ = (unsigned long long)__builtin_amdgcn_kernarg_segment_ptr(); asm volatile("" : "+s"(kp_)); \
    Fp.in = (ArgTab)kp_; Fp.out = *(float* const __attribute__((address_space(4)))*)(kp_ + 248); Fp.ws = *(unsigned char* const __attribute__((address_space(4)))*)(kp_ + 256); Fp.ctl = (unsigned*)Fp.ws; \
    Fp.lds = F0.lds; Fp.G = F0.G; Fp.bid = F0.bid; Fp.wave = F0.wave; Fp.lane = opq(lane_id()); Fp.tid = Fp.wave * 64 + Fp.lane; }
#endif
    int step = 0;
    if (IN(step)) { PROBE_T0(0) if constexpr (PHON(0)) { PF(F); step_weights(F); for (int m = 0; m < NMB; ++m) step_xb(F, m);
        { bf16_t* rwh = ws_bf(F, WS_RWH); bf16_t* rwl = ws_bf(F, WS_RWL); const float* rw = F.in[I_RW];
#pragma nounroll
          for (int i = F.bid * NTHREADS + F.tid; i < DEPTH * NTE * 16 * D; i += F.G * NTHREADS) { const int l = i / (NTE * 16 * D), e = (i / D) % (NTE * 16), k = i % D;
              const float wv = e < NEXP ? rw[((size_t)l * D + k) * NEXP + e] : 0.f; const unsigned hi = f2bf(wv); rwh[i] = (bf16_t)hi; rwl[i] = (bf16_t)f2bf(wv - bf2f(hi)); } } } PROBE_T1(0) SEAM(step); }
    ++step;
#define PHV const int mb = opqs(mb0), layer = opqs(layer0), nr = rows_of(mb); (void)nr; (void)layer
    for (int mb0 = 0; mb0 < NMB; ++mb0)
        for (int layer0 = 0; layer0 < DEPTH; ++layer0) {
            if (IN(step)) { PROBE_T0(2) if constexpr (PHON(2)) { PF(F); PHV; pg8::Gemm g{layer == 0 ? ws_bf(F, WS_XB0) + (size_t)mb * R * D : ws_bf(F, WS_XB), wl_ptr(F, layer, WL_IN), nr, DINP, D, D, nullptr}; pg8::StaticOrder S; S.init(nr, DINP, F.G, F.bid, 2);
                pg8::EpiStoreBf16 E{ws_bf(F, WS_H), DINP}; pg8::gemm_phase(F.lds, g, S, E, F.wave); } PROBE_T1(2) SEAM(step); }
            ++step;
            if (IN(step)) { PROBE_T0(13) if constexpr (PHON(13)) { PF(F); PHV; step_premix(F, layer, mb); } PROBE_T1(13) SEAM(step); }
            ++step;
            if (IN(step)) { PROBE_T0(3) if constexpr (PHON(3)) { PF(F); PHV; step_mixers(F, layer, mb); } PROBE_T1(3) SEAM(step); }
            ++step;
            if (IN(step)) { PROBE_T0(5) if constexpr (PHON(5)) { PF(F); PHV; pg8::StaticOrder S; S.init(NP, D, F.G, F.bid); bf16_t* H = ws_bf(F, WS_H); bf16_t* MGb = ws_bf(F, WS_XB);
#ifndef MERGE_MASK
#define MERGE_MASK 7
#endif
                if constexpr (MERGE_MASK & 1) { pg8::Gemm g{H + C_Z, wl_ptr(F, layer, WL_SSD), NP, D, DINNER, DINP, nullptr, ws_f(F, WS_SSQ)}; pg8::EpiGate<0> E{H + C_GSSD, MGb}; pg8::gemm_phase<pg8::EpiGate<0>, pg8::StaticOrder, false, true>(F.lds, g, S, E, F.wave); }
                if constexpr (MERGE_MASK & 2) { pg8::Gemm g{H + C_Q, wl_ptr(F, layer, WL_ATT), NP, D, D, DINP, nullptr}; pg8::EpiGate<1> E{H + C_GATT, MGb}; pg8::gemm_phase(F.lds, g, S, E, F.wave); }
                if constexpr (MERGE_MASK & 4) { pg8::Gemm g{H + C_SCB, wl_ptr(F, layer, WL_SC), NP, D, D, DINP, nullptr}; pg8::EpiGate<1> E{H + C_GSC, MGb}; pg8::gemm_phase(F.lds, g, S, E, F.wave); }
                if (mb == 0) for (int u = F.bid; u < 256; u += F.G) sample_unit<0>(F, layer, u); }
                PROBE_T1(5) SEAM(step); }
            ++step;
            if (IN(step)) { PROBE_T0(6) if constexpr (PHON(6)) { PF(F); PHV; pg8::Gemm g{ws_bf(F, WS_XB), wl_ptr(F, layer, WL_O), NP, D, D, D, nullptr}; pg8::StaticOrder S; S.init(NP, D, F.G, F.bid);
                pg8::EpiResid E{layer == 0 ? F.in[I_XP] + (size_t)mb * NP * D : F.out + O_YP + (size_t)mb * NP * D, layer == 0 ? F.in[I_XS] : F.out + O_YS, F.out + O_YP + (size_t)mb * NP * D, F.out + O_YS, ws_f(F, WS_STAT)};
                pg8::gemm_phase(F.lds, g, S, E, F.wave);
                if (mb == 0) for (int u = F.bid; u < 256; u += F.G) sample_unit<1>(F, layer, u); } PROBE_T1(6) SEAM(step); }
            ++step;
            if (IN(step)) { PROBE_T0(7) if constexpr (PHON(7)) { PF(F); PHV; step_ln1_router_mfma(F, layer, mb); } PROBE_T1(7) SEAM(step); }
            ++step;
            if (IN(step)) { PROBE_T0(8) if constexpr (PHON(8)) { PF(F); PHV; step_gather(F, layer, mb); } PROBE_T1(8) SEAM(step); }
            ++step;
            if (IN(step)) { PROBE_T0(9) if constexpr (PHON(9)) { PF(F); PHV; const int nt = moe_table(F, layer, mb); pg8::MoeOrder S{(const LAS int*)(F.lds + MISC_OFF) + 16, 8, nt * 8, F.G, F.bid};
                pg8::Gemm g{ws_bf(F, WS_XB), wl_ptr(F, layer, WL_UP), nr  , 2048, D, D, (const int*)(F.ws + WS_RTOK)}; pg8::EpiSwiglu E{ws_bf(F, WS_H) + (size_t)RP * D, F.in[I_BUP] + (size_t)layer * NEXP * 2048, F.lds};
                pg8::gemm_phase<pg8::EpiSwiglu, pg8::MoeOrder, true>(F.lds, g, S, E, F.wave); } PROBE_T1(9) SEAM(step); }
            ++step;
            if (IN(step)) { PROBE_T0(10) if constexpr (PHON(10)) { PF(F); PHV; const int nt = moe_table(F, layer, mb); pg8::MoeOrder S{(const LAS int*)(F.lds + MISC_OFF) + 16, 4, nt * 4, F.G, F.bid};
                pg8::Gemm g{ws_bf(F, WS_H) + (size_t)RP * D, wl_ptr(F, layer, WL_DN), nt * 256, D, D, D, nullptr}; pg8::EpiDown E{ws_bf(F, WS_H) + (size_t)2 * RP * D, F.in[I_BDN] + (size_t)layer * NEXP * D, ws_f(F, WS_GSORT), F.lds};
                pg8::gemm_phase(F.lds, g, S, E, F.wave); } PROBE_T1(10) SEAM(step); }
            ++step;
            if (IN(step)) { PROBE_T0(11) if constexpr (PHON(11)) { PF(F); PHV; step_ln2(F, layer, mb); } PROBE_T1(11) SEAM(step); }
            ++step;
        }
}

#ifdef EMU
extern int emu_grid, emu_step_lo, emu_step_hi;
#endif
extern "C" void kernel_launch(void* const* d_in, const int* in_sizes, int n_in, void* d_out, int out_size, void* d_ws, size_t ws_size, hipStream_t stream) {
    (void)in_sizes; (void)out_size;
    if (n_in != 31 || ws_size < WS_END) { fprintf(stderr, "kernel_launch: expected 31 inputs and >= %zu bytes of workspace (got %d, %zu)\n", (size_t)WS_END, n_in, ws_size); return; }
    Args a; memset(&a, 0, sizeof(a));
    for (int i = 0; i < 31; ++i) a.in[i] = (const float*)d_in[i];
    a.out = (float*)d_out; a.ws = (unsigned char*)d_ws;
#ifdef EMU
    if (emu_step_lo == 0) memset((char*)d_ws + WS_CTL, 0, CTL_BYTES);
    for (int s = emu_step_lo; s < emu_step_hi && s < NSTEPS; ++s) { a.lo = s; a.hi = s + 1; emu_launch(fwd, emu_grid, NTHREADS, LDS_BYTES, a); fprintf(stderr, "step %d done\n", s); }
#else
    (void)hipMemsetAsync((char*)d_ws + WS_CTL, 0, CTL_BYTES, stream);
    static int grid = 0;
    if (grid == 0) {
        int dev = 0, cus = 0;
        if (hipGetDevice(&dev) != hipSuccess || hipDeviceGetAttribute(&cus, hipDeviceAttributeMultiprocessorCount, dev) != hipSuccess) { grid = -1; return; }
        if (hipFuncSetAttribute((const void*)fwd, hipFuncAttributeMaxDynamicSharedMemorySize, LDS_BYTES) != hipSuccess) { grid = -1; return; }
        int per_cu = 0; (void)hipOccupancyMaxActiveBlocksPerMultiprocessor(&per_cu, (const void*)fwd, NTHREADS, LDS_BYTES); (void)hipGetLastError();
        grid = cus / 64 * 64;
        if (grid < 64) { grid = -1; return; }
    }
    if (grid < 0) return;
#if CFG_ONE_LAUNCH
    a.lo = 0; a.hi = NSTEPS; hipLaunchKernelGGL(fwd, dim3(grid), dim3(NTHREADS), LDS_BYTES, stream, a);
#else
    for (int s = 0; s < NSTEPS; ++s) { a.lo = s; a.hi = s + 1; hipLaunchKernelGGL(fwd, dim3(grid), dim3(NTHREADS), LDS_BYTES, stream, a); }
#endif
#endif
}
```
